# Optimizing an MI355X kernel written in HIP

```python
import jax, jax.numpy as jnp
from jax import lax
import numpy as np

D_MODEL = 2048
BATCH = 4
SEQ = 4096
DEPTH = 1

NORM_EPS = 1e-6
MIX_WIDTH = D_MODEL
GLA_HEADS = 4
GLA_WIDTH = MIX_WIDTH // 2
GLA_DV = GLA_WIDTH // GLA_HEADS
GLA_DK = GLA_DV // 2
GLA_GATE_RANK = 16
GLA_TAU = 16.0
GLA_CHUNK = 64
DIL_HD = 128
DIL_WIDTH = MIX_WIDTH - GLA_WIDTH
DIL_HEADS = DIL_WIDTH // DIL_HD
DIL_PATTERNS = ((128, 1), (512, 4), (2048, 16))
DIL_BLOCK = 64
ROPE_THETA = 10000.0
NEG_INF = -1e30
PEER_HEADS = 8
PEER_NKEYS = 128
PEER_NEXPERTS = PEER_NKEYS * PEER_NKEYS
PEER_QDIM = 256
PEER_TOPK = 16
PEER_TOKEN_BLOCK = 128
IN_SIZES = (GLA_HEADS * GLA_DK, GLA_HEADS * GLA_DK, GLA_WIDTH, GLA_WIDTH,
            GLA_GATE_RANK, GLA_GATE_RANK, DIL_WIDTH, DIL_WIDTH, DIL_WIDTH)
IN_WIDTH = sum(IN_SIZES)

kernel_name = "hybrid_gla_dilated_peer_encoder_block"


def rms_norm(x, g):
    xf = x.astype(jnp.float32)
    y = xf * lax.rsqrt(jnp.mean(xf * xf, axis=-1, keepdims=True) + NORM_EPS)
    return (y * g.astype(jnp.float32)).astype(x.dtype)


def split_cols(t, sizes):
    outs, start = [], 0
    for s in sizes:
        outs.append(t[..., start:start + s])
        start += s
    return outs


def apply_rope(t, positions):
    hd = t.shape[-1]
    half = hd // 2
    inv_freq = jnp.power(ROPE_THETA, -jnp.arange(half, dtype=jnp.float32) * 2.0 / hd)
    ang = positions.astype(jnp.float32)[..., None] * inv_freq
    cos = jnp.cos(ang)[:, :, None, :]
    sin = jnp.sin(ang)[:, :, None, :]
    tf = t.astype(jnp.float32)
    t1, t2 = tf[..., :half], tf[..., half:]
    return jnp.concatenate([t1 * cos - t2 * sin, t1 * sin + t2 * cos], axis=-1).astype(t.dtype)


def gla_chunked(q, k, v, log_a):
    B, S, H, dk = q.shape
    dv = v.shape[-1]
    C = GLA_CHUNK
    n = S // C

    def to_chunks(t):
        return t.reshape(B, n, C, H, t.shape[-1]).transpose(1, 0, 3, 2, 4)

    qc, kc, vc = to_chunks(q), to_chunks(k), to_chunks(v.astype(jnp.float32))
    b = jnp.cumsum(to_chunks(log_a).astype(jnp.float32), axis=-2)
    b_last = b[..., -1:, :]
    q_dec = qc.astype(jnp.float32) * jnp.exp(b)
    k_inv = kc.astype(jnp.float32) * jnp.exp(-b)
    k_to_end = kc.astype(jnp.float32) * jnp.exp(b_last - b)
    lower = jnp.tril(jnp.ones((C, C), dtype=bool))
    attn = jnp.where(lower, jnp.einsum('nbhid,nbhjd->nbhij', q_dec, k_inv), 0.0)
    o_intra = jnp.einsum('nbhij,nbhjv->nbhiv', attn, vc)

    def step(state, inp):
        kt, vt, decay = inp
        new = state * decay[:, :, 0, :, None] + jnp.einsum('bhcd,bhcv->bhdv', kt, vt)
        return new, state

    state0 = jnp.zeros((B, H, dk, dv), jnp.float32)
    _, states = lax.scan(step, state0, (k_to_end, vc, jnp.exp(b_last)))
    o_inter = jnp.einsum('nbhid,nbhdv->nbhiv', q_dec, states)
    return (o_intra + o_inter).transpose(1, 0, 3, 2, 4).reshape(B, S, H, dv)


def gla_mixer(q, k, v, r, gz_f, gz_b, w_gate_f, b_gate_f, w_gate_b, b_gate_b, g_gla_out):
    B, S, _ = q.shape
    q = q.reshape(B, S, GLA_HEADS, GLA_DK) * (GLA_DK ** -0.5)
    k = k.reshape(B, S, GLA_HEADS, GLA_DK)
    v = v.reshape(B, S, GLA_HEADS, GLA_DV)

    def log_gate(gz, w, bias):
        z = gz.astype(jnp.float32) @ w.astype(jnp.float32) + bias.astype(jnp.float32)
        return (jax.nn.log_sigmoid(z) / GLA_TAU).reshape(B, S, GLA_HEADS, GLA_DK)

    la_f = log_gate(gz_f, w_gate_f, b_gate_f)
    la_b = log_gate(gz_b, w_gate_b, b_gate_b)
    o_f = gla_chunked(q, k, v, la_f)
    flip = lambda t: jnp.flip(t, axis=1)
    o_b = flip(gla_chunked(flip(q), flip(k), flip(v), flip(la_b)))
    o = rms_norm(o_f + o_b, g_gla_out)
    return o.reshape(B, S, GLA_WIDTH).astype(r.dtype) * jax.nn.silu(r)


def dilated_band_attention(q, k, v, dilation, half):
    B, S, H, hd = q.shape
    M = S // dilation
    N = B * dilation

    def split(t):
        return t.reshape(B, M, dilation, H, hd).transpose(0, 2, 1, 3, 4).reshape(N, M, H, hd)

    qs, ks, vs = split(q), split(k), split(v)
    Qb = DIL_BLOCK
    nb = -(-M // Qb)
    Mp = nb * Qb
    L = Qb + 2 * half
    qs = jnp.pad(qs, ((0, 0), (0, Mp - M), (0, 0), (0, 0)))
    pad_kv = ((0, 0), (half, Mp - M + half), (0, 0), (0, 0))
    ks = jnp.pad(ks, pad_kv)
    vs = jnp.pad(vs, pad_kv)
    kidx = jnp.arange(nb)[:, None] * Qb + jnp.arange(L)[None, :]
    kb = ks[:, kidx]
    vb = vs[:, kidx].astype(jnp.float32)
    qb = qs.reshape(N, nb, Qb, H, hd)
    s = jnp.einsum('nbqhd,nbkhd->nbhqk', qb, kb).astype(jnp.float32) * (hd ** -0.5)
    qpos = jnp.arange(nb)[:, None] * Qb + jnp.arange(Qb)[None, :]
    kpos = kidx - half
    rel = kpos[:, None, :] - qpos[:, :, None]
    valid = (jnp.abs(rel) <= half) & (kpos[:, None, :] >= 0) & (kpos[:, None, :] < M)
    s = jnp.where(valid[None, :, None], s, NEG_INF)
    m = jnp.max(s, axis=-1, keepdims=True)
    p = jnp.exp(s - m)
    den = jnp.sum(p, axis=-1, keepdims=True)
    o = jnp.einsum('nbhqk,nbkhd->nbqhd', p / den, vb)
    lse = (m + jnp.log(den))[..., 0].transpose(0, 1, 3, 2)
    o = o.reshape(N, Mp, H, hd)[:, :M]
    lse = lse.reshape(N, Mp, H)[:, :M]

    def merge(t):
        return t.reshape(B, dilation, M, *t.shape[2:]).swapaxes(1, 2).reshape(B, S, *t.shape[2:])

    return merge(o), merge(lse)


def dilated_mixer(q, k, v, positions):
    B, S, _ = q.shape
    q = apply_rope(q.reshape(B, S, DIL_HEADS, DIL_HD), positions)
    k = apply_rope(k.reshape(B, S, DIL_HEADS, DIL_HD), positions)
    v = v.reshape(B, S, DIL_HEADS, DIL_HD)
    outs, lses = [], []
    for window, dilation in DIL_PATTERNS:
        o, l = dilated_band_attention(q, k, v, dilation, window // (2 * dilation))
        outs.append(o)
        lses.append(l)
    w = jax.nn.softmax(jnp.stack(lses, axis=0), axis=0)
    o = jnp.sum(w[..., None] * jnp.stack(outs, axis=0), axis=0)
    return o.reshape(B, S, DIL_WIDTH).astype(q.dtype)


def peer_ffn(h, w_peer_q, peer_sub_keys, peer_u, peer_v):
    B, S, D = h.shape
    T = B * S
    x = h.reshape(T, D)
    q = (x @ w_peer_q).reshape(T, PEER_HEADS, 2, PEER_QDIM // 2)
    scores = jnp.einsum('thsd,hskd->thsk', q, peer_sub_keys).astype(jnp.float32)
    top_s, top_i = lax.top_k(scores, PEER_TOPK)
    cand_s = (top_s[:, :, 0, :, None] + top_s[:, :, 1, None, :]).reshape(T, PEER_HEADS, PEER_TOPK * PEER_TOPK)
    cand_i = (top_i[:, :, 0, :, None] * PEER_NKEYS + top_i[:, :, 1, None, :]).reshape(T, PEER_HEADS, PEER_TOPK * PEER_TOPK)
    best_s, pos = lax.top_k(cand_s, PEER_TOPK)
    idx = jnp.take_along_axis(cand_i, pos, axis=-1)
    gate = jax.nn.softmax(best_s, axis=-1)
    Tb = PEER_TOKEN_BLOCK
    nblk = T // Tb
    HK = PEER_HEADS * PEER_TOPK

    def block(args):
        xb, ib, gb = args
        a = jnp.einsum('tkd,td->tk', peer_u[ib], xb).astype(jnp.float32)
        wgt = (gb * jax.nn.gelu(a, approximate=False)).astype(xb.dtype)
        return jnp.einsum('tk,tkd->td', wgt, peer_v[ib])

    out = lax.map(block, (x.reshape(nblk, Tb, D), idx.reshape(nblk, Tb, HK), gate.reshape(nblk, Tb, HK)))
    return out.reshape(B, S, D)


def setup_inputs(seed: int = 0) -> dict:
    key = jax.random.key(seed)
    ks = jax.random.split(key, 20)
    nrm = lambda k, shape, std: jax.random.normal(k, shape, jnp.float32) * std
    L, D = DEPTH, D_MODEL
    return {
        "x": nrm(ks[0], (BATCH, SEQ, D), 1.0),
        "c": nrm(ks[1], (BATCH, D), 1.0),
        "positions": jnp.broadcast_to(jnp.arange(SEQ, dtype=jnp.int32), (BATCH, SEQ)),
        "w_ada": nrm(ks[2], (L, D, 6 * D), 0.5 * D ** -0.5),
        "b_ada": nrm(ks[3], (L, 6 * D), 0.02),
        "g_norm_mix": 1.0 + nrm(ks[4], (L, D), 0.02),
        "w_in": nrm(ks[5], (L, D, IN_WIDTH), D ** -0.5),
        "w_gate_f": nrm(ks[6], (L, GLA_GATE_RANK, GLA_HEADS * GLA_DK), GLA_GATE_RANK ** -0.5),
        "b_gate_f": nrm(ks[7], (L, GLA_HEADS * GLA_DK), 0.1),
        "w_gate_b": nrm(ks[8], (L, GLA_GATE_RANK, GLA_HEADS * GLA_DK), GLA_GATE_RANK ** -0.5),
        "b_gate_b": nrm(ks[9], (L, GLA_HEADS * GLA_DK), 0.1),
        "g_gla_out": 1.0 + nrm(ks[10], (L, GLA_HEADS, GLA_DV), 0.02),
        "w_out": nrm(ks[11], (L, MIX_WIDTH, D), MIX_WIDTH ** -0.5),
        "g_norm_ffn": 1.0 + nrm(ks[12], (L, D), 0.02),
        "w_peer_q": nrm(ks[13], (L, D, PEER_HEADS * PEER_QDIM), D ** -0.5),
        "peer_sub_keys": nrm(ks[14], (L, PEER_HEADS, 2, PEER_NKEYS, PEER_QDIM // 2), (PEER_QDIM // 2) ** -0.5),
        "peer_u": nrm(ks[15], (L, PEER_NEXPERTS, D), D ** -0.5),
        "peer_v": nrm(ks[16], (L, PEER_NEXPERTS, D), 0.5),
        "g_final": 1.0 + nrm(ks[17], (D,), 0.02),
    }


def reference(x, c, positions, w_ada, b_ada, g_norm_mix, w_in, w_gate_f, b_gate_f, w_gate_b, b_gate_b,
              g_gla_out, w_out, g_norm_ffn, w_peer_q, peer_sub_keys, peer_u, peer_v, g_final):
    for l in range(DEPTH):
        mod = jax.nn.silu(c) @ w_ada[l] + b_ada[l]
        sh_a, sc_a, ga_a, sh_f, sc_f, ga_f = [m[:, None, :] for m in jnp.split(mod, 6, axis=-1)]
        h = rms_norm(x, g_norm_mix[l]) * (1.0 + sc_a) + sh_a
        proj = h @ w_in[l]
        gq, gk, gv, gr, gz_f, gz_b, dq, dk, dv = split_cols(proj, IN_SIZES)
        o_gla = gla_mixer(gq, gk, gv, gr, gz_f, gz_b, w_gate_f[l], b_gate_f[l], w_gate_b[l], b_gate_b[l], g_gla_out[l])
        o_dil = dilated_mixer(dq, dk, dv, positions)
        mixed = jnp.concatenate([o_gla, o_dil], axis=-1) @ w_out[l]
        x = x + ga_a * mixed
        h = rms_norm(x, g_norm_ffn[l]) * (1.0 + sc_f) + sh_f
        x = x + ga_f * peer_ffn(h, w_peer_q[l], peer_sub_keys[l], peer_u[l], peer_v[l])
    return rms_norm(x, g_final)
```

```cpp
#include <hip/hip_runtime.h>
#include <hip/hip_cooperative_groups.h>
#include <cstdio>
#include <cstdint>

namespace cg = cooperative_groups;

typedef unsigned short u16;
typedef __attribute__((ext_vector_type(8))) short bf16x8;
typedef __attribute__((ext_vector_type(4))) float f32x4;

constexpr int D = 2048, NB = 4, S = 4096, T = NB * S;
constexpr int INW = 6176;
constexpr int NP = 6144;
constexpr int NPAD = 6272;
constexpr int C_GQ = 0, C_GK = 512, C_GV = 1024, C_GR = 2048, C_DQ = 3072, C_DK = 4096, C_DV = 5120;
constexpr int NTHREADS = 512, NWAVES = 8;
constexpr int LDS_BYTES = 128 * 1024;
constexpr float NORM_EPS = 1e-6f;

constexpr size_t WS_CTL = 0;
constexpr size_t WS_MOD = 65536;
constexpr size_t WS_CS = 524288;
constexpr size_t WS_WIN = WS_CS + (size_t)T * 64 * 8;
constexpr size_t WS_WOUT = WS_WIN + (size_t)NPAD * D * 2;
constexpr size_t WS_WPQ = WS_WOUT + (size_t)D * D * 2;
constexpr size_t WS_ACT = WS_WPQ + (size_t)D * D * 2;
constexpr size_t WS_P = WS_ACT + (size_t)T * D * 2;
constexpr size_t WS_X1 = WS_P;
constexpr size_t WS_Q = WS_P + (size_t)T * D * 4;
constexpr size_t WS_GZ = WS_P + (size_t)T * NP * 2;
constexpr size_t WS_LA = WS_GZ + (size_t)T * 32 * 4;
constexpr size_t WS_OFB = WS_LA + (size_t)2 * T * 512 * 4;
constexpr size_t WS_IDX = WS_OFB + (size_t)2 * T * 1024 * 4;
constexpr size_t WS_GATE = WS_IDX + (size_t)T * 128 * 4;
constexpr size_t WS_END = WS_GATE + (size_t)T * 128 * 4;

struct Args {
    const float* x; const float* c; const int* pos; const float* w_ada; const float* b_ada; const float* g_mix;
    const float* w_in; const float* wgf; const float* bgf; const float* wgb; const float* bgb; const float* g_gla;
    const float* w_out; const float* g_ffn; const float* w_pq; const float* subk; const float* pu; const float* pv; const float* g_fin;
    float* out; unsigned char* ws; int ph_lo, ph_hi;
};

__device__ __forceinline__ float bf2f(u16 h) { return __uint_as_float(((unsigned)h) << 16); }
__device__ __forceinline__ u16 f2bf(float f) { unsigned u = __float_as_uint(f); u += 0x7fffu + ((u >> 16) & 1u); return (u16)(u >> 16); }
__device__ __forceinline__ unsigned pack2(float a, float b) { return (unsigned)f2bf(a) | ((unsigned)f2bf(b) << 16); }
__device__ __forceinline__ float lo2f(unsigned p) { return __uint_as_float(p << 16); }
__device__ __forceinline__ float hi2f(unsigned p) { return __uint_as_float(p & 0xffff0000u); }
__device__ __forceinline__ float wave_sum(float v) {
#pragma unroll
    for (int o = 32; o > 0; o >>= 1) v += __shfl_xor(v, o);
    return v;
}
__device__ __forceinline__ float wave_max(float v) {
#pragma unroll
    for (int o = 32; o > 0; o >>= 1) v = fmaxf(v, __shfl_xor(v, o));
    return v;
}
__device__ __forceinline__ float silu_f(float v) { return v / (1.f + __expf(-v)); }
__device__ __forceinline__ float gelu_f(float a) { return 0.5f * a * (1.f + erff(a * 0.70710678118654752f)); }
__device__ __forceinline__ float logsigmoid_f(float z) { return z < 0.f ? z - log1pf(expf(z)) : -log1pf(expf(-z)); }

__device__ __forceinline__ void p0_mod(const Args& a, unsigned char* lds, int bi) {
    float* sc = (float*)lds;
    float* red = sc + 4 * 2048;
    const int tid = threadIdx.x, lane = tid & 63, wave = tid >> 6;
    for (int i = tid; i < 4 * 2048; i += NTHREADS) sc[i] = silu_f(a.c[i]);
    __syncthreads();
    const int j0 = bi * 256 + lane * 4;
    float acc[4][4];
#pragma unroll
    for (int b = 0; b < 4; ++b)
#pragma unroll
        for (int q = 0; q < 4; ++q) acc[b][q] = 0.f;
    const int k0 = wave * 256;
#pragma unroll 4
    for (int kk = 0; kk < 256; ++kk) {
        const int k = k0 + kk;
        const float4 w = *(const float4*)(a.w_ada + (size_t)k * 12288 + j0);
#pragma unroll
        for (int b = 0; b < 4; ++b) {
            const float s = sc[b * 2048 + k];
            acc[b][0] += s * w.x; acc[b][1] += s * w.y; acc[b][2] += s * w.z; acc[b][3] += s * w.w;
        }
    }
#pragma unroll
    for (int b = 0; b < 4; ++b)
#pragma unroll
        for (int q = 0; q < 4; ++q) red[(wave * 4 + b) * 256 + lane * 4 + q] = acc[b][q];
    __syncthreads();
    float* mod = (float*)(a.ws + WS_MOD);
    for (int i = tid; i < 4 * 256; i += NTHREADS) {
        const int b = i >> 8, jc = i & 255;
        float s = 0.f;
#pragma unroll
        for (int w = 0; w < 8; ++w) s += red[(w * 4 + b) * 256 + jc];
        mod[b * 12288 + bi * 256 + jc] = s + a.b_ada[bi * 256 + jc];
    }
    __syncthreads();
}

__device__ __forceinline__ void p0_transpose_item(const float* __restrict__ W, int ldw, int k0, int src_col0, int n_valid,
                                                  u16* __restrict__ WT, int ldt, int n_out0, unsigned char* lds) {
    u16* tl = (u16*)lds;
    const int tid = threadIdx.x;
    {
        const int k = tid >> 3, nc = (tid & 7) * 8;
        float v[8];
        if (nc < n_valid) {
            const float4 v0 = *(const float4*)(W + (size_t)(k0 + k) * ldw + src_col0 + nc);
            const float4 v1 = *(const float4*)(W + (size_t)(k0 + k) * ldw + src_col0 + nc + 4);
            v[0] = v0.x; v[1] = v0.y; v[2] = v0.z; v[3] = v0.w; v[4] = v1.x; v[5] = v1.y; v[6] = v1.z; v[7] = v1.w;
        } else {
#pragma unroll
            for (int i = 0; i < 8; ++i) v[i] = 0.f;
        }
#pragma unroll
        for (int i = 0; i < 8; ++i) tl[(nc + i) * 72 + k] = f2bf(v[i]);
    }
    __syncthreads();
    {
        const int n = tid >> 3, kc = (tid & 7) * 8;
        const uint4 v = *(const uint4*)(tl + n * 72 + kc);
        *(uint4*)(WT + (size_t)(n_out0 + n) * ldt + k0 + kc) = v;
    }
    __syncthreads();
}

__device__ __forceinline__ void phase0(const Args& a, unsigned char* lds) {
    const int bi = blockIdx.x, G = gridDim.x, tid = threadIdx.x;
    if (bi < 48) p0_mod(a, lds, bi);
    constexpr int I_IN = 32 * (NPAD / 64), I_SQ = 32 * 32;
    u16* WinT = (u16*)(a.ws + WS_WIN); u16* WoutT = (u16*)(a.ws + WS_WOUT); u16* WpqT = (u16*)(a.ws + WS_WPQ);
    for (int it = bi; it < I_IN + 2 * I_SQ; it += G) {
        if (it < I_IN) {
            const int kt = it & 31, nt = it >> 5;
            const int n0 = nt * 64;
            int src, nv;
            if (n0 < 3072) { src = n0; nv = 64; }
            else if (n0 < 6144) { src = n0 + 32; nv = 64; }
            else if (n0 == 6144) { src = 3072; nv = 32; }
            else { src = 0; nv = 0; }
            p0_transpose_item(a.w_in, INW, kt * 64, src, nv, WinT, D, n0, lds);
        } else if (it < I_IN + I_SQ) {
            const int r = it - I_IN; const int kt = r & 31, nt = r >> 5;
            p0_transpose_item(a.w_out, D, kt * 64, nt * 64, 64, WoutT, D, nt * 64, lds);
        } else {
            const int r = it - I_IN - I_SQ; const int kt = r & 31, nt = r >> 5;
            p0_transpose_item(a.w_pq, D, kt * 64, nt * 64, 64, WpqT, D, nt * 64, lds);
        }
    }
    float2* cs = (float2*)(a.ws + WS_CS);
    for (int i = bi * NTHREADS + tid; i < T * 64; i += G * NTHREADS) {
        const int t = i >> 6, f = i & 63;
        const float inv_freq = powf(10000.0f, -(float)f * 2.0f / 128.0f);
        const float ang = (float)a.pos[t] * inv_freq;
        const double rev = (double)ang * 0.15915494309189533577;
        const float fr = (float)(rev - floor(rev));
        cs[i] = make_float2(__builtin_amdgcn_cosf(fr), __builtin_amdgcn_sinf(fr));
    }
}

__device__ __forceinline__ void norm_mod_phase(const float* __restrict__ xin, const float* __restrict__ g, const float* __restrict__ mod,
                                               int sh_chunk, int sc_chunk, u16* __restrict__ outp) {
    const int lane = threadIdx.x & 63, wave = threadIdx.x >> 6;
    const int gw = blockIdx.x * NWAVES + wave, NGW = gridDim.x * NWAVES;
    for (int t = gw; t < T; t += NGW) {
        const int b = t / S;
        const float4* xr = (const float4*)(xin + (size_t)t * D);
        float4 v[8]; float ss = 0.f;
#pragma unroll
        for (int m = 0; m < 8; ++m) { v[m] = xr[lane + 64 * m]; ss += v[m].x * v[m].x + v[m].y * v[m].y + v[m].z * v[m].z + v[m].w * v[m].w; }
        ss = wave_sum(ss);
        const float rstd = rsqrtf(ss * (1.f / D) + NORM_EPS);
        const float4* gp = (const float4*)g;
        const float4* shp = (const float4*)(mod + b * 12288 + sh_chunk * 2048);
        const float4* scp = (const float4*)(mod + b * 12288 + sc_chunk * 2048);
        uint2* op = (uint2*)(outp + (size_t)t * D);
#pragma unroll
        for (int m = 0; m < 8; ++m) {
            const int i = lane + 64 * m;
            const float4 gg = gp[i], sh = shp[i], sc = scp[i];
            const float h0 = v[m].x * rstd * gg.x * (1.f + sc.x) + sh.x;
            const float h1 = v[m].y * rstd * gg.y * (1.f + sc.y) + sh.y;
            const float h2 = v[m].z * rstd * gg.z * (1.f + sc.z) + sh.z;
            const float h3 = v[m].w * rstd * gg.w * (1.f + sc.w) + sh.w;
            op[i] = make_uint2(pack2(h0, h1), pack2(h2, h3));
        }
    }
}

struct EpiProj {
    u16* P; float* gz;
    __device__ __forceinline__ void operator()(int row, int col, float v) const {
        if (col < NP) P[(size_t)row * NP + col] = f2bf(v);
        else if (col < NP + 32) gz[(size_t)row * 32 + (col - NP)] = v;
    }
};
struct EpiResid {
    const float* x; const float* mod; float* x1;
    __device__ __forceinline__ void operator()(int row, int col, float v) const {
        const int b = row / S;
        x1[(size_t)row * D + col] = x[(size_t)row * D + col] + mod[b * 12288 + 2 * 2048 + col] * v;
    }
};
struct EpiBf16 {
    u16* Q;
    __device__ __forceinline__ void operator()(int row, int col, float v) const { Q[(size_t)row * D + col] = f2bf(v); }
};

template <class Epi>
__device__ __forceinline__ void gemm_phase(unsigned char* lds, const u16* __restrict__ A, const u16* __restrict__ Bt, int M, int N, int K, const Epi epi) {
    constexpr int BM = 256, BN = 128, BK = 32, LS = 40;
    u16* As = (u16*)lds;
    u16* Bs = As + BM * LS;
    const int tid = threadIdx.x, lane = tid & 63, wave = tid >> 6, wm = wave >> 1, wn = wave & 1;
    const int fr = lane & 15, fq = lane >> 4;
    const int ntm = M / BM, ntn = N / BN, ntiles = ntm * ntn, nk = K / BK;
    const int lr = tid >> 2, lk = (tid & 3) * 8;
    for (int tile = blockIdx.x; tile < ntiles; tile += gridDim.x) {
        const int tm = tile % ntm, tn = tile / ntm;
        const int row0 = tm * BM, col0 = tn * BN;
        f32x4 acc[4][4];
#pragma unroll
        for (int m = 0; m < 4; ++m)
#pragma unroll
            for (int n = 0; n < 4; ++n) acc[m][n] = (f32x4){0.f, 0.f, 0.f, 0.f};
        const u16* ag0 = A + (size_t)(row0 + lr) * K + lk;
        const u16* ag1 = A + (size_t)(row0 + 128 + lr) * K + lk;
        const u16* bg = Bt + (size_t)(col0 + lr) * K + lk;
        uint4 ra0 = *(const uint4*)ag0, ra1 = *(const uint4*)ag1, rb = *(const uint4*)bg;
        for (int kt = 0; kt < nk; ++kt) {
            __syncthreads();
            *(uint4*)(As + lr * LS + lk) = ra0;
            *(uint4*)(As + (128 + lr) * LS + lk) = ra1;
            *(uint4*)(Bs + lr * LS + lk) = rb;
            __syncthreads();
            if (kt + 1 < nk) {
                ra0 = *(const uint4*)(ag0 + (kt + 1) * BK);
                ra1 = *(const uint4*)(ag1 + (kt + 1) * BK);
                rb = *(const uint4*)(bg + (kt + 1) * BK);
            }
            bf16x8 af[4], bfr[4];
#pragma unroll
            for (int m = 0; m < 4; ++m) af[m] = *(const bf16x8*)(As + (wm * 64 + m * 16 + fr) * LS + fq * 8);
#pragma unroll
            for (int n = 0; n < 4; ++n) bfr[n] = *(const bf16x8*)(Bs + (wn * 64 + n * 16 + fr) * LS + fq * 8);
#pragma unroll
            for (int m = 0; m < 4; ++m)
#pragma unroll
                for (int n = 0; n < 4; ++n) acc[m][n] = __builtin_amdgcn_mfma_f32_16x16x32_bf16(af[m], bfr[n], acc[m][n], 0, 0, 0);
        }
#pragma unroll
        for (int m = 0; m < 4; ++m)
#pragma unroll
            for (int n = 0; n < 4; ++n)
#pragma unroll
                for (int j = 0; j < 4; ++j)
                    epi(row0 + wm * 64 + m * 16 + fq * 4 + j, col0 + wn * 64 + n * 16 + fr, acc[m][n][j]);
    }
    __syncthreads();
}

__device__ __forceinline__ void phase_rope_gates(const Args& a) {
    u16* P = (u16*)(a.ws + WS_P);
    const float2* cs = (const float2*)(a.ws + WS_CS);
    const int gt = blockIdx.x * NTHREADS + threadIdx.x, NT = gridDim.x * NTHREADS;
    for (int i = gt; i < T * 2 * 8 * 64; i += NT) {
        const int f = i & 63, hh = (i >> 6) & 7, which = (i >> 9) & 1, t = i >> 10;
        const float2 c = cs[t * 64 + f];
        u16* p = P + (size_t)t * NP + (which ? C_DK : C_DQ) + hh * 128 + f;
        const float t1 = bf2f(p[0]), t2 = bf2f(p[64]);
        p[0] = f2bf(t1 * c.x - t2 * c.y);
        p[64] = f2bf(t1 * c.y + t2 * c.x);
    }
    const float* gz = (const float*)(a.ws + WS_GZ);
    float* la = (float*)(a.ws + WS_LA);
    for (int i = gt; i < 2 * T * 512; i += NT) {
        const int col = i & 511, t = (i >> 9) % T, dir = i / (T * 512);
        const float* w = dir ? a.wgb : a.wgf; const float* bb = dir ? a.bgb : a.bgf;
        float z = bb[col];
#pragma unroll
        for (int r = 0; r < 16; ++r) z += gz[(size_t)t * 32 + dir * 16 + r] * w[r * 512 + col];
        la[i] = logsigmoid_f(z) * (1.f / 16.f);
    }
}

__device__ __forceinline__ void gla_naive_item(const Args& a, unsigned char* lds, int item) {
    const int slice = item & 3, dir = (item >> 2) & 1, hh = (item >> 3) & 3, b = item >> 5;
    float* qs = (float*)lds;
    float* ks = qs + 32 * 128;
    float* as = ks + 32 * 128;
    float* vs = as + 32 * 128;
    float* po = vs + 32 * 64;
    const u16* P = (const u16*)(a.ws + WS_P);
    const float* la = (const float*)(a.ws + WS_LA) + (size_t)dir * T * 512;
    float* O = (float*)(a.ws + WS_OFB) + (size_t)dir * T * 1024;
    const int tid = threadIdx.x, g = tid >> 6, j = tid & 63;
    float st[16];
#pragma unroll
    for (int i = 0; i < 16; ++i) st[i] = 0.f;
    const float qscale = 0.08838834764831845f;
    for (int ch = 0; ch < S / 32; ++ch) {
        for (int e = tid; e < 32 * 128; e += NTHREADS) {
            const int i = e >> 7, d = e & 127;
            const int s = dir ? (S - 1 - (ch * 32 + i)) : (ch * 32 + i);
            const size_t t = (size_t)b * S + s;
            qs[e] = bf2f(P[t * NP + C_GQ + hh * 128 + d]) * qscale;
            ks[e] = bf2f(P[t * NP + C_GK + hh * 128 + d]);
            as[e] = expf(la[t * 512 + hh * 128 + d]);
        }
        for (int e = tid; e < 32 * 64; e += NTHREADS) {
            const int i = e >> 6, jj = e & 63;
            const int s = dir ? (S - 1 - (ch * 32 + i)) : (ch * 32 + i);
            const size_t t = (size_t)b * S + s;
            vs[e] = bf2f(P[t * NP + C_GV + hh * 256 + slice * 64 + jj]);
        }
        __syncthreads();
        for (int i = 0; i < 32; ++i) {
            const float vv = vs[i * 64 + j];
            float p = 0.f;
#pragma unroll
            for (int dd = 0; dd < 16; ++dd) {
                const int d = g * 16 + dd;
                st[dd] = as[i * 128 + d] * st[dd] + ks[i * 128 + d] * vv;
                p += qs[i * 128 + d] * st[dd];
            }
            po[(i * 8 + g) * 64 + j] = p;
        }
        __syncthreads();
        for (int e = tid; e < 32 * 64; e += NTHREADS) {
            const int i = e >> 6, jj = e & 63;
            float sum = 0.f;
#pragma unroll
            for (int gg = 0; gg < 8; ++gg) sum += po[(i * 8 + gg) * 64 + jj];
            const int s = dir ? (S - 1 - (ch * 32 + i)) : (ch * 32 + i);
            const size_t t = (size_t)b * S + s;
            O[t * 1024 + hh * 256 + slice * 64 + jj] = sum;
        }
        __syncthreads();
    }
}

__device__ __forceinline__ void attn_naive(const Args& a, int wave_id, int nwaves) {
    const u16* P = (const u16*)(a.ws + WS_P);
    u16* A2 = (u16*)(a.ws + WS_ACT);
    const int lane = threadIdx.x & 63;
    const float scale = 0.08838834764831845f;
    for (int item = wave_id; item < T * 8; item += nwaves) {
        const int hh = item & 7, t = item >> 3;
        const int b = t / S, s = t % S;
        const unsigned qp = *(const unsigned*)(P + (size_t)t * NP + C_DQ + hh * 128 + 2 * lane);
        const float q0 = lo2f(qp) * scale, q1 = hi2f(qp) * scale;
        float m = -1e30f, l = 0.f, o0 = 0.f, o1 = 0.f;
#pragma unroll 1
        for (int pat = 0; pat < 3; ++pat) {
            const int dil = pat == 0 ? 1 : (pat == 1 ? 4 : 16);
#pragma unroll 2
            for (int j = -64; j <= 64; ++j) {
                const int sk = s + dil * j;
                if (sk < 0 || sk >= S) continue;
                const size_t tk = (size_t)b * S + sk;
                const unsigned kp = *(const unsigned*)(P + tk * NP + C_DK + hh * 128 + 2 * lane);
                const unsigned vp = *(const unsigned*)(P + tk * NP + C_DV + hh * 128 + 2 * lane);
                float sc = wave_sum(q0 * lo2f(kp) + q1 * hi2f(kp));
                const float mn = fmaxf(m, sc);
                const float al = __expf(m - mn), p = __expf(sc - mn);
                l = l * al + p;
                o0 = o0 * al + p * lo2f(vp);
                o1 = o1 * al + p * hi2f(vp);
                m = mn;
            }
        }
        const float inv = 1.f / l;
        *(unsigned*)(A2 + (size_t)t * D + 1024 + hh * 128 + 2 * lane) = pack2(o0 * inv, o1 * inv);
    }
}

__device__ __forceinline__ void phase_mixers(const Args& a, unsigned char* lds) {
    const int bi = blockIdx.x, G = gridDim.x;
    if (bi < 128) {
        gla_naive_item(a, lds, bi);
    } else {
        const int wave = threadIdx.x >> 6;
        attn_naive(a, (bi - 128) * NWAVES + wave, (G - 128) * NWAVES);
    }
}

__device__ __forceinline__ void phase_gla_fin(const Args& a) {
    const float* Of = (const float*)(a.ws + WS_OFB);
    const float* Ob = Of + (size_t)T * 1024;
    const u16* P = (const u16*)(a.ws + WS_P);
    u16* A2 = (u16*)(a.ws + WS_ACT);
    const int lane = threadIdx.x & 63, wave = threadIdx.x >> 6;
    const int gw = blockIdx.x * NWAVES + wave, NGW = gridDim.x * NWAVES;
    for (int item = gw; item < T * 4; item += NGW) {
        const int hh = item & 3, t = item >> 2;
        const size_t base = (size_t)t * 1024 + hh * 256 + lane * 4;
        const float4 f = *(const float4*)(Of + base), bb = *(const float4*)(Ob + base);
        const float o0 = f.x + bb.x, o1 = f.y + bb.y, o2 = f.z + bb.z, o3 = f.w + bb.w;
        const float ss = wave_sum(o0 * o0 + o1 * o1 + o2 * o2 + o3 * o3);
        const float rstd = rsqrtf(ss * (1.f / 256.f) + NORM_EPS);
        const float4 gg = *(const float4*)(a.g_gla + hh * 256 + lane * 4);
        const uint2 rp = *(const uint2*)(P + (size_t)t * NP + C_GR + hh * 256 + lane * 4);
        const float r0 = lo2f(rp.x), r1 = hi2f(rp.x), r2 = lo2f(rp.y), r3 = hi2f(rp.y);
        const float y0 = o0 * rstd * gg.x * silu_f(r0), y1 = o1 * rstd * gg.y * silu_f(r1);
        const float y2 = o2 * rstd * gg.z * silu_f(r2), y3 = o3 * rstd * gg.w * silu_f(r3);
        *(uint2*)(A2 + (size_t)t * D + hh * 256 + lane * 4) = make_uint2(pack2(y0, y1), pack2(y2, y3));
    }
}

__device__ __forceinline__ void phase_route(const Args& a) {
    const u16* Q = (const u16*)(a.ws + WS_Q);
    int* IDX = (int*)(a.ws + WS_IDX);
    float* GATE = (float*)(a.ws + WS_GATE);
    const int lane = threadIdx.x & 63, wave = threadIdx.x >> 6;
    const int gw = blockIdx.x * NWAVES + wave, NGW = gridDim.x * NWAVES;
    for (int item = gw; item < T * 8; item += NGW) {
        const int hh = item & 7, t = item >> 3;
        float ts[2]; int ti[2];
        ts[0] = ts[1] = 0.f; ti[0] = ti[1] = 0;
#pragma unroll
        for (int half = 0; half < 2; ++half) {
            const u16* qp = Q + (size_t)t * D + hh * 256 + half * 128;
            const float* k0p = a.subk + ((size_t)(hh * 2 + half) * 128 + lane) * 128;
            const float* k1p = k0p + 64 * 128;
            float v0 = 0.f, v1 = 0.f;
            for (int d = 0; d < 128; d += 4) {
                const uint2 qq = *(const uint2*)(qp + d);
                const float4 ka = *(const float4*)(k0p + d), kb = *(const float4*)(k1p + d);
                const float x0 = lo2f(qq.x), x1 = hi2f(qq.x), x2 = lo2f(qq.y), x3 = hi2f(qq.y);
                v0 += x0 * ka.x + x1 * ka.y + x2 * ka.z + x3 * ka.w;
                v1 += x0 * kb.x + x1 * kb.y + x2 * kb.z + x3 * kb.w;
            }
            float mys = 0.f; int myi = 0;
            for (int it = 0; it < 16; ++it) {
                const float lm = fmaxf(v0, v1);
                const float wm = wave_max(lm);
                const unsigned long long bal = __ballot(lm == wm);
                const int src = __ffsll((long long)bal) - 1;
                const int which = (v0 >= v1) ? 0 : 1;
                const int kidx = __shfl(lane + 64 * which, src);
                if (lane == src) { if (which == 0) v0 = -3.0e38f; else v1 = -3.0e38f; }
                if (lane == it) { mys = wm; myi = kidx; }
            }
            ts[half] = mys; ti[half] = myi;
        }
        float cv[4];
#pragma unroll
        for (int r = 0; r < 4; ++r) {
            const int c = lane + 64 * r;
            cv[r] = __shfl(ts[0], c >> 4) + __shfl(ts[1], c & 15);
        }
        float bs = 0.f; int bc = 0;
        for (int it = 0; it < 16; ++it) {
            const float lm = fmaxf(fmaxf(cv[0], cv[1]), fmaxf(cv[2], cv[3]));
            const float wm = wave_max(lm);
            const unsigned long long bal = __ballot(lm == wm);
            const int src = __ffsll((long long)bal) - 1;
            int which = 3;
            if (cv[2] == lm) which = 2;
            if (cv[1] == lm) which = 1;
            if (cv[0] == lm) which = 0;
            const int cidx = __shfl(lane + 64 * which, src);
            if (lane == src) {
                if (which == 0) cv[0] = -3.0e38f; else if (which == 1) cv[1] = -3.0e38f; else if (which == 2) cv[2] = -3.0e38f; else cv[3] = -3.0e38f;
            }
            if (lane == it) { bs = wm; bc = cidx; }
        }
        const float top = __shfl(bs, 0);
        const float e = (lane < 16) ? __expf(bs - top) : 0.f;
        const float den = wave_sum(e);
        const int i0 = __shfl(ti[0], bc >> 4), i1 = __shfl(ti[1], bc & 15);
        if (lane < 16) {
            IDX[(size_t)t * 128 + hh * 16 + lane] = i0 * 128 + i1;
            GATE[(size_t)t * 128 + hh * 16 + lane] = e / den;
        }
    }
}

__device__ __forceinline__ void phase_experts(const Args& a) {
    const u16* H2 = (const u16*)(a.ws + WS_ACT);
    const float* X1 = (const float*)(a.ws + WS_X1);
    const int* IDX = (const int*)(a.ws + WS_IDX);
    const float* GATE = (const float*)(a.ws + WS_GATE);
    const float* mod = (const float*)(a.ws + WS_MOD);
    const int lane = threadIdx.x & 63, wave = threadIdx.x >> 6;
    const int gw = blockIdx.x * NWAVES + wave, NGW = gridDim.x * NWAVES;
    for (int t = gw; t < T; t += NGW) {
        const int b = t / S;
        float4 h[8], acc[8];
        {
            const uint2* hp = (const uint2*)(H2 + (size_t)t * D);
#pragma unroll
            for (int m = 0; m < 8; ++m) {
                const uint2 p = hp[lane + 64 * m];
                h[m] = make_float4(lo2f(p.x), hi2f(p.x), lo2f(p.y), hi2f(p.y));
                acc[m] = make_float4(0.f, 0.f, 0.f, 0.f);
            }
        }
#pragma unroll 1
        for (int r = 0; r < 128; ++r) {
            const int e = __builtin_amdgcn_readfirstlane(IDX[(size_t)t * 128 + r]);
            const float gt = GATE[(size_t)t * 128 + r];
            const float4* up = (const float4*)(a.pu + (size_t)e * D);
            const float4* vp = (const float4*)(a.pv + (size_t)e * D);
            float4 u[8], vv[8];
#pragma unroll
            for (int m = 0; m < 8; ++m) u[m] = up[lane + 64 * m];
#pragma unroll
            for (int m = 0; m < 8; ++m) vv[m] = vp[lane + 64 * m];
            float dsum = 0.f;
#pragma unroll
            for (int m = 0; m < 8; ++m) dsum += u[m].x * h[m].x + u[m].y * h[m].y + u[m].z * h[m].z + u[m].w * h[m].w;
            dsum = wave_sum(dsum);
            const float w = gt * gelu_f(dsum);
#pragma unroll
            for (int m = 0; m < 8; ++m) { acc[m].x += w * vv[m].x; acc[m].y += w * vv[m].y; acc[m].z += w * vv[m].z; acc[m].w += w * vv[m].w; }
        }
        const float4* x1p = (const float4*)(X1 + (size_t)t * D);
        const float4* gap = (const float4*)(mod + b * 12288 + 5 * 2048);
        float ss = 0.f;
#pragma unroll
        for (int m = 0; m < 8; ++m) {
            const float4 xv = x1p[lane + 64 * m], ga = gap[lane + 64 * m];
            acc[m].x = xv.x + ga.x * acc[m].x; acc[m].y = xv.y + ga.y * acc[m].y; acc[m].z = xv.z + ga.z * acc[m].z; acc[m].w = xv.w + ga.w * acc[m].w;
            ss += acc[m].x * acc[m].x + acc[m].y * acc[m].y + acc[m].z * acc[m].z + acc[m].w * acc[m].w;
        }
        ss = wave_sum(ss);
        const float rstd = rsqrtf(ss * (1.f / D) + NORM_EPS);
        const float4* gf = (const float4*)a.g_fin;
        float4* op = (float4*)(a.out + (size_t)t * D);
#pragma unroll
        for (int m = 0; m < 8; ++m) {
            const float4 g = gf[lane + 64 * m];
            op[lane + 64 * m] = make_float4(acc[m].x * rstd * g.x, acc[m].y * rstd * g.y, acc[m].z * rstd * g.z, acc[m].w * rstd * g.w);
        }
    }
}

constexpr int NPHASES = 11;
__global__ void __launch_bounds__(NTHREADS, 2) mk_fwd(Args a) {
    extern __shared__ __attribute__((aligned(16))) unsigned char lds[];
    cg::grid_group grid = cg::this_grid();
    const int lo = a.ph_lo, hi = a.ph_hi;
#define IN(k) (lo <= (k) && (k) < hi)
#define SEAM(k) do { if (IN(k) && IN((k) + 1)) grid.sync(); } while (0)
    const float* mod = (const float*)(a.ws + WS_MOD);
    if (IN(0)) phase0(a, lds);
    SEAM(0);
    if (IN(1)) norm_mod_phase(a.x, a.g_mix, mod, 0, 1, (u16*)(a.ws + WS_ACT));
    SEAM(1);
    if (IN(2)) gemm_phase(lds, (const u16*)(a.ws + WS_ACT), (const u16*)(a.ws + WS_WIN), T, NPAD, D, EpiProj{(u16*)(a.ws + WS_P), (float*)(a.ws + WS_GZ)});
    SEAM(2);
    if (IN(3)) phase_rope_gates(a);
    SEAM(3);
    if (IN(4)) phase_mixers(a, lds);
    SEAM(4);
    if (IN(5)) phase_gla_fin(a);
    SEAM(5);
    if (IN(6)) gemm_phase(lds, (const u16*)(a.ws + WS_ACT), (const u16*)(a.ws + WS_WOUT), T, D, D, EpiResid{a.x, mod, (float*)(a.ws + WS_X1)});
    SEAM(6);
    if (IN(7)) norm_mod_phase((const float*)(a.ws + WS_X1), a.g_ffn, mod, 3, 4, (u16*)(a.ws + WS_ACT));
    SEAM(7);
    if (IN(8)) gemm_phase(lds, (const u16*)(a.ws + WS_ACT), (const u16*)(a.ws + WS_WPQ), T, D, D, EpiBf16{(u16*)(a.ws + WS_Q)});
    SEAM(8);
    if (IN(9)) phase_route(a);
    SEAM(9);
    if (IN(10)) phase_experts(a);
#undef IN
#undef SEAM
}

#ifndef MK_ONE_LAUNCH
#define MK_ONE_LAUNCH 0
#endif
extern "C" void kernel_launch(void* const* d_in, const int* in_sizes, int n_in, void* d_out, int out_size, void* d_ws, size_t ws_size, hipStream_t stream) {
    static int grid = 0;
    if (grid == 0) {
        if (n_in != 19 || out_size != T * D || ws_size < WS_END) {
            fprintf(stderr, "kernel_launch: unexpected shapes: n_in %d out %d ws %zu (need %zu)\n", n_in, out_size, ws_size, (size_t)WS_END);
            grid = -1; return;
        }
        int dev = 0, cus = 0, per_cu = 0;
        (void)hipGetDevice(&dev);
        (void)hipDeviceGetAttribute(&cus, hipDeviceAttributeMultiprocessorCount, dev);
        (void)hipFuncSetAttribute((const void*)mk_fwd, hipFuncAttributeMaxDynamicSharedMemorySize, LDS_BYTES);
        (void)hipOccupancyMaxActiveBlocksPerMultiprocessor(&per_cu, (const void*)mk_fwd, NTHREADS, LDS_BYTES);
        if (per_cu < 1) { fprintf(stderr, "kernel_launch: occupancy query says %d blocks/CU\n", per_cu); grid = -1; return; }
        grid = cus;
        (void)hipGetLastError();
    }
    if (grid < 0) return;
    Args a{};
    a.x = (const float*)d_in[0]; a.c = (const float*)d_in[1]; a.pos = (const int*)d_in[2]; a.w_ada = (const float*)d_in[3];
    a.b_ada = (const float*)d_in[4]; a.g_mix = (const float*)d_in[5]; a.w_in = (const float*)d_in[6]; a.wgf = (const float*)d_in[7];
    a.bgf = (const float*)d_in[8]; a.wgb = (const float*)d_in[9]; a.bgb = (const float*)d_in[10]; a.g_gla = (const float*)d_in[11];
    a.w_out = (const float*)d_in[12]; a.g_ffn = (const float*)d_in[13]; a.w_pq = (const float*)d_in[14]; a.subk = (const float*)d_in[15];
    a.pu = (const float*)d_in[16]; a.pv = (const float*)d_in[17]; a.g_fin = (const float*)d_in[18];
    a.out = (float*)d_out; a.ws = (unsigned char*)d_ws;
#if MK_ONE_LAUNCH
    a.ph_lo = 0; a.ph_hi = NPHASES;
    void* args[] = {&a};
    hipError_t e = hipLaunchCooperativeKernel((const void*)mk_fwd, dim3(grid), dim3(NTHREADS), args, LDS_BYTES, stream);
    if (e != hipSuccess) fprintf(stderr, "cooperative launch failed: %s (grid %d)\n", hipGetErrorString(e), grid);
#else
    for (int p = 0; p < NPHASES; ++p) {
        a.ph_lo = p; a.ph_hi = p + 1;
        hipLaunchKernelGGL(mk_fwd, dim3(grid), dim3(NTHREADS), LDS_BYTES, stream, a);
    }
#endif
}
```

```cpp
#include <hip/hip_runtime.h>
#include <hip/hip_cooperative_groups.h>
#include <cstdio>
#include <cstdint>

namespace cg = cooperative_groups;

typedef unsigned short u16;
typedef __attribute__((ext_vector_type(8))) short bf16x8;
typedef __attribute__((ext_vector_type(4))) float f32x4;

constexpr int D = 2048, NB = 4, S = 4096, T = NB * S;
constexpr int INW = 6176;
constexpr int NP = 6144;
constexpr int NPAD = 6272;
constexpr int C_GQ = 0, C_GK = 512, C_GV = 1024, C_GR = 2048, C_DQ = 3072, C_DK = 4096, C_DV = 5120;
constexpr int NTHREADS = 512, NWAVES = 8;
constexpr int LDS_BYTES = 128 * 1024;
constexpr float NORM_EPS = 1e-6f;

constexpr size_t WS_CTL = 0;
constexpr size_t WS_MOD = 65536;
constexpr size_t WS_CS = 524288;
constexpr size_t WS_WIN = WS_CS + (size_t)T * 64 * 8;
constexpr size_t WS_WOUT = WS_WIN + (size_t)NPAD * D * 2;
constexpr size_t WS_WPQ = WS_WOUT + (size_t)D * D * 2;
constexpr size_t WS_ACT = WS_WPQ + (size_t)D * D * 2;
constexpr size_t WS_P = WS_ACT + (size_t)T * D * 2;
constexpr size_t WS_X1 = WS_P;
constexpr size_t WS_Q = WS_P + (size_t)T * D * 4;
constexpr size_t WS_GZ = WS_P + (size_t)T * NP * 2;
constexpr size_t WS_LA = WS_GZ + (size_t)T * 32 * 4;
constexpr size_t WS_OFB = WS_LA + (size_t)2 * T * 512 * 4;
constexpr size_t WS_IDX = WS_OFB + (size_t)2 * T * 1024 * 4;
constexpr size_t WS_GATE = WS_IDX + (size_t)T * 128 * 4;
constexpr size_t WS_END = WS_GATE + (size_t)T * 128 * 4;

struct Args {
    const float* x; const float* c; const int* pos; const float* w_ada; const float* b_ada; const float* g_mix;
    const float* w_in; const float* wgf; const float* bgf; const float* wgb; const float* bgb; const float* g_gla;
    const float* w_out; const float* g_ffn; const float* w_pq; const float* subk; const float* pu; const float* pv; const float* g_fin;
    float* out; unsigned char* ws; int ph_lo, ph_hi;
};

__device__ __forceinline__ float bf2f(u16 h) { return __uint_as_float(((unsigned)h) << 16); }
__device__ __forceinline__ u16 f2bf(float f) { unsigned u = __float_as_uint(f); u += 0x7fffu + ((u >> 16) & 1u); return (u16)(u >> 16); }
__device__ __forceinline__ unsigned pack2(float a, float b) { return (unsigned)f2bf(a) | ((unsigned)f2bf(b) << 16); }
__device__ __forceinline__ float lo2f(unsigned p) { return __uint_as_float(p << 16); }
__device__ __forceinline__ float hi2f(unsigned p) { return __uint_as_float(p & 0xffff0000u); }
__device__ __forceinline__ float wave_sum(float v) {
#pragma unroll
    for (int o = 32; o > 0; o >>= 1) v += __shfl_xor(v, o);
    return v;
}
__device__ __forceinline__ float wave_max(float v) {
#pragma unroll
    for (int o = 32; o > 0; o >>= 1) v = fmaxf(v, __shfl_xor(v, o));
    return v;
}
__device__ __forceinline__ float silu_f(float v) { return v / (1.f + __expf(-v)); }
__device__ __forceinline__ float gelu_f(float a) { return 0.5f * a * (1.f + erff(a * 0.70710678118654752f)); }
__device__ __forceinline__ float logsigmoid_f(float z) { return z < 0.f ? z - log1pf(expf(z)) : -log1pf(expf(-z)); }

__device__ __forceinline__ void p0_mod(const Args& a, unsigned char* lds, int bi) {
    float* sc = (float*)lds;
    float* red = sc + 4 * 2048;
    const int tid = threadIdx.x, lane = tid & 63, wave = tid >> 6;
    for (int i = tid; i < 4 * 2048; i += NTHREADS) sc[i] = silu_f(a.c[i]);
    __syncthreads();
    const int j0 = bi * 256 + lane * 4;
    float acc[4][4];
#pragma unroll
    for (int b = 0; b < 4; ++b)
#pragma unroll
        for (int q = 0; q < 4; ++q) acc[b][q] = 0.f;
    const int k0 = wave * 256;
#pragma unroll 4
    for (int kk = 0; kk < 256; ++kk) {
        const int k = k0 + kk;
        const float4 w = *(const float4*)(a.w_ada + (size_t)k * 12288 + j0);
#pragma unroll
        for (int b = 0; b < 4; ++b) {
            const float s = sc[b * 2048 + k];
            acc[b][0] += s * w.x; acc[b][1] += s * w.y; acc[b][2] += s * w.z; acc[b][3] += s * w.w;
        }
    }
#pragma unroll
    for (int b = 0; b < 4; ++b)
#pragma unroll
        for (int q = 0; q < 4; ++q) red[(wave * 4 + b) * 256 + lane * 4 + q] = acc[b][q];
    __syncthreads();
    float* mod = (float*)(a.ws + WS_MOD);
    for (int i = tid; i < 4 * 256; i += NTHREADS) {
        const int b = i >> 8, jc = i & 255;
        float s = 0.f;
#pragma unroll
        for (int w = 0; w < 8; ++w) s += red[(w * 4 + b) * 256 + jc];
        mod[b * 12288 + bi * 256 + jc] = s + a.b_ada[bi * 256 + jc];
    }
    __syncthreads();
}

__device__ __forceinline__ void p0_transpose_item(const float* __restrict__ W, int ldw, int k0, int src_col0, int n_valid,
                                                  u16* __restrict__ WT, int ldt, int n_out0, unsigned char* lds) {
    u16* tl = (u16*)lds;
    const int tid = threadIdx.x;
    {
        const int k = tid >> 3, nc = (tid & 7) * 8;
        float v[8];
        if (nc < n_valid) {
            const float4 v0 = *(const float4*)(W + (size_t)(k0 + k) * ldw + src_col0 + nc);
            const float4 v1 = *(const float4*)(W + (size_t)(k0 + k) * ldw + src_col0 + nc + 4);
            v[0] = v0.x; v[1] = v0.y; v[2] = v0.z; v[3] = v0.w; v[4] = v1.x; v[5] = v1.y; v[6] = v1.z; v[7] = v1.w;
        } else {
#pragma unroll
            for (int i = 0; i < 8; ++i) v[i] = 0.f;
        }
#pragma unroll
        for (int i = 0; i < 8; ++i) tl[(nc + i) * 72 + k] = f2bf(v[i]);
    }
    __syncthreads();
    {
        const int n = tid >> 3, kc = (tid & 7) * 8;
        const uint4 v = *(const uint4*)(tl + n * 72 + kc);
        *(uint4*)(WT + (size_t)(n_out0 + n) * ldt + k0 + kc) = v;
    }
    __syncthreads();
}

__device__ __forceinline__ void phase0(const Args& a, unsigned char* lds) {
    const int bi = blockIdx.x, G = gridDim.x, tid = threadIdx.x;
    if (bi < 48) p0_mod(a, lds, bi);
    constexpr int I_IN = 32 * (NPAD / 64), I_SQ = 32 * 32;
    u16* WinT = (u16*)(a.ws + WS_WIN); u16* WoutT = (u16*)(a.ws + WS_WOUT); u16* WpqT = (u16*)(a.ws + WS_WPQ);
    for (int it = bi; it < I_IN + 2 * I_SQ; it += G) {
        if (it < I_IN) {
            const int kt = it & 31, nt = it >> 5;
            const int n0 = nt * 64;
            int src, nv;
            if (n0 < 3072) { src = n0; nv = 64; }
            else if (n0 < 6144) { src = n0 + 32; nv = 64; }
            else if (n0 == 6144) { src = 3072; nv = 32; }
            else { src = 0; nv = 0; }
            p0_transpose_item(a.w_in, INW, kt * 64, src, nv, WinT, D, n0, lds);
        } else if (it < I_IN + I_SQ) {
            const int r = it - I_IN; const int kt = r & 31, nt = r >> 5;
            p0_transpose_item(a.w_out, D, kt * 64, nt * 64, 64, WoutT, D, nt * 64, lds);
        } else {
            const int r = it - I_IN - I_SQ; const int kt = r & 31, nt = r >> 5;
            p0_transpose_item(a.w_pq, D, kt * 64, nt * 64, 64, WpqT, D, nt * 64, lds);
        }
    }
    float2* cs = (float2*)(a.ws + WS_CS);
    for (int i = bi * NTHREADS + tid; i < T * 64; i += G * NTHREADS) {
        const int t = i >> 6, f = i & 63;
        const float inv_freq = powf(10000.0f, -(float)f * 2.0f / 128.0f);
        const float ang = (float)a.pos[t] * inv_freq;
        const double rev = (double)ang * 0.15915494309189533577;
        const float fr = (float)(rev - floor(rev));
        cs[i] = make_float2(__builtin_amdgcn_cosf(fr), __builtin_amdgcn_sinf(fr));
    }
}

__device__ __forceinline__ void norm_mod_phase(const float* __restrict__ xin, const float* __restrict__ g, const float* __restrict__ mod,
                                               int sh_chunk, int sc_chunk, u16* __restrict__ outp) {
    const int lane = threadIdx.x & 63, wave = threadIdx.x >> 6;
    const int gw = blockIdx.x * NWAVES + wave, NGW = gridDim.x * NWAVES;
    for (int t = gw; t < T; t += NGW) {
        const int b = t / S;
        const float4* xr = (const float4*)(xin + (size_t)t * D);
        float4 v[8]; float ss = 0.f;
#pragma unroll
        for (int m = 0; m < 8; ++m) { v[m] = xr[lane + 64 * m]; ss += v[m].x * v[m].x + v[m].y * v[m].y + v[m].z * v[m].z + v[m].w * v[m].w; }
        ss = wave_sum(ss);
        const float rstd = rsqrtf(ss * (1.f / D) + NORM_EPS);
        const float4* gp = (const float4*)g;
        const float4* shp = (const float4*)(mod + b * 12288 + sh_chunk * 2048);
        const float4* scp = (const float4*)(mod + b * 12288 + sc_chunk * 2048);
        uint2* op = (uint2*)(outp + (size_t)t * D);
#pragma unroll
        for (int m = 0; m < 8; ++m) {
            const int i = lane + 64 * m;
            const float4 gg = gp[i], sh = shp[i], sc = scp[i];
            const float h0 = v[m].x * rstd * gg.x * (1.f + sc.x) + sh.x;
            const float h1 = v[m].y * rstd * gg.y * (1.f + sc.y) + sh.y;
            const float h2 = v[m].z * rstd * gg.z * (1.f + sc.z) + sh.z;
            const float h3 = v[m].w * rstd * gg.w * (1.f + sc.w) + sh.w;
            op[i] = make_uint2(pack2(h0, h1), pack2(h2, h3));
        }
    }
}

struct EpiProj {
    u16* P; float* gz;
    __device__ __forceinline__ void operator()(int row, int col, float v) const {
        if (col < NP) P[(size_t)row * NP + col] = f2bf(v);
        else if (col < NP + 32) gz[(size_t)row * 32 + (col - NP)] = v;
    }
};
struct EpiResid {
    const float* x; const float* mod; float* x1;
    __device__ __forceinline__ void operator()(int row, int col, float v) const {
        const int b = row / S;
        x1[(size_t)row * D + col] = x[(size_t)row * D + col] + mod[b * 12288 + 2 * 2048 + col] * v;
    }
};
struct EpiBf16 {
    u16* Q;
    __device__ __forceinline__ void operator()(int row, int col, float v) const { Q[(size_t)row * D + col] = f2bf(v); }
};

template <class Epi>
__device__ __forceinline__ void gemm_phase(unsigned char* lds, const u16* __restrict__ A, const u16* __restrict__ Bt, int M, int N, int K, const Epi epi) {
    constexpr int BM = 256, BN = 128, BK = 32, LS = 40;
    u16* As = (u16*)lds;
    u16* Bs = As + BM * LS;
    const int tid = threadIdx.x, lane = tid & 63, wave = tid >> 6, wm = wave >> 1, wn = wave & 1;
    const int fr = lane & 15, fq = lane >> 4;
    const int ntm = M / BM, ntn = N / BN, ntiles = ntm * ntn, nk = K / BK;
    const int lr = tid >> 2, lk = (tid & 3) * 8;
    for (int tile = blockIdx.x; tile < ntiles; tile += gridDim.x) {
        const int tm = tile % ntm, tn = tile / ntm;
        const int row0 = tm * BM, col0 = tn * BN;
        f32x4 acc[4][4];
#pragma unroll
        for (int m = 0; m < 4; ++m)
#pragma unroll
            for (int n = 0; n < 4; ++n) acc[m][n] = (f32x4){0.f, 0.f, 0.f, 0.f};
        const u16* ag0 = A + (size_t)(row0 + lr) * K + lk;
        const u16* ag1 = A + (size_t)(row0 + 128 + lr) * K + lk;
        const u16* bg = Bt + (size_t)(col0 + lr) * K + lk;
        uint4 ra0 = *(const uint4*)ag0, ra1 = *(const uint4*)ag1, rb = *(const uint4*)bg;
        for (int kt = 0; kt < nk; ++kt) {
            __syncthreads();
            *(uint4*)(As + lr * LS + lk) = ra0;
            *(uint4*)(As + (128 + lr) * LS + lk) = ra1;
            *(uint4*)(Bs + lr * LS + lk) = rb;
            __syncthreads();
            if (kt + 1 < nk) {
                ra0 = *(const uint4*)(ag0 + (kt + 1) * BK);
                ra1 = *(const uint4*)(ag1 + (kt + 1) * BK);
                rb = *(const uint4*)(bg + (kt + 1) * BK);
            }
            bf16x8 af[4], bfr[4];
#pragma unroll
            for (int m = 0; m < 4; ++m) af[m] = *(const bf16x8*)(As + (wm * 64 + m * 16 + fr) * LS + fq * 8);
#pragma unroll
            for (int n = 0; n < 4; ++n) bfr[n] = *(const bf16x8*)(Bs + (wn * 64 + n * 16 + fr) * LS + fq * 8);
#pragma unroll
            for (int m = 0; m < 4; ++m)
#pragma unroll
                for (int n = 0; n < 4; ++n) acc[m][n] = __builtin_amdgcn_mfma_f32_16x16x32_bf16(af[m], bfr[n], acc[m][n], 0, 0, 0);
        }
#pragma unroll
        for (int m = 0; m < 4; ++m)
#pragma unroll
            for (int n = 0; n < 4; ++n)
#pragma unroll
                for (int j = 0; j < 4; ++j)
                    epi(row0 + wm * 64 + m * 16 + fq * 4 + j, col0 + wn * 64 + n * 16 + fr, acc[m][n][j]);
    }
    __syncthreads();
}

__device__ __forceinline__ void phase_rope_gates(const Args& a) {
    u16* P = (u16*)(a.ws + WS_P);
    const float2* cs = (const float2*)(a.ws + WS_CS);
    const int gt = blockIdx.x * NTHREADS + threadIdx.x, NT = gridDim.x * NTHREADS;
    for (int i = gt; i < T * 2 * 8 * 64; i += NT) {
        const int f = i & 63, hh = (i >> 6) & 7, which = (i >> 9) & 1, t = i >> 10;
        const float2 c = cs[t * 64 + f];
        u16* p = P + (size_t)t * NP + (which ? C_DK : C_DQ) + hh * 128 + f;
        const float t1 = bf2f(p[0]), t2 = bf2f(p[64]);
        p[0] = f2bf(t1 * c.x - t2 * c.y);
        p[64] = f2bf(t1 * c.y + t2 * c.x);
    }
    const float* gz = (const float*)(a.ws + WS_GZ);
    float* la = (float*)(a.ws + WS_LA);
    for (int i = gt; i < 2 * T * 512; i += NT) {
        const int col = i & 511, t = (i >> 9) % T, dir = i / (T * 512);
        const float* w = dir ? a.wgb : a.wgf; const float* bb = dir ? a.bgb : a.bgf;
        float z = bb[col];
#pragma unroll
        for (int r = 0; r < 16; ++r) z += gz[(size_t)t * 32 + dir * 16 + r] * w[r * 512 + col];
        la[i] = logsigmoid_f(z) * (1.f / 16.f);
    }
}

__device__ __forceinline__ void gla_naive_item(const Args& a, unsigned char* lds, int item) {
    const int slice = item & 3, dir = (item >> 2) & 1, hh = (item >> 3) & 3, b = item >> 5;
    float* qs = (float*)lds;
    float* ks = qs + 32 * 128;
    float* as = ks + 32 * 128;
    float* vs = as + 32 * 128;
    float* po = vs + 32 * 64;
    const u16* P = (const u16*)(a.ws + WS_P);
    const float* la = (const float*)(a.ws + WS_LA) + (size_t)dir * T * 512;
    float* O = (float*)(a.ws + WS_OFB) + (size_t)dir * T * 1024;
    const int tid = threadIdx.x, g = tid >> 6, j = tid & 63;
    float st[16];
#pragma unroll
    for (int i = 0; i < 16; ++i) st[i] = 0.f;
    const float qscale = 0.08838834764831845f;
    for (int ch = 0; ch < S / 32; ++ch) {
        for (int e = tid; e < 32 * 128; e += NTHREADS) {
            const int i = e >> 7, d = e & 127;
            const int s = dir ? (S - 1 - (ch * 32 + i)) : (ch * 32 + i);
            const size_t t = (size_t)b * S + s;
            qs[e] = bf2f(P[t * NP + C_GQ + hh * 128 + d]) * qscale;
            ks[e] = bf2f(P[t * NP + C_GK + hh * 128 + d]);
            as[e] = expf(la[t * 512 + hh * 128 + d]);
        }
        for (int e = tid; e < 32 * 64; e += NTHREADS) {
            const int i = e >> 6, jj = e & 63;
            const int s = dir ? (S - 1 - (ch * 32 + i)) : (ch * 32 + i);
            const size_t t = (size_t)b * S + s;
            vs[e] = bf2f(P[t * NP + C_GV + hh * 256 + slice * 64 + jj]);
        }
        __syncthreads();
        for (int i = 0; i < 32; ++i) {
            const float vv = vs[i * 64 + j];
            float p = 0.f;
#pragma unroll
            for (int dd = 0; dd < 16; ++dd) {
                const int d = g * 16 + dd;
                st[dd] = as[i * 128 + d] * st[dd] + ks[i * 128 + d] * vv;
                p += qs[i * 128 + d] * st[dd];
            }
            po[(i * 8 + g) * 64 + j] = p;
        }
        __syncthreads();
        for (int e = tid; e < 32 * 64; e += NTHREADS) {
            const int i = e >> 6, jj = e & 63;
            float sum = 0.f;
#pragma unroll
            for (int gg = 0; gg < 8; ++gg) sum += po[(i * 8 + gg) * 64 + jj];
            const int s = dir ? (S - 1 - (ch * 32 + i)) : (ch * 32 + i);
            const size_t t = (size_t)b * S + s;
            O[t * 1024 + hh * 256 + slice * 64 + jj] = sum;
        }
        __syncthreads();
    }
}

__device__ __forceinline__ void attn_naive(const Args& a, int wave_id, int nwaves) {
    const u16* P = (const u16*)(a.ws + WS_P);
    u16* A2 = (u16*)(a.ws + WS_ACT);
    const int lane = threadIdx.x & 63;
    const float scale = 0.08838834764831845f;
    for (int item = wave_id; item < T * 8; item += nwaves) {
        const int hh = item & 7, t = item >> 3;
        const int b = t / S, s = t % S;
        const unsigned qp = *(const unsigned*)(P + (size_t)t * NP + C_DQ + hh * 128 + 2 * lane);
        const float q0 = lo2f(qp) * scale, q1 = hi2f(qp) * scale;
        float m = -1e30f, l = 0.f, o0 = 0.f, o1 = 0.f;
#pragma unroll 1
        for (int pat = 0; pat < 3; ++pat) {
            const int dil = pat == 0 ? 1 : (pat == 1 ? 4 : 16);
#pragma unroll 2
            for (int j = -64; j <= 64; ++j) {
                const int sk = s + dil * j;
                if (sk < 0 || sk >= S) continue;
                const size_t tk = (size_t)b * S + sk;
                const unsigned kp = *(const unsigned*)(P + tk * NP + C_DK + hh * 128 + 2 * lane);
                const unsigned vp = *(const unsigned*)(P + tk * NP + C_DV + hh * 128 + 2 * lane);
                float sc = wave_sum(q0 * lo2f(kp) + q1 * hi2f(kp));
                const float mn = fmaxf(m, sc);
                const float al = __expf(m - mn), p = __expf(sc - mn);
                l = l * al + p;
                o0 = o0 * al + p * lo2f(vp);
                o1 = o1 * al + p * hi2f(vp);
                m = mn;
            }
        }
        const float inv = 1.f / l;
        *(unsigned*)(A2 + (size_t)t * D + 1024 + hh * 128 + 2 * lane) = pack2(o0 * inv, o1 * inv);
    }
}

__device__ __forceinline__ void phase_mixers(const Args& a, unsigned char* lds) {
    const int bi = blockIdx.x, G = gridDim.x;
    if (bi < 128) {
        gla_naive_item(a, lds, bi);
    } else {
        const int wave = threadIdx.x >> 6;
        attn_naive(a, (bi - 128) * NWAVES + wave, (G - 128) * NWAVES);
    }
}

__device__ __forceinline__ void phase_gla_fin(const Args& a) {
    const float* Of = (const float*)(a.ws + WS_OFB);
    const float* Ob = Of + (size_t)T * 1024;
    const u16* P = (const u16*)(a.ws + WS_P);
    u16* A2 = (u16*)(a.ws + WS_ACT);
    const int lane = threadIdx.x & 63, wave = threadIdx.x >> 6;
    const int gw = blockIdx.x * NWAVES + wave, NGW = gridDim.x * NWAVES;
    for (int item = gw; item < T * 4; item += NGW) {
        const int hh = item & 3, t = item >> 2;
        const size_t base = (size_t)t * 1024 + hh * 256 + lane * 4;
        const float4 f = *(const float4*)(Of + base), bb = *(const float4*)(Ob + base);
        const float o0 = f.x + bb.x, o1 = f.y + bb.y, o2 = f.z + bb.z, o3 = f.w + bb.w;
        const float ss = wave_sum(o0 * o0 + o1 * o1 + o2 * o2 + o3 * o3);
        const float rstd = rsqrtf(ss * (1.f / 256.f) + NORM_EPS);
        const float4 gg = *(const float4*)(a.g_gla + hh * 256 + lane * 4);
        const uint2 rp = *(const uint2*)(P + (size_t)t * NP + C_GR + hh * 256 + lane * 4);
        const float r0 = lo2f(rp.x), r1 = hi2f(rp.x), r2 = lo2f(rp.y), r3 = hi2f(rp.y);
        const float y0 = o0 * rstd * gg.x * silu_f(r0), y1 = o1 * rstd * gg.y * silu_f(r1);
        const float y2 = o2 * rstd * gg.z * silu_f(r2), y3 = o3 * rstd * gg.w * silu_f(r3);
        *(uint2*)(A2 + (size_t)t * D + hh * 256 + lane * 4) = make_uint2(pack2(y0, y1), pack2(y2, y3));
    }
}

__device__ __forceinline__ void phase_route(const Args& a) {
    const u16* Q = (const u16*)(a.ws + WS_Q);
    int* IDX = (int*)(a.ws + WS_IDX);
    float* GATE = (float*)(a.ws + WS_GATE);
    const int lane = threadIdx.x & 63, wave = threadIdx.x >> 6;
    const int gw = blockIdx.x * NWAVES + wave, NGW = gridDim.x * NWAVES;
    for (int item = gw; item < T * 8; item += NGW) {
        const int hh = item & 7, t = item >> 3;
        float ts[2]; int ti[2];
        ts[0] = ts[1] = 0.f; ti[0] = ti[1] = 0;
#pragma unroll
        for (int half = 0; half < 2; ++half) {
            const u16* qp = Q + (size_t)t * D + hh * 256 + half * 128;
            const float* k0p = a.subk + ((size_t)(hh * 2 + half) * 128 + lane) * 128;
            const float* k1p = k0p + 64 * 128;
            float v0 = 0.f, v1 = 0.f;
            for (int d = 0; d < 128; d += 4) {
                const uint2 qq = *(const uint2*)(qp + d);
                const float4 ka = *(const float4*)(k0p + d), kb = *(const float4*)(k1p + d);
                const float x0 = lo2f(qq.x), x1 = hi2f(qq.x), x2 = lo2f(qq.y), x3 = hi2f(qq.y);
                v0 += x0 * ka.x + x1 * ka.y + x2 * ka.z + x3 * ka.w;
                v1 += x0 * kb.x + x1 * kb.y + x2 * kb.z + x3 * kb.w;
            }
            float mys = 0.f; int myi = 0;
            for (int it = 0; it < 16; ++it) {
                const float lm = fmaxf(v0, v1);
                const float wm = wave_max(lm);
                const unsigned long long bal = __ballot(lm == wm);
                const int src = __ffsll((long long)bal) - 1;
                const int which = (v0 >= v1) ? 0 : 1;
                const int kidx = __shfl(lane + 64 * which, src);
                if (lane == src) { if (which == 0) v0 = -3.0e38f; else v1 = -3.0e38f; }
                if (lane == it) { mys = wm; myi = kidx; }
            }
            ts[half] = mys; ti[half] = myi;
        }
        float cv[4];
#pragma unroll
        for (int r = 0; r < 4; ++r) {
            const int c = lane + 64 * r;
            cv[r] = __shfl(ts[0], c >> 4) + __shfl(ts[1], c & 15);
        }
        float bs = 0.f; int bc = 0;
        for (int it = 0; it < 16; ++it) {
            const float lm = fmaxf(fmaxf(cv[0], cv[1]), fmaxf(cv[2], cv[3]));
            const float wm = wave_max(lm);
            const unsigned long long bal = __ballot(lm == wm);
            const int src = __ffsll((long long)bal) - 1;
            int which = 3;
            if (cv[2] == lm) which = 2;
            if (cv[1] == lm) which = 1;
            if (cv[0] == lm) which = 0;
            const int cidx = __shfl(lane + 64 * which, src);
            if (lane == src) {
                if (which == 0) cv[0] = -3.0e38f; else if (which == 1) cv[1] = -3.0e38f; else if (which == 2) cv[2] = -3.0e38f; else cv[3] = -3.0e38f;
            }
            if (lane == it) { bs = wm; bc = cidx; }
        }
        const float top = __shfl(bs, 0);
        const float e = (lane < 16) ? __expf(bs - top) : 0.f;
        const float den = wave_sum(e);
        const int i0 = __shfl(ti[0], bc >> 4), i1 = __shfl(ti[1], bc & 15);
        if (lane < 16) {
            IDX[(size_t)t * 128 + hh * 16 + lane] = i0 * 128 + i1;
            GATE[(size_t)t * 128 + hh * 16 + lane] = e / den;
        }
    }
}

__device__ __forceinline__ void phase_experts(const Args& a) {
    const u16* H2 = (const u16*)(a.ws + WS_ACT);
    const float* X1 = (const float*)(a.ws + WS_X1);
    const int* IDX = (const int*)(a.ws + WS_IDX);
    const float* GATE = (const float*)(a.ws + WS_GATE);
    const float* mod = (const float*)(a.ws + WS_MOD);
    const int lane = threadIdx.x & 63, wave = threadIdx.x >> 6;
    const int gw = blockIdx.x * NWAVES + wave, NGW = gridDim.x * NWAVES;
    for (int t = gw; t < T; t += NGW) {
        const int b = t / S;
        float4 h[8], acc[8];
        {
            const uint2* hp = (const uint2*)(H2 + (size_t)t * D);
#pragma unroll
            for (int m = 0; m < 8; ++m) {
                const uint2 p = hp[lane + 64 * m];
                h[m] = make_float4(lo2f(p.x), hi2f(p.x), lo2f(p.y), hi2f(p.y));
                acc[m] = make_float4(0.f, 0.f, 0.f, 0.f);
            }
        }
#pragma unroll 1
        for (int r = 0; r < 128; ++r) {
            const int e = __builtin_amdgcn_readfirstlane(IDX[(size_t)t * 128 + r]);
            const float gt = GATE[(size_t)t * 128 + r];
            const float4* up = (const float4*)(a.pu + (size_t)e * D);
            const float4* vp = (const float4*)(a.pv + (size_t)e * D);
            float4 u[8], vv[8];
#pragma unroll
            for (int m = 0; m < 8; ++m) u[m] = up[lane + 64 * m];
#pragma unroll
            for (int m = 0; m < 8; ++m) vv[m] = vp[lane + 64 * m];
            float dsum = 0.f;
#pragma unroll
            for (int m = 0; m < 8; ++m) dsum += u[m].x * h[m].x + u[m].y * h[m].y + u[m].z * h[m].z + u[m].w * h[m].w;
            dsum = wave_sum(dsum);
            const float w = gt * gelu_f(dsum);
#pragma unroll
            for (int m = 0; m < 8; ++m) { acc[m].x += w * vv[m].x; acc[m].y += w * vv[m].y; acc[m].z += w * vv[m].z; acc[m].w += w * vv[m].w; }
        }
        const float4* x1p = (const float4*)(X1 + (size_t)t * D);
        const float4* gap = (const float4*)(mod + b * 12288 + 5 * 2048);
        float ss = 0.f;
#pragma unroll
        for (int m = 0; m < 8; ++m) {
            const float4 xv = x1p[lane + 64 * m], ga = gap[lane + 64 * m];
            acc[m].x = xv.x + ga.x * acc[m].x; acc[m].y = xv.y + ga.y * acc[m].y; acc[m].z = xv.z + ga.z * acc[m].z; acc[m].w = xv.w + ga.w * acc[m].w;
            ss += acc[m].x * acc[m].x + acc[m].y * acc[m].y + acc[m].z * acc[m].z + acc[m].w * acc[m].w;
        }
        ss = wave_sum(ss);
        const float rstd = rsqrtf(ss * (1.f / D) + NORM_EPS);
        const float4* gf = (const float4*)a.g_fin;
        float4* op = (float4*)(a.out + (size_t)t * D);
#pragma unroll
        for (int m = 0; m < 8; ++m) {
            const float4 g = gf[lane + 64 * m];
            op[lane + 64 * m] = make_float4(acc[m].x * rstd * g.x, acc[m].y * rstd * g.y, acc[m].z * rstd * g.z, acc[m].w * rstd * g.w);
        }
    }
}

constexpr int NPHASES = 11;
__global__ void __launch_bounds__(NTHREADS, 2) mk_fwd(Args a) {
    extern __shared__ __attribute__((aligned(16))) unsigned char lds[];
    cg::grid_group grid = cg::this_grid();
    const int lo = a.ph_lo, hi = a.ph_hi;
#define IN(k) (lo <= (k) && (k) < hi)
#define SEAM(k) do { if (IN(k) && IN((k) + 1)) grid.sync(); } while (0)
    const float* mod = (const float*)(a.ws + WS_MOD);
    if (IN(0)) phase0(a, lds);
    SEAM(0);
    if (IN(1)) norm_mod_phase(a.x, a.g_mix, mod, 0, 1, (u16*)(a.ws + WS_ACT));
    SEAM(1);
    if (IN(2)) gemm_phase(lds, (const u16*)(a.ws + WS_ACT), (const u16*)(a.ws + WS_WIN), T, NPAD, D, EpiProj{(u16*)(a.ws + WS_P), (float*)(a.ws + WS_GZ)});
    SEAM(2);
    if (IN(3)) phase_rope_gates(a);
    SEAM(3);
    if (IN(4)) phase_mixers(a, lds);
    SEAM(4);
    if (IN(5)) phase_gla_fin(a);
    SEAM(5);
    if (IN(6)) gemm_phase(lds, (const u16*)(a.ws + WS_ACT), (const u16*)(a.ws + WS_WOUT), T, D, D, EpiResid{a.x, mod, (float*)(a.ws + WS_X1)});
    SEAM(6);
    if (IN(7)) norm_mod_phase((const float*)(a.ws + WS_X1), a.g_ffn, mod, 3, 4, (u16*)(a.ws + WS_ACT));
    SEAM(7);
    if (IN(8)) gemm_phase(lds, (const u16*)(a.ws + WS_ACT), (const u16*)(a.ws + WS_WPQ), T, D, D, EpiBf16{(u16*)(a.ws + WS_Q)});
    SEAM(8);
    if (IN(9)) phase_route(a);
    SEAM(9);
    if (IN(10)) phase_experts(a);
#undef IN
#undef SEAM
}

#ifndef MK_ONE_LAUNCH
#define MK_ONE_LAUNCH 1
#endif
extern "C" void kernel_launch(void* const* d_in, const int* in_sizes, int n_in, void* d_out, int out_size, void* d_ws, size_t ws_size, hipStream_t stream) {
    static int grid = 0;
    if (grid == 0) {
        if (n_in != 19 || out_size != T * D || ws_size < WS_END) {
            fprintf(stderr, "kernel_launch: unexpected shapes: n_in %d out %d ws %zu (need %zu)\n", n_in, out_size, ws_size, (size_t)WS_END);
            grid = -1; return;
        }
        int dev = 0, cus = 0, per_cu = 0;
        (void)hipGetDevice(&dev);
        (void)hipDeviceGetAttribute(&cus, hipDeviceAttributeMultiprocessorCount, dev);
        (void)hipFuncSetAttribute((const void*)mk_fwd, hipFuncAttributeMaxDynamicSharedMemorySize, LDS_BYTES);
        (void)hipOccupancyMaxActiveBlocksPerMultiprocessor(&per_cu, (const void*)mk_fwd, NTHREADS, LDS_BYTES);
        if (per_cu < 1) { fprintf(stderr, "kernel_launch: occupancy query says %d blocks/CU\n", per_cu); grid = -1; return; }
        grid = cus;
        (void)hipGetLastError();
    }
    if (grid < 0) return;
    Args a{};
    a.x = (const float*)d_in[0]; a.c = (const float*)d_in[1]; a.pos = (const int*)d_in[2]; a.w_ada = (const float*)d_in[3];
    a.b_ada = (const float*)d_in[4]; a.g_mix = (const float*)d_in[5]; a.w_in = (const float*)d_in[6]; a.wgf = (const float*)d_in[7];
    a.bgf = (const float*)d_in[8]; a.wgb = (const float*)d_in[9]; a.bgb = (const float*)d_in[10]; a.g_gla = (const float*)d_in[11];
    a.w_out = (const float*)d_in[12]; a.g_ffn = (const float*)d_in[13]; a.w_pq = (const float*)d_in[14]; a.subk = (const float*)d_in[15];
    a.pu = (const float*)d_in[16]; a.pv = (const float*)d_in[17]; a.g_fin = (const float*)d_in[18];
    a.out = (float*)d_out; a.ws = (unsigned char*)d_ws;
#if MK_ONE_LAUNCH
    a.ph_lo = 0; a.ph_hi = NPHASES;
    void* args[] = {&a};
    hipError_t e = hipLaunchCooperativeKernel((const void*)mk_fwd, dim3(grid), dim3(NTHREADS), args, LDS_BYTES, stream);
    if (e != hipSuccess) fprintf(stderr, "cooperative launch failed: %s (grid %d)\n", hipGetErrorString(e), grid);
#else
    for (int p = 0; p < NPHASES; ++p) {
        a.ph_lo = p; a.ph_hi = p + 1;
        hipLaunchKernelGGL(mk_fwd, dim3(grid), dim3(NTHREADS), LDS_BYTES, stream, a);
    }
#endif
}
```

```cpp
#include <hip/hip_runtime.h>
#include <hip/hip_cooperative_groups.h>
#include <cstdio>
#include <cstdint>

namespace cg = cooperative_groups;

typedef unsigned short u16;
typedef __attribute__((ext_vector_type(8))) short bf16x8;
typedef __attribute__((ext_vector_type(4))) float f32x4;

constexpr int D = 2048, NB = 4, S = 4096, T = NB * S;
constexpr int INW = 6176;
constexpr int NP = 6144;
constexpr int NPAD = 6400;
constexpr int C_GQ = 0, C_GK = 512, C_GV = 1024, C_GR = 2048, C_DQ = 3072, C_DK = 4096, C_DV = 5120;
constexpr int NTHREADS = 512, NWAVES = 8;
constexpr int LDS_BYTES = 128 * 1024;
constexpr float NORM_EPS = 1e-6f;

constexpr size_t WS_CTL = 0;
constexpr size_t WS_MOD = 65536;
constexpr size_t WS_CS = 524288;
constexpr size_t WS_WIN = WS_CS + (size_t)T * 64 * 8;
constexpr size_t WS_WOUT = WS_WIN + (size_t)NPAD * D * 2;
constexpr size_t WS_WPQ = WS_WOUT + (size_t)D * D * 2;
constexpr size_t WS_ACT = WS_WPQ + (size_t)D * D * 2;
constexpr size_t WS_P = WS_ACT + (size_t)T * D * 2;
constexpr size_t WS_X1 = WS_P;
constexpr size_t WS_Q = WS_P + (size_t)T * D * 4;
constexpr size_t WS_GZ = WS_P + (size_t)T * NP * 2;
constexpr size_t WS_LA = WS_GZ + (size_t)T * 32 * 4;
constexpr size_t WS_OFB = WS_LA + (size_t)2 * T * 512 * 4;
constexpr size_t WS_IDX = WS_OFB + (size_t)2 * T * 1024 * 4;
constexpr size_t WS_GATE = WS_IDX + (size_t)T * 128 * 4;
constexpr size_t WS_END = WS_GATE + (size_t)T * 128 * 4;
constexpr size_t WS_TU = WS_LA;
constexpr size_t WS_TV = WS_OFB;

struct Args {
    const float* x; const float* c; const int* pos; const float* w_ada; const float* b_ada; const float* g_mix;
    const float* w_in; const float* wgf; const float* bgf; const float* wgb; const float* bgb; const float* g_gla;
    const float* w_out; const float* g_ffn; const float* w_pq; const float* subk; const float* pu; const float* pv; const float* g_fin;
    float* out; unsigned char* ws; int ph_lo, ph_hi;
};

__device__ __forceinline__ float bf2f(u16 h) { return __uint_as_float(((unsigned)h) << 16); }
__device__ __forceinline__ u16 f2bf(float f) { unsigned u = __float_as_uint(f); u += 0x7fffu + ((u >> 16) & 1u); return (u16)(u >> 16); }
__device__ __forceinline__ unsigned pack2(float a, float b) { return (unsigned)f2bf(a) | ((unsigned)f2bf(b) << 16); }
__device__ __forceinline__ float lo2f(unsigned p) { return __uint_as_float(p << 16); }
__device__ __forceinline__ float hi2f(unsigned p) { return __uint_as_float(p & 0xffff0000u); }
__device__ __forceinline__ float wave_sum(float v) {
#pragma unroll
    for (int o = 32; o > 0; o >>= 1) v += __shfl_xor(v, o);
    return v;
}
__device__ __forceinline__ float wave_max(float v) {
#pragma unroll
    for (int o = 32; o > 0; o >>= 1) v = fmaxf(v, __shfl_xor(v, o));
    return v;
}
__device__ __forceinline__ float silu_f(float v) { return v / (1.f + __expf(-v)); }
__device__ __forceinline__ float gelu_f(float a) { return 0.5f * a * (1.f + erff(a * 0.70710678118654752f)); }
__device__ __forceinline__ float logsigmoid_f(float z) { return z < 0.f ? z - log1pf(expf(z)) : -log1pf(expf(-z)); }

__device__ __forceinline__ void p0_mod(const Args& a, unsigned char* lds, int bi) {
    float* sc = (float*)lds;
    float* red = sc + 4 * 2048;
    const int tid = threadIdx.x, lane = tid & 63, wave = tid >> 6;
    for (int i = tid; i < 4 * 2048; i += NTHREADS) sc[i] = silu_f(a.c[i]);
    __syncthreads();
    const int j0 = bi * 256 + lane * 4;
    float acc[4][4];
#pragma unroll
    for (int b = 0; b < 4; ++b)
#pragma unroll
        for (int q = 0; q < 4; ++q) acc[b][q] = 0.f;
    const int k0 = wave * 256;
#pragma unroll 4
    for (int kk = 0; kk < 256; ++kk) {
        const int k = k0 + kk;
        const float4 w = *(const float4*)(a.w_ada + (size_t)k * 12288 + j0);
#pragma unroll
        for (int b = 0; b < 4; ++b) {
            const float s = sc[b * 2048 + k];
            acc[b][0] += s * w.x; acc[b][1] += s * w.y; acc[b][2] += s * w.z; acc[b][3] += s * w.w;
        }
    }
#pragma unroll
    for (int b = 0; b < 4; ++b)
#pragma unroll
        for (int q = 0; q < 4; ++q) red[(wave * 4 + b) * 256 + lane * 4 + q] = acc[b][q];
    __syncthreads();
    float* mod = (float*)(a.ws + WS_MOD);
    for (int i = tid; i < 4 * 256; i += NTHREADS) {
        const int b = i >> 8, jc = i & 255;
        float s = 0.f;
#pragma unroll
        for (int w = 0; w < 8; ++w) s += red[(w * 4 + b) * 256 + jc];
        mod[b * 12288 + bi * 256 + jc] = s + a.b_ada[bi * 256 + jc];
    }
    __syncthreads();
}

__device__ __forceinline__ void p0_transpose_item(const float* __restrict__ W, int ldw, int k0, int src_col0, int n_valid,
                                                  u16* __restrict__ WT, int ldt, int n_out0, unsigned char* lds) {
    u16* tl = (u16*)lds;
    const int tid = threadIdx.x;
    {
        const int k = tid >> 3, nc = (tid & 7) * 8;
        float v[8];
        if (nc < n_valid) {
            const float4 v0 = *(const float4*)(W + (size_t)(k0 + k) * ldw + src_col0 + nc);
            const float4 v1 = *(const float4*)(W + (size_t)(k0 + k) * ldw + src_col0 + nc + 4);
            v[0] = v0.x; v[1] = v0.y; v[2] = v0.z; v[3] = v0.w; v[4] = v1.x; v[5] = v1.y; v[6] = v1.z; v[7] = v1.w;
        } else {
#pragma unroll
            for (int i = 0; i < 8; ++i) v[i] = 0.f;
        }
#pragma unroll
        for (int i = 0; i < 8; ++i) tl[(nc + i) * 72 + k] = f2bf(v[i]);
    }
    __syncthreads();
    {
        const int n = tid >> 3, kc = (tid & 7) * 8;
        const uint4 v = *(const uint4*)(tl + n * 72 + kc);
        *(uint4*)(WT + (size_t)(n_out0 + n) * ldt + k0 + kc) = v;
    }
    __syncthreads();
}

__device__ __forceinline__ void phase0(const Args& a, unsigned char* lds) {
    const int bi = blockIdx.x, G = gridDim.x, tid = threadIdx.x;
    if (bi < 48) p0_mod(a, lds, bi);
    constexpr int I_IN = 32 * (NPAD / 64), I_SQ = 32 * 32;
    u16* WinT = (u16*)(a.ws + WS_WIN); u16* WoutT = (u16*)(a.ws + WS_WOUT); u16* WpqT = (u16*)(a.ws + WS_WPQ);
    for (int it = bi; it < I_IN + 2 * I_SQ; it += G) {
        if (it < I_IN) {
            const int kt = it & 31, nt = it >> 5;
            const int n0 = nt * 64;
            int src, nv;
            if (n0 < 3072) { src = n0; nv = 64; }
            else if (n0 < 6144) { src = n0 + 32; nv = 64; }
            else if (n0 == 6144) { src = 3072; nv = 32; }
            else { src = 0; nv = 0; }
            p0_transpose_item(a.w_in, INW, kt * 64, src, nv, WinT, D, n0, lds);
        } else if (it < I_IN + I_SQ) {
            const int r = it - I_IN; const int kt = r & 31, nt = r >> 5;
            p0_transpose_item(a.w_out, D, kt * 64, nt * 64, 64, WoutT, D, nt * 64, lds);
        } else {
            const int r = it - I_IN - I_SQ; const int kt = r & 31, nt = r >> 5;
            p0_transpose_item(a.w_pq, D, kt * 64, nt * 64, 64, WpqT, D, nt * 64, lds);
        }
    }
    float2* cs = (float2*)(a.ws + WS_CS);
    for (int i = bi * NTHREADS + tid; i < T * 64; i += G * NTHREADS) {
        const int t = i >> 6, f = i & 63;
        const float inv_freq = powf(10000.0f, -(float)f * 2.0f / 128.0f);
        const float ang = (float)a.pos[t] * inv_freq;
        const double rev = (double)ang * 0.15915494309189533577;
        const float fr = (float)(rev - floor(rev));
        cs[i] = make_float2(__builtin_amdgcn_cosf(fr), __builtin_amdgcn_sinf(fr));
    }
}

__device__ __forceinline__ void norm_mod_phase(const float* __restrict__ xin, const float* __restrict__ g, const float* __restrict__ mod,
                                               int sh_chunk, int sc_chunk, u16* __restrict__ outp) {
    const int lane = threadIdx.x & 63, wave = threadIdx.x >> 6;
    const int gw = blockIdx.x * NWAVES + wave, NGW = gridDim.x * NWAVES;
    for (int t = gw; t < T; t += NGW) {
        const int b = t / S;
        const float4* xr = (const float4*)(xin + (size_t)t * D);
        float4 v[8]; float ss = 0.f;
#pragma unroll
        for (int m = 0; m < 8; ++m) { v[m] = xr[lane + 64 * m]; ss += v[m].x * v[m].x + v[m].y * v[m].y + v[m].z * v[m].z + v[m].w * v[m].w; }
        ss = wave_sum(ss);
        const float rstd = rsqrtf(ss * (1.f / D) + NORM_EPS);
        const float4* gp = (const float4*)g;
        const float4* shp = (const float4*)(mod + b * 12288 + sh_chunk * 2048);
        const float4* scp = (const float4*)(mod + b * 12288 + sc_chunk * 2048);
        uint2* op = (uint2*)(outp + (size_t)t * D);
#pragma unroll
        for (int m = 0; m < 8; ++m) {
            const int i = lane + 64 * m;
            const float4 gg = gp[i], sh = shp[i], sc = scp[i];
            const float h0 = v[m].x * rstd * gg.x * (1.f + sc.x) + sh.x;
            const float h1 = v[m].y * rstd * gg.y * (1.f + sc.y) + sh.y;
            const float h2 = v[m].z * rstd * gg.z * (1.f + sc.z) + sh.z;
            const float h3 = v[m].w * rstd * gg.w * (1.f + sc.w) + sh.w;
            op[i] = make_uint2(pack2(h0, h1), pack2(h2, h3));
        }
    }
}

namespace pg8 {
#define PG8_LAS __attribute__((address_space(3)))
typedef unsigned short bf16_t;
typedef short bf16x8 __attribute__((ext_vector_type(8)));
typedef float f32x4 __attribute__((ext_vector_type(4)));
typedef unsigned u32x4 __attribute__((ext_vector_type(4)));
constexpr int BM = 256, BK = 64, HALF = 128, HTB = HALF * BK * 2  , STAGE_BYTES = 8 * HTB, NXCD = 8, WGM = 8;

__host__ __device__ __forceinline__ int lds_byte(int r, int c) { const int st = (r >> 4) * 2 + (c >> 5), rr = r & 15, cc = c & 31, ob = rr * 64 + cc * 2; return st * 1024 + (ob ^ (((ob >> 9) & 1) << 5)); }
__host__ __device__ __forceinline__ void stage_rc(int b, int& R, int& C) { const int st = b / 1024, sb = b % 1024, swz = sb ^ (((sb >> 9) & 1) << 5); R = (st >> 1) * 16 + swz / 64; C = (st & 1) * 32 + (swz % 64) / 2; }
__host__ __device__ __forceinline__ int perm32(int rho) { const int n = rho >> 4, i = rho & 15; return 8 * (i >> 2) + 4 * n + (i & 3); }

struct Unit { int pm, pn; };
struct Gemm { const bf16_t* A; const bf16_t* Bt; int M, N, K; };

struct StaticOrder {
    int nM, nN, nwg, G, c;
    __host__ __device__ void init(int M, int N, int G_, int c_) { nM = M / BM; nN = N / BM; nwg = nM * nN; G = G_; c = c_; }
    __host__ __device__ bool next(int i, Unit& u) const {
        const long L = (long)i * G + c; if (L >= nwg) return false;
        int wgid = (int)L; { const int q = nwg / NXCD, r = nwg % NXCD, xcd = wgid % NXCD, off = wgid / NXCD; wgid = (xcd < r ? xcd * (q + 1) : r * (q + 1) + (xcd - r) * q) + off; }
        const int nig = WGM * nN, gid = wgid / nig, fm = gid * WGM, gsz = (nM - fm) < WGM ? (nM - fm) : WGM;
        u.pm = fm + ((wgid % nig) % gsz); u.pn = (wgid % nig) / gsz; return true;
    }
    __device__ __forceinline__ void a_ready(const Unit&) const {}
    __device__ __forceinline__ void done(const Unit&) const {}
};
__device__ __forceinline__ unsigned cvt_pk_bf16(float lo, float hi) { unsigned r; asm volatile("v_cvt_pk_bf16_f32 %0, %1, %2" : "=v"(r) : "v"(lo), "v"(hi)); return r; }
typedef float f32x2 __attribute__((ext_vector_type(2)));
template <class Epi, class Sched, bool STAMP = false>
__device__ __forceinline__ void gemm_phase(PG8_LAS unsigned char* lds, const Gemm g, const Sched& S, const Epi& E, unsigned long long* stamps) {
    const int tid = threadIdx.x, wid = __builtin_amdgcn_readfirstlane(tid >> 6), lane = tid & 63, wr = wid >> 2, wc = wid & 3, fr = lane & 15, fq = lane >> 4;
    const int K = g.K, nt = K / BK;
    int ts_lo = 0, ts_hi = 0, nts = 0; const unsigned long long rt_entry = STAMP ? (unsigned long long)wall_clock64() : 0ull;
#define PG8_STAMP() do { if (STAMP && wid == 0 && nts < 64) { const unsigned long long _c = (unsigned long long)clock64(); \
        ts_lo = (lane == nts) ? (int)(unsigned)_c : ts_lo; ts_hi = (lane == nts) ? (int)(unsigned)(_c >> 32) : ts_hi; ++nts; } } while (0)
    PG8_STAMP();
    unsigned voffA[2], voffB[2];
#pragma unroll
    for (int i = 0; i < 2; ++i) { int R, C; stage_rc(tid * 16 + i * 8192, R, C); const int Rb = Epi::PERM ? ((R & ~31) + perm32(R & 31)) : R;
        voffA[i] = (unsigned)(R * K + C) * 2u; voffB[i] = (unsigned)(Rb * K + C) * 2u; }
    const size_t kstep = (size_t)(BK * 2);
    const size_t hstep = (size_t)HALF * K * 2;
    const size_t tstep = 2 * hstep;
    const unsigned ldsw = (unsigned)wid * 1024u;
    const int aoff = lds_byte(wr * 64 + fr, fq * 8), boff = lds_byte(wc * 32 + fr, fq * 8);
#define PG8_SA(b, h) (((b) * 2 + (h)) * HTB)
#define PG8_SB(b, h) ((4 + (b) * 2 + (h)) * HTB)
#define PG8_STAGE(bufoff, gbase, voff) do { _Pragma("unroll") for (int _i = 0; _i < 2; ++_i) \
        __builtin_amdgcn_global_load_lds((const unsigned*)((const char*)(gbase) + (voff)[_i]), (PG8_LAS unsigned*)(lds + (bufoff) + ldsw + _i * 8192), 16, 0, 0); } while (0)
#define PG8_LDA(dst, b, h) do { _Pragma("unroll") for (int m = 0; m < 4; ++m) _Pragma("unroll") for (int k = 0; k < 2; ++k) dst[m][k] = *(const PG8_LAS bf16x8*)(lds + PG8_SA(b, h) + aoff + m * 2048 + k * 1024); } while (0)
#define PG8_LDB(dst, b, h) do { _Pragma("unroll") for (int n = 0; n < 2; ++n) _Pragma("unroll") for (int k = 0; k < 2; ++k) dst[n][k] = *(const PG8_LAS bf16x8*)(lds + PG8_SB(b, h) + boff + n * 2048 + k * 1024); } while (0)
#define PG8_MMA(ai, bj, At, Bt) do { __builtin_amdgcn_s_setprio(1); _Pragma("unroll") for (int m = 0; m < 4; ++m) _Pragma("unroll") for (int n = 0; n < 2; ++n) _Pragma("unroll") for (int k = 0; k < 2; ++k) \
        acc[ai][bj][m][n] = __builtin_amdgcn_mfma_f32_16x16x32_bf16(Bt[n][k], At[m][k], acc[ai][bj][m][n], 0, 0, 0); __builtin_amdgcn_s_setprio(0); } while (0)
#define PG8_WAIT_V(n) asm volatile("s_waitcnt vmcnt(" #n ")" ::: "memory")
#define PG8_WAIT_L(n) asm volatile("s_waitcnt lgkmcnt(" #n ")" ::: "memory")
#define PG8_BAR __builtin_amdgcn_s_barrier()
#define PG8_SCHED __builtin_amdgcn_sched_barrier(0)
    Unit cur, nxt; int ui = 0;
    if (!S.next(0, cur)) return;
    f32x4 acc[2][2][4][2];
#pragma unroll
    for (int a = 0; a < 2; ++a)
#pragma unroll
        for (int b = 0; b < 2; ++b)
#pragma unroll
            for (int m = 0; m < 4; ++m)
#pragma unroll
                for (int n = 0; n < 2; ++n) acc[a][b][m][n] = (f32x4){0.f, 0.f, 0.f, 0.f};
    bf16x8 At[4][2], B0[2][2], B1[2][2];
    const char* cA = (const char*)g.A + (size_t)cur.pm * tstep; const char* cB = (const char*)g.Bt + (size_t)cur.pn * tstep;
    S.a_ready(cur);
    PG8_STAGE(PG8_SB(0, 0), cB, voffB); PG8_STAGE(PG8_SA(0, 0), cA, voffA); PG8_STAGE(PG8_SB(0, 1), cB + hstep, voffB); PG8_STAGE(PG8_SA(0, 1), cA + hstep, voffA);
    if (wr == 1) PG8_BAR;
    PG8_WAIT_V(4); PG8_BAR;
    PG8_STAGE(PG8_SB(1, 0), cB + kstep, voffB); PG8_STAGE(PG8_SA(1, 0), cA + kstep, voffA); PG8_STAGE(PG8_SB(1, 1), cB + hstep + kstep, voffB);
    PG8_WAIT_V(6); PG8_BAR;
    PG8_STAMP();
    for (;;) {
        const bool has_next = S.next(ui + 1, nxt);
        const char* nA = has_next ? (const char*)g.A + (size_t)nxt.pm * tstep : cA; const char* nB = has_next ? (const char*)g.Bt + (size_t)nxt.pn * tstep : cB;
        for (int t = 0; t < nt; t += 2) {
            const bool last = (t == nt - 2);
            const char* a1 = cA + (size_t)(t + 1) * kstep;
            const char* a2 = last ? nA : cA + (size_t)(t + 2) * kstep; const char* b2 = last ? nB : cB + (size_t)(t + 2) * kstep;
            const char* a3 = a2 + kstep; const char* b3 = b2 + kstep;
            if (last && has_next) S.a_ready(nxt);
            PG8_LDB(B0, 0, 0); PG8_SCHED; PG8_LDA(At, 0, 0); PG8_STAGE(PG8_SA(1, 1), a1 + hstep, voffA);
            PG8_WAIT_L(8); PG8_BAR; PG8_WAIT_L(0); PG8_MMA(0, 0, At, B0); PG8_BAR; PG8_SCHED;
            PG8_LDB(B1, 0, 1); PG8_STAGE(PG8_SB(0, 0), b2, voffB);
            PG8_BAR; PG8_WAIT_L(0); PG8_MMA(0, 1, At, B1); PG8_BAR;
            PG8_LDA(At, 0, 1); PG8_STAGE(PG8_SA(0, 0), a2, voffA);
            PG8_BAR; PG8_WAIT_L(0); PG8_MMA(1, 0, At, B0); PG8_BAR; PG8_SCHED;
            PG8_STAGE(PG8_SB(0, 1), b2 + hstep, voffB);
            PG8_WAIT_V(6); PG8_BAR; PG8_MMA(1, 1, At, B1); PG8_BAR;
            PG8_LDB(B0, 1, 0); PG8_SCHED; PG8_LDA(At, 1, 0); PG8_STAGE(PG8_SA(0, 1), a2 + hstep, voffA);
            PG8_WAIT_L(8); PG8_BAR; PG8_WAIT_L(0); PG8_MMA(0, 0, At, B0); PG8_BAR; PG8_SCHED;
            PG8_LDB(B1, 1, 1); PG8_STAGE(PG8_SB(1, 0), b3, voffB);
            PG8_BAR; PG8_WAIT_L(0); PG8_MMA(0, 1, At, B1); PG8_BAR;
            PG8_LDA(At, 1, 1); PG8_STAGE(PG8_SA(1, 0), a3, voffA);
            PG8_BAR; PG8_WAIT_L(0); PG8_MMA(1, 0, At, B0); PG8_BAR; PG8_SCHED;
            PG8_STAGE(PG8_SB(1, 1), b3 + hstep, voffB);
            PG8_WAIT_V(6); PG8_BAR; PG8_MMA(1, 1, At, B1); PG8_BAR;
        }
        PG8_STAMP();
        if constexpr (!Epi::AFTER_DRAIN) { E(acc, cur, wr, wc, fr, fq); S.done(cur); }
        PG8_STAMP();
        if (!has_next) break;
#pragma unroll
        for (int a = 0; a < 2; ++a)
#pragma unroll
            for (int b = 0; b < 2; ++b)
#pragma unroll
                for (int m = 0; m < 4; ++m)
#pragma unroll
                    for (int n = 0; n < 2; ++n) acc[a][b][m][n] = (f32x4){0.f, 0.f, 0.f, 0.f};
        cur = nxt; cA = nA; cB = nB; ++ui;
    }
    PG8_WAIT_V(0);
    if (wr == 0) PG8_BAR;
    PG8_BAR;
    if constexpr (Epi::AFTER_DRAIN) { E.fused(acc, cur, wr, wc, fr, fq, lds, wid, lane); S.done(cur); }
    PG8_STAMP();
    if (STAMP && wid == 0) { stamps[lane] = lane < nts ? (((unsigned long long)(unsigned)ts_hi << 32) | (unsigned)ts_lo) : 0ull;
        if (lane == 62) stamps[62] = rt_entry; if (lane == 63) stamps[63] = (unsigned long long)wall_clock64(); }
#undef PG8_STAMP
#undef PG8_SA
#undef PG8_SB
#undef PG8_STAGE
#undef PG8_LDA
#undef PG8_LDB
#undef PG8_MMA
#undef PG8_WAIT_V
#undef PG8_WAIT_L
#undef PG8_BAR
#undef PG8_SCHED
}
}

struct EpiProj {
    static constexpr bool PERM = true, AFTER_DRAIN = false;
    u16* P; float* gz;
    __device__ __forceinline__ void operator()(const pg8::f32x4 (&acc)[2][2][4][2], const pg8::Unit& u, int wr, int wc, int fr, int fq) const {
        const int row0 = u.pm * 256 + wr * 64 + fr;
        if (u.pn < 24) {
            const int col0 = u.pn * 256 + wc * 32 + 8 * fq;
#pragma unroll
            for (int ai = 0; ai < 2; ++ai)
#pragma unroll
                for (int m = 0; m < 4; ++m) { u16* rowp = P + (size_t)(row0 + ai * 128 + m * 16) * NP + col0;
#pragma unroll
                    for (int bj = 0; bj < 2; ++bj) { const pg8::f32x4 v0 = acc[ai][bj][m][0], v1 = acc[ai][bj][m][1];
                        pg8::u32x4 w; w.x = pg8::cvt_pk_bf16(v0[0], v0[1]); w.y = pg8::cvt_pk_bf16(v0[2], v0[3]); w.z = pg8::cvt_pk_bf16(v1[0], v1[1]); w.w = pg8::cvt_pk_bf16(v1[2], v1[3]);
                        *(pg8::u32x4*)(rowp + bj * 128) = w; } }
        } else if (wc == 0) {
#pragma unroll
            for (int ai = 0; ai < 2; ++ai)
#pragma unroll
                for (int m = 0; m < 4; ++m) { float* rowp = gz + (size_t)(row0 + ai * 128 + m * 16) * 32 + 8 * fq;
                    *(pg8::f32x4*)(rowp) = acc[ai][0][m][0]; *(pg8::f32x4*)(rowp + 4) = acc[ai][0][m][1]; }
        }
    }
};
struct EpiResid {
    static constexpr bool PERM = false, AFTER_DRAIN = false;
    const float* x; const float* mod; float* x1;
    __device__ __forceinline__ void operator()(const pg8::f32x4 (&acc)[2][2][4][2], const pg8::Unit& u, int wr, int wc, int fr, int fq) const {
        const int row0 = u.pm * 256 + wr * 64 + fr, col0 = u.pn * 256 + wc * 32 + 4 * fq;
        const int b = (u.pm * 256) / S;
        pg8::f32x4 ga[2][2];
#pragma unroll
        for (int bj = 0; bj < 2; ++bj)
#pragma unroll
            for (int n = 0; n < 2; ++n) ga[bj][n] = *(const pg8::f32x4*)(mod + b * 12288 + 2 * 2048 + col0 + bj * 128 + n * 16);
#pragma unroll
        for (int ai = 0; ai < 2; ++ai)
#pragma unroll
            for (int m = 0; m < 4; ++m) { const size_t off = (size_t)(row0 + ai * 128 + m * 16) * D + col0;
#pragma unroll
                for (int bj = 0; bj < 2; ++bj)
#pragma unroll
                    for (int n = 0; n < 2; ++n) { const pg8::f32x4 xv = *(const pg8::f32x4*)(x + off + bj * 128 + n * 16);
                        *(pg8::f32x4*)(x1 + off + bj * 128 + n * 16) = xv + ga[bj][n] * acc[ai][bj][m][n]; } }
    }
};
struct EpiBf16 {
    static constexpr bool PERM = true, AFTER_DRAIN = false;
    u16* Q;
    __device__ __forceinline__ void operator()(const pg8::f32x4 (&acc)[2][2][4][2], const pg8::Unit& u, int wr, int wc, int fr, int fq) const {
        const int row0 = u.pm * 256 + wr * 64 + fr, col0 = u.pn * 256 + wc * 32 + 8 * fq;
#pragma unroll
        for (int ai = 0; ai < 2; ++ai)
#pragma unroll
            for (int m = 0; m < 4; ++m) { u16* rowp = Q + (size_t)(row0 + ai * 128 + m * 16) * D + col0;
#pragma unroll
                for (int bj = 0; bj < 2; ++bj) { const pg8::f32x4 v0 = acc[ai][bj][m][0], v1 = acc[ai][bj][m][1];
                    pg8::u32x4 w; w.x = pg8::cvt_pk_bf16(v0[0], v0[1]); w.y = pg8::cvt_pk_bf16(v0[2], v0[3]); w.z = pg8::cvt_pk_bf16(v1[0], v1[1]); w.w = pg8::cvt_pk_bf16(v1[2], v1[3]);
                    *(pg8::u32x4*)(rowp + bj * 128) = w; } }
    }
};
template <class Epi>
__device__ __forceinline__ void gemm8(unsigned char* lds, const u16* A, const u16* Bt, int M, int N, int K, const Epi& E) {
    pg8::Gemm g{A, Bt, M, N, K}; pg8::StaticOrder So; So.init(M, N, (int)gridDim.x, (int)blockIdx.x);
    pg8::gemm_phase<Epi, pg8::StaticOrder, false>((PG8_LAS unsigned char*)lds, g, So, E, nullptr);
    __syncthreads();
}

__device__ __forceinline__ void phase_rope_gates(const Args& a) {
    u16* P = (u16*)(a.ws + WS_P);
    const float2* cs = (const float2*)(a.ws + WS_CS);
    const int gt = blockIdx.x * NTHREADS + threadIdx.x, NT = gridDim.x * NTHREADS;
    for (int i = gt; i < T * 2 * 8 * 64; i += NT) {
        const int f = i & 63, hh = (i >> 6) & 7, which = (i >> 9) & 1, t = i >> 10;
        const float2 c = cs[t * 64 + f];
        u16* p = P + (size_t)t * NP + (which ? C_DK : C_DQ) + hh * 128 + f;
        const float t1 = bf2f(p[0]), t2 = bf2f(p[64]);
        p[0] = f2bf(t1 * c.x - t2 * c.y);
        p[64] = f2bf(t1 * c.y + t2 * c.x);
    }
    const float* gz = (const float*)(a.ws + WS_GZ);
    float* la = (float*)(a.ws + WS_LA);
    for (int i = gt; i < 2 * T * 512; i += NT) {
        const int col = i & 511, t = (i >> 9) % T, dir = i / (T * 512);
        const float* w = dir ? a.wgb : a.wgf; const float* bb = dir ? a.bgb : a.bgf;
        float z = bb[col];
#pragma unroll
        for (int r = 0; r < 16; ++r) z += gz[(size_t)t * 32 + dir * 16 + r] * w[r * 512 + col];
        la[i] = logsigmoid_f(z) * (1.f / 16.f);
    }
}

__device__ __forceinline__ void gla_naive_item(const Args& a, unsigned char* lds, int item) {
    const int slice = item & 3, dir = (item >> 2) & 1, hh = (item >> 3) & 3, b = item >> 5;
    float* qs = (float*)lds;
    float* ks = qs + 32 * 128;
    float* as = ks + 32 * 128;
    float* vs = as + 32 * 128;
    float* po = vs + 32 * 64;
    const u16* P = (const u16*)(a.ws + WS_P);
    const float* la = (const float*)(a.ws + WS_LA) + (size_t)dir * T * 512;
    float* O = (float*)(a.ws + WS_OFB) + (size_t)dir * T * 1024;
    const int tid = threadIdx.x, g = tid >> 6, j = tid & 63;
    float st[16];
#pragma unroll
    for (int i = 0; i < 16; ++i) st[i] = 0.f;
    const float qscale = 0.08838834764831845f;
    for (int ch = 0; ch < S / 32; ++ch) {
        for (int e = tid; e < 32 * 128; e += NTHREADS) {
            const int i = e >> 7, d = e & 127;
            const int s = dir ? (S - 1 - (ch * 32 + i)) : (ch * 32 + i);
            const size_t t = (size_t)b * S + s;
            qs[e] = bf2f(P[t * NP + C_GQ + hh * 128 + d]) * qscale;
            ks[e] = bf2f(P[t * NP + C_GK + hh * 128 + d]);
            as[e] = expf(la[t * 512 + hh * 128 + d]);
        }
        for (int e = tid; e < 32 * 64; e += NTHREADS) {
            const int i = e >> 6, jj = e & 63;
            const int s = dir ? (S - 1 - (ch * 32 + i)) : (ch * 32 + i);
            const size_t t = (size_t)b * S + s;
            vs[e] = bf2f(P[t * NP + C_GV + hh * 256 + slice * 64 + jj]);
        }
        __syncthreads();
        for (int i = 0; i < 32; ++i) {
            const float vv = vs[i * 64 + j];
            float p = 0.f;
#pragma unroll
            for (int dd = 0; dd < 16; ++dd) {
                const int d = g * 16 + dd;
                st[dd] = as[i * 128 + d] * st[dd] + ks[i * 128 + d] * vv;
                p += qs[i * 128 + d] * st[dd];
            }
            po[(i * 8 + g) * 64 + j] = p;
        }
        __syncthreads();
        for (int e = tid; e < 32 * 64; e += NTHREADS) {
            const int i = e >> 6, jj = e & 63;
            float sum = 0.f;
#pragma unroll
            for (int gg = 0; gg < 8; ++gg) sum += po[(i * 8 + gg) * 64 + jj];
            const int s = dir ? (S - 1 - (ch * 32 + i)) : (ch * 32 + i);
            const size_t t = (size_t)b * S + s;
            O[t * 1024 + hh * 256 + slice * 64 + jj] = sum;
        }
        __syncthreads();
    }
}

__device__ __forceinline__ void attn_naive(const Args& a, int wave_id, int nwaves) {
    const u16* P = (const u16*)(a.ws + WS_P);
    u16* A2 = (u16*)(a.ws + WS_ACT);
    const int lane = threadIdx.x & 63;
    const float scale = 0.08838834764831845f;
    for (int item = wave_id; item < T * 8; item += nwaves) {
        const int hh = item & 7, t = item >> 3;
        const int b = t / S, s = t % S;
        const unsigned qp = *(const unsigned*)(P + (size_t)t * NP + C_DQ + hh * 128 + 2 * lane);
        const float q0 = lo2f(qp) * scale, q1 = hi2f(qp) * scale;
        float m = -1e30f, l = 0.f, o0 = 0.f, o1 = 0.f;
#pragma unroll 1
        for (int pat = 0; pat < 3; ++pat) {
            const int dil = pat == 0 ? 1 : (pat == 1 ? 4 : 16);
#pragma unroll 2
            for (int j = -64; j <= 64; ++j) {
                const int sk = s + dil * j;
                if (sk < 0 || sk >= S) continue;
                const size_t tk = (size_t)b * S + sk;
                const unsigned kp = *(const unsigned*)(P + tk * NP + C_DK + hh * 128 + 2 * lane);
                const unsigned vp = *(const unsigned*)(P + tk * NP + C_DV + hh * 128 + 2 * lane);
                float sc = wave_sum(q0 * lo2f(kp) + q1 * hi2f(kp));
                const float mn = fmaxf(m, sc);
                const float al = __expf(m - mn), p = __expf(sc - mn);
                l = l * al + p;
                o0 = o0 * al + p * lo2f(vp);
                o1 = o1 * al + p * hi2f(vp);
                m = mn;
            }
        }
        const float inv = 1.f / l;
        *(unsigned*)(A2 + (size_t)t * D + 1024 + hh * 128 + 2 * lane) = pack2(o0 * inv, o1 * inv);
    }
}

__device__ __forceinline__ void phase_mixers(const Args& a, unsigned char* lds) {
    const int bi = blockIdx.x, G = gridDim.x;
    if (bi < 128) {
        gla_naive_item(a, lds, bi);
    } else {
        const int wave = threadIdx.x >> 6;
        attn_naive(a, (bi - 128) * NWAVES + wave, (G - 128) * NWAVES);
    }
}

__device__ __forceinline__ void phase_gla_fin(const Args& a) {
    const float* Of = (const float*)(a.ws + WS_OFB);
    const float* Ob = Of + (size_t)T * 1024;
    const u16* P = (const u16*)(a.ws + WS_P);
    u16* A2 = (u16*)(a.ws + WS_ACT);
    const int lane = threadIdx.x & 63, wave = threadIdx.x >> 6;
    const int gw = blockIdx.x * NWAVES + wave, NGW = gridDim.x * NWAVES;
    for (int item = gw; item < T * 4; item += NGW) {
        const int hh = item & 3, t = item >> 2;
        const size_t base = (size_t)t * 1024 + hh * 256 + lane * 4;
        const float4 f = *(const float4*)(Of + base), bb = *(const float4*)(Ob + base);
        const float o0 = f.x + bb.x, o1 = f.y + bb.y, o2 = f.z + bb.z, o3 = f.w + bb.w;
        const float ss = wave_sum(o0 * o0 + o1 * o1 + o2 * o2 + o3 * o3);
        const float rstd = rsqrtf(ss * (1.f / 256.f) + NORM_EPS);
        const float4 gg = *(const float4*)(a.g_gla + hh * 256 + lane * 4);
        const uint2 rp = *(const uint2*)(P + (size_t)t * NP + C_GR + hh * 256 + lane * 4);
        const float r0 = lo2f(rp.x), r1 = hi2f(rp.x), r2 = lo2f(rp.y), r3 = hi2f(rp.y);
        const float y0 = o0 * rstd * gg.x * silu_f(r0), y1 = o1 * rstd * gg.y * silu_f(r1);
        const float y2 = o2 * rstd * gg.z * silu_f(r2), y3 = o3 * rstd * gg.w * silu_f(r3);
        *(uint2*)(A2 + (size_t)t * D + hh * 256 + lane * 4) = make_uint2(pack2(y0, y1), pack2(y2, y3));
    }
}

__device__ __forceinline__ void phase_route(const Args& a) {
    const u16* Q = (const u16*)(a.ws + WS_Q);
    int* IDX = (int*)(a.ws + WS_IDX);
    float* GATE = (float*)(a.ws + WS_GATE);
    const int lane = threadIdx.x & 63, wave = threadIdx.x >> 6;
    const int gw = blockIdx.x * NWAVES + wave, NGW = gridDim.x * NWAVES;
    for (int item = gw; item < T * 8; item += NGW) {
        const int hh = item & 7, t = item >> 3;
        float ts[2]; int ti[2];
        ts[0] = ts[1] = 0.f; ti[0] = ti[1] = 0;
#pragma unroll
        for (int half = 0; half < 2; ++half) {
            const u16* qp = Q + (size_t)t * D + hh * 256 + half * 128;
            const float* k0p = a.subk + ((size_t)(hh * 2 + half) * 128 + lane) * 128;
            const float* k1p = k0p + 64 * 128;
            float v0 = 0.f, v1 = 0.f;
            for (int d = 0; d < 128; d += 4) {
                const uint2 qq = *(const uint2*)(qp + d);
                const float4 ka = *(const float4*)(k0p + d), kb = *(const float4*)(k1p + d);
                const float x0 = lo2f(qq.x), x1 = hi2f(qq.x), x2 = lo2f(qq.y), x3 = hi2f(qq.y);
                v0 += x0 * ka.x + x1 * ka.y + x2 * ka.z + x3 * ka.w;
                v1 += x0 * kb.x + x1 * kb.y + x2 * kb.z + x3 * kb.w;
            }
            float mys = 0.f; int myi = 0;
            for (int it = 0; it < 16; ++it) {
                const float lm = fmaxf(v0, v1);
                const float wm = wave_max(lm);
                const unsigned long long bal = __ballot(lm == wm);
                const int src = __ffsll((long long)bal) - 1;
                const int which = (v0 >= v1) ? 0 : 1;
                const int kidx = __shfl(lane + 64 * which, src);
                if (lane == src) { if (which == 0) v0 = -3.0e38f; else v1 = -3.0e38f; }
                if (lane == it) { mys = wm; myi = kidx; }
            }
            ts[half] = mys; ti[half] = myi;
        }
        float cv[4];
#pragma unroll
        for (int r = 0; r < 4; ++r) {
            const int c = lane + 64 * r;
            cv[r] = __shfl(ts[0], c >> 4) + __shfl(ts[1], c & 15);
        }
        float bs = 0.f; int bc = 0;
        for (int it = 0; it < 16; ++it) {
            const float lm = fmaxf(fmaxf(cv[0], cv[1]), fmaxf(cv[2], cv[3]));
            const float wm = wave_max(lm);
            const unsigned long long bal = __ballot(lm == wm);
            const int src = __ffsll((long long)bal) - 1;
            int which = 3;
            if (cv[2] == lm) which = 2;
            if (cv[1] == lm) which = 1;
            if (cv[0] == lm) which = 0;
            const int cidx = __shfl(lane + 64 * which, src);
            if (lane == src) {
                if (which == 0) cv[0] = -3.0e38f; else if (which == 1) cv[1] = -3.0e38f; else if (which == 2) cv[2] = -3.0e38f; else cv[3] = -3.0e38f;
            }
            if (lane == it) { bs = wm; bc = cidx; }
        }
        const float top = __shfl(bs, 0);
        const float e = (lane < 16) ? __expf(bs - top) : 0.f;
        const float den = wave_sum(e);
        const int i0 = __shfl(ti[0], bc >> 4), i1 = __shfl(ti[1], bc & 15);
        if (lane < 16) {
            IDX[(size_t)t * 128 + hh * 16 + lane] = i0 * 128 + i1;
            GATE[(size_t)t * 128 + hh * 16 + lane] = e / den;
        }
    }
}

typedef __bf16 bf16x2_t __attribute__((ext_vector_type(2)));
__device__ __forceinline__ float dot2bf(unsigned w, unsigned x, float acc) {
    return __builtin_amdgcn_fdot2_f32_bf16(__builtin_bit_cast(bf16x2_t, w), __builtin_bit_cast(bf16x2_t, x), acc, false);
}
__device__ __forceinline__ void convert_tables(const Args& a) {
    uint4* U = (uint4*)(a.ws + WS_TU); uint4* V = (uint4*)(a.ws + WS_TV);
    const size_t n8 = (size_t)16384 * D / 8;
    const size_t gt = (size_t)blockIdx.x * NTHREADS + threadIdx.x, NT = (size_t)gridDim.x * NTHREADS;
    for (size_t i = gt; i < 2 * n8; i += NT) {
        const bool isv = i >= n8; const size_t j = isv ? i - n8 : i;
        const f32x4* sp = (const f32x4*)(isv ? a.pv : a.pu) + 2 * j;
        const f32x4 v0 = __builtin_nontemporal_load(sp), v1 = __builtin_nontemporal_load(sp + 1);
        const uint4 o = make_uint4(pack2(v0.x, v0.y), pack2(v0.z, v0.w), pack2(v1.x, v1.y), pack2(v1.z, v1.w));
        (isv ? V : U)[j] = o;
    }
}

__device__ __forceinline__ void phase_experts(const Args& a) {
    const u16* H2 = (const u16*)(a.ws + WS_ACT);
    const float* X1 = (const float*)(a.ws + WS_X1);
    const int* IDX = (const int*)(a.ws + WS_IDX);
    const float* GATE = (const float*)(a.ws + WS_GATE);
    const float* mod = (const float*)(a.ws + WS_MOD);
    const uint4* U = (const uint4*)(a.ws + WS_TU); const uint4* V = (const uint4*)(a.ws + WS_TV);
    const int lane = threadIdx.x & 63, wave = threadIdx.x >> 6;
    const int gw = blockIdx.x * NWAVES + wave, NGW = gridDim.x * NWAVES;
    for (int t = gw; t < T; t += NGW) {
        const int b = t / S;
        uint4 h[4]; float acc[4][8];
        {
            const uint4* hp = (const uint4*)(H2 + (size_t)t * D);
#pragma unroll
            for (int m = 0; m < 4; ++m) { h[m] = hp[lane + 64 * m];
#pragma unroll
                for (int i = 0; i < 8; ++i) acc[m][i] = 0.f; }
        }
#pragma unroll 1
        for (int r0 = 0; r0 < 128; r0 += 4) {
            const int4 e4 = *(const int4*)(IDX + (size_t)t * 128 + r0);
            const float4 g4 = *(const float4*)(GATE + (size_t)t * 128 + r0);
            int e[4] = {__builtin_amdgcn_readfirstlane(e4.x), __builtin_amdgcn_readfirstlane(e4.y), __builtin_amdgcn_readfirstlane(e4.z), __builtin_amdgcn_readfirstlane(e4.w)};
            const float g[4] = {g4.x, g4.y, g4.z, g4.w};
            uint4 u[4][4], v[4][4];
#pragma unroll
            for (int q = 0; q < 4; ++q)
#pragma unroll
                for (int m = 0; m < 4; ++m) u[q][m] = U[(size_t)e[q] * 256 + lane + 64 * m];
#pragma unroll
            for (int q = 0; q < 4; ++q)
#pragma unroll
                for (int m = 0; m < 4; ++m) v[q][m] = V[(size_t)e[q] * 256 + lane + 64 * m];
            float d[4];
#pragma unroll
            for (int q = 0; q < 4; ++q) { float s0 = 0.f, s1 = 0.f;
#pragma unroll
                for (int m = 0; m < 4; ++m) { s0 = dot2bf(u[q][m].x, h[m].x, s0); s1 = dot2bf(u[q][m].y, h[m].y, s1); s0 = dot2bf(u[q][m].z, h[m].z, s0); s1 = dot2bf(u[q][m].w, h[m].w, s1); }
                d[q] = s0 + s1; }
#pragma unroll
            for (int o = 32; o > 0; o >>= 1) {
#pragma unroll
                for (int q = 0; q < 4; ++q) d[q] += __shfl_xor(d[q], o);
            }
#pragma unroll
            for (int q = 0; q < 4; ++q) { const float w = g[q] * gelu_f(d[q]);
#pragma unroll
                for (int m = 0; m < 4; ++m) {
                    acc[m][0] += w * lo2f(v[q][m].x); acc[m][1] += w * hi2f(v[q][m].x); acc[m][2] += w * lo2f(v[q][m].y); acc[m][3] += w * hi2f(v[q][m].y);
                    acc[m][4] += w * lo2f(v[q][m].z); acc[m][5] += w * hi2f(v[q][m].z); acc[m][6] += w * lo2f(v[q][m].w); acc[m][7] += w * hi2f(v[q][m].w); } }
        }
        float ss = 0.f;
#pragma unroll
        for (int m = 0; m < 4; ++m) {
            const int c0 = lane * 8 + 512 * m;
            const float4 xa = *(const float4*)(X1 + (size_t)t * D + c0), xb = *(const float4*)(X1 + (size_t)t * D + c0 + 4);
            const float4 ga = *(const float4*)(mod + b * 12288 + 5 * 2048 + c0), gb = *(const float4*)(mod + b * 12288 + 5 * 2048 + c0 + 4);
            acc[m][0] = xa.x + ga.x * acc[m][0]; acc[m][1] = xa.y + ga.y * acc[m][1]; acc[m][2] = xa.z + ga.z * acc[m][2]; acc[m][3] = xa.w + ga.w * acc[m][3];
            acc[m][4] = xb.x + gb.x * acc[m][4]; acc[m][5] = xb.y + gb.y * acc[m][5]; acc[m][6] = xb.z + gb.z * acc[m][6]; acc[m][7] = xb.w + gb.w * acc[m][7];
#pragma unroll
            for (int i = 0; i < 8; ++i) ss += acc[m][i] * acc[m][i];
        }
        ss = wave_sum(ss);
        const float rstd = rsqrtf(ss * (1.f / D) + NORM_EPS);
#pragma unroll
        for (int m = 0; m < 4; ++m) {
            const int c0 = lane * 8 + 512 * m;
            const float4 ga = *(const float4*)(a.g_fin + c0), gb = *(const float4*)(a.g_fin + c0 + 4);
            *(float4*)(a.out + (size_t)t * D + c0) = make_float4(acc[m][0] * rstd * ga.x, acc[m][1] * rstd * ga.y, acc[m][2] * rstd * ga.z, acc[m][3] * rstd * ga.w);
            *(float4*)(a.out + (size_t)t * D + c0 + 4) = make_float4(acc[m][4] * rstd * gb.x, acc[m][5] * rstd * gb.y, acc[m][6] * rstd * gb.z, acc[m][7] * rstd * gb.w);
        }
    }
}

constexpr int NPHASES = 11;
__global__ void __launch_bounds__(NTHREADS, 2) mk_fwd(Args a) {
    extern __shared__ __attribute__((aligned(16))) unsigned char lds[];
    cg::grid_group grid = cg::this_grid();
    const int lo = a.ph_lo, hi = a.ph_hi;
#define IN(k) (lo <= (k) && (k) < hi)
#define SEAM(k) do { if (IN(k) && IN((k) + 1)) grid.sync(); } while (0)
    const float* mod = (const float*)(a.ws + WS_MOD);
    if (IN(0)) phase0(a, lds);
    SEAM(0);
    if (IN(1)) norm_mod_phase(a.x, a.g_mix, mod, 0, 1, (u16*)(a.ws + WS_ACT));
    SEAM(1);
    if (IN(2)) gemm8(lds, (const u16*)(a.ws + WS_ACT), (const u16*)(a.ws + WS_WIN), T, NPAD, D, EpiProj{(u16*)(a.ws + WS_P), (float*)(a.ws + WS_GZ)});
    SEAM(2);
    if (IN(3)) phase_rope_gates(a);
    SEAM(3);
    if (IN(4)) phase_mixers(a, lds);
    SEAM(4);
    if (IN(5)) phase_gla_fin(a);
    SEAM(5);
    if (IN(6)) gemm8(lds, (const u16*)(a.ws + WS_ACT), (const u16*)(a.ws + WS_WOUT), T, D, D, EpiResid{a.x, mod, (float*)(a.ws + WS_X1)});
    SEAM(6);
    if (IN(7)) { norm_mod_phase((const float*)(a.ws + WS_X1), a.g_ffn, mod, 3, 4, (u16*)(a.ws + WS_ACT)); convert_tables(a); }
    SEAM(7);
    if (IN(8)) gemm8(lds, (const u16*)(a.ws + WS_ACT), (const u16*)(a.ws + WS_WPQ), T, D, D, EpiBf16{(u16*)(a.ws + WS_Q)});
    SEAM(8);
    if (IN(9)) phase_route(a);
    SEAM(9);
    if (IN(10)) phase_experts(a);
#undef IN
#undef SEAM
}

#ifndef MK_ONE_LAUNCH
#define MK_ONE_LAUNCH 1
#endif
extern "C" void kernel_launch(void* const* d_in, const int* in_sizes, int n_in, void* d_out, int out_size, void* d_ws, size_t ws_size, hipStream_t stream) {
    static int grid = 0;
    if (grid == 0) {
        if (n_in != 19 || out_size != T * D || ws_size < WS_END) {
            fprintf(stderr, "kernel_launch: unexpected shapes: n_in %d out %d ws %zu (need %zu)\n", n_in, out_size, ws_size, (size_t)WS_END);
            grid = -1; return;
        }
        int dev = 0, cus = 0, per_cu = 0;
        (void)hipGetDevice(&dev);
        (void)hipDeviceGetAttribute(&cus, hipDeviceAttributeMultiprocessorCount, dev);
        (void)hipFuncSetAttribute((const void*)mk_fwd, hipFuncAttributeMaxDynamicSharedMemorySize, LDS_BYTES);
        (void)hipOccupancyMaxActiveBlocksPerMultiprocessor(&per_cu, (const void*)mk_fwd, NTHREADS, LDS_BYTES);
        if (per_cu < 1) { fprintf(stderr, "kernel_launch: occupancy query says %d blocks/CU\n", per_cu); grid = -1; return; }
        grid = cus;
        (void)hipGetLastError();
    }
    if (grid < 0) return;
    Args a{};
    a.x = (const float*)d_in[0]; a.c = (const float*)d_in[1]; a.pos = (const int*)d_in[2]; a.w_ada = (const float*)d_in[3];
    a.b_ada = (const float*)d_in[4]; a.g_mix = (const float*)d_in[5]; a.w_in = (const float*)d_in[6]; a.wgf = (const float*)d_in[7];
    a.bgf = (const float*)d_in[8]; a.wgb = (const float*)d_in[9]; a.bgb = (const float*)d_in[10]; a.g_gla = (const float*)d_in[11];
    a.w_out = (const float*)d_in[12]; a.g_ffn = (const float*)d_in[13]; a.w_pq = (const float*)d_in[14]; a.subk = (const float*)d_in[15];
    a.pu = (const float*)d_in[16]; a.pv = (const float*)d_in[17]; a.g_fin = (const float*)d_in[18];
    a.out = (float*)d_out; a.ws = (unsigned char*)d_ws;
#if MK_ONE_LAUNCH
    a.ph_lo = 0; a.ph_hi = NPHASES;
    void* args[] = {&a};
    hipError_t e = hipLaunchCooperativeKernel((const void*)mk_fwd, dim3(grid), dim3(NTHREADS), args, LDS_BYTES, stream);
    if (e != hipSuccess) fprintf(stderr, "cooperative launch failed: %s (grid %d)\n", hipGetErrorString(e), grid);
#else
    for (int p = 0; p < NPHASES; ++p) {
        a.ph_lo = p; a.ph_hi = p + 1;
        hipLaunchKernelGGL(mk_fwd, dim3(grid), dim3(NTHREADS), LDS_BYTES, stream, a);
    }
#endif
}
```

```cpp
#include <hip/hip_runtime.h>
#include <hip/hip_cooperative_groups.h>
#include <cstdio>
#include <cstdint>

namespace cg = cooperative_groups;

typedef unsigned short u16;
typedef __attribute__((ext_vector_type(8))) short bf16x8;
typedef __attribute__((ext_vector_type(4))) float f32x4;
typedef short s16x4 __attribute__((ext_vector_type(4)));
#define TID ((int)threadIdx.x)
#define BID ((int)blockIdx.x)
#define GDIM ((int)gridDim.x)
#define LAS __attribute__((address_space(3)))

constexpr int D = 2048, NB = 4, S = 4096, T = NB * S;
constexpr int INW = 6176;
constexpr int NP = 6144;
constexpr int NPAD = 6400;
constexpr int C_GQ = 0, C_GK = 512, C_GV = 1024, C_GR = 2048, C_DQ = 3072, C_DK = 4096, C_DV = 5120;
constexpr int NTHREADS = 512, NWAVES = 8;
constexpr int LDS_BYTES = 128 * 1024;
constexpr float NORM_EPS = 1e-6f;

constexpr size_t WS_CTL = 0;
constexpr size_t WS_MOD = 65536;
constexpr size_t WS_CS = 524288;
constexpr size_t WS_WIN = WS_CS + (size_t)T * 64 * 8;
constexpr size_t WS_WOUT = WS_WIN + (size_t)NPAD * D * 2;
constexpr size_t WS_WPQ = WS_WOUT + (size_t)D * D * 2;
constexpr size_t WS_ACT = WS_WPQ + (size_t)D * D * 2;
constexpr size_t WS_P = WS_ACT + (size_t)T * D * 2;
constexpr size_t WS_X1 = WS_P;
constexpr size_t WS_Q = WS_P + (size_t)T * D * 4;
constexpr size_t WS_GZ = WS_P + (size_t)T * NP * 2;
constexpr size_t WS_LA = WS_GZ + (size_t)T * 32 * 4;
constexpr size_t WS_OFB = WS_LA + (size_t)2 * T * 512 * 4;
constexpr size_t WS_IDX = WS_OFB + (size_t)2 * T * 1024 * 4;
constexpr size_t WS_GATE = WS_IDX + (size_t)T * 128 * 4;
constexpr size_t WS_END = WS_GATE + (size_t)T * 128 * 4;
constexpr size_t WS_TU = WS_LA;
constexpr size_t WS_TV = WS_OFB;

struct Args {
    const float* x; const float* c; const int* pos; const float* w_ada; const float* b_ada; const float* g_mix;
    const float* w_in; const float* wgf; const float* bgf; const float* wgb; const float* bgb; const float* g_gla;
    const float* w_out; const float* g_ffn; const float* w_pq; const float* subk; const float* pu; const float* pv; const float* g_fin;
    float* out; unsigned char* ws; int ph_lo, ph_hi;
};

__device__ __forceinline__ float bf2f(u16 h) { return __uint_as_float(((unsigned)h) << 16); }
__device__ __forceinline__ u16 f2bf(float f) { unsigned u = __float_as_uint(f); u += 0x7fffu + ((u >> 16) & 1u); return (u16)(u >> 16); }
__device__ __forceinline__ unsigned pack2(float a, float b) { return (unsigned)f2bf(a) | ((unsigned)f2bf(b) << 16); }
__device__ __forceinline__ float lo2f(unsigned p) { return __uint_as_float(p << 16); }
__device__ __forceinline__ float hi2f(unsigned p) { return __uint_as_float(p & 0xffff0000u); }
__device__ __forceinline__ float wave_sum(float v) {
#pragma unroll
    for (int o = 32; o > 0; o >>= 1) v += __shfl_xor(v, o);
    return v;
}
__device__ __forceinline__ float wave_max(float v) {
#pragma unroll
    for (int o = 32; o > 0; o >>= 1) v = fmaxf(v, __shfl_xor(v, o));
    return v;
}
__device__ __forceinline__ float silu_f(float v) { return v / (1.f + __expf(-v)); }
__device__ __forceinline__ float gelu_f(float a) { return 0.5f * a * (1.f + erff(a * 0.70710678118654752f)); }
__device__ __forceinline__ float logsigmoid_f(float z) { return z < 0.f ? z - log1pf(expf(z)) : -log1pf(expf(-z)); }

__device__ __forceinline__ void p0_mod(const Args& a, unsigned char* lds, int bi) {
    float* sc = (float*)lds;
    float* red = sc + 4 * 2048;
    const int tid = threadIdx.x, lane = tid & 63, wave = tid >> 6;
    for (int i = tid; i < 4 * 2048; i += NTHREADS) sc[i] = silu_f(a.c[i]);
    __syncthreads();
    const int j0 = bi * 256 + lane * 4;
    float acc[4][4];
#pragma unroll
    for (int b = 0; b < 4; ++b)
#pragma unroll
        for (int q = 0; q < 4; ++q) acc[b][q] = 0.f;
    const int k0 = wave * 256;
#pragma unroll 4
    for (int kk = 0; kk < 256; ++kk) {
        const int k = k0 + kk;
        const float4 w = *(const float4*)(a.w_ada + (size_t)k * 12288 + j0);
#pragma unroll
        for (int b = 0; b < 4; ++b) {
            const float s = sc[b * 2048 + k];
            acc[b][0] += s * w.x; acc[b][1] += s * w.y; acc[b][2] += s * w.z; acc[b][3] += s * w.w;
        }
    }
#pragma unroll
    for (int b = 0; b < 4; ++b)
#pragma unroll
        for (int q = 0; q < 4; ++q) red[(wave * 4 + b) * 256 + lane * 4 + q] = acc[b][q];
    __syncthreads();
    float* mod = (float*)(a.ws + WS_MOD);
    for (int i = tid; i < 4 * 256; i += NTHREADS) {
        const int b = i >> 8, jc = i & 255;
        float s = 0.f;
#pragma unroll
        for (int w = 0; w < 8; ++w) s += red[(w * 4 + b) * 256 + jc];
        mod[b * 12288 + bi * 256 + jc] = s + a.b_ada[bi * 256 + jc];
    }
    __syncthreads();
}

__device__ __forceinline__ void p0_transpose_item(const float* __restrict__ W, int ldw, int k0, int src_col0, int n_valid,
                                                  u16* __restrict__ WT, int ldt, int n_out0, unsigned char* lds) {
    u16* tl = (u16*)lds;
    const int tid = threadIdx.x;
    {
        const int k = tid >> 3, nc = (tid & 7) * 8;
        float v[8];
        if (nc < n_valid) {
            const float4 v0 = *(const float4*)(W + (size_t)(k0 + k) * ldw + src_col0 + nc);
            const float4 v1 = *(const float4*)(W + (size_t)(k0 + k) * ldw + src_col0 + nc + 4);
            v[0] = v0.x; v[1] = v0.y; v[2] = v0.z; v[3] = v0.w; v[4] = v1.x; v[5] = v1.y; v[6] = v1.z; v[7] = v1.w;
        } else {
#pragma unroll
            for (int i = 0; i < 8; ++i) v[i] = 0.f;
        }
#pragma unroll
        for (int i = 0; i < 8; ++i) tl[(nc + i) * 72 + k] = f2bf(v[i]);
    }
    __syncthreads();
    {
        const int n = tid >> 3, kc = (tid & 7) * 8;
        const uint4 v = *(const uint4*)(tl + n * 72 + kc);
        *(uint4*)(WT + (size_t)(n_out0 + n) * ldt + k0 + kc) = v;
    }
    __syncthreads();
}

__device__ __forceinline__ void phase0(const Args& a, unsigned char* lds) {
    const int bi = blockIdx.x, G = gridDim.x, tid = threadIdx.x;
    if (bi < 48) p0_mod(a, lds, bi);
    constexpr int I_IN = 32 * (NPAD / 64), I_SQ = 32 * 32;
    u16* WinT = (u16*)(a.ws + WS_WIN); u16* WoutT = (u16*)(a.ws + WS_WOUT); u16* WpqT = (u16*)(a.ws + WS_WPQ);
    for (int it = bi; it < I_IN + 2 * I_SQ; it += G) {
        if (it < I_IN) {
            const int kt = it & 31, nt = it >> 5;
            const int n0 = nt * 64;
            int src, nv;
            if (n0 < 3072) { src = n0; nv = 64; }
            else if (n0 < 6144) { src = n0 + 32; nv = 64; }
            else if (n0 == 6144) { src = 3072; nv = 32; }
            else { src = 0; nv = 0; }
            p0_transpose_item(a.w_in, INW, kt * 64, src, nv, WinT, D, n0, lds);
        } else if (it < I_IN + I_SQ) {
            const int r = it - I_IN; const int kt = r & 31, nt = r >> 5;
            p0_transpose_item(a.w_out, D, kt * 64, nt * 64, 64, WoutT, D, nt * 64, lds);
        } else {
            const int r = it - I_IN - I_SQ; const int kt = r & 31, nt = r >> 5;
            p0_transpose_item(a.w_pq, D, kt * 64, nt * 64, 64, WpqT, D, nt * 64, lds);
        }
    }
    float2* cs = (float2*)(a.ws + WS_CS);
    for (int i = bi * NTHREADS + tid; i < T * 64; i += G * NTHREADS) {
        const int t = i >> 6, f = i & 63;
        const float inv_freq = powf(10000.0f, -(float)f * 2.0f / 128.0f);
        const float ang = (float)a.pos[t] * inv_freq;
        const double rev = (double)ang * 0.15915494309189533577;
        const float fr = (float)(rev - floor(rev));
        cs[i] = make_float2(__builtin_amdgcn_cosf(fr), __builtin_amdgcn_sinf(fr));
    }
}

__device__ __forceinline__ void norm_mod_phase(const float* __restrict__ xin, const float* __restrict__ g, const float* __restrict__ mod,
                                               int sh_chunk, int sc_chunk, u16* __restrict__ outp) {
    const int lane = threadIdx.x & 63, wave = threadIdx.x >> 6;
    const int gw = blockIdx.x * NWAVES + wave, NGW = gridDim.x * NWAVES;
    for (int t = gw; t < T; t += NGW) {
        const int b = t / S;
        const float4* xr = (const float4*)(xin + (size_t)t * D);
        float4 v[8]; float ss = 0.f;
#pragma unroll
        for (int m = 0; m < 8; ++m) { v[m] = xr[lane + 64 * m]; ss += v[m].x * v[m].x + v[m].y * v[m].y + v[m].z * v[m].z + v[m].w * v[m].w; }
        ss = wave_sum(ss);
        const float rstd = rsqrtf(ss * (1.f / D) + NORM_EPS);
        const float4* gp = (const float4*)g;
        const float4* shp = (const float4*)(mod + b * 12288 + sh_chunk * 2048);
        const float4* scp = (const float4*)(mod + b * 12288 + sc_chunk * 2048);
        uint2* op = (uint2*)(outp + (size_t)t * D);
#pragma unroll
        for (int m = 0; m < 8; ++m) {
            const int i = lane + 64 * m;
            const float4 gg = gp[i], sh = shp[i], sc = scp[i];
            const float h0 = v[m].x * rstd * gg.x * (1.f + sc.x) + sh.x;
            const float h1 = v[m].y * rstd * gg.y * (1.f + sc.y) + sh.y;
            const float h2 = v[m].z * rstd * gg.z * (1.f + sc.z) + sh.z;
            const float h3 = v[m].w * rstd * gg.w * (1.f + sc.w) + sh.w;
            op[i] = make_uint2(pack2(h0, h1), pack2(h2, h3));
        }
    }
}

namespace pg8 {
#define PG8_LAS __attribute__((address_space(3)))
typedef unsigned short bf16_t;
typedef short bf16x8 __attribute__((ext_vector_type(8)));
typedef float f32x4 __attribute__((ext_vector_type(4)));
typedef unsigned u32x4 __attribute__((ext_vector_type(4)));
constexpr int BM = 256, BK = 64, HALF = 128, HTB = HALF * BK * 2  , STAGE_BYTES = 8 * HTB, NXCD = 8, WGM = 8;

__host__ __device__ __forceinline__ int lds_byte(int r, int c) { const int st = (r >> 4) * 2 + (c >> 5), rr = r & 15, cc = c & 31, ob = rr * 64 + cc * 2; return st * 1024 + (ob ^ (((ob >> 9) & 1) << 5)); }
__host__ __device__ __forceinline__ void stage_rc(int b, int& R, int& C) { const int st = b / 1024, sb = b % 1024, swz = sb ^ (((sb >> 9) & 1) << 5); R = (st >> 1) * 16 + swz / 64; C = (st & 1) * 32 + (swz % 64) / 2; }
__host__ __device__ __forceinline__ int perm32(int rho) { const int n = rho >> 4, i = rho & 15; return 8 * (i >> 2) + 4 * n + (i & 3); }

struct Unit { int pm, pn; };
struct Gemm { const bf16_t* A; const bf16_t* Bt; int M, N, K; };

struct StaticOrder {
    int nM, nN, nwg, G, c;
    __host__ __device__ void init(int M, int N, int G_, int c_) { nM = M / BM; nN = N / BM; nwg = nM * nN; G = G_; c = c_; }
    __host__ __device__ bool next(int i, Unit& u) const {
        const long L = (long)i * G + c; if (L >= nwg) return false;
        int wgid = (int)L; { const int q = nwg / NXCD, r = nwg % NXCD, xcd = wgid % NXCD, off = wgid / NXCD; wgid = (xcd < r ? xcd * (q + 1) : r * (q + 1) + (xcd - r) * q) + off; }
        const int nig = WGM * nN, gid = wgid / nig, fm = gid * WGM, gsz = (nM - fm) < WGM ? (nM - fm) : WGM;
        u.pm = fm + ((wgid % nig) % gsz); u.pn = (wgid % nig) / gsz; return true;
    }
    __device__ __forceinline__ void a_ready(const Unit&) const {}
    __device__ __forceinline__ void done(const Unit&) const {}
};
__device__ __forceinline__ unsigned cvt_pk_bf16(float lo, float hi) { unsigned r; asm volatile("v_cvt_pk_bf16_f32 %0, %1, %2" : "=v"(r) : "v"(lo), "v"(hi)); return r; }
typedef float f32x2 __attribute__((ext_vector_type(2)));
template <class Epi, class Sched, bool STAMP = false>
__device__ __forceinline__ void gemm_phase(PG8_LAS unsigned char* lds, const Gemm g, const Sched& S, const Epi& E, unsigned long long* stamps) {
    const int tid = threadIdx.x, wid = __builtin_amdgcn_readfirstlane(tid >> 6), lane = tid & 63, wr = wid >> 2, wc = wid & 3, fr = lane & 15, fq = lane >> 4;
    const int K = g.K, nt = K / BK;
    int ts_lo = 0, ts_hi = 0, nts = 0; const unsigned long long rt_entry = STAMP ? (unsigned long long)wall_clock64() : 0ull;
#define PG8_STAMP() do { if (STAMP && wid == 0 && nts < 64) { const unsigned long long _c = (unsigned long long)clock64(); \
        ts_lo = (lane == nts) ? (int)(unsigned)_c : ts_lo; ts_hi = (lane == nts) ? (int)(unsigned)(_c >> 32) : ts_hi; ++nts; } } while (0)
    PG8_STAMP();
    unsigned voffA[2], voffB[2];
#pragma unroll
    for (int i = 0; i < 2; ++i) { int R, C; stage_rc(tid * 16 + i * 8192, R, C); const int Rb = Epi::PERM ? ((R & ~31) + perm32(R & 31)) : R;
        voffA[i] = (unsigned)(R * K + C) * 2u; voffB[i] = (unsigned)(Rb * K + C) * 2u; }
    const size_t kstep = (size_t)(BK * 2);
    const size_t hstep = (size_t)HALF * K * 2;
    const size_t tstep = 2 * hstep;
    const unsigned ldsw = (unsigned)wid * 1024u;
    const int aoff = lds_byte(wr * 64 + fr, fq * 8), boff = lds_byte(wc * 32 + fr, fq * 8);
#define PG8_SA(b, h) (((b) * 2 + (h)) * HTB)
#define PG8_SB(b, h) ((4 + (b) * 2 + (h)) * HTB)
#define PG8_STAGE(bufoff, gbase, voff) do { _Pragma("unroll") for (int _i = 0; _i < 2; ++_i) \
        __builtin_amdgcn_global_load_lds((const unsigned*)((const char*)(gbase) + (voff)[_i]), (PG8_LAS unsigned*)(lds + (bufoff) + ldsw + _i * 8192), 16, 0, 0); } while (0)
#define PG8_LDA(dst, b, h) do { _Pragma("unroll") for (int m = 0; m < 4; ++m) _Pragma("unroll") for (int k = 0; k < 2; ++k) dst[m][k] = *(const PG8_LAS bf16x8*)(lds + PG8_SA(b, h) + aoff + m * 2048 + k * 1024); } while (0)
#define PG8_LDB(dst, b, h) do { _Pragma("unroll") for (int n = 0; n < 2; ++n) _Pragma("unroll") for (int k = 0; k < 2; ++k) dst[n][k] = *(const PG8_LAS bf16x8*)(lds + PG8_SB(b, h) + boff + n * 2048 + k * 1024); } while (0)
#define PG8_MMA(ai, bj, At, Bt) do { __builtin_amdgcn_s_setprio(1); _Pragma("unroll") for (int m = 0; m < 4; ++m) _Pragma("unroll") for (int n = 0; n < 2; ++n) _Pragma("unroll") for (int k = 0; k < 2; ++k) \
        acc[ai][bj][m][n] = __builtin_amdgcn_mfma_f32_16x16x32_bf16(Bt[n][k], At[m][k], acc[ai][bj][m][n], 0, 0, 0); __builtin_amdgcn_s_setprio(0); } while (0)
#define PG8_WAIT_V(n) asm volatile("s_waitcnt vmcnt(" #n ")" ::: "memory")
#define PG8_WAIT_L(n) asm volatile("s_waitcnt lgkmcnt(" #n ")" ::: "memory")
#define PG8_BAR __builtin_amdgcn_s_barrier()
#define PG8_SCHED __builtin_amdgcn_sched_barrier(0)
    Unit cur, nxt; int ui = 0;
    if (!S.next(0, cur)) return;
    f32x4 acc[2][2][4][2];
#pragma unroll
    for (int a = 0; a < 2; ++a)
#pragma unroll
        for (int b = 0; b < 2; ++b)
#pragma unroll
            for (int m = 0; m < 4; ++m)
#pragma unroll
                for (int n = 0; n < 2; ++n) acc[a][b][m][n] = (f32x4){0.f, 0.f, 0.f, 0.f};
    bf16x8 At[4][2], B0[2][2], B1[2][2];
    const char* cA = (const char*)g.A + (size_t)cur.pm * tstep; const char* cB = (const char*)g.Bt + (size_t)cur.pn * tstep;
    S.a_ready(cur);
    PG8_STAGE(PG8_SB(0, 0), cB, voffB); PG8_STAGE(PG8_SA(0, 0), cA, voffA); PG8_STAGE(PG8_SB(0, 1), cB + hstep, voffB); PG8_STAGE(PG8_SA(0, 1), cA + hstep, voffA);
    if (wr == 1) PG8_BAR;
    PG8_WAIT_V(4); PG8_BAR;
    PG8_STAGE(PG8_SB(1, 0), cB + kstep, voffB); PG8_STAGE(PG8_SA(1, 0), cA + kstep, voffA); PG8_STAGE(PG8_SB(1, 1), cB + hstep + kstep, voffB);
    PG8_WAIT_V(6); PG8_BAR;
    PG8_STAMP();
    for (;;) {
        const bool has_next = S.next(ui + 1, nxt);
        const char* nA = has_next ? (const char*)g.A + (size_t)nxt.pm * tstep : cA; const char* nB = has_next ? (const char*)g.Bt + (size_t)nxt.pn * tstep : cB;
        for (int t = 0; t < nt; t += 2) {
            const bool last = (t == nt - 2);
            const char* a1 = cA + (size_t)(t + 1) * kstep;
            const char* a2 = last ? nA : cA + (size_t)(t + 2) * kstep; const char* b2 = last ? nB : cB + (size_t)(t + 2) * kstep;
            const char* a3 = a2 + kstep; const char* b3 = b2 + kstep;
            if (last && has_next) S.a_ready(nxt);
            PG8_LDB(B0, 0, 0); PG8_SCHED; PG8_LDA(At, 0, 0); PG8_STAGE(PG8_SA(1, 1), a1 + hstep, voffA);
            PG8_WAIT_L(8); PG8_BAR; PG8_WAIT_L(0); PG8_MMA(0, 0, At, B0); PG8_BAR; PG8_SCHED;
            PG8_LDB(B1, 0, 1); PG8_STAGE(PG8_SB(0, 0), b2, voffB);
            PG8_BAR; PG8_WAIT_L(0); PG8_MMA(0, 1, At, B1); PG8_BAR;
            PG8_LDA(At, 0, 1); PG8_STAGE(PG8_SA(0, 0), a2, voffA);
            PG8_BAR; PG8_WAIT_L(0); PG8_MMA(1, 0, At, B0); PG8_BAR; PG8_SCHED;
            PG8_STAGE(PG8_SB(0, 1), b2 + hstep, voffB);
            PG8_WAIT_V(6); PG8_BAR; PG8_MMA(1, 1, At, B1); PG8_BAR;
            PG8_LDB(B0, 1, 0); PG8_SCHED; PG8_LDA(At, 1, 0); PG8_STAGE(PG8_SA(0, 1), a2 + hstep, voffA);
            PG8_WAIT_L(8); PG8_BAR; PG8_WAIT_L(0); PG8_MMA(0, 0, At, B0); PG8_BAR; PG8_SCHED;
            PG8_LDB(B1, 1, 1); PG8_STAGE(PG8_SB(1, 0), b3, voffB);
            PG8_BAR; PG8_WAIT_L(0); PG8_MMA(0, 1, At, B1); PG8_BAR;
            PG8_LDA(At, 1, 1); PG8_STAGE(PG8_SA(1, 0), a3, voffA);
            PG8_BAR; PG8_WAIT_L(0); PG8_MMA(1, 0, At, B0); PG8_BAR; PG8_SCHED;
            PG8_STAGE(PG8_SB(1, 1), b3 + hstep, voffB);
            PG8_WAIT_V(6); PG8_BAR; PG8_MMA(1, 1, At, B1); PG8_BAR;
        }
        PG8_STAMP();
        if constexpr (!Epi::AFTER_DRAIN) { E(acc, cur, wr, wc, fr, fq); S.done(cur); }
        PG8_STAMP();
        if (!has_next) break;
#pragma unroll
        for (int a = 0; a < 2; ++a)
#pragma unroll
            for (int b = 0; b < 2; ++b)
#pragma unroll
                for (int m = 0; m < 4; ++m)
#pragma unroll
                    for (int n = 0; n < 2; ++n) acc[a][b][m][n] = (f32x4){0.f, 0.f, 0.f, 0.f};
        cur = nxt; cA = nA; cB = nB; ++ui;
    }
    PG8_WAIT_V(0);
    if (wr == 0) PG8_BAR;
    PG8_BAR;
    if constexpr (Epi::AFTER_DRAIN) { E.fused(acc, cur, wr, wc, fr, fq, lds, wid, lane); S.done(cur); }
    PG8_STAMP();
    if (STAMP && wid == 0) { stamps[lane] = lane < nts ? (((unsigned long long)(unsigned)ts_hi << 32) | (unsigned)ts_lo) : 0ull;
        if (lane == 62) stamps[62] = rt_entry; if (lane == 63) stamps[63] = (unsigned long long)wall_clock64(); }
#undef PG8_STAMP
#undef PG8_SA
#undef PG8_SB
#undef PG8_STAGE
#undef PG8_LDA
#undef PG8_LDB
#undef PG8_MMA
#undef PG8_WAIT_V
#undef PG8_WAIT_L
#undef PG8_BAR
#undef PG8_SCHED
}
}

struct EpiProj {
    static constexpr bool PERM = true, AFTER_DRAIN = false;
    u16* P; float* gz;
    __device__ __forceinline__ void operator()(const pg8::f32x4 (&acc)[2][2][4][2], const pg8::Unit& u, int wr, int wc, int fr, int fq) const {
        const int row0 = u.pm * 256 + wr * 64 + fr;
        if (u.pn < 24) {
            const int col0 = u.pn * 256 + wc * 32 + 8 * fq;
#pragma unroll
            for (int ai = 0; ai < 2; ++ai)
#pragma unroll
                for (int m = 0; m < 4; ++m) { u16* rowp = P + (size_t)(row0 + ai * 128 + m * 16) * NP + col0;
#pragma unroll
                    for (int bj = 0; bj < 2; ++bj) { const pg8::f32x4 v0 = acc[ai][bj][m][0], v1 = acc[ai][bj][m][1];
                        pg8::u32x4 w; w.x = pg8::cvt_pk_bf16(v0[0], v0[1]); w.y = pg8::cvt_pk_bf16(v0[2], v0[3]); w.z = pg8::cvt_pk_bf16(v1[0], v1[1]); w.w = pg8::cvt_pk_bf16(v1[2], v1[3]);
                        *(pg8::u32x4*)(rowp + bj * 128) = w; } }
        } else if (wc == 0) {
#pragma unroll
            for (int ai = 0; ai < 2; ++ai)
#pragma unroll
                for (int m = 0; m < 4; ++m) { float* rowp = gz + (size_t)(row0 + ai * 128 + m * 16) * 32 + 8 * fq;
                    *(pg8::f32x4*)(rowp) = acc[ai][0][m][0]; *(pg8::f32x4*)(rowp + 4) = acc[ai][0][m][1]; }
        }
    }
};
struct EpiResid {
    static constexpr bool PERM = false, AFTER_DRAIN = false;
    const float* x; const float* mod; float* x1;
    __device__ __forceinline__ void operator()(const pg8::f32x4 (&acc)[2][2][4][2], const pg8::Unit& u, int wr, int wc, int fr, int fq) const {
        const int row0 = u.pm * 256 + wr * 64 + fr, col0 = u.pn * 256 + wc * 32 + 4 * fq;
        const int b = (u.pm * 256) / S;
        pg8::f32x4 ga[2][2];
#pragma unroll
        for (int bj = 0; bj < 2; ++bj)
#pragma unroll
            for (int n = 0; n < 2; ++n) ga[bj][n] = *(const pg8::f32x4*)(mod + b * 12288 + 2 * 2048 + col0 + bj * 128 + n * 16);
#pragma unroll
        for (int ai = 0; ai < 2; ++ai)
#pragma unroll
            for (int m = 0; m < 4; ++m) { const size_t off = (size_t)(row0 + ai * 128 + m * 16) * D + col0;
#pragma unroll
                for (int bj = 0; bj < 2; ++bj)
#pragma unroll
                    for (int n = 0; n < 2; ++n) { const pg8::f32x4 xv = *(const pg8::f32x4*)(x + off + bj * 128 + n * 16);
                        *(pg8::f32x4*)(x1 + off + bj * 128 + n * 16) = xv + ga[bj][n] * acc[ai][bj][m][n]; } }
    }
};
struct EpiBf16 {
    static constexpr bool PERM = true, AFTER_DRAIN = false;
    u16* Q;
    __device__ __forceinline__ void operator()(const pg8::f32x4 (&acc)[2][2][4][2], const pg8::Unit& u, int wr, int wc, int fr, int fq) const {
        const int row0 = u.pm * 256 + wr * 64 + fr, col0 = u.pn * 256 + wc * 32 + 8 * fq;
#pragma unroll
        for (int ai = 0; ai < 2; ++ai)
#pragma unroll
            for (int m = 0; m < 4; ++m) { u16* rowp = Q + (size_t)(row0 + ai * 128 + m * 16) * D + col0;
#pragma unroll
                for (int bj = 0; bj < 2; ++bj) { const pg8::f32x4 v0 = acc[ai][bj][m][0], v1 = acc[ai][bj][m][1];
                    pg8::u32x4 w; w.x = pg8::cvt_pk_bf16(v0[0], v0[1]); w.y = pg8::cvt_pk_bf16(v0[2], v0[3]); w.z = pg8::cvt_pk_bf16(v1[0], v1[1]); w.w = pg8::cvt_pk_bf16(v1[2], v1[3]);
                    *(pg8::u32x4*)(rowp + bj * 128) = w; } }
    }
};
template <class Epi>
__device__ __forceinline__ void gemm8(unsigned char* lds, const u16* A, const u16* Bt, int M, int N, int K, const Epi& E) {
    pg8::Gemm g{A, Bt, M, N, K}; pg8::StaticOrder So; So.init(M, N, (int)gridDim.x, (int)blockIdx.x);
    pg8::gemm_phase<Epi, pg8::StaticOrder, false>((PG8_LAS unsigned char*)lds, g, So, E, nullptr);
    __syncthreads();
}

__device__ __forceinline__ void phase_rope_gates(const Args& a) {
    u16* P = (u16*)(a.ws + WS_P);
    const float2* cs = (const float2*)(a.ws + WS_CS);
    const int gt = blockIdx.x * NTHREADS + threadIdx.x, NT = gridDim.x * NTHREADS;
    for (int i = gt; i < T * 2 * 8 * 64; i += NT) {
        const int f = i & 63, hh = (i >> 6) & 7, which = (i >> 9) & 1, t = i >> 10;
        const float2 c = cs[t * 64 + f];
        u16* p = P + (size_t)t * NP + (which ? C_DK : C_DQ) + hh * 128 + f;
        const float t1 = bf2f(p[0]), t2 = bf2f(p[64]);
        p[0] = f2bf(t1 * c.x - t2 * c.y);
        p[64] = f2bf(t1 * c.y + t2 * c.x);
    }
    const float* gz = (const float*)(a.ws + WS_GZ);
    float* la = (float*)(a.ws + WS_LA);
    for (int i = gt; i < 2 * T * 512; i += NT) {
        const int col = i & 511, t = (i >> 9) % T, dir = i / (T * 512);
        const float* w = dir ? a.wgb : a.wgf; const float* bb = dir ? a.bgb : a.bgf;
        float z = bb[col];
#pragma unroll
        for (int r = 0; r < 16; ++r) z += gz[(size_t)t * 32 + dir * 16 + r] * w[r * 512 + col];
        la[i] = logsigmoid_f(z) * (1.f / 16.f);
    }
}

__device__ __forceinline__ void gla_naive_item(const Args& a, unsigned char* lds, int item) {
    const int slice = item & 3, dir = (item >> 2) & 1, hh = (item >> 3) & 3, b = item >> 5;
    float* qs = (float*)lds;
    float* ks = qs + 32 * 128;
    float* as = ks + 32 * 128;
    float* vs = as + 32 * 128;
    float* po = vs + 32 * 64;
    const u16* P = (const u16*)(a.ws + WS_P);
    const float* la = (const float*)(a.ws + WS_LA) + (size_t)dir * T * 512;
    float* O = (float*)(a.ws + WS_OFB) + (size_t)dir * T * 1024;
    const int tid = threadIdx.x, g = tid >> 6, j = tid & 63;
    float st[16];
#pragma unroll
    for (int i = 0; i < 16; ++i) st[i] = 0.f;
    const float qscale = 0.08838834764831845f;
    for (int ch = 0; ch < S / 32; ++ch) {
        for (int e = tid; e < 32 * 128; e += NTHREADS) {
            const int i = e >> 7, d = e & 127;
            const int s = dir ? (S - 1 - (ch * 32 + i)) : (ch * 32 + i);
            const size_t t = (size_t)b * S + s;
            qs[e] = bf2f(P[t * NP + C_GQ + hh * 128 + d]) * qscale;
            ks[e] = bf2f(P[t * NP + C_GK + hh * 128 + d]);
            as[e] = expf(la[t * 512 + hh * 128 + d]);
        }
        for (int e = tid; e < 32 * 64; e += NTHREADS) {
            const int i = e >> 6, jj = e & 63;
            const int s = dir ? (S - 1 - (ch * 32 + i)) : (ch * 32 + i);
            const size_t t = (size_t)b * S + s;
            vs[e] = bf2f(P[t * NP + C_GV + hh * 256 + slice * 64 + jj]);
        }
        __syncthreads();
        for (int i = 0; i < 32; ++i) {
            const float vv = vs[i * 64 + j];
            float p = 0.f;
#pragma unroll
            for (int dd = 0; dd < 16; ++dd) {
                const int d = g * 16 + dd;
                st[dd] = as[i * 128 + d] * st[dd] + ks[i * 128 + d] * vv;
                p += qs[i * 128 + d] * st[dd];
            }
            po[(i * 8 + g) * 64 + j] = p;
        }
        __syncthreads();
        for (int e = tid; e < 32 * 64; e += NTHREADS) {
            const int i = e >> 6, jj = e & 63;
            float sum = 0.f;
#pragma unroll
            for (int gg = 0; gg < 8; ++gg) sum += po[(i * 8 + gg) * 64 + jj];
            const int s = dir ? (S - 1 - (ch * 32 + i)) : (ch * 32 + i);
            const size_t t = (size_t)b * S + s;
            O[t * 1024 + hh * 256 + slice * 64 + jj] = sum;
        }
        __syncthreads();
    }
}

__device__ __forceinline__ void attn_item(const u16* __restrict__ P, int ldp, int cq, int ck, int cv, int Sq,
                                          u16* __restrict__ part_o, float* __restrict__ part_lse, int Ttot,
                                          unsigned char* lds, int item) {
    const int tid = TID, lane = tid & 63, wave = tid >> 6, li = lane & 15, fq = lane >> 4;
    const int nb_per = Sq / 128;
    const int within = item % nb_per, hh = (item / nb_per) & 7, b = (item / (nb_per * 8)) & 3, pat = item / (nb_per * 32);
    const int dil = pat == 0 ? 1 : (pat == 1 ? 4 : 16);
    const int M = Sq / dil;
    const int r = within % dil, blk = within / dil;
    const int p0 = blk * 128, kbase = p0 - 64;
    unsigned char* Ks = lds;
    unsigned char* Vs = lds + 65536;
    const size_t tok0 = (size_t)b * Sq;
    __syncthreads();
#pragma unroll
    for (int i = 0; i < 8; ++i) {
        const int id = tid + 512 * i, row = id >> 4, c = id & 15;
        int kp = kbase + row; kp = kp < 0 ? 0 : (kp > M - 1 ? M - 1 : kp);
        const size_t t = tok0 + r + (size_t)dil * kp;
        const uint4 kv = *(const uint4*)(P + t * ldp + ck + hh * 128 + c * 8);
        const uint4 vv = *(const uint4*)(P + t * ldp + cv + hh * 128 + c * 8);
        const int off = row * 256 + ((c ^ (row & 15)) << 4);
        *(uint4*)(Ks + off) = kv;
        *(uint4*)(Vs + off) = vv;
    }
    const int qp = p0 + 16 * wave + li;
    const size_t tq = tok0 + r + (size_t)dil * qp;
    bf16x8 qf[4];
#pragma unroll
    for (int ks = 0; ks < 4; ++ks) qf[ks] = *(const bf16x8*)(P + tq * ldp + cq + hh * 128 + 32 * ks + 8 * fq);
    __syncthreads();
    const float scale = 0.08838834764831845f;
    float m = -1e30f, l = 0.f;
    f32x4 o[8];
#pragma unroll
    for (int dt = 0; dt < 8; ++dt) o[dt] = (f32x4){0.f, 0.f, 0.f, 0.f};
#pragma unroll 1
    for (int tp = 0; tp < 5; ++tp) {
        float s[8]; bool ok[8];
#pragma unroll
        for (int h2 = 0; h2 < 2; ++h2) {
            const int kk0 = 16 * wave + 16 * (2 * tp + h2);
            int krow = kk0 + li; krow = krow > 255 ? 255 : krow;
            f32x4 acc = (f32x4){0.f, 0.f, 0.f, 0.f};
#pragma unroll
            for (int ks = 0; ks < 4; ++ks) {
                const bf16x8 kf = *(const bf16x8*)(Ks + krow * 256 + (((4 * ks + fq) ^ (krow & 15)) << 4));
                acc = __builtin_amdgcn_mfma_f32_16x16x32_bf16(kf, qf[ks], acc, 0, 0, 0);
            }
#pragma unroll
            for (int j = 0; j < 4; ++j) {
                const int kp = kbase + kk0 + 4 * fq + j;
                const int rel = kp - qp;
                ok[4 * h2 + j] = (kp >= 0) && (kp < M) && (rel <= 64) && (rel >= -64);
                s[4 * h2 + j] = acc[j] * scale;
            }
        }
        float mx = -1e30f;
#pragma unroll
        for (int j = 0; j < 8; ++j) mx = ok[j] ? fmaxf(mx, s[j]) : mx;
        mx = fmaxf(mx, __shfl_xor(mx, 16));
        mx = fmaxf(mx, __shfl_xor(mx, 32));
        const float mn = fmaxf(m, mx);
        const float al = __expf(m - mn);
        float ps = 0.f; float p[8];
#pragma unroll
        for (int j = 0; j < 8; ++j) { p[j] = ok[j] ? __expf(s[j] - mn) : 0.f; ps += p[j]; }
        l = l * al + ps; m = mn;
        bf16x8 pf;
#pragma unroll
        for (int j = 0; j < 8; ++j) pf[j] = (short)f2bf(p[j]);
#pragma unroll
        for (int dt = 0; dt < 8; ++dt) o[dt] *= al;
        int rowA = 16 * wave + 32 * tp + 4 * fq + (li >> 2); rowA = rowA > 255 ? 255 : rowA;
        int rowB = 16 * wave + 32 * tp + 16 + 4 * fq + (li >> 2); rowB = rowB > 255 ? 255 : rowB;
#pragma unroll
        for (int dt = 0; dt < 8; ++dt) {
            const int chunk = 2 * dt + ((li & 3) >> 1), sub = ((li & 3) & 1) * 8;
            const s16x4 va = __builtin_amdgcn_ds_read_tr16_b64_v4i16((LAS s16x4*)(Vs + rowA * 256 + ((chunk ^ (rowA & 15)) << 4) + sub));
            const s16x4 vb = __builtin_amdgcn_ds_read_tr16_b64_v4i16((LAS s16x4*)(Vs + rowB * 256 + ((chunk ^ (rowB & 15)) << 4) + sub));
            bf16x8 vf;
            vf[0] = va[0]; vf[1] = va[1]; vf[2] = va[2]; vf[3] = va[3]; vf[4] = vb[0]; vf[5] = vb[1]; vf[6] = vb[2]; vf[7] = vb[3];
            o[dt] = __builtin_amdgcn_mfma_f32_16x16x32_bf16(vf, pf, o[dt], 0, 0, 0);
        }
    }
    l += __shfl_xor(l, 16);
    l += __shfl_xor(l, 32);
    const float inv = 1.f / l;
    u16* orow = part_o + ((size_t)pat * Ttot + tq) * 1024 + hh * 128 + 4 * fq;
#pragma unroll
    for (int dt = 0; dt < 8; ++dt)
        *(uint2*)(orow + 16 * dt) = make_uint2(pack2(o[dt][0] * inv, o[dt][1] * inv), pack2(o[dt][2] * inv, o[dt][3] * inv));
    if (fq == 0) part_lse[((size_t)pat * Ttot + tq) * 8 + hh] = m + logf(l);
}

__device__ __forceinline__ void attn_merge_token(const u16* __restrict__ part_o, const float* __restrict__ part_lse, int Ttot, size_t t,
                                                 u16* __restrict__ dst  , int lane) {
    const int hh = lane >> 3;
    const float l0 = part_lse[((size_t)0 * Ttot + t) * 8 + hh], l1 = part_lse[((size_t)1 * Ttot + t) * 8 + hh], l2 = part_lse[((size_t)2 * Ttot + t) * 8 + hh];
    const float mx = fmaxf(l0, fmaxf(l1, l2));
    const float e0 = __expf(l0 - mx), e1 = __expf(l1 - mx), e2 = __expf(l2 - mx);
    const float inv = 1.f / (e0 + e1 + e2);
    const float w[3] = {e0 * inv, e1 * inv, e2 * inv};
    float acc[16];
#pragma unroll
    for (int i = 0; i < 16; ++i) acc[i] = 0.f;
#pragma unroll
    for (int p = 0; p < 3; ++p) {
        const uint4* src = (const uint4*)(part_o + ((size_t)p * Ttot + t) * 1024 + lane * 16);
        const uint4 a = src[0], bb = src[1];
        acc[0] += w[p] * lo2f(a.x); acc[1] += w[p] * hi2f(a.x); acc[2] += w[p] * lo2f(a.y); acc[3] += w[p] * hi2f(a.y);
        acc[4] += w[p] * lo2f(a.z); acc[5] += w[p] * hi2f(a.z); acc[6] += w[p] * lo2f(a.w); acc[7] += w[p] * hi2f(a.w);
        acc[8] += w[p] * lo2f(bb.x); acc[9] += w[p] * hi2f(bb.x); acc[10] += w[p] * lo2f(bb.y); acc[11] += w[p] * hi2f(bb.y);
        acc[12] += w[p] * lo2f(bb.z); acc[13] += w[p] * hi2f(bb.z); acc[14] += w[p] * lo2f(bb.w); acc[15] += w[p] * hi2f(bb.w);
    }
    uint4* d = (uint4*)(dst + lane * 16);
    d[0] = make_uint4(pack2(acc[0], acc[1]), pack2(acc[2], acc[3]), pack2(acc[4], acc[5]), pack2(acc[6], acc[7]));
    d[1] = make_uint4(pack2(acc[8], acc[9]), pack2(acc[10], acc[11]), pack2(acc[12], acc[13]), pack2(acc[14], acc[15]));
}

__device__ __forceinline__ void phase_mixers(const Args& a, unsigned char* lds) {
    const int bi = blockIdx.x, G = gridDim.x;
    if (bi < 128) {
        gla_naive_item(a, lds, bi);
    } else {
        u16* part_o = (u16*)a.out; float* part_lse = (float*)((unsigned char*)a.out + (size_t)3 * T * 1024 * 2);
        for (int item = bi - 128; item < 3 * 4 * 8 * (S / 128); item += G - 128)
            attn_item((const u16*)(a.ws + WS_P), NP, C_DQ, C_DK, C_DV, S, part_o, part_lse, T, lds, item);
    }
}

__device__ __forceinline__ void phase_gla_fin(const Args& a) {
    const float* Of = (const float*)(a.ws + WS_OFB);
    const float* Ob = Of + (size_t)T * 1024;
    const u16* P = (const u16*)(a.ws + WS_P);
    u16* A2 = (u16*)(a.ws + WS_ACT);
    const int lane = threadIdx.x & 63, wave = threadIdx.x >> 6;
    const int gw = blockIdx.x * NWAVES + wave, NGW = gridDim.x * NWAVES;
    for (int item = gw; item < T * 4; item += NGW) {
        const int hh = item & 3, t = item >> 2;
        const size_t base = (size_t)t * 1024 + hh * 256 + lane * 4;
        const float4 f = *(const float4*)(Of + base), bb = *(const float4*)(Ob + base);
        const float o0 = f.x + bb.x, o1 = f.y + bb.y, o2 = f.z + bb.z, o3 = f.w + bb.w;
        const float ss = wave_sum(o0 * o0 + o1 * o1 + o2 * o2 + o3 * o3);
        const float rstd = rsqrtf(ss * (1.f / 256.f) + NORM_EPS);
        const float4 gg = *(const float4*)(a.g_gla + hh * 256 + lane * 4);
        const uint2 rp = *(const uint2*)(P + (size_t)t * NP + C_GR + hh * 256 + lane * 4);
        const float r0 = lo2f(rp.x), r1 = hi2f(rp.x), r2 = lo2f(rp.y), r3 = hi2f(rp.y);
        const float y0 = o0 * rstd * gg.x * silu_f(r0), y1 = o1 * rstd * gg.y * silu_f(r1);
        const float y2 = o2 * rstd * gg.z * silu_f(r2), y3 = o3 * rstd * gg.w * silu_f(r3);
        *(uint2*)(A2 + (size_t)t * D + hh * 256 + lane * 4) = make_uint2(pack2(y0, y1), pack2(y2, y3));
    }
    const u16* part_o = (const u16*)a.out; const float* part_lse = (const float*)((const unsigned char*)a.out + (size_t)3 * T * 1024 * 2);
    for (int t = gw; t < T; t += NGW) attn_merge_token(part_o, part_lse, T, (size_t)t, A2 + (size_t)t * D + 1024, lane);
}

__device__ __forceinline__ void phase_route(const Args& a) {
    const u16* Q = (const u16*)(a.ws + WS_Q);
    int* IDX = (int*)(a.ws + WS_IDX);
    float* GATE = (float*)(a.ws + WS_GATE);
    const int lane = threadIdx.x & 63, wave = threadIdx.x >> 6;
    const int gw = blockIdx.x * NWAVES + wave, NGW = gridDim.x * NWAVES;
    for (int item = gw; item < T * 8; item += NGW) {
        const int hh = item & 7, t = item >> 3;
        float ts[2]; int ti[2];
        ts[0] = ts[1] = 0.f; ti[0] = ti[1] = 0;
#pragma unroll
        for (int half = 0; half < 2; ++half) {
            const u16* qp = Q + (size_t)t * D + hh * 256 + half * 128;
            const float* k0p = a.subk + ((size_t)(hh * 2 + half) * 128 + lane) * 128;
            const float* k1p = k0p + 64 * 128;
            float v0 = 0.f, v1 = 0.f;
            for (int d = 0; d < 128; d += 4) {
                const uint2 qq = *(const uint2*)(qp + d);
                const float4 ka = *(const float4*)(k0p + d), kb = *(const float4*)(k1p + d);
                const float x0 = lo2f(qq.x), x1 = hi2f(qq.x), x2 = lo2f(qq.y), x3 = hi2f(qq.y);
                v0 += x0 * ka.x + x1 * ka.y + x2 * ka.z + x3 * ka.w;
                v1 += x0 * kb.x + x1 * kb.y + x2 * kb.z + x3 * kb.w;
            }
            float mys = 0.f; int myi = 0;
            for (int it = 0; it < 16; ++it) {
                const float lm = fmaxf(v0, v1);
                const float wm = wave_max(lm);
                const unsigned long long bal = __ballot(lm == wm);
                const int src = __ffsll((long long)bal) - 1;
                const int which = (v0 >= v1) ? 0 : 1;
                const int kidx = __shfl(lane + 64 * which, src);
                if (lane == src) { if (which == 0) v0 = -3.0e38f; else v1 = -3.0e38f; }
                if (lane == it) { mys = wm; myi = kidx; }
            }
            ts[half] = mys; ti[half] = myi;
        }
        float cv[4];
#pragma unroll
        for (int r = 0; r < 4; ++r) {
            const int c = lane + 64 * r;
            cv[r] = __shfl(ts[0], c >> 4) + __shfl(ts[1], c & 15);
        }
        float bs = 0.f; int bc = 0;
        for (int it = 0; it < 16; ++it) {
            const float lm = fmaxf(fmaxf(cv[0], cv[1]), fmaxf(cv[2], cv[3]));
            const float wm = wave_max(lm);
            const unsigned long long bal = __ballot(lm == wm);
            const int src = __ffsll((long long)bal) - 1;
            int which = 3;
            if (cv[2] == lm) which = 2;
            if (cv[1] == lm) which = 1;
            if (cv[0] == lm) which = 0;
            const int cidx = __shfl(lane + 64 * which, src);
            if (lane == src) {
                if (which == 0) cv[0] = -3.0e38f; else if (which == 1) cv[1] = -3.0e38f; else if (which == 2) cv[2] = -3.0e38f; else cv[3] = -3.0e38f;
            }
            if (lane == it) { bs = wm; bc = cidx; }
        }
        const float top = __shfl(bs, 0);
        const float e = (lane < 16) ? __expf(bs - top) : 0.f;
        const float den = wave_sum(e);
        const int i0 = __shfl(ti[0], bc >> 4), i1 = __shfl(ti[1], bc & 15);
        if (lane < 16) {
            IDX[(size_t)t * 128 + hh * 16 + lane] = i0 * 128 + i1;
            GATE[(size_t)t * 128 + hh * 16 + lane] = e / den;
        }
    }
}

typedef __bf16 bf16x2_t __attribute__((ext_vector_type(2)));
__device__ __forceinline__ float dot2bf(unsigned w, unsigned x, float acc) {
    return __builtin_amdgcn_fdot2_f32_bf16(__builtin_bit_cast(bf16x2_t, w), __builtin_bit_cast(bf16x2_t, x), acc, false);
}
__device__ __forceinline__ void convert_tables(const Args& a) {
    uint4* U = (uint4*)(a.ws + WS_TU); uint4* V = (uint4*)(a.ws + WS_TV);
    const size_t n8 = (size_t)16384 * D / 8;
    const size_t gt = (size_t)blockIdx.x * NTHREADS + threadIdx.x, NT = (size_t)gridDim.x * NTHREADS;
    for (size_t i = gt; i < 2 * n8; i += NT) {
        const bool isv = i >= n8; const size_t j = isv ? i - n8 : i;
        const f32x4* sp = (const f32x4*)(isv ? a.pv : a.pu) + 2 * j;
        const f32x4 v0 = __builtin_nontemporal_load(sp), v1 = __builtin_nontemporal_load(sp + 1);
        const uint4 o = make_uint4(pack2(v0.x, v0.y), pack2(v0.z, v0.w), pack2(v1.x, v1.y), pack2(v1.z, v1.w));
        (isv ? V : U)[j] = o;
    }
}

__device__ __forceinline__ void phase_experts(const Args& a) {
    const u16* H2 = (const u16*)(a.ws + WS_ACT);
    const float* X1 = (const float*)(a.ws + WS_X1);
    const int* IDX = (const int*)(a.ws + WS_IDX);
    const float* GATE = (const float*)(a.ws + WS_GATE);
    const float* mod = (const float*)(a.ws + WS_MOD);
    const uint4* U = (const uint4*)(a.ws + WS_TU); const uint4* V = (const uint4*)(a.ws + WS_TV);
    const int lane = threadIdx.x & 63, wave = threadIdx.x >> 6;
    const int gw = blockIdx.x * NWAVES + wave, NGW = gridDim.x * NWAVES;
    for (int t = gw; t < T; t += NGW) {
        const int b = t / S;
        uint4 h[4]; float acc[4][8];
        {
            const uint4* hp = (const uint4*)(H2 + (size_t)t * D);
#pragma unroll
            for (int m = 0; m < 4; ++m) { h[m] = hp[lane + 64 * m];
#pragma unroll
                for (int i = 0; i < 8; ++i) acc[m][i] = 0.f; }
        }
#pragma unroll 1
        for (int r0 = 0; r0 < 128; r0 += 4) {
            const int4 e4 = *(const int4*)(IDX + (size_t)t * 128 + r0);
            const float4 g4 = *(const float4*)(GATE + (size_t)t * 128 + r0);
            int e[4] = {__builtin_amdgcn_readfirstlane(e4.x), __builtin_amdgcn_readfirstlane(e4.y), __builtin_amdgcn_readfirstlane(e4.z), __builtin_amdgcn_readfirstlane(e4.w)};
            const float g[4] = {g4.x, g4.y, g4.z, g4.w};
            uint4 u[4][4], v[4][4];
#pragma unroll
            for (int q = 0; q < 4; ++q)
#pragma unroll
                for (int m = 0; m < 4; ++m) u[q][m] = U[(size_t)e[q] * 256 + lane + 64 * m];
#pragma unroll
            for (int q = 0; q < 4; ++q)
#pragma unroll
                for (int m = 0; m < 4; ++m) v[q][m] = V[(size_t)e[q] * 256 + lane + 64 * m];
            float d[4];
#pragma unroll
            for (int q = 0; q < 4; ++q) { float s0 = 0.f, s1 = 0.f;
#pragma unroll
                for (int m = 0; m < 4; ++m) { s0 = dot2bf(u[q][m].x, h[m].x, s0); s1 = dot2bf(u[q][m].y, h[m].y, s1); s0 = dot2bf(u[q][m].z, h[m].z, s0); s1 = dot2bf(u[q][m].w, h[m].w, s1); }
                d[q] = s0 + s1; }
#pragma unroll
            for (int o = 32; o > 0; o >>= 1) {
#pragma unroll
                for (int q = 0; q < 4; ++q) d[q] += __shfl_xor(d[q], o);
            }
#pragma unroll
            for (int q = 0; q < 4; ++q) { const float w = g[q] * gelu_f(d[q]);
#pragma unroll
                for (int m = 0; m < 4; ++m) {
                    acc[m][0] += w * lo2f(v[q][m].x); acc[m][1] += w * hi2f(v[q][m].x); acc[m][2] += w * lo2f(v[q][m].y); acc[m][3] += w * hi2f(v[q][m].y);
                    acc[m][4] += w * lo2f(v[q][m].z); acc[m][5] += w * hi2f(v[q][m].z); acc[m][6] += w * lo2f(v[q][m].w); acc[m][7] += w * hi2f(v[q][m].w); } }
        }
        float ss = 0.f;
#pragma unroll
        for (int m = 0; m < 4; ++m) {
            const int c0 = lane * 8 + 512 * m;
            const float4 xa = *(const float4*)(X1 + (size_t)t * D + c0), xb = *(const float4*)(X1 + (size_t)t * D + c0 + 4);
            const float4 ga = *(const float4*)(mod + b * 12288 + 5 * 2048 + c0), gb = *(const float4*)(mod + b * 12288 + 5 * 2048 + c0 + 4);
            acc[m][0] = xa.x + ga.x * acc[m][0]; acc[m][1] = xa.y + ga.y * acc[m][1]; acc[m][2] = xa.z + ga.z * acc[m][2]; acc[m][3] = xa.w + ga.w * acc[m][3];
            acc[m][4] = xb.x + gb.x * acc[m][4]; acc[m][5] = xb.y + gb.y * acc[m][5]; acc[m][6] = xb.z + gb.z * acc[m][6]; acc[m][7] = xb.w + gb.w * acc[m][7];
#pragma unroll
            for (int i = 0; i < 8; ++i) ss += acc[m][i] * acc[m][i];
        }
        ss = wave_sum(ss);
        const float rstd = rsqrtf(ss * (1.f / D) + NORM_EPS);
#pragma unroll
        for (int m = 0; m < 4; ++m) {
            const int c0 = lane * 8 + 512 * m;
            const float4 ga = *(const float4*)(a.g_fin + c0), gb = *(const float4*)(a.g_fin + c0 + 4);
            *(float4*)(a.out + (size_t)t * D + c0) = make_float4(acc[m][0] * rstd * ga.x, acc[m][1] * rstd * ga.y, acc[m][2] * rstd * ga.z, acc[m][3] * rstd * ga.w);
            *(float4*)(a.out + (size_t)t * D + c0 + 4) = make_float4(acc[m][4] * rstd * gb.x, acc[m][5] * rstd * gb.y, acc[m][6] * rstd * gb.z, acc[m][7] * rstd * gb.w);
        }
    }
}

constexpr int NPHASES = 11;
__global__ void __launch_bounds__(NTHREADS, 2) mk_fwd(Args a) {
    extern __shared__ __attribute__((aligned(16))) unsigned char lds[];
    cg::grid_group grid = cg::this_grid();
    const int lo = a.ph_lo, hi = a.ph_hi;
#define IN(k) (lo <= (k) && (k) < hi)
#define SEAM(k) do { if (IN(k) && IN((k) + 1)) grid.sync(); } while (0)
    const float* mod = (const float*)(a.ws + WS_MOD);
    if (IN(0)) phase0(a, lds);
    SEAM(0);
    if (IN(1)) norm_mod_phase(a.x, a.g_mix, mod, 0, 1, (u16*)(a.ws + WS_ACT));
    SEAM(1);
    if (IN(2)) gemm8(lds, (const u16*)(a.ws + WS_ACT), (const u16*)(a.ws + WS_WIN), T, NPAD, D, EpiProj{(u16*)(a.ws + WS_P), (float*)(a.ws + WS_GZ)});
    SEAM(2);
    if (IN(3)) phase_rope_gates(a);
    SEAM(3);
    if (IN(4)) phase_mixers(a, lds);
    SEAM(4);
    if (IN(5)) phase_gla_fin(a);
    SEAM(5);
    if (IN(6)) gemm8(lds, (const u16*)(a.ws + WS_ACT), (const u16*)(a.ws + WS_WOUT), T, D, D, EpiResid{a.x, mod, (float*)(a.ws + WS_X1)});
    SEAM(6);
    if (IN(7)) { norm_mod_phase((const float*)(a.ws + WS_X1), a.g_ffn, mod, 3, 4, (u16*)(a.ws + WS_ACT)); convert_tables(a); }
    SEAM(7);
    if (IN(8)) gemm8(lds, (const u16*)(a.ws + WS_ACT), (const u16*)(a.ws + WS_WPQ), T, D, D, EpiBf16{(u16*)(a.ws + WS_Q)});
    SEAM(8);
    if (IN(9)) phase_route(a);
    SEAM(9);
    if (IN(10)) phase_experts(a);
#undef IN
#undef SEAM
}

#ifndef MK_ONE_LAUNCH
#define MK_ONE_LAUNCH 1
#endif
extern "C" void kernel_launch(void* const* d_in, const int* in_sizes, int n_in, void* d_out, int out_size, void* d_ws, size_t ws_size, hipStream_t stream) {
    static int grid = 0;
    if (grid == 0) {
        if (n_in != 19 || out_size != T * D || ws_size < WS_END) {
            fprintf(stderr, "kernel_launch: unexpected shapes: n_in %d out %d ws %zu (need %zu)\n", n_in, out_size, ws_size, (size_t)WS_END);
            grid = -1; return;
        }
        int dev = 0, cus = 0, per_cu = 0;
        (void)hipGetDevice(&dev);
        (void)hipDeviceGetAttribute(&cus, hipDeviceAttributeMultiprocessorCount, dev);
        (void)hipFuncSetAttribute((const void*)mk_fwd, hipFuncAttributeMaxDynamicSharedMemorySize, LDS_BYTES);
        (void)hipOccupancyMaxActiveBlocksPerMultiprocessor(&per_cu, (const void*)mk_fwd, NTHREADS, LDS_BYTES);
        if (per_cu < 1) { fprintf(stderr, "kernel_launch: occupancy query says %d blocks/CU\n", per_cu); grid = -1; return; }
        grid = cus;
        (void)hipGetLastError();
    }
    if (grid < 0) return;
    Args a{};
    a.x = (const float*)d_in[0]; a.c = (const float*)d_in[1]; a.pos = (const int*)d_in[2]; a.w_ada = (const float*)d_in[3];
    a.b_ada = (const float*)d_in[4]; a.g_mix = (const float*)d_in[5]; a.w_in = (const float*)d_in[6]; a.wgf = (const float*)d_in[7];
    a.bgf = (const float*)d_in[8]; a.wgb = (const float*)d_in[9]; a.bgb = (const float*)d_in[10]; a.g_gla = (const float*)d_in[11];
    a.w_out = (const float*)d_in[12]; a.g_ffn = (const float*)d_in[13]; a.w_pq = (const float*)d_in[14]; a.subk = (const float*)d_in[15];
    a.pu = (const float*)d_in[16]; a.pv = (const float*)d_in[17]; a.g_fin = (const float*)d_in[18];
    a.out = (float*)d_out; a.ws = (unsigned char*)d_ws;
#if MK_ONE_LAUNCH
    a.ph_lo = 0; a.ph_hi = NPHASES;
    void* args[] = {&a};
    hipError_t e = hipLaunchCooperativeKernel((const void*)mk_fwd, dim3(grid), dim3(NTHREADS), args, LDS_BYTES, stream);
    if (e != hipSuccess) fprintf(stderr, "cooperative launch failed: %s (grid %d)\n", hipGetErrorString(e), grid);
#else
    for (int p = 0; p < NPHASES; ++p) {
        a.ph_lo = p; a.ph_hi = p + 1;
        hipLaunchKernelGGL(mk_fwd, dim3(grid), dim3(NTHREADS), LDS_BYTES, stream, a);
    }
#endif
}
```

```cpp
#include <hip/hip_runtime.h>
#include <hip/hip_cooperative_groups.h>
#include <cstdio>
#include <cstdint>

namespace cg = cooperative_groups;

typedef unsigned short u16;
typedef __attribute__((ext_vector_type(8))) short bf16x8;
typedef __attribute__((ext_vector_type(4))) float f32x4;
typedef short s16x4 __attribute__((ext_vector_type(4)));
#define TID ((int)threadIdx.x)
#define BID ((int)blockIdx.x)
#define GDIM ((int)gridDim.x)
#define LAS __attribute__((address_space(3)))

constexpr int D = 2048, NB = 4, S = 4096, T = NB * S;
constexpr int INW = 6176;
constexpr int NP = 6144;
constexpr int NPAD = 6400;
constexpr int C_GQ = 0, C_GK = 512, C_GV = 1024, C_GR = 2048, C_DQ = 3072, C_DK = 4096, C_DV = 5120;
constexpr int NTHREADS = 512, NWAVES = 8;
constexpr int LDS_BYTES = 128 * 1024;
constexpr float NORM_EPS = 1e-6f;

constexpr size_t WS_CTL = 0;
constexpr size_t WS_MOD = 65536;
constexpr size_t WS_CS = 524288;
constexpr size_t WS_WIN = WS_CS + (size_t)T * 64 * 8;
constexpr size_t WS_WOUT = WS_WIN + (size_t)NPAD * D * 2;
constexpr size_t WS_WPQ = WS_WOUT + (size_t)D * D * 2;
constexpr size_t WS_ACT = WS_WPQ + (size_t)D * D * 2;
constexpr size_t WS_P = WS_ACT + (size_t)T * D * 2;
constexpr size_t WS_X1 = WS_P;
constexpr size_t WS_Q = WS_P + (size_t)T * D * 4;
constexpr size_t WS_GZ = WS_P + (size_t)T * NP * 2;
constexpr int GLA_NPREP = NB * 4 * 2 * (S / 64);
constexpr size_t WS_QD = WS_GZ + (size_t)T * 32 * 4;
constexpr size_t WS_KE = WS_QD + (size_t)GLA_NPREP * 16384;
constexpr size_t WS_AT = WS_KE + (size_t)GLA_NPREP * 16384;
constexpr size_t WS_DEC = WS_AT + (size_t)GLA_NPREP * 8192;
constexpr size_t WS_OFB = WS_DEC + (size_t)GLA_NPREP * 512;
constexpr size_t WS_IDX = WS_OFB + (size_t)2 * T * 1024 * 2;
constexpr size_t WS_GATE = WS_IDX + (size_t)T * 128 * 4;
constexpr size_t WS_END = WS_GATE + (size_t)T * 128 * 4;
constexpr size_t WS_TU = WS_QD;
constexpr size_t WS_TV = WS_QD + (size_t)16384 * D * 2;
static_assert(WS_TV + (size_t)16384 * D * 2 <= WS_IDX, "table region");

struct Args {
    const float* x; const float* c; const int* pos; const float* w_ada; const float* b_ada; const float* g_mix;
    const float* w_in; const float* wgf; const float* bgf; const float* wgb; const float* bgb; const float* g_gla;
    const float* w_out; const float* g_ffn; const float* w_pq; const float* subk; const float* pu; const float* pv; const float* g_fin;
    float* out; unsigned char* ws; int ph_lo, ph_hi;
};

__device__ __forceinline__ float bf2f(u16 h) { return __uint_as_float(((unsigned)h) << 16); }
__device__ __forceinline__ u16 f2bf(float f) { unsigned u = __float_as_uint(f); u += 0x7fffu + ((u >> 16) & 1u); return (u16)(u >> 16); }
__device__ __forceinline__ unsigned pack2(float a, float b) { return (unsigned)f2bf(a) | ((unsigned)f2bf(b) << 16); }
__device__ __forceinline__ float lo2f(unsigned p) { return __uint_as_float(p << 16); }
__device__ __forceinline__ float hi2f(unsigned p) { return __uint_as_float(p & 0xffff0000u); }
__device__ __forceinline__ float wave_sum(float v) {
#pragma unroll
    for (int o = 32; o > 0; o >>= 1) v += __shfl_xor(v, o);
    return v;
}
__device__ __forceinline__ float wave_max(float v) {
#pragma unroll
    for (int o = 32; o > 0; o >>= 1) v = fmaxf(v, __shfl_xor(v, o));
    return v;
}
__device__ __forceinline__ float silu_f(float v) { return v / (1.f + __expf(-v)); }
__device__ __forceinline__ float gelu_f(float a) { return 0.5f * a * (1.f + erff(a * 0.70710678118654752f)); }
__device__ __forceinline__ float logsigmoid_f(float z) { return z < 0.f ? z - log1pf(expf(z)) : -log1pf(expf(-z)); }

__device__ __forceinline__ void p0_mod(const Args& a, unsigned char* lds, int bi) {
    float* sc = (float*)lds;
    float* red = sc + 4 * 2048;
    const int tid = threadIdx.x, lane = tid & 63, wave = tid >> 6;
    for (int i = tid; i < 4 * 2048; i += NTHREADS) sc[i] = silu_f(a.c[i]);
    __syncthreads();
    const int j0 = bi * 256 + lane * 4;
    float acc[4][4];
#pragma unroll
    for (int b = 0; b < 4; ++b)
#pragma unroll
        for (int q = 0; q < 4; ++q) acc[b][q] = 0.f;
    const int k0 = wave * 256;
#pragma unroll 4
    for (int kk = 0; kk < 256; ++kk) {
        const int k = k0 + kk;
        const float4 w = *(const float4*)(a.w_ada + (size_t)k * 12288 + j0);
#pragma unroll
        for (int b = 0; b < 4; ++b) {
            const float s = sc[b * 2048 + k];
            acc[b][0] += s * w.x; acc[b][1] += s * w.y; acc[b][2] += s * w.z; acc[b][3] += s * w.w;
        }
    }
#pragma unroll
    for (int b = 0; b < 4; ++b)
#pragma unroll
        for (int q = 0; q < 4; ++q) red[(wave * 4 + b) * 256 + lane * 4 + q] = acc[b][q];
    __syncthreads();
    float* mod = (float*)(a.ws + WS_MOD);
    for (int i = tid; i < 4 * 256; i += NTHREADS) {
        const int b = i >> 8, jc = i & 255;
        float s = 0.f;
#pragma unroll
        for (int w = 0; w < 8; ++w) s += red[(w * 4 + b) * 256 + jc];
        mod[b * 12288 + bi * 256 + jc] = s + a.b_ada[bi * 256 + jc];
    }
    __syncthreads();
}

__device__ __forceinline__ void p0_transpose_item(const float* __restrict__ W, int ldw, int k0, int src_col0, int n_valid,
                                                  u16* __restrict__ WT, int ldt, int n_out0, unsigned char* lds) {
    u16* tl = (u16*)lds;
    const int tid = threadIdx.x;
    {
        const int k = tid >> 3, nc = (tid & 7) * 8;
        float v[8];
        if (nc < n_valid) {
            const float4 v0 = *(const float4*)(W + (size_t)(k0 + k) * ldw + src_col0 + nc);
            const float4 v1 = *(const float4*)(W + (size_t)(k0 + k) * ldw + src_col0 + nc + 4);
            v[0] = v0.x; v[1] = v0.y; v[2] = v0.z; v[3] = v0.w; v[4] = v1.x; v[5] = v1.y; v[6] = v1.z; v[7] = v1.w;
        } else {
#pragma unroll
            for (int i = 0; i < 8; ++i) v[i] = 0.f;
        }
#pragma unroll
        for (int i = 0; i < 8; ++i) tl[(nc + i) * 72 + k] = f2bf(v[i]);
    }
    __syncthreads();
    {
        const int n = tid >> 3, kc = (tid & 7) * 8;
        const uint4 v = *(const uint4*)(tl + n * 72 + kc);
        *(uint4*)(WT + (size_t)(n_out0 + n) * ldt + k0 + kc) = v;
    }
    __syncthreads();
}

__device__ __forceinline__ void phase0(const Args& a, unsigned char* lds) {
    const int bi = blockIdx.x, G = gridDim.x, tid = threadIdx.x;
    if (bi < 48) p0_mod(a, lds, bi);
    constexpr int I_IN = 32 * (NPAD / 64), I_SQ = 32 * 32;
    u16* WinT = (u16*)(a.ws + WS_WIN); u16* WoutT = (u16*)(a.ws + WS_WOUT); u16* WpqT = (u16*)(a.ws + WS_WPQ);
    for (int it = bi; it < I_IN + 2 * I_SQ; it += G) {
        if (it < I_IN) {
            const int kt = it & 31, nt = it >> 5;
            const int n0 = nt * 64;
            int src, nv;
            if (n0 < 3072) { src = n0; nv = 64; }
            else if (n0 < 6144) { src = n0 + 32; nv = 64; }
            else if (n0 == 6144) { src = 3072; nv = 32; }
            else { src = 0; nv = 0; }
            p0_transpose_item(a.w_in, INW, kt * 64, src, nv, WinT, D, n0, lds);
        } else if (it < I_IN + I_SQ) {
            const int r = it - I_IN; const int kt = r & 31, nt = r >> 5;
            p0_transpose_item(a.w_out, D, kt * 64, nt * 64, 64, WoutT, D, nt * 64, lds);
        } else {
            const int r = it - I_IN - I_SQ; const int kt = r & 31, nt = r >> 5;
            p0_transpose_item(a.w_pq, D, kt * 64, nt * 64, 64, WpqT, D, nt * 64, lds);
        }
    }
    float2* cs = (float2*)(a.ws + WS_CS);
    for (int i = bi * NTHREADS + tid; i < T * 64; i += G * NTHREADS) {
        const int t = i >> 6, f = i & 63;
        const float inv_freq = powf(10000.0f, -(float)f * 2.0f / 128.0f);
        const float ang = (float)a.pos[t] * inv_freq;
        const double rev = (double)ang * 0.15915494309189533577;
        const float fr = (float)(rev - floor(rev));
        cs[i] = make_float2(__builtin_amdgcn_cosf(fr), __builtin_amdgcn_sinf(fr));
    }
}

__device__ __forceinline__ void norm_mod_phase(const float* __restrict__ xin, const float* __restrict__ g, const float* __restrict__ mod,
                                               int sh_chunk, int sc_chunk, u16* __restrict__ outp) {
    const int lane = threadIdx.x & 63, wave = threadIdx.x >> 6;
    const int gw = blockIdx.x * NWAVES + wave, NGW = gridDim.x * NWAVES;
    for (int t = gw; t < T; t += NGW) {
        const int b = t / S;
        const float4* xr = (const float4*)(xin + (size_t)t * D);
        float4 v[8]; float ss = 0.f;
#pragma unroll
        for (int m = 0; m < 8; ++m) { v[m] = xr[lane + 64 * m]; ss += v[m].x * v[m].x + v[m].y * v[m].y + v[m].z * v[m].z + v[m].w * v[m].w; }
        ss = wave_sum(ss);
        const float rstd = rsqrtf(ss * (1.f / D) + NORM_EPS);
        const float4* gp = (const float4*)g;
        const float4* shp = (const float4*)(mod + b * 12288 + sh_chunk * 2048);
        const float4* scp = (const float4*)(mod + b * 12288 + sc_chunk * 2048);
        uint2* op = (uint2*)(outp + (size_t)t * D);
#pragma unroll
        for (int m = 0; m < 8; ++m) {
            const int i = lane + 64 * m;
            const float4 gg = gp[i], sh = shp[i], sc = scp[i];
            const float h0 = v[m].x * rstd * gg.x * (1.f + sc.x) + sh.x;
            const float h1 = v[m].y * rstd * gg.y * (1.f + sc.y) + sh.y;
            const float h2 = v[m].z * rstd * gg.z * (1.f + sc.z) + sh.z;
            const float h3 = v[m].w * rstd * gg.w * (1.f + sc.w) + sh.w;
            op[i] = make_uint2(pack2(h0, h1), pack2(h2, h3));
        }
    }
}

namespace pg8 {
#define PG8_LAS __attribute__((address_space(3)))
typedef unsigned short bf16_t;
typedef short bf16x8 __attribute__((ext_vector_type(8)));
typedef float f32x4 __attribute__((ext_vector_type(4)));
typedef unsigned u32x4 __attribute__((ext_vector_type(4)));
constexpr int BM = 256, BK = 64, HALF = 128, HTB = HALF * BK * 2  , STAGE_BYTES = 8 * HTB, NXCD = 8, WGM = 8;

__host__ __device__ __forceinline__ int lds_byte(int r, int c) { const int st = (r >> 4) * 2 + (c >> 5), rr = r & 15, cc = c & 31, ob = rr * 64 + cc * 2; return st * 1024 + (ob ^ (((ob >> 9) & 1) << 5)); }
__host__ __device__ __forceinline__ void stage_rc(int b, int& R, int& C) { const int st = b / 1024, sb = b % 1024, swz = sb ^ (((sb >> 9) & 1) << 5); R = (st >> 1) * 16 + swz / 64; C = (st & 1) * 32 + (swz % 64) / 2; }
__host__ __device__ __forceinline__ int perm32(int rho) { const int n = rho >> 4, i = rho & 15; return 8 * (i >> 2) + 4 * n + (i & 3); }

struct Unit { int pm, pn; };
struct Gemm { const bf16_t* A; const bf16_t* Bt; int M, N, K; };

struct StaticOrder {
    int nM, nN, nwg, G, c;
    __host__ __device__ void init(int M, int N, int G_, int c_) { nM = M / BM; nN = N / BM; nwg = nM * nN; G = G_; c = c_; }
    __host__ __device__ bool next(int i, Unit& u) const {
        const long L = (long)i * G + c; if (L >= nwg) return false;
        int wgid = (int)L; { const int q = nwg / NXCD, r = nwg % NXCD, xcd = wgid % NXCD, off = wgid / NXCD; wgid = (xcd < r ? xcd * (q + 1) : r * (q + 1) + (xcd - r) * q) + off; }
        const int nig = WGM * nN, gid = wgid / nig, fm = gid * WGM, gsz = (nM - fm) < WGM ? (nM - fm) : WGM;
        u.pm = fm + ((wgid % nig) % gsz); u.pn = (wgid % nig) / gsz; return true;
    }
    __device__ __forceinline__ void a_ready(const Unit&) const {}
    __device__ __forceinline__ void done(const Unit&) const {}
};
__device__ __forceinline__ unsigned cvt_pk_bf16(float lo, float hi) { unsigned r; asm volatile("v_cvt_pk_bf16_f32 %0, %1, %2" : "=v"(r) : "v"(lo), "v"(hi)); return r; }
typedef float f32x2 __attribute__((ext_vector_type(2)));
template <class Epi, class Sched, bool STAMP = false>
__device__ __forceinline__ void gemm_phase(PG8_LAS unsigned char* lds, const Gemm g, const Sched& S, const Epi& E, unsigned long long* stamps) {
    const int tid = threadIdx.x, wid = __builtin_amdgcn_readfirstlane(tid >> 6), lane = tid & 63, wr = wid >> 2, wc = wid & 3, fr = lane & 15, fq = lane >> 4;
    const int K = g.K, nt = K / BK;
    int ts_lo = 0, ts_hi = 0, nts = 0; const unsigned long long rt_entry = STAMP ? (unsigned long long)wall_clock64() : 0ull;
#define PG8_STAMP() do { if (STAMP && wid == 0 && nts < 64) { const unsigned long long _c = (unsigned long long)clock64(); \
        ts_lo = (lane == nts) ? (int)(unsigned)_c : ts_lo; ts_hi = (lane == nts) ? (int)(unsigned)(_c >> 32) : ts_hi; ++nts; } } while (0)
    PG8_STAMP();
    unsigned voffA[2], voffB[2];
#pragma unroll
    for (int i = 0; i < 2; ++i) { int R, C; stage_rc(tid * 16 + i * 8192, R, C); const int Rb = Epi::PERM ? ((R & ~31) + perm32(R & 31)) : R;
        voffA[i] = (unsigned)(R * K + C) * 2u; voffB[i] = (unsigned)(Rb * K + C) * 2u; }
    const size_t kstep = (size_t)(BK * 2);
    const size_t hstep = (size_t)HALF * K * 2;
    const size_t tstep = 2 * hstep;
    const unsigned ldsw = (unsigned)wid * 1024u;
    const int aoff = lds_byte(wr * 64 + fr, fq * 8), boff = lds_byte(wc * 32 + fr, fq * 8);
#define PG8_SA(b, h) (((b) * 2 + (h)) * HTB)
#define PG8_SB(b, h) ((4 + (b) * 2 + (h)) * HTB)
#define PG8_STAGE(bufoff, gbase, voff) do { _Pragma("unroll") for (int _i = 0; _i < 2; ++_i) \
        __builtin_amdgcn_global_load_lds((const unsigned*)((const char*)(gbase) + (voff)[_i]), (PG8_LAS unsigned*)(lds + (bufoff) + ldsw + _i * 8192), 16, 0, 0); } while (0)
#define PG8_LDA(dst, b, h) do { _Pragma("unroll") for (int m = 0; m < 4; ++m) _Pragma("unroll") for (int k = 0; k < 2; ++k) dst[m][k] = *(const PG8_LAS bf16x8*)(lds + PG8_SA(b, h) + aoff + m * 2048 + k * 1024); } while (0)
#define PG8_LDB(dst, b, h) do { _Pragma("unroll") for (int n = 0; n < 2; ++n) _Pragma("unroll") for (int k = 0; k < 2; ++k) dst[n][k] = *(const PG8_LAS bf16x8*)(lds + PG8_SB(b, h) + boff + n * 2048 + k * 1024); } while (0)
#define PG8_MMA(ai, bj, At, Bt) do { __builtin_amdgcn_s_setprio(1); _Pragma("unroll") for (int m = 0; m < 4; ++m) _Pragma("unroll") for (int n = 0; n < 2; ++n) _Pragma("unroll") for (int k = 0; k < 2; ++k) \
        acc[ai][bj][m][n] = __builtin_amdgcn_mfma_f32_16x16x32_bf16(Bt[n][k], At[m][k], acc[ai][bj][m][n], 0, 0, 0); __builtin_amdgcn_s_setprio(0); } while (0)
#define PG8_WAIT_V(n) asm volatile("s_waitcnt vmcnt(" #n ")" ::: "memory")
#define PG8_WAIT_L(n) asm volatile("s_waitcnt lgkmcnt(" #n ")" ::: "memory")
#define PG8_BAR __builtin_amdgcn_s_barrier()
#define PG8_SCHED __builtin_amdgcn_sched_barrier(0)
    Unit cur, nxt; int ui = 0;
    if (!S.next(0, cur)) return;
    f32x4 acc[2][2][4][2];
#pragma unroll
    for (int a = 0; a < 2; ++a)
#pragma unroll
        for (int b = 0; b < 2; ++b)
#pragma unroll
            for (int m = 0; m < 4; ++m)
#pragma unroll
                for (int n = 0; n < 2; ++n) acc[a][b][m][n] = (f32x4){0.f, 0.f, 0.f, 0.f};
    bf16x8 At[4][2], B0[2][2], B1[2][2];
    const char* cA = (const char*)g.A + (size_t)cur.pm * tstep; const char* cB = (const char*)g.Bt + (size_t)cur.pn * tstep;
    S.a_ready(cur);
    PG8_STAGE(PG8_SB(0, 0), cB, voffB); PG8_STAGE(PG8_SA(0, 0), cA, voffA); PG8_STAGE(PG8_SB(0, 1), cB + hstep, voffB); PG8_STAGE(PG8_SA(0, 1), cA + hstep, voffA);
    if (wr == 1) PG8_BAR;
    PG8_WAIT_V(4); PG8_BAR;
    PG8_STAGE(PG8_SB(1, 0), cB + kstep, voffB); PG8_STAGE(PG8_SA(1, 0), cA + kstep, voffA); PG8_STAGE(PG8_SB(1, 1), cB + hstep + kstep, voffB);
    PG8_WAIT_V(6); PG8_BAR;
    PG8_STAMP();
    for (;;) {
        const bool has_next = S.next(ui + 1, nxt);
        const char* nA = has_next ? (const char*)g.A + (size_t)nxt.pm * tstep : cA; const char* nB = has_next ? (const char*)g.Bt + (size_t)nxt.pn * tstep : cB;
        for (int t = 0; t < nt; t += 2) {
            const bool last = (t == nt - 2);
            const char* a1 = cA + (size_t)(t + 1) * kstep;
            const char* a2 = last ? nA : cA + (size_t)(t + 2) * kstep; const char* b2 = last ? nB : cB + (size_t)(t + 2) * kstep;
            const char* a3 = a2 + kstep; const char* b3 = b2 + kstep;
            if (last && has_next) S.a_ready(nxt);
            PG8_LDB(B0, 0, 0); PG8_SCHED; PG8_LDA(At, 0, 0); PG8_STAGE(PG8_SA(1, 1), a1 + hstep, voffA);
            PG8_WAIT_L(8); PG8_BAR; PG8_WAIT_L(0); PG8_MMA(0, 0, At, B0); PG8_BAR; PG8_SCHED;
            PG8_LDB(B1, 0, 1); PG8_STAGE(PG8_SB(0, 0), b2, voffB);
            PG8_BAR; PG8_WAIT_L(0); PG8_MMA(0, 1, At, B1); PG8_BAR;
            PG8_LDA(At, 0, 1); PG8_STAGE(PG8_SA(0, 0), a2, voffA);
            PG8_BAR; PG8_WAIT_L(0); PG8_MMA(1, 0, At, B0); PG8_BAR; PG8_SCHED;
            PG8_STAGE(PG8_SB(0, 1), b2 + hstep, voffB);
            PG8_WAIT_V(6); PG8_BAR; PG8_MMA(1, 1, At, B1); PG8_BAR;
            PG8_LDB(B0, 1, 0); PG8_SCHED; PG8_LDA(At, 1, 0); PG8_STAGE(PG8_SA(0, 1), a2 + hstep, voffA);
            PG8_WAIT_L(8); PG8_BAR; PG8_WAIT_L(0); PG8_MMA(0, 0, At, B0); PG8_BAR; PG8_SCHED;
            PG8_LDB(B1, 1, 1); PG8_STAGE(PG8_SB(1, 0), b3, voffB);
            PG8_BAR; PG8_WAIT_L(0); PG8_MMA(0, 1, At, B1); PG8_BAR;
            PG8_LDA(At, 1, 1); PG8_STAGE(PG8_SA(1, 0), a3, voffA);
            PG8_BAR; PG8_WAIT_L(0); PG8_MMA(1, 0, At, B0); PG8_BAR; PG8_SCHED;
            PG8_STAGE(PG8_SB(1, 1), b3 + hstep, voffB);
            PG8_WAIT_V(6); PG8_BAR; PG8_MMA(1, 1, At, B1); PG8_BAR;
        }
        PG8_STAMP();
        if constexpr (!Epi::AFTER_DRAIN) { E(acc, cur, wr, wc, fr, fq); S.done(cur); }
        PG8_STAMP();
        if (!has_next) break;
#pragma unroll
        for (int a = 0; a < 2; ++a)
#pragma unroll
            for (int b = 0; b < 2; ++b)
#pragma unroll
                for (int m = 0; m < 4; ++m)
#pragma unroll
                    for (int n = 0; n < 2; ++n) acc[a][b][m][n] = (f32x4){0.f, 0.f, 0.f, 0.f};
        cur = nxt; cA = nA; cB = nB; ++ui;
    }
    PG8_WAIT_V(0);
    if (wr == 0) PG8_BAR;
    PG8_BAR;
    if constexpr (Epi::AFTER_DRAIN) { E.fused(acc, cur, wr, wc, fr, fq, lds, wid, lane); S.done(cur); }
    PG8_STAMP();
    if (STAMP && wid == 0) { stamps[lane] = lane < nts ? (((unsigned long long)(unsigned)ts_hi << 32) | (unsigned)ts_lo) : 0ull;
        if (lane == 62) stamps[62] = rt_entry; if (lane == 63) stamps[63] = (unsigned long long)wall_clock64(); }
#undef PG8_STAMP
#undef PG8_SA
#undef PG8_SB
#undef PG8_STAGE
#undef PG8_LDA
#undef PG8_LDB
#undef PG8_MMA
#undef PG8_WAIT_V
#undef PG8_WAIT_L
#undef PG8_BAR
#undef PG8_SCHED
}
}

struct EpiProj {
    static constexpr bool PERM = true, AFTER_DRAIN = false;
    u16* P; float* gz;
    __device__ __forceinline__ void operator()(const pg8::f32x4 (&acc)[2][2][4][2], const pg8::Unit& u, int wr, int wc, int fr, int fq) const {
        const int row0 = u.pm * 256 + wr * 64 + fr;
        if (u.pn < 24) {
            const int col0 = u.pn * 256 + wc * 32 + 8 * fq;
#pragma unroll
            for (int ai = 0; ai < 2; ++ai)
#pragma unroll
                for (int m = 0; m < 4; ++m) { u16* rowp = P + (size_t)(row0 + ai * 128 + m * 16) * NP + col0;
#pragma unroll
                    for (int bj = 0; bj < 2; ++bj) { const pg8::f32x4 v0 = acc[ai][bj][m][0], v1 = acc[ai][bj][m][1];
                        pg8::u32x4 w; w.x = pg8::cvt_pk_bf16(v0[0], v0[1]); w.y = pg8::cvt_pk_bf16(v0[2], v0[3]); w.z = pg8::cvt_pk_bf16(v1[0], v1[1]); w.w = pg8::cvt_pk_bf16(v1[2], v1[3]);
                        *(pg8::u32x4*)(rowp + bj * 128) = w; } }
        } else if (wc == 0) {
#pragma unroll
            for (int ai = 0; ai < 2; ++ai)
#pragma unroll
                for (int m = 0; m < 4; ++m) { float* rowp = gz + (size_t)(row0 + ai * 128 + m * 16) * 32 + 8 * fq;
                    *(pg8::f32x4*)(rowp) = acc[ai][0][m][0]; *(pg8::f32x4*)(rowp + 4) = acc[ai][0][m][1]; }
        }
    }
};
struct EpiResid {
    static constexpr bool PERM = false, AFTER_DRAIN = false;
    const float* x; const float* mod; float* x1;
    __device__ __forceinline__ void operator()(const pg8::f32x4 (&acc)[2][2][4][2], const pg8::Unit& u, int wr, int wc, int fr, int fq) const {
        const int row0 = u.pm * 256 + wr * 64 + fr, col0 = u.pn * 256 + wc * 32 + 4 * fq;
        const int b = (u.pm * 256) / S;
        pg8::f32x4 ga[2][2];
#pragma unroll
        for (int bj = 0; bj < 2; ++bj)
#pragma unroll
            for (int n = 0; n < 2; ++n) ga[bj][n] = *(const pg8::f32x4*)(mod + b * 12288 + 2 * 2048 + col0 + bj * 128 + n * 16);
#pragma unroll
        for (int ai = 0; ai < 2; ++ai)
#pragma unroll
            for (int m = 0; m < 4; ++m) { const size_t off = (size_t)(row0 + ai * 128 + m * 16) * D + col0;
#pragma unroll
                for (int bj = 0; bj < 2; ++bj)
#pragma unroll
                    for (int n = 0; n < 2; ++n) { const pg8::f32x4 xv = *(const pg8::f32x4*)(x + off + bj * 128 + n * 16);
                        *(pg8::f32x4*)(x1 + off + bj * 128 + n * 16) = xv + ga[bj][n] * acc[ai][bj][m][n]; } }
    }
};
struct EpiBf16 {
    static constexpr bool PERM = true, AFTER_DRAIN = false;
    u16* Q;
    __device__ __forceinline__ void operator()(const pg8::f32x4 (&acc)[2][2][4][2], const pg8::Unit& u, int wr, int wc, int fr, int fq) const {
        const int row0 = u.pm * 256 + wr * 64 + fr, col0 = u.pn * 256 + wc * 32 + 8 * fq;
#pragma unroll
        for (int ai = 0; ai < 2; ++ai)
#pragma unroll
            for (int m = 0; m < 4; ++m) { u16* rowp = Q + (size_t)(row0 + ai * 128 + m * 16) * D + col0;
#pragma unroll
                for (int bj = 0; bj < 2; ++bj) { const pg8::f32x4 v0 = acc[ai][bj][m][0], v1 = acc[ai][bj][m][1];
                    pg8::u32x4 w; w.x = pg8::cvt_pk_bf16(v0[0], v0[1]); w.y = pg8::cvt_pk_bf16(v0[2], v0[3]); w.z = pg8::cvt_pk_bf16(v1[0], v1[1]); w.w = pg8::cvt_pk_bf16(v1[2], v1[3]);
                    *(pg8::u32x4*)(rowp + bj * 128) = w; } }
    }
};
template <class Epi>
__device__ __forceinline__ void gemm8(unsigned char* lds, const u16* A, const u16* Bt, int M, int N, int K, const Epi& E) {
    pg8::Gemm g{A, Bt, M, N, K}; pg8::StaticOrder So; So.init(M, N, (int)gridDim.x, (int)blockIdx.x);
    pg8::gemm_phase<Epi, pg8::StaticOrder, false>((PG8_LAS unsigned char*)lds, g, So, E, nullptr);
    __syncthreads();
}

#define GLA_QD_BYTES 16384
#define GLA_AT_BYTES 8192
__device__ __forceinline__ float gla_logsigmoid(float z) { return z < 0.f ? z - log1pf(expf(z)) : -log1pf(expf(-z)); }

__device__ __forceinline__ void gla_prep_item(const u16* __restrict__ P, int ldp, int cq, int ck, const float* __restrict__ gz,
                                              const float* __restrict__ wg_f, const float* __restrict__ bg_f, const float* __restrict__ wg_b, const float* __restrict__ bg_b,
                                              int Sq, unsigned char* __restrict__ QDg, unsigned char* __restrict__ KEg, unsigned char* __restrict__ ATg, float* __restrict__ DECg,
                                              unsigned char* lds, int item) {
    const int nch = Sq / 64;
    const int c = item % nch, dir = (item / nch) & 1, hh = (item / (nch * 2)) & 3, b = item / (nch * 8);
    const int tid = TID, lane = tid & 63, wave = tid >> 6, li = lane & 15, fq = lane >> 4;
    float* gzs = (float*)lds;
    float* segs = gzs + 64 * 16;
    unsigned char* QDs = lds + 8192;
    unsigned char* KIs = QDs + 16384;
    unsigned char* KEs = KIs + 16384;
    const size_t tok0 = (size_t)b * Sq;
    __syncthreads();
    for (int e = tid; e < 64 * 16; e += 512) {
        const int i = e >> 4, r = e & 15;
        const int s = dir ? (Sq - 1 - (64 * c + i)) : (64 * c + i);
        gzs[e] = gz[(tok0 + s) * 32 + dir * 16 + r];
    }
    const int d = tid & 127, seg = tid >> 7;
    const float* wg = dir ? wg_b : wg_f;
    float wcol[16];
#pragma unroll
    for (int r = 0; r < 16; ++r) wcol[r] = wg[r * 512 + hh * 128 + d];
    const float bias = (dir ? bg_b : bg_f)[hh * 128 + d];
    __syncthreads();
    float pre[16]; float run = 0.f;
#pragma unroll
    for (int k = 0; k < 16; ++k) {
        const int i = 16 * seg + k;
        float z = bias;
#pragma unroll
        for (int r = 0; r < 16; ++r) z += gzs[i * 16 + r] * wcol[r];
        run += gla_logsigmoid(z) * (1.f / 16.f);
        pre[k] = run;
    }
    segs[seg * 128 + d] = run;
    __syncthreads();
    float off = 0.f, tot = 0.f;
#pragma unroll
    for (int s2 = 0; s2 < 4; ++s2) { const float v = segs[s2 * 128 + d]; tot += v; off += (s2 < seg) ? v : 0.f; }
    const float qscale = 0.08838834764831845f;
#pragma unroll
    for (int k = 0; k < 16; ++k) {
        const int i = 16 * seg + k;
        const int s = dir ? (Sq - 1 - (64 * c + i)) : (64 * c + i);
        const float bb = off + pre[k];
        const float q = bf2f(P[(tok0 + s) * ldp + cq + hh * 128 + d]), kx = bf2f(P[(tok0 + s) * ldp + ck + hh * 128 + d]);
        const int o = i * 256 + ((((d >> 3) ^ (i & 15)) << 4) | ((d & 7) << 1));
        *(u16*)(QDs + o) = f2bf(q * qscale * __expf(bb));
        *(u16*)(KIs + o) = f2bf(kx * __expf(-bb));
        *(u16*)(KEs + o) = f2bf(kx * __expf(tot - bb));
    }
    if (seg == 0) DECg[(size_t)item * 128 + d] = __expf(tot);
    __syncthreads();
    {
        uint4* qo = (uint4*)(QDg + (size_t)item * GLA_QD_BYTES); uint4* ko = (uint4*)(KEg + (size_t)item * GLA_QD_BYTES);
#pragma unroll
        for (int k = 0; k < 2; ++k) { const int e = tid + 512 * k; qo[e] = ((const uint4*)QDs)[e]; ko[e] = ((const uint4*)KEs)[e]; }
    }
#pragma unroll
    for (int tt = 0; tt < 2; ++tt) {
        const int tile = wave + 8 * tt, jt = tile >> 2, it = tile & 3;
        f32x4 acc = (f32x4){0.f, 0.f, 0.f, 0.f};
        if (jt <= it) {
            const int jr = 16 * jt + li, ir = 16 * it + li;
#pragma unroll
            for (int ks = 0; ks < 4; ++ks) {
                const bf16x8 kf = *(const bf16x8*)(KIs + jr * 256 + (((4 * ks + fq) ^ (jr & 15)) << 4));
                const bf16x8 qf = *(const bf16x8*)(QDs + ir * 256 + (((4 * ks + fq) ^ (ir & 15)) << 4));
                acc = __builtin_amdgcn_mfma_f32_16x16x32_bf16(kf, qf, acc, 0, 0, 0);
            }
        }
        const int i = 16 * it + li, j0 = 16 * jt + 4 * fq;
        float v[4];
#pragma unroll
        for (int jj = 0; jj < 4; ++jj) v[jj] = (j0 + jj <= i) ? acc[jj] : 0.f;
        const int chunk = 2 * jt + (fq >> 1), sub = (fq & 1) * 8;
        *(uint2*)(ATg + (size_t)item * GLA_AT_BYTES + i * 128 + ((chunk ^ (i & 7)) << 4) + sub) = make_uint2(pack2(v[0], v[1]), pack2(v[2], v[3]));
    }
}

__device__ __forceinline__ void gla_seq_item(const u16* __restrict__ P, int ldp, int cv, int Sq,
                                             const unsigned char* __restrict__ QDg, const unsigned char* __restrict__ KEg, const unsigned char* __restrict__ ATg, const float* __restrict__ DECg,
                                             u16* __restrict__ Oout  , int Ttot, unsigned char* lds, int item) {
    const int slice = item & 1, dir = (item >> 1) & 1, hh = (item >> 2) & 3, b = item >> 4;
    const int nch = Sq / 64;
    const int tid = TID, lane = tid & 63, wave = tid >> 6, li = lane & 15, fq = lane >> 4;
    const size_t tok0 = (size_t)b * Sq;
    const int pitem0 = ((b * 4 + hh) * 2 + dir) * nch;
    constexpr int BUF = 16384 * 3 + 8192 + 512;
    typedef unsigned gla_u32x4 __attribute__((ext_vector_type(4)));
    gla_u32x4 rq0, rq1, rk0, rk1, rv0, rv1, ra; float rd = 0.f;
#define GLA_VROW(c_, k_) ((tok0 + (size_t)(dir ? (Sq - 1 - (64 * (c_) + ((tid + 512 * (k_)) >> 4))) : (64 * (c_) + ((tid + 512 * (k_)) >> 4)))) * ldp + cv + hh * 256 + slice * 128 + ((tid + 512 * (k_)) & 15) * 8)
#define GLA_ISSUE(c_) do { \
        const gla_u32x4* qsrc_ = (const gla_u32x4*)(QDg + (size_t)(pitem0 + (c_)) * GLA_QD_BYTES); const gla_u32x4* ksrc_ = (const gla_u32x4*)(KEg + (size_t)(pitem0 + (c_)) * GLA_QD_BYTES); \
        rq0 = qsrc_[tid]; rq1 = qsrc_[tid + 512]; rk0 = ksrc_[tid]; rk1 = ksrc_[tid + 512]; \
        ra = ((const gla_u32x4*)(ATg + (size_t)(pitem0 + (c_)) * GLA_AT_BYTES))[tid]; \
        rv0 = *(const gla_u32x4*)(P + GLA_VROW(c_, 0)); rv1 = *(const gla_u32x4*)(P + GLA_VROW(c_, 1)); \
        if (tid < 128) rd = DECg[(size_t)(pitem0 + (c_)) * 128 + tid]; } while (0)
#define GLA_COMMIT(buf_) do { \
        unsigned char* base_ = lds + (buf_) * BUF; \
        ((gla_u32x4*)base_)[tid] = rq0; ((gla_u32x4*)base_)[tid + 512] = rq1; ((gla_u32x4*)(base_ + 16384))[tid] = rk0; ((gla_u32x4*)(base_ + 16384))[tid + 512] = rk1; \
        { const int row_ = tid >> 4, ch_ = tid & 15; *(gla_u32x4*)(base_ + 32768 + row_ * 256 + ((ch_ ^ (row_ & 15)) << 4)) = rv0; } \
        { const int row_ = (tid + 512) >> 4, ch_ = tid & 15; *(gla_u32x4*)(base_ + 32768 + row_ * 256 + ((ch_ ^ (row_ & 15)) << 4)) = rv1; } \
        ((gla_u32x4*)(base_ + 49152))[tid] = ra; \
        if (tid < 128) ((float*)(base_ + 57344))[tid] = rd; } while (0)
    f32x4 st[8];
#pragma unroll
    for (int dt = 0; dt < 8; ++dt) st[dt] = (f32x4){0.f, 0.f, 0.f, 0.f};
    __syncthreads();
    GLA_ISSUE(0); GLA_COMMIT(0);
    __syncthreads();
#pragma unroll 1
    for (int c = 0; c < nch; ++c) {
        const int buf = c & 1;
        if (c + 1 < nch) GLA_ISSUE(c + 1);
        const unsigned char* QDs = lds + buf * BUF; const unsigned char* KEs = QDs + 16384; const unsigned char* Vs = QDs + 32768;
        const unsigned char* ATs = QDs + 49152; const float* DECs = (const float*)(QDs + 57344);
        bf16x8 vf[2];
#pragma unroll
        for (int jp = 0; jp < 2; ++jp) {
            const int rowA = 32 * jp + 8 * fq + (li >> 2), rowB = rowA + 4;
            const int chunk = 2 * wave + ((li & 3) >> 1), sub = ((li & 3) & 1) * 8;
            const s16x4 va = __builtin_amdgcn_ds_read_tr16_b64_v4i16((LAS s16x4*)(Vs + rowA * 256 + ((chunk ^ (rowA & 15)) << 4) + sub));
            const s16x4 vb = __builtin_amdgcn_ds_read_tr16_b64_v4i16((LAS s16x4*)(Vs + rowB * 256 + ((chunk ^ (rowB & 15)) << 4) + sub));
            vf[jp][0] = va[0]; vf[jp][1] = va[1]; vf[jp][2] = va[2]; vf[jp][3] = va[3]; vf[jp][4] = vb[0]; vf[jp][5] = vb[1]; vf[jp][6] = vb[2]; vf[jp][7] = vb[3];
        }
        bf16x8 sf[4];
#pragma unroll
        for (int dp = 0; dp < 4; ++dp)
#pragma unroll
            for (int jj = 0; jj < 4; ++jj) { sf[dp][jj] = (short)f2bf(st[2 * dp][jj]); sf[dp][4 + jj] = (short)f2bf(st[2 * dp + 1][jj]); }
        f32x4 ot[4];
#pragma unroll
        for (int it = 0; it < 4; ++it) {
            f32x4 acc = (f32x4){0.f, 0.f, 0.f, 0.f};
            const int ir = 16 * it + li;
#pragma unroll
            for (int dp = 0; dp < 4; ++dp) {
                const int c0 = 4 * dp + (fq >> 1), c1 = c0 + 2, sub = (fq & 1) * 8;
                const uint2 lo = *(const uint2*)(QDs + ir * 256 + ((c0 ^ (ir & 15)) << 4) + sub);
                const uint2 hi = *(const uint2*)(QDs + ir * 256 + ((c1 ^ (ir & 15)) << 4) + sub);
                bf16x8 qf;
                qf[0] = (short)(lo.x & 0xffff); qf[1] = (short)(lo.x >> 16); qf[2] = (short)(lo.y & 0xffff); qf[3] = (short)(lo.y >> 16);
                qf[4] = (short)(hi.x & 0xffff); qf[5] = (short)(hi.x >> 16); qf[6] = (short)(hi.y & 0xffff); qf[7] = (short)(hi.y >> 16);
                acc = __builtin_amdgcn_mfma_f32_16x16x32_bf16(sf[dp], qf, acc, 0, 0, 0);
            }
#pragma unroll
            for (int jp = 0; jp < 2; ++jp) {
                if (32 * jp <= 16 * it + 15) {
                    const bf16x8 af = *(const bf16x8*)(ATs + ir * 128 + (((4 * jp + fq) ^ (ir & 7)) << 4));
                    acc = __builtin_amdgcn_mfma_f32_16x16x32_bf16(vf[jp], af, acc, 0, 0, 0);
                }
            }
            ot[it] = acc;
        }
#pragma unroll
        for (int dt = 0; dt < 8; ++dt) {
            const f32x4 dec = *(const f32x4*)(DECs + 16 * dt + 4 * fq);
            f32x4 acc = st[dt] * dec;
#pragma unroll
            for (int jp = 0; jp < 2; ++jp) {
                const int rowA = 32 * jp + 8 * fq + (li >> 2), rowB = rowA + 4;
                const int chunk = 2 * dt + ((li & 3) >> 1), sub = ((li & 3) & 1) * 8;
                const s16x4 ka = __builtin_amdgcn_ds_read_tr16_b64_v4i16((LAS s16x4*)(KEs + rowA * 256 + ((chunk ^ (rowA & 15)) << 4) + sub));
                const s16x4 kb = __builtin_amdgcn_ds_read_tr16_b64_v4i16((LAS s16x4*)(KEs + rowB * 256 + ((chunk ^ (rowB & 15)) << 4) + sub));
                bf16x8 kf;
                kf[0] = ka[0]; kf[1] = ka[1]; kf[2] = ka[2]; kf[3] = ka[3]; kf[4] = kb[0]; kf[5] = kb[1]; kf[6] = kb[2]; kf[7] = kb[3];
                acc = __builtin_amdgcn_mfma_f32_16x16x32_bf16(kf, vf[jp], acc, 0, 0, 0);
            }
            st[dt] = acc;
        }
#pragma unroll
        for (int it = 0; it < 4; ++it) {
            const int i = 16 * it + li;
            const int s = dir ? (Sq - 1 - (64 * c + i)) : (64 * c + i);
            *(uint2*)(Oout + ((size_t)dir * Ttot + tok0 + s) * 1024 + hh * 256 + slice * 128 + 16 * wave + 4 * fq) =
                make_uint2(pack2(ot[it][0], ot[it][1]), pack2(ot[it][2], ot[it][3]));
        }
        if (c + 1 < nch) GLA_COMMIT(buf ^ 1);
        __syncthreads();
    }
}
__device__ __forceinline__ void phase_rope_prep(const Args& a, unsigned char* lds) {
    u16* P = (u16*)(a.ws + WS_P);
    const float2* cs = (const float2*)(a.ws + WS_CS);
    const int gt = blockIdx.x * NTHREADS + threadIdx.x, NT = gridDim.x * NTHREADS;
    for (int i = gt; i < T * 2 * 8 * 64; i += NT) {
        const int f = i & 63, hh = (i >> 6) & 7, which = (i >> 9) & 1, t = i >> 10;
        const float2 c = cs[t * 64 + f];
        u16* p = P + (size_t)t * NP + (which ? C_DK : C_DQ) + hh * 128 + f;
        const float t1 = bf2f(p[0]), t2 = bf2f(p[64]);
        p[0] = f2bf(t1 * c.x - t2 * c.y);
        p[64] = f2bf(t1 * c.y + t2 * c.x);
    }
    for (int item = blockIdx.x; item < GLA_NPREP; item += gridDim.x)
        gla_prep_item(P, NP, C_GQ, C_GK, (const float*)(a.ws + WS_GZ), a.wgf, a.bgf, a.wgb, a.bgb, S,
                      a.ws + WS_QD, a.ws + WS_KE, a.ws + WS_AT, (float*)(a.ws + WS_DEC), lds, item);
}

__device__ __forceinline__ void attn_item(const u16* __restrict__ P, int ldp, int cq, int ck, int cv, int Sq,
                                          u16* __restrict__ part_o, float* __restrict__ part_lse, int Ttot,
                                          unsigned char* lds, int item) {
    const int tid = TID, lane = tid & 63, wave = tid >> 6, li = lane & 15, fq = lane >> 4;
    const int nb_per = Sq / 128;
    const int within = item % nb_per, hh = (item / nb_per) & 7, b = (item / (nb_per * 8)) & 3, pat = item / (nb_per * 32);
    const int dil = pat == 0 ? 1 : (pat == 1 ? 4 : 16);
    const int M = Sq / dil;
    const int r = within % dil, blk = within / dil;
    const int p0 = blk * 128, kbase = p0 - 64;
    unsigned char* Ks = lds;
    unsigned char* Vs = lds + 65536;
    const size_t tok0 = (size_t)b * Sq;
    __syncthreads();
#pragma unroll
    for (int i = 0; i < 8; ++i) {
        const int id = tid + 512 * i, row = id >> 4, c = id & 15;
        int kp = kbase + row; kp = kp < 0 ? 0 : (kp > M - 1 ? M - 1 : kp);
        const size_t t = tok0 + r + (size_t)dil * kp;
        const uint4 kv = *(const uint4*)(P + t * ldp + ck + hh * 128 + c * 8);
        const uint4 vv = *(const uint4*)(P + t * ldp + cv + hh * 128 + c * 8);
        const int off = row * 256 + ((c ^ (row & 15)) << 4);
        *(uint4*)(Ks + off) = kv;
        *(uint4*)(Vs + off) = vv;
    }
    const int qp = p0 + 16 * wave + li;
    const size_t tq = tok0 + r + (size_t)dil * qp;
    bf16x8 qf[4];
#pragma unroll
    for (int ks = 0; ks < 4; ++ks) qf[ks] = *(const bf16x8*)(P + tq * ldp + cq + hh * 128 + 32 * ks + 8 * fq);
    __syncthreads();
    const float scale = 0.08838834764831845f;
    float m = -1e30f, l = 0.f;
    f32x4 o[8];
#pragma unroll
    for (int dt = 0; dt < 8; ++dt) o[dt] = (f32x4){0.f, 0.f, 0.f, 0.f};
#pragma unroll 1
    for (int tp = 0; tp < 5; ++tp) {
        float s[8]; bool ok[8];
#pragma unroll
        for (int h2 = 0; h2 < 2; ++h2) {
            const int kk0 = 16 * wave + 16 * (2 * tp + h2);
            int krow = kk0 + li; krow = krow > 255 ? 255 : krow;
            f32x4 acc = (f32x4){0.f, 0.f, 0.f, 0.f};
#pragma unroll
            for (int ks = 0; ks < 4; ++ks) {
                const bf16x8 kf = *(const bf16x8*)(Ks + krow * 256 + (((4 * ks + fq) ^ (krow & 15)) << 4));
                acc = __builtin_amdgcn_mfma_f32_16x16x32_bf16(kf, qf[ks], acc, 0, 0, 0);
            }
#pragma unroll
            for (int j = 0; j < 4; ++j) {
                const int kp = kbase + kk0 + 4 * fq + j;
                const int rel = kp - qp;
                ok[4 * h2 + j] = (kp >= 0) && (kp < M) && (rel <= 64) && (rel >= -64);
                s[4 * h2 + j] = acc[j] * scale;
            }
        }
        float mx = -1e30f;
#pragma unroll
        for (int j = 0; j < 8; ++j) mx = ok[j] ? fmaxf(mx, s[j]) : mx;
        mx = fmaxf(mx, __shfl_xor(mx, 16));
        mx = fmaxf(mx, __shfl_xor(mx, 32));
        const float mn = fmaxf(m, mx);
        const float al = __expf(m - mn);
        float ps = 0.f; float p[8];
#pragma unroll
        for (int j = 0; j < 8; ++j) { p[j] = ok[j] ? __expf(s[j] - mn) : 0.f; ps += p[j]; }
        l = l * al + ps; m = mn;
        bf16x8 pf;
#pragma unroll
        for (int j = 0; j < 8; ++j) pf[j] = (short)f2bf(p[j]);
#pragma unroll
        for (int dt = 0; dt < 8; ++dt) o[dt] *= al;
        int rowA = 16 * wave + 32 * tp + 4 * fq + (li >> 2); rowA = rowA > 255 ? 255 : rowA;
        int rowB = 16 * wave + 32 * tp + 16 + 4 * fq + (li >> 2); rowB = rowB > 255 ? 255 : rowB;
#pragma unroll
        for (int dt = 0; dt < 8; ++dt) {
            const int chunk = 2 * dt + ((li & 3) >> 1), sub = ((li & 3) & 1) * 8;
            const s16x4 va = __builtin_amdgcn_ds_read_tr16_b64_v4i16((LAS s16x4*)(Vs + rowA * 256 + ((chunk ^ (rowA & 15)) << 4) + sub));
            const s16x4 vb = __builtin_amdgcn_ds_read_tr16_b64_v4i16((LAS s16x4*)(Vs + rowB * 256 + ((chunk ^ (rowB & 15)) << 4) + sub));
            bf16x8 vf;
            vf[0] = va[0]; vf[1] = va[1]; vf[2] = va[2]; vf[3] = va[3]; vf[4] = vb[0]; vf[5] = vb[1]; vf[6] = vb[2]; vf[7] = vb[3];
            o[dt] = __builtin_amdgcn_mfma_f32_16x16x32_bf16(vf, pf, o[dt], 0, 0, 0);
        }
    }
    l += __shfl_xor(l, 16);
    l += __shfl_xor(l, 32);
    const float inv = 1.f / l;
    u16* orow = part_o + ((size_t)pat * Ttot + tq) * 1024 + hh * 128 + 4 * fq;
#pragma unroll
    for (int dt = 0; dt < 8; ++dt)
        *(uint2*)(orow + 16 * dt) = make_uint2(pack2(o[dt][0] * inv, o[dt][1] * inv), pack2(o[dt][2] * inv, o[dt][3] * inv));
    if (fq == 0) part_lse[((size_t)pat * Ttot + tq) * 8 + hh] = m + logf(l);
}

__device__ __forceinline__ void attn_merge_token(const u16* __restrict__ part_o, const float* __restrict__ part_lse, int Ttot, size_t t,
                                                 u16* __restrict__ dst  , int lane) {
    const int hh = lane >> 3;
    const float l0 = part_lse[((size_t)0 * Ttot + t) * 8 + hh], l1 = part_lse[((size_t)1 * Ttot + t) * 8 + hh], l2 = part_lse[((size_t)2 * Ttot + t) * 8 + hh];
    const float mx = fmaxf(l0, fmaxf(l1, l2));
    const float e0 = __expf(l0 - mx), e1 = __expf(l1 - mx), e2 = __expf(l2 - mx);
    const float inv = 1.f / (e0 + e1 + e2);
    const float w[3] = {e0 * inv, e1 * inv, e2 * inv};
    float acc[16];
#pragma unroll
    for (int i = 0; i < 16; ++i) acc[i] = 0.f;
#pragma unroll
    for (int p = 0; p < 3; ++p) {
        const uint4* src = (const uint4*)(part_o + ((size_t)p * Ttot + t) * 1024 + lane * 16);
        const uint4 a = src[0], bb = src[1];
        acc[0] += w[p] * lo2f(a.x); acc[1] += w[p] * hi2f(a.x); acc[2] += w[p] * lo2f(a.y); acc[3] += w[p] * hi2f(a.y);
        acc[4] += w[p] * lo2f(a.z); acc[5] += w[p] * hi2f(a.z); acc[6] += w[p] * lo2f(a.w); acc[7] += w[p] * hi2f(a.w);
        acc[8] += w[p] * lo2f(bb.x); acc[9] += w[p] * hi2f(bb.x); acc[10] += w[p] * lo2f(bb.y); acc[11] += w[p] * hi2f(bb.y);
        acc[12] += w[p] * lo2f(bb.z); acc[13] += w[p] * hi2f(bb.z); acc[14] += w[p] * lo2f(bb.w); acc[15] += w[p] * hi2f(bb.w);
    }
    uint4* d = (uint4*)(dst + lane * 16);
    d[0] = make_uint4(pack2(acc[0], acc[1]), pack2(acc[2], acc[3]), pack2(acc[4], acc[5]), pack2(acc[6], acc[7]));
    d[1] = make_uint4(pack2(acc[8], acc[9]), pack2(acc[10], acc[11]), pack2(acc[12], acc[13]), pack2(acc[14], acc[15]));
}

__device__ __forceinline__ void phase_mixers(const Args& a, unsigned char* lds) {
    const int bi = blockIdx.x, G = gridDim.x;
    if (bi < 64) {
        gla_seq_item((const u16*)(a.ws + WS_P), NP, C_GV, S, a.ws + WS_QD, a.ws + WS_KE, a.ws + WS_AT, (const float*)(a.ws + WS_DEC),
                     (u16*)(a.ws + WS_OFB), T, lds, bi);
    } else {
        u16* part_o = (u16*)a.out; float* part_lse = (float*)((unsigned char*)a.out + (size_t)3 * T * 1024 * 2);
        for (int item = bi - 64; item < 3 * 4 * 8 * (S / 128); item += G - 64)
            attn_item((const u16*)(a.ws + WS_P), NP, C_DQ, C_DK, C_DV, S, part_o, part_lse, T, lds, item);
    }
}

__device__ __forceinline__ void phase_gla_fin(const Args& a) {
    const u16* Of = (const u16*)(a.ws + WS_OFB);
    const u16* Ob = Of + (size_t)T * 1024;
    const u16* P = (const u16*)(a.ws + WS_P);
    u16* A2 = (u16*)(a.ws + WS_ACT);
    const int lane = threadIdx.x & 63, wave = threadIdx.x >> 6;
    const int gw = blockIdx.x * NWAVES + wave, NGW = gridDim.x * NWAVES;
    for (int item = gw; item < T * 4; item += NGW) {
        const int hh = item & 3, t = item >> 2;
        const size_t base = (size_t)t * 1024 + hh * 256 + lane * 4;
        const uint2 f = *(const uint2*)(Of + base), bb = *(const uint2*)(Ob + base);
        const float o0 = lo2f(f.x) + lo2f(bb.x), o1 = hi2f(f.x) + hi2f(bb.x), o2 = lo2f(f.y) + lo2f(bb.y), o3 = hi2f(f.y) + hi2f(bb.y);
        const float ss = wave_sum(o0 * o0 + o1 * o1 + o2 * o2 + o3 * o3);
        const float rstd = rsqrtf(ss * (1.f / 256.f) + NORM_EPS);
        const float4 gg = *(const float4*)(a.g_gla + hh * 256 + lane * 4);
        const uint2 rp = *(const uint2*)(P + (size_t)t * NP + C_GR + hh * 256 + lane * 4);
        const float r0 = lo2f(rp.x), r1 = hi2f(rp.x), r2 = lo2f(rp.y), r3 = hi2f(rp.y);
        const float y0 = o0 * rstd * gg.x * silu_f(r0), y1 = o1 * rstd * gg.y * silu_f(r1);
        const float y2 = o2 * rstd * gg.z * silu_f(r2), y3 = o3 * rstd * gg.w * silu_f(r3);
        *(uint2*)(A2 + (size_t)t * D + hh * 256 + lane * 4) = make_uint2(pack2(y0, y1), pack2(y2, y3));
    }
    const u16* part_o = (const u16*)a.out; const float* part_lse = (const float*)((const unsigned char*)a.out + (size_t)3 * T * 1024 * 2);
    for (int t = gw; t < T; t += NGW) attn_merge_token(part_o, part_lse, T, (size_t)t, A2 + (size_t)t * D + 1024, lane);
}

__device__ __forceinline__ void phase_route(const Args& a) {
    const u16* Q = (const u16*)(a.ws + WS_Q);
    int* IDX = (int*)(a.ws + WS_IDX);
    float* GATE = (float*)(a.ws + WS_GATE);
    const int lane = threadIdx.x & 63, wave = threadIdx.x >> 6;
    const int gw = blockIdx.x * NWAVES + wave, NGW = gridDim.x * NWAVES;
    for (int item = gw; item < T * 8; item += NGW) {
        const int hh = item & 7, t = item >> 3;
        float ts[2]; int ti[2];
        ts[0] = ts[1] = 0.f; ti[0] = ti[1] = 0;
#pragma unroll
        for (int half = 0; half < 2; ++half) {
            const u16* qp = Q + (size_t)t * D + hh * 256 + half * 128;
            const float* k0p = a.subk + ((size_t)(hh * 2 + half) * 128 + lane) * 128;
            const float* k1p = k0p + 64 * 128;
            float v0 = 0.f, v1 = 0.f;
            for (int d = 0; d < 128; d += 4) {
                const uint2 qq = *(const uint2*)(qp + d);
                const float4 ka = *(const float4*)(k0p + d), kb = *(const float4*)(k1p + d);
                const float x0 = lo2f(qq.x), x1 = hi2f(qq.x), x2 = lo2f(qq.y), x3 = hi2f(qq.y);
                v0 += x0 * ka.x + x1 * ka.y + x2 * ka.z + x3 * ka.w;
                v1 += x0 * kb.x + x1 * kb.y + x2 * kb.z + x3 * kb.w;
            }
            float mys = 0.f; int myi = 0;
            for (int it = 0; it < 16; ++it) {
                const float lm = fmaxf(v0, v1);
                const float wm = wave_max(lm);
                const unsigned long long bal = __ballot(lm == wm);
                const int src = __ffsll((long long)bal) - 1;
                const int which = (v0 >= v1) ? 0 : 1;
                const int kidx = __shfl(lane + 64 * which, src);
                if (lane == src) { if (which == 0) v0 = -3.0e38f; else v1 = -3.0e38f; }
                if (lane == it) { mys = wm; myi = kidx; }
            }
            ts[half] = mys; ti[half] = myi;
        }
        float cv[4];
#pragma unroll
        for (int r = 0; r < 4; ++r) {
            const int c = lane + 64 * r;
            cv[r] = __shfl(ts[0], c >> 4) + __shfl(ts[1], c & 15);
        }
        float bs = 0.f; int bc = 0;
        for (int it = 0; it < 16; ++it) {
            const float lm = fmaxf(fmaxf(cv[0], cv[1]), fmaxf(cv[2], cv[3]));
            const float wm = wave_max(lm);
            const unsigned long long bal = __ballot(lm == wm);
            const int src = __ffsll((long long)bal) - 1;
            int which = 3;
            if (cv[2] == lm) which = 2;
            if (cv[1] == lm) which = 1;
            if (cv[0] == lm) which = 0;
            const int cidx = __shfl(lane + 64 * which, src);
            if (lane == src) {
                if (which == 0) cv[0] = -3.0e38f; else if (which == 1) cv[1] = -3.0e38f; else if (which == 2) cv[2] = -3.0e38f; else cv[3] = -3.0e38f;
            }
            if (lane == it) { bs = wm; bc = cidx; }
        }
        const float top = __shfl(bs, 0);
        const float e = (lane < 16) ? __expf(bs - top) : 0.f;
        const float den = wave_sum(e);
        const int i0 = __shfl(ti[0], bc >> 4), i1 = __shfl(ti[1], bc & 15);
        if (lane < 16) {
            IDX[(size_t)t * 128 + hh * 16 + lane] = i0 * 128 + i1;
            GATE[(size_t)t * 128 + hh * 16 + lane] = e / den;
        }
    }
}

typedef __bf16 bf16x2_t __attribute__((ext_vector_type(2)));
__device__ __forceinline__ float dot2bf(unsigned w, unsigned x, float acc) {
    return __builtin_amdgcn_fdot2_f32_bf16(__builtin_bit_cast(bf16x2_t, w), __builtin_bit_cast(bf16x2_t, x), acc, false);
}
__device__ __forceinline__ void convert_tables(const Args& a) {
    uint4* U = (uint4*)(a.ws + WS_TU); uint4* V = (uint4*)(a.ws + WS_TV);
    const size_t n8 = (size_t)16384 * D / 8;
    const size_t gt = (size_t)blockIdx.x * NTHREADS + threadIdx.x, NT = (size_t)gridDim.x * NTHREADS;
    for (size_t i = gt; i < 2 * n8; i += NT) {
        const bool isv = i >= n8; const size_t j = isv ? i - n8 : i;
        const f32x4* sp = (const f32x4*)(isv ? a.pv : a.pu) + 2 * j;
        const f32x4 v0 = __builtin_nontemporal_load(sp), v1 = __builtin_nontemporal_load(sp + 1);
        const uint4 o = make_uint4(pack2(v0.x, v0.y), pack2(v0.z, v0.w), pack2(v1.x, v1.y), pack2(v1.z, v1.w));
        (isv ? V : U)[j] = o;
    }
}

__device__ __forceinline__ void phase_experts(const Args& a) {
    const u16* H2 = (const u16*)(a.ws + WS_ACT);
    const float* X1 = (const float*)(a.ws + WS_X1);
    const int* IDX = (const int*)(a.ws + WS_IDX);
    const float* GATE = (const float*)(a.ws + WS_GATE);
    const float* mod = (const float*)(a.ws + WS_MOD);
    const uint4* U = (const uint4*)(a.ws + WS_TU); const uint4* V = (const uint4*)(a.ws + WS_TV);
    const int lane = threadIdx.x & 63, wave = threadIdx.x >> 6;
    const int gw = blockIdx.x * NWAVES + wave, NGW = gridDim.x * NWAVES;
    for (int t = gw; t < T; t += NGW) {
        const int b = t / S;
        uint4 h[4]; float acc[4][8];
        {
            const uint4* hp = (const uint4*)(H2 + (size_t)t * D);
#pragma unroll
            for (int m = 0; m < 4; ++m) { h[m] = hp[lane + 64 * m];
#pragma unroll
                for (int i = 0; i < 8; ++i) acc[m][i] = 0.f; }
        }
#pragma unroll 1
        for (int r0 = 0; r0 < 128; r0 += 4) {
            const int4 e4 = *(const int4*)(IDX + (size_t)t * 128 + r0);
            const float4 g4 = *(const float4*)(GATE + (size_t)t * 128 + r0);
            int e[4] = {__builtin_amdgcn_readfirstlane(e4.x), __builtin_amdgcn_readfirstlane(e4.y), __builtin_amdgcn_readfirstlane(e4.z), __builtin_amdgcn_readfirstlane(e4.w)};
            const float g[4] = {g4.x, g4.y, g4.z, g4.w};
            uint4 u[4][4], v[4][4];
#pragma unroll
            for (int q = 0; q < 4; ++q)
#pragma unroll
                for (int m = 0; m < 4; ++m) u[q][m] = U[(size_t)e[q] * 256 + lane + 64 * m];
#pragma unroll
            for (int q = 0; q < 4; ++q)
#pragma unroll
                for (int m = 0; m < 4; ++m) v[q][m] = V[(size_t)e[q] * 256 + lane + 64 * m];
            float d[4];
#pragma unroll
            for (int q = 0; q < 4; ++q) { float s0 = 0.f, s1 = 0.f;
#pragma unroll
                for (int m = 0; m < 4; ++m) { s0 = dot2bf(u[q][m].x, h[m].x, s0); s1 = dot2bf(u[q][m].y, h[m].y, s1); s0 = dot2bf(u[q][m].z, h[m].z, s0); s1 = dot2bf(u[q][m].w, h[m].w, s1); }
                d[q] = s0 + s1; }
#pragma unroll
            for (int o = 32; o > 0; o >>= 1) {
#pragma unroll
                for (int q = 0; q < 4; ++q) d[q] += __shfl_xor(d[q], o);
            }
#pragma unroll
            for (int q = 0; q < 4; ++q) { const float w = g[q] * gelu_f(d[q]);
#pragma unroll
                for (int m = 0; m < 4; ++m) {
                    acc[m][0] += w * lo2f(v[q][m].x); acc[m][1] += w * hi2f(v[q][m].x); acc[m][2] += w * lo2f(v[q][m].y); acc[m][3] += w * hi2f(v[q][m].y);
                    acc[m][4] += w * lo2f(v[q][m].z); acc[m][5] += w * hi2f(v[q][m].z); acc[m][6] += w * lo2f(v[q][m].w); acc[m][7] += w * hi2f(v[q][m].w); } }
        }
        float ss = 0.f;
#pragma unroll
        for (int m = 0; m < 4; ++m) {
            const int c0 = lane * 8 + 512 * m;
            const float4 xa = *(const float4*)(X1 + (size_t)t * D + c0), xb = *(const float4*)(X1 + (size_t)t * D + c0 + 4);
            const float4 ga = *(const float4*)(mod + b * 12288 + 5 * 2048 + c0), gb = *(const float4*)(mod + b * 12288 + 5 * 2048 + c0 + 4);
            acc[m][0] = xa.x + ga.x * acc[m][0]; acc[m][1] = xa.y + ga.y * acc[m][1]; acc[m][2] = xa.z + ga.z * acc[m][2]; acc[m][3] = xa.w + ga.w * acc[m][3];
            acc[m][4] = xb.x + gb.x * acc[m][4]; acc[m][5] = xb.y + gb.y * acc[m][5]; acc[m][6] = xb.z + gb.z * acc[m][6]; acc[m][7] = xb.w + gb.w * acc[m][7];
#pragma unroll
            for (int i = 0; i < 8; ++i) ss += acc[m][i] * acc[m][i];
        }
        ss = wave_sum(ss);
        const float rstd = rsqrtf(ss * (1.f / D) + NORM_EPS);
#pragma unroll
        for (int m = 0; m < 4; ++m) {
            const int c0 = lane * 8 + 512 * m;
            const float4 ga = *(const float4*)(a.g_fin + c0), gb = *(const float4*)(a.g_fin + c0 + 4);
            *(float4*)(a.out + (size_t)t * D + c0) = make_float4(acc[m][0] * rstd * ga.x, acc[m][1] * rstd * ga.y, acc[m][2] * rstd * ga.z, acc[m][3] * rstd * ga.w);
            *(float4*)(a.out + (size_t)t * D + c0 + 4) = make_float4(acc[m][4] * rstd * gb.x, acc[m][5] * rstd * gb.y, acc[m][6] * rstd * gb.z, acc[m][7] * rstd * gb.w);
        }
    }
}

constexpr int NPHASES = 11;
__global__ void __launch_bounds__(NTHREADS, 2) mk_fwd(Args a) {
    extern __shared__ __attribute__((aligned(16))) unsigned char lds[];
    cg::grid_group grid = cg::this_grid();
    const int lo = a.ph_lo, hi = a.ph_hi;
#define IN(k) (lo <= (k) && (k) < hi)
#define SEAM(k) do { if (IN(k) && IN((k) + 1)) grid.sync(); } while (0)
    const float* mod = (const float*)(a.ws + WS_MOD);
    if (IN(0)) phase0(a, lds);
    SEAM(0);
    if (IN(1)) norm_mod_phase(a.x, a.g_mix, mod, 0, 1, (u16*)(a.ws + WS_ACT));
    SEAM(1);
    if (IN(2)) gemm8(lds, (const u16*)(a.ws + WS_ACT), (const u16*)(a.ws + WS_WIN), T, NPAD, D, EpiProj{(u16*)(a.ws + WS_P), (float*)(a.ws + WS_GZ)});
    SEAM(2);
    if (IN(3)) phase_rope_prep(a, lds);
    SEAM(3);
    if (IN(4)) phase_mixers(a, lds);
    SEAM(4);
    if (IN(5)) phase_gla_fin(a);
    SEAM(5);
    if (IN(6)) gemm8(lds, (const u16*)(a.ws + WS_ACT), (const u16*)(a.ws + WS_WOUT), T, D, D, EpiResid{a.x, mod, (float*)(a.ws + WS_X1)});
    SEAM(6);
    if (IN(7)) { norm_mod_phase((const float*)(a.ws + WS_X1), a.g_ffn, mod, 3, 4, (u16*)(a.ws + WS_ACT)); convert_tables(a); }
    SEAM(7);
    if (IN(8)) gemm8(lds, (const u16*)(a.ws + WS_ACT), (const u16*)(a.ws + WS_WPQ), T, D, D, EpiBf16{(u16*)(a.ws + WS_Q)});
    SEAM(8);
    if (IN(9)) phase_route(a);
    SEAM(9);
    if (IN(10)) phase_experts(a);
#undef IN
#undef SEAM
}

#ifndef MK_ONE_LAUNCH
#define MK_ONE_LAUNCH 1
#endif
extern "C" void kernel_launch(void* const* d_in, const int* in_sizes, int n_in, void* d_out, int out_size, void* d_ws, size_t ws_size, hipStream_t stream) {
    static int grid = 0;
    if (grid == 0) {
        if (n_in != 19 || out_size != T * D || ws_size < WS_END) {
            fprintf(stderr, "kernel_launch: unexpected shapes: n_in %d out %d ws %zu (need %zu)\n", n_in, out_size, ws_size, (size_t)WS_END);
            grid = -1; return;
        }
        int dev = 0, cus = 0, per_cu = 0;
        (void)hipGetDevice(&dev);
        (void)hipDeviceGetAttribute(&cus, hipDeviceAttributeMultiprocessorCount, dev);
        (void)hipFuncSetAttribute((const void*)mk_fwd, hipFuncAttributeMaxDynamicSharedMemorySize, LDS_BYTES);
        (void)hipOccupancyMaxActiveBlocksPerMultiprocessor(&per_cu, (const void*)mk_fwd, NTHREADS, LDS_BYTES);
        if (per_cu < 1) { fprintf(stderr, "kernel_launch: occupancy query says %d blocks/CU\n", per_cu); grid = -1; return; }
        grid = cus;
        (void)hipGetLastError();
    }
    if (grid < 0) return;
    Args a{};
    a.x = (const float*)d_in[0]; a.c = (const float*)d_in[1]; a.pos = (const int*)d_in[2]; a.w_ada = (const float*)d_in[3];
    a.b_ada = (const float*)d_in[4]; a.g_mix = (const float*)d_in[5]; a.w_in = (const float*)d_in[6]; a.wgf = (const float*)d_in[7];
    a.bgf = (const float*)d_in[8]; a.wgb = (const float*)d_in[9]; a.bgb = (const float*)d_in[10]; a.g_gla = (const float*)d_in[11];
    a.w_out = (const float*)d_in[12]; a.g_ffn = (const float*)d_in[13]; a.w_pq = (const float*)d_in[14]; a.subk = (const float*)d_in[15];
    a.pu = (const float*)d_in[16]; a.pv = (const float*)d_in[17]; a.g_fin = (const float*)d_in[18];
    a.out = (float*)d_out; a.ws = (unsigned char*)d_ws;
#if MK_ONE_LAUNCH
    a.ph_lo = 0; a.ph_hi = NPHASES;
    void* args[] = {&a};
    hipError_t e = hipLaunchCooperativeKernel((const void*)mk_fwd, dim3(grid), dim3(NTHREADS), args, LDS_BYTES, stream);
    if (e != hipSuccess) fprintf(stderr, "cooperative launch failed: %s (grid %d)\n", hipGetErrorString(e), grid);
#else
    for (int p = 0; p < NPHASES; ++p) {
        a.ph_lo = p; a.ph_hi = p + 1;
        hipLaunchKernelGGL(mk_fwd, dim3(grid), dim3(NTHREADS), LDS_BYTES, stream, a);
    }
#endif
}
```

```cpp
#include <hip/hip_runtime.h>
#include <hip/hip_cooperative_groups.h>
#include <cstdio>
#include <cstdint>

namespace cg = cooperative_groups;

typedef unsigned short u16;
typedef __attribute__((ext_vector_type(8))) short bf16x8;
typedef __attribute__((ext_vector_type(4))) float f32x4;
typedef short s16x4 __attribute__((ext_vector_type(4)));
#define TID ((int)threadIdx.x)
#define BID ((int)blockIdx.x)
#define GDIM ((int)gridDim.x)
#define LAS __attribute__((address_space(3)))

constexpr int D = 2048, NB = 4, S = 4096, T = NB * S;
constexpr int INW = 6176;
constexpr int NP = 6144;
constexpr int NPAD = 6400;
constexpr int C_GQ = 0, C_GK = 512, C_GV = 1024, C_GR = 2048, C_DQ = 3072, C_DK = 4096, C_DV = 5120;
constexpr int NTHREADS = 512, NWAVES = 8;
constexpr int LDS_BYTES = 128 * 1024;
constexpr float NORM_EPS = 1e-6f;

constexpr size_t WS_CTL = 0;
constexpr size_t WS_MOD = 65536;
constexpr size_t WS_CS = 524288;
constexpr size_t WS_WIN = WS_CS + (size_t)T * 64 * 8;
constexpr size_t WS_WOUT = WS_WIN + (size_t)NPAD * D * 2;
constexpr size_t WS_WPQ = WS_WOUT + (size_t)D * D * 2;
constexpr size_t WS_ACT = WS_WPQ + (size_t)D * D * 2;
constexpr size_t WS_P = WS_ACT + (size_t)T * D * 2;
constexpr size_t WS_X1 = WS_P;
constexpr size_t WS_Q = WS_P + (size_t)T * D * 4;
constexpr size_t WS_GZ = WS_P + (size_t)T * NP * 2;
constexpr int GLA_NPREP = NB * 4 * 2 * (S / 64);
constexpr size_t WS_QD = WS_GZ + (size_t)T * 32 * 4;
constexpr size_t WS_KE = WS_QD + (size_t)GLA_NPREP * 16384;
constexpr size_t WS_AT = WS_KE + (size_t)GLA_NPREP * 16384;
constexpr size_t WS_DEC = WS_AT + (size_t)GLA_NPREP * 8192;
constexpr size_t WS_OFB = WS_DEC + (size_t)GLA_NPREP * 512;
constexpr size_t WS_IDX = WS_OFB + (size_t)2 * T * 1024 * 2;
constexpr size_t WS_GATE = WS_IDX + (size_t)T * 128 * 4;
constexpr size_t WS_END = WS_GATE + (size_t)T * 128 * 4;
constexpr size_t WS_TU = WS_QD;
constexpr size_t WS_TV = WS_QD + (size_t)16384 * D * 2;
static_assert(WS_TV + (size_t)16384 * D * 2 <= WS_IDX, "table region");

struct Args {
    const float* x; const float* c; const int* pos; const float* w_ada; const float* b_ada; const float* g_mix;
    const float* w_in; const float* wgf; const float* bgf; const float* wgb; const float* bgb; const float* g_gla;
    const float* w_out; const float* g_ffn; const float* w_pq; const float* subk; const float* pu; const float* pv; const float* g_fin;
    float* out; unsigned char* ws; int ph_lo, ph_hi;
};

__device__ __forceinline__ float bf2f(u16 h) { return __uint_as_float(((unsigned)h) << 16); }
__device__ __forceinline__ u16 f2bf(float f) { unsigned u = __float_as_uint(f); u += 0x7fffu + ((u >> 16) & 1u); return (u16)(u >> 16); }
__device__ __forceinline__ unsigned pack2(float a, float b) { return (unsigned)f2bf(a) | ((unsigned)f2bf(b) << 16); }
__device__ __forceinline__ float lo2f(unsigned p) { return __uint_as_float(p << 16); }
__device__ __forceinline__ float hi2f(unsigned p) { return __uint_as_float(p & 0xffff0000u); }
__device__ __forceinline__ float wave_sum(float v) {
#pragma unroll
    for (int o = 32; o > 0; o >>= 1) v += __shfl_xor(v, o);
    return v;
}
__device__ __forceinline__ float wave_max(float v) {
#pragma unroll
    for (int o = 32; o > 0; o >>= 1) v = fmaxf(v, __shfl_xor(v, o));
    return v;
}
__device__ __forceinline__ float silu_f(float v) { return v / (1.f + __expf(-v)); }
__device__ __forceinline__ float gelu_f(float a) { return 0.5f * a * (1.f + erff(a * 0.70710678118654752f)); }
__device__ __forceinline__ float logsigmoid_f(float z) { return z < 0.f ? z - log1pf(expf(z)) : -log1pf(expf(-z)); }

__device__ __forceinline__ void p0_mod(const Args& a, unsigned char* lds, int bi) {
    float* sc = (float*)lds;
    float* red = sc + 4 * 2048;
    const int tid = threadIdx.x, lane = tid & 63, wave = tid >> 6;
    for (int i = tid; i < 4 * 2048; i += NTHREADS) sc[i] = silu_f(a.c[i]);
    __syncthreads();
    const int j0 = bi * 256 + lane * 4;
    float acc[4][4];
#pragma unroll
    for (int b = 0; b < 4; ++b)
#pragma unroll
        for (int q = 0; q < 4; ++q) acc[b][q] = 0.f;
    const int k0 = wave * 256;
#pragma unroll 4
    for (int kk = 0; kk < 256; ++kk) {
        const int k = k0 + kk;
        const float4 w = *(const float4*)(a.w_ada + (size_t)k * 12288 + j0);
#pragma unroll
        for (int b = 0; b < 4; ++b) {
            const float s = sc[b * 2048 + k];
            acc[b][0] += s * w.x; acc[b][1] += s * w.y; acc[b][2] += s * w.z; acc[b][3] += s * w.w;
        }
    }
#pragma unroll
    for (int b = 0; b < 4; ++b)
#pragma unroll
        for (int q = 0; q < 4; ++q) red[(wave * 4 + b) * 256 + lane * 4 + q] = acc[b][q];
    __syncthreads();
    float* mod = (float*)(a.ws + WS_MOD);
    for (int i = tid; i < 4 * 256; i += NTHREADS) {
        const int b = i >> 8, jc = i & 255;
        float s = 0.f;
#pragma unroll
        for (int w = 0; w < 8; ++w) s += red[(w * 4 + b) * 256 + jc];
        mod[b * 12288 + bi * 256 + jc] = s + a.b_ada[bi * 256 + jc];
    }
    __syncthreads();
}

__device__ __forceinline__ void p0_transpose_item(const float* __restrict__ W, int ldw, int k0, int src_col0, int n_valid,
                                                  u16* __restrict__ WT, int ldt, int n_out0, unsigned char* lds) {
    u16* tl = (u16*)lds;
    const int tid = threadIdx.x;
    {
        const int k = tid >> 3, nc = (tid & 7) * 8;
        float v[8];
        if (nc < n_valid) {
            const float4 v0 = *(const float4*)(W + (size_t)(k0 + k) * ldw + src_col0 + nc);
            const float4 v1 = *(const float4*)(W + (size_t)(k0 + k) * ldw + src_col0 + nc + 4);
            v[0] = v0.x; v[1] = v0.y; v[2] = v0.z; v[3] = v0.w; v[4] = v1.x; v[5] = v1.y; v[6] = v1.z; v[7] = v1.w;
        } else {
#pragma unroll
            for (int i = 0; i < 8; ++i) v[i] = 0.f;
        }
#pragma unroll
        for (int i = 0; i < 8; ++i) tl[(nc + i) * 72 + k] = f2bf(v[i]);
    }
    __syncthreads();
    {
        const int n = tid >> 3, kc = (tid & 7) * 8;
        const uint4 v = *(const uint4*)(tl + n * 72 + kc);
        *(uint4*)(WT + (size_t)(n_out0 + n) * ldt + k0 + kc) = v;
    }
    __syncthreads();
}

__device__ __forceinline__ void phase0(const Args& a, unsigned char* lds) {
    const int bi = blockIdx.x, G = gridDim.x, tid = threadIdx.x;
    if (bi < 48) p0_mod(a, lds, bi);
    constexpr int I_IN = 32 * (NPAD / 64), I_SQ = 32 * 32;
    u16* WinT = (u16*)(a.ws + WS_WIN); u16* WoutT = (u16*)(a.ws + WS_WOUT); u16* WpqT = (u16*)(a.ws + WS_WPQ);
    for (int it = bi; it < I_IN + 2 * I_SQ; it += G) {
        if (it < I_IN) {
            const int kt = it & 31, nt = it >> 5;
            const int n0 = nt * 64;
            int src, nv;
            if (n0 < 3072) { src = n0; nv = 64; }
            else if (n0 < 6144) { src = n0 + 32; nv = 64; }
            else if (n0 == 6144) { src = 3072; nv = 32; }
            else { src = 0; nv = 0; }
            p0_transpose_item(a.w_in, INW, kt * 64, src, nv, WinT, D, n0, lds);
        } else if (it < I_IN + I_SQ) {
            const int r = it - I_IN; const int kt = r & 31, nt = r >> 5;
            p0_transpose_item(a.w_out, D, kt * 64, nt * 64, 64, WoutT, D, nt * 64, lds);
        } else {
            const int r = it - I_IN - I_SQ; const int kt = r & 31, nt = r >> 5;
            p0_transpose_item(a.w_pq, D, kt * 64, nt * 64, 64, WpqT, D, nt * 64, lds);
        }
    }
    float2* cs = (float2*)(a.ws + WS_CS);
    for (int i = bi * NTHREADS + tid; i < T * 64; i += G * NTHREADS) {
        const int t = i >> 6, f = i & 63;
        const float inv_freq = powf(10000.0f, -(float)f * 2.0f / 128.0f);
        const float ang = (float)a.pos[t] * inv_freq;
        const double rev = (double)ang * 0.15915494309189533577;
        const float fr = (float)(rev - floor(rev));
        cs[i] = make_float2(__builtin_amdgcn_cosf(fr), __builtin_amdgcn_sinf(fr));
    }
}

__device__ __forceinline__ void norm_mod_phase(const float* __restrict__ xin, const float* __restrict__ g, const float* __restrict__ mod,
                                               int sh_chunk, int sc_chunk, u16* __restrict__ outp) {
    const int lane = threadIdx.x & 63, wave = threadIdx.x >> 6;
    const int gw = blockIdx.x * NWAVES + wave, NGW = gridDim.x * NWAVES;
    for (int t = gw; t < T; t += NGW) {
        const int b = t / S;
        const float4* xr = (const float4*)(xin + (size_t)t * D);
        float4 v[8]; float ss = 0.f;
#pragma unroll
        for (int m = 0; m < 8; ++m) { v[m] = xr[lane + 64 * m]; ss += v[m].x * v[m].x + v[m].y * v[m].y + v[m].z * v[m].z + v[m].w * v[m].w; }
        ss = wave_sum(ss);
        const float rstd = rsqrtf(ss * (1.f / D) + NORM_EPS);
        const float4* gp = (const float4*)g;
        const float4* shp = (const float4*)(mod + b * 12288 + sh_chunk * 2048);
        const float4* scp = (const float4*)(mod + b * 12288 + sc_chunk * 2048);
        uint2* op = (uint2*)(outp + (size_t)t * D);
#pragma unroll
        for (int m = 0; m < 8; ++m) {
            const int i = lane + 64 * m;
            const float4 gg = gp[i], sh = shp[i], sc = scp[i];
            const float h0 = v[m].x * rstd * gg.x * (1.f + sc.x) + sh.x;
            const float h1 = v[m].y * rstd * gg.y * (1.f + sc.y) + sh.y;
            const float h2 = v[m].z * rstd * gg.z * (1.f + sc.z) + sh.z;
            const float h3 = v[m].w * rstd * gg.w * (1.f + sc.w) + sh.w;
            op[i] = make_uint2(pack2(h0, h1), pack2(h2, h3));
        }
    }
}

namespace pg8 {
#define PG8_LAS __attribute__((address_space(3)))
typedef unsigned short bf16_t;
typedef short bf16x8 __attribute__((ext_vector_type(8)));
typedef float f32x4 __attribute__((ext_vector_type(4)));
typedef unsigned u32x4 __attribute__((ext_vector_type(4)));
constexpr int BM = 256, BK = 64, HALF = 128, HTB = HALF * BK * 2  , STAGE_BYTES = 8 * HTB, NXCD = 8, WGM = 8;

__host__ __device__ __forceinline__ int lds_byte(int r, int c) { const int st = (r >> 4) * 2 + (c >> 5), rr = r & 15, cc = c & 31, ob = rr * 64 + cc * 2; return st * 1024 + (ob ^ (((ob >> 9) & 1) << 5)); }
__host__ __device__ __forceinline__ void stage_rc(int b, int& R, int& C) { const int st = b / 1024, sb = b % 1024, swz = sb ^ (((sb >> 9) & 1) << 5); R = (st >> 1) * 16 + swz / 64; C = (st & 1) * 32 + (swz % 64) / 2; }
__host__ __device__ __forceinline__ int perm32(int rho) { const int n = rho >> 4, i = rho & 15; return 8 * (i >> 2) + 4 * n + (i & 3); }

struct Unit { int pm, pn; };
struct Gemm { const bf16_t* A; const bf16_t* Bt; int M, N, K; };

struct StaticOrder {
    int nM, nN, nwg, G, c;
    __host__ __device__ void init(int M, int N, int G_, int c_) { nM = M / BM; nN = N / BM; nwg = nM * nN; G = G_; c = c_; }
    __host__ __device__ bool next(int i, Unit& u) const {
        const long L = (long)i * G + c; if (L >= nwg) return false;
        int wgid = (int)L; { const int q = nwg / NXCD, r = nwg % NXCD, xcd = wgid % NXCD, off = wgid / NXCD; wgid = (xcd < r ? xcd * (q + 1) : r * (q + 1) + (xcd - r) * q) + off; }
        const int nig = WGM * nN, gid = wgid / nig, fm = gid * WGM, gsz = (nM - fm) < WGM ? (nM - fm) : WGM;
        u.pm = fm + ((wgid % nig) % gsz); u.pn = (wgid % nig) / gsz; return true;
    }
    __device__ __forceinline__ void a_ready(const Unit&) const {}
    __device__ __forceinline__ void done(const Unit&) const {}
};
__device__ __forceinline__ unsigned cvt_pk_bf16(float lo, float hi) { unsigned r; asm volatile("v_cvt_pk_bf16_f32 %0, %1, %2" : "=v"(r) : "v"(lo), "v"(hi)); return r; }
typedef float f32x2 __attribute__((ext_vector_type(2)));
template <class Epi, class Sched, bool STAMP = false>
__device__ __forceinline__ void gemm_phase(PG8_LAS unsigned char* lds, const Gemm g, const Sched& S, const Epi& E, unsigned long long* stamps) {
    const int tid = threadIdx.x, wid = __builtin_amdgcn_readfirstlane(tid >> 6), lane = tid & 63, wr = wid >> 2, wc = wid & 3, fr = lane & 15, fq = lane >> 4;
    const int K = g.K, nt = K / BK;
    int ts_lo = 0, ts_hi = 0, nts = 0; const unsigned long long rt_entry = STAMP ? (unsigned long long)wall_clock64() : 0ull;
#define PG8_STAMP() do { if (STAMP && wid == 0 && nts < 64) { const unsigned long long _c = (unsigned long long)clock64(); \
        ts_lo = (lane == nts) ? (int)(unsigned)_c : ts_lo; ts_hi = (lane == nts) ? (int)(unsigned)(_c >> 32) : ts_hi; ++nts; } } while (0)
    PG8_STAMP();
    unsigned voffA[2], voffB[2];
#pragma unroll
    for (int i = 0; i < 2; ++i) { int R, C; stage_rc(tid * 16 + i * 8192, R, C); const int Rb = Epi::PERM ? ((R & ~31) + perm32(R & 31)) : R;
        voffA[i] = (unsigned)(R * K + C) * 2u; voffB[i] = (unsigned)(Rb * K + C) * 2u; }
    const size_t kstep = (size_t)(BK * 2);
    const size_t hstep = (size_t)HALF * K * 2;
    const size_t tstep = 2 * hstep;
    const unsigned ldsw = (unsigned)wid * 1024u;
    const int aoff = lds_byte(wr * 64 + fr, fq * 8), boff = lds_byte(wc * 32 + fr, fq * 8);
#define PG8_SA(b, h) (((b) * 2 + (h)) * HTB)
#define PG8_SB(b, h) ((4 + (b) * 2 + (h)) * HTB)
#define PG8_STAGE(bufoff, gbase, voff) do { _Pragma("unroll") for (int _i = 0; _i < 2; ++_i) \
        __builtin_amdgcn_global_load_lds((const unsigned*)((const char*)(gbase) + (voff)[_i]), (PG8_LAS unsigned*)(lds + (bufoff) + ldsw + _i * 8192), 16, 0, 0); } while (0)
#define PG8_LDA(dst, b, h) do { _Pragma("unroll") for (int m = 0; m < 4; ++m) _Pragma("unroll") for (int k = 0; k < 2; ++k) dst[m][k] = *(const PG8_LAS bf16x8*)(lds + PG8_SA(b, h) + aoff + m * 2048 + k * 1024); } while (0)
#define PG8_LDB(dst, b, h) do { _Pragma("unroll") for (int n = 0; n < 2; ++n) _Pragma("unroll") for (int k = 0; k < 2; ++k) dst[n][k] = *(const PG8_LAS bf16x8*)(lds + PG8_SB(b, h) + boff + n * 2048 + k * 1024); } while (0)
#define PG8_MMA(ai, bj, At, Bt) do { __builtin_amdgcn_s_setprio(1); _Pragma("unroll") for (int m = 0; m < 4; ++m) _Pragma("unroll") for (int n = 0; n < 2; ++n) _Pragma("unroll") for (int k = 0; k < 2; ++k) \
        acc[ai][bj][m][n] = __builtin_amdgcn_mfma_f32_16x16x32_bf16(Bt[n][k], At[m][k], acc[ai][bj][m][n], 0, 0, 0); __builtin_amdgcn_s_setprio(0); } while (0)
#define PG8_WAIT_V(n) asm volatile("s_waitcnt vmcnt(" #n ")" ::: "memory")
#define PG8_WAIT_L(n) asm volatile("s_waitcnt lgkmcnt(" #n ")" ::: "memory")
#define PG8_BAR __builtin_amdgcn_s_barrier()
#define PG8_SCHED __builtin_amdgcn_sched_barrier(0)
    Unit cur, nxt; int ui = 0;
    if (!S.next(0, cur)) return;
    f32x4 acc[2][2][4][2];
#pragma unroll
    for (int a = 0; a < 2; ++a)
#pragma unroll
        for (int b = 0; b < 2; ++b)
#pragma unroll
            for (int m = 0; m < 4; ++m)
#pragma unroll
                for (int n = 0; n < 2; ++n) acc[a][b][m][n] = (f32x4){0.f, 0.f, 0.f, 0.f};
    bf16x8 At[4][2], B0[2][2], B1[2][2];
    const char* cA = (const char*)g.A + (size_t)cur.pm * tstep; const char* cB = (const char*)g.Bt + (size_t)cur.pn * tstep;
    S.a_ready(cur);
    PG8_STAGE(PG8_SB(0, 0), cB, voffB); PG8_STAGE(PG8_SA(0, 0), cA, voffA); PG8_STAGE(PG8_SB(0, 1), cB + hstep, voffB); PG8_STAGE(PG8_SA(0, 1), cA + hstep, voffA);
    if (wr == 1) PG8_BAR;
    PG8_WAIT_V(4); PG8_BAR;
    PG8_STAGE(PG8_SB(1, 0), cB + kstep, voffB); PG8_STAGE(PG8_SA(1, 0), cA + kstep, voffA); PG8_STAGE(PG8_SB(1, 1), cB + hstep + kstep, voffB);
    PG8_WAIT_V(6); PG8_BAR;
    PG8_STAMP();
    for (;;) {
        const bool has_next = S.next(ui + 1, nxt);
        const char* nA = has_next ? (const char*)g.A + (size_t)nxt.pm * tstep : cA; const char* nB = has_next ? (const char*)g.Bt + (size_t)nxt.pn * tstep : cB;
        for (int t = 0; t < nt; t += 2) {
            const bool last = (t == nt - 2);
            const char* a1 = cA + (size_t)(t + 1) * kstep;
            const char* a2 = last ? nA : cA + (size_t)(t + 2) * kstep; const char* b2 = last ? nB : cB + (size_t)(t + 2) * kstep;
            const char* a3 = a2 + kstep; const char* b3 = b2 + kstep;
            if (last && has_next) S.a_ready(nxt);
            PG8_LDB(B0, 0, 0); PG8_SCHED; PG8_LDA(At, 0, 0); PG8_STAGE(PG8_SA(1, 1), a1 + hstep, voffA);
            PG8_WAIT_L(8); PG8_BAR; PG8_WAIT_L(0); PG8_MMA(0, 0, At, B0); PG8_BAR; PG8_SCHED;
            PG8_LDB(B1, 0, 1); PG8_STAGE(PG8_SB(0, 0), b2, voffB);
            PG8_BAR; PG8_WAIT_L(0); PG8_MMA(0, 1, At, B1); PG8_BAR;
            PG8_LDA(At, 0, 1); PG8_STAGE(PG8_SA(0, 0), a2, voffA);
            PG8_BAR; PG8_WAIT_L(0); PG8_MMA(1, 0, At, B0); PG8_BAR; PG8_SCHED;
            PG8_STAGE(PG8_SB(0, 1), b2 + hstep, voffB);
            PG8_WAIT_V(6); PG8_BAR; PG8_MMA(1, 1, At, B1); PG8_BAR;
            PG8_LDB(B0, 1, 0); PG8_SCHED; PG8_LDA(At, 1, 0); PG8_STAGE(PG8_SA(0, 1), a2 + hstep, voffA);
            PG8_WAIT_L(8); PG8_BAR; PG8_WAIT_L(0); PG8_MMA(0, 0, At, B0); PG8_BAR; PG8_SCHED;
            PG8_LDB(B1, 1, 1); PG8_STAGE(PG8_SB(1, 0), b3, voffB);
            PG8_BAR; PG8_WAIT_L(0); PG8_MMA(0, 1, At, B1); PG8_BAR;
            PG8_LDA(At, 1, 1); PG8_STAGE(PG8_SA(1, 0), a3, voffA);
            PG8_BAR; PG8_WAIT_L(0); PG8_MMA(1, 0, At, B0); PG8_BAR; PG8_SCHED;
            PG8_STAGE(PG8_SB(1, 1), b3 + hstep, voffB);
            PG8_WAIT_V(6); PG8_BAR; PG8_MMA(1, 1, At, B1); PG8_BAR;
        }
        PG8_STAMP();
        if constexpr (!Epi::AFTER_DRAIN) { E(acc, cur, wr, wc, fr, fq); S.done(cur); }
        PG8_STAMP();
        if (!has_next) break;
#pragma unroll
        for (int a = 0; a < 2; ++a)
#pragma unroll
            for (int b = 0; b < 2; ++b)
#pragma unroll
                for (int m = 0; m < 4; ++m)
#pragma unroll
                    for (int n = 0; n < 2; ++n) acc[a][b][m][n] = (f32x4){0.f, 0.f, 0.f, 0.f};
        cur = nxt; cA = nA; cB = nB; ++ui;
    }
    PG8_WAIT_V(0);
    if (wr == 0) PG8_BAR;
    PG8_BAR;
    if constexpr (Epi::AFTER_DRAIN) { E.fused(acc, cur, wr, wc, fr, fq, lds, wid, lane); S.done(cur); }
    PG8_STAMP();
    if (STAMP && wid == 0) { stamps[lane] = lane < nts ? (((unsigned long long)(unsigned)ts_hi << 32) | (unsigned)ts_lo) : 0ull;
        if (lane == 62) stamps[62] = rt_entry; if (lane == 63) stamps[63] = (unsigned long long)wall_clock64(); }
#undef PG8_STAMP
#undef PG8_SA
#undef PG8_SB
#undef PG8_STAGE
#undef PG8_LDA
#undef PG8_LDB
#undef PG8_MMA
#undef PG8_WAIT_V
#undef PG8_WAIT_L
#undef PG8_BAR
#undef PG8_SCHED
}
}

struct EpiProj {
    static constexpr bool PERM = true, AFTER_DRAIN = false;
    u16* P; float* gz;
    __device__ __forceinline__ void operator()(const pg8::f32x4 (&acc)[2][2][4][2], const pg8::Unit& u, int wr, int wc, int fr, int fq) const {
        const int row0 = u.pm * 256 + wr * 64 + fr;
        if (u.pn < 24) {
            const int col0 = u.pn * 256 + wc * 32 + 8 * fq;
#pragma unroll
            for (int ai = 0; ai < 2; ++ai)
#pragma unroll
                for (int m = 0; m < 4; ++m) { u16* rowp = P + (size_t)(row0 + ai * 128 + m * 16) * NP + col0;
#pragma unroll
                    for (int bj = 0; bj < 2; ++bj) { const pg8::f32x4 v0 = acc[ai][bj][m][0], v1 = acc[ai][bj][m][1];
                        pg8::u32x4 w; w.x = pg8::cvt_pk_bf16(v0[0], v0[1]); w.y = pg8::cvt_pk_bf16(v0[2], v0[3]); w.z = pg8::cvt_pk_bf16(v1[0], v1[1]); w.w = pg8::cvt_pk_bf16(v1[2], v1[3]);
                        *(pg8::u32x4*)(rowp + bj * 128) = w; } }
        } else if (wc == 0) {
#pragma unroll
            for (int ai = 0; ai < 2; ++ai)
#pragma unroll
                for (int m = 0; m < 4; ++m) { float* rowp = gz + (size_t)(row0 + ai * 128 + m * 16) * 32 + 8 * fq;
                    *(pg8::f32x4*)(rowp) = acc[ai][0][m][0]; *(pg8::f32x4*)(rowp + 4) = acc[ai][0][m][1]; }
        }
    }
};
struct EpiResid {
    static constexpr bool PERM = false, AFTER_DRAIN = false;
    const float* x; const float* mod; float* x1;
    __device__ __forceinline__ void operator()(const pg8::f32x4 (&acc)[2][2][4][2], const pg8::Unit& u, int wr, int wc, int fr, int fq) const {
        const int row0 = u.pm * 256 + wr * 64 + fr, col0 = u.pn * 256 + wc * 32 + 4 * fq;
        const int b = (u.pm * 256) / S;
        pg8::f32x4 ga[2][2];
#pragma unroll
        for (int bj = 0; bj < 2; ++bj)
#pragma unroll
            for (int n = 0; n < 2; ++n) ga[bj][n] = *(const pg8::f32x4*)(mod + b * 12288 + 2 * 2048 + col0 + bj * 128 + n * 16);
#pragma unroll
        for (int ai = 0; ai < 2; ++ai)
#pragma unroll
            for (int m = 0; m < 4; ++m) { const size_t off = (size_t)(row0 + ai * 128 + m * 16) * D + col0;
#pragma unroll
                for (int bj = 0; bj < 2; ++bj)
#pragma unroll
                    for (int n = 0; n < 2; ++n) { const pg8::f32x4 xv = *(const pg8::f32x4*)(x + off + bj * 128 + n * 16);
                        *(pg8::f32x4*)(x1 + off + bj * 128 + n * 16) = xv + ga[bj][n] * acc[ai][bj][m][n]; } }
    }
};
struct EpiBf16 {
    static constexpr bool PERM = true, AFTER_DRAIN = false;
    u16* Q;
    __device__ __forceinline__ void operator()(const pg8::f32x4 (&acc)[2][2][4][2], const pg8::Unit& u, int wr, int wc, int fr, int fq) const {
        const int row0 = u.pm * 256 + wr * 64 + fr, col0 = u.pn * 256 + wc * 32 + 8 * fq;
#pragma unroll
        for (int ai = 0; ai < 2; ++ai)
#pragma unroll
            for (int m = 0; m < 4; ++m) { u16* rowp = Q + (size_t)(row0 + ai * 128 + m * 16) * D + col0;
#pragma unroll
                for (int bj = 0; bj < 2; ++bj) { const pg8::f32x4 v0 = acc[ai][bj][m][0], v1 = acc[ai][bj][m][1];
                    pg8::u32x4 w; w.x = pg8::cvt_pk_bf16(v0[0], v0[1]); w.y = pg8::cvt_pk_bf16(v0[2], v0[3]); w.z = pg8::cvt_pk_bf16(v1[0], v1[1]); w.w = pg8::cvt_pk_bf16(v1[2], v1[3]);
                    *(pg8::u32x4*)(rowp + bj * 128) = w; } }
    }
};
template <class Epi>
__device__ __forceinline__ void gemm8(unsigned char* lds, const u16* A, const u16* Bt, int M, int N, int K, const Epi& E) {
    pg8::Gemm g{A, Bt, M, N, K}; pg8::StaticOrder So; So.init(M, N, (int)gridDim.x, (int)blockIdx.x);
    pg8::gemm_phase<Epi, pg8::StaticOrder, false>((PG8_LAS unsigned char*)lds, g, So, E, nullptr);
    __syncthreads();
}

#define GLA_QD_BYTES 16384
#define GLA_AT_BYTES 8192
__device__ __forceinline__ float gla_logsigmoid(float z) { return z < 0.f ? z - log1pf(expf(z)) : -log1pf(expf(-z)); }

__device__ __forceinline__ void gla_prep_item(const u16* __restrict__ P, int ldp, int cq, int ck, const float* __restrict__ gz,
                                              const float* __restrict__ wg_f, const float* __restrict__ bg_f, const float* __restrict__ wg_b, const float* __restrict__ bg_b,
                                              int Sq, unsigned char* __restrict__ QDg, unsigned char* __restrict__ KEg, unsigned char* __restrict__ ATg, float* __restrict__ DECg,
                                              unsigned char* lds, int item) {
    const int nch = Sq / 64;
    const int c = item % nch, dir = (item / nch) & 1, hh = (item / (nch * 2)) & 3, b = item / (nch * 8);
    const int tid = TID, lane = tid & 63, wave = tid >> 6, li = lane & 15, fq = lane >> 4;
    float* gzs = (float*)lds;
    float* segs = gzs + 64 * 16;
    unsigned char* QDs = lds + 8192;
    unsigned char* KIs = QDs + 16384;
    unsigned char* KEs = KIs + 16384;
    const size_t tok0 = (size_t)b * Sq;
    __syncthreads();
    for (int e = tid; e < 64 * 16; e += 512) {
        const int i = e >> 4, r = e & 15;
        const int s = dir ? (Sq - 1 - (64 * c + i)) : (64 * c + i);
        gzs[e] = gz[(tok0 + s) * 32 + dir * 16 + r];
    }
    const int d = tid & 127, seg = tid >> 7;
    const float* wg = dir ? wg_b : wg_f;
    float wcol[16];
#pragma unroll
    for (int r = 0; r < 16; ++r) wcol[r] = wg[r * 512 + hh * 128 + d];
    const float bias = (dir ? bg_b : bg_f)[hh * 128 + d];
    __syncthreads();
    float pre[16]; float run = 0.f;
#pragma unroll
    for (int k = 0; k < 16; ++k) {
        const int i = 16 * seg + k;
        float z = bias;
#pragma unroll
        for (int r = 0; r < 16; ++r) z += gzs[i * 16 + r] * wcol[r];
        run += gla_logsigmoid(z) * (1.f / 16.f);
        pre[k] = run;
    }
    segs[seg * 128 + d] = run;
    __syncthreads();
    float off = 0.f, tot = 0.f;
#pragma unroll
    for (int s2 = 0; s2 < 4; ++s2) { const float v = segs[s2 * 128 + d]; tot += v; off += (s2 < seg) ? v : 0.f; }
    const float qscale = 0.08838834764831845f;
#pragma unroll
    for (int k = 0; k < 16; ++k) {
        const int i = 16 * seg + k;
        const int s = dir ? (Sq - 1 - (64 * c + i)) : (64 * c + i);
        const float bb = off + pre[k];
        const float q = bf2f(P[(tok0 + s) * ldp + cq + hh * 128 + d]), kx = bf2f(P[(tok0 + s) * ldp + ck + hh * 128 + d]);
        const int o = i * 256 + ((((d >> 3) ^ (i & 15)) << 4) | ((d & 7) << 1));
        *(u16*)(QDs + o) = f2bf(q * qscale * __expf(bb));
        *(u16*)(KIs + o) = f2bf(kx * __expf(-bb));
        *(u16*)(KEs + o) = f2bf(kx * __expf(tot - bb));
    }
    if (seg == 0) DECg[(size_t)item * 128 + d] = __expf(tot);
    __syncthreads();
    {
        uint4* qo = (uint4*)(QDg + (size_t)item * GLA_QD_BYTES); uint4* ko = (uint4*)(KEg + (size_t)item * GLA_QD_BYTES);
#pragma unroll
        for (int k = 0; k < 2; ++k) { const int e = tid + 512 * k; qo[e] = ((const uint4*)QDs)[e]; ko[e] = ((const uint4*)KEs)[e]; }
    }
#pragma unroll
    for (int tt = 0; tt < 2; ++tt) {
        const int tile = wave + 8 * tt, jt = tile >> 2, it = tile & 3;
        f32x4 acc = (f32x4){0.f, 0.f, 0.f, 0.f};
        if (jt <= it) {
            const int jr = 16 * jt + li, ir = 16 * it + li;
#pragma unroll
            for (int ks = 0; ks < 4; ++ks) {
                const bf16x8 kf = *(const bf16x8*)(KIs + jr * 256 + (((4 * ks + fq) ^ (jr & 15)) << 4));
                const bf16x8 qf = *(const bf16x8*)(QDs + ir * 256 + (((4 * ks + fq) ^ (ir & 15)) << 4));
                acc = __builtin_amdgcn_mfma_f32_16x16x32_bf16(kf, qf, acc, 0, 0, 0);
            }
        }
        const int i = 16 * it + li, j0 = 16 * jt + 4 * fq;
        float v[4];
#pragma unroll
        for (int jj = 0; jj < 4; ++jj) v[jj] = (j0 + jj <= i) ? acc[jj] : 0.f;
        const int chunk = 2 * jt + (fq >> 1), sub = (fq & 1) * 8;
        *(uint2*)(ATg + (size_t)item * GLA_AT_BYTES + i * 128 + ((chunk ^ (i & 7)) << 4) + sub) = make_uint2(pack2(v[0], v[1]), pack2(v[2], v[3]));
    }
}

__device__ __forceinline__ void gla_seq_item(const u16* __restrict__ P, int ldp, int cv, int Sq,
                                             const unsigned char* __restrict__ QDg, const unsigned char* __restrict__ KEg, const unsigned char* __restrict__ ATg, const float* __restrict__ DECg,
                                             u16* __restrict__ Oout  , int Ttot, unsigned char* lds, int item) {
    const int slice = item & 1, dir = (item >> 1) & 1, hh = (item >> 2) & 3, b = item >> 4;
    const int nch = Sq / 64;
    const int tid = TID, lane = tid & 63, wave = tid >> 6, li = lane & 15, fq = lane >> 4;
    const size_t tok0 = (size_t)b * Sq;
    const int pitem0 = ((b * 4 + hh) * 2 + dir) * nch;
    constexpr int BUF = 16384 * 3 + 8192 + 512;
    typedef unsigned gla_u32x4 __attribute__((ext_vector_type(4)));
    gla_u32x4 rq0, rq1, rk0, rk1, rv0, rv1, ra; float rd = 0.f;
#define GLA_VROW(c_, k_) ((tok0 + (size_t)(dir ? (Sq - 1 - (64 * (c_) + ((tid + 512 * (k_)) >> 4))) : (64 * (c_) + ((tid + 512 * (k_)) >> 4)))) * ldp + cv + hh * 256 + slice * 128 + ((tid + 512 * (k_)) & 15) * 8)
#define GLA_ISSUE(c_) do { \
        const gla_u32x4* qsrc_ = (const gla_u32x4*)(QDg + (size_t)(pitem0 + (c_)) * GLA_QD_BYTES); const gla_u32x4* ksrc_ = (const gla_u32x4*)(KEg + (size_t)(pitem0 + (c_)) * GLA_QD_BYTES); \
        rq0 = qsrc_[tid]; rq1 = qsrc_[tid + 512]; rk0 = ksrc_[tid]; rk1 = ksrc_[tid + 512]; \
        ra = ((const gla_u32x4*)(ATg + (size_t)(pitem0 + (c_)) * GLA_AT_BYTES))[tid]; \
        rv0 = *(const gla_u32x4*)(P + GLA_VROW(c_, 0)); rv1 = *(const gla_u32x4*)(P + GLA_VROW(c_, 1)); \
        if (tid < 128) rd = DECg[(size_t)(pitem0 + (c_)) * 128 + tid]; } while (0)
#define GLA_COMMIT(buf_) do { \
        unsigned char* base_ = lds + (buf_) * BUF; \
        ((gla_u32x4*)base_)[tid] = rq0; ((gla_u32x4*)base_)[tid + 512] = rq1; ((gla_u32x4*)(base_ + 16384))[tid] = rk0; ((gla_u32x4*)(base_ + 16384))[tid + 512] = rk1; \
        { const int row_ = tid >> 4, ch_ = tid & 15; *(gla_u32x4*)(base_ + 32768 + row_ * 256 + ((ch_ ^ (row_ & 15)) << 4)) = rv0; } \
        { const int row_ = (tid + 512) >> 4, ch_ = tid & 15; *(gla_u32x4*)(base_ + 32768 + row_ * 256 + ((ch_ ^ (row_ & 15)) << 4)) = rv1; } \
        ((gla_u32x4*)(base_ + 49152))[tid] = ra; \
        if (tid < 128) ((float*)(base_ + 57344))[tid] = rd; } while (0)
    f32x4 st[8];
#pragma unroll
    for (int dt = 0; dt < 8; ++dt) st[dt] = (f32x4){0.f, 0.f, 0.f, 0.f};
    __syncthreads();
    GLA_ISSUE(0); GLA_COMMIT(0);
    __syncthreads();
#pragma unroll 1
    for (int c = 0; c < nch; ++c) {
        const int buf = c & 1;
        if (c + 1 < nch) GLA_ISSUE(c + 1);
        const unsigned char* QDs = lds + buf * BUF; const unsigned char* KEs = QDs + 16384; const unsigned char* Vs = QDs + 32768;
        const unsigned char* ATs = QDs + 49152; const float* DECs = (const float*)(QDs + 57344);
        bf16x8 vf[2];
#pragma unroll
        for (int jp = 0; jp < 2; ++jp) {
            const int rowA = 32 * jp + 8 * fq + (li >> 2), rowB = rowA + 4;
            const int chunk = 2 * wave + ((li & 3) >> 1), sub = ((li & 3) & 1) * 8;
            const s16x4 va = __builtin_amdgcn_ds_read_tr16_b64_v4i16((LAS s16x4*)(Vs + rowA * 256 + ((chunk ^ (rowA & 15)) << 4) + sub));
            const s16x4 vb = __builtin_amdgcn_ds_read_tr16_b64_v4i16((LAS s16x4*)(Vs + rowB * 256 + ((chunk ^ (rowB & 15)) << 4) + sub));
            vf[jp][0] = va[0]; vf[jp][1] = va[1]; vf[jp][2] = va[2]; vf[jp][3] = va[3]; vf[jp][4] = vb[0]; vf[jp][5] = vb[1]; vf[jp][6] = vb[2]; vf[jp][7] = vb[3];
        }
        bf16x8 sf[4];
#pragma unroll
        for (int dp = 0; dp < 4; ++dp)
#pragma unroll
            for (int jj = 0; jj < 4; ++jj) { sf[dp][jj] = (short)f2bf(st[2 * dp][jj]); sf[dp][4 + jj] = (short)f2bf(st[2 * dp + 1][jj]); }
        f32x4 ot[4];
#pragma unroll
        for (int it = 0; it < 4; ++it) {
            f32x4 acc = (f32x4){0.f, 0.f, 0.f, 0.f};
            const int ir = 16 * it + li;
#pragma unroll
            for (int dp = 0; dp < 4; ++dp) {
                const int c0 = 4 * dp + (fq >> 1), c1 = c0 + 2, sub = (fq & 1) * 8;
                const uint2 lo = *(const uint2*)(QDs + ir * 256 + ((c0 ^ (ir & 15)) << 4) + sub);
                const uint2 hi = *(const uint2*)(QDs + ir * 256 + ((c1 ^ (ir & 15)) << 4) + sub);
                bf16x8 qf;
                qf[0] = (short)(lo.x & 0xffff); qf[1] = (short)(lo.x >> 16); qf[2] = (short)(lo.y & 0xffff); qf[3] = (short)(lo.y >> 16);
                qf[4] = (short)(hi.x & 0xffff); qf[5] = (short)(hi.x >> 16); qf[6] = (short)(hi.y & 0xffff); qf[7] = (short)(hi.y >> 16);
                acc = __builtin_amdgcn_mfma_f32_16x16x32_bf16(sf[dp], qf, acc, 0, 0, 0);
            }
#pragma unroll
            for (int jp = 0; jp < 2; ++jp) {
                if (32 * jp <= 16 * it + 15) {
                    const bf16x8 af = *(const bf16x8*)(ATs + ir * 128 + (((4 * jp + fq) ^ (ir & 7)) << 4));
                    acc = __builtin_amdgcn_mfma_f32_16x16x32_bf16(vf[jp], af, acc, 0, 0, 0);
                }
            }
            ot[it] = acc;
        }
#pragma unroll
        for (int dt = 0; dt < 8; ++dt) {
            const f32x4 dec = *(const f32x4*)(DECs + 16 * dt + 4 * fq);
            f32x4 acc = st[dt] * dec;
#pragma unroll
            for (int jp = 0; jp < 2; ++jp) {
                const int rowA = 32 * jp + 8 * fq + (li >> 2), rowB = rowA + 4;
                const int chunk = 2 * dt + ((li & 3) >> 1), sub = ((li & 3) & 1) * 8;
                const s16x4 ka = __builtin_amdgcn_ds_read_tr16_b64_v4i16((LAS s16x4*)(KEs + rowA * 256 + ((chunk ^ (rowA & 15)) << 4) + sub));
                const s16x4 kb = __builtin_amdgcn_ds_read_tr16_b64_v4i16((LAS s16x4*)(KEs + rowB * 256 + ((chunk ^ (rowB & 15)) << 4) + sub));
                bf16x8 kf;
                kf[0] = ka[0]; kf[1] = ka[1]; kf[2] = ka[2]; kf[3] = ka[3]; kf[4] = kb[0]; kf[5] = kb[1]; kf[6] = kb[2]; kf[7] = kb[3];
                acc = __builtin_amdgcn_mfma_f32_16x16x32_bf16(kf, vf[jp], acc, 0, 0, 0);
            }
            st[dt] = acc;
        }
#pragma unroll
        for (int it = 0; it < 4; ++it) {
            const int i = 16 * it + li;
            const int s = dir ? (Sq - 1 - (64 * c + i)) : (64 * c + i);
            *(uint2*)(Oout + ((size_t)dir * Ttot + tok0 + s) * 1024 + hh * 256 + slice * 128 + 16 * wave + 4 * fq) =
                make_uint2(pack2(ot[it][0], ot[it][1]), pack2(ot[it][2], ot[it][3]));
        }
        if (c + 1 < nch) GLA_COMMIT(buf ^ 1);
        __syncthreads();
    }
}
__device__ __forceinline__ void phase_rope_prep(const Args& a, unsigned char* lds) {
    u16* P = (u16*)(a.ws + WS_P);
    const float2* cs = (const float2*)(a.ws + WS_CS);
    const int gt = blockIdx.x * NTHREADS + threadIdx.x, NT = gridDim.x * NTHREADS;
    for (int i = gt; i < T * 2 * 8 * 64; i += NT) {
        const int f = i & 63, hh = (i >> 6) & 7, which = (i >> 9) & 1, t = i >> 10;
        const float2 c = cs[t * 64 + f];
        u16* p = P + (size_t)t * NP + (which ? C_DK : C_DQ) + hh * 128 + f;
        const float t1 = bf2f(p[0]), t2 = bf2f(p[64]);
        p[0] = f2bf(t1 * c.x - t2 * c.y);
        p[64] = f2bf(t1 * c.y + t2 * c.x);
    }
    for (int item = blockIdx.x; item < GLA_NPREP; item += gridDim.x)
        gla_prep_item(P, NP, C_GQ, C_GK, (const float*)(a.ws + WS_GZ), a.wgf, a.bgf, a.wgb, a.bgb, S,
                      a.ws + WS_QD, a.ws + WS_KE, a.ws + WS_AT, (float*)(a.ws + WS_DEC), lds, item);
}

__device__ __forceinline__ void attn_item(const u16* __restrict__ P, int ldp, int cq, int ck, int cv, int Sq,
                                          u16* __restrict__ part_o, float* __restrict__ part_lse, int Ttot,
                                          unsigned char* lds, int item) {
    const int tid = TID, lane = tid & 63, wave = tid >> 6, li = lane & 15, fq = lane >> 4;
    const int nb_per = Sq / 128;
    const int within = item % nb_per, hh = (item / nb_per) & 7, b = (item / (nb_per * 8)) & 3, pat = item / (nb_per * 32);
    const int dil = pat == 0 ? 1 : (pat == 1 ? 4 : 16);
    const int M = Sq / dil;
    const int r = within % dil, blk = within / dil;
    const int p0 = blk * 128, kbase = p0 - 64;
    unsigned char* Ks = lds;
    unsigned char* Vs = lds + 65536;
    const size_t tok0 = (size_t)b * Sq;
    __syncthreads();
#pragma unroll
    for (int i = 0; i < 8; ++i) {
        const int id = tid + 512 * i, row = id >> 4, c = id & 15;
        int kp = kbase + row; kp = kp < 0 ? 0 : (kp > M - 1 ? M - 1 : kp);
        const size_t t = tok0 + r + (size_t)dil * kp;
        const uint4 kv = *(const uint4*)(P + t * ldp + ck + hh * 128 + c * 8);
        const uint4 vv = *(const uint4*)(P + t * ldp + cv + hh * 128 + c * 8);
        const int off = row * 256 + ((c ^ (row & 15)) << 4);
        *(uint4*)(Ks + off) = kv;
        *(uint4*)(Vs + off) = vv;
    }
    const int qp = p0 + 16 * wave + li;
    const size_t tq = tok0 + r + (size_t)dil * qp;
    bf16x8 qf[4];
#pragma unroll
    for (int ks = 0; ks < 4; ++ks) qf[ks] = *(const bf16x8*)(P + tq * ldp + cq + hh * 128 + 32 * ks + 8 * fq);
    __syncthreads();
    const float scale = 0.08838834764831845f;
    float m = -1e30f, l = 0.f;
    f32x4 o[8];
#pragma unroll
    for (int dt = 0; dt < 8; ++dt) o[dt] = (f32x4){0.f, 0.f, 0.f, 0.f};
#pragma unroll 1
    for (int tp = 0; tp < 5; ++tp) {
        float s[8]; bool ok[8];
#pragma unroll
        for (int h2 = 0; h2 < 2; ++h2) {
            const int kk0 = 16 * wave + 16 * (2 * tp + h2);
            int krow = kk0 + li; krow = krow > 255 ? 255 : krow;
            f32x4 acc = (f32x4){0.f, 0.f, 0.f, 0.f};
#pragma unroll
            for (int ks = 0; ks < 4; ++ks) {
                const bf16x8 kf = *(const bf16x8*)(Ks + krow * 256 + (((4 * ks + fq) ^ (krow & 15)) << 4));
                acc = __builtin_amdgcn_mfma_f32_16x16x32_bf16(kf, qf[ks], acc, 0, 0, 0);
            }
#pragma unroll
            for (int j = 0; j < 4; ++j) {
                const int kp = kbase + kk0 + 4 * fq + j;
                const int rel = kp - qp;
                ok[4 * h2 + j] = (kp >= 0) && (kp < M) && (rel <= 64) && (rel >= -64);
                s[4 * h2 + j] = acc[j] * scale;
            }
        }
        float mx = -1e30f;
#pragma unroll
        for (int j = 0; j < 8; ++j) mx = ok[j] ? fmaxf(mx, s[j]) : mx;
        mx = fmaxf(mx, __shfl_xor(mx, 16));
        mx = fmaxf(mx, __shfl_xor(mx, 32));
        const float mn = fmaxf(m, mx);
        const float al = __expf(m - mn);
        float ps = 0.f; float p[8];
#pragma unroll
        for (int j = 0; j < 8; ++j) { p[j] = ok[j] ? __expf(s[j] - mn) : 0.f; ps += p[j]; }
        l = l * al + ps; m = mn;
        bf16x8 pf;
#pragma unroll
        for (int j = 0; j < 8; ++j) pf[j] = (short)f2bf(p[j]);
#pragma unroll
        for (int dt = 0; dt < 8; ++dt) o[dt] *= al;
        int rowA = 16 * wave + 32 * tp + 4 * fq + (li >> 2); rowA = rowA > 255 ? 255 : rowA;
        int rowB = 16 * wave + 32 * tp + 16 + 4 * fq + (li >> 2); rowB = rowB > 255 ? 255 : rowB;
#pragma unroll
        for (int dt = 0; dt < 8; ++dt) {
            const int chunk = 2 * dt + ((li & 3) >> 1), sub = ((li & 3) & 1) * 8;
            const s16x4 va = __builtin_amdgcn_ds_read_tr16_b64_v4i16((LAS s16x4*)(Vs + rowA * 256 + ((chunk ^ (rowA & 15)) << 4) + sub));
            const s16x4 vb = __builtin_amdgcn_ds_read_tr16_b64_v4i16((LAS s16x4*)(Vs + rowB * 256 + ((chunk ^ (rowB & 15)) << 4) + sub));
            bf16x8 vf;
            vf[0] = va[0]; vf[1] = va[1]; vf[2] = va[2]; vf[3] = va[3]; vf[4] = vb[0]; vf[5] = vb[1]; vf[6] = vb[2]; vf[7] = vb[3];
            o[dt] = __builtin_amdgcn_mfma_f32_16x16x32_bf16(vf, pf, o[dt], 0, 0, 0);
        }
    }
    l += __shfl_xor(l, 16);
    l += __shfl_xor(l, 32);
    const float inv = 1.f / l;
    u16* orow = part_o + ((size_t)pat * Ttot + tq) * 1024 + hh * 128 + 4 * fq;
#pragma unroll
    for (int dt = 0; dt < 8; ++dt)
        *(uint2*)(orow + 16 * dt) = make_uint2(pack2(o[dt][0] * inv, o[dt][1] * inv), pack2(o[dt][2] * inv, o[dt][3] * inv));
    if (fq == 0) part_lse[((size_t)pat * Ttot + tq) * 8 + hh] = m + logf(l);
}

__device__ __forceinline__ void attn_merge_token(const u16* __restrict__ part_o, const float* __restrict__ part_lse, int Ttot, size_t t,
                                                 u16* __restrict__ dst  , int lane) {
    const int hh = lane >> 3;
    const float l0 = part_lse[((size_t)0 * Ttot + t) * 8 + hh], l1 = part_lse[((size_t)1 * Ttot + t) * 8 + hh], l2 = part_lse[((size_t)2 * Ttot + t) * 8 + hh];
    const float mx = fmaxf(l0, fmaxf(l1, l2));
    const float e0 = __expf(l0 - mx), e1 = __expf(l1 - mx), e2 = __expf(l2 - mx);
    const float inv = 1.f / (e0 + e1 + e2);
    const float w[3] = {e0 * inv, e1 * inv, e2 * inv};
    float acc[16];
#pragma unroll
    for (int i = 0; i < 16; ++i) acc[i] = 0.f;
#pragma unroll
    for (int p = 0; p < 3; ++p) {
        const uint4* src = (const uint4*)(part_o + ((size_t)p * Ttot + t) * 1024 + lane * 16);
        const uint4 a = src[0], bb = src[1];
        acc[0] += w[p] * lo2f(a.x); acc[1] += w[p] * hi2f(a.x); acc[2] += w[p] * lo2f(a.y); acc[3] += w[p] * hi2f(a.y);
        acc[4] += w[p] * lo2f(a.z); acc[5] += w[p] * hi2f(a.z); acc[6] += w[p] * lo2f(a.w); acc[7] += w[p] * hi2f(a.w);
        acc[8] += w[p] * lo2f(bb.x); acc[9] += w[p] * hi2f(bb.x); acc[10] += w[p] * lo2f(bb.y); acc[11] += w[p] * hi2f(bb.y);
        acc[12] += w[p] * lo2f(bb.z); acc[13] += w[p] * hi2f(bb.z); acc[14] += w[p] * lo2f(bb.w); acc[15] += w[p] * hi2f(bb.w);
    }
    uint4* d = (uint4*)(dst + lane * 16);
    d[0] = make_uint4(pack2(acc[0], acc[1]), pack2(acc[2], acc[3]), pack2(acc[4], acc[5]), pack2(acc[6], acc[7]));
    d[1] = make_uint4(pack2(acc[8], acc[9]), pack2(acc[10], acc[11]), pack2(acc[12], acc[13]), pack2(acc[14], acc[15]));
}

__device__ __forceinline__ void phase_mixers(const Args& a, unsigned char* lds) {
    const int bi = blockIdx.x, G = gridDim.x;
    if (bi < 64) {
        gla_seq_item((const u16*)(a.ws + WS_P), NP, C_GV, S, a.ws + WS_QD, a.ws + WS_KE, a.ws + WS_AT, (const float*)(a.ws + WS_DEC),
                     (u16*)(a.ws + WS_OFB), T, lds, bi);
    } else {
        u16* part_o = (u16*)a.out; float* part_lse = (float*)((unsigned char*)a.out + (size_t)3 * T * 1024 * 2);
        for (int item = bi - 64; item < 3 * 4 * 8 * (S / 128); item += G - 64)
            attn_item((const u16*)(a.ws + WS_P), NP, C_DQ, C_DK, C_DV, S, part_o, part_lse, T, lds, item);
    }
}

__device__ __forceinline__ void phase_gla_fin(const Args& a) {
    const u16* Of = (const u16*)(a.ws + WS_OFB);
    const u16* Ob = Of + (size_t)T * 1024;
    const u16* P = (const u16*)(a.ws + WS_P);
    u16* A2 = (u16*)(a.ws + WS_ACT);
    const int lane = threadIdx.x & 63, wave = threadIdx.x >> 6;
    const int gw = blockIdx.x * NWAVES + wave, NGW = gridDim.x * NWAVES;
    for (int item = gw; item < T * 4; item += NGW) {
        const int hh = item & 3, t = item >> 2;
        const size_t base = (size_t)t * 1024 + hh * 256 + lane * 4;
        const uint2 f = *(const uint2*)(Of + base), bb = *(const uint2*)(Ob + base);
        const float o0 = lo2f(f.x) + lo2f(bb.x), o1 = hi2f(f.x) + hi2f(bb.x), o2 = lo2f(f.y) + lo2f(bb.y), o3 = hi2f(f.y) + hi2f(bb.y);
        const float ss = wave_sum(o0 * o0 + o1 * o1 + o2 * o2 + o3 * o3);
        const float rstd = rsqrtf(ss * (1.f / 256.f) + NORM_EPS);
        const float4 gg = *(const float4*)(a.g_gla + hh * 256 + lane * 4);
        const uint2 rp = *(const uint2*)(P + (size_t)t * NP + C_GR + hh * 256 + lane * 4);
        const float r0 = lo2f(rp.x), r1 = hi2f(rp.x), r2 = lo2f(rp.y), r3 = hi2f(rp.y);
        const float y0 = o0 * rstd * gg.x * silu_f(r0), y1 = o1 * rstd * gg.y * silu_f(r1);
        const float y2 = o2 * rstd * gg.z * silu_f(r2), y3 = o3 * rstd * gg.w * silu_f(r3);
        *(uint2*)(A2 + (size_t)t * D + hh * 256 + lane * 4) = make_uint2(pack2(y0, y1), pack2(y2, y3));
    }
    const u16* part_o = (const u16*)a.out; const float* part_lse = (const float*)((const unsigned char*)a.out + (size_t)3 * T * 1024 * 2);
    for (int t = gw; t < T; t += NGW) attn_merge_token(part_o, part_lse, T, (size_t)t, A2 + (size_t)t * D + 1024, lane);
}

typedef float f32x16 __attribute__((ext_vector_type(16)));
#define RT_CE(a_, b_) do { const float hi_ = fmaxf(a_, b_), lo_ = fminf(a_, b_); a_ = hi_; b_ = lo_; } while (0)
template <int N> __device__ __forceinline__ void rt_sort_desc(float (&v)[N], int base) {
#pragma unroll
    for (int k = 2; k <= 16; k <<= 1)
#pragma unroll
        for (int j = k >> 1; j > 0; j >>= 1)
#pragma unroll
            for (int i = 0; i < 16; ++i) {
                const int l = i ^ j;
                if (l > i) { if ((i & k) == 0) RT_CE(v[base + i], v[base + l]); else RT_CE(v[base + l], v[base + i]); }
            }
}
template <int N> __device__ __forceinline__ void rt_merge_desc(float (&v)[N], int a, int b) {
#pragma unroll
    for (int i = 0; i < 16; ++i) v[a + i] = fmaxf(v[a + i], v[b + 15 - i]);
#pragma unroll
    for (int j = 8; j > 0; j >>= 1)
#pragma unroll
        for (int i = 0; i < 16; ++i) { const int l = i ^ j; if (l > i) RT_CE(v[a + i], v[a + l]); }
}

__device__ __forceinline__ void route_stage_keys(const float* __restrict__ subk, int hh, unsigned char* lds) {
    const int tid = TID;
    __syncthreads();
    for (int e = tid; e < 2 * 128 * 16; e += 512) {
        const int c = e & 15, row = e >> 4;
        const float* src = subk + ((size_t)(hh * 2) * 128 + row) * 128 + c * 8;
        const float4 v0 = *(const float4*)src, v1 = *(const float4*)(src + 4);
        *(uint4*)(lds + row * 256 + ((c ^ (row & 15)) << 4)) = make_uint4(pack2(v0.x, v0.y), pack2(v0.z, v0.w), pack2(v1.x, v1.y), pack2(v1.z, v1.w));
    }
    __syncthreads();
}

__device__ __forceinline__ void route_tile(const u16* __restrict__ Q, int ldq, int hh, int tok_base, const unsigned char* lds,
                                           int* __restrict__ IDX, float* __restrict__ GATE) {
    const int lane = TID & 63, r = lane & 31, h = lane >> 5;
    float sc[128];
    {
        f32x16 X[4], Y[4];
#pragma unroll
        for (int kt = 0; kt < 4; ++kt) {
#pragma unroll
            for (int i = 0; i < 16; ++i) { X[kt][i] = 0.f; Y[kt][i] = 0.f; }
        }
        const u16* qrow = Q + (size_t)(tok_base + r) * ldq + hh * 256;
#pragma unroll
        for (int half = 0; half < 2; ++half) {
            bf16x8 qf[8];
#pragma unroll
            for (int ks = 0; ks < 8; ++ks) qf[ks] = *(const bf16x8*)(qrow + half * 128 + 16 * ks + 8 * h);
#pragma unroll
            for (int kt = 0; kt < 4; ++kt) {
                const int krow = half * 128 + 32 * kt + r;
#pragma unroll
                for (int ks = 0; ks < 8; ++ks) {
                    const bf16x8 kf = *(const bf16x8*)(lds + krow * 256 + (((2 * ks + h) ^ (krow & 15)) << 4));
                    if (half == 0) X[kt] = __builtin_amdgcn_mfma_f32_32x32x16_bf16(kf, qf[ks], X[kt], 0, 0, 0);
                    else Y[kt] = __builtin_amdgcn_mfma_f32_32x32x16_bf16(kf, qf[ks], Y[kt], 0, 0, 0);
                }
            }
        }
#pragma unroll
        for (int kt = 0; kt < 4; ++kt)
#pragma unroll
            for (int i = 0; i < 16; ++i) {
                const auto sw = __builtin_amdgcn_permlane32_swap(__float_as_uint(X[kt][i]), __float_as_uint(Y[kt][i]), false, false);
                const int key0 = 32 * kt + (i & 3) + 8 * (i >> 2);
                sc[kt * 32 + i] = __uint_as_float((sw[0] & 0xffffff80u) | (unsigned)key0);
                sc[kt * 32 + 16 + i] = __uint_as_float((sw[1] & 0xffffff80u) | (unsigned)(key0 + 4));
            }
    }
#pragma unroll
    for (int g = 0; g < 8; ++g) rt_sort_desc(sc, 16 * g);
    rt_merge_desc(sc, 0, 16); rt_merge_desc(sc, 32, 48); rt_merge_desc(sc, 64, 80); rt_merge_desc(sc, 96, 112);
    rt_merge_desc(sc, 0, 32); rt_merge_desc(sc, 64, 96);
    rt_merge_desc(sc, 0, 64);
    float l0[16], l1[16];
#pragma unroll
    for (int i = 0; i < 16; ++i) {
        const auto sw = __builtin_amdgcn_permlane32_swap(__float_as_uint(sc[i]), __float_as_uint(sc[i]), false, false);
        l0[i] = __uint_as_float(sw[0]); l1[i] = __uint_as_float(sw[1]);
    }
    float s0[16], s1[16]; int k0[16], k1[16];
#pragma unroll
    for (int i = 0; i < 16; ++i) {
        const unsigned a = __float_as_uint(l0[i]), b = __float_as_uint(l1[i]);
        s0[i] = __uint_as_float(a & 0xffffff80u); k0[i] = (int)(a & 0x7fu);
        s1[i] = __uint_as_float(b & 0xffffff80u); k1[i] = (int)(b & 0x7fu);
    }
    float cs[64];
    {
        int n = 0;
#pragma unroll
        for (int i = 0; i < 16; ++i)
#pragma unroll
            for (int j = 0; j < 16; ++j)
                if ((i + 1) * (j + 1) <= 16) { cs[n] = s0[i] + s1[j]; ++n; }
#pragma unroll
        for (int q = 50; q < 64; ++q) cs[q] = -3.0e38f;
    }
    float ct[64];
#pragma unroll
    for (int q = 0; q < 64; ++q) ct[q] = cs[q];
#pragma unroll
    for (int g = 0; g < 4; ++g) rt_sort_desc(ct, 16 * g);
    rt_merge_desc(ct, 0, 16); rt_merge_desc(ct, 32, 48); rt_merge_desc(ct, 0, 32);
    const float theta = ct[15], smax = ct[0];
    float den = 0.f;
    {
        int cnt = 0;
#pragma unroll
        for (int q = 0; q < 50; ++q) { const bool sel = (cs[q] >= theta) && (cnt < 16); den += sel ? __expf(cs[q] - smax) : 0.f; cnt += sel ? 1 : 0; }
    }
    const float inv = 1.f / den;
    const size_t obase = (size_t)(tok_base + r) * 128 + hh * 16;
    int pos = 0;
    {
        int n = 0;
#pragma unroll
        for (int i = 0; i < 16; ++i)
#pragma unroll
            for (int j = 0; j < 16; ++j)
                if ((i + 1) * (j + 1) <= 16) {
                    const bool sel = (cs[n] >= theta) && (pos < 16);
                    if (sel) {
                        if (h == 0) IDX[obase + pos] = k0[i] * 128 + k1[j];
                        else GATE[obase + pos] = __expf(cs[n] - smax) * inv;
                        ++pos;
                    }
                    ++n;
                }
    }
}
__device__ __forceinline__ void phase_route(const Args& a, unsigned char* lds) {
    const int hh = BID & 7, grp = BID >> 3, ngrp = GDIM >> 3, wave = TID >> 6;
    route_stage_keys(a.subk, hh, lds);
    int j = 0;
    for (int tile = grp; tile < T / 32; tile += ngrp, ++j)
        if ((j & 7) == wave) route_tile((const u16*)(a.ws + WS_Q), D, hh, tile * 32, lds, (int*)(a.ws + WS_IDX), (float*)(a.ws + WS_GATE));
    __syncthreads();
}

typedef __bf16 bf16x2_t __attribute__((ext_vector_type(2)));
__device__ __forceinline__ float dot2bf(unsigned w, unsigned x, float acc) {
    return __builtin_amdgcn_fdot2_f32_bf16(__builtin_bit_cast(bf16x2_t, w), __builtin_bit_cast(bf16x2_t, x), acc, false);
}
__device__ __forceinline__ void convert_tables(const Args& a) {
    uint4* U = (uint4*)(a.ws + WS_TU); uint4* V = (uint4*)(a.ws + WS_TV);
    const size_t n8 = (size_t)16384 * D / 8;
    const size_t gt = (size_t)blockIdx.x * NTHREADS + threadIdx.x, NT = (size_t)gridDim.x * NTHREADS;
    for (size_t i = gt; i < 2 * n8; i += NT) {
        const bool isv = i >= n8; const size_t j = isv ? i - n8 : i;
        const f32x4* sp = (const f32x4*)(isv ? a.pv : a.pu) + 2 * j;
        const f32x4 v0 = __builtin_nontemporal_load(sp), v1 = __builtin_nontemporal_load(sp + 1);
        const uint4 o = make_uint4(pack2(v0.x, v0.y), pack2(v0.z, v0.w), pack2(v1.x, v1.y), pack2(v1.z, v1.w));
        (isv ? V : U)[j] = o;
    }
}

__device__ __forceinline__ void phase_experts(const Args& a) {
    const u16* H2 = (const u16*)(a.ws + WS_ACT);
    const float* X1 = (const float*)(a.ws + WS_X1);
    const int* IDX = (const int*)(a.ws + WS_IDX);
    const float* GATE = (const float*)(a.ws + WS_GATE);
    const float* mod = (const float*)(a.ws + WS_MOD);
    const uint4* U = (const uint4*)(a.ws + WS_TU); const uint4* V = (const uint4*)(a.ws + WS_TV);
    const int lane = threadIdx.x & 63, wave = threadIdx.x >> 6;
    const int gw = blockIdx.x * NWAVES + wave, NGW = gridDim.x * NWAVES;
    for (int t = gw; t < T; t += NGW) {
        const int b = t / S;
        uint4 h[4]; float acc[4][8];
        {
            const uint4* hp = (const uint4*)(H2 + (size_t)t * D);
#pragma unroll
            for (int m = 0; m < 4; ++m) { h[m] = hp[lane + 64 * m];
#pragma unroll
                for (int i = 0; i < 8; ++i) acc[m][i] = 0.f; }
        }
#pragma unroll 1
        for (int r0 = 0; r0 < 128; r0 += 4) {
            const int4 e4 = *(const int4*)(IDX + (size_t)t * 128 + r0);
            const float4 g4 = *(const float4*)(GATE + (size_t)t * 128 + r0);
            int e[4] = {__builtin_amdgcn_readfirstlane(e4.x), __builtin_amdgcn_readfirstlane(e4.y), __builtin_amdgcn_readfirstlane(e4.z), __builtin_amdgcn_readfirstlane(e4.w)};
            const float g[4] = {g4.x, g4.y, g4.z, g4.w};
            uint4 u[4][4], v[4][4];
#pragma unroll
            for (int q = 0; q < 4; ++q)
#pragma unroll
                for (int m = 0; m < 4; ++m) u[q][m] = U[(size_t)e[q] * 256 + lane + 64 * m];
#pragma unroll
            for (int q = 0; q < 4; ++q)
#pragma unroll
                for (int m = 0; m < 4; ++m) v[q][m] = V[(size_t)e[q] * 256 + lane + 64 * m];
            float d[4];
#pragma unroll
            for (int q = 0; q < 4; ++q) { float s0 = 0.f, s1 = 0.f;
#pragma unroll
                for (int m = 0; m < 4; ++m) { s0 = dot2bf(u[q][m].x, h[m].x, s0); s1 = dot2bf(u[q][m].y, h[m].y, s1); s0 = dot2bf(u[q][m].z, h[m].z, s0); s1 = dot2bf(u[q][m].w, h[m].w, s1); }
                d[q] = s0 + s1; }
#pragma unroll
            for (int o = 32; o > 0; o >>= 1) {
#pragma unroll
                for (int q = 0; q < 4; ++q) d[q] += __shfl_xor(d[q], o);
            }
#pragma unroll
            for (int q = 0; q < 4; ++q) { const float w = g[q] * gelu_f(d[q]);
#pragma unroll
                for (int m = 0; m < 4; ++m) {
                    acc[m][0] += w * lo2f(v[q][m].x); acc[m][1] += w * hi2f(v[q][m].x); acc[m][2] += w * lo2f(v[q][m].y); acc[m][3] += w * hi2f(v[q][m].y);
                    acc[m][4] += w * lo2f(v[q][m].z); acc[m][5] += w * hi2f(v[q][m].z); acc[m][6] += w * lo2f(v[q][m].w); acc[m][7] += w * hi2f(v[q][m].w); } }
        }
        float ss = 0.f;
#pragma unroll
        for (int m = 0; m < 4; ++m) {
            const int c0 = lane * 8 + 512 * m;
            const float4 xa = *(const float4*)(X1 + (size_t)t * D + c0), xb = *(const float4*)(X1 + (size_t)t * D + c0 + 4);
            const float4 ga = *(const float4*)(mod + b * 12288 + 5 * 2048 + c0), gb = *(const float4*)(mod + b * 12288 + 5 * 2048 + c0 + 4);
            acc[m][0] = xa.x + ga.x * acc[m][0]; acc[m][1] = xa.y + ga.y * acc[m][1]; acc[m][2] = xa.z + ga.z * acc[m][2]; acc[m][3] = xa.w + ga.w * acc[m][3];
            acc[m][4] = xb.x + gb.x * acc[m][4]; acc[m][5] = xb.y + gb.y * acc[m][5]; acc[m][6] = xb.z + gb.z * acc[m][6]; acc[m][7] = xb.w + gb.w * acc[m][7];
#pragma unroll
            for (int i = 0; i < 8; ++i) ss += acc[m][i] * acc[m][i];
        }
        ss = wave_sum(ss);
        const float rstd = rsqrtf(ss * (1.f / D) + NORM_EPS);
#pragma unroll
        for (int m = 0; m < 4; ++m) {
            const int c0 = lane * 8 + 512 * m;
            const float4 ga = *(const float4*)(a.g_fin + c0), gb = *(const float4*)(a.g_fin + c0 + 4);
            *(float4*)(a.out + (size_t)t * D + c0) = make_float4(acc[m][0] * rstd * ga.x, acc[m][1] * rstd * ga.y, acc[m][2] * rstd * ga.z, acc[m][3] * rstd * ga.w);
            *(float4*)(a.out + (size_t)t * D + c0 + 4) = make_float4(acc[m][4] * rstd * gb.x, acc[m][5] * rstd * gb.y, acc[m][6] * rstd * gb.z, acc[m][7] * rstd * gb.w);
        }
    }
}

constexpr int NPHASES = 11;
__global__ void __launch_bounds__(NTHREADS, 2) mk_fwd(Args a) {
    extern __shared__ __attribute__((aligned(16))) unsigned char lds[];
    cg::grid_group grid = cg::this_grid();
    const int lo = a.ph_lo, hi = a.ph_hi;
#define IN(k) (lo <= (k) && (k) < hi)
#define SEAM(k) do { if (IN(k) && IN((k) + 1)) grid.sync(); } while (0)
    const float* mod = (const float*)(a.ws + WS_MOD);
    if (IN(0)) phase0(a, lds);
    SEAM(0);
    if (IN(1)) norm_mod_phase(a.x, a.g_mix, mod, 0, 1, (u16*)(a.ws + WS_ACT));
    SEAM(1);
    if (IN(2)) gemm8(lds, (const u16*)(a.ws + WS_ACT), (const u16*)(a.ws + WS_WIN), T, NPAD, D, EpiProj{(u16*)(a.ws + WS_P), (float*)(a.ws + WS_GZ)});
    SEAM(2);
    if (IN(3)) phase_rope_prep(a, lds);
    SEAM(3);
    if (IN(4)) phase_mixers(a, lds);
    SEAM(4);
    if (IN(5)) phase_gla_fin(a);
    SEAM(5);
    if (IN(6)) gemm8(lds, (const u16*)(a.ws + WS_ACT), (const u16*)(a.ws + WS_WOUT), T, D, D, EpiResid{a.x, mod, (float*)(a.ws + WS_X1)});
    SEAM(6);
    if (IN(7)) { norm_mod_phase((const float*)(a.ws + WS_X1), a.g_ffn, mod, 3, 4, (u16*)(a.ws + WS_ACT)); convert_tables(a); }
    SEAM(7);
    if (IN(8)) gemm8(lds, (const u16*)(a.ws + WS_ACT), (const u16*)(a.ws + WS_WPQ), T, D, D, EpiBf16{(u16*)(a.ws + WS_Q)});
    SEAM(8);
    if (IN(9)) phase_route(a, lds);
    SEAM(9);
    if (IN(10)) phase_experts(a);
#ifdef PROBE_REP10
    grid.sync(); phase_experts(a);
#endif
#ifdef PROBE_REP9
    grid.sync(); phase_route(a, lds); grid.sync(); phase_experts(a);
#endif
#undef IN
#undef SEAM
}

#ifndef MK_ONE_LAUNCH
#define MK_ONE_LAUNCH 1
#endif
extern "C" void kernel_launch(void* const* d_in, const int* in_sizes, int n_in, void* d_out, int out_size, void* d_ws, size_t ws_size, hipStream_t stream) {
    static int grid = 0;
    if (grid == 0) {
        if (n_in != 19 || out_size != T * D || ws_size < WS_END) {
            fprintf(stderr, "kernel_launch: unexpected shapes: n_in %d out %d ws %zu (need %zu)\n", n_in, out_size, ws_size, (size_t)WS_END);
            grid = -1; return;
        }
        int dev = 0, cus = 0, per_cu = 0;
        (void)hipGetDevice(&dev);
        (void)hipDeviceGetAttribute(&cus, hipDeviceAttributeMultiprocessorCount, dev);
        (void)hipFuncSetAttribute((const void*)mk_fwd, hipFuncAttributeMaxDynamicSharedMemorySize, LDS_BYTES);
        (void)hipOccupancyMaxActiveBlocksPerMultiprocessor(&per_cu, (const void*)mk_fwd, NTHREADS, LDS_BYTES);
        if (per_cu < 1) { fprintf(stderr, "kernel_launch: occupancy query says %d blocks/CU\n", per_cu); grid = -1; return; }
        grid = cus;
        (void)hipGetLastError();
    }
    if (grid < 0) return;
    Args a{};
    a.x = (const float*)d_in[0]; a.c = (const float*)d_in[1]; a.pos = (const int*)d_in[2]; a.w_ada = (const float*)d_in[3];
    a.b_ada = (const float*)d_in[4]; a.g_mix = (const float*)d_in[5]; a.w_in = (const float*)d_in[6]; a.wgf = (const float*)d_in[7];
    a.bgf = (const float*)d_in[8]; a.wgb = (const float*)d_in[9]; a.bgb = (const float*)d_in[10]; a.g_gla = (const float*)d_in[11];
    a.w_out = (const float*)d_in[12]; a.g_ffn = (const float*)d_in[13]; a.w_pq = (const float*)d_in[14]; a.subk = (const float*)d_in[15];
    a.pu = (const float*)d_in[16]; a.pv = (const float*)d_in[17]; a.g_fin = (const float*)d_in[18];
    a.out = (float*)d_out; a.ws = (unsigned char*)d_ws;
#if MK_ONE_LAUNCH
    a.ph_lo = 0; a.ph_hi = NPHASES;
    void* args[] = {&a};
    hipError_t e = hipLaunchCooperativeKernel((const void*)mk_fwd, dim3(grid), dim3(NTHREADS), args, LDS_BYTES, stream);
    if (e != hipSuccess) fprintf(stderr, "cooperative launch failed: %s (grid %d)\n", hipGetErrorString(e), grid);
#else
    for (int p = 0; p < NPHASES; ++p) {
        a.ph_lo = p; a.ph_hi = p + 1;
        hipLaunchKernelGGL(mk_fwd, dim3(grid), dim3(NTHREADS), LDS_BYTES, stream, a);
    }
#endif
}
```

```cpp
#include <hip/hip_runtime.h>
#include <hip/hip_cooperative_groups.h>
#include <cstdio>
#include <cstdint>

namespace cg = cooperative_groups;

typedef unsigned short u16;
typedef __attribute__((ext_vector_type(8))) short bf16x8;
typedef __attribute__((ext_vector_type(4))) float f32x4;
typedef short s16x4 __attribute__((ext_vector_type(4)));
#define TID ((int)threadIdx.x)
#define BID ((int)blockIdx.x)
#define GDIM ((int)gridDim.x)
#define LAS __attribute__((address_space(3)))

constexpr int D = 2048, NB = 4, S = 4096, T = NB * S;
constexpr int INW = 6176;
constexpr int NP = 6144;
constexpr int NPAD = 6400;
constexpr int C_GQ = 0, C_GK = 512, C_GV = 1024, C_GR = 2048, C_DQ = 3072, C_DK = 4096, C_DV = 5120;
constexpr int NTHREADS = 512, NWAVES = 8;
constexpr int LDS_BYTES = 128 * 1024;
constexpr float NORM_EPS = 1e-6f;

constexpr size_t WS_CTL = 0;
constexpr size_t WS_MOD = 65536;
constexpr size_t WS_CS = 524288;
constexpr size_t WS_WIN = WS_CS + (size_t)T * 64 * 8;
constexpr size_t WS_WOUT = WS_WIN + (size_t)NPAD * D * 2;
constexpr size_t WS_WPQ = WS_WOUT + (size_t)D * D * 2;
constexpr size_t WS_ACT = WS_WPQ + (size_t)D * D * 2;
constexpr size_t WS_P = WS_ACT + (size_t)T * D * 2;
constexpr size_t WS_X1 = WS_P;
constexpr size_t WS_Q = WS_P + (size_t)T * D * 4;
constexpr size_t WS_GZ = WS_P + (size_t)T * NP * 2;
constexpr int GLA_NPREP = NB * 4 * 2 * (S / 64);
constexpr size_t WS_QD = WS_GZ + (size_t)T * 32 * 4;
constexpr size_t WS_KE = WS_QD + (size_t)GLA_NPREP * 16384;
constexpr size_t WS_AT = WS_KE + (size_t)GLA_NPREP * 16384;
constexpr size_t WS_DEC = WS_AT + (size_t)GLA_NPREP * 8192;
constexpr size_t WS_OFB = WS_DEC + (size_t)GLA_NPREP * 512;
constexpr size_t WS_IDX = WS_OFB + (size_t)2 * T * 1024 * 2;
constexpr size_t WS_GATE = WS_IDX + (size_t)T * 128 * 4;
constexpr size_t WS_END = WS_GATE + (size_t)T * 128 * 4;
constexpr size_t WS_TU = WS_QD;
constexpr size_t WS_TV = WS_QD + (size_t)16384 * D;
static_assert(WS_TV + (size_t)16384 * D <= WS_IDX, "table region");

struct Args {
    const float* x; const float* c; const int* pos; const float* w_ada; const float* b_ada; const float* g_mix;
    const float* w_in; const float* wgf; const float* bgf; const float* wgb; const float* bgb; const float* g_gla;
    const float* w_out; const float* g_ffn; const float* w_pq; const float* subk; const float* pu; const float* pv; const float* g_fin;
    float* out; unsigned char* ws; int ph_lo, ph_hi;
};

__device__ __forceinline__ float bf2f(u16 h) { return __uint_as_float(((unsigned)h) << 16); }
__device__ __forceinline__ u16 f2bf(float f) { unsigned u = __float_as_uint(f); u += 0x7fffu + ((u >> 16) & 1u); return (u16)(u >> 16); }
__device__ __forceinline__ unsigned pack2(float a, float b) { return (unsigned)f2bf(a) | ((unsigned)f2bf(b) << 16); }
__device__ __forceinline__ float lo2f(unsigned p) { return __uint_as_float(p << 16); }
__device__ __forceinline__ float hi2f(unsigned p) { return __uint_as_float(p & 0xffff0000u); }
__device__ __forceinline__ float wave_sum(float v) {
#pragma unroll
    for (int o = 32; o > 0; o >>= 1) v += __shfl_xor(v, o);
    return v;
}
__device__ __forceinline__ float wave_max(float v) {
#pragma unroll
    for (int o = 32; o > 0; o >>= 1) v = fmaxf(v, __shfl_xor(v, o));
    return v;
}
__device__ __forceinline__ float silu_f(float v) { return v / (1.f + __expf(-v)); }
__device__ __forceinline__ float gelu_f(float a) { return 0.5f * a * (1.f + erff(a * 0.70710678118654752f)); }
__device__ __forceinline__ float logsigmoid_f(float z) { return z < 0.f ? z - log1pf(expf(z)) : -log1pf(expf(-z)); }

__device__ __forceinline__ void p0_mod(const Args& a, unsigned char* lds, int bi) {
    float* sc = (float*)lds;
    float* red = sc + 4 * 2048;
    const int tid = threadIdx.x, lane = tid & 63, wave = tid >> 6;
    for (int i = tid; i < 4 * 2048; i += NTHREADS) sc[i] = silu_f(a.c[i]);
    __syncthreads();
    const int j0 = bi * 256 + lane * 4;
    float acc[4][4];
#pragma unroll
    for (int b = 0; b < 4; ++b)
#pragma unroll
        for (int q = 0; q < 4; ++q) acc[b][q] = 0.f;
    const int k0 = wave * 256;
#pragma unroll 4
    for (int kk = 0; kk < 256; ++kk) {
        const int k = k0 + kk;
        const float4 w = *(const float4*)(a.w_ada + (size_t)k * 12288 + j0);
#pragma unroll
        for (int b = 0; b < 4; ++b) {
            const float s = sc[b * 2048 + k];
            acc[b][0] += s * w.x; acc[b][1] += s * w.y; acc[b][2] += s * w.z; acc[b][3] += s * w.w;
        }
    }
#pragma unroll
    for (int b = 0; b < 4; ++b)
#pragma unroll
        for (int q = 0; q < 4; ++q) red[(wave * 4 + b) * 256 + lane * 4 + q] = acc[b][q];
    __syncthreads();
    float* mod = (float*)(a.ws + WS_MOD);
    for (int i = tid; i < 4 * 256; i += NTHREADS) {
        const int b = i >> 8, jc = i & 255;
        float s = 0.f;
#pragma unroll
        for (int w = 0; w < 8; ++w) s += red[(w * 4 + b) * 256 + jc];
        mod[b * 12288 + bi * 256 + jc] = s + a.b_ada[bi * 256 + jc];
    }
    __syncthreads();
}

__device__ __forceinline__ void p0_transpose_item(const float* __restrict__ W, int ldw, int k0, int src_col0, int n_valid,
                                                  u16* __restrict__ WT, int ldt, int n_out0, unsigned char* lds) {
    u16* tl = (u16*)lds;
    const int tid = threadIdx.x;
    {
        const int k = tid >> 3, nc = (tid & 7) * 8;
        float v[8];
        if (nc < n_valid) {
            const float4 v0 = *(const float4*)(W + (size_t)(k0 + k) * ldw + src_col0 + nc);
            const float4 v1 = *(const float4*)(W + (size_t)(k0 + k) * ldw + src_col0 + nc + 4);
            v[0] = v0.x; v[1] = v0.y; v[2] = v0.z; v[3] = v0.w; v[4] = v1.x; v[5] = v1.y; v[6] = v1.z; v[7] = v1.w;
        } else {
#pragma unroll
            for (int i = 0; i < 8; ++i) v[i] = 0.f;
        }
#pragma unroll
        for (int i = 0; i < 8; ++i) tl[(nc + i) * 72 + k] = f2bf(v[i]);
    }
    __syncthreads();
    {
        const int n = tid >> 3, kc = (tid & 7) * 8;
        const uint4 v = *(const uint4*)(tl + n * 72 + kc);
        *(uint4*)(WT + (size_t)(n_out0 + n) * ldt + k0 + kc) = v;
    }
    __syncthreads();
}

__device__ __forceinline__ void phase0(const Args& a, unsigned char* lds) {
    const int bi = blockIdx.x, G = gridDim.x, tid = threadIdx.x;
    if (bi < 48) p0_mod(a, lds, bi);
    constexpr int I_IN = 32 * (NPAD / 64), I_SQ = 32 * 32;
    u16* WinT = (u16*)(a.ws + WS_WIN); u16* WoutT = (u16*)(a.ws + WS_WOUT); u16* WpqT = (u16*)(a.ws + WS_WPQ);
    for (int it = bi; it < I_IN + 2 * I_SQ; it += G) {
        if (it < I_IN) {
            const int kt = it & 31, nt = it >> 5;
            const int n0 = nt * 64;
            int src, nv;
            if (n0 < 3072) { src = n0; nv = 64; }
            else if (n0 < 6144) { src = n0 + 32; nv = 64; }
            else if (n0 == 6144) { src = 3072; nv = 32; }
            else { src = 0; nv = 0; }
            p0_transpose_item(a.w_in, INW, kt * 64, src, nv, WinT, D, n0, lds);
        } else if (it < I_IN + I_SQ) {
            const int r = it - I_IN; const int kt = r & 31, nt = r >> 5;
            p0_transpose_item(a.w_out, D, kt * 64, nt * 64, 64, WoutT, D, nt * 64, lds);
        } else {
            const int r = it - I_IN - I_SQ; const int kt = r & 31, nt = r >> 5;
            p0_transpose_item(a.w_pq, D, kt * 64, nt * 64, 64, WpqT, D, nt * 64, lds);
        }
    }
    float2* cs = (float2*)(a.ws + WS_CS);
    for (int i = bi * NTHREADS + tid; i < T * 64; i += G * NTHREADS) {
        const int t = i >> 6, f = i & 63;
        const float inv_freq = powf(10000.0f, -(float)f * 2.0f / 128.0f);
        const float ang = (float)a.pos[t] * inv_freq;
        const double rev = (double)ang * 0.15915494309189533577;
        const float fr = (float)(rev - floor(rev));
        cs[i] = make_float2(__builtin_amdgcn_cosf(fr), __builtin_amdgcn_sinf(fr));
    }
}

__device__ __forceinline__ void norm_mod_phase(const float* __restrict__ xin, const float* __restrict__ g, const float* __restrict__ mod,
                                               int sh_chunk, int sc_chunk, u16* __restrict__ outp) {
    const int lane = threadIdx.x & 63, wave = threadIdx.x >> 6;
    const int gw = blockIdx.x * NWAVES + wave, NGW = gridDim.x * NWAVES;
    for (int t = gw; t < T; t += NGW) {
        const int b = t / S;
        const float4* xr = (const float4*)(xin + (size_t)t * D);
        float4 v[8]; float ss = 0.f;
#pragma unroll
        for (int m = 0; m < 8; ++m) { v[m] = xr[lane + 64 * m]; ss += v[m].x * v[m].x + v[m].y * v[m].y + v[m].z * v[m].z + v[m].w * v[m].w; }
        ss = wave_sum(ss);
        const float rstd = rsqrtf(ss * (1.f / D) + NORM_EPS);
        const float4* gp = (const float4*)g;
        const float4* shp = (const float4*)(mod + b * 12288 + sh_chunk * 2048);
        const float4* scp = (const float4*)(mod + b * 12288 + sc_chunk * 2048);
        uint2* op = (uint2*)(outp + (size_t)t * D);
#pragma unroll
        for (int m = 0; m < 8; ++m) {
            const int i = lane + 64 * m;
            const float4 gg = gp[i], sh = shp[i], sc = scp[i];
            const float h0 = v[m].x * rstd * gg.x * (1.f + sc.x) + sh.x;
            const float h1 = v[m].y * rstd * gg.y * (1.f + sc.y) + sh.y;
            const float h2 = v[m].z * rstd * gg.z * (1.f + sc.z) + sh.z;
            const float h3 = v[m].w * rstd * gg.w * (1.f + sc.w) + sh.w;
            op[i] = make_uint2(pack2(h0, h1), pack2(h2, h3));
        }
    }
}

namespace pg8 {
#define PG8_LAS __attribute__((address_space(3)))
typedef unsigned short bf16_t;
typedef short bf16x8 __attribute__((ext_vector_type(8)));
typedef float f32x4 __attribute__((ext_vector_type(4)));
typedef unsigned u32x4 __attribute__((ext_vector_type(4)));
constexpr int BM = 256, BK = 64, HALF = 128, HTB = HALF * BK * 2  , STAGE_BYTES = 8 * HTB, NXCD = 8, WGM = 8;

__host__ __device__ __forceinline__ int lds_byte(int r, int c) { const int st = (r >> 4) * 2 + (c >> 5), rr = r & 15, cc = c & 31, ob = rr * 64 + cc * 2; return st * 1024 + (ob ^ (((ob >> 9) & 1) << 5)); }
__host__ __device__ __forceinline__ void stage_rc(int b, int& R, int& C) { const int st = b / 1024, sb = b % 1024, swz = sb ^ (((sb >> 9) & 1) << 5); R = (st >> 1) * 16 + swz / 64; C = (st & 1) * 32 + (swz % 64) / 2; }
__host__ __device__ __forceinline__ int perm32(int rho) { const int n = rho >> 4, i = rho & 15; return 8 * (i >> 2) + 4 * n + (i & 3); }

struct Unit { int pm, pn; };
struct Gemm { const bf16_t* A; const bf16_t* Bt; int M, N, K; };

struct StaticOrder {
    int nM, nN, nwg, G, c;
    __host__ __device__ void init(int M, int N, int G_, int c_) { nM = M / BM; nN = N / BM; nwg = nM * nN; G = G_; c = c_; }
    __host__ __device__ bool next(int i, Unit& u) const {
        const long L = (long)i * G + c; if (L >= nwg) return false;
        int wgid = (int)L; { const int q = nwg / NXCD, r = nwg % NXCD, xcd = wgid % NXCD, off = wgid / NXCD; wgid = (xcd < r ? xcd * (q + 1) : r * (q + 1) + (xcd - r) * q) + off; }
        const int nig = WGM * nN, gid = wgid / nig, fm = gid * WGM, gsz = (nM - fm) < WGM ? (nM - fm) : WGM;
        u.pm = fm + ((wgid % nig) % gsz); u.pn = (wgid % nig) / gsz; return true;
    }
    __device__ __forceinline__ void a_ready(const Unit&) const {}
    __device__ __forceinline__ void done(const Unit&) const {}
};
__device__ __forceinline__ unsigned cvt_pk_bf16(float lo, float hi) { unsigned r; asm volatile("v_cvt_pk_bf16_f32 %0, %1, %2" : "=v"(r) : "v"(lo), "v"(hi)); return r; }
typedef float f32x2 __attribute__((ext_vector_type(2)));
template <class Epi, class Sched, bool STAMP = false>
__device__ __forceinline__ void gemm_phase(PG8_LAS unsigned char* lds, const Gemm g, const Sched& S, const Epi& E, unsigned long long* stamps) {
    const int tid = threadIdx.x, wid = __builtin_amdgcn_readfirstlane(tid >> 6), lane = tid & 63, wr = wid >> 2, wc = wid & 3, fr = lane & 15, fq = lane >> 4;
    const int K = g.K, nt = K / BK;
    int ts_lo = 0, ts_hi = 0, nts = 0; const unsigned long long rt_entry = STAMP ? (unsigned long long)wall_clock64() : 0ull;
#define PG8_STAMP() do { if (STAMP && wid == 0 && nts < 64) { const unsigned long long _c = (unsigned long long)clock64(); \
        ts_lo = (lane == nts) ? (int)(unsigned)_c : ts_lo; ts_hi = (lane == nts) ? (int)(unsigned)(_c >> 32) : ts_hi; ++nts; } } while (0)
    PG8_STAMP();
    unsigned voffA[2], voffB[2];
#pragma unroll
    for (int i = 0; i < 2; ++i) { int R, C; stage_rc(tid * 16 + i * 8192, R, C); const int Rb = Epi::PERM ? ((R & ~31) + perm32(R & 31)) : R;
        voffA[i] = (unsigned)(R * K + C) * 2u; voffB[i] = (unsigned)(Rb * K + C) * 2u; }
    const size_t kstep = (size_t)(BK * 2);
    const size_t hstep = (size_t)HALF * K * 2;
    const size_t tstep = 2 * hstep;
    const unsigned ldsw = (unsigned)wid * 1024u;
    const int aoff = lds_byte(wr * 64 + fr, fq * 8), boff = lds_byte(wc * 32 + fr, fq * 8);
#define PG8_SA(b, h) (((b) * 2 + (h)) * HTB)
#define PG8_SB(b, h) ((4 + (b) * 2 + (h)) * HTB)
#define PG8_STAGE(bufoff, gbase, voff) do { _Pragma("unroll") for (int _i = 0; _i < 2; ++_i) \
        __builtin_amdgcn_global_load_lds((const unsigned*)((const char*)(gbase) + (voff)[_i]), (PG8_LAS unsigned*)(lds + (bufoff) + ldsw + _i * 8192), 16, 0, 0); } while (0)
#define PG8_LDA(dst, b, h) do { _Pragma("unroll") for (int m = 0; m < 4; ++m) _Pragma("unroll") for (int k = 0; k < 2; ++k) dst[m][k] = *(const PG8_LAS bf16x8*)(lds + PG8_SA(b, h) + aoff + m * 2048 + k * 1024); } while (0)
#define PG8_LDB(dst, b, h) do { _Pragma("unroll") for (int n = 0; n < 2; ++n) _Pragma("unroll") for (int k = 0; k < 2; ++k) dst[n][k] = *(const PG8_LAS bf16x8*)(lds + PG8_SB(b, h) + boff + n * 2048 + k * 1024); } while (0)
#define PG8_MMA(ai, bj, At, Bt) do { __builtin_amdgcn_s_setprio(1); _Pragma("unroll") for (int m = 0; m < 4; ++m) _Pragma("unroll") for (int n = 0; n < 2; ++n) _Pragma("unroll") for (int k = 0; k < 2; ++k) \
        acc[ai][bj][m][n] = __builtin_amdgcn_mfma_f32_16x16x32_bf16(Bt[n][k], At[m][k], acc[ai][bj][m][n], 0, 0, 0); __builtin_amdgcn_s_setprio(0); } while (0)
#define PG8_WAIT_V(n) asm volatile("s_waitcnt vmcnt(" #n ")" ::: "memory")
#define PG8_WAIT_L(n) asm volatile("s_waitcnt lgkmcnt(" #n ")" ::: "memory")
#define PG8_BAR __builtin_amdgcn_s_barrier()
#define PG8_SCHED __builtin_amdgcn_sched_barrier(0)
    Unit cur, nxt; int ui = 0;
    if (!S.next(0, cur)) return;
    f32x4 acc[2][2][4][2];
#pragma unroll
    for (int a = 0; a < 2; ++a)
#pragma unroll
        for (int b = 0; b < 2; ++b)
#pragma unroll
            for (int m = 0; m < 4; ++m)
#pragma unroll
                for (int n = 0; n < 2; ++n) acc[a][b][m][n] = (f32x4){0.f, 0.f, 0.f, 0.f};
    bf16x8 At[4][2], B0[2][2], B1[2][2];
    const char* cA = (const char*)g.A + (size_t)cur.pm * tstep; const char* cB = (const char*)g.Bt + (size_t)cur.pn * tstep;
    S.a_ready(cur);
    PG8_STAGE(PG8_SB(0, 0), cB, voffB); PG8_STAGE(PG8_SA(0, 0), cA, voffA); PG8_STAGE(PG8_SB(0, 1), cB + hstep, voffB); PG8_STAGE(PG8_SA(0, 1), cA + hstep, voffA);
    if (wr == 1) PG8_BAR;
    PG8_WAIT_V(4); PG8_BAR;
    PG8_STAGE(PG8_SB(1, 0), cB + kstep, voffB); PG8_STAGE(PG8_SA(1, 0), cA + kstep, voffA); PG8_STAGE(PG8_SB(1, 1), cB + hstep + kstep, voffB);
    PG8_WAIT_V(6); PG8_BAR;
    PG8_STAMP();
    for (;;) {
        const bool has_next = S.next(ui + 1, nxt);
        const char* nA = has_next ? (const char*)g.A + (size_t)nxt.pm * tstep : cA; const char* nB = has_next ? (const char*)g.Bt + (size_t)nxt.pn * tstep : cB;
        for (int t = 0; t < nt; t += 2) {
            const bool last = (t == nt - 2);
            const char* a1 = cA + (size_t)(t + 1) * kstep;
            const char* a2 = last ? nA : cA + (size_t)(t + 2) * kstep; const char* b2 = last ? nB : cB + (size_t)(t + 2) * kstep;
            const char* a3 = a2 + kstep; const char* b3 = b2 + kstep;
            if (last && has_next) S.a_ready(nxt);
            PG8_LDB(B0, 0, 0); PG8_SCHED; PG8_LDA(At, 0, 0); PG8_STAGE(PG8_SA(1, 1), a1 + hstep, voffA);
            PG8_WAIT_L(8); PG8_BAR; PG8_WAIT_L(0); PG8_MMA(0, 0, At, B0); PG8_BAR; PG8_SCHED;
            PG8_LDB(B1, 0, 1); PG8_STAGE(PG8_SB(0, 0), b2, voffB);
            PG8_BAR; PG8_WAIT_L(0); PG8_MMA(0, 1, At, B1); PG8_BAR;
            PG8_LDA(At, 0, 1); PG8_STAGE(PG8_SA(0, 0), a2, voffA);
            PG8_BAR; PG8_WAIT_L(0); PG8_MMA(1, 0, At, B0); PG8_BAR; PG8_SCHED;
            PG8_STAGE(PG8_SB(0, 1), b2 + hstep, voffB);
            PG8_WAIT_V(6); PG8_BAR; PG8_MMA(1, 1, At, B1); PG8_BAR;
            PG8_LDB(B0, 1, 0); PG8_SCHED; PG8_LDA(At, 1, 0); PG8_STAGE(PG8_SA(0, 1), a2 + hstep, voffA);
            PG8_WAIT_L(8); PG8_BAR; PG8_WAIT_L(0); PG8_MMA(0, 0, At, B0); PG8_BAR; PG8_SCHED;
            PG8_LDB(B1, 1, 1); PG8_STAGE(PG8_SB(1, 0), b3, voffB);
            PG8_BAR; PG8_WAIT_L(0); PG8_MMA(0, 1, At, B1); PG8_BAR;
            PG8_LDA(At, 1, 1); PG8_STAGE(PG8_SA(1, 0), a3, voffA);
            PG8_BAR; PG8_WAIT_L(0); PG8_MMA(1, 0, At, B0); PG8_BAR; PG8_SCHED;
            PG8_STAGE(PG8_SB(1, 1), b3 + hstep, voffB);
            PG8_WAIT_V(6); PG8_BAR; PG8_MMA(1, 1, At, B1); PG8_BAR;
        }
        PG8_STAMP();
        if constexpr (!Epi::AFTER_DRAIN) { E(acc, cur, wr, wc, fr, fq); S.done(cur); }
        PG8_STAMP();
        if (!has_next) break;
#pragma unroll
        for (int a = 0; a < 2; ++a)
#pragma unroll
            for (int b = 0; b < 2; ++b)
#pragma unroll
                for (int m = 0; m < 4; ++m)
#pragma unroll
                    for (int n = 0; n < 2; ++n) acc[a][b][m][n] = (f32x4){0.f, 0.f, 0.f, 0.f};
        cur = nxt; cA = nA; cB = nB; ++ui;
    }
    PG8_WAIT_V(0);
    if (wr == 0) PG8_BAR;
    PG8_BAR;
    if constexpr (Epi::AFTER_DRAIN) { E.fused(acc, cur, wr, wc, fr, fq, lds, wid, lane); S.done(cur); }
    PG8_STAMP();
    if (STAMP && wid == 0) { stamps[lane] = lane < nts ? (((unsigned long long)(unsigned)ts_hi << 32) | (unsigned)ts_lo) : 0ull;
        if (lane == 62) stamps[62] = rt_entry; if (lane == 63) stamps[63] = (unsigned long long)wall_clock64(); }
#undef PG8_STAMP
#undef PG8_SA
#undef PG8_SB
#undef PG8_STAGE
#undef PG8_LDA
#undef PG8_LDB
#undef PG8_MMA
#undef PG8_WAIT_V
#undef PG8_WAIT_L
#undef PG8_BAR
#undef PG8_SCHED
}
}

struct EpiProj {
    static constexpr bool PERM = true, AFTER_DRAIN = false;
    u16* P; float* gz;
    __device__ __forceinline__ void operator()(const pg8::f32x4 (&acc)[2][2][4][2], const pg8::Unit& u, int wr, int wc, int fr, int fq) const {
        const int row0 = u.pm * 256 + wr * 64 + fr;
        if (u.pn < 24) {
            const int col0 = u.pn * 256 + wc * 32 + 8 * fq;
#pragma unroll
            for (int ai = 0; ai < 2; ++ai)
#pragma unroll
                for (int m = 0; m < 4; ++m) { u16* rowp = P + (size_t)(row0 + ai * 128 + m * 16) * NP + col0;
#pragma unroll
                    for (int bj = 0; bj < 2; ++bj) { const pg8::f32x4 v0 = acc[ai][bj][m][0], v1 = acc[ai][bj][m][1];
                        pg8::u32x4 w; w.x = pg8::cvt_pk_bf16(v0[0], v0[1]); w.y = pg8::cvt_pk_bf16(v0[2], v0[3]); w.z = pg8::cvt_pk_bf16(v1[0], v1[1]); w.w = pg8::cvt_pk_bf16(v1[2], v1[3]);
                        *(pg8::u32x4*)(rowp + bj * 128) = w; } }
        } else if (wc == 0) {
#pragma unroll
            for (int ai = 0; ai < 2; ++ai)
#pragma unroll
                for (int m = 0; m < 4; ++m) { float* rowp = gz + (size_t)(row0 + ai * 128 + m * 16) * 32 + 8 * fq;
                    *(pg8::f32x4*)(rowp) = acc[ai][0][m][0]; *(pg8::f32x4*)(rowp + 4) = acc[ai][0][m][1]; }
        }
    }
};
struct EpiResid {
    static constexpr bool PERM = false, AFTER_DRAIN = false;
    const float* x; const float* mod; float* x1;
    __device__ __forceinline__ void operator()(const pg8::f32x4 (&acc)[2][2][4][2], const pg8::Unit& u, int wr, int wc, int fr, int fq) const {
        const int row0 = u.pm * 256 + wr * 64 + fr, col0 = u.pn * 256 + wc * 32 + 4 * fq;
        const int b = (u.pm * 256) / S;
        pg8::f32x4 ga[2][2];
#pragma unroll
        for (int bj = 0; bj < 2; ++bj)
#pragma unroll
            for (int n = 0; n < 2; ++n) ga[bj][n] = *(const pg8::f32x4*)(mod + b * 12288 + 2 * 2048 + col0 + bj * 128 + n * 16);
#pragma unroll
        for (int ai = 0; ai < 2; ++ai)
#pragma unroll
            for (int m = 0; m < 4; ++m) { const size_t off = (size_t)(row0 + ai * 128 + m * 16) * D + col0;
#pragma unroll
                for (int bj = 0; bj < 2; ++bj)
#pragma unroll
                    for (int n = 0; n < 2; ++n) { const pg8::f32x4 xv = *(const pg8::f32x4*)(x + off + bj * 128 + n * 16);
                        *(pg8::f32x4*)(x1 + off + bj * 128 + n * 16) = xv + ga[bj][n] * acc[ai][bj][m][n]; } }
    }
};
struct EpiBf16 {
    static constexpr bool PERM = true, AFTER_DRAIN = false;
    u16* Q;
    __device__ __forceinline__ void operator()(const pg8::f32x4 (&acc)[2][2][4][2], const pg8::Unit& u, int wr, int wc, int fr, int fq) const {
        const int row0 = u.pm * 256 + wr * 64 + fr, col0 = u.pn * 256 + wc * 32 + 8 * fq;
#pragma unroll
        for (int ai = 0; ai < 2; ++ai)
#pragma unroll
            for (int m = 0; m < 4; ++m) { u16* rowp = Q + (size_t)(row0 + ai * 128 + m * 16) * D + col0;
#pragma unroll
                for (int bj = 0; bj < 2; ++bj) { const pg8::f32x4 v0 = acc[ai][bj][m][0], v1 = acc[ai][bj][m][1];
                    pg8::u32x4 w; w.x = pg8::cvt_pk_bf16(v0[0], v0[1]); w.y = pg8::cvt_pk_bf16(v0[2], v0[3]); w.z = pg8::cvt_pk_bf16(v1[0], v1[1]); w.w = pg8::cvt_pk_bf16(v1[2], v1[3]);
                    *(pg8::u32x4*)(rowp + bj * 128) = w; } }
    }
};
template <class Epi>
__device__ __forceinline__ void gemm8(unsigned char* lds, const u16* A, const u16* Bt, int M, int N, int K, const Epi& E) {
    pg8::Gemm g{A, Bt, M, N, K}; pg8::StaticOrder So; So.init(M, N, (int)gridDim.x, (int)blockIdx.x);
    pg8::gemm_phase<Epi, pg8::StaticOrder, false>((PG8_LAS unsigned char*)lds, g, So, E, nullptr);
    __syncthreads();
}

#define GLA_QD_BYTES 16384
#define GLA_AT_BYTES 8192
__device__ __forceinline__ float gla_logsigmoid(float z) { return z < 0.f ? z - log1pf(expf(z)) : -log1pf(expf(-z)); }

__device__ __forceinline__ void gla_prep_item(const u16* __restrict__ P, int ldp, int cq, int ck, const float* __restrict__ gz,
                                              const float* __restrict__ wg_f, const float* __restrict__ bg_f, const float* __restrict__ wg_b, const float* __restrict__ bg_b,
                                              int Sq, unsigned char* __restrict__ QDg, unsigned char* __restrict__ KEg, unsigned char* __restrict__ ATg, float* __restrict__ DECg,
                                              unsigned char* lds, int item) {
    const int nch = Sq / 64;
    const int c = item % nch, dir = (item / nch) & 1, hh = (item / (nch * 2)) & 3, b = item / (nch * 8);
    const int tid = TID, lane = tid & 63, wave = tid >> 6, li = lane & 15, fq = lane >> 4;
    float* gzs = (float*)lds;
    float* segs = gzs + 64 * 16;
    unsigned char* QDs = lds + 8192;
    unsigned char* KIs = QDs + 16384;
    unsigned char* KEs = KIs + 16384;
    const size_t tok0 = (size_t)b * Sq;
    __syncthreads();
    for (int e = tid; e < 64 * 16; e += 512) {
        const int i = e >> 4, r = e & 15;
        const int s = dir ? (Sq - 1 - (64 * c + i)) : (64 * c + i);
        gzs[e] = gz[(tok0 + s) * 32 + dir * 16 + r];
    }
    const int d = tid & 127, seg = tid >> 7;
    const float* wg = dir ? wg_b : wg_f;
    float wcol[16];
#pragma unroll
    for (int r = 0; r < 16; ++r) wcol[r] = wg[r * 512 + hh * 128 + d];
    const float bias = (dir ? bg_b : bg_f)[hh * 128 + d];
    __syncthreads();
    float pre[16]; float run = 0.f;
#pragma unroll
    for (int k = 0; k < 16; ++k) {
        const int i = 16 * seg + k;
        float z = bias;
#pragma unroll
        for (int r = 0; r < 16; ++r) z += gzs[i * 16 + r] * wcol[r];
        run += gla_logsigmoid(z) * (1.f / 16.f);
        pre[k] = run;
    }
    segs[seg * 128 + d] = run;
    __syncthreads();
    float off = 0.f, tot = 0.f;
#pragma unroll
    for (int s2 = 0; s2 < 4; ++s2) { const float v = segs[s2 * 128 + d]; tot += v; off += (s2 < seg) ? v : 0.f; }
    const float qscale = 0.08838834764831845f;
#pragma unroll
    for (int k = 0; k < 16; ++k) {
        const int i = 16 * seg + k;
        const int s = dir ? (Sq - 1 - (64 * c + i)) : (64 * c + i);
        const float bb = off + pre[k];
        const float q = bf2f(P[(tok0 + s) * ldp + cq + hh * 128 + d]), kx = bf2f(P[(tok0 + s) * ldp + ck + hh * 128 + d]);
        const int o = i * 256 + ((((d >> 3) ^ (i & 15)) << 4) | ((d & 7) << 1));
        *(u16*)(QDs + o) = f2bf(q * qscale * __expf(bb));
        *(u16*)(KIs + o) = f2bf(kx * __expf(-bb));
        *(u16*)(KEs + o) = f2bf(kx * __expf(tot - bb));
    }
    if (seg == 0) DECg[(size_t)item * 128 + d] = __expf(tot);
    __syncthreads();
    {
        uint4* qo = (uint4*)(QDg + (size_t)item * GLA_QD_BYTES); uint4* ko = (uint4*)(KEg + (size_t)item * GLA_QD_BYTES);
#pragma unroll
        for (int k = 0; k < 2; ++k) { const int e = tid + 512 * k; qo[e] = ((const uint4*)QDs)[e]; ko[e] = ((const uint4*)KEs)[e]; }
    }
#pragma unroll
    for (int tt = 0; tt < 2; ++tt) {
        const int tile = wave + 8 * tt, jt = tile >> 2, it = tile & 3;
        f32x4 acc = (f32x4){0.f, 0.f, 0.f, 0.f};
        if (jt <= it) {
            const int jr = 16 * jt + li, ir = 16 * it + li;
#pragma unroll
            for (int ks = 0; ks < 4; ++ks) {
                const bf16x8 kf = *(const bf16x8*)(KIs + jr * 256 + (((4 * ks + fq) ^ (jr & 15)) << 4));
                const bf16x8 qf = *(const bf16x8*)(QDs + ir * 256 + (((4 * ks + fq) ^ (ir & 15)) << 4));
                acc = __builtin_amdgcn_mfma_f32_16x16x32_bf16(kf, qf, acc, 0, 0, 0);
            }
        }
        const int i = 16 * it + li, j0 = 16 * jt + 4 * fq;
        float v[4];
#pragma unroll
        for (int jj = 0; jj < 4; ++jj) v[jj] = (j0 + jj <= i) ? acc[jj] : 0.f;
        const int chunk = 2 * jt + (fq >> 1), sub = (fq & 1) * 8;
        *(uint2*)(ATg + (size_t)item * GLA_AT_BYTES + i * 128 + ((chunk ^ (i & 7)) << 4) + sub) = make_uint2(pack2(v[0], v[1]), pack2(v[2], v[3]));
    }
}

__device__ __forceinline__ void gla_seq_item(const u16* __restrict__ P, int ldp, int cv, int Sq,
                                             const unsigned char* __restrict__ QDg, const unsigned char* __restrict__ KEg, const unsigned char* __restrict__ ATg, const float* __restrict__ DECg,
                                             u16* __restrict__ Oout  , int Ttot, unsigned char* lds, int item) {
    const int slice = item & 1, dir = (item >> 1) & 1, hh = (item >> 2) & 3, b = item >> 4;
    const int nch = Sq / 64;
    const int tid = TID, lane = tid & 63, wave = tid >> 6, li = lane & 15, fq = lane >> 4;
    const size_t tok0 = (size_t)b * Sq;
    const int pitem0 = ((b * 4 + hh) * 2 + dir) * nch;
    constexpr int BUF = 16384 * 3 + 8192 + 512;
    typedef unsigned gla_u32x4 __attribute__((ext_vector_type(4)));
    gla_u32x4 rq0, rq1, rk0, rk1, rv0, rv1, ra; float rd = 0.f;
#define GLA_VROW(c_, k_) ((tok0 + (size_t)(dir ? (Sq - 1 - (64 * (c_) + ((tid + 512 * (k_)) >> 4))) : (64 * (c_) + ((tid + 512 * (k_)) >> 4)))) * ldp + cv + hh * 256 + slice * 128 + ((tid + 512 * (k_)) & 15) * 8)
#define GLA_ISSUE(c_) do { \
        const gla_u32x4* qsrc_ = (const gla_u32x4*)(QDg + (size_t)(pitem0 + (c_)) * GLA_QD_BYTES); const gla_u32x4* ksrc_ = (const gla_u32x4*)(KEg + (size_t)(pitem0 + (c_)) * GLA_QD_BYTES); \
        rq0 = qsrc_[tid]; rq1 = qsrc_[tid + 512]; rk0 = ksrc_[tid]; rk1 = ksrc_[tid + 512]; \
        ra = ((const gla_u32x4*)(ATg + (size_t)(pitem0 + (c_)) * GLA_AT_BYTES))[tid]; \
        rv0 = *(const gla_u32x4*)(P + GLA_VROW(c_, 0)); rv1 = *(const gla_u32x4*)(P + GLA_VROW(c_, 1)); \
        if (tid < 128) rd = DECg[(size_t)(pitem0 + (c_)) * 128 + tid]; } while (0)
#define GLA_COMMIT(buf_) do { \
        unsigned char* base_ = lds + (buf_) * BUF; \
        ((gla_u32x4*)base_)[tid] = rq0; ((gla_u32x4*)base_)[tid + 512] = rq1; ((gla_u32x4*)(base_ + 16384))[tid] = rk0; ((gla_u32x4*)(base_ + 16384))[tid + 512] = rk1; \
        { const int row_ = tid >> 4, ch_ = tid & 15; *(gla_u32x4*)(base_ + 32768 + row_ * 256 + ((ch_ ^ (row_ & 15)) << 4)) = rv0; } \
        { const int row_ = (tid + 512) >> 4, ch_ = tid & 15; *(gla_u32x4*)(base_ + 32768 + row_ * 256 + ((ch_ ^ (row_ & 15)) << 4)) = rv1; } \
        ((gla_u32x4*)(base_ + 49152))[tid] = ra; \
        if (tid < 128) ((float*)(base_ + 57344))[tid] = rd; } while (0)
    f32x4 st[8];
#pragma unroll
    for (int dt = 0; dt < 8; ++dt) st[dt] = (f32x4){0.f, 0.f, 0.f, 0.f};
    __syncthreads();
    GLA_ISSUE(0); GLA_COMMIT(0);
    __syncthreads();
#pragma unroll 1
    for (int c = 0; c < nch; ++c) {
        const int buf = c & 1;
        if (c + 1 < nch) GLA_ISSUE(c + 1);
        const unsigned char* QDs = lds + buf * BUF; const unsigned char* KEs = QDs + 16384; const unsigned char* Vs = QDs + 32768;
        const unsigned char* ATs = QDs + 49152; const float* DECs = (const float*)(QDs + 57344);
        bf16x8 vf[2];
#pragma unroll
        for (int jp = 0; jp < 2; ++jp) {
            const int rowA = 32 * jp + 8 * fq + (li >> 2), rowB = rowA + 4;
            const int chunk = 2 * wave + ((li & 3) >> 1), sub = ((li & 3) & 1) * 8;
            const s16x4 va = __builtin_amdgcn_ds_read_tr16_b64_v4i16((LAS s16x4*)(Vs + rowA * 256 + ((chunk ^ (rowA & 15)) << 4) + sub));
            const s16x4 vb = __builtin_amdgcn_ds_read_tr16_b64_v4i16((LAS s16x4*)(Vs + rowB * 256 + ((chunk ^ (rowB & 15)) << 4) + sub));
            vf[jp][0] = va[0]; vf[jp][1] = va[1]; vf[jp][2] = va[2]; vf[jp][3] = va[3]; vf[jp][4] = vb[0]; vf[jp][5] = vb[1]; vf[jp][6] = vb[2]; vf[jp][7] = vb[3];
        }
        bf16x8 sf[4];
#pragma unroll
        for (int dp = 0; dp < 4; ++dp)
#pragma unroll
            for (int jj = 0; jj < 4; ++jj) { sf[dp][jj] = (short)f2bf(st[2 * dp][jj]); sf[dp][4 + jj] = (short)f2bf(st[2 * dp + 1][jj]); }
        f32x4 ot[4];
#pragma unroll
        for (int it = 0; it < 4; ++it) {
            f32x4 acc = (f32x4){0.f, 0.f, 0.f, 0.f};
            const int ir = 16 * it + li;
#pragma unroll
            for (int dp = 0; dp < 4; ++dp) {
                const int c0 = 4 * dp + (fq >> 1), c1 = c0 + 2, sub = (fq & 1) * 8;
                const uint2 lo = *(const uint2*)(QDs + ir * 256 + ((c0 ^ (ir & 15)) << 4) + sub);
                const uint2 hi = *(const uint2*)(QDs + ir * 256 + ((c1 ^ (ir & 15)) << 4) + sub);
                bf16x8 qf;
                qf[0] = (short)(lo.x & 0xffff); qf[1] = (short)(lo.x >> 16); qf[2] = (short)(lo.y & 0xffff); qf[3] = (short)(lo.y >> 16);
                qf[4] = (short)(hi.x & 0xffff); qf[5] = (short)(hi.x >> 16); qf[6] = (short)(hi.y & 0xffff); qf[7] = (short)(hi.y >> 16);
                acc = __builtin_amdgcn_mfma_f32_16x16x32_bf16(sf[dp], qf, acc, 0, 0, 0);
            }
#pragma unroll
            for (int jp = 0; jp < 2; ++jp) {
                if (32 * jp <= 16 * it + 15) {
                    const bf16x8 af = *(const bf16x8*)(ATs + ir * 128 + (((4 * jp + fq) ^ (ir & 7)) << 4));
                    acc = __builtin_amdgcn_mfma_f32_16x16x32_bf16(vf[jp], af, acc, 0, 0, 0);
                }
            }
            ot[it] = acc;
        }
#pragma unroll
        for (int dt = 0; dt < 8; ++dt) {
            const f32x4 dec = *(const f32x4*)(DECs + 16 * dt + 4 * fq);
            f32x4 acc = st[dt] * dec;
#pragma unroll
            for (int jp = 0; jp < 2; ++jp) {
                const int rowA = 32 * jp + 8 * fq + (li >> 2), rowB = rowA + 4;
                const int chunk = 2 * dt + ((li & 3) >> 1), sub = ((li & 3) & 1) * 8;
                const s16x4 ka = __builtin_amdgcn_ds_read_tr16_b64_v4i16((LAS s16x4*)(KEs + rowA * 256 + ((chunk ^ (rowA & 15)) << 4) + sub));
                const s16x4 kb = __builtin_amdgcn_ds_read_tr16_b64_v4i16((LAS s16x4*)(KEs + rowB * 256 + ((chunk ^ (rowB & 15)) << 4) + sub));
                bf16x8 kf;
                kf[0] = ka[0]; kf[1] = ka[1]; kf[2] = ka[2]; kf[3] = ka[3]; kf[4] = kb[0]; kf[5] = kb[1]; kf[6] = kb[2]; kf[7] = kb[3];
                acc = __builtin_amdgcn_mfma_f32_16x16x32_bf16(kf, vf[jp], acc, 0, 0, 0);
            }
            st[dt] = acc;
        }
#pragma unroll
        for (int it = 0; it < 4; ++it) {
            const int i = 16 * it + li;
            const int s = dir ? (Sq - 1 - (64 * c + i)) : (64 * c + i);
            *(uint2*)(Oout + ((size_t)dir * Ttot + tok0 + s) * 1024 + hh * 256 + slice * 128 + 16 * wave + 4 * fq) =
                make_uint2(pack2(ot[it][0], ot[it][1]), pack2(ot[it][2], ot[it][3]));
        }
        if (c + 1 < nch) GLA_COMMIT(buf ^ 1);
        __syncthreads();
    }
}
__device__ __forceinline__ void phase_rope_prep(const Args& a, unsigned char* lds) {
    u16* P = (u16*)(a.ws + WS_P);
    const float2* cs = (const float2*)(a.ws + WS_CS);
    const int gt = blockIdx.x * NTHREADS + threadIdx.x, NT = gridDim.x * NTHREADS;
    for (int i = gt; i < T * 2 * 8 * 64; i += NT) {
        const int f = i & 63, hh = (i >> 6) & 7, which = (i >> 9) & 1, t = i >> 10;
        const float2 c = cs[t * 64 + f];
        u16* p = P + (size_t)t * NP + (which ? C_DK : C_DQ) + hh * 128 + f;
        const float t1 = bf2f(p[0]), t2 = bf2f(p[64]);
        p[0] = f2bf(t1 * c.x - t2 * c.y);
        p[64] = f2bf(t1 * c.y + t2 * c.x);
    }
    for (int item = blockIdx.x; item < GLA_NPREP; item += gridDim.x)
        gla_prep_item(P, NP, C_GQ, C_GK, (const float*)(a.ws + WS_GZ), a.wgf, a.bgf, a.wgb, a.bgb, S,
                      a.ws + WS_QD, a.ws + WS_KE, a.ws + WS_AT, (float*)(a.ws + WS_DEC), lds, item);
}

__device__ __forceinline__ void attn_item(const u16* __restrict__ P, int ldp, int cq, int ck, int cv, int Sq,
                                          u16* __restrict__ part_o, float* __restrict__ part_lse, int Ttot,
                                          unsigned char* lds, int item) {
    const int tid = TID, lane = tid & 63, wave = tid >> 6, li = lane & 15, fq = lane >> 4;
    const int nb_per = Sq / 128;
    const int within = item % nb_per, hh = (item / nb_per) & 7, b = (item / (nb_per * 8)) & 3, pat = item / (nb_per * 32);
    const int dil = pat == 0 ? 1 : (pat == 1 ? 4 : 16);
    const int M = Sq / dil;
    const int r = within % dil, blk = within / dil;
    const int p0 = blk * 128, kbase = p0 - 64;
    unsigned char* Ks = lds;
    unsigned char* Vs = lds + 65536;
    const size_t tok0 = (size_t)b * Sq;
    __syncthreads();
#pragma unroll
    for (int i = 0; i < 8; ++i) {
        const int id = tid + 512 * i, row = id >> 4, c = id & 15;
        int kp = kbase + row; kp = kp < 0 ? 0 : (kp > M - 1 ? M - 1 : kp);
        const size_t t = tok0 + r + (size_t)dil * kp;
        const uint4 kv = *(const uint4*)(P + t * ldp + ck + hh * 128 + c * 8);
        const uint4 vv = *(const uint4*)(P + t * ldp + cv + hh * 128 + c * 8);
        const int off = row * 256 + ((c ^ (row & 15)) << 4);
        *(uint4*)(Ks + off) = kv;
        *(uint4*)(Vs + off) = vv;
    }
    const int qp = p0 + 16 * wave + li;
    const size_t tq = tok0 + r + (size_t)dil * qp;
    bf16x8 qf[4];
#pragma unroll
    for (int ks = 0; ks < 4; ++ks) qf[ks] = *(const bf16x8*)(P + tq * ldp + cq + hh * 128 + 32 * ks + 8 * fq);
    __syncthreads();
    const float scale = 0.08838834764831845f;
    float m = -1e30f, l = 0.f;
    f32x4 o[8];
#pragma unroll
    for (int dt = 0; dt < 8; ++dt) o[dt] = (f32x4){0.f, 0.f, 0.f, 0.f};
#pragma unroll 1
    for (int tp = 0; tp < 5; ++tp) {
        float s[8]; bool ok[8];
#pragma unroll
        for (int h2 = 0; h2 < 2; ++h2) {
            const int kk0 = 16 * wave + 16 * (2 * tp + h2);
            int krow = kk0 + li; krow = krow > 255 ? 255 : krow;
            f32x4 acc = (f32x4){0.f, 0.f, 0.f, 0.f};
#pragma unroll
            for (int ks = 0; ks < 4; ++ks) {
                const bf16x8 kf = *(const bf16x8*)(Ks + krow * 256 + (((4 * ks + fq) ^ (krow & 15)) << 4));
                acc = __builtin_amdgcn_mfma_f32_16x16x32_bf16(kf, qf[ks], acc, 0, 0, 0);
            }
#pragma unroll
            for (int j = 0; j < 4; ++j) {
                const int kp = kbase + kk0 + 4 * fq + j;
                const int rel = kp - qp;
                ok[4 * h2 + j] = (kp >= 0) && (kp < M) && (rel <= 64) && (rel >= -64);
                s[4 * h2 + j] = acc[j] * scale;
            }
        }
        float mx = -1e30f;
#pragma unroll
        for (int j = 0; j < 8; ++j) mx = ok[j] ? fmaxf(mx, s[j]) : mx;
        mx = fmaxf(mx, __shfl_xor(mx, 16));
        mx = fmaxf(mx, __shfl_xor(mx, 32));
        const float mn = fmaxf(m, mx);
        const float al = __expf(m - mn);
        float ps = 0.f; float p[8];
#pragma unroll
        for (int j = 0; j < 8; ++j) { p[j] = ok[j] ? __expf(s[j] - mn) : 0.f; ps += p[j]; }
        l = l * al + ps; m = mn;
        bf16x8 pf;
#pragma unroll
        for (int j = 0; j < 8; ++j) pf[j] = (short)f2bf(p[j]);
#pragma unroll
        for (int dt = 0; dt < 8; ++dt) o[dt] *= al;
        int rowA = 16 * wave + 32 * tp + 4 * fq + (li >> 2); rowA = rowA > 255 ? 255 : rowA;
        int rowB = 16 * wave + 32 * tp + 16 + 4 * fq + (li >> 2); rowB = rowB > 255 ? 255 : rowB;
#pragma unroll
        for (int dt = 0; dt < 8; ++dt) {
            const int chunk = 2 * dt + ((li & 3) >> 1), sub = ((li & 3) & 1) * 8;
            const s16x4 va = __builtin_amdgcn_ds_read_tr16_b64_v4i16((LAS s16x4*)(Vs + rowA * 256 + ((chunk ^ (rowA & 15)) << 4) + sub));
            const s16x4 vb = __builtin_amdgcn_ds_read_tr16_b64_v4i16((LAS s16x4*)(Vs + rowB * 256 + ((chunk ^ (rowB & 15)) << 4) + sub));
            bf16x8 vf;
            vf[0] = va[0]; vf[1] = va[1]; vf[2] = va[2]; vf[3] = va[3]; vf[4] = vb[0]; vf[5] = vb[1]; vf[6] = vb[2]; vf[7] = vb[3];
            o[dt] = __builtin_amdgcn_mfma_f32_16x16x32_bf16(vf, pf, o[dt], 0, 0, 0);
        }
    }
    l += __shfl_xor(l, 16);
    l += __shfl_xor(l, 32);
    const float inv = 1.f / l;
    u16* orow = part_o + ((size_t)pat * Ttot + tq) * 1024 + hh * 128 + 4 * fq;
#pragma unroll
    for (int dt = 0; dt < 8; ++dt)
        *(uint2*)(orow + 16 * dt) = make_uint2(pack2(o[dt][0] * inv, o[dt][1] * inv), pack2(o[dt][2] * inv, o[dt][3] * inv));
    if (fq == 0) part_lse[((size_t)pat * Ttot + tq) * 8 + hh] = m + logf(l);
}

__device__ __forceinline__ void attn_merge_token(const u16* __restrict__ part_o, const float* __restrict__ part_lse, int Ttot, size_t t,
                                                 u16* __restrict__ dst  , int lane) {
    const int hh = lane >> 3;
    const float l0 = part_lse[((size_t)0 * Ttot + t) * 8 + hh], l1 = part_lse[((size_t)1 * Ttot + t) * 8 + hh], l2 = part_lse[((size_t)2 * Ttot + t) * 8 + hh];
    const float mx = fmaxf(l0, fmaxf(l1, l2));
    const float e0 = __expf(l0 - mx), e1 = __expf(l1 - mx), e2 = __expf(l2 - mx);
    const float inv = 1.f / (e0 + e1 + e2);
    const float w[3] = {e0 * inv, e1 * inv, e2 * inv};
    float acc[16];
#pragma unroll
    for (int i = 0; i < 16; ++i) acc[i] = 0.f;
#pragma unroll
    for (int p = 0; p < 3; ++p) {
        const uint4* src = (const uint4*)(part_o + ((size_t)p * Ttot + t) * 1024 + lane * 16);
        const uint4 a = src[0], bb = src[1];
        acc[0] += w[p] * lo2f(a.x); acc[1] += w[p] * hi2f(a.x); acc[2] += w[p] * lo2f(a.y); acc[3] += w[p] * hi2f(a.y);
        acc[4] += w[p] * lo2f(a.z); acc[5] += w[p] * hi2f(a.z); acc[6] += w[p] * lo2f(a.w); acc[7] += w[p] * hi2f(a.w);
        acc[8] += w[p] * lo2f(bb.x); acc[9] += w[p] * hi2f(bb.x); acc[10] += w[p] * lo2f(bb.y); acc[11] += w[p] * hi2f(bb.y);
        acc[12] += w[p] * lo2f(bb.z); acc[13] += w[p] * hi2f(bb.z); acc[14] += w[p] * lo2f(bb.w); acc[15] += w[p] * hi2f(bb.w);
    }
    uint4* d = (uint4*)(dst + lane * 16);
    d[0] = make_uint4(pack2(acc[0], acc[1]), pack2(acc[2], acc[3]), pack2(acc[4], acc[5]), pack2(acc[6], acc[7]));
    d[1] = make_uint4(pack2(acc[8], acc[9]), pack2(acc[10], acc[11]), pack2(acc[12], acc[13]), pack2(acc[14], acc[15]));
}

__device__ __forceinline__ void phase_mixers(const Args& a, unsigned char* lds) {
    const int bi = blockIdx.x, G = gridDim.x;
    if (bi < 64) {
        gla_seq_item((const u16*)(a.ws + WS_P), NP, C_GV, S, a.ws + WS_QD, a.ws + WS_KE, a.ws + WS_AT, (const float*)(a.ws + WS_DEC),
                     (u16*)(a.ws + WS_OFB), T, lds, bi);
    } else {
        u16* part_o = (u16*)a.out; float* part_lse = (float*)((unsigned char*)a.out + (size_t)3 * T * 1024 * 2);
        for (int item = bi - 64; item < 3 * 4 * 8 * (S / 128); item += G - 64)
            attn_item((const u16*)(a.ws + WS_P), NP, C_DQ, C_DK, C_DV, S, part_o, part_lse, T, lds, item);
    }
}

__device__ __forceinline__ void phase_gla_fin(const Args& a) {
    const u16* Of = (const u16*)(a.ws + WS_OFB);
    const u16* Ob = Of + (size_t)T * 1024;
    const u16* P = (const u16*)(a.ws + WS_P);
    u16* A2 = (u16*)(a.ws + WS_ACT);
    const int lane = threadIdx.x & 63, wave = threadIdx.x >> 6;
    const int gw = blockIdx.x * NWAVES + wave, NGW = gridDim.x * NWAVES;
    for (int item = gw; item < T * 4; item += NGW) {
        const int hh = item & 3, t = item >> 2;
        const size_t base = (size_t)t * 1024 + hh * 256 + lane * 4;
        const uint2 f = *(const uint2*)(Of + base), bb = *(const uint2*)(Ob + base);
        const float o0 = lo2f(f.x) + lo2f(bb.x), o1 = hi2f(f.x) + hi2f(bb.x), o2 = lo2f(f.y) + lo2f(bb.y), o3 = hi2f(f.y) + hi2f(bb.y);
        const float ss = wave_sum(o0 * o0 + o1 * o1 + o2 * o2 + o3 * o3);
        const float rstd = rsqrtf(ss * (1.f / 256.f) + NORM_EPS);
        const float4 gg = *(const float4*)(a.g_gla + hh * 256 + lane * 4);
        const uint2 rp = *(const uint2*)(P + (size_t)t * NP + C_GR + hh * 256 + lane * 4);
        const float r0 = lo2f(rp.x), r1 = hi2f(rp.x), r2 = lo2f(rp.y), r3 = hi2f(rp.y);
        const float y0 = o0 * rstd * gg.x * silu_f(r0), y1 = o1 * rstd * gg.y * silu_f(r1);
        const float y2 = o2 * rstd * gg.z * silu_f(r2), y3 = o3 * rstd * gg.w * silu_f(r3);
        *(uint2*)(A2 + (size_t)t * D + hh * 256 + lane * 4) = make_uint2(pack2(y0, y1), pack2(y2, y3));
    }
    const u16* part_o = (const u16*)a.out; const float* part_lse = (const float*)((const unsigned char*)a.out + (size_t)3 * T * 1024 * 2);
    for (int t = gw; t < T; t += NGW) attn_merge_token(part_o, part_lse, T, (size_t)t, A2 + (size_t)t * D + 1024, lane);
}

typedef float f32x16 __attribute__((ext_vector_type(16)));
#define RT_CE(a_, b_) do { const float hi_ = fmaxf(a_, b_), lo_ = fminf(a_, b_); a_ = hi_; b_ = lo_; } while (0)
template <int N> __device__ __forceinline__ void rt_sort_desc(float (&v)[N], int base) {
#pragma unroll
    for (int k = 2; k <= 16; k <<= 1)
#pragma unroll
        for (int j = k >> 1; j > 0; j >>= 1)
#pragma unroll
            for (int i = 0; i < 16; ++i) {
                const int l = i ^ j;
                if (l > i) { if ((i & k) == 0) RT_CE(v[base + i], v[base + l]); else RT_CE(v[base + l], v[base + i]); }
            }
}
template <int N> __device__ __forceinline__ void rt_merge_desc(float (&v)[N], int a, int b) {
#pragma unroll
    for (int i = 0; i < 16; ++i) v[a + i] = fmaxf(v[a + i], v[b + 15 - i]);
#pragma unroll
    for (int j = 8; j > 0; j >>= 1)
#pragma unroll
        for (int i = 0; i < 16; ++i) { const int l = i ^ j; if (l > i) RT_CE(v[a + i], v[a + l]); }
}

__device__ __forceinline__ void route_stage_keys(const float* __restrict__ subk, int hh, unsigned char* lds) {
    const int tid = TID;
    __syncthreads();
    for (int e = tid; e < 2 * 128 * 16; e += 512) {
        const int c = e & 15, row = e >> 4;
        const float* src = subk + ((size_t)(hh * 2) * 128 + row) * 128 + c * 8;
        const float4 v0 = *(const float4*)src, v1 = *(const float4*)(src + 4);
        *(uint4*)(lds + row * 256 + ((c ^ (row & 15)) << 4)) = make_uint4(pack2(v0.x, v0.y), pack2(v0.z, v0.w), pack2(v1.x, v1.y), pack2(v1.z, v1.w));
    }
    __syncthreads();
}

__device__ __forceinline__ void route_tile(const u16* __restrict__ Q, int ldq, int hh, int tok_base, const unsigned char* lds,
                                           int* __restrict__ IDX, float* __restrict__ GATE) {
    const int lane = TID & 63, r = lane & 31, h = lane >> 5;
    float sc[128];
    {
        f32x16 X[4], Y[4];
#pragma unroll
        for (int kt = 0; kt < 4; ++kt) {
#pragma unroll
            for (int i = 0; i < 16; ++i) { X[kt][i] = 0.f; Y[kt][i] = 0.f; }
        }
        const u16* qrow = Q + (size_t)(tok_base + r) * ldq + hh * 256;
#pragma unroll
        for (int half = 0; half < 2; ++half) {
            bf16x8 qf[8];
#pragma unroll
            for (int ks = 0; ks < 8; ++ks) qf[ks] = *(const bf16x8*)(qrow + half * 128 + 16 * ks + 8 * h);
#pragma unroll
            for (int kt = 0; kt < 4; ++kt) {
                const int krow = half * 128 + 32 * kt + r;
#pragma unroll
                for (int ks = 0; ks < 8; ++ks) {
                    const bf16x8 kf = *(const bf16x8*)(lds + krow * 256 + (((2 * ks + h) ^ (krow & 15)) << 4));
                    if (half == 0) X[kt] = __builtin_amdgcn_mfma_f32_32x32x16_bf16(kf, qf[ks], X[kt], 0, 0, 0);
                    else Y[kt] = __builtin_amdgcn_mfma_f32_32x32x16_bf16(kf, qf[ks], Y[kt], 0, 0, 0);
                }
            }
        }
#pragma unroll
        for (int kt = 0; kt < 4; ++kt)
#pragma unroll
            for (int i = 0; i < 16; ++i) {
                const auto sw = __builtin_amdgcn_permlane32_swap(__float_as_uint(X[kt][i]), __float_as_uint(Y[kt][i]), false, false);
                const int key0 = 32 * kt + (i & 3) + 8 * (i >> 2);
                sc[kt * 32 + i] = __uint_as_float((sw[0] & 0xffffff80u) | (unsigned)key0);
                sc[kt * 32 + 16 + i] = __uint_as_float((sw[1] & 0xffffff80u) | (unsigned)(key0 + 4));
            }
    }
#pragma unroll
    for (int g = 0; g < 8; ++g) rt_sort_desc(sc, 16 * g);
    rt_merge_desc(sc, 0, 16); rt_merge_desc(sc, 32, 48); rt_merge_desc(sc, 64, 80); rt_merge_desc(sc, 96, 112);
    rt_merge_desc(sc, 0, 32); rt_merge_desc(sc, 64, 96);
    rt_merge_desc(sc, 0, 64);
    float l0[16], l1[16];
#pragma unroll
    for (int i = 0; i < 16; ++i) {
        const auto sw = __builtin_amdgcn_permlane32_swap(__float_as_uint(sc[i]), __float_as_uint(sc[i]), false, false);
        l0[i] = __uint_as_float(sw[0]); l1[i] = __uint_as_float(sw[1]);
    }
    float s0[16], s1[16]; int k0[16], k1[16];
#pragma unroll
    for (int i = 0; i < 16; ++i) {
        const unsigned a = __float_as_uint(l0[i]), b = __float_as_uint(l1[i]);
        s0[i] = __uint_as_float(a & 0xffffff80u); k0[i] = (int)(a & 0x7fu);
        s1[i] = __uint_as_float(b & 0xffffff80u); k1[i] = (int)(b & 0x7fu);
    }
    float cs[64];
    {
        int n = 0;
#pragma unroll
        for (int i = 0; i < 16; ++i)
#pragma unroll
            for (int j = 0; j < 16; ++j)
                if ((i + 1) * (j + 1) <= 16) { cs[n] = s0[i] + s1[j]; ++n; }
#pragma unroll
        for (int q = 50; q < 64; ++q) cs[q] = -3.0e38f;
    }
    float ct[64];
#pragma unroll
    for (int q = 0; q < 64; ++q) ct[q] = cs[q];
#pragma unroll
    for (int g = 0; g < 4; ++g) rt_sort_desc(ct, 16 * g);
    rt_merge_desc(ct, 0, 16); rt_merge_desc(ct, 32, 48); rt_merge_desc(ct, 0, 32);
    const float theta = ct[15], smax = ct[0];
    float den = 0.f;
    {
        int cnt = 0;
#pragma unroll
        for (int q = 0; q < 50; ++q) { const bool sel = (cs[q] >= theta) && (cnt < 16); den += sel ? __expf(cs[q] - smax) : 0.f; cnt += sel ? 1 : 0; }
    }
    const float inv = 1.f / den;
    const size_t obase = (size_t)(tok_base + r) * 128 + hh * 16;
    int pos = 0;
    {
        int n = 0;
#pragma unroll
        for (int i = 0; i < 16; ++i)
#pragma unroll
            for (int j = 0; j < 16; ++j)
                if ((i + 1) * (j + 1) <= 16) {
                    const bool sel = (cs[n] >= theta) && (pos < 16);
                    if (sel) {
                        if (h == 0) IDX[obase + pos] = k0[i] * 128 + k1[j];
                        else GATE[obase + pos] = __expf(cs[n] - smax) * inv;
                        ++pos;
                    }
                    ++n;
                }
    }
}
__device__ __forceinline__ void phase_route(const Args& a, unsigned char* lds) {
    const int hh = BID & 7, grp = BID >> 3, ngrp = GDIM >> 3, wave = TID >> 6;
    route_stage_keys(a.subk, hh, lds);
    int j = 0;
    for (int tile = grp; tile < T / 32; tile += ngrp, ++j)
        if ((j & 7) == wave) route_tile((const u16*)(a.ws + WS_Q), D, hh, tile * 32, lds, (int*)(a.ws + WS_IDX), (float*)(a.ws + WS_GATE));
    __syncthreads();
}

typedef __bf16 bf16x2_t __attribute__((ext_vector_type(2)));
__device__ __forceinline__ float dot2bf(unsigned w, unsigned x, float acc) {
    return __builtin_amdgcn_fdot2_f32_bf16(__builtin_bit_cast(bf16x2_t, w), __builtin_bit_cast(bf16x2_t, x), acc, false);
}
constexpr float U_SCALE = 64.f, V_SCALE = 4.f;
typedef float f32x2_t __attribute__((ext_vector_type(2)));
__device__ __forceinline__ unsigned pk4_fp8(float a, float b, float c, float d, float s) {
    int p = __builtin_amdgcn_cvt_pk_fp8_f32(a * s, b * s, 0, false);
    p = __builtin_amdgcn_cvt_pk_fp8_f32(c * s, d * s, p, true);
    return (unsigned)p;
}
__device__ __forceinline__ void convert_tables(const Args& a) {
    uint4* U = (uint4*)(a.ws + WS_TU); uint4* V = (uint4*)(a.ws + WS_TV);
    const size_t n16 = (size_t)16384 * D / 16;
    const size_t gt = (size_t)blockIdx.x * NTHREADS + threadIdx.x, NT = (size_t)gridDim.x * NTHREADS;
    for (size_t i = gt; i < 2 * n16; i += NT) {
        const bool isv = i >= n16; const size_t j = isv ? i - n16 : i;
        const f32x4* sp = (const f32x4*)(isv ? a.pv : a.pu) + 4 * j;
        const f32x4 v0 = __builtin_nontemporal_load(sp), v1 = __builtin_nontemporal_load(sp + 1), v2 = __builtin_nontemporal_load(sp + 2), v3 = __builtin_nontemporal_load(sp + 3);
        const float s = isv ? V_SCALE : U_SCALE;
        const uint4 o = make_uint4(pk4_fp8(v0[0], v0[1], v0[2], v0[3], s), pk4_fp8(v1[0], v1[1], v1[2], v1[3], s), pk4_fp8(v2[0], v2[1], v2[2], v2[3], s), pk4_fp8(v3[0], v3[1], v3[2], v3[3], s));
        (isv ? V : U)[j] = o;
    }
}

__device__ __forceinline__ float dot16_fp8(const uint4 w, const float (&h)[16], float acc) {
    const f32x2_t a0 = __builtin_amdgcn_cvt_pk_f32_fp8((int)w.x, false), a1 = __builtin_amdgcn_cvt_pk_f32_fp8((int)w.x, true);
    const f32x2_t a2 = __builtin_amdgcn_cvt_pk_f32_fp8((int)w.y, false), a3 = __builtin_amdgcn_cvt_pk_f32_fp8((int)w.y, true);
    const f32x2_t a4 = __builtin_amdgcn_cvt_pk_f32_fp8((int)w.z, false), a5 = __builtin_amdgcn_cvt_pk_f32_fp8((int)w.z, true);
    const f32x2_t a6 = __builtin_amdgcn_cvt_pk_f32_fp8((int)w.w, false), a7 = __builtin_amdgcn_cvt_pk_f32_fp8((int)w.w, true);
    acc += a0.x * h[0] + a0.y * h[1] + a1.x * h[2] + a1.y * h[3] + a2.x * h[4] + a2.y * h[5] + a3.x * h[6] + a3.y * h[7]
         + a4.x * h[8] + a4.y * h[9] + a5.x * h[10] + a5.y * h[11] + a6.x * h[12] + a6.y * h[13] + a7.x * h[14] + a7.y * h[15];
    return acc;
}
__device__ __forceinline__ void axpy16_fp8(const uint4 w, const float s, float (&acc)[16]) {
    const f32x2_t a0 = __builtin_amdgcn_cvt_pk_f32_fp8((int)w.x, false), a1 = __builtin_amdgcn_cvt_pk_f32_fp8((int)w.x, true);
    const f32x2_t a2 = __builtin_amdgcn_cvt_pk_f32_fp8((int)w.y, false), a3 = __builtin_amdgcn_cvt_pk_f32_fp8((int)w.y, true);
    const f32x2_t a4 = __builtin_amdgcn_cvt_pk_f32_fp8((int)w.z, false), a5 = __builtin_amdgcn_cvt_pk_f32_fp8((int)w.z, true);
    const f32x2_t a6 = __builtin_amdgcn_cvt_pk_f32_fp8((int)w.w, false), a7 = __builtin_amdgcn_cvt_pk_f32_fp8((int)w.w, true);
    acc[0] += s * a0.x; acc[1] += s * a0.y; acc[2] += s * a1.x; acc[3] += s * a1.y; acc[4] += s * a2.x; acc[5] += s * a2.y; acc[6] += s * a3.x; acc[7] += s * a3.y;
    acc[8] += s * a4.x; acc[9] += s * a4.y; acc[10] += s * a5.x; acc[11] += s * a5.y; acc[12] += s * a6.x; acc[13] += s * a6.y; acc[14] += s * a7.x; acc[15] += s * a7.y;
}
__device__ __forceinline__ void phase_experts(const Args& a) {
    const u16* H2 = (const u16*)(a.ws + WS_ACT);
    const float* X1 = (const float*)(a.ws + WS_X1);
    const int* IDX = (const int*)(a.ws + WS_IDX);
    const float* GATE = (const float*)(a.ws + WS_GATE);
    const float* mod = (const float*)(a.ws + WS_MOD);
    const uint4* U = (const uint4*)(a.ws + WS_TU); const uint4* V = (const uint4*)(a.ws + WS_TV);
    const int lane = threadIdx.x & 63, wave = threadIdx.x >> 6;
    const int gw = blockIdx.x * NWAVES + wave, NGW = gridDim.x * NWAVES;
    for (int t = gw; t < T; t += NGW) {
        const int b = t / S;
        float h[2][16], acc[2][16];
#pragma unroll
        for (int m = 0; m < 2; ++m) {
            const uint4* hp = (const uint4*)(H2 + (size_t)t * D + lane * 16 + 1024 * m);
            const uint4 p0 = hp[0], p1 = hp[1];
            h[m][0] = lo2f(p0.x); h[m][1] = hi2f(p0.x); h[m][2] = lo2f(p0.y); h[m][3] = hi2f(p0.y); h[m][4] = lo2f(p0.z); h[m][5] = hi2f(p0.z); h[m][6] = lo2f(p0.w); h[m][7] = hi2f(p0.w);
            h[m][8] = lo2f(p1.x); h[m][9] = hi2f(p1.x); h[m][10] = lo2f(p1.y); h[m][11] = hi2f(p1.y); h[m][12] = lo2f(p1.z); h[m][13] = hi2f(p1.z); h[m][14] = lo2f(p1.w); h[m][15] = hi2f(p1.w);
#pragma unroll
            for (int i = 0; i < 16; ++i) acc[m][i] = 0.f;
        }
#pragma unroll 1
        for (int r0 = 0; r0 < 128; r0 += 2) {
            const int2 e2 = *(const int2*)(IDX + (size_t)t * 128 + r0);
            const float2 g2 = *(const float2*)(GATE + (size_t)t * 128 + r0);
            const int e[2] = {__builtin_amdgcn_readfirstlane(e2.x), __builtin_amdgcn_readfirstlane(e2.y)};
            const float g[2] = {g2.x, g2.y};
            uint4 u[2][2], v[2][2];
#pragma unroll
            for (int q = 0; q < 2; ++q)
#pragma unroll
                for (int m = 0; m < 2; ++m) u[q][m] = U[(size_t)e[q] * 128 + lane + 64 * m];
#pragma unroll
            for (int q = 0; q < 2; ++q)
#pragma unroll
                for (int m = 0; m < 2; ++m) v[q][m] = V[(size_t)e[q] * 128 + lane + 64 * m];
            float d[2];
#pragma unroll
            for (int q = 0; q < 2; ++q) d[q] = dot16_fp8(u[q][1], h[1], dot16_fp8(u[q][0], h[0], 0.f));
#pragma unroll
            for (int o = 32; o > 0; o >>= 1) {
#pragma unroll
                for (int q = 0; q < 2; ++q) d[q] += __shfl_xor(d[q], o);
            }
#pragma unroll
            for (int q = 0; q < 2; ++q) { const float w = g[q] * gelu_f(d[q] * (1.f / U_SCALE)) * (1.f / V_SCALE);
                axpy16_fp8(v[q][0], w, acc[0]); axpy16_fp8(v[q][1], w, acc[1]); }
        }
        float ss = 0.f;
#pragma unroll
        for (int m = 0; m < 2; ++m)
#pragma unroll
            for (int k = 0; k < 4; ++k) {
                const int c0 = lane * 16 + 1024 * m + 4 * k;
                const float4 xa = *(const float4*)(X1 + (size_t)t * D + c0);
                const float4 ga = *(const float4*)(mod + b * 12288 + 5 * 2048 + c0);
                acc[m][4 * k + 0] = xa.x + ga.x * acc[m][4 * k + 0]; acc[m][4 * k + 1] = xa.y + ga.y * acc[m][4 * k + 1];
                acc[m][4 * k + 2] = xa.z + ga.z * acc[m][4 * k + 2]; acc[m][4 * k + 3] = xa.w + ga.w * acc[m][4 * k + 3];
#pragma unroll
                for (int i = 0; i < 4; ++i) ss += acc[m][4 * k + i] * acc[m][4 * k + i];
            }
        ss = wave_sum(ss);
        const float rstd = rsqrtf(ss * (1.f / D) + NORM_EPS);
#pragma unroll
        for (int m = 0; m < 2; ++m)
#pragma unroll
            for (int k = 0; k < 4; ++k) {
                const int c0 = lane * 16 + 1024 * m + 4 * k;
                const float4 gf = *(const float4*)(a.g_fin + c0);
                *(float4*)(a.out + (size_t)t * D + c0) = make_float4(acc[m][4 * k + 0] * rstd * gf.x, acc[m][4 * k + 1] * rstd * gf.y, acc[m][4 * k + 2] * rstd * gf.z, acc[m][4 * k + 3] * rstd * gf.w);
            }
    }
}

constexpr int NPHASES = 11;
__global__ void __launch_bounds__(NTHREADS, 2) mk_fwd(Args a) {
    extern __shared__ __attribute__((aligned(16))) unsigned char lds[];
    cg::grid_group grid = cg::this_grid();
    const int lo = a.ph_lo, hi = a.ph_hi;
#define IN(k) (lo <= (k) && (k) < hi)
#define SEAM(k) do { if (IN(k) && IN((k) + 1)) grid.sync(); } while (0)
    const float* mod = (const float*)(a.ws + WS_MOD);
    if (IN(0)) phase0(a, lds);
    SEAM(0);
    if (IN(1)) norm_mod_phase(a.x, a.g_mix, mod, 0, 1, (u16*)(a.ws + WS_ACT));
    SEAM(1);
    if (IN(2)) gemm8(lds, (const u16*)(a.ws + WS_ACT), (const u16*)(a.ws + WS_WIN), T, NPAD, D, EpiProj{(u16*)(a.ws + WS_P), (float*)(a.ws + WS_GZ)});
    SEAM(2);
    if (IN(3)) phase_rope_prep(a, lds);
    SEAM(3);
    if (IN(4)) phase_mixers(a, lds);
    SEAM(4);
    if (IN(5)) phase_gla_fin(a);
    SEAM(5);
    if (IN(6)) gemm8(lds, (const u16*)(a.ws + WS_ACT), (const u16*)(a.ws + WS_WOUT), T, D, D, EpiResid{a.x, mod, (float*)(a.ws + WS_X1)});
    SEAM(6);
    if (IN(7)) { norm_mod_phase((const float*)(a.ws + WS_X1), a.g_ffn, mod, 3, 4, (u16*)(a.ws + WS_ACT)); convert_tables(a); }
    SEAM(7);
    if (IN(8)) gemm8(lds, (const u16*)(a.ws + WS_ACT), (const u16*)(a.ws + WS_WPQ), T, D, D, EpiBf16{(u16*)(a.ws + WS_Q)});
    SEAM(8);
    if (IN(9)) phase_route(a, lds);
    SEAM(9);
    if (IN(10)) phase_experts(a);
#ifdef PROBE_REP10
    grid.sync(); phase_experts(a);
#endif
#ifdef PROBE_REP9
    grid.sync(); phase_route(a, lds); grid.sync(); phase_experts(a);
#endif
#undef IN
#undef SEAM
}

#ifndef MK_ONE_LAUNCH
#define MK_ONE_LAUNCH 1
#endif
extern "C" void kernel_launch(void* const* d_in, const int* in_sizes, int n_in, void* d_out, int out_size, void* d_ws, size_t ws_size, hipStream_t stream) {
    static int grid = 0;
    if (grid == 0) {
        if (n_in != 19 || out_size != T * D || ws_size < WS_END) {
            fprintf(stderr, "kernel_launch: unexpected shapes: n_in %d out %d ws %zu (need %zu)\n", n_in, out_size, ws_size, (size_t)WS_END);
            grid = -1; return;
        }
        int dev = 0, cus = 0, per_cu = 0;
        (void)hipGetDevice(&dev);
        (void)hipDeviceGetAttribute(&cus, hipDeviceAttributeMultiprocessorCount, dev);
        (void)hipFuncSetAttribute((const void*)mk_fwd, hipFuncAttributeMaxDynamicSharedMemorySize, LDS_BYTES);
        (void)hipOccupancyMaxActiveBlocksPerMultiprocessor(&per_cu, (const void*)mk_fwd, NTHREADS, LDS_BYTES);
        if (per_cu < 1) { fprintf(stderr, "kernel_launch: occupancy query says %d blocks/CU\n", per_cu); grid = -1; return; }
        grid = cus;
        (void)hipGetLastError();
    }
    if (grid < 0) return;
    Args a{};
    a.x = (const float*)d_in[0]; a.c = (const float*)d_in[1]; a.pos = (const int*)d_in[2]; a.w_ada = (const float*)d_in[3];
    a.b_ada = (const float*)d_in[4]; a.g_mix = (const float*)d_in[5]; a.w_in = (const float*)d_in[6]; a.wgf = (const float*)d_in[7];
    a.bgf = (const float*)d_in[8]; a.wgb = (const float*)d_in[9]; a.bgb = (const float*)d_in[10]; a.g_gla = (const float*)d_in[11];
    a.w_out = (const float*)d_in[12]; a.g_ffn = (const float*)d_in[13]; a.w_pq = (const float*)d_in[14]; a.subk = (const float*)d_in[15];
    a.pu = (const float*)d_in[16]; a.pv = (const float*)d_in[17]; a.g_fin = (const float*)d_in[18];
    a.out = (float*)d_out; a.ws = (unsigned char*)d_ws;
#if MK_ONE_LAUNCH
    a.ph_lo = 0; a.ph_hi = NPHASES;
    void* args[] = {&a};
    hipError_t e = hipLaunchCooperativeKernel((const void*)mk_fwd, dim3(grid), dim3(NTHREADS), args, LDS_BYTES, stream);
    if (e != hipSuccess) fprintf(stderr, "cooperative launch failed: %s (grid %d)\n", hipGetErrorString(e), grid);
#else
    for (int p = 0; p < NPHASES; ++p) {
        a.ph_lo = p; a.ph_hi = p + 1;
        hipLaunchKernelGGL(mk_fwd, dim3(grid), dim3(NTHREADS), LDS_BYTES, stream, a);
    }
#endif
}
```

```cpp
#include <hip/hip_runtime.h>
#include <hip/hip_cooperative_groups.h>
#include <cstdio>
#include <cstdint>

namespace cg = cooperative_groups;

typedef unsigned short u16;
typedef __attribute__((ext_vector_type(8))) short bf16x8;
typedef __attribute__((ext_vector_type(4))) float f32x4;
typedef short s16x4 __attribute__((ext_vector_type(4)));
#define TID ((int)threadIdx.x)
#define BID ((int)blockIdx.x)
#define GDIM ((int)gridDim.x)
#define LAS __attribute__((address_space(3)))

constexpr int D = 2048, NB = 4, S = 4096, T = NB * S;
constexpr int INW = 6176;
constexpr int NP = 6144;
constexpr int NPAD = 6400;
constexpr int C_GQ = 0, C_GK = 512, C_GV = 1024, C_GR = 2048, C_DQ = 3072, C_DK = 4096, C_DV = 5120;
constexpr int NTHREADS = 512, NWAVES = 8;
constexpr int LDS_MAIN = 128 * 1024;
constexpr int LDS_BYTES = LDS_MAIN + 16;
constexpr float NORM_EPS = 1e-6f;

constexpr size_t WS_CTL = 0;
constexpr size_t WS_MOD = 65536;
constexpr size_t WS_CS = 524288;
constexpr size_t WS_WIN = WS_CS + (size_t)T * 64 * 8;
constexpr size_t WS_WOUT = WS_WIN + (size_t)NPAD * D * 2;
constexpr size_t WS_WPQ = WS_WOUT + (size_t)D * D * 2;
constexpr size_t WS_ACT = WS_WPQ + (size_t)D * D * 2;
constexpr size_t WS_P = WS_ACT + (size_t)T * D * 2;
constexpr size_t WS_X1 = WS_P;
constexpr size_t WS_Q = WS_P + (size_t)T * D * 4;
constexpr size_t WS_GZ = WS_P + (size_t)T * NP * 2;
constexpr int GLA_NPREP = NB * 4 * 2 * (S / 64);
constexpr size_t WS_QD = WS_GZ + (size_t)T * 32 * 4;
constexpr size_t WS_KE = WS_QD + (size_t)GLA_NPREP * 16384;
constexpr size_t WS_AT = WS_KE + (size_t)GLA_NPREP * 16384;
constexpr size_t WS_DEC = WS_AT + (size_t)GLA_NPREP * 8192;
constexpr size_t WS_OFB = WS_DEC + (size_t)GLA_NPREP * 512;
constexpr size_t WS_IDX = WS_OFB + (size_t)2 * T * 1024 * 2;
constexpr size_t WS_GATE = WS_IDX + (size_t)T * 128 * 4;
constexpr size_t WS_END = WS_GATE + (size_t)T * 128 * 4;
constexpr size_t WS_TU = WS_QD;
constexpr size_t WS_TV = WS_QD + (size_t)16384 * D;
static_assert(WS_TV + (size_t)16384 * D <= WS_IDX, "table region");

struct Args {
    const float* x; const float* c; const int* pos; const float* w_ada; const float* b_ada; const float* g_mix;
    const float* w_in; const float* wgf; const float* bgf; const float* wgb; const float* bgb; const float* g_gla;
    const float* w_out; const float* g_ffn; const float* w_pq; const float* subk; const float* pu; const float* pv; const float* g_fin;
    float* out; unsigned char* ws; int ph_lo, ph_hi;
};

__device__ __forceinline__ float bf2f(u16 h) { return __uint_as_float(((unsigned)h) << 16); }
__device__ __forceinline__ u16 f2bf(float f) { unsigned u = __float_as_uint(f); u += 0x7fffu + ((u >> 16) & 1u); return (u16)(u >> 16); }
__device__ __forceinline__ unsigned pack2(float a, float b) { return (unsigned)f2bf(a) | ((unsigned)f2bf(b) << 16); }
__device__ __forceinline__ float lo2f(unsigned p) { return __uint_as_float(p << 16); }
__device__ __forceinline__ float hi2f(unsigned p) { return __uint_as_float(p & 0xffff0000u); }
__device__ __forceinline__ float wave_sum(float v) {
#pragma unroll
    for (int o = 32; o > 0; o >>= 1) v += __shfl_xor(v, o);
    return v;
}
__device__ __forceinline__ float wave_max(float v) {
#pragma unroll
    for (int o = 32; o > 0; o >>= 1) v = fmaxf(v, __shfl_xor(v, o));
    return v;
}
__device__ __forceinline__ float silu_f(float v) { return v / (1.f + __expf(-v)); }
__device__ __forceinline__ float gelu_f(float a) { return 0.5f * a * (1.f + erff(a * 0.70710678118654752f)); }
__device__ __forceinline__ float logsigmoid_f(float z) { return z < 0.f ? z - log1pf(expf(z)) : -log1pf(expf(-z)); }

__device__ __forceinline__ void p0_mod(const Args& a, unsigned char* lds, int bi) {
    float* sc = (float*)lds;
    float* red = sc + 4 * 2048;
    const int tid = threadIdx.x, lane = tid & 63, wave = tid >> 6;
    for (int i = tid; i < 4 * 2048; i += NTHREADS) sc[i] = silu_f(a.c[i]);
    __syncthreads();
    const int j0 = bi * 256 + lane * 4;
    float acc[4][4];
#pragma unroll
    for (int b = 0; b < 4; ++b)
#pragma unroll
        for (int q = 0; q < 4; ++q) acc[b][q] = 0.f;
    const int k0 = wave * 256;
#pragma unroll 4
    for (int kk = 0; kk < 256; ++kk) {
        const int k = k0 + kk;
        const float4 w = *(const float4*)(a.w_ada + (size_t)k * 12288 + j0);
#pragma unroll
        for (int b = 0; b < 4; ++b) {
            const float s = sc[b * 2048 + k];
            acc[b][0] += s * w.x; acc[b][1] += s * w.y; acc[b][2] += s * w.z; acc[b][3] += s * w.w;
        }
    }
#pragma unroll
    for (int b = 0; b < 4; ++b)
#pragma unroll
        for (int q = 0; q < 4; ++q) red[(wave * 4 + b) * 256 + lane * 4 + q] = acc[b][q];
    __syncthreads();
    float* mod = (float*)(a.ws + WS_MOD);
    for (int i = tid; i < 4 * 256; i += NTHREADS) {
        const int b = i >> 8, jc = i & 255;
        float s = 0.f;
#pragma unroll
        for (int w = 0; w < 8; ++w) s += red[(w * 4 + b) * 256 + jc];
        mod[b * 12288 + bi * 256 + jc] = s + a.b_ada[bi * 256 + jc];
    }
    __syncthreads();
}

__device__ __forceinline__ void p0_transpose_item(const float* __restrict__ W, int ldw, int k0, int src_col0, int n_valid,
                                                  u16* __restrict__ WT, int ldt, int n_out0, unsigned char* lds) {
    u16* tl = (u16*)lds;
    const int tid = threadIdx.x;
    {
        const int k = tid >> 3, nc = (tid & 7) * 8;
        float v[8];
        if (nc < n_valid) {
            const float4 v0 = *(const float4*)(W + (size_t)(k0 + k) * ldw + src_col0 + nc);
            const float4 v1 = *(const float4*)(W + (size_t)(k0 + k) * ldw + src_col0 + nc + 4);
            v[0] = v0.x; v[1] = v0.y; v[2] = v0.z; v[3] = v0.w; v[4] = v1.x; v[5] = v1.y; v[6] = v1.z; v[7] = v1.w;
        } else {
#pragma unroll
            for (int i = 0; i < 8; ++i) v[i] = 0.f;
        }
#pragma unroll
        for (int i = 0; i < 8; ++i) tl[(nc + i) * 72 + k] = f2bf(v[i]);
    }
    __syncthreads();
    {
        const int n = tid >> 3, kc = (tid & 7) * 8;
        const uint4 v = *(const uint4*)(tl + n * 72 + kc);
        *(uint4*)(WT + (size_t)(n_out0 + n) * ldt + k0 + kc) = v;
    }
    __syncthreads();
}

__device__ __forceinline__ void phase0(const Args& a, unsigned char* lds) {
    const int bi = blockIdx.x, G = gridDim.x, tid = threadIdx.x;
    if (bi < 48) p0_mod(a, lds, bi);
    constexpr int I_IN = 32 * (NPAD / 64), I_SQ = 32 * 32;
    u16* WinT = (u16*)(a.ws + WS_WIN); u16* WoutT = (u16*)(a.ws + WS_WOUT); u16* WpqT = (u16*)(a.ws + WS_WPQ);
    for (int it = bi; it < I_IN + 2 * I_SQ; it += G) {
        if (it < I_IN) {
            const int kt = it & 31, nt = it >> 5;
            const int n0 = nt * 64;
            int src, nv;
            if (n0 < 3072) { src = n0; nv = 64; }
            else if (n0 < 6144) { src = n0 + 32; nv = 64; }
            else if (n0 == 6144) { src = 3072; nv = 32; }
            else { src = 0; nv = 0; }
            p0_transpose_item(a.w_in, INW, kt * 64, src, nv, WinT, D, n0, lds);
        } else if (it < I_IN + I_SQ) {
            const int r = it - I_IN; const int kt = r & 31, nt = r >> 5;
            p0_transpose_item(a.w_out, D, kt * 64, nt * 64, 64, WoutT, D, nt * 64, lds);
        } else {
            const int r = it - I_IN - I_SQ; const int kt = r & 31, nt = r >> 5;
            p0_transpose_item(a.w_pq, D, kt * 64, nt * 64, 64, WpqT, D, nt * 64, lds);
        }
    }
    float2* cs = (float2*)(a.ws + WS_CS);
    for (int i = bi * NTHREADS + tid; i < T * 64; i += G * NTHREADS) {
        const int t = i >> 6, f = i & 63;
        const float inv_freq = powf(10000.0f, -(float)f * 2.0f / 128.0f);
        const float ang = (float)a.pos[t] * inv_freq;
        const double rev = (double)ang * 0.15915494309189533577;
        const float fr = (float)(rev - floor(rev));
        cs[i] = make_float2(__builtin_amdgcn_cosf(fr), __builtin_amdgcn_sinf(fr));
    }
}

__device__ __forceinline__ void norm_mod_phase(const float* __restrict__ xin, const float* __restrict__ g, const float* __restrict__ mod,
                                               int sh_chunk, int sc_chunk, u16* __restrict__ outp) {
    const int lane = threadIdx.x & 63, wave = threadIdx.x >> 6;
    const int gw = blockIdx.x * NWAVES + wave, NGW = gridDim.x * NWAVES;
    for (int t = gw; t < T; t += NGW) {
        const int b = t / S;
        const float4* xr = (const float4*)(xin + (size_t)t * D);
        float4 v[8]; float ss = 0.f;
#pragma unroll
        for (int m = 0; m < 8; ++m) { v[m] = xr[lane + 64 * m]; ss += v[m].x * v[m].x + v[m].y * v[m].y + v[m].z * v[m].z + v[m].w * v[m].w; }
        ss = wave_sum(ss);
        const float rstd = rsqrtf(ss * (1.f / D) + NORM_EPS);
        const float4* gp = (const float4*)g;
        const float4* shp = (const float4*)(mod + b * 12288 + sh_chunk * 2048);
        const float4* scp = (const float4*)(mod + b * 12288 + sc_chunk * 2048);
        uint2* op = (uint2*)(outp + (size_t)t * D);
#pragma unroll
        for (int m = 0; m < 8; ++m) {
            const int i = lane + 64 * m;
            const float4 gg = gp[i], sh = shp[i], sc = scp[i];
            const float h0 = v[m].x * rstd * gg.x * (1.f + sc.x) + sh.x;
            const float h1 = v[m].y * rstd * gg.y * (1.f + sc.y) + sh.y;
            const float h2 = v[m].z * rstd * gg.z * (1.f + sc.z) + sh.z;
            const float h3 = v[m].w * rstd * gg.w * (1.f + sc.w) + sh.w;
            op[i] = make_uint2(pack2(h0, h1), pack2(h2, h3));
        }
    }
}

namespace pg8 {
#define PG8_LAS __attribute__((address_space(3)))
typedef unsigned short bf16_t;
typedef short bf16x8 __attribute__((ext_vector_type(8)));
typedef float f32x4 __attribute__((ext_vector_type(4)));
typedef unsigned u32x4 __attribute__((ext_vector_type(4)));
constexpr int BM = 256, BK = 64, HALF = 128, HTB = HALF * BK * 2  , STAGE_BYTES = 8 * HTB, NXCD = 8, WGM = 8;

__host__ __device__ __forceinline__ int lds_byte(int r, int c) { const int st = (r >> 4) * 2 + (c >> 5), rr = r & 15, cc = c & 31, ob = rr * 64 + cc * 2; return st * 1024 + (ob ^ (((ob >> 9) & 1) << 5)); }
__host__ __device__ __forceinline__ void stage_rc(int b, int& R, int& C) { const int st = b / 1024, sb = b % 1024, swz = sb ^ (((sb >> 9) & 1) << 5); R = (st >> 1) * 16 + swz / 64; C = (st & 1) * 32 + (swz % 64) / 2; }
__host__ __device__ __forceinline__ int perm32(int rho) { const int n = rho >> 4, i = rho & 15; return 8 * (i >> 2) + 4 * n + (i & 3); }

struct Unit { int pm, pn; };
struct Gemm { const bf16_t* A; const bf16_t* Bt; int M, N, K; };

struct StaticOrder {
    int nM, nN, nwg, G, c;
    __host__ __device__ void init(int M, int N, int G_, int c_) { nM = M / BM; nN = N / BM; nwg = nM * nN; G = G_; c = c_; }
    __host__ __device__ bool next(int i, Unit& u) const {
        const long L = (long)i * G + c; if (L >= nwg) return false;
        int wgid = (int)L; { const int q = nwg / NXCD, r = nwg % NXCD, xcd = wgid % NXCD, off = wgid / NXCD; wgid = (xcd < r ? xcd * (q + 1) : r * (q + 1) + (xcd - r) * q) + off; }
        const int nig = WGM * nN, gid = wgid / nig, fm = gid * WGM, gsz = (nM - fm) < WGM ? (nM - fm) : WGM;
        u.pm = fm + ((wgid % nig) % gsz); u.pn = (wgid % nig) / gsz; return true;
    }
    __device__ __forceinline__ void a_ready(const Unit&) const {}
    __device__ __forceinline__ void done(const Unit&) const {}
};
__device__ __forceinline__ unsigned cvt_pk_bf16(float lo, float hi) { unsigned r; asm volatile("v_cvt_pk_bf16_f32 %0, %1, %2" : "=v"(r) : "v"(lo), "v"(hi)); return r; }
typedef float f32x2 __attribute__((ext_vector_type(2)));
template <class Epi, class Sched, bool STAMP = false>
__device__ __forceinline__ void gemm_phase(PG8_LAS unsigned char* lds, const Gemm g, const Sched& S, const Epi& E, unsigned long long* stamps) {
    const int tid = threadIdx.x, wid = __builtin_amdgcn_readfirstlane(tid >> 6), lane = tid & 63, wr = wid >> 2, wc = wid & 3, fr = lane & 15, fq = lane >> 4;
    const int K = g.K, nt = K / BK;
    int ts_lo = 0, ts_hi = 0, nts = 0; const unsigned long long rt_entry = STAMP ? (unsigned long long)wall_clock64() : 0ull;
#define PG8_STAMP() do { if (STAMP && wid == 0 && nts < 64) { const unsigned long long _c = (unsigned long long)clock64(); \
        ts_lo = (lane == nts) ? (int)(unsigned)_c : ts_lo; ts_hi = (lane == nts) ? (int)(unsigned)(_c >> 32) : ts_hi; ++nts; } } while (0)
    PG8_STAMP();
    unsigned voffA[2], voffB[2];
#pragma unroll
    for (int i = 0; i < 2; ++i) { int R, C; stage_rc(tid * 16 + i * 8192, R, C); const int Rb = Epi::PERM ? ((R & ~31) + perm32(R & 31)) : R;
        voffA[i] = (unsigned)(R * K + C) * 2u; voffB[i] = (unsigned)(Rb * K + C) * 2u; }
    const size_t kstep = (size_t)(BK * 2);
    const size_t hstep = (size_t)HALF * K * 2;
    const size_t tstep = 2 * hstep;
    const unsigned ldsw = (unsigned)wid * 1024u;
    const int aoff = lds_byte(wr * 64 + fr, fq * 8), boff = lds_byte(wc * 32 + fr, fq * 8);
#define PG8_SA(b, h) (((b) * 2 + (h)) * HTB)
#define PG8_SB(b, h) ((4 + (b) * 2 + (h)) * HTB)
#define PG8_STAGE(bufoff, gbase, voff) do { _Pragma("unroll") for (int _i = 0; _i < 2; ++_i) \
        __builtin_amdgcn_global_load_lds((const unsigned*)((const char*)(gbase) + (voff)[_i]), (PG8_LAS unsigned*)(lds + (bufoff) + ldsw + _i * 8192), 16, 0, 0); } while (0)
#define PG8_LDA(dst, b, h) do { _Pragma("unroll") for (int m = 0; m < 4; ++m) _Pragma("unroll") for (int k = 0; k < 2; ++k) dst[m][k] = *(const PG8_LAS bf16x8*)(lds + PG8_SA(b, h) + aoff + m * 2048 + k * 1024); } while (0)
#define PG8_LDB(dst, b, h) do { _Pragma("unroll") for (int n = 0; n < 2; ++n) _Pragma("unroll") for (int k = 0; k < 2; ++k) dst[n][k] = *(const PG8_LAS bf16x8*)(lds + PG8_SB(b, h) + boff + n * 2048 + k * 1024); } while (0)
#define PG8_MMA(ai, bj, At, Bt) do { __builtin_amdgcn_s_setprio(1); _Pragma("unroll") for (int m = 0; m < 4; ++m) _Pragma("unroll") for (int n = 0; n < 2; ++n) _Pragma("unroll") for (int k = 0; k < 2; ++k) \
        acc[ai][bj][m][n] = __builtin_amdgcn_mfma_f32_16x16x32_bf16(Bt[n][k], At[m][k], acc[ai][bj][m][n], 0, 0, 0); __builtin_amdgcn_s_setprio(0); } while (0)
#define PG8_WAIT_V(n) asm volatile("s_waitcnt vmcnt(" #n ")" ::: "memory")
#define PG8_WAIT_L(n) asm volatile("s_waitcnt lgkmcnt(" #n ")" ::: "memory")
#define PG8_BAR __builtin_amdgcn_s_barrier()
#define PG8_SCHED __builtin_amdgcn_sched_barrier(0)
    Unit cur, nxt; int ui = 0;
    if (!S.next(0, cur)) return;
    f32x4 acc[2][2][4][2];
#pragma unroll
    for (int a = 0; a < 2; ++a)
#pragma unroll
        for (int b = 0; b < 2; ++b)
#pragma unroll
            for (int m = 0; m < 4; ++m)
#pragma unroll
                for (int n = 0; n < 2; ++n) acc[a][b][m][n] = (f32x4){0.f, 0.f, 0.f, 0.f};
    bf16x8 At[4][2], B0[2][2], B1[2][2];
    const char* cA = (const char*)g.A + (size_t)cur.pm * tstep; const char* cB = (const char*)g.Bt + (size_t)cur.pn * tstep;
    S.a_ready(cur);
    PG8_STAGE(PG8_SB(0, 0), cB, voffB); PG8_STAGE(PG8_SA(0, 0), cA, voffA); PG8_STAGE(PG8_SB(0, 1), cB + hstep, voffB); PG8_STAGE(PG8_SA(0, 1), cA + hstep, voffA);
    if (wr == 1) PG8_BAR;
    PG8_WAIT_V(4); PG8_BAR;
    PG8_STAGE(PG8_SB(1, 0), cB + kstep, voffB); PG8_STAGE(PG8_SA(1, 0), cA + kstep, voffA); PG8_STAGE(PG8_SB(1, 1), cB + hstep + kstep, voffB);
    PG8_WAIT_V(6); PG8_BAR;
    PG8_STAMP();
    for (;;) {
        const bool has_next = S.next(ui + 1, nxt);
        const char* nA = has_next ? (const char*)g.A + (size_t)nxt.pm * tstep : cA; const char* nB = has_next ? (const char*)g.Bt + (size_t)nxt.pn * tstep : cB;
        for (int t = 0; t < nt; t += 2) {
            const bool last = (t == nt - 2);
            const char* a1 = cA + (size_t)(t + 1) * kstep;
            const char* a2 = last ? nA : cA + (size_t)(t + 2) * kstep; const char* b2 = last ? nB : cB + (size_t)(t + 2) * kstep;
            const char* a3 = a2 + kstep; const char* b3 = b2 + kstep;
            if (last && has_next) S.a_ready(nxt);
            PG8_LDB(B0, 0, 0); PG8_SCHED; PG8_LDA(At, 0, 0); PG8_STAGE(PG8_SA(1, 1), a1 + hstep, voffA);
            PG8_WAIT_L(8); PG8_BAR; PG8_WAIT_L(0); PG8_MMA(0, 0, At, B0); PG8_BAR; PG8_SCHED;
            PG8_LDB(B1, 0, 1); PG8_STAGE(PG8_SB(0, 0), b2, voffB);
            PG8_BAR; PG8_WAIT_L(0); PG8_MMA(0, 1, At, B1); PG8_BAR;
            PG8_LDA(At, 0, 1); PG8_STAGE(PG8_SA(0, 0), a2, voffA);
            PG8_BAR; PG8_WAIT_L(0); PG8_MMA(1, 0, At, B0); PG8_BAR; PG8_SCHED;
            PG8_STAGE(PG8_SB(0, 1), b2 + hstep, voffB);
            PG8_WAIT_V(6); PG8_BAR; PG8_MMA(1, 1, At, B1); PG8_BAR;
            PG8_LDB(B0, 1, 0); PG8_SCHED; PG8_LDA(At, 1, 0); PG8_STAGE(PG8_SA(0, 1), a2 + hstep, voffA);
            PG8_WAIT_L(8); PG8_BAR; PG8_WAIT_L(0); PG8_MMA(0, 0, At, B0); PG8_BAR; PG8_SCHED;
            PG8_LDB(B1, 1, 1); PG8_STAGE(PG8_SB(1, 0), b3, voffB);
            PG8_BAR; PG8_WAIT_L(0); PG8_MMA(0, 1, At, B1); PG8_BAR;
            PG8_LDA(At, 1, 1); PG8_STAGE(PG8_SA(1, 0), a3, voffA);
            PG8_BAR; PG8_WAIT_L(0); PG8_MMA(1, 0, At, B0); PG8_BAR; PG8_SCHED;
            PG8_STAGE(PG8_SB(1, 1), b3 + hstep, voffB);
            PG8_WAIT_V(6); PG8_BAR; PG8_MMA(1, 1, At, B1); PG8_BAR;
        }
        PG8_STAMP();
        if constexpr (!Epi::AFTER_DRAIN) { E(acc, cur, wr, wc, fr, fq); S.done(cur); }
        PG8_STAMP();
        if (!has_next) break;
#pragma unroll
        for (int a = 0; a < 2; ++a)
#pragma unroll
            for (int b = 0; b < 2; ++b)
#pragma unroll
                for (int m = 0; m < 4; ++m)
#pragma unroll
                    for (int n = 0; n < 2; ++n) acc[a][b][m][n] = (f32x4){0.f, 0.f, 0.f, 0.f};
        cur = nxt; cA = nA; cB = nB; ++ui;
    }
    PG8_WAIT_V(0);
    if (wr == 0) PG8_BAR;
    PG8_BAR;
    if constexpr (Epi::AFTER_DRAIN) { E.fused(acc, cur, wr, wc, fr, fq, lds, wid, lane); S.done(cur); }
    PG8_STAMP();
    if (STAMP && wid == 0) { stamps[lane] = lane < nts ? (((unsigned long long)(unsigned)ts_hi << 32) | (unsigned)ts_lo) : 0ull;
        if (lane == 62) stamps[62] = rt_entry; if (lane == 63) stamps[63] = (unsigned long long)wall_clock64(); }
#undef PG8_STAMP
#undef PG8_SA
#undef PG8_SB
#undef PG8_STAGE
#undef PG8_LDA
#undef PG8_LDB
#undef PG8_MMA
#undef PG8_WAIT_V
#undef PG8_WAIT_L
#undef PG8_BAR
#undef PG8_SCHED
}
}

struct EpiProj {
    static constexpr bool PERM = true, AFTER_DRAIN = false;
    u16* P; float* gz;
    __device__ __forceinline__ void operator()(const pg8::f32x4 (&acc)[2][2][4][2], const pg8::Unit& u, int wr, int wc, int fr, int fq) const {
        const int row0 = u.pm * 256 + wr * 64 + fr;
        if (u.pn < 24) {
            const int col0 = u.pn * 256 + wc * 32 + 8 * fq;
#pragma unroll
            for (int ai = 0; ai < 2; ++ai)
#pragma unroll
                for (int m = 0; m < 4; ++m) { u16* rowp = P + (size_t)(row0 + ai * 128 + m * 16) * NP + col0;
#pragma unroll
                    for (int bj = 0; bj < 2; ++bj) { const pg8::f32x4 v0 = acc[ai][bj][m][0], v1 = acc[ai][bj][m][1];
                        pg8::u32x4 w; w.x = pg8::cvt_pk_bf16(v0[0], v0[1]); w.y = pg8::cvt_pk_bf16(v0[2], v0[3]); w.z = pg8::cvt_pk_bf16(v1[0], v1[1]); w.w = pg8::cvt_pk_bf16(v1[2], v1[3]);
                        *(pg8::u32x4*)(rowp + bj * 128) = w; } }
        } else if (wc == 0) {
#pragma unroll
            for (int ai = 0; ai < 2; ++ai)
#pragma unroll
                for (int m = 0; m < 4; ++m) { float* rowp = gz + (size_t)(row0 + ai * 128 + m * 16) * 32 + 8 * fq;
                    *(pg8::f32x4*)(rowp) = acc[ai][0][m][0]; *(pg8::f32x4*)(rowp + 4) = acc[ai][0][m][1]; }
        }
    }
};
struct EpiResid {
    static constexpr bool PERM = false, AFTER_DRAIN = false;
    const float* x; const float* mod; float* x1;
    __device__ __forceinline__ void operator()(const pg8::f32x4 (&acc)[2][2][4][2], const pg8::Unit& u, int wr, int wc, int fr, int fq) const {
        const int row0 = u.pm * 256 + wr * 64 + fr, col0 = u.pn * 256 + wc * 32 + 4 * fq;
        const int b = (u.pm * 256) / S;
        pg8::f32x4 ga[2][2];
#pragma unroll
        for (int bj = 0; bj < 2; ++bj)
#pragma unroll
            for (int n = 0; n < 2; ++n) ga[bj][n] = *(const pg8::f32x4*)(mod + b * 12288 + 2 * 2048 + col0 + bj * 128 + n * 16);
#pragma unroll
        for (int ai = 0; ai < 2; ++ai)
#pragma unroll
            for (int m = 0; m < 4; ++m) { const size_t off = (size_t)(row0 + ai * 128 + m * 16) * D + col0;
#pragma unroll
                for (int bj = 0; bj < 2; ++bj)
#pragma unroll
                    for (int n = 0; n < 2; ++n) { const pg8::f32x4 xv = *(const pg8::f32x4*)(x + off + bj * 128 + n * 16);
                        *(pg8::f32x4*)(x1 + off + bj * 128 + n * 16) = xv + ga[bj][n] * acc[ai][bj][m][n]; } }
    }
};
struct EpiBf16 {
    static constexpr bool PERM = true, AFTER_DRAIN = false;
    u16* Q;
    __device__ __forceinline__ void operator()(const pg8::f32x4 (&acc)[2][2][4][2], const pg8::Unit& u, int wr, int wc, int fr, int fq) const {
        const int row0 = u.pm * 256 + wr * 64 + fr, col0 = u.pn * 256 + wc * 32 + 8 * fq;
#pragma unroll
        for (int ai = 0; ai < 2; ++ai)
#pragma unroll
            for (int m = 0; m < 4; ++m) { u16* rowp = Q + (size_t)(row0 + ai * 128 + m * 16) * D + col0;
#pragma unroll
                for (int bj = 0; bj < 2; ++bj) { const pg8::f32x4 v0 = acc[ai][bj][m][0], v1 = acc[ai][bj][m][1];
                    pg8::u32x4 w; w.x = pg8::cvt_pk_bf16(v0[0], v0[1]); w.y = pg8::cvt_pk_bf16(v0[2], v0[3]); w.z = pg8::cvt_pk_bf16(v1[0], v1[1]); w.w = pg8::cvt_pk_bf16(v1[2], v1[3]);
                    *(pg8::u32x4*)(rowp + bj * 128) = w; } }
    }
};
template <class Epi>
__device__ __forceinline__ void gemm8(unsigned char* lds, const u16* A, const u16* Bt, int M, int N, int K, const Epi& E) {
    pg8::Gemm g{A, Bt, M, N, K}; pg8::StaticOrder So; So.init(M, N, (int)gridDim.x, (int)blockIdx.x);
    pg8::gemm_phase<Epi, pg8::StaticOrder, false>((PG8_LAS unsigned char*)lds, g, So, E, nullptr);
    __syncthreads();
}

#define GLA_QD_BYTES 16384
#define GLA_AT_BYTES 8192
__device__ __forceinline__ float gla_logsigmoid(float z) { return z < 0.f ? z - log1pf(expf(z)) : -log1pf(expf(-z)); }

__device__ __forceinline__ void gla_prep_item(const u16* __restrict__ P, int ldp, int cq, int ck, const float* __restrict__ gz,
                                              const float* __restrict__ wg_f, const float* __restrict__ bg_f, const float* __restrict__ wg_b, const float* __restrict__ bg_b,
                                              int Sq, unsigned char* __restrict__ QDg, unsigned char* __restrict__ KEg, unsigned char* __restrict__ ATg, float* __restrict__ DECg,
                                              unsigned char* lds, int item) {
    const int nch = Sq / 64;
    const int c = item % nch, dir = (item / nch) & 1, hh = (item / (nch * 2)) & 3, b = item / (nch * 8);
    const int tid = TID, lane = tid & 63, wave = tid >> 6, li = lane & 15, fq = lane >> 4;
    float* gzs = (float*)lds;
    float* segs = gzs + 64 * 16;
    unsigned char* QDs = lds + 8192;
    unsigned char* KIs = QDs + 16384;
    unsigned char* KEs = KIs + 16384;
    const size_t tok0 = (size_t)b * Sq;
    __syncthreads();
    for (int e = tid; e < 64 * 16; e += 512) {
        const int i = e >> 4, r = e & 15;
        const int s = dir ? (Sq - 1 - (64 * c + i)) : (64 * c + i);
        gzs[e] = gz[(tok0 + s) * 32 + dir * 16 + r];
    }
    const int d = tid & 127, seg = tid >> 7;
    const float* wg = dir ? wg_b : wg_f;
    float wcol[16];
#pragma unroll
    for (int r = 0; r < 16; ++r) wcol[r] = wg[r * 512 + hh * 128 + d];
    const float bias = (dir ? bg_b : bg_f)[hh * 128 + d];
    __syncthreads();
    float pre[16]; float run = 0.f;
#pragma unroll
    for (int k = 0; k < 16; ++k) {
        const int i = 16 * seg + k;
        float z = bias;
#pragma unroll
        for (int r = 0; r < 16; ++r) z += gzs[i * 16 + r] * wcol[r];
        run += gla_logsigmoid(z) * (1.f / 16.f);
        pre[k] = run;
    }
    segs[seg * 128 + d] = run;
    __syncthreads();
    float off = 0.f, tot = 0.f;
#pragma unroll
    for (int s2 = 0; s2 < 4; ++s2) { const float v = segs[s2 * 128 + d]; tot += v; off += (s2 < seg) ? v : 0.f; }
    const float qscale = 0.08838834764831845f;
#pragma unroll
    for (int k = 0; k < 16; ++k) {
        const int i = 16 * seg + k;
        const int s = dir ? (Sq - 1 - (64 * c + i)) : (64 * c + i);
        const float bb = off + pre[k];
        const float q = bf2f(P[(tok0 + s) * ldp + cq + hh * 128 + d]), kx = bf2f(P[(tok0 + s) * ldp + ck + hh * 128 + d]);
        const int o = i * 256 + ((((d >> 3) ^ (i & 15)) << 4) | ((d & 7) << 1));
        *(u16*)(QDs + o) = f2bf(q * qscale * __expf(bb));
        *(u16*)(KIs + o) = f2bf(kx * __expf(-bb));
        *(u16*)(KEs + o) = f2bf(kx * __expf(tot - bb));
    }
    if (seg == 0) DECg[(size_t)item * 128 + d] = __expf(tot);
    __syncthreads();
    {
        uint4* qo = (uint4*)(QDg + (size_t)item * GLA_QD_BYTES); uint4* ko = (uint4*)(KEg + (size_t)item * GLA_QD_BYTES);
#pragma unroll
        for (int k = 0; k < 2; ++k) { const int e = tid + 512 * k; qo[e] = ((const uint4*)QDs)[e]; ko[e] = ((const uint4*)KEs)[e]; }
    }
#pragma unroll
    for (int tt = 0; tt < 2; ++tt) {
        const int tile = wave + 8 * tt, jt = tile >> 2, it = tile & 3;
        f32x4 acc = (f32x4){0.f, 0.f, 0.f, 0.f};
        if (jt <= it) {
            const int jr = 16 * jt + li, ir = 16 * it + li;
#pragma unroll
            for (int ks = 0; ks < 4; ++ks) {
                const bf16x8 kf = *(const bf16x8*)(KIs + jr * 256 + (((4 * ks + fq) ^ (jr & 15)) << 4));
                const bf16x8 qf = *(const bf16x8*)(QDs + ir * 256 + (((4 * ks + fq) ^ (ir & 15)) << 4));
                acc = __builtin_amdgcn_mfma_f32_16x16x32_bf16(kf, qf, acc, 0, 0, 0);
            }
        }
        const int i = 16 * it + li, j0 = 16 * jt + 4 * fq;
        float v[4];
#pragma unroll
        for (int jj = 0; jj < 4; ++jj) v[jj] = (j0 + jj <= i) ? acc[jj] : 0.f;
        const int chunk = 2 * jt + (fq >> 1), sub = (fq & 1) * 8;
        *(uint2*)(ATg + (size_t)item * GLA_AT_BYTES + i * 128 + ((chunk ^ (i & 7)) << 4) + sub) = make_uint2(pack2(v[0], v[1]), pack2(v[2], v[3]));
    }
}

__device__ __forceinline__ void gla_seq_item(const u16* __restrict__ P, int ldp, int cv, int Sq,
                                             const unsigned char* __restrict__ QDg, const unsigned char* __restrict__ KEg, const unsigned char* __restrict__ ATg, const float* __restrict__ DECg,
                                             u16* __restrict__ Oout  , int Ttot, unsigned char* lds, int item) {
    const int slice = item & 1, dir = (item >> 1) & 1, hh = (item >> 2) & 3, b = item >> 4;
    const int nch = Sq / 64;
    const int tid = TID, lane = tid & 63, wave = tid >> 6, li = lane & 15, fq = lane >> 4;
    const size_t tok0 = (size_t)b * Sq;
    const int pitem0 = ((b * 4 + hh) * 2 + dir) * nch;
    constexpr int BUF = 16384 * 3 + 8192 + 512;
    typedef unsigned gla_u32x4 __attribute__((ext_vector_type(4)));
    gla_u32x4 rq0, rq1, rk0, rk1, rv0, rv1, ra; float rd = 0.f;
#define GLA_VROW(c_, k_) ((tok0 + (size_t)(dir ? (Sq - 1 - (64 * (c_) + ((tid + 512 * (k_)) >> 4))) : (64 * (c_) + ((tid + 512 * (k_)) >> 4)))) * ldp + cv + hh * 256 + slice * 128 + ((tid + 512 * (k_)) & 15) * 8)
#define GLA_ISSUE(c_) do { \
        const gla_u32x4* qsrc_ = (const gla_u32x4*)(QDg + (size_t)(pitem0 + (c_)) * GLA_QD_BYTES); const gla_u32x4* ksrc_ = (const gla_u32x4*)(KEg + (size_t)(pitem0 + (c_)) * GLA_QD_BYTES); \
        rq0 = qsrc_[tid]; rq1 = qsrc_[tid + 512]; rk0 = ksrc_[tid]; rk1 = ksrc_[tid + 512]; \
        ra = ((const gla_u32x4*)(ATg + (size_t)(pitem0 + (c_)) * GLA_AT_BYTES))[tid]; \
        rv0 = *(const gla_u32x4*)(P + GLA_VROW(c_, 0)); rv1 = *(const gla_u32x4*)(P + GLA_VROW(c_, 1)); \
        if (tid < 128) rd = DECg[(size_t)(pitem0 + (c_)) * 128 + tid]; } while (0)
#define GLA_COMMIT(buf_) do { \
        unsigned char* base_ = lds + (buf_) * BUF; \
        ((gla_u32x4*)base_)[tid] = rq0; ((gla_u32x4*)base_)[tid + 512] = rq1; ((gla_u32x4*)(base_ + 16384))[tid] = rk0; ((gla_u32x4*)(base_ + 16384))[tid + 512] = rk1; \
        { const int row_ = tid >> 4, ch_ = tid & 15; *(gla_u32x4*)(base_ + 32768 + row_ * 256 + ((ch_ ^ (row_ & 15)) << 4)) = rv0; } \
        { const int row_ = (tid + 512) >> 4, ch_ = tid & 15; *(gla_u32x4*)(base_ + 32768 + row_ * 256 + ((ch_ ^ (row_ & 15)) << 4)) = rv1; } \
        ((gla_u32x4*)(base_ + 49152))[tid] = ra; \
        if (tid < 128) ((float*)(base_ + 57344))[tid] = rd; } while (0)
    f32x4 st[8];
#pragma unroll
    for (int dt = 0; dt < 8; ++dt) st[dt] = (f32x4){0.f, 0.f, 0.f, 0.f};
    __syncthreads();
    GLA_ISSUE(0); GLA_COMMIT(0);
    __syncthreads();
#pragma unroll 1
    for (int c = 0; c < nch; ++c) {
        const int buf = c & 1;
        if (c + 1 < nch) GLA_ISSUE(c + 1);
        const unsigned char* QDs = lds + buf * BUF; const unsigned char* KEs = QDs + 16384; const unsigned char* Vs = QDs + 32768;
        const unsigned char* ATs = QDs + 49152; const float* DECs = (const float*)(QDs + 57344);
        bf16x8 vf[2];
#pragma unroll
        for (int jp = 0; jp < 2; ++jp) {
            const int rowA = 32 * jp + 8 * fq + (li >> 2), rowB = rowA + 4;
            const int chunk = 2 * wave + ((li & 3) >> 1), sub = ((li & 3) & 1) * 8;
            const s16x4 va = __builtin_amdgcn_ds_read_tr16_b64_v4i16((LAS s16x4*)(Vs + rowA * 256 + ((chunk ^ (rowA & 15)) << 4) + sub));
            const s16x4 vb = __builtin_amdgcn_ds_read_tr16_b64_v4i16((LAS s16x4*)(Vs + rowB * 256 + ((chunk ^ (rowB & 15)) << 4) + sub));
            vf[jp][0] = va[0]; vf[jp][1] = va[1]; vf[jp][2] = va[2]; vf[jp][3] = va[3]; vf[jp][4] = vb[0]; vf[jp][5] = vb[1]; vf[jp][6] = vb[2]; vf[jp][7] = vb[3];
        }
        bf16x8 sf[4];
#pragma unroll
        for (int dp = 0; dp < 4; ++dp)
#pragma unroll
            for (int jj = 0; jj < 4; ++jj) { sf[dp][jj] = (short)f2bf(st[2 * dp][jj]); sf[dp][4 + jj] = (short)f2bf(st[2 * dp + 1][jj]); }
        f32x4 ot[4];
#pragma unroll
        for (int it = 0; it < 4; ++it) {
            f32x4 acc = (f32x4){0.f, 0.f, 0.f, 0.f};
            const int ir = 16 * it + li;
#pragma unroll
            for (int dp = 0; dp < 4; ++dp) {
                const int c0 = 4 * dp + (fq >> 1), c1 = c0 + 2, sub = (fq & 1) * 8;
                const uint2 lo = *(const uint2*)(QDs + ir * 256 + ((c0 ^ (ir & 15)) << 4) + sub);
                const uint2 hi = *(const uint2*)(QDs + ir * 256 + ((c1 ^ (ir & 15)) << 4) + sub);
                bf16x8 qf;
                qf[0] = (short)(lo.x & 0xffff); qf[1] = (short)(lo.x >> 16); qf[2] = (short)(lo.y & 0xffff); qf[3] = (short)(lo.y >> 16);
                qf[4] = (short)(hi.x & 0xffff); qf[5] = (short)(hi.x >> 16); qf[6] = (short)(hi.y & 0xffff); qf[7] = (short)(hi.y >> 16);
                acc = __builtin_amdgcn_mfma_f32_16x16x32_bf16(sf[dp], qf, acc, 0, 0, 0);
            }
#pragma unroll
            for (int jp = 0; jp < 2; ++jp) {
                if (32 * jp <= 16 * it + 15) {
                    const bf16x8 af = *(const bf16x8*)(ATs + ir * 128 + (((4 * jp + fq) ^ (ir & 7)) << 4));
                    acc = __builtin_amdgcn_mfma_f32_16x16x32_bf16(vf[jp], af, acc, 0, 0, 0);
                }
            }
            ot[it] = acc;
        }
#pragma unroll
        for (int dt = 0; dt < 8; ++dt) {
            const f32x4 dec = *(const f32x4*)(DECs + 16 * dt + 4 * fq);
            f32x4 acc = st[dt] * dec;
#pragma unroll
            for (int jp = 0; jp < 2; ++jp) {
                const int rowA = 32 * jp + 8 * fq + (li >> 2), rowB = rowA + 4;
                const int chunk = 2 * dt + ((li & 3) >> 1), sub = ((li & 3) & 1) * 8;
                const s16x4 ka = __builtin_amdgcn_ds_read_tr16_b64_v4i16((LAS s16x4*)(KEs + rowA * 256 + ((chunk ^ (rowA & 15)) << 4) + sub));
                const s16x4 kb = __builtin_amdgcn_ds_read_tr16_b64_v4i16((LAS s16x4*)(KEs + rowB * 256 + ((chunk ^ (rowB & 15)) << 4) + sub));
                bf16x8 kf;
                kf[0] = ka[0]; kf[1] = ka[1]; kf[2] = ka[2]; kf[3] = ka[3]; kf[4] = kb[0]; kf[5] = kb[1]; kf[6] = kb[2]; kf[7] = kb[3];
                acc = __builtin_amdgcn_mfma_f32_16x16x32_bf16(kf, vf[jp], acc, 0, 0, 0);
            }
            st[dt] = acc;
        }
#pragma unroll
        for (int it = 0; it < 4; ++it) {
            const int i = 16 * it + li;
            const int s = dir ? (Sq - 1 - (64 * c + i)) : (64 * c + i);
            *(uint2*)(Oout + ((size_t)dir * Ttot + tok0 + s) * 1024 + hh * 256 + slice * 128 + 16 * wave + 4 * fq) =
                make_uint2(pack2(ot[it][0], ot[it][1]), pack2(ot[it][2], ot[it][3]));
        }
        if (c + 1 < nch) GLA_COMMIT(buf ^ 1);
        __syncthreads();
    }
}
__device__ __forceinline__ void phase_rope_prep(const Args& a, unsigned char* lds) {
    u16* P = (u16*)(a.ws + WS_P);
    const float2* cs = (const float2*)(a.ws + WS_CS);
    const int gt = blockIdx.x * NTHREADS + threadIdx.x, NT = gridDim.x * NTHREADS;
    for (int i = gt; i < T * 2 * 8 * 64; i += NT) {
        const int f = i & 63, hh = (i >> 6) & 7, which = (i >> 9) & 1, t = i >> 10;
        const float2 c = cs[t * 64 + f];
        u16* p = P + (size_t)t * NP + (which ? C_DK : C_DQ) + hh * 128 + f;
        const float t1 = bf2f(p[0]), t2 = bf2f(p[64]);
        p[0] = f2bf(t1 * c.x - t2 * c.y);
        p[64] = f2bf(t1 * c.y + t2 * c.x);
    }
    for (int item = blockIdx.x; item < GLA_NPREP; item += gridDim.x)
        gla_prep_item(P, NP, C_GQ, C_GK, (const float*)(a.ws + WS_GZ), a.wgf, a.bgf, a.wgb, a.bgb, S,
                      a.ws + WS_QD, a.ws + WS_KE, a.ws + WS_AT, (float*)(a.ws + WS_DEC), lds, item);
}

__device__ __forceinline__ void attn_item(const u16* __restrict__ P, int ldp, int cq, int ck, int cv, int Sq,
                                          u16* __restrict__ part_o, float* __restrict__ part_lse, int Ttot,
                                          unsigned char* lds, int item) {
    const int tid = TID, lane = tid & 63, wave = tid >> 6, li = lane & 15, fq = lane >> 4;
    const int nb_per = Sq / 128;
    const int within = item % nb_per, hh = (item / nb_per) & 7, b = (item / (nb_per * 8)) & 3, pat = item / (nb_per * 32);
    const int dil = pat == 0 ? 1 : (pat == 1 ? 4 : 16);
    const int M = Sq / dil;
    const int r = within % dil, blk = within / dil;
    const int p0 = blk * 128, kbase = p0 - 64;
    unsigned char* Ks = lds;
    unsigned char* Vs = lds + 65536;
    const size_t tok0 = (size_t)b * Sq;
    __syncthreads();
#pragma unroll
    for (int i = 0; i < 8; ++i) {
        const int id = tid + 512 * i, row = id >> 4, c = id & 15;
        int kp = kbase + row; kp = kp < 0 ? 0 : (kp > M - 1 ? M - 1 : kp);
        const size_t t = tok0 + r + (size_t)dil * kp;
        const uint4 kv = *(const uint4*)(P + t * ldp + ck + hh * 128 + c * 8);
        const uint4 vv = *(const uint4*)(P + t * ldp + cv + hh * 128 + c * 8);
        const int off = row * 256 + ((c ^ (row & 15)) << 4);
        *(uint4*)(Ks + off) = kv;
        *(uint4*)(Vs + off) = vv;
    }
    const int qp = p0 + 16 * wave + li;
    const size_t tq = tok0 + r + (size_t)dil * qp;
    bf16x8 qf[4];
#pragma unroll
    for (int ks = 0; ks < 4; ++ks) qf[ks] = *(const bf16x8*)(P + tq * ldp + cq + hh * 128 + 32 * ks + 8 * fq);
    __syncthreads();
    const float scale = 0.08838834764831845f;
    float m = -1e30f, l = 0.f;
    f32x4 o[8];
#pragma unroll
    for (int dt = 0; dt < 8; ++dt) o[dt] = (f32x4){0.f, 0.f, 0.f, 0.f};
#pragma unroll 1
    for (int tp = 0; tp < 5; ++tp) {
        float s[8]; bool ok[8];
#pragma unroll
        for (int h2 = 0; h2 < 2; ++h2) {
            const int kk0 = 16 * wave + 16 * (2 * tp + h2);
            int krow = kk0 + li; krow = krow > 255 ? 255 : krow;
            f32x4 acc = (f32x4){0.f, 0.f, 0.f, 0.f};
#pragma unroll
            for (int ks = 0; ks < 4; ++ks) {
                const bf16x8 kf = *(const bf16x8*)(Ks + krow * 256 + (((4 * ks + fq) ^ (krow & 15)) << 4));
                acc = __builtin_amdgcn_mfma_f32_16x16x32_bf16(kf, qf[ks], acc, 0, 0, 0);
            }
#pragma unroll
            for (int j = 0; j < 4; ++j) {
                const int kp = kbase + kk0 + 4 * fq + j;
                const int rel = kp - qp;
                ok[4 * h2 + j] = (kp >= 0) && (kp < M) && (rel <= 64) && (rel >= -64);
                s[4 * h2 + j] = acc[j] * scale;
            }
        }
        float mx = -1e30f;
#pragma unroll
        for (int j = 0; j < 8; ++j) mx = ok[j] ? fmaxf(mx, s[j]) : mx;
        mx = fmaxf(mx, __shfl_xor(mx, 16));
        mx = fmaxf(mx, __shfl_xor(mx, 32));
        const float mn = fmaxf(m, mx);
        const float al = __expf(m - mn);
        float ps = 0.f; float p[8];
#pragma unroll
        for (int j = 0; j < 8; ++j) { p[j] = ok[j] ? __expf(s[j] - mn) : 0.f; ps += p[j]; }
        l = l * al + ps; m = mn;
        bf16x8 pf;
#pragma unroll
        for (int j = 0; j < 8; ++j) pf[j] = (short)f2bf(p[j]);
#pragma unroll
        for (int dt = 0; dt < 8; ++dt) o[dt] *= al;
        int rowA = 16 * wave + 32 * tp + 4 * fq + (li >> 2); rowA = rowA > 255 ? 255 : rowA;
        int rowB = 16 * wave + 32 * tp + 16 + 4 * fq + (li >> 2); rowB = rowB > 255 ? 255 : rowB;
#pragma unroll
        for (int dt = 0; dt < 8; ++dt) {
            const int chunk = 2 * dt + ((li & 3) >> 1), sub = ((li & 3) & 1) * 8;
            const s16x4 va = __builtin_amdgcn_ds_read_tr16_b64_v4i16((LAS s16x4*)(Vs + rowA * 256 + ((chunk ^ (rowA & 15)) << 4) + sub));
            const s16x4 vb = __builtin_amdgcn_ds_read_tr16_b64_v4i16((LAS s16x4*)(Vs + rowB * 256 + ((chunk ^ (rowB & 15)) << 4) + sub));
            bf16x8 vf;
            vf[0] = va[0]; vf[1] = va[1]; vf[2] = va[2]; vf[3] = va[3]; vf[4] = vb[0]; vf[5] = vb[1]; vf[6] = vb[2]; vf[7] = vb[3];
            o[dt] = __builtin_amdgcn_mfma_f32_16x16x32_bf16(vf, pf, o[dt], 0, 0, 0);
        }
    }
    l += __shfl_xor(l, 16);
    l += __shfl_xor(l, 32);
    const float inv = 1.f / l;
    u16* orow = part_o + ((size_t)pat * Ttot + tq) * 1024 + hh * 128 + 4 * fq;
#pragma unroll
    for (int dt = 0; dt < 8; ++dt)
        *(uint2*)(orow + 16 * dt) = make_uint2(pack2(o[dt][0] * inv, o[dt][1] * inv), pack2(o[dt][2] * inv, o[dt][3] * inv));
    if (fq == 0) part_lse[((size_t)pat * Ttot + tq) * 8 + hh] = m + logf(l);
}

__device__ __forceinline__ void attn_merge_token(const u16* __restrict__ part_o, const float* __restrict__ part_lse, int Ttot, size_t t,
                                                 u16* __restrict__ dst  , int lane) {
    const int hh = lane >> 3;
    const float l0 = part_lse[((size_t)0 * Ttot + t) * 8 + hh], l1 = part_lse[((size_t)1 * Ttot + t) * 8 + hh], l2 = part_lse[((size_t)2 * Ttot + t) * 8 + hh];
    const float mx = fmaxf(l0, fmaxf(l1, l2));
    const float e0 = __expf(l0 - mx), e1 = __expf(l1 - mx), e2 = __expf(l2 - mx);
    const float inv = 1.f / (e0 + e1 + e2);
    const float w[3] = {e0 * inv, e1 * inv, e2 * inv};
    float acc[16];
#pragma unroll
    for (int i = 0; i < 16; ++i) acc[i] = 0.f;
#pragma unroll
    for (int p = 0; p < 3; ++p) {
        const uint4* src = (const uint4*)(part_o + ((size_t)p * Ttot + t) * 1024 + lane * 16);
        const uint4 a = src[0], bb = src[1];
        acc[0] += w[p] * lo2f(a.x); acc[1] += w[p] * hi2f(a.x); acc[2] += w[p] * lo2f(a.y); acc[3] += w[p] * hi2f(a.y);
        acc[4] += w[p] * lo2f(a.z); acc[5] += w[p] * hi2f(a.z); acc[6] += w[p] * lo2f(a.w); acc[7] += w[p] * hi2f(a.w);
        acc[8] += w[p] * lo2f(bb.x); acc[9] += w[p] * hi2f(bb.x); acc[10] += w[p] * lo2f(bb.y); acc[11] += w[p] * hi2f(bb.y);
        acc[12] += w[p] * lo2f(bb.z); acc[13] += w[p] * hi2f(bb.z); acc[14] += w[p] * lo2f(bb.w); acc[15] += w[p] * hi2f(bb.w);
    }
    uint4* d = (uint4*)(dst + lane * 16);
    d[0] = make_uint4(pack2(acc[0], acc[1]), pack2(acc[2], acc[3]), pack2(acc[4], acc[5]), pack2(acc[6], acc[7]));
    d[1] = make_uint4(pack2(acc[8], acc[9]), pack2(acc[10], acc[11]), pack2(acc[12], acc[13]), pack2(acc[14], acc[15]));
}

__device__ __forceinline__ void phase_mixers(const Args& a, unsigned char* lds) {
    const int bi = blockIdx.x, G = gridDim.x;
    if (bi < 64) {
        gla_seq_item((const u16*)(a.ws + WS_P), NP, C_GV, S, a.ws + WS_QD, a.ws + WS_KE, a.ws + WS_AT, (const float*)(a.ws + WS_DEC),
                     (u16*)(a.ws + WS_OFB), T, lds, bi);
    } else {
        u16* part_o = (u16*)a.out; float* part_lse = (float*)((unsigned char*)a.out + (size_t)3 * T * 1024 * 2);
        for (int item = bi - 64; item < 3 * 4 * 8 * (S / 128); item += G - 64)
            attn_item((const u16*)(a.ws + WS_P), NP, C_DQ, C_DK, C_DV, S, part_o, part_lse, T, lds, item);
    }
}

__device__ __forceinline__ void phase_gla_fin(const Args& a) {
    const u16* Of = (const u16*)(a.ws + WS_OFB);
    const u16* Ob = Of + (size_t)T * 1024;
    const u16* P = (const u16*)(a.ws + WS_P);
    u16* A2 = (u16*)(a.ws + WS_ACT);
    const int lane = threadIdx.x & 63, wave = threadIdx.x >> 6;
    const int gw = blockIdx.x * NWAVES + wave, NGW = gridDim.x * NWAVES;
    for (int item = gw; item < T * 4; item += NGW) {
        const int hh = item & 3, t = item >> 2;
        const size_t base = (size_t)t * 1024 + hh * 256 + lane * 4;
        const uint2 f = *(const uint2*)(Of + base), bb = *(const uint2*)(Ob + base);
        const float o0 = lo2f(f.x) + lo2f(bb.x), o1 = hi2f(f.x) + hi2f(bb.x), o2 = lo2f(f.y) + lo2f(bb.y), o3 = hi2f(f.y) + hi2f(bb.y);
        const float ss = wave_sum(o0 * o0 + o1 * o1 + o2 * o2 + o3 * o3);
        const float rstd = rsqrtf(ss * (1.f / 256.f) + NORM_EPS);
        const float4 gg = *(const float4*)(a.g_gla + hh * 256 + lane * 4);
        const uint2 rp = *(const uint2*)(P + (size_t)t * NP + C_GR + hh * 256 + lane * 4);
        const float r0 = lo2f(rp.x), r1 = hi2f(rp.x), r2 = lo2f(rp.y), r3 = hi2f(rp.y);
        const float y0 = o0 * rstd * gg.x * silu_f(r0), y1 = o1 * rstd * gg.y * silu_f(r1);
        const float y2 = o2 * rstd * gg.z * silu_f(r2), y3 = o3 * rstd * gg.w * silu_f(r3);
        *(uint2*)(A2 + (size_t)t * D + hh * 256 + lane * 4) = make_uint2(pack2(y0, y1), pack2(y2, y3));
    }
    const u16* part_o = (const u16*)a.out; const float* part_lse = (const float*)((const unsigned char*)a.out + (size_t)3 * T * 1024 * 2);
    for (int t = gw; t < T; t += NGW) attn_merge_token(part_o, part_lse, T, (size_t)t, A2 + (size_t)t * D + 1024, lane);
}

typedef float f32x16 __attribute__((ext_vector_type(16)));
#define RT_CE(a_, b_) do { const float hi_ = fmaxf(a_, b_), lo_ = fminf(a_, b_); a_ = hi_; b_ = lo_; } while (0)
template <int N> __device__ __forceinline__ void rt_sort_desc(float (&v)[N], int base) {
#pragma unroll
    for (int k = 2; k <= 16; k <<= 1)
#pragma unroll
        for (int j = k >> 1; j > 0; j >>= 1)
#pragma unroll
            for (int i = 0; i < 16; ++i) {
                const int l = i ^ j;
                if (l > i) { if ((i & k) == 0) RT_CE(v[base + i], v[base + l]); else RT_CE(v[base + l], v[base + i]); }
            }
}
template <int N> __device__ __forceinline__ void rt_merge_desc(float (&v)[N], int a, int b) {
#pragma unroll
    for (int i = 0; i < 16; ++i) v[a + i] = fmaxf(v[a + i], v[b + 15 - i]);
#pragma unroll
    for (int j = 8; j > 0; j >>= 1)
#pragma unroll
        for (int i = 0; i < 16; ++i) { const int l = i ^ j; if (l > i) RT_CE(v[a + i], v[a + l]); }
}

__device__ __forceinline__ void route_stage_keys(const float* __restrict__ subk, int hh, unsigned char* lds) {
    const int tid = TID;
    __syncthreads();
    for (int e = tid; e < 2 * 128 * 16; e += 512) {
        const int c = e & 15, row = e >> 4;
        const float* src = subk + ((size_t)(hh * 2) * 128 + row) * 128 + c * 8;
        const float4 v0 = *(const float4*)src, v1 = *(const float4*)(src + 4);
        *(uint4*)(lds + row * 256 + ((c ^ (row & 15)) << 4)) = make_uint4(pack2(v0.x, v0.y), pack2(v0.z, v0.w), pack2(v1.x, v1.y), pack2(v1.z, v1.w));
    }
    __syncthreads();
}

__device__ __forceinline__ void route_tile(const u16* __restrict__ Q, int ldq, int hh, int tok_base, const unsigned char* lds,
                                           int* __restrict__ IDX, float* __restrict__ GATE) {
    const int lane = TID & 63, r = lane & 31, h = lane >> 5;
    float sc[128];
    {
        f32x16 X[4], Y[4];
#pragma unroll
        for (int kt = 0; kt < 4; ++kt) {
#pragma unroll
            for (int i = 0; i < 16; ++i) { X[kt][i] = 0.f; Y[kt][i] = 0.f; }
        }
        const u16* qrow = Q + (size_t)(tok_base + r) * ldq + hh * 256;
#pragma unroll
        for (int half = 0; half < 2; ++half) {
            bf16x8 qf[8];
#pragma unroll
            for (int ks = 0; ks < 8; ++ks) qf[ks] = *(const bf16x8*)(qrow + half * 128 + 16 * ks + 8 * h);
#pragma unroll
            for (int kt = 0; kt < 4; ++kt) {
                const int krow = half * 128 + 32 * kt + r;
#pragma unroll
                for (int ks = 0; ks < 8; ++ks) {
                    const bf16x8 kf = *(const bf16x8*)(lds + krow * 256 + (((2 * ks + h) ^ (krow & 15)) << 4));
                    if (half == 0) X[kt] = __builtin_amdgcn_mfma_f32_32x32x16_bf16(kf, qf[ks], X[kt], 0, 0, 0);
                    else Y[kt] = __builtin_amdgcn_mfma_f32_32x32x16_bf16(kf, qf[ks], Y[kt], 0, 0, 0);
                }
            }
        }
#pragma unroll
        for (int kt = 0; kt < 4; ++kt)
#pragma unroll
            for (int i = 0; i < 16; ++i) {
                const auto sw = __builtin_amdgcn_permlane32_swap(__float_as_uint(X[kt][i]), __float_as_uint(Y[kt][i]), false, false);
                const int key0 = 32 * kt + (i & 3) + 8 * (i >> 2);
                sc[kt * 32 + i] = __uint_as_float((sw[0] & 0xffffff80u) | (unsigned)key0);
                sc[kt * 32 + 16 + i] = __uint_as_float((sw[1] & 0xffffff80u) | (unsigned)(key0 + 4));
            }
    }
#pragma unroll
    for (int g = 0; g < 8; ++g) rt_sort_desc(sc, 16 * g);
    rt_merge_desc(sc, 0, 16); rt_merge_desc(sc, 32, 48); rt_merge_desc(sc, 64, 80); rt_merge_desc(sc, 96, 112);
    rt_merge_desc(sc, 0, 32); rt_merge_desc(sc, 64, 96);
    rt_merge_desc(sc, 0, 64);
    float l0[16], l1[16];
#pragma unroll
    for (int i = 0; i < 16; ++i) {
        const auto sw = __builtin_amdgcn_permlane32_swap(__float_as_uint(sc[i]), __float_as_uint(sc[i]), false, false);
        l0[i] = __uint_as_float(sw[0]); l1[i] = __uint_as_float(sw[1]);
    }
    float s0[16], s1[16]; int k0[16], k1[16];
#pragma unroll
    for (int i = 0; i < 16; ++i) {
        const unsigned a = __float_as_uint(l0[i]), b = __float_as_uint(l1[i]);
        s0[i] = __uint_as_float(a & 0xffffff80u); k0[i] = (int)(a & 0x7fu);
        s1[i] = __uint_as_float(b & 0xffffff80u); k1[i] = (int)(b & 0x7fu);
    }
    float cs[64];
    {
        int n = 0;
#pragma unroll
        for (int i = 0; i < 16; ++i)
#pragma unroll
            for (int j = 0; j < 16; ++j)
                if ((i + 1) * (j + 1) <= 16) { cs[n] = s0[i] + s1[j]; ++n; }
#pragma unroll
        for (int q = 50; q < 64; ++q) cs[q] = -3.0e38f;
    }
    float ct[64];
#pragma unroll
    for (int q = 0; q < 64; ++q) ct[q] = cs[q];
#pragma unroll
    for (int g = 0; g < 4; ++g) rt_sort_desc(ct, 16 * g);
    rt_merge_desc(ct, 0, 16); rt_merge_desc(ct, 32, 48); rt_merge_desc(ct, 0, 32);
    const float theta = ct[15], smax = ct[0];
    float den = 0.f;
    {
        int cnt = 0;
#pragma unroll
        for (int q = 0; q < 50; ++q) { const bool sel = (cs[q] >= theta) && (cnt < 16); den += sel ? __expf(cs[q] - smax) : 0.f; cnt += sel ? 1 : 0; }
    }
    const float inv = 1.f / den;
    const size_t obase = (size_t)(tok_base + r) * 128 + hh * 16;
    int pos = 0;
    {
        int n = 0;
#pragma unroll
        for (int i = 0; i < 16; ++i)
#pragma unroll
            for (int j = 0; j < 16; ++j)
                if ((i + 1) * (j + 1) <= 16) {
                    const bool sel = (cs[n] >= theta) && (pos < 16);
                    if (sel) {
                        if (h == 0) IDX[obase + pos] = k0[i] * 128 + k1[j];
                        else GATE[obase + pos] = __expf(cs[n] - smax) * inv;
                        ++pos;
                    }
                    ++n;
                }
    }
}
__device__ __forceinline__ void phase_route(const Args& a, unsigned char* lds) {
    const int hh = BID & 7, grp = BID >> 3, ngrp = GDIM >> 3, wave = TID >> 6;
    route_stage_keys(a.subk, hh, lds);
    int j = 0;
    for (int tile = grp; tile < T / 32; tile += ngrp, ++j)
        if ((j & 7) == wave) route_tile((const u16*)(a.ws + WS_Q), D, hh, tile * 32, lds, (int*)(a.ws + WS_IDX), (float*)(a.ws + WS_GATE));
    __syncthreads();
}

typedef __bf16 bf16x2_t __attribute__((ext_vector_type(2)));
__device__ __forceinline__ float dot2bf(unsigned w, unsigned x, float acc) {
    return __builtin_amdgcn_fdot2_f32_bf16(__builtin_bit_cast(bf16x2_t, w), __builtin_bit_cast(bf16x2_t, x), acc, false);
}
constexpr float U_SCALE = 64.f, V_SCALE = 4.f;
typedef float f32x2_t __attribute__((ext_vector_type(2)));
__device__ __forceinline__ unsigned pk4_fp8(float a, float b, float c, float d, float s) {
    int p = __builtin_amdgcn_cvt_pk_fp8_f32(a * s, b * s, 0, false);
    p = __builtin_amdgcn_cvt_pk_fp8_f32(c * s, d * s, p, true);
    return (unsigned)p;
}
__device__ __forceinline__ void convert_tables(const Args& a) {
    uint4* U = (uint4*)(a.ws + WS_TU); uint4* V = (uint4*)(a.ws + WS_TV);
    const size_t n16 = (size_t)16384 * D / 16;
    const size_t gt = (size_t)blockIdx.x * NTHREADS + threadIdx.x, NT = (size_t)gridDim.x * NTHREADS;
    for (size_t i = gt; i < 2 * n16; i += NT) {
        const bool isv = i >= n16; const size_t j = isv ? i - n16 : i;
        const f32x4* sp = (const f32x4*)(isv ? a.pv : a.pu) + 4 * j;
        const f32x4 v0 = __builtin_nontemporal_load(sp), v1 = __builtin_nontemporal_load(sp + 1), v2 = __builtin_nontemporal_load(sp + 2), v3 = __builtin_nontemporal_load(sp + 3);
        const float s = isv ? V_SCALE : U_SCALE;
        const uint4 o = make_uint4(pk4_fp8(v0[0], v0[1], v0[2], v0[3], s), pk4_fp8(v1[0], v1[1], v1[2], v1[3], s), pk4_fp8(v2[0], v2[1], v2[2], v2[3], s), pk4_fp8(v3[0], v3[1], v3[2], v3[3], s));
        (isv ? V : U)[j] = o;
    }
}

__device__ __forceinline__ float dot16_fp8(const uint4 w, const float (&h)[16], float acc) {
    const f32x2_t a0 = __builtin_amdgcn_cvt_pk_f32_fp8((int)w.x, false), a1 = __builtin_amdgcn_cvt_pk_f32_fp8((int)w.x, true);
    const f32x2_t a2 = __builtin_amdgcn_cvt_pk_f32_fp8((int)w.y, false), a3 = __builtin_amdgcn_cvt_pk_f32_fp8((int)w.y, true);
    const f32x2_t a4 = __builtin_amdgcn_cvt_pk_f32_fp8((int)w.z, false), a5 = __builtin_amdgcn_cvt_pk_f32_fp8((int)w.z, true);
    const f32x2_t a6 = __builtin_amdgcn_cvt_pk_f32_fp8((int)w.w, false), a7 = __builtin_amdgcn_cvt_pk_f32_fp8((int)w.w, true);
    acc += a0.x * h[0] + a0.y * h[1] + a1.x * h[2] + a1.y * h[3] + a2.x * h[4] + a2.y * h[5] + a3.x * h[6] + a3.y * h[7]
         + a4.x * h[8] + a4.y * h[9] + a5.x * h[10] + a5.y * h[11] + a6.x * h[12] + a6.y * h[13] + a7.x * h[14] + a7.y * h[15];
    return acc;
}
__device__ __forceinline__ void axpy16_fp8(const uint4 w, const float s, float (&acc)[16]) {
    const f32x2_t a0 = __builtin_amdgcn_cvt_pk_f32_fp8((int)w.x, false), a1 = __builtin_amdgcn_cvt_pk_f32_fp8((int)w.x, true);
    const f32x2_t a2 = __builtin_amdgcn_cvt_pk_f32_fp8((int)w.y, false), a3 = __builtin_amdgcn_cvt_pk_f32_fp8((int)w.y, true);
    const f32x2_t a4 = __builtin_amdgcn_cvt_pk_f32_fp8((int)w.z, false), a5 = __builtin_amdgcn_cvt_pk_f32_fp8((int)w.z, true);
    const f32x2_t a6 = __builtin_amdgcn_cvt_pk_f32_fp8((int)w.w, false), a7 = __builtin_amdgcn_cvt_pk_f32_fp8((int)w.w, true);
    acc[0] += s * a0.x; acc[1] += s * a0.y; acc[2] += s * a1.x; acc[3] += s * a1.y; acc[4] += s * a2.x; acc[5] += s * a2.y; acc[6] += s * a3.x; acc[7] += s * a3.y;
    acc[8] += s * a4.x; acc[9] += s * a4.y; acc[10] += s * a5.x; acc[11] += s * a5.y; acc[12] += s * a6.x; acc[13] += s * a6.y; acc[14] += s * a7.x; acc[15] += s * a7.y;
}
__device__ __forceinline__ void phase_experts(const Args& a) {
    const u16* H2 = (const u16*)(a.ws + WS_ACT);
    const float* X1 = (const float*)(a.ws + WS_X1);
    const int* IDX = (const int*)(a.ws + WS_IDX);
    const float* GATE = (const float*)(a.ws + WS_GATE);
    const float* mod = (const float*)(a.ws + WS_MOD);
    const uint4* U = (const uint4*)(a.ws + WS_TU); const uint4* V = (const uint4*)(a.ws + WS_TV);
    const int lane = threadIdx.x & 63, wave = threadIdx.x >> 6;
    const int gw = blockIdx.x * NWAVES + wave, NGW = gridDim.x * NWAVES;
    for (int t = gw; t < T; t += NGW) {
        const int b = t / S;
        float h[2][16], acc[2][16];
#pragma unroll
        for (int m = 0; m < 2; ++m) {
            const uint4* hp = (const uint4*)(H2 + (size_t)t * D + lane * 16 + 1024 * m);
            const uint4 p0 = hp[0], p1 = hp[1];
            h[m][0] = lo2f(p0.x); h[m][1] = hi2f(p0.x); h[m][2] = lo2f(p0.y); h[m][3] = hi2f(p0.y); h[m][4] = lo2f(p0.z); h[m][5] = hi2f(p0.z); h[m][6] = lo2f(p0.w); h[m][7] = hi2f(p0.w);
            h[m][8] = lo2f(p1.x); h[m][9] = hi2f(p1.x); h[m][10] = lo2f(p1.y); h[m][11] = hi2f(p1.y); h[m][12] = lo2f(p1.z); h[m][13] = hi2f(p1.z); h[m][14] = lo2f(p1.w); h[m][15] = hi2f(p1.w);
#pragma unroll
            for (int i = 0; i < 16; ++i) acc[m][i] = 0.f;
        }
#pragma unroll 1
        for (int r0 = 0; r0 < 128; r0 += 2) {
            const int2 e2 = *(const int2*)(IDX + (size_t)t * 128 + r0);
            const float2 g2 = *(const float2*)(GATE + (size_t)t * 128 + r0);
            const int e[2] = {__builtin_amdgcn_readfirstlane(e2.x), __builtin_amdgcn_readfirstlane(e2.y)};
            const float g[2] = {g2.x, g2.y};
            uint4 u[2][2], v[2][2];
#pragma unroll
            for (int q = 0; q < 2; ++q)
#pragma unroll
                for (int m = 0; m < 2; ++m) u[q][m] = U[(size_t)e[q] * 128 + lane + 64 * m];
#pragma unroll
            for (int q = 0; q < 2; ++q)
#pragma unroll
                for (int m = 0; m < 2; ++m) v[q][m] = V[(size_t)e[q] * 128 + lane + 64 * m];
            float d[2];
#pragma unroll
            for (int q = 0; q < 2; ++q) d[q] = dot16_fp8(u[q][1], h[1], dot16_fp8(u[q][0], h[0], 0.f));
#pragma unroll
            for (int o = 32; o > 0; o >>= 1) {
#pragma unroll
                for (int q = 0; q < 2; ++q) d[q] += __shfl_xor(d[q], o);
            }
#pragma unroll
            for (int q = 0; q < 2; ++q) { const float w = g[q] * gelu_f(d[q] * (1.f / U_SCALE)) * (1.f / V_SCALE);
                axpy16_fp8(v[q][0], w, acc[0]); axpy16_fp8(v[q][1], w, acc[1]); }
        }
        float ss = 0.f;
#pragma unroll
        for (int m = 0; m < 2; ++m)
#pragma unroll
            for (int k = 0; k < 4; ++k) {
                const int c0 = lane * 16 + 1024 * m + 4 * k;
                const float4 xa = *(const float4*)(X1 + (size_t)t * D + c0);
                const float4 ga = *(const float4*)(mod + b * 12288 + 5 * 2048 + c0);
                acc[m][4 * k + 0] = xa.x + ga.x * acc[m][4 * k + 0]; acc[m][4 * k + 1] = xa.y + ga.y * acc[m][4 * k + 1];
                acc[m][4 * k + 2] = xa.z + ga.z * acc[m][4 * k + 2]; acc[m][4 * k + 3] = xa.w + ga.w * acc[m][4 * k + 3];
#pragma unroll
                for (int i = 0; i < 4; ++i) ss += acc[m][4 * k + i] * acc[m][4 * k + i];
            }
        ss = wave_sum(ss);
        const float rstd = rsqrtf(ss * (1.f / D) + NORM_EPS);
#pragma unroll
        for (int m = 0; m < 2; ++m)
#pragma unroll
            for (int k = 0; k < 4; ++k) {
                const int c0 = lane * 16 + 1024 * m + 4 * k;
                const float4 gf = *(const float4*)(a.g_fin + c0);
                *(float4*)(a.out + (size_t)t * D + c0) = make_float4(acc[m][4 * k + 0] * rstd * gf.x, acc[m][4 * k + 1] * rstd * gf.y, acc[m][4 * k + 2] * rstd * gf.z, acc[m][4 * k + 3] * rstd * gf.w);
            }
    }
}

#define XB_TMO      128
#define XB_XCNT(j)  (256  + 64 * (j))
#define XB_XSUB(j)  (1280 + 64 * (j))
#define XB_XGEN(j)  (2304 + 64 * (j))
#define XB_TOP      3328
#define XB_TOPGEN   3392
#define XCD_BAR_WORDS 3456
#define XB_SPIN_CAP (1u << 18)

__device__ __forceinline__ unsigned xb_ld(unsigned* p)              { return __hip_atomic_load(p, __ATOMIC_RELAXED, __HIP_MEMORY_SCOPE_AGENT); }
__device__ __forceinline__ unsigned xb_add(unsigned* p, unsigned v) { return __hip_atomic_fetch_add(p, v, __ATOMIC_RELAXED, __HIP_MEMORY_SCOPE_AGENT); }
__device__ __forceinline__ unsigned xb_xcc_id() { return (unsigned)__builtin_amdgcn_s_getreg((3 << 11) | 20) & 0xFu; }
#define XB_SPIN(cond, bar) do { unsigned _sp = 0; while (cond) { __builtin_amdgcn_s_sleep(1); \
    if ((++_sp & 255u) == 0u) { if (xb_ld(&(bar)[XB_TMO])) break; if (_sp > XB_SPIN_CAP) { atomicAdd(&(bar)[XB_TMO], 1u); break; } } } } while (0)

struct XcdBarrier {
    unsigned* bar; unsigned x;
    volatile LAS unsigned* st;
};

__device__ __forceinline__ XcdBarrier xcd_barrier_post(unsigned* bar, volatile LAS unsigned* st) {
    XcdBarrier b; b.bar = bar; b.x = xb_xcc_id(); b.st = st;
    if (threadIdx.x == 0) (void)xb_add(&bar[XB_XCNT(b.x)], 1u);
    return b;
}
__device__ __forceinline__ void xcd_barrier_complete(unsigned* bar, unsigned x, unsigned& nloc, unsigned& nx) {
    const unsigned G = gridDim.x * gridDim.y * gridDim.z;
    unsigned sum, cnt, mine, sp = 0u;
    for (;;) {
        sum = 0u; cnt = 0u; mine = 0u;
#pragma unroll
        for (unsigned j = 0; j < 16; ++j) { const unsigned c = xb_ld(&bar[XB_XCNT(j)]); sum += c; cnt += (c > 0u) ? 1u : 0u; mine = (j == x) ? c : mine; }
        if (sum == G) break;
        __builtin_amdgcn_s_sleep(1);
        if ((++sp & 255u) == 0u) { if (xb_ld(&bar[XB_TMO])) break; if (sp > XB_SPIN_CAP) { atomicAdd(&bar[XB_TMO], 1u); break; } }
    }
    nloc = mine > 0u ? mine : 1u; nx = cnt > 0u ? cnt : 1u;
}

__device__ __forceinline__ void xcd_barrier(const XcdBarrier& b) {
    asm volatile("s_waitcnt vmcnt(0)" ::: "memory");
    __syncthreads();
    if (threadIdx.x == 0) {
        unsigned* bar = b.bar;
        __builtin_amdgcn_s_waitcnt(0);
        unsigned nloc = b.st[0], nx = b.st[1];
        if (nloc == 0u) { xcd_barrier_complete(bar, b.x, nloc, nx); b.st[0] = nloc; b.st[1] = nx; }
        const unsigned old = xb_add(&bar[XB_XSUB(b.x)], 1u);
        const unsigned gen = old / nloc;
        if (old + 1u == (gen + 1u) * nloc) {
            __builtin_amdgcn_fence(__ATOMIC_RELEASE, "agent");
            asm volatile("s_waitcnt vmcnt(0)" ::: "memory");
            const unsigned og = xb_add(&bar[XB_TOP], 1u);
            const unsigned tg = og / nx;
            if (og + 1u == (tg + 1u) * nx) xb_add(&bar[XB_TOPGEN], 1u);
            else XB_SPIN(xb_ld(&bar[XB_TOPGEN]) == tg, bar);
            __builtin_amdgcn_fence(__ATOMIC_ACQUIRE, "agent");
            xb_add(&bar[XB_XGEN(b.x)], 1u);
            asm volatile("s_waitcnt vmcnt(0)" ::: "memory");
        } else {
            XB_SPIN(xb_ld(&bar[XB_XGEN(b.x)]) == gen, bar);
            __builtin_amdgcn_fence(__ATOMIC_ACQUIRE, "agent");
            asm volatile("s_waitcnt vmcnt(0)" ::: "memory");
        }
    }
    __syncthreads();
}

constexpr int NPHASES = 11;
__global__ void __launch_bounds__(NTHREADS, 2) mk_fwd(Args a) {
    extern __shared__ __attribute__((aligned(16))) unsigned char lds[];
    cg::grid_group grid = cg::this_grid();
    const int lo = a.ph_lo, hi = a.ph_hi;
    volatile LAS unsigned* xbw = (volatile LAS unsigned*)(lds + LDS_MAIN);
    if (threadIdx.x < 4) xbw[threadIdx.x] = 0u;
    __syncthreads();
    XcdBarrier xbar = xcd_barrier_post((unsigned*)(a.ws + WS_CTL), xbw);
#define IN(k) (lo <= (k) && (k) < hi)
#define SEAM(k) do { if (IN(k) && IN((k) + 1)) { if ((k) == 0) grid.sync(); else xcd_barrier(xbar); } } while (0)
    const float* mod = (const float*)(a.ws + WS_MOD);
    if (IN(0)) phase0(a, lds);
    SEAM(0);
    if (IN(1)) norm_mod_phase(a.x, a.g_mix, mod, 0, 1, (u16*)(a.ws + WS_ACT));
    SEAM(1);
    if (IN(2)) gemm8(lds, (const u16*)(a.ws + WS_ACT), (const u16*)(a.ws + WS_WIN), T, NPAD, D, EpiProj{(u16*)(a.ws + WS_P), (float*)(a.ws + WS_GZ)});
    SEAM(2);
    if (IN(3)) phase_rope_prep(a, lds);
    SEAM(3);
    if (IN(4)) phase_mixers(a, lds);
    SEAM(4);
    if (IN(5)) phase_gla_fin(a);
    SEAM(5);
    if (IN(6)) gemm8(lds, (const u16*)(a.ws + WS_ACT), (const u16*)(a.ws + WS_WOUT), T, D, D, EpiResid{a.x, mod, (float*)(a.ws + WS_X1)});
    SEAM(6);
    if (IN(7)) { norm_mod_phase((const float*)(a.ws + WS_X1), a.g_ffn, mod, 3, 4, (u16*)(a.ws + WS_ACT)); convert_tables(a); }
    SEAM(7);
    if (IN(8)) gemm8(lds, (const u16*)(a.ws + WS_ACT), (const u16*)(a.ws + WS_WPQ), T, D, D, EpiBf16{(u16*)(a.ws + WS_Q)});
    SEAM(8);
    if (IN(9)) phase_route(a, lds);
    SEAM(9);
    if (IN(10)) phase_experts(a);
#ifdef PROBE_REP10
    grid.sync(); phase_experts(a);
#endif
#ifdef PROBE_REP9
    grid.sync(); phase_route(a, lds); grid.sync(); phase_experts(a);
#endif
#undef IN
#undef SEAM
}

#ifndef MK_ONE_LAUNCH
#define MK_ONE_LAUNCH 1
#endif
extern "C" void kernel_launch(void* const* d_in, const int* in_sizes, int n_in, void* d_out, int out_size, void* d_ws, size_t ws_size, hipStream_t stream) {
    static int grid = 0;
    if (grid == 0) {
        if (n_in != 19 || out_size != T * D || ws_size < WS_END) {
            fprintf(stderr, "kernel_launch: unexpected shapes: n_in %d out %d ws %zu (need %zu)\n", n_in, out_size, ws_size, (size_t)WS_END);
            grid = -1; return;
        }
        int dev = 0, cus = 0, per_cu = 0;
        (void)hipGetDevice(&dev);
        (void)hipDeviceGetAttribute(&cus, hipDeviceAttributeMultiprocessorCount, dev);
        (void)hipFuncSetAttribute((const void*)mk_fwd, hipFuncAttributeMaxDynamicSharedMemorySize, LDS_BYTES);
        (void)hipOccupancyMaxActiveBlocksPerMultiprocessor(&per_cu, (const void*)mk_fwd, NTHREADS, LDS_BYTES);
        if (per_cu < 1) { fprintf(stderr, "kernel_launch: occupancy query says %d blocks/CU\n", per_cu); grid = -1; return; }
        grid = cus;
        (void)hipGetLastError();
    }
    if (grid < 0) return;
    Args a{};
    a.x = (const float*)d_in[0]; a.c = (const float*)d_in[1]; a.pos = (const int*)d_in[2]; a.w_ada = (const float*)d_in[3];
    a.b_ada = (const float*)d_in[4]; a.g_mix = (const float*)d_in[5]; a.w_in = (const float*)d_in[6]; a.wgf = (const float*)d_in[7];
    a.bgf = (const float*)d_in[8]; a.wgb = (const float*)d_in[9]; a.bgb = (const float*)d_in[10]; a.g_gla = (const float*)d_in[11];
    a.w_out = (const float*)d_in[12]; a.g_ffn = (const float*)d_in[13]; a.w_pq = (const float*)d_in[14]; a.subk = (const float*)d_in[15];
    a.pu = (const float*)d_in[16]; a.pv = (const float*)d_in[17]; a.g_fin = (const float*)d_in[18];
    a.out = (float*)d_out; a.ws = (unsigned char*)d_ws;
#if MK_ONE_LAUNCH
    (void)hipMemsetAsync((unsigned char*)d_ws + WS_CTL, 0, XCD_BAR_WORDS * 4, stream);
    a.ph_lo = 0; a.ph_hi = NPHASES;
    void* args[] = {&a};
    hipError_t e = hipLaunchCooperativeKernel((const void*)mk_fwd, dim3(grid), dim3(NTHREADS), args, LDS_BYTES, stream);
    if (e != hipSuccess) fprintf(stderr, "cooperative launch failed: %s (grid %d)\n", hipGetErrorString(e), grid);
#else
    for (int p = 0; p < NPHASES; ++p) {
        a.ph_lo = p; a.ph_hi = p + 1;
        hipLaunchKernelGGL(mk_fwd, dim3(grid), dim3(NTHREADS), LDS_BYTES, stream, a);
    }
#endif
}
```

```cpp
#include <hip/hip_runtime.h>
#include <hip/hip_cooperative_groups.h>
#include <cstdio>
#include <cstdint>

namespace cg = cooperative_groups;

typedef unsigned short u16;
typedef __attribute__((ext_vector_type(8))) short bf16x8;
typedef __attribute__((ext_vector_type(4))) float f32x4;
typedef short s16x4 __attribute__((ext_vector_type(4)));
#define TID ((int)threadIdx.x)
#define BID ((int)blockIdx.x)
#define GDIM ((int)gridDim.x)
#define LAS __attribute__((address_space(3)))

constexpr int D = 2048, NB = 4, S = 4096, T = NB * S;
constexpr int INW = 6176;
constexpr int NP = 6144;
constexpr int NPAD = 6400;
constexpr int C_GQ = 0, C_GK = 512, C_GV = 1024, C_GR = 2048, C_DQ = 3072, C_DK = 4096, C_DV = 5120;
constexpr int NTHREADS = 512, NWAVES = 8;
constexpr int LDS_MAIN = 128 * 1024;
constexpr int LDS_BYTES = LDS_MAIN + 16;
constexpr float NORM_EPS = 1e-6f;

constexpr size_t WS_CTL = 0;
constexpr size_t WS_MOD = 65536;
constexpr size_t WS_CS = 524288;
constexpr size_t WS_WIN = WS_CS + (size_t)T * 64 * 8;
constexpr size_t WS_WOUT = WS_WIN + (size_t)NPAD * D * 2;
constexpr size_t WS_WPQ = WS_WOUT + (size_t)D * D * 2;
constexpr size_t WS_ACT = WS_WPQ + (size_t)D * D * 2;
constexpr size_t WS_P = WS_ACT + (size_t)T * D * 2;
constexpr size_t WS_X1 = WS_P;
constexpr size_t WS_Q = WS_P + (size_t)T * D * 4;
constexpr size_t WS_GZ = WS_P + (size_t)T * NP * 2;
constexpr int GLA_NPREP = NB * 4 * 2 * (S / 64);
constexpr size_t WS_QD = WS_GZ + (size_t)T * 32 * 4;
constexpr size_t WS_KE = WS_QD + (size_t)GLA_NPREP * 16384;
constexpr size_t WS_AT = WS_KE + (size_t)GLA_NPREP * 16384;
constexpr size_t WS_DEC = WS_AT + (size_t)GLA_NPREP * 8192;
constexpr size_t WS_OFB = WS_DEC + (size_t)GLA_NPREP * 512;
constexpr size_t WS_IDX = WS_OFB + (size_t)2 * T * 1024 * 2;
constexpr size_t WS_GATE = WS_IDX + (size_t)T * 128 * 4;
constexpr size_t WS_END = WS_GATE + (size_t)T * 128 * 4;
constexpr size_t WS_TU = WS_QD;
constexpr size_t WS_TV = WS_QD + (size_t)16384 * 1152;
static_assert(WS_TV + (size_t)16384 * 1152 <= WS_IDX, "table region");

struct Args {
    const float* x; const float* c; const int* pos; const float* w_ada; const float* b_ada; const float* g_mix;
    const float* w_in; const float* wgf; const float* bgf; const float* wgb; const float* bgb; const float* g_gla;
    const float* w_out; const float* g_ffn; const float* w_pq; const float* subk; const float* pu; const float* pv; const float* g_fin;
    float* out; unsigned char* ws; int ph_lo, ph_hi;
};

__device__ __forceinline__ float bf2f(u16 h) { return __uint_as_float(((unsigned)h) << 16); }
__device__ __forceinline__ u16 f2bf(float f) { unsigned u = __float_as_uint(f); u += 0x7fffu + ((u >> 16) & 1u); return (u16)(u >> 16); }
__device__ __forceinline__ unsigned pack2(float a, float b) { return (unsigned)f2bf(a) | ((unsigned)f2bf(b) << 16); }
__device__ __forceinline__ float lo2f(unsigned p) { return __uint_as_float(p << 16); }
__device__ __forceinline__ float hi2f(unsigned p) { return __uint_as_float(p & 0xffff0000u); }
__device__ __forceinline__ float wave_sum(float v) {
#pragma unroll
    for (int o = 32; o > 0; o >>= 1) v += __shfl_xor(v, o);
    return v;
}
__device__ __forceinline__ float wave_max(float v) {
#pragma unroll
    for (int o = 32; o > 0; o >>= 1) v = fmaxf(v, __shfl_xor(v, o));
    return v;
}
__device__ __forceinline__ float silu_f(float v) { return v / (1.f + __expf(-v)); }
__device__ __forceinline__ float gelu_f(float a) { return 0.5f * a * (1.f + erff(a * 0.70710678118654752f)); }
__device__ __forceinline__ float logsigmoid_f(float z) { return z < 0.f ? z - log1pf(expf(z)) : -log1pf(expf(-z)); }

__device__ __forceinline__ void p0_mod(const Args& a, unsigned char* lds, int bi) {
    float* sc = (float*)lds;
    float* red = sc + 4 * 2048;
    const int tid = threadIdx.x, lane = tid & 63, wave = tid >> 6;
    for (int i = tid; i < 4 * 2048; i += NTHREADS) sc[i] = silu_f(a.c[i]);
    __syncthreads();
    const int j0 = bi * 256 + lane * 4;
    float acc[4][4];
#pragma unroll
    for (int b = 0; b < 4; ++b)
#pragma unroll
        for (int q = 0; q < 4; ++q) acc[b][q] = 0.f;
    const int k0 = wave * 256;
#pragma unroll 4
    for (int kk = 0; kk < 256; ++kk) {
        const int k = k0 + kk;
        const float4 w = *(const float4*)(a.w_ada + (size_t)k * 12288 + j0);
#pragma unroll
        for (int b = 0; b < 4; ++b) {
            const float s = sc[b * 2048 + k];
            acc[b][0] += s * w.x; acc[b][1] += s * w.y; acc[b][2] += s * w.z; acc[b][3] += s * w.w;
        }
    }
#pragma unroll
    for (int b = 0; b < 4; ++b)
#pragma unroll
        for (int q = 0; q < 4; ++q) red[(wave * 4 + b) * 256 + lane * 4 + q] = acc[b][q];
    __syncthreads();
    float* mod = (float*)(a.ws + WS_MOD);
    for (int i = tid; i < 4 * 256; i += NTHREADS) {
        const int b = i >> 8, jc = i & 255;
        float s = 0.f;
#pragma unroll
        for (int w = 0; w < 8; ++w) s += red[(w * 4 + b) * 256 + jc];
        mod[b * 12288 + bi * 256 + jc] = s + a.b_ada[bi * 256 + jc];
    }
    __syncthreads();
}

__device__ __forceinline__ void p0_transpose_item(const float* __restrict__ W, int ldw, int k0, int src_col0, int n_valid,
                                                  u16* __restrict__ WT, int ldt, int n_out0, unsigned char* lds) {
    u16* tl = (u16*)lds;
    const int tid = threadIdx.x;
    {
        const int k = tid >> 3, nc = (tid & 7) * 8;
        float v[8];
        if (nc < n_valid) {
            const float4 v0 = *(const float4*)(W + (size_t)(k0 + k) * ldw + src_col0 + nc);
            const float4 v1 = *(const float4*)(W + (size_t)(k0 + k) * ldw + src_col0 + nc + 4);
            v[0] = v0.x; v[1] = v0.y; v[2] = v0.z; v[3] = v0.w; v[4] = v1.x; v[5] = v1.y; v[6] = v1.z; v[7] = v1.w;
        } else {
#pragma unroll
            for (int i = 0; i < 8; ++i) v[i] = 0.f;
        }
#pragma unroll
        for (int i = 0; i < 8; ++i) tl[(nc + i) * 72 + k] = f2bf(v[i]);
    }
    __syncthreads();
    {
        const int n = tid >> 3, kc = (tid & 7) * 8;
        const uint4 v = *(const uint4*)(tl + n * 72 + kc);
        *(uint4*)(WT + (size_t)(n_out0 + n) * ldt + k0 + kc) = v;
    }
    __syncthreads();
}

__device__ __forceinline__ void phase0(const Args& a, unsigned char* lds) {
    const int bi = blockIdx.x, G = gridDim.x, tid = threadIdx.x;
    if (bi < 48) p0_mod(a, lds, bi);
    constexpr int I_IN = 32 * (NPAD / 64), I_SQ = 32 * 32;
    u16* WinT = (u16*)(a.ws + WS_WIN); u16* WoutT = (u16*)(a.ws + WS_WOUT); u16* WpqT = (u16*)(a.ws + WS_WPQ);
    for (int it = bi; it < I_IN + 2 * I_SQ; it += G) {
        if (it < I_IN) {
            const int kt = it & 31, nt = it >> 5;
            const int n0 = nt * 64;
            int src, nv;
            if (n0 < 3072) { src = n0; nv = 64; }
            else if (n0 < 6144) { src = n0 + 32; nv = 64; }
            else if (n0 == 6144) { src = 3072; nv = 32; }
            else { src = 0; nv = 0; }
            p0_transpose_item(a.w_in, INW, kt * 64, src, nv, WinT, D, n0, lds);
        } else if (it < I_IN + I_SQ) {
            const int r = it - I_IN; const int kt = r & 31, nt = r >> 5;
            p0_transpose_item(a.w_out, D, kt * 64, nt * 64, 64, WoutT, D, nt * 64, lds);
        } else {
            const int r = it - I_IN - I_SQ; const int kt = r & 31, nt = r >> 5;
            p0_transpose_item(a.w_pq, D, kt * 64, nt * 64, 64, WpqT, D, nt * 64, lds);
        }
    }
    float2* cs = (float2*)(a.ws + WS_CS);
    for (int i = bi * NTHREADS + tid; i < T * 64; i += G * NTHREADS) {
        const int t = i >> 6, f = i & 63;
        const float inv_freq = powf(10000.0f, -(float)f * 2.0f / 128.0f);
        const float ang = (float)a.pos[t] * inv_freq;
        const double rev = (double)ang * 0.15915494309189533577;
        const float fr = (float)(rev - floor(rev));
        cs[i] = make_float2(__builtin_amdgcn_cosf(fr), __builtin_amdgcn_sinf(fr));
    }
}

__device__ __forceinline__ void norm_mod_phase(const float* __restrict__ xin, const float* __restrict__ g, const float* __restrict__ mod,
                                               int sh_chunk, int sc_chunk, u16* __restrict__ outp) {
    const int lane = threadIdx.x & 63, wave = threadIdx.x >> 6;
    const int gw = blockIdx.x * NWAVES + wave, NGW = gridDim.x * NWAVES;
    for (int t = gw; t < T; t += NGW) {
        const int b = t / S;
        const float4* xr = (const float4*)(xin + (size_t)t * D);
        float4 v[8]; float ss = 0.f;
#pragma unroll
        for (int m = 0; m < 8; ++m) { v[m] = xr[lane + 64 * m]; ss += v[m].x * v[m].x + v[m].y * v[m].y + v[m].z * v[m].z + v[m].w * v[m].w; }
        ss = wave_sum(ss);
        const float rstd = rsqrtf(ss * (1.f / D) + NORM_EPS);
        const float4* gp = (const float4*)g;
        const float4* shp = (const float4*)(mod + b * 12288 + sh_chunk * 2048);
        const float4* scp = (const float4*)(mod + b * 12288 + sc_chunk * 2048);
        uint2* op = (uint2*)(outp + (size_t)t * D);
#pragma unroll
        for (int m = 0; m < 8; ++m) {
            const int i = lane + 64 * m;
            const float4 gg = gp[i], sh = shp[i], sc = scp[i];
            const float h0 = v[m].x * rstd * gg.x * (1.f + sc.x) + sh.x;
            const float h1 = v[m].y * rstd * gg.y * (1.f + sc.y) + sh.y;
            const float h2 = v[m].z * rstd * gg.z * (1.f + sc.z) + sh.z;
            const float h3 = v[m].w * rstd * gg.w * (1.f + sc.w) + sh.w;
            op[i] = make_uint2(pack2(h0, h1), pack2(h2, h3));
        }
    }
}

namespace pg8 {
#define PG8_LAS __attribute__((address_space(3)))
typedef unsigned short bf16_t;
typedef short bf16x8 __attribute__((ext_vector_type(8)));
typedef float f32x4 __attribute__((ext_vector_type(4)));
typedef unsigned u32x4 __attribute__((ext_vector_type(4)));
constexpr int BM = 256, BK = 64, HALF = 128, HTB = HALF * BK * 2  , STAGE_BYTES = 8 * HTB, NXCD = 8, WGM = 8;

__host__ __device__ __forceinline__ int lds_byte(int r, int c) { const int st = (r >> 4) * 2 + (c >> 5), rr = r & 15, cc = c & 31, ob = rr * 64 + cc * 2; return st * 1024 + (ob ^ (((ob >> 9) & 1) << 5)); }
__host__ __device__ __forceinline__ void stage_rc(int b, int& R, int& C) { const int st = b / 1024, sb = b % 1024, swz = sb ^ (((sb >> 9) & 1) << 5); R = (st >> 1) * 16 + swz / 64; C = (st & 1) * 32 + (swz % 64) / 2; }
__host__ __device__ __forceinline__ int perm32(int rho) { const int n = rho >> 4, i = rho & 15; return 8 * (i >> 2) + 4 * n + (i & 3); }

struct Unit { int pm, pn; };
struct Gemm { const bf16_t* A; const bf16_t* Bt; int M, N, K; };

struct StaticOrder {
    int nM, nN, nwg, G, c;
    __host__ __device__ void init(int M, int N, int G_, int c_) { nM = M / BM; nN = N / BM; nwg = nM * nN; G = G_; c = c_; }
    __host__ __device__ bool next(int i, Unit& u) const {
        const long L = (long)i * G + c; if (L >= nwg) return false;
        int wgid = (int)L; { const int q = nwg / NXCD, r = nwg % NXCD, xcd = wgid % NXCD, off = wgid / NXCD; wgid = (xcd < r ? xcd * (q + 1) : r * (q + 1) + (xcd - r) * q) + off; }
        const int nig = WGM * nN, gid = wgid / nig, fm = gid * WGM, gsz = (nM - fm) < WGM ? (nM - fm) : WGM;
        u.pm = fm + ((wgid % nig) % gsz); u.pn = (wgid % nig) / gsz; return true;
    }
    __device__ __forceinline__ void a_ready(const Unit&) const {}
    __device__ __forceinline__ void done(const Unit&) const {}
};
__device__ __forceinline__ unsigned cvt_pk_bf16(float lo, float hi) { unsigned r; asm volatile("v_cvt_pk_bf16_f32 %0, %1, %2" : "=v"(r) : "v"(lo), "v"(hi)); return r; }
typedef float f32x2 __attribute__((ext_vector_type(2)));
template <class Epi, class Sched, bool STAMP = false>
__device__ __forceinline__ void gemm_phase(PG8_LAS unsigned char* lds, const Gemm g, const Sched& S, const Epi& E, unsigned long long* stamps) {
    const int tid = threadIdx.x, wid = __builtin_amdgcn_readfirstlane(tid >> 6), lane = tid & 63, wr = wid >> 2, wc = wid & 3, fr = lane & 15, fq = lane >> 4;
    const int K = g.K, nt = K / BK;
    int ts_lo = 0, ts_hi = 0, nts = 0; const unsigned long long rt_entry = STAMP ? (unsigned long long)wall_clock64() : 0ull;
#define PG8_STAMP() do { if (STAMP && wid == 0 && nts < 64) { const unsigned long long _c = (unsigned long long)clock64(); \
        ts_lo = (lane == nts) ? (int)(unsigned)_c : ts_lo; ts_hi = (lane == nts) ? (int)(unsigned)(_c >> 32) : ts_hi; ++nts; } } while (0)
    PG8_STAMP();
    unsigned voffA[2], voffB[2];
#pragma unroll
    for (int i = 0; i < 2; ++i) { int R, C; stage_rc(tid * 16 + i * 8192, R, C); const int Rb = Epi::PERM ? ((R & ~31) + perm32(R & 31)) : R;
        voffA[i] = (unsigned)(R * K + C) * 2u; voffB[i] = (unsigned)(Rb * K + C) * 2u; }
    const size_t kstep = (size_t)(BK * 2);
    const size_t hstep = (size_t)HALF * K * 2;
    const size_t tstep = 2 * hstep;
    const unsigned ldsw = (unsigned)wid * 1024u;
    const int aoff = lds_byte(wr * 64 + fr, fq * 8), boff = lds_byte(wc * 32 + fr, fq * 8);
#define PG8_SA(b, h) (((b) * 2 + (h)) * HTB)
#define PG8_SB(b, h) ((4 + (b) * 2 + (h)) * HTB)
#define PG8_STAGE(bufoff, gbase, voff) do { _Pragma("unroll") for (int _i = 0; _i < 2; ++_i) \
        __builtin_amdgcn_global_load_lds((const unsigned*)((const char*)(gbase) + (voff)[_i]), (PG8_LAS unsigned*)(lds + (bufoff) + ldsw + _i * 8192), 16, 0, 0); } while (0)
#define PG8_LDA(dst, b, h) do { _Pragma("unroll") for (int m = 0; m < 4; ++m) _Pragma("unroll") for (int k = 0; k < 2; ++k) dst[m][k] = *(const PG8_LAS bf16x8*)(lds + PG8_SA(b, h) + aoff + m * 2048 + k * 1024); } while (0)
#define PG8_LDB(dst, b, h) do { _Pragma("unroll") for (int n = 0; n < 2; ++n) _Pragma("unroll") for (int k = 0; k < 2; ++k) dst[n][k] = *(const PG8_LAS bf16x8*)(lds + PG8_SB(b, h) + boff + n * 2048 + k * 1024); } while (0)
#define PG8_MMA(ai, bj, At, Bt) do { __builtin_amdgcn_s_setprio(1); _Pragma("unroll") for (int m = 0; m < 4; ++m) _Pragma("unroll") for (int n = 0; n < 2; ++n) _Pragma("unroll") for (int k = 0; k < 2; ++k) \
        acc[ai][bj][m][n] = __builtin_amdgcn_mfma_f32_16x16x32_bf16(Bt[n][k], At[m][k], acc[ai][bj][m][n], 0, 0, 0); __builtin_amdgcn_s_setprio(0); } while (0)
#define PG8_WAIT_V(n) asm volatile("s_waitcnt vmcnt(" #n ")" ::: "memory")
#define PG8_WAIT_L(n) asm volatile("s_waitcnt lgkmcnt(" #n ")" ::: "memory")
#define PG8_BAR __builtin_amdgcn_s_barrier()
#define PG8_SCHED __builtin_amdgcn_sched_barrier(0)
    Unit cur, nxt; int ui = 0;
    if (!S.next(0, cur)) return;
    f32x4 acc[2][2][4][2];
#pragma unroll
    for (int a = 0; a < 2; ++a)
#pragma unroll
        for (int b = 0; b < 2; ++b)
#pragma unroll
            for (int m = 0; m < 4; ++m)
#pragma unroll
                for (int n = 0; n < 2; ++n) acc[a][b][m][n] = (f32x4){0.f, 0.f, 0.f, 0.f};
    bf16x8 At[4][2], B0[2][2], B1[2][2];
    const char* cA = (const char*)g.A + (size_t)cur.pm * tstep; const char* cB = (const char*)g.Bt + (size_t)cur.pn * tstep;
    S.a_ready(cur);
    PG8_STAGE(PG8_SB(0, 0), cB, voffB); PG8_STAGE(PG8_SA(0, 0), cA, voffA); PG8_STAGE(PG8_SB(0, 1), cB + hstep, voffB); PG8_STAGE(PG8_SA(0, 1), cA + hstep, voffA);
    if (wr == 1) PG8_BAR;
    PG8_WAIT_V(4); PG8_BAR;
    PG8_STAGE(PG8_SB(1, 0), cB + kstep, voffB); PG8_STAGE(PG8_SA(1, 0), cA + kstep, voffA); PG8_STAGE(PG8_SB(1, 1), cB + hstep + kstep, voffB);
    PG8_WAIT_V(6); PG8_BAR;
    PG8_STAMP();
    for (;;) {
        const bool has_next = S.next(ui + 1, nxt);
        const char* nA = has_next ? (const char*)g.A + (size_t)nxt.pm * tstep : cA; const char* nB = has_next ? (const char*)g.Bt + (size_t)nxt.pn * tstep : cB;
        for (int t = 0; t < nt; t += 2) {
            const bool last = (t == nt - 2);
            const char* a1 = cA + (size_t)(t + 1) * kstep;
            const char* a2 = last ? nA : cA + (size_t)(t + 2) * kstep; const char* b2 = last ? nB : cB + (size_t)(t + 2) * kstep;
            const char* a3 = a2 + kstep; const char* b3 = b2 + kstep;
            if (last && has_next) S.a_ready(nxt);
            PG8_LDB(B0, 0, 0); PG8_SCHED; PG8_LDA(At, 0, 0); PG8_STAGE(PG8_SA(1, 1), a1 + hstep, voffA);
            PG8_WAIT_L(8); PG8_BAR; PG8_WAIT_L(0); PG8_MMA(0, 0, At, B0); PG8_BAR; PG8_SCHED;
            PG8_LDB(B1, 0, 1); PG8_STAGE(PG8_SB(0, 0), b2, voffB);
            PG8_BAR; PG8_WAIT_L(0); PG8_MMA(0, 1, At, B1); PG8_BAR;
            PG8_LDA(At, 0, 1); PG8_STAGE(PG8_SA(0, 0), a2, voffA);
            PG8_BAR; PG8_WAIT_L(0); PG8_MMA(1, 0, At, B0); PG8_BAR; PG8_SCHED;
            PG8_STAGE(PG8_SB(0, 1), b2 + hstep, voffB);
            PG8_WAIT_V(6); PG8_BAR; PG8_MMA(1, 1, At, B1); PG8_BAR;
            PG8_LDB(B0, 1, 0); PG8_SCHED; PG8_LDA(At, 1, 0); PG8_STAGE(PG8_SA(0, 1), a2 + hstep, voffA);
            PG8_WAIT_L(8); PG8_BAR; PG8_WAIT_L(0); PG8_MMA(0, 0, At, B0); PG8_BAR; PG8_SCHED;
            PG8_LDB(B1, 1, 1); PG8_STAGE(PG8_SB(1, 0), b3, voffB);
            PG8_BAR; PG8_WAIT_L(0); PG8_MMA(0, 1, At, B1); PG8_BAR;
            PG8_LDA(At, 1, 1); PG8_STAGE(PG8_SA(1, 0), a3, voffA);
            PG8_BAR; PG8_WAIT_L(0); PG8_MMA(1, 0, At, B0); PG8_BAR; PG8_SCHED;
            PG8_STAGE(PG8_SB(1, 1), b3 + hstep, voffB);
            PG8_WAIT_V(6); PG8_BAR; PG8_MMA(1, 1, At, B1); PG8_BAR;
        }
        PG8_STAMP();
        if constexpr (!Epi::AFTER_DRAIN) { E(acc, cur, wr, wc, fr, fq); S.done(cur); }
        PG8_STAMP();
        if (!has_next) break;
#pragma unroll
        for (int a = 0; a < 2; ++a)
#pragma unroll
            for (int b = 0; b < 2; ++b)
#pragma unroll
                for (int m = 0; m < 4; ++m)
#pragma unroll
                    for (int n = 0; n < 2; ++n) acc[a][b][m][n] = (f32x4){0.f, 0.f, 0.f, 0.f};
        cur = nxt; cA = nA; cB = nB; ++ui;
    }
    PG8_WAIT_V(0);
    if (wr == 0) PG8_BAR;
    PG8_BAR;
    if constexpr (Epi::AFTER_DRAIN) { E.fused(acc, cur, wr, wc, fr, fq, lds, wid, lane); S.done(cur); }
    PG8_STAMP();
    if (STAMP && wid == 0) { stamps[lane] = lane < nts ? (((unsigned long long)(unsigned)ts_hi << 32) | (unsigned)ts_lo) : 0ull;
        if (lane == 62) stamps[62] = rt_entry; if (lane == 63) stamps[63] = (unsigned long long)wall_clock64(); }
#undef PG8_STAMP
#undef PG8_SA
#undef PG8_SB
#undef PG8_STAGE
#undef PG8_LDA
#undef PG8_LDB
#undef PG8_MMA
#undef PG8_WAIT_V
#undef PG8_WAIT_L
#undef PG8_BAR
#undef PG8_SCHED
}
}

struct EpiProj {
    static constexpr bool PERM = true, AFTER_DRAIN = false;
    u16* P; float* gz;
    __device__ __forceinline__ void operator()(const pg8::f32x4 (&acc)[2][2][4][2], const pg8::Unit& u, int wr, int wc, int fr, int fq) const {
        const int row0 = u.pm * 256 + wr * 64 + fr;
        if (u.pn < 24) {
            const int col0 = u.pn * 256 + wc * 32 + 8 * fq;
#pragma unroll
            for (int ai = 0; ai < 2; ++ai)
#pragma unroll
                for (int m = 0; m < 4; ++m) { u16* rowp = P + (size_t)(row0 + ai * 128 + m * 16) * NP + col0;
#pragma unroll
                    for (int bj = 0; bj < 2; ++bj) { const pg8::f32x4 v0 = acc[ai][bj][m][0], v1 = acc[ai][bj][m][1];
                        pg8::u32x4 w; w.x = pg8::cvt_pk_bf16(v0[0], v0[1]); w.y = pg8::cvt_pk_bf16(v0[2], v0[3]); w.z = pg8::cvt_pk_bf16(v1[0], v1[1]); w.w = pg8::cvt_pk_bf16(v1[2], v1[3]);
                        *(pg8::u32x4*)(rowp + bj * 128) = w; } }
        } else if (wc == 0) {
#pragma unroll
            for (int ai = 0; ai < 2; ++ai)
#pragma unroll
                for (int m = 0; m < 4; ++m) { float* rowp = gz + (size_t)(row0 + ai * 128 + m * 16) * 32 + 8 * fq;
                    *(pg8::f32x4*)(rowp) = acc[ai][0][m][0]; *(pg8::f32x4*)(rowp + 4) = acc[ai][0][m][1]; }
        }
    }
};
struct EpiResid {
    static constexpr bool PERM = false, AFTER_DRAIN = false;
    const float* x; const float* mod; float* x1;
    __device__ __forceinline__ void operator()(const pg8::f32x4 (&acc)[2][2][4][2], const pg8::Unit& u, int wr, int wc, int fr, int fq) const {
        const int row0 = u.pm * 256 + wr * 64 + fr, col0 = u.pn * 256 + wc * 32 + 4 * fq;
        const int b = (u.pm * 256) / S;
        pg8::f32x4 ga[2][2];
#pragma unroll
        for (int bj = 0; bj < 2; ++bj)
#pragma unroll
            for (int n = 0; n < 2; ++n) ga[bj][n] = *(const pg8::f32x4*)(mod + b * 12288 + 2 * 2048 + col0 + bj * 128 + n * 16);
#pragma unroll
        for (int ai = 0; ai < 2; ++ai)
#pragma unroll
            for (int m = 0; m < 4; ++m) { const size_t off = (size_t)(row0 + ai * 128 + m * 16) * D + col0;
#pragma unroll
                for (int bj = 0; bj < 2; ++bj)
#pragma unroll
                    for (int n = 0; n < 2; ++n) { const pg8::f32x4 xv = *(const pg8::f32x4*)(x + off + bj * 128 + n * 16);
                        *(pg8::f32x4*)(x1 + off + bj * 128 + n * 16) = xv + ga[bj][n] * acc[ai][bj][m][n]; } }
    }
};
struct EpiBf16 {
    static constexpr bool PERM = true, AFTER_DRAIN = false;
    u16* Q;
    __device__ __forceinline__ void operator()(const pg8::f32x4 (&acc)[2][2][4][2], const pg8::Unit& u, int wr, int wc, int fr, int fq) const {
        const int row0 = u.pm * 256 + wr * 64 + fr, col0 = u.pn * 256 + wc * 32 + 8 * fq;
#pragma unroll
        for (int ai = 0; ai < 2; ++ai)
#pragma unroll
            for (int m = 0; m < 4; ++m) { u16* rowp = Q + (size_t)(row0 + ai * 128 + m * 16) * D + col0;
#pragma unroll
                for (int bj = 0; bj < 2; ++bj) { const pg8::f32x4 v0 = acc[ai][bj][m][0], v1 = acc[ai][bj][m][1];
                    pg8::u32x4 w; w.x = pg8::cvt_pk_bf16(v0[0], v0[1]); w.y = pg8::cvt_pk_bf16(v0[2], v0[3]); w.z = pg8::cvt_pk_bf16(v1[0], v1[1]); w.w = pg8::cvt_pk_bf16(v1[2], v1[3]);
                    *(pg8::u32x4*)(rowp + bj * 128) = w; } }
    }
};
template <class Epi>
__device__ __forceinline__ void gemm8(unsigned char* lds, const u16* A, const u16* Bt, int M, int N, int K, const Epi& E) {
    pg8::Gemm g{A, Bt, M, N, K}; pg8::StaticOrder So; So.init(M, N, (int)gridDim.x, (int)blockIdx.x);
    pg8::gemm_phase<Epi, pg8::StaticOrder, false>((PG8_LAS unsigned char*)lds, g, So, E, nullptr);
    __syncthreads();
}

#define GLA_QD_BYTES 16384
#define GLA_AT_BYTES 8192
__device__ __forceinline__ float gla_logsigmoid(float z) { return z < 0.f ? z - log1pf(expf(z)) : -log1pf(expf(-z)); }

__device__ __forceinline__ void gla_prep_item(const u16* __restrict__ P, int ldp, int cq, int ck, const float* __restrict__ gz,
                                              const float* __restrict__ wg_f, const float* __restrict__ bg_f, const float* __restrict__ wg_b, const float* __restrict__ bg_b,
                                              int Sq, unsigned char* __restrict__ QDg, unsigned char* __restrict__ KEg, unsigned char* __restrict__ ATg, float* __restrict__ DECg,
                                              unsigned char* lds, int item) {
    const int nch = Sq / 64;
    const int c = item % nch, dir = (item / nch) & 1, hh = (item / (nch * 2)) & 3, b = item / (nch * 8);
    const int tid = TID, lane = tid & 63, wave = tid >> 6, li = lane & 15, fq = lane >> 4;
    float* gzs = (float*)lds;
    float* segs = gzs + 64 * 16;
    unsigned char* QDs = lds + 8192;
    unsigned char* KIs = QDs + 16384;
    unsigned char* KEs = KIs + 16384;
    const size_t tok0 = (size_t)b * Sq;
    __syncthreads();
    for (int e = tid; e < 64 * 16; e += 512) {
        const int i = e >> 4, r = e & 15;
        const int s = dir ? (Sq - 1 - (64 * c + i)) : (64 * c + i);
        gzs[e] = gz[(tok0 + s) * 32 + dir * 16 + r];
    }
    const int d = tid & 127, seg = tid >> 7;
    const float* wg = dir ? wg_b : wg_f;
    float wcol[16];
#pragma unroll
    for (int r = 0; r < 16; ++r) wcol[r] = wg[r * 512 + hh * 128 + d];
    const float bias = (dir ? bg_b : bg_f)[hh * 128 + d];
    __syncthreads();
    float pre[16]; float run = 0.f;
#pragma unroll
    for (int k = 0; k < 16; ++k) {
        const int i = 16 * seg + k;
        float z = bias;
#pragma unroll
        for (int r = 0; r < 16; ++r) z += gzs[i * 16 + r] * wcol[r];
        run += gla_logsigmoid(z) * (1.f / 16.f);
        pre[k] = run;
    }
    segs[seg * 128 + d] = run;
    __syncthreads();
    float off = 0.f, tot = 0.f;
#pragma unroll
    for (int s2 = 0; s2 < 4; ++s2) { const float v = segs[s2 * 128 + d]; tot += v; off += (s2 < seg) ? v : 0.f; }
    const float qscale = 0.08838834764831845f;
#pragma unroll
    for (int k = 0; k < 16; ++k) {
        const int i = 16 * seg + k;
        const int s = dir ? (Sq - 1 - (64 * c + i)) : (64 * c + i);
        const float bb = off + pre[k];
        const float q = bf2f(P[(tok0 + s) * ldp + cq + hh * 128 + d]), kx = bf2f(P[(tok0 + s) * ldp + ck + hh * 128 + d]);
        const int o = i * 256 + ((((d >> 3) ^ (i & 15)) << 4) | ((d & 7) << 1));
        *(u16*)(QDs + o) = f2bf(q * qscale * __expf(bb));
        *(u16*)(KIs + o) = f2bf(kx * __expf(-bb));
        *(u16*)(KEs + o) = f2bf(kx * __expf(tot - bb));
    }
    if (seg == 0) DECg[(size_t)item * 128 + d] = __expf(tot);
    __syncthreads();
    {
        uint4* qo = (uint4*)(QDg + (size_t)item * GLA_QD_BYTES); uint4* ko = (uint4*)(KEg + (size_t)item * GLA_QD_BYTES);
#pragma unroll
        for (int k = 0; k < 2; ++k) { const int e = tid + 512 * k; qo[e] = ((const uint4*)QDs)[e]; ko[e] = ((const uint4*)KEs)[e]; }
    }
#pragma unroll
    for (int tt = 0; tt < 2; ++tt) {
        const int tile = wave + 8 * tt, jt = tile >> 2, it = tile & 3;
        f32x4 acc = (f32x4){0.f, 0.f, 0.f, 0.f};
        if (jt <= it) {
            const int jr = 16 * jt + li, ir = 16 * it + li;
#pragma unroll
            for (int ks = 0; ks < 4; ++ks) {
                const bf16x8 kf = *(const bf16x8*)(KIs + jr * 256 + (((4 * ks + fq) ^ (jr & 15)) << 4));
                const bf16x8 qf = *(const bf16x8*)(QDs + ir * 256 + (((4 * ks + fq) ^ (ir & 15)) << 4));
                acc = __builtin_amdgcn_mfma_f32_16x16x32_bf16(kf, qf, acc, 0, 0, 0);
            }
        }
        const int i = 16 * it + li, j0 = 16 * jt + 4 * fq;
        float v[4];
#pragma unroll
        for (int jj = 0; jj < 4; ++jj) v[jj] = (j0 + jj <= i) ? acc[jj] : 0.f;
        const int chunk = 2 * jt + (fq >> 1), sub = (fq & 1) * 8;
        *(uint2*)(ATg + (size_t)item * GLA_AT_BYTES + i * 128 + ((chunk ^ (i & 7)) << 4) + sub) = make_uint2(pack2(v[0], v[1]), pack2(v[2], v[3]));
    }
}

__device__ __forceinline__ void gla_seq_item(const u16* __restrict__ P, int ldp, int cv, int Sq,
                                             const unsigned char* __restrict__ QDg, const unsigned char* __restrict__ KEg, const unsigned char* __restrict__ ATg, const float* __restrict__ DECg,
                                             u16* __restrict__ Oout  , int Ttot, unsigned char* lds, int item) {
    const int slice = item & 1, dir = (item >> 1) & 1, hh = (item >> 2) & 3, b = item >> 4;
    const int nch = Sq / 64;
    const int tid = TID, lane = tid & 63, wave = tid >> 6, li = lane & 15, fq = lane >> 4;
    const size_t tok0 = (size_t)b * Sq;
    const int pitem0 = ((b * 4 + hh) * 2 + dir) * nch;
    constexpr int BUF = 16384 * 3 + 8192 + 512;
    typedef unsigned gla_u32x4 __attribute__((ext_vector_type(4)));
    gla_u32x4 rq0, rq1, rk0, rk1, rv0, rv1, ra; float rd = 0.f;
#define GLA_VROW(c_, k_) ((tok0 + (size_t)(dir ? (Sq - 1 - (64 * (c_) + ((tid + 512 * (k_)) >> 4))) : (64 * (c_) + ((tid + 512 * (k_)) >> 4)))) * ldp + cv + hh * 256 + slice * 128 + ((tid + 512 * (k_)) & 15) * 8)
#define GLA_ISSUE(c_) do { \
        const gla_u32x4* qsrc_ = (const gla_u32x4*)(QDg + (size_t)(pitem0 + (c_)) * GLA_QD_BYTES); const gla_u32x4* ksrc_ = (const gla_u32x4*)(KEg + (size_t)(pitem0 + (c_)) * GLA_QD_BYTES); \
        rq0 = qsrc_[tid]; rq1 = qsrc_[tid + 512]; rk0 = ksrc_[tid]; rk1 = ksrc_[tid + 512]; \
        ra = ((const gla_u32x4*)(ATg + (size_t)(pitem0 + (c_)) * GLA_AT_BYTES))[tid]; \
        rv0 = *(const gla_u32x4*)(P + GLA_VROW(c_, 0)); rv1 = *(const gla_u32x4*)(P + GLA_VROW(c_, 1)); \
        if (tid < 128) rd = DECg[(size_t)(pitem0 + (c_)) * 128 + tid]; } while (0)
#define GLA_COMMIT(buf_) do { \
        unsigned char* base_ = lds + (buf_) * BUF; \
        ((gla_u32x4*)base_)[tid] = rq0; ((gla_u32x4*)base_)[tid + 512] = rq1; ((gla_u32x4*)(base_ + 16384))[tid] = rk0; ((gla_u32x4*)(base_ + 16384))[tid + 512] = rk1; \
        { const int row_ = tid >> 4, ch_ = tid & 15; *(gla_u32x4*)(base_ + 32768 + row_ * 256 + ((ch_ ^ (row_ & 15)) << 4)) = rv0; } \
        { const int row_ = (tid + 512) >> 4, ch_ = tid & 15; *(gla_u32x4*)(base_ + 32768 + row_ * 256 + ((ch_ ^ (row_ & 15)) << 4)) = rv1; } \
        ((gla_u32x4*)(base_ + 49152))[tid] = ra; \
        if (tid < 128) ((float*)(base_ + 57344))[tid] = rd; } while (0)
    f32x4 st[8];
#pragma unroll
    for (int dt = 0; dt < 8; ++dt) st[dt] = (f32x4){0.f, 0.f, 0.f, 0.f};
    __syncthreads();
    GLA_ISSUE(0); GLA_COMMIT(0);
    __syncthreads();
#pragma unroll 1
    for (int c = 0; c < nch; ++c) {
        const int buf = c & 1;
        if (c + 1 < nch) GLA_ISSUE(c + 1);
        const unsigned char* QDs = lds + buf * BUF; const unsigned char* KEs = QDs + 16384; const unsigned char* Vs = QDs + 32768;
        const unsigned char* ATs = QDs + 49152; const float* DECs = (const float*)(QDs + 57344);
        bf16x8 vf[2];
#pragma unroll
        for (int jp = 0; jp < 2; ++jp) {
            const int rowA = 32 * jp + 8 * fq + (li >> 2), rowB = rowA + 4;
            const int chunk = 2 * wave + ((li & 3) >> 1), sub = ((li & 3) & 1) * 8;
            const s16x4 va = __builtin_amdgcn_ds_read_tr16_b64_v4i16((LAS s16x4*)(Vs + rowA * 256 + ((chunk ^ (rowA & 15)) << 4) + sub));
            const s16x4 vb = __builtin_amdgcn_ds_read_tr16_b64_v4i16((LAS s16x4*)(Vs + rowB * 256 + ((chunk ^ (rowB & 15)) << 4) + sub));
            vf[jp][0] = va[0]; vf[jp][1] = va[1]; vf[jp][2] = va[2]; vf[jp][3] = va[3]; vf[jp][4] = vb[0]; vf[jp][5] = vb[1]; vf[jp][6] = vb[2]; vf[jp][7] = vb[3];
        }
        bf16x8 sf[4];
#pragma unroll
        for (int dp = 0; dp < 4; ++dp)
#pragma unroll
            for (int jj = 0; jj < 4; ++jj) { sf[dp][jj] = (short)f2bf(st[2 * dp][jj]); sf[dp][4 + jj] = (short)f2bf(st[2 * dp + 1][jj]); }
        f32x4 ot[4];
#pragma unroll
        for (int it = 0; it < 4; ++it) {
            f32x4 acc = (f32x4){0.f, 0.f, 0.f, 0.f};
            const int ir = 16 * it + li;
#pragma unroll
            for (int dp = 0; dp < 4; ++dp) {
                const int c0 = 4 * dp + (fq >> 1), c1 = c0 + 2, sub = (fq & 1) * 8;
                const uint2 lo = *(const uint2*)(QDs + ir * 256 + ((c0 ^ (ir & 15)) << 4) + sub);
                const uint2 hi = *(const uint2*)(QDs + ir * 256 + ((c1 ^ (ir & 15)) << 4) + sub);
                bf16x8 qf;
                qf[0] = (short)(lo.x & 0xffff); qf[1] = (short)(lo.x >> 16); qf[2] = (short)(lo.y & 0xffff); qf[3] = (short)(lo.y >> 16);
                qf[4] = (short)(hi.x & 0xffff); qf[5] = (short)(hi.x >> 16); qf[6] = (short)(hi.y & 0xffff); qf[7] = (short)(hi.y >> 16);
                acc = __builtin_amdgcn_mfma_f32_16x16x32_bf16(sf[dp], qf, acc, 0, 0, 0);
            }
#pragma unroll
            for (int jp = 0; jp < 2; ++jp) {
                if (32 * jp <= 16 * it + 15) {
                    const bf16x8 af = *(const bf16x8*)(ATs + ir * 128 + (((4 * jp + fq) ^ (ir & 7)) << 4));
                    acc = __builtin_amdgcn_mfma_f32_16x16x32_bf16(vf[jp], af, acc, 0, 0, 0);
                }
            }
            ot[it] = acc;
        }
#pragma unroll
        for (int dt = 0; dt < 8; ++dt) {
            const f32x4 dec = *(const f32x4*)(DECs + 16 * dt + 4 * fq);
            f32x4 acc = st[dt] * dec;
#pragma unroll
            for (int jp = 0; jp < 2; ++jp) {
                const int rowA = 32 * jp + 8 * fq + (li >> 2), rowB = rowA + 4;
                const int chunk = 2 * dt + ((li & 3) >> 1), sub = ((li & 3) & 1) * 8;
                const s16x4 ka = __builtin_amdgcn_ds_read_tr16_b64_v4i16((LAS s16x4*)(KEs + rowA * 256 + ((chunk ^ (rowA & 15)) << 4) + sub));
                const s16x4 kb = __builtin_amdgcn_ds_read_tr16_b64_v4i16((LAS s16x4*)(KEs + rowB * 256 + ((chunk ^ (rowB & 15)) << 4) + sub));
                bf16x8 kf;
                kf[0] = ka[0]; kf[1] = ka[1]; kf[2] = ka[2]; kf[3] = ka[3]; kf[4] = kb[0]; kf[5] = kb[1]; kf[6] = kb[2]; kf[7] = kb[3];
                acc = __builtin_amdgcn_mfma_f32_16x16x32_bf16(kf, vf[jp], acc, 0, 0, 0);
            }
            st[dt] = acc;
        }
#pragma unroll
        for (int it = 0; it < 4; ++it) {
            const int i = 16 * it + li;
            const int s = dir ? (Sq - 1 - (64 * c + i)) : (64 * c + i);
            *(uint2*)(Oout + ((size_t)dir * Ttot + tok0 + s) * 1024 + hh * 256 + slice * 128 + 16 * wave + 4 * fq) =
                make_uint2(pack2(ot[it][0], ot[it][1]), pack2(ot[it][2], ot[it][3]));
        }
        if (c + 1 < nch) GLA_COMMIT(buf ^ 1);
        __syncthreads();
    }
}
__device__ __forceinline__ void phase_rope_prep(const Args& a, unsigned char* lds) {
    u16* P = (u16*)(a.ws + WS_P);
    const float2* cs = (const float2*)(a.ws + WS_CS);
    const int gt = blockIdx.x * NTHREADS + threadIdx.x, NT = gridDim.x * NTHREADS;
    for (int i = gt; i < T * 2 * 8 * 64; i += NT) {
        const int f = i & 63, hh = (i >> 6) & 7, which = (i >> 9) & 1, t = i >> 10;
        const float2 c = cs[t * 64 + f];
        u16* p = P + (size_t)t * NP + (which ? C_DK : C_DQ) + hh * 128 + f;
        const float t1 = bf2f(p[0]), t2 = bf2f(p[64]);
        p[0] = f2bf(t1 * c.x - t2 * c.y);
        p[64] = f2bf(t1 * c.y + t2 * c.x);
    }
    for (int item = blockIdx.x; item < GLA_NPREP; item += gridDim.x)
        gla_prep_item(P, NP, C_GQ, C_GK, (const float*)(a.ws + WS_GZ), a.wgf, a.bgf, a.wgb, a.bgb, S,
                      a.ws + WS_QD, a.ws + WS_KE, a.ws + WS_AT, (float*)(a.ws + WS_DEC), lds, item);
}

__device__ __forceinline__ void attn_item(const u16* __restrict__ P, int ldp, int cq, int ck, int cv, int Sq,
                                          u16* __restrict__ part_o, float* __restrict__ part_lse, int Ttot,
                                          unsigned char* lds, int item) {
    const int tid = TID, lane = tid & 63, wave = tid >> 6, li = lane & 15, fq = lane >> 4;
    const int nb_per = Sq / 128;
    const int within = item % nb_per, hh = (item / nb_per) & 7, b = (item / (nb_per * 8)) & 3, pat = item / (nb_per * 32);
    const int dil = pat == 0 ? 1 : (pat == 1 ? 4 : 16);
    const int M = Sq / dil;
    const int r = within % dil, blk = within / dil;
    const int p0 = blk * 128, kbase = p0 - 64;
    unsigned char* Ks = lds;
    unsigned char* Vs = lds + 65536;
    const size_t tok0 = (size_t)b * Sq;
    __syncthreads();
#pragma unroll
    for (int i = 0; i < 8; ++i) {
        const int id = tid + 512 * i, row = id >> 4, c = id & 15;
        int kp = kbase + row; kp = kp < 0 ? 0 : (kp > M - 1 ? M - 1 : kp);
        const size_t t = tok0 + r + (size_t)dil * kp;
        const uint4 kv = *(const uint4*)(P + t * ldp + ck + hh * 128 + c * 8);
        const uint4 vv = *(const uint4*)(P + t * ldp + cv + hh * 128 + c * 8);
        const int off = row * 256 + ((c ^ (row & 15)) << 4);
        *(uint4*)(Ks + off) = kv;
        *(uint4*)(Vs + off) = vv;
    }
    const int qp = p0 + 16 * wave + li;
    const size_t tq = tok0 + r + (size_t)dil * qp;
    bf16x8 qf[4];
#pragma unroll
    for (int ks = 0; ks < 4; ++ks) qf[ks] = *(const bf16x8*)(P + tq * ldp + cq + hh * 128 + 32 * ks + 8 * fq);
    __syncthreads();
    const float scale = 0.08838834764831845f;
    float m = -1e30f, l = 0.f;
    f32x4 o[8];
#pragma unroll
    for (int dt = 0; dt < 8; ++dt) o[dt] = (f32x4){0.f, 0.f, 0.f, 0.f};
#pragma unroll 1
    for (int tp = 0; tp < 5; ++tp) {
        float s[8]; bool ok[8];
#pragma unroll
        for (int h2 = 0; h2 < 2; ++h2) {
            const int kk0 = 16 * wave + 16 * (2 * tp + h2);
            int krow = kk0 + li; krow = krow > 255 ? 255 : krow;
            f32x4 acc = (f32x4){0.f, 0.f, 0.f, 0.f};
#pragma unroll
            for (int ks = 0; ks < 4; ++ks) {
                const bf16x8 kf = *(const bf16x8*)(Ks + krow * 256 + (((4 * ks + fq) ^ (krow & 15)) << 4));
                acc = __builtin_amdgcn_mfma_f32_16x16x32_bf16(kf, qf[ks], acc, 0, 0, 0);
            }
#pragma unroll
            for (int j = 0; j < 4; ++j) {
                const int kp = kbase + kk0 + 4 * fq + j;
                const int rel = kp - qp;
                ok[4 * h2 + j] = (kp >= 0) && (kp < M) && (rel <= 64) && (rel >= -64);
                s[4 * h2 + j] = acc[j] * scale;
            }
        }
        float mx = -1e30f;
#pragma unroll
        for (int j = 0; j < 8; ++j) mx = ok[j] ? fmaxf(mx, s[j]) : mx;
        mx = fmaxf(mx, __shfl_xor(mx, 16));
        mx = fmaxf(mx, __shfl_xor(mx, 32));
        const float mn = fmaxf(m, mx);
        const float al = __expf(m - mn);
        float ps = 0.f; float p[8];
#pragma unroll
        for (int j = 0; j < 8; ++j) { p[j] = ok[j] ? __expf(s[j] - mn) : 0.f; ps += p[j]; }
        l = l * al + ps; m = mn;
        bf16x8 pf;
#pragma unroll
        for (int j = 0; j < 8; ++j) pf[j] = (short)f2bf(p[j]);
#pragma unroll
        for (int dt = 0; dt < 8; ++dt) o[dt] *= al;
        int rowA = 16 * wave + 32 * tp + 4 * fq + (li >> 2); rowA = rowA > 255 ? 255 : rowA;
        int rowB = 16 * wave + 32 * tp + 16 + 4 * fq + (li >> 2); rowB = rowB > 255 ? 255 : rowB;
#pragma unroll
        for (int dt = 0; dt < 8; ++dt) {
            const int chunk = 2 * dt + ((li & 3) >> 1), sub = ((li & 3) & 1) * 8;
            const s16x4 va = __builtin_amdgcn_ds_read_tr16_b64_v4i16((LAS s16x4*)(Vs + rowA * 256 + ((chunk ^ (rowA & 15)) << 4) + sub));
            const s16x4 vb = __builtin_amdgcn_ds_read_tr16_b64_v4i16((LAS s16x4*)(Vs + rowB * 256 + ((chunk ^ (rowB & 15)) << 4) + sub));
            bf16x8 vf;
            vf[0] = va[0]; vf[1] = va[1]; vf[2] = va[2]; vf[3] = va[3]; vf[4] = vb[0]; vf[5] = vb[1]; vf[6] = vb[2]; vf[7] = vb[3];
            o[dt] = __builtin_amdgcn_mfma_f32_16x16x32_bf16(vf, pf, o[dt], 0, 0, 0);
        }
    }
    l += __shfl_xor(l, 16);
    l += __shfl_xor(l, 32);
    const float inv = 1.f / l;
    u16* orow = part_o + ((size_t)pat * Ttot + tq) * 1024 + hh * 128 + 4 * fq;
#pragma unroll
    for (int dt = 0; dt < 8; ++dt)
        *(uint2*)(orow + 16 * dt) = make_uint2(pack2(o[dt][0] * inv, o[dt][1] * inv), pack2(o[dt][2] * inv, o[dt][3] * inv));
    if (fq == 0) part_lse[((size_t)pat * Ttot + tq) * 8 + hh] = m + logf(l);
}

__device__ __forceinline__ void attn_merge_token(const u16* __restrict__ part_o, const float* __restrict__ part_lse, int Ttot, size_t t,
                                                 u16* __restrict__ dst  , int lane) {
    const int hh = lane >> 3;
    const float l0 = part_lse[((size_t)0 * Ttot + t) * 8 + hh], l1 = part_lse[((size_t)1 * Ttot + t) * 8 + hh], l2 = part_lse[((size_t)2 * Ttot + t) * 8 + hh];
    const float mx = fmaxf(l0, fmaxf(l1, l2));
    const float e0 = __expf(l0 - mx), e1 = __expf(l1 - mx), e2 = __expf(l2 - mx);
    const float inv = 1.f / (e0 + e1 + e2);
    const float w[3] = {e0 * inv, e1 * inv, e2 * inv};
    float acc[16];
#pragma unroll
    for (int i = 0; i < 16; ++i) acc[i] = 0.f;
#pragma unroll
    for (int p = 0; p < 3; ++p) {
        const uint4* src = (const uint4*)(part_o + ((size_t)p * Ttot + t) * 1024 + lane * 16);
        const uint4 a = src[0], bb = src[1];
        acc[0] += w[p] * lo2f(a.x); acc[1] += w[p] * hi2f(a.x); acc[2] += w[p] * lo2f(a.y); acc[3] += w[p] * hi2f(a.y);
        acc[4] += w[p] * lo2f(a.z); acc[5] += w[p] * hi2f(a.z); acc[6] += w[p] * lo2f(a.w); acc[7] += w[p] * hi2f(a.w);
        acc[8] += w[p] * lo2f(bb.x); acc[9] += w[p] * hi2f(bb.x); acc[10] += w[p] * lo2f(bb.y); acc[11] += w[p] * hi2f(bb.y);
        acc[12] += w[p] * lo2f(bb.z); acc[13] += w[p] * hi2f(bb.z); acc[14] += w[p] * lo2f(bb.w); acc[15] += w[p] * hi2f(bb.w);
    }
    uint4* d = (uint4*)(dst + lane * 16);
    d[0] = make_uint4(pack2(acc[0], acc[1]), pack2(acc[2], acc[3]), pack2(acc[4], acc[5]), pack2(acc[6], acc[7]));
    d[1] = make_uint4(pack2(acc[8], acc[9]), pack2(acc[10], acc[11]), pack2(acc[12], acc[13]), pack2(acc[14], acc[15]));
}

__device__ __forceinline__ void phase_mixers(const Args& a, unsigned char* lds) {
    const int bi = blockIdx.x, G = gridDim.x;
    if (bi < 64) {
        gla_seq_item((const u16*)(a.ws + WS_P), NP, C_GV, S, a.ws + WS_QD, a.ws + WS_KE, a.ws + WS_AT, (const float*)(a.ws + WS_DEC),
                     (u16*)(a.ws + WS_OFB), T, lds, bi);
    } else {
        u16* part_o = (u16*)a.out; float* part_lse = (float*)((unsigned char*)a.out + (size_t)3 * T * 1024 * 2);
        for (int item = bi - 64; item < 3 * 4 * 8 * (S / 128); item += G - 64)
            attn_item((const u16*)(a.ws + WS_P), NP, C_DQ, C_DK, C_DV, S, part_o, part_lse, T, lds, item);
    }
}

__device__ __forceinline__ void phase_gla_fin(const Args& a) {
    const u16* Of = (const u16*)(a.ws + WS_OFB);
    const u16* Ob = Of + (size_t)T * 1024;
    const u16* P = (const u16*)(a.ws + WS_P);
    u16* A2 = (u16*)(a.ws + WS_ACT);
    const int lane = threadIdx.x & 63, wave = threadIdx.x >> 6;
    const int gw = blockIdx.x * NWAVES + wave, NGW = gridDim.x * NWAVES;
    for (int item = gw; item < T * 4; item += NGW) {
        const int hh = item & 3, t = item >> 2;
        const size_t base = (size_t)t * 1024 + hh * 256 + lane * 4;
        const uint2 f = *(const uint2*)(Of + base), bb = *(const uint2*)(Ob + base);
        const float o0 = lo2f(f.x) + lo2f(bb.x), o1 = hi2f(f.x) + hi2f(bb.x), o2 = lo2f(f.y) + lo2f(bb.y), o3 = hi2f(f.y) + hi2f(bb.y);
        const float ss = wave_sum(o0 * o0 + o1 * o1 + o2 * o2 + o3 * o3);
        const float rstd = rsqrtf(ss * (1.f / 256.f) + NORM_EPS);
        const float4 gg = *(const float4*)(a.g_gla + hh * 256 + lane * 4);
        const uint2 rp = *(const uint2*)(P + (size_t)t * NP + C_GR + hh * 256 + lane * 4);
        const float r0 = lo2f(rp.x), r1 = hi2f(rp.x), r2 = lo2f(rp.y), r3 = hi2f(rp.y);
        const float y0 = o0 * rstd * gg.x * silu_f(r0), y1 = o1 * rstd * gg.y * silu_f(r1);
        const float y2 = o2 * rstd * gg.z * silu_f(r2), y3 = o3 * rstd * gg.w * silu_f(r3);
        *(uint2*)(A2 + (size_t)t * D + hh * 256 + lane * 4) = make_uint2(pack2(y0, y1), pack2(y2, y3));
    }
    const u16* part_o = (const u16*)a.out; const float* part_lse = (const float*)((const unsigned char*)a.out + (size_t)3 * T * 1024 * 2);
    for (int t = gw; t < T; t += NGW) attn_merge_token(part_o, part_lse, T, (size_t)t, A2 + (size_t)t * D + 1024, lane);
}

typedef float f32x16 __attribute__((ext_vector_type(16)));
#define RT_CE(a_, b_) do { const float hi_ = fmaxf(a_, b_), lo_ = fminf(a_, b_); a_ = hi_; b_ = lo_; } while (0)
template <int N> __device__ __forceinline__ void rt_sort_desc(float (&v)[N], int base) {
#pragma unroll
    for (int k = 2; k <= 16; k <<= 1)
#pragma unroll
        for (int j = k >> 1; j > 0; j >>= 1)
#pragma unroll
            for (int i = 0; i < 16; ++i) {
                const int l = i ^ j;
                if (l > i) { if ((i & k) == 0) RT_CE(v[base + i], v[base + l]); else RT_CE(v[base + l], v[base + i]); }
            }
}
template <int N> __device__ __forceinline__ void rt_merge_desc(float (&v)[N], int a, int b) {
#pragma unroll
    for (int i = 0; i < 16; ++i) v[a + i] = fmaxf(v[a + i], v[b + 15 - i]);
#pragma unroll
    for (int j = 8; j > 0; j >>= 1)
#pragma unroll
        for (int i = 0; i < 16; ++i) { const int l = i ^ j; if (l > i) RT_CE(v[a + i], v[a + l]); }
}

__device__ __forceinline__ void route_stage_keys(const float* __restrict__ subk, int hh, unsigned char* lds) {
    const int tid = TID;
    __syncthreads();
    for (int e = tid; e < 2 * 128 * 16; e += 512) {
        const int c = e & 15, row = e >> 4;
        const float* src = subk + ((size_t)(hh * 2) * 128 + row) * 128 + c * 8;
        const float4 v0 = *(const float4*)src, v1 = *(const float4*)(src + 4);
        *(uint4*)(lds + row * 256 + ((c ^ (row & 15)) << 4)) = make_uint4(pack2(v0.x, v0.y), pack2(v0.z, v0.w), pack2(v1.x, v1.y), pack2(v1.z, v1.w));
    }
    __syncthreads();
}

__device__ __forceinline__ void route_tile(const u16* __restrict__ Q, int ldq, int hh, int tok_base, const unsigned char* lds,
                                           int* __restrict__ IDX, float* __restrict__ GATE) {
    const int lane = TID & 63, r = lane & 31, h = lane >> 5;
    float sc[128];
    {
        f32x16 X[4], Y[4];
#pragma unroll
        for (int kt = 0; kt < 4; ++kt) {
#pragma unroll
            for (int i = 0; i < 16; ++i) { X[kt][i] = 0.f; Y[kt][i] = 0.f; }
        }
        const u16* qrow = Q + (size_t)(tok_base + r) * ldq + hh * 256;
#pragma unroll
        for (int half = 0; half < 2; ++half) {
            bf16x8 qf[8];
#pragma unroll
            for (int ks = 0; ks < 8; ++ks) qf[ks] = *(const bf16x8*)(qrow + half * 128 + 16 * ks + 8 * h);
#pragma unroll
            for (int kt = 0; kt < 4; ++kt) {
                const int krow = half * 128 + 32 * kt + r;
#pragma unroll
                for (int ks = 0; ks < 8; ++ks) {
                    const bf16x8 kf = *(const bf16x8*)(lds + krow * 256 + (((2 * ks + h) ^ (krow & 15)) << 4));
                    if (half == 0) X[kt] = __builtin_amdgcn_mfma_f32_32x32x16_bf16(kf, qf[ks], X[kt], 0, 0, 0);
                    else Y[kt] = __builtin_amdgcn_mfma_f32_32x32x16_bf16(kf, qf[ks], Y[kt], 0, 0, 0);
                }
            }
        }
#pragma unroll
        for (int kt = 0; kt < 4; ++kt)
#pragma unroll
            for (int i = 0; i < 16; ++i) {
                const auto sw = __builtin_amdgcn_permlane32_swap(__float_as_uint(X[kt][i]), __float_as_uint(Y[kt][i]), false, false);
                const int key0 = 32 * kt + (i & 3) + 8 * (i >> 2);
                sc[kt * 32 + i] = __uint_as_float((sw[0] & 0xffffff80u) | (unsigned)key0);
                sc[kt * 32 + 16 + i] = __uint_as_float((sw[1] & 0xffffff80u) | (unsigned)(key0 + 4));
            }
    }
#pragma unroll
    for (int g = 0; g < 8; ++g) rt_sort_desc(sc, 16 * g);
    rt_merge_desc(sc, 0, 16); rt_merge_desc(sc, 32, 48); rt_merge_desc(sc, 64, 80); rt_merge_desc(sc, 96, 112);
    rt_merge_desc(sc, 0, 32); rt_merge_desc(sc, 64, 96);
    rt_merge_desc(sc, 0, 64);
    float l0[16], l1[16];
#pragma unroll
    for (int i = 0; i < 16; ++i) {
        const auto sw = __builtin_amdgcn_permlane32_swap(__float_as_uint(sc[i]), __float_as_uint(sc[i]), false, false);
        l0[i] = __uint_as_float(sw[0]); l1[i] = __uint_as_float(sw[1]);
    }
    float s0[16], s1[16]; int k0[16], k1[16];
#pragma unroll
    for (int i = 0; i < 16; ++i) {
        const unsigned a = __float_as_uint(l0[i]), b = __float_as_uint(l1[i]);
        s0[i] = __uint_as_float(a & 0xffffff80u); k0[i] = (int)(a & 0x7fu);
        s1[i] = __uint_as_float(b & 0xffffff80u); k1[i] = (int)(b & 0x7fu);
    }
    float cs[64];
    {
        int n = 0;
#pragma unroll
        for (int i = 0; i < 16; ++i)
#pragma unroll
            for (int j = 0; j < 16; ++j)
                if ((i + 1) * (j + 1) <= 16) { cs[n] = s0[i] + s1[j]; ++n; }
#pragma unroll
        for (int q = 50; q < 64; ++q) cs[q] = -3.0e38f;
    }
    float ct[64];
#pragma unroll
    for (int q = 0; q < 64; ++q) ct[q] = cs[q];
#pragma unroll
    for (int g = 0; g < 4; ++g) rt_sort_desc(ct, 16 * g);
    rt_merge_desc(ct, 0, 16); rt_merge_desc(ct, 32, 48); rt_merge_desc(ct, 0, 32);
    const float theta = ct[15], smax = ct[0];
    float den = 0.f;
    {
        int cnt = 0;
#pragma unroll
        for (int q = 0; q < 50; ++q) { const bool sel = (cs[q] >= theta) && (cnt < 16); den += sel ? __expf(cs[q] - smax) : 0.f; cnt += sel ? 1 : 0; }
    }
    const float inv = 1.f / den;
    const size_t obase = (size_t)(tok_base + r) * 128 + hh * 16;
    int pos = 0;
    {
        int n = 0;
#pragma unroll
        for (int i = 0; i < 16; ++i)
#pragma unroll
            for (int j = 0; j < 16; ++j)
                if ((i + 1) * (j + 1) <= 16) {
                    const bool sel = (cs[n] >= theta) && (pos < 16);
                    if (sel) {
                        if (h == 0) IDX[obase + pos] = k0[i] * 128 + k1[j];
                        else GATE[obase + pos] = __expf(cs[n] - smax) * inv;
                        ++pos;
                    }
                    ++n;
                }
    }
}
__device__ __forceinline__ void phase_route(const Args& a, unsigned char* lds) {
    const int hh = BID & 7, grp = BID >> 3, ngrp = GDIM >> 3, wave = TID >> 6;
    route_stage_keys(a.subk, hh, lds);
    int j = 0;
    for (int tile = grp; tile < T / 32; tile += ngrp, ++j)
        if ((j & 7) == wave) route_tile((const u16*)(a.ws + WS_Q), D, hh, tile * 32, lds, (int*)(a.ws + WS_IDX), (float*)(a.ws + WS_GATE));
    __syncthreads();
}

typedef __bf16 bf16x2_t __attribute__((ext_vector_type(2)));
__device__ __forceinline__ float dot2bf(unsigned w, unsigned x, float acc) {
    return __builtin_amdgcn_fdot2_f32_bf16(__builtin_bit_cast(bf16x2_t, w), __builtin_bit_cast(bf16x2_t, x), acc, false);
}
constexpr int TROW = 1152;
typedef float f32x2_t __attribute__((ext_vector_type(2)));
__device__ __forceinline__ void convert_tables(const Args& a) {
    const int lane = threadIdx.x & 63, wave = threadIdx.x >> 6;
    const int gw = blockIdx.x * NWAVES + wave, NGW = gridDim.x * NWAVES;
    for (int row = gw; row < 2 * 16384; row += NGW) {
        const bool isv = row >= 16384; const int e = isv ? row - 16384 : row;
        const f32x4* sp = (const f32x4*)((isv ? a.pv : a.pu) + (size_t)e * D + lane * 32);
        f32x4 v[8]; float mx = 0.f;
#pragma unroll
        for (int k = 0; k < 8; ++k) { v[k] = __builtin_nontemporal_load(sp + k);
            mx = fmaxf(mx, fmaxf(fmaxf(fabsf(v[k][0]), fabsf(v[k][1])), fmaxf(fabsf(v[k][2]), fabsf(v[k][3])))); }
        float s = mx * (1.f / 6.f); s = (s > 0.f) ? s : 1.f;
        const u16 sb = f2bf(s); const float sr = bf2f(sb); const float inv = 1.f / sr;
        unsigned w[4];
#pragma unroll
        for (int k = 0; k < 4; ++k) {
            unsigned p = 0u;
            p = __builtin_amdgcn_cvt_scalef32_pk_fp4_f32(p, v[2 * k][0] * inv, v[2 * k][1] * inv, 1.0f, 0);
            p = __builtin_amdgcn_cvt_scalef32_pk_fp4_f32(p, v[2 * k][2] * inv, v[2 * k][3] * inv, 1.0f, 1);
            p = __builtin_amdgcn_cvt_scalef32_pk_fp4_f32(p, v[2 * k + 1][0] * inv, v[2 * k + 1][1] * inv, 1.0f, 2);
            p = __builtin_amdgcn_cvt_scalef32_pk_fp4_f32(p, v[2 * k + 1][2] * inv, v[2 * k + 1][3] * inv, 1.0f, 3);
            w[k] = p;
        }
        unsigned char* dst = a.ws + (isv ? WS_TV : WS_TU) + (size_t)e * TROW;
        *(uint4*)(dst + lane * 16) = make_uint4(w[0], w[1], w[2], w[3]);
        *(u16*)(dst + 1024 + lane * 2) = sb;
    }
}

__device__ __forceinline__ float dot32_fp4(const uint4 w, const float (&h)[32], float acc) {
    const unsigned ww[4] = {w.x, w.y, w.z, w.w};
#pragma unroll
    for (int k = 0; k < 4; ++k) {
        const f32x2_t a0 = __builtin_amdgcn_cvt_scalef32_pk_f32_fp4(ww[k], 1.0f, 0), a1 = __builtin_amdgcn_cvt_scalef32_pk_f32_fp4(ww[k], 1.0f, 1);
        const f32x2_t a2 = __builtin_amdgcn_cvt_scalef32_pk_f32_fp4(ww[k], 1.0f, 2), a3 = __builtin_amdgcn_cvt_scalef32_pk_f32_fp4(ww[k], 1.0f, 3);
        acc += a0.x * h[8 * k + 0] + a0.y * h[8 * k + 1] + a1.x * h[8 * k + 2] + a1.y * h[8 * k + 3] + a2.x * h[8 * k + 4] + a2.y * h[8 * k + 5] + a3.x * h[8 * k + 6] + a3.y * h[8 * k + 7];
    }
    return acc;
}
__device__ __forceinline__ void axpy32_fp4(const uint4 w, const float s, float (&acc)[32]) {
    const unsigned ww[4] = {w.x, w.y, w.z, w.w};
#pragma unroll
    for (int k = 0; k < 4; ++k) {
        const f32x2_t a0 = __builtin_amdgcn_cvt_scalef32_pk_f32_fp4(ww[k], 1.0f, 0), a1 = __builtin_amdgcn_cvt_scalef32_pk_f32_fp4(ww[k], 1.0f, 1);
        const f32x2_t a2 = __builtin_amdgcn_cvt_scalef32_pk_f32_fp4(ww[k], 1.0f, 2), a3 = __builtin_amdgcn_cvt_scalef32_pk_f32_fp4(ww[k], 1.0f, 3);
        acc[8 * k + 0] += s * a0.x; acc[8 * k + 1] += s * a0.y; acc[8 * k + 2] += s * a1.x; acc[8 * k + 3] += s * a1.y;
        acc[8 * k + 4] += s * a2.x; acc[8 * k + 5] += s * a2.y; acc[8 * k + 6] += s * a3.x; acc[8 * k + 7] += s * a3.y;
    }
}
__device__ __forceinline__ void phase_experts(const Args& a) {
    const u16* H2 = (const u16*)(a.ws + WS_ACT);
    const float* X1 = (const float*)(a.ws + WS_X1);
    const int* IDX = (const int*)(a.ws + WS_IDX);
    const float* GATE = (const float*)(a.ws + WS_GATE);
    const float* mod = (const float*)(a.ws + WS_MOD);
    const unsigned char* U = a.ws + WS_TU; const unsigned char* V = a.ws + WS_TV;
    const int lane = threadIdx.x & 63, wave = threadIdx.x >> 6;
    const int gw = blockIdx.x * NWAVES + wave, NGW = gridDim.x * NWAVES;
    for (int t = gw; t < T; t += NGW) {
        const int b = t / S;
        float h[32], acc[32];
        {
            const uint4* hp = (const uint4*)(H2 + (size_t)t * D + lane * 32);
#pragma unroll
            for (int k = 0; k < 4; ++k) { const uint4 p = hp[k];
                h[8 * k + 0] = lo2f(p.x); h[8 * k + 1] = hi2f(p.x); h[8 * k + 2] = lo2f(p.y); h[8 * k + 3] = hi2f(p.y);
                h[8 * k + 4] = lo2f(p.z); h[8 * k + 5] = hi2f(p.z); h[8 * k + 6] = lo2f(p.w); h[8 * k + 7] = hi2f(p.w); }
#pragma unroll
            for (int i = 0; i < 32; ++i) acc[i] = 0.f;
        }
#pragma unroll 1
        for (int r0 = 0; r0 < 128; r0 += 4) {
            const int4 e4 = *(const int4*)(IDX + (size_t)t * 128 + r0);
            const float4 g4 = *(const float4*)(GATE + (size_t)t * 128 + r0);
            const int e[4] = {__builtin_amdgcn_readfirstlane(e4.x), __builtin_amdgcn_readfirstlane(e4.y), __builtin_amdgcn_readfirstlane(e4.z), __builtin_amdgcn_readfirstlane(e4.w)};
            const float g[4] = {g4.x, g4.y, g4.z, g4.w};
            uint4 u[4], v[4]; u16 su[4], sv[4];
#pragma unroll
            for (int q = 0; q < 4; ++q) { const unsigned char* rp = U + (size_t)e[q] * TROW; u[q] = *(const uint4*)(rp + lane * 16); su[q] = *(const u16*)(rp + 1024 + lane * 2); }
#pragma unroll
            for (int q = 0; q < 4; ++q) { const unsigned char* rp = V + (size_t)e[q] * TROW; v[q] = *(const uint4*)(rp + lane * 16); sv[q] = *(const u16*)(rp + 1024 + lane * 2); }
            float d[4];
#pragma unroll
            for (int q = 0; q < 4; ++q) d[q] = dot32_fp4(u[q], h, 0.f) * bf2f(su[q]);
#pragma unroll
            for (int o = 32; o > 0; o >>= 1) {
#pragma unroll
                for (int q = 0; q < 4; ++q) d[q] += __shfl_xor(d[q], o);
            }
#pragma unroll
            for (int q = 0; q < 4; ++q) { const float w = g[q] * gelu_f(d[q]) * bf2f(sv[q]); axpy32_fp4(v[q], w, acc); }
        }
        float ss = 0.f;
#pragma unroll
        for (int k = 0; k < 8; ++k) {
            const int c0 = lane * 32 + 4 * k;
            const float4 xa = *(const float4*)(X1 + (size_t)t * D + c0);
            const float4 ga = *(const float4*)(mod + b * 12288 + 5 * 2048 + c0);
            acc[4 * k + 0] = xa.x + ga.x * acc[4 * k + 0]; acc[4 * k + 1] = xa.y + ga.y * acc[4 * k + 1];
            acc[4 * k + 2] = xa.z + ga.z * acc[4 * k + 2]; acc[4 * k + 3] = xa.w + ga.w * acc[4 * k + 3];
#pragma unroll
            for (int i = 0; i < 4; ++i) ss += acc[4 * k + i] * acc[4 * k + i];
        }
        ss = wave_sum(ss);
        const float rstd = rsqrtf(ss * (1.f / D) + NORM_EPS);
#pragma unroll
        for (int k = 0; k < 8; ++k) {
            const int c0 = lane * 32 + 4 * k;
            const float4 gf = *(const float4*)(a.g_fin + c0);
            *(float4*)(a.out + (size_t)t * D + c0) = make_float4(acc[4 * k + 0] * rstd * gf.x, acc[4 * k + 1] * rstd * gf.y, acc[4 * k + 2] * rstd * gf.z, acc[4 * k + 3] * rstd * gf.w);
        }
    }
}

#define XB_TMO      128
#define XB_XCNT(j)  (256  + 64 * (j))
#define XB_XSUB(j)  (1280 + 64 * (j))
#define XB_XGEN(j)  (2304 + 64 * (j))
#define XB_TOP      3328
#define XB_TOPGEN   3392
#define XCD_BAR_WORDS 3456
#define XB_SPIN_CAP (1u << 18)

__device__ __forceinline__ unsigned xb_ld(unsigned* p)              { return __hip_atomic_load(p, __ATOMIC_RELAXED, __HIP_MEMORY_SCOPE_AGENT); }
__device__ __forceinline__ unsigned xb_add(unsigned* p, unsigned v) { return __hip_atomic_fetch_add(p, v, __ATOMIC_RELAXED, __HIP_MEMORY_SCOPE_AGENT); }
__device__ __forceinline__ unsigned xb_xcc_id() { return (unsigned)__builtin_amdgcn_s_getreg((3 << 11) | 20) & 0xFu; }
#define XB_SPIN(cond, bar) do { unsigned _sp = 0; while (cond) { __builtin_amdgcn_s_sleep(1); \
    if ((++_sp & 255u) == 0u) { if (xb_ld(&(bar)[XB_TMO])) break; if (_sp > XB_SPIN_CAP) { atomicAdd(&(bar)[XB_TMO], 1u); break; } } } } while (0)

struct XcdBarrier {
    unsigned* bar; unsigned x;
    volatile LAS unsigned* st;
};

__device__ __forceinline__ XcdBarrier xcd_barrier_post(unsigned* bar, volatile LAS unsigned* st) {
    XcdBarrier b; b.bar = bar; b.x = xb_xcc_id(); b.st = st;
    if (threadIdx.x == 0) (void)xb_add(&bar[XB_XCNT(b.x)], 1u);
    return b;
}
__device__ __forceinline__ void xcd_barrier_complete(unsigned* bar, unsigned x, unsigned& nloc, unsigned& nx) {
    const unsigned G = gridDim.x * gridDim.y * gridDim.z;
    unsigned sum, cnt, mine, sp = 0u;
    for (;;) {
        sum = 0u; cnt = 0u; mine = 0u;
#pragma unroll
        for (unsigned j = 0; j < 16; ++j) { const unsigned c = xb_ld(&bar[XB_XCNT(j)]); sum += c; cnt += (c > 0u) ? 1u : 0u; mine = (j == x) ? c : mine; }
        if (sum == G) break;
        __builtin_amdgcn_s_sleep(1);
        if ((++sp & 255u) == 0u) { if (xb_ld(&bar[XB_TMO])) break; if (sp > XB_SPIN_CAP) { atomicAdd(&bar[XB_TMO], 1u); break; } }
    }
    nloc = mine > 0u ? mine : 1u; nx = cnt > 0u ? cnt : 1u;
}

__device__ __forceinline__ void xcd_barrier(const XcdBarrier& b) {
    asm volatile("s_waitcnt vmcnt(0)" ::: "memory");
    __syncthreads();
    if (threadIdx.x == 0) {
        unsigned* bar = b.bar;
        __builtin_amdgcn_s_waitcnt(0);
        unsigned nloc = b.st[0], nx = b.st[1];
        if (nloc == 0u) { xcd_barrier_complete(bar, b.x, nloc, nx); b.st[0] = nloc; b.st[1] = nx; }
        const unsigned old = xb_add(&bar[XB_XSUB(b.x)], 1u);
        const unsigned gen = old / nloc;
        if (old + 1u == (gen + 1u) * nloc) {
            __builtin_amdgcn_fence(__ATOMIC_RELEASE, "agent");
            asm volatile("s_waitcnt vmcnt(0)" ::: "memory");
            const unsigned og = xb_add(&bar[XB_TOP], 1u);
            const unsigned tg = og / nx;
            if (og + 1u == (tg + 1u) * nx) xb_add(&bar[XB_TOPGEN], 1u);
            else XB_SPIN(xb_ld(&bar[XB_TOPGEN]) == tg, bar);
            __builtin_amdgcn_fence(__ATOMIC_ACQUIRE, "agent");
            xb_add(&bar[XB_XGEN(b.x)], 1u);
            asm volatile("s_waitcnt vmcnt(0)" ::: "memory");
        } else {
            XB_SPIN(xb_ld(&bar[XB_XGEN(b.x)]) == gen, bar);
            __builtin_amdgcn_fence(__ATOMIC_ACQUIRE, "agent");
            asm volatile("s_waitcnt vmcnt(0)" ::: "memory");
        }
    }
    __syncthreads();
}

constexpr int NPHASES = 11;
__global__ void __launch_bounds__(NTHREADS, 2) mk_fwd(Args a) {
    extern __shared__ __attribute__((aligned(16))) unsigned char lds[];
    cg::grid_group grid = cg::this_grid();
    const int lo = a.ph_lo, hi = a.ph_hi;
    volatile LAS unsigned* xbw = (volatile LAS unsigned*)(lds + LDS_MAIN);
    if (threadIdx.x < 4) xbw[threadIdx.x] = 0u;
    __syncthreads();
    XcdBarrier xbar = xcd_barrier_post((unsigned*)(a.ws + WS_CTL), xbw);
#define IN(k) (lo <= (k) && (k) < hi)
#define SEAM(k) do { if (IN(k) && IN((k) + 1)) { if ((k) == 0) grid.sync(); else xcd_barrier(xbar); } } while (0)
    const float* mod = (const float*)(a.ws + WS_MOD);
    if (IN(0)) phase0(a, lds);
    SEAM(0);
    if (IN(1)) norm_mod_phase(a.x, a.g_mix, mod, 0, 1, (u16*)(a.ws + WS_ACT));
    SEAM(1);
    if (IN(2)) gemm8(lds, (const u16*)(a.ws + WS_ACT), (const u16*)(a.ws + WS_WIN), T, NPAD, D, EpiProj{(u16*)(a.ws + WS_P), (float*)(a.ws + WS_GZ)});
    SEAM(2);
    if (IN(3)) phase_rope_prep(a, lds);
    SEAM(3);
    if (IN(4)) phase_mixers(a, lds);
    SEAM(4);
    if (IN(5)) phase_gla_fin(a);
    SEAM(5);
    if (IN(6)) gemm8(lds, (const u16*)(a.ws + WS_ACT), (const u16*)(a.ws + WS_WOUT), T, D, D, EpiResid{a.x, mod, (float*)(a.ws + WS_X1)});
    SEAM(6);
    if (IN(7)) { norm_mod_phase((const float*)(a.ws + WS_X1), a.g_ffn, mod, 3, 4, (u16*)(a.ws + WS_ACT)); convert_tables(a); }
    SEAM(7);
    if (IN(8)) gemm8(lds, (const u16*)(a.ws + WS_ACT), (const u16*)(a.ws + WS_WPQ), T, D, D, EpiBf16{(u16*)(a.ws + WS_Q)});
    SEAM(8);
    if (IN(9)) phase_route(a, lds);
    SEAM(9);
    if (IN(10)) phase_experts(a);
#ifdef PROBE_REP10
    grid.sync(); phase_experts(a);
#endif
#ifdef PROBE_REP9
    grid.sync(); phase_route(a, lds); grid.sync(); phase_experts(a);
#endif
#undef IN
#undef SEAM
}

#ifndef MK_ONE_LAUNCH
#define MK_ONE_LAUNCH 1
#endif
extern "C" void kernel_launch(void* const* d_in, const int* in_sizes, int n_in, void* d_out, int out_size, void* d_ws, size_t ws_size, hipStream_t stream) {
    static int grid = 0;
    if (grid == 0) {
        if (n_in != 19 || out_size != T * D || ws_size < WS_END) {
            fprintf(stderr, "kernel_launch: unexpected shapes: n_in %d out %d ws %zu (need %zu)\n", n_in, out_size, ws_size, (size_t)WS_END);
            grid = -1; return;
        }
        int dev = 0, cus = 0, per_cu = 0;
        (void)hipGetDevice(&dev);
        (void)hipDeviceGetAttribute(&cus, hipDeviceAttributeMultiprocessorCount, dev);
        (void)hipFuncSetAttribute((const void*)mk_fwd, hipFuncAttributeMaxDynamicSharedMemorySize, LDS_BYTES);
        (void)hipOccupancyMaxActiveBlocksPerMultiprocessor(&per_cu, (const void*)mk_fwd, NTHREADS, LDS_BYTES);
        if (per_cu < 1) { fprintf(stderr, "kernel_launch: occupancy query says %d blocks/CU\n", per_cu); grid = -1; return; }
        grid = cus;
        (void)hipGetLastError();
    }
    if (grid < 0) return;
    Args a{};
    a.x = (const float*)d_in[0]; a.c = (const float*)d_in[1]; a.pos = (const int*)d_in[2]; a.w_ada = (const float*)d_in[3];
    a.b_ada = (const float*)d_in[4]; a.g_mix = (const float*)d_in[5]; a.w_in = (const float*)d_in[6]; a.wgf = (const float*)d_in[7];
    a.bgf = (const float*)d_in[8]; a.wgb = (const float*)d_in[9]; a.bgb = (const float*)d_in[10]; a.g_gla = (const float*)d_in[11];
    a.w_out = (const float*)d_in[12]; a.g_ffn = (const float*)d_in[13]; a.w_pq = (const float*)d_in[14]; a.subk = (const float*)d_in[15];
    a.pu = (const float*)d_in[16]; a.pv = (const float*)d_in[17]; a.g_fin = (const float*)d_in[18];
    a.out = (float*)d_out; a.ws = (unsigned char*)d_ws;
#if MK_ONE_LAUNCH
    (void)hipMemsetAsync((unsigned char*)d_ws + WS_CTL, 0, XCD_BAR_WORDS * 4, stream);
    a.ph_lo = 0; a.ph_hi = NPHASES;
    void* args[] = {&a};
    hipError_t e = hipLaunchCooperativeKernel((const void*)mk_fwd, dim3(grid), dim3(NTHREADS), args, LDS_BYTES, stream);
    if (e != hipSuccess) fprintf(stderr, "cooperative launch failed: %s (grid %d)\n", hipGetErrorString(e), grid);
#else
    for (int p = 0; p < NPHASES; ++p) {
        a.ph_lo = p; a.ph_hi = p + 1;
        hipLaunchKernelGGL(mk_fwd, dim3(grid), dim3(NTHREADS), LDS_BYTES, stream, a);
    }
#endif
}
```

```cpp
#include <hip/hip_runtime.h>
#include <hip/hip_cooperative_groups.h>
#include <cstdio>
#include <cstdint>

namespace cg = cooperative_groups;

typedef unsigned short u16;
typedef __attribute__((ext_vector_type(8))) short bf16x8;
typedef __attribute__((ext_vector_type(4))) float f32x4;
typedef short s16x4 __attribute__((ext_vector_type(4)));
#define TID ((int)threadIdx.x)
#define BID ((int)blockIdx.x)
#define GDIM ((int)gridDim.x)
#define LAS __attribute__((address_space(3)))

constexpr int D = 2048, NB = 4, S = 4096, T = NB * S;
constexpr int INW = 6176;
constexpr int NP = 6144;
constexpr int NPAD = 6208;
constexpr int C_GQ = 0, C_GK = 512, C_GV = 1024, C_GR = 2048, C_DQ = 3072, C_DK = 4096, C_DV = 5120;
constexpr int NTHREADS = 512, NWAVES = 8;
constexpr int LDS_MAIN = 128 * 1024;
constexpr int LDS_BYTES = LDS_MAIN + 16;
constexpr float NORM_EPS = 1e-6f;

constexpr size_t WS_CTL = 0;
constexpr size_t WS_MOD = 65536;
constexpr size_t WS_CS = 524288;
constexpr size_t WS_WIN = WS_CS + (size_t)T * 64 * 8;
constexpr size_t WS_WOUT = WS_WIN + (size_t)NPAD * D * 2;
constexpr size_t WS_WPQ = WS_WOUT + (size_t)D * D * 2;
constexpr size_t WS_ACT = WS_WPQ + (size_t)D * D * 2;
constexpr size_t WS_P = WS_ACT + (size_t)T * D * 2;
constexpr size_t WS_X1 = WS_P;
constexpr size_t WS_Q = WS_P + (size_t)T * D * 4;
constexpr size_t WS_GZ = WS_P + (size_t)T * NP * 2;
constexpr int GLA_NPREP = NB * 4 * 2 * (S / 64);
constexpr size_t WS_QD = WS_GZ + (size_t)T * 32 * 4;
constexpr size_t WS_KE = WS_QD + (size_t)GLA_NPREP * 16384;
constexpr size_t WS_AT = WS_KE + (size_t)GLA_NPREP * 16384;
constexpr size_t WS_DEC = WS_AT + (size_t)GLA_NPREP * 8192;
constexpr size_t WS_OFB = WS_DEC + (size_t)GLA_NPREP * 512;
constexpr size_t WS_IDX = WS_OFB + (size_t)2 * T * 1024 * 2;
constexpr size_t WS_GATE = WS_IDX + (size_t)T * 128 * 4;
constexpr size_t WS_END = WS_GATE + (size_t)T * 128 * 4;
constexpr size_t WS_TU = WS_QD;
constexpr size_t WS_TV = WS_QD + (size_t)16384 * 1152;
static_assert(WS_TV + (size_t)16384 * 1152 <= WS_IDX, "table region");

struct Args {
    const float* x; const float* c; const int* pos; const float* w_ada; const float* b_ada; const float* g_mix;
    const float* w_in; const float* wgf; const float* bgf; const float* wgb; const float* bgb; const float* g_gla;
    const float* w_out; const float* g_ffn; const float* w_pq; const float* subk; const float* pu; const float* pv; const float* g_fin;
    float* out; unsigned char* ws; int ph_lo, ph_hi;
};

__device__ __forceinline__ float bf2f(u16 h) { return __uint_as_float(((unsigned)h) << 16); }
__device__ __forceinline__ u16 f2bf(float f) { unsigned u = __float_as_uint(f); u += 0x7fffu + ((u >> 16) & 1u); return (u16)(u >> 16); }
__device__ __forceinline__ unsigned pack2(float a, float b) { return (unsigned)f2bf(a) | ((unsigned)f2bf(b) << 16); }
__device__ __forceinline__ float lo2f(unsigned p) { return __uint_as_float(p << 16); }
__device__ __forceinline__ float hi2f(unsigned p) { return __uint_as_float(p & 0xffff0000u); }
__device__ __forceinline__ float wave_sum(float v) {
#pragma unroll
    for (int o = 32; o > 0; o >>= 1) v += __shfl_xor(v, o);
    return v;
}
__device__ __forceinline__ float wave_max(float v) {
#pragma unroll
    for (int o = 32; o > 0; o >>= 1) v = fmaxf(v, __shfl_xor(v, o));
    return v;
}
__device__ __forceinline__ float silu_f(float v) { return v / (1.f + __expf(-v)); }
__device__ __forceinline__ float gelu_f(float a) { return 0.5f * a * (1.f + erff(a * 0.70710678118654752f)); }
__device__ __forceinline__ float logsigmoid_f(float z) { return z < 0.f ? z - log1pf(expf(z)) : -log1pf(expf(-z)); }

__device__ __forceinline__ void p0_mod(const Args& a, unsigned char* lds, int bi) {
    float* sc = (float*)lds;
    float* red = sc + 4 * 2048;
    const int tid = threadIdx.x, lane = tid & 63, wave = tid >> 6;
    for (int i = tid; i < 4 * 2048; i += NTHREADS) sc[i] = silu_f(a.c[i]);
    __syncthreads();
    const int j0 = bi * 256 + lane * 4;
    float acc[4][4];
#pragma unroll
    for (int b = 0; b < 4; ++b)
#pragma unroll
        for (int q = 0; q < 4; ++q) acc[b][q] = 0.f;
    const int k0 = wave * 256;
#pragma unroll 4
    for (int kk = 0; kk < 256; ++kk) {
        const int k = k0 + kk;
        const float4 w = *(const float4*)(a.w_ada + (size_t)k * 12288 + j0);
#pragma unroll
        for (int b = 0; b < 4; ++b) {
            const float s = sc[b * 2048 + k];
            acc[b][0] += s * w.x; acc[b][1] += s * w.y; acc[b][2] += s * w.z; acc[b][3] += s * w.w;
        }
    }
#pragma unroll
    for (int b = 0; b < 4; ++b)
#pragma unroll
        for (int q = 0; q < 4; ++q) red[(wave * 4 + b) * 256 + lane * 4 + q] = acc[b][q];
    __syncthreads();
    float* mod = (float*)(a.ws + WS_MOD);
    for (int i = tid; i < 4 * 256; i += NTHREADS) {
        const int b = i >> 8, jc = i & 255;
        float s = 0.f;
#pragma unroll
        for (int w = 0; w < 8; ++w) s += red[(w * 4 + b) * 256 + jc];
        mod[b * 12288 + bi * 256 + jc] = s + a.b_ada[bi * 256 + jc];
    }
    __syncthreads();
}

__device__ __forceinline__ void p0_transpose_item(const float* __restrict__ W, int ldw, int k0, int src_col0, int n_valid,
                                                  u16* __restrict__ WT, int ldt, int n_out0, unsigned char* lds) {
    u16* tl = (u16*)lds;
    const int tid = threadIdx.x;
    {
        const int k = tid >> 3, nc = (tid & 7) * 8;
        float v[8];
        if (nc < n_valid) {
            const float4 v0 = *(const float4*)(W + (size_t)(k0 + k) * ldw + src_col0 + nc);
            const float4 v1 = *(const float4*)(W + (size_t)(k0 + k) * ldw + src_col0 + nc + 4);
            v[0] = v0.x; v[1] = v0.y; v[2] = v0.z; v[3] = v0.w; v[4] = v1.x; v[5] = v1.y; v[6] = v1.z; v[7] = v1.w;
        } else {
#pragma unroll
            for (int i = 0; i < 8; ++i) v[i] = 0.f;
        }
#pragma unroll
        for (int i = 0; i < 8; ++i) tl[(nc + i) * 72 + k] = f2bf(v[i]);
    }
    __syncthreads();
    {
        const int n = tid >> 3, kc = (tid & 7) * 8;
        const uint4 v = *(const uint4*)(tl + n * 72 + kc);
        *(uint4*)(WT + (size_t)(n_out0 + n) * ldt + k0 + kc) = v;
    }
    __syncthreads();
}

__device__ __forceinline__ void phase0(const Args& a, unsigned char* lds) {
    const int bi = blockIdx.x, G = gridDim.x, tid = threadIdx.x;
    if (bi < 48) p0_mod(a, lds, bi);
    constexpr int I_IN = 32 * (NPAD / 64), I_SQ = 32 * 32;
    u16* WinT = (u16*)(a.ws + WS_WIN); u16* WoutT = (u16*)(a.ws + WS_WOUT); u16* WpqT = (u16*)(a.ws + WS_WPQ);
    for (int it = bi; it < I_IN + 2 * I_SQ; it += G) {
        if (it < I_IN) {
            const int kt = it & 31, nt = it >> 5;
            const int n0 = nt * 64;
            int src, nv;
            if (n0 < 3072) { src = n0; nv = 64; }
            else if (n0 < 6144) { src = n0 + 32; nv = 64; }
            else if (n0 == 6144) { src = 3072; nv = 32; }
            else { src = 0; nv = 0; }
            p0_transpose_item(a.w_in, INW, kt * 64, src, nv, WinT, D, n0, lds);
        } else if (it < I_IN + I_SQ) {
            const int r = it - I_IN; const int kt = r & 31, nt = r >> 5;
            p0_transpose_item(a.w_out, D, kt * 64, nt * 64, 64, WoutT, D, nt * 64, lds);
        } else {
            const int r = it - I_IN - I_SQ; const int kt = r & 31, nt = r >> 5;
            p0_transpose_item(a.w_pq, D, kt * 64, nt * 64, 64, WpqT, D, nt * 64, lds);
        }
    }
    float2* cs = (float2*)(a.ws + WS_CS);
    for (int i = bi * NTHREADS + tid; i < T * 64; i += G * NTHREADS) {
        const int t = i >> 6, f = i & 63;
        const float inv_freq = powf(10000.0f, -(float)f * 2.0f / 128.0f);
        const float ang = (float)a.pos[t] * inv_freq;
        const double rev = (double)ang * 0.15915494309189533577;
        const float fr = (float)(rev - floor(rev));
        cs[i] = make_float2(__builtin_amdgcn_cosf(fr), __builtin_amdgcn_sinf(fr));
    }
}

__device__ __forceinline__ void norm_mod_phase(const float* __restrict__ xin, const float* __restrict__ g, const float* __restrict__ mod,
                                               int sh_chunk, int sc_chunk, u16* __restrict__ outp) {
    const int lane = threadIdx.x & 63, wave = threadIdx.x >> 6;
    const int gw = blockIdx.x * NWAVES + wave, NGW = gridDim.x * NWAVES;
    for (int t = gw; t < T; t += NGW) {
        const int b = t / S;
        const float4* xr = (const float4*)(xin + (size_t)t * D);
        float4 v[8]; float ss = 0.f;
#pragma unroll
        for (int m = 0; m < 8; ++m) { v[m] = xr[lane + 64 * m]; ss += v[m].x * v[m].x + v[m].y * v[m].y + v[m].z * v[m].z + v[m].w * v[m].w; }
        ss = wave_sum(ss);
        const float rstd = rsqrtf(ss * (1.f / D) + NORM_EPS);
        const float4* gp = (const float4*)g;
        const float4* shp = (const float4*)(mod + b * 12288 + sh_chunk * 2048);
        const float4* scp = (const float4*)(mod + b * 12288 + sc_chunk * 2048);
        uint2* op = (uint2*)(outp + (size_t)t * D);
#pragma unroll
        for (int m = 0; m < 8; ++m) {
            const int i = lane + 64 * m;
            const float4 gg = gp[i], sh = shp[i], sc = scp[i];
            const float h0 = v[m].x * rstd * gg.x * (1.f + sc.x) + sh.x;
            const float h1 = v[m].y * rstd * gg.y * (1.f + sc.y) + sh.y;
            const float h2 = v[m].z * rstd * gg.z * (1.f + sc.z) + sh.z;
            const float h3 = v[m].w * rstd * gg.w * (1.f + sc.w) + sh.w;
            op[i] = make_uint2(pack2(h0, h1), pack2(h2, h3));
        }
    }
}

namespace pg8 {
#define PG8_LAS __attribute__((address_space(3)))
typedef unsigned short bf16_t;
typedef short bf16x8 __attribute__((ext_vector_type(8)));
typedef float f32x4 __attribute__((ext_vector_type(4)));
typedef unsigned u32x4 __attribute__((ext_vector_type(4)));
constexpr int BM = 256, BK = 64, HALF = 128, HTB = HALF * BK * 2  , STAGE_BYTES = 8 * HTB, NXCD = 8, WGM = 8;

__host__ __device__ __forceinline__ int lds_byte(int r, int c) { const int st = (r >> 4) * 2 + (c >> 5), rr = r & 15, cc = c & 31, ob = rr * 64 + cc * 2; return st * 1024 + (ob ^ (((ob >> 9) & 1) << 5)); }
__host__ __device__ __forceinline__ void stage_rc(int b, int& R, int& C) { const int st = b / 1024, sb = b % 1024, swz = sb ^ (((sb >> 9) & 1) << 5); R = (st >> 1) * 16 + swz / 64; C = (st & 1) * 32 + (swz % 64) / 2; }
__host__ __device__ __forceinline__ int perm32(int rho) { const int n = rho >> 4, i = rho & 15; return 8 * (i >> 2) + 4 * n + (i & 3); }

struct Unit { int pm, pn; };
struct Gemm { const bf16_t* A; const bf16_t* Bt; int M, N, K; };

struct StaticOrder {
    int nM, nN, nwg, G, c;
    __host__ __device__ void init(int M, int N, int G_, int c_) { nM = M / BM; nN = N / BM; nwg = nM * nN; G = G_; c = c_; }
    __host__ __device__ bool next(int i, Unit& u) const {
        const long L = (long)i * G + c; if (L >= nwg) return false;
        int wgid = (int)L; { const int q = nwg / NXCD, r = nwg % NXCD, xcd = wgid % NXCD, off = wgid / NXCD; wgid = (xcd < r ? xcd * (q + 1) : r * (q + 1) + (xcd - r) * q) + off; }
        const int nig = WGM * nN, gid = wgid / nig, fm = gid * WGM, gsz = (nM - fm) < WGM ? (nM - fm) : WGM;
        u.pm = fm + ((wgid % nig) % gsz); u.pn = (wgid % nig) / gsz; return true;
    }
    __device__ __forceinline__ void a_ready(const Unit&) const {}
    __device__ __forceinline__ void done(const Unit&) const {}
};
__device__ __forceinline__ unsigned cvt_pk_bf16(float lo, float hi) { unsigned r; asm volatile("v_cvt_pk_bf16_f32 %0, %1, %2" : "=v"(r) : "v"(lo), "v"(hi)); return r; }
typedef float f32x2 __attribute__((ext_vector_type(2)));
template <class Epi, class Sched, bool STAMP = false>
__device__ __forceinline__ void gemm_phase(PG8_LAS unsigned char* lds, const Gemm g, const Sched& S, const Epi& E, unsigned long long* stamps) {
    const int tid = threadIdx.x, wid = __builtin_amdgcn_readfirstlane(tid >> 6), lane = tid & 63, wr = wid >> 2, wc = wid & 3, fr = lane & 15, fq = lane >> 4;
    const int K = g.K, nt = K / BK;
    int ts_lo = 0, ts_hi = 0, nts = 0; const unsigned long long rt_entry = STAMP ? (unsigned long long)wall_clock64() : 0ull;
#define PG8_STAMP() do { if (STAMP && wid == 0 && nts < 64) { const unsigned long long _c = (unsigned long long)clock64(); \
        ts_lo = (lane == nts) ? (int)(unsigned)_c : ts_lo; ts_hi = (lane == nts) ? (int)(unsigned)(_c >> 32) : ts_hi; ++nts; } } while (0)
    PG8_STAMP();
    unsigned voffA[2], voffB[2];
#pragma unroll
    for (int i = 0; i < 2; ++i) { int R, C; stage_rc(tid * 16 + i * 8192, R, C); const int Rb = Epi::PERM ? ((R & ~31) + perm32(R & 31)) : R;
        voffA[i] = (unsigned)(R * K + C) * 2u; voffB[i] = (unsigned)(Rb * K + C) * 2u; }
    const size_t kstep = (size_t)(BK * 2);
    const size_t hstep = (size_t)HALF * K * 2;
    const size_t tstep = 2 * hstep;
    const unsigned ldsw = (unsigned)wid * 1024u;
    const int aoff = lds_byte(wr * 64 + fr, fq * 8), boff = lds_byte(wc * 32 + fr, fq * 8);
#define PG8_SA(b, h) (((b) * 2 + (h)) * HTB)
#define PG8_SB(b, h) ((4 + (b) * 2 + (h)) * HTB)
#define PG8_STAGE(bufoff, gbase, voff) do { _Pragma("unroll") for (int _i = 0; _i < 2; ++_i) \
        __builtin_amdgcn_global_load_lds((const unsigned*)((const char*)(gbase) + (voff)[_i]), (PG8_LAS unsigned*)(lds + (bufoff) + ldsw + _i * 8192), 16, 0, 0); } while (0)
#define PG8_LDA(dst, b, h) do { _Pragma("unroll") for (int m = 0; m < 4; ++m) _Pragma("unroll") for (int k = 0; k < 2; ++k) dst[m][k] = *(const PG8_LAS bf16x8*)(lds + PG8_SA(b, h) + aoff + m * 2048 + k * 1024); } while (0)
#define PG8_LDB(dst, b, h) do { _Pragma("unroll") for (int n = 0; n < 2; ++n) _Pragma("unroll") for (int k = 0; k < 2; ++k) dst[n][k] = *(const PG8_LAS bf16x8*)(lds + PG8_SB(b, h) + boff + n * 2048 + k * 1024); } while (0)
#define PG8_MMA(ai, bj, At, Bt) do { __builtin_amdgcn_s_setprio(1); _Pragma("unroll") for (int m = 0; m < 4; ++m) _Pragma("unroll") for (int n = 0; n < 2; ++n) _Pragma("unroll") for (int k = 0; k < 2; ++k) \
        acc[ai][bj][m][n] = __builtin_amdgcn_mfma_f32_16x16x32_bf16(Bt[n][k], At[m][k], acc[ai][bj][m][n], 0, 0, 0); __builtin_amdgcn_s_setprio(0); } while (0)
#define PG8_WAIT_V(n) asm volatile("s_waitcnt vmcnt(" #n ")" ::: "memory")
#define PG8_WAIT_L(n) asm volatile("s_waitcnt lgkmcnt(" #n ")" ::: "memory")
#define PG8_BAR __builtin_amdgcn_s_barrier()
#define PG8_SCHED __builtin_amdgcn_sched_barrier(0)
    Unit cur, nxt; int ui = 0;
    if (!S.next(0, cur)) return;
    f32x4 acc[2][2][4][2];
#pragma unroll
    for (int a = 0; a < 2; ++a)
#pragma unroll
        for (int b = 0; b < 2; ++b)
#pragma unroll
            for (int m = 0; m < 4; ++m)
#pragma unroll
                for (int n = 0; n < 2; ++n) acc[a][b][m][n] = (f32x4){0.f, 0.f, 0.f, 0.f};
    bf16x8 At[4][2], B0[2][2], B1[2][2];
    const char* cA = (const char*)g.A + (size_t)cur.pm * tstep; const char* cB = (const char*)g.Bt + (size_t)cur.pn * tstep;
    S.a_ready(cur);
    PG8_STAGE(PG8_SB(0, 0), cB, voffB); PG8_STAGE(PG8_SA(0, 0), cA, voffA); PG8_STAGE(PG8_SB(0, 1), cB + hstep, voffB); PG8_STAGE(PG8_SA(0, 1), cA + hstep, voffA);
    if (wr == 1) PG8_BAR;
    PG8_WAIT_V(4); PG8_BAR;
    PG8_STAGE(PG8_SB(1, 0), cB + kstep, voffB); PG8_STAGE(PG8_SA(1, 0), cA + kstep, voffA); PG8_STAGE(PG8_SB(1, 1), cB + hstep + kstep, voffB);
    PG8_WAIT_V(6); PG8_BAR;
    PG8_STAMP();
    for (;;) {
        const bool has_next = S.next(ui + 1, nxt);
        const char* nA = has_next ? (const char*)g.A + (size_t)nxt.pm * tstep : cA; const char* nB = has_next ? (const char*)g.Bt + (size_t)nxt.pn * tstep : cB;
        for (int t = 0; t < nt; t += 2) {
            const bool last = (t == nt - 2);
            const char* a1 = cA + (size_t)(t + 1) * kstep;
            const char* a2 = last ? nA : cA + (size_t)(t + 2) * kstep; const char* b2 = last ? nB : cB + (size_t)(t + 2) * kstep;
            const char* a3 = a2 + kstep; const char* b3 = b2 + kstep;
            if (last && has_next) S.a_ready(nxt);
            PG8_LDB(B0, 0, 0); PG8_SCHED; PG8_LDA(At, 0, 0); PG8_STAGE(PG8_SA(1, 1), a1 + hstep, voffA);
            PG8_WAIT_L(8); PG8_BAR; PG8_WAIT_L(0); PG8_MMA(0, 0, At, B0); PG8_BAR; PG8_SCHED;
            PG8_LDB(B1, 0, 1); PG8_STAGE(PG8_SB(0, 0), b2, voffB);
            PG8_BAR; PG8_WAIT_L(0); PG8_MMA(0, 1, At, B1); PG8_BAR;
            PG8_LDA(At, 0, 1); PG8_STAGE(PG8_SA(0, 0), a2, voffA);
            PG8_BAR; PG8_WAIT_L(0); PG8_MMA(1, 0, At, B0); PG8_BAR; PG8_SCHED;
            PG8_STAGE(PG8_SB(0, 1), b2 + hstep, voffB);
            PG8_WAIT_V(6); PG8_BAR; PG8_MMA(1, 1, At, B1); PG8_BAR;
            PG8_LDB(B0, 1, 0); PG8_SCHED; PG8_LDA(At, 1, 0); PG8_STAGE(PG8_SA(0, 1), a2 + hstep, voffA);
            PG8_WAIT_L(8); PG8_BAR; PG8_WAIT_L(0); PG8_MMA(0, 0, At, B0); PG8_BAR; PG8_SCHED;
            PG8_LDB(B1, 1, 1); PG8_STAGE(PG8_SB(1, 0), b3, voffB);
            PG8_BAR; PG8_WAIT_L(0); PG8_MMA(0, 1, At, B1); PG8_BAR;
            PG8_LDA(At, 1, 1); PG8_STAGE(PG8_SA(1, 0), a3, voffA);
            PG8_BAR; PG8_WAIT_L(0); PG8_MMA(1, 0, At, B0); PG8_BAR; PG8_SCHED;
            PG8_STAGE(PG8_SB(1, 1), b3 + hstep, voffB);
            PG8_WAIT_V(6); PG8_BAR; PG8_MMA(1, 1, At, B1); PG8_BAR;
        }
        PG8_STAMP();
        if constexpr (!Epi::AFTER_DRAIN) { E(acc, cur, wr, wc, fr, fq); S.done(cur); }
        PG8_STAMP();
        if (!has_next) break;
#pragma unroll
        for (int a = 0; a < 2; ++a)
#pragma unroll
            for (int b = 0; b < 2; ++b)
#pragma unroll
                for (int m = 0; m < 4; ++m)
#pragma unroll
                    for (int n = 0; n < 2; ++n) acc[a][b][m][n] = (f32x4){0.f, 0.f, 0.f, 0.f};
        cur = nxt; cA = nA; cB = nB; ++ui;
    }
    PG8_WAIT_V(0);
    if (wr == 0) PG8_BAR;
    PG8_BAR;
    if constexpr (Epi::AFTER_DRAIN) { E.fused(acc, cur, wr, wc, fr, fq, lds, wid, lane); S.done(cur); }
    PG8_STAMP();
    if (STAMP && wid == 0) { stamps[lane] = lane < nts ? (((unsigned long long)(unsigned)ts_hi << 32) | (unsigned)ts_lo) : 0ull;
        if (lane == 62) stamps[62] = rt_entry; if (lane == 63) stamps[63] = (unsigned long long)wall_clock64(); }
#undef PG8_STAMP
#undef PG8_SA
#undef PG8_SB
#undef PG8_STAGE
#undef PG8_LDA
#undef PG8_LDB
#undef PG8_MMA
#undef PG8_WAIT_V
#undef PG8_WAIT_L
#undef PG8_BAR
#undef PG8_SCHED
}
}

struct EpiProj {
    static constexpr bool PERM = true, AFTER_DRAIN = false;
    u16* P;
    __device__ __forceinline__ void operator()(const pg8::f32x4 (&acc)[2][2][4][2], const pg8::Unit& u, int wr, int wc, int fr, int fq) const {
        const int row0 = u.pm * 256 + wr * 64 + fr;
        const int col0 = u.pn * 256 + wc * 32 + 8 * fq;
#pragma unroll
        for (int ai = 0; ai < 2; ++ai)
#pragma unroll
            for (int m = 0; m < 4; ++m) { u16* rowp = P + (size_t)(row0 + ai * 128 + m * 16) * NP + col0;
#pragma unroll
                for (int bj = 0; bj < 2; ++bj) { const pg8::f32x4 v0 = acc[ai][bj][m][0], v1 = acc[ai][bj][m][1];
                    pg8::u32x4 w; w.x = pg8::cvt_pk_bf16(v0[0], v0[1]); w.y = pg8::cvt_pk_bf16(v0[2], v0[3]); w.z = pg8::cvt_pk_bf16(v1[0], v1[1]); w.w = pg8::cvt_pk_bf16(v1[2], v1[3]);
                    *(pg8::u32x4*)(rowp + bj * 128) = w; } }
    }
};
__device__ __forceinline__ void gz_phase(unsigned char* lds, const u16* __restrict__ H1, const u16* __restrict__ Wg, float* __restrict__ gz) {
    const int tid = threadIdx.x, lane = tid & 63, wave = tid >> 6, fr = lane & 15, fq = lane >> 4;
    float* red = (float*)lds;
    for (int rb = blockIdx.x; rb < T / 64; rb += gridDim.x) {
        const int r0 = rb * 64, k0 = wave * 256;
        f32x4 acc[4][2];
#pragma unroll
        for (int m = 0; m < 4; ++m) { acc[m][0] = (f32x4){0.f, 0.f, 0.f, 0.f}; acc[m][1] = (f32x4){0.f, 0.f, 0.f, 0.f}; }
#pragma unroll
        for (int ks = 0; ks < 8; ++ks) {
            bf16x8 af[4], bfr[2];
#pragma unroll
            for (int m = 0; m < 4; ++m) af[m] = *(const bf16x8*)(H1 + (size_t)(r0 + 16 * m + fr) * D + k0 + 32 * ks + 8 * fq);
#pragma unroll
            for (int n = 0; n < 2; ++n) bfr[n] = *(const bf16x8*)(Wg + (size_t)(16 * n + fr) * D + k0 + 32 * ks + 8 * fq);
#pragma unroll
            for (int m = 0; m < 4; ++m)
#pragma unroll
                for (int n = 0; n < 2; ++n) acc[m][n] = __builtin_amdgcn_mfma_f32_16x16x32_bf16(af[m], bfr[n], acc[m][n], 0, 0, 0);
        }
        __syncthreads();
#pragma unroll
        for (int m = 0; m < 4; ++m)
#pragma unroll
            for (int n = 0; n < 2; ++n)
#pragma unroll
                for (int j = 0; j < 4; ++j) red[(wave * 64 + 16 * m + 4 * fq + j) * 32 + 16 * n + fr] = acc[m][n][j];
        __syncthreads();
#pragma unroll
        for (int k = 0; k < 4; ++k) {
            const int e = tid + 512 * k;
            float s = 0.f;
#pragma unroll
            for (int w = 0; w < 8; ++w) s += red[w * 2048 + e];
            gz[(size_t)r0 * 32 + e] = s;
        }
    }
    __syncthreads();
}
struct EpiResid {
    static constexpr bool PERM = false, AFTER_DRAIN = false;
    const float* x; const float* mod; float* x1;
    __device__ __forceinline__ void operator()(const pg8::f32x4 (&acc)[2][2][4][2], const pg8::Unit& u, int wr, int wc, int fr, int fq) const {
        const int row0 = u.pm * 256 + wr * 64 + fr, col0 = u.pn * 256 + wc * 32 + 4 * fq;
        const int b = (u.pm * 256) / S;
        pg8::f32x4 ga[2][2];
#pragma unroll
        for (int bj = 0; bj < 2; ++bj)
#pragma unroll
            for (int n = 0; n < 2; ++n) ga[bj][n] = *(const pg8::f32x4*)(mod + b * 12288 + 2 * 2048 + col0 + bj * 128 + n * 16);
#pragma unroll
        for (int ai = 0; ai < 2; ++ai)
#pragma unroll
            for (int m = 0; m < 4; ++m) { const size_t off = (size_t)(row0 + ai * 128 + m * 16) * D + col0;
#pragma unroll
                for (int bj = 0; bj < 2; ++bj)
#pragma unroll
                    for (int n = 0; n < 2; ++n) { const pg8::f32x4 xv = *(const pg8::f32x4*)(x + off + bj * 128 + n * 16);
                        *(pg8::f32x4*)(x1 + off + bj * 128 + n * 16) = xv + ga[bj][n] * acc[ai][bj][m][n]; } }
    }
};
struct EpiBf16 {
    static constexpr bool PERM = true, AFTER_DRAIN = false;
    u16* Q;
    __device__ __forceinline__ void operator()(const pg8::f32x4 (&acc)[2][2][4][2], const pg8::Unit& u, int wr, int wc, int fr, int fq) const {
        const int row0 = u.pm * 256 + wr * 64 + fr, col0 = u.pn * 256 + wc * 32 + 8 * fq;
#pragma unroll
        for (int ai = 0; ai < 2; ++ai)
#pragma unroll
            for (int m = 0; m < 4; ++m) { u16* rowp = Q + (size_t)(row0 + ai * 128 + m * 16) * D + col0;
#pragma unroll
                for (int bj = 0; bj < 2; ++bj) { const pg8::f32x4 v0 = acc[ai][bj][m][0], v1 = acc[ai][bj][m][1];
                    pg8::u32x4 w; w.x = pg8::cvt_pk_bf16(v0[0], v0[1]); w.y = pg8::cvt_pk_bf16(v0[2], v0[3]); w.z = pg8::cvt_pk_bf16(v1[0], v1[1]); w.w = pg8::cvt_pk_bf16(v1[2], v1[3]);
                    *(pg8::u32x4*)(rowp + bj * 128) = w; } }
    }
};
template <class Epi>
__device__ __forceinline__ void gemm8(unsigned char* lds, const u16* A, const u16* Bt, int M, int N, int K, const Epi& E) {
    pg8::Gemm g{A, Bt, M, N, K}; pg8::StaticOrder So; So.init(M, N, (int)gridDim.x, (int)blockIdx.x);
    pg8::gemm_phase<Epi, pg8::StaticOrder, false>((PG8_LAS unsigned char*)lds, g, So, E, nullptr);
    __syncthreads();
}

#define GLA_QD_BYTES 16384
#define GLA_AT_BYTES 8192
__device__ __forceinline__ float gla_logsigmoid(float z) { return z < 0.f ? z - log1pf(expf(z)) : -log1pf(expf(-z)); }

__device__ __forceinline__ void gla_prep_item(const u16* __restrict__ P, int ldp, int cq, int ck, const float* __restrict__ gz,
                                              const float* __restrict__ wg_f, const float* __restrict__ bg_f, const float* __restrict__ wg_b, const float* __restrict__ bg_b,
                                              int Sq, unsigned char* __restrict__ QDg, unsigned char* __restrict__ KEg, unsigned char* __restrict__ ATg, float* __restrict__ DECg,
                                              unsigned char* lds, int item) {
    const int nch = Sq / 64;
    const int c = item % nch, dir = (item / nch) & 1, hh = (item / (nch * 2)) & 3, b = item / (nch * 8);
    const int tid = TID, lane = tid & 63, wave = tid >> 6, li = lane & 15, fq = lane >> 4;
    float* gzs = (float*)lds;
    float* segs = gzs + 64 * 16;
    unsigned char* QDs = lds + 8192;
    unsigned char* KIs = QDs + 16384;
    unsigned char* KEs = KIs + 16384;
    float* bmat = (float*)(KEs + 16384);
    const size_t tok0 = (size_t)b * Sq;
    __syncthreads();
    uint4 rq0, rq1, rk0, rk1;
    {
        const int i0 = tid >> 4, i1 = (tid + 512) >> 4, cc = tid & 15;
        const int s0 = dir ? (Sq - 1 - (64 * c + i0)) : (64 * c + i0), s1 = dir ? (Sq - 1 - (64 * c + i1)) : (64 * c + i1);
        rq0 = *(const uint4*)(P + (tok0 + s0) * ldp + cq + hh * 128 + cc * 8); rk0 = *(const uint4*)(P + (tok0 + s0) * ldp + ck + hh * 128 + cc * 8);
        rq1 = *(const uint4*)(P + (tok0 + s1) * ldp + cq + hh * 128 + cc * 8); rk1 = *(const uint4*)(P + (tok0 + s1) * ldp + ck + hh * 128 + cc * 8);
    }
    for (int e = tid; e < 64 * 16; e += 512) {
        const int i = e >> 4, r = e & 15;
        const int s = dir ? (Sq - 1 - (64 * c + i)) : (64 * c + i);
        gzs[e] = gz[(tok0 + s) * 32 + dir * 16 + r];
    }
    const int d = tid & 127, seg = tid >> 7;
    const float* wg = dir ? wg_b : wg_f;
    float wcol[16];
#pragma unroll
    for (int r = 0; r < 16; ++r) wcol[r] = wg[r * 512 + hh * 128 + d];
    const float bias = (dir ? bg_b : bg_f)[hh * 128 + d];
    __syncthreads();
    float run = 0.f;
#pragma unroll
    for (int k = 0; k < 16; ++k) {
        const int i = 16 * seg + k;
        float z = bias;
#pragma unroll
        for (int r = 0; r < 16; ++r) z += gzs[i * 16 + r] * wcol[r];
        run += gla_logsigmoid(z) * (1.f / 16.f);
        bmat[i * 128 + d] = run;
    }
    segs[seg * 128 + d] = run;
    __syncthreads();
    if (seg == 0) {
        const float t0 = segs[d], t1 = segs[128 + d], t2 = segs[256 + d], t3 = segs[384 + d];
        segs[d] = 0.f; segs[128 + d] = t0; segs[256 + d] = t0 + t1; segs[384 + d] = t0 + t1 + t2; segs[512 + d] = t0 + t1 + t2 + t3;
        DECg[(size_t)item * 128 + d] = __expf(t0 + t1 + t2 + t3);
    }
    __syncthreads();
    const float qscale = 0.08838834764831845f;
#pragma unroll
    for (int k = 0; k < 2; ++k) {
        const int id = tid + 512 * k, i = id >> 4, cc = id & 15, d0 = cc * 8, sg = i >> 4;
        const uint4 qv = k ? rq1 : rq0, kv = k ? rk1 : rk0;
        const float qx[8] = {lo2f(qv.x), hi2f(qv.x), lo2f(qv.y), hi2f(qv.y), lo2f(qv.z), hi2f(qv.z), lo2f(qv.w), hi2f(qv.w)};
        const float kx[8] = {lo2f(kv.x), hi2f(kv.x), lo2f(kv.y), hi2f(kv.y), lo2f(kv.z), hi2f(kv.z), lo2f(kv.w), hi2f(kv.w)};
        float qd[8], ki[8], ke[8];
#pragma unroll
        for (int e = 0; e < 8; ++e) {
            const float bb = bmat[i * 128 + d0 + e] + segs[sg * 128 + d0 + e], tot = segs[512 + d0 + e];
            qd[e] = qx[e] * qscale * __expf(bb); ki[e] = kx[e] * __expf(-bb); ke[e] = kx[e] * __expf(tot - bb);
        }
        const int o = i * 256 + ((cc ^ (i & 15)) << 4);
        *(uint4*)(QDs + o) = make_uint4(pack2(qd[0], qd[1]), pack2(qd[2], qd[3]), pack2(qd[4], qd[5]), pack2(qd[6], qd[7]));
        *(uint4*)(KIs + o) = make_uint4(pack2(ki[0], ki[1]), pack2(ki[2], ki[3]), pack2(ki[4], ki[5]), pack2(ki[6], ki[7]));
        *(uint4*)(KEs + o) = make_uint4(pack2(ke[0], ke[1]), pack2(ke[2], ke[3]), pack2(ke[4], ke[5]), pack2(ke[6], ke[7]));
    }
    __syncthreads();
    {
        uint4* qo = (uint4*)(QDg + (size_t)item * GLA_QD_BYTES); uint4* ko = (uint4*)(KEg + (size_t)item * GLA_QD_BYTES);
#pragma unroll
        for (int k = 0; k < 2; ++k) { const int e = tid + 512 * k; qo[e] = ((const uint4*)QDs)[e]; ko[e] = ((const uint4*)KEs)[e]; }
    }
#pragma unroll
    for (int tt = 0; tt < 2; ++tt) {
        const int tile = wave + 8 * tt, jt = tile >> 2, it = tile & 3;
        f32x4 acc = (f32x4){0.f, 0.f, 0.f, 0.f};
        if (jt <= it) {
            const int jr = 16 * jt + li, ir = 16 * it + li;
#pragma unroll
            for (int ks = 0; ks < 4; ++ks) {
                const bf16x8 kf = *(const bf16x8*)(KIs + jr * 256 + (((4 * ks + fq) ^ (jr & 15)) << 4));
                const bf16x8 qf = *(const bf16x8*)(QDs + ir * 256 + (((4 * ks + fq) ^ (ir & 15)) << 4));
                acc = __builtin_amdgcn_mfma_f32_16x16x32_bf16(kf, qf, acc, 0, 0, 0);
            }
        }
        const int i = 16 * it + li, j0 = 16 * jt + 4 * fq;
        float v[4];
#pragma unroll
        for (int jj = 0; jj < 4; ++jj) v[jj] = (j0 + jj <= i) ? acc[jj] : 0.f;
        const int chunk = 2 * jt + (fq >> 1), sub = (fq & 1) * 8;
        *(uint2*)(ATg + (size_t)item * GLA_AT_BYTES + i * 128 + ((chunk ^ (i & 7)) << 4) + sub) = make_uint2(pack2(v[0], v[1]), pack2(v[2], v[3]));
    }
}

__device__ __forceinline__ void gla_seq_item(const u16* __restrict__ P, int ldp, int cv, int Sq,
                                             const unsigned char* __restrict__ QDg, const unsigned char* __restrict__ KEg, const unsigned char* __restrict__ ATg, const float* __restrict__ DECg,
                                             u16* __restrict__ Oout  , int Ttot, unsigned char* lds, int item) {
    const int slice = item & 1, dir = (item >> 1) & 1, hh = (item >> 2) & 3, b = item >> 4;
    const int nch = Sq / 64;
    const int tid = TID, lane = tid & 63, wave = tid >> 6, li = lane & 15, fq = lane >> 4;
    const size_t tok0 = (size_t)b * Sq;
    const int pitem0 = ((b * 4 + hh) * 2 + dir) * nch;
    constexpr int BUF = 16384 * 3 + 8192 + 512;
    typedef unsigned gla_u32x4 __attribute__((ext_vector_type(4)));
    gla_u32x4 rq0, rq1, rk0, rk1, rv0, rv1, ra; float rd = 0.f;
#define GLA_VROW(c_, k_) ((tok0 + (size_t)(dir ? (Sq - 1 - (64 * (c_) + ((tid + 512 * (k_)) >> 4))) : (64 * (c_) + ((tid + 512 * (k_)) >> 4)))) * ldp + cv + hh * 256 + slice * 128 + ((tid + 512 * (k_)) & 15) * 8)
#define GLA_ISSUE(c_) do { \
        const gla_u32x4* qsrc_ = (const gla_u32x4*)(QDg + (size_t)(pitem0 + (c_)) * GLA_QD_BYTES); const gla_u32x4* ksrc_ = (const gla_u32x4*)(KEg + (size_t)(pitem0 + (c_)) * GLA_QD_BYTES); \
        rq0 = qsrc_[tid]; rq1 = qsrc_[tid + 512]; rk0 = ksrc_[tid]; rk1 = ksrc_[tid + 512]; \
        ra = ((const gla_u32x4*)(ATg + (size_t)(pitem0 + (c_)) * GLA_AT_BYTES))[tid]; \
        rv0 = *(const gla_u32x4*)(P + GLA_VROW(c_, 0)); rv1 = *(const gla_u32x4*)(P + GLA_VROW(c_, 1)); \
        if (tid < 128) rd = DECg[(size_t)(pitem0 + (c_)) * 128 + tid]; } while (0)
#define GLA_COMMIT(buf_) do { \
        unsigned char* base_ = lds + (buf_) * BUF; \
        ((gla_u32x4*)base_)[tid] = rq0; ((gla_u32x4*)base_)[tid + 512] = rq1; ((gla_u32x4*)(base_ + 16384))[tid] = rk0; ((gla_u32x4*)(base_ + 16384))[tid + 512] = rk1; \
        { const int row_ = tid >> 4, ch_ = tid & 15; *(gla_u32x4*)(base_ + 32768 + row_ * 256 + ((ch_ ^ (row_ & 15)) << 4)) = rv0; } \
        { const int row_ = (tid + 512) >> 4, ch_ = tid & 15; *(gla_u32x4*)(base_ + 32768 + row_ * 256 + ((ch_ ^ (row_ & 15)) << 4)) = rv1; } \
        ((gla_u32x4*)(base_ + 49152))[tid] = ra; \
        if (tid < 128) ((float*)(base_ + 57344))[tid] = rd; } while (0)
    f32x4 st[8];
#pragma unroll
    for (int dt = 0; dt < 8; ++dt) st[dt] = (f32x4){0.f, 0.f, 0.f, 0.f};
    __syncthreads();
    GLA_ISSUE(0); GLA_COMMIT(0);
    __syncthreads();
#pragma unroll 1
    for (int c = 0; c < nch; ++c) {
        const int buf = c & 1;
        if (c + 1 < nch) GLA_ISSUE(c + 1);
        const unsigned char* QDs = lds + buf * BUF; const unsigned char* KEs = QDs + 16384; const unsigned char* Vs = QDs + 32768;
        const unsigned char* ATs = QDs + 49152; const float* DECs = (const float*)(QDs + 57344);
        bf16x8 vf[2];
#pragma unroll
        for (int jp = 0; jp < 2; ++jp) {
            const int rowA = 32 * jp + 8 * fq + (li >> 2), rowB = rowA + 4;
            const int chunk = 2 * wave + ((li & 3) >> 1), sub = ((li & 3) & 1) * 8;
            const s16x4 va = __builtin_amdgcn_ds_read_tr16_b64_v4i16((LAS s16x4*)(Vs + rowA * 256 + ((chunk ^ (rowA & 15)) << 4) + sub));
            const s16x4 vb = __builtin_amdgcn_ds_read_tr16_b64_v4i16((LAS s16x4*)(Vs + rowB * 256 + ((chunk ^ (rowB & 15)) << 4) + sub));
            vf[jp][0] = va[0]; vf[jp][1] = va[1]; vf[jp][2] = va[2]; vf[jp][3] = va[3]; vf[jp][4] = vb[0]; vf[jp][5] = vb[1]; vf[jp][6] = vb[2]; vf[jp][7] = vb[3];
        }
        bf16x8 sf[4];
#pragma unroll
        for (int dp = 0; dp < 4; ++dp)
#pragma unroll
            for (int jj = 0; jj < 4; ++jj) { sf[dp][jj] = (short)f2bf(st[2 * dp][jj]); sf[dp][4 + jj] = (short)f2bf(st[2 * dp + 1][jj]); }
        f32x4 ot[4];
#pragma unroll
        for (int it = 0; it < 4; ++it) {
            f32x4 acc = (f32x4){0.f, 0.f, 0.f, 0.f};
            const int ir = 16 * it + li;
#pragma unroll
            for (int dp = 0; dp < 4; ++dp) {
                const int c0 = 4 * dp + (fq >> 1), c1 = c0 + 2, sub = (fq & 1) * 8;
                const uint2 lo = *(const uint2*)(QDs + ir * 256 + ((c0 ^ (ir & 15)) << 4) + sub);
                const uint2 hi = *(const uint2*)(QDs + ir * 256 + ((c1 ^ (ir & 15)) << 4) + sub);
                bf16x8 qf;
                qf[0] = (short)(lo.x & 0xffff); qf[1] = (short)(lo.x >> 16); qf[2] = (short)(lo.y & 0xffff); qf[3] = (short)(lo.y >> 16);
                qf[4] = (short)(hi.x & 0xffff); qf[5] = (short)(hi.x >> 16); qf[6] = (short)(hi.y & 0xffff); qf[7] = (short)(hi.y >> 16);
                acc = __builtin_amdgcn_mfma_f32_16x16x32_bf16(sf[dp], qf, acc, 0, 0, 0);
            }
#pragma unroll
            for (int jp = 0; jp < 2; ++jp) {
                if (32 * jp <= 16 * it + 15) {
                    const bf16x8 af = *(const bf16x8*)(ATs + ir * 128 + (((4 * jp + fq) ^ (ir & 7)) << 4));
                    acc = __builtin_amdgcn_mfma_f32_16x16x32_bf16(vf[jp], af, acc, 0, 0, 0);
                }
            }
            ot[it] = acc;
        }
#pragma unroll
        for (int dt = 0; dt < 8; ++dt) {
            const f32x4 dec = *(const f32x4*)(DECs + 16 * dt + 4 * fq);
            f32x4 acc = st[dt] * dec;
#pragma unroll
            for (int jp = 0; jp < 2; ++jp) {
                const int rowA = 32 * jp + 8 * fq + (li >> 2), rowB = rowA + 4;
                const int chunk = 2 * dt + ((li & 3) >> 1), sub = ((li & 3) & 1) * 8;
                const s16x4 ka = __builtin_amdgcn_ds_read_tr16_b64_v4i16((LAS s16x4*)(KEs + rowA * 256 + ((chunk ^ (rowA & 15)) << 4) + sub));
                const s16x4 kb = __builtin_amdgcn_ds_read_tr16_b64_v4i16((LAS s16x4*)(KEs + rowB * 256 + ((chunk ^ (rowB & 15)) << 4) + sub));
                bf16x8 kf;
                kf[0] = ka[0]; kf[1] = ka[1]; kf[2] = ka[2]; kf[3] = ka[3]; kf[4] = kb[0]; kf[5] = kb[1]; kf[6] = kb[2]; kf[7] = kb[3];
                acc = __builtin_amdgcn_mfma_f32_16x16x32_bf16(kf, vf[jp], acc, 0, 0, 0);
            }
            st[dt] = acc;
        }
#pragma unroll
        for (int it = 0; it < 4; ++it) {
            const int i = 16 * it + li;
            const int s = dir ? (Sq - 1 - (64 * c + i)) : (64 * c + i);
            *(uint2*)(Oout + ((size_t)dir * Ttot + tok0 + s) * 1024 + hh * 256 + slice * 128 + 16 * wave + 4 * fq) =
                make_uint2(pack2(ot[it][0], ot[it][1]), pack2(ot[it][2], ot[it][3]));
        }
        if (c + 1 < nch) GLA_COMMIT(buf ^ 1);
        __syncthreads();
    }
}
__device__ __forceinline__ void phase_rope_prep(const Args& a, unsigned char* lds) {
    u16* P = (u16*)(a.ws + WS_P);
    const float2* cs = (const float2*)(a.ws + WS_CS);
    const int gt = blockIdx.x * NTHREADS + threadIdx.x, NT = gridDim.x * NTHREADS;
    for (int i = gt; i < T * 2 * 8 * 8; i += NT) {
        const int f0 = (i & 7) * 8, hh = (i >> 3) & 7, which = (i >> 6) & 1, t = i >> 7;
        u16* p = P + (size_t)t * NP + (which ? C_DK : C_DQ) + hh * 128 + f0;
        const uint4 a1 = *(const uint4*)p, a2 = *(const uint4*)(p + 64);
        const float4* cp = (const float4*)(cs + t * 64 + f0);
        const float4 c0 = cp[0], c1 = cp[1], c2 = cp[2], c3 = cp[3];
        const float x1[8] = {lo2f(a1.x), hi2f(a1.x), lo2f(a1.y), hi2f(a1.y), lo2f(a1.z), hi2f(a1.z), lo2f(a1.w), hi2f(a1.w)};
        const float x2[8] = {lo2f(a2.x), hi2f(a2.x), lo2f(a2.y), hi2f(a2.y), lo2f(a2.z), hi2f(a2.z), lo2f(a2.w), hi2f(a2.w)};
        const float cc[8] = {c0.x, c0.z, c1.x, c1.z, c2.x, c2.z, c3.x, c3.z}, sn[8] = {c0.y, c0.w, c1.y, c1.w, c2.y, c2.w, c3.y, c3.w};
        float y1[8], y2[8];
#pragma unroll
        for (int k = 0; k < 8; ++k) { y1[k] = x1[k] * cc[k] - x2[k] * sn[k]; y2[k] = x1[k] * sn[k] + x2[k] * cc[k]; }
        *(uint4*)p = make_uint4(pack2(y1[0], y1[1]), pack2(y1[2], y1[3]), pack2(y1[4], y1[5]), pack2(y1[6], y1[7]));
        *(uint4*)(p + 64) = make_uint4(pack2(y2[0], y2[1]), pack2(y2[2], y2[3]), pack2(y2[4], y2[5]), pack2(y2[6], y2[7]));
    }
    for (int item = blockIdx.x; item < GLA_NPREP; item += gridDim.x)
        gla_prep_item(P, NP, C_GQ, C_GK, (const float*)(a.ws + WS_GZ), a.wgf, a.bgf, a.wgb, a.bgb, S,
                      a.ws + WS_QD, a.ws + WS_KE, a.ws + WS_AT, (float*)(a.ws + WS_DEC), lds, item);
}

__device__ __forceinline__ void attn_item(const u16* __restrict__ P, int ldp, int cq, int ck, int cv, int Sq,
                                          u16* __restrict__ part_o, float* __restrict__ part_lse, int Ttot,
                                          unsigned char* lds, int item) {
    const int tid = TID, lane = tid & 63, wave = tid >> 6, li = lane & 15, fq = lane >> 4;
    const int nb_per = Sq / 128;
    const int within = item % nb_per, hh = (item / nb_per) & 7, b = (item / (nb_per * 8)) & 3, pat = item / (nb_per * 32);
    const int dil = pat == 0 ? 1 : (pat == 1 ? 4 : 16);
    const int M = Sq / dil;
    const int r = within % dil, blk = within / dil;
    const int p0 = blk * 128, kbase = p0 - 64;
    unsigned char* Ks = lds;
    unsigned char* Vs = lds + 65536;
    const size_t tok0 = (size_t)b * Sq;
    __syncthreads();
#pragma unroll
    for (int i = 0; i < 8; ++i) {
        const int id = tid + 512 * i, row = id >> 4, c = id & 15;
        int kp = kbase + row; kp = kp < 0 ? 0 : (kp > M - 1 ? M - 1 : kp);
        const size_t t = tok0 + r + (size_t)dil * kp;
        const uint4 kv = *(const uint4*)(P + t * ldp + ck + hh * 128 + c * 8);
        const uint4 vv = *(const uint4*)(P + t * ldp + cv + hh * 128 + c * 8);
        const int off = row * 256 + ((c ^ (row & 15)) << 4);
        *(uint4*)(Ks + off) = kv;
        *(uint4*)(Vs + off) = vv;
    }
    const int qp = p0 + 16 * wave + li;
    const size_t tq = tok0 + r + (size_t)dil * qp;
    bf16x8 qf[4];
#pragma unroll
    for (int ks = 0; ks < 4; ++ks) qf[ks] = *(const bf16x8*)(P + tq * ldp + cq + hh * 128 + 32 * ks + 8 * fq);
    __syncthreads();
    const float scale = 0.08838834764831845f;
    float m = -1e30f, l = 0.f;
    f32x4 o[8];
#pragma unroll
    for (int dt = 0; dt < 8; ++dt) o[dt] = (f32x4){0.f, 0.f, 0.f, 0.f};
#pragma unroll 1
    for (int tp = 0; tp < 5; ++tp) {
        float s[8]; bool ok[8];
#pragma unroll
        for (int h2 = 0; h2 < 2; ++h2) {
            const int kk0 = 16 * wave + 16 * (2 * tp + h2);
            int krow = kk0 + li; krow = krow > 255 ? 255 : krow;
            f32x4 acc = (f32x4){0.f, 0.f, 0.f, 0.f};
#pragma unroll
            for (int ks = 0; ks < 4; ++ks) {
                const bf16x8 kf = *(const bf16x8*)(Ks + krow * 256 + (((4 * ks + fq) ^ (krow & 15)) << 4));
                acc = __builtin_amdgcn_mfma_f32_16x16x32_bf16(kf, qf[ks], acc, 0, 0, 0);
            }
#pragma unroll
            for (int j = 0; j < 4; ++j) {
                const int kp = kbase + kk0 + 4 * fq + j;
                const int rel = kp - qp;
                ok[4 * h2 + j] = (kp >= 0) && (kp < M) && (rel <= 64) && (rel >= -64);
                s[4 * h2 + j] = acc[j] * scale;
            }
        }
        float mx = -1e30f;
#pragma unroll
        for (int j = 0; j < 8; ++j) mx = ok[j] ? fmaxf(mx, s[j]) : mx;
        mx = fmaxf(mx, __shfl_xor(mx, 16));
        mx = fmaxf(mx, __shfl_xor(mx, 32));
        const float mn = fmaxf(m, mx);
        const float al = __expf(m - mn);
        float ps = 0.f; float p[8];
#pragma unroll
        for (int j = 0; j < 8; ++j) { p[j] = ok[j] ? __expf(s[j] - mn) : 0.f; ps += p[j]; }
        l = l * al + ps; m = mn;
        bf16x8 pf;
#pragma unroll
        for (int j = 0; j < 8; ++j) pf[j] = (short)f2bf(p[j]);
#pragma unroll
        for (int dt = 0; dt < 8; ++dt) o[dt] *= al;
        int rowA = 16 * wave + 32 * tp + 4 * fq + (li >> 2); rowA = rowA > 255 ? 255 : rowA;
        int rowB = 16 * wave + 32 * tp + 16 + 4 * fq + (li >> 2); rowB = rowB > 255 ? 255 : rowB;
#pragma unroll
        for (int dt = 0; dt < 8; ++dt) {
            const int chunk = 2 * dt + ((li & 3) >> 1), sub = ((li & 3) & 1) * 8;
            const s16x4 va = __builtin_amdgcn_ds_read_tr16_b64_v4i16((LAS s16x4*)(Vs + rowA * 256 + ((chunk ^ (rowA & 15)) << 4) + sub));
            const s16x4 vb = __builtin_amdgcn_ds_read_tr16_b64_v4i16((LAS s16x4*)(Vs + rowB * 256 + ((chunk ^ (rowB & 15)) << 4) + sub));
            bf16x8 vf;
            vf[0] = va[0]; vf[1] = va[1]; vf[2] = va[2]; vf[3] = va[3]; vf[4] = vb[0]; vf[5] = vb[1]; vf[6] = vb[2]; vf[7] = vb[3];
            o[dt] = __builtin_amdgcn_mfma_f32_16x16x32_bf16(vf, pf, o[dt], 0, 0, 0);
        }
    }
    l += __shfl_xor(l, 16);
    l += __shfl_xor(l, 32);
    const float inv = 1.f / l;
    u16* orow = part_o + ((size_t)pat * Ttot + tq) * 1024 + hh * 128 + 4 * fq;
#pragma unroll
    for (int dt = 0; dt < 8; ++dt)
        *(uint2*)(orow + 16 * dt) = make_uint2(pack2(o[dt][0] * inv, o[dt][1] * inv), pack2(o[dt][2] * inv, o[dt][3] * inv));
    if (fq == 0) part_lse[((size_t)pat * Ttot + tq) * 8 + hh] = m + logf(l);
}

__device__ __forceinline__ void attn_merge_token(const u16* __restrict__ part_o, const float* __restrict__ part_lse, int Ttot, size_t t,
                                                 u16* __restrict__ dst  , int lane) {
    const int hh = lane >> 3;
    const float l0 = part_lse[((size_t)0 * Ttot + t) * 8 + hh], l1 = part_lse[((size_t)1 * Ttot + t) * 8 + hh], l2 = part_lse[((size_t)2 * Ttot + t) * 8 + hh];
    const float mx = fmaxf(l0, fmaxf(l1, l2));
    const float e0 = __expf(l0 - mx), e1 = __expf(l1 - mx), e2 = __expf(l2 - mx);
    const float inv = 1.f / (e0 + e1 + e2);
    const float w[3] = {e0 * inv, e1 * inv, e2 * inv};
    float acc[16];
#pragma unroll
    for (int i = 0; i < 16; ++i) acc[i] = 0.f;
#pragma unroll
    for (int p = 0; p < 3; ++p) {
        const uint4* src = (const uint4*)(part_o + ((size_t)p * Ttot + t) * 1024 + lane * 16);
        const uint4 a = src[0], bb = src[1];
        acc[0] += w[p] * lo2f(a.x); acc[1] += w[p] * hi2f(a.x); acc[2] += w[p] * lo2f(a.y); acc[3] += w[p] * hi2f(a.y);
        acc[4] += w[p] * lo2f(a.z); acc[5] += w[p] * hi2f(a.z); acc[6] += w[p] * lo2f(a.w); acc[7] += w[p] * hi2f(a.w);
        acc[8] += w[p] * lo2f(bb.x); acc[9] += w[p] * hi2f(bb.x); acc[10] += w[p] * lo2f(bb.y); acc[11] += w[p] * hi2f(bb.y);
        acc[12] += w[p] * lo2f(bb.z); acc[13] += w[p] * hi2f(bb.z); acc[14] += w[p] * lo2f(bb.w); acc[15] += w[p] * hi2f(bb.w);
    }
    uint4* d = (uint4*)(dst + lane * 16);
    d[0] = make_uint4(pack2(acc[0], acc[1]), pack2(acc[2], acc[3]), pack2(acc[4], acc[5]), pack2(acc[6], acc[7]));
    d[1] = make_uint4(pack2(acc[8], acc[9]), pack2(acc[10], acc[11]), pack2(acc[12], acc[13]), pack2(acc[14], acc[15]));
}

__device__ __forceinline__ void phase_mixers(const Args& a, unsigned char* lds) {
    const int bi = blockIdx.x, G = gridDim.x;
    if (bi < 64) {
        gla_seq_item((const u16*)(a.ws + WS_P), NP, C_GV, S, a.ws + WS_QD, a.ws + WS_KE, a.ws + WS_AT, (const float*)(a.ws + WS_DEC),
                     (u16*)(a.ws + WS_OFB), T, lds, bi);
    } else {
        u16* part_o = (u16*)a.out; float* part_lse = (float*)((unsigned char*)a.out + (size_t)3 * T * 1024 * 2);
        for (int item = bi - 64; item < 3 * 4 * 8 * (S / 128); item += G - 64)
            attn_item((const u16*)(a.ws + WS_P), NP, C_DQ, C_DK, C_DV, S, part_o, part_lse, T, lds, item);
    }
}

__device__ __forceinline__ void phase_gla_fin(const Args& a) {
    const u16* Of = (const u16*)(a.ws + WS_OFB);
    const u16* Ob = Of + (size_t)T * 1024;
    const u16* P = (const u16*)(a.ws + WS_P);
    u16* A2 = (u16*)(a.ws + WS_ACT);
    const int lane = threadIdx.x & 63, wave = threadIdx.x >> 6;
    const int gw = blockIdx.x * NWAVES + wave, NGW = gridDim.x * NWAVES;
    for (int item = gw; item < T * 4; item += NGW) {
        const int hh = item & 3, t = item >> 2;
        const size_t base = (size_t)t * 1024 + hh * 256 + lane * 4;
        const uint2 f = *(const uint2*)(Of + base), bb = *(const uint2*)(Ob + base);
        const float o0 = lo2f(f.x) + lo2f(bb.x), o1 = hi2f(f.x) + hi2f(bb.x), o2 = lo2f(f.y) + lo2f(bb.y), o3 = hi2f(f.y) + hi2f(bb.y);
        const float ss = wave_sum(o0 * o0 + o1 * o1 + o2 * o2 + o3 * o3);
        const float rstd = rsqrtf(ss * (1.f / 256.f) + NORM_EPS);
        const float4 gg = *(const float4*)(a.g_gla + hh * 256 + lane * 4);
        const uint2 rp = *(const uint2*)(P + (size_t)t * NP + C_GR + hh * 256 + lane * 4);
        const float r0 = lo2f(rp.x), r1 = hi2f(rp.x), r2 = lo2f(rp.y), r3 = hi2f(rp.y);
        const float y0 = o0 * rstd * gg.x * silu_f(r0), y1 = o1 * rstd * gg.y * silu_f(r1);
        const float y2 = o2 * rstd * gg.z * silu_f(r2), y3 = o3 * rstd * gg.w * silu_f(r3);
        *(uint2*)(A2 + (size_t)t * D + hh * 256 + lane * 4) = make_uint2(pack2(y0, y1), pack2(y2, y3));
    }
    const u16* part_o = (const u16*)a.out; const float* part_lse = (const float*)((const unsigned char*)a.out + (size_t)3 * T * 1024 * 2);
    for (int t = gw; t < T; t += NGW) attn_merge_token(part_o, part_lse, T, (size_t)t, A2 + (size_t)t * D + 1024, lane);
}

typedef float f32x16 __attribute__((ext_vector_type(16)));
#define RT_CE(a_, b_) do { const float hi_ = fmaxf(a_, b_), lo_ = fminf(a_, b_); a_ = hi_; b_ = lo_; } while (0)
template <int N> __device__ __forceinline__ void rt_sort_desc(float (&v)[N], int base) {
#pragma unroll
    for (int k = 2; k <= 16; k <<= 1)
#pragma unroll
        for (int j = k >> 1; j > 0; j >>= 1)
#pragma unroll
            for (int i = 0; i < 16; ++i) {
                const int l = i ^ j;
                if (l > i) { if ((i & k) == 0) RT_CE(v[base + i], v[base + l]); else RT_CE(v[base + l], v[base + i]); }
            }
}
template <int N> __device__ __forceinline__ void rt_merge_desc(float (&v)[N], int a, int b) {
#pragma unroll
    for (int i = 0; i < 16; ++i) v[a + i] = fmaxf(v[a + i], v[b + 15 - i]);
#pragma unroll
    for (int j = 8; j > 0; j >>= 1)
#pragma unroll
        for (int i = 0; i < 16; ++i) { const int l = i ^ j; if (l > i) RT_CE(v[a + i], v[a + l]); }
}

__device__ __forceinline__ void route_stage_keys(const float* __restrict__ subk, int hh, unsigned char* lds) {
    const int tid = TID;
    __syncthreads();
    for (int e = tid; e < 2 * 128 * 16; e += 512) {
        const int c = e & 15, row = e >> 4;
        const float* src = subk + ((size_t)(hh * 2) * 128 + row) * 128 + c * 8;
        const float4 v0 = *(const float4*)src, v1 = *(const float4*)(src + 4);
        *(uint4*)(lds + row * 256 + ((c ^ (row & 15)) << 4)) = make_uint4(pack2(v0.x, v0.y), pack2(v0.z, v0.w), pack2(v1.x, v1.y), pack2(v1.z, v1.w));
    }
    __syncthreads();
}

__device__ __forceinline__ void route_tile(const u16* __restrict__ Q, int ldq, int hh, int tok_base, const unsigned char* lds,
                                           int* __restrict__ IDX, float* __restrict__ GATE) {
    const int lane = TID & 63, r = lane & 31, h = lane >> 5;
    float sc[128];
    {
        f32x16 X[4], Y[4];
#pragma unroll
        for (int kt = 0; kt < 4; ++kt) {
#pragma unroll
            for (int i = 0; i < 16; ++i) { X[kt][i] = 0.f; Y[kt][i] = 0.f; }
        }
        const u16* qrow = Q + (size_t)(tok_base + r) * ldq + hh * 256;
#pragma unroll
        for (int half = 0; half < 2; ++half) {
            bf16x8 qf[8];
#pragma unroll
            for (int ks = 0; ks < 8; ++ks) qf[ks] = *(const bf16x8*)(qrow + half * 128 + 16 * ks + 8 * h);
#pragma unroll
            for (int kt = 0; kt < 4; ++kt) {
                const int krow = half * 128 + 32 * kt + r;
#pragma unroll
                for (int ks = 0; ks < 8; ++ks) {
                    const bf16x8 kf = *(const bf16x8*)(lds + krow * 256 + (((2 * ks + h) ^ (krow & 15)) << 4));
                    if (half == 0) X[kt] = __builtin_amdgcn_mfma_f32_32x32x16_bf16(kf, qf[ks], X[kt], 0, 0, 0);
                    else Y[kt] = __builtin_amdgcn_mfma_f32_32x32x16_bf16(kf, qf[ks], Y[kt], 0, 0, 0);
                }
            }
        }
#pragma unroll
        for (int kt = 0; kt < 4; ++kt)
#pragma unroll
            for (int i = 0; i < 16; ++i) {
                const auto sw = __builtin_amdgcn_permlane32_swap(__float_as_uint(X[kt][i]), __float_as_uint(Y[kt][i]), false, false);
                const int key0 = 32 * kt + (i & 3) + 8 * (i >> 2);
                sc[kt * 32 + i] = __uint_as_float((sw[0] & 0xffffff80u) | (unsigned)key0);
                sc[kt * 32 + 16 + i] = __uint_as_float((sw[1] & 0xffffff80u) | (unsigned)(key0 + 4));
            }
    }
#pragma unroll
    for (int g = 0; g < 8; ++g) rt_sort_desc(sc, 16 * g);
    rt_merge_desc(sc, 0, 16); rt_merge_desc(sc, 32, 48); rt_merge_desc(sc, 64, 80); rt_merge_desc(sc, 96, 112);
    rt_merge_desc(sc, 0, 32); rt_merge_desc(sc, 64, 96);
    rt_merge_desc(sc, 0, 64);
    float l0[16], l1[16];
#pragma unroll
    for (int i = 0; i < 16; ++i) {
        const auto sw = __builtin_amdgcn_permlane32_swap(__float_as_uint(sc[i]), __float_as_uint(sc[i]), false, false);
        l0[i] = __uint_as_float(sw[0]); l1[i] = __uint_as_float(sw[1]);
    }
    float s0[16], s1[16]; int k0[16], k1[16];
#pragma unroll
    for (int i = 0; i < 16; ++i) {
        const unsigned a = __float_as_uint(l0[i]), b = __float_as_uint(l1[i]);
        s0[i] = __uint_as_float(a & 0xffffff80u); k0[i] = (int)(a & 0x7fu);
        s1[i] = __uint_as_float(b & 0xffffff80u); k1[i] = (int)(b & 0x7fu);
    }
    float cs[64];
    {
        int n = 0;
#pragma unroll
        for (int i = 0; i < 16; ++i)
#pragma unroll
            for (int j = 0; j < 16; ++j)
                if ((i + 1) * (j + 1) <= 16) { cs[n] = s0[i] + s1[j]; ++n; }
#pragma unroll
        for (int q = 50; q < 64; ++q) cs[q] = -3.0e38f;
    }
    float ct[64];
#pragma unroll
    for (int q = 0; q < 64; ++q) ct[q] = cs[q];
#pragma unroll
    for (int g = 0; g < 4; ++g) rt_sort_desc(ct, 16 * g);
    rt_merge_desc(ct, 0, 16); rt_merge_desc(ct, 32, 48); rt_merge_desc(ct, 0, 32);
    const float theta = ct[15], smax = ct[0];
    float den = 0.f;
    {
        int cnt = 0;
#pragma unroll
        for (int q = 0; q < 50; ++q) { const bool sel = (cs[q] >= theta) && (cnt < 16); den += sel ? __expf(cs[q] - smax) : 0.f; cnt += sel ? 1 : 0; }
    }
    const float inv = 1.f / den;
    const size_t obase = (size_t)(tok_base + r) * 128 + hh * 16;
    int pos = 0;
    {
        int n = 0;
#pragma unroll
        for (int i = 0; i < 16; ++i)
#pragma unroll
            for (int j = 0; j < 16; ++j)
                if ((i + 1) * (j + 1) <= 16) {
                    const bool sel = (cs[n] >= theta) && (pos < 16);
                    if (sel) {
                        if (h == 0) IDX[obase + pos] = k0[i] * 128 + k1[j];
                        else GATE[obase + pos] = __expf(cs[n] - smax) * inv;
                        ++pos;
                    }
                    ++n;
                }
    }
}
__device__ __forceinline__ void phase_route(const Args& a, unsigned char* lds) {
    const int hh = BID & 7, grp = BID >> 3, ngrp = GDIM >> 3, wave = TID >> 6;
    route_stage_keys(a.subk, hh, lds);
    int j = 0;
    for (int tile = grp; tile < T / 32; tile += ngrp, ++j)
        if ((j & 7) == wave) route_tile((const u16*)(a.ws + WS_Q), D, hh, tile * 32, lds, (int*)(a.ws + WS_IDX), (float*)(a.ws + WS_GATE));
    __syncthreads();
}

typedef __bf16 bf16x2_t __attribute__((ext_vector_type(2)));
__device__ __forceinline__ float dot2bf(unsigned w, unsigned x, float acc) {
    return __builtin_amdgcn_fdot2_f32_bf16(__builtin_bit_cast(bf16x2_t, w), __builtin_bit_cast(bf16x2_t, x), acc, false);
}
constexpr int TROW = 1152;
typedef float f32x2_t __attribute__((ext_vector_type(2)));
__device__ __forceinline__ void convert_tables(const Args& a) {
    const int lane = threadIdx.x & 63, wave = threadIdx.x >> 6;
    const int gw = blockIdx.x * NWAVES + wave, NGW = gridDim.x * NWAVES;
    for (int row = gw; row < 2 * 16384; row += NGW) {
        const bool isv = row >= 16384; const int e = isv ? row - 16384 : row;
        const f32x4* sp = (const f32x4*)((isv ? a.pv : a.pu) + (size_t)e * D + lane * 32);
        f32x4 v[8]; float mx = 0.f;
#pragma unroll
        for (int k = 0; k < 8; ++k) { v[k] = __builtin_nontemporal_load(sp + k);
            mx = fmaxf(mx, fmaxf(fmaxf(fabsf(v[k][0]), fabsf(v[k][1])), fmaxf(fabsf(v[k][2]), fabsf(v[k][3])))); }
        float s = mx * (1.f / 6.f); s = (s > 0.f) ? s : 1.f;
        const u16 sb = f2bf(s); const float sr = bf2f(sb); const float inv = 1.f / sr;
        unsigned w[4];
#pragma unroll
        for (int k = 0; k < 4; ++k) {
            unsigned p = 0u;
            p = __builtin_amdgcn_cvt_scalef32_pk_fp4_f32(p, v[2 * k][0] * inv, v[2 * k][1] * inv, 1.0f, 0);
            p = __builtin_amdgcn_cvt_scalef32_pk_fp4_f32(p, v[2 * k][2] * inv, v[2 * k][3] * inv, 1.0f, 1);
            p = __builtin_amdgcn_cvt_scalef32_pk_fp4_f32(p, v[2 * k + 1][0] * inv, v[2 * k + 1][1] * inv, 1.0f, 2);
            p = __builtin_amdgcn_cvt_scalef32_pk_fp4_f32(p, v[2 * k + 1][2] * inv, v[2 * k + 1][3] * inv, 1.0f, 3);
            w[k] = p;
        }
        unsigned char* dst = a.ws + (isv ? WS_TV : WS_TU) + (size_t)e * TROW;
        *(uint4*)(dst + lane * 16) = make_uint4(w[0], w[1], w[2], w[3]);
        *(u16*)(dst + 1024 + lane * 2) = sb;
    }
}

__device__ __forceinline__ float dot32_fp4(const uint4 w, const float (&h)[32], float acc) {
    const unsigned ww[4] = {w.x, w.y, w.z, w.w};
#pragma unroll
    for (int k = 0; k < 4; ++k) {
        const f32x2_t a0 = __builtin_amdgcn_cvt_scalef32_pk_f32_fp4(ww[k], 1.0f, 0), a1 = __builtin_amdgcn_cvt_scalef32_pk_f32_fp4(ww[k], 1.0f, 1);
        const f32x2_t a2 = __builtin_amdgcn_cvt_scalef32_pk_f32_fp4(ww[k], 1.0f, 2), a3 = __builtin_amdgcn_cvt_scalef32_pk_f32_fp4(ww[k], 1.0f, 3);
        acc += a0.x * h[8 * k + 0] + a0.y * h[8 * k + 1] + a1.x * h[8 * k + 2] + a1.y * h[8 * k + 3] + a2.x * h[8 * k + 4] + a2.y * h[8 * k + 5] + a3.x * h[8 * k + 6] + a3.y * h[8 * k + 7];
    }
    return acc;
}
__device__ __forceinline__ void axpy32_fp4(const uint4 w, const float s, float (&acc)[32]) {
    const unsigned ww[4] = {w.x, w.y, w.z, w.w};
#pragma unroll
    for (int k = 0; k < 4; ++k) {
        const f32x2_t a0 = __builtin_amdgcn_cvt_scalef32_pk_f32_fp4(ww[k], 1.0f, 0), a1 = __builtin_amdgcn_cvt_scalef32_pk_f32_fp4(ww[k], 1.0f, 1);
        const f32x2_t a2 = __builtin_amdgcn_cvt_scalef32_pk_f32_fp4(ww[k], 1.0f, 2), a3 = __builtin_amdgcn_cvt_scalef32_pk_f32_fp4(ww[k], 1.0f, 3);
        acc[8 * k + 0] += s * a0.x; acc[8 * k + 1] += s * a0.y; acc[8 * k + 2] += s * a1.x; acc[8 * k + 3] += s * a1.y;
        acc[8 * k + 4] += s * a2.x; acc[8 * k + 5] += s * a2.y; acc[8 * k + 6] += s * a3.x; acc[8 * k + 7] += s * a3.y;
    }
}
__device__ __forceinline__ void phase_experts(const Args& a) {
    const u16* H2 = (const u16*)(a.ws + WS_ACT);
    const float* X1 = (const float*)(a.ws + WS_X1);
    const int* IDX = (const int*)(a.ws + WS_IDX);
    const float* GATE = (const float*)(a.ws + WS_GATE);
    const float* mod = (const float*)(a.ws + WS_MOD);
    const unsigned char* U = a.ws + WS_TU; const unsigned char* V = a.ws + WS_TV;
    const int lane = threadIdx.x & 63, wave = threadIdx.x >> 6;
    const int gw = blockIdx.x * NWAVES + wave, NGW = gridDim.x * NWAVES;
    for (int t = gw; t < T; t += NGW) {
        const int b = t / S;
        float h[32], acc[32];
        {
            const uint4* hp = (const uint4*)(H2 + (size_t)t * D + lane * 32);
#pragma unroll
            for (int k = 0; k < 4; ++k) { const uint4 p = hp[k];
                h[8 * k + 0] = lo2f(p.x); h[8 * k + 1] = hi2f(p.x); h[8 * k + 2] = lo2f(p.y); h[8 * k + 3] = hi2f(p.y);
                h[8 * k + 4] = lo2f(p.z); h[8 * k + 5] = hi2f(p.z); h[8 * k + 6] = lo2f(p.w); h[8 * k + 7] = hi2f(p.w); }
#pragma unroll
            for (int i = 0; i < 32; ++i) acc[i] = 0.f;
        }
        const int iv0 = IDX[(size_t)t * 128 + lane], iv1 = IDX[(size_t)t * 128 + 64 + lane];
        const float gv0 = GATE[(size_t)t * 128 + lane], gv1 = GATE[(size_t)t * 128 + 64 + lane];
        uint4 uA[4], vA[4], uB[4], vB[4]; u16 suA[4], svA[4], suB[4], svB[4];
#define EXP_LOAD(u_, v_, su_, sv_, r0_) do { _Pragma("unroll") for (int q = 0; q < 4; ++q) { \
            const int rr_ = (r0_) + q; const int e_ = __builtin_amdgcn_readlane(rr_ < 64 ? iv0 : iv1, rr_ & 63); \
            const unsigned char* up_ = U + (size_t)e_ * TROW; const unsigned char* vp_ = V + (size_t)e_ * TROW; \
            u_[q] = *(const uint4*)(up_ + lane * 16); su_[q] = *(const u16*)(up_ + 1024 + lane * 2); \
            v_[q] = *(const uint4*)(vp_ + lane * 16); sv_[q] = *(const u16*)(vp_ + 1024 + lane * 2); } } while (0)
#define EXP_COMPUTE(u_, v_, su_, sv_, r0_) do { float d_[4]; \
            _Pragma("unroll") for (int q = 0; q < 4; ++q) d_[q] = dot32_fp4(u_[q], h, 0.f) * bf2f(su_[q]); \
            _Pragma("unroll") for (int o = 32; o > 0; o >>= 1) { _Pragma("unroll") for (int q = 0; q < 4; ++q) d_[q] += __shfl_xor(d_[q], o); } \
            _Pragma("unroll") for (int q = 0; q < 4; ++q) { const int rr_ = (r0_) + q; \
                const float g_ = __builtin_bit_cast(float, __builtin_amdgcn_readlane(__builtin_bit_cast(int, rr_ < 64 ? gv0 : gv1), rr_ & 63)); \
                const float w_ = g_ * gelu_f(d_[q]) * bf2f(sv_[q]); axpy32_fp4(v_[q], w_, acc); } } while (0)
        EXP_LOAD(uA, vA, suA, svA, 0);
#pragma unroll 1
        for (int r0 = 0; r0 < 128; r0 += 8) {
            EXP_LOAD(uB, vB, suB, svB, r0 + 4);
            EXP_COMPUTE(uA, vA, suA, svA, r0);
            if (r0 + 8 < 128) EXP_LOAD(uA, vA, suA, svA, r0 + 8);
            EXP_COMPUTE(uB, vB, suB, svB, r0 + 4);
        }
#undef EXP_LOAD
#undef EXP_COMPUTE
        float ss = 0.f;
#pragma unroll
        for (int k = 0; k < 8; ++k) {
            const int c0 = lane * 32 + 4 * k;
            const float4 xa = *(const float4*)(X1 + (size_t)t * D + c0);
            const float4 ga = *(const float4*)(mod + b * 12288 + 5 * 2048 + c0);
            acc[4 * k + 0] = xa.x + ga.x * acc[4 * k + 0]; acc[4 * k + 1] = xa.y + ga.y * acc[4 * k + 1];
            acc[4 * k + 2] = xa.z + ga.z * acc[4 * k + 2]; acc[4 * k + 3] = xa.w + ga.w * acc[4 * k + 3];
#pragma unroll
            for (int i = 0; i < 4; ++i) ss += acc[4 * k + i] * acc[4 * k + i];
        }
        ss = wave_sum(ss);
        const float rstd = rsqrtf(ss * (1.f / D) + NORM_EPS);
#pragma unroll
        for (int k = 0; k < 8; ++k) {
            const int c0 = lane * 32 + 4 * k;
            const float4 gf = *(const float4*)(a.g_fin + c0);
            *(float4*)(a.out + (size_t)t * D + c0) = make_float4(acc[4 * k + 0] * rstd * gf.x, acc[4 * k + 1] * rstd * gf.y, acc[4 * k + 2] * rstd * gf.z, acc[4 * k + 3] * rstd * gf.w);
        }
    }
}

#define XB_TMO      128
#define XB_XCNT(j)  (256  + 64 * (j))
#define XB_XSUB(j)  (1280 + 64 * (j))
#define XB_XGEN(j)  (2304 + 64 * (j))
#define XB_TOP      3328
#define XB_TOPGEN   3392
#define XCD_BAR_WORDS 3456
#define XB_SPIN_CAP (1u << 18)

__device__ __forceinline__ unsigned xb_ld(unsigned* p)              { return __hip_atomic_load(p, __ATOMIC_RELAXED, __HIP_MEMORY_SCOPE_AGENT); }
__device__ __forceinline__ unsigned xb_add(unsigned* p, unsigned v) { return __hip_atomic_fetch_add(p, v, __ATOMIC_RELAXED, __HIP_MEMORY_SCOPE_AGENT); }
__device__ __forceinline__ unsigned xb_xcc_id() { return (unsigned)__builtin_amdgcn_s_getreg((3 << 11) | 20) & 0xFu; }
#define XB_SPIN(cond, bar) do { unsigned _sp = 0; while (cond) { __builtin_amdgcn_s_sleep(1); \
    if ((++_sp & 255u) == 0u) { if (xb_ld(&(bar)[XB_TMO])) break; if (_sp > XB_SPIN_CAP) { atomicAdd(&(bar)[XB_TMO], 1u); break; } } } } while (0)

struct XcdBarrier {
    unsigned* bar; unsigned x;
    volatile LAS unsigned* st;
};

__device__ __forceinline__ XcdBarrier xcd_barrier_post(unsigned* bar, volatile LAS unsigned* st) {
    XcdBarrier b; b.bar = bar; b.x = xb_xcc_id(); b.st = st;
    if (threadIdx.x == 0) (void)xb_add(&bar[XB_XCNT(b.x)], 1u);
    return b;
}
__device__ __forceinline__ void xcd_barrier_complete(unsigned* bar, unsigned x, unsigned& nloc, unsigned& nx) {
    const unsigned G = gridDim.x * gridDim.y * gridDim.z;
    unsigned sum, cnt, mine, sp = 0u;
    for (;;) {
        sum = 0u; cnt = 0u; mine = 0u;
#pragma unroll
        for (unsigned j = 0; j < 16; ++j) { const unsigned c = xb_ld(&bar[XB_XCNT(j)]); sum += c; cnt += (c > 0u) ? 1u : 0u; mine = (j == x) ? c : mine; }
        if (sum == G) break;
        __builtin_amdgcn_s_sleep(1);
        if ((++sp & 255u) == 0u) { if (xb_ld(&bar[XB_TMO])) break; if (sp > XB_SPIN_CAP) { atomicAdd(&bar[XB_TMO], 1u); break; } }
    }
    nloc = mine > 0u ? mine : 1u; nx = cnt > 0u ? cnt : 1u;
}

__device__ __forceinline__ void xcd_barrier(const XcdBarrier& b) {
    asm volatile("s_waitcnt vmcnt(0)" ::: "memory");
    __syncthreads();
    if (threadIdx.x == 0) {
        unsigned* bar = b.bar;
        __builtin_amdgcn_s_waitcnt(0);
        unsigned nloc = b.st[0], nx = b.st[1];
        if (nloc == 0u) { xcd_barrier_complete(bar, b.x, nloc, nx); b.st[0] = nloc; b.st[1] = nx; }
        const unsigned old = xb_add(&bar[XB_XSUB(b.x)], 1u);
        const unsigned gen = old / nloc;
        if (old + 1u == (gen + 1u) * nloc) {
            __builtin_amdgcn_fence(__ATOMIC_RELEASE, "agent");
            asm volatile("s_waitcnt vmcnt(0)" ::: "memory");
            const unsigned og = xb_add(&bar[XB_TOP], 1u);
            const unsigned tg = og / nx;
            if (og + 1u == (tg + 1u) * nx) xb_add(&bar[XB_TOPGEN], 1u);
            else XB_SPIN(xb_ld(&bar[XB_TOPGEN]) == tg, bar);
            __builtin_amdgcn_fence(__ATOMIC_ACQUIRE, "agent");
            xb_add(&bar[XB_XGEN(b.x)], 1u);
            asm volatile("s_waitcnt vmcnt(0)" ::: "memory");
        } else {
            XB_SPIN(xb_ld(&bar[XB_XGEN(b.x)]) == gen, bar);
            __builtin_amdgcn_fence(__ATOMIC_ACQUIRE, "agent");
            asm volatile("s_waitcnt vmcnt(0)" ::: "memory");
        }
    }
    __syncthreads();
}

constexpr int NPHASES = 11;
__global__ void __launch_bounds__(NTHREADS, 2) mk_fwd(Args a) {
    extern __shared__ __attribute__((aligned(16))) unsigned char lds[];
    cg::grid_group grid = cg::this_grid();
    const int lo = a.ph_lo, hi = a.ph_hi;
    volatile LAS unsigned* xbw = (volatile LAS unsigned*)(lds + LDS_MAIN);
    if (threadIdx.x < 4) xbw[threadIdx.x] = 0u;
    __syncthreads();
    XcdBarrier xbar = xcd_barrier_post((unsigned*)(a.ws + WS_CTL), xbw);
#define IN(k) (lo <= (k) && (k) < hi)
#define SEAM(k) do { if (IN(k) && IN((k) + 1)) { if ((k) == 0) grid.sync(); else xcd_barrier(xbar); } } while (0)
    const float* mod = (const float*)(a.ws + WS_MOD);
    if (IN(0)) phase0(a, lds);
    SEAM(0);
    if (IN(1)) norm_mod_phase(a.x, a.g_mix, mod, 0, 1, (u16*)(a.ws + WS_ACT));
    SEAM(1);
    if (IN(2)) { gemm8(lds, (const u16*)(a.ws + WS_ACT), (const u16*)(a.ws + WS_WIN), T, NP, D, EpiProj{(u16*)(a.ws + WS_P)}); gz_phase(lds, (const u16*)(a.ws + WS_ACT), (const u16*)(a.ws + WS_WIN) + (size_t)NP * D, (float*)(a.ws + WS_GZ)); }
    SEAM(2);
    if (IN(3)) phase_rope_prep(a, lds);
    SEAM(3);
    if (IN(4)) phase_mixers(a, lds);
    SEAM(4);
    if (IN(5)) phase_gla_fin(a);
    SEAM(5);
    if (IN(6)) gemm8(lds, (const u16*)(a.ws + WS_ACT), (const u16*)(a.ws + WS_WOUT), T, D, D, EpiResid{a.x, mod, (float*)(a.ws + WS_X1)});
    SEAM(6);
    if (IN(7)) { norm_mod_phase((const float*)(a.ws + WS_X1), a.g_ffn, mod, 3, 4, (u16*)(a.ws + WS_ACT)); convert_tables(a); }
    SEAM(7);
    if (IN(8)) gemm8(lds, (const u16*)(a.ws + WS_ACT), (const u16*)(a.ws + WS_WPQ), T, D, D, EpiBf16{(u16*)(a.ws + WS_Q)});
    SEAM(8);
    if (IN(9)) phase_route(a, lds);
    SEAM(9);
    if (IN(10)) phase_experts(a);
#ifdef PROBE_REP10
    grid.sync(); phase_experts(a);
#endif
#ifdef PROBE_REP9
    grid.sync(); phase_route(a, lds); grid.sync(); phase_experts(a);
#endif
#undef IN
#undef SEAM
}

#ifndef MK_ONE_LAUNCH
#define MK_ONE_LAUNCH 1
#endif
extern "C" void kernel_launch(void* const* d_in, const int* in_sizes, int n_in, void* d_out, int out_size, void* d_ws, size_t ws_size, hipStream_t stream) {
    static int grid = 0;
    if (grid == 0) {
        if (n_in != 19 || out_size != T * D || ws_size < WS_END) {
            fprintf(stderr, "kernel_launch: unexpected shapes: n_in %d out %d ws %zu (need %zu)\n", n_in, out_size, ws_size, (size_t)WS_END);
            grid = -1; return;
        }
        int dev = 0, cus = 0, per_cu = 0;
        (void)hipGetDevice(&dev);
        (void)hipDeviceGetAttribute(&cus, hipDeviceAttributeMultiprocessorCount, dev);
        (void)hipFuncSetAttribute((const void*)mk_fwd, hipFuncAttributeMaxDynamicSharedMemorySize, LDS_BYTES);
        (void)hipOccupancyMaxActiveBlocksPerMultiprocessor(&per_cu, (const void*)mk_fwd, NTHREADS, LDS_BYTES);
        if (per_cu < 1) { fprintf(stderr, "kernel_launch: occupancy query says %d blocks/CU\n", per_cu); grid = -1; return; }
        grid = cus;
        (void)hipGetLastError();
    }
    if (grid < 0) return;
    Args a{};
    a.x = (const float*)d_in[0]; a.c = (const float*)d_in[1]; a.pos = (const int*)d_in[2]; a.w_ada = (const float*)d_in[3];
    a.b_ada = (const float*)d_in[4]; a.g_mix = (const float*)d_in[5]; a.w_in = (const float*)d_in[6]; a.wgf = (const float*)d_in[7];
    a.bgf = (const float*)d_in[8]; a.wgb = (const float*)d_in[9]; a.bgb = (const float*)d_in[10]; a.g_gla = (const float*)d_in[11];
    a.w_out = (const float*)d_in[12]; a.g_ffn = (const float*)d_in[13]; a.w_pq = (const float*)d_in[14]; a.subk = (const float*)d_in[15];
    a.pu = (const float*)d_in[16]; a.pv = (const float*)d_in[17]; a.g_fin = (const float*)d_in[18];
    a.out = (float*)d_out; a.ws = (unsigned char*)d_ws;
#if MK_ONE_LAUNCH
    (void)hipMemsetAsync((unsigned char*)d_ws + WS_CTL, 0, XCD_BAR_WORDS * 4, stream);
    a.ph_lo = 0; a.ph_hi = NPHASES;
    void* args[] = {&a};
    hipError_t e = hipLaunchCooperativeKernel((const void*)mk_fwd, dim3(grid), dim3(NTHREADS), args, LDS_BYTES, stream);
    if (e != hipSuccess) fprintf(stderr, "cooperative launch failed: %s (grid %d)\n", hipGetErrorString(e), grid);
#else
    for (int p = 0; p < NPHASES; ++p) {
        a.ph_lo = p; a.ph_hi = p + 1;
        hipLaunchKernelGGL(mk_fwd, dim3(grid), dim3(NTHREADS), LDS_BYTES, stream, a);
    }
#endif
}
```

```cpp
#include <hip/hip_runtime.h>
#include <hip/hip_cooperative_groups.h>
#include <cstdio>
#include <cstdint>

namespace cg = cooperative_groups;

typedef unsigned short u16;
typedef __attribute__((ext_vector_type(8))) short bf16x8;
typedef __attribute__((ext_vector_type(4))) float f32x4;
typedef short s16x4 __attribute__((ext_vector_type(4)));
#define TID ((int)threadIdx.x)
#define BID ((int)blockIdx.x)
#define GDIM ((int)gridDim.x)
#define LAS __attribute__((address_space(3)))

constexpr int D = 2048, NB = 4, S = 4096, T = NB * S;
constexpr int INW = 6176;
constexpr int NP = 6144;
constexpr int NPAD = 6208;
constexpr int C_GQ = 0, C_GK = 512, C_GV = 1024, C_GR = 2048, C_DQ = 3072, C_DK = 4096, C_DV = 5120;
constexpr int NTHREADS = 512, NWAVES = 8;
constexpr int LDS_MAIN = 128 * 1024;
constexpr int LDS_BYTES = LDS_MAIN + 16;
constexpr float NORM_EPS = 1e-6f;

constexpr size_t WS_CTL = 0;
constexpr size_t WS_MOD = 65536;
constexpr size_t WS_CS = 524288;
constexpr size_t WS_WIN = WS_CS + (size_t)T * 64 * 8;
constexpr size_t WS_WOUT = WS_WIN + (size_t)NPAD * D * 2;
constexpr size_t WS_WPQ = WS_WOUT + (size_t)D * D * 2;
constexpr size_t WS_ACT = WS_WPQ + (size_t)D * D * 2;
constexpr size_t WS_P = WS_ACT + (size_t)T * D * 2;
constexpr size_t WS_X1 = WS_P;
constexpr size_t WS_Q = WS_P + (size_t)T * D * 4;
constexpr size_t WS_GZ = WS_P + (size_t)T * NP * 2;
constexpr int GLA_NPREP = NB * 4 * 2 * (S / 64);
constexpr size_t WS_QD = WS_GZ + (size_t)T * 32 * 4;
constexpr size_t WS_KE = WS_QD + (size_t)GLA_NPREP * 16384;
constexpr size_t WS_AT = WS_KE + (size_t)GLA_NPREP * 16384;
constexpr size_t WS_DEC = WS_AT + (size_t)GLA_NPREP * 8192;
constexpr size_t WS_OFB = WS_DEC + (size_t)GLA_NPREP * 512;
constexpr size_t WS_IDX = WS_OFB + (size_t)2 * T * 1024 * 2;
constexpr size_t WS_GATE = WS_IDX + (size_t)T * 128 * 4;
constexpr size_t WS_END = WS_GATE + (size_t)T * 128 * 4;
constexpr size_t WS_TU = WS_QD;
constexpr size_t WS_TV = WS_QD + (size_t)16384 * 1152;
static_assert(WS_TV + (size_t)16384 * 1152 <= WS_IDX, "table region");

struct Args {
    const float* x; const float* c; const int* pos; const float* w_ada; const float* b_ada; const float* g_mix;
    const float* w_in; const float* wgf; const float* bgf; const float* wgb; const float* bgb; const float* g_gla;
    const float* w_out; const float* g_ffn; const float* w_pq; const float* subk; const float* pu; const float* pv; const float* g_fin;
    float* out; unsigned char* ws; int ph_lo, ph_hi;
};

__device__ __forceinline__ float bf2f(u16 h) { return __uint_as_float(((unsigned)h) << 16); }
__device__ __forceinline__ u16 f2bf(float f) { unsigned u = __float_as_uint(f); u += 0x7fffu + ((u >> 16) & 1u); return (u16)(u >> 16); }
__device__ __forceinline__ unsigned pack2(float a, float b) { return (unsigned)f2bf(a) | ((unsigned)f2bf(b) << 16); }
__device__ __forceinline__ float lo2f(unsigned p) { return __uint_as_float(p << 16); }
__device__ __forceinline__ float hi2f(unsigned p) { return __uint_as_float(p & 0xffff0000u); }
__device__ __forceinline__ float wave_sum(float v) {
#pragma unroll
    for (int o = 32; o > 0; o >>= 1) v += __shfl_xor(v, o);
    return v;
}
__device__ __forceinline__ float wave_max(float v) {
#pragma unroll
    for (int o = 32; o > 0; o >>= 1) v = fmaxf(v, __shfl_xor(v, o));
    return v;
}
__device__ __forceinline__ float silu_f(float v) { return v / (1.f + __expf(-v)); }
__device__ __forceinline__ float gelu_f(float a) { return 0.5f * a * (1.f + erff(a * 0.70710678118654752f)); }
__device__ __forceinline__ float logsigmoid_f(float z) { return z < 0.f ? z - log1pf(expf(z)) : -log1pf(expf(-z)); }

__device__ __forceinline__ void p0_mod(const Args& a, unsigned char* lds, int bi) {
    float* sc = (float*)lds;
    float* red = sc + 4 * 2048;
    const int tid = threadIdx.x, lane = tid & 63, wave = tid >> 6;
    for (int i = tid; i < 4 * 2048; i += NTHREADS) sc[i] = silu_f(a.c[i]);
    __syncthreads();
    const int j0 = bi * 256 + lane * 4;
    float acc[4][4];
#pragma unroll
    for (int b = 0; b < 4; ++b)
#pragma unroll
        for (int q = 0; q < 4; ++q) acc[b][q] = 0.f;
    const int k0 = wave * 256;
#pragma unroll 4
    for (int kk = 0; kk < 256; ++kk) {
        const int k = k0 + kk;
        const float4 w = *(const float4*)(a.w_ada + (size_t)k * 12288 + j0);
#pragma unroll
        for (int b = 0; b < 4; ++b) {
            const float s = sc[b * 2048 + k];
            acc[b][0] += s * w.x; acc[b][1] += s * w.y; acc[b][2] += s * w.z; acc[b][3] += s * w.w;
        }
    }
#pragma unroll
    for (int b = 0; b < 4; ++b)
#pragma unroll
        for (int q = 0; q < 4; ++q) red[(wave * 4 + b) * 256 + lane * 4 + q] = acc[b][q];
    __syncthreads();
    float* mod = (float*)(a.ws + WS_MOD);
    for (int i = tid; i < 4 * 256; i += NTHREADS) {
        const int b = i >> 8, jc = i & 255;
        float s = 0.f;
#pragma unroll
        for (int w = 0; w < 8; ++w) s += red[(w * 4 + b) * 256 + jc];
        mod[b * 12288 + bi * 256 + jc] = s + a.b_ada[bi * 256 + jc];
    }
    __syncthreads();
}

__device__ __forceinline__ void p0_transpose_item(const float* __restrict__ W, int ldw, int k0, int src_col0, int n_valid,
                                                  u16* __restrict__ WT, int ldt, int n_out0, unsigned char* lds) {
    u16* tl = (u16*)lds;
    const int tid = threadIdx.x;
    {
        const int k = tid >> 3, nc = (tid & 7) * 8;
        float v[8];
        if (nc < n_valid) {
            const float4 v0 = *(const float4*)(W + (size_t)(k0 + k) * ldw + src_col0 + nc);
            const float4 v1 = *(const float4*)(W + (size_t)(k0 + k) * ldw + src_col0 + nc + 4);
            v[0] = v0.x; v[1] = v0.y; v[2] = v0.z; v[3] = v0.w; v[4] = v1.x; v[5] = v1.y; v[6] = v1.z; v[7] = v1.w;
        } else {
#pragma unroll
            for (int i = 0; i < 8; ++i) v[i] = 0.f;
        }
#pragma unroll
        for (int i = 0; i < 8; ++i) tl[(nc + i) * 72 + k] = f2bf(v[i]);
    }
    __syncthreads();
    {
        const int n = tid >> 3, kc = (tid & 7) * 8;
        const uint4 v = *(const uint4*)(tl + n * 72 + kc);
        *(uint4*)(WT + (size_t)(n_out0 + n) * ldt + k0 + kc) = v;
    }
    __syncthreads();
}

__device__ __forceinline__ void phase0(const Args& a, unsigned char* lds) {
    const int bi = blockIdx.x, G = gridDim.x, tid = threadIdx.x;
    if (bi < 48) p0_mod(a, lds, bi);
    constexpr int I_IN = 32 * (NPAD / 64), I_SQ = 32 * 32;
    u16* WinT = (u16*)(a.ws + WS_WIN); u16* WoutT = (u16*)(a.ws + WS_WOUT); u16* WpqT = (u16*)(a.ws + WS_WPQ);
    for (int it = bi; it < I_IN + 2 * I_SQ; it += G) {
        if (it < I_IN) {
            const int kt = it & 31, nt = it >> 5;
            const int n0 = nt * 64;
            int src, nv;
            if (n0 < 3072) { src = n0; nv = 64; }
            else if (n0 < 6144) { src = n0 + 32; nv = 64; }
            else if (n0 == 6144) { src = 3072; nv = 32; }
            else { src = 0; nv = 0; }
            p0_transpose_item(a.w_in, INW, kt * 64, src, nv, WinT, D, n0, lds);
        } else if (it < I_IN + I_SQ) {
            const int r = it - I_IN; const int kt = r & 31, nt = r >> 5;
            p0_transpose_item(a.w_out, D, kt * 64, nt * 64, 64, WoutT, D, nt * 64, lds);
        } else {
            const int r = it - I_IN - I_SQ; const int kt = r & 31, nt = r >> 5;
            p0_transpose_item(a.w_pq, D, kt * 64, nt * 64, 64, WpqT, D, nt * 64, lds);
        }
    }
    float2* cs = (float2*)(a.ws + WS_CS);
    for (int i = bi * NTHREADS + tid; i < T * 64; i += G * NTHREADS) {
        const int t = i >> 6, f = i & 63;
        const float inv_freq = powf(10000.0f, -(float)f * 2.0f / 128.0f);
        const float ang = (float)a.pos[t] * inv_freq;
        const double rev = (double)ang * 0.15915494309189533577;
        const float fr = (float)(rev - floor(rev));
        cs[i] = make_float2(__builtin_amdgcn_cosf(fr), __builtin_amdgcn_sinf(fr));
    }
}

__device__ __forceinline__ void norm_mod_phase(const float* __restrict__ xin, const float* __restrict__ g, const float* __restrict__ mod,
                                               int sh_chunk, int sc_chunk, u16* __restrict__ outp) {
    const int lane = threadIdx.x & 63, wave = threadIdx.x >> 6;
    const int gw = blockIdx.x * NWAVES + wave, NGW = gridDim.x * NWAVES;
    for (int t = gw; t < T; t += NGW) {
        const int b = t / S;
        const float4* xr = (const float4*)(xin + (size_t)t * D);
        float4 v[8]; float ss = 0.f;
#pragma unroll
        for (int m = 0; m < 8; ++m) { v[m] = xr[lane + 64 * m]; ss += v[m].x * v[m].x + v[m].y * v[m].y + v[m].z * v[m].z + v[m].w * v[m].w; }
        ss = wave_sum(ss);
        const float rstd = rsqrtf(ss * (1.f / D) + NORM_EPS);
        const float4* gp = (const float4*)g;
        const float4* shp = (const float4*)(mod + b * 12288 + sh_chunk * 2048);
        const float4* scp = (const float4*)(mod + b * 12288 + sc_chunk * 2048);
        uint2* op = (uint2*)(outp + (size_t)t * D);
#pragma unroll
        for (int m = 0; m < 8; ++m) {
            const int i = lane + 64 * m;
            const float4 gg = gp[i], sh = shp[i], sc = scp[i];
            const float h0 = v[m].x * rstd * gg.x * (1.f + sc.x) + sh.x;
            const float h1 = v[m].y * rstd * gg.y * (1.f + sc.y) + sh.y;
            const float h2 = v[m].z * rstd * gg.z * (1.f + sc.z) + sh.z;
            const float h3 = v[m].w * rstd * gg.w * (1.f + sc.w) + sh.w;
            op[i] = make_uint2(pack2(h0, h1), pack2(h2, h3));
        }
    }
}

namespace pg8 {
#define PG8_LAS __attribute__((address_space(3)))
typedef unsigned short bf16_t;
typedef short bf16x8 __attribute__((ext_vector_type(8)));
typedef float f32x4 __attribute__((ext_vector_type(4)));
typedef unsigned u32x4 __attribute__((ext_vector_type(4)));
constexpr int BM = 256, BK = 64, HALF = 128, HTB = HALF * BK * 2  , STAGE_BYTES = 8 * HTB, NXCD = 8, WGM = 8;

__host__ __device__ __forceinline__ int lds_byte(int r, int c) { const int st = (r >> 4) * 2 + (c >> 5), rr = r & 15, cc = c & 31, ob = rr * 64 + cc * 2; return st * 1024 + (ob ^ (((ob >> 9) & 1) << 5)); }
__host__ __device__ __forceinline__ void stage_rc(int b, int& R, int& C) { const int st = b / 1024, sb = b % 1024, swz = sb ^ (((sb >> 9) & 1) << 5); R = (st >> 1) * 16 + swz / 64; C = (st & 1) * 32 + (swz % 64) / 2; }
__host__ __device__ __forceinline__ int perm32(int rho) { const int n = rho >> 4, i = rho & 15; return 8 * (i >> 2) + 4 * n + (i & 3); }

struct Unit { int pm, pn; };
struct Gemm { const bf16_t* A; const bf16_t* Bt; int M, N, K; };

struct StaticOrder {
    int nM, nN, nwg, G, c;
    __host__ __device__ void init(int M, int N, int G_, int c_) { nM = M / BM; nN = N / BM; nwg = nM * nN; G = G_; c = c_; }
    __host__ __device__ bool next(int i, Unit& u) const {
        const long L = (long)i * G + c; if (L >= nwg) return false;
        int wgid = (int)L; { const int q = nwg / NXCD, r = nwg % NXCD, xcd = wgid % NXCD, off = wgid / NXCD; wgid = (xcd < r ? xcd * (q + 1) : r * (q + 1) + (xcd - r) * q) + off; }
        const int nig = WGM * nN, gid = wgid / nig, fm = gid * WGM, gsz = (nM - fm) < WGM ? (nM - fm) : WGM;
        u.pm = fm + ((wgid % nig) % gsz); u.pn = (wgid % nig) / gsz; return true;
    }
    __device__ __forceinline__ void a_ready(const Unit&) const {}
    __device__ __forceinline__ void done(const Unit&) const {}
};
__device__ __forceinline__ unsigned cvt_pk_bf16(float lo, float hi) { unsigned r; asm volatile("v_cvt_pk_bf16_f32 %0, %1, %2" : "=v"(r) : "v"(lo), "v"(hi)); return r; }
typedef float f32x2 __attribute__((ext_vector_type(2)));
template <class Epi, class Sched, bool STAMP = false>
__device__ __forceinline__ void gemm_phase(PG8_LAS unsigned char* lds, const Gemm g, const Sched& S, const Epi& E, unsigned long long* stamps) {
    const int tid = threadIdx.x, wid = __builtin_amdgcn_readfirstlane(tid >> 6), lane = tid & 63, wr = wid >> 2, wc = wid & 3, fr = lane & 15, fq = lane >> 4;
    const int K = g.K, nt = K / BK;
    int ts_lo = 0, ts_hi = 0, nts = 0; const unsigned long long rt_entry = STAMP ? (unsigned long long)wall_clock64() : 0ull;
#define PG8_STAMP() do { if (STAMP && wid == 0 && nts < 64) { const unsigned long long _c = (unsigned long long)clock64(); \
        ts_lo = (lane == nts) ? (int)(unsigned)_c : ts_lo; ts_hi = (lane == nts) ? (int)(unsigned)(_c >> 32) : ts_hi; ++nts; } } while (0)
    PG8_STAMP();
    unsigned voffA[2], voffB[2];
#pragma unroll
    for (int i = 0; i < 2; ++i) { int R, C; stage_rc(tid * 16 + i * 8192, R, C); const int Rb = Epi::PERM ? ((R & ~31) + perm32(R & 31)) : R;
        voffA[i] = (unsigned)(R * K + C) * 2u; voffB[i] = (unsigned)(Rb * K + C) * 2u; }
    const size_t kstep = (size_t)(BK * 2);
    const size_t hstep = (size_t)HALF * K * 2;
    const size_t tstep = 2 * hstep;
    const unsigned ldsw = (unsigned)wid * 1024u;
    const int aoff = lds_byte(wr * 64 + fr, fq * 8), boff = lds_byte(wc * 32 + fr, fq * 8);
#define PG8_SA(b, h) (((b) * 2 + (h)) * HTB)
#define PG8_SB(b, h) ((4 + (b) * 2 + (h)) * HTB)
#define PG8_STAGE(bufoff, gbase, voff) do { _Pragma("unroll") for (int _i = 0; _i < 2; ++_i) \
        __builtin_amdgcn_global_load_lds((const unsigned*)((const char*)(gbase) + (voff)[_i]), (PG8_LAS unsigned*)(lds + (bufoff) + ldsw + _i * 8192), 16, 0, 0); } while (0)
#define PG8_LDA(dst, b, h) do { _Pragma("unroll") for (int m = 0; m < 4; ++m) _Pragma("unroll") for (int k = 0; k < 2; ++k) dst[m][k] = *(const PG8_LAS bf16x8*)(lds + PG8_SA(b, h) + aoff + m * 2048 + k * 1024); } while (0)
#define PG8_LDB(dst, b, h) do { _Pragma("unroll") for (int n = 0; n < 2; ++n) _Pragma("unroll") for (int k = 0; k < 2; ++k) dst[n][k] = *(const PG8_LAS bf16x8*)(lds + PG8_SB(b, h) + boff + n * 2048 + k * 1024); } while (0)
#define PG8_MMA(ai, bj, At, Bt) do { __builtin_amdgcn_s_setprio(1); _Pragma("unroll") for (int m = 0; m < 4; ++m) _Pragma("unroll") for (int n = 0; n < 2; ++n) _Pragma("unroll") for (int k = 0; k < 2; ++k) \
        acc[ai][bj][m][n] = __builtin_amdgcn_mfma_f32_16x16x32_bf16(Bt[n][k], At[m][k], acc[ai][bj][m][n], 0, 0, 0); __builtin_amdgcn_s_setprio(0); } while (0)
#define PG8_WAIT_V(n) asm volatile("s_waitcnt vmcnt(" #n ")" ::: "memory")
#define PG8_WAIT_L(n) asm volatile("s_waitcnt lgkmcnt(" #n ")" ::: "memory")
#define PG8_BAR __builtin_amdgcn_s_barrier()
#define PG8_SCHED __builtin_amdgcn_sched_barrier(0)
    Unit cur, nxt; int ui = 0;
    if (!S.next(0, cur)) return;
    f32x4 acc[2][2][4][2];
#pragma unroll
    for (int a = 0; a < 2; ++a)
#pragma unroll
        for (int b = 0; b < 2; ++b)
#pragma unroll
            for (int m = 0; m < 4; ++m)
#pragma unroll
                for (int n = 0; n < 2; ++n) acc[a][b][m][n] = (f32x4){0.f, 0.f, 0.f, 0.f};
    bf16x8 At[4][2], B0[2][2], B1[2][2];
    const char* cA = (const char*)g.A + (size_t)cur.pm * tstep; const char* cB = (const char*)g.Bt + (size_t)cur.pn * tstep;
    S.a_ready(cur);
    PG8_STAGE(PG8_SB(0, 0), cB, voffB); PG8_STAGE(PG8_SA(0, 0), cA, voffA); PG8_STAGE(PG8_SB(0, 1), cB + hstep, voffB); PG8_STAGE(PG8_SA(0, 1), cA + hstep, voffA);
    if (wr == 1) PG8_BAR;
    PG8_WAIT_V(4); PG8_BAR;
    PG8_STAGE(PG8_SB(1, 0), cB + kstep, voffB); PG8_STAGE(PG8_SA(1, 0), cA + kstep, voffA); PG8_STAGE(PG8_SB(1, 1), cB + hstep + kstep, voffB);
    PG8_WAIT_V(6); PG8_BAR;
    PG8_STAMP();
    for (;;) {
        const bool has_next = S.next(ui + 1, nxt);
        const char* nA = has_next ? (const char*)g.A + (size_t)nxt.pm * tstep : cA; const char* nB = has_next ? (const char*)g.Bt + (size_t)nxt.pn * tstep : cB;
        for (int t = 0; t < nt; t += 2) {
            const bool last = (t == nt - 2);
            const char* a1 = cA + (size_t)(t + 1) * kstep;
            const char* a2 = last ? nA : cA + (size_t)(t + 2) * kstep; const char* b2 = last ? nB : cB + (size_t)(t + 2) * kstep;
            const char* a3 = a2 + kstep; const char* b3 = b2 + kstep;
            if (last && has_next) S.a_ready(nxt);
            PG8_LDB(B0, 0, 0); PG8_SCHED; PG8_LDA(At, 0, 0); PG8_STAGE(PG8_SA(1, 1), a1 + hstep, voffA);
            PG8_WAIT_L(8); PG8_BAR; PG8_WAIT_L(0); PG8_MMA(0, 0, At, B0); PG8_BAR; PG8_SCHED;
            PG8_LDB(B1, 0, 1); PG8_STAGE(PG8_SB(0, 0), b2, voffB);
            PG8_BAR; PG8_WAIT_L(0); PG8_MMA(0, 1, At, B1); PG8_BAR;
            PG8_LDA(At, 0, 1); PG8_STAGE(PG8_SA(0, 0), a2, voffA);
            PG8_BAR; PG8_WAIT_L(0); PG8_MMA(1, 0, At, B0); PG8_BAR; PG8_SCHED;
            PG8_STAGE(PG8_SB(0, 1), b2 + hstep, voffB);
            PG8_WAIT_V(6); PG8_BAR; PG8_MMA(1, 1, At, B1); PG8_BAR;
            PG8_LDB(B0, 1, 0); PG8_SCHED; PG8_LDA(At, 1, 0); PG8_STAGE(PG8_SA(0, 1), a2 + hstep, voffA);
            PG8_WAIT_L(8); PG8_BAR; PG8_WAIT_L(0); PG8_MMA(0, 0, At, B0); PG8_BAR; PG8_SCHED;
            PG8_LDB(B1, 1, 1); PG8_STAGE(PG8_SB(1, 0), b3, voffB);
            PG8_BAR; PG8_WAIT_L(0); PG8_MMA(0, 1, At, B1); PG8_BAR;
            PG8_LDA(At, 1, 1); PG8_STAGE(PG8_SA(1, 0), a3, voffA);
            PG8_BAR; PG8_WAIT_L(0); PG8_MMA(1, 0, At, B0); PG8_BAR; PG8_SCHED;
            PG8_STAGE(PG8_SB(1, 1), b3 + hstep, voffB);
            PG8_WAIT_V(6); PG8_BAR; PG8_MMA(1, 1, At, B1); PG8_BAR;
        }
        PG8_STAMP();
        if constexpr (!Epi::AFTER_DRAIN) { E(acc, cur, wr, wc, fr, fq); S.done(cur); }
        PG8_STAMP();
        if (!has_next) break;
#pragma unroll
        for (int a = 0; a < 2; ++a)
#pragma unroll
            for (int b = 0; b < 2; ++b)
#pragma unroll
                for (int m = 0; m < 4; ++m)
#pragma unroll
                    for (int n = 0; n < 2; ++n) acc[a][b][m][n] = (f32x4){0.f, 0.f, 0.f, 0.f};
        cur = nxt; cA = nA; cB = nB; ++ui;
    }
    PG8_WAIT_V(0);
    if (wr == 0) PG8_BAR;
    PG8_BAR;
    if constexpr (Epi::AFTER_DRAIN) { E.fused(acc, cur, wr, wc, fr, fq, lds, wid, lane); S.done(cur); }
    PG8_STAMP();
    if (STAMP && wid == 0) { stamps[lane] = lane < nts ? (((unsigned long long)(unsigned)ts_hi << 32) | (unsigned)ts_lo) : 0ull;
        if (lane == 62) stamps[62] = rt_entry; if (lane == 63) stamps[63] = (unsigned long long)wall_clock64(); }
#undef PG8_STAMP
#undef PG8_SA
#undef PG8_SB
#undef PG8_STAGE
#undef PG8_LDA
#undef PG8_LDB
#undef PG8_MMA
#undef PG8_WAIT_V
#undef PG8_WAIT_L
#undef PG8_BAR
#undef PG8_SCHED
}
}

struct EpiProj {
    static constexpr bool PERM = true, AFTER_DRAIN = false;
    u16* P;
    __device__ __forceinline__ void operator()(const pg8::f32x4 (&acc)[2][2][4][2], const pg8::Unit& u, int wr, int wc, int fr, int fq) const {
        const int row0 = u.pm * 256 + wr * 64 + fr;
        const int col0 = u.pn * 256 + wc * 32 + 8 * fq;
#pragma unroll
        for (int ai = 0; ai < 2; ++ai)
#pragma unroll
            for (int m = 0; m < 4; ++m) { u16* rowp = P + (size_t)(row0 + ai * 128 + m * 16) * NP + col0;
#pragma unroll
                for (int bj = 0; bj < 2; ++bj) { const pg8::f32x4 v0 = acc[ai][bj][m][0], v1 = acc[ai][bj][m][1];
                    pg8::u32x4 w; w.x = pg8::cvt_pk_bf16(v0[0], v0[1]); w.y = pg8::cvt_pk_bf16(v0[2], v0[3]); w.z = pg8::cvt_pk_bf16(v1[0], v1[1]); w.w = pg8::cvt_pk_bf16(v1[2], v1[3]);
                    *(pg8::u32x4*)(rowp + bj * 128) = w; } }
    }
};
__device__ __forceinline__ void gz_phase(unsigned char* lds, const u16* __restrict__ H1, const u16* __restrict__ Wg, float* __restrict__ gz) {
    const int tid = threadIdx.x, lane = tid & 63, wave = tid >> 6, fr = lane & 15, fq = lane >> 4;
    float* red = (float*)lds;
    for (int rb = blockIdx.x; rb < T / 64; rb += gridDim.x) {
        const int r0 = rb * 64, k0 = wave * 256;
        f32x4 acc[4][2];
#pragma unroll
        for (int m = 0; m < 4; ++m) { acc[m][0] = (f32x4){0.f, 0.f, 0.f, 0.f}; acc[m][1] = (f32x4){0.f, 0.f, 0.f, 0.f}; }
#pragma unroll
        for (int ks = 0; ks < 8; ++ks) {
            bf16x8 af[4], bfr[2];
#pragma unroll
            for (int m = 0; m < 4; ++m) af[m] = *(const bf16x8*)(H1 + (size_t)(r0 + 16 * m + fr) * D + k0 + 32 * ks + 8 * fq);
#pragma unroll
            for (int n = 0; n < 2; ++n) bfr[n] = *(const bf16x8*)(Wg + (size_t)(16 * n + fr) * D + k0 + 32 * ks + 8 * fq);
#pragma unroll
            for (int m = 0; m < 4; ++m)
#pragma unroll
                for (int n = 0; n < 2; ++n) acc[m][n] = __builtin_amdgcn_mfma_f32_16x16x32_bf16(af[m], bfr[n], acc[m][n], 0, 0, 0);
        }
        __syncthreads();
#pragma unroll
        for (int m = 0; m < 4; ++m)
#pragma unroll
            for (int n = 0; n < 2; ++n)
#pragma unroll
                for (int j = 0; j < 4; ++j) red[(wave * 64 + 16 * m + 4 * fq + j) * 32 + 16 * n + fr] = acc[m][n][j];
        __syncthreads();
#pragma unroll
        for (int k = 0; k < 4; ++k) {
            const int e = tid + 512 * k;
            float s = 0.f;
#pragma unroll
            for (int w = 0; w < 8; ++w) s += red[w * 2048 + e];
            gz[(size_t)r0 * 32 + e] = s;
        }
    }
    __syncthreads();
}
struct EpiResid {
    static constexpr bool PERM = false, AFTER_DRAIN = false;
    const float* x; const float* mod; float* x1;
    __device__ __forceinline__ void operator()(const pg8::f32x4 (&acc)[2][2][4][2], const pg8::Unit& u, int wr, int wc, int fr, int fq) const {
        const int row0 = u.pm * 256 + wr * 64 + fr, col0 = u.pn * 256 + wc * 32 + 4 * fq;
        const int b = (u.pm * 256) / S;
        pg8::f32x4 ga[2][2];
#pragma unroll
        for (int bj = 0; bj < 2; ++bj)
#pragma unroll
            for (int n = 0; n < 2; ++n) ga[bj][n] = *(const pg8::f32x4*)(mod + b * 12288 + 2 * 2048 + col0 + bj * 128 + n * 16);
#pragma unroll
        for (int ai = 0; ai < 2; ++ai)
#pragma unroll
            for (int m = 0; m < 4; ++m) { const size_t off = (size_t)(row0 + ai * 128 + m * 16) * D + col0;
#pragma unroll
                for (int bj = 0; bj < 2; ++bj)
#pragma unroll
                    for (int n = 0; n < 2; ++n) { const pg8::f32x4 xv = *(const pg8::f32x4*)(x + off + bj * 128 + n * 16);
                        *(pg8::f32x4*)(x1 + off + bj * 128 + n * 16) = xv + ga[bj][n] * acc[ai][bj][m][n]; } }
    }
};
struct EpiBf16 {
    static constexpr bool PERM = true, AFTER_DRAIN = false;
    u16* Q;
    __device__ __forceinline__ void operator()(const pg8::f32x4 (&acc)[2][2][4][2], const pg8::Unit& u, int wr, int wc, int fr, int fq) const {
        const int row0 = u.pm * 256 + wr * 64 + fr, col0 = u.pn * 256 + wc * 32 + 8 * fq;
#pragma unroll
        for (int ai = 0; ai < 2; ++ai)
#pragma unroll
            for (int m = 0; m < 4; ++m) { u16* rowp = Q + (size_t)(row0 + ai * 128 + m * 16) * D + col0;
#pragma unroll
                for (int bj = 0; bj < 2; ++bj) { const pg8::f32x4 v0 = acc[ai][bj][m][0], v1 = acc[ai][bj][m][1];
                    pg8::u32x4 w; w.x = pg8::cvt_pk_bf16(v0[0], v0[1]); w.y = pg8::cvt_pk_bf16(v0[2], v0[3]); w.z = pg8::cvt_pk_bf16(v1[0], v1[1]); w.w = pg8::cvt_pk_bf16(v1[2], v1[3]);
                    *(pg8::u32x4*)(rowp + bj * 128) = w; } }
    }
};
template <class Epi>
__device__ __forceinline__ void gemm8(unsigned char* lds, const u16* A, const u16* Bt, int M, int N, int K, const Epi& E) {
    pg8::Gemm g{A, Bt, M, N, K}; pg8::StaticOrder So; So.init(M, N, (int)gridDim.x, (int)blockIdx.x);
    pg8::gemm_phase<Epi, pg8::StaticOrder, false>((PG8_LAS unsigned char*)lds, g, So, E, nullptr);
    __syncthreads();
}

#define GLA_QD_BYTES 16384
#define GLA_AT_BYTES 8192
__device__ __forceinline__ float gla_logsigmoid(float z) { return z < 0.f ? z - log1pf(expf(z)) : -log1pf(expf(-z)); }

__device__ __forceinline__ void gla_prep_item(const u16* __restrict__ P, int ldp, int cq, int ck, const float* __restrict__ gz,
                                              const float* __restrict__ wg_f, const float* __restrict__ bg_f, const float* __restrict__ wg_b, const float* __restrict__ bg_b,
                                              int Sq, unsigned char* __restrict__ QDg, unsigned char* __restrict__ KEg, unsigned char* __restrict__ ATg, float* __restrict__ DECg,
                                              unsigned char* lds, int item) {
    const int nch = Sq / 64;
    const int c = item % nch, dir = (item / nch) & 1, hh = (item / (nch * 2)) & 3, b = item / (nch * 8);
    const int tid = TID, lane = tid & 63, wave = tid >> 6, li = lane & 15, fq = lane >> 4;
    float* gzs = (float*)lds;
    float* segs = gzs + 64 * 16;
    unsigned char* QDs = lds + 8192;
    unsigned char* KIs = QDs + 16384;
    unsigned char* KEs = KIs + 16384;
    float* bmat = (float*)(KEs + 16384);
    const size_t tok0 = (size_t)b * Sq;
    __syncthreads();
    uint4 rq0, rq1, rk0, rk1;
    {
        const int i0 = tid >> 4, i1 = (tid + 512) >> 4, cc = tid & 15;
        const int s0 = dir ? (Sq - 1 - (64 * c + i0)) : (64 * c + i0), s1 = dir ? (Sq - 1 - (64 * c + i1)) : (64 * c + i1);
        rq0 = *(const uint4*)(P + (tok0 + s0) * ldp + cq + hh * 128 + cc * 8); rk0 = *(const uint4*)(P + (tok0 + s0) * ldp + ck + hh * 128 + cc * 8);
        rq1 = *(const uint4*)(P + (tok0 + s1) * ldp + cq + hh * 128 + cc * 8); rk1 = *(const uint4*)(P + (tok0 + s1) * ldp + ck + hh * 128 + cc * 8);
    }
    for (int e = tid; e < 64 * 16; e += 512) {
        const int i = e >> 4, r = e & 15;
        const int s = dir ? (Sq - 1 - (64 * c + i)) : (64 * c + i);
        gzs[e] = gz[(tok0 + s) * 32 + dir * 16 + r];
    }
    const int d = tid & 127, seg = tid >> 7;
    const float* wg = dir ? wg_b : wg_f;
    float wcol[16];
#pragma unroll
    for (int r = 0; r < 16; ++r) wcol[r] = wg[r * 512 + hh * 128 + d];
    const float bias = (dir ? bg_b : bg_f)[hh * 128 + d];
    __syncthreads();
    float run = 0.f;
#pragma unroll
    for (int k = 0; k < 16; ++k) {
        const int i = 16 * seg + k;
        float z = bias;
#pragma unroll
        for (int r = 0; r < 16; ++r) z += gzs[i * 16 + r] * wcol[r];
        run += gla_logsigmoid(z) * (1.f / 16.f);
        bmat[i * 128 + d] = run;
    }
    segs[seg * 128 + d] = run;
    __syncthreads();
    if (seg == 0) {
        const float t0 = segs[d], t1 = segs[128 + d], t2 = segs[256 + d], t3 = segs[384 + d];
        segs[d] = 0.f; segs[128 + d] = t0; segs[256 + d] = t0 + t1; segs[384 + d] = t0 + t1 + t2; segs[512 + d] = t0 + t1 + t2 + t3;
        DECg[(size_t)item * 128 + d] = __expf(t0 + t1 + t2 + t3);
    }
    __syncthreads();
    const float qscale = 0.08838834764831845f;
#pragma unroll
    for (int k = 0; k < 2; ++k) {
        const int id = tid + 512 * k, i = id >> 4, cc = id & 15, d0 = cc * 8, sg = i >> 4;
        const uint4 qv = k ? rq1 : rq0, kv = k ? rk1 : rk0;
        const float qx[8] = {lo2f(qv.x), hi2f(qv.x), lo2f(qv.y), hi2f(qv.y), lo2f(qv.z), hi2f(qv.z), lo2f(qv.w), hi2f(qv.w)};
        const float kx[8] = {lo2f(kv.x), hi2f(kv.x), lo2f(kv.y), hi2f(kv.y), lo2f(kv.z), hi2f(kv.z), lo2f(kv.w), hi2f(kv.w)};
        float qd[8], ki[8], ke[8];
#pragma unroll
        for (int e = 0; e < 8; ++e) {
            const float bb = bmat[i * 128 + d0 + e] + segs[sg * 128 + d0 + e], tot = segs[512 + d0 + e];
            qd[e] = qx[e] * qscale * __expf(bb); ki[e] = kx[e] * __expf(-bb); ke[e] = kx[e] * __expf(tot - bb);
        }
        const int o = i * 256 + ((cc ^ (i & 15)) << 4);
        *(uint4*)(QDs + o) = make_uint4(pack2(qd[0], qd[1]), pack2(qd[2], qd[3]), pack2(qd[4], qd[5]), pack2(qd[6], qd[7]));
        *(uint4*)(KIs + o) = make_uint4(pack2(ki[0], ki[1]), pack2(ki[2], ki[3]), pack2(ki[4], ki[5]), pack2(ki[6], ki[7]));
        *(uint4*)(KEs + o) = make_uint4(pack2(ke[0], ke[1]), pack2(ke[2], ke[3]), pack2(ke[4], ke[5]), pack2(ke[6], ke[7]));
    }
    __syncthreads();
    {
        uint4* qo = (uint4*)(QDg + (size_t)item * GLA_QD_BYTES); uint4* ko = (uint4*)(KEg + (size_t)item * GLA_QD_BYTES);
#pragma unroll
        for (int k = 0; k < 2; ++k) { const int e = tid + 512 * k; qo[e] = ((const uint4*)QDs)[e]; ko[e] = ((const uint4*)KEs)[e]; }
    }
#pragma unroll
    for (int tt = 0; tt < 2; ++tt) {
        const int tile = wave + 8 * tt, jt = tile >> 2, it = tile & 3;
        f32x4 acc = (f32x4){0.f, 0.f, 0.f, 0.f};
        if (jt <= it) {
            const int jr = 16 * jt + li, ir = 16 * it + li;
#pragma unroll
            for (int ks = 0; ks < 4; ++ks) {
                const bf16x8 kf = *(const bf16x8*)(KIs + jr * 256 + (((4 * ks + fq) ^ (jr & 15)) << 4));
                const bf16x8 qf = *(const bf16x8*)(QDs + ir * 256 + (((4 * ks + fq) ^ (ir & 15)) << 4));
                acc = __builtin_amdgcn_mfma_f32_16x16x32_bf16(kf, qf, acc, 0, 0, 0);
            }
        }
        const int i = 16 * it + li, j0 = 16 * jt + 4 * fq;
        float v[4];
#pragma unroll
        for (int jj = 0; jj < 4; ++jj) v[jj] = (j0 + jj <= i) ? acc[jj] : 0.f;
        const int chunk = 2 * jt + (fq >> 1), sub = (fq & 1) * 8;
        *(uint2*)(ATg + (size_t)item * GLA_AT_BYTES + i * 128 + ((chunk ^ (i & 7)) << 4) + sub) = make_uint2(pack2(v[0], v[1]), pack2(v[2], v[3]));
    }
}

__device__ __forceinline__ void gla_seq_item(const u16* __restrict__ P, int ldp, int cv, int Sq,
                                             const unsigned char* __restrict__ QDg, const unsigned char* __restrict__ KEg, const unsigned char* __restrict__ ATg, const float* __restrict__ DECg,
                                             u16* __restrict__ Oout  , int Ttot, unsigned char* lds, int item) {
    const int slice = item & 1, dir = (item >> 1) & 1, hh = (item >> 2) & 3, b = item >> 4;
    const int nch = Sq / 64;
    const int tid = TID, lane = tid & 63, wave = tid >> 6, li = lane & 15, fq = lane >> 4;
    const size_t tok0 = (size_t)b * Sq;
    const int pitem0 = ((b * 4 + hh) * 2 + dir) * nch;
    constexpr int BUF = 16384 * 3 + 8192 + 512;
    typedef unsigned gla_u32x4 __attribute__((ext_vector_type(4)));
    gla_u32x4 rq0, rq1, rk0, rk1, rv0, rv1, ra; float rd = 0.f;
#define GLA_VROW(c_, k_) ((tok0 + (size_t)(dir ? (Sq - 1 - (64 * (c_) + ((tid + 512 * (k_)) >> 4))) : (64 * (c_) + ((tid + 512 * (k_)) >> 4)))) * ldp + cv + hh * 256 + slice * 128 + ((tid + 512 * (k_)) & 15) * 8)
#define GLA_ISSUE(c_) do { \
        const gla_u32x4* qsrc_ = (const gla_u32x4*)(QDg + (size_t)(pitem0 + (c_)) * GLA_QD_BYTES); const gla_u32x4* ksrc_ = (const gla_u32x4*)(KEg + (size_t)(pitem0 + (c_)) * GLA_QD_BYTES); \
        rq0 = qsrc_[tid]; rq1 = qsrc_[tid + 512]; rk0 = ksrc_[tid]; rk1 = ksrc_[tid + 512]; \
        ra = ((const gla_u32x4*)(ATg + (size_t)(pitem0 + (c_)) * GLA_AT_BYTES))[tid]; \
        rv0 = *(const gla_u32x4*)(P + GLA_VROW(c_, 0)); rv1 = *(const gla_u32x4*)(P + GLA_VROW(c_, 1)); \
        if (tid < 128) rd = DECg[(size_t)(pitem0 + (c_)) * 128 + tid]; } while (0)
#define GLA_COMMIT(buf_) do { \
        unsigned char* base_ = lds + (buf_) * BUF; \
        ((gla_u32x4*)base_)[tid] = rq0; ((gla_u32x4*)base_)[tid + 512] = rq1; ((gla_u32x4*)(base_ + 16384))[tid] = rk0; ((gla_u32x4*)(base_ + 16384))[tid + 512] = rk1; \
        { const int row_ = tid >> 4, ch_ = tid & 15; *(gla_u32x4*)(base_ + 32768 + row_ * 256 + ((ch_ ^ (row_ & 15)) << 4)) = rv0; } \
        { const int row_ = (tid + 512) >> 4, ch_ = tid & 15; *(gla_u32x4*)(base_ + 32768 + row_ * 256 + ((ch_ ^ (row_ & 15)) << 4)) = rv1; } \
        ((gla_u32x4*)(base_ + 49152))[tid] = ra; \
        if (tid < 128) ((float*)(base_ + 57344))[tid] = rd; } while (0)
    f32x4 st[8];
#pragma unroll
    for (int dt = 0; dt < 8; ++dt) st[dt] = (f32x4){0.f, 0.f, 0.f, 0.f};
    __syncthreads();
    GLA_ISSUE(0); GLA_COMMIT(0);
    __syncthreads();
#pragma unroll 1
    for (int c = 0; c < nch; ++c) {
        const int buf = c & 1;
        if (c + 1 < nch) GLA_ISSUE(c + 1);
        const unsigned char* QDs = lds + buf * BUF; const unsigned char* KEs = QDs + 16384; const unsigned char* Vs = QDs + 32768;
        const unsigned char* ATs = QDs + 49152; const float* DECs = (const float*)(QDs + 57344);
        bf16x8 vf[2];
#pragma unroll
        for (int jp = 0; jp < 2; ++jp) {
            const int rowA = 32 * jp + 8 * fq + (li >> 2), rowB = rowA + 4;
            const int chunk = 2 * wave + ((li & 3) >> 1), sub = ((li & 3) & 1) * 8;
            const s16x4 va = __builtin_amdgcn_ds_read_tr16_b64_v4i16((LAS s16x4*)(Vs + rowA * 256 + ((chunk ^ (rowA & 15)) << 4) + sub));
            const s16x4 vb = __builtin_amdgcn_ds_read_tr16_b64_v4i16((LAS s16x4*)(Vs + rowB * 256 + ((chunk ^ (rowB & 15)) << 4) + sub));
            vf[jp][0] = va[0]; vf[jp][1] = va[1]; vf[jp][2] = va[2]; vf[jp][3] = va[3]; vf[jp][4] = vb[0]; vf[jp][5] = vb[1]; vf[jp][6] = vb[2]; vf[jp][7] = vb[3];
        }
        bf16x8 sf[4];
#pragma unroll
        for (int dp = 0; dp < 4; ++dp)
#pragma unroll
            for (int jj = 0; jj < 4; ++jj) { sf[dp][jj] = (short)f2bf(st[2 * dp][jj]); sf[dp][4 + jj] = (short)f2bf(st[2 * dp + 1][jj]); }
        f32x4 ot[4];
#pragma unroll
        for (int it = 0; it < 4; ++it) {
            f32x4 acc = (f32x4){0.f, 0.f, 0.f, 0.f};
            const int ir = 16 * it + li;
#pragma unroll
            for (int dp = 0; dp < 4; ++dp) {
                const int c0 = 4 * dp + (fq >> 1), c1 = c0 + 2, sub = (fq & 1) * 8;
                const uint2 lo = *(const uint2*)(QDs + ir * 256 + ((c0 ^ (ir & 15)) << 4) + sub);
                const uint2 hi = *(const uint2*)(QDs + ir * 256 + ((c1 ^ (ir & 15)) << 4) + sub);
                bf16x8 qf;
                qf[0] = (short)(lo.x & 0xffff); qf[1] = (short)(lo.x >> 16); qf[2] = (short)(lo.y & 0xffff); qf[3] = (short)(lo.y >> 16);
                qf[4] = (short)(hi.x & 0xffff); qf[5] = (short)(hi.x >> 16); qf[6] = (short)(hi.y & 0xffff); qf[7] = (short)(hi.y >> 16);
                acc = __builtin_amdgcn_mfma_f32_16x16x32_bf16(sf[dp], qf, acc, 0, 0, 0);
            }
#pragma unroll
            for (int jp = 0; jp < 2; ++jp) {
                if (32 * jp <= 16 * it + 15) {
                    const bf16x8 af = *(const bf16x8*)(ATs + ir * 128 + (((4 * jp + fq) ^ (ir & 7)) << 4));
                    acc = __builtin_amdgcn_mfma_f32_16x16x32_bf16(vf[jp], af, acc, 0, 0, 0);
                }
            }
            ot[it] = acc;
        }
#pragma unroll
        for (int dt = 0; dt < 8; ++dt) {
            const f32x4 dec = *(const f32x4*)(DECs + 16 * dt + 4 * fq);
            f32x4 acc = st[dt] * dec;
#pragma unroll
            for (int jp = 0; jp < 2; ++jp) {
                const int rowA = 32 * jp + 8 * fq + (li >> 2), rowB = rowA + 4;
                const int chunk = 2 * dt + ((li & 3) >> 1), sub = ((li & 3) & 1) * 8;
                const s16x4 ka = __builtin_amdgcn_ds_read_tr16_b64_v4i16((LAS s16x4*)(KEs + rowA * 256 + ((chunk ^ (rowA & 15)) << 4) + sub));
                const s16x4 kb = __builtin_amdgcn_ds_read_tr16_b64_v4i16((LAS s16x4*)(KEs + rowB * 256 + ((chunk ^ (rowB & 15)) << 4) + sub));
                bf16x8 kf;
                kf[0] = ka[0]; kf[1] = ka[1]; kf[2] = ka[2]; kf[3] = ka[3]; kf[4] = kb[0]; kf[5] = kb[1]; kf[6] = kb[2]; kf[7] = kb[3];
                acc = __builtin_amdgcn_mfma_f32_16x16x32_bf16(kf, vf[jp], acc, 0, 0, 0);
            }
            st[dt] = acc;
        }
#pragma unroll
        for (int it = 0; it < 4; ++it) {
            const int i = 16 * it + li;
            const int s = dir ? (Sq - 1 - (64 * c + i)) : (64 * c + i);
            *(uint2*)(Oout + ((size_t)dir * Ttot + tok0 + s) * 1024 + hh * 256 + slice * 128 + 16 * wave + 4 * fq) =
                make_uint2(pack2(ot[it][0], ot[it][1]), pack2(ot[it][2], ot[it][3]));
        }
        if (c + 1 < nch) GLA_COMMIT(buf ^ 1);
        __syncthreads();
    }
}
__device__ __forceinline__ void phase_rope_prep(const Args& a, unsigned char* lds) {
    u16* P = (u16*)(a.ws + WS_P);
    const float2* cs = (const float2*)(a.ws + WS_CS);
    const int gt = blockIdx.x * NTHREADS + threadIdx.x, NT = gridDim.x * NTHREADS;
    for (int i = gt; i < T * 2 * 8 * 8; i += NT) {
        const int f0 = (i & 7) * 8, hh = (i >> 3) & 7, which = (i >> 6) & 1, t = i >> 7;
        u16* p = P + (size_t)t * NP + (which ? C_DK : C_DQ) + hh * 128 + f0;
        const uint4 a1 = *(const uint4*)p, a2 = *(const uint4*)(p + 64);
        const float4* cp = (const float4*)(cs + t * 64 + f0);
        const float4 c0 = cp[0], c1 = cp[1], c2 = cp[2], c3 = cp[3];
        const float x1[8] = {lo2f(a1.x), hi2f(a1.x), lo2f(a1.y), hi2f(a1.y), lo2f(a1.z), hi2f(a1.z), lo2f(a1.w), hi2f(a1.w)};
        const float x2[8] = {lo2f(a2.x), hi2f(a2.x), lo2f(a2.y), hi2f(a2.y), lo2f(a2.z), hi2f(a2.z), lo2f(a2.w), hi2f(a2.w)};
        const float cc[8] = {c0.x, c0.z, c1.x, c1.z, c2.x, c2.z, c3.x, c3.z}, sn[8] = {c0.y, c0.w, c1.y, c1.w, c2.y, c2.w, c3.y, c3.w};
        float y1[8], y2[8];
#pragma unroll
        for (int k = 0; k < 8; ++k) { y1[k] = x1[k] * cc[k] - x2[k] * sn[k]; y2[k] = x1[k] * sn[k] + x2[k] * cc[k]; }
        *(uint4*)p = make_uint4(pack2(y1[0], y1[1]), pack2(y1[2], y1[3]), pack2(y1[4], y1[5]), pack2(y1[6], y1[7]));
        *(uint4*)(p + 64) = make_uint4(pack2(y2[0], y2[1]), pack2(y2[2], y2[3]), pack2(y2[4], y2[5]), pack2(y2[6], y2[7]));
    }
    for (int item = blockIdx.x; item < GLA_NPREP; item += gridDim.x)
        gla_prep_item(P, NP, C_GQ, C_GK, (const float*)(a.ws + WS_GZ), a.wgf, a.bgf, a.wgb, a.bgb, S,
                      a.ws + WS_QD, a.ws + WS_KE, a.ws + WS_AT, (float*)(a.ws + WS_DEC), lds, item);
}

__device__ __forceinline__ void attn_item(const u16* __restrict__ P, int ldp, int cq, int ck, int cv, int Sq,
                                          u16* __restrict__ part_o, float* __restrict__ part_lse, int Ttot,
                                          unsigned char* lds, int item) {
    const int tid = TID, lane = tid & 63, wave = tid >> 6, li = lane & 15, fq = lane >> 4;
    const int nb_per = Sq / 128;
    const int within = item % nb_per, hh = (item / nb_per) & 7, b = (item / (nb_per * 8)) & 3, pat = item / (nb_per * 32);
    const int dil = pat == 0 ? 1 : (pat == 1 ? 4 : 16);
    const int M = Sq / dil;
    const int r = within % dil, blk = within / dil;
    const int p0 = blk * 128, kbase = p0 - 64;
    unsigned char* Ks = lds;
    unsigned char* Vs = lds + 65536;
    const size_t tok0 = (size_t)b * Sq;
    __syncthreads();
#pragma unroll
    for (int i = 0; i < 8; ++i) {
        const int id = tid + 512 * i, row = id >> 4, c = id & 15;
        int kp = kbase + row; kp = kp < 0 ? 0 : (kp > M - 1 ? M - 1 : kp);
        const size_t t = tok0 + r + (size_t)dil * kp;
        const uint4 kv = *(const uint4*)(P + t * ldp + ck + hh * 128 + c * 8);
        const uint4 vv = *(const uint4*)(P + t * ldp + cv + hh * 128 + c * 8);
        const int off = row * 256 + ((c ^ (row & 15)) << 4);
        *(uint4*)(Ks + off) = kv;
        *(uint4*)(Vs + off) = vv;
    }
    const int qp = p0 + 16 * wave + li;
    const size_t tq = tok0 + r + (size_t)dil * qp;
    bf16x8 qf[4];
#pragma unroll
    for (int ks = 0; ks < 4; ++ks) qf[ks] = *(const bf16x8*)(P + tq * ldp + cq + hh * 128 + 32 * ks + 8 * fq);
    __syncthreads();
    const float scale = 0.08838834764831845f;
    float m = -1e30f, l = 0.f;
    f32x4 o[8];
#pragma unroll
    for (int dt = 0; dt < 8; ++dt) o[dt] = (f32x4){0.f, 0.f, 0.f, 0.f};
#pragma unroll 1
    for (int tp = 0; tp < 5; ++tp) {
        float s[8]; bool ok[8];
#pragma unroll
        for (int h2 = 0; h2 < 2; ++h2) {
            const int kk0 = 16 * wave + 16 * (2 * tp + h2);
            int krow = kk0 + li; krow = krow > 255 ? 255 : krow;
            f32x4 acc = (f32x4){0.f, 0.f, 0.f, 0.f};
#pragma unroll
            for (int ks = 0; ks < 4; ++ks) {
                const bf16x8 kf = *(const bf16x8*)(Ks + krow * 256 + (((4 * ks + fq) ^ (krow & 15)) << 4));
                acc = __builtin_amdgcn_mfma_f32_16x16x32_bf16(kf, qf[ks], acc, 0, 0, 0);
            }
#pragma unroll
            for (int j = 0; j < 4; ++j) {
                const int kp = kbase + kk0 + 4 * fq + j;
                const int rel = kp - qp;
                ok[4 * h2 + j] = (kp >= 0) && (kp < M) && (rel <= 64) && (rel >= -64);
                s[4 * h2 + j] = acc[j] * scale;
            }
        }
        float mx = -1e30f;
#pragma unroll
        for (int j = 0; j < 8; ++j) mx = ok[j] ? fmaxf(mx, s[j]) : mx;
        mx = fmaxf(mx, __shfl_xor(mx, 16));
        mx = fmaxf(mx, __shfl_xor(mx, 32));
        const float mn = fmaxf(m, mx);
        const float al = __expf(m - mn);
        float ps = 0.f; float p[8];
#pragma unroll
        for (int j = 0; j < 8; ++j) { p[j] = ok[j] ? __expf(s[j] - mn) : 0.f; ps += p[j]; }
        l = l * al + ps; m = mn;
        bf16x8 pf;
#pragma unroll
        for (int j = 0; j < 8; ++j) pf[j] = (short)f2bf(p[j]);
#pragma unroll
        for (int dt = 0; dt < 8; ++dt) o[dt] *= al;
        int rowA = 16 * wave + 32 * tp + 4 * fq + (li >> 2); rowA = rowA > 255 ? 255 : rowA;
        int rowB = 16 * wave + 32 * tp + 16 + 4 * fq + (li >> 2); rowB = rowB > 255 ? 255 : rowB;
#pragma unroll
        for (int dt = 0; dt < 8; ++dt) {
            const int chunk = 2 * dt + ((li & 3) >> 1), sub = ((li & 3) & 1) * 8;
            const s16x4 va = __builtin_amdgcn_ds_read_tr16_b64_v4i16((LAS s16x4*)(Vs + rowA * 256 + ((chunk ^ (rowA & 15)) << 4) + sub));
            const s16x4 vb = __builtin_amdgcn_ds_read_tr16_b64_v4i16((LAS s16x4*)(Vs + rowB * 256 + ((chunk ^ (rowB & 15)) << 4) + sub));
            bf16x8 vf;
            vf[0] = va[0]; vf[1] = va[1]; vf[2] = va[2]; vf[3] = va[3]; vf[4] = vb[0]; vf[5] = vb[1]; vf[6] = vb[2]; vf[7] = vb[3];
            o[dt] = __builtin_amdgcn_mfma_f32_16x16x32_bf16(vf, pf, o[dt], 0, 0, 0);
        }
    }
    l += __shfl_xor(l, 16);
    l += __shfl_xor(l, 32);
    const float inv = 1.f / l;
    u16* orow = part_o + ((size_t)pat * Ttot + tq) * 1024 + hh * 128 + 4 * fq;
#pragma unroll
    for (int dt = 0; dt < 8; ++dt)
        *(uint2*)(orow + 16 * dt) = make_uint2(pack2(o[dt][0] * inv, o[dt][1] * inv), pack2(o[dt][2] * inv, o[dt][3] * inv));
    if (fq == 0) part_lse[((size_t)pat * Ttot + tq) * 8 + hh] = m + logf(l);
}

__device__ __forceinline__ void attn_merge_token(const u16* __restrict__ part_o, const float* __restrict__ part_lse, int Ttot, size_t t,
                                                 u16* __restrict__ dst  , int lane) {
    const int hh = lane >> 3;
    const float l0 = part_lse[((size_t)0 * Ttot + t) * 8 + hh], l1 = part_lse[((size_t)1 * Ttot + t) * 8 + hh], l2 = part_lse[((size_t)2 * Ttot + t) * 8 + hh];
    const float mx = fmaxf(l0, fmaxf(l1, l2));
    const float e0 = __expf(l0 - mx), e1 = __expf(l1 - mx), e2 = __expf(l2 - mx);
    const float inv = 1.f / (e0 + e1 + e2);
    const float w[3] = {e0 * inv, e1 * inv, e2 * inv};
    float acc[16];
#pragma unroll
    for (int i = 0; i < 16; ++i) acc[i] = 0.f;
#pragma unroll
    for (int p = 0; p < 3; ++p) {
        const uint4* src = (const uint4*)(part_o + ((size_t)p * Ttot + t) * 1024 + lane * 16);
        const uint4 a = src[0], bb = src[1];
        acc[0] += w[p] * lo2f(a.x); acc[1] += w[p] * hi2f(a.x); acc[2] += w[p] * lo2f(a.y); acc[3] += w[p] * hi2f(a.y);
        acc[4] += w[p] * lo2f(a.z); acc[5] += w[p] * hi2f(a.z); acc[6] += w[p] * lo2f(a.w); acc[7] += w[p] * hi2f(a.w);
        acc[8] += w[p] * lo2f(bb.x); acc[9] += w[p] * hi2f(bb.x); acc[10] += w[p] * lo2f(bb.y); acc[11] += w[p] * hi2f(bb.y);
        acc[12] += w[p] * lo2f(bb.z); acc[13] += w[p] * hi2f(bb.z); acc[14] += w[p] * lo2f(bb.w); acc[15] += w[p] * hi2f(bb.w);
    }
    uint4* d = (uint4*)(dst + lane * 16);
    d[0] = make_uint4(pack2(acc[0], acc[1]), pack2(acc[2], acc[3]), pack2(acc[4], acc[5]), pack2(acc[6], acc[7]));
    d[1] = make_uint4(pack2(acc[8], acc[9]), pack2(acc[10], acc[11]), pack2(acc[12], acc[13]), pack2(acc[14], acc[15]));
}

__device__ __forceinline__ void phase_mixers(const Args& a, unsigned char* lds) {
    const int bi = blockIdx.x, G = gridDim.x;
    if (bi < 64) {
        gla_seq_item((const u16*)(a.ws + WS_P), NP, C_GV, S, a.ws + WS_QD, a.ws + WS_KE, a.ws + WS_AT, (const float*)(a.ws + WS_DEC),
                     (u16*)(a.ws + WS_OFB), T, lds, bi);
    } else {
        u16* part_o = (u16*)a.out; float* part_lse = (float*)((unsigned char*)a.out + (size_t)3 * T * 1024 * 2);
        for (int item = bi - 64; item < 3 * 4 * 8 * (S / 128); item += G - 64)
            attn_item((const u16*)(a.ws + WS_P), NP, C_DQ, C_DK, C_DV, S, part_o, part_lse, T, lds, item);
    }
}

__device__ __forceinline__ void phase_gla_fin(const Args& a) {
    const u16* Of = (const u16*)(a.ws + WS_OFB);
    const u16* Ob = Of + (size_t)T * 1024;
    const u16* P = (const u16*)(a.ws + WS_P);
    u16* A2 = (u16*)(a.ws + WS_ACT);
    const int lane = threadIdx.x & 63, wave = threadIdx.x >> 6;
    const int gw = blockIdx.x * NWAVES + wave, NGW = gridDim.x * NWAVES;
    for (int item = gw; item < T * 4; item += NGW) {
        const int hh = item & 3, t = item >> 2;
        const size_t base = (size_t)t * 1024 + hh * 256 + lane * 4;
        const uint2 f = *(const uint2*)(Of + base), bb = *(const uint2*)(Ob + base);
        const float o0 = lo2f(f.x) + lo2f(bb.x), o1 = hi2f(f.x) + hi2f(bb.x), o2 = lo2f(f.y) + lo2f(bb.y), o3 = hi2f(f.y) + hi2f(bb.y);
        const float ss = wave_sum(o0 * o0 + o1 * o1 + o2 * o2 + o3 * o3);
        const float rstd = rsqrtf(ss * (1.f / 256.f) + NORM_EPS);
        const float4 gg = *(const float4*)(a.g_gla + hh * 256 + lane * 4);
        const uint2 rp = *(const uint2*)(P + (size_t)t * NP + C_GR + hh * 256 + lane * 4);
        const float r0 = lo2f(rp.x), r1 = hi2f(rp.x), r2 = lo2f(rp.y), r3 = hi2f(rp.y);
        const float y0 = o0 * rstd * gg.x * silu_f(r0), y1 = o1 * rstd * gg.y * silu_f(r1);
        const float y2 = o2 * rstd * gg.z * silu_f(r2), y3 = o3 * rstd * gg.w * silu_f(r3);
        *(uint2*)(A2 + (size_t)t * D + hh * 256 + lane * 4) = make_uint2(pack2(y0, y1), pack2(y2, y3));
    }
    const u16* part_o = (const u16*)a.out; const float* part_lse = (const float*)((const unsigned char*)a.out + (size_t)3 * T * 1024 * 2);
    for (int t = gw; t < T; t += NGW) attn_merge_token(part_o, part_lse, T, (size_t)t, A2 + (size_t)t * D + 1024, lane);
}

typedef float f32x16 __attribute__((ext_vector_type(16)));
#define RT_CE(a_, b_) do { const float hi_ = fmaxf(a_, b_), lo_ = fminf(a_, b_); a_ = hi_; b_ = lo_; } while (0)
template <int N> __device__ __forceinline__ void rt_sort_desc(float (&v)[N], int base) {
#pragma unroll
    for (int k = 2; k <= 16; k <<= 1)
#pragma unroll
        for (int j = k >> 1; j > 0; j >>= 1)
#pragma unroll
            for (int i = 0; i < 16; ++i) {
                const int l = i ^ j;
                if (l > i) { if ((i & k) == 0) RT_CE(v[base + i], v[base + l]); else RT_CE(v[base + l], v[base + i]); }
            }
}
template <int N> __device__ __forceinline__ void rt_merge_desc(float (&v)[N], int a, int b) {
#pragma unroll
    for (int i = 0; i < 16; ++i) v[a + i] = fmaxf(v[a + i], v[b + 15 - i]);
#pragma unroll
    for (int j = 8; j > 0; j >>= 1)
#pragma unroll
        for (int i = 0; i < 16; ++i) { const int l = i ^ j; if (l > i) RT_CE(v[a + i], v[a + l]); }
}

__device__ __forceinline__ void route_stage_keys(const float* __restrict__ subk, int hh, unsigned char* lds) {
    const int tid = TID;
    __syncthreads();
    for (int e = tid; e < 2 * 128 * 16; e += 512) {
        const int c = e & 15, row = e >> 4;
        const float* src = subk + ((size_t)(hh * 2) * 128 + row) * 128 + c * 8;
        const float4 v0 = *(const float4*)src, v1 = *(const float4*)(src + 4);
        *(uint4*)(lds + row * 256 + ((c ^ (row & 15)) << 4)) = make_uint4(pack2(v0.x, v0.y), pack2(v0.z, v0.w), pack2(v1.x, v1.y), pack2(v1.z, v1.w));
    }
    __syncthreads();
}

__device__ __forceinline__ void route_tile(const u16* __restrict__ Q, int ldq, int hh, int tok_base, const unsigned char* lds,
                                           int* __restrict__ IDX, float* __restrict__ GATE) {
    const int lane = TID & 63, r = lane & 31, h = lane >> 5;
    float sc[128];
    {
        f32x16 X[4], Y[4];
#pragma unroll
        for (int kt = 0; kt < 4; ++kt) {
#pragma unroll
            for (int i = 0; i < 16; ++i) { X[kt][i] = 0.f; Y[kt][i] = 0.f; }
        }
        const u16* qrow = Q + (size_t)(tok_base + r) * ldq + hh * 256;
#pragma unroll
        for (int half = 0; half < 2; ++half) {
            bf16x8 qf[8];
#pragma unroll
            for (int ks = 0; ks < 8; ++ks) qf[ks] = *(const bf16x8*)(qrow + half * 128 + 16 * ks + 8 * h);
#pragma unroll
            for (int kt = 0; kt < 4; ++kt) {
                const int krow = half * 128 + 32 * kt + r;
#pragma unroll
                for (int ks = 0; ks < 8; ++ks) {
                    const bf16x8 kf = *(const bf16x8*)(lds + krow * 256 + (((2 * ks + h) ^ (krow & 15)) << 4));
                    if (half == 0) X[kt] = __builtin_amdgcn_mfma_f32_32x32x16_bf16(kf, qf[ks], X[kt], 0, 0, 0);
                    else Y[kt] = __builtin_amdgcn_mfma_f32_32x32x16_bf16(kf, qf[ks], Y[kt], 0, 0, 0);
                }
            }
        }
#pragma unroll
        for (int kt = 0; kt < 4; ++kt)
#pragma unroll
            for (int i = 0; i < 16; ++i) {
                const auto sw = __builtin_amdgcn_permlane32_swap(__float_as_uint(X[kt][i]), __float_as_uint(Y[kt][i]), false, false);
                const int key0 = 32 * kt + (i & 3) + 8 * (i >> 2);
                sc[kt * 32 + i] = __uint_as_float((sw[0] & 0xffffff80u) | (unsigned)key0);
                sc[kt * 32 + 16 + i] = __uint_as_float((sw[1] & 0xffffff80u) | (unsigned)(key0 + 4));
            }
    }
#pragma unroll
    for (int g = 0; g < 8; ++g) rt_sort_desc(sc, 16 * g);
    rt_merge_desc(sc, 0, 16); rt_merge_desc(sc, 32, 48); rt_merge_desc(sc, 64, 80); rt_merge_desc(sc, 96, 112);
    rt_merge_desc(sc, 0, 32); rt_merge_desc(sc, 64, 96);
    rt_merge_desc(sc, 0, 64);
    float l0[16], l1[16];
#pragma unroll
    for (int i = 0; i < 16; ++i) {
        const auto sw = __builtin_amdgcn_permlane32_swap(__float_as_uint(sc[i]), __float_as_uint(sc[i]), false, false);
        l0[i] = __uint_as_float(sw[0]); l1[i] = __uint_as_float(sw[1]);
    }
    float s0[16], s1[16]; int k0[16], k1[16];
#pragma unroll
    for (int i = 0; i < 16; ++i) {
        const unsigned a = __float_as_uint(l0[i]), b = __float_as_uint(l1[i]);
        s0[i] = __uint_as_float(a & 0xffffff80u); k0[i] = (int)(a & 0x7fu);
        s1[i] = __uint_as_float(b & 0xffffff80u); k1[i] = (int)(b & 0x7fu);
    }
    float cs[64];
    {
        int n = 0;
#pragma unroll
        for (int i = 0; i < 16; ++i)
#pragma unroll
            for (int j = 0; j < 16; ++j)
                if ((i + 1) * (j + 1) <= 16) { cs[n] = s0[i] + s1[j]; ++n; }
#pragma unroll
        for (int q = 50; q < 64; ++q) cs[q] = -3.0e38f;
    }
    float ct[64];
#pragma unroll
    for (int q = 0; q < 64; ++q) ct[q] = cs[q];
#pragma unroll
    for (int g = 0; g < 4; ++g) rt_sort_desc(ct, 16 * g);
    rt_merge_desc(ct, 0, 16); rt_merge_desc(ct, 32, 48); rt_merge_desc(ct, 0, 32);
    const float theta = ct[15], smax = ct[0];
    float den = 0.f;
    {
        int cnt = 0;
#pragma unroll
        for (int q = 0; q < 50; ++q) { const bool sel = (cs[q] >= theta) && (cnt < 16); den += sel ? __expf(cs[q] - smax) : 0.f; cnt += sel ? 1 : 0; }
    }
    const float inv = 1.f / den;
    const size_t obase = (size_t)(tok_base + r) * 128 + hh * 16;
    int pos = 0;
    {
        int n = 0;
#pragma unroll
        for (int i = 0; i < 16; ++i)
#pragma unroll
            for (int j = 0; j < 16; ++j)
                if ((i + 1) * (j + 1) <= 16) {
                    const bool sel = (cs[n] >= theta) && (pos < 16);
                    if (sel) {
                        if (h == 0) IDX[obase + pos] = k0[i] * 128 + k1[j];
                        else GATE[obase + pos] = __expf(cs[n] - smax) * inv;
                        ++pos;
                    }
                    ++n;
                }
    }
}
__device__ __forceinline__ void phase_route(const Args& a, unsigned char* lds) {
    const int hh = BID & 7, grp = BID >> 3, ngrp = GDIM >> 3, wave = TID >> 6;
    route_stage_keys(a.subk, hh, lds);
    int j = 0;
    for (int tile = grp; tile < T / 32; tile += ngrp, ++j)
        if ((j & 7) == wave) route_tile((const u16*)(a.ws + WS_Q), D, hh, tile * 32, lds, (int*)(a.ws + WS_IDX), (float*)(a.ws + WS_GATE));
    __syncthreads();
}

typedef __bf16 bf16x2_t __attribute__((ext_vector_type(2)));
__device__ __forceinline__ float dot2bf(unsigned w, unsigned x, float acc) {
    return __builtin_amdgcn_fdot2_f32_bf16(__builtin_bit_cast(bf16x2_t, w), __builtin_bit_cast(bf16x2_t, x), acc, false);
}
constexpr int TROW = 1152;
typedef float f32x2_t __attribute__((ext_vector_type(2)));
__device__ __forceinline__ void convert_tables(const Args& a) {
    const int lane = threadIdx.x & 63, wave = threadIdx.x >> 6;
    const int gw = blockIdx.x * NWAVES + wave, NGW = gridDim.x * NWAVES;
    for (int row = gw; row < 2 * 16384; row += NGW) {
        const bool isv = row >= 16384; const int e = isv ? row - 16384 : row;
        const f32x4* sp = (const f32x4*)((isv ? a.pv : a.pu) + (size_t)e * D + lane * 32);
        f32x4 v[8]; float mx = 0.f;
#pragma unroll
        for (int k = 0; k < 8; ++k) { v[k] = __builtin_nontemporal_load(sp + k);
            mx = fmaxf(mx, fmaxf(fmaxf(fabsf(v[k][0]), fabsf(v[k][1])), fmaxf(fabsf(v[k][2]), fabsf(v[k][3])))); }
        float s = mx * (isv ? (1.f / 6.f) : (1.f / 7.f)); s = (s > 0.f) ? s : 1.f;
        u16 sb = f2bf(s); if (bf2f(sb) < s) sb += 1;
        const float inv = 1.f / bf2f(sb);
        unsigned w[4];
        if (isv) {
#pragma unroll
            for (int k = 0; k < 4; ++k) {
                unsigned p = 0u;
                p = __builtin_amdgcn_cvt_scalef32_pk_fp4_f32(p, v[2 * k][0] * inv, v[2 * k][1] * inv, 1.0f, 0);
                p = __builtin_amdgcn_cvt_scalef32_pk_fp4_f32(p, v[2 * k][2] * inv, v[2 * k][3] * inv, 1.0f, 1);
                p = __builtin_amdgcn_cvt_scalef32_pk_fp4_f32(p, v[2 * k + 1][0] * inv, v[2 * k + 1][1] * inv, 1.0f, 2);
                p = __builtin_amdgcn_cvt_scalef32_pk_fp4_f32(p, v[2 * k + 1][2] * inv, v[2 * k + 1][3] * inv, 1.0f, 3);
                w[k] = p;
            }
        } else {
#pragma unroll
            for (int k = 0; k < 4; ++k) {
                unsigned p = 0u;
#pragma unroll
                for (int bq = 0; bq < 4; ++bq) {
                    int lo = (int)rintf(v[2 * k][bq] * inv) + 8, hi = (int)rintf(v[2 * k + 1][bq] * inv) + 8;
                    lo = lo < 1 ? 1 : (lo > 15 ? 15 : lo); hi = hi < 1 ? 1 : (hi > 15 ? 15 : hi);
                    p |= ((unsigned)lo | ((unsigned)hi << 4)) << (8 * bq);
                }
                w[k] = p;
            }
        }
        unsigned char* dst = a.ws + (isv ? WS_TV : WS_TU) + (size_t)e * TROW;
        *(uint4*)(dst + lane * 16) = make_uint4(w[0], w[1], w[2], w[3]);
        *(u16*)(dst + 1024 + lane * 2) = sb;
    }
}

__device__ __forceinline__ int idot32_i4(const uint4 w, const int (&hq)[8]) {
    const unsigned ww[4] = {w.x, w.y, w.z, w.w};
    int acc = 0;
#pragma unroll
    for (int k = 0; k < 4; ++k) {
        acc = __builtin_amdgcn_sdot4((int)(ww[k] & 0x0f0f0f0fu), hq[2 * k], acc, false);
        acc = __builtin_amdgcn_sdot4((int)((ww[k] >> 4) & 0x0f0f0f0fu), hq[2 * k + 1], acc, false);
    }
    return acc;
}
__device__ __forceinline__ void axpy32_fp4(const uint4 w, const float s, float (&acc)[32]) {
    const unsigned ww[4] = {w.x, w.y, w.z, w.w};
#pragma unroll
    for (int k = 0; k < 4; ++k) {
        const f32x2_t a0 = __builtin_amdgcn_cvt_scalef32_pk_f32_fp4(ww[k], 1.0f, 0), a1 = __builtin_amdgcn_cvt_scalef32_pk_f32_fp4(ww[k], 1.0f, 1);
        const f32x2_t a2 = __builtin_amdgcn_cvt_scalef32_pk_f32_fp4(ww[k], 1.0f, 2), a3 = __builtin_amdgcn_cvt_scalef32_pk_f32_fp4(ww[k], 1.0f, 3);
        acc[8 * k + 0] += s * a0.x; acc[8 * k + 1] += s * a0.y; acc[8 * k + 2] += s * a1.x; acc[8 * k + 3] += s * a1.y;
        acc[8 * k + 4] += s * a2.x; acc[8 * k + 5] += s * a2.y; acc[8 * k + 6] += s * a3.x; acc[8 * k + 7] += s * a3.y;
    }
}
__device__ __forceinline__ void phase_experts(const Args& a) {
    const u16* H2 = (const u16*)(a.ws + WS_ACT);
    const float* X1 = (const float*)(a.ws + WS_X1);
    const int* IDX = (const int*)(a.ws + WS_IDX);
    const float* GATE = (const float*)(a.ws + WS_GATE);
    const float* mod = (const float*)(a.ws + WS_MOD);
    const unsigned char* U = a.ws + WS_TU; const unsigned char* V = a.ws + WS_TV;
    const int lane = threadIdx.x & 63, wave = threadIdx.x >> 6;
    const int gw = blockIdx.x * NWAVES + wave, NGW = gridDim.x * NWAVES;
    int iv0 = 0, iv1 = 0; float gv0 = 0.f, gv1 = 0.f;
    int niv0 = 0, niv1 = 0; float ngv0 = 0.f, ngv1 = 0.f;
    uint4 rA[4], rB[4]; u16 sA[4], sB[4];
#define ROW_LOAD(TB_, r_, s_, r0_) do { _Pragma("unroll") for (int q = 0; q < 4; ++q) { \
            const int rr_ = (r0_) + q; const int e_ = __builtin_amdgcn_readlane(rr_ < 64 ? iv0 : iv1, rr_ & 63); \
            const unsigned char* rp_ = TB_ + (size_t)e_ * TROW; \
            r_[q] = *(const uint4*)(rp_ + lane * 16); s_[q] = *(const u16*)(rp_ + 1024 + lane * 2); } } while (0)
#define TOK_FETCH(t_, i0_, i1_, g0_, g1_) do { \
            i0_ = IDX[(size_t)(t_) * 128 + lane]; i1_ = IDX[(size_t)(t_) * 128 + 64 + lane]; \
            g0_ = GATE[(size_t)(t_) * 128 + lane]; g1_ = GATE[(size_t)(t_) * 128 + 64 + lane]; } while (0)
    if (gw < T) { TOK_FETCH(gw, iv0, iv1, gv0, gv1); ROW_LOAD(U, rA, sA, 0); }
    for (int t = gw; t < T; t += NGW) {
        const int b = t / S;
        const bool has_next = (t + NGW) < T;
        int hq[8]; int hsum8; float sh;
        {
            float h[32];
            const uint4* hp = (const uint4*)(H2 + (size_t)t * D + lane * 32);
#pragma unroll
            for (int k = 0; k < 4; ++k) { const uint4 p = hp[k];
                h[8 * k + 0] = lo2f(p.x); h[8 * k + 1] = hi2f(p.x); h[8 * k + 2] = lo2f(p.y); h[8 * k + 3] = hi2f(p.y);
                h[8 * k + 4] = lo2f(p.z); h[8 * k + 5] = hi2f(p.z); h[8 * k + 6] = lo2f(p.w); h[8 * k + 7] = hi2f(p.w); }
            float mx = 0.f;
#pragma unroll
            for (int i = 0; i < 32; ++i) mx = fmaxf(mx, fabsf(h[i]));
            sh = (mx > 0.f) ? mx * (1.f / 127.f) : 1.f;
            const float inv = 1.f / sh;
            int hs = 0;
#pragma unroll
            for (int k = 0; k < 8; ++k) {
                const int q0 = (int)rintf(h[4 * k + 0] * inv), q1 = (int)rintf(h[4 * k + 1] * inv), q2 = (int)rintf(h[4 * k + 2] * inv), q3 = (int)rintf(h[4 * k + 3] * inv);
                hs += q0 + q1 + q2 + q3;
                hq[k] = (q0 & 0xff) | ((q1 & 0xff) << 8) | ((q2 & 0xff) << 16) | ((int)((unsigned)(q3 & 0xff) << 24));
            }
            hsum8 = 8 * hs;
        }
        float a0 = 0.f, a1 = 0.f;
#define U_COMPUTE(r_, s_, r0_) do { float d_[4]; \
            _Pragma("unroll") for (int q = 0; q < 4; ++q) d_[q] = (float)(idot32_i4(r_[q], hq) - hsum8) * (bf2f(s_[q]) * sh); \
            _Pragma("unroll") for (int o = 32; o > 0; o >>= 1) { _Pragma("unroll") for (int q = 0; q < 4; ++q) d_[q] += __shfl_xor(d_[q], o); } \
            _Pragma("unroll") for (int q = 0; q < 4; ++q) { const int rr_ = (r0_) + q; \
                if (rr_ < 64) a0 = (lane == rr_) ? d_[q] : a0; else a1 = (lane == rr_ - 64) ? d_[q] : a1; } } while (0)
#pragma unroll 1
        for (int r0 = 0; r0 < 128; r0 += 8) {
            ROW_LOAD(U, rB, sB, r0 + 4);
            U_COMPUTE(rA, sA, r0);
            if (r0 + 8 < 128) ROW_LOAD(U, rA, sA, r0 + 8); else ROW_LOAD(V, rA, sA, 0);
            U_COMPUTE(rB, sB, r0 + 4);
        }
        const float w0 = gv0 * gelu_f(a0), w1 = gv1 * gelu_f(a1);
        float acc[32];
#pragma unroll
        for (int i = 0; i < 32; ++i) acc[i] = 0.f;
#define V_COMPUTE(r_, s_, r0_) do { _Pragma("unroll") for (int q = 0; q < 4; ++q) { const int rr_ = (r0_) + q; \
                const float g_ = __builtin_bit_cast(float, __builtin_amdgcn_readlane(__builtin_bit_cast(int, rr_ < 64 ? w0 : w1), rr_ & 63)); \
                axpy32_fp4(r_[q], g_ * bf2f(s_[q]), acc); } } while (0)
        if (has_next) TOK_FETCH(t + NGW, niv0, niv1, ngv0, ngv1);
#pragma unroll 1
        for (int r0 = 0; r0 < 128; r0 += 8) {
            ROW_LOAD(V, rB, sB, r0 + 4);
            V_COMPUTE(rA, sA, r0);
            if (r0 + 8 < 128) ROW_LOAD(V, rA, sA, r0 + 8);
            else if (has_next) { iv0 = niv0; iv1 = niv1; gv0 = ngv0; gv1 = ngv1; ROW_LOAD(U, rA, sA, 0); }
            V_COMPUTE(rB, sB, r0 + 4);
        }
#undef U_COMPUTE
#undef V_COMPUTE
        float ss = 0.f;
#pragma unroll
        for (int k = 0; k < 8; ++k) {
            const int c0 = lane * 32 + 4 * k;
            const float4 xa = *(const float4*)(X1 + (size_t)t * D + c0);
            const float4 ga = *(const float4*)(mod + b * 12288 + 5 * 2048 + c0);
            acc[4 * k + 0] = xa.x + ga.x * acc[4 * k + 0]; acc[4 * k + 1] = xa.y + ga.y * acc[4 * k + 1];
            acc[4 * k + 2] = xa.z + ga.z * acc[4 * k + 2]; acc[4 * k + 3] = xa.w + ga.w * acc[4 * k + 3];
#pragma unroll
            for (int i = 0; i < 4; ++i) ss += acc[4 * k + i] * acc[4 * k + i];
        }
        ss = wave_sum(ss);
        const float rstd = rsqrtf(ss * (1.f / D) + NORM_EPS);
#pragma unroll
        for (int k = 0; k < 8; ++k) {
            const int c0 = lane * 32 + 4 * k;
            const float4 gf = *(const float4*)(a.g_fin + c0);
            *(float4*)(a.out + (size_t)t * D + c0) = make_float4(acc[4 * k + 0] * rstd * gf.x, acc[4 * k + 1] * rstd * gf.y, acc[4 * k + 2] * rstd * gf.z, acc[4 * k + 3] * rstd * gf.w);
        }
    }
#undef ROW_LOAD
#undef TOK_FETCH
}

#define XB_TMO      128
#define XB_XCNT(j)  (256  + 64 * (j))
#define XB_XSUB(j)  (1280 + 64 * (j))
#define XB_XGEN(j)  (2304 + 64 * (j))
#define XB_TOP      3328
#define XB_TOPGEN   3392
#define XCD_BAR_WORDS 3456
#define XB_SPIN_CAP (1u << 18)

__device__ __forceinline__ unsigned xb_ld(unsigned* p)              { return __hip_atomic_load(p, __ATOMIC_RELAXED, __HIP_MEMORY_SCOPE_AGENT); }
__device__ __forceinline__ unsigned xb_add(unsigned* p, unsigned v) { return __hip_atomic_fetch_add(p, v, __ATOMIC_RELAXED, __HIP_MEMORY_SCOPE_AGENT); }
__device__ __forceinline__ unsigned xb_xcc_id() { return (unsigned)__builtin_amdgcn_s_getreg((3 << 11) | 20) & 0xFu; }
#define XB_SPIN(cond, bar) do { unsigned _sp = 0; while (cond) { __builtin_amdgcn_s_sleep(1); \
    if ((++_sp & 255u) == 0u) { if (xb_ld(&(bar)[XB_TMO])) break; if (_sp > XB_SPIN_CAP) { atomicAdd(&(bar)[XB_TMO], 1u); break; } } } } while (0)

struct XcdBarrier {
    unsigned* bar; unsigned x;
    volatile LAS unsigned* st;
};

__device__ __forceinline__ XcdBarrier xcd_barrier_post(unsigned* bar, volatile LAS unsigned* st) {
    XcdBarrier b; b.bar = bar; b.x = xb_xcc_id(); b.st = st;
    if (threadIdx.x == 0) (void)xb_add(&bar[XB_XCNT(b.x)], 1u);
    return b;
}
__device__ __forceinline__ void xcd_barrier_complete(unsigned* bar, unsigned x, unsigned& nloc, unsigned& nx) {
    const unsigned G = gridDim.x * gridDim.y * gridDim.z;
    unsigned sum, cnt, mine, sp = 0u;
    for (;;) {
        sum = 0u; cnt = 0u; mine = 0u;
#pragma unroll
        for (unsigned j = 0; j < 16; ++j) { const unsigned c = xb_ld(&bar[XB_XCNT(j)]); sum += c; cnt += (c > 0u) ? 1u : 0u; mine = (j == x) ? c : mine; }
        if (sum == G) break;
        __builtin_amdgcn_s_sleep(1);
        if ((++sp & 255u) == 0u) { if (xb_ld(&bar[XB_TMO])) break; if (sp > XB_SPIN_CAP) { atomicAdd(&bar[XB_TMO], 1u); break; } }
    }
    nloc = mine > 0u ? mine : 1u; nx = cnt > 0u ? cnt : 1u;
}

__device__ __forceinline__ void xcd_barrier(const XcdBarrier& b) {
    asm volatile("s_waitcnt vmcnt(0)" ::: "memory");
    __syncthreads();
    if (threadIdx.x == 0) {
        unsigned* bar = b.bar;
        __builtin_amdgcn_s_waitcnt(0);
        unsigned nloc = b.st[0], nx = b.st[1];
        if (nloc == 0u) { xcd_barrier_complete(bar, b.x, nloc, nx); b.st[0] = nloc; b.st[1] = nx; }
        const unsigned old = xb_add(&bar[XB_XSUB(b.x)], 1u);
        const unsigned gen = old / nloc;
        if (old + 1u == (gen + 1u) * nloc) {
            __builtin_amdgcn_fence(__ATOMIC_RELEASE, "agent");
            asm volatile("s_waitcnt vmcnt(0)" ::: "memory");
            const unsigned og = xb_add(&bar[XB_TOP], 1u);
            const unsigned tg = og / nx;
            if (og + 1u == (tg + 1u) * nx) xb_add(&bar[XB_TOPGEN], 1u);
            else XB_SPIN(xb_ld(&bar[XB_TOPGEN]) == tg, bar);
            __builtin_amdgcn_fence(__ATOMIC_ACQUIRE, "agent");
            xb_add(&bar[XB_XGEN(b.x)], 1u);
            asm volatile("s_waitcnt vmcnt(0)" ::: "memory");
        } else {
            XB_SPIN(xb_ld(&bar[XB_XGEN(b.x)]) == gen, bar);
            __builtin_amdgcn_fence(__ATOMIC_ACQUIRE, "agent");
            asm volatile("s_waitcnt vmcnt(0)" ::: "memory");
        }
    }
    __syncthreads();
}

constexpr int NPHASES = 11;
__global__ void __launch_bounds__(NTHREADS, 2) mk_fwd(Args a) {
    extern __shared__ __attribute__((aligned(16))) unsigned char lds[];
    cg::grid_group grid = cg::this_grid();
    const int lo = a.ph_lo, hi = a.ph_hi;
    volatile LAS unsigned* xbw = (volatile LAS unsigned*)(lds + LDS_MAIN);
    if (threadIdx.x < 4) xbw[threadIdx.x] = 0u;
    __syncthreads();
    XcdBarrier xbar = xcd_barrier_post((unsigned*)(a.ws + WS_CTL), xbw);
#define IN(k) (lo <= (k) && (k) < hi)
#define SEAM(k) do { if (IN(k) && IN((k) + 1)) { if ((k) == 0) grid.sync(); else xcd_barrier(xbar); } } while (0)
    const float* mod = (const float*)(a.ws + WS_MOD);
    if (IN(0)) phase0(a, lds);
    SEAM(0);
    if (IN(1)) norm_mod_phase(a.x, a.g_mix, mod, 0, 1, (u16*)(a.ws + WS_ACT));
    SEAM(1);
    if (IN(2)) { gemm8(lds, (const u16*)(a.ws + WS_ACT), (const u16*)(a.ws + WS_WIN), T, NP, D, EpiProj{(u16*)(a.ws + WS_P)}); gz_phase(lds, (const u16*)(a.ws + WS_ACT), (const u16*)(a.ws + WS_WIN) + (size_t)NP * D, (float*)(a.ws + WS_GZ)); }
    SEAM(2);
    if (IN(3)) phase_rope_prep(a, lds);
    SEAM(3);
    if (IN(4)) phase_mixers(a, lds);
    SEAM(4);
    if (IN(5)) phase_gla_fin(a);
    SEAM(5);
    if (IN(6)) gemm8(lds, (const u16*)(a.ws + WS_ACT), (const u16*)(a.ws + WS_WOUT), T, D, D, EpiResid{a.x, mod, (float*)(a.ws + WS_X1)});
    SEAM(6);
    if (IN(7)) { norm_mod_phase((const float*)(a.ws + WS_X1), a.g_ffn, mod, 3, 4, (u16*)(a.ws + WS_ACT)); convert_tables(a); }
    SEAM(7);
    if (IN(8)) gemm8(lds, (const u16*)(a.ws + WS_ACT), (const u16*)(a.ws + WS_WPQ), T, D, D, EpiBf16{(u16*)(a.ws + WS_Q)});
    SEAM(8);
    if (IN(9)) phase_route(a, lds);
    SEAM(9);
    if (IN(10)) phase_experts(a);
#ifdef PROBE_REP10
    grid.sync(); phase_experts(a);
#endif
#ifdef PROBE_REP9
    grid.sync(); phase_route(a, lds); grid.sync(); phase_experts(a);
#endif
#undef IN
#undef SEAM
}

#ifndef MK_ONE_LAUNCH
#define MK_ONE_LAUNCH 1
#endif
extern "C" void kernel_launch(void* const* d_in, const int* in_sizes, int n_in, void* d_out, int out_size, void* d_ws, size_t ws_size, hipStream_t stream) {
    static int grid = 0;
    if (grid == 0) {
        if (n_in != 19 || out_size != T * D || ws_size < WS_END) {
            fprintf(stderr, "kernel_launch: unexpected shapes: n_in %d out %d ws %zu (need %zu)\n", n_in, out_size, ws_size, (size_t)WS_END);
            grid = -1; return;
        }
        int dev = 0, cus = 0, per_cu = 0;
        (void)hipGetDevice(&dev);
        (void)hipDeviceGetAttribute(&cus, hipDeviceAttributeMultiprocessorCount, dev);
        (void)hipFuncSetAttribute((const void*)mk_fwd, hipFuncAttributeMaxDynamicSharedMemorySize, LDS_BYTES);
        (void)hipOccupancyMaxActiveBlocksPerMultiprocessor(&per_cu, (const void*)mk_fwd, NTHREADS, LDS_BYTES);
        if (per_cu < 1) { fprintf(stderr, "kernel_launch: occupancy query says %d blocks/CU\n", per_cu); grid = -1; return; }
        grid = cus;
        (void)hipGetLastError();
    }
    if (grid < 0) return;
    Args a{};
    a.x = (const float*)d_in[0]; a.c = (const float*)d_in[1]; a.pos = (const int*)d_in[2]; a.w_ada = (const float*)d_in[3];
    a.b_ada = (const float*)d_in[4]; a.g_mix = (const float*)d_in[5]; a.w_in = (const float*)d_in[6]; a.wgf = (const float*)d_in[7];
    a.bgf = (const float*)d_in[8]; a.wgb = (const float*)d_in[9]; a.bgb = (const float*)d_in[10]; a.g_gla = (const float*)d_in[11];
    a.w_out = (const float*)d_in[12]; a.g_ffn = (const float*)d_in[13]; a.w_pq = (const float*)d_in[14]; a.subk = (const float*)d_in[15];
    a.pu = (const float*)d_in[16]; a.pv = (const float*)d_in[17]; a.g_fin = (const float*)d_in[18];
    a.out = (float*)d_out; a.ws = (unsigned char*)d_ws;
#if MK_ONE_LAUNCH
    (void)hipMemsetAsync((unsigned char*)d_ws + WS_CTL, 0, XCD_BAR_WORDS * 4, stream);
    a.ph_lo = 0; a.ph_hi = NPHASES;
    void* args[] = {&a};
    hipError_t e = hipLaunchCooperativeKernel((const void*)mk_fwd, dim3(grid), dim3(NTHREADS), args, LDS_BYTES, stream);
    if (e != hipSuccess) fprintf(stderr, "cooperative launch failed: %s (grid %d)\n", hipGetErrorString(e), grid);
#else
    for (int p = 0; p < NPHASES; ++p) {
        a.ph_lo = p; a.ph_hi = p + 1;
        hipLaunchKernelGGL(mk_fwd, dim3(grid), dim3(NTHREADS), LDS_BYTES, stream, a);
    }
#endif
}
```

```cpp
#include <hip/hip_runtime.h>
#include <hip/hip_cooperative_groups.h>
#include <cstdio>
#include <cstdint>

namespace cg = cooperative_groups;

typedef unsigned short u16;
typedef __attribute__((ext_vector_type(8))) short bf16x8;
typedef __attribute__((ext_vector_type(4))) float f32x4;
typedef short s16x4 __attribute__((ext_vector_type(4)));
#define TID ((int)threadIdx.x)
#define BID ((int)blockIdx.x)
#define GDIM ((int)gridDim.x)
#define LAS __attribute__((address_space(3)))

constexpr int D = 2048, NB = 4, S = 4096, T = NB * S;
constexpr int INW = 6176;
constexpr int NP = 6144;
constexpr int NPAD = 6208;
constexpr int C_GQ = 0, C_GK = 512, C_GV = 1024, C_GR = 2048, C_DQ = 3072, C_DK = 4096, C_DV = 5120;
constexpr int NTHREADS = 512, NWAVES = 8;
constexpr int LDS_MAIN = 128 * 1024;
constexpr int LDS_BYTES = LDS_MAIN + 16;
constexpr float NORM_EPS = 1e-6f;

constexpr size_t WS_CTL = 0;
constexpr size_t WS_MOD = 65536;
constexpr size_t WS_CS = 524288;
constexpr size_t WS_WIN = WS_CS + (size_t)T * 64 * 8;
constexpr size_t WS_WOUT = WS_WIN + (size_t)NPAD * D * 2;
constexpr size_t WS_WPQ = WS_WOUT + (size_t)D * D * 2;
constexpr size_t WS_ACT = WS_WPQ + (size_t)D * D * 2;
constexpr size_t WS_P = WS_ACT + (size_t)T * D * 2;
constexpr size_t WS_X1 = WS_P;
constexpr size_t WS_Q = WS_P + (size_t)T * D * 4;
constexpr size_t WS_GZ = WS_P + (size_t)T * NP * 2;
constexpr int GLA_NPREP = NB * 4 * 2 * (S / 64);
constexpr size_t WS_QD = WS_GZ + (size_t)T * 32 * 4;
constexpr size_t WS_KE = WS_QD + (size_t)GLA_NPREP * 16384;
constexpr size_t WS_AT = WS_KE + (size_t)GLA_NPREP * 16384;
constexpr size_t WS_DEC = WS_AT + (size_t)GLA_NPREP * 8192;
constexpr size_t WS_OFB = WS_DEC + (size_t)GLA_NPREP * 512;
constexpr size_t WS_IDX = WS_OFB + (size_t)2 * T * 1024 * 2;
constexpr size_t WS_GATE = WS_IDX + (size_t)T * 128 * 4;
constexpr size_t WS_END = WS_GATE + (size_t)T * 128 * 4;
constexpr size_t WS_TU = WS_QD;
constexpr size_t WS_TV = WS_QD + (size_t)16384 * 1152;
static_assert(WS_TV + (size_t)16384 * 1152 <= WS_IDX, "table region");

struct Args {
    const float* x; const float* c; const int* pos; const float* w_ada; const float* b_ada; const float* g_mix;
    const float* w_in; const float* wgf; const float* bgf; const float* wgb; const float* bgb; const float* g_gla;
    const float* w_out; const float* g_ffn; const float* w_pq; const float* subk; const float* pu; const float* pv; const float* g_fin;
    float* out; unsigned char* ws; int ph_lo, ph_hi;
};

__device__ __forceinline__ float bf2f(u16 h) { return __uint_as_float(((unsigned)h) << 16); }
typedef __bf16 hw_bf16x2 __attribute__((ext_vector_type(2)));
typedef float hw_f32x2 __attribute__((ext_vector_type(2)));
__device__ __forceinline__ unsigned pack2(float a, float b) { const hw_f32x2 f = {a, b}; return __builtin_bit_cast(unsigned, __builtin_convertvector(f, hw_bf16x2)); }
__device__ __forceinline__ u16 f2bf(float f) { return (u16)(pack2(f, 0.f) & 0xffffu); }
__device__ __forceinline__ float lo2f(unsigned p) { return __uint_as_float(p << 16); }
__device__ __forceinline__ float hi2f(unsigned p) { return __uint_as_float(p & 0xffff0000u); }
__device__ __forceinline__ float wave_sum(float v) {
#pragma unroll
    for (int o = 32; o > 0; o >>= 1) v += __shfl_xor(v, o);
    return v;
}
__device__ __forceinline__ float wave_max(float v) {
#pragma unroll
    for (int o = 32; o > 0; o >>= 1) v = fmaxf(v, __shfl_xor(v, o));
    return v;
}
__device__ __forceinline__ float silu_f(float v) { return v / (1.f + __expf(-v)); }
__device__ __forceinline__ float gelu_f(float a) { return 0.5f * a * (1.f + erff(a * 0.70710678118654752f)); }
__device__ __forceinline__ float logsigmoid_f(float z) { return z < 0.f ? z - log1pf(expf(z)) : -log1pf(expf(-z)); }

__device__ __forceinline__ void p0_mod(const Args& a, unsigned char* lds, int bi) {
    float* sc = (float*)lds;
    float* red = sc + 4 * 2048;
    const int tid = threadIdx.x, lane = tid & 63, wave = tid >> 6;
    for (int i = tid; i < 4 * 2048; i += NTHREADS) sc[i] = silu_f(a.c[i]);
    __syncthreads();
    const int j0 = bi * 256 + lane * 4;
    float acc[4][4];
#pragma unroll
    for (int b = 0; b < 4; ++b)
#pragma unroll
        for (int q = 0; q < 4; ++q) acc[b][q] = 0.f;
    const int k0 = wave * 256;
#pragma unroll 4
    for (int kk = 0; kk < 256; ++kk) {
        const int k = k0 + kk;
        const float4 w = *(const float4*)(a.w_ada + (size_t)k * 12288 + j0);
#pragma unroll
        for (int b = 0; b < 4; ++b) {
            const float s = sc[b * 2048 + k];
            acc[b][0] += s * w.x; acc[b][1] += s * w.y; acc[b][2] += s * w.z; acc[b][3] += s * w.w;
        }
    }
#pragma unroll
    for (int b = 0; b < 4; ++b)
#pragma unroll
        for (int q = 0; q < 4; ++q) red[(wave * 4 + b) * 256 + lane * 4 + q] = acc[b][q];
    __syncthreads();
    float* mod = (float*)(a.ws + WS_MOD);
    for (int i = tid; i < 4 * 256; i += NTHREADS) {
        const int b = i >> 8, jc = i & 255;
        float s = 0.f;
#pragma unroll
        for (int w = 0; w < 8; ++w) s += red[(w * 4 + b) * 256 + jc];
        mod[b * 12288 + bi * 256 + jc] = s + a.b_ada[bi * 256 + jc];
    }
    __syncthreads();
}

__device__ __forceinline__ void p0_transpose_item(const float* __restrict__ W, int ldw, int k0, int src_col0, int n_valid,
                                                  u16* __restrict__ WT, int ldt, int n_out0, unsigned char* lds) {
    u16* tl = (u16*)lds;
    const int tid = threadIdx.x;
    {
        const int k = tid >> 3, nc = (tid & 7) * 8;
        float v[8];
        if (nc < n_valid) {
            const float4 v0 = *(const float4*)(W + (size_t)(k0 + k) * ldw + src_col0 + nc);
            const float4 v1 = *(const float4*)(W + (size_t)(k0 + k) * ldw + src_col0 + nc + 4);
            v[0] = v0.x; v[1] = v0.y; v[2] = v0.z; v[3] = v0.w; v[4] = v1.x; v[5] = v1.y; v[6] = v1.z; v[7] = v1.w;
        } else {
#pragma unroll
            for (int i = 0; i < 8; ++i) v[i] = 0.f;
        }
#pragma unroll
        for (int i = 0; i < 8; ++i) tl[(nc + i) * 72 + k] = f2bf(v[i]);
    }
    __syncthreads();
    {
        const int n = tid >> 3, kc = (tid & 7) * 8;
        const uint4 v = *(const uint4*)(tl + n * 72 + kc);
        *(uint4*)(WT + (size_t)(n_out0 + n) * ldt + k0 + kc) = v;
    }
    __syncthreads();
}

__device__ __forceinline__ void phase0(const Args& a, unsigned char* lds) {
    const int bi = blockIdx.x, G = gridDim.x, tid = threadIdx.x;
    if (bi < 48) p0_mod(a, lds, bi);
    constexpr int I_IN = 32 * (NPAD / 64), I_SQ = 32 * 32;
    u16* WinT = (u16*)(a.ws + WS_WIN); u16* WoutT = (u16*)(a.ws + WS_WOUT); u16* WpqT = (u16*)(a.ws + WS_WPQ);
    for (int it = bi; it < I_IN + 2 * I_SQ; it += G) {
        if (it < I_IN) {
            const int kt = it & 31, nt = it >> 5;
            const int n0 = nt * 64;
            int src, nv;
            if (n0 < 3072) { src = n0; nv = 64; }
            else if (n0 < 6144) { src = n0 + 32; nv = 64; }
            else if (n0 == 6144) { src = 3072; nv = 32; }
            else { src = 0; nv = 0; }
            p0_transpose_item(a.w_in, INW, kt * 64, src, nv, WinT, D, n0, lds);
        } else if (it < I_IN + I_SQ) {
            const int r = it - I_IN; const int kt = r & 31, nt = r >> 5;
            p0_transpose_item(a.w_out, D, kt * 64, nt * 64, 64, WoutT, D, nt * 64, lds);
        } else {
            const int r = it - I_IN - I_SQ; const int kt = r & 31, nt = r >> 5;
            p0_transpose_item(a.w_pq, D, kt * 64, nt * 64, 64, WpqT, D, nt * 64, lds);
        }
    }
    float2* cs = (float2*)(a.ws + WS_CS);
    for (int i = bi * NTHREADS + tid; i < T * 64; i += G * NTHREADS) {
        const int t = i >> 6, f = i & 63;
        const float inv_freq = powf(10000.0f, -(float)f * 2.0f / 128.0f);
        const float ang = (float)a.pos[t] * inv_freq;
        const double rev = (double)ang * 0.15915494309189533577;
        const float fr = (float)(rev - floor(rev));
        cs[i] = make_float2(__builtin_amdgcn_cosf(fr), __builtin_amdgcn_sinf(fr));
    }
}

template <bool BF16IN> __device__ __forceinline__ void norm_mod_phase(const void* __restrict__ xin_, const float* __restrict__ g, const float* __restrict__ mod,
                                               int sh_chunk, int sc_chunk, u16* __restrict__ outp) {
    const int lane = threadIdx.x & 63, wave = threadIdx.x >> 6;
    const int gw = blockIdx.x * NWAVES + wave, NGW = gridDim.x * NWAVES;
    for (int t = gw; t < T; t += NGW) {
        const int b = t / S;
        float4 v[8]; float ss = 0.f;
        if (BF16IN) {
            const uint2* xr = (const uint2*)((const u16*)xin_ + (size_t)t * D);
#pragma unroll
            for (int m = 0; m < 8; ++m) { const uint2 p = xr[lane + 64 * m]; v[m] = make_float4(lo2f(p.x), hi2f(p.x), lo2f(p.y), hi2f(p.y)); }
        } else {
            const float4* xr = (const float4*)((const float*)xin_ + (size_t)t * D);
#pragma unroll
            for (int m = 0; m < 8; ++m) v[m] = xr[lane + 64 * m];
        }
#pragma unroll
        for (int m = 0; m < 8; ++m) ss += v[m].x * v[m].x + v[m].y * v[m].y + v[m].z * v[m].z + v[m].w * v[m].w;
        ss = wave_sum(ss);
        const float rstd = rsqrtf(ss * (1.f / D) + NORM_EPS);
        const float4* gp = (const float4*)g;
        const float4* shp = (const float4*)(mod + b * 12288 + sh_chunk * 2048);
        const float4* scp = (const float4*)(mod + b * 12288 + sc_chunk * 2048);
        uint2* op = (uint2*)(outp + (size_t)t * D);
#pragma unroll
        for (int m = 0; m < 8; ++m) {
            const int i = lane + 64 * m;
            const float4 gg = gp[i], sh = shp[i], sc = scp[i];
            const float h0 = v[m].x * rstd * gg.x * (1.f + sc.x) + sh.x;
            const float h1 = v[m].y * rstd * gg.y * (1.f + sc.y) + sh.y;
            const float h2 = v[m].z * rstd * gg.z * (1.f + sc.z) + sh.z;
            const float h3 = v[m].w * rstd * gg.w * (1.f + sc.w) + sh.w;
            op[i] = make_uint2(pack2(h0, h1), pack2(h2, h3));
        }
    }
}

namespace pg8 {
#define PG8_LAS __attribute__((address_space(3)))
typedef unsigned short bf16_t;
typedef short bf16x8 __attribute__((ext_vector_type(8)));
typedef float f32x4 __attribute__((ext_vector_type(4)));
typedef unsigned u32x4 __attribute__((ext_vector_type(4)));
constexpr int BM = 256, BK = 64, HALF = 128, HTB = HALF * BK * 2  , STAGE_BYTES = 8 * HTB, NXCD = 8, WGM = 8;

__host__ __device__ __forceinline__ int lds_byte(int r, int c) { const int st = (r >> 4) * 2 + (c >> 5), rr = r & 15, cc = c & 31, ob = rr * 64 + cc * 2; return st * 1024 + (ob ^ (((ob >> 9) & 1) << 5)); }
__host__ __device__ __forceinline__ void stage_rc(int b, int& R, int& C) { const int st = b / 1024, sb = b % 1024, swz = sb ^ (((sb >> 9) & 1) << 5); R = (st >> 1) * 16 + swz / 64; C = (st & 1) * 32 + (swz % 64) / 2; }
__host__ __device__ __forceinline__ int perm32(int rho) { const int n = rho >> 4, i = rho & 15; return 8 * (i >> 2) + 4 * n + (i & 3); }

struct Unit { int pm, pn; };
struct Gemm { const bf16_t* A; const bf16_t* Bt; int M, N, K; };

struct StaticOrder {
    int nM, nN, nwg, G, c;
    __host__ __device__ void init(int M, int N, int G_, int c_) { nM = M / BM; nN = N / BM; nwg = nM * nN; G = G_; c = c_; }
    __host__ __device__ bool next(int i, Unit& u) const {
        const long L = (long)i * G + c; if (L >= nwg) return false;
        int wgid = (int)L; { const int q = nwg / NXCD, r = nwg % NXCD, xcd = wgid % NXCD, off = wgid / NXCD; wgid = (xcd < r ? xcd * (q + 1) : r * (q + 1) + (xcd - r) * q) + off; }
        const int nig = WGM * nN, gid = wgid / nig, fm = gid * WGM, gsz = (nM - fm) < WGM ? (nM - fm) : WGM;
        u.pm = fm + ((wgid % nig) % gsz); u.pn = (wgid % nig) / gsz; return true;
    }
    __device__ __forceinline__ void a_ready(const Unit&) const {}
    __device__ __forceinline__ void done(const Unit&) const {}
};
__device__ __forceinline__ unsigned cvt_pk_bf16(float lo, float hi) { unsigned r; asm volatile("v_cvt_pk_bf16_f32 %0, %1, %2" : "=v"(r) : "v"(lo), "v"(hi)); return r; }
typedef float f32x2 __attribute__((ext_vector_type(2)));
template <class Epi, class Sched, bool STAMP = false>
__device__ __forceinline__ void gemm_phase(PG8_LAS unsigned char* lds, const Gemm g, const Sched& S, const Epi& E, unsigned long long* stamps) {
    const int tid = threadIdx.x, wid = __builtin_amdgcn_readfirstlane(tid >> 6), lane = tid & 63, wr = wid >> 2, wc = wid & 3, fr = lane & 15, fq = lane >> 4;
    const int K = g.K, nt = K / BK;
    int ts_lo = 0, ts_hi = 0, nts = 0; const unsigned long long rt_entry = STAMP ? (unsigned long long)wall_clock64() : 0ull;
#define PG8_STAMP() do { if (STAMP && wid == 0 && nts < 64) { const unsigned long long _c = (unsigned long long)clock64(); \
        ts_lo = (lane == nts) ? (int)(unsigned)_c : ts_lo; ts_hi = (lane == nts) ? (int)(unsigned)(_c >> 32) : ts_hi; ++nts; } } while (0)
    PG8_STAMP();
    unsigned voffA[2], voffB[2];
#pragma unroll
    for (int i = 0; i < 2; ++i) { int R, C; stage_rc(tid * 16 + i * 8192, R, C); const int Rb = Epi::PERM ? ((R & ~31) + perm32(R & 31)) : R;
        voffA[i] = (unsigned)(R * K + C) * 2u; voffB[i] = (unsigned)(Rb * K + C) * 2u; }
    const size_t kstep = (size_t)(BK * 2);
    const size_t hstep = (size_t)HALF * K * 2;
    const size_t tstep = 2 * hstep;
    const unsigned ldsw = (unsigned)wid * 1024u;
    const int aoff = lds_byte(wr * 64 + fr, fq * 8), boff = lds_byte(wc * 32 + fr, fq * 8);
#define PG8_SA(b, h) (((b) * 2 + (h)) * HTB)
#define PG8_SB(b, h) ((4 + (b) * 2 + (h)) * HTB)
#define PG8_STAGE(bufoff, gbase, voff) do { _Pragma("unroll") for (int _i = 0; _i < 2; ++_i) \
        __builtin_amdgcn_global_load_lds((const unsigned*)((const char*)(gbase) + (voff)[_i]), (PG8_LAS unsigned*)(lds + (bufoff) + ldsw + _i * 8192), 16, 0, 0); } while (0)
#define PG8_LDA(dst, b, h) do { _Pragma("unroll") for (int m = 0; m < 4; ++m) _Pragma("unroll") for (int k = 0; k < 2; ++k) dst[m][k] = *(const PG8_LAS bf16x8*)(lds + PG8_SA(b, h) + aoff + m * 2048 + k * 1024); } while (0)
#define PG8_LDB(dst, b, h) do { _Pragma("unroll") for (int n = 0; n < 2; ++n) _Pragma("unroll") for (int k = 0; k < 2; ++k) dst[n][k] = *(const PG8_LAS bf16x8*)(lds + PG8_SB(b, h) + boff + n * 2048 + k * 1024); } while (0)
#define PG8_MMA(ai, bj, At, Bt) do { __builtin_amdgcn_s_setprio(1); _Pragma("unroll") for (int m = 0; m < 4; ++m) _Pragma("unroll") for (int n = 0; n < 2; ++n) _Pragma("unroll") for (int k = 0; k < 2; ++k) \
        acc[ai][bj][m][n] = __builtin_amdgcn_mfma_f32_16x16x32_bf16(Bt[n][k], At[m][k], acc[ai][bj][m][n], 0, 0, 0); __builtin_amdgcn_s_setprio(0); } while (0)
#define PG8_WAIT_V(n) asm volatile("s_waitcnt vmcnt(" #n ")" ::: "memory")
#define PG8_WAIT_L(n) asm volatile("s_waitcnt lgkmcnt(" #n ")" ::: "memory")
#define PG8_BAR __builtin_amdgcn_s_barrier()
#define PG8_SCHED __builtin_amdgcn_sched_barrier(0)
    Unit cur, nxt; int ui = 0;
    if (!S.next(0, cur)) return;
    f32x4 acc[2][2][4][2];
#pragma unroll
    for (int a = 0; a < 2; ++a)
#pragma unroll
        for (int b = 0; b < 2; ++b)
#pragma unroll
            for (int m = 0; m < 4; ++m)
#pragma unroll
                for (int n = 0; n < 2; ++n) acc[a][b][m][n] = (f32x4){0.f, 0.f, 0.f, 0.f};
    bf16x8 At[4][2], B0[2][2], B1[2][2];
    const char* cA = (const char*)g.A + (size_t)cur.pm * tstep; const char* cB = (const char*)g.Bt + (size_t)cur.pn * tstep;
    S.a_ready(cur);
    PG8_STAGE(PG8_SB(0, 0), cB, voffB); PG8_STAGE(PG8_SA(0, 0), cA, voffA); PG8_STAGE(PG8_SB(0, 1), cB + hstep, voffB); PG8_STAGE(PG8_SA(0, 1), cA + hstep, voffA);
    if (wr == 1) PG8_BAR;
    PG8_WAIT_V(4); PG8_BAR;
    PG8_STAGE(PG8_SB(1, 0), cB + kstep, voffB); PG8_STAGE(PG8_SA(1, 0), cA + kstep, voffA); PG8_STAGE(PG8_SB(1, 1), cB + hstep + kstep, voffB);
    PG8_WAIT_V(6); PG8_BAR;
    PG8_STAMP();
    for (;;) {
        const bool has_next = S.next(ui + 1, nxt);
        const char* nA = has_next ? (const char*)g.A + (size_t)nxt.pm * tstep : cA; const char* nB = has_next ? (const char*)g.Bt + (size_t)nxt.pn * tstep : cB;
        for (int t = 0; t < nt; t += 2) {
            const bool last = (t == nt - 2);
            const char* a1 = cA + (size_t)(t + 1) * kstep;
            const char* a2 = last ? nA : cA + (size_t)(t + 2) * kstep; const char* b2 = last ? nB : cB + (size_t)(t + 2) * kstep;
            const char* a3 = a2 + kstep; const char* b3 = b2 + kstep;
            if (last && has_next) S.a_ready(nxt);
            PG8_LDB(B0, 0, 0); PG8_SCHED; PG8_LDA(At, 0, 0); PG8_STAGE(PG8_SA(1, 1), a1 + hstep, voffA);
            PG8_WAIT_L(8); PG8_BAR; PG8_WAIT_L(0); PG8_MMA(0, 0, At, B0); PG8_BAR; PG8_SCHED;
            PG8_LDB(B1, 0, 1); PG8_STAGE(PG8_SB(0, 0), b2, voffB);
            PG8_BAR; PG8_WAIT_L(0); PG8_MMA(0, 1, At, B1); PG8_BAR;
            PG8_LDA(At, 0, 1); PG8_STAGE(PG8_SA(0, 0), a2, voffA);
            PG8_BAR; PG8_WAIT_L(0); PG8_MMA(1, 0, At, B0); PG8_BAR; PG8_SCHED;
            PG8_STAGE(PG8_SB(0, 1), b2 + hstep, voffB);
            PG8_WAIT_V(6); PG8_BAR; PG8_MMA(1, 1, At, B1); PG8_BAR;
            PG8_LDB(B0, 1, 0); PG8_SCHED; PG8_LDA(At, 1, 0); PG8_STAGE(PG8_SA(0, 1), a2 + hstep, voffA);
            PG8_WAIT_L(8); PG8_BAR; PG8_WAIT_L(0); PG8_MMA(0, 0, At, B0); PG8_BAR; PG8_SCHED;
            PG8_LDB(B1, 1, 1); PG8_STAGE(PG8_SB(1, 0), b3, voffB);
            PG8_BAR; PG8_WAIT_L(0); PG8_MMA(0, 1, At, B1); PG8_BAR;
            PG8_LDA(At, 1, 1); PG8_STAGE(PG8_SA(1, 0), a3, voffA);
            PG8_BAR; PG8_WAIT_L(0); PG8_MMA(1, 0, At, B0); PG8_BAR; PG8_SCHED;
            PG8_STAGE(PG8_SB(1, 1), b3 + hstep, voffB);
            PG8_WAIT_V(6); PG8_BAR; PG8_MMA(1, 1, At, B1); PG8_BAR;
        }
        PG8_STAMP();
        if constexpr (!Epi::AFTER_DRAIN) { E(acc, cur, wr, wc, fr, fq); S.done(cur); }
        PG8_STAMP();
        if (!has_next) break;
#pragma unroll
        for (int a = 0; a < 2; ++a)
#pragma unroll
            for (int b = 0; b < 2; ++b)
#pragma unroll
                for (int m = 0; m < 4; ++m)
#pragma unroll
                    for (int n = 0; n < 2; ++n) acc[a][b][m][n] = (f32x4){0.f, 0.f, 0.f, 0.f};
        cur = nxt; cA = nA; cB = nB; ++ui;
    }
    PG8_WAIT_V(0);
    if (wr == 0) PG8_BAR;
    PG8_BAR;
    if constexpr (Epi::AFTER_DRAIN) { E.fused(acc, cur, wr, wc, fr, fq, lds, wid, lane); S.done(cur); }
    PG8_STAMP();
    if (STAMP && wid == 0) { stamps[lane] = lane < nts ? (((unsigned long long)(unsigned)ts_hi << 32) | (unsigned)ts_lo) : 0ull;
        if (lane == 62) stamps[62] = rt_entry; if (lane == 63) stamps[63] = (unsigned long long)wall_clock64(); }
#undef PG8_STAMP
#undef PG8_SA
#undef PG8_SB
#undef PG8_STAGE
#undef PG8_LDA
#undef PG8_LDB
#undef PG8_MMA
#undef PG8_WAIT_V
#undef PG8_WAIT_L
#undef PG8_BAR
#undef PG8_SCHED
}
}

struct EpiProj {
    static constexpr bool PERM = true, AFTER_DRAIN = false;
    u16* P;
    __device__ __forceinline__ void operator()(const pg8::f32x4 (&acc)[2][2][4][2], const pg8::Unit& u, int wr, int wc, int fr, int fq) const {
        const int row0 = u.pm * 256 + wr * 64 + fr;
        const int col0 = u.pn * 256 + wc * 32 + 8 * fq;
#pragma unroll
        for (int ai = 0; ai < 2; ++ai)
#pragma unroll
            for (int m = 0; m < 4; ++m) { u16* rowp = P + (size_t)(row0 + ai * 128 + m * 16) * NP + col0;
#pragma unroll
                for (int bj = 0; bj < 2; ++bj) { const pg8::f32x4 v0 = acc[ai][bj][m][0], v1 = acc[ai][bj][m][1];
                    pg8::u32x4 w; w.x = pg8::cvt_pk_bf16(v0[0], v0[1]); w.y = pg8::cvt_pk_bf16(v0[2], v0[3]); w.z = pg8::cvt_pk_bf16(v1[0], v1[1]); w.w = pg8::cvt_pk_bf16(v1[2], v1[3]);
                    *(pg8::u32x4*)(rowp + bj * 128) = w; } }
    }
};
__device__ __forceinline__ void gz_phase(unsigned char* lds, const u16* __restrict__ H1, const u16* __restrict__ Wg, float* __restrict__ gz) {
    const int tid = threadIdx.x, lane = tid & 63, wave = tid >> 6, fr = lane & 15, fq = lane >> 4;
    float* red = (float*)lds;
    for (int rb = blockIdx.x; rb < T / 64; rb += gridDim.x) {
        const int r0 = rb * 64, k0 = wave * 256;
        f32x4 acc[4][2];
#pragma unroll
        for (int m = 0; m < 4; ++m) { acc[m][0] = (f32x4){0.f, 0.f, 0.f, 0.f}; acc[m][1] = (f32x4){0.f, 0.f, 0.f, 0.f}; }
#pragma unroll
        for (int ks = 0; ks < 8; ++ks) {
            bf16x8 af[4], bfr[2];
#pragma unroll
            for (int m = 0; m < 4; ++m) af[m] = *(const bf16x8*)(H1 + (size_t)(r0 + 16 * m + fr) * D + k0 + 32 * ks + 8 * fq);
#pragma unroll
            for (int n = 0; n < 2; ++n) bfr[n] = *(const bf16x8*)(Wg + (size_t)(16 * n + fr) * D + k0 + 32 * ks + 8 * fq);
#pragma unroll
            for (int m = 0; m < 4; ++m)
#pragma unroll
                for (int n = 0; n < 2; ++n) acc[m][n] = __builtin_amdgcn_mfma_f32_16x16x32_bf16(af[m], bfr[n], acc[m][n], 0, 0, 0);
        }
        __syncthreads();
#pragma unroll
        for (int m = 0; m < 4; ++m)
#pragma unroll
            for (int n = 0; n < 2; ++n)
#pragma unroll
                for (int j = 0; j < 4; ++j) red[(wave * 64 + 16 * m + 4 * fq + j) * 32 + 16 * n + fr] = acc[m][n][j];
        __syncthreads();
#pragma unroll
        for (int k = 0; k < 4; ++k) {
            const int e = tid + 512 * k;
            float s = 0.f;
#pragma unroll
            for (int w = 0; w < 8; ++w) s += red[w * 2048 + e];
            gz[(size_t)r0 * 32 + e] = s;
        }
    }
    __syncthreads();
}
struct EpiResid {
    static constexpr bool PERM = true, AFTER_DRAIN = false;
    const float* x; const float* mod; u16* x1;
    __device__ __forceinline__ void operator()(const pg8::f32x4 (&acc)[2][2][4][2], const pg8::Unit& u, int wr, int wc, int fr, int fq) const {
        const int row0 = u.pm * 256 + wr * 64 + fr, col0 = u.pn * 256 + wc * 32 + 8 * fq;
        const int b = (u.pm * 256) / S;
        pg8::f32x4 ga[2][2];
#pragma unroll
        for (int bj = 0; bj < 2; ++bj)
#pragma unroll
            for (int n = 0; n < 2; ++n) ga[bj][n] = *(const pg8::f32x4*)(mod + b * 12288 + 2 * 2048 + col0 + bj * 128 + 4 * n);
#pragma unroll
        for (int ai = 0; ai < 2; ++ai)
#pragma unroll
            for (int m = 0; m < 4; ++m) { const size_t off = (size_t)(row0 + ai * 128 + m * 16) * D + col0;
#pragma unroll
                for (int bj = 0; bj < 2; ++bj) {
                    const pg8::f32x4 x0 = *(const pg8::f32x4*)(x + off + bj * 128), x1v = *(const pg8::f32x4*)(x + off + bj * 128 + 4);
                    const pg8::f32x4 v0 = x0 + ga[bj][0] * acc[ai][bj][m][0], v1 = x1v + ga[bj][1] * acc[ai][bj][m][1];
                    pg8::u32x4 w; w.x = pg8::cvt_pk_bf16(v0[0], v0[1]); w.y = pg8::cvt_pk_bf16(v0[2], v0[3]); w.z = pg8::cvt_pk_bf16(v1[0], v1[1]); w.w = pg8::cvt_pk_bf16(v1[2], v1[3]);
                    *(pg8::u32x4*)(x1 + off + bj * 128) = w; } }
    }
};
struct EpiBf16 {
    static constexpr bool PERM = true, AFTER_DRAIN = false;
    u16* Q;
    __device__ __forceinline__ void operator()(const pg8::f32x4 (&acc)[2][2][4][2], const pg8::Unit& u, int wr, int wc, int fr, int fq) const {
        const int row0 = u.pm * 256 + wr * 64 + fr, col0 = u.pn * 256 + wc * 32 + 8 * fq;
#pragma unroll
        for (int ai = 0; ai < 2; ++ai)
#pragma unroll
            for (int m = 0; m < 4; ++m) { u16* rowp = Q + (size_t)(row0 + ai * 128 + m * 16) * D + col0;
#pragma unroll
                for (int bj = 0; bj < 2; ++bj) { const pg8::f32x4 v0 = acc[ai][bj][m][0], v1 = acc[ai][bj][m][1];
                    pg8::u32x4 w; w.x = pg8::cvt_pk_bf16(v0[0], v0[1]); w.y = pg8::cvt_pk_bf16(v0[2], v0[3]); w.z = pg8::cvt_pk_bf16(v1[0], v1[1]); w.w = pg8::cvt_pk_bf16(v1[2], v1[3]);
                    *(pg8::u32x4*)(rowp + bj * 128) = w; } }
    }
};
template <class Epi>
__device__ __forceinline__ void gemm8(unsigned char* lds, const u16* A, const u16* Bt, int M, int N, int K, const Epi& E) {
    pg8::Gemm g{A, Bt, M, N, K}; pg8::StaticOrder So; So.init(M, N, (int)gridDim.x, (int)blockIdx.x);
    pg8::gemm_phase<Epi, pg8::StaticOrder, false>((PG8_LAS unsigned char*)lds, g, So, E, nullptr);
    __syncthreads();
}

#define GLA_QD_BYTES 16384
#define GLA_AT_BYTES 8192
__device__ __forceinline__ float gla_logsigmoid(float z) { return fminf(z, 0.f) - __logf(1.f + __expf(-fabsf(z))); }

__device__ __forceinline__ void gla_prep_item(const u16* __restrict__ P, int ldp, int cq, int ck, const float* __restrict__ gz,
                                              const float* __restrict__ wg_f, const float* __restrict__ bg_f, const float* __restrict__ wg_b, const float* __restrict__ bg_b,
                                              int Sq, unsigned char* __restrict__ QDg, unsigned char* __restrict__ KEg, unsigned char* __restrict__ ATg, float* __restrict__ DECg,
                                              unsigned char* lds, int item) {
    const int nch = Sq / 64;
    const int c = item % nch, dir = (item / nch) & 1, hh = (item / (nch * 2)) & 3, b = item / (nch * 8);
    const int tid = TID, lane = tid & 63, wave = tid >> 6, li = lane & 15, fq = lane >> 4;
    float* gzs = (float*)lds;
    float* segs = gzs + 64 * 16;
    unsigned char* QDs = lds + 8192;
    unsigned char* KIs = QDs + 16384;
    unsigned char* KEs = KIs + 16384;
    float* bmat = (float*)(KEs + 16384);
    const size_t tok0 = (size_t)b * Sq;
    __syncthreads();
    uint4 rq0, rq1, rk0, rk1;
    {
        const int i0 = tid >> 4, i1 = (tid + 512) >> 4, cc = tid & 15;
        const int s0 = dir ? (Sq - 1 - (64 * c + i0)) : (64 * c + i0), s1 = dir ? (Sq - 1 - (64 * c + i1)) : (64 * c + i1);
        rq0 = *(const uint4*)(P + (tok0 + s0) * ldp + cq + hh * 128 + cc * 8); rk0 = *(const uint4*)(P + (tok0 + s0) * ldp + ck + hh * 128 + cc * 8);
        rq1 = *(const uint4*)(P + (tok0 + s1) * ldp + cq + hh * 128 + cc * 8); rk1 = *(const uint4*)(P + (tok0 + s1) * ldp + ck + hh * 128 + cc * 8);
    }
    for (int e = tid; e < 64 * 16; e += 512) {
        const int i = e >> 4, r = e & 15;
        const int s = dir ? (Sq - 1 - (64 * c + i)) : (64 * c + i);
        gzs[e] = gz[(tok0 + s) * 32 + dir * 16 + r];
    }
    const int d = tid & 127, seg = tid >> 7;
    const float* wg = dir ? wg_b : wg_f;
    float wcol[16];
#pragma unroll
    for (int r = 0; r < 16; ++r) wcol[r] = wg[r * 512 + hh * 128 + d];
    const float bias = (dir ? bg_b : bg_f)[hh * 128 + d];
    __syncthreads();
    float run = 0.f;
#pragma unroll
    for (int k = 0; k < 16; ++k) {
        const int i = 16 * seg + k;
        float z = bias;
#pragma unroll
        for (int r = 0; r < 16; ++r) z += gzs[i * 16 + r] * wcol[r];
        run += gla_logsigmoid(z) * (1.f / 16.f);
        bmat[i * 128 + d] = run;
    }
    segs[seg * 128 + d] = run;
    __syncthreads();
    if (seg == 0) {
        const float t0 = segs[d], t1 = segs[128 + d], t2 = segs[256 + d], t3 = segs[384 + d];
        segs[d] = 0.f; segs[128 + d] = t0; segs[256 + d] = t0 + t1; segs[384 + d] = t0 + t1 + t2; segs[512 + d] = t0 + t1 + t2 + t3;
        DECg[(size_t)item * 128 + d] = __expf(t0 + t1 + t2 + t3);
    }
    __syncthreads();
    const float qscale = 0.08838834764831845f;
#pragma unroll
    for (int k = 0; k < 2; ++k) {
        const int id = tid + 512 * k, i = id >> 4, cc = id & 15, d0 = cc * 8, sg = i >> 4;
        const uint4 qv = k ? rq1 : rq0, kv = k ? rk1 : rk0;
        const float qx[8] = {lo2f(qv.x), hi2f(qv.x), lo2f(qv.y), hi2f(qv.y), lo2f(qv.z), hi2f(qv.z), lo2f(qv.w), hi2f(qv.w)};
        const float kx[8] = {lo2f(kv.x), hi2f(kv.x), lo2f(kv.y), hi2f(kv.y), lo2f(kv.z), hi2f(kv.z), lo2f(kv.w), hi2f(kv.w)};
        float qd[8], ki[8], ke[8];
        const float4 bA = *(const float4*)(bmat + i * 128 + d0), bB = *(const float4*)(bmat + i * 128 + d0 + 4);
        const float4 oA = *(const float4*)(segs + sg * 128 + d0), oB = *(const float4*)(segs + sg * 128 + d0 + 4);
        const float4 tA = *(const float4*)(segs + 512 + d0), tB = *(const float4*)(segs + 512 + d0 + 4);
        const float bv[8] = {bA.x + oA.x, bA.y + oA.y, bA.z + oA.z, bA.w + oA.w, bB.x + oB.x, bB.y + oB.y, bB.z + oB.z, bB.w + oB.w};
        const float tv[8] = {tA.x, tA.y, tA.z, tA.w, tB.x, tB.y, tB.z, tB.w};
#pragma unroll
        for (int e = 0; e < 8; ++e) {
            const float bb = bv[e], tot = tv[e];
            qd[e] = qx[e] * qscale * __expf(bb); ki[e] = kx[e] * __expf(-bb); ke[e] = kx[e] * __expf(tot - bb);
        }
        const int o = i * 256 + ((cc ^ (i & 15)) << 4);
        *(uint4*)(QDs + o) = make_uint4(pack2(qd[0], qd[1]), pack2(qd[2], qd[3]), pack2(qd[4], qd[5]), pack2(qd[6], qd[7]));
        *(uint4*)(KIs + o) = make_uint4(pack2(ki[0], ki[1]), pack2(ki[2], ki[3]), pack2(ki[4], ki[5]), pack2(ki[6], ki[7]));
        *(uint4*)(KEs + o) = make_uint4(pack2(ke[0], ke[1]), pack2(ke[2], ke[3]), pack2(ke[4], ke[5]), pack2(ke[6], ke[7]));
    }
    __syncthreads();
    {
        uint4* qo = (uint4*)(QDg + (size_t)item * GLA_QD_BYTES); uint4* ko = (uint4*)(KEg + (size_t)item * GLA_QD_BYTES);
#pragma unroll
        for (int k = 0; k < 2; ++k) { const int e = tid + 512 * k; qo[e] = ((const uint4*)QDs)[e]; ko[e] = ((const uint4*)KEs)[e]; }
    }
#pragma unroll
    for (int tt = 0; tt < 2; ++tt) {
        const int tile = wave + 8 * tt, jt = tile >> 2, it = tile & 3;
        f32x4 acc = (f32x4){0.f, 0.f, 0.f, 0.f};
        if (jt <= it) {
            const int jr = 16 * jt + li, ir = 16 * it + li;
#pragma unroll
            for (int ks = 0; ks < 4; ++ks) {
                const bf16x8 kf = *(const bf16x8*)(KIs + jr * 256 + (((4 * ks + fq) ^ (jr & 15)) << 4));
                const bf16x8 qf = *(const bf16x8*)(QDs + ir * 256 + (((4 * ks + fq) ^ (ir & 15)) << 4));
                acc = __builtin_amdgcn_mfma_f32_16x16x32_bf16(kf, qf, acc, 0, 0, 0);
            }
        }
        const int i = 16 * it + li, j0 = 16 * jt + 4 * fq;
        float v[4];
#pragma unroll
        for (int jj = 0; jj < 4; ++jj) v[jj] = (j0 + jj <= i) ? acc[jj] : 0.f;
        const int chunk = 2 * jt + (fq >> 1), sub = (fq & 1) * 8;
        *(uint2*)(ATg + (size_t)item * GLA_AT_BYTES + i * 128 + ((chunk ^ (i & 7)) << 4) + sub) = make_uint2(pack2(v[0], v[1]), pack2(v[2], v[3]));
    }
}

__device__ __forceinline__ void gla_seq_item(const u16* __restrict__ P, int ldp, int cv, int Sq,
                                             const unsigned char* __restrict__ QDg, const unsigned char* __restrict__ KEg, const unsigned char* __restrict__ ATg, const float* __restrict__ DECg,
                                             u16* __restrict__ Oout  , int Ttot, unsigned char* lds, int item) {
    const int slice = item & 1, dir = (item >> 1) & 1, hh = (item >> 2) & 3, b = item >> 4;
    const int nch = Sq / 64;
    const int tid = TID, lane = tid & 63, wave = tid >> 6, li = lane & 15, fq = lane >> 4;
    const size_t tok0 = (size_t)b * Sq;
    const int pitem0 = ((b * 4 + hh) * 2 + dir) * nch;
    constexpr int BUF = 16384 * 3 + 8192 + 512;
    typedef unsigned gla_u32x4 __attribute__((ext_vector_type(4)));
    gla_u32x4 rq0, rq1, rk0, rk1, rv0, rv1, ra; float rd = 0.f;
#define GLA_VROW(c_, k_) ((tok0 + (size_t)(dir ? (Sq - 1 - (64 * (c_) + ((tid + 512 * (k_)) >> 4))) : (64 * (c_) + ((tid + 512 * (k_)) >> 4)))) * ldp + cv + hh * 256 + slice * 128 + ((tid + 512 * (k_)) & 15) * 8)
#define GLA_ISSUE(c_) do { \
        const gla_u32x4* qsrc_ = (const gla_u32x4*)(QDg + (size_t)(pitem0 + (c_)) * GLA_QD_BYTES); const gla_u32x4* ksrc_ = (const gla_u32x4*)(KEg + (size_t)(pitem0 + (c_)) * GLA_QD_BYTES); \
        rq0 = qsrc_[tid]; rq1 = qsrc_[tid + 512]; rk0 = ksrc_[tid]; rk1 = ksrc_[tid + 512]; \
        ra = ((const gla_u32x4*)(ATg + (size_t)(pitem0 + (c_)) * GLA_AT_BYTES))[tid]; \
        rv0 = *(const gla_u32x4*)(P + GLA_VROW(c_, 0)); rv1 = *(const gla_u32x4*)(P + GLA_VROW(c_, 1)); \
        if (tid < 128) rd = DECg[(size_t)(pitem0 + (c_)) * 128 + tid]; } while (0)
#define GLA_COMMIT(buf_) do { \
        unsigned char* base_ = lds + (buf_) * BUF; \
        ((gla_u32x4*)base_)[tid] = rq0; ((gla_u32x4*)base_)[tid + 512] = rq1; ((gla_u32x4*)(base_ + 16384))[tid] = rk0; ((gla_u32x4*)(base_ + 16384))[tid + 512] = rk1; \
        { const int row_ = tid >> 4, ch_ = tid & 15; *(gla_u32x4*)(base_ + 32768 + row_ * 256 + ((ch_ ^ (row_ & 15)) << 4)) = rv0; } \
        { const int row_ = (tid + 512) >> 4, ch_ = tid & 15; *(gla_u32x4*)(base_ + 32768 + row_ * 256 + ((ch_ ^ (row_ & 15)) << 4)) = rv1; } \
        ((gla_u32x4*)(base_ + 49152))[tid] = ra; \
        if (tid < 128) ((float*)(base_ + 57344))[tid] = rd; } while (0)
    f32x4 st[8];
#pragma unroll
    for (int dt = 0; dt < 8; ++dt) st[dt] = (f32x4){0.f, 0.f, 0.f, 0.f};
    __syncthreads();
    GLA_ISSUE(0); GLA_COMMIT(0);
    __syncthreads();
#pragma unroll 1
    for (int c = 0; c < nch; ++c) {
        const int buf = c & 1;
        if (c + 1 < nch) GLA_ISSUE(c + 1);
        const unsigned char* QDs = lds + buf * BUF; const unsigned char* KEs = QDs + 16384; const unsigned char* Vs = QDs + 32768;
        const unsigned char* ATs = QDs + 49152; const float* DECs = (const float*)(QDs + 57344);
        bf16x8 vf[2];
#pragma unroll
        for (int jp = 0; jp < 2; ++jp) {
            const int rowA = 32 * jp + 8 * fq + (li >> 2), rowB = rowA + 4;
            const int chunk = 2 * wave + ((li & 3) >> 1), sub = ((li & 3) & 1) * 8;
            const s16x4 va = __builtin_amdgcn_ds_read_tr16_b64_v4i16((LAS s16x4*)(Vs + rowA * 256 + ((chunk ^ (rowA & 15)) << 4) + sub));
            const s16x4 vb = __builtin_amdgcn_ds_read_tr16_b64_v4i16((LAS s16x4*)(Vs + rowB * 256 + ((chunk ^ (rowB & 15)) << 4) + sub));
            vf[jp] = __builtin_shufflevector(va, vb, 0, 1, 2, 3, 4, 5, 6, 7);
        }
        bf16x8 sf[4];
#pragma unroll
        for (int dp = 0; dp < 4; ++dp) {
            const gla_u32x4 t_ = {pack2(st[2 * dp][0], st[2 * dp][1]), pack2(st[2 * dp][2], st[2 * dp][3]), pack2(st[2 * dp + 1][0], st[2 * dp + 1][1]), pack2(st[2 * dp + 1][2], st[2 * dp + 1][3])};
            sf[dp] = __builtin_bit_cast(bf16x8, t_);
        }
        f32x4 ot[4];
#pragma unroll
        for (int it = 0; it < 4; ++it) {
            f32x4 acc = (f32x4){0.f, 0.f, 0.f, 0.f};
            const int ir = 16 * it + li;
#pragma unroll
            for (int dp = 0; dp < 4; ++dp) {
                const int c0 = 4 * dp + (fq >> 1), c1 = c0 + 2, sub = (fq & 1) * 8;
                const uint2 lo = *(const uint2*)(QDs + ir * 256 + ((c0 ^ (ir & 15)) << 4) + sub);
                const uint2 hi = *(const uint2*)(QDs + ir * 256 + ((c1 ^ (ir & 15)) << 4) + sub);
                const gla_u32x4 q_ = {lo.x, lo.y, hi.x, hi.y};
                const bf16x8 qf = __builtin_bit_cast(bf16x8, q_);
                acc = __builtin_amdgcn_mfma_f32_16x16x32_bf16(sf[dp], qf, acc, 0, 0, 0);
            }
#pragma unroll
            for (int jp = 0; jp < 2; ++jp) {
                if (32 * jp <= 16 * it + 15) {
                    const bf16x8 af = *(const bf16x8*)(ATs + ir * 128 + (((4 * jp + fq) ^ (ir & 7)) << 4));
                    acc = __builtin_amdgcn_mfma_f32_16x16x32_bf16(vf[jp], af, acc, 0, 0, 0);
                }
            }
            ot[it] = acc;
        }
#pragma unroll
        for (int dt = 0; dt < 8; ++dt) {
            const f32x4 dec = *(const f32x4*)(DECs + 16 * dt + 4 * fq);
            f32x4 acc = st[dt] * dec;
#pragma unroll
            for (int jp = 0; jp < 2; ++jp) {
                const int rowA = 32 * jp + 8 * fq + (li >> 2), rowB = rowA + 4;
                const int chunk = 2 * dt + ((li & 3) >> 1), sub = ((li & 3) & 1) * 8;
                const s16x4 ka = __builtin_amdgcn_ds_read_tr16_b64_v4i16((LAS s16x4*)(KEs + rowA * 256 + ((chunk ^ (rowA & 15)) << 4) + sub));
                const s16x4 kb = __builtin_amdgcn_ds_read_tr16_b64_v4i16((LAS s16x4*)(KEs + rowB * 256 + ((chunk ^ (rowB & 15)) << 4) + sub));
                const bf16x8 kf = __builtin_shufflevector(ka, kb, 0, 1, 2, 3, 4, 5, 6, 7);
                acc = __builtin_amdgcn_mfma_f32_16x16x32_bf16(kf, vf[jp], acc, 0, 0, 0);
            }
            st[dt] = acc;
        }
#pragma unroll
        for (int it = 0; it < 4; ++it) {
            const int i = 16 * it + li;
            const int s = dir ? (Sq - 1 - (64 * c + i)) : (64 * c + i);
            *(uint2*)(Oout + ((size_t)dir * Ttot + tok0 + s) * 1024 + hh * 256 + slice * 128 + 16 * wave + 4 * fq) =
                make_uint2(pack2(ot[it][0], ot[it][1]), pack2(ot[it][2], ot[it][3]));
        }
        if (c + 1 < nch) GLA_COMMIT(buf ^ 1);
        __syncthreads();
    }
}
__device__ __forceinline__ void phase_rope_prep(const Args& a, unsigned char* lds) {
    u16* P = (u16*)(a.ws + WS_P);
    const float2* cs = (const float2*)(a.ws + WS_CS);
    const int gt = blockIdx.x * NTHREADS + threadIdx.x, NT = gridDim.x * NTHREADS;
    for (int i = gt; i < T * 2 * 8 * 8; i += NT) {
        const int f0 = (i & 7) * 8, hh = (i >> 3) & 7, which = (i >> 6) & 1, t = i >> 7;
        u16* p = P + (size_t)t * NP + (which ? C_DK : C_DQ) + hh * 128 + f0;
        const uint4 a1 = *(const uint4*)p, a2 = *(const uint4*)(p + 64);
        const float4* cp = (const float4*)(cs + t * 64 + f0);
        const float4 c0 = cp[0], c1 = cp[1], c2 = cp[2], c3 = cp[3];
        const float x1[8] = {lo2f(a1.x), hi2f(a1.x), lo2f(a1.y), hi2f(a1.y), lo2f(a1.z), hi2f(a1.z), lo2f(a1.w), hi2f(a1.w)};
        const float x2[8] = {lo2f(a2.x), hi2f(a2.x), lo2f(a2.y), hi2f(a2.y), lo2f(a2.z), hi2f(a2.z), lo2f(a2.w), hi2f(a2.w)};
        const float cc[8] = {c0.x, c0.z, c1.x, c1.z, c2.x, c2.z, c3.x, c3.z}, sn[8] = {c0.y, c0.w, c1.y, c1.w, c2.y, c2.w, c3.y, c3.w};
        float y1[8], y2[8];
#pragma unroll
        for (int k = 0; k < 8; ++k) { y1[k] = x1[k] * cc[k] - x2[k] * sn[k]; y2[k] = x1[k] * sn[k] + x2[k] * cc[k]; }
        *(uint4*)p = make_uint4(pack2(y1[0], y1[1]), pack2(y1[2], y1[3]), pack2(y1[4], y1[5]), pack2(y1[6], y1[7]));
        *(uint4*)(p + 64) = make_uint4(pack2(y2[0], y2[1]), pack2(y2[2], y2[3]), pack2(y2[4], y2[5]), pack2(y2[6], y2[7]));
    }
    for (int item = blockIdx.x; item < GLA_NPREP; item += gridDim.x)
        gla_prep_item(P, NP, C_GQ, C_GK, (const float*)(a.ws + WS_GZ), a.wgf, a.bgf, a.wgb, a.bgb, S,
                      a.ws + WS_QD, a.ws + WS_KE, a.ws + WS_AT, (float*)(a.ws + WS_DEC), lds, item);
}

#define ATTN_DECODE(item_) \
    const int nb_per = Sq / 128; \
    const int within = (item_) % nb_per, hh = ((item_) / nb_per) & 7, b = ((item_) / (nb_per * 8)) & 3, pat = (item_) / (nb_per * 32); \
    const int dil = pat == 0 ? 1 : (pat == 1 ? 4 : 16); \
    const int M = Sq / dil; \
    const int r = within % dil, blk = within / dil; \
    const int p0 = blk * 128, kbase = p0 - 64; \
    const size_t tok0 = (size_t)b * Sq;
typedef unsigned attn_u32x4 __attribute__((ext_vector_type(4)));
__device__ __forceinline__ void attn_phase(const u16* __restrict__ P, int ldp, int cq, int ck, int cv, int Sq,
                                           u16* __restrict__ part_o, float* __restrict__ part_lse, int Ttot,
                                           unsigned char* lds, int first, int stride, int nitems) {
    const int tid = TID, lane = tid & 63, wave = tid >> 6, li = lane & 15, fq = lane >> 4;
    unsigned char* Ks = lds;
    unsigned char* Vs = lds + 65536;
    attn_u32x4 kr0, kr1, kr2, kr3, kr4, kr5, kr6, kr7, vr0, vr1, vr2, vr3, vr4, vr5, vr6, vr7;
#define ATTN_LD1(i_, kreg_, vreg_) { const int id_ = tid + 512 * (i_), row_ = id_ >> 4, c_ = id_ & 15; \
        int kp_ = kbase + row_; kp_ = kp_ < 0 ? 0 : (kp_ > M - 1 ? M - 1 : kp_); \
        const size_t t_ = tok0 + r + (size_t)dil * kp_; \
        kreg_ = *(const attn_u32x4*)(P + t_ * ldp + ck + hh * 128 + c_ * 8); vreg_ = *(const attn_u32x4*)(P + t_ * ldp + cv + hh * 128 + c_ * 8); }
#define ATTN_LOAD(item_) do { ATTN_DECODE(item_) \
        ATTN_LD1(0, kr0, vr0) ATTN_LD1(1, kr1, vr1) ATTN_LD1(2, kr2, vr2) ATTN_LD1(3, kr3, vr3) ATTN_LD1(4, kr4, vr4) ATTN_LD1(5, kr5, vr5) ATTN_LD1(6, kr6, vr6) ATTN_LD1(7, kr7, vr7) } while (0)
#define ATTN_ST1(i_, kreg_, vreg_) { const int id_ = tid + 512 * (i_), row_ = id_ >> 4, c_ = id_ & 15; const int off_ = row_ * 256 + ((c_ ^ (row_ & 15)) << 4); \
        *(attn_u32x4*)(Ks + off_) = kreg_; *(attn_u32x4*)(Vs + off_) = vreg_; }
#define ATTN_COMMIT() do { ATTN_ST1(0, kr0, vr0) ATTN_ST1(1, kr1, vr1) ATTN_ST1(2, kr2, vr2) ATTN_ST1(3, kr3, vr3) ATTN_ST1(4, kr4, vr4) ATTN_ST1(5, kr5, vr5) ATTN_ST1(6, kr6, vr6) ATTN_ST1(7, kr7, vr7) } while (0)
    int item = first;
    if (item < nitems) ATTN_LOAD(item);
    for (; item < nitems; item += stride) {
        ATTN_DECODE(item)
        __syncthreads();
        ATTN_COMMIT();
        const int qp = p0 + 16 * wave + li;
        const size_t tq = tok0 + r + (size_t)dil * qp;
        bf16x8 qf[4];
#pragma unroll
        for (int ks = 0; ks < 4; ++ks) qf[ks] = *(const bf16x8*)(P + tq * ldp + cq + hh * 128 + 32 * ks + 8 * fq);
        __syncthreads();
        if (item + stride < nitems) ATTN_LOAD(item + stride);
        const float scale = 0.08838834764831845f;
        float m = -1e30f, l = 0.f;
        f32x4 o[8];
#pragma unroll
        for (int dt = 0; dt < 8; ++dt) o[dt] = (f32x4){0.f, 0.f, 0.f, 0.f};
#pragma unroll 1
        for (int tp = 0; tp < 5; ++tp) {
            float s[8]; bool ok[8];
#pragma unroll
            for (int h2 = 0; h2 < 2; ++h2) {
                const int kk0 = 16 * wave + 16 * (2 * tp + h2);
                int krow = kk0 + li; krow = krow > 255 ? 255 : krow;
                f32x4 acc = (f32x4){0.f, 0.f, 0.f, 0.f};
#pragma unroll
                for (int ks = 0; ks < 4; ++ks) {
                    const bf16x8 kf = *(const bf16x8*)(Ks + krow * 256 + (((4 * ks + fq) ^ (krow & 15)) << 4));
                    acc = __builtin_amdgcn_mfma_f32_16x16x32_bf16(kf, qf[ks], acc, 0, 0, 0);
                }
#pragma unroll
                for (int j = 0; j < 4; ++j) {
                    const int kp = kbase + kk0 + 4 * fq + j;
                    const int rel = kp - qp;
                    ok[4 * h2 + j] = (kp >= 0) && (kp < M) && (rel <= 64) && (rel >= -64);
                    s[4 * h2 + j] = acc[j] * scale;
                }
            }
            float mx = -1e30f;
#pragma unroll
            for (int j = 0; j < 8; ++j) mx = ok[j] ? fmaxf(mx, s[j]) : mx;
            mx = fmaxf(mx, __shfl_xor(mx, 16));
            mx = fmaxf(mx, __shfl_xor(mx, 32));
            const float mn = fmaxf(m, mx);
            const float al = __expf(m - mn);
            float ps = 0.f; float p[8];
#pragma unroll
            for (int j = 0; j < 8; ++j) { p[j] = ok[j] ? __expf(s[j] - mn) : 0.f; ps += p[j]; }
            l = l * al + ps; m = mn;
            const attn_u32x4 p_ = {pack2(p[0], p[1]), pack2(p[2], p[3]), pack2(p[4], p[5]), pack2(p[6], p[7])};
            const bf16x8 pf = __builtin_bit_cast(bf16x8, p_);
#pragma unroll
            for (int dt = 0; dt < 8; ++dt) o[dt] *= al;
            int rowA = 16 * wave + 32 * tp + 4 * fq + (li >> 2); rowA = rowA > 255 ? 255 : rowA;
            int rowB = 16 * wave + 32 * tp + 16 + 4 * fq + (li >> 2); rowB = rowB > 255 ? 255 : rowB;
#pragma unroll
            for (int dt = 0; dt < 8; ++dt) {
                const int chunk = 2 * dt + ((li & 3) >> 1), sub = ((li & 3) & 1) * 8;
                const s16x4 va = __builtin_amdgcn_ds_read_tr16_b64_v4i16((LAS s16x4*)(Vs + rowA * 256 + ((chunk ^ (rowA & 15)) << 4) + sub));
                const s16x4 vb = __builtin_amdgcn_ds_read_tr16_b64_v4i16((LAS s16x4*)(Vs + rowB * 256 + ((chunk ^ (rowB & 15)) << 4) + sub));
                const bf16x8 vf = __builtin_shufflevector(va, vb, 0, 1, 2, 3, 4, 5, 6, 7);
                o[dt] = __builtin_amdgcn_mfma_f32_16x16x32_bf16(vf, pf, o[dt], 0, 0, 0);
            }
        }
        l += __shfl_xor(l, 16);
        l += __shfl_xor(l, 32);
        const float inv = 1.f / l;
        u16* orow = part_o + ((size_t)pat * Ttot + tq) * 1024 + hh * 128 + 4 * fq;
#pragma unroll
        for (int dt = 0; dt < 8; ++dt)
            *(uint2*)(orow + 16 * dt) = make_uint2(pack2(o[dt][0] * inv, o[dt][1] * inv), pack2(o[dt][2] * inv, o[dt][3] * inv));
        if (fq == 0) part_lse[((size_t)pat * Ttot + tq) * 8 + hh] = m + logf(l);
    }
#undef ATTN_LD1
#undef ATTN_LOAD
#undef ATTN_ST1
#undef ATTN_COMMIT
}

__device__ __forceinline__ void attn_merge_token(const u16* __restrict__ part_o, const float* __restrict__ part_lse, int Ttot, size_t t,
                                                 u16* __restrict__ dst  , int lane) {
    const int hh = lane >> 3;
    const float l0 = part_lse[((size_t)0 * Ttot + t) * 8 + hh], l1 = part_lse[((size_t)1 * Ttot + t) * 8 + hh], l2 = part_lse[((size_t)2 * Ttot + t) * 8 + hh];
    const float mx = fmaxf(l0, fmaxf(l1, l2));
    const float e0 = __expf(l0 - mx), e1 = __expf(l1 - mx), e2 = __expf(l2 - mx);
    const float inv = 1.f / (e0 + e1 + e2);
    const float w[3] = {e0 * inv, e1 * inv, e2 * inv};
    float acc[16];
#pragma unroll
    for (int i = 0; i < 16; ++i) acc[i] = 0.f;
#pragma unroll
    for (int p = 0; p < 3; ++p) {
        const uint4* src = (const uint4*)(part_o + ((size_t)p * Ttot + t) * 1024 + lane * 16);
        const uint4 a = src[0], bb = src[1];
        acc[0] += w[p] * lo2f(a.x); acc[1] += w[p] * hi2f(a.x); acc[2] += w[p] * lo2f(a.y); acc[3] += w[p] * hi2f(a.y);
        acc[4] += w[p] * lo2f(a.z); acc[5] += w[p] * hi2f(a.z); acc[6] += w[p] * lo2f(a.w); acc[7] += w[p] * hi2f(a.w);
        acc[8] += w[p] * lo2f(bb.x); acc[9] += w[p] * hi2f(bb.x); acc[10] += w[p] * lo2f(bb.y); acc[11] += w[p] * hi2f(bb.y);
        acc[12] += w[p] * lo2f(bb.z); acc[13] += w[p] * hi2f(bb.z); acc[14] += w[p] * lo2f(bb.w); acc[15] += w[p] * hi2f(bb.w);
    }
    uint4* d = (uint4*)(dst + lane * 16);
    d[0] = make_uint4(pack2(acc[0], acc[1]), pack2(acc[2], acc[3]), pack2(acc[4], acc[5]), pack2(acc[6], acc[7]));
    d[1] = make_uint4(pack2(acc[8], acc[9]), pack2(acc[10], acc[11]), pack2(acc[12], acc[13]), pack2(acc[14], acc[15]));
}

__device__ __forceinline__ void phase_mixers(const Args& a, unsigned char* lds) {
    const int bi = blockIdx.x, G = gridDim.x;
    if (bi < 64) {
        gla_seq_item((const u16*)(a.ws + WS_P), NP, C_GV, S, a.ws + WS_QD, a.ws + WS_KE, a.ws + WS_AT, (const float*)(a.ws + WS_DEC),
                     (u16*)(a.ws + WS_OFB), T, lds, bi);
    } else {
        u16* part_o = (u16*)a.out; float* part_lse = (float*)((unsigned char*)a.out + (size_t)3 * T * 1024 * 2);
        attn_phase((const u16*)(a.ws + WS_P), NP, C_DQ, C_DK, C_DV, S, part_o, part_lse, T, lds, bi - 64, G - 64, 3 * 4 * 8 * (S / 128));
    }
}

__device__ __forceinline__ void phase_gla_fin(const Args& a) {
    const u16* Of = (const u16*)(a.ws + WS_OFB);
    const u16* Ob = Of + (size_t)T * 1024;
    const u16* P = (const u16*)(a.ws + WS_P);
    u16* A2 = (u16*)(a.ws + WS_ACT);
    const int lane = threadIdx.x & 63, wave = threadIdx.x >> 6;
    const int gw = blockIdx.x * NWAVES + wave, NGW = gridDim.x * NWAVES;
    for (int item = gw; item < T * 4; item += NGW) {
        const int hh = item & 3, t = item >> 2;
        const size_t base = (size_t)t * 1024 + hh * 256 + lane * 4;
        const uint2 f = *(const uint2*)(Of + base), bb = *(const uint2*)(Ob + base);
        const float o0 = lo2f(f.x) + lo2f(bb.x), o1 = hi2f(f.x) + hi2f(bb.x), o2 = lo2f(f.y) + lo2f(bb.y), o3 = hi2f(f.y) + hi2f(bb.y);
        const float ss = wave_sum(o0 * o0 + o1 * o1 + o2 * o2 + o3 * o3);
        const float rstd = rsqrtf(ss * (1.f / 256.f) + NORM_EPS);
        const float4 gg = *(const float4*)(a.g_gla + hh * 256 + lane * 4);
        const uint2 rp = *(const uint2*)(P + (size_t)t * NP + C_GR + hh * 256 + lane * 4);
        const float r0 = lo2f(rp.x), r1 = hi2f(rp.x), r2 = lo2f(rp.y), r3 = hi2f(rp.y);
        const float y0 = o0 * rstd * gg.x * silu_f(r0), y1 = o1 * rstd * gg.y * silu_f(r1);
        const float y2 = o2 * rstd * gg.z * silu_f(r2), y3 = o3 * rstd * gg.w * silu_f(r3);
        *(uint2*)(A2 + (size_t)t * D + hh * 256 + lane * 4) = make_uint2(pack2(y0, y1), pack2(y2, y3));
    }
    const u16* part_o = (const u16*)a.out; const float* part_lse = (const float*)((const unsigned char*)a.out + (size_t)3 * T * 1024 * 2);
    for (int t = gw; t < T; t += NGW) attn_merge_token(part_o, part_lse, T, (size_t)t, A2 + (size_t)t * D + 1024, lane);
}

typedef float f32x16 __attribute__((ext_vector_type(16)));
#define RT_CE(a_, b_) do { const float hi_ = fmaxf(a_, b_), lo_ = fminf(a_, b_); a_ = hi_; b_ = lo_; } while (0)
template <int N> __device__ __forceinline__ void rt_sort_desc(float (&v)[N], int base) {
#pragma unroll
    for (int k = 2; k <= 16; k <<= 1)
#pragma unroll
        for (int j = k >> 1; j > 0; j >>= 1)
#pragma unroll
            for (int i = 0; i < 16; ++i) {
                const int l = i ^ j;
                if (l > i) { if ((i & k) == 0) RT_CE(v[base + i], v[base + l]); else RT_CE(v[base + l], v[base + i]); }
            }
}
template <int N> __device__ __forceinline__ void rt_merge_desc(float (&v)[N], int a, int b) {
#pragma unroll
    for (int i = 0; i < 16; ++i) v[a + i] = fmaxf(v[a + i], v[b + 15 - i]);
#pragma unroll
    for (int j = 8; j > 0; j >>= 1)
#pragma unroll
        for (int i = 0; i < 16; ++i) { const int l = i ^ j; if (l > i) RT_CE(v[a + i], v[a + l]); }
}

__device__ __forceinline__ void route_stage_keys(const float* __restrict__ subk, int hh, unsigned char* lds) {
    const int tid = TID;
    __syncthreads();
    for (int e = tid; e < 2 * 128 * 16; e += 512) {
        const int c = e & 15, row = e >> 4;
        const float* src = subk + ((size_t)(hh * 2) * 128 + row) * 128 + c * 8;
        const float4 v0 = *(const float4*)src, v1 = *(const float4*)(src + 4);
        *(uint4*)(lds + row * 256 + ((c ^ (row & 15)) << 4)) = make_uint4(pack2(v0.x, v0.y), pack2(v0.z, v0.w), pack2(v1.x, v1.y), pack2(v1.z, v1.w));
    }
    __syncthreads();
}

__device__ __forceinline__ void route_tile(const u16* __restrict__ Q, int ldq, int hh, int tok_base, const unsigned char* lds,
                                           int* __restrict__ IDX, float* __restrict__ GATE) {
    const int lane = TID & 63, r = lane & 31, h = lane >> 5;
    float sc[128];
    {
        f32x16 X[4], Y[4];
#pragma unroll
        for (int kt = 0; kt < 4; ++kt) {
#pragma unroll
            for (int i = 0; i < 16; ++i) { X[kt][i] = 0.f; Y[kt][i] = 0.f; }
        }
        const u16* qrow = Q + (size_t)(tok_base + r) * ldq + hh * 256;
#pragma unroll
        for (int half = 0; half < 2; ++half) {
            bf16x8 qf[8];
#pragma unroll
            for (int ks = 0; ks < 8; ++ks) qf[ks] = *(const bf16x8*)(qrow + half * 128 + 16 * ks + 8 * h);
#pragma unroll
            for (int kt = 0; kt < 4; ++kt) {
                const int krow = half * 128 + 32 * kt + r;
#pragma unroll
                for (int ks = 0; ks < 8; ++ks) {
                    const bf16x8 kf = *(const bf16x8*)(lds + krow * 256 + (((2 * ks + h) ^ (krow & 15)) << 4));
                    if (half == 0) X[kt] = __builtin_amdgcn_mfma_f32_32x32x16_bf16(kf, qf[ks], X[kt], 0, 0, 0);
                    else Y[kt] = __builtin_amdgcn_mfma_f32_32x32x16_bf16(kf, qf[ks], Y[kt], 0, 0, 0);
                }
            }
        }
#pragma unroll
        for (int kt = 0; kt < 4; ++kt)
#pragma unroll
            for (int i = 0; i < 16; ++i) {
                const auto sw = __builtin_amdgcn_permlane32_swap(__float_as_uint(X[kt][i]), __float_as_uint(Y[kt][i]), false, false);
                const int key0 = 32 * kt + (i & 3) + 8 * (i >> 2);
                sc[kt * 32 + i] = __uint_as_float((sw[0] & 0xffffff80u) | (unsigned)key0);
                sc[kt * 32 + 16 + i] = __uint_as_float((sw[1] & 0xffffff80u) | (unsigned)(key0 + 4));
            }
    }
#pragma unroll
    for (int g = 0; g < 8; ++g) rt_sort_desc(sc, 16 * g);
    rt_merge_desc(sc, 0, 16); rt_merge_desc(sc, 32, 48); rt_merge_desc(sc, 64, 80); rt_merge_desc(sc, 96, 112);
    rt_merge_desc(sc, 0, 32); rt_merge_desc(sc, 64, 96);
    rt_merge_desc(sc, 0, 64);
    float l0[16], l1[16];
#pragma unroll
    for (int i = 0; i < 16; ++i) {
        const auto sw = __builtin_amdgcn_permlane32_swap(__float_as_uint(sc[i]), __float_as_uint(sc[i]), false, false);
        l0[i] = __uint_as_float(sw[0]); l1[i] = __uint_as_float(sw[1]);
    }
    float s0[16], s1[16]; int k0[16], k1[16];
#pragma unroll
    for (int i = 0; i < 16; ++i) {
        const unsigned a = __float_as_uint(l0[i]), b = __float_as_uint(l1[i]);
        s0[i] = __uint_as_float(a & 0xffffff80u); k0[i] = (int)(a & 0x7fu);
        s1[i] = __uint_as_float(b & 0xffffff80u); k1[i] = (int)(b & 0x7fu);
    }
    float cs[64];
    {
        int n = 0;
#pragma unroll
        for (int i = 0; i < 16; ++i)
#pragma unroll
            for (int j = 0; j < 16; ++j)
                if ((i + 1) * (j + 1) <= 16) { cs[n] = s0[i] + s1[j]; ++n; }
#pragma unroll
        for (int q = 50; q < 64; ++q) cs[q] = -3.0e38f;
    }
    float ct[64];
#pragma unroll
    for (int q = 0; q < 64; ++q) ct[q] = cs[q];
#pragma unroll
    for (int g = 0; g < 4; ++g) rt_sort_desc(ct, 16 * g);
    rt_merge_desc(ct, 0, 16); rt_merge_desc(ct, 32, 48); rt_merge_desc(ct, 0, 32);
    const float theta = ct[15], smax = ct[0];
    float den = 0.f;
    {
        int cnt = 0;
#pragma unroll
        for (int q = 0; q < 50; ++q) { const bool sel = (cs[q] >= theta) && (cnt < 16); den += sel ? __expf(cs[q] - smax) : 0.f; cnt += sel ? 1 : 0; }
    }
    const float inv = 1.f / den;
    const size_t obase = (size_t)(tok_base + r) * 128 + hh * 16;
    int pos = 0;
    {
        int n = 0;
#pragma unroll
        for (int i = 0; i < 16; ++i)
#pragma unroll
            for (int j = 0; j < 16; ++j)
                if ((i + 1) * (j + 1) <= 16) {
                    const bool sel = (cs[n] >= theta) && (pos < 16);
                    if (sel) {
                        if (h == 0) IDX[obase + pos] = k0[i] * 128 + k1[j];
                        else GATE[obase + pos] = __expf(cs[n] - smax) * inv;
                        ++pos;
                    }
                    ++n;
                }
    }
}
__device__ __forceinline__ void phase_route(const Args& a, unsigned char* lds) {
    const int hh = BID & 7, grp = BID >> 3, ngrp = GDIM >> 3, wave = TID >> 6;
    route_stage_keys(a.subk, hh, lds);
    int j = 0;
    for (int tile = grp; tile < T / 32; tile += ngrp, ++j)
        if ((j & 7) == wave) route_tile((const u16*)(a.ws + WS_Q), D, hh, tile * 32, lds, (int*)(a.ws + WS_IDX), (float*)(a.ws + WS_GATE));
    __syncthreads();
}

typedef __bf16 bf16x2_t __attribute__((ext_vector_type(2)));
__device__ __forceinline__ float dot2bf(unsigned w, unsigned x, float acc) {
    return __builtin_amdgcn_fdot2_f32_bf16(__builtin_bit_cast(bf16x2_t, w), __builtin_bit_cast(bf16x2_t, x), acc, false);
}
constexpr int TROW = 1152;
typedef float f32x2_t __attribute__((ext_vector_type(2)));
__device__ __forceinline__ void convert_tables(const Args& a) {
    const int lane = threadIdx.x & 63, wave = threadIdx.x >> 6;
    const int gw = blockIdx.x * NWAVES + wave, NGW = gridDim.x * NWAVES;
    for (int row = gw; row < 2 * 16384; row += NGW) {
        const bool isv = row >= 16384; const int e = isv ? row - 16384 : row;
        const f32x4* sp = (const f32x4*)((isv ? a.pv : a.pu) + (size_t)e * D);
        unsigned char* dst = a.ws + (isv ? WS_TV : WS_TU) + (size_t)e * TROW;
        f32x4 v[8];
#pragma unroll
        for (int k = 0; k < 8; ++k) v[k] = __builtin_nontemporal_load(sp + lane + 64 * k);
#pragma unroll
        for (int k = 0; k < 8; ++k) {
            float mx = fmaxf(fmaxf(fabsf(v[k][0]), fabsf(v[k][1])), fmaxf(fabsf(v[k][2]), fabsf(v[k][3])));
            mx = fmaxf(mx, __shfl_xor(mx, 1)); mx = fmaxf(mx, __shfl_xor(mx, 2)); mx = fmaxf(mx, __shfl_xor(mx, 4));
            float s = mx * (isv ? (1.f / 6.f) : (1.f / 7.f)); s = (s > 0.f) ? s : 1.f;
            u16 sb = f2bf(s); if (bf2f(sb) < s) sb += 1;
            const float inv = 1.f / bf2f(sb);
            unsigned p = 0u;
            if (isv) {
                p = __builtin_amdgcn_cvt_scalef32_pk_fp4_f32(p, v[k][0] * inv, v[k][1] * inv, 1.0f, 0);
                p = __builtin_amdgcn_cvt_scalef32_pk_fp4_f32(p, v[k][2] * inv, v[k][3] * inv, 1.0f, 1);
            } else {
#pragma unroll
                for (int j = 0; j < 4; ++j) { int q = (int)rintf(v[k][j] * inv) + 8; q = q < 1 ? 1 : (q > 15 ? 15 : q); p |= (unsigned)q << (4 * j); }
            }
            const int i = lane + 64 * k;
            *(u16*)(dst + 2 * i) = (u16)p;
            if ((lane & 7) == 0) *(u16*)(dst + 1024 + 2 * (i >> 3)) = sb;
        }
    }
}

__device__ __forceinline__ int idot32_i4(const uint4 w, const int (&hq)[8]) {
    const unsigned ww[4] = {w.x, w.y, w.z, w.w};
    int acc = 0;
#pragma unroll
    for (int k = 0; k < 4; ++k) {
        acc = __builtin_amdgcn_sdot4((int)(ww[k] & 0x0f0f0f0fu), hq[2 * k], acc, false);
        acc = __builtin_amdgcn_sdot4((int)((ww[k] >> 4) & 0x0f0f0f0fu), hq[2 * k + 1], acc, false);
    }
    return acc;
}
__device__ __forceinline__ void axpy32_fp4(const uint4 w, const float s, float (&acc)[32]) {
    const unsigned ww[4] = {w.x, w.y, w.z, w.w};
#pragma unroll
    for (int k = 0; k < 4; ++k) {
        const f32x2_t a0 = __builtin_amdgcn_cvt_scalef32_pk_f32_fp4(ww[k], 1.0f, 0), a1 = __builtin_amdgcn_cvt_scalef32_pk_f32_fp4(ww[k], 1.0f, 1);
        const f32x2_t a2 = __builtin_amdgcn_cvt_scalef32_pk_f32_fp4(ww[k], 1.0f, 2), a3 = __builtin_amdgcn_cvt_scalef32_pk_f32_fp4(ww[k], 1.0f, 3);
        acc[8 * k + 0] += s * a0.x; acc[8 * k + 1] += s * a0.y; acc[8 * k + 2] += s * a1.x; acc[8 * k + 3] += s * a1.y;
        acc[8 * k + 4] += s * a2.x; acc[8 * k + 5] += s * a2.y; acc[8 * k + 6] += s * a3.x; acc[8 * k + 7] += s * a3.y;
    }
}
__device__ __forceinline__ void phase_experts(const Args& a) {
    const u16* H2 = (const u16*)(a.ws + WS_ACT);
    const u16* X1 = (const u16*)(a.ws + WS_X1);
    const int* IDX = (const int*)(a.ws + WS_IDX);
    const float* GATE = (const float*)(a.ws + WS_GATE);
    const float* mod = (const float*)(a.ws + WS_MOD);
    const unsigned char* U = a.ws + WS_TU; const unsigned char* V = a.ws + WS_TV;
    const int lane = threadIdx.x & 63, wave = threadIdx.x >> 6;
    const int gw = blockIdx.x * NWAVES + wave, NGW = gridDim.x * NWAVES;
    int iv0 = 0, iv1 = 0; float gv0 = 0.f, gv1 = 0.f;
    int niv0 = 0, niv1 = 0; float ngv0 = 0.f, ngv1 = 0.f;
    uint4 rA[4], rB[4]; u16 sA[4], sB[4];
#define ROW_LOAD(TB_, r_, s_, r0_) do { _Pragma("unroll") for (int q = 0; q < 4; ++q) { \
            const int rr_ = (r0_) + q; const int e_ = __builtin_amdgcn_readlane(rr_ < 64 ? iv0 : iv1, rr_ & 63); \
            const unsigned char* rp_ = TB_ + (size_t)e_ * TROW; \
            r_[q] = *(const uint4*)(rp_ + lane * 16); s_[q] = *(const u16*)(rp_ + 1024 + lane * 2); } } while (0)
#define TOK_FETCH(t_, i0_, i1_, g0_, g1_) do { \
            i0_ = IDX[(size_t)(t_) * 128 + lane]; i1_ = IDX[(size_t)(t_) * 128 + 64 + lane]; \
            g0_ = GATE[(size_t)(t_) * 128 + lane]; g1_ = GATE[(size_t)(t_) * 128 + 64 + lane]; } while (0)
    if (gw < T) { TOK_FETCH(gw, iv0, iv1, gv0, gv1); ROW_LOAD(U, rA, sA, 0); }
    for (int t = gw; t < T; t += NGW) {
        const int b = t / S;
        const bool has_next = (t + NGW) < T;
        int hq[8]; int hsum8; float sh;
        {
            float h[32];
            const uint4* hp = (const uint4*)(H2 + (size_t)t * D + lane * 32);
#pragma unroll
            for (int k = 0; k < 4; ++k) { const uint4 p = hp[k];
                h[8 * k + 0] = lo2f(p.x); h[8 * k + 1] = hi2f(p.x); h[8 * k + 2] = lo2f(p.y); h[8 * k + 3] = hi2f(p.y);
                h[8 * k + 4] = lo2f(p.z); h[8 * k + 5] = hi2f(p.z); h[8 * k + 6] = lo2f(p.w); h[8 * k + 7] = hi2f(p.w); }
            float mx = 0.f;
#pragma unroll
            for (int i = 0; i < 32; ++i) mx = fmaxf(mx, fabsf(h[i]));
            sh = (mx > 0.f) ? mx * (1.f / 127.f) : 1.f;
            const float inv = 1.f / sh;
            int hs = 0;
#pragma unroll
            for (int k = 0; k < 4; ++k)
#pragma unroll
                for (int par = 0; par < 2; ++par) {
                    const int q0 = (int)rintf(h[8 * k + par] * inv), q1 = (int)rintf(h[8 * k + 2 + par] * inv), q2 = (int)rintf(h[8 * k + 4 + par] * inv), q3 = (int)rintf(h[8 * k + 6 + par] * inv);
                    hs += q0 + q1 + q2 + q3;
                    hq[2 * k + par] = (q0 & 0xff) | ((q1 & 0xff) << 8) | ((q2 & 0xff) << 16) | ((int)((unsigned)(q3 & 0xff) << 24));
                }
            hsum8 = 8 * hs;
        }
        float a0 = 0.f, a1 = 0.f;
#define U_COMPUTE(r_, s_, r0_) do { float d_[4]; \
            _Pragma("unroll") for (int q = 0; q < 4; ++q) d_[q] = (float)(idot32_i4(r_[q], hq) - hsum8) * (bf2f(s_[q]) * sh); \
            _Pragma("unroll") for (int o = 32; o > 0; o >>= 1) { _Pragma("unroll") for (int q = 0; q < 4; ++q) d_[q] += __shfl_xor(d_[q], o); } \
            _Pragma("unroll") for (int q = 0; q < 4; ++q) { const int rr_ = (r0_) + q; \
                if (rr_ < 64) a0 = (lane == rr_) ? d_[q] : a0; else a1 = (lane == rr_ - 64) ? d_[q] : a1; } } while (0)
#pragma unroll 1
        for (int r0 = 0; r0 < 128; r0 += 8) {
            ROW_LOAD(U, rB, sB, r0 + 4);
            U_COMPUTE(rA, sA, r0);
            if (r0 + 8 < 128) ROW_LOAD(U, rA, sA, r0 + 8); else ROW_LOAD(V, rA, sA, 0);
            U_COMPUTE(rB, sB, r0 + 4);
        }
        const float w0 = gv0 * gelu_f(a0), w1 = gv1 * gelu_f(a1);
        float acc[32];
#pragma unroll
        for (int i = 0; i < 32; ++i) acc[i] = 0.f;
#define V_COMPUTE(r_, s_, r0_) do { _Pragma("unroll") for (int q = 0; q < 4; ++q) { const int rr_ = (r0_) + q; \
                const float g_ = __builtin_bit_cast(float, __builtin_amdgcn_readlane(__builtin_bit_cast(int, rr_ < 64 ? w0 : w1), rr_ & 63)); \
                axpy32_fp4(r_[q], g_ * bf2f(s_[q]), acc); } } while (0)
        if (has_next) TOK_FETCH(t + NGW, niv0, niv1, ngv0, ngv1);
#pragma unroll 1
        for (int r0 = 0; r0 < 128; r0 += 8) {
            ROW_LOAD(V, rB, sB, r0 + 4);
            V_COMPUTE(rA, sA, r0);
            if (r0 + 8 < 128) ROW_LOAD(V, rA, sA, r0 + 8);
            else if (has_next) { iv0 = niv0; iv1 = niv1; gv0 = ngv0; gv1 = ngv1; ROW_LOAD(U, rA, sA, 0); }
            V_COMPUTE(rB, sB, r0 + 4);
        }
#undef U_COMPUTE
#undef V_COMPUTE
        float ss = 0.f;
#pragma unroll
        for (int k = 0; k < 8; ++k) {
            const int c0 = lane * 32 + 4 * k;
            const uint2 xp = *(const uint2*)(X1 + (size_t)t * D + c0);
            const float4 xa = make_float4(lo2f(xp.x), hi2f(xp.x), lo2f(xp.y), hi2f(xp.y));
            const float4 ga = *(const float4*)(mod + b * 12288 + 5 * 2048 + c0);
            acc[4 * k + 0] = xa.x + ga.x * acc[4 * k + 0]; acc[4 * k + 1] = xa.y + ga.y * acc[4 * k + 1];
            acc[4 * k + 2] = xa.z + ga.z * acc[4 * k + 2]; acc[4 * k + 3] = xa.w + ga.w * acc[4 * k + 3];
#pragma unroll
            for (int i = 0; i < 4; ++i) ss += acc[4 * k + i] * acc[4 * k + i];
        }
        ss = wave_sum(ss);
        const float rstd = rsqrtf(ss * (1.f / D) + NORM_EPS);
#pragma unroll
        for (int k = 0; k < 8; ++k) {
            const int c0 = lane * 32 + 4 * k;
            const float4 gf = *(const float4*)(a.g_fin + c0);
            *(float4*)(a.out + (size_t)t * D + c0) = make_float4(acc[4 * k + 0] * rstd * gf.x, acc[4 * k + 1] * rstd * gf.y, acc[4 * k + 2] * rstd * gf.z, acc[4 * k + 3] * rstd * gf.w);
        }
    }
#undef ROW_LOAD
#undef TOK_FETCH
}

#define XB_TMO      128
#define XB_XCNT(j)  (256  + 64 * (j))
#define XB_XSUB(j)  (1280 + 64 * (j))
#define XB_XGEN(j)  (2304 + 64 * (j))
#define XB_TOP      3328
#define XB_TOPGEN   3392
#define XCD_BAR_WORDS 3456
#define XB_SPIN_CAP (1u << 18)

__device__ __forceinline__ unsigned xb_ld(unsigned* p)              { return __hip_atomic_load(p, __ATOMIC_RELAXED, __HIP_MEMORY_SCOPE_AGENT); }
__device__ __forceinline__ unsigned xb_add(unsigned* p, unsigned v) { return __hip_atomic_fetch_add(p, v, __ATOMIC_RELAXED, __HIP_MEMORY_SCOPE_AGENT); }
__device__ __forceinline__ unsigned xb_xcc_id() { return (unsigned)__builtin_amdgcn_s_getreg((3 << 11) | 20) & 0xFu; }
#define XB_SPIN(cond, bar) do { unsigned _sp = 0; while (cond) { __builtin_amdgcn_s_sleep(1); \
    if ((++_sp & 255u) == 0u) { if (xb_ld(&(bar)[XB_TMO])) break; if (_sp > XB_SPIN_CAP) { atomicAdd(&(bar)[XB_TMO], 1u); break; } } } } while (0)

struct XcdBarrier {
    unsigned* bar; unsigned x;
    volatile LAS unsigned* st;
};

__device__ __forceinline__ XcdBarrier xcd_barrier_post(unsigned* bar, volatile LAS unsigned* st) {
    XcdBarrier b; b.bar = bar; b.x = xb_xcc_id(); b.st = st;
    if (threadIdx.x == 0) (void)xb_add(&bar[XB_XCNT(b.x)], 1u);
    return b;
}
__device__ __forceinline__ void xcd_barrier_complete(unsigned* bar, unsigned x, unsigned& nloc, unsigned& nx) {
    const unsigned G = gridDim.x * gridDim.y * gridDim.z;
    unsigned sum, cnt, mine, sp = 0u;
    for (;;) {
        sum = 0u; cnt = 0u; mine = 0u;
#pragma unroll
        for (unsigned j = 0; j < 16; ++j) { const unsigned c = xb_ld(&bar[XB_XCNT(j)]); sum += c; cnt += (c > 0u) ? 1u : 0u; mine = (j == x) ? c : mine; }
        if (sum == G) break;
        __builtin_amdgcn_s_sleep(1);
        if ((++sp & 255u) == 0u) { if (xb_ld(&bar[XB_TMO])) break; if (sp > XB_SPIN_CAP) { atomicAdd(&bar[XB_TMO], 1u); break; } }
    }
    nloc = mine > 0u ? mine : 1u; nx = cnt > 0u ? cnt : 1u;
}

__device__ __forceinline__ void xcd_barrier(const XcdBarrier& b) {
    asm volatile("s_waitcnt vmcnt(0)" ::: "memory");
    __syncthreads();
    if (threadIdx.x == 0) {
        unsigned* bar = b.bar;
        __builtin_amdgcn_s_waitcnt(0);
        unsigned nloc = b.st[0], nx = b.st[1];
        if (nloc == 0u) { xcd_barrier_complete(bar, b.x, nloc, nx); b.st[0] = nloc; b.st[1] = nx; }
        const unsigned old = xb_add(&bar[XB_XSUB(b.x)], 1u);
        const unsigned gen = old / nloc;
        if (old + 1u == (gen + 1u) * nloc) {
            __builtin_amdgcn_fence(__ATOMIC_RELEASE, "agent");
            asm volatile("s_waitcnt vmcnt(0)" ::: "memory");
            const unsigned og = xb_add(&bar[XB_TOP], 1u);
            const unsigned tg = og / nx;
            if (og + 1u == (tg + 1u) * nx) xb_add(&bar[XB_TOPGEN], 1u);
            else XB_SPIN(xb_ld(&bar[XB_TOPGEN]) == tg, bar);
            __builtin_amdgcn_fence(__ATOMIC_ACQUIRE, "agent");
            xb_add(&bar[XB_XGEN(b.x)], 1u);
            asm volatile("s_waitcnt vmcnt(0)" ::: "memory");
        } else {
            XB_SPIN(xb_ld(&bar[XB_XGEN(b.x)]) == gen, bar);
            __builtin_amdgcn_fence(__ATOMIC_ACQUIRE, "agent");
            asm volatile("s_waitcnt vmcnt(0)" ::: "memory");
        }
    }
    __syncthreads();
}

constexpr int NPHASES = 11;
__global__ void __launch_bounds__(NTHREADS, 2) mk_fwd(Args a) {
    extern __shared__ __attribute__((aligned(16))) unsigned char lds[];
    cg::grid_group grid = cg::this_grid();
    const int lo = a.ph_lo, hi = a.ph_hi;
    volatile LAS unsigned* xbw = (volatile LAS unsigned*)(lds + LDS_MAIN);
    if (threadIdx.x < 4) xbw[threadIdx.x] = 0u;
    __syncthreads();
    XcdBarrier xbar = xcd_barrier_post((unsigned*)(a.ws + WS_CTL), xbw);
#define IN(k) (lo <= (k) && (k) < hi)
#define SEAM(k) do { if (IN(k) && IN((k) + 1)) { if ((k) == 0) grid.sync(); else xcd_barrier(xbar); } } while (0)
    const float* mod = (const float*)(a.ws + WS_MOD);
    if (IN(0)) phase0(a, lds);
    SEAM(0);
    if (IN(1)) norm_mod_phase<false>(a.x, a.g_mix, mod, 0, 1, (u16*)(a.ws + WS_ACT));
    SEAM(1);
    if (IN(2)) { gemm8(lds, (const u16*)(a.ws + WS_ACT), (const u16*)(a.ws + WS_WIN), T, NP, D, EpiProj{(u16*)(a.ws + WS_P)}); gz_phase(lds, (const u16*)(a.ws + WS_ACT), (const u16*)(a.ws + WS_WIN) + (size_t)NP * D, (float*)(a.ws + WS_GZ)); }
    SEAM(2);
    if (IN(3)) phase_rope_prep(a, lds);
    SEAM(3);
    if (IN(4)) phase_mixers(a, lds);
    SEAM(4);
    if (IN(5)) phase_gla_fin(a);
    SEAM(5);
    if (IN(6)) gemm8(lds, (const u16*)(a.ws + WS_ACT), (const u16*)(a.ws + WS_WOUT), T, D, D, EpiResid{a.x, mod, (u16*)(a.ws + WS_X1)});
    SEAM(6);
    if (IN(7)) { norm_mod_phase<true>(a.ws + WS_X1, a.g_ffn, mod, 3, 4, (u16*)(a.ws + WS_ACT)); convert_tables(a); }
    SEAM(7);
    if (IN(8)) gemm8(lds, (const u16*)(a.ws + WS_ACT), (const u16*)(a.ws + WS_WPQ), T, D, D, EpiBf16{(u16*)(a.ws + WS_Q)});
    SEAM(8);
    if (IN(9)) phase_route(a, lds);
    SEAM(9);
    if (IN(10)) phase_experts(a);
#ifdef PROBE_REP10
    grid.sync(); phase_experts(a);
#endif
#ifdef PROBE_REP9
    grid.sync(); phase_route(a, lds); grid.sync(); phase_experts(a);
#endif
#undef IN
#undef SEAM
}

#ifndef MK_ONE_LAUNCH
#define MK_ONE_LAUNCH 1
#endif
extern "C" void kernel_launch(void* const* d_in, const int* in_sizes, int n_in, void* d_out, int out_size, void* d_ws, size_t ws_size, hipStream_t stream) {
    static int grid = 0;
    if (grid == 0) {
        if (n_in != 19 || out_size != T * D || ws_size < WS_END) {
            fprintf(stderr, "kernel_launch: unexpected shapes: n_in %d out %d ws %zu (need %zu)\n", n_in, out_size, ws_size, (size_t)WS_END);
            grid = -1; return;
        }
        int dev = 0, cus = 0, per_cu = 0;
        (void)hipGetDevice(&dev);
        (void)hipDeviceGetAttribute(&cus, hipDeviceAttributeMultiprocessorCount, dev);
        (void)hipFuncSetAttribute((const void*)mk_fwd, hipFuncAttributeMaxDynamicSharedMemorySize, LDS_BYTES);
        (void)hipOccupancyMaxActiveBlocksPerMultiprocessor(&per_cu, (const void*)mk_fwd, NTHREADS, LDS_BYTES);
        if (per_cu < 1) { fprintf(stderr, "kernel_launch: occupancy query says %d blocks/CU\n", per_cu); grid = -1; return; }
        grid = cus;
        (void)hipGetLastError();
    }
    if (grid < 0) return;
    Args a{};
    a.x = (const float*)d_in[0]; a.c = (const float*)d_in[1]; a.pos = (const int*)d_in[2]; a.w_ada = (const float*)d_in[3];
    a.b_ada = (const float*)d_in[4]; a.g_mix = (const float*)d_in[5]; a.w_in = (const float*)d_in[6]; a.wgf = (const float*)d_in[7];
    a.bgf = (const float*)d_in[8]; a.wgb = (const float*)d_in[9]; a.bgb = (const float*)d_in[10]; a.g_gla = (const float*)d_in[11];
    a.w_out = (const float*)d_in[12]; a.g_ffn = (const float*)d_in[13]; a.w_pq = (const float*)d_in[14]; a.subk = (const float*)d_in[15];
    a.pu = (const float*)d_in[16]; a.pv = (const float*)d_in[17]; a.g_fin = (const float*)d_in[18];
    a.out = (float*)d_out; a.ws = (unsigned char*)d_ws;
#if MK_ONE_LAUNCH
    (void)hipMemsetAsync((unsigned char*)d_ws + WS_CTL, 0, XCD_BAR_WORDS * 4, stream);
    a.ph_lo = 0; a.ph_hi = NPHASES;
    void* args[] = {&a};
    hipError_t e = hipLaunchCooperativeKernel((const void*)mk_fwd, dim3(grid), dim3(NTHREADS), args, LDS_BYTES, stream);
    if (e != hipSuccess) fprintf(stderr, "cooperative launch failed: %s (grid %d)\n", hipGetErrorString(e), grid);
#else
    for (int p = 0; p < NPHASES; ++p) {
        a.ph_lo = p; a.ph_hi = p + 1;
        hipLaunchKernelGGL(mk_fwd, dim3(grid), dim3(NTHREADS), LDS_BYTES, stream, a);
    }
#endif
}
```

```cpp
#include <hip/hip_runtime.h>
#include <hip/hip_cooperative_groups.h>
#include <cstdio>
#include <cstdint>

namespace cg = cooperative_groups;

typedef unsigned short u16;
typedef __attribute__((ext_vector_type(8))) short bf16x8;
typedef __attribute__((ext_vector_type(4))) float f32x4;
typedef short s16x4 __attribute__((ext_vector_type(4)));
#define TID ((int)threadIdx.x)
#define BID ((int)blockIdx.x)
#define GDIM ((int)gridDim.x)
#define LAS __attribute__((address_space(3)))

constexpr int D = 2048, NB = 4, S = 4096, T = NB * S;
constexpr int INW = 6176;
constexpr int NP = 6144;
constexpr int NPAD = 6208;
constexpr int C_GQ = 0, C_GK = 512, C_GV = 1024, C_GR = 2048, C_DQ = 3072, C_DK = 4096, C_DV = 5120;
constexpr int NTHREADS = 512, NWAVES = 8;
constexpr int LDS_MAIN = 128 * 1024;
constexpr int LDS_BYTES = LDS_MAIN + 16;
constexpr float NORM_EPS = 1e-6f;

constexpr size_t WS_CTL = 0;
constexpr size_t WS_MOD = 65536;
constexpr size_t WS_CS = 524288;
constexpr size_t WS_WIN = WS_CS + (size_t)T * 64 * 8;
constexpr size_t WS_WOUT = WS_WIN + (size_t)NPAD * D * 2;
constexpr size_t WS_WPQ = WS_WOUT + (size_t)D * D * 2;
constexpr size_t WS_ACT = WS_WPQ + (size_t)D * D * 2;
constexpr size_t WS_P = WS_ACT + (size_t)T * D * 2;
constexpr size_t WS_X1 = WS_P;
constexpr size_t WS_Q = WS_P + (size_t)T * D * 4;
constexpr size_t WS_GZ = WS_P + (size_t)T * NP * 2;
constexpr int GLA_NPREP = NB * 4 * 2 * (S / 64);
constexpr size_t WS_QD = WS_GZ + (size_t)T * 32 * 4;
constexpr size_t WS_KE = WS_QD + (size_t)GLA_NPREP * 16384;
constexpr size_t WS_AT = WS_KE + (size_t)GLA_NPREP * 16384;
constexpr size_t WS_DEC = WS_AT + (size_t)GLA_NPREP * 8192;
constexpr size_t WS_OFB = WS_DEC + (size_t)GLA_NPREP * 512;
constexpr size_t WS_IDX = WS_OFB + (size_t)2 * T * 1024 * 2;
constexpr size_t WS_GATE = WS_IDX + (size_t)T * 128 * 4;
constexpr size_t WS_END = WS_GATE + (size_t)T * 128 * 4;
constexpr size_t WS_TU = WS_QD;
constexpr size_t WS_TV = WS_QD + (size_t)16384 * 1152;
static_assert(WS_TV + (size_t)16384 * 1152 <= WS_IDX, "table region");

struct Args {
    const float* x; const float* c; const int* pos; const float* w_ada; const float* b_ada; const float* g_mix;
    const float* w_in; const float* wgf; const float* bgf; const float* wgb; const float* bgb; const float* g_gla;
    const float* w_out; const float* g_ffn; const float* w_pq; const float* subk; const float* pu; const float* pv; const float* g_fin;
    float* out; unsigned char* ws; int ph_lo, ph_hi;
};

__device__ __forceinline__ float bf2f(u16 h) { return __uint_as_float(((unsigned)h) << 16); }
typedef __bf16 hw_bf16x2 __attribute__((ext_vector_type(2)));
typedef float hw_f32x2 __attribute__((ext_vector_type(2)));
__device__ __forceinline__ unsigned pack2(float a, float b) { const hw_f32x2 f = {a, b}; return __builtin_bit_cast(unsigned, __builtin_convertvector(f, hw_bf16x2)); }
__device__ __forceinline__ u16 f2bf(float f) { return (u16)(pack2(f, 0.f) & 0xffffu); }
__device__ __forceinline__ float lo2f(unsigned p) { return __uint_as_float(p << 16); }
__device__ __forceinline__ float hi2f(unsigned p) { return __uint_as_float(p & 0xffff0000u); }
__device__ __forceinline__ float wave_sum(float v) {
#pragma unroll
    for (int o = 32; o > 0; o >>= 1) v += __shfl_xor(v, o);
    return v;
}
__device__ __forceinline__ float wave_max(float v) {
#pragma unroll
    for (int o = 32; o > 0; o >>= 1) v = fmaxf(v, __shfl_xor(v, o));
    return v;
}
__device__ __forceinline__ float silu_f(float v) { return v / (1.f + __expf(-v)); }
__device__ __forceinline__ float gelu_f(float a) { return 0.5f * a * (1.f + erff(a * 0.70710678118654752f)); }
__device__ __forceinline__ float logsigmoid_f(float z) { return z < 0.f ? z - log1pf(expf(z)) : -log1pf(expf(-z)); }

constexpr int MOD_BLOCKS = 96;
__device__ __forceinline__ void p0_mod(const Args& a, unsigned char* lds, int bi) {
    float* sc = (float*)lds;
    float* red = sc + 4 * 2048;
    const int tid = threadIdx.x, lane = tid & 63, wave = tid >> 6;
    for (int i = tid; i < 4 * 2048; i += NTHREADS) sc[i] = silu_f(a.c[i]);
    __syncthreads();
    const int j0 = bi * 128 + lane * 2;
    float acc[4][2];
#pragma unroll
    for (int b = 0; b < 4; ++b) { acc[b][0] = 0.f; acc[b][1] = 0.f; }
    const int k0 = wave * 256;
#pragma unroll 8
    for (int kk = 0; kk < 256; ++kk) {
        const int k = k0 + kk;
        const float2 w = *(const float2*)(a.w_ada + (size_t)k * 12288 + j0);
#pragma unroll
        for (int b = 0; b < 4; ++b) { const float s = sc[b * 2048 + k]; acc[b][0] += s * w.x; acc[b][1] += s * w.y; }
    }
#pragma unroll
    for (int b = 0; b < 4; ++b) { red[(wave * 4 + b) * 128 + lane * 2] = acc[b][0]; red[(wave * 4 + b) * 128 + lane * 2 + 1] = acc[b][1]; }
    __syncthreads();
    float* mod = (float*)(a.ws + WS_MOD);
    {
        const int b = tid >> 7, jc = tid & 127;
        float s = 0.f;
#pragma unroll
        for (int w = 0; w < 8; ++w) s += red[(w * 4 + b) * 128 + jc];
        mod[b * 12288 + bi * 128 + jc] = s + a.b_ada[bi * 128 + jc];
    }
    __syncthreads();
}

__device__ __forceinline__ void p0_transpose_item(const float* __restrict__ W, int ldw, int k0, int src_col0, int n_valid,
                                                  u16* __restrict__ WT, int ldt, int n_out0, unsigned char* wlds) {
    u16* tl = (u16*)wlds;
    const int lane = threadIdx.x & 63;
    const int rsub = lane >> 4, nc = (lane & 15) * 4;
    float4 v[16];
#pragma unroll
    for (int j = 0; j < 16; ++j) {
        const int k = 4 * j + rsub;
        v[j] = (nc < n_valid) ? *(const float4*)(W + (size_t)(k0 + k) * ldw + src_col0 + nc) : make_float4(0.f, 0.f, 0.f, 0.f);
    }
#pragma unroll
    for (int j = 0; j < 16; ++j) {
        const int k = 4 * j + rsub;
        tl[(nc + 0) * 72 + k] = f2bf(v[j].x); tl[(nc + 1) * 72 + k] = f2bf(v[j].y); tl[(nc + 2) * 72 + k] = f2bf(v[j].z); tl[(nc + 3) * 72 + k] = f2bf(v[j].w);
    }
#pragma unroll
    for (int j = 0; j < 8; ++j) {
        const int c = lane + 64 * j, n = c >> 3, kc = (c & 7) * 8;
        const uint4 o = *(const uint4*)(tl + n * 72 + kc);
        *(uint4*)(WT + (size_t)(n_out0 + n) * ldt + k0 + kc) = o;
    }
}

__device__ __forceinline__ void phase0(const Args& a, unsigned char* lds) {
    const int bi = blockIdx.x, G = gridDim.x, tid = threadIdx.x, wave = tid >> 6;
    const bool modblk = (G > MOD_BLOCKS) && (bi < MOD_BLOCKS);
    if (G > MOD_BLOCKS) { if (modblk) p0_mod(a, lds, bi); }
    else { for (int mb = bi; mb < MOD_BLOCKS; mb += G) p0_mod(a, lds, mb); }
    const int nb = (G > MOD_BLOCKS) ? G - MOD_BLOCKS : G, b0 = (G > MOD_BLOCKS) ? bi - MOD_BLOCKS : bi;
    if (!modblk) {
        constexpr int I_IN = 32 * (NPAD / 64), I_SQ = 32 * 32;
        u16* WinT = (u16*)(a.ws + WS_WIN); u16* WoutT = (u16*)(a.ws + WS_WOUT); u16* WpqT = (u16*)(a.ws + WS_WPQ);
        unsigned char* wlds = lds + wave * 9216;
        for (int it = b0 * NWAVES + wave; it < I_IN + 2 * I_SQ; it += nb * NWAVES) {
            if (it < I_IN) {
                const int kt = it & 31, nt = it >> 5;
                const int n0 = nt * 64;
                int src, nv;
                if (n0 < 3072) { src = n0; nv = 64; }
                else if (n0 < 6144) { src = n0 + 32; nv = 64; }
                else if (n0 == 6144) { src = 3072; nv = 32; }
                else { src = 0; nv = 0; }
                p0_transpose_item(a.w_in, INW, kt * 64, src, nv, WinT, D, n0, wlds);
            } else if (it < I_IN + I_SQ) {
                const int r = it - I_IN; const int kt = r & 31, nt = r >> 5;
                p0_transpose_item(a.w_out, D, kt * 64, nt * 64, 64, WoutT, D, nt * 64, wlds);
            } else {
                const int r = it - I_IN - I_SQ; const int kt = r & 31, nt = r >> 5;
                p0_transpose_item(a.w_pq, D, kt * 64, nt * 64, 64, WpqT, D, nt * 64, wlds);
            }
        }
        float2* cs = (float2*)(a.ws + WS_CS);
        for (int i = b0 * NTHREADS + tid; i < T * 64; i += nb * NTHREADS) {
            const int t = i >> 6, f = i & 63;
            const float inv_freq = powf(10000.0f, -(float)f * 2.0f / 128.0f);
            const float ang = (float)a.pos[t] * inv_freq;
            const double rev = (double)ang * 0.15915494309189533577;
            const float fr = (float)(rev - floor(rev));
            cs[i] = make_float2(__builtin_amdgcn_cosf(fr), __builtin_amdgcn_sinf(fr));
        }
    }
    __syncthreads();
}

template <bool BF16IN> __device__ __forceinline__ void norm_mod_phase(const void* __restrict__ xin_, const float* __restrict__ g, const float* __restrict__ mod,
                                               int sh_chunk, int sc_chunk, u16* __restrict__ outp) {
    const int lane = threadIdx.x & 63, wave = threadIdx.x >> 6;
    const int gw = blockIdx.x * NWAVES + wave, NGW = gridDim.x * NWAVES;
    float4 v[8], vn[8];
#define NM_LOAD(dst_, t_) do { if (BF16IN) { const uint2* xr_ = (const uint2*)((const u16*)xin_ + (size_t)(t_) * D); \
            _Pragma("unroll") for (int m = 0; m < 8; ++m) { const uint2 p_ = xr_[lane + 64 * m]; dst_[m] = make_float4(lo2f(p_.x), hi2f(p_.x), lo2f(p_.y), hi2f(p_.y)); } } \
        else { const float4* xr_ = (const float4*)((const float*)xin_ + (size_t)(t_) * D); _Pragma("unroll") for (int m = 0; m < 8; ++m) dst_[m] = xr_[lane + 64 * m]; } } while (0)
    if (gw < T) NM_LOAD(v, gw);
    for (int t = gw; t < T; t += NGW) {
        const int b = t / S;
        if (t + NGW < T) NM_LOAD(vn, t + NGW);
        float ss = 0.f;
#pragma unroll
        for (int m = 0; m < 8; ++m) ss += v[m].x * v[m].x + v[m].y * v[m].y + v[m].z * v[m].z + v[m].w * v[m].w;
        ss = wave_sum(ss);
        const float rstd = rsqrtf(ss * (1.f / D) + NORM_EPS);
        const float4* gp = (const float4*)g;
        const float4* shp = (const float4*)(mod + b * 12288 + sh_chunk * 2048);
        const float4* scp = (const float4*)(mod + b * 12288 + sc_chunk * 2048);
        uint2* op = (uint2*)(outp + (size_t)t * D);
#pragma unroll
        for (int m = 0; m < 8; ++m) {
            const int i = lane + 64 * m;
            const float4 gg = gp[i], sh = shp[i], sc = scp[i];
            const float h0 = v[m].x * rstd * gg.x * (1.f + sc.x) + sh.x;
            const float h1 = v[m].y * rstd * gg.y * (1.f + sc.y) + sh.y;
            const float h2 = v[m].z * rstd * gg.z * (1.f + sc.z) + sh.z;
            const float h3 = v[m].w * rstd * gg.w * (1.f + sc.w) + sh.w;
            op[i] = make_uint2(pack2(h0, h1), pack2(h2, h3));
        }
#pragma unroll
        for (int m = 0; m < 8; ++m) v[m] = vn[m];
    }
#undef NM_LOAD
}

namespace pg8 {
#define PG8_LAS __attribute__((address_space(3)))
typedef unsigned short bf16_t;
typedef short bf16x8 __attribute__((ext_vector_type(8)));
typedef float f32x4 __attribute__((ext_vector_type(4)));
typedef unsigned u32x4 __attribute__((ext_vector_type(4)));
constexpr int BM = 256, BK = 64, HALF = 128, HTB = HALF * BK * 2  , STAGE_BYTES = 8 * HTB, NXCD = 8, WGM = 8;

__host__ __device__ __forceinline__ int lds_byte(int r, int c) { const int st = (r >> 4) * 2 + (c >> 5), rr = r & 15, cc = c & 31, ob = rr * 64 + cc * 2; return st * 1024 + (ob ^ (((ob >> 9) & 1) << 5)); }
__host__ __device__ __forceinline__ void stage_rc(int b, int& R, int& C) { const int st = b / 1024, sb = b % 1024, swz = sb ^ (((sb >> 9) & 1) << 5); R = (st >> 1) * 16 + swz / 64; C = (st & 1) * 32 + (swz % 64) / 2; }
__host__ __device__ __forceinline__ int perm32(int rho) { const int n = rho >> 4, i = rho & 15; return 8 * (i >> 2) + 4 * n + (i & 3); }

struct Unit { int pm, pn; };
struct Gemm { const bf16_t* A; const bf16_t* Bt; int M, N, K; };

struct StaticOrder {
    int nM, nN, nwg, G, c;
    __host__ __device__ void init(int M, int N, int G_, int c_) { nM = M / BM; nN = N / BM; nwg = nM * nN; G = G_; c = c_; }
    __host__ __device__ bool next(int i, Unit& u) const {
        const long L = (long)i * G + c; if (L >= nwg) return false;
        int wgid = (int)L; { const int q = nwg / NXCD, r = nwg % NXCD, xcd = wgid % NXCD, off = wgid / NXCD; wgid = (xcd < r ? xcd * (q + 1) : r * (q + 1) + (xcd - r) * q) + off; }
        const int nig = WGM * nN, gid = wgid / nig, fm = gid * WGM, gsz = (nM - fm) < WGM ? (nM - fm) : WGM;
        u.pm = fm + ((wgid % nig) % gsz); u.pn = (wgid % nig) / gsz; return true;
    }
    __device__ __forceinline__ void a_ready(const Unit&) const {}
    __device__ __forceinline__ void done(const Unit&) const {}
};
__device__ __forceinline__ unsigned cvt_pk_bf16(float lo, float hi) { unsigned r; asm volatile("v_cvt_pk_bf16_f32 %0, %1, %2" : "=v"(r) : "v"(lo), "v"(hi)); return r; }
typedef float f32x2 __attribute__((ext_vector_type(2)));
template <class Epi, class Sched, bool STAMP = false>
__device__ __forceinline__ void gemm_phase(PG8_LAS unsigned char* lds, const Gemm g, const Sched& S, const Epi& E, unsigned long long* stamps) {
    const int tid = threadIdx.x, wid = __builtin_amdgcn_readfirstlane(tid >> 6), lane = tid & 63, wr = wid >> 2, wc = wid & 3, fr = lane & 15, fq = lane >> 4;
    const int K = g.K, nt = K / BK;
    int ts_lo = 0, ts_hi = 0, nts = 0; const unsigned long long rt_entry = STAMP ? (unsigned long long)wall_clock64() : 0ull;
#define PG8_STAMP() do { if (STAMP && wid == 0 && nts < 64) { const unsigned long long _c = (unsigned long long)clock64(); \
        ts_lo = (lane == nts) ? (int)(unsigned)_c : ts_lo; ts_hi = (lane == nts) ? (int)(unsigned)(_c >> 32) : ts_hi; ++nts; } } while (0)
    PG8_STAMP();
    unsigned voffA[2], voffB[2];
#pragma unroll
    for (int i = 0; i < 2; ++i) { int R, C; stage_rc(tid * 16 + i * 8192, R, C); const int Rb = Epi::PERM ? ((R & ~31) + perm32(R & 31)) : R;
        voffA[i] = (unsigned)(R * K + C) * 2u; voffB[i] = (unsigned)(Rb * K + C) * 2u; }
    const size_t kstep = (size_t)(BK * 2);
    const size_t hstep = (size_t)HALF * K * 2;
    const size_t tstep = 2 * hstep;
    const unsigned ldsw = (unsigned)wid * 1024u;
    const int aoff = lds_byte(wr * 64 + fr, fq * 8), boff = lds_byte(wc * 32 + fr, fq * 8);
#define PG8_SA(b, h) (((b) * 2 + (h)) * HTB)
#define PG8_SB(b, h) ((4 + (b) * 2 + (h)) * HTB)
#define PG8_STAGE(bufoff, gbase, voff) do { _Pragma("unroll") for (int _i = 0; _i < 2; ++_i) \
        __builtin_amdgcn_global_load_lds((const unsigned*)((const char*)(gbase) + (voff)[_i]), (PG8_LAS unsigned*)(lds + (bufoff) + ldsw + _i * 8192), 16, 0, 0); } while (0)
#define PG8_LDA(dst, b, h) do { _Pragma("unroll") for (int m = 0; m < 4; ++m) _Pragma("unroll") for (int k = 0; k < 2; ++k) dst[m][k] = *(const PG8_LAS bf16x8*)(lds + PG8_SA(b, h) + aoff + m * 2048 + k * 1024); } while (0)
#define PG8_LDB(dst, b, h) do { _Pragma("unroll") for (int n = 0; n < 2; ++n) _Pragma("unroll") for (int k = 0; k < 2; ++k) dst[n][k] = *(const PG8_LAS bf16x8*)(lds + PG8_SB(b, h) + boff + n * 2048 + k * 1024); } while (0)
#define PG8_MMA(ai, bj, At, Bt) do { __builtin_amdgcn_s_setprio(1); _Pragma("unroll") for (int m = 0; m < 4; ++m) _Pragma("unroll") for (int n = 0; n < 2; ++n) _Pragma("unroll") for (int k = 0; k < 2; ++k) \
        acc[ai][bj][m][n] = __builtin_amdgcn_mfma_f32_16x16x32_bf16(Bt[n][k], At[m][k], acc[ai][bj][m][n], 0, 0, 0); __builtin_amdgcn_s_setprio(0); } while (0)
#define PG8_WAIT_V(n) asm volatile("s_waitcnt vmcnt(" #n ")" ::: "memory")
#define PG8_WAIT_L(n) asm volatile("s_waitcnt lgkmcnt(" #n ")" ::: "memory")
#define PG8_BAR __builtin_amdgcn_s_barrier()
#define PG8_SCHED __builtin_amdgcn_sched_barrier(0)
    Unit cur, nxt; int ui = 0;
    if (!S.next(0, cur)) return;
    f32x4 acc[2][2][4][2];
#pragma unroll
    for (int a = 0; a < 2; ++a)
#pragma unroll
        for (int b = 0; b < 2; ++b)
#pragma unroll
            for (int m = 0; m < 4; ++m)
#pragma unroll
                for (int n = 0; n < 2; ++n) acc[a][b][m][n] = (f32x4){0.f, 0.f, 0.f, 0.f};
    bf16x8 At[4][2], B0[2][2], B1[2][2];
    const char* cA = (const char*)g.A + (size_t)cur.pm * tstep; const char* cB = (const char*)g.Bt + (size_t)cur.pn * tstep;
    S.a_ready(cur);
    PG8_STAGE(PG8_SB(0, 0), cB, voffB); PG8_STAGE(PG8_SA(0, 0), cA, voffA); PG8_STAGE(PG8_SB(0, 1), cB + hstep, voffB); PG8_STAGE(PG8_SA(0, 1), cA + hstep, voffA);
    if (wr == 1) PG8_BAR;
    PG8_WAIT_V(4); PG8_BAR;
    PG8_STAGE(PG8_SB(1, 0), cB + kstep, voffB); PG8_STAGE(PG8_SA(1, 0), cA + kstep, voffA); PG8_STAGE(PG8_SB(1, 1), cB + hstep + kstep, voffB);
    PG8_WAIT_V(6); PG8_BAR;
    PG8_STAMP();
    for (;;) {
        const bool has_next = S.next(ui + 1, nxt);
        const char* nA = has_next ? (const char*)g.A + (size_t)nxt.pm * tstep : cA; const char* nB = has_next ? (const char*)g.Bt + (size_t)nxt.pn * tstep : cB;
        for (int t = 0; t < nt; t += 2) {
            const bool last = (t == nt - 2);
            const char* a1 = cA + (size_t)(t + 1) * kstep;
            const char* a2 = last ? nA : cA + (size_t)(t + 2) * kstep; const char* b2 = last ? nB : cB + (size_t)(t + 2) * kstep;
            const char* a3 = a2 + kstep; const char* b3 = b2 + kstep;
            if (last && has_next) S.a_ready(nxt);
            PG8_LDB(B0, 0, 0); PG8_SCHED; PG8_LDA(At, 0, 0); PG8_STAGE(PG8_SA(1, 1), a1 + hstep, voffA);
            PG8_WAIT_L(8); PG8_BAR; PG8_WAIT_L(0); PG8_MMA(0, 0, At, B0); PG8_BAR; PG8_SCHED;
            PG8_LDB(B1, 0, 1); PG8_STAGE(PG8_SB(0, 0), b2, voffB);
            PG8_BAR; PG8_WAIT_L(0); PG8_MMA(0, 1, At, B1); PG8_BAR;
            PG8_LDA(At, 0, 1); PG8_STAGE(PG8_SA(0, 0), a2, voffA);
            PG8_BAR; PG8_WAIT_L(0); PG8_MMA(1, 0, At, B0); PG8_BAR; PG8_SCHED;
            PG8_STAGE(PG8_SB(0, 1), b2 + hstep, voffB);
            PG8_WAIT_V(6); PG8_BAR; PG8_MMA(1, 1, At, B1); PG8_BAR;
            PG8_LDB(B0, 1, 0); PG8_SCHED; PG8_LDA(At, 1, 0); PG8_STAGE(PG8_SA(0, 1), a2 + hstep, voffA);
            PG8_WAIT_L(8); PG8_BAR; PG8_WAIT_L(0); PG8_MMA(0, 0, At, B0); PG8_BAR; PG8_SCHED;
            PG8_LDB(B1, 1, 1); PG8_STAGE(PG8_SB(1, 0), b3, voffB);
            PG8_BAR; PG8_WAIT_L(0); PG8_MMA(0, 1, At, B1); PG8_BAR;
            PG8_LDA(At, 1, 1); PG8_STAGE(PG8_SA(1, 0), a3, voffA);
            PG8_BAR; PG8_WAIT_L(0); PG8_MMA(1, 0, At, B0); PG8_BAR; PG8_SCHED;
            PG8_STAGE(PG8_SB(1, 1), b3 + hstep, voffB);
            PG8_WAIT_V(6); PG8_BAR; PG8_MMA(1, 1, At, B1); PG8_BAR;
        }
        PG8_STAMP();
        if constexpr (!Epi::AFTER_DRAIN) { E(acc, cur, wr, wc, fr, fq); S.done(cur); }
        PG8_STAMP();
        if (!has_next) break;
#pragma unroll
        for (int a = 0; a < 2; ++a)
#pragma unroll
            for (int b = 0; b < 2; ++b)
#pragma unroll
                for (int m = 0; m < 4; ++m)
#pragma unroll
                    for (int n = 0; n < 2; ++n) acc[a][b][m][n] = (f32x4){0.f, 0.f, 0.f, 0.f};
        cur = nxt; cA = nA; cB = nB; ++ui;
    }
    PG8_WAIT_V(0);
    if (wr == 0) PG8_BAR;
    PG8_BAR;
    if constexpr (Epi::AFTER_DRAIN) { E.fused(acc, cur, wr, wc, fr, fq, lds, wid, lane); S.done(cur); }
    PG8_STAMP();
    if (STAMP && wid == 0) { stamps[lane] = lane < nts ? (((unsigned long long)(unsigned)ts_hi << 32) | (unsigned)ts_lo) : 0ull;
        if (lane == 62) stamps[62] = rt_entry; if (lane == 63) stamps[63] = (unsigned long long)wall_clock64(); }
#undef PG8_STAMP
#undef PG8_SA
#undef PG8_SB
#undef PG8_STAGE
#undef PG8_LDA
#undef PG8_LDB
#undef PG8_MMA
#undef PG8_WAIT_V
#undef PG8_WAIT_L
#undef PG8_BAR
#undef PG8_SCHED
}
}

struct EpiProj {
    static constexpr bool PERM = true, AFTER_DRAIN = false;
    u16* P;
    __device__ __forceinline__ void operator()(const pg8::f32x4 (&acc)[2][2][4][2], const pg8::Unit& u, int wr, int wc, int fr, int fq) const {
        const int row0 = u.pm * 256 + wr * 64 + fr;
        const int col0 = u.pn * 256 + wc * 32 + 8 * fq;
#pragma unroll
        for (int ai = 0; ai < 2; ++ai)
#pragma unroll
            for (int m = 0; m < 4; ++m) { u16* rowp = P + (size_t)(row0 + ai * 128 + m * 16) * NP + col0;
#pragma unroll
                for (int bj = 0; bj < 2; ++bj) { const pg8::f32x4 v0 = acc[ai][bj][m][0], v1 = acc[ai][bj][m][1];
                    pg8::u32x4 w; w.x = pg8::cvt_pk_bf16(v0[0], v0[1]); w.y = pg8::cvt_pk_bf16(v0[2], v0[3]); w.z = pg8::cvt_pk_bf16(v1[0], v1[1]); w.w = pg8::cvt_pk_bf16(v1[2], v1[3]);
                    *(pg8::u32x4*)(rowp + bj * 128) = w; } }
    }
};
__device__ __forceinline__ void gz_phase(unsigned char* lds, const u16* __restrict__ H1, const u16* __restrict__ Wg, float* __restrict__ gz) {
    const int tid = threadIdx.x, lane = tid & 63, wave = tid >> 6, fr = lane & 15, fq = lane >> 4;
    float* red = (float*)lds;
    for (int rb = blockIdx.x; rb < T / 64; rb += gridDim.x) {
        const int r0 = rb * 64, k0 = wave * 256;
        f32x4 acc[4][2];
#pragma unroll
        for (int m = 0; m < 4; ++m) { acc[m][0] = (f32x4){0.f, 0.f, 0.f, 0.f}; acc[m][1] = (f32x4){0.f, 0.f, 0.f, 0.f}; }
#pragma unroll
        for (int ks = 0; ks < 8; ++ks) {
            bf16x8 af[4], bfr[2];
#pragma unroll
            for (int m = 0; m < 4; ++m) af[m] = *(const bf16x8*)(H1 + (size_t)(r0 + 16 * m + fr) * D + k0 + 32 * ks + 8 * fq);
#pragma unroll
            for (int n = 0; n < 2; ++n) bfr[n] = *(const bf16x8*)(Wg + (size_t)(16 * n + fr) * D + k0 + 32 * ks + 8 * fq);
#pragma unroll
            for (int m = 0; m < 4; ++m)
#pragma unroll
                for (int n = 0; n < 2; ++n) acc[m][n] = __builtin_amdgcn_mfma_f32_16x16x32_bf16(af[m], bfr[n], acc[m][n], 0, 0, 0);
        }
        __syncthreads();
#pragma unroll
        for (int m = 0; m < 4; ++m)
#pragma unroll
            for (int n = 0; n < 2; ++n)
#pragma unroll
                for (int j = 0; j < 4; ++j) red[(wave * 64 + 16 * m + 4 * fq + j) * 32 + 16 * n + fr] = acc[m][n][j];
        __syncthreads();
#pragma unroll
        for (int k = 0; k < 4; ++k) {
            const int e = tid + 512 * k;
            float s = 0.f;
#pragma unroll
            for (int w = 0; w < 8; ++w) s += red[w * 2048 + e];
            gz[(size_t)r0 * 32 + e] = s;
        }
    }
    __syncthreads();
}
struct EpiResid {
    static constexpr bool PERM = true, AFTER_DRAIN = false;
    const float* x; const float* mod; u16* x1;
    __device__ __forceinline__ void operator()(const pg8::f32x4 (&acc)[2][2][4][2], const pg8::Unit& u, int wr, int wc, int fr, int fq) const {
        const int row0 = u.pm * 256 + wr * 64 + fr, col0 = u.pn * 256 + wc * 32 + 8 * fq;
        const int b = (u.pm * 256) / S;
        pg8::f32x4 ga[2][2];
#pragma unroll
        for (int bj = 0; bj < 2; ++bj)
#pragma unroll
            for (int n = 0; n < 2; ++n) ga[bj][n] = *(const pg8::f32x4*)(mod + b * 12288 + 2 * 2048 + col0 + bj * 128 + 4 * n);
#pragma unroll
        for (int ai = 0; ai < 2; ++ai)
#pragma unroll
            for (int m = 0; m < 4; ++m) { const size_t off = (size_t)(row0 + ai * 128 + m * 16) * D + col0;
#pragma unroll
                for (int bj = 0; bj < 2; ++bj) {
                    const pg8::f32x4 x0 = *(const pg8::f32x4*)(x + off + bj * 128), x1v = *(const pg8::f32x4*)(x + off + bj * 128 + 4);
                    const pg8::f32x4 v0 = x0 + ga[bj][0] * acc[ai][bj][m][0], v1 = x1v + ga[bj][1] * acc[ai][bj][m][1];
                    pg8::u32x4 w; w.x = pg8::cvt_pk_bf16(v0[0], v0[1]); w.y = pg8::cvt_pk_bf16(v0[2], v0[3]); w.z = pg8::cvt_pk_bf16(v1[0], v1[1]); w.w = pg8::cvt_pk_bf16(v1[2], v1[3]);
                    *(pg8::u32x4*)(x1 + off + bj * 128) = w; } }
    }
};
struct EpiBf16 {
    static constexpr bool PERM = true, AFTER_DRAIN = false;
    u16* Q;
    __device__ __forceinline__ void operator()(const pg8::f32x4 (&acc)[2][2][4][2], const pg8::Unit& u, int wr, int wc, int fr, int fq) const {
        const int row0 = u.pm * 256 + wr * 64 + fr, col0 = u.pn * 256 + wc * 32 + 8 * fq;
#pragma unroll
        for (int ai = 0; ai < 2; ++ai)
#pragma unroll
            for (int m = 0; m < 4; ++m) { u16* rowp = Q + (size_t)(row0 + ai * 128 + m * 16) * D + col0;
#pragma unroll
                for (int bj = 0; bj < 2; ++bj) { const pg8::f32x4 v0 = acc[ai][bj][m][0], v1 = acc[ai][bj][m][1];
                    pg8::u32x4 w; w.x = pg8::cvt_pk_bf16(v0[0], v0[1]); w.y = pg8::cvt_pk_bf16(v0[2], v0[3]); w.z = pg8::cvt_pk_bf16(v1[0], v1[1]); w.w = pg8::cvt_pk_bf16(v1[2], v1[3]);
                    *(pg8::u32x4*)(rowp + bj * 128) = w; } }
    }
};
template <class Epi>
__device__ __forceinline__ void gemm8(unsigned char* lds, const u16* A, const u16* Bt, int M, int N, int K, const Epi& E) {
    pg8::Gemm g{A, Bt, M, N, K}; pg8::StaticOrder So; So.init(M, N, (int)gridDim.x, (int)blockIdx.x);
    pg8::gemm_phase<Epi, pg8::StaticOrder, false>((PG8_LAS unsigned char*)lds, g, So, E, nullptr);
    __syncthreads();
}

#define GLA_QD_BYTES 16384
#define GLA_AT_BYTES 8192
__device__ __forceinline__ float gla_logsigmoid(float z) { return fminf(z, 0.f) - __logf(1.f + __expf(-fabsf(z))); }

__device__ __forceinline__ void gla_prep_item(const u16* __restrict__ P, int ldp, int cq, int ck, const float* __restrict__ gz,
                                              const float* __restrict__ wg_f, const float* __restrict__ bg_f, const float* __restrict__ wg_b, const float* __restrict__ bg_b,
                                              int Sq, unsigned char* __restrict__ QDg, unsigned char* __restrict__ KEg, unsigned char* __restrict__ ATg, float* __restrict__ DECg,
                                              unsigned char* lds, int item) {
    const int nch = Sq / 64;
    const int c = item % nch, dir = (item / nch) & 1, hh = (item / (nch * 2)) & 3, b = item / (nch * 8);
    const int tid = TID, lane = tid & 63, wave = tid >> 6, li = lane & 15, fq = lane >> 4;
    float* gzs = (float*)lds;
    float* segs = gzs + 64 * 16;
    unsigned char* QDs = lds + 8192;
    unsigned char* KIs = QDs + 16384;
    unsigned char* KEs = KIs + 16384;
    float* bmat = (float*)(KEs + 16384);
    const size_t tok0 = (size_t)b * Sq;
    __syncthreads();
    uint4 rq0, rq1, rk0, rk1;
    {
        const int i0 = tid >> 4, i1 = (tid + 512) >> 4, cc = tid & 15;
        const int s0 = dir ? (Sq - 1 - (64 * c + i0)) : (64 * c + i0), s1 = dir ? (Sq - 1 - (64 * c + i1)) : (64 * c + i1);
        rq0 = *(const uint4*)(P + (tok0 + s0) * ldp + cq + hh * 128 + cc * 8); rk0 = *(const uint4*)(P + (tok0 + s0) * ldp + ck + hh * 128 + cc * 8);
        rq1 = *(const uint4*)(P + (tok0 + s1) * ldp + cq + hh * 128 + cc * 8); rk1 = *(const uint4*)(P + (tok0 + s1) * ldp + ck + hh * 128 + cc * 8);
    }
    for (int e = tid; e < 64 * 16; e += 512) {
        const int i = e >> 4, r = e & 15;
        const int s = dir ? (Sq - 1 - (64 * c + i)) : (64 * c + i);
        gzs[e] = gz[(tok0 + s) * 32 + dir * 16 + r];
    }
    const int d = tid & 127, seg = tid >> 7;
    const float* wg = dir ? wg_b : wg_f;
    float wcol[16];
#pragma unroll
    for (int r = 0; r < 16; ++r) wcol[r] = wg[r * 512 + hh * 128 + d];
    const float bias = (dir ? bg_b : bg_f)[hh * 128 + d];
    __syncthreads();
    float run = 0.f;
#pragma unroll
    for (int k = 0; k < 16; ++k) {
        const int i = 16 * seg + k;
        float z = bias;
#pragma unroll
        for (int r = 0; r < 16; ++r) z += gzs[i * 16 + r] * wcol[r];
        run += gla_logsigmoid(z) * (1.f / 16.f);
        bmat[i * 128 + d] = run;
    }
    segs[seg * 128 + d] = run;
    __syncthreads();
    if (seg == 0) {
        const float t0 = segs[d], t1 = segs[128 + d], t2 = segs[256 + d], t3 = segs[384 + d];
        segs[d] = 0.f; segs[128 + d] = t0; segs[256 + d] = t0 + t1; segs[384 + d] = t0 + t1 + t2; segs[512 + d] = t0 + t1 + t2 + t3;
        DECg[(size_t)item * 128 + d] = __expf(t0 + t1 + t2 + t3);
    }
    __syncthreads();
    const float qscale = 0.08838834764831845f;
#pragma unroll
    for (int k = 0; k < 2; ++k) {
        const int id = tid + 512 * k, i = id >> 4, cc = id & 15, d0 = cc * 8, sg = i >> 4;
        const uint4 qv = k ? rq1 : rq0, kv = k ? rk1 : rk0;
        const float qx[8] = {lo2f(qv.x), hi2f(qv.x), lo2f(qv.y), hi2f(qv.y), lo2f(qv.z), hi2f(qv.z), lo2f(qv.w), hi2f(qv.w)};
        const float kx[8] = {lo2f(kv.x), hi2f(kv.x), lo2f(kv.y), hi2f(kv.y), lo2f(kv.z), hi2f(kv.z), lo2f(kv.w), hi2f(kv.w)};
        float qd[8], ki[8], ke[8];
        const float4 bA = *(const float4*)(bmat + i * 128 + d0), bB = *(const float4*)(bmat + i * 128 + d0 + 4);
        const float4 oA = *(const float4*)(segs + sg * 128 + d0), oB = *(const float4*)(segs + sg * 128 + d0 + 4);
        const float4 tA = *(const float4*)(segs + 512 + d0), tB = *(const float4*)(segs + 512 + d0 + 4);
        const float bv[8] = {bA.x + oA.x, bA.y + oA.y, bA.z + oA.z, bA.w + oA.w, bB.x + oB.x, bB.y + oB.y, bB.z + oB.z, bB.w + oB.w};
        const float tv[8] = {tA.x, tA.y, tA.z, tA.w, tB.x, tB.y, tB.z, tB.w};
#pragma unroll
        for (int e = 0; e < 8; ++e) {
            const float bb = bv[e], tot = tv[e];
            qd[e] = qx[e] * qscale * __expf(bb); ki[e] = kx[e] * __expf(-bb); ke[e] = kx[e] * __expf(tot - bb);
        }
        const int o = i * 256 + ((cc ^ (i & 15)) << 4);
        *(uint4*)(QDs + o) = make_uint4(pack2(qd[0], qd[1]), pack2(qd[2], qd[3]), pack2(qd[4], qd[5]), pack2(qd[6], qd[7]));
        *(uint4*)(KIs + o) = make_uint4(pack2(ki[0], ki[1]), pack2(ki[2], ki[3]), pack2(ki[4], ki[5]), pack2(ki[6], ki[7]));
        *(uint4*)(KEs + o) = make_uint4(pack2(ke[0], ke[1]), pack2(ke[2], ke[3]), pack2(ke[4], ke[5]), pack2(ke[6], ke[7]));
    }
    __syncthreads();
    {
        uint4* qo = (uint4*)(QDg + (size_t)item * GLA_QD_BYTES); uint4* ko = (uint4*)(KEg + (size_t)item * GLA_QD_BYTES);
#pragma unroll
        for (int k = 0; k < 2; ++k) { const int e = tid + 512 * k; qo[e] = ((const uint4*)QDs)[e]; ko[e] = ((const uint4*)KEs)[e]; }
    }
#pragma unroll
    for (int tt = 0; tt < 2; ++tt) {
        const int tile = wave + 8 * tt, jt = tile >> 2, it = tile & 3;
        f32x4 acc = (f32x4){0.f, 0.f, 0.f, 0.f};
        if (jt <= it) {
            const int jr = 16 * jt + li, ir = 16 * it + li;
#pragma unroll
            for (int ks = 0; ks < 4; ++ks) {
                const bf16x8 kf = *(const bf16x8*)(KIs + jr * 256 + (((4 * ks + fq) ^ (jr & 15)) << 4));
                const bf16x8 qf = *(const bf16x8*)(QDs + ir * 256 + (((4 * ks + fq) ^ (ir & 15)) << 4));
                acc = __builtin_amdgcn_mfma_f32_16x16x32_bf16(kf, qf, acc, 0, 0, 0);
            }
        }
        const int i = 16 * it + li, j0 = 16 * jt + 4 * fq;
        float v[4];
#pragma unroll
        for (int jj = 0; jj < 4; ++jj) v[jj] = (j0 + jj <= i) ? acc[jj] : 0.f;
        const int chunk = 2 * jt + (fq >> 1), sub = (fq & 1) * 8;
        *(uint2*)(ATg + (size_t)item * GLA_AT_BYTES + i * 128 + ((chunk ^ (i & 7)) << 4) + sub) = make_uint2(pack2(v[0], v[1]), pack2(v[2], v[3]));
    }
}

__device__ __forceinline__ void gla_seq_item(const u16* __restrict__ P, int ldp, int cv, int Sq,
                                             const unsigned char* __restrict__ QDg, const unsigned char* __restrict__ KEg, const unsigned char* __restrict__ ATg, const float* __restrict__ DECg,
                                             u16* __restrict__ Oout  , int Ttot, unsigned char* lds, int item) {
    const int slice = item & 1, dir = (item >> 1) & 1, hh = (item >> 2) & 3, b = item >> 4;
    const int nch = Sq / 64;
    const int tid = TID, lane = tid & 63, wave = tid >> 6, li = lane & 15, fq = lane >> 4;
    const size_t tok0 = (size_t)b * Sq;
    const int pitem0 = ((b * 4 + hh) * 2 + dir) * nch;
    constexpr int BUF = 16384 * 3 + 8192 + 512;
    typedef unsigned gla_u32x4 __attribute__((ext_vector_type(4)));
    gla_u32x4 rq0, rq1, rk0, rk1, rv0, rv1, ra; float rd = 0.f;
#define GLA_VROW(c_, k_) ((tok0 + (size_t)(dir ? (Sq - 1 - (64 * (c_) + ((tid + 512 * (k_)) >> 4))) : (64 * (c_) + ((tid + 512 * (k_)) >> 4)))) * ldp + cv + hh * 256 + slice * 128 + ((tid + 512 * (k_)) & 15) * 8)
#define GLA_ISSUE(c_) do { \
        const gla_u32x4* qsrc_ = (const gla_u32x4*)(QDg + (size_t)(pitem0 + (c_)) * GLA_QD_BYTES); const gla_u32x4* ksrc_ = (const gla_u32x4*)(KEg + (size_t)(pitem0 + (c_)) * GLA_QD_BYTES); \
        rq0 = qsrc_[tid]; rq1 = qsrc_[tid + 512]; rk0 = ksrc_[tid]; rk1 = ksrc_[tid + 512]; \
        ra = ((const gla_u32x4*)(ATg + (size_t)(pitem0 + (c_)) * GLA_AT_BYTES))[tid]; \
        rv0 = *(const gla_u32x4*)(P + GLA_VROW(c_, 0)); rv1 = *(const gla_u32x4*)(P + GLA_VROW(c_, 1)); \
        if (tid < 128) rd = DECg[(size_t)(pitem0 + (c_)) * 128 + tid]; } while (0)
#define GLA_COMMIT(buf_) do { \
        unsigned char* base_ = lds + (buf_) * BUF; \
        ((gla_u32x4*)base_)[tid] = rq0; ((gla_u32x4*)base_)[tid + 512] = rq1; ((gla_u32x4*)(base_ + 16384))[tid] = rk0; ((gla_u32x4*)(base_ + 16384))[tid + 512] = rk1; \
        { const int row_ = tid >> 4, ch_ = tid & 15; *(gla_u32x4*)(base_ + 32768 + row_ * 256 + ((ch_ ^ (row_ & 15)) << 4)) = rv0; } \
        { const int row_ = (tid + 512) >> 4, ch_ = tid & 15; *(gla_u32x4*)(base_ + 32768 + row_ * 256 + ((ch_ ^ (row_ & 15)) << 4)) = rv1; } \
        ((gla_u32x4*)(base_ + 49152))[tid] = ra; \
        if (tid < 128) ((float*)(base_ + 57344))[tid] = rd; } while (0)
    f32x4 st[8];
#pragma unroll
    for (int dt = 0; dt < 8; ++dt) st[dt] = (f32x4){0.f, 0.f, 0.f, 0.f};
    __syncthreads();
    GLA_ISSUE(0); GLA_COMMIT(0);
    __syncthreads();
#pragma unroll 1
    for (int c = 0; c < nch; ++c) {
        const int buf = c & 1;
        if (c + 1 < nch) GLA_ISSUE(c + 1);
        const unsigned char* QDs = lds + buf * BUF; const unsigned char* KEs = QDs + 16384; const unsigned char* Vs = QDs + 32768;
        const unsigned char* ATs = QDs + 49152; const float* DECs = (const float*)(QDs + 57344);
        bf16x8 vf[2];
#pragma unroll
        for (int jp = 0; jp < 2; ++jp) {
            const int rowA = 32 * jp + 8 * fq + (li >> 2), rowB = rowA + 4;
            const int chunk = 2 * wave + ((li & 3) >> 1), sub = ((li & 3) & 1) * 8;
            const s16x4 va = __builtin_amdgcn_ds_read_tr16_b64_v4i16((LAS s16x4*)(Vs + rowA * 256 + ((chunk ^ (rowA & 15)) << 4) + sub));
            const s16x4 vb = __builtin_amdgcn_ds_read_tr16_b64_v4i16((LAS s16x4*)(Vs + rowB * 256 + ((chunk ^ (rowB & 15)) << 4) + sub));
            vf[jp] = __builtin_shufflevector(va, vb, 0, 1, 2, 3, 4, 5, 6, 7);
        }
        bf16x8 sf[4];
#pragma unroll
        for (int dp = 0; dp < 4; ++dp) {
            const gla_u32x4 t_ = {pack2(st[2 * dp][0], st[2 * dp][1]), pack2(st[2 * dp][2], st[2 * dp][3]), pack2(st[2 * dp + 1][0], st[2 * dp + 1][1]), pack2(st[2 * dp + 1][2], st[2 * dp + 1][3])};
            sf[dp] = __builtin_bit_cast(bf16x8, t_);
        }
        f32x4 ot[4];
#pragma unroll
        for (int it = 0; it < 4; ++it) {
            f32x4 acc = (f32x4){0.f, 0.f, 0.f, 0.f};
            const int ir = 16 * it + li;
#pragma unroll
            for (int dp = 0; dp < 4; ++dp) {
                const int c0 = 4 * dp + (fq >> 1), c1 = c0 + 2, sub = (fq & 1) * 8;
                const uint2 lo = *(const uint2*)(QDs + ir * 256 + ((c0 ^ (ir & 15)) << 4) + sub);
                const uint2 hi = *(const uint2*)(QDs + ir * 256 + ((c1 ^ (ir & 15)) << 4) + sub);
                const gla_u32x4 q_ = {lo.x, lo.y, hi.x, hi.y};
                const bf16x8 qf = __builtin_bit_cast(bf16x8, q_);
                acc = __builtin_amdgcn_mfma_f32_16x16x32_bf16(sf[dp], qf, acc, 0, 0, 0);
            }
#pragma unroll
            for (int jp = 0; jp < 2; ++jp) {
                if (32 * jp <= 16 * it + 15) {
                    const bf16x8 af = *(const bf16x8*)(ATs + ir * 128 + (((4 * jp + fq) ^ (ir & 7)) << 4));
                    acc = __builtin_amdgcn_mfma_f32_16x16x32_bf16(vf[jp], af, acc, 0, 0, 0);
                }
            }
            ot[it] = acc;
        }
#pragma unroll
        for (int dt = 0; dt < 8; ++dt) {
            const f32x4 dec = *(const f32x4*)(DECs + 16 * dt + 4 * fq);
            f32x4 acc = st[dt] * dec;
#pragma unroll
            for (int jp = 0; jp < 2; ++jp) {
                const int rowA = 32 * jp + 8 * fq + (li >> 2), rowB = rowA + 4;
                const int chunk = 2 * dt + ((li & 3) >> 1), sub = ((li & 3) & 1) * 8;
                const s16x4 ka = __builtin_amdgcn_ds_read_tr16_b64_v4i16((LAS s16x4*)(KEs + rowA * 256 + ((chunk ^ (rowA & 15)) << 4) + sub));
                const s16x4 kb = __builtin_amdgcn_ds_read_tr16_b64_v4i16((LAS s16x4*)(KEs + rowB * 256 + ((chunk ^ (rowB & 15)) << 4) + sub));
                const bf16x8 kf = __builtin_shufflevector(ka, kb, 0, 1, 2, 3, 4, 5, 6, 7);
                acc = __builtin_amdgcn_mfma_f32_16x16x32_bf16(kf, vf[jp], acc, 0, 0, 0);
            }
            st[dt] = acc;
        }
#pragma unroll
        for (int it = 0; it < 4; ++it) {
            const int i = 16 * it + li;
            const int s = dir ? (Sq - 1 - (64 * c + i)) : (64 * c + i);
            *(uint2*)(Oout + ((size_t)dir * Ttot + tok0 + s) * 1024 + hh * 256 + slice * 128 + 16 * wave + 4 * fq) =
                make_uint2(pack2(ot[it][0], ot[it][1]), pack2(ot[it][2], ot[it][3]));
        }
        if (c + 1 < nch) GLA_COMMIT(buf ^ 1);
        __syncthreads();
    }
}
__device__ __forceinline__ void phase_rope_prep(const Args& a, unsigned char* lds) {
    u16* P = (u16*)(a.ws + WS_P);
    const float2* cs = (const float2*)(a.ws + WS_CS);
    const int gt = blockIdx.x * NTHREADS + threadIdx.x, NT = gridDim.x * NTHREADS;
    for (int i = gt; i < T * 2 * 8 * 8; i += NT) {
        const int f0 = (i & 7) * 8, hh = (i >> 3) & 7, which = (i >> 6) & 1, t = i >> 7;
        u16* p = P + (size_t)t * NP + (which ? C_DK : C_DQ) + hh * 128 + f0;
        const uint4 a1 = *(const uint4*)p, a2 = *(const uint4*)(p + 64);
        const float4* cp = (const float4*)(cs + t * 64 + f0);
        const float4 c0 = cp[0], c1 = cp[1], c2 = cp[2], c3 = cp[3];
        const float x1[8] = {lo2f(a1.x), hi2f(a1.x), lo2f(a1.y), hi2f(a1.y), lo2f(a1.z), hi2f(a1.z), lo2f(a1.w), hi2f(a1.w)};
        const float x2[8] = {lo2f(a2.x), hi2f(a2.x), lo2f(a2.y), hi2f(a2.y), lo2f(a2.z), hi2f(a2.z), lo2f(a2.w), hi2f(a2.w)};
        const float cc[8] = {c0.x, c0.z, c1.x, c1.z, c2.x, c2.z, c3.x, c3.z}, sn[8] = {c0.y, c0.w, c1.y, c1.w, c2.y, c2.w, c3.y, c3.w};
        float y1[8], y2[8];
#pragma unroll
        for (int k = 0; k < 8; ++k) { y1[k] = x1[k] * cc[k] - x2[k] * sn[k]; y2[k] = x1[k] * sn[k] + x2[k] * cc[k]; }
        *(uint4*)p = make_uint4(pack2(y1[0], y1[1]), pack2(y1[2], y1[3]), pack2(y1[4], y1[5]), pack2(y1[6], y1[7]));
        *(uint4*)(p + 64) = make_uint4(pack2(y2[0], y2[1]), pack2(y2[2], y2[3]), pack2(y2[4], y2[5]), pack2(y2[6], y2[7]));
    }
    for (int item = blockIdx.x; item < GLA_NPREP; item += gridDim.x)
        gla_prep_item(P, NP, C_GQ, C_GK, (const float*)(a.ws + WS_GZ), a.wgf, a.bgf, a.wgb, a.bgb, S,
                      a.ws + WS_QD, a.ws + WS_KE, a.ws + WS_AT, (float*)(a.ws + WS_DEC), lds, item);
}

#define ATTN_DECODE(item_) \
    const int nb_per = Sq / 128; \
    const int within = (item_) % nb_per, hh = ((item_) / nb_per) & 7, b = ((item_) / (nb_per * 8)) & 3, pat = (item_) / (nb_per * 32); \
    const int dil = pat == 0 ? 1 : (pat == 1 ? 4 : 16); \
    const int M = Sq / dil; \
    const int r = within % dil, blk = within / dil; \
    const int p0 = blk * 128, kbase = p0 - 64; \
    const size_t tok0 = (size_t)b * Sq;
typedef unsigned attn_u32x4 __attribute__((ext_vector_type(4)));
__device__ __forceinline__ void attn_phase(const u16* __restrict__ P, int ldp, int cq, int ck, int cv, int Sq,
                                           u16* __restrict__ part_o, float* __restrict__ part_lse, int Ttot,
                                           unsigned char* lds, int first, int stride, int nitems) {
    const int tid = TID, lane = tid & 63, wave = tid >> 6, li = lane & 15, fq = lane >> 4;
    unsigned char* Ks = lds;
    unsigned char* Vs = lds + 65536;
    attn_u32x4 kr0, kr1, kr2, kr3, kr4, kr5, kr6, kr7, vr0, vr1, vr2, vr3, vr4, vr5, vr6, vr7;
#define ATTN_LD1(i_, kreg_, vreg_) { const int id_ = tid + 512 * (i_), row_ = id_ >> 4, c_ = id_ & 15; \
        int kp_ = kbase + row_; kp_ = kp_ < 0 ? 0 : (kp_ > M - 1 ? M - 1 : kp_); \
        const size_t t_ = tok0 + r + (size_t)dil * kp_; \
        kreg_ = *(const attn_u32x4*)(P + t_ * ldp + ck + hh * 128 + c_ * 8); vreg_ = *(const attn_u32x4*)(P + t_ * ldp + cv + hh * 128 + c_ * 8); }
#define ATTN_LOAD(item_) do { ATTN_DECODE(item_) \
        ATTN_LD1(0, kr0, vr0) ATTN_LD1(1, kr1, vr1) ATTN_LD1(2, kr2, vr2) ATTN_LD1(3, kr3, vr3) ATTN_LD1(4, kr4, vr4) ATTN_LD1(5, kr5, vr5) ATTN_LD1(6, kr6, vr6) ATTN_LD1(7, kr7, vr7) } while (0)
#define ATTN_ST1(i_, kreg_, vreg_) { const int id_ = tid + 512 * (i_), row_ = id_ >> 4, c_ = id_ & 15; const int off_ = row_ * 256 + ((c_ ^ (row_ & 15)) << 4); \
        *(attn_u32x4*)(Ks + off_) = kreg_; *(attn_u32x4*)(Vs + off_) = vreg_; }
#define ATTN_COMMIT() do { ATTN_ST1(0, kr0, vr0) ATTN_ST1(1, kr1, vr1) ATTN_ST1(2, kr2, vr2) ATTN_ST1(3, kr3, vr3) ATTN_ST1(4, kr4, vr4) ATTN_ST1(5, kr5, vr5) ATTN_ST1(6, kr6, vr6) ATTN_ST1(7, kr7, vr7) } while (0)
    int item = first;
    if (item < nitems) ATTN_LOAD(item);
    for (; item < nitems; item += stride) {
        ATTN_DECODE(item)
        __syncthreads();
        ATTN_COMMIT();
        const int qp = p0 + 16 * wave + li;
        const size_t tq = tok0 + r + (size_t)dil * qp;
        bf16x8 qf[4];
#pragma unroll
        for (int ks = 0; ks < 4; ++ks) qf[ks] = *(const bf16x8*)(P + tq * ldp + cq + hh * 128 + 32 * ks + 8 * fq);
        __syncthreads();
        if (item + stride < nitems) ATTN_LOAD(item + stride);
        const float scale = 0.08838834764831845f;
        float m = -1e30f, l = 0.f;
        f32x4 o[8];
#pragma unroll
        for (int dt = 0; dt < 8; ++dt) o[dt] = (f32x4){0.f, 0.f, 0.f, 0.f};
#pragma unroll 1
        for (int tp = 0; tp < 5; ++tp) {
            float s[8]; bool ok[8];
#pragma unroll
            for (int h2 = 0; h2 < 2; ++h2) {
                const int kk0 = 16 * wave + 16 * (2 * tp + h2);
                int krow = kk0 + li; krow = krow > 255 ? 255 : krow;
                f32x4 acc = (f32x4){0.f, 0.f, 0.f, 0.f};
#pragma unroll
                for (int ks = 0; ks < 4; ++ks) {
                    const bf16x8 kf = *(const bf16x8*)(Ks + krow * 256 + (((4 * ks + fq) ^ (krow & 15)) << 4));
                    acc = __builtin_amdgcn_mfma_f32_16x16x32_bf16(kf, qf[ks], acc, 0, 0, 0);
                }
#pragma unroll
                for (int j = 0; j < 4; ++j) {
                    const int kp = kbase + kk0 + 4 * fq + j;
                    const int rel = kp - qp;
                    ok[4 * h2 + j] = (kp >= 0) && (kp < M) && (rel <= 64) && (rel >= -64);
                    s[4 * h2 + j] = acc[j] * scale;
                }
            }
            float mx = -1e30f;
#pragma unroll
            for (int j = 0; j < 8; ++j) mx = ok[j] ? fmaxf(mx, s[j]) : mx;
            mx = fmaxf(mx, __shfl_xor(mx, 16));
            mx = fmaxf(mx, __shfl_xor(mx, 32));
            const float mn = fmaxf(m, mx);
            const float al = __expf(m - mn);
            float ps = 0.f; float p[8];
#pragma unroll
            for (int j = 0; j < 8; ++j) { p[j] = ok[j] ? __expf(s[j] - mn) : 0.f; ps += p[j]; }
            l = l * al + ps; m = mn;
            const attn_u32x4 p_ = {pack2(p[0], p[1]), pack2(p[2], p[3]), pack2(p[4], p[5]), pack2(p[6], p[7])};
            const bf16x8 pf = __builtin_bit_cast(bf16x8, p_);
#pragma unroll
            for (int dt = 0; dt < 8; ++dt) o[dt] *= al;
            int rowA = 16 * wave + 32 * tp + 4 * fq + (li >> 2); rowA = rowA > 255 ? 255 : rowA;
            int rowB = 16 * wave + 32 * tp + 16 + 4 * fq + (li >> 2); rowB = rowB > 255 ? 255 : rowB;
#pragma unroll
            for (int dt = 0; dt < 8; ++dt) {
                const int chunk = 2 * dt + ((li & 3) >> 1), sub = ((li & 3) & 1) * 8;
                const s16x4 va = __builtin_amdgcn_ds_read_tr16_b64_v4i16((LAS s16x4*)(Vs + rowA * 256 + ((chunk ^ (rowA & 15)) << 4) + sub));
                const s16x4 vb = __builtin_amdgcn_ds_read_tr16_b64_v4i16((LAS s16x4*)(Vs + rowB * 256 + ((chunk ^ (rowB & 15)) << 4) + sub));
                const bf16x8 vf = __builtin_shufflevector(va, vb, 0, 1, 2, 3, 4, 5, 6, 7);
                o[dt] = __builtin_amdgcn_mfma_f32_16x16x32_bf16(vf, pf, o[dt], 0, 0, 0);
            }
        }
        l += __shfl_xor(l, 16);
        l += __shfl_xor(l, 32);
        const float inv = 1.f / l;
        u16* orow = part_o + ((size_t)pat * Ttot + tq) * 1024 + hh * 128 + 4 * fq;
#pragma unroll
        for (int dt = 0; dt < 8; ++dt)
            *(uint2*)(orow + 16 * dt) = make_uint2(pack2(o[dt][0] * inv, o[dt][1] * inv), pack2(o[dt][2] * inv, o[dt][3] * inv));
        if (fq == 0) part_lse[((size_t)pat * Ttot + tq) * 8 + hh] = m + logf(l);
    }
#undef ATTN_LD1
#undef ATTN_LOAD
#undef ATTN_ST1
#undef ATTN_COMMIT
}

__device__ __forceinline__ void attn_merge_token(const u16* __restrict__ part_o, const float* __restrict__ part_lse, int Ttot, size_t t,
                                                 u16* __restrict__ dst  , int lane) {
    const int hh = lane >> 3;
    const float l0 = part_lse[((size_t)0 * Ttot + t) * 8 + hh], l1 = part_lse[((size_t)1 * Ttot + t) * 8 + hh], l2 = part_lse[((size_t)2 * Ttot + t) * 8 + hh];
    const float mx = fmaxf(l0, fmaxf(l1, l2));
    const float e0 = __expf(l0 - mx), e1 = __expf(l1 - mx), e2 = __expf(l2 - mx);
    const float inv = 1.f / (e0 + e1 + e2);
    const float w[3] = {e0 * inv, e1 * inv, e2 * inv};
    float acc[16];
#pragma unroll
    for (int i = 0; i < 16; ++i) acc[i] = 0.f;
#pragma unroll
    for (int p = 0; p < 3; ++p) {
        const uint4* src = (const uint4*)(part_o + ((size_t)p * Ttot + t) * 1024 + lane * 16);
        const uint4 a = src[0], bb = src[1];
        acc[0] += w[p] * lo2f(a.x); acc[1] += w[p] * hi2f(a.x); acc[2] += w[p] * lo2f(a.y); acc[3] += w[p] * hi2f(a.y);
        acc[4] += w[p] * lo2f(a.z); acc[5] += w[p] * hi2f(a.z); acc[6] += w[p] * lo2f(a.w); acc[7] += w[p] * hi2f(a.w);
        acc[8] += w[p] * lo2f(bb.x); acc[9] += w[p] * hi2f(bb.x); acc[10] += w[p] * lo2f(bb.y); acc[11] += w[p] * hi2f(bb.y);
        acc[12] += w[p] * lo2f(bb.z); acc[13] += w[p] * hi2f(bb.z); acc[14] += w[p] * lo2f(bb.w); acc[15] += w[p] * hi2f(bb.w);
    }
    uint4* d = (uint4*)(dst + lane * 16);
    d[0] = make_uint4(pack2(acc[0], acc[1]), pack2(acc[2], acc[3]), pack2(acc[4], acc[5]), pack2(acc[6], acc[7]));
    d[1] = make_uint4(pack2(acc[8], acc[9]), pack2(acc[10], acc[11]), pack2(acc[12], acc[13]), pack2(acc[14], acc[15]));
}

__device__ __forceinline__ void phase_mixers(const Args& a, unsigned char* lds) {
    const int bi = blockIdx.x, G = gridDim.x;
    if (bi < 64) {
        gla_seq_item((const u16*)(a.ws + WS_P), NP, C_GV, S, a.ws + WS_QD, a.ws + WS_KE, a.ws + WS_AT, (const float*)(a.ws + WS_DEC),
                     (u16*)(a.ws + WS_OFB), T, lds, bi);
    } else {
        u16* part_o = (u16*)a.out; float* part_lse = (float*)((unsigned char*)a.out + (size_t)3 * T * 1024 * 2);
        attn_phase((const u16*)(a.ws + WS_P), NP, C_DQ, C_DK, C_DV, S, part_o, part_lse, T, lds, bi - 64, G - 64, 3 * 4 * 8 * (S / 128));
    }
}

__device__ __forceinline__ void phase_gla_fin(const Args& a) {
    const u16* Of = (const u16*)(a.ws + WS_OFB);
    const u16* Ob = Of + (size_t)T * 1024;
    const u16* P = (const u16*)(a.ws + WS_P);
    u16* A2 = (u16*)(a.ws + WS_ACT);
    const int lane = threadIdx.x & 63, wave = threadIdx.x >> 6;
    const int gw = blockIdx.x * NWAVES + wave, NGW = gridDim.x * NWAVES;
    for (int item = gw; item < T * 4; item += NGW) {
        const int hh = item & 3, t = item >> 2;
        const size_t base = (size_t)t * 1024 + hh * 256 + lane * 4;
        const uint2 f = *(const uint2*)(Of + base), bb = *(const uint2*)(Ob + base);
        const float o0 = lo2f(f.x) + lo2f(bb.x), o1 = hi2f(f.x) + hi2f(bb.x), o2 = lo2f(f.y) + lo2f(bb.y), o3 = hi2f(f.y) + hi2f(bb.y);
        const float ss = wave_sum(o0 * o0 + o1 * o1 + o2 * o2 + o3 * o3);
        const float rstd = rsqrtf(ss * (1.f / 256.f) + NORM_EPS);
        const float4 gg = *(const float4*)(a.g_gla + hh * 256 + lane * 4);
        const uint2 rp = *(const uint2*)(P + (size_t)t * NP + C_GR + hh * 256 + lane * 4);
        const float r0 = lo2f(rp.x), r1 = hi2f(rp.x), r2 = lo2f(rp.y), r3 = hi2f(rp.y);
        const float y0 = o0 * rstd * gg.x * silu_f(r0), y1 = o1 * rstd * gg.y * silu_f(r1);
        const float y2 = o2 * rstd * gg.z * silu_f(r2), y3 = o3 * rstd * gg.w * silu_f(r3);
        *(uint2*)(A2 + (size_t)t * D + hh * 256 + lane * 4) = make_uint2(pack2(y0, y1), pack2(y2, y3));
    }
    const u16* part_o = (const u16*)a.out; const float* part_lse = (const float*)((const unsigned char*)a.out + (size_t)3 * T * 1024 * 2);
    for (int t = gw; t < T; t += NGW) attn_merge_token(part_o, part_lse, T, (size_t)t, A2 + (size_t)t * D + 1024, lane);
}

typedef float f32x16 __attribute__((ext_vector_type(16)));
#define RT_CE(a_, b_) do { const float hi_ = fmaxf(a_, b_), lo_ = fminf(a_, b_); a_ = hi_; b_ = lo_; } while (0)
template <int N> __device__ __forceinline__ void rt_sort_desc(float (&v)[N], int base) {
#pragma unroll
    for (int k = 2; k <= 16; k <<= 1)
#pragma unroll
        for (int j = k >> 1; j > 0; j >>= 1)
#pragma unroll
            for (int i = 0; i < 16; ++i) {
                const int l = i ^ j;
                if (l > i) { if ((i & k) == 0) RT_CE(v[base + i], v[base + l]); else RT_CE(v[base + l], v[base + i]); }
            }
}
template <int N> __device__ __forceinline__ void rt_merge_desc(float (&v)[N], int a, int b) {
#pragma unroll
    for (int i = 0; i < 16; ++i) v[a + i] = fmaxf(v[a + i], v[b + 15 - i]);
#pragma unroll
    for (int j = 8; j > 0; j >>= 1)
#pragma unroll
        for (int i = 0; i < 16; ++i) { const int l = i ^ j; if (l > i) RT_CE(v[a + i], v[a + l]); }
}

__device__ __forceinline__ void route_stage_keys(const float* __restrict__ subk, int hh, unsigned char* lds) {
    const int tid = TID;
    __syncthreads();
    for (int e = tid; e < 2 * 128 * 16; e += 512) {
        const int c = e & 15, row = e >> 4;
        const float* src = subk + ((size_t)(hh * 2) * 128 + row) * 128 + c * 8;
        const float4 v0 = *(const float4*)src, v1 = *(const float4*)(src + 4);
        *(uint4*)(lds + row * 256 + ((c ^ (row & 15)) << 4)) = make_uint4(pack2(v0.x, v0.y), pack2(v0.z, v0.w), pack2(v1.x, v1.y), pack2(v1.z, v1.w));
    }
    __syncthreads();
}

__device__ __forceinline__ void route_tile(const u16* __restrict__ Q, int ldq, int hh, int tok_base, const unsigned char* lds,
                                           int* __restrict__ IDX, float* __restrict__ GATE) {
    const int lane = TID & 63, r = lane & 31, h = lane >> 5;
    float sc[128];
    {
        f32x16 X[4], Y[4];
#pragma unroll
        for (int kt = 0; kt < 4; ++kt) {
#pragma unroll
            for (int i = 0; i < 16; ++i) { X[kt][i] = 0.f; Y[kt][i] = 0.f; }
        }
        const u16* qrow = Q + (size_t)(tok_base + r) * ldq + hh * 256;
#pragma unroll
        for (int half = 0; half < 2; ++half) {
            bf16x8 qf[8];
#pragma unroll
            for (int ks = 0; ks < 8; ++ks) qf[ks] = *(const bf16x8*)(qrow + half * 128 + 16 * ks + 8 * h);
#pragma unroll
            for (int kt = 0; kt < 4; ++kt) {
                const int krow = half * 128 + 32 * kt + r;
#pragma unroll
                for (int ks = 0; ks < 8; ++ks) {
                    const bf16x8 kf = *(const bf16x8*)(lds + krow * 256 + (((2 * ks + h) ^ (krow & 15)) << 4));
                    if (half == 0) X[kt] = __builtin_amdgcn_mfma_f32_32x32x16_bf16(kf, qf[ks], X[kt], 0, 0, 0);
                    else Y[kt] = __builtin_amdgcn_mfma_f32_32x32x16_bf16(kf, qf[ks], Y[kt], 0, 0, 0);
                }
            }
        }
#pragma unroll
        for (int kt = 0; kt < 4; ++kt)
#pragma unroll
            for (int i = 0; i < 16; ++i) {
                const auto sw = __builtin_amdgcn_permlane32_swap(__float_as_uint(X[kt][i]), __float_as_uint(Y[kt][i]), false, false);
                const int key0 = 32 * kt + (i & 3) + 8 * (i >> 2);
                sc[kt * 32 + i] = __uint_as_float((sw[0] & 0xffffff80u) | (unsigned)key0);
                sc[kt * 32 + 16 + i] = __uint_as_float((sw[1] & 0xffffff80u) | (unsigned)(key0 + 4));
            }
    }
#pragma unroll
    for (int g = 0; g < 8; ++g) rt_sort_desc(sc, 16 * g);
    rt_merge_desc(sc, 0, 16); rt_merge_desc(sc, 32, 48); rt_merge_desc(sc, 64, 80); rt_merge_desc(sc, 96, 112);
    rt_merge_desc(sc, 0, 32); rt_merge_desc(sc, 64, 96);
    rt_merge_desc(sc, 0, 64);
    float l0[16], l1[16];
#pragma unroll
    for (int i = 0; i < 16; ++i) {
        const auto sw = __builtin_amdgcn_permlane32_swap(__float_as_uint(sc[i]), __float_as_uint(sc[i]), false, false);
        l0[i] = __uint_as_float(sw[0]); l1[i] = __uint_as_float(sw[1]);
    }
    float s0[16], s1[16]; int k0[16], k1[16];
#pragma unroll
    for (int i = 0; i < 16; ++i) {
        const unsigned a = __float_as_uint(l0[i]), b = __float_as_uint(l1[i]);
        s0[i] = __uint_as_float(a & 0xffffff80u); k0[i] = (int)(a & 0x7fu);
        s1[i] = __uint_as_float(b & 0xffffff80u); k1[i] = (int)(b & 0x7fu);
    }
    float cs[64];
    {
        int n = 0;
#pragma unroll
        for (int i = 0; i < 16; ++i)
#pragma unroll
            for (int j = 0; j < 16; ++j)
                if ((i + 1) * (j + 1) <= 16) { cs[n] = s0[i] + s1[j]; ++n; }
#pragma unroll
        for (int q = 50; q < 64; ++q) cs[q] = -3.0e38f;
    }
    float ct[64];
#pragma unroll
    for (int q = 0; q < 64; ++q) ct[q] = cs[q];
#pragma unroll
    for (int g = 0; g < 4; ++g) rt_sort_desc(ct, 16 * g);
    rt_merge_desc(ct, 0, 16); rt_merge_desc(ct, 32, 48); rt_merge_desc(ct, 0, 32);
    const float theta = ct[15], smax = ct[0];
    float den = 0.f;
    {
        int cnt = 0;
#pragma unroll
        for (int q = 0; q < 50; ++q) { const bool sel = (cs[q] >= theta) && (cnt < 16); den += sel ? __expf(cs[q] - smax) : 0.f; cnt += sel ? 1 : 0; }
    }
    const float inv = 1.f / den;
    const size_t obase = (size_t)(tok_base + r) * 128 + hh * 16;
    int pos = 0;
    {
        int n = 0;
#pragma unroll
        for (int i = 0; i < 16; ++i)
#pragma unroll
            for (int j = 0; j < 16; ++j)
                if ((i + 1) * (j + 1) <= 16) {
                    const bool sel = (cs[n] >= theta) && (pos < 16);
                    if (sel) {
                        if (h == 0) IDX[obase + pos] = k0[i] * 128 + k1[j];
                        else GATE[obase + pos] = __expf(cs[n] - smax) * inv;
                        ++pos;
                    }
                    ++n;
                }
    }
}
__device__ __forceinline__ void phase_route(const Args& a, unsigned char* lds) {
    const int hh = BID & 7, grp = BID >> 3, ngrp = GDIM >> 3, wave = TID >> 6;
    route_stage_keys(a.subk, hh, lds);
    int j = 0;
    for (int tile = grp; tile < T / 32; tile += ngrp, ++j)
        if ((j & 7) == wave) route_tile((const u16*)(a.ws + WS_Q), D, hh, tile * 32, lds, (int*)(a.ws + WS_IDX), (float*)(a.ws + WS_GATE));
    __syncthreads();
}

typedef __bf16 bf16x2_t __attribute__((ext_vector_type(2)));
__device__ __forceinline__ float dot2bf(unsigned w, unsigned x, float acc) {
    return __builtin_amdgcn_fdot2_f32_bf16(__builtin_bit_cast(bf16x2_t, w), __builtin_bit_cast(bf16x2_t, x), acc, false);
}
constexpr int TROW = 1152;
typedef float f32x2_t __attribute__((ext_vector_type(2)));
__device__ __forceinline__ void convert_tables(const Args& a) {
    const int lane = threadIdx.x & 63, wave = threadIdx.x >> 6;
    const int gw = blockIdx.x * NWAVES + wave, NGW = gridDim.x * NWAVES;
    for (int row = gw; row < 2 * 16384; row += NGW) {
        const bool isv = row >= 16384; const int e = isv ? row - 16384 : row;
        const f32x4* sp = (const f32x4*)((isv ? a.pv : a.pu) + (size_t)e * D);
        unsigned char* dst = a.ws + (isv ? WS_TV : WS_TU) + (size_t)e * TROW;
        f32x4 v[8];
#pragma unroll
        for (int k = 0; k < 8; ++k) v[k] = __builtin_nontemporal_load(sp + lane + 64 * k);
#pragma unroll
        for (int k = 0; k < 8; ++k) {
            float mx = fmaxf(fmaxf(fabsf(v[k][0]), fabsf(v[k][1])), fmaxf(fabsf(v[k][2]), fabsf(v[k][3])));
            mx = fmaxf(mx, __shfl_xor(mx, 1)); mx = fmaxf(mx, __shfl_xor(mx, 2)); mx = fmaxf(mx, __shfl_xor(mx, 4));
            float s = mx * (isv ? (1.f / 6.f) : (1.f / 7.f)); s = (s > 0.f) ? s : 1.f;
            u16 sb = f2bf(s); if (bf2f(sb) < s) sb += 1;
            const float inv = 1.f / bf2f(sb);
            unsigned p = 0u;
            if (isv) {
                p = __builtin_amdgcn_cvt_scalef32_pk_fp4_f32(p, v[k][0] * inv, v[k][1] * inv, 1.0f, 0);
                p = __builtin_amdgcn_cvt_scalef32_pk_fp4_f32(p, v[k][2] * inv, v[k][3] * inv, 1.0f, 1);
            } else {
#pragma unroll
                for (int j = 0; j < 4; ++j) { int q = (int)rintf(v[k][j] * inv) + 8; q = q < 1 ? 1 : (q > 15 ? 15 : q); p |= (unsigned)q << (4 * j); }
            }
            const int i = lane + 64 * k;
            *(u16*)(dst + 2 * i) = (u16)p;
            if ((lane & 7) == 0) *(u16*)(dst + 1024 + 2 * (i >> 3)) = sb;
        }
    }
}

__device__ __forceinline__ int idot32_i4(const uint4 w, const int (&hq)[8]) {
    const unsigned ww[4] = {w.x, w.y, w.z, w.w};
    int acc = 0;
#pragma unroll
    for (int k = 0; k < 4; ++k) {
        acc = __builtin_amdgcn_sdot4((int)(ww[k] & 0x0f0f0f0fu), hq[2 * k], acc, false);
        acc = __builtin_amdgcn_sdot4((int)((ww[k] >> 4) & 0x0f0f0f0fu), hq[2 * k + 1], acc, false);
    }
    return acc;
}
__device__ __forceinline__ void axpy32_fp4(const uint4 w, const float s, float (&acc)[32]) {
    const unsigned ww[4] = {w.x, w.y, w.z, w.w};
#pragma unroll
    for (int k = 0; k < 4; ++k) {
        const f32x2_t a0 = __builtin_amdgcn_cvt_scalef32_pk_f32_fp4(ww[k], 1.0f, 0), a1 = __builtin_amdgcn_cvt_scalef32_pk_f32_fp4(ww[k], 1.0f, 1);
        const f32x2_t a2 = __builtin_amdgcn_cvt_scalef32_pk_f32_fp4(ww[k], 1.0f, 2), a3 = __builtin_amdgcn_cvt_scalef32_pk_f32_fp4(ww[k], 1.0f, 3);
        acc[8 * k + 0] += s * a0.x; acc[8 * k + 1] += s * a0.y; acc[8 * k + 2] += s * a1.x; acc[8 * k + 3] += s * a1.y;
        acc[8 * k + 4] += s * a2.x; acc[8 * k + 5] += s * a2.y; acc[8 * k + 6] += s * a3.x; acc[8 * k + 7] += s * a3.y;
    }
}
__device__ __forceinline__ void phase_experts(const Args& a) {
    const u16* H2 = (const u16*)(a.ws + WS_ACT);
    const u16* X1 = (const u16*)(a.ws + WS_X1);
    const int* IDX = (const int*)(a.ws + WS_IDX);
    const float* GATE = (const float*)(a.ws + WS_GATE);
    const float* mod = (const float*)(a.ws + WS_MOD);
    const unsigned char* U = a.ws + WS_TU; const unsigned char* V = a.ws + WS_TV;
    const int lane = threadIdx.x & 63, wave = threadIdx.x >> 6;
    const int gw = blockIdx.x * NWAVES + wave, NGW = gridDim.x * NWAVES;
    int iv0 = 0, iv1 = 0; float gv0 = 0.f, gv1 = 0.f;
    int niv0 = 0, niv1 = 0; float ngv0 = 0.f, ngv1 = 0.f;
    uint4 rA[4], rB[4]; u16 sA[4], sB[4];
#define ROW_LOAD(TB_, r_, s_, r0_) do { _Pragma("unroll") for (int q = 0; q < 4; ++q) { \
            const int rr_ = (r0_) + q; const int e_ = __builtin_amdgcn_readlane(rr_ < 64 ? iv0 : iv1, rr_ & 63); \
            const unsigned char* rp_ = TB_ + (size_t)e_ * TROW; \
            r_[q] = *(const uint4*)(rp_ + lane * 16); s_[q] = *(const u16*)(rp_ + 1024 + lane * 2); } } while (0)
#define TOK_FETCH(t_, i0_, i1_, g0_, g1_) do { \
            i0_ = IDX[(size_t)(t_) * 128 + lane]; i1_ = IDX[(size_t)(t_) * 128 + 64 + lane]; \
            g0_ = GATE[(size_t)(t_) * 128 + lane]; g1_ = GATE[(size_t)(t_) * 128 + 64 + lane]; } while (0)
    if (gw < T) { TOK_FETCH(gw, iv0, iv1, gv0, gv1); ROW_LOAD(U, rA, sA, 0); }
    for (int t = gw; t < T; t += NGW) {
        const int b = t / S;
        const bool has_next = (t + NGW) < T;
        int hq[8]; int hsum8; float sh;
        {
            float h[32];
            const uint4* hp = (const uint4*)(H2 + (size_t)t * D + lane * 32);
#pragma unroll
            for (int k = 0; k < 4; ++k) { const uint4 p = hp[k];
                h[8 * k + 0] = lo2f(p.x); h[8 * k + 1] = hi2f(p.x); h[8 * k + 2] = lo2f(p.y); h[8 * k + 3] = hi2f(p.y);
                h[8 * k + 4] = lo2f(p.z); h[8 * k + 5] = hi2f(p.z); h[8 * k + 6] = lo2f(p.w); h[8 * k + 7] = hi2f(p.w); }
            float mx = 0.f;
#pragma unroll
            for (int i = 0; i < 32; ++i) mx = fmaxf(mx, fabsf(h[i]));
            sh = (mx > 0.f) ? mx * (1.f / 127.f) : 1.f;
            const float inv = 1.f / sh;
            int hs = 0;
#pragma unroll
            for (int k = 0; k < 4; ++k)
#pragma unroll
                for (int par = 0; par < 2; ++par) {
                    const int q0 = (int)rintf(h[8 * k + par] * inv), q1 = (int)rintf(h[8 * k + 2 + par] * inv), q2 = (int)rintf(h[8 * k + 4 + par] * inv), q3 = (int)rintf(h[8 * k + 6 + par] * inv);
                    hs += q0 + q1 + q2 + q3;
                    hq[2 * k + par] = (q0 & 0xff) | ((q1 & 0xff) << 8) | ((q2 & 0xff) << 16) | ((int)((unsigned)(q3 & 0xff) << 24));
                }
            hsum8 = 8 * hs;
        }
        float a0 = 0.f, a1 = 0.f;
#define U_COMPUTE(r_, s_, r0_) do { float d_[4]; \
            _Pragma("unroll") for (int q = 0; q < 4; ++q) d_[q] = (float)(idot32_i4(r_[q], hq) - hsum8) * (bf2f(s_[q]) * sh); \
            _Pragma("unroll") for (int o = 32; o > 0; o >>= 1) { _Pragma("unroll") for (int q = 0; q < 4; ++q) d_[q] += __shfl_xor(d_[q], o); } \
            _Pragma("unroll") for (int q = 0; q < 4; ++q) { const int rr_ = (r0_) + q; \
                if (rr_ < 64) a0 = (lane == rr_) ? d_[q] : a0; else a1 = (lane == rr_ - 64) ? d_[q] : a1; } } while (0)
#pragma unroll 1
        for (int r0 = 0; r0 < 128; r0 += 8) {
            ROW_LOAD(U, rB, sB, r0 + 4);
            U_COMPUTE(rA, sA, r0);
            if (r0 + 8 < 128) ROW_LOAD(U, rA, sA, r0 + 8); else ROW_LOAD(V, rA, sA, 0);
            U_COMPUTE(rB, sB, r0 + 4);
        }
        const float w0 = gv0 * gelu_f(a0), w1 = gv1 * gelu_f(a1);
        float acc[32];
#pragma unroll
        for (int i = 0; i < 32; ++i) acc[i] = 0.f;
#define V_COMPUTE(r_, s_, r0_) do { _Pragma("unroll") for (int q = 0; q < 4; ++q) { const int rr_ = (r0_) + q; \
                const float g_ = __builtin_bit_cast(float, __builtin_amdgcn_readlane(__builtin_bit_cast(int, rr_ < 64 ? w0 : w1), rr_ & 63)); \
                axpy32_fp4(r_[q], g_ * bf2f(s_[q]), acc); } } while (0)
        if (has_next) TOK_FETCH(t + NGW, niv0, niv1, ngv0, ngv1);
#pragma unroll 1
        for (int r0 = 0; r0 < 128; r0 += 8) {
            ROW_LOAD(V, rB, sB, r0 + 4);
            V_COMPUTE(rA, sA, r0);
            if (r0 + 8 < 128) ROW_LOAD(V, rA, sA, r0 + 8);
            else if (has_next) { iv0 = niv0; iv1 = niv1; gv0 = ngv0; gv1 = ngv1; ROW_LOAD(U, rA, sA, 0); }
            V_COMPUTE(rB, sB, r0 + 4);
        }
#undef U_COMPUTE
#undef V_COMPUTE
        float ss = 0.f;
#pragma unroll
        for (int k = 0; k < 8; ++k) {
            const int c0 = lane * 32 + 4 * k;
            const uint2 xp = *(const uint2*)(X1 + (size_t)t * D + c0);
            const float4 xa = make_float4(lo2f(xp.x), hi2f(xp.x), lo2f(xp.y), hi2f(xp.y));
            const float4 ga = *(const float4*)(mod + b * 12288 + 5 * 2048 + c0);
            acc[4 * k + 0] = xa.x + ga.x * acc[4 * k + 0]; acc[4 * k + 1] = xa.y + ga.y * acc[4 * k + 1];
            acc[4 * k + 2] = xa.z + ga.z * acc[4 * k + 2]; acc[4 * k + 3] = xa.w + ga.w * acc[4 * k + 3];
#pragma unroll
            for (int i = 0; i < 4; ++i) ss += acc[4 * k + i] * acc[4 * k + i];
        }
        ss = wave_sum(ss);
        const float rstd = rsqrtf(ss * (1.f / D) + NORM_EPS);
#pragma unroll
        for (int k = 0; k < 8; ++k) {
            const int c0 = lane * 32 + 4 * k;
            const float4 gf = *(const float4*)(a.g_fin + c0);
            *(float4*)(a.out + (size_t)t * D + c0) = make_float4(acc[4 * k + 0] * rstd * gf.x, acc[4 * k + 1] * rstd * gf.y, acc[4 * k + 2] * rstd * gf.z, acc[4 * k + 3] * rstd * gf.w);
        }
    }
#undef ROW_LOAD
#undef TOK_FETCH
}

#define XB_TMO      128
#define XB_XCNT(j)  (256  + 64 * (j))
#define XB_XSUB(j)  (1280 + 64 * (j))
#define XB_XGEN(j)  (2304 + 64 * (j))
#define XB_TOP      3328
#define XB_TOPGEN   3392
#define XCD_BAR_WORDS 3456
#define XB_SPIN_CAP (1u << 18)

__device__ __forceinline__ unsigned xb_ld(unsigned* p)              { return __hip_atomic_load(p, __ATOMIC_RELAXED, __HIP_MEMORY_SCOPE_AGENT); }
__device__ __forceinline__ unsigned xb_add(unsigned* p, unsigned v) { return __hip_atomic_fetch_add(p, v, __ATOMIC_RELAXED, __HIP_MEMORY_SCOPE_AGENT); }
__device__ __forceinline__ unsigned xb_xcc_id() { return (unsigned)__builtin_amdgcn_s_getreg((3 << 11) | 20) & 0xFu; }
#define XB_SPIN(cond, bar) do { unsigned _sp = 0; while (cond) { __builtin_amdgcn_s_sleep(1); \
    if ((++_sp & 255u) == 0u) { if (xb_ld(&(bar)[XB_TMO])) break; if (_sp > XB_SPIN_CAP) { atomicAdd(&(bar)[XB_TMO], 1u); break; } } } } while (0)

struct XcdBarrier {
    unsigned* bar; unsigned x;
    volatile LAS unsigned* st;
};

__device__ __forceinline__ XcdBarrier xcd_barrier_post(unsigned* bar, volatile LAS unsigned* st) {
    XcdBarrier b; b.bar = bar; b.x = xb_xcc_id(); b.st = st;
    if (threadIdx.x == 0) (void)xb_add(&bar[XB_XCNT(b.x)], 1u);
    return b;
}
__device__ __forceinline__ void xcd_barrier_complete(unsigned* bar, unsigned x, unsigned& nloc, unsigned& nx) {
    const unsigned G = gridDim.x * gridDim.y * gridDim.z;
    unsigned sum, cnt, mine, sp = 0u;
    for (;;) {
        sum = 0u; cnt = 0u; mine = 0u;
#pragma unroll
        for (unsigned j = 0; j < 16; ++j) { const unsigned c = xb_ld(&bar[XB_XCNT(j)]); sum += c; cnt += (c > 0u) ? 1u : 0u; mine = (j == x) ? c : mine; }
        if (sum == G) break;
        __builtin_amdgcn_s_sleep(1);
        if ((++sp & 255u) == 0u) { if (xb_ld(&bar[XB_TMO])) break; if (sp > XB_SPIN_CAP) { atomicAdd(&bar[XB_TMO], 1u); break; } }
    }
    nloc = mine > 0u ? mine : 1u; nx = cnt > 0u ? cnt : 1u;
}

__device__ __forceinline__ void xcd_barrier(const XcdBarrier& b) {
    asm volatile("s_waitcnt vmcnt(0)" ::: "memory");
    __syncthreads();
    if (threadIdx.x == 0) {
        unsigned* bar = b.bar;
        __builtin_amdgcn_s_waitcnt(0);
        unsigned nloc = b.st[0], nx = b.st[1];
        if (nloc == 0u) { xcd_barrier_complete(bar, b.x, nloc, nx); b.st[0] = nloc; b.st[1] = nx; }
        const unsigned old = xb_add(&bar[XB_XSUB(b.x)], 1u);
        const unsigned gen = old / nloc;
        if (old + 1u == (gen + 1u) * nloc) {
            __builtin_amdgcn_fence(__ATOMIC_RELEASE, "agent");
            asm volatile("s_waitcnt vmcnt(0)" ::: "memory");
            const unsigned og = xb_add(&bar[XB_TOP], 1u);
            const unsigned tg = og / nx;
            if (og + 1u == (tg + 1u) * nx) xb_add(&bar[XB_TOPGEN], 1u);
            else XB_SPIN(xb_ld(&bar[XB_TOPGEN]) == tg, bar);
            __builtin_amdgcn_fence(__ATOMIC_ACQUIRE, "agent");
            xb_add(&bar[XB_XGEN(b.x)], 1u);
            asm volatile("s_waitcnt vmcnt(0)" ::: "memory");
        } else {
            XB_SPIN(xb_ld(&bar[XB_XGEN(b.x)]) == gen, bar);
            __builtin_amdgcn_fence(__ATOMIC_ACQUIRE, "agent");
            asm volatile("s_waitcnt vmcnt(0)" ::: "memory");
        }
    }
    __syncthreads();
}

constexpr int NPHASES = 11;
__global__ void __launch_bounds__(NTHREADS, 2) mk_fwd(Args a) {
    extern __shared__ __attribute__((aligned(16))) unsigned char lds[];
    cg::grid_group grid = cg::this_grid();
    const int lo = a.ph_lo, hi = a.ph_hi;
    volatile LAS unsigned* xbw = (volatile LAS unsigned*)(lds + LDS_MAIN);
    if (threadIdx.x < 4) xbw[threadIdx.x] = 0u;
    __syncthreads();
    XcdBarrier xbar = xcd_barrier_post((unsigned*)(a.ws + WS_CTL), xbw);
#define IN(k) (lo <= (k) && (k) < hi)
    if (lo < 0) grid.sync();
#define SEAM(k) do { if (IN(k) && IN((k) + 1)) xcd_barrier(xbar); } while (0)
    const float* mod = (const float*)(a.ws + WS_MOD);
    if (IN(0)) phase0(a, lds);
    SEAM(0);
    if (IN(1)) norm_mod_phase<false>(a.x, a.g_mix, mod, 0, 1, (u16*)(a.ws + WS_ACT));
    SEAM(1);
    if (IN(2)) { gemm8(lds, (const u16*)(a.ws + WS_ACT), (const u16*)(a.ws + WS_WIN), T, NP, D, EpiProj{(u16*)(a.ws + WS_P)}); gz_phase(lds, (const u16*)(a.ws + WS_ACT), (const u16*)(a.ws + WS_WIN) + (size_t)NP * D, (float*)(a.ws + WS_GZ)); }
    SEAM(2);
    if (IN(3)) phase_rope_prep(a, lds);
    SEAM(3);
    if (IN(4)) phase_mixers(a, lds);
    SEAM(4);
    if (IN(5)) phase_gla_fin(a);
    SEAM(5);
    if (IN(6)) gemm8(lds, (const u16*)(a.ws + WS_ACT), (const u16*)(a.ws + WS_WOUT), T, D, D, EpiResid{a.x, mod, (u16*)(a.ws + WS_X1)});
    SEAM(6);
    if (IN(7)) { norm_mod_phase<true>(a.ws + WS_X1, a.g_ffn, mod, 3, 4, (u16*)(a.ws + WS_ACT)); convert_tables(a); }
    SEAM(7);
    if (IN(8)) gemm8(lds, (const u16*)(a.ws + WS_ACT), (const u16*)(a.ws + WS_WPQ), T, D, D, EpiBf16{(u16*)(a.ws + WS_Q)});
    SEAM(8);
    if (IN(9)) phase_route(a, lds);
    SEAM(9);
    if (IN(10)) phase_experts(a);
#ifdef PROBE_REP10
    grid.sync(); phase_experts(a);
#endif
#ifdef PROBE_REP9
    grid.sync(); phase_route(a, lds); grid.sync(); phase_experts(a);
#endif
#undef IN
#undef SEAM
}

#ifndef MK_ONE_LAUNCH
#define MK_ONE_LAUNCH 1
#endif
extern "C" void kernel_launch(void* const* d_in, const int* in_sizes, int n_in, void* d_out, int out_size, void* d_ws, size_t ws_size, hipStream_t stream) {
    static int grid = 0;
    if (grid == 0) {
        if (n_in != 19 || out_size != T * D || ws_size < WS_END) {
            fprintf(stderr, "kernel_launch: unexpected shapes: n_in %d out %d ws %zu (need %zu)\n", n_in, out_size, ws_size, (size_t)WS_END);
            grid = -1; return;
        }
        int dev = 0, cus = 0, per_cu = 0;
        (void)hipGetDevice(&dev);
        (void)hipDeviceGetAttribute(&cus, hipDeviceAttributeMultiprocessorCount, dev);
        (void)hipFuncSetAttribute((const void*)mk_fwd, hipFuncAttributeMaxDynamicSharedMemorySize, LDS_BYTES);
        (void)hipOccupancyMaxActiveBlocksPerMultiprocessor(&per_cu, (const void*)mk_fwd, NTHREADS, LDS_BYTES);
        if (per_cu < 1) { fprintf(stderr, "kernel_launch: occupancy query says %d blocks/CU\n", per_cu); grid = -1; return; }
        grid = cus;
        (void)hipGetLastError();
    }
    if (grid < 0) return;
    Args a{};
    a.x = (const float*)d_in[0]; a.c = (const float*)d_in[1]; a.pos = (const int*)d_in[2]; a.w_ada = (const float*)d_in[3];
    a.b_ada = (const float*)d_in[4]; a.g_mix = (const float*)d_in[5]; a.w_in = (const float*)d_in[6]; a.wgf = (const float*)d_in[7];
    a.bgf = (const float*)d_in[8]; a.wgb = (const float*)d_in[9]; a.bgb = (const float*)d_in[10]; a.g_gla = (const float*)d_in[11];
    a.w_out = (const float*)d_in[12]; a.g_ffn = (const float*)d_in[13]; a.w_pq = (const float*)d_in[14]; a.subk = (const float*)d_in[15];
    a.pu = (const float*)d_in[16]; a.pv = (const float*)d_in[17]; a.g_fin = (const float*)d_in[18];
    a.out = (float*)d_out; a.ws = (unsigned char*)d_ws;
#if MK_ONE_LAUNCH
    (void)hipMemsetAsync((unsigned char*)d_ws + WS_CTL, 0, XCD_BAR_WORDS * 4, stream);
    a.ph_lo = 0; a.ph_hi = NPHASES;
    void* args[] = {&a};
    hipError_t e = hipLaunchCooperativeKernel((const void*)mk_fwd, dim3(grid), dim3(NTHREADS), args, LDS_BYTES, stream);
    if (e != hipSuccess) fprintf(stderr, "cooperative launch failed: %s (grid %d)\n", hipGetErrorString(e), grid);
#else
    for (int p = 0; p < NPHASES; ++p) {
        a.ph_lo = p; a.ph_hi = p + 1;
        hipLaunchKernelGGL(mk_fwd, dim3(grid), dim3(NTHREADS), LDS_BYTES, stream, a);
    }
#endif
}
```

```cpp
#include <hip/hip_runtime.h>
#include <hip/hip_cooperative_groups.h>
#include <cstdio>
#include <cstdint>

namespace cg = cooperative_groups;

typedef unsigned short u16;
typedef __attribute__((ext_vector_type(8))) short bf16x8;
typedef __attribute__((ext_vector_type(4))) float f32x4;
typedef short s16x4 __attribute__((ext_vector_type(4)));
#define TID ((int)threadIdx.x)
#define BID ((int)blockIdx.x)
#define GDIM ((int)gridDim.x)
#define LAS __attribute__((address_space(3)))

constexpr int D = 2048, NB = 4, S = 4096, T = NB * S;
constexpr int INW = 6176;
constexpr int NP = 6144;
constexpr int NPAD = 6208;
constexpr int C_GQ = 0, C_GK = 512, C_GV = 1024, C_GR = 2048, C_DQ = 3072, C_DK = 4096, C_DV = 5120;
constexpr int NTHREADS = 512, NWAVES = 8;
constexpr int LDS_MAIN = 128 * 1024;
constexpr int LDS_BYTES = LDS_MAIN + 16;
constexpr float NORM_EPS = 1e-6f;

constexpr size_t WS_CTL = 0;
constexpr size_t WS_MOD = 65536;
constexpr size_t WS_CS = 524288;
constexpr size_t WS_WIN = WS_CS + (size_t)T * 64 * 8;
constexpr size_t WS_WOUT = WS_WIN + (size_t)NPAD * D * 2;
constexpr size_t WS_WPQ = WS_WOUT + (size_t)D * D * 2;
constexpr size_t WS_ACT = WS_WPQ + (size_t)D * D * 2;
constexpr size_t WS_P = WS_ACT + (size_t)T * D * 2;
constexpr size_t WS_X1 = WS_P;
constexpr size_t WS_Q = WS_P + (size_t)T * D * 4;
constexpr size_t WS_GZ = WS_P + (size_t)T * NP * 2;
constexpr int GLA_NPREP = NB * 4 * 2 * (S / 64);
constexpr size_t WS_QD = WS_GZ + (size_t)T * 32 * 4;
constexpr size_t WS_KE = WS_QD + (size_t)GLA_NPREP * 16384;
constexpr size_t WS_AT = WS_KE + (size_t)GLA_NPREP * 16384;
constexpr size_t WS_DEC = WS_AT + (size_t)GLA_NPREP * 8192;
constexpr size_t WS_OFB = WS_DEC + (size_t)GLA_NPREP * 512;
constexpr size_t WS_IDX = WS_OFB + (size_t)2 * T * 1024 * 2;
constexpr size_t WS_GATE = WS_IDX + (size_t)T * 128 * 4;
constexpr size_t WS_END = WS_GATE + (size_t)T * 128 * 4;
constexpr size_t WS_TU = WS_QD;
constexpr size_t WS_TV = WS_QD + (size_t)16384 * 1152;
static_assert(WS_TV + (size_t)16384 * 1152 <= WS_IDX, "table region");

struct Args {
    const float* x; const float* c; const int* pos; const float* w_ada; const float* b_ada; const float* g_mix;
    const float* w_in; const float* wgf; const float* bgf; const float* wgb; const float* bgb; const float* g_gla;
    const float* w_out; const float* g_ffn; const float* w_pq; const float* subk; const float* pu; const float* pv; const float* g_fin;
    float* out; unsigned char* ws; int ph_lo, ph_hi;
};

__device__ __forceinline__ float bf2f(u16 h) { return __uint_as_float(((unsigned)h) << 16); }
typedef __bf16 hw_bf16x2 __attribute__((ext_vector_type(2)));
typedef float hw_f32x2 __attribute__((ext_vector_type(2)));
__device__ __forceinline__ unsigned pack2(float a, float b) { const hw_f32x2 f = {a, b}; return __builtin_bit_cast(unsigned, __builtin_convertvector(f, hw_bf16x2)); }
__device__ __forceinline__ u16 f2bf(float f) { return (u16)(pack2(f, 0.f) & 0xffffu); }
__device__ __forceinline__ float lo2f(unsigned p) { return __uint_as_float(p << 16); }
__device__ __forceinline__ float hi2f(unsigned p) { return __uint_as_float(p & 0xffff0000u); }
__device__ __forceinline__ float wave_sum(float v) {
#pragma unroll
    for (int o = 32; o > 0; o >>= 1) v += __shfl_xor(v, o);
    return v;
}
__device__ __forceinline__ float wave_max(float v) {
#pragma unroll
    for (int o = 32; o > 0; o >>= 1) v = fmaxf(v, __shfl_xor(v, o));
    return v;
}
__device__ __forceinline__ float silu_f(float v) { return v / (1.f + __expf(-v)); }
__device__ __forceinline__ float gelu_f(float a) { return 0.5f * a * (1.f + erff(a * 0.70710678118654752f)); }
__device__ __forceinline__ float logsigmoid_f(float z) { return z < 0.f ? z - log1pf(expf(z)) : -log1pf(expf(-z)); }

constexpr int MOD_BLOCKS = 96;
__device__ __forceinline__ void p0_mod(const Args& a, unsigned char* lds, int bi) {
    float* sc = (float*)lds;
    float* red = sc + 4 * 2048;
    const int tid = threadIdx.x, lane = tid & 63, wave = tid >> 6;
    for (int i = tid; i < 4 * 2048; i += NTHREADS) sc[i] = silu_f(a.c[i]);
    __syncthreads();
    const int j0 = bi * 128 + lane * 2;
    float acc[4][2];
#pragma unroll
    for (int b = 0; b < 4; ++b) { acc[b][0] = 0.f; acc[b][1] = 0.f; }
    const int k0 = wave * 256;
#pragma unroll 8
    for (int kk = 0; kk < 256; ++kk) {
        const int k = k0 + kk;
        const float2 w = *(const float2*)(a.w_ada + (size_t)k * 12288 + j0);
#pragma unroll
        for (int b = 0; b < 4; ++b) { const float s = sc[b * 2048 + k]; acc[b][0] += s * w.x; acc[b][1] += s * w.y; }
    }
#pragma unroll
    for (int b = 0; b < 4; ++b) { red[(wave * 4 + b) * 128 + lane * 2] = acc[b][0]; red[(wave * 4 + b) * 128 + lane * 2 + 1] = acc[b][1]; }
    __syncthreads();
    float* mod = (float*)(a.ws + WS_MOD);
    {
        const int b = tid >> 7, jc = tid & 127;
        float s = 0.f;
#pragma unroll
        for (int w = 0; w < 8; ++w) s += red[(w * 4 + b) * 128 + jc];
        mod[b * 12288 + bi * 128 + jc] = s + a.b_ada[bi * 128 + jc];
    }
    __syncthreads();
}

__device__ __forceinline__ void p0_transpose_item(const float* __restrict__ W, int ldw, int k0, int src_col0, int n_valid,
                                                  u16* __restrict__ WT, int ldt, int n_out0, unsigned char* wlds, bool rope_perm = false) {
    u16* tl = (u16*)wlds;
    const int lane = threadIdx.x & 63;
    const int rsub = lane >> 4, nc = (lane & 15) * 4;
    int scol = src_col0 + nc;
    if (rope_perm) { const int p = (n_out0 & 64) + nc, g = p >> 3; scol = (src_col0 - (n_out0 & 64)) + ((p & 4) ? 64 + 4 * g : 4 * g); }
    float4 v[16];
#pragma unroll
    for (int j = 0; j < 16; ++j) {
        const int k = 4 * j + rsub;
        v[j] = (nc < n_valid) ? *(const float4*)(W + (size_t)(k0 + k) * ldw + scol) : make_float4(0.f, 0.f, 0.f, 0.f);
    }
#pragma unroll
    for (int j = 0; j < 16; ++j) {
        const int k = 4 * j + rsub;
        tl[(nc + 0) * 72 + k] = f2bf(v[j].x); tl[(nc + 1) * 72 + k] = f2bf(v[j].y); tl[(nc + 2) * 72 + k] = f2bf(v[j].z); tl[(nc + 3) * 72 + k] = f2bf(v[j].w);
    }
#pragma unroll
    for (int j = 0; j < 8; ++j) {
        const int c = lane + 64 * j, n = c >> 3, kc = (c & 7) * 8;
        const uint4 o = *(const uint4*)(tl + n * 72 + kc);
        *(uint4*)(WT + (size_t)(n_out0 + n) * ldt + k0 + kc) = o;
    }
}

__device__ __forceinline__ void phase0(const Args& a, unsigned char* lds) {
    const int bi = blockIdx.x, G = gridDim.x, tid = threadIdx.x, wave = tid >> 6;
    const bool modblk = (G > MOD_BLOCKS) && (bi < MOD_BLOCKS);
    if (G > MOD_BLOCKS) { if (modblk) p0_mod(a, lds, bi); }
    else { for (int mb = bi; mb < MOD_BLOCKS; mb += G) p0_mod(a, lds, mb); }
    const int nb = (G > MOD_BLOCKS) ? G - MOD_BLOCKS : G, b0 = (G > MOD_BLOCKS) ? bi - MOD_BLOCKS : bi;
    if (!modblk) {
        constexpr int I_IN = 32 * (NPAD / 64), I_SQ = 32 * 32;
        u16* WinT = (u16*)(a.ws + WS_WIN); u16* WoutT = (u16*)(a.ws + WS_WOUT); u16* WpqT = (u16*)(a.ws + WS_WPQ);
        unsigned char* wlds = lds + wave * 9216;
        for (int it = b0 * NWAVES + wave; it < I_IN + 2 * I_SQ; it += nb * NWAVES) {
            if (it < I_IN) {
                const int kt = it & 31, nt = it >> 5;
                const int n0 = nt * 64;
                int src, nv;
                if (n0 < 3072) { src = n0; nv = 64; }
                else if (n0 < 6144) { src = n0 + 32; nv = 64; }
                else if (n0 == 6144) { src = 3072; nv = 32; }
                else { src = 0; nv = 0; }
                p0_transpose_item(a.w_in, INW, kt * 64, src, nv, WinT, D, n0, wlds, n0 >= C_DQ && n0 < C_DV);
            } else if (it < I_IN + I_SQ) {
                const int r = it - I_IN; const int kt = r & 31, nt = r >> 5;
                p0_transpose_item(a.w_out, D, kt * 64, nt * 64, 64, WoutT, D, nt * 64, wlds);
            } else {
                const int r = it - I_IN - I_SQ; const int kt = r & 31, nt = r >> 5;
                p0_transpose_item(a.w_pq, D, kt * 64, nt * 64, 64, WpqT, D, nt * 64, wlds);
            }
        }
        float2* cs = (float2*)(a.ws + WS_CS);
        for (int i = b0 * NTHREADS + tid; i < T * 64; i += nb * NTHREADS) {
            const int t = i >> 6, f = i & 63;
            const float inv_freq = powf(10000.0f, -(float)f * 2.0f / 128.0f);
            const float ang = (float)a.pos[t] * inv_freq;
            const double rev = (double)ang * 0.15915494309189533577;
            const float fr = (float)(rev - floor(rev));
            cs[i] = make_float2(__builtin_amdgcn_cosf(fr), __builtin_amdgcn_sinf(fr));
        }
    }
    __syncthreads();
}

template <bool BF16IN> __device__ __forceinline__ void norm_mod_phase(const void* __restrict__ xin_, const float* __restrict__ g, const float* __restrict__ mod,
                                               int sh_chunk, int sc_chunk, u16* __restrict__ outp) {
    const int lane = threadIdx.x & 63, wave = threadIdx.x >> 6;
    const int gw = blockIdx.x * NWAVES + wave, NGW = gridDim.x * NWAVES;
    float4 v[8], vn[8];
#define NM_LOAD(dst_, t_) do { if (BF16IN) { const uint2* xr_ = (const uint2*)((const u16*)xin_ + (size_t)(t_) * D); \
            _Pragma("unroll") for (int m = 0; m < 8; ++m) { const uint2 p_ = xr_[lane + 64 * m]; dst_[m] = make_float4(lo2f(p_.x), hi2f(p_.x), lo2f(p_.y), hi2f(p_.y)); } } \
        else { const float4* xr_ = (const float4*)((const float*)xin_ + (size_t)(t_) * D); _Pragma("unroll") for (int m = 0; m < 8; ++m) dst_[m] = xr_[lane + 64 * m]; } } while (0)
    if (gw < T) NM_LOAD(v, gw);
    for (int t = gw; t < T; t += NGW) {
        const int b = t / S;
        if (t + NGW < T) NM_LOAD(vn, t + NGW);
        float ss = 0.f;
#pragma unroll
        for (int m = 0; m < 8; ++m) ss += v[m].x * v[m].x + v[m].y * v[m].y + v[m].z * v[m].z + v[m].w * v[m].w;
        ss = wave_sum(ss);
        const float rstd = rsqrtf(ss * (1.f / D) + NORM_EPS);
        const float4* gp = (const float4*)g;
        const float4* shp = (const float4*)(mod + b * 12288 + sh_chunk * 2048);
        const float4* scp = (const float4*)(mod + b * 12288 + sc_chunk * 2048);
        uint2* op = (uint2*)(outp + (size_t)t * D);
#pragma unroll
        for (int m = 0; m < 8; ++m) {
            const int i = lane + 64 * m;
            const float4 gg = gp[i], sh = shp[i], sc = scp[i];
            const float h0 = v[m].x * rstd * gg.x * (1.f + sc.x) + sh.x;
            const float h1 = v[m].y * rstd * gg.y * (1.f + sc.y) + sh.y;
            const float h2 = v[m].z * rstd * gg.z * (1.f + sc.z) + sh.z;
            const float h3 = v[m].w * rstd * gg.w * (1.f + sc.w) + sh.w;
            op[i] = make_uint2(pack2(h0, h1), pack2(h2, h3));
        }
#pragma unroll
        for (int m = 0; m < 8; ++m) v[m] = vn[m];
    }
#undef NM_LOAD
}

namespace pg8 {
#define PG8_LAS __attribute__((address_space(3)))
typedef unsigned short bf16_t;
typedef short bf16x8 __attribute__((ext_vector_type(8)));
typedef float f32x4 __attribute__((ext_vector_type(4)));
typedef unsigned u32x4 __attribute__((ext_vector_type(4)));
constexpr int BM = 256, BK = 64, HALF = 128, HTB = HALF * BK * 2  , STAGE_BYTES = 8 * HTB, NXCD = 8, WGM = 8;

__host__ __device__ __forceinline__ int lds_byte(int r, int c) { const int st = (r >> 4) * 2 + (c >> 5), rr = r & 15, cc = c & 31, ob = rr * 64 + cc * 2; return st * 1024 + (ob ^ (((ob >> 9) & 1) << 5)); }
__host__ __device__ __forceinline__ void stage_rc(int b, int& R, int& C) { const int st = b / 1024, sb = b % 1024, swz = sb ^ (((sb >> 9) & 1) << 5); R = (st >> 1) * 16 + swz / 64; C = (st & 1) * 32 + (swz % 64) / 2; }
__host__ __device__ __forceinline__ int perm32(int rho) { const int n = rho >> 4, i = rho & 15; return 8 * (i >> 2) + 4 * n + (i & 3); }

struct Unit { int pm, pn; };
struct Gemm { const bf16_t* A; const bf16_t* Bt; int M, N, K; };

struct StaticOrder {
    int nM, nN, nwg, G, c;
    __host__ __device__ void init(int M, int N, int G_, int c_) { nM = M / BM; nN = N / BM; nwg = nM * nN; G = G_; c = c_; }
    __host__ __device__ bool next(int i, Unit& u) const {
        const long L = (long)i * G + c; if (L >= nwg) return false;
        int wgid = (int)L; { const int q = nwg / NXCD, r = nwg % NXCD, xcd = wgid % NXCD, off = wgid / NXCD; wgid = (xcd < r ? xcd * (q + 1) : r * (q + 1) + (xcd - r) * q) + off; }
        const int nig = WGM * nN, gid = wgid / nig, fm = gid * WGM, gsz = (nM - fm) < WGM ? (nM - fm) : WGM;
        u.pm = fm + ((wgid % nig) % gsz); u.pn = (wgid % nig) / gsz; return true;
    }
    __device__ __forceinline__ void a_ready(const Unit&) const {}
    __device__ __forceinline__ void done(const Unit&) const {}
};
__device__ __forceinline__ unsigned cvt_pk_bf16(float lo, float hi) { unsigned r; asm volatile("v_cvt_pk_bf16_f32 %0, %1, %2" : "=v"(r) : "v"(lo), "v"(hi)); return r; }
typedef float f32x2 __attribute__((ext_vector_type(2)));
template <class Epi, class Sched, bool STAMP = false>
__device__ __forceinline__ void gemm_phase(PG8_LAS unsigned char* lds, const Gemm g, const Sched& S, const Epi& E, unsigned long long* stamps) {
    const int tid = threadIdx.x, wid = __builtin_amdgcn_readfirstlane(tid >> 6), lane = tid & 63, wr = wid >> 2, wc = wid & 3, fr = lane & 15, fq = lane >> 4;
    const int K = g.K, nt = K / BK;
    int ts_lo = 0, ts_hi = 0, nts = 0; const unsigned long long rt_entry = STAMP ? (unsigned long long)wall_clock64() : 0ull;
#define PG8_STAMP() do { if (STAMP && wid == 0 && nts < 64) { const unsigned long long _c = (unsigned long long)clock64(); \
        ts_lo = (lane == nts) ? (int)(unsigned)_c : ts_lo; ts_hi = (lane == nts) ? (int)(unsigned)(_c >> 32) : ts_hi; ++nts; } } while (0)
    PG8_STAMP();
    unsigned voffA[2], voffB[2];
#pragma unroll
    for (int i = 0; i < 2; ++i) { int R, C; stage_rc(tid * 16 + i * 8192, R, C); const int Rb = Epi::PERM ? ((R & ~31) + perm32(R & 31)) : R;
        voffA[i] = (unsigned)(R * K + C) * 2u; voffB[i] = (unsigned)(Rb * K + C) * 2u; }
    const size_t kstep = (size_t)(BK * 2);
    const size_t hstep = (size_t)HALF * K * 2;
    const size_t tstep = 2 * hstep;
    const unsigned ldsw = (unsigned)wid * 1024u;
    const int aoff = lds_byte(wr * 64 + fr, fq * 8), boff = lds_byte(wc * 32 + fr, fq * 8);
#define PG8_SA(b, h) (((b) * 2 + (h)) * HTB)
#define PG8_SB(b, h) ((4 + (b) * 2 + (h)) * HTB)
#define PG8_STAGE(bufoff, gbase, voff) do { _Pragma("unroll") for (int _i = 0; _i < 2; ++_i) \
        __builtin_amdgcn_global_load_lds((const unsigned*)((const char*)(gbase) + (voff)[_i]), (PG8_LAS unsigned*)(lds + (bufoff) + ldsw + _i * 8192), 16, 0, 0); } while (0)
#define PG8_LDA(dst, b, h) do { _Pragma("unroll") for (int m = 0; m < 4; ++m) _Pragma("unroll") for (int k = 0; k < 2; ++k) dst[m][k] = *(const PG8_LAS bf16x8*)(lds + PG8_SA(b, h) + aoff + m * 2048 + k * 1024); } while (0)
#define PG8_LDB(dst, b, h) do { _Pragma("unroll") for (int n = 0; n < 2; ++n) _Pragma("unroll") for (int k = 0; k < 2; ++k) dst[n][k] = *(const PG8_LAS bf16x8*)(lds + PG8_SB(b, h) + boff + n * 2048 + k * 1024); } while (0)
#define PG8_MMA(ai, bj, At, Bt) do { __builtin_amdgcn_s_setprio(1); _Pragma("unroll") for (int m = 0; m < 4; ++m) _Pragma("unroll") for (int n = 0; n < 2; ++n) _Pragma("unroll") for (int k = 0; k < 2; ++k) \
        acc[ai][bj][m][n] = __builtin_amdgcn_mfma_f32_16x16x32_bf16(Bt[n][k], At[m][k], acc[ai][bj][m][n], 0, 0, 0); __builtin_amdgcn_s_setprio(0); } while (0)
#define PG8_WAIT_V(n) asm volatile("s_waitcnt vmcnt(" #n ")" ::: "memory")
#define PG8_WAIT_L(n) asm volatile("s_waitcnt lgkmcnt(" #n ")" ::: "memory")
#define PG8_BAR __builtin_amdgcn_s_barrier()
#define PG8_SCHED __builtin_amdgcn_sched_barrier(0)
    Unit cur, nxt; int ui = 0;
    if (!S.next(0, cur)) return;
    f32x4 acc[2][2][4][2];
#pragma unroll
    for (int a = 0; a < 2; ++a)
#pragma unroll
        for (int b = 0; b < 2; ++b)
#pragma unroll
            for (int m = 0; m < 4; ++m)
#pragma unroll
                for (int n = 0; n < 2; ++n) acc[a][b][m][n] = (f32x4){0.f, 0.f, 0.f, 0.f};
    bf16x8 At[4][2], B0[2][2], B1[2][2];
    const char* cA = (const char*)g.A + (size_t)cur.pm * tstep; const char* cB = (const char*)g.Bt + (size_t)cur.pn * tstep;
    S.a_ready(cur);
    PG8_STAGE(PG8_SB(0, 0), cB, voffB); PG8_STAGE(PG8_SA(0, 0), cA, voffA); PG8_STAGE(PG8_SB(0, 1), cB + hstep, voffB); PG8_STAGE(PG8_SA(0, 1), cA + hstep, voffA);
    if (wr == 1) PG8_BAR;
    PG8_WAIT_V(4); PG8_BAR;
    PG8_STAGE(PG8_SB(1, 0), cB + kstep, voffB); PG8_STAGE(PG8_SA(1, 0), cA + kstep, voffA); PG8_STAGE(PG8_SB(1, 1), cB + hstep + kstep, voffB);
    PG8_WAIT_V(6); PG8_BAR;
    PG8_STAMP();
    for (;;) {
        const bool has_next = S.next(ui + 1, nxt);
        const char* nA = has_next ? (const char*)g.A + (size_t)nxt.pm * tstep : cA; const char* nB = has_next ? (const char*)g.Bt + (size_t)nxt.pn * tstep : cB;
        for (int t = 0; t < nt; t += 2) {
            const bool last = (t == nt - 2);
            const char* a1 = cA + (size_t)(t + 1) * kstep;
            const char* a2 = last ? nA : cA + (size_t)(t + 2) * kstep; const char* b2 = last ? nB : cB + (size_t)(t + 2) * kstep;
            const char* a3 = a2 + kstep; const char* b3 = b2 + kstep;
            if (last && has_next) S.a_ready(nxt);
            PG8_LDB(B0, 0, 0); PG8_SCHED; PG8_LDA(At, 0, 0); PG8_STAGE(PG8_SA(1, 1), a1 + hstep, voffA);
            PG8_WAIT_L(8); PG8_BAR; PG8_WAIT_L(0); PG8_MMA(0, 0, At, B0); PG8_BAR; PG8_SCHED;
            PG8_LDB(B1, 0, 1); PG8_STAGE(PG8_SB(0, 0), b2, voffB);
            PG8_BAR; PG8_WAIT_L(0); PG8_MMA(0, 1, At, B1); PG8_BAR;
            PG8_LDA(At, 0, 1); PG8_STAGE(PG8_SA(0, 0), a2, voffA);
            PG8_BAR; PG8_WAIT_L(0); PG8_MMA(1, 0, At, B0); PG8_BAR; PG8_SCHED;
            PG8_STAGE(PG8_SB(0, 1), b2 + hstep, voffB);
            PG8_WAIT_V(6); PG8_BAR; PG8_MMA(1, 1, At, B1); PG8_BAR;
            PG8_LDB(B0, 1, 0); PG8_SCHED; PG8_LDA(At, 1, 0); PG8_STAGE(PG8_SA(0, 1), a2 + hstep, voffA);
            PG8_WAIT_L(8); PG8_BAR; PG8_WAIT_L(0); PG8_MMA(0, 0, At, B0); PG8_BAR; PG8_SCHED;
            PG8_LDB(B1, 1, 1); PG8_STAGE(PG8_SB(1, 0), b3, voffB);
            PG8_BAR; PG8_WAIT_L(0); PG8_MMA(0, 1, At, B1); PG8_BAR;
            PG8_LDA(At, 1, 1); PG8_STAGE(PG8_SA(1, 0), a3, voffA);
            PG8_BAR; PG8_WAIT_L(0); PG8_MMA(1, 0, At, B0); PG8_BAR; PG8_SCHED;
            PG8_STAGE(PG8_SB(1, 1), b3 + hstep, voffB);
            PG8_WAIT_V(6); PG8_BAR; PG8_MMA(1, 1, At, B1); PG8_BAR;
        }
        PG8_STAMP();
        if constexpr (!Epi::AFTER_DRAIN) { E(acc, cur, wr, wc, fr, fq); S.done(cur); }
        PG8_STAMP();
        if (!has_next) break;
#pragma unroll
        for (int a = 0; a < 2; ++a)
#pragma unroll
            for (int b = 0; b < 2; ++b)
#pragma unroll
                for (int m = 0; m < 4; ++m)
#pragma unroll
                    for (int n = 0; n < 2; ++n) acc[a][b][m][n] = (f32x4){0.f, 0.f, 0.f, 0.f};
        cur = nxt; cA = nA; cB = nB; ++ui;
    }
    PG8_WAIT_V(0);
    if (wr == 0) PG8_BAR;
    PG8_BAR;
    if constexpr (Epi::AFTER_DRAIN) { E.fused(acc, cur, wr, wc, fr, fq, lds, wid, lane); S.done(cur); }
    PG8_STAMP();
    if (STAMP && wid == 0) { stamps[lane] = lane < nts ? (((unsigned long long)(unsigned)ts_hi << 32) | (unsigned)ts_lo) : 0ull;
        if (lane == 62) stamps[62] = rt_entry; if (lane == 63) stamps[63] = (unsigned long long)wall_clock64(); }
#undef PG8_STAMP
#undef PG8_SA
#undef PG8_SB
#undef PG8_STAGE
#undef PG8_LDA
#undef PG8_LDB
#undef PG8_MMA
#undef PG8_WAIT_V
#undef PG8_WAIT_L
#undef PG8_BAR
#undef PG8_SCHED
}
}

struct EpiProj {
    static constexpr bool PERM = true, AFTER_DRAIN = false;
    u16* P; const float* cs;
    __device__ __forceinline__ void operator()(const pg8::f32x4 (&acc)[2][2][4][2], const pg8::Unit& u, int wr, int wc, int fr, int fq) const {
        const int row0 = u.pm * 256 + wr * 64 + fr;
        const int col0 = u.pn * 256 + wc * 32 + 8 * fq;
        const bool rope = (u.pn >= C_DQ / 256) && (u.pn < C_DV / 256);
#pragma unroll
        for (int ai = 0; ai < 2; ++ai)
#pragma unroll
            for (int m = 0; m < 4; ++m) { const int row = row0 + ai * 128 + m * 16; u16* rowp = P + (size_t)row * NP + col0;
                pg8::f32x4 c01 = (pg8::f32x4){1.f, 0.f, 1.f, 0.f}, c23 = c01;
                if (rope) { const pg8::f32x4* cp = (const pg8::f32x4*)(cs + ((size_t)row * 64 + 4 * (4 * wc + fq)) * 2); c01 = cp[0]; c23 = cp[1]; }
#pragma unroll
                for (int bj = 0; bj < 2; ++bj) { pg8::f32x4 v0 = acc[ai][bj][m][0], v1 = acc[ai][bj][m][1];
                    if (rope) {
                        const pg8::f32x4 cc = {c01[0], c01[2], c23[0], c23[2]}, sn = {c01[1], c01[3], c23[1], c23[3]};
                        const pg8::f32x4 y1 = v0 * cc - v1 * sn, y2 = v0 * sn + v1 * cc; v0 = y1; v1 = y2; }
                    pg8::u32x4 w; w.x = pg8::cvt_pk_bf16(v0[0], v0[1]); w.y = pg8::cvt_pk_bf16(v0[2], v0[3]); w.z = pg8::cvt_pk_bf16(v1[0], v1[1]); w.w = pg8::cvt_pk_bf16(v1[2], v1[3]);
                    *(pg8::u32x4*)(rowp + bj * 128) = w; } }
    }
};
__device__ __forceinline__ void gz_phase(unsigned char* lds, const u16* __restrict__ H1, const u16* __restrict__ Wg, float* __restrict__ gz) {
    const int tid = threadIdx.x, lane = tid & 63, wave = tid >> 6, fr = lane & 15, fq = lane >> 4;
    float* red = (float*)lds;
    for (int rb = blockIdx.x; rb < T / 64; rb += gridDim.x) {
        const int r0 = rb * 64, k0 = wave * 256;
        f32x4 acc[4][2];
#pragma unroll
        for (int m = 0; m < 4; ++m) { acc[m][0] = (f32x4){0.f, 0.f, 0.f, 0.f}; acc[m][1] = (f32x4){0.f, 0.f, 0.f, 0.f}; }
#pragma unroll
        for (int ks = 0; ks < 8; ++ks) {
            bf16x8 af[4], bfr[2];
#pragma unroll
            for (int m = 0; m < 4; ++m) af[m] = *(const bf16x8*)(H1 + (size_t)(r0 + 16 * m + fr) * D + k0 + 32 * ks + 8 * fq);
#pragma unroll
            for (int n = 0; n < 2; ++n) bfr[n] = *(const bf16x8*)(Wg + (size_t)(16 * n + fr) * D + k0 + 32 * ks + 8 * fq);
#pragma unroll
            for (int m = 0; m < 4; ++m)
#pragma unroll
                for (int n = 0; n < 2; ++n) acc[m][n] = __builtin_amdgcn_mfma_f32_16x16x32_bf16(af[m], bfr[n], acc[m][n], 0, 0, 0);
        }
        __syncthreads();
#pragma unroll
        for (int m = 0; m < 4; ++m)
#pragma unroll
            for (int n = 0; n < 2; ++n)
#pragma unroll
                for (int j = 0; j < 4; ++j) red[(wave * 64 + 16 * m + 4 * fq + j) * 32 + 16 * n + fr] = acc[m][n][j];
        __syncthreads();
#pragma unroll
        for (int k = 0; k < 4; ++k) {
            const int e = tid + 512 * k;
            float s = 0.f;
#pragma unroll
            for (int w = 0; w < 8; ++w) s += red[w * 2048 + e];
            gz[(size_t)r0 * 32 + e] = s;
        }
    }
    __syncthreads();
}
struct EpiResid {
    static constexpr bool PERM = true, AFTER_DRAIN = false;
    const float* x; const float* mod; u16* x1;
    __device__ __forceinline__ void operator()(const pg8::f32x4 (&acc)[2][2][4][2], const pg8::Unit& u, int wr, int wc, int fr, int fq) const {
        const int row0 = u.pm * 256 + wr * 64 + fr, col0 = u.pn * 256 + wc * 32 + 8 * fq;
        const int b = (u.pm * 256) / S;
        pg8::f32x4 ga[2][2];
#pragma unroll
        for (int bj = 0; bj < 2; ++bj)
#pragma unroll
            for (int n = 0; n < 2; ++n) ga[bj][n] = *(const pg8::f32x4*)(mod + b * 12288 + 2 * 2048 + col0 + bj * 128 + 4 * n);
#pragma unroll
        for (int ai = 0; ai < 2; ++ai)
#pragma unroll
            for (int m = 0; m < 4; ++m) { const size_t off = (size_t)(row0 + ai * 128 + m * 16) * D + col0;
#pragma unroll
                for (int bj = 0; bj < 2; ++bj) {
                    const pg8::f32x4 x0 = *(const pg8::f32x4*)(x + off + bj * 128), x1v = *(const pg8::f32x4*)(x + off + bj * 128 + 4);
                    const pg8::f32x4 v0 = x0 + ga[bj][0] * acc[ai][bj][m][0], v1 = x1v + ga[bj][1] * acc[ai][bj][m][1];
                    pg8::u32x4 w; w.x = pg8::cvt_pk_bf16(v0[0], v0[1]); w.y = pg8::cvt_pk_bf16(v0[2], v0[3]); w.z = pg8::cvt_pk_bf16(v1[0], v1[1]); w.w = pg8::cvt_pk_bf16(v1[2], v1[3]);
                    *(pg8::u32x4*)(x1 + off + bj * 128) = w; } }
    }
};
struct EpiBf16 {
    static constexpr bool PERM = true, AFTER_DRAIN = false;
    u16* Q;
    __device__ __forceinline__ void operator()(const pg8::f32x4 (&acc)[2][2][4][2], const pg8::Unit& u, int wr, int wc, int fr, int fq) const {
        const int row0 = u.pm * 256 + wr * 64 + fr, col0 = u.pn * 256 + wc * 32 + 8 * fq;
#pragma unroll
        for (int ai = 0; ai < 2; ++ai)
#pragma unroll
            for (int m = 0; m < 4; ++m) { u16* rowp = Q + (size_t)(row0 + ai * 128 + m * 16) * D + col0;
#pragma unroll
                for (int bj = 0; bj < 2; ++bj) { const pg8::f32x4 v0 = acc[ai][bj][m][0], v1 = acc[ai][bj][m][1];
                    pg8::u32x4 w; w.x = pg8::cvt_pk_bf16(v0[0], v0[1]); w.y = pg8::cvt_pk_bf16(v0[2], v0[3]); w.z = pg8::cvt_pk_bf16(v1[0], v1[1]); w.w = pg8::cvt_pk_bf16(v1[2], v1[3]);
                    *(pg8::u32x4*)(rowp + bj * 128) = w; } }
    }
};
template <class Epi>
__device__ __forceinline__ void gemm8(unsigned char* lds, const u16* A, const u16* Bt, int M, int N, int K, const Epi& E) {
    pg8::Gemm g{A, Bt, M, N, K}; pg8::StaticOrder So; So.init(M, N, (int)gridDim.x, (int)blockIdx.x);
    pg8::gemm_phase<Epi, pg8::StaticOrder, false>((PG8_LAS unsigned char*)lds, g, So, E, nullptr);
    __syncthreads();
}

#define GLA_QD_BYTES 16384
#define GLA_AT_BYTES 8192
__device__ __forceinline__ float gla_logsigmoid(float z) { return fminf(z, 0.f) - __logf(1.f + __expf(-fabsf(z))); }

__device__ __forceinline__ void gla_prep_item(const u16* __restrict__ P, int ldp, int cq, int ck, const float* __restrict__ gz,
                                              const float* __restrict__ wg_f, const float* __restrict__ bg_f, const float* __restrict__ wg_b, const float* __restrict__ bg_b,
                                              int Sq, unsigned char* __restrict__ QDg, unsigned char* __restrict__ KEg, unsigned char* __restrict__ ATg, float* __restrict__ DECg,
                                              unsigned char* lds, int item) {
    const int nch = Sq / 64;
    const int c = item % nch, dir = (item / nch) & 1, hh = (item / (nch * 2)) & 3, b = item / (nch * 8);
    const int tid = TID, lane = tid & 63, wave = tid >> 6, li = lane & 15, fq = lane >> 4;
    float* gzs = (float*)lds;
    float* segs = gzs + 64 * 16;
    unsigned char* QDs = lds + 8192;
    unsigned char* KIs = QDs + 16384;
    unsigned char* KEs = KIs + 16384;
    float* bmat = (float*)(KEs + 16384);
    const size_t tok0 = (size_t)b * Sq;
    __syncthreads();
    uint4 rq0, rq1, rk0, rk1;
    {
        const int i0 = tid >> 4, i1 = (tid + 512) >> 4, cc = tid & 15;
        const int s0 = dir ? (Sq - 1 - (64 * c + i0)) : (64 * c + i0), s1 = dir ? (Sq - 1 - (64 * c + i1)) : (64 * c + i1);
        rq0 = *(const uint4*)(P + (tok0 + s0) * ldp + cq + hh * 128 + cc * 8); rk0 = *(const uint4*)(P + (tok0 + s0) * ldp + ck + hh * 128 + cc * 8);
        rq1 = *(const uint4*)(P + (tok0 + s1) * ldp + cq + hh * 128 + cc * 8); rk1 = *(const uint4*)(P + (tok0 + s1) * ldp + ck + hh * 128 + cc * 8);
    }
    for (int e = tid; e < 64 * 16; e += 512) {
        const int i = e >> 4, r = e & 15;
        const int s = dir ? (Sq - 1 - (64 * c + i)) : (64 * c + i);
        gzs[e] = gz[(tok0 + s) * 32 + dir * 16 + r];
    }
    const int d = tid & 127, seg = tid >> 7;
    const float* wg = dir ? wg_b : wg_f;
    float wcol[16];
#pragma unroll
    for (int r = 0; r < 16; ++r) wcol[r] = wg[r * 512 + hh * 128 + d];
    const float bias = (dir ? bg_b : bg_f)[hh * 128 + d];
    __syncthreads();
    float run = 0.f;
#pragma unroll
    for (int k = 0; k < 16; ++k) {
        const int i = 16 * seg + k;
        float z = bias;
#pragma unroll
        for (int r = 0; r < 16; ++r) z += gzs[i * 16 + r] * wcol[r];
        run += gla_logsigmoid(z) * (1.f / 16.f);
        bmat[i * 128 + d] = run;
    }
    segs[seg * 128 + d] = run;
    __syncthreads();
    if (seg == 0) {
        const float t0 = segs[d], t1 = segs[128 + d], t2 = segs[256 + d], t3 = segs[384 + d];
        segs[d] = 0.f; segs[128 + d] = t0; segs[256 + d] = t0 + t1; segs[384 + d] = t0 + t1 + t2; segs[512 + d] = t0 + t1 + t2 + t3;
        DECg[(size_t)item * 128 + d] = __expf(t0 + t1 + t2 + t3);
    }
    __syncthreads();
    const float qscale = 0.08838834764831845f;
#pragma unroll
    for (int k = 0; k < 2; ++k) {
        const int id = tid + 512 * k, i = id >> 4, cc = id & 15, d0 = cc * 8, sg = i >> 4;
        const uint4 qv = k ? rq1 : rq0, kv = k ? rk1 : rk0;
        const float qx[8] = {lo2f(qv.x), hi2f(qv.x), lo2f(qv.y), hi2f(qv.y), lo2f(qv.z), hi2f(qv.z), lo2f(qv.w), hi2f(qv.w)};
        const float kx[8] = {lo2f(kv.x), hi2f(kv.x), lo2f(kv.y), hi2f(kv.y), lo2f(kv.z), hi2f(kv.z), lo2f(kv.w), hi2f(kv.w)};
        float qd[8], ki[8], ke[8];
        const float4 bA = *(const float4*)(bmat + i * 128 + d0), bB = *(const float4*)(bmat + i * 128 + d0 + 4);
        const float4 oA = *(const float4*)(segs + sg * 128 + d0), oB = *(const float4*)(segs + sg * 128 + d0 + 4);
        const float4 tA = *(const float4*)(segs + 512 + d0), tB = *(const float4*)(segs + 512 + d0 + 4);
        const float bv[8] = {bA.x + oA.x, bA.y + oA.y, bA.z + oA.z, bA.w + oA.w, bB.x + oB.x, bB.y + oB.y, bB.z + oB.z, bB.w + oB.w};
        const float tv[8] = {tA.x, tA.y, tA.z, tA.w, tB.x, tB.y, tB.z, tB.w};
#pragma unroll
        for (int e = 0; e < 8; ++e) {
            const float bb = bv[e], tot = tv[e];
            qd[e] = qx[e] * qscale * __expf(bb); ki[e] = kx[e] * __expf(-bb); ke[e] = kx[e] * __expf(tot - bb);
        }
        const int o = i * 256 + ((cc ^ (i & 15)) << 4);
        *(uint4*)(QDs + o) = make_uint4(pack2(qd[0], qd[1]), pack2(qd[2], qd[3]), pack2(qd[4], qd[5]), pack2(qd[6], qd[7]));
        *(uint4*)(KIs + o) = make_uint4(pack2(ki[0], ki[1]), pack2(ki[2], ki[3]), pack2(ki[4], ki[5]), pack2(ki[6], ki[7]));
        *(uint4*)(KEs + o) = make_uint4(pack2(ke[0], ke[1]), pack2(ke[2], ke[3]), pack2(ke[4], ke[5]), pack2(ke[6], ke[7]));
    }
    __syncthreads();
    {
        uint4* qo = (uint4*)(QDg + (size_t)item * GLA_QD_BYTES); uint4* ko = (uint4*)(KEg + (size_t)item * GLA_QD_BYTES);
#pragma unroll
        for (int k = 0; k < 2; ++k) { const int e = tid + 512 * k; qo[e] = ((const uint4*)QDs)[e]; ko[e] = ((const uint4*)KEs)[e]; }
    }
#pragma unroll
    for (int tt = 0; tt < 2; ++tt) {
        const int tile = wave + 8 * tt, jt = tile >> 2, it = tile & 3;
        f32x4 acc = (f32x4){0.f, 0.f, 0.f, 0.f};
        if (jt <= it) {
            const int jr = 16 * jt + li, ir = 16 * it + li;
#pragma unroll
            for (int ks = 0; ks < 4; ++ks) {
                const bf16x8 kf = *(const bf16x8*)(KIs + jr * 256 + (((4 * ks + fq) ^ (jr & 15)) << 4));
                const bf16x8 qf = *(const bf16x8*)(QDs + ir * 256 + (((4 * ks + fq) ^ (ir & 15)) << 4));
                acc = __builtin_amdgcn_mfma_f32_16x16x32_bf16(kf, qf, acc, 0, 0, 0);
            }
        }
        const int i = 16 * it + li, j0 = 16 * jt + 4 * fq;
        float v[4];
#pragma unroll
        for (int jj = 0; jj < 4; ++jj) v[jj] = (j0 + jj <= i) ? acc[jj] : 0.f;
        const int chunk = 2 * jt + (fq >> 1), sub = (fq & 1) * 8;
        *(uint2*)(ATg + (size_t)item * GLA_AT_BYTES + i * 128 + ((chunk ^ (i & 7)) << 4) + sub) = make_uint2(pack2(v[0], v[1]), pack2(v[2], v[3]));
    }
}

__device__ __forceinline__ void gla_seq_item(const u16* __restrict__ P, int ldp, int cv, int Sq,
                                             const unsigned char* __restrict__ QDg, const unsigned char* __restrict__ KEg, const unsigned char* __restrict__ ATg, const float* __restrict__ DECg,
                                             u16* __restrict__ Oout  , int Ttot, unsigned char* lds, int item) {
    const int slice = item & 1, dir = (item >> 1) & 1, hh = (item >> 2) & 3, b = item >> 4;
    const int nch = Sq / 64;
    const int tid = TID, lane = tid & 63, wave = tid >> 6, li = lane & 15, fq = lane >> 4;
    const size_t tok0 = (size_t)b * Sq;
    const int pitem0 = ((b * 4 + hh) * 2 + dir) * nch;
    constexpr int BUF = 16384 * 3 + 8192 + 512;
    typedef unsigned gla_u32x4 __attribute__((ext_vector_type(4)));
    gla_u32x4 rq0, rq1, rk0, rk1, rv0, rv1, ra; float rd = 0.f;
#define GLA_VROW(c_, k_) ((tok0 + (size_t)(dir ? (Sq - 1 - (64 * (c_) + ((tid + 512 * (k_)) >> 4))) : (64 * (c_) + ((tid + 512 * (k_)) >> 4)))) * ldp + cv + hh * 256 + slice * 128 + ((tid + 512 * (k_)) & 15) * 8)
#define GLA_ISSUE(c_) do { \
        const gla_u32x4* qsrc_ = (const gla_u32x4*)(QDg + (size_t)(pitem0 + (c_)) * GLA_QD_BYTES); const gla_u32x4* ksrc_ = (const gla_u32x4*)(KEg + (size_t)(pitem0 + (c_)) * GLA_QD_BYTES); \
        rq0 = qsrc_[tid]; rq1 = qsrc_[tid + 512]; rk0 = ksrc_[tid]; rk1 = ksrc_[tid + 512]; \
        ra = ((const gla_u32x4*)(ATg + (size_t)(pitem0 + (c_)) * GLA_AT_BYTES))[tid]; \
        rv0 = *(const gla_u32x4*)(P + GLA_VROW(c_, 0)); rv1 = *(const gla_u32x4*)(P + GLA_VROW(c_, 1)); \
        if (tid < 128) rd = DECg[(size_t)(pitem0 + (c_)) * 128 + tid]; } while (0)
#define GLA_COMMIT(buf_) do { \
        unsigned char* base_ = lds + (buf_) * BUF; \
        ((gla_u32x4*)base_)[tid] = rq0; ((gla_u32x4*)base_)[tid + 512] = rq1; ((gla_u32x4*)(base_ + 16384))[tid] = rk0; ((gla_u32x4*)(base_ + 16384))[tid + 512] = rk1; \
        { const int row_ = tid >> 4, ch_ = tid & 15; *(gla_u32x4*)(base_ + 32768 + row_ * 256 + ((ch_ ^ (row_ & 15)) << 4)) = rv0; } \
        { const int row_ = (tid + 512) >> 4, ch_ = tid & 15; *(gla_u32x4*)(base_ + 32768 + row_ * 256 + ((ch_ ^ (row_ & 15)) << 4)) = rv1; } \
        ((gla_u32x4*)(base_ + 49152))[tid] = ra; \
        if (tid < 128) ((float*)(base_ + 57344))[tid] = rd; } while (0)
    f32x4 st[8];
#pragma unroll
    for (int dt = 0; dt < 8; ++dt) st[dt] = (f32x4){0.f, 0.f, 0.f, 0.f};
    __syncthreads();
    GLA_ISSUE(0); GLA_COMMIT(0);
    __syncthreads();
#pragma unroll 1
    for (int c = 0; c < nch; ++c) {
        const int buf = c & 1;
        if (c + 1 < nch) GLA_ISSUE(c + 1);
        const unsigned char* QDs = lds + buf * BUF; const unsigned char* KEs = QDs + 16384; const unsigned char* Vs = QDs + 32768;
        const unsigned char* ATs = QDs + 49152; const float* DECs = (const float*)(QDs + 57344);
        bf16x8 vf[2];
#pragma unroll
        for (int jp = 0; jp < 2; ++jp) {
            const int rowA = 32 * jp + 8 * fq + (li >> 2), rowB = rowA + 4;
            const int chunk = 2 * wave + ((li & 3) >> 1), sub = ((li & 3) & 1) * 8;
            const s16x4 va = __builtin_amdgcn_ds_read_tr16_b64_v4i16((LAS s16x4*)(Vs + rowA * 256 + ((chunk ^ (rowA & 15)) << 4) + sub));
            const s16x4 vb = __builtin_amdgcn_ds_read_tr16_b64_v4i16((LAS s16x4*)(Vs + rowB * 256 + ((chunk ^ (rowB & 15)) << 4) + sub));
            vf[jp] = __builtin_shufflevector(va, vb, 0, 1, 2, 3, 4, 5, 6, 7);
        }
        bf16x8 sf[4];
#pragma unroll
        for (int dp = 0; dp < 4; ++dp) {
            const gla_u32x4 t_ = {pack2(st[2 * dp][0], st[2 * dp][1]), pack2(st[2 * dp][2], st[2 * dp][3]), pack2(st[2 * dp + 1][0], st[2 * dp + 1][1]), pack2(st[2 * dp + 1][2], st[2 * dp + 1][3])};
            sf[dp] = __builtin_bit_cast(bf16x8, t_);
        }
        f32x4 ot[4];
#pragma unroll
        for (int it = 0; it < 4; ++it) {
            f32x4 acc = (f32x4){0.f, 0.f, 0.f, 0.f};
            const int ir = 16 * it + li;
#pragma unroll
            for (int dp = 0; dp < 4; ++dp) {
                const int c0 = 4 * dp + (fq >> 1), c1 = c0 + 2, sub = (fq & 1) * 8;
                const uint2 lo = *(const uint2*)(QDs + ir * 256 + ((c0 ^ (ir & 15)) << 4) + sub);
                const uint2 hi = *(const uint2*)(QDs + ir * 256 + ((c1 ^ (ir & 15)) << 4) + sub);
                const gla_u32x4 q_ = {lo.x, lo.y, hi.x, hi.y};
                const bf16x8 qf = __builtin_bit_cast(bf16x8, q_);
                acc = __builtin_amdgcn_mfma_f32_16x16x32_bf16(sf[dp], qf, acc, 0, 0, 0);
            }
#pragma unroll
            for (int jp = 0; jp < 2; ++jp) {
                if (32 * jp <= 16 * it + 15) {
                    const bf16x8 af = *(const bf16x8*)(ATs + ir * 128 + (((4 * jp + fq) ^ (ir & 7)) << 4));
                    acc = __builtin_amdgcn_mfma_f32_16x16x32_bf16(vf[jp], af, acc, 0, 0, 0);
                }
            }
            ot[it] = acc;
        }
#pragma unroll
        for (int dt = 0; dt < 8; ++dt) {
            const f32x4 dec = *(const f32x4*)(DECs + 16 * dt + 4 * fq);
            f32x4 acc = st[dt] * dec;
#pragma unroll
            for (int jp = 0; jp < 2; ++jp) {
                const int rowA = 32 * jp + 8 * fq + (li >> 2), rowB = rowA + 4;
                const int chunk = 2 * dt + ((li & 3) >> 1), sub = ((li & 3) & 1) * 8;
                const s16x4 ka = __builtin_amdgcn_ds_read_tr16_b64_v4i16((LAS s16x4*)(KEs + rowA * 256 + ((chunk ^ (rowA & 15)) << 4) + sub));
                const s16x4 kb = __builtin_amdgcn_ds_read_tr16_b64_v4i16((LAS s16x4*)(KEs + rowB * 256 + ((chunk ^ (rowB & 15)) << 4) + sub));
                const bf16x8 kf = __builtin_shufflevector(ka, kb, 0, 1, 2, 3, 4, 5, 6, 7);
                acc = __builtin_amdgcn_mfma_f32_16x16x32_bf16(kf, vf[jp], acc, 0, 0, 0);
            }
            st[dt] = acc;
        }
#pragma unroll
        for (int it = 0; it < 4; ++it) {
            const int i = 16 * it + li;
            const int s = dir ? (Sq - 1 - (64 * c + i)) : (64 * c + i);
            *(uint2*)(Oout + ((size_t)dir * Ttot + tok0 + s) * 1024 + hh * 256 + slice * 128 + 16 * wave + 4 * fq) =
                make_uint2(pack2(ot[it][0], ot[it][1]), pack2(ot[it][2], ot[it][3]));
        }
        if (c + 1 < nch) GLA_COMMIT(buf ^ 1);
        __syncthreads();
    }
}
__device__ __forceinline__ void phase_rope_prep(const Args& a, unsigned char* lds) {
    u16* P = (u16*)(a.ws + WS_P);
    const float2* cs = (const float2*)(a.ws + WS_CS);
    const int gt = blockIdx.x * NTHREADS + threadIdx.x, NT = gridDim.x * NTHREADS;
    for (int item = blockIdx.x; item < GLA_NPREP; item += gridDim.x)
        gla_prep_item(P, NP, C_GQ, C_GK, (const float*)(a.ws + WS_GZ), a.wgf, a.bgf, a.wgb, a.bgb, S,
                      a.ws + WS_QD, a.ws + WS_KE, a.ws + WS_AT, (float*)(a.ws + WS_DEC), lds, item);
}

#define ATTN_DECODE(item_) \
    const int nb_per = Sq / 128; \
    const int within = (item_) % nb_per, hh = ((item_) / nb_per) & 7, b = ((item_) / (nb_per * 8)) & 3, pat = (item_) / (nb_per * 32); \
    const int dil = pat == 0 ? 1 : (pat == 1 ? 4 : 16); \
    const int M = Sq / dil; \
    const int r = within % dil, blk = within / dil; \
    const int p0 = blk * 128, kbase = p0 - 64; \
    const size_t tok0 = (size_t)b * Sq;
typedef unsigned attn_u32x4 __attribute__((ext_vector_type(4)));
__device__ __forceinline__ void attn_phase(const u16* __restrict__ P, int ldp, int cq, int ck, int cv, int Sq,
                                           u16* __restrict__ part_o, float* __restrict__ part_lse, int Ttot,
                                           unsigned char* lds, int first, int stride, int nitems) {
    const int tid = TID, lane = tid & 63, wave = tid >> 6, li = lane & 15, fq = lane >> 4;
    unsigned char* Ks = lds;
    unsigned char* Vs = lds + 65536;
    attn_u32x4 kr0, kr1, kr2, kr3, kr4, kr5, kr6, kr7, vr0, vr1, vr2, vr3, vr4, vr5, vr6, vr7;
#define ATTN_LD1(i_, kreg_, vreg_) { const int id_ = tid + 512 * (i_), row_ = id_ >> 4, c_ = id_ & 15; \
        int kp_ = kbase + row_; kp_ = kp_ < 0 ? 0 : (kp_ > M - 1 ? M - 1 : kp_); \
        const size_t t_ = tok0 + r + (size_t)dil * kp_; \
        kreg_ = *(const attn_u32x4*)(P + t_ * ldp + ck + hh * 128 + c_ * 8); vreg_ = *(const attn_u32x4*)(P + t_ * ldp + cv + hh * 128 + c_ * 8); }
#define ATTN_LOAD(item_) do { ATTN_DECODE(item_) \
        ATTN_LD1(0, kr0, vr0) ATTN_LD1(1, kr1, vr1) ATTN_LD1(2, kr2, vr2) ATTN_LD1(3, kr3, vr3) ATTN_LD1(4, kr4, vr4) ATTN_LD1(5, kr5, vr5) ATTN_LD1(6, kr6, vr6) ATTN_LD1(7, kr7, vr7) } while (0)
#define ATTN_ST1(i_, kreg_, vreg_) { const int id_ = tid + 512 * (i_), row_ = id_ >> 4, c_ = id_ & 15; const int off_ = row_ * 256 + ((c_ ^ (row_ & 15)) << 4); \
        *(attn_u32x4*)(Ks + off_) = kreg_; *(attn_u32x4*)(Vs + off_) = vreg_; }
#define ATTN_COMMIT() do { ATTN_ST1(0, kr0, vr0) ATTN_ST1(1, kr1, vr1) ATTN_ST1(2, kr2, vr2) ATTN_ST1(3, kr3, vr3) ATTN_ST1(4, kr4, vr4) ATTN_ST1(5, kr5, vr5) ATTN_ST1(6, kr6, vr6) ATTN_ST1(7, kr7, vr7) } while (0)
    int item = first;
    if (item < nitems) ATTN_LOAD(item);
    for (; item < nitems; item += stride) {
        ATTN_DECODE(item)
        __syncthreads();
        ATTN_COMMIT();
        const int qp = p0 + 16 * wave + li;
        const size_t tq = tok0 + r + (size_t)dil * qp;
        bf16x8 qf[4];
#pragma unroll
        for (int ks = 0; ks < 4; ++ks) qf[ks] = *(const bf16x8*)(P + tq * ldp + cq + hh * 128 + 32 * ks + 8 * fq);
        __syncthreads();
        if (item + stride < nitems) ATTN_LOAD(item + stride);
        const float scale = 0.08838834764831845f;
        float m = -1e30f, l = 0.f;
        f32x4 o[8];
#pragma unroll
        for (int dt = 0; dt < 8; ++dt) o[dt] = (f32x4){0.f, 0.f, 0.f, 0.f};
#pragma unroll 1
        for (int tp = 0; tp < 5; ++tp) {
            float s[8]; bool ok[8];
#pragma unroll
            for (int h2 = 0; h2 < 2; ++h2) {
                const int kk0 = 16 * wave + 16 * (2 * tp + h2);
                int krow = kk0 + li; krow = krow > 255 ? 255 : krow;
                f32x4 acc = (f32x4){0.f, 0.f, 0.f, 0.f};
#pragma unroll
                for (int ks = 0; ks < 4; ++ks) {
                    const bf16x8 kf = *(const bf16x8*)(Ks + krow * 256 + (((4 * ks + fq) ^ (krow & 15)) << 4));
                    acc = __builtin_amdgcn_mfma_f32_16x16x32_bf16(kf, qf[ks], acc, 0, 0, 0);
                }
#pragma unroll
                for (int j = 0; j < 4; ++j) {
                    const int kp = kbase + kk0 + 4 * fq + j;
                    const int rel = kp - qp;
                    ok[4 * h2 + j] = (kp >= 0) && (kp < M) && (rel <= 64) && (rel >= -64);
                    s[4 * h2 + j] = acc[j] * scale;
                }
            }
            float mx = -1e30f;
#pragma unroll
            for (int j = 0; j < 8; ++j) mx = ok[j] ? fmaxf(mx, s[j]) : mx;
            mx = fmaxf(mx, __shfl_xor(mx, 16));
            mx = fmaxf(mx, __shfl_xor(mx, 32));
            const float mn = fmaxf(m, mx);
            const float al = __expf(m - mn);
            float ps = 0.f; float p[8];
#pragma unroll
            for (int j = 0; j < 8; ++j) { p[j] = ok[j] ? __expf(s[j] - mn) : 0.f; ps += p[j]; }
            l = l * al + ps; m = mn;
            const attn_u32x4 p_ = {pack2(p[0], p[1]), pack2(p[2], p[3]), pack2(p[4], p[5]), pack2(p[6], p[7])};
            const bf16x8 pf = __builtin_bit_cast(bf16x8, p_);
#pragma unroll
            for (int dt = 0; dt < 8; ++dt) o[dt] *= al;
            int rowA = 16 * wave + 32 * tp + 4 * fq + (li >> 2); rowA = rowA > 255 ? 255 : rowA;
            int rowB = 16 * wave + 32 * tp + 16 + 4 * fq + (li >> 2); rowB = rowB > 255 ? 255 : rowB;
#pragma unroll
            for (int dt = 0; dt < 8; ++dt) {
                const int chunk = 2 * dt + ((li & 3) >> 1), sub = ((li & 3) & 1) * 8;
                const s16x4 va = __builtin_amdgcn_ds_read_tr16_b64_v4i16((LAS s16x4*)(Vs + rowA * 256 + ((chunk ^ (rowA & 15)) << 4) + sub));
                const s16x4 vb = __builtin_amdgcn_ds_read_tr16_b64_v4i16((LAS s16x4*)(Vs + rowB * 256 + ((chunk ^ (rowB & 15)) << 4) + sub));
                const bf16x8 vf = __builtin_shufflevector(va, vb, 0, 1, 2, 3, 4, 5, 6, 7);
                o[dt] = __builtin_amdgcn_mfma_f32_16x16x32_bf16(vf, pf, o[dt], 0, 0, 0);
            }
        }
        l += __shfl_xor(l, 16);
        l += __shfl_xor(l, 32);
        const float inv = 1.f / l;
        u16* orow = part_o + ((size_t)pat * Ttot + tq) * 1024 + hh * 128 + 4 * fq;
#pragma unroll
        for (int dt = 0; dt < 8; ++dt)
            *(uint2*)(orow + 16 * dt) = make_uint2(pack2(o[dt][0] * inv, o[dt][1] * inv), pack2(o[dt][2] * inv, o[dt][3] * inv));
        if (fq == 0) part_lse[((size_t)pat * Ttot + tq) * 8 + hh] = m + logf(l);
    }
#undef ATTN_LD1
#undef ATTN_LOAD
#undef ATTN_ST1
#undef ATTN_COMMIT
}

__device__ __forceinline__ void attn_merge_token(const u16* __restrict__ part_o, const float* __restrict__ part_lse, int Ttot, size_t t,
                                                 u16* __restrict__ dst  , int lane) {
    const int hh = lane >> 3;
    const float l0 = part_lse[((size_t)0 * Ttot + t) * 8 + hh], l1 = part_lse[((size_t)1 * Ttot + t) * 8 + hh], l2 = part_lse[((size_t)2 * Ttot + t) * 8 + hh];
    const float mx = fmaxf(l0, fmaxf(l1, l2));
    const float e0 = __expf(l0 - mx), e1 = __expf(l1 - mx), e2 = __expf(l2 - mx);
    const float inv = 1.f / (e0 + e1 + e2);
    const float w[3] = {e0 * inv, e1 * inv, e2 * inv};
    float acc[16];
#pragma unroll
    for (int i = 0; i < 16; ++i) acc[i] = 0.f;
#pragma unroll
    for (int p = 0; p < 3; ++p) {
        const uint4* src = (const uint4*)(part_o + ((size_t)p * Ttot + t) * 1024 + lane * 16);
        const uint4 a = src[0], bb = src[1];
        acc[0] += w[p] * lo2f(a.x); acc[1] += w[p] * hi2f(a.x); acc[2] += w[p] * lo2f(a.y); acc[3] += w[p] * hi2f(a.y);
        acc[4] += w[p] * lo2f(a.z); acc[5] += w[p] * hi2f(a.z); acc[6] += w[p] * lo2f(a.w); acc[7] += w[p] * hi2f(a.w);
        acc[8] += w[p] * lo2f(bb.x); acc[9] += w[p] * hi2f(bb.x); acc[10] += w[p] * lo2f(bb.y); acc[11] += w[p] * hi2f(bb.y);
        acc[12] += w[p] * lo2f(bb.z); acc[13] += w[p] * hi2f(bb.z); acc[14] += w[p] * lo2f(bb.w); acc[15] += w[p] * hi2f(bb.w);
    }
    uint4* d = (uint4*)(dst + lane * 16);
    d[0] = make_uint4(pack2(acc[0], acc[1]), pack2(acc[2], acc[3]), pack2(acc[4], acc[5]), pack2(acc[6], acc[7]));
    d[1] = make_uint4(pack2(acc[8], acc[9]), pack2(acc[10], acc[11]), pack2(acc[12], acc[13]), pack2(acc[14], acc[15]));
}

__device__ __forceinline__ void phase_mixers(const Args& a, unsigned char* lds) {
    const int bi = blockIdx.x, G = gridDim.x;
    if (bi < 64) {
        gla_seq_item((const u16*)(a.ws + WS_P), NP, C_GV, S, a.ws + WS_QD, a.ws + WS_KE, a.ws + WS_AT, (const float*)(a.ws + WS_DEC),
                     (u16*)(a.ws + WS_OFB), T, lds, bi);
    } else {
        u16* part_o = (u16*)a.out; float* part_lse = (float*)((unsigned char*)a.out + (size_t)3 * T * 1024 * 2);
        attn_phase((const u16*)(a.ws + WS_P), NP, C_DQ, C_DK, C_DV, S, part_o, part_lse, T, lds, bi - 64, G - 64, 3 * 4 * 8 * (S / 128));
    }
}

__device__ __forceinline__ void phase_gla_fin(const Args& a) {
    const u16* Of = (const u16*)(a.ws + WS_OFB);
    const u16* Ob = Of + (size_t)T * 1024;
    const u16* P = (const u16*)(a.ws + WS_P);
    u16* A2 = (u16*)(a.ws + WS_ACT);
    const u16* part_o = (const u16*)a.out; const float* part_lse = (const float*)((const unsigned char*)a.out + (size_t)3 * T * 1024 * 2);
    const int lane = threadIdx.x & 63, wave = threadIdx.x >> 6;
    const int gw = blockIdx.x * NWAVES + wave, NGW = gridDim.x * NWAVES;
    const int hh = lane >> 4;
    float gg[16];
#pragma unroll
    for (int k = 0; k < 4; ++k) { const float4 g4 = *(const float4*)(a.g_gla + lane * 16 + 4 * k); gg[4 * k] = g4.x; gg[4 * k + 1] = g4.y; gg[4 * k + 2] = g4.z; gg[4 * k + 3] = g4.w; }
    for (int t = gw; t < T; t += NGW) {
        const uint4* fp = (const uint4*)(Of + (size_t)t * 1024 + lane * 16); const uint4* bp = (const uint4*)(Ob + (size_t)t * 1024 + lane * 16);
        const uint4* rp = (const uint4*)(P + (size_t)t * NP + C_GR + lane * 16);
        const uint4 f0 = fp[0], f1 = fp[1], b0 = bp[0], b1 = bp[1], r0 = rp[0], r1 = rp[1];
        attn_merge_token(part_o, part_lse, T, (size_t)t, A2 + (size_t)t * D + 1024, lane);
        const unsigned fw[8] = {f0.x, f0.y, f0.z, f0.w, f1.x, f1.y, f1.z, f1.w}, bw[8] = {b0.x, b0.y, b0.z, b0.w, b1.x, b1.y, b1.z, b1.w};
        const unsigned rw[8] = {r0.x, r0.y, r0.z, r0.w, r1.x, r1.y, r1.z, r1.w};
        float o[16]; float ss = 0.f;
#pragma unroll
        for (int k = 0; k < 8; ++k) { o[2 * k] = lo2f(fw[k]) + lo2f(bw[k]); o[2 * k + 1] = hi2f(fw[k]) + hi2f(bw[k]); ss += o[2 * k] * o[2 * k] + o[2 * k + 1] * o[2 * k + 1]; }
        ss += __shfl_xor(ss, 1); ss += __shfl_xor(ss, 2); ss += __shfl_xor(ss, 4); ss += __shfl_xor(ss, 8);
        const float rstd = rsqrtf(ss * (1.f / 256.f) + NORM_EPS);
        unsigned y[8];
#pragma unroll
        for (int k = 0; k < 8; ++k) y[k] = pack2(o[2 * k] * rstd * gg[2 * k] * silu_f(lo2f(rw[k])), o[2 * k + 1] * rstd * gg[2 * k + 1] * silu_f(hi2f(rw[k])));
        uint4* dp = (uint4*)(A2 + (size_t)t * D + lane * 16);
        dp[0] = make_uint4(y[0], y[1], y[2], y[3]); dp[1] = make_uint4(y[4], y[5], y[6], y[7]);
    }
    (void)hh;
}

typedef float f32x16 __attribute__((ext_vector_type(16)));
#define RT_CE(a_, b_) do { const float hi_ = fmaxf(a_, b_), lo_ = fminf(a_, b_); a_ = hi_; b_ = lo_; } while (0)
template <int N> __device__ __forceinline__ void rt_sort_desc(float (&v)[N], int base) {
#pragma unroll
    for (int k = 2; k <= 16; k <<= 1)
#pragma unroll
        for (int j = k >> 1; j > 0; j >>= 1)
#pragma unroll
            for (int i = 0; i < 16; ++i) {
                const int l = i ^ j;
                if (l > i) { if ((i & k) == 0) RT_CE(v[base + i], v[base + l]); else RT_CE(v[base + l], v[base + i]); }
            }
}
template <int N> __device__ __forceinline__ void rt_merge_desc(float (&v)[N], int a, int b) {
#pragma unroll
    for (int i = 0; i < 16; ++i) v[a + i] = fmaxf(v[a + i], v[b + 15 - i]);
#pragma unroll
    for (int j = 8; j > 0; j >>= 1)
#pragma unroll
        for (int i = 0; i < 16; ++i) { const int l = i ^ j; if (l > i) RT_CE(v[a + i], v[a + l]); }
}

__device__ __forceinline__ void route_stage_keys(const float* __restrict__ subk, int hh, unsigned char* lds) {
    const int tid = TID;
    __syncthreads();
    for (int e = tid; e < 2 * 128 * 16; e += 512) {
        const int c = e & 15, row = e >> 4;
        const float* src = subk + ((size_t)(hh * 2) * 128 + row) * 128 + c * 8;
        const float4 v0 = *(const float4*)src, v1 = *(const float4*)(src + 4);
        *(uint4*)(lds + row * 256 + ((c ^ (row & 15)) << 4)) = make_uint4(pack2(v0.x, v0.y), pack2(v0.z, v0.w), pack2(v1.x, v1.y), pack2(v1.z, v1.w));
    }
    __syncthreads();
}

__device__ __forceinline__ void route_tile(const u16* __restrict__ Q, int ldq, int hh, int tok_base, const unsigned char* lds,
                                           int* __restrict__ IDX, float* __restrict__ GATE) {
    const int lane = TID & 63, r = lane & 31, h = lane >> 5;
    float sc[128];
    {
        f32x16 X[4], Y[4];
#pragma unroll
        for (int kt = 0; kt < 4; ++kt) {
#pragma unroll
            for (int i = 0; i < 16; ++i) { X[kt][i] = 0.f; Y[kt][i] = 0.f; }
        }
        const u16* qrow = Q + (size_t)(tok_base + r) * ldq + hh * 256;
#pragma unroll
        for (int half = 0; half < 2; ++half) {
            bf16x8 qf[8];
#pragma unroll
            for (int ks = 0; ks < 8; ++ks) qf[ks] = *(const bf16x8*)(qrow + half * 128 + 16 * ks + 8 * h);
#pragma unroll
            for (int kt = 0; kt < 4; ++kt) {
                const int krow = half * 128 + 32 * kt + r;
#pragma unroll
                for (int ks = 0; ks < 8; ++ks) {
                    const bf16x8 kf = *(const bf16x8*)(lds + krow * 256 + (((2 * ks + h) ^ (krow & 15)) << 4));
                    if (half == 0) X[kt] = __builtin_amdgcn_mfma_f32_32x32x16_bf16(kf, qf[ks], X[kt], 0, 0, 0);
                    else Y[kt] = __builtin_amdgcn_mfma_f32_32x32x16_bf16(kf, qf[ks], Y[kt], 0, 0, 0);
                }
            }
        }
#pragma unroll
        for (int kt = 0; kt < 4; ++kt)
#pragma unroll
            for (int i = 0; i < 16; ++i) {
                const auto sw = __builtin_amdgcn_permlane32_swap(__float_as_uint(X[kt][i]), __float_as_uint(Y[kt][i]), false, false);
                const int key0 = 32 * kt + (i & 3) + 8 * (i >> 2);
                sc[kt * 32 + i] = __uint_as_float((sw[0] & 0xffffff80u) | (unsigned)key0);
                sc[kt * 32 + 16 + i] = __uint_as_float((sw[1] & 0xffffff80u) | (unsigned)(key0 + 4));
            }
    }
#pragma unroll
    for (int g = 0; g < 8; ++g) rt_sort_desc(sc, 16 * g);
    rt_merge_desc(sc, 0, 16); rt_merge_desc(sc, 32, 48); rt_merge_desc(sc, 64, 80); rt_merge_desc(sc, 96, 112);
    rt_merge_desc(sc, 0, 32); rt_merge_desc(sc, 64, 96);
    rt_merge_desc(sc, 0, 64);
    float l0[16], l1[16];
#pragma unroll
    for (int i = 0; i < 16; ++i) {
        const auto sw = __builtin_amdgcn_permlane32_swap(__float_as_uint(sc[i]), __float_as_uint(sc[i]), false, false);
        l0[i] = __uint_as_float(sw[0]); l1[i] = __uint_as_float(sw[1]);
    }
    float s0[16], s1[16]; int k0[16], k1[16];
#pragma unroll
    for (int i = 0; i < 16; ++i) {
        const unsigned a = __float_as_uint(l0[i]), b = __float_as_uint(l1[i]);
        s0[i] = __uint_as_float(a & 0xffffff80u); k0[i] = (int)(a & 0x7fu);
        s1[i] = __uint_as_float(b & 0xffffff80u); k1[i] = (int)(b & 0x7fu);
    }
    float cs[64];
    {
        int n = 0;
#pragma unroll
        for (int i = 0; i < 16; ++i)
#pragma unroll
            for (int j = 0; j < 16; ++j)
                if ((i + 1) * (j + 1) <= 16) { cs[n] = s0[i] + s1[j]; ++n; }
#pragma unroll
        for (int q = 50; q < 64; ++q) cs[q] = -3.0e38f;
    }
    float ct[64];
#pragma unroll
    for (int q = 0; q < 64; ++q) ct[q] = cs[q];
#pragma unroll
    for (int g = 0; g < 4; ++g) rt_sort_desc(ct, 16 * g);
    rt_merge_desc(ct, 0, 16); rt_merge_desc(ct, 32, 48); rt_merge_desc(ct, 0, 32);
    const float theta = ct[15], smax = ct[0];
    float den = 0.f;
    {
        int cnt = 0;
#pragma unroll
        for (int q = 0; q < 50; ++q) { const bool sel = (cs[q] >= theta) && (cnt < 16); den += sel ? __expf(cs[q] - smax) : 0.f; cnt += sel ? 1 : 0; }
    }
    const float inv = 1.f / den;
    const size_t obase = (size_t)(tok_base + r) * 128 + hh * 16;
    int pos = 0;
    {
        int n = 0;
#pragma unroll
        for (int i = 0; i < 16; ++i)
#pragma unroll
            for (int j = 0; j < 16; ++j)
                if ((i + 1) * (j + 1) <= 16) {
                    const bool sel = (cs[n] >= theta) && (pos < 16);
                    if (sel) {
                        if (h == 0) IDX[obase + pos] = k0[i] * 128 + k1[j];
                        else GATE[obase + pos] = __expf(cs[n] - smax) * inv;
                        ++pos;
                    }
                    ++n;
                }
    }
}
__device__ __forceinline__ void phase_route(const Args& a, unsigned char* lds) {
    const int hh = BID & 7, grp = BID >> 3, ngrp = GDIM >> 3, wave = TID >> 6;
    route_stage_keys(a.subk, hh, lds);
    int j = 0;
    for (int tile = grp; tile < T / 32; tile += ngrp, ++j)
        if ((j & 7) == wave) route_tile((const u16*)(a.ws + WS_Q), D, hh, tile * 32, lds, (int*)(a.ws + WS_IDX), (float*)(a.ws + WS_GATE));
    __syncthreads();
}

typedef __bf16 bf16x2_t __attribute__((ext_vector_type(2)));
__device__ __forceinline__ float dot2bf(unsigned w, unsigned x, float acc) {
    return __builtin_amdgcn_fdot2_f32_bf16(__builtin_bit_cast(bf16x2_t, w), __builtin_bit_cast(bf16x2_t, x), acc, false);
}
constexpr int TROW = 1152;
typedef float f32x2_t __attribute__((ext_vector_type(2)));
__device__ __forceinline__ void convert_tables(const Args& a) {
    const int lane = threadIdx.x & 63, wave = threadIdx.x >> 6;
    const int gw = blockIdx.x * NWAVES + wave, NGW = gridDim.x * NWAVES;
    for (int row = gw; row < 2 * 16384; row += NGW) {
        const bool isv = row >= 16384; const int e = isv ? row - 16384 : row;
        const f32x4* sp = (const f32x4*)((isv ? a.pv : a.pu) + (size_t)e * D);
        unsigned char* dst = a.ws + (isv ? WS_TV : WS_TU) + (size_t)e * TROW;
        f32x4 v[8];
#pragma unroll
        for (int k = 0; k < 8; ++k) v[k] = __builtin_nontemporal_load(sp + lane + 64 * k);
#pragma unroll
        for (int k = 0; k < 8; ++k) {
            float mx = fmaxf(fmaxf(fabsf(v[k][0]), fabsf(v[k][1])), fmaxf(fabsf(v[k][2]), fabsf(v[k][3])));
            mx = fmaxf(mx, __shfl_xor(mx, 1)); mx = fmaxf(mx, __shfl_xor(mx, 2)); mx = fmaxf(mx, __shfl_xor(mx, 4));
            float s = mx * (isv ? (1.f / 6.f) : (1.f / 7.f)); s = (s > 0.f) ? s : 1.f;
            u16 sb = f2bf(s); if (bf2f(sb) < s) sb += 1;
            const float inv = 1.f / bf2f(sb);
            unsigned p = 0u;
            if (isv) {
                p = __builtin_amdgcn_cvt_scalef32_pk_fp4_f32(p, v[k][0] * inv, v[k][1] * inv, 1.0f, 0);
                p = __builtin_amdgcn_cvt_scalef32_pk_fp4_f32(p, v[k][2] * inv, v[k][3] * inv, 1.0f, 1);
            } else {
#pragma unroll
                for (int j = 0; j < 4; ++j) { int q = (int)rintf(v[k][j] * inv) + 8; q = q < 1 ? 1 : (q > 15 ? 15 : q); p |= (unsigned)q << (4 * j); }
            }
            const int i = lane + 64 * k;
            *(u16*)(dst + 2 * i) = (u16)p;
            if ((lane & 7) == 0) *(u16*)(dst + 1024 + 2 * (i >> 3)) = sb;
        }
    }
}

__device__ __forceinline__ int idot32_i4(const uint4 w, const int (&hq)[8]) {
    const unsigned ww[4] = {w.x, w.y, w.z, w.w};
    int acc = 0;
#pragma unroll
    for (int k = 0; k < 4; ++k) {
        acc = __builtin_amdgcn_sdot4((int)(ww[k] & 0x0f0f0f0fu), hq[2 * k], acc, false);
        acc = __builtin_amdgcn_sdot4((int)((ww[k] >> 4) & 0x0f0f0f0fu), hq[2 * k + 1], acc, false);
    }
    return acc;
}
__device__ __forceinline__ void axpy32_fp4(const uint4 w, const float s, float (&acc)[32]) {
    const unsigned ww[4] = {w.x, w.y, w.z, w.w};
#pragma unroll
    for (int k = 0; k < 4; ++k) {
        const f32x2_t a0 = __builtin_amdgcn_cvt_scalef32_pk_f32_fp4(ww[k], 1.0f, 0), a1 = __builtin_amdgcn_cvt_scalef32_pk_f32_fp4(ww[k], 1.0f, 1);
        const f32x2_t a2 = __builtin_amdgcn_cvt_scalef32_pk_f32_fp4(ww[k], 1.0f, 2), a3 = __builtin_amdgcn_cvt_scalef32_pk_f32_fp4(ww[k], 1.0f, 3);
        acc[8 * k + 0] += s * a0.x; acc[8 * k + 1] += s * a0.y; acc[8 * k + 2] += s * a1.x; acc[8 * k + 3] += s * a1.y;
        acc[8 * k + 4] += s * a2.x; acc[8 * k + 5] += s * a2.y; acc[8 * k + 6] += s * a3.x; acc[8 * k + 7] += s * a3.y;
    }
}
__device__ __forceinline__ void phase_experts(const Args& a) {
    const u16* H2 = (const u16*)(a.ws + WS_ACT);
    const u16* X1 = (const u16*)(a.ws + WS_X1);
    const int* IDX = (const int*)(a.ws + WS_IDX);
    const float* GATE = (const float*)(a.ws + WS_GATE);
    const float* mod = (const float*)(a.ws + WS_MOD);
    const unsigned char* U = a.ws + WS_TU; const unsigned char* V = a.ws + WS_TV;
    const int lane = threadIdx.x & 63, wave = threadIdx.x >> 6;
    const int gw = blockIdx.x * NWAVES + wave, NGW = gridDim.x * NWAVES;
    int iv0 = 0, iv1 = 0; float gv0 = 0.f, gv1 = 0.f;
    int niv0 = 0, niv1 = 0; float ngv0 = 0.f, ngv1 = 0.f;
    uint4 rA[4], rB[4]; u16 sA[4], sB[4];
#define ROW_LOAD(TB_, r_, s_, r0_) do { _Pragma("unroll") for (int q = 0; q < 4; ++q) { \
            const int rr_ = (r0_) + q; const int e_ = __builtin_amdgcn_readlane(rr_ < 64 ? iv0 : iv1, rr_ & 63); \
            const unsigned char* rp_ = TB_ + (size_t)e_ * TROW; \
            r_[q] = *(const uint4*)(rp_ + lane * 16); s_[q] = *(const u16*)(rp_ + 1024 + lane * 2); } } while (0)
#define TOK_FETCH(t_, i0_, i1_, g0_, g1_) do { \
            i0_ = IDX[(size_t)(t_) * 128 + lane]; i1_ = IDX[(size_t)(t_) * 128 + 64 + lane]; \
            g0_ = GATE[(size_t)(t_) * 128 + lane]; g1_ = GATE[(size_t)(t_) * 128 + 64 + lane]; } while (0)
    if (gw < T) { TOK_FETCH(gw, iv0, iv1, gv0, gv1); ROW_LOAD(U, rA, sA, 0); }
    for (int t = gw; t < T; t += NGW) {
        const int b = t / S;
        const bool has_next = (t + NGW) < T;
        int hq[8]; int hsum8; float sh;
        {
            float h[32];
            const uint4* hp = (const uint4*)(H2 + (size_t)t * D + lane * 32);
#pragma unroll
            for (int k = 0; k < 4; ++k) { const uint4 p = hp[k];
                h[8 * k + 0] = lo2f(p.x); h[8 * k + 1] = hi2f(p.x); h[8 * k + 2] = lo2f(p.y); h[8 * k + 3] = hi2f(p.y);
                h[8 * k + 4] = lo2f(p.z); h[8 * k + 5] = hi2f(p.z); h[8 * k + 6] = lo2f(p.w); h[8 * k + 7] = hi2f(p.w); }
            float mx = 0.f;
#pragma unroll
            for (int i = 0; i < 32; ++i) mx = fmaxf(mx, fabsf(h[i]));
            sh = (mx > 0.f) ? mx * (1.f / 127.f) : 1.f;
            const float inv = 1.f / sh;
            int hs = 0;
#pragma unroll
            for (int k = 0; k < 4; ++k)
#pragma unroll
                for (int par = 0; par < 2; ++par) {
                    const int q0 = (int)rintf(h[8 * k + par] * inv), q1 = (int)rintf(h[8 * k + 2 + par] * inv), q2 = (int)rintf(h[8 * k + 4 + par] * inv), q3 = (int)rintf(h[8 * k + 6 + par] * inv);
                    hs += q0 + q1 + q2 + q3;
                    hq[2 * k + par] = (q0 & 0xff) | ((q1 & 0xff) << 8) | ((q2 & 0xff) << 16) | ((int)((unsigned)(q3 & 0xff) << 24));
                }
            hsum8 = 8 * hs;
        }
        float a0 = 0.f, a1 = 0.f;
#define U_COMPUTE(r_, s_, r0_) do { float d_[4]; \
            _Pragma("unroll") for (int q = 0; q < 4; ++q) d_[q] = (float)(idot32_i4(r_[q], hq) - hsum8) * (bf2f(s_[q]) * sh); \
            _Pragma("unroll") for (int o = 32; o > 0; o >>= 1) { _Pragma("unroll") for (int q = 0; q < 4; ++q) d_[q] += __shfl_xor(d_[q], o); } \
            _Pragma("unroll") for (int q = 0; q < 4; ++q) { const int rr_ = (r0_) + q; \
                if (rr_ < 64) a0 = (lane == rr_) ? d_[q] : a0; else a1 = (lane == rr_ - 64) ? d_[q] : a1; } } while (0)
#pragma unroll 1
        for (int r0 = 0; r0 < 128; r0 += 8) {
            ROW_LOAD(U, rB, sB, r0 + 4);
            U_COMPUTE(rA, sA, r0);
            if (r0 + 8 < 128) ROW_LOAD(U, rA, sA, r0 + 8); else ROW_LOAD(V, rA, sA, 0);
            U_COMPUTE(rB, sB, r0 + 4);
        }
        const float w0 = gv0 * gelu_f(a0), w1 = gv1 * gelu_f(a1);
        float acc[32];
#pragma unroll
        for (int i = 0; i < 32; ++i) acc[i] = 0.f;
#define V_COMPUTE(r_, s_, r0_) do { _Pragma("unroll") for (int q = 0; q < 4; ++q) { const int rr_ = (r0_) + q; \
                const float g_ = __builtin_bit_cast(float, __builtin_amdgcn_readlane(__builtin_bit_cast(int, rr_ < 64 ? w0 : w1), rr_ & 63)); \
                axpy32_fp4(r_[q], g_ * bf2f(s_[q]), acc); } } while (0)
        if (has_next) TOK_FETCH(t + NGW, niv0, niv1, ngv0, ngv1);
#pragma unroll 1
        for (int r0 = 0; r0 < 128; r0 += 8) {
            ROW_LOAD(V, rB, sB, r0 + 4);
            V_COMPUTE(rA, sA, r0);
            if (r0 + 8 < 128) ROW_LOAD(V, rA, sA, r0 + 8);
            else if (has_next) { iv0 = niv0; iv1 = niv1; gv0 = ngv0; gv1 = ngv1; ROW_LOAD(U, rA, sA, 0); }
            V_COMPUTE(rB, sB, r0 + 4);
        }
#undef U_COMPUTE
#undef V_COMPUTE
        float ss = 0.f;
#pragma unroll
        for (int k = 0; k < 8; ++k) {
            const int c0 = lane * 32 + 4 * k;
            const uint2 xp = *(const uint2*)(X1 + (size_t)t * D + c0);
            const float4 xa = make_float4(lo2f(xp.x), hi2f(xp.x), lo2f(xp.y), hi2f(xp.y));
            const float4 ga = *(const float4*)(mod + b * 12288 + 5 * 2048 + c0);
            acc[4 * k + 0] = xa.x + ga.x * acc[4 * k + 0]; acc[4 * k + 1] = xa.y + ga.y * acc[4 * k + 1];
            acc[4 * k + 2] = xa.z + ga.z * acc[4 * k + 2]; acc[4 * k + 3] = xa.w + ga.w * acc[4 * k + 3];
#pragma unroll
            for (int i = 0; i < 4; ++i) ss += acc[4 * k + i] * acc[4 * k + i];
        }
        ss = wave_sum(ss);
        const float rstd = rsqrtf(ss * (1.f / D) + NORM_EPS);
#pragma unroll
        for (int k = 0; k < 8; ++k) {
            const int c0 = lane * 32 + 4 * k;
            const float4 gf = *(const float4*)(a.g_fin + c0);
            *(float4*)(a.out + (size_t)t * D + c0) = make_float4(acc[4 * k + 0] * rstd * gf.x, acc[4 * k + 1] * rstd * gf.y, acc[4 * k + 2] * rstd * gf.z, acc[4 * k + 3] * rstd * gf.w);
        }
    }
#undef ROW_LOAD
#undef TOK_FETCH
}

#define XB_TMO      128
#define XB_XCNT(j)  (256  + 64 * (j))
#define XB_XSUB(j)  (1280 + 64 * (j))
#define XB_XGEN(j)  (2304 + 64 * (j))
#define XB_TOP      3328
#define XB_TOPGEN   3392
#define XCD_BAR_WORDS 3456
#define XB_SPIN_CAP (1u << 18)

__device__ __forceinline__ unsigned xb_ld(unsigned* p)              { return __hip_atomic_load(p, __ATOMIC_RELAXED, __HIP_MEMORY_SCOPE_AGENT); }
__device__ __forceinline__ unsigned xb_add(unsigned* p, unsigned v) { return __hip_atomic_fetch_add(p, v, __ATOMIC_RELAXED, __HIP_MEMORY_SCOPE_AGENT); }
__device__ __forceinline__ unsigned xb_xcc_id() { return (unsigned)__builtin_amdgcn_s_getreg((3 << 11) | 20) & 0xFu; }
#define XB_SPIN(cond, bar) do { unsigned _sp = 0; while (cond) { __builtin_amdgcn_s_sleep(1); \
    if ((++_sp & 255u) == 0u) { if (xb_ld(&(bar)[XB_TMO])) break; if (_sp > XB_SPIN_CAP) { atomicAdd(&(bar)[XB_TMO], 1u); break; } } } } while (0)

struct XcdBarrier {
    unsigned* bar; unsigned x;
    volatile LAS unsigned* st;
};

__device__ __forceinline__ XcdBarrier xcd_barrier_post(unsigned* bar, volatile LAS unsigned* st) {
    XcdBarrier b; b.bar = bar; b.x = xb_xcc_id(); b.st = st;
    if (threadIdx.x == 0) (void)xb_add(&bar[XB_XCNT(b.x)], 1u);
    return b;
}
__device__ __forceinline__ void xcd_barrier_complete(unsigned* bar, unsigned x, unsigned& nloc, unsigned& nx) {
    const unsigned G = gridDim.x * gridDim.y * gridDim.z;
    unsigned sum, cnt, mine, sp = 0u;
    for (;;) {
        sum = 0u; cnt = 0u; mine = 0u;
#pragma unroll
        for (unsigned j = 0; j < 16; ++j) { const unsigned c = xb_ld(&bar[XB_XCNT(j)]); sum += c; cnt += (c > 0u) ? 1u : 0u; mine = (j == x) ? c : mine; }
        if (sum == G) break;
        __builtin_amdgcn_s_sleep(1);
        if ((++sp & 255u) == 0u) { if (xb_ld(&bar[XB_TMO])) break; if (sp > XB_SPIN_CAP) { atomicAdd(&bar[XB_TMO], 1u); break; } }
    }
    nloc = mine > 0u ? mine : 1u; nx = cnt > 0u ? cnt : 1u;
}

__device__ __forceinline__ void xcd_barrier(const XcdBarrier& b) {
    asm volatile("s_waitcnt vmcnt(0)" ::: "memory");
    __syncthreads();
    if (threadIdx.x == 0) {
        unsigned* bar = b.bar;
        __builtin_amdgcn_s_waitcnt(0);
        unsigned nloc = b.st[0], nx = b.st[1];
        if (nloc == 0u) { xcd_barrier_complete(bar, b.x, nloc, nx); b.st[0] = nloc; b.st[1] = nx; }
        const unsigned old = xb_add(&bar[XB_XSUB(b.x)], 1u);
        const unsigned gen = old / nloc;
        if (old + 1u == (gen + 1u) * nloc) {
            __builtin_amdgcn_fence(__ATOMIC_RELEASE, "agent");
            asm volatile("s_waitcnt vmcnt(0)" ::: "memory");
            const unsigned og = xb_add(&bar[XB_TOP], 1u);
            const unsigned tg = og / nx;
            if (og + 1u == (tg + 1u) * nx) xb_add(&bar[XB_TOPGEN], 1u);
            else XB_SPIN(xb_ld(&bar[XB_TOPGEN]) == tg, bar);
            __builtin_amdgcn_fence(__ATOMIC_ACQUIRE, "agent");
            xb_add(&bar[XB_XGEN(b.x)], 1u);
            asm volatile("s_waitcnt vmcnt(0)" ::: "memory");
        } else {
            XB_SPIN(xb_ld(&bar[XB_XGEN(b.x)]) == gen, bar);
            __builtin_amdgcn_fence(__ATOMIC_ACQUIRE, "agent");
            asm volatile("s_waitcnt vmcnt(0)" ::: "memory");
        }
    }
    __syncthreads();
}

constexpr int NPHASES = 11;
__global__ void __launch_bounds__(NTHREADS, 2) mk_fwd(Args a) {
    extern __shared__ __attribute__((aligned(16))) unsigned char lds[];
    cg::grid_group grid = cg::this_grid();
    const int lo = a.ph_lo, hi = a.ph_hi;
    volatile LAS unsigned* xbw = (volatile LAS unsigned*)(lds + LDS_MAIN);
    if (threadIdx.x < 4) xbw[threadIdx.x] = 0u;
    __syncthreads();
    XcdBarrier xbar = xcd_barrier_post((unsigned*)(a.ws + WS_CTL), xbw);
#define IN(k) (lo <= (k) && (k) < hi)
    if (lo < 0) grid.sync();
#define SEAM(k) do { if (IN(k) && IN((k) + 1)) xcd_barrier(xbar); } while (0)
    const float* mod = (const float*)(a.ws + WS_MOD);
    if (IN(0)) phase0(a, lds);
    SEAM(0);
    if (IN(1)) norm_mod_phase<false>(a.x, a.g_mix, mod, 0, 1, (u16*)(a.ws + WS_ACT));
    SEAM(1);
    if (IN(2)) { gemm8(lds, (const u16*)(a.ws + WS_ACT), (const u16*)(a.ws + WS_WIN), T, NP, D, EpiProj{(u16*)(a.ws + WS_P), (const float*)(a.ws + WS_CS)}); gz_phase(lds, (const u16*)(a.ws + WS_ACT), (const u16*)(a.ws + WS_WIN) + (size_t)NP * D, (float*)(a.ws + WS_GZ)); }
    SEAM(2);
    if (IN(3)) phase_rope_prep(a, lds);
    SEAM(3);
    if (IN(4)) phase_mixers(a, lds);
    SEAM(4);
    if (IN(5)) phase_gla_fin(a);
    SEAM(5);
    if (IN(6)) gemm8(lds, (const u16*)(a.ws + WS_ACT), (const u16*)(a.ws + WS_WOUT), T, D, D, EpiResid{a.x, mod, (u16*)(a.ws + WS_X1)});
    SEAM(6);
    if (IN(7)) { norm_mod_phase<true>(a.ws + WS_X1, a.g_ffn, mod, 3, 4, (u16*)(a.ws + WS_ACT)); convert_tables(a); }
    SEAM(7);
    if (IN(8)) gemm8(lds, (const u16*)(a.ws + WS_ACT), (const u16*)(a.ws + WS_WPQ), T, D, D, EpiBf16{(u16*)(a.ws + WS_Q)});
    SEAM(8);
    if (IN(9)) phase_route(a, lds);
    SEAM(9);
    if (IN(10)) phase_experts(a);
#ifdef PROBE_REP10
    grid.sync(); phase_experts(a);
#endif
#ifdef PROBE_REP9
    grid.sync(); phase_route(a, lds); grid.sync(); phase_experts(a);
#endif
#undef IN
#undef SEAM
}

#ifndef MK_ONE_LAUNCH
#define MK_ONE_LAUNCH 1
#endif
extern "C" void kernel_launch(void* const* d_in, const int* in_sizes, int n_in, void* d_out, int out_size, void* d_ws, size_t ws_size, hipStream_t stream) {
    static int grid = 0;
    if (grid == 0) {
        if (n_in != 19 || out_size != T * D || ws_size < WS_END) {
            fprintf(stderr, "kernel_launch: unexpected shapes: n_in %d out %d ws %zu (need %zu)\n", n_in, out_size, ws_size, (size_t)WS_END);
            grid = -1; return;
        }
        int dev = 0, cus = 0, per_cu = 0;
        (void)hipGetDevice(&dev);
        (void)hipDeviceGetAttribute(&cus, hipDeviceAttributeMultiprocessorCount, dev);
        (void)hipFuncSetAttribute((const void*)mk_fwd, hipFuncAttributeMaxDynamicSharedMemorySize, LDS_BYTES);
        (void)hipOccupancyMaxActiveBlocksPerMultiprocessor(&per_cu, (const void*)mk_fwd, NTHREADS, LDS_BYTES);
        if (per_cu < 1) { fprintf(stderr, "kernel_launch: occupancy query says %d blocks/CU\n", per_cu); grid = -1; return; }
        grid = cus;
        (void)hipGetLastError();
    }
    if (grid < 0) return;
    Args a{};
    a.x = (const float*)d_in[0]; a.c = (const float*)d_in[1]; a.pos = (const int*)d_in[2]; a.w_ada = (const float*)d_in[3];
    a.b_ada = (const float*)d_in[4]; a.g_mix = (const float*)d_in[5]; a.w_in = (const float*)d_in[6]; a.wgf = (const float*)d_in[7];
    a.bgf = (const float*)d_in[8]; a.wgb = (const float*)d_in[9]; a.bgb = (const float*)d_in[10]; a.g_gla = (const float*)d_in[11];
    a.w_out = (const float*)d_in[12]; a.g_ffn = (const float*)d_in[13]; a.w_pq = (const float*)d_in[14]; a.subk = (const float*)d_in[15];
    a.pu = (const float*)d_in[16]; a.pv = (const float*)d_in[17]; a.g_fin = (const float*)d_in[18];
    a.out = (float*)d_out; a.ws = (unsigned char*)d_ws;
#if MK_ONE_LAUNCH
    (void)hipMemsetAsync((unsigned char*)d_ws + WS_CTL, 0, XCD_BAR_WORDS * 4, stream);
    a.ph_lo = 0; a.ph_hi = NPHASES;
    void* args[] = {&a};
    hipError_t e = hipLaunchCooperativeKernel((const void*)mk_fwd, dim3(grid), dim3(NTHREADS), args, LDS_BYTES, stream);
    if (e != hipSuccess) fprintf(stderr, "cooperative launch failed: %s (grid %d)\n", hipGetErrorString(e), grid);
#else
    for (int p = 0; p < NPHASES; ++p) {
        a.ph_lo = p; a.ph_hi = p + 1;
        hipLaunchKernelGGL(mk_fwd, dim3(grid), dim3(NTHREADS), LDS_BYTES, stream, a);
    }
#endif
}
```

```cpp
#include <hip/hip_runtime.h>
#include <hip/hip_cooperative_groups.h>
#include <cstdio>
#include <cstdint>

namespace cg = cooperative_groups;

typedef unsigned short u16;
typedef __attribute__((ext_vector_type(8))) short bf16x8;
typedef __attribute__((ext_vector_type(4))) float f32x4;
typedef short s16x4 __attribute__((ext_vector_type(4)));
#define TID ((int)threadIdx.x)
#define BID ((int)blockIdx.x)
#define GDIM ((int)gridDim.x)
#define LAS __attribute__((address_space(3)))

constexpr int D = 2048, NB = 4, S = 4096, T = NB * S;
constexpr int INW = 6176;
constexpr int NP = 6144;
constexpr int NPAD = 6208;
constexpr int C_GQ = 0, C_GK = 512, C_GV = 1024, C_GR = 2048, C_DQ = 3072, C_DK = 4096, C_DV = 5120;
constexpr int NTHREADS = 512, NWAVES = 8;
constexpr int LDS_MAIN = 128 * 1024;
constexpr int LDS_BYTES = LDS_MAIN + 16;
constexpr float NORM_EPS = 1e-6f;

constexpr size_t WS_CTL = 0;
constexpr size_t WS_MOD = 65536;
constexpr size_t WS_CS = 524288;
constexpr size_t WS_WIN = WS_CS + (size_t)T * 64 * 8;
constexpr size_t WS_WOUT = WS_WIN + (size_t)NPAD * D * 2;
constexpr size_t WS_WPQ = WS_WOUT + (size_t)D * D * 2;
constexpr size_t WS_ACT = WS_WPQ + (size_t)D * D * 2;
constexpr size_t WS_P = WS_ACT + (size_t)T * D * 2;
constexpr size_t WS_X1 = WS_P;
constexpr size_t WS_Q = WS_P + (size_t)T * D * 4;
constexpr size_t WS_GZ = WS_P + (size_t)T * NP * 2;
constexpr int GLA_NPREP = NB * 4 * 2 * (S / 64);
constexpr size_t WS_QD = WS_GZ + (size_t)T * 32 * 4;
constexpr size_t WS_KE = WS_QD + (size_t)GLA_NPREP * 16384;
constexpr size_t WS_AT = WS_KE + (size_t)GLA_NPREP * 16384;
constexpr size_t WS_DEC = WS_AT + (size_t)GLA_NPREP * 8192;
constexpr size_t WS_OFB = WS_DEC + (size_t)GLA_NPREP * 512;
constexpr size_t WS_IDX = WS_OFB + (size_t)2 * T * 1024 * 2;
constexpr size_t WS_GATE = WS_IDX + (size_t)T * 128 * 4;
constexpr size_t WS_END = WS_GATE + (size_t)T * 128 * 4;
constexpr size_t WS_TU = WS_QD;
constexpr size_t WS_TV = WS_QD + (size_t)16384 * 1152;
static_assert(WS_TV + (size_t)16384 * 1152 <= WS_IDX, "table region");

struct Args {
    const float* x; const float* c; const int* pos; const float* w_ada; const float* b_ada; const float* g_mix;
    const float* w_in; const float* wgf; const float* bgf; const float* wgb; const float* bgb; const float* g_gla;
    const float* w_out; const float* g_ffn; const float* w_pq; const float* subk; const float* pu; const float* pv; const float* g_fin;
    float* out; unsigned char* ws; int ph_lo, ph_hi;
};

__device__ __forceinline__ float bf2f(u16 h) { return __uint_as_float(((unsigned)h) << 16); }
typedef __bf16 hw_bf16x2 __attribute__((ext_vector_type(2)));
typedef float hw_f32x2 __attribute__((ext_vector_type(2)));
__device__ __forceinline__ unsigned pack2(float a, float b) { const hw_f32x2 f = {a, b}; return __builtin_bit_cast(unsigned, __builtin_convertvector(f, hw_bf16x2)); }
__device__ __forceinline__ u16 f2bf(float f) { return (u16)(pack2(f, 0.f) & 0xffffu); }
__device__ __forceinline__ float lo2f(unsigned p) { return __uint_as_float(p << 16); }
__device__ __forceinline__ float hi2f(unsigned p) { return __uint_as_float(p & 0xffff0000u); }
__device__ __forceinline__ float wave_sum(float v) {
#pragma unroll
    for (int o = 32; o > 0; o >>= 1) v += __shfl_xor(v, o);
    return v;
}
__device__ __forceinline__ float wave_max(float v) {
#pragma unroll
    for (int o = 32; o > 0; o >>= 1) v = fmaxf(v, __shfl_xor(v, o));
    return v;
}
__device__ __forceinline__ float silu_f(float v) { return v / (1.f + __expf(-v)); }
__device__ __forceinline__ float gelu_f(float a) { return 0.5f * a * (1.f + erff(a * 0.70710678118654752f)); }
__device__ __forceinline__ float logsigmoid_f(float z) { return z < 0.f ? z - log1pf(expf(z)) : -log1pf(expf(-z)); }

constexpr int MOD_BLOCKS = 96;
__device__ __forceinline__ void p0_mod(const Args& a, unsigned char* lds, int bi) {
    float* sc = (float*)lds;
    float* red = sc + 4 * 2048;
    const int tid = threadIdx.x, lane = tid & 63, wave = tid >> 6;
    for (int i = tid; i < 4 * 2048; i += NTHREADS) sc[i] = silu_f(a.c[i]);
    __syncthreads();
    const int j0 = bi * 128 + lane * 2;
    float acc[4][2];
#pragma unroll
    for (int b = 0; b < 4; ++b) { acc[b][0] = 0.f; acc[b][1] = 0.f; }
    const int k0 = wave * 256;
#pragma unroll 8
    for (int kk = 0; kk < 256; ++kk) {
        const int k = k0 + kk;
        const float2 w = *(const float2*)(a.w_ada + (size_t)k * 12288 + j0);
#pragma unroll
        for (int b = 0; b < 4; ++b) { const float s = sc[b * 2048 + k]; acc[b][0] += s * w.x; acc[b][1] += s * w.y; }
    }
#pragma unroll
    for (int b = 0; b < 4; ++b) { red[(wave * 4 + b) * 128 + lane * 2] = acc[b][0]; red[(wave * 4 + b) * 128 + lane * 2 + 1] = acc[b][1]; }
    __syncthreads();
    float* mod = (float*)(a.ws + WS_MOD);
    {
        const int b = tid >> 7, jc = tid & 127;
        float s = 0.f;
#pragma unroll
        for (int w = 0; w < 8; ++w) s += red[(w * 4 + b) * 128 + jc];
        mod[b * 12288 + bi * 128 + jc] = s + a.b_ada[bi * 128 + jc];
    }
    __syncthreads();
}

__device__ __forceinline__ void p0_transpose_item(const float* __restrict__ W, int ldw, int k0, int src_col0, int n_valid,
                                                  u16* __restrict__ WT, int ldt, int n_out0, unsigned char* wlds, bool rope_perm = false) {
    u16* tl = (u16*)wlds;
    const int lane = threadIdx.x & 63;
    const int rsub = lane >> 4, nc = (lane & 15) * 4;
    int scol = src_col0 + nc;
    if (rope_perm) { const int p = (n_out0 & 64) + nc, g = p >> 3; scol = (src_col0 - (n_out0 & 64)) + ((p & 4) ? 64 + 4 * g : 4 * g); }
    float4 v[16];
#pragma unroll
    for (int j = 0; j < 16; ++j) {
        const int k = 4 * j + rsub;
        v[j] = (nc < n_valid) ? *(const float4*)(W + (size_t)(k0 + k) * ldw + scol) : make_float4(0.f, 0.f, 0.f, 0.f);
    }
#pragma unroll
    for (int j = 0; j < 16; ++j) {
        const int k = 4 * j + rsub;
        tl[(nc + 0) * 72 + k] = f2bf(v[j].x); tl[(nc + 1) * 72 + k] = f2bf(v[j].y); tl[(nc + 2) * 72 + k] = f2bf(v[j].z); tl[(nc + 3) * 72 + k] = f2bf(v[j].w);
    }
#pragma unroll
    for (int j = 0; j < 8; ++j) {
        const int c = lane + 64 * j, n = c >> 3, kc = (c & 7) * 8;
        const uint4 o = *(const uint4*)(tl + n * 72 + kc);
        *(uint4*)(WT + (size_t)(n_out0 + n) * ldt + k0 + kc) = o;
    }
}

__device__ __forceinline__ void phase0(const Args& a, unsigned char* lds) {
    const int bi = blockIdx.x, G = gridDim.x, tid = threadIdx.x, wave = tid >> 6;
    const bool modblk = (G > MOD_BLOCKS) && (bi < MOD_BLOCKS);
    if (G > MOD_BLOCKS) { if (modblk) p0_mod(a, lds, bi); }
    else { for (int mb = bi; mb < MOD_BLOCKS; mb += G) p0_mod(a, lds, mb); }
    const int nb = (G > MOD_BLOCKS) ? G - MOD_BLOCKS : G, b0 = (G > MOD_BLOCKS) ? bi - MOD_BLOCKS : bi;
    if (!modblk) {
        constexpr int I_IN = 32 * (NPAD / 64), I_SQ = 32 * 32;
        u16* WinT = (u16*)(a.ws + WS_WIN); u16* WoutT = (u16*)(a.ws + WS_WOUT); u16* WpqT = (u16*)(a.ws + WS_WPQ);
        unsigned char* wlds = lds + wave * 9216;
        for (int it = b0 * NWAVES + wave; it < I_IN + 2 * I_SQ; it += nb * NWAVES) {
            if (it < I_IN) {
                const int kt = it & 31, nt = it >> 5;
                const int n0 = nt * 64;
                int src, nv;
                if (n0 < 3072) { src = n0; nv = 64; }
                else if (n0 < 6144) { src = n0 + 32; nv = 64; }
                else if (n0 == 6144) { src = 3072; nv = 32; }
                else { src = 0; nv = 0; }
                p0_transpose_item(a.w_in, INW, kt * 64, src, nv, WinT, D, n0, wlds, n0 >= C_DQ && n0 < C_DV);
            } else if (it < I_IN + I_SQ) {
                const int r = it - I_IN; const int kt = r & 31, nt = r >> 5;
                p0_transpose_item(a.w_out, D, kt * 64, nt * 64, 64, WoutT, D, nt * 64, wlds);
            } else {
                const int r = it - I_IN - I_SQ; const int kt = r & 31, nt = r >> 5;
                p0_transpose_item(a.w_pq, D, kt * 64, nt * 64, 64, WpqT, D, nt * 64, wlds);
            }
        }
        float2* cs = (float2*)(a.ws + WS_CS);
        for (int i = b0 * NTHREADS + tid; i < T * 64; i += nb * NTHREADS) {
            const int t = i >> 6, f = i & 63;
            const float inv_freq = powf(10000.0f, -(float)f * 2.0f / 128.0f);
            const float ang = (float)a.pos[t] * inv_freq;
            const double rev = (double)ang * 0.15915494309189533577;
            const float fr = (float)(rev - floor(rev));
            cs[i] = make_float2(__builtin_amdgcn_cosf(fr), __builtin_amdgcn_sinf(fr));
        }
    }
    __syncthreads();
}

template <bool BF16IN> __device__ __forceinline__ void norm_mod_phase(const void* __restrict__ xin_, const float* __restrict__ g, const float* __restrict__ mod,
                                               int sh_chunk, int sc_chunk, u16* __restrict__ outp) {
    const int lane = threadIdx.x & 63, wave = threadIdx.x >> 6;
    const int gw = blockIdx.x * NWAVES + wave, NGW = gridDim.x * NWAVES;
    float4 v[8], vn[8];
#define NM_LOAD(dst_, t_) do { if (BF16IN) { const uint2* xr_ = (const uint2*)((const u16*)xin_ + (size_t)(t_) * D); \
            _Pragma("unroll") for (int m = 0; m < 8; ++m) { const uint2 p_ = xr_[lane + 64 * m]; dst_[m] = make_float4(lo2f(p_.x), hi2f(p_.x), lo2f(p_.y), hi2f(p_.y)); } } \
        else { const float4* xr_ = (const float4*)((const float*)xin_ + (size_t)(t_) * D); _Pragma("unroll") for (int m = 0; m < 8; ++m) dst_[m] = xr_[lane + 64 * m]; } } while (0)
    if (gw < T) NM_LOAD(v, gw);
    for (int t = gw; t < T; t += NGW) {
        const int b = t / S;
        if (t + NGW < T) NM_LOAD(vn, t + NGW);
        float ss = 0.f;
#pragma unroll
        for (int m = 0; m < 8; ++m) ss += v[m].x * v[m].x + v[m].y * v[m].y + v[m].z * v[m].z + v[m].w * v[m].w;
        ss = wave_sum(ss);
        const float rstd = rsqrtf(ss * (1.f / D) + NORM_EPS);
        const float4* gp = (const float4*)g;
        const float4* shp = (const float4*)(mod + b * 12288 + sh_chunk * 2048);
        const float4* scp = (const float4*)(mod + b * 12288 + sc_chunk * 2048);
        uint2* op = (uint2*)(outp + (size_t)t * D);
#pragma unroll
        for (int m = 0; m < 8; ++m) {
            const int i = lane + 64 * m;
            const float4 gg = gp[i], sh = shp[i], sc = scp[i];
            const float h0 = v[m].x * rstd * gg.x * (1.f + sc.x) + sh.x;
            const float h1 = v[m].y * rstd * gg.y * (1.f + sc.y) + sh.y;
            const float h2 = v[m].z * rstd * gg.z * (1.f + sc.z) + sh.z;
            const float h3 = v[m].w * rstd * gg.w * (1.f + sc.w) + sh.w;
            op[i] = make_uint2(pack2(h0, h1), pack2(h2, h3));
        }
#pragma unroll
        for (int m = 0; m < 8; ++m) v[m] = vn[m];
    }
#undef NM_LOAD
}

namespace pg8 {
#define PG8_LAS __attribute__((address_space(3)))
typedef unsigned short bf16_t;
typedef short bf16x8 __attribute__((ext_vector_type(8)));
typedef float f32x4 __attribute__((ext_vector_type(4)));
typedef unsigned u32x4 __attribute__((ext_vector_type(4)));
constexpr int BM = 256, BK = 64, HALF = 128, HTB = HALF * BK * 2  , STAGE_BYTES = 8 * HTB, NXCD = 8, WGM = 8;

__host__ __device__ __forceinline__ int lds_byte(int r, int c) { const int st = (r >> 4) * 2 + (c >> 5), rr = r & 15, cc = c & 31, ob = rr * 64 + cc * 2; return st * 1024 + (ob ^ (((ob >> 9) & 1) << 5)); }
__host__ __device__ __forceinline__ void stage_rc(int b, int& R, int& C) { const int st = b / 1024, sb = b % 1024, swz = sb ^ (((sb >> 9) & 1) << 5); R = (st >> 1) * 16 + swz / 64; C = (st & 1) * 32 + (swz % 64) / 2; }
__host__ __device__ __forceinline__ int perm32(int rho) { const int n = rho >> 4, i = rho & 15; return 8 * (i >> 2) + 4 * n + (i & 3); }

struct Unit { int pm, pn; };
struct Gemm { const bf16_t* A; const bf16_t* Bt; int M, N, K; };

struct StaticOrder {
    int nM, nN, nwg, G, c;
    __host__ __device__ void init(int M, int N, int G_, int c_) { nM = M / BM; nN = N / BM; nwg = nM * nN; G = G_; c = c_; }
    __host__ __device__ bool next(int i, Unit& u) const {
        const long L = (long)i * G + c; if (L >= nwg) return false;
        int wgid = (int)L; { const int q = nwg / NXCD, r = nwg % NXCD, xcd = wgid % NXCD, off = wgid / NXCD; wgid = (xcd < r ? xcd * (q + 1) : r * (q + 1) + (xcd - r) * q) + off; }
        const int nig = WGM * nN, gid = wgid / nig, fm = gid * WGM, gsz = (nM - fm) < WGM ? (nM - fm) : WGM;
        u.pm = fm + ((wgid % nig) % gsz); u.pn = (wgid % nig) / gsz; return true;
    }
    __device__ __forceinline__ void a_ready(const Unit&) const {}
    __device__ __forceinline__ void done(const Unit&) const {}
};
__device__ __forceinline__ unsigned cvt_pk_bf16(float lo, float hi) { unsigned r; asm volatile("v_cvt_pk_bf16_f32 %0, %1, %2" : "=v"(r) : "v"(lo), "v"(hi)); return r; }
typedef float f32x2 __attribute__((ext_vector_type(2)));
template <class Epi, class Sched, bool STAMP = false>
__device__ __forceinline__ void gemm_phase(PG8_LAS unsigned char* lds, const Gemm g, const Sched& S, const Epi& E, unsigned long long* stamps) {
    const int tid = threadIdx.x, wid = __builtin_amdgcn_readfirstlane(tid >> 6), lane = tid & 63, wr = wid >> 2, wc = wid & 3, fr = lane & 15, fq = lane >> 4;
    const int K = g.K, nt = K / BK;
    int ts_lo = 0, ts_hi = 0, nts = 0; const unsigned long long rt_entry = STAMP ? (unsigned long long)wall_clock64() : 0ull;
#define PG8_STAMP() do { if (STAMP && wid == 0 && nts < 64) { const unsigned long long _c = (unsigned long long)clock64(); \
        ts_lo = (lane == nts) ? (int)(unsigned)_c : ts_lo; ts_hi = (lane == nts) ? (int)(unsigned)(_c >> 32) : ts_hi; ++nts; } } while (0)
    PG8_STAMP();
    unsigned voffA[2], voffB[2];
#pragma unroll
    for (int i = 0; i < 2; ++i) { int R, C; stage_rc(tid * 16 + i * 8192, R, C); const int Rb = Epi::PERM ? ((R & ~31) + perm32(R & 31)) : R;
        voffA[i] = (unsigned)(R * K + C) * 2u; voffB[i] = (unsigned)(Rb * K + C) * 2u; }
    const size_t kstep = (size_t)(BK * 2);
    const size_t hstep = (size_t)HALF * K * 2;
    const size_t tstep = 2 * hstep;
    const unsigned ldsw = (unsigned)wid * 1024u;
    const int aoff = lds_byte(wr * 64 + fr, fq * 8), boff = lds_byte(wc * 32 + fr, fq * 8);
#define PG8_SA(b, h) (((b) * 2 + (h)) * HTB)
#define PG8_SB(b, h) ((4 + (b) * 2 + (h)) * HTB)
#define PG8_STAGE(bufoff, gbase, voff) do { _Pragma("unroll") for (int _i = 0; _i < 2; ++_i) \
        __builtin_amdgcn_global_load_lds((const unsigned*)((const char*)(gbase) + (voff)[_i]), (PG8_LAS unsigned*)(lds + (bufoff) + ldsw + _i * 8192), 16, 0, 0); } while (0)
#define PG8_LDA(dst, b, h) do { _Pragma("unroll") for (int m = 0; m < 4; ++m) _Pragma("unroll") for (int k = 0; k < 2; ++k) dst[m][k] = *(const PG8_LAS bf16x8*)(lds + PG8_SA(b, h) + aoff + m * 2048 + k * 1024); } while (0)
#define PG8_LDB(dst, b, h) do { _Pragma("unroll") for (int n = 0; n < 2; ++n) _Pragma("unroll") for (int k = 0; k < 2; ++k) dst[n][k] = *(const PG8_LAS bf16x8*)(lds + PG8_SB(b, h) + boff + n * 2048 + k * 1024); } while (0)
#define PG8_MMA(ai, bj, At, Bt) do { __builtin_amdgcn_s_setprio(1); _Pragma("unroll") for (int m = 0; m < 4; ++m) _Pragma("unroll") for (int n = 0; n < 2; ++n) _Pragma("unroll") for (int k = 0; k < 2; ++k) \
        acc[ai][bj][m][n] = __builtin_amdgcn_mfma_f32_16x16x32_bf16(Bt[n][k], At[m][k], acc[ai][bj][m][n], 0, 0, 0); __builtin_amdgcn_s_setprio(0); } while (0)
#define PG8_WAIT_V(n) asm volatile("s_waitcnt vmcnt(" #n ")" ::: "memory")
#define PG8_WAIT_L(n) asm volatile("s_waitcnt lgkmcnt(" #n ")" ::: "memory")
#define PG8_BAR __builtin_amdgcn_s_barrier()
#define PG8_SCHED __builtin_amdgcn_sched_barrier(0)
    Unit cur, nxt; int ui = 0;
    if (!S.next(0, cur)) return;
    f32x4 acc[2][2][4][2];
#pragma unroll
    for (int a = 0; a < 2; ++a)
#pragma unroll
        for (int b = 0; b < 2; ++b)
#pragma unroll
            for (int m = 0; m < 4; ++m)
#pragma unroll
                for (int n = 0; n < 2; ++n) acc[a][b][m][n] = (f32x4){0.f, 0.f, 0.f, 0.f};
    bf16x8 At[4][2], B0[2][2], B1[2][2];
    const char* cA = (const char*)g.A + (size_t)cur.pm * tstep; const char* cB = (const char*)g.Bt + (size_t)cur.pn * tstep;
    S.a_ready(cur);
    PG8_STAGE(PG8_SB(0, 0), cB, voffB); PG8_STAGE(PG8_SA(0, 0), cA, voffA); PG8_STAGE(PG8_SB(0, 1), cB + hstep, voffB); PG8_STAGE(PG8_SA(0, 1), cA + hstep, voffA);
    if (wr == 1) PG8_BAR;
    PG8_WAIT_V(4); PG8_BAR;
    PG8_STAGE(PG8_SB(1, 0), cB + kstep, voffB); PG8_STAGE(PG8_SA(1, 0), cA + kstep, voffA); PG8_STAGE(PG8_SB(1, 1), cB + hstep + kstep, voffB);
    PG8_WAIT_V(6); PG8_BAR;
    PG8_STAMP();
    for (;;) {
        const bool has_next = S.next(ui + 1, nxt);
        const char* nA = has_next ? (const char*)g.A + (size_t)nxt.pm * tstep : cA; const char* nB = has_next ? (const char*)g.Bt + (size_t)nxt.pn * tstep : cB;
        for (int t = 0; t < nt; t += 2) {
            const bool last = (t == nt - 2);
            const char* a1 = cA + (size_t)(t + 1) * kstep;
            const char* a2 = last ? nA : cA + (size_t)(t + 2) * kstep; const char* b2 = last ? nB : cB + (size_t)(t + 2) * kstep;
            const char* a3 = a2 + kstep; const char* b3 = b2 + kstep;
            if (last && has_next) S.a_ready(nxt);
            PG8_LDB(B0, 0, 0); PG8_SCHED; PG8_LDA(At, 0, 0); PG8_STAGE(PG8_SA(1, 1), a1 + hstep, voffA);
            PG8_WAIT_L(8); PG8_BAR; PG8_WAIT_L(0); PG8_MMA(0, 0, At, B0); PG8_BAR; PG8_SCHED;
            PG8_LDB(B1, 0, 1); PG8_STAGE(PG8_SB(0, 0), b2, voffB);
            PG8_BAR; PG8_WAIT_L(0); PG8_MMA(0, 1, At, B1); PG8_BAR;
            PG8_LDA(At, 0, 1); PG8_STAGE(PG8_SA(0, 0), a2, voffA);
            PG8_BAR; PG8_WAIT_L(0); PG8_MMA(1, 0, At, B0); PG8_BAR; PG8_SCHED;
            PG8_STAGE(PG8_SB(0, 1), b2 + hstep, voffB);
            PG8_WAIT_V(6); PG8_BAR; PG8_MMA(1, 1, At, B1); PG8_BAR;
            PG8_LDB(B0, 1, 0); PG8_SCHED; PG8_LDA(At, 1, 0); PG8_STAGE(PG8_SA(0, 1), a2 + hstep, voffA);
            PG8_WAIT_L(8); PG8_BAR; PG8_WAIT_L(0); PG8_MMA(0, 0, At, B0); PG8_BAR; PG8_SCHED;
            PG8_LDB(B1, 1, 1); PG8_STAGE(PG8_SB(1, 0), b3, voffB);
            PG8_BAR; PG8_WAIT_L(0); PG8_MMA(0, 1, At, B1); PG8_BAR;
            PG8_LDA(At, 1, 1); PG8_STAGE(PG8_SA(1, 0), a3, voffA);
            PG8_BAR; PG8_WAIT_L(0); PG8_MMA(1, 0, At, B0); PG8_BAR; PG8_SCHED;
            PG8_STAGE(PG8_SB(1, 1), b3 + hstep, voffB);
            PG8_WAIT_V(6); PG8_BAR; PG8_MMA(1, 1, At, B1); PG8_BAR;
        }
        PG8_STAMP();
        if constexpr (!Epi::AFTER_DRAIN) { E(acc, cur, wr, wc, fr, fq); S.done(cur); }
        PG8_STAMP();
        if (!has_next) break;
#pragma unroll
        for (int a = 0; a < 2; ++a)
#pragma unroll
            for (int b = 0; b < 2; ++b)
#pragma unroll
                for (int m = 0; m < 4; ++m)
#pragma unroll
                    for (int n = 0; n < 2; ++n) acc[a][b][m][n] = (f32x4){0.f, 0.f, 0.f, 0.f};
        cur = nxt; cA = nA; cB = nB; ++ui;
    }
    PG8_WAIT_V(0);
    if (wr == 0) PG8_BAR;
    PG8_BAR;
    if constexpr (Epi::AFTER_DRAIN) { E.fused(acc, cur, wr, wc, fr, fq, lds, wid, lane); S.done(cur); }
    PG8_STAMP();
    if (STAMP && wid == 0) { stamps[lane] = lane < nts ? (((unsigned long long)(unsigned)ts_hi << 32) | (unsigned)ts_lo) : 0ull;
        if (lane == 62) stamps[62] = rt_entry; if (lane == 63) stamps[63] = (unsigned long long)wall_clock64(); }
#undef PG8_STAMP
#undef PG8_SA
#undef PG8_SB
#undef PG8_STAGE
#undef PG8_LDA
#undef PG8_LDB
#undef PG8_MMA
#undef PG8_WAIT_V
#undef PG8_WAIT_L
#undef PG8_BAR
#undef PG8_SCHED
}
}

struct EpiProj {
    static constexpr bool PERM = true, AFTER_DRAIN = false;
    u16* P; const float* cs;
    __device__ __forceinline__ void operator()(const pg8::f32x4 (&acc)[2][2][4][2], const pg8::Unit& u, int wr, int wc, int fr, int fq) const {
        const int row0 = u.pm * 256 + wr * 64 + fr;
        const int col0 = u.pn * 256 + wc * 32 + 8 * fq;
        const bool rope = (u.pn >= C_DQ / 256) && (u.pn < C_DV / 256);
#pragma unroll
        for (int ai = 0; ai < 2; ++ai)
#pragma unroll
            for (int m = 0; m < 4; ++m) { const int row = row0 + ai * 128 + m * 16; u16* rowp = P + (size_t)row * NP + col0;
                pg8::f32x4 c01 = (pg8::f32x4){1.f, 0.f, 1.f, 0.f}, c23 = c01;
                if (rope) { const pg8::f32x4* cp = (const pg8::f32x4*)(cs + ((size_t)row * 64 + 4 * (4 * wc + fq)) * 2); c01 = cp[0]; c23 = cp[1]; }
#pragma unroll
                for (int bj = 0; bj < 2; ++bj) { pg8::f32x4 v0 = acc[ai][bj][m][0], v1 = acc[ai][bj][m][1];
                    if (rope) {
                        const pg8::f32x4 cc = {c01[0], c01[2], c23[0], c23[2]}, sn = {c01[1], c01[3], c23[1], c23[3]};
                        const pg8::f32x4 y1 = v0 * cc - v1 * sn, y2 = v0 * sn + v1 * cc; v0 = y1; v1 = y2; }
                    pg8::u32x4 w; w.x = pg8::cvt_pk_bf16(v0[0], v0[1]); w.y = pg8::cvt_pk_bf16(v0[2], v0[3]); w.z = pg8::cvt_pk_bf16(v1[0], v1[1]); w.w = pg8::cvt_pk_bf16(v1[2], v1[3]);
                    *(pg8::u32x4*)(rowp + bj * 128) = w; } }
    }
};
__device__ __forceinline__ void gz_phase(unsigned char* lds, const u16* __restrict__ H1, const u16* __restrict__ Wg, float* __restrict__ gz) {
    const int tid = threadIdx.x, lane = tid & 63, wave = tid >> 6, fr = lane & 15, fq = lane >> 4;
    float* red = (float*)lds;
    for (int rb = blockIdx.x; rb < T / 64; rb += gridDim.x) {
        const int r0 = rb * 64, k0 = wave * 256;
        f32x4 acc[4][2];
#pragma unroll
        for (int m = 0; m < 4; ++m) { acc[m][0] = (f32x4){0.f, 0.f, 0.f, 0.f}; acc[m][1] = (f32x4){0.f, 0.f, 0.f, 0.f}; }
#pragma unroll
        for (int ks = 0; ks < 8; ++ks) {
            bf16x8 af[4], bfr[2];
#pragma unroll
            for (int m = 0; m < 4; ++m) af[m] = *(const bf16x8*)(H1 + (size_t)(r0 + 16 * m + fr) * D + k0 + 32 * ks + 8 * fq);
#pragma unroll
            for (int n = 0; n < 2; ++n) bfr[n] = *(const bf16x8*)(Wg + (size_t)(16 * n + fr) * D + k0 + 32 * ks + 8 * fq);
#pragma unroll
            for (int m = 0; m < 4; ++m)
#pragma unroll
                for (int n = 0; n < 2; ++n) acc[m][n] = __builtin_amdgcn_mfma_f32_16x16x32_bf16(af[m], bfr[n], acc[m][n], 0, 0, 0);
        }
        __syncthreads();
#pragma unroll
        for (int m = 0; m < 4; ++m)
#pragma unroll
            for (int n = 0; n < 2; ++n)
#pragma unroll
                for (int j = 0; j < 4; ++j) red[(wave * 64 + 16 * m + 4 * fq + j) * 32 + 16 * n + fr] = acc[m][n][j];
        __syncthreads();
#pragma unroll
        for (int k = 0; k < 4; ++k) {
            const int e = tid + 512 * k;
            float s = 0.f;
#pragma unroll
            for (int w = 0; w < 8; ++w) s += red[w * 2048 + e];
            gz[(size_t)r0 * 32 + e] = s;
        }
    }
    __syncthreads();
}
struct EpiResid {
    static constexpr bool PERM = true, AFTER_DRAIN = false;
    const float* x; const float* mod; u16* x1;
    __device__ __forceinline__ void operator()(const pg8::f32x4 (&acc)[2][2][4][2], const pg8::Unit& u, int wr, int wc, int fr, int fq) const {
        const int row0 = u.pm * 256 + wr * 64 + fr, col0 = u.pn * 256 + wc * 32 + 8 * fq;
        const int b = (u.pm * 256) / S;
        pg8::f32x4 ga[2][2];
#pragma unroll
        for (int bj = 0; bj < 2; ++bj)
#pragma unroll
            for (int n = 0; n < 2; ++n) ga[bj][n] = *(const pg8::f32x4*)(mod + b * 12288 + 2 * 2048 + col0 + bj * 128 + 4 * n);
#pragma unroll
        for (int ai = 0; ai < 2; ++ai)
#pragma unroll
            for (int m = 0; m < 4; ++m) { const size_t off = (size_t)(row0 + ai * 128 + m * 16) * D + col0;
#pragma unroll
                for (int bj = 0; bj < 2; ++bj) {
                    const pg8::f32x4 x0 = *(const pg8::f32x4*)(x + off + bj * 128), x1v = *(const pg8::f32x4*)(x + off + bj * 128 + 4);
                    const pg8::f32x4 v0 = x0 + ga[bj][0] * acc[ai][bj][m][0], v1 = x1v + ga[bj][1] * acc[ai][bj][m][1];
                    pg8::u32x4 w; w.x = pg8::cvt_pk_bf16(v0[0], v0[1]); w.y = pg8::cvt_pk_bf16(v0[2], v0[3]); w.z = pg8::cvt_pk_bf16(v1[0], v1[1]); w.w = pg8::cvt_pk_bf16(v1[2], v1[3]);
                    *(pg8::u32x4*)(x1 + off + bj * 128) = w; } }
    }
};
struct EpiBf16 {
    static constexpr bool PERM = true, AFTER_DRAIN = false;
    u16* Q;
    __device__ __forceinline__ void operator()(const pg8::f32x4 (&acc)[2][2][4][2], const pg8::Unit& u, int wr, int wc, int fr, int fq) const {
        const int row0 = u.pm * 256 + wr * 64 + fr, col0 = u.pn * 256 + wc * 32 + 8 * fq;
#pragma unroll
        for (int ai = 0; ai < 2; ++ai)
#pragma unroll
            for (int m = 0; m < 4; ++m) { u16* rowp = Q + (size_t)(row0 + ai * 128 + m * 16) * D + col0;
#pragma unroll
                for (int bj = 0; bj < 2; ++bj) { const pg8::f32x4 v0 = acc[ai][bj][m][0], v1 = acc[ai][bj][m][1];
                    pg8::u32x4 w; w.x = pg8::cvt_pk_bf16(v0[0], v0[1]); w.y = pg8::cvt_pk_bf16(v0[2], v0[3]); w.z = pg8::cvt_pk_bf16(v1[0], v1[1]); w.w = pg8::cvt_pk_bf16(v1[2], v1[3]);
                    *(pg8::u32x4*)(rowp + bj * 128) = w; } }
    }
};
template <class Epi>
__device__ __forceinline__ void gemm8(unsigned char* lds, const u16* A, const u16* Bt, int M, int N, int K, const Epi& E) {
    pg8::Gemm g{A, Bt, M, N, K}; pg8::StaticOrder So; So.init(M, N, (int)gridDim.x, (int)blockIdx.x);
    pg8::gemm_phase<Epi, pg8::StaticOrder, false>((PG8_LAS unsigned char*)lds, g, So, E, nullptr);
    __syncthreads();
}

#define GLA_QD_BYTES 16384
#define GLA_AT_BYTES 8192
__device__ __forceinline__ float gla_logsigmoid(float z) { return fminf(z, 0.f) - __logf(1.f + __expf(-fabsf(z))); }

__device__ __forceinline__ void gla_prep_item(const u16* __restrict__ P, int ldp, int cq, int ck, const float* __restrict__ gz,
                                              const float* __restrict__ wg_f, const float* __restrict__ bg_f, const float* __restrict__ wg_b, const float* __restrict__ bg_b,
                                              int Sq, unsigned char* __restrict__ QDg, unsigned char* __restrict__ KEg, unsigned char* __restrict__ ATg, float* __restrict__ DECg,
                                              unsigned char* lds, int item) {
    const int nch = Sq / 64;
    const int c = item % nch, dir = (item / nch) & 1, hh = (item / (nch * 2)) & 3, b = item / (nch * 8);
    const int tid = TID, lane = tid & 63, wave = tid >> 6, li = lane & 15, fq = lane >> 4;
    float* gzs = (float*)lds;
    float* segs = gzs + 64 * 16;
    unsigned char* QDs = lds + 8192;
    unsigned char* KIs = QDs + 16384;
    unsigned char* KEs = KIs + 16384;
    float* bmat = (float*)(KEs + 16384);
    const size_t tok0 = (size_t)b * Sq;
    __syncthreads();
    uint4 rq0, rq1, rk0, rk1;
    {
        const int i0 = tid >> 4, i1 = (tid + 512) >> 4, cc = tid & 15;
        const int s0 = dir ? (Sq - 1 - (64 * c + i0)) : (64 * c + i0), s1 = dir ? (Sq - 1 - (64 * c + i1)) : (64 * c + i1);
        rq0 = *(const uint4*)(P + (tok0 + s0) * ldp + cq + hh * 128 + cc * 8); rk0 = *(const uint4*)(P + (tok0 + s0) * ldp + ck + hh * 128 + cc * 8);
        rq1 = *(const uint4*)(P + (tok0 + s1) * ldp + cq + hh * 128 + cc * 8); rk1 = *(const uint4*)(P + (tok0 + s1) * ldp + ck + hh * 128 + cc * 8);
    }
    for (int e = tid; e < 64 * 16; e += 512) {
        const int i = e >> 4, r = e & 15;
        const int s = dir ? (Sq - 1 - (64 * c + i)) : (64 * c + i);
        gzs[e] = gz[(tok0 + s) * 32 + dir * 16 + r];
    }
    const int d = tid & 127, seg = tid >> 7;
    const float* wg = dir ? wg_b : wg_f;
    float wcol[16];
#pragma unroll
    for (int r = 0; r < 16; ++r) wcol[r] = wg[r * 512 + hh * 128 + d];
    const float bias = (dir ? bg_b : bg_f)[hh * 128 + d];
    __syncthreads();
    float run = 0.f;
#pragma unroll
    for (int k = 0; k < 16; ++k) {
        const int i = 16 * seg + k;
        float z = bias;
#pragma unroll
        for (int r = 0; r < 16; ++r) z += gzs[i * 16 + r] * wcol[r];
        run += gla_logsigmoid(z) * (1.f / 16.f);
        bmat[i * 128 + d] = run;
    }
    segs[seg * 128 + d] = run;
    __syncthreads();
    if (seg == 0) {
        const float t0 = segs[d], t1 = segs[128 + d], t2 = segs[256 + d], t3 = segs[384 + d];
        segs[d] = 0.f; segs[128 + d] = t0; segs[256 + d] = t0 + t1; segs[384 + d] = t0 + t1 + t2; segs[512 + d] = t0 + t1 + t2 + t3;
        DECg[(size_t)item * 128 + d] = __expf(t0 + t1 + t2 + t3);
    }
    __syncthreads();
    const float qscale = 0.08838834764831845f;
#pragma unroll
    for (int k = 0; k < 2; ++k) {
        const int id = tid + 512 * k, i = id >> 4, cc = id & 15, d0 = cc * 8, sg = i >> 4;
        const uint4 qv = k ? rq1 : rq0, kv = k ? rk1 : rk0;
        const float qx[8] = {lo2f(qv.x), hi2f(qv.x), lo2f(qv.y), hi2f(qv.y), lo2f(qv.z), hi2f(qv.z), lo2f(qv.w), hi2f(qv.w)};
        const float kx[8] = {lo2f(kv.x), hi2f(kv.x), lo2f(kv.y), hi2f(kv.y), lo2f(kv.z), hi2f(kv.z), lo2f(kv.w), hi2f(kv.w)};
        float qd[8], ki[8], ke[8];
        const float4 bA = *(const float4*)(bmat + i * 128 + d0), bB = *(const float4*)(bmat + i * 128 + d0 + 4);
        const float4 oA = *(const float4*)(segs + sg * 128 + d0), oB = *(const float4*)(segs + sg * 128 + d0 + 4);
        const float4 tA = *(const float4*)(segs + 512 + d0), tB = *(const float4*)(segs + 512 + d0 + 4);
        const float bv[8] = {bA.x + oA.x, bA.y + oA.y, bA.z + oA.z, bA.w + oA.w, bB.x + oB.x, bB.y + oB.y, bB.z + oB.z, bB.w + oB.w};
        const float tv[8] = {tA.x, tA.y, tA.z, tA.w, tB.x, tB.y, tB.z, tB.w};
#pragma unroll
        for (int e = 0; e < 8; ++e) {
            const float bb = bv[e], tot = tv[e];
            qd[e] = qx[e] * qscale * __expf(bb); ki[e] = kx[e] * __expf(-bb); ke[e] = kx[e] * __expf(tot - bb);
        }
        const int o = i * 256 + ((cc ^ (i & 15)) << 4);
        *(uint4*)(QDs + o) = make_uint4(pack2(qd[0], qd[1]), pack2(qd[2], qd[3]), pack2(qd[4], qd[5]), pack2(qd[6], qd[7]));
        *(uint4*)(KIs + o) = make_uint4(pack2(ki[0], ki[1]), pack2(ki[2], ki[3]), pack2(ki[4], ki[5]), pack2(ki[6], ki[7]));
        *(uint4*)(KEs + o) = make_uint4(pack2(ke[0], ke[1]), pack2(ke[2], ke[3]), pack2(ke[4], ke[5]), pack2(ke[6], ke[7]));
    }
    __syncthreads();
    {
        uint4* qo = (uint4*)(QDg + (size_t)item * GLA_QD_BYTES); uint4* ko = (uint4*)(KEg + (size_t)item * GLA_QD_BYTES);
#pragma unroll
        for (int k = 0; k < 2; ++k) { const int e = tid + 512 * k; qo[e] = ((const uint4*)QDs)[e]; ko[e] = ((const uint4*)KEs)[e]; }
    }
#pragma unroll
    for (int tt = 0; tt < 2; ++tt) {
        const int tile = wave + 8 * tt, jt = tile >> 2, it = tile & 3;
        f32x4 acc = (f32x4){0.f, 0.f, 0.f, 0.f};
        if (jt <= it) {
            const int jr = 16 * jt + li, ir = 16 * it + li;
#pragma unroll
            for (int ks = 0; ks < 4; ++ks) {
                const bf16x8 kf = *(const bf16x8*)(KIs + jr * 256 + (((4 * ks + fq) ^ (jr & 15)) << 4));
                const bf16x8 qf = *(const bf16x8*)(QDs + ir * 256 + (((4 * ks + fq) ^ (ir & 15)) << 4));
                acc = __builtin_amdgcn_mfma_f32_16x16x32_bf16(kf, qf, acc, 0, 0, 0);
            }
        }
        const int i = 16 * it + li, j0 = 16 * jt + 4 * fq;
        float v[4];
#pragma unroll
        for (int jj = 0; jj < 4; ++jj) v[jj] = (j0 + jj <= i) ? acc[jj] : 0.f;
        const int chunk = 2 * jt + (fq >> 1), sub = (fq & 1) * 8;
        *(uint2*)(ATg + (size_t)item * GLA_AT_BYTES + i * 128 + ((chunk ^ (i & 7)) << 4) + sub) = make_uint2(pack2(v[0], v[1]), pack2(v[2], v[3]));
    }
}

__device__ __forceinline__ void gla_seq_item(const u16* __restrict__ P, int ldp, int cv, int Sq,
                                             const unsigned char* __restrict__ QDg, const unsigned char* __restrict__ KEg, const unsigned char* __restrict__ ATg, const float* __restrict__ DECg,
                                             u16* __restrict__ Oout  , int Ttot, unsigned char* lds, int item) {
    const int slice = item & 1, dir = (item >> 1) & 1, hh = (item >> 2) & 3, b = item >> 4;
    const int nch = Sq / 64;
    const int tid = TID, lane = tid & 63, wave = tid >> 6, li = lane & 15, fq = lane >> 4;
    const size_t tok0 = (size_t)b * Sq;
    const int pitem0 = ((b * 4 + hh) * 2 + dir) * nch;
    constexpr int BUF = 16384 * 3 + 8192 + 512;
    typedef unsigned gla_u32x4 __attribute__((ext_vector_type(4)));
    gla_u32x4 rq0, rq1, rk0, rk1, rv0, rv1, ra; float rd = 0.f;
#define GLA_VROW(c_, k_) ((tok0 + (size_t)(dir ? (Sq - 1 - (64 * (c_) + ((tid + 512 * (k_)) >> 4))) : (64 * (c_) + ((tid + 512 * (k_)) >> 4)))) * ldp + cv + hh * 256 + slice * 128 + ((tid + 512 * (k_)) & 15) * 8)
#define GLA_ISSUE(c_) do { \
        const gla_u32x4* qsrc_ = (const gla_u32x4*)(QDg + (size_t)(pitem0 + (c_)) * GLA_QD_BYTES); const gla_u32x4* ksrc_ = (const gla_u32x4*)(KEg + (size_t)(pitem0 + (c_)) * GLA_QD_BYTES); \
        rq0 = qsrc_[tid]; rq1 = qsrc_[tid + 512]; rk0 = ksrc_[tid]; rk1 = ksrc_[tid + 512]; \
        ra = ((const gla_u32x4*)(ATg + (size_t)(pitem0 + (c_)) * GLA_AT_BYTES))[tid]; \
        rv0 = *(const gla_u32x4*)(P + GLA_VROW(c_, 0)); rv1 = *(const gla_u32x4*)(P + GLA_VROW(c_, 1)); \
        if (tid < 128) rd = DECg[(size_t)(pitem0 + (c_)) * 128 + tid]; } while (0)
#define GLA_COMMIT(buf_) do { \
        unsigned char* base_ = lds + (buf_) * BUF; \
        ((gla_u32x4*)base_)[tid] = rq0; ((gla_u32x4*)base_)[tid + 512] = rq1; ((gla_u32x4*)(base_ + 16384))[tid] = rk0; ((gla_u32x4*)(base_ + 16384))[tid + 512] = rk1; \
        { const int row_ = tid >> 4, ch_ = tid & 15; *(gla_u32x4*)(base_ + 32768 + row_ * 256 + ((ch_ ^ (row_ & 15)) << 4)) = rv0; } \
        { const int row_ = (tid + 512) >> 4, ch_ = tid & 15; *(gla_u32x4*)(base_ + 32768 + row_ * 256 + ((ch_ ^ (row_ & 15)) << 4)) = rv1; } \
        ((gla_u32x4*)(base_ + 49152))[tid] = ra; \
        if (tid < 128) ((float*)(base_ + 57344))[tid] = rd; } while (0)
    f32x4 st[8];
#pragma unroll
    for (int dt = 0; dt < 8; ++dt) st[dt] = (f32x4){0.f, 0.f, 0.f, 0.f};
    __syncthreads();
    GLA_ISSUE(0); GLA_COMMIT(0);
    __syncthreads();
#pragma unroll 1
    for (int c = 0; c < nch; ++c) {
        const int buf = c & 1;
        if (c + 1 < nch) GLA_ISSUE(c + 1);
        const unsigned char* QDs = lds + buf * BUF; const unsigned char* KEs = QDs + 16384; const unsigned char* Vs = QDs + 32768;
        const unsigned char* ATs = QDs + 49152; const float* DECs = (const float*)(QDs + 57344);
        bf16x8 vf[2];
#pragma unroll
        for (int jp = 0; jp < 2; ++jp) {
            const int rowA = 32 * jp + 8 * fq + (li >> 2), rowB = rowA + 4;
            const int chunk = 2 * wave + ((li & 3) >> 1), sub = ((li & 3) & 1) * 8;
            const s16x4 va = __builtin_amdgcn_ds_read_tr16_b64_v4i16((LAS s16x4*)(Vs + rowA * 256 + ((chunk ^ (rowA & 15)) << 4) + sub));
            const s16x4 vb = __builtin_amdgcn_ds_read_tr16_b64_v4i16((LAS s16x4*)(Vs + rowB * 256 + ((chunk ^ (rowB & 15)) << 4) + sub));
            vf[jp] = __builtin_shufflevector(va, vb, 0, 1, 2, 3, 4, 5, 6, 7);
        }
        bf16x8 sf[4];
#pragma unroll
        for (int dp = 0; dp < 4; ++dp) {
            const gla_u32x4 t_ = {pack2(st[2 * dp][0], st[2 * dp][1]), pack2(st[2 * dp][2], st[2 * dp][3]), pack2(st[2 * dp + 1][0], st[2 * dp + 1][1]), pack2(st[2 * dp + 1][2], st[2 * dp + 1][3])};
            sf[dp] = __builtin_bit_cast(bf16x8, t_);
        }
        f32x4 ot[4];
#pragma unroll
        for (int it = 0; it < 4; ++it) {
            f32x4 acc = (f32x4){0.f, 0.f, 0.f, 0.f};
            const int ir = 16 * it + li;
#pragma unroll
            for (int dp = 0; dp < 4; ++dp) {
                const int c0 = 4 * dp + (fq >> 1), c1 = c0 + 2, sub = (fq & 1) * 8;
                const uint2 lo = *(const uint2*)(QDs + ir * 256 + ((c0 ^ (ir & 15)) << 4) + sub);
                const uint2 hi = *(const uint2*)(QDs + ir * 256 + ((c1 ^ (ir & 15)) << 4) + sub);
                const gla_u32x4 q_ = {lo.x, lo.y, hi.x, hi.y};
                const bf16x8 qf = __builtin_bit_cast(bf16x8, q_);
                acc = __builtin_amdgcn_mfma_f32_16x16x32_bf16(sf[dp], qf, acc, 0, 0, 0);
            }
#pragma unroll
            for (int jp = 0; jp < 2; ++jp) {
                if (32 * jp <= 16 * it + 15) {
                    const bf16x8 af = *(const bf16x8*)(ATs + ir * 128 + (((4 * jp + fq) ^ (ir & 7)) << 4));
                    acc = __builtin_amdgcn_mfma_f32_16x16x32_bf16(vf[jp], af, acc, 0, 0, 0);
                }
            }
            ot[it] = acc;
        }
#pragma unroll
        for (int dt = 0; dt < 8; ++dt) {
            const f32x4 dec = *(const f32x4*)(DECs + 16 * dt + 4 * fq);
            f32x4 acc = st[dt] * dec;
#pragma unroll
            for (int jp = 0; jp < 2; ++jp) {
                const int rowA = 32 * jp + 8 * fq + (li >> 2), rowB = rowA + 4;
                const int chunk = 2 * dt + ((li & 3) >> 1), sub = ((li & 3) & 1) * 8;
                const s16x4 ka = __builtin_amdgcn_ds_read_tr16_b64_v4i16((LAS s16x4*)(KEs + rowA * 256 + ((chunk ^ (rowA & 15)) << 4) + sub));
                const s16x4 kb = __builtin_amdgcn_ds_read_tr16_b64_v4i16((LAS s16x4*)(KEs + rowB * 256 + ((chunk ^ (rowB & 15)) << 4) + sub));
                const bf16x8 kf = __builtin_shufflevector(ka, kb, 0, 1, 2, 3, 4, 5, 6, 7);
                acc = __builtin_amdgcn_mfma_f32_16x16x32_bf16(kf, vf[jp], acc, 0, 0, 0);
            }
            st[dt] = acc;
        }
#pragma unroll
        for (int it = 0; it < 4; ++it) {
            const int i = 16 * it + li;
            const int s = dir ? (Sq - 1 - (64 * c + i)) : (64 * c + i);
            *(uint2*)(Oout + ((size_t)dir * Ttot + tok0 + s) * 1024 + hh * 256 + slice * 128 + 16 * wave + 4 * fq) =
                make_uint2(pack2(ot[it][0], ot[it][1]), pack2(ot[it][2], ot[it][3]));
        }
        if (c + 1 < nch) GLA_COMMIT(buf ^ 1);
        __syncthreads();
    }
}
__device__ __forceinline__ void phase_rope_prep(const Args& a, unsigned char* lds) {
    u16* P = (u16*)(a.ws + WS_P);
    const float2* cs = (const float2*)(a.ws + WS_CS);
    const int gt = blockIdx.x * NTHREADS + threadIdx.x, NT = gridDim.x * NTHREADS;
    for (int item = blockIdx.x; item < GLA_NPREP; item += gridDim.x)
        gla_prep_item(P, NP, C_GQ, C_GK, (const float*)(a.ws + WS_GZ), a.wgf, a.bgf, a.wgb, a.bgb, S,
                      a.ws + WS_QD, a.ws + WS_KE, a.ws + WS_AT, (float*)(a.ws + WS_DEC), lds, item);
}

#define ATTN_DECODE(item_) \
    const int nb_per = Sq / 128; \
    const int within = (item_) % nb_per, hh = ((item_) / nb_per) & 7, b = ((item_) / (nb_per * 8)) & 3, pat = (item_) / (nb_per * 32); \
    const int dil = pat == 0 ? 1 : (pat == 1 ? 4 : 16); \
    const int M = Sq / dil; \
    const int r = within % dil, blk = within / dil; \
    const int p0 = blk * 128, kbase = p0 - 64; \
    const size_t tok0 = (size_t)b * Sq;
typedef unsigned attn_u32x4 __attribute__((ext_vector_type(4)));
__device__ __forceinline__ void attn_phase(const u16* __restrict__ P, int ldp, int cq, int ck, int cv, int Sq,
                                           u16* __restrict__ part_o, float* __restrict__ part_lse, int Ttot,
                                           unsigned char* lds, int first, int stride, int nitems) {
    const int tid = TID, lane = tid & 63, wave = tid >> 6, li = lane & 15, fq = lane >> 4;
    unsigned char* Ks = lds;
    unsigned char* Vs = lds + 65536;
    attn_u32x4 kr0, kr1, kr2, kr3, kr4, kr5, kr6, kr7, vr0, vr1, vr2, vr3, vr4, vr5, vr6, vr7;
#define ATTN_LD1(i_, kreg_, vreg_) { const int id_ = tid + 512 * (i_), row_ = id_ >> 4, c_ = id_ & 15; \
        int kp_ = kbase + row_; kp_ = kp_ < 0 ? 0 : (kp_ > M - 1 ? M - 1 : kp_); \
        const size_t t_ = tok0 + r + (size_t)dil * kp_; \
        kreg_ = *(const attn_u32x4*)(P + t_ * ldp + ck + hh * 128 + c_ * 8); vreg_ = *(const attn_u32x4*)(P + t_ * ldp + cv + hh * 128 + c_ * 8); }
#define ATTN_LOAD(item_) do { ATTN_DECODE(item_) \
        ATTN_LD1(0, kr0, vr0) ATTN_LD1(1, kr1, vr1) ATTN_LD1(2, kr2, vr2) ATTN_LD1(3, kr3, vr3) ATTN_LD1(4, kr4, vr4) ATTN_LD1(5, kr5, vr5) ATTN_LD1(6, kr6, vr6) ATTN_LD1(7, kr7, vr7) } while (0)
#define ATTN_ST1(i_, kreg_, vreg_) { const int id_ = tid + 512 * (i_), row_ = id_ >> 4, c_ = id_ & 15; const int off_ = row_ * 256 + ((c_ ^ (row_ & 15)) << 4); \
        *(attn_u32x4*)(Ks + off_) = kreg_; *(attn_u32x4*)(Vs + off_) = vreg_; }
#define ATTN_COMMIT() do { ATTN_ST1(0, kr0, vr0) ATTN_ST1(1, kr1, vr1) ATTN_ST1(2, kr2, vr2) ATTN_ST1(3, kr3, vr3) ATTN_ST1(4, kr4, vr4) ATTN_ST1(5, kr5, vr5) ATTN_ST1(6, kr6, vr6) ATTN_ST1(7, kr7, vr7) } while (0)
    int item = first;
    if (item < nitems) ATTN_LOAD(item);
    for (; item < nitems; item += stride) {
        ATTN_DECODE(item)
        __syncthreads();
        ATTN_COMMIT();
        const int qp = p0 + 16 * wave + li;
        const size_t tq = tok0 + r + (size_t)dil * qp;
        bf16x8 qf[4];
#pragma unroll
        for (int ks = 0; ks < 4; ++ks) qf[ks] = *(const bf16x8*)(P + tq * ldp + cq + hh * 128 + 32 * ks + 8 * fq);
        __syncthreads();
        if (item + stride < nitems) ATTN_LOAD(item + stride);
        const float scale = 0.08838834764831845f;
        float m = -1e30f, l = 0.f;
        f32x4 o[8];
#pragma unroll
        for (int dt = 0; dt < 8; ++dt) o[dt] = (f32x4){0.f, 0.f, 0.f, 0.f};
#pragma unroll 1
        for (int tp = 0; tp < 5; ++tp) {
            float s[8]; bool ok[8];
#pragma unroll
            for (int h2 = 0; h2 < 2; ++h2) {
                const int kk0 = 16 * wave + 16 * (2 * tp + h2);
                int krow = kk0 + li; krow = krow > 255 ? 255 : krow;
                f32x4 acc = (f32x4){0.f, 0.f, 0.f, 0.f};
#pragma unroll
                for (int ks = 0; ks < 4; ++ks) {
                    const bf16x8 kf = *(const bf16x8*)(Ks + krow * 256 + (((4 * ks + fq) ^ (krow & 15)) << 4));
                    acc = __builtin_amdgcn_mfma_f32_16x16x32_bf16(kf, qf[ks], acc, 0, 0, 0);
                }
#pragma unroll
                for (int j = 0; j < 4; ++j) {
                    const int kp = kbase + kk0 + 4 * fq + j;
                    const int rel = kp - qp;
                    ok[4 * h2 + j] = (kp >= 0) && (kp < M) && (rel <= 64) && (rel >= -64);
                    s[4 * h2 + j] = acc[j] * scale;
                }
            }
            float mx = -1e30f;
#pragma unroll
            for (int j = 0; j < 8; ++j) mx = ok[j] ? fmaxf(mx, s[j]) : mx;
            mx = fmaxf(mx, __shfl_xor(mx, 16));
            mx = fmaxf(mx, __shfl_xor(mx, 32));
            const float mn = fmaxf(m, mx);
            const float al = __expf(m - mn);
            float ps = 0.f; float p[8];
#pragma unroll
            for (int j = 0; j < 8; ++j) { p[j] = ok[j] ? __expf(s[j] - mn) : 0.f; ps += p[j]; }
            l = l * al + ps; m = mn;
            const attn_u32x4 p_ = {pack2(p[0], p[1]), pack2(p[2], p[3]), pack2(p[4], p[5]), pack2(p[6], p[7])};
            const bf16x8 pf = __builtin_bit_cast(bf16x8, p_);
#pragma unroll
            for (int dt = 0; dt < 8; ++dt) o[dt] *= al;
            int rowA = 16 * wave + 32 * tp + 4 * fq + (li >> 2); rowA = rowA > 255 ? 255 : rowA;
            int rowB = 16 * wave + 32 * tp + 16 + 4 * fq + (li >> 2); rowB = rowB > 255 ? 255 : rowB;
#pragma unroll
            for (int dt = 0; dt < 8; ++dt) {
                const int chunk = 2 * dt + ((li & 3) >> 1), sub = ((li & 3) & 1) * 8;
                const s16x4 va = __builtin_amdgcn_ds_read_tr16_b64_v4i16((LAS s16x4*)(Vs + rowA * 256 + ((chunk ^ (rowA & 15)) << 4) + sub));
                const s16x4 vb = __builtin_amdgcn_ds_read_tr16_b64_v4i16((LAS s16x4*)(Vs + rowB * 256 + ((chunk ^ (rowB & 15)) << 4) + sub));
                const bf16x8 vf = __builtin_shufflevector(va, vb, 0, 1, 2, 3, 4, 5, 6, 7);
                o[dt] = __builtin_amdgcn_mfma_f32_16x16x32_bf16(vf, pf, o[dt], 0, 0, 0);
            }
        }
        l += __shfl_xor(l, 16);
        l += __shfl_xor(l, 32);
        const float inv = 1.f / l;
        u16* orow = part_o + ((size_t)pat * Ttot + tq) * 1024 + hh * 128 + 4 * fq;
#pragma unroll
        for (int dt = 0; dt < 8; ++dt)
            *(uint2*)(orow + 16 * dt) = make_uint2(pack2(o[dt][0] * inv, o[dt][1] * inv), pack2(o[dt][2] * inv, o[dt][3] * inv));
        if (fq == 0) part_lse[((size_t)pat * Ttot + tq) * 8 + hh] = m + logf(l);
    }
#undef ATTN_LD1
#undef ATTN_LOAD
#undef ATTN_ST1
#undef ATTN_COMMIT
}

__device__ __forceinline__ void attn_merge_token(const u16* __restrict__ part_o, const float* __restrict__ part_lse, int Ttot, size_t t,
                                                 u16* __restrict__ dst  , int lane) {
    const int hh = lane >> 3;
    const float l0 = part_lse[((size_t)0 * Ttot + t) * 8 + hh], l1 = part_lse[((size_t)1 * Ttot + t) * 8 + hh], l2 = part_lse[((size_t)2 * Ttot + t) * 8 + hh];
    const float mx = fmaxf(l0, fmaxf(l1, l2));
    const float e0 = __expf(l0 - mx), e1 = __expf(l1 - mx), e2 = __expf(l2 - mx);
    const float inv = 1.f / (e0 + e1 + e2);
    const float w[3] = {e0 * inv, e1 * inv, e2 * inv};
    float acc[16];
#pragma unroll
    for (int i = 0; i < 16; ++i) acc[i] = 0.f;
#pragma unroll
    for (int p = 0; p < 3; ++p) {
        const uint4* src = (const uint4*)(part_o + ((size_t)p * Ttot + t) * 1024 + lane * 16);
        const uint4 a = src[0], bb = src[1];
        acc[0] += w[p] * lo2f(a.x); acc[1] += w[p] * hi2f(a.x); acc[2] += w[p] * lo2f(a.y); acc[3] += w[p] * hi2f(a.y);
        acc[4] += w[p] * lo2f(a.z); acc[5] += w[p] * hi2f(a.z); acc[6] += w[p] * lo2f(a.w); acc[7] += w[p] * hi2f(a.w);
        acc[8] += w[p] * lo2f(bb.x); acc[9] += w[p] * hi2f(bb.x); acc[10] += w[p] * lo2f(bb.y); acc[11] += w[p] * hi2f(bb.y);
        acc[12] += w[p] * lo2f(bb.z); acc[13] += w[p] * hi2f(bb.z); acc[14] += w[p] * lo2f(bb.w); acc[15] += w[p] * hi2f(bb.w);
    }
    uint4* d = (uint4*)(dst + lane * 16);
    d[0] = make_uint4(pack2(acc[0], acc[1]), pack2(acc[2], acc[3]), pack2(acc[4], acc[5]), pack2(acc[6], acc[7]));
    d[1] = make_uint4(pack2(acc[8], acc[9]), pack2(acc[10], acc[11]), pack2(acc[12], acc[13]), pack2(acc[14], acc[15]));
}

__device__ __forceinline__ void phase_mixers(const Args& a, unsigned char* lds) {
    const int bi = blockIdx.x, G = gridDim.x;
    if (bi < 64) {
        gla_seq_item((const u16*)(a.ws + WS_P), NP, C_GV, S, a.ws + WS_QD, a.ws + WS_KE, a.ws + WS_AT, (const float*)(a.ws + WS_DEC),
                     (u16*)(a.ws + WS_OFB), T, lds, bi);
    } else {
        u16* part_o = (u16*)a.out; float* part_lse = (float*)((unsigned char*)a.out + (size_t)3 * T * 1024 * 2);
        attn_phase((const u16*)(a.ws + WS_P), NP, C_DQ, C_DK, C_DV, S, part_o, part_lse, T, lds, bi - 64, G - 64, 3 * 4 * 8 * (S / 128));
    }
}

__device__ __forceinline__ void phase_gla_fin(const Args& a) {
    const u16* Of = (const u16*)(a.ws + WS_OFB);
    const u16* Ob = Of + (size_t)T * 1024;
    const u16* P = (const u16*)(a.ws + WS_P);
    u16* A2 = (u16*)(a.ws + WS_ACT);
    const u16* part_o = (const u16*)a.out; const float* part_lse = (const float*)((const unsigned char*)a.out + (size_t)3 * T * 1024 * 2);
    const int lane = threadIdx.x & 63, wave = threadIdx.x >> 6;
    const int gw = blockIdx.x * NWAVES + wave, NGW = gridDim.x * NWAVES;
    const int hh = lane >> 4;
    float gg[16];
#pragma unroll
    for (int k = 0; k < 4; ++k) { const float4 g4 = *(const float4*)(a.g_gla + lane * 16 + 4 * k); gg[4 * k] = g4.x; gg[4 * k + 1] = g4.y; gg[4 * k + 2] = g4.z; gg[4 * k + 3] = g4.w; }
    for (int t = gw; t < T; t += NGW) {
        const uint4* fp = (const uint4*)(Of + (size_t)t * 1024 + lane * 16); const uint4* bp = (const uint4*)(Ob + (size_t)t * 1024 + lane * 16);
        const uint4* rp = (const uint4*)(P + (size_t)t * NP + C_GR + lane * 16);
        const uint4 f0 = fp[0], f1 = fp[1], b0 = bp[0], b1 = bp[1], r0 = rp[0], r1 = rp[1];
        attn_merge_token(part_o, part_lse, T, (size_t)t, A2 + (size_t)t * D + 1024, lane);
        const unsigned fw[8] = {f0.x, f0.y, f0.z, f0.w, f1.x, f1.y, f1.z, f1.w}, bw[8] = {b0.x, b0.y, b0.z, b0.w, b1.x, b1.y, b1.z, b1.w};
        const unsigned rw[8] = {r0.x, r0.y, r0.z, r0.w, r1.x, r1.y, r1.z, r1.w};
        float o[16]; float ss = 0.f;
#pragma unroll
        for (int k = 0; k < 8; ++k) { o[2 * k] = lo2f(fw[k]) + lo2f(bw[k]); o[2 * k + 1] = hi2f(fw[k]) + hi2f(bw[k]); ss += o[2 * k] * o[2 * k] + o[2 * k + 1] * o[2 * k + 1]; }
        ss += __shfl_xor(ss, 1); ss += __shfl_xor(ss, 2); ss += __shfl_xor(ss, 4); ss += __shfl_xor(ss, 8);
        const float rstd = rsqrtf(ss * (1.f / 256.f) + NORM_EPS);
        unsigned y[8];
#pragma unroll
        for (int k = 0; k < 8; ++k) y[k] = pack2(o[2 * k] * rstd * gg[2 * k] * silu_f(lo2f(rw[k])), o[2 * k + 1] * rstd * gg[2 * k + 1] * silu_f(hi2f(rw[k])));
        uint4* dp = (uint4*)(A2 + (size_t)t * D + lane * 16);
        dp[0] = make_uint4(y[0], y[1], y[2], y[3]); dp[1] = make_uint4(y[4], y[5], y[6], y[7]);
    }
    (void)hh;
}

typedef float f32x16 __attribute__((ext_vector_type(16)));
#define RT_CE(a_, b_) do { const float hi_ = fmaxf(a_, b_), lo_ = fminf(a_, b_); a_ = hi_; b_ = lo_; } while (0)
template <int N> __device__ __forceinline__ void rt_sort_desc(float (&v)[N], int base) {
#pragma unroll
    for (int k = 2; k <= 16; k <<= 1)
#pragma unroll
        for (int j = k >> 1; j > 0; j >>= 1)
#pragma unroll
            for (int i = 0; i < 16; ++i) {
                const int l = i ^ j;
                if (l > i) { if ((i & k) == 0) RT_CE(v[base + i], v[base + l]); else RT_CE(v[base + l], v[base + i]); }
            }
}
template <int N> __device__ __forceinline__ void rt_merge_desc(float (&v)[N], int a, int b) {
#pragma unroll
    for (int i = 0; i < 16; ++i) v[a + i] = fmaxf(v[a + i], v[b + 15 - i]);
#pragma unroll
    for (int j = 8; j > 0; j >>= 1)
#pragma unroll
        for (int i = 0; i < 16; ++i) { const int l = i ^ j; if (l > i) RT_CE(v[a + i], v[a + l]); }
}

__device__ __forceinline__ void route_stage_keys(const float* __restrict__ subk, int hh, unsigned char* lds) {
    const int tid = TID;
    __syncthreads();
    for (int e = tid; e < 2 * 128 * 16; e += 512) {
        const int c = e & 15, row = e >> 4;
        const float* src = subk + ((size_t)(hh * 2) * 128 + row) * 128 + c * 8;
        const float4 v0 = *(const float4*)src, v1 = *(const float4*)(src + 4);
        *(uint4*)(lds + row * 256 + ((c ^ (row & 15)) << 4)) = make_uint4(pack2(v0.x, v0.y), pack2(v0.z, v0.w), pack2(v1.x, v1.y), pack2(v1.z, v1.w));
    }
    __syncthreads();
}

__device__ __forceinline__ void route_tile(const u16* __restrict__ Q, int ldq, int hh, int tok_base, const unsigned char* lds,
                                           int* __restrict__ IDX, float* __restrict__ GATE) {
    const int lane = TID & 63, r = lane & 31, h = lane >> 5;
    float sc[128];
    {
        f32x16 X[4], Y[4];
#pragma unroll
        for (int kt = 0; kt < 4; ++kt) {
#pragma unroll
            for (int i = 0; i < 16; ++i) { X[kt][i] = 0.f; Y[kt][i] = 0.f; }
        }
        const u16* qrow = Q + (size_t)(tok_base + r) * ldq + hh * 256;
#pragma unroll
        for (int half = 0; half < 2; ++half) {
            bf16x8 qf[8];
#pragma unroll
            for (int ks = 0; ks < 8; ++ks) qf[ks] = *(const bf16x8*)(qrow + half * 128 + 16 * ks + 8 * h);
#pragma unroll
            for (int kt = 0; kt < 4; ++kt) {
                const int krow = half * 128 + 32 * kt + r;
#pragma unroll
                for (int ks = 0; ks < 8; ++ks) {
                    const bf16x8 kf = *(const bf16x8*)(lds + krow * 256 + (((2 * ks + h) ^ (krow & 15)) << 4));
                    if (half == 0) X[kt] = __builtin_amdgcn_mfma_f32_32x32x16_bf16(kf, qf[ks], X[kt], 0, 0, 0);
                    else Y[kt] = __builtin_amdgcn_mfma_f32_32x32x16_bf16(kf, qf[ks], Y[kt], 0, 0, 0);
                }
            }
        }
#pragma unroll
        for (int kt = 0; kt < 4; ++kt)
#pragma unroll
            for (int i = 0; i < 16; ++i) {
                const auto sw = __builtin_amdgcn_permlane32_swap(__float_as_uint(X[kt][i]), __float_as_uint(Y[kt][i]), false, false);
                const int key0 = 32 * kt + (i & 3) + 8 * (i >> 2);
                sc[kt * 32 + i] = __uint_as_float((sw[0] & 0xffffff80u) | (unsigned)key0);
                sc[kt * 32 + 16 + i] = __uint_as_float((sw[1] & 0xffffff80u) | (unsigned)(key0 + 4));
            }
    }
#pragma unroll
    for (int g = 0; g < 8; ++g) rt_sort_desc(sc, 16 * g);
    rt_merge_desc(sc, 0, 16); rt_merge_desc(sc, 32, 48); rt_merge_desc(sc, 64, 80); rt_merge_desc(sc, 96, 112);
    rt_merge_desc(sc, 0, 32); rt_merge_desc(sc, 64, 96);
    rt_merge_desc(sc, 0, 64);
    float l0[16], l1[16];
#pragma unroll
    for (int i = 0; i < 16; ++i) {
        const auto sw = __builtin_amdgcn_permlane32_swap(__float_as_uint(sc[i]), __float_as_uint(sc[i]), false, false);
        l0[i] = __uint_as_float(sw[0]); l1[i] = __uint_as_float(sw[1]);
    }
    float s0[16], s1[16]; int k0[16], k1[16];
#pragma unroll
    for (int i = 0; i < 16; ++i) {
        const unsigned a = __float_as_uint(l0[i]), b = __float_as_uint(l1[i]);
        s0[i] = __uint_as_float(a & 0xffffff80u); k0[i] = (int)(a & 0x7fu);
        s1[i] = __uint_as_float(b & 0xffffff80u); k1[i] = (int)(b & 0x7fu);
    }
    float cs[64];
    {
        int n = 0;
#pragma unroll
        for (int i = 0; i < 16; ++i)
#pragma unroll
            for (int j = 0; j < 16; ++j)
                if ((i + 1) * (j + 1) <= 16) { cs[n] = s0[i] + s1[j]; ++n; }
#pragma unroll
        for (int q = 50; q < 64; ++q) cs[q] = -3.0e38f;
    }
    float ct[64];
#pragma unroll
    for (int q = 0; q < 64; ++q) ct[q] = cs[q];
#pragma unroll
    for (int g = 0; g < 4; ++g) rt_sort_desc(ct, 16 * g);
    rt_merge_desc(ct, 0, 16); rt_merge_desc(ct, 32, 48); rt_merge_desc(ct, 0, 32);
    const float theta = ct[15], smax = ct[0];
    float den = 0.f;
    {
        int cnt = 0;
#pragma unroll
        for (int q = 0; q < 50; ++q) { const bool sel = (cs[q] >= theta) && (cnt < 16); den += sel ? __expf(cs[q] - smax) : 0.f; cnt += sel ? 1 : 0; }
    }
    const float inv = 1.f / den;
    const size_t obase = (size_t)(tok_base + r) * 128 + hh * 16;
    int pos = 0;
    {
        int n = 0;
#pragma unroll
        for (int i = 0; i < 16; ++i)
#pragma unroll
            for (int j = 0; j < 16; ++j)
                if ((i + 1) * (j + 1) <= 16) {
                    const bool sel = (cs[n] >= theta) && (pos < 16);
                    if (sel) {
                        if (h == 0) IDX[obase + pos] = k0[i] * 128 + k1[j];
                        else GATE[obase + pos] = __expf(cs[n] - smax) * inv;
                        ++pos;
                    }
                    ++n;
                }
    }
}
__device__ __forceinline__ void phase_route(const Args& a, unsigned char* lds) {
    const int hh = BID & 7, grp = BID >> 3, ngrp = GDIM >> 3, wave = TID >> 6;
    route_stage_keys(a.subk, hh, lds);
    int j = 0;
    for (int tile = grp; tile < T / 32; tile += ngrp, ++j)
        if ((j & 7) == wave) route_tile((const u16*)(a.ws + WS_Q), D, hh, tile * 32, lds, (int*)(a.ws + WS_IDX), (float*)(a.ws + WS_GATE));
    __syncthreads();
}

typedef __bf16 bf16x2_t __attribute__((ext_vector_type(2)));
__device__ __forceinline__ float dot2bf(unsigned w, unsigned x, float acc) {
    return __builtin_amdgcn_fdot2_f32_bf16(__builtin_bit_cast(bf16x2_t, w), __builtin_bit_cast(bf16x2_t, x), acc, false);
}
constexpr int TROW = 1152;
typedef float f32x2_t __attribute__((ext_vector_type(2)));
__device__ __forceinline__ void convert_tables(const Args& a) {
    const int lane = threadIdx.x & 63, wave = threadIdx.x >> 6;
    const int gw = blockIdx.x * NWAVES + wave, NGW = gridDim.x * NWAVES;
    for (int row = gw; row < 2 * 16384; row += NGW) {
        const bool isv = row >= 16384; const int e = isv ? row - 16384 : row;
        const f32x4* sp = (const f32x4*)((isv ? a.pv : a.pu) + (size_t)e * D);
        unsigned char* dst = a.ws + (isv ? WS_TV : WS_TU) + (size_t)e * TROW;
        f32x4 v[8];
#pragma unroll
        for (int k = 0; k < 8; ++k) v[k] = __builtin_nontemporal_load(sp + lane + 64 * k);
#pragma unroll
        for (int k = 0; k < 8; ++k) {
            float mx = fmaxf(fmaxf(fabsf(v[k][0]), fabsf(v[k][1])), fmaxf(fabsf(v[k][2]), fabsf(v[k][3])));
            mx = fmaxf(mx, __shfl_xor(mx, 1)); mx = fmaxf(mx, __shfl_xor(mx, 2)); mx = fmaxf(mx, __shfl_xor(mx, 4));
            float s = mx * (isv ? (1.f / 6.f) : (1.f / 7.f)); s = (s > 0.f) ? s : 1.f;
            u16 sb = f2bf(s); if (bf2f(sb) < s) sb += 1;
            const float inv = 1.f / bf2f(sb);
            unsigned p = 0u;
            if (isv) {
                p = __builtin_amdgcn_cvt_scalef32_pk_fp4_f32(p, v[k][0] * inv, v[k][1] * inv, 1.0f, 0);
                p = __builtin_amdgcn_cvt_scalef32_pk_fp4_f32(p, v[k][2] * inv, v[k][3] * inv, 1.0f, 1);
            } else {
#pragma unroll
                for (int j = 0; j < 4; ++j) { int q = (int)rintf(v[k][j] * inv) + 8; q = q < 1 ? 1 : (q > 15 ? 15 : q); p |= (unsigned)q << (4 * j); }
            }
            const int i = lane + 64 * k;
            *(u16*)(dst + 2 * i) = (u16)p;
            if ((lane & 7) == 0) *(u16*)(dst + 1024 + 2 * (i >> 3)) = sb;
        }
    }
}

__device__ __forceinline__ int idot32_i4(const uint4 w, const int (&hq)[8]) {
    const unsigned ww[4] = {w.x, w.y, w.z, w.w};
    int acc = 0;
#pragma unroll
    for (int k = 0; k < 4; ++k) {
        acc = __builtin_amdgcn_sdot4((int)(ww[k] & 0x0f0f0f0fu), hq[2 * k], acc, false);
        acc = __builtin_amdgcn_sdot4((int)((ww[k] >> 4) & 0x0f0f0f0fu), hq[2 * k + 1], acc, false);
    }
    return acc;
}
__device__ __forceinline__ void axpy32_fp4(const uint4 w, const float s, float (&acc)[32]) {
    const unsigned ww[4] = {w.x, w.y, w.z, w.w};
#pragma unroll
    for (int k = 0; k < 4; ++k) {
        const f32x2_t a0 = __builtin_amdgcn_cvt_scalef32_pk_f32_fp4(ww[k], 1.0f, 0), a1 = __builtin_amdgcn_cvt_scalef32_pk_f32_fp4(ww[k], 1.0f, 1);
        const f32x2_t a2 = __builtin_amdgcn_cvt_scalef32_pk_f32_fp4(ww[k], 1.0f, 2), a3 = __builtin_amdgcn_cvt_scalef32_pk_f32_fp4(ww[k], 1.0f, 3);
        acc[8 * k + 0] += s * a0.x; acc[8 * k + 1] += s * a0.y; acc[8 * k + 2] += s * a1.x; acc[8 * k + 3] += s * a1.y;
        acc[8 * k + 4] += s * a2.x; acc[8 * k + 5] += s * a2.y; acc[8 * k + 6] += s * a3.x; acc[8 * k + 7] += s * a3.y;
    }
}
__device__ __forceinline__ void phase_experts(const Args& a) {
    const u16* H2 = (const u16*)(a.ws + WS_ACT);
    const u16* X1 = (const u16*)(a.ws + WS_X1);
    const int* IDX = (const int*)(a.ws + WS_IDX);
    const float* GATE = (const float*)(a.ws + WS_GATE);
    const float* mod = (const float*)(a.ws + WS_MOD);
    const unsigned char* U = a.ws + WS_TU; const unsigned char* V = a.ws + WS_TV;
    const int lane = threadIdx.x & 63, wave = threadIdx.x >> 6;
    const int gw = blockIdx.x * NWAVES + wave, NGW = gridDim.x * NWAVES;
    int iv0 = 0, iv1 = 0; float gv0 = 0.f, gv1 = 0.f;
    int niv0 = 0, niv1 = 0; float ngv0 = 0.f, ngv1 = 0.f;
    uint4 rA[4], rB[4]; u16 sA[4], sB[4];
#define ROW_LOAD(TB_, r_, s_, r0_) do { _Pragma("unroll") for (int q = 0; q < 4; ++q) { \
            const int rr_ = (r0_) + q; const int e_ = __builtin_amdgcn_readlane(rr_ < 64 ? iv0 : iv1, rr_ & 63); \
            const unsigned char* rp_ = TB_ + (size_t)e_ * TROW; \
            r_[q] = *(const uint4*)(rp_ + lane * 16); s_[q] = *(const u16*)(rp_ + 1024 + lane * 2); } } while (0)
#define TOK_FETCH(t_, i0_, i1_, g0_, g1_) do { \
            i0_ = IDX[(size_t)(t_) * 128 + lane]; i1_ = IDX[(size_t)(t_) * 128 + 64 + lane]; \
            g0_ = GATE[(size_t)(t_) * 128 + lane]; g1_ = GATE[(size_t)(t_) * 128 + 64 + lane]; } while (0)
    if (gw < T) { TOK_FETCH(gw, iv0, iv1, gv0, gv1); ROW_LOAD(U, rA, sA, 0); }
    for (int t = gw; t < T; t += NGW) {
        const int b = t / S;
        const bool has_next = (t + NGW) < T;
        int hq[8]; int hsum8; float sh;
        {
            float h[32];
            const f32x4* hp = (const f32x4*)(H2 + (size_t)t * D + lane * 32);
#pragma unroll
            for (int k = 0; k < 4; ++k) { const f32x4 pn = __builtin_nontemporal_load(hp + k);
                const uint4 p = make_uint4(__float_as_uint(pn[0]), __float_as_uint(pn[1]), __float_as_uint(pn[2]), __float_as_uint(pn[3]));
                h[8 * k + 0] = lo2f(p.x); h[8 * k + 1] = hi2f(p.x); h[8 * k + 2] = lo2f(p.y); h[8 * k + 3] = hi2f(p.y);
                h[8 * k + 4] = lo2f(p.z); h[8 * k + 5] = hi2f(p.z); h[8 * k + 6] = lo2f(p.w); h[8 * k + 7] = hi2f(p.w); }
            float mx = 0.f;
#pragma unroll
            for (int i = 0; i < 32; ++i) mx = fmaxf(mx, fabsf(h[i]));
            sh = (mx > 0.f) ? mx * (1.f / 127.f) : 1.f;
            const float inv = 1.f / sh;
            int hs = 0;
#pragma unroll
            for (int k = 0; k < 4; ++k)
#pragma unroll
                for (int par = 0; par < 2; ++par) {
                    const int q0 = (int)rintf(h[8 * k + par] * inv), q1 = (int)rintf(h[8 * k + 2 + par] * inv), q2 = (int)rintf(h[8 * k + 4 + par] * inv), q3 = (int)rintf(h[8 * k + 6 + par] * inv);
                    hs += q0 + q1 + q2 + q3;
                    hq[2 * k + par] = (q0 & 0xff) | ((q1 & 0xff) << 8) | ((q2 & 0xff) << 16) | ((int)((unsigned)(q3 & 0xff) << 24));
                }
            hsum8 = 8 * hs;
        }
        float a0 = 0.f, a1 = 0.f;
#define U_COMPUTE(r_, s_, r0_) do { float d_[4]; \
            _Pragma("unroll") for (int q = 0; q < 4; ++q) d_[q] = (float)(idot32_i4(r_[q], hq) - hsum8) * (bf2f(s_[q]) * sh); \
            _Pragma("unroll") for (int o = 32; o > 0; o >>= 1) { _Pragma("unroll") for (int q = 0; q < 4; ++q) d_[q] += __shfl_xor(d_[q], o); } \
            _Pragma("unroll") for (int q = 0; q < 4; ++q) { const int rr_ = (r0_) + q; \
                if (rr_ < 64) a0 = (lane == rr_) ? d_[q] : a0; else a1 = (lane == rr_ - 64) ? d_[q] : a1; } } while (0)
#pragma unroll 1
        for (int r0 = 0; r0 < 128; r0 += 8) {
            ROW_LOAD(U, rB, sB, r0 + 4);
            U_COMPUTE(rA, sA, r0);
            if (r0 + 8 < 128) ROW_LOAD(U, rA, sA, r0 + 8); else ROW_LOAD(V, rA, sA, 0);
            U_COMPUTE(rB, sB, r0 + 4);
        }
        const float w0 = gv0 * gelu_f(a0), w1 = gv1 * gelu_f(a1);
        float acc[32];
#pragma unroll
        for (int i = 0; i < 32; ++i) acc[i] = 0.f;
#define V_COMPUTE(r_, s_, r0_) do { _Pragma("unroll") for (int q = 0; q < 4; ++q) { const int rr_ = (r0_) + q; \
                const float g_ = __builtin_bit_cast(float, __builtin_amdgcn_readlane(__builtin_bit_cast(int, rr_ < 64 ? w0 : w1), rr_ & 63)); \
                axpy32_fp4(r_[q], g_ * bf2f(s_[q]), acc); } } while (0)
        if (has_next) TOK_FETCH(t + NGW, niv0, niv1, ngv0, ngv1);
#pragma unroll 1
        for (int r0 = 0; r0 < 128; r0 += 8) {
            ROW_LOAD(V, rB, sB, r0 + 4);
            V_COMPUTE(rA, sA, r0);
            if (r0 + 8 < 128) ROW_LOAD(V, rA, sA, r0 + 8);
            else if (has_next) { iv0 = niv0; iv1 = niv1; gv0 = ngv0; gv1 = ngv1; ROW_LOAD(U, rA, sA, 0); }
            V_COMPUTE(rB, sB, r0 + 4);
        }
#undef U_COMPUTE
#undef V_COMPUTE
        float ss = 0.f;
#pragma unroll
        for (int k = 0; k < 8; ++k) {
            const int c0 = lane * 32 + 4 * k;
            const hw_f32x2 xn = __builtin_nontemporal_load((const hw_f32x2*)(X1 + (size_t)t * D + c0));
            const uint2 xp = make_uint2(__float_as_uint(xn[0]), __float_as_uint(xn[1]));
            const float4 xa = make_float4(lo2f(xp.x), hi2f(xp.x), lo2f(xp.y), hi2f(xp.y));
            const float4 ga = *(const float4*)(mod + b * 12288 + 5 * 2048 + c0);
            acc[4 * k + 0] = xa.x + ga.x * acc[4 * k + 0]; acc[4 * k + 1] = xa.y + ga.y * acc[4 * k + 1];
            acc[4 * k + 2] = xa.z + ga.z * acc[4 * k + 2]; acc[4 * k + 3] = xa.w + ga.w * acc[4 * k + 3];
#pragma unroll
            for (int i = 0; i < 4; ++i) ss += acc[4 * k + i] * acc[4 * k + i];
        }
        ss = wave_sum(ss);
        const float rstd = rsqrtf(ss * (1.f / D) + NORM_EPS);
#pragma unroll
        for (int k = 0; k < 8; ++k) {
            const int c0 = lane * 32 + 4 * k;
            const float4 gf = *(const float4*)(a.g_fin + c0);
            *(float4*)(a.out + (size_t)t * D + c0) = make_float4(acc[4 * k + 0] * rstd * gf.x, acc[4 * k + 1] * rstd * gf.y, acc[4 * k + 2] * rstd * gf.z, acc[4 * k + 3] * rstd * gf.w);
        }
    }
#undef ROW_LOAD
#undef TOK_FETCH
}

#define XB_TMO      128
#define XB_XCNT(j)  (256  + 64 * (j))
#define XB_XSUB(j)  (1280 + 64 * (j))
#define XB_XGEN(j)  (2304 + 64 * (j))
#define XB_TOP      3328
#define XB_TOPGEN   3392
#define XCD_BAR_WORDS 3456
#define XB_SPIN_CAP (1u << 18)

__device__ __forceinline__ unsigned xb_ld(unsigned* p)              { return __hip_atomic_load(p, __ATOMIC_RELAXED, __HIP_MEMORY_SCOPE_AGENT); }
__device__ __forceinline__ unsigned xb_add(unsigned* p, unsigned v) { return __hip_atomic_fetch_add(p, v, __ATOMIC_RELAXED, __HIP_MEMORY_SCOPE_AGENT); }
__device__ __forceinline__ unsigned xb_xcc_id() { return (unsigned)__builtin_amdgcn_s_getreg((3 << 11) | 20) & 0xFu; }
#define XB_SPIN(cond, bar) do { unsigned _sp = 0; while (cond) { __builtin_amdgcn_s_sleep(1); \
    if ((++_sp & 255u) == 0u) { if (xb_ld(&(bar)[XB_TMO])) break; if (_sp > XB_SPIN_CAP) { atomicAdd(&(bar)[XB_TMO], 1u); break; } } } } while (0)

struct XcdBarrier {
    unsigned* bar; unsigned x;
    volatile LAS unsigned* st;
};

__device__ __forceinline__ XcdBarrier xcd_barrier_post(unsigned* bar, volatile LAS unsigned* st) {
    XcdBarrier b; b.bar = bar; b.x = xb_xcc_id(); b.st = st;
    if (threadIdx.x == 0) (void)xb_add(&bar[XB_XCNT(b.x)], 1u);
    return b;
}
__device__ __forceinline__ void xcd_barrier_complete(unsigned* bar, unsigned x, unsigned& nloc, unsigned& nx) {
    const unsigned G = gridDim.x * gridDim.y * gridDim.z;
    unsigned sum, cnt, mine, sp = 0u;
    for (;;) {
        sum = 0u; cnt = 0u; mine = 0u;
#pragma unroll
        for (unsigned j = 0; j < 16; ++j) { const unsigned c = xb_ld(&bar[XB_XCNT(j)]); sum += c; cnt += (c > 0u) ? 1u : 0u; mine = (j == x) ? c : mine; }
        if (sum == G) break;
        __builtin_amdgcn_s_sleep(1);
        if ((++sp & 255u) == 0u) { if (xb_ld(&bar[XB_TMO])) break; if (sp > XB_SPIN_CAP) { atomicAdd(&bar[XB_TMO], 1u); break; } }
    }
    nloc = mine > 0u ? mine : 1u; nx = cnt > 0u ? cnt : 1u;
}

__device__ __forceinline__ void xcd_barrier(const XcdBarrier& b) {
    asm volatile("s_waitcnt vmcnt(0)" ::: "memory");
    __syncthreads();
    if (threadIdx.x == 0) {
        unsigned* bar = b.bar;
        __builtin_amdgcn_s_waitcnt(0);
        unsigned nloc = b.st[0], nx = b.st[1];
        if (nloc == 0u) { xcd_barrier_complete(bar, b.x, nloc, nx); b.st[0] = nloc; b.st[1] = nx; }
        const unsigned old = xb_add(&bar[XB_XSUB(b.x)], 1u);
        const unsigned gen = old / nloc;
        if (old + 1u == (gen + 1u) * nloc) {
            __builtin_amdgcn_fence(__ATOMIC_RELEASE, "agent");
            asm volatile("s_waitcnt vmcnt(0)" ::: "memory");
            const unsigned og = xb_add(&bar[XB_TOP], 1u);
            const unsigned tg = og / nx;
            if (og + 1u == (tg + 1u) * nx) xb_add(&bar[XB_TOPGEN], 1u);
            else XB_SPIN(xb_ld(&bar[XB_TOPGEN]) == tg, bar);
            __builtin_amdgcn_fence(__ATOMIC_ACQUIRE, "agent");
            xb_add(&bar[XB_XGEN(b.x)], 1u);
            asm volatile("s_waitcnt vmcnt(0)" ::: "memory");
        } else {
            XB_SPIN(xb_ld(&bar[XB_XGEN(b.x)]) == gen, bar);
            __builtin_amdgcn_fence(__ATOMIC_ACQUIRE, "agent");
            asm volatile("s_waitcnt vmcnt(0)" ::: "memory");
        }
    }
    __syncthreads();
}

constexpr int NPHASES = 11;
__global__ void __launch_bounds__(NTHREADS, 2) mk_fwd(Args a) {
    extern __shared__ __attribute__((aligned(16))) unsigned char lds[];
    cg::grid_group grid = cg::this_grid();
    const int lo = a.ph_lo, hi = a.ph_hi;
    volatile LAS unsigned* xbw = (volatile LAS unsigned*)(lds + LDS_MAIN);
    if (threadIdx.x < 4) xbw[threadIdx.x] = 0u;
    __syncthreads();
    XcdBarrier xbar = xcd_barrier_post((unsigned*)(a.ws + WS_CTL), xbw);
#define IN(k) (lo <= (k) && (k) < hi)
    if (lo < 0) grid.sync();
#define SEAM(k) do { if (IN(k) && IN((k) + 1)) xcd_barrier(xbar); } while (0)
    const float* mod = (const float*)(a.ws + WS_MOD);
    if (IN(0)) phase0(a, lds);
    SEAM(0);
    if (IN(1)) norm_mod_phase<false>(a.x, a.g_mix, mod, 0, 1, (u16*)(a.ws + WS_ACT));
    SEAM(1);
    if (IN(2)) { gemm8(lds, (const u16*)(a.ws + WS_ACT), (const u16*)(a.ws + WS_WIN), T, NP, D, EpiProj{(u16*)(a.ws + WS_P), (const float*)(a.ws + WS_CS)}); gz_phase(lds, (const u16*)(a.ws + WS_ACT), (const u16*)(a.ws + WS_WIN) + (size_t)NP * D, (float*)(a.ws + WS_GZ)); }
    SEAM(2);
    if (IN(3)) phase_rope_prep(a, lds);
    SEAM(3);
    if (IN(4)) phase_mixers(a, lds);
    SEAM(4);
    if (IN(5)) phase_gla_fin(a);
    SEAM(5);
    if (IN(6)) gemm8(lds, (const u16*)(a.ws + WS_ACT), (const u16*)(a.ws + WS_WOUT), T, D, D, EpiResid{a.x, mod, (u16*)(a.ws + WS_X1)});
    SEAM(6);
    if (IN(7)) { norm_mod_phase<true>(a.ws + WS_X1, a.g_ffn, mod, 3, 4, (u16*)(a.ws + WS_ACT)); convert_tables(a); }
    SEAM(7);
    if (IN(8)) gemm8(lds, (const u16*)(a.ws + WS_ACT), (const u16*)(a.ws + WS_WPQ), T, D, D, EpiBf16{(u16*)(a.ws + WS_Q)});
    SEAM(8);
    if (IN(9)) phase_route(a, lds);
    SEAM(9);
    if (IN(10)) phase_experts(a);
#ifdef PROBE_REP10
    grid.sync(); phase_experts(a);
#endif
#ifdef PROBE_REP9
    grid.sync(); phase_route(a, lds); grid.sync(); phase_experts(a);
#endif
#undef IN
#undef SEAM
}

#ifndef MK_ONE_LAUNCH
#define MK_ONE_LAUNCH 1
#endif
extern "C" void kernel_launch(void* const* d_in, const int* in_sizes, int n_in, void* d_out, int out_size, void* d_ws, size_t ws_size, hipStream_t stream) {
    static int grid = 0;
    if (grid == 0) {
        if (n_in != 19 || out_size != T * D || ws_size < WS_END) {
            fprintf(stderr, "kernel_launch: unexpected shapes: n_in %d out %d ws %zu (need %zu)\n", n_in, out_size, ws_size, (size_t)WS_END);
            grid = -1; return;
        }
        int dev = 0, cus = 0, per_cu = 0;
        (void)hipGetDevice(&dev);
        (void)hipDeviceGetAttribute(&cus, hipDeviceAttributeMultiprocessorCount, dev);
        (void)hipFuncSetAttribute((const void*)mk_fwd, hipFuncAttributeMaxDynamicSharedMemorySize, LDS_BYTES);
        (void)hipOccupancyMaxActiveBlocksPerMultiprocessor(&per_cu, (const void*)mk_fwd, NTHREADS, LDS_BYTES);
        if (per_cu < 1) { fprintf(stderr, "kernel_launch: occupancy query says %d blocks/CU\n", per_cu); grid = -1; return; }
        grid = cus;
        (void)hipGetLastError();
    }
    if (grid < 0) return;
    Args a{};
    a.x = (const float*)d_in[0]; a.c = (const float*)d_in[1]; a.pos = (const int*)d_in[2]; a.w_ada = (const float*)d_in[3];
    a.b_ada = (const float*)d_in[4]; a.g_mix = (const float*)d_in[5]; a.w_in = (const float*)d_in[6]; a.wgf = (const float*)d_in[7];
    a.bgf = (const float*)d_in[8]; a.wgb = (const float*)d_in[9]; a.bgb = (const float*)d_in[10]; a.g_gla = (const float*)d_in[11];
    a.w_out = (const float*)d_in[12]; a.g_ffn = (const float*)d_in[13]; a.w_pq = (const float*)d_in[14]; a.subk = (const float*)d_in[15];
    a.pu = (const float*)d_in[16]; a.pv = (const float*)d_in[17]; a.g_fin = (const float*)d_in[18];
    a.out = (float*)d_out; a.ws = (unsigned char*)d_ws;
#if MK_ONE_LAUNCH
    (void)hipMemsetAsync((unsigned char*)d_ws + WS_CTL, 0, XCD_BAR_WORDS * 4, stream);
    a.ph_lo = 0; a.ph_hi = NPHASES;
    void* args[] = {&a};
    hipError_t e = hipLaunchCooperativeKernel((const void*)mk_fwd, dim3(grid), dim3(NTHREADS), args, LDS_BYTES, stream);
    if (e != hipSuccess) fprintf(stderr, "cooperative launch failed: %s (grid %d)\n", hipGetErrorString(e), grid);
#else
    for (int p = 0; p < NPHASES; ++p) {
        a.ph_lo = p; a.ph_hi = p + 1;
        hipLaunchKernelGGL(mk_fwd, dim3(grid), dim3(NTHREADS), LDS_BYTES, stream, a);
    }
#endif
}
```

```cpp
#include <hip/hip_runtime.h>
#include <hip/hip_cooperative_groups.h>
#include <cstdio>
#include <cstdint>

namespace cg = cooperative_groups;

typedef unsigned short u16;
typedef __attribute__((ext_vector_type(8))) short bf16x8;
typedef __attribute__((ext_vector_type(4))) float f32x4;
typedef short s16x4 __attribute__((ext_vector_type(4)));
#define TID ((int)threadIdx.x)
#define BID ((int)blockIdx.x)
#define GDIM ((int)gridDim.x)
#define LAS __attribute__((address_space(3)))

constexpr int D = 2048, NB = 4, S = 4096, T = NB * S;
constexpr int INW = 6176;
constexpr int NP = 6144;
constexpr int NPAD = 6208;
constexpr int C_GQ = 0, C_GK = 512, C_GV = 1024, C_GR = 2048, C_DQ = 3072, C_DK = 4096, C_DV = 5120;
constexpr int NTHREADS = 512, NWAVES = 8;
constexpr int LDS_MAIN = 128 * 1024;
constexpr int LDS_BYTES = LDS_MAIN + 16;
constexpr float NORM_EPS = 1e-6f;

constexpr size_t WS_CTL = 0;
constexpr size_t WS_MOD = 65536;
constexpr size_t WS_CS = 524288;
constexpr size_t WS_WIN = WS_CS + (size_t)T * 64 * 8;
constexpr size_t WS_WOUT = WS_WIN + (size_t)NPAD * D * 2;
constexpr size_t WS_WPQ = WS_WOUT + (size_t)D * D * 2;
constexpr size_t WS_ACT = WS_WPQ + (size_t)D * D * 2;
constexpr size_t WS_P = WS_ACT + (size_t)T * D * 2;
constexpr size_t WS_X1 = WS_P;
constexpr size_t WS_Q = WS_P + (size_t)T * D * 4;
constexpr size_t WS_GZ = WS_P + (size_t)T * NP * 2;
constexpr int GLA_NPREP = NB * 4 * 2 * (S / 64);
constexpr size_t WS_QD = WS_GZ + (size_t)T * 32 * 4;
constexpr size_t WS_KE = WS_QD + (size_t)GLA_NPREP * 16384;
constexpr size_t WS_AT = WS_KE + (size_t)GLA_NPREP * 16384;
constexpr size_t WS_DEC = WS_AT + (size_t)GLA_NPREP * 8192;
constexpr size_t WS_OFB = WS_DEC + (size_t)GLA_NPREP * 512;
constexpr size_t WS_IDX = WS_OFB + (size_t)2 * T * 1024 * 2;
constexpr size_t WS_GATE = WS_IDX + (size_t)T * 128 * 4;
constexpr size_t WS_END = WS_GATE + (size_t)T * 128 * 4;
constexpr size_t WS_TU = WS_QD;
constexpr size_t WS_TV = WS_QD + (size_t)16384 * 1152;
static_assert(WS_TV + (size_t)16384 * 1152 <= WS_IDX, "table region");

struct Args {
    const float* x; const float* c; const int* pos; const float* w_ada; const float* b_ada; const float* g_mix;
    const float* w_in; const float* wgf; const float* bgf; const float* wgb; const float* bgb; const float* g_gla;
    const float* w_out; const float* g_ffn; const float* w_pq; const float* subk; const float* pu; const float* pv; const float* g_fin;
    float* out; unsigned char* ws; int ph_lo, ph_hi;
};

__device__ __forceinline__ float bf2f(u16 h) { return __uint_as_float(((unsigned)h) << 16); }
typedef __bf16 hw_bf16x2 __attribute__((ext_vector_type(2)));
typedef float hw_f32x2 __attribute__((ext_vector_type(2)));
__device__ __forceinline__ unsigned pack2(float a, float b) { const hw_f32x2 f = {a, b}; return __builtin_bit_cast(unsigned, __builtin_convertvector(f, hw_bf16x2)); }
__device__ __forceinline__ u16 f2bf(float f) { return (u16)(pack2(f, 0.f) & 0xffffu); }
__device__ __forceinline__ float lo2f(unsigned p) { return __uint_as_float(p << 16); }
__device__ __forceinline__ float hi2f(unsigned p) { return __uint_as_float(p & 0xffff0000u); }
__device__ __forceinline__ float wave_sum(float v) {
#pragma unroll
    for (int o = 32; o > 0; o >>= 1) v += __shfl_xor(v, o);
    return v;
}
__device__ __forceinline__ float wave_max(float v) {
#pragma unroll
    for (int o = 32; o > 0; o >>= 1) v = fmaxf(v, __shfl_xor(v, o));
    return v;
}
__device__ __forceinline__ float silu_f(float v) { return v / (1.f + __expf(-v)); }
__device__ __forceinline__ float gelu_f(float a) { return 0.5f * a * (1.f + erff(a * 0.70710678118654752f)); }
__device__ __forceinline__ float logsigmoid_f(float z) { return z < 0.f ? z - log1pf(expf(z)) : -log1pf(expf(-z)); }

constexpr int MOD_BLOCKS = 96;
__device__ __forceinline__ void p0_mod(const Args& a, unsigned char* lds, int bi) {
    float* sc = (float*)lds;
    float* red = sc + 4 * 2048;
    const int tid = threadIdx.x, lane = tid & 63, wave = tid >> 6;
    for (int i = tid; i < 4 * 2048; i += NTHREADS) sc[i] = silu_f(a.c[i]);
    __syncthreads();
    const int j0 = bi * 128 + lane * 2;
    float acc[4][2];
#pragma unroll
    for (int b = 0; b < 4; ++b) { acc[b][0] = 0.f; acc[b][1] = 0.f; }
    const int k0 = wave * 256;
#pragma unroll 8
    for (int kk = 0; kk < 256; ++kk) {
        const int k = k0 + kk;
        const hw_f32x2 wv_ = __builtin_nontemporal_load((const hw_f32x2*)(a.w_ada + (size_t)k * 12288 + j0)); const float2 w = make_float2(wv_[0], wv_[1]);
#pragma unroll
        for (int b = 0; b < 4; ++b) { const float s = sc[b * 2048 + k]; acc[b][0] += s * w.x; acc[b][1] += s * w.y; }
    }
#pragma unroll
    for (int b = 0; b < 4; ++b) { red[(wave * 4 + b) * 128 + lane * 2] = acc[b][0]; red[(wave * 4 + b) * 128 + lane * 2 + 1] = acc[b][1]; }
    __syncthreads();
    float* mod = (float*)(a.ws + WS_MOD);
    {
        const int b = tid >> 7, jc = tid & 127;
        float s = 0.f;
#pragma unroll
        for (int w = 0; w < 8; ++w) s += red[(w * 4 + b) * 128 + jc];
        mod[b * 12288 + bi * 128 + jc] = s + a.b_ada[bi * 128 + jc];
    }
    __syncthreads();
}

__device__ __forceinline__ void p0_transpose_item(const float* __restrict__ W, int ldw, int k0, int src_col0, int n_valid,
                                                  u16* __restrict__ WT, int ldt, int n_out0, unsigned char* wlds, bool rope_perm = false) {
    u16* tl = (u16*)wlds;
    const int lane = threadIdx.x & 63;
    const int rsub = lane >> 4, nc = (lane & 15) * 4;
    int scol = src_col0 + nc;
    if (rope_perm) { const int p = (n_out0 & 64) + nc, g = p >> 3; scol = (src_col0 - (n_out0 & 64)) + ((p & 4) ? 64 + 4 * g : 4 * g); }
    float4 v[16];
#pragma unroll
    for (int j = 0; j < 16; ++j) {
        const int k = 4 * j + rsub;
        if (nc < n_valid) { const f32x4 q_ = __builtin_nontemporal_load((const f32x4*)(W + (size_t)(k0 + k) * ldw + scol)); v[j] = make_float4(q_[0], q_[1], q_[2], q_[3]); }
        else v[j] = make_float4(0.f, 0.f, 0.f, 0.f);
    }
#pragma unroll
    for (int j = 0; j < 16; ++j) {
        const int k = 4 * j + rsub;
        tl[(nc + 0) * 72 + k] = f2bf(v[j].x); tl[(nc + 1) * 72 + k] = f2bf(v[j].y); tl[(nc + 2) * 72 + k] = f2bf(v[j].z); tl[(nc + 3) * 72 + k] = f2bf(v[j].w);
    }
#pragma unroll
    for (int j = 0; j < 8; ++j) {
        const int c = lane + 64 * j, n = c >> 3, kc = (c & 7) * 8;
        const uint4 o = *(const uint4*)(tl + n * 72 + kc);
        *(uint4*)(WT + (size_t)(n_out0 + n) * ldt + k0 + kc) = o;
    }
}

__device__ __forceinline__ void phase0(const Args& a, unsigned char* lds) {
    const int bi = blockIdx.x, G = gridDim.x, tid = threadIdx.x, wave = tid >> 6;
    const bool modblk = (G > MOD_BLOCKS) && (bi < MOD_BLOCKS);
    if (G > MOD_BLOCKS) { if (modblk) p0_mod(a, lds, bi); }
    else { for (int mb = bi; mb < MOD_BLOCKS; mb += G) p0_mod(a, lds, mb); }
    const int nb = (G > MOD_BLOCKS) ? G - MOD_BLOCKS : G, b0 = (G > MOD_BLOCKS) ? bi - MOD_BLOCKS : bi;
    if (!modblk) {
        constexpr int I_IN = 32 * (NPAD / 64), I_SQ = 32 * 32;
        u16* WinT = (u16*)(a.ws + WS_WIN); u16* WoutT = (u16*)(a.ws + WS_WOUT); u16* WpqT = (u16*)(a.ws + WS_WPQ);
        unsigned char* wlds = lds + wave * 9216;
        for (int it = b0 * NWAVES + wave; it < I_IN + 2 * I_SQ; it += nb * NWAVES) {
            if (it < I_IN) {
                const int kt = it & 31, nt = it >> 5;
                const int n0 = nt * 64;
                int src, nv;
                if (n0 < 3072) { src = n0; nv = 64; }
                else if (n0 < 6144) { src = n0 + 32; nv = 64; }
                else if (n0 == 6144) { src = 3072; nv = 32; }
                else { src = 0; nv = 0; }
                p0_transpose_item(a.w_in, INW, kt * 64, src, nv, WinT, D, n0, wlds, n0 >= C_DQ && n0 < C_DV);
            } else if (it < I_IN + I_SQ) {
                const int r = it - I_IN; const int kt = r & 31, nt = r >> 5;
                p0_transpose_item(a.w_out, D, kt * 64, nt * 64, 64, WoutT, D, nt * 64, wlds);
            } else {
                const int r = it - I_IN - I_SQ; const int kt = r & 31, nt = r >> 5;
                p0_transpose_item(a.w_pq, D, kt * 64, nt * 64, 64, WpqT, D, nt * 64, wlds);
            }
        }
        float2* cs = (float2*)(a.ws + WS_CS);
        for (int i = b0 * NTHREADS + tid; i < T * 64; i += nb * NTHREADS) {
            const int t = i >> 6, f = i & 63;
            const float inv_freq = powf(10000.0f, -(float)f * 2.0f / 128.0f);
            const float ang = (float)a.pos[t] * inv_freq;
            const double rev = (double)ang * 0.15915494309189533577;
            const float fr = (float)(rev - floor(rev));
            cs[i] = make_float2(__builtin_amdgcn_cosf(fr), __builtin_amdgcn_sinf(fr));
        }
    }
    __syncthreads();
}

template <bool BF16IN> __device__ __forceinline__ void norm_mod_phase(const void* __restrict__ xin_, const float* __restrict__ g, const float* __restrict__ mod,
                                               int sh_chunk, int sc_chunk, u16* __restrict__ outp) {
    const int lane = threadIdx.x & 63, wave = threadIdx.x >> 6;
    const int gw = blockIdx.x * NWAVES + wave, NGW = gridDim.x * NWAVES;
    float4 v[8], vn[8];
#define NM_LOAD(dst_, t_) do { if (BF16IN) { const hw_f32x2* xr_ = (const hw_f32x2*)((const u16*)xin_ + (size_t)(t_) * D); \
            _Pragma("unroll") for (int m = 0; m < 8; ++m) { const hw_f32x2 q_ = __builtin_nontemporal_load(xr_ + lane + 64 * m); const unsigned px_ = __float_as_uint(q_[0]), py_ = __float_as_uint(q_[1]); \
                dst_[m] = make_float4(lo2f(px_), hi2f(px_), lo2f(py_), hi2f(py_)); } } \
        else { const f32x4* xr_ = (const f32x4*)((const float*)xin_ + (size_t)(t_) * D); \
            _Pragma("unroll") for (int m = 0; m < 8; ++m) { const f32x4 q_ = __builtin_nontemporal_load(xr_ + lane + 64 * m); dst_[m] = make_float4(q_[0], q_[1], q_[2], q_[3]); } } } while (0)
    if (gw < T) NM_LOAD(v, gw);
    for (int t = gw; t < T; t += NGW) {
        const int b = t / S;
        if (t + NGW < T) NM_LOAD(vn, t + NGW);
        float ss = 0.f;
#pragma unroll
        for (int m = 0; m < 8; ++m) ss += v[m].x * v[m].x + v[m].y * v[m].y + v[m].z * v[m].z + v[m].w * v[m].w;
        ss = wave_sum(ss);
        const float rstd = rsqrtf(ss * (1.f / D) + NORM_EPS);
        const float4* gp = (const float4*)g;
        const float4* shp = (const float4*)(mod + b * 12288 + sh_chunk * 2048);
        const float4* scp = (const float4*)(mod + b * 12288 + sc_chunk * 2048);
        uint2* op = (uint2*)(outp + (size_t)t * D);
#pragma unroll
        for (int m = 0; m < 8; ++m) {
            const int i = lane + 64 * m;
            const float4 gg = gp[i], sh = shp[i], sc = scp[i];
            const float h0 = v[m].x * rstd * gg.x * (1.f + sc.x) + sh.x;
            const float h1 = v[m].y * rstd * gg.y * (1.f + sc.y) + sh.y;
            const float h2 = v[m].z * rstd * gg.z * (1.f + sc.z) + sh.z;
            const float h3 = v[m].w * rstd * gg.w * (1.f + sc.w) + sh.w;
            op[i] = make_uint2(pack2(h0, h1), pack2(h2, h3));
        }
#pragma unroll
        for (int m = 0; m < 8; ++m) v[m] = vn[m];
    }
#undef NM_LOAD
}

namespace pg8 {
#define PG8_LAS __attribute__((address_space(3)))
typedef unsigned short bf16_t;
typedef short bf16x8 __attribute__((ext_vector_type(8)));
typedef float f32x4 __attribute__((ext_vector_type(4)));
typedef unsigned u32x4 __attribute__((ext_vector_type(4)));
constexpr int BM = 256, BK = 64, HALF = 128, HTB = HALF * BK * 2  , STAGE_BYTES = 8 * HTB, NXCD = 8, WGM = 8;

__host__ __device__ __forceinline__ int lds_byte(int r, int c) { const int st = (r >> 4) * 2 + (c >> 5), rr = r & 15, cc = c & 31, ob = rr * 64 + cc * 2; return st * 1024 + (ob ^ (((ob >> 9) & 1) << 5)); }
__host__ __device__ __forceinline__ void stage_rc(int b, int& R, int& C) { const int st = b / 1024, sb = b % 1024, swz = sb ^ (((sb >> 9) & 1) << 5); R = (st >> 1) * 16 + swz / 64; C = (st & 1) * 32 + (swz % 64) / 2; }
__host__ __device__ __forceinline__ int perm32(int rho) { const int n = rho >> 4, i = rho & 15; return 8 * (i >> 2) + 4 * n + (i & 3); }

struct Unit { int pm, pn; };
struct Gemm { const bf16_t* A; const bf16_t* Bt; int M, N, K; };

struct StaticOrder {
    int nM, nN, nwg, G, c;
    __host__ __device__ void init(int M, int N, int G_, int c_) { nM = M / BM; nN = N / BM; nwg = nM * nN; G = G_; c = c_; }
    __host__ __device__ bool next(int i, Unit& u) const {
        const long L = (long)i * G + c; if (L >= nwg) return false;
        int wgid = (int)L; { const int q = nwg / NXCD, r = nwg % NXCD, xcd = wgid % NXCD, off = wgid / NXCD; wgid = (xcd < r ? xcd * (q + 1) : r * (q + 1) + (xcd - r) * q) + off; }
        const int nig = WGM * nN, gid = wgid / nig, fm = gid * WGM, gsz = (nM - fm) < WGM ? (nM - fm) : WGM;
        u.pm = fm + ((wgid % nig) % gsz); u.pn = (wgid % nig) / gsz; return true;
    }
    __device__ __forceinline__ void a_ready(const Unit&) const {}
    __device__ __forceinline__ void done(const Unit&) const {}
};
__device__ __forceinline__ unsigned cvt_pk_bf16(float lo, float hi) { unsigned r; asm volatile("v_cvt_pk_bf16_f32 %0, %1, %2" : "=v"(r) : "v"(lo), "v"(hi)); return r; }
typedef float f32x2 __attribute__((ext_vector_type(2)));
template <class Epi, class Sched, bool STAMP = false>
__device__ __forceinline__ void gemm_phase(PG8_LAS unsigned char* lds, const Gemm g, const Sched& S, const Epi& E, unsigned long long* stamps) {
    const int tid = threadIdx.x, wid = __builtin_amdgcn_readfirstlane(tid >> 6), lane = tid & 63, wr = wid >> 2, wc = wid & 3, fr = lane & 15, fq = lane >> 4;
    const int K = g.K, nt = K / BK;
    int ts_lo = 0, ts_hi = 0, nts = 0; const unsigned long long rt_entry = STAMP ? (unsigned long long)wall_clock64() : 0ull;
#define PG8_STAMP() do { if (STAMP && wid == 0 && nts < 64) { const unsigned long long _c = (unsigned long long)clock64(); \
        ts_lo = (lane == nts) ? (int)(unsigned)_c : ts_lo; ts_hi = (lane == nts) ? (int)(unsigned)(_c >> 32) : ts_hi; ++nts; } } while (0)
    PG8_STAMP();
    unsigned voffA[2], voffB[2];
#pragma unroll
    for (int i = 0; i < 2; ++i) { int R, C; stage_rc(tid * 16 + i * 8192, R, C); const int Rb = Epi::PERM ? ((R & ~31) + perm32(R & 31)) : R;
        voffA[i] = (unsigned)(R * K + C) * 2u; voffB[i] = (unsigned)(Rb * K + C) * 2u; }
    const size_t kstep = (size_t)(BK * 2);
    const size_t hstep = (size_t)HALF * K * 2;
    const size_t tstep = 2 * hstep;
    const unsigned ldsw = (unsigned)wid * 1024u;
    const int aoff = lds_byte(wr * 64 + fr, fq * 8), boff = lds_byte(wc * 32 + fr, fq * 8);
#define PG8_SA(b, h) (((b) * 2 + (h)) * HTB)
#define PG8_SB(b, h) ((4 + (b) * 2 + (h)) * HTB)
#define PG8_STAGE(bufoff, gbase, voff) do { _Pragma("unroll") for (int _i = 0; _i < 2; ++_i) \
        __builtin_amdgcn_global_load_lds((const unsigned*)((const char*)(gbase) + (voff)[_i]), (PG8_LAS unsigned*)(lds + (bufoff) + ldsw + _i * 8192), 16, 0, 0); } while (0)
#define PG8_LDA(dst, b, h) do { _Pragma("unroll") for (int m = 0; m < 4; ++m) _Pragma("unroll") for (int k = 0; k < 2; ++k) dst[m][k] = *(const PG8_LAS bf16x8*)(lds + PG8_SA(b, h) + aoff + m * 2048 + k * 1024); } while (0)
#define PG8_LDB(dst, b, h) do { _Pragma("unroll") for (int n = 0; n < 2; ++n) _Pragma("unroll") for (int k = 0; k < 2; ++k) dst[n][k] = *(const PG8_LAS bf16x8*)(lds + PG8_SB(b, h) + boff + n * 2048 + k * 1024); } while (0)
#define PG8_MMA(ai, bj, At, Bt) do { __builtin_amdgcn_s_setprio(1); _Pragma("unroll") for (int m = 0; m < 4; ++m) _Pragma("unroll") for (int n = 0; n < 2; ++n) _Pragma("unroll") for (int k = 0; k < 2; ++k) \
        acc[ai][bj][m][n] = __builtin_amdgcn_mfma_f32_16x16x32_bf16(Bt[n][k], At[m][k], acc[ai][bj][m][n], 0, 0, 0); __builtin_amdgcn_s_setprio(0); } while (0)
#define PG8_WAIT_V(n) asm volatile("s_waitcnt vmcnt(" #n ")" ::: "memory")
#define PG8_WAIT_L(n) asm volatile("s_waitcnt lgkmcnt(" #n ")" ::: "memory")
#define PG8_BAR __builtin_amdgcn_s_barrier()
#define PG8_SCHED __builtin_amdgcn_sched_barrier(0)
    Unit cur, nxt; int ui = 0;
    if (!S.next(0, cur)) return;
    f32x4 acc[2][2][4][2];
#pragma unroll
    for (int a = 0; a < 2; ++a)
#pragma unroll
        for (int b = 0; b < 2; ++b)
#pragma unroll
            for (int m = 0; m < 4; ++m)
#pragma unroll
                for (int n = 0; n < 2; ++n) acc[a][b][m][n] = (f32x4){0.f, 0.f, 0.f, 0.f};
    bf16x8 At[4][2], B0[2][2], B1[2][2];
    const char* cA = (const char*)g.A + (size_t)cur.pm * tstep; const char* cB = (const char*)g.Bt + (size_t)cur.pn * tstep;
    S.a_ready(cur);
    PG8_STAGE(PG8_SB(0, 0), cB, voffB); PG8_STAGE(PG8_SA(0, 0), cA, voffA); PG8_STAGE(PG8_SB(0, 1), cB + hstep, voffB); PG8_STAGE(PG8_SA(0, 1), cA + hstep, voffA);
    if (wr == 1) PG8_BAR;
    PG8_WAIT_V(4); PG8_BAR;
    PG8_STAGE(PG8_SB(1, 0), cB + kstep, voffB); PG8_STAGE(PG8_SA(1, 0), cA + kstep, voffA); PG8_STAGE(PG8_SB(1, 1), cB + hstep + kstep, voffB);
    PG8_WAIT_V(6); PG8_BAR;
    PG8_STAMP();
    for (;;) {
        const bool has_next = S.next(ui + 1, nxt);
        const char* nA = has_next ? (const char*)g.A + (size_t)nxt.pm * tstep : cA; const char* nB = has_next ? (const char*)g.Bt + (size_t)nxt.pn * tstep : cB;
        for (int t = 0; t < nt; t += 2) {
            const bool last = (t == nt - 2);
            const char* a1 = cA + (size_t)(t + 1) * kstep;
            const char* a2 = last ? nA : cA + (size_t)(t + 2) * kstep; const char* b2 = last ? nB : cB + (size_t)(t + 2) * kstep;
            const char* a3 = a2 + kstep; const char* b3 = b2 + kstep;
            if (last && has_next) S.a_ready(nxt);
            PG8_LDB(B0, 0, 0); PG8_SCHED; PG8_LDA(At, 0, 0); PG8_STAGE(PG8_SA(1, 1), a1 + hstep, voffA);
            PG8_WAIT_L(8); PG8_BAR; PG8_WAIT_L(0); PG8_MMA(0, 0, At, B0); PG8_BAR; PG8_SCHED;
            PG8_LDB(B1, 0, 1); PG8_STAGE(PG8_SB(0, 0), b2, voffB);
            PG8_BAR; PG8_WAIT_L(0); PG8_MMA(0, 1, At, B1); PG8_BAR;
            PG8_LDA(At, 0, 1); PG8_STAGE(PG8_SA(0, 0), a2, voffA);
            PG8_BAR; PG8_WAIT_L(0); PG8_MMA(1, 0, At, B0); PG8_BAR; PG8_SCHED;
            PG8_STAGE(PG8_SB(0, 1), b2 + hstep, voffB);
            PG8_WAIT_V(6); PG8_BAR; PG8_MMA(1, 1, At, B1); PG8_BAR;
            PG8_LDB(B0, 1, 0); PG8_SCHED; PG8_LDA(At, 1, 0); PG8_STAGE(PG8_SA(0, 1), a2 + hstep, voffA);
            PG8_WAIT_L(8); PG8_BAR; PG8_WAIT_L(0); PG8_MMA(0, 0, At, B0); PG8_BAR; PG8_SCHED;
            PG8_LDB(B1, 1, 1); PG8_STAGE(PG8_SB(1, 0), b3, voffB);
            PG8_BAR; PG8_WAIT_L(0); PG8_MMA(0, 1, At, B1); PG8_BAR;
            PG8_LDA(At, 1, 1); PG8_STAGE(PG8_SA(1, 0), a3, voffA);
            PG8_BAR; PG8_WAIT_L(0); PG8_MMA(1, 0, At, B0); PG8_BAR; PG8_SCHED;
            PG8_STAGE(PG8_SB(1, 1), b3 + hstep, voffB);
            PG8_WAIT_V(6); PG8_BAR; PG8_MMA(1, 1, At, B1); PG8_BAR;
        }
        PG8_STAMP();
        if constexpr (!Epi::AFTER_DRAIN) { E(acc, cur, wr, wc, fr, fq); S.done(cur); }
        PG8_STAMP();
        if (!has_next) break;
#pragma unroll
        for (int a = 0; a < 2; ++a)
#pragma unroll
            for (int b = 0; b < 2; ++b)
#pragma unroll
                for (int m = 0; m < 4; ++m)
#pragma unroll
                    for (int n = 0; n < 2; ++n) acc[a][b][m][n] = (f32x4){0.f, 0.f, 0.f, 0.f};
        cur = nxt; cA = nA; cB = nB; ++ui;
    }
    PG8_WAIT_V(0);
    if (wr == 0) PG8_BAR;
    PG8_BAR;
    if constexpr (Epi::AFTER_DRAIN) { E.fused(acc, cur, wr, wc, fr, fq, lds, wid, lane); S.done(cur); }
    PG8_STAMP();
    if (STAMP && wid == 0) { stamps[lane] = lane < nts ? (((unsigned long long)(unsigned)ts_hi << 32) | (unsigned)ts_lo) : 0ull;
        if (lane == 62) stamps[62] = rt_entry; if (lane == 63) stamps[63] = (unsigned long long)wall_clock64(); }
#undef PG8_STAMP
#undef PG8_SA
#undef PG8_SB
#undef PG8_STAGE
#undef PG8_LDA
#undef PG8_LDB
#undef PG8_MMA
#undef PG8_WAIT_V
#undef PG8_WAIT_L
#undef PG8_BAR
#undef PG8_SCHED
}
}

struct EpiProj {
    static constexpr bool PERM = true, AFTER_DRAIN = false;
    u16* P; const float* cs;
    __device__ __forceinline__ void operator()(const pg8::f32x4 (&acc)[2][2][4][2], const pg8::Unit& u, int wr, int wc, int fr, int fq) const {
        const int row0 = u.pm * 256 + wr * 64 + fr;
        const int col0 = u.pn * 256 + wc * 32 + 8 * fq;
        const bool rope = (u.pn >= C_DQ / 256) && (u.pn < C_DV / 256);
#pragma unroll
        for (int ai = 0; ai < 2; ++ai)
#pragma unroll
            for (int m = 0; m < 4; ++m) { const int row = row0 + ai * 128 + m * 16; u16* rowp = P + (size_t)row * NP + col0;
                pg8::f32x4 c01 = (pg8::f32x4){1.f, 0.f, 1.f, 0.f}, c23 = c01;
                if (rope) { const pg8::f32x4* cp = (const pg8::f32x4*)(cs + ((size_t)row * 64 + 4 * (4 * wc + fq)) * 2); c01 = cp[0]; c23 = cp[1]; }
#pragma unroll
                for (int bj = 0; bj < 2; ++bj) { pg8::f32x4 v0 = acc[ai][bj][m][0], v1 = acc[ai][bj][m][1];
                    if (rope) {
                        const pg8::f32x4 cc = {c01[0], c01[2], c23[0], c23[2]}, sn = {c01[1], c01[3], c23[1], c23[3]};
                        const pg8::f32x4 y1 = v0 * cc - v1 * sn, y2 = v0 * sn + v1 * cc; v0 = y1; v1 = y2; }
                    pg8::u32x4 w; w.x = pg8::cvt_pk_bf16(v0[0], v0[1]); w.y = pg8::cvt_pk_bf16(v0[2], v0[3]); w.z = pg8::cvt_pk_bf16(v1[0], v1[1]); w.w = pg8::cvt_pk_bf16(v1[2], v1[3]);
                    *(pg8::u32x4*)(rowp + bj * 128) = w; } }
    }
};
__device__ __forceinline__ void gz_phase(unsigned char* lds, const u16* __restrict__ H1, const u16* __restrict__ Wg, float* __restrict__ gz) {
    const int tid = threadIdx.x, lane = tid & 63, wave = tid >> 6, fr = lane & 15, fq = lane >> 4;
    float* red = (float*)lds;
    for (int rb = blockIdx.x; rb < T / 64; rb += gridDim.x) {
        const int r0 = rb * 64, k0 = wave * 256;
        f32x4 acc[4][2];
#pragma unroll
        for (int m = 0; m < 4; ++m) { acc[m][0] = (f32x4){0.f, 0.f, 0.f, 0.f}; acc[m][1] = (f32x4){0.f, 0.f, 0.f, 0.f}; }
#pragma unroll
        for (int ks = 0; ks < 8; ++ks) {
            bf16x8 af[4], bfr[2];
#pragma unroll
            for (int m = 0; m < 4; ++m) af[m] = *(const bf16x8*)(H1 + (size_t)(r0 + 16 * m + fr) * D + k0 + 32 * ks + 8 * fq);
#pragma unroll
            for (int n = 0; n < 2; ++n) bfr[n] = *(const bf16x8*)(Wg + (size_t)(16 * n + fr) * D + k0 + 32 * ks + 8 * fq);
#pragma unroll
            for (int m = 0; m < 4; ++m)
#pragma unroll
                for (int n = 0; n < 2; ++n) acc[m][n] = __builtin_amdgcn_mfma_f32_16x16x32_bf16(af[m], bfr[n], acc[m][n], 0, 0, 0);
        }
        __syncthreads();
#pragma unroll
        for (int m = 0; m < 4; ++m)
#pragma unroll
            for (int n = 0; n < 2; ++n)
#pragma unroll
                for (int j = 0; j < 4; ++j) red[(wave * 64 + 16 * m + 4 * fq + j) * 32 + 16 * n + fr] = acc[m][n][j];
        __syncthreads();
#pragma unroll
        for (int k = 0; k < 4; ++k) {
            const int e = tid + 512 * k;
            float s = 0.f;
#pragma unroll
            for (int w = 0; w < 8; ++w) s += red[w * 2048 + e];
            gz[(size_t)r0 * 32 + e] = s;
        }
    }
    __syncthreads();
}
struct EpiResid {
    static constexpr bool PERM = true, AFTER_DRAIN = false;
    const float* x; const float* mod; u16* x1;
    __device__ __forceinline__ void operator()(const pg8::f32x4 (&acc)[2][2][4][2], const pg8::Unit& u, int wr, int wc, int fr, int fq) const {
        const int row0 = u.pm * 256 + wr * 64 + fr, col0 = u.pn * 256 + wc * 32 + 8 * fq;
        const int b = (u.pm * 256) / S;
        pg8::f32x4 ga[2][2];
#pragma unroll
        for (int bj = 0; bj < 2; ++bj)
#pragma unroll
            for (int n = 0; n < 2; ++n) ga[bj][n] = *(const pg8::f32x4*)(mod + b * 12288 + 2 * 2048 + col0 + bj * 128 + 4 * n);
#pragma unroll
        for (int ai = 0; ai < 2; ++ai)
#pragma unroll
            for (int m = 0; m < 4; ++m) { const size_t off = (size_t)(row0 + ai * 128 + m * 16) * D + col0;
#pragma unroll
                for (int bj = 0; bj < 2; ++bj) {
                    const pg8::f32x4 x0 = __builtin_nontemporal_load((const pg8::f32x4*)(x + off + bj * 128)), x1v = __builtin_nontemporal_load((const pg8::f32x4*)(x + off + bj * 128 + 4));
                    const pg8::f32x4 v0 = x0 + ga[bj][0] * acc[ai][bj][m][0], v1 = x1v + ga[bj][1] * acc[ai][bj][m][1];
                    pg8::u32x4 w; w.x = pg8::cvt_pk_bf16(v0[0], v0[1]); w.y = pg8::cvt_pk_bf16(v0[2], v0[3]); w.z = pg8::cvt_pk_bf16(v1[0], v1[1]); w.w = pg8::cvt_pk_bf16(v1[2], v1[3]);
                    *(pg8::u32x4*)(x1 + off + bj * 128) = w; } }
    }
};
struct EpiBf16 {
    static constexpr bool PERM = true, AFTER_DRAIN = false;
    u16* Q;
    __device__ __forceinline__ void operator()(const pg8::f32x4 (&acc)[2][2][4][2], const pg8::Unit& u, int wr, int wc, int fr, int fq) const {
        const int row0 = u.pm * 256 + wr * 64 + fr, col0 = u.pn * 256 + wc * 32 + 8 * fq;
#pragma unroll
        for (int ai = 0; ai < 2; ++ai)
#pragma unroll
            for (int m = 0; m < 4; ++m) { u16* rowp = Q + (size_t)(row0 + ai * 128 + m * 16) * D + col0;
#pragma unroll
                for (int bj = 0; bj < 2; ++bj) { const pg8::f32x4 v0 = acc[ai][bj][m][0], v1 = acc[ai][bj][m][1];
                    pg8::u32x4 w; w.x = pg8::cvt_pk_bf16(v0[0], v0[1]); w.y = pg8::cvt_pk_bf16(v0[2], v0[3]); w.z = pg8::cvt_pk_bf16(v1[0], v1[1]); w.w = pg8::cvt_pk_bf16(v1[2], v1[3]);
                    *(pg8::u32x4*)(rowp + bj * 128) = w; } }
    }
};
template <class Epi>
__device__ __forceinline__ void gemm8(unsigned char* lds, const u16* A, const u16* Bt, int M, int N, int K, const Epi& E) {
    pg8::Gemm g{A, Bt, M, N, K}; pg8::StaticOrder So; So.init(M, N, (int)gridDim.x, (int)blockIdx.x);
    pg8::gemm_phase<Epi, pg8::StaticOrder, false>((PG8_LAS unsigned char*)lds, g, So, E, nullptr);
    __syncthreads();
}

#define GLA_QD_BYTES 16384
#define GLA_AT_BYTES 8192
__device__ __forceinline__ float gla_logsigmoid(float z) { return fminf(z, 0.f) - __logf(1.f + __expf(-fabsf(z))); }

__device__ __forceinline__ void gla_prep_item(const u16* __restrict__ P, int ldp, int cq, int ck, const float* __restrict__ gz,
                                              const float* __restrict__ wg_f, const float* __restrict__ bg_f, const float* __restrict__ wg_b, const float* __restrict__ bg_b,
                                              int Sq, unsigned char* __restrict__ QDg, unsigned char* __restrict__ KEg, unsigned char* __restrict__ ATg, float* __restrict__ DECg,
                                              unsigned char* lds, int item) {
    const int nch = Sq / 64;
    const int c = item % nch, dir = (item / nch) & 1, hh = (item / (nch * 2)) & 3, b = item / (nch * 8);
    const int tid = TID, lane = tid & 63, wave = tid >> 6, li = lane & 15, fq = lane >> 4;
    float* gzs = (float*)lds;
    float* segs = gzs + 64 * 16;
    unsigned char* QDs = lds + 8192;
    unsigned char* KIs = QDs + 16384;
    unsigned char* KEs = KIs + 16384;
    float* bmat = (float*)(KEs + 16384);
    const size_t tok0 = (size_t)b * Sq;
    __syncthreads();
    uint4 rq0, rq1, rk0, rk1;
    {
        const int i0 = tid >> 4, i1 = (tid + 512) >> 4, cc = tid & 15;
        const int s0 = dir ? (Sq - 1 - (64 * c + i0)) : (64 * c + i0), s1 = dir ? (Sq - 1 - (64 * c + i1)) : (64 * c + i1);
        rq0 = *(const uint4*)(P + (tok0 + s0) * ldp + cq + hh * 128 + cc * 8); rk0 = *(const uint4*)(P + (tok0 + s0) * ldp + ck + hh * 128 + cc * 8);
        rq1 = *(const uint4*)(P + (tok0 + s1) * ldp + cq + hh * 128 + cc * 8); rk1 = *(const uint4*)(P + (tok0 + s1) * ldp + ck + hh * 128 + cc * 8);
    }
    for (int e = tid; e < 64 * 16; e += 512) {
        const int i = e >> 4, r = e & 15;
        const int s = dir ? (Sq - 1 - (64 * c + i)) : (64 * c + i);
        gzs[e] = gz[(tok0 + s) * 32 + dir * 16 + r];
    }
    const int d = tid & 127, seg = tid >> 7;
    const float* wg = dir ? wg_b : wg_f;
    float wcol[16];
#pragma unroll
    for (int r = 0; r < 16; ++r) wcol[r] = wg[r * 512 + hh * 128 + d];
    const float bias = (dir ? bg_b : bg_f)[hh * 128 + d];
    __syncthreads();
    float run = 0.f;
#pragma unroll
    for (int k = 0; k < 16; ++k) {
        const int i = 16 * seg + k;
        float z = bias;
#pragma unroll
        for (int r = 0; r < 16; ++r) z += gzs[i * 16 + r] * wcol[r];
        run += gla_logsigmoid(z) * (1.f / 16.f);
        bmat[i * 128 + d] = run;
    }
    segs[seg * 128 + d] = run;
    __syncthreads();
    if (seg == 0) {
        const float t0 = segs[d], t1 = segs[128 + d], t2 = segs[256 + d], t3 = segs[384 + d];
        segs[d] = 0.f; segs[128 + d] = t0; segs[256 + d] = t0 + t1; segs[384 + d] = t0 + t1 + t2; segs[512 + d] = t0 + t1 + t2 + t3;
        DECg[(size_t)item * 128 + d] = __expf(t0 + t1 + t2 + t3);
    }
    __syncthreads();
    const float qscale = 0.08838834764831845f;
#pragma unroll
    for (int k = 0; k < 2; ++k) {
        const int id = tid + 512 * k, i = id >> 4, cc = id & 15, d0 = cc * 8, sg = i >> 4;
        const uint4 qv = k ? rq1 : rq0, kv = k ? rk1 : rk0;
        const float qx[8] = {lo2f(qv.x), hi2f(qv.x), lo2f(qv.y), hi2f(qv.y), lo2f(qv.z), hi2f(qv.z), lo2f(qv.w), hi2f(qv.w)};
        const float kx[8] = {lo2f(kv.x), hi2f(kv.x), lo2f(kv.y), hi2f(kv.y), lo2f(kv.z), hi2f(kv.z), lo2f(kv.w), hi2f(kv.w)};
        float qd[8], ki[8], ke[8];
        const float4 bA = *(const float4*)(bmat + i * 128 + d0), bB = *(const float4*)(bmat + i * 128 + d0 + 4);
        const float4 oA = *(const float4*)(segs + sg * 128 + d0), oB = *(const float4*)(segs + sg * 128 + d0 + 4);
        const float4 tA = *(const float4*)(segs + 512 + d0), tB = *(const float4*)(segs + 512 + d0 + 4);
        const float bv[8] = {bA.x + oA.x, bA.y + oA.y, bA.z + oA.z, bA.w + oA.w, bB.x + oB.x, bB.y + oB.y, bB.z + oB.z, bB.w + oB.w};
        const float tv[8] = {tA.x, tA.y, tA.z, tA.w, tB.x, tB.y, tB.z, tB.w};
#pragma unroll
        for (int e = 0; e < 8; ++e) {
            const float bb = bv[e], tot = tv[e];
            qd[e] = qx[e] * qscale * __expf(bb); ki[e] = kx[e] * __expf(-bb); ke[e] = kx[e] * __expf(tot - bb);
        }
        const int o = i * 256 + ((cc ^ (i & 15)) << 4);
        *(uint4*)(QDs + o) = make_uint4(pack2(qd[0], qd[1]), pack2(qd[2], qd[3]), pack2(qd[4], qd[5]), pack2(qd[6], qd[7]));
        *(uint4*)(KIs + o) = make_uint4(pack2(ki[0], ki[1]), pack2(ki[2], ki[3]), pack2(ki[4], ki[5]), pack2(ki[6], ki[7]));
        *(uint4*)(KEs + o) = make_uint4(pack2(ke[0], ke[1]), pack2(ke[2], ke[3]), pack2(ke[4], ke[5]), pack2(ke[6], ke[7]));
    }
    __syncthreads();
    {
        uint4* qo = (uint4*)(QDg + (size_t)item * GLA_QD_BYTES); uint4* ko = (uint4*)(KEg + (size_t)item * GLA_QD_BYTES);
#pragma unroll
        for (int k = 0; k < 2; ++k) { const int e = tid + 512 * k; qo[e] = ((const uint4*)QDs)[e]; ko[e] = ((const uint4*)KEs)[e]; }
    }
#pragma unroll
    for (int tt = 0; tt < 2; ++tt) {
        const int tile = wave + 8 * tt, jt = tile >> 2, it = tile & 3;
        f32x4 acc = (f32x4){0.f, 0.f, 0.f, 0.f};
        if (jt <= it) {
            const int jr = 16 * jt + li, ir = 16 * it + li;
#pragma unroll
            for (int ks = 0; ks < 4; ++ks) {
                const bf16x8 kf = *(const bf16x8*)(KIs + jr * 256 + (((4 * ks + fq) ^ (jr & 15)) << 4));
                const bf16x8 qf = *(const bf16x8*)(QDs + ir * 256 + (((4 * ks + fq) ^ (ir & 15)) << 4));
                acc = __builtin_amdgcn_mfma_f32_16x16x32_bf16(kf, qf, acc, 0, 0, 0);
            }
        }
        const int i = 16 * it + li, j0 = 16 * jt + 4 * fq;
        float v[4];
#pragma unroll
        for (int jj = 0; jj < 4; ++jj) v[jj] = (j0 + jj <= i) ? acc[jj] : 0.f;
        const int chunk = 2 * jt + (fq >> 1), sub = (fq & 1) * 8;
        *(uint2*)(ATg + (size_t)item * GLA_AT_BYTES + i * 128 + ((chunk ^ (i & 7)) << 4) + sub) = make_uint2(pack2(v[0], v[1]), pack2(v[2], v[3]));
    }
}

__device__ __forceinline__ void gla_seq_item(const u16* __restrict__ P, int ldp, int cv, int Sq,
                                             const unsigned char* __restrict__ QDg, const unsigned char* __restrict__ KEg, const unsigned char* __restrict__ ATg, const float* __restrict__ DECg,
                                             u16* __restrict__ Oout  , int Ttot, unsigned char* lds, int item) {
    const int slice = item & 1, dir = (item >> 1) & 1, hh = (item >> 2) & 3, b = item >> 4;
    const int nch = Sq / 64;
    const int tid = TID, lane = tid & 63, wave = tid >> 6, li = lane & 15, fq = lane >> 4;
    const size_t tok0 = (size_t)b * Sq;
    const int pitem0 = ((b * 4 + hh) * 2 + dir) * nch;
    constexpr int BUF = 16384 * 3 + 8192 + 512;
    typedef unsigned gla_u32x4 __attribute__((ext_vector_type(4)));
    gla_u32x4 rq0, rq1, rk0, rk1, rv0, rv1, ra; float rd = 0.f;
#define GLA_VROW(c_, k_) ((tok0 + (size_t)(dir ? (Sq - 1 - (64 * (c_) + ((tid + 512 * (k_)) >> 4))) : (64 * (c_) + ((tid + 512 * (k_)) >> 4)))) * ldp + cv + hh * 256 + slice * 128 + ((tid + 512 * (k_)) & 15) * 8)
#define GLA_ISSUE(c_) do { \
        const gla_u32x4* qsrc_ = (const gla_u32x4*)(QDg + (size_t)(pitem0 + (c_)) * GLA_QD_BYTES); const gla_u32x4* ksrc_ = (const gla_u32x4*)(KEg + (size_t)(pitem0 + (c_)) * GLA_QD_BYTES); \
        rq0 = qsrc_[tid]; rq1 = qsrc_[tid + 512]; rk0 = ksrc_[tid]; rk1 = ksrc_[tid + 512]; \
        ra = ((const gla_u32x4*)(ATg + (size_t)(pitem0 + (c_)) * GLA_AT_BYTES))[tid]; \
        rv0 = *(const gla_u32x4*)(P + GLA_VROW(c_, 0)); rv1 = *(const gla_u32x4*)(P + GLA_VROW(c_, 1)); \
        if (tid < 128) rd = DECg[(size_t)(pitem0 + (c_)) * 128 + tid]; } while (0)
#define GLA_COMMIT(buf_) do { \
        unsigned char* base_ = lds + (buf_) * BUF; \
        ((gla_u32x4*)base_)[tid] = rq0; ((gla_u32x4*)base_)[tid + 512] = rq1; ((gla_u32x4*)(base_ + 16384))[tid] = rk0; ((gla_u32x4*)(base_ + 16384))[tid + 512] = rk1; \
        { const int row_ = tid >> 4, ch_ = tid & 15; *(gla_u32x4*)(base_ + 32768 + row_ * 256 + ((ch_ ^ (row_ & 15)) << 4)) = rv0; } \
        { const int row_ = (tid + 512) >> 4, ch_ = tid & 15; *(gla_u32x4*)(base_ + 32768 + row_ * 256 + ((ch_ ^ (row_ & 15)) << 4)) = rv1; } \
        ((gla_u32x4*)(base_ + 49152))[tid] = ra; \
        if (tid < 128) ((float*)(base_ + 57344))[tid] = rd; } while (0)
    f32x4 st[8];
#pragma unroll
    for (int dt = 0; dt < 8; ++dt) st[dt] = (f32x4){0.f, 0.f, 0.f, 0.f};
    __syncthreads();
    GLA_ISSUE(0); GLA_COMMIT(0);
    __syncthreads();
#pragma unroll 1
    for (int c = 0; c < nch; ++c) {
        const int buf = c & 1;
        if (c + 1 < nch) GLA_ISSUE(c + 1);
        const unsigned char* QDs = lds + buf * BUF; const unsigned char* KEs = QDs + 16384; const unsigned char* Vs = QDs + 32768;
        const unsigned char* ATs = QDs + 49152; const float* DECs = (const float*)(QDs + 57344);
        bf16x8 vf[2];
#pragma unroll
        for (int jp = 0; jp < 2; ++jp) {
            const int rowA = 32 * jp + 8 * fq + (li >> 2), rowB = rowA + 4;
            const int chunk = 2 * wave + ((li & 3) >> 1), sub = ((li & 3) & 1) * 8;
            const s16x4 va = __builtin_amdgcn_ds_read_tr16_b64_v4i16((LAS s16x4*)(Vs + rowA * 256 + ((chunk ^ (rowA & 15)) << 4) + sub));
            const s16x4 vb = __builtin_amdgcn_ds_read_tr16_b64_v4i16((LAS s16x4*)(Vs + rowB * 256 + ((chunk ^ (rowB & 15)) << 4) + sub));
            vf[jp] = __builtin_shufflevector(va, vb, 0, 1, 2, 3, 4, 5, 6, 7);
        }
        bf16x8 sf[4];
#pragma unroll
        for (int dp = 0; dp < 4; ++dp) {
            const gla_u32x4 t_ = {pack2(st[2 * dp][0], st[2 * dp][1]), pack2(st[2 * dp][2], st[2 * dp][3]), pack2(st[2 * dp + 1][0], st[2 * dp + 1][1]), pack2(st[2 * dp + 1][2], st[2 * dp + 1][3])};
            sf[dp] = __builtin_bit_cast(bf16x8, t_);
        }
        f32x4 ot[4];
#pragma unroll
        for (int it = 0; it < 4; ++it) {
            f32x4 acc = (f32x4){0.f, 0.f, 0.f, 0.f};
            const int ir = 16 * it + li;
#pragma unroll
            for (int dp = 0; dp < 4; ++dp) {
                const int c0 = 4 * dp + (fq >> 1), c1 = c0 + 2, sub = (fq & 1) * 8;
                const uint2 lo = *(const uint2*)(QDs + ir * 256 + ((c0 ^ (ir & 15)) << 4) + sub);
                const uint2 hi = *(const uint2*)(QDs + ir * 256 + ((c1 ^ (ir & 15)) << 4) + sub);
                const gla_u32x4 q_ = {lo.x, lo.y, hi.x, hi.y};
                const bf16x8 qf = __builtin_bit_cast(bf16x8, q_);
                acc = __builtin_amdgcn_mfma_f32_16x16x32_bf16(sf[dp], qf, acc, 0, 0, 0);
            }
#pragma unroll
            for (int jp = 0; jp < 2; ++jp) {
                if (32 * jp <= 16 * it + 15) {
                    const bf16x8 af = *(const bf16x8*)(ATs + ir * 128 + (((4 * jp + fq) ^ (ir & 7)) << 4));
                    acc = __builtin_amdgcn_mfma_f32_16x16x32_bf16(vf[jp], af, acc, 0, 0, 0);
                }
            }
            ot[it] = acc;
        }
#pragma unroll
        for (int dt = 0; dt < 8; ++dt) {
            const f32x4 dec = *(const f32x4*)(DECs + 16 * dt + 4 * fq);
            f32x4 acc = st[dt] * dec;
#pragma unroll
            for (int jp = 0; jp < 2; ++jp) {
                const int rowA = 32 * jp + 8 * fq + (li >> 2), rowB = rowA + 4;
                const int chunk = 2 * dt + ((li & 3) >> 1), sub = ((li & 3) & 1) * 8;
                const s16x4 ka = __builtin_amdgcn_ds_read_tr16_b64_v4i16((LAS s16x4*)(KEs + rowA * 256 + ((chunk ^ (rowA & 15)) << 4) + sub));
                const s16x4 kb = __builtin_amdgcn_ds_read_tr16_b64_v4i16((LAS s16x4*)(KEs + rowB * 256 + ((chunk ^ (rowB & 15)) << 4) + sub));
                const bf16x8 kf = __builtin_shufflevector(ka, kb, 0, 1, 2, 3, 4, 5, 6, 7);
                acc = __builtin_amdgcn_mfma_f32_16x16x32_bf16(kf, vf[jp], acc, 0, 0, 0);
            }
            st[dt] = acc;
        }
#pragma unroll
        for (int it = 0; it < 4; ++it) {
            const int i = 16 * it + li;
            const int s = dir ? (Sq - 1 - (64 * c + i)) : (64 * c + i);
            *(uint2*)(Oout + ((size_t)dir * Ttot + tok0 + s) * 1024 + hh * 256 + slice * 128 + 16 * wave + 4 * fq) =
                make_uint2(pack2(ot[it][0], ot[it][1]), pack2(ot[it][2], ot[it][3]));
        }
        if (c + 1 < nch) GLA_COMMIT(buf ^ 1);
        __syncthreads();
    }
}
__device__ __forceinline__ void phase_rope_prep(const Args& a, unsigned char* lds) {
    u16* P = (u16*)(a.ws + WS_P);
    const float2* cs = (const float2*)(a.ws + WS_CS);
    const int gt = blockIdx.x * NTHREADS + threadIdx.x, NT = gridDim.x * NTHREADS;
    for (int item = blockIdx.x; item < GLA_NPREP; item += gridDim.x)
        gla_prep_item(P, NP, C_GQ, C_GK, (const float*)(a.ws + WS_GZ), a.wgf, a.bgf, a.wgb, a.bgb, S,
                      a.ws + WS_QD, a.ws + WS_KE, a.ws + WS_AT, (float*)(a.ws + WS_DEC), lds, item);
}

#define ATTN_DECODE(item_) \
    const int nb_per = Sq / 128; \
    const int within = (item_) % nb_per, hh = ((item_) / nb_per) & 7, b = ((item_) / (nb_per * 8)) & 3, pat = (item_) / (nb_per * 32); \
    const int dil = pat == 0 ? 1 : (pat == 1 ? 4 : 16); \
    const int M = Sq / dil; \
    const int r = within % dil, blk = within / dil; \
    const int p0 = blk * 128, kbase = p0 - 64; \
    const size_t tok0 = (size_t)b * Sq;
typedef unsigned attn_u32x4 __attribute__((ext_vector_type(4)));
__device__ __forceinline__ void attn_phase(const u16* __restrict__ P, int ldp, int cq, int ck, int cv, int Sq,
                                           u16* __restrict__ part_o, float* __restrict__ part_lse, int Ttot,
                                           unsigned char* lds, int first, int stride, int nitems) {
    const int tid = TID, lane = tid & 63, wave = tid >> 6, li = lane & 15, fq = lane >> 4;
    unsigned char* Ks = lds;
    unsigned char* Vs = lds + 65536;
    attn_u32x4 kr0, kr1, kr2, kr3, kr4, kr5, kr6, kr7, vr0, vr1, vr2, vr3, vr4, vr5, vr6, vr7;
#define ATTN_LD1(i_, kreg_, vreg_) { const int id_ = tid + 512 * (i_), row_ = id_ >> 4, c_ = id_ & 15; \
        int kp_ = kbase + row_; kp_ = kp_ < 0 ? 0 : (kp_ > M - 1 ? M - 1 : kp_); \
        const size_t t_ = tok0 + r + (size_t)dil * kp_; \
        kreg_ = *(const attn_u32x4*)(P + t_ * ldp + ck + hh * 128 + c_ * 8); vreg_ = *(const attn_u32x4*)(P + t_ * ldp + cv + hh * 128 + c_ * 8); }
#define ATTN_LOAD(item_) do { ATTN_DECODE(item_) \
        ATTN_LD1(0, kr0, vr0) ATTN_LD1(1, kr1, vr1) ATTN_LD1(2, kr2, vr2) ATTN_LD1(3, kr3, vr3) ATTN_LD1(4, kr4, vr4) ATTN_LD1(5, kr5, vr5) ATTN_LD1(6, kr6, vr6) ATTN_LD1(7, kr7, vr7) } while (0)
#define ATTN_ST1(i_, kreg_, vreg_) { const int id_ = tid + 512 * (i_), row_ = id_ >> 4, c_ = id_ & 15; const int off_ = row_ * 256 + ((c_ ^ (row_ & 15)) << 4); \
        *(attn_u32x4*)(Ks + off_) = kreg_; *(attn_u32x4*)(Vs + off_) = vreg_; }
#define ATTN_COMMIT() do { ATTN_ST1(0, kr0, vr0) ATTN_ST1(1, kr1, vr1) ATTN_ST1(2, kr2, vr2) ATTN_ST1(3, kr3, vr3) ATTN_ST1(4, kr4, vr4) ATTN_ST1(5, kr5, vr5) ATTN_ST1(6, kr6, vr6) ATTN_ST1(7, kr7, vr7) } while (0)
    int item = first;
    if (item < nitems) ATTN_LOAD(item);
    for (; item < nitems; item += stride) {
        ATTN_DECODE(item)
        __syncthreads();
        ATTN_COMMIT();
        const int qp = p0 + 16 * wave + li;
        const size_t tq = tok0 + r + (size_t)dil * qp;
        bf16x8 qf[4];
#pragma unroll
        for (int ks = 0; ks < 4; ++ks) qf[ks] = *(const bf16x8*)(P + tq * ldp + cq + hh * 128 + 32 * ks + 8 * fq);
        __syncthreads();
        if (item + stride < nitems) ATTN_LOAD(item + stride);
        const float scale = 0.08838834764831845f;
        float m = -1e30f, l = 0.f;
        f32x4 o[8];
#pragma unroll
        for (int dt = 0; dt < 8; ++dt) o[dt] = (f32x4){0.f, 0.f, 0.f, 0.f};
#pragma unroll 1
        for (int tp = 0; tp < 5; ++tp) {
            float s[8]; bool ok[8];
#pragma unroll
            for (int h2 = 0; h2 < 2; ++h2) {
                const int kk0 = 16 * wave + 16 * (2 * tp + h2);
                int krow = kk0 + li; krow = krow > 255 ? 255 : krow;
                f32x4 acc = (f32x4){0.f, 0.f, 0.f, 0.f};
#pragma unroll
                for (int ks = 0; ks < 4; ++ks) {
                    const bf16x8 kf = *(const bf16x8*)(Ks + krow * 256 + (((4 * ks + fq) ^ (krow & 15)) << 4));
                    acc = __builtin_amdgcn_mfma_f32_16x16x32_bf16(kf, qf[ks], acc, 0, 0, 0);
                }
#pragma unroll
                for (int j = 0; j < 4; ++j) {
                    const int kp = kbase + kk0 + 4 * fq + j;
                    const int rel = kp - qp;
                    ok[4 * h2 + j] = (kp >= 0) && (kp < M) && (rel <= 64) && (rel >= -64);
                    s[4 * h2 + j] = acc[j] * scale;
                }
            }
            float mx = -1e30f;
#pragma unroll
            for (int j = 0; j < 8; ++j) mx = ok[j] ? fmaxf(mx, s[j]) : mx;
            mx = fmaxf(mx, __shfl_xor(mx, 16));
            mx = fmaxf(mx, __shfl_xor(mx, 32));
            const float mn = fmaxf(m, mx);
            const float al = __expf(m - mn);
            float ps = 0.f; float p[8];
#pragma unroll
            for (int j = 0; j < 8; ++j) { p[j] = ok[j] ? __expf(s[j] - mn) : 0.f; ps += p[j]; }
            l = l * al + ps; m = mn;
            const attn_u32x4 p_ = {pack2(p[0], p[1]), pack2(p[2], p[3]), pack2(p[4], p[5]), pack2(p[6], p[7])};
            const bf16x8 pf = __builtin_bit_cast(bf16x8, p_);
#pragma unroll
            for (int dt = 0; dt < 8; ++dt) o[dt] *= al;
            int rowA = 16 * wave + 32 * tp + 4 * fq + (li >> 2); rowA = rowA > 255 ? 255 : rowA;
            int rowB = 16 * wave + 32 * tp + 16 + 4 * fq + (li >> 2); rowB = rowB > 255 ? 255 : rowB;
#pragma unroll
            for (int dt = 0; dt < 8; ++dt) {
                const int chunk = 2 * dt + ((li & 3) >> 1), sub = ((li & 3) & 1) * 8;
                const s16x4 va = __builtin_amdgcn_ds_read_tr16_b64_v4i16((LAS s16x4*)(Vs + rowA * 256 + ((chunk ^ (rowA & 15)) << 4) + sub));
                const s16x4 vb = __builtin_amdgcn_ds_read_tr16_b64_v4i16((LAS s16x4*)(Vs + rowB * 256 + ((chunk ^ (rowB & 15)) << 4) + sub));
                const bf16x8 vf = __builtin_shufflevector(va, vb, 0, 1, 2, 3, 4, 5, 6, 7);
                o[dt] = __builtin_amdgcn_mfma_f32_16x16x32_bf16(vf, pf, o[dt], 0, 0, 0);
            }
        }
        l += __shfl_xor(l, 16);
        l += __shfl_xor(l, 32);
        const float inv = 1.f / l;
        u16* orow = part_o + ((size_t)pat * Ttot + tq) * 1024 + hh * 128 + 4 * fq;
#pragma unroll
        for (int dt = 0; dt < 8; ++dt)
            *(uint2*)(orow + 16 * dt) = make_uint2(pack2(o[dt][0] * inv, o[dt][1] * inv), pack2(o[dt][2] * inv, o[dt][3] * inv));
        if (fq == 0) part_lse[((size_t)pat * Ttot + tq) * 8 + hh] = m + logf(l);
    }
#undef ATTN_LD1
#undef ATTN_LOAD
#undef ATTN_ST1
#undef ATTN_COMMIT
}

__device__ __forceinline__ void attn_merge_token(const u16* __restrict__ part_o, const float* __restrict__ part_lse, int Ttot, size_t t,
                                                 u16* __restrict__ dst  , int lane) {
    const int hh = lane >> 3;
    const float l0 = part_lse[((size_t)0 * Ttot + t) * 8 + hh], l1 = part_lse[((size_t)1 * Ttot + t) * 8 + hh], l2 = part_lse[((size_t)2 * Ttot + t) * 8 + hh];
    const float mx = fmaxf(l0, fmaxf(l1, l2));
    const float e0 = __expf(l0 - mx), e1 = __expf(l1 - mx), e2 = __expf(l2 - mx);
    const float inv = 1.f / (e0 + e1 + e2);
    const float w[3] = {e0 * inv, e1 * inv, e2 * inv};
    float acc[16];
#pragma unroll
    for (int i = 0; i < 16; ++i) acc[i] = 0.f;
#pragma unroll
    for (int p = 0; p < 3; ++p) {
        const uint4* src = (const uint4*)(part_o + ((size_t)p * Ttot + t) * 1024 + lane * 16);
        const uint4 a = src[0], bb = src[1];
        acc[0] += w[p] * lo2f(a.x); acc[1] += w[p] * hi2f(a.x); acc[2] += w[p] * lo2f(a.y); acc[3] += w[p] * hi2f(a.y);
        acc[4] += w[p] * lo2f(a.z); acc[5] += w[p] * hi2f(a.z); acc[6] += w[p] * lo2f(a.w); acc[7] += w[p] * hi2f(a.w);
        acc[8] += w[p] * lo2f(bb.x); acc[9] += w[p] * hi2f(bb.x); acc[10] += w[p] * lo2f(bb.y); acc[11] += w[p] * hi2f(bb.y);
        acc[12] += w[p] * lo2f(bb.z); acc[13] += w[p] * hi2f(bb.z); acc[14] += w[p] * lo2f(bb.w); acc[15] += w[p] * hi2f(bb.w);
    }
    uint4* d = (uint4*)(dst + lane * 16);
    d[0] = make_uint4(pack2(acc[0], acc[1]), pack2(acc[2], acc[3]), pack2(acc[4], acc[5]), pack2(acc[6], acc[7]));
    d[1] = make_uint4(pack2(acc[8], acc[9]), pack2(acc[10], acc[11]), pack2(acc[12], acc[13]), pack2(acc[14], acc[15]));
}

__device__ __forceinline__ void phase_mixers(const Args& a, unsigned char* lds) {
    const int bi = blockIdx.x, G = gridDim.x;
    if (bi < 64) {
        gla_seq_item((const u16*)(a.ws + WS_P), NP, C_GV, S, a.ws + WS_QD, a.ws + WS_KE, a.ws + WS_AT, (const float*)(a.ws + WS_DEC),
                     (u16*)(a.ws + WS_OFB), T, lds, bi);
    } else {
        u16* part_o = (u16*)a.out; float* part_lse = (float*)((unsigned char*)a.out + (size_t)3 * T * 1024 * 2);
        attn_phase((const u16*)(a.ws + WS_P), NP, C_DQ, C_DK, C_DV, S, part_o, part_lse, T, lds, bi - 64, G - 64, 3 * 4 * 8 * (S / 128));
    }
}

__device__ __forceinline__ void phase_gla_fin(const Args& a) {
    const u16* Of = (const u16*)(a.ws + WS_OFB);
    const u16* Ob = Of + (size_t)T * 1024;
    const u16* P = (const u16*)(a.ws + WS_P);
    u16* A2 = (u16*)(a.ws + WS_ACT);
    const u16* part_o = (const u16*)a.out; const float* part_lse = (const float*)((const unsigned char*)a.out + (size_t)3 * T * 1024 * 2);
    const int lane = threadIdx.x & 63, wave = threadIdx.x >> 6;
    const int gw = blockIdx.x * NWAVES + wave, NGW = gridDim.x * NWAVES;
    const int hh = lane >> 4;
    float gg[16];
#pragma unroll
    for (int k = 0; k < 4; ++k) { const float4 g4 = *(const float4*)(a.g_gla + lane * 16 + 4 * k); gg[4 * k] = g4.x; gg[4 * k + 1] = g4.y; gg[4 * k + 2] = g4.z; gg[4 * k + 3] = g4.w; }
    for (int t = gw; t < T; t += NGW) {
        const uint4* fp = (const uint4*)(Of + (size_t)t * 1024 + lane * 16); const uint4* bp = (const uint4*)(Ob + (size_t)t * 1024 + lane * 16);
        const uint4* rp = (const uint4*)(P + (size_t)t * NP + C_GR + lane * 16);
#define NT16(p_) ({ const f32x4 q_ = __builtin_nontemporal_load((const f32x4*)(p_)); make_uint4(__float_as_uint(q_[0]), __float_as_uint(q_[1]), __float_as_uint(q_[2]), __float_as_uint(q_[3])); })
        const uint4 f0 = NT16(fp), f1 = NT16(fp + 1), b0 = NT16(bp), b1 = NT16(bp + 1), r0 = NT16(rp), r1 = NT16(rp + 1);
#undef NT16
        attn_merge_token(part_o, part_lse, T, (size_t)t, A2 + (size_t)t * D + 1024, lane);
        const unsigned fw[8] = {f0.x, f0.y, f0.z, f0.w, f1.x, f1.y, f1.z, f1.w}, bw[8] = {b0.x, b0.y, b0.z, b0.w, b1.x, b1.y, b1.z, b1.w};
        const unsigned rw[8] = {r0.x, r0.y, r0.z, r0.w, r1.x, r1.y, r1.z, r1.w};
        float o[16]; float ss = 0.f;
#pragma unroll
        for (int k = 0; k < 8; ++k) { o[2 * k] = lo2f(fw[k]) + lo2f(bw[k]); o[2 * k + 1] = hi2f(fw[k]) + hi2f(bw[k]); ss += o[2 * k] * o[2 * k] + o[2 * k + 1] * o[2 * k + 1]; }
        ss += __shfl_xor(ss, 1); ss += __shfl_xor(ss, 2); ss += __shfl_xor(ss, 4); ss += __shfl_xor(ss, 8);
        const float rstd = rsqrtf(ss * (1.f / 256.f) + NORM_EPS);
        unsigned y[8];
#pragma unroll
        for (int k = 0; k < 8; ++k) y[k] = pack2(o[2 * k] * rstd * gg[2 * k] * silu_f(lo2f(rw[k])), o[2 * k + 1] * rstd * gg[2 * k + 1] * silu_f(hi2f(rw[k])));
        uint4* dp = (uint4*)(A2 + (size_t)t * D + lane * 16);
        dp[0] = make_uint4(y[0], y[1], y[2], y[3]); dp[1] = make_uint4(y[4], y[5], y[6], y[7]);
    }
    (void)hh;
}

typedef float f32x16 __attribute__((ext_vector_type(16)));
#define RT_CE(a_, b_) do { const float hi_ = fmaxf(a_, b_), lo_ = fminf(a_, b_); a_ = hi_; b_ = lo_; } while (0)
template <int N> __device__ __forceinline__ void rt_sort_desc(float (&v)[N], int base) {
#pragma unroll
    for (int k = 2; k <= 16; k <<= 1)
#pragma unroll
        for (int j = k >> 1; j > 0; j >>= 1)
#pragma unroll
            for (int i = 0; i < 16; ++i) {
                const int l = i ^ j;
                if (l > i) { if ((i & k) == 0) RT_CE(v[base + i], v[base + l]); else RT_CE(v[base + l], v[base + i]); }
            }
}
template <int N> __device__ __forceinline__ void rt_merge_desc(float (&v)[N], int a, int b) {
#pragma unroll
    for (int i = 0; i < 16; ++i) v[a + i] = fmaxf(v[a + i], v[b + 15 - i]);
#pragma unroll
    for (int j = 8; j > 0; j >>= 1)
#pragma unroll
        for (int i = 0; i < 16; ++i) { const int l = i ^ j; if (l > i) RT_CE(v[a + i], v[a + l]); }
}

__device__ __forceinline__ void route_stage_keys(const float* __restrict__ subk, int hh, unsigned char* lds) {
    const int tid = TID;
    __syncthreads();
    for (int e = tid; e < 2 * 128 * 16; e += 512) {
        const int c = e & 15, row = e >> 4;
        const float* src = subk + ((size_t)(hh * 2) * 128 + row) * 128 + c * 8;
        const float4 v0 = *(const float4*)src, v1 = *(const float4*)(src + 4);
        *(uint4*)(lds + row * 256 + ((c ^ (row & 15)) << 4)) = make_uint4(pack2(v0.x, v0.y), pack2(v0.z, v0.w), pack2(v1.x, v1.y), pack2(v1.z, v1.w));
    }
    __syncthreads();
}

__device__ __forceinline__ void route_tile(const u16* __restrict__ Q, int ldq, int hh, int tok_base, const unsigned char* lds,
                                           int* __restrict__ IDX, float* __restrict__ GATE) {
    const int lane = TID & 63, r = lane & 31, h = lane >> 5;
    float sc[128];
    {
        f32x16 X[4], Y[4];
#pragma unroll
        for (int kt = 0; kt < 4; ++kt) {
#pragma unroll
            for (int i = 0; i < 16; ++i) { X[kt][i] = 0.f; Y[kt][i] = 0.f; }
        }
        const u16* qrow = Q + (size_t)(tok_base + r) * ldq + hh * 256;
#pragma unroll
        for (int half = 0; half < 2; ++half) {
            bf16x8 qf[8];
#pragma unroll
            for (int ks = 0; ks < 8; ++ks) qf[ks] = *(const bf16x8*)(qrow + half * 128 + 16 * ks + 8 * h);
#pragma unroll
            for (int kt = 0; kt < 4; ++kt) {
                const int krow = half * 128 + 32 * kt + r;
#pragma unroll
                for (int ks = 0; ks < 8; ++ks) {
                    const bf16x8 kf = *(const bf16x8*)(lds + krow * 256 + (((2 * ks + h) ^ (krow & 15)) << 4));
                    if (half == 0) X[kt] = __builtin_amdgcn_mfma_f32_32x32x16_bf16(kf, qf[ks], X[kt], 0, 0, 0);
                    else Y[kt] = __builtin_amdgcn_mfma_f32_32x32x16_bf16(kf, qf[ks], Y[kt], 0, 0, 0);
                }
            }
        }
#pragma unroll
        for (int kt = 0; kt < 4; ++kt)
#pragma unroll
            for (int i = 0; i < 16; ++i) {
                const auto sw = __builtin_amdgcn_permlane32_swap(__float_as_uint(X[kt][i]), __float_as_uint(Y[kt][i]), false, false);
                const int key0 = 32 * kt + (i & 3) + 8 * (i >> 2);
                sc[kt * 32 + i] = __uint_as_float((sw[0] & 0xffffff80u) | (unsigned)key0);
                sc[kt * 32 + 16 + i] = __uint_as_float((sw[1] & 0xffffff80u) | (unsigned)(key0 + 4));
            }
    }
#pragma unroll
    for (int g = 0; g < 8; ++g) rt_sort_desc(sc, 16 * g);
    rt_merge_desc(sc, 0, 16); rt_merge_desc(sc, 32, 48); rt_merge_desc(sc, 64, 80); rt_merge_desc(sc, 96, 112);
    rt_merge_desc(sc, 0, 32); rt_merge_desc(sc, 64, 96);
    rt_merge_desc(sc, 0, 64);
    float l0[16], l1[16];
#pragma unroll
    for (int i = 0; i < 16; ++i) {
        const auto sw = __builtin_amdgcn_permlane32_swap(__float_as_uint(sc[i]), __float_as_uint(sc[i]), false, false);
        l0[i] = __uint_as_float(sw[0]); l1[i] = __uint_as_float(sw[1]);
    }
    float s0[16], s1[16]; int k0[16], k1[16];
#pragma unroll
    for (int i = 0; i < 16; ++i) {
        const unsigned a = __float_as_uint(l0[i]), b = __float_as_uint(l1[i]);
        s0[i] = __uint_as_float(a & 0xffffff80u); k0[i] = (int)(a & 0x7fu);
        s1[i] = __uint_as_float(b & 0xffffff80u); k1[i] = (int)(b & 0x7fu);
    }
    float cs[64];
    {
        int n = 0;
#pragma unroll
        for (int i = 0; i < 16; ++i)
#pragma unroll
            for (int j = 0; j < 16; ++j)
                if ((i + 1) * (j + 1) <= 16) { cs[n] = s0[i] + s1[j]; ++n; }
#pragma unroll
        for (int q = 50; q < 64; ++q) cs[q] = -3.0e38f;
    }
    float ct[64];
#pragma unroll
    for (int q = 0; q < 64; ++q) ct[q] = cs[q];
#pragma unroll
    for (int g = 0; g < 4; ++g) rt_sort_desc(ct, 16 * g);
    rt_merge_desc(ct, 0, 16); rt_merge_desc(ct, 32, 48); rt_merge_desc(ct, 0, 32);
    const float theta = ct[15], smax = ct[0];
    float den = 0.f;
    {
        int cnt = 0;
#pragma unroll
        for (int q = 0; q < 50; ++q) { const bool sel = (cs[q] >= theta) && (cnt < 16); den += sel ? __expf(cs[q] - smax) : 0.f; cnt += sel ? 1 : 0; }
    }
    const float inv = 1.f / den;
    const size_t obase = (size_t)(tok_base + r) * 128 + hh * 16;
    int pos = 0;
    {
        int n = 0;
#pragma unroll
        for (int i = 0; i < 16; ++i)
#pragma unroll
            for (int j = 0; j < 16; ++j)
                if ((i + 1) * (j + 1) <= 16) {
                    const bool sel = (cs[n] >= theta) && (pos < 16);
                    if (sel) {
                        if (h == 0) IDX[obase + pos] = k0[i] * 128 + k1[j];
                        else GATE[obase + pos] = __expf(cs[n] - smax) * inv;
                        ++pos;
                    }
                    ++n;
                }
    }
}
__device__ __forceinline__ void phase_route(const Args& a, unsigned char* lds) {
    const int hh = BID & 7, grp = BID >> 3, ngrp = GDIM >> 3, wave = TID >> 6;
    route_stage_keys(a.subk, hh, lds);
    int j = 0;
    for (int tile = grp; tile < T / 32; tile += ngrp, ++j)
        if ((j & 7) == wave) route_tile((const u16*)(a.ws + WS_Q), D, hh, tile * 32, lds, (int*)(a.ws + WS_IDX), (float*)(a.ws + WS_GATE));
    __syncthreads();
}

typedef __bf16 bf16x2_t __attribute__((ext_vector_type(2)));
__device__ __forceinline__ float dot2bf(unsigned w, unsigned x, float acc) {
    return __builtin_amdgcn_fdot2_f32_bf16(__builtin_bit_cast(bf16x2_t, w), __builtin_bit_cast(bf16x2_t, x), acc, false);
}
constexpr int TROW = 1152;
typedef float f32x2_t __attribute__((ext_vector_type(2)));
__device__ __forceinline__ void convert_tables(const Args& a) {
    const int lane = threadIdx.x & 63, wave = threadIdx.x >> 6;
    const int gw = blockIdx.x * NWAVES + wave, NGW = gridDim.x * NWAVES;
    for (int row = gw; row < 2 * 16384; row += NGW) {
        const bool isv = row >= 16384; const int e = isv ? row - 16384 : row;
        const f32x4* sp = (const f32x4*)((isv ? a.pv : a.pu) + (size_t)e * D);
        unsigned char* dst = a.ws + (isv ? WS_TV : WS_TU) + (size_t)e * TROW;
        f32x4 v[8];
#pragma unroll
        for (int k = 0; k < 8; ++k) v[k] = __builtin_nontemporal_load(sp + lane + 64 * k);
#pragma unroll
        for (int k = 0; k < 8; ++k) {
            float mx = fmaxf(fmaxf(fabsf(v[k][0]), fabsf(v[k][1])), fmaxf(fabsf(v[k][2]), fabsf(v[k][3])));
            mx = fmaxf(mx, __shfl_xor(mx, 1)); mx = fmaxf(mx, __shfl_xor(mx, 2)); mx = fmaxf(mx, __shfl_xor(mx, 4));
            float s = mx * (isv ? (1.f / 6.f) : (1.f / 7.f)); s = (s > 0.f) ? s : 1.f;
            u16 sb = f2bf(s); if (bf2f(sb) < s) sb += 1;
            const float inv = 1.f / bf2f(sb);
            unsigned p = 0u;
            if (isv) {
                p = __builtin_amdgcn_cvt_scalef32_pk_fp4_f32(p, v[k][0] * inv, v[k][1] * inv, 1.0f, 0);
                p = __builtin_amdgcn_cvt_scalef32_pk_fp4_f32(p, v[k][2] * inv, v[k][3] * inv, 1.0f, 1);
            } else {
#pragma unroll
                for (int j = 0; j < 4; ++j) { int q = (int)rintf(v[k][j] * inv) + 8; q = q < 1 ? 1 : (q > 15 ? 15 : q); p |= (unsigned)q << (4 * j); }
            }
            const int i = lane + 64 * k;
            *(u16*)(dst + 2 * i) = (u16)p;
            if ((lane & 7) == 0) *(u16*)(dst + 1024 + 2 * (i >> 3)) = sb;
        }
    }
}

__device__ __forceinline__ int idot32_i4(const uint4 w, const int (&hq)[8]) {
    const unsigned ww[4] = {w.x, w.y, w.z, w.w};
    int acc = 0;
#pragma unroll
    for (int k = 0; k < 4; ++k) {
        acc = __builtin_amdgcn_sdot4((int)(ww[k] & 0x0f0f0f0fu), hq[2 * k], acc, false);
        acc = __builtin_amdgcn_sdot4((int)((ww[k] >> 4) & 0x0f0f0f0fu), hq[2 * k + 1], acc, false);
    }
    return acc;
}
__device__ __forceinline__ void axpy32_fp4(const uint4 w, const float s, float (&acc)[32]) {
    const unsigned ww[4] = {w.x, w.y, w.z, w.w};
#pragma unroll
    for (int k = 0; k < 4; ++k) {
        const f32x2_t a0 = __builtin_amdgcn_cvt_scalef32_pk_f32_fp4(ww[k], 1.0f, 0), a1 = __builtin_amdgcn_cvt_scalef32_pk_f32_fp4(ww[k], 1.0f, 1);
        const f32x2_t a2 = __builtin_amdgcn_cvt_scalef32_pk_f32_fp4(ww[k], 1.0f, 2), a3 = __builtin_amdgcn_cvt_scalef32_pk_f32_fp4(ww[k], 1.0f, 3);
        acc[8 * k + 0] += s * a0.x; acc[8 * k + 1] += s * a0.y; acc[8 * k + 2] += s * a1.x; acc[8 * k + 3] += s * a1.y;
        acc[8 * k + 4] += s * a2.x; acc[8 * k + 5] += s * a2.y; acc[8 * k + 6] += s * a3.x; acc[8 * k + 7] += s * a3.y;
    }
}
__device__ __forceinline__ void phase_experts(const Args& a) {
    const u16* H2 = (const u16*)(a.ws + WS_ACT);
    const u16* X1 = (const u16*)(a.ws + WS_X1);
    const int* IDX = (const int*)(a.ws + WS_IDX);
    const float* GATE = (const float*)(a.ws + WS_GATE);
    const float* mod = (const float*)(a.ws + WS_MOD);
    const unsigned char* U = a.ws + WS_TU; const unsigned char* V = a.ws + WS_TV;
    const int lane = threadIdx.x & 63, wave = threadIdx.x >> 6;
    const int gw = blockIdx.x * NWAVES + wave, NGW = gridDim.x * NWAVES;
    int iv0 = 0, iv1 = 0; float gv0 = 0.f, gv1 = 0.f;
    int niv0 = 0, niv1 = 0; float ngv0 = 0.f, ngv1 = 0.f;
    uint4 rA[4], rB[4]; u16 sA[4], sB[4];
#define ROW_LOAD(TB_, r_, s_, r0_) do { _Pragma("unroll") for (int q = 0; q < 4; ++q) { \
            const int rr_ = (r0_) + q; const int e_ = __builtin_amdgcn_readlane(rr_ < 64 ? iv0 : iv1, rr_ & 63); \
            const unsigned char* rp_ = TB_ + (size_t)e_ * TROW; \
            r_[q] = *(const uint4*)(rp_ + lane * 16); s_[q] = *(const u16*)(rp_ + 1024 + lane * 2); } } while (0)
#define TOK_FETCH(t_, i0_, i1_, g0_, g1_) do { \
            i0_ = IDX[(size_t)(t_) * 128 + lane]; i1_ = IDX[(size_t)(t_) * 128 + 64 + lane]; \
            g0_ = GATE[(size_t)(t_) * 128 + lane]; g1_ = GATE[(size_t)(t_) * 128 + 64 + lane]; } while (0)
    if (gw < T) { TOK_FETCH(gw, iv0, iv1, gv0, gv1); ROW_LOAD(U, rA, sA, 0); }
    for (int t = gw; t < T; t += NGW) {
        const int b = t / S;
        const bool has_next = (t + NGW) < T;
        int hq[8]; int hsum8; float sh;
        {
            float h[32];
            const f32x4* hp = (const f32x4*)(H2 + (size_t)t * D + lane * 32);
#pragma unroll
            for (int k = 0; k < 4; ++k) { const f32x4 pn = __builtin_nontemporal_load(hp + k);
                const uint4 p = make_uint4(__float_as_uint(pn[0]), __float_as_uint(pn[1]), __float_as_uint(pn[2]), __float_as_uint(pn[3]));
                h[8 * k + 0] = lo2f(p.x); h[8 * k + 1] = hi2f(p.x); h[8 * k + 2] = lo2f(p.y); h[8 * k + 3] = hi2f(p.y);
                h[8 * k + 4] = lo2f(p.z); h[8 * k + 5] = hi2f(p.z); h[8 * k + 6] = lo2f(p.w); h[8 * k + 7] = hi2f(p.w); }
            float mx = 0.f;
#pragma unroll
            for (int i = 0; i < 32; ++i) mx = fmaxf(mx, fabsf(h[i]));
            sh = (mx > 0.f) ? mx * (1.f / 127.f) : 1.f;
            const float inv = 1.f / sh;
            int hs = 0;
#pragma unroll
            for (int k = 0; k < 4; ++k)
#pragma unroll
                for (int par = 0; par < 2; ++par) {
                    const int q0 = (int)rintf(h[8 * k + par] * inv), q1 = (int)rintf(h[8 * k + 2 + par] * inv), q2 = (int)rintf(h[8 * k + 4 + par] * inv), q3 = (int)rintf(h[8 * k + 6 + par] * inv);
                    hs += q0 + q1 + q2 + q3;
                    hq[2 * k + par] = (q0 & 0xff) | ((q1 & 0xff) << 8) | ((q2 & 0xff) << 16) | ((int)((unsigned)(q3 & 0xff) << 24));
                }
            hsum8 = 8 * hs;
        }
        float a0 = 0.f, a1 = 0.f;
#define U_COMPUTE(r_, s_, r0_) do { float d_[4]; \
            _Pragma("unroll") for (int q = 0; q < 4; ++q) d_[q] = (float)(idot32_i4(r_[q], hq) - hsum8) * (bf2f(s_[q]) * sh); \
            _Pragma("unroll") for (int o = 32; o > 0; o >>= 1) { _Pragma("unroll") for (int q = 0; q < 4; ++q) d_[q] += __shfl_xor(d_[q], o); } \
            _Pragma("unroll") for (int q = 0; q < 4; ++q) { const int rr_ = (r0_) + q; \
                if (rr_ < 64) a0 = (lane == rr_) ? d_[q] : a0; else a1 = (lane == rr_ - 64) ? d_[q] : a1; } } while (0)
#pragma unroll 1
        for (int r0 = 0; r0 < 128; r0 += 8) {
            ROW_LOAD(U, rB, sB, r0 + 4);
            U_COMPUTE(rA, sA, r0);
            if (r0 + 8 < 128) ROW_LOAD(U, rA, sA, r0 + 8); else ROW_LOAD(V, rA, sA, 0);
            U_COMPUTE(rB, sB, r0 + 4);
        }
        const float w0 = gv0 * gelu_f(a0), w1 = gv1 * gelu_f(a1);
        float acc[32];
#pragma unroll
        for (int i = 0; i < 32; ++i) acc[i] = 0.f;
#define V_COMPUTE(r_, s_, r0_) do { _Pragma("unroll") for (int q = 0; q < 4; ++q) { const int rr_ = (r0_) + q; \
                const float g_ = __builtin_bit_cast(float, __builtin_amdgcn_readlane(__builtin_bit_cast(int, rr_ < 64 ? w0 : w1), rr_ & 63)); \
                axpy32_fp4(r_[q], g_ * bf2f(s_[q]), acc); } } while (0)
        if (has_next) TOK_FETCH(t + NGW, niv0, niv1, ngv0, ngv1);
#pragma unroll 1
        for (int r0 = 0; r0 < 128; r0 += 8) {
            ROW_LOAD(V, rB, sB, r0 + 4);
            V_COMPUTE(rA, sA, r0);
            if (r0 + 8 < 128) ROW_LOAD(V, rA, sA, r0 + 8);
            else if (has_next) { iv0 = niv0; iv1 = niv1; gv0 = ngv0; gv1 = ngv1; ROW_LOAD(U, rA, sA, 0); }
            V_COMPUTE(rB, sB, r0 + 4);
        }
#undef U_COMPUTE
#undef V_COMPUTE
        float ss = 0.f;
#pragma unroll
        for (int k = 0; k < 8; ++k) {
            const int c0 = lane * 32 + 4 * k;
            const hw_f32x2 xn = __builtin_nontemporal_load((const hw_f32x2*)(X1 + (size_t)t * D + c0));
            const uint2 xp = make_uint2(__float_as_uint(xn[0]), __float_as_uint(xn[1]));
            const float4 xa = make_float4(lo2f(xp.x), hi2f(xp.x), lo2f(xp.y), hi2f(xp.y));
            const float4 ga = *(const float4*)(mod + b * 12288 + 5 * 2048 + c0);
            acc[4 * k + 0] = xa.x + ga.x * acc[4 * k + 0]; acc[4 * k + 1] = xa.y + ga.y * acc[4 * k + 1];
            acc[4 * k + 2] = xa.z + ga.z * acc[4 * k + 2]; acc[4 * k + 3] = xa.w + ga.w * acc[4 * k + 3];
#pragma unroll
            for (int i = 0; i < 4; ++i) ss += acc[4 * k + i] * acc[4 * k + i];
        }
        ss = wave_sum(ss);
        const float rstd = rsqrtf(ss * (1.f / D) + NORM_EPS);
#pragma unroll
        for (int k = 0; k < 8; ++k) {
            const int c0 = lane * 32 + 4 * k;
            const float4 gf = *(const float4*)(a.g_fin + c0);
            *(float4*)(a.out + (size_t)t * D + c0) = make_float4(acc[4 * k + 0] * rstd * gf.x, acc[4 * k + 1] * rstd * gf.y, acc[4 * k + 2] * rstd * gf.z, acc[4 * k + 3] * rstd * gf.w);
        }
    }
#undef ROW_LOAD
#undef TOK_FETCH
}

#define XB_TMO      128
#define XB_XCNT(j)  (256  + 64 * (j))
#define XB_XSUB(j)  (1280 + 64 * (j))
#define XB_XGEN(j)  (2304 + 64 * (j))
#define XB_TOP      3328
#define XB_TOPGEN   3392
#define XCD_BAR_WORDS 3456
#define XB_SPIN_CAP (1u << 18)

__device__ __forceinline__ unsigned xb_ld(unsigned* p)              { return __hip_atomic_load(p, __ATOMIC_RELAXED, __HIP_MEMORY_SCOPE_AGENT); }
__device__ __forceinline__ unsigned xb_add(unsigned* p, unsigned v) { return __hip_atomic_fetch_add(p, v, __ATOMIC_RELAXED, __HIP_MEMORY_SCOPE_AGENT); }
__device__ __forceinline__ unsigned xb_xcc_id() { return (unsigned)__builtin_amdgcn_s_getreg((3 << 11) | 20) & 0xFu; }
#define XB_SPIN(cond, bar) do { unsigned _sp = 0; while (cond) { __builtin_amdgcn_s_sleep(1); \
    if ((++_sp & 255u) == 0u) { if (xb_ld(&(bar)[XB_TMO])) break; if (_sp > XB_SPIN_CAP) { atomicAdd(&(bar)[XB_TMO], 1u); break; } } } } while (0)

struct XcdBarrier {
    unsigned* bar; unsigned x;
    volatile LAS unsigned* st;
};

__device__ __forceinline__ XcdBarrier xcd_barrier_post(unsigned* bar, volatile LAS unsigned* st) {
    XcdBarrier b; b.bar = bar; b.x = xb_xcc_id(); b.st = st;
    if (threadIdx.x == 0) (void)xb_add(&bar[XB_XCNT(b.x)], 1u);
    return b;
}
__device__ __forceinline__ void xcd_barrier_complete(unsigned* bar, unsigned x, unsigned& nloc, unsigned& nx) {
    const unsigned G = gridDim.x * gridDim.y * gridDim.z;
    unsigned sum, cnt, mine, sp = 0u;
    for (;;) {
        sum = 0u; cnt = 0u; mine = 0u;
#pragma unroll
        for (unsigned j = 0; j < 16; ++j) { const unsigned c = xb_ld(&bar[XB_XCNT(j)]); sum += c; cnt += (c > 0u) ? 1u : 0u; mine = (j == x) ? c : mine; }
        if (sum == G) break;
        __builtin_amdgcn_s_sleep(1);
        if ((++sp & 255u) == 0u) { if (xb_ld(&bar[XB_TMO])) break; if (sp > XB_SPIN_CAP) { atomicAdd(&bar[XB_TMO], 1u); break; } }
    }
    nloc = mine > 0u ? mine : 1u; nx = cnt > 0u ? cnt : 1u;
}

__device__ __forceinline__ void xcd_barrier(const XcdBarrier& b) {
    asm volatile("s_waitcnt vmcnt(0)" ::: "memory");
    __syncthreads();
    if (threadIdx.x == 0) {
        unsigned* bar = b.bar;
        __builtin_amdgcn_s_waitcnt(0);
        unsigned nloc = b.st[0], nx = b.st[1];
        if (nloc == 0u) { xcd_barrier_complete(bar, b.x, nloc, nx); b.st[0] = nloc; b.st[1] = nx; }
        const unsigned old = xb_add(&bar[XB_XSUB(b.x)], 1u);
        const unsigned gen = old / nloc;
        if (old + 1u == (gen + 1u) * nloc) {
            __builtin_amdgcn_fence(__ATOMIC_RELEASE, "agent");
            asm volatile("s_waitcnt vmcnt(0)" ::: "memory");
            const unsigned og = xb_add(&bar[XB_TOP], 1u);
            const unsigned tg = og / nx;
            if (og + 1u == (tg + 1u) * nx) xb_add(&bar[XB_TOPGEN], 1u);
            else XB_SPIN(xb_ld(&bar[XB_TOPGEN]) == tg, bar);
            __builtin_amdgcn_fence(__ATOMIC_ACQUIRE, "agent");
            xb_add(&bar[XB_XGEN(b.x)], 1u);
            asm volatile("s_waitcnt vmcnt(0)" ::: "memory");
        } else {
            XB_SPIN(xb_ld(&bar[XB_XGEN(b.x)]) == gen, bar);
            __builtin_amdgcn_fence(__ATOMIC_ACQUIRE, "agent");
            asm volatile("s_waitcnt vmcnt(0)" ::: "memory");
        }
    }
    __syncthreads();
}

constexpr int NPHASES = 11;
__global__ void __launch_bounds__(NTHREADS, 2) mk_fwd(Args a) {
    extern __shared__ __attribute__((aligned(16))) unsigned char lds[];
    cg::grid_group grid = cg::this_grid();
    const int lo = a.ph_lo, hi = a.ph_hi;
    volatile LAS unsigned* xbw = (volatile LAS unsigned*)(lds + LDS_MAIN);
    if (threadIdx.x < 4) xbw[threadIdx.x] = 0u;
    __syncthreads();
    XcdBarrier xbar = xcd_barrier_post((unsigned*)(a.ws + WS_CTL), xbw);
#define IN(k) (lo <= (k) && (k) < hi)
    if (lo < 0) grid.sync();
#define SEAM(k) do { if (IN(k) && IN((k) + 1)) xcd_barrier(xbar); } while (0)
    const float* mod = (const float*)(a.ws + WS_MOD);
    if (IN(0)) phase0(a, lds);
    SEAM(0);
    if (IN(1)) norm_mod_phase<false>(a.x, a.g_mix, mod, 0, 1, (u16*)(a.ws + WS_ACT));
    SEAM(1);
    if (IN(2)) { gemm8(lds, (const u16*)(a.ws + WS_ACT), (const u16*)(a.ws + WS_WIN), T, NP, D, EpiProj{(u16*)(a.ws + WS_P), (const float*)(a.ws + WS_CS)}); gz_phase(lds, (const u16*)(a.ws + WS_ACT), (const u16*)(a.ws + WS_WIN) + (size_t)NP * D, (float*)(a.ws + WS_GZ)); }
    SEAM(2);
    if (IN(3)) phase_rope_prep(a, lds);
    SEAM(3);
    if (IN(4)) phase_mixers(a, lds);
    SEAM(4);
    if (IN(5)) phase_gla_fin(a);
    SEAM(5);
    if (IN(6)) gemm8(lds, (const u16*)(a.ws + WS_ACT), (const u16*)(a.ws + WS_WOUT), T, D, D, EpiResid{a.x, mod, (u16*)(a.ws + WS_X1)});
    SEAM(6);
    if (IN(7)) { norm_mod_phase<true>(a.ws + WS_X1, a.g_ffn, mod, 3, 4, (u16*)(a.ws + WS_ACT)); convert_tables(a); }
    SEAM(7);
    if (IN(8)) gemm8(lds, (const u16*)(a.ws + WS_ACT), (const u16*)(a.ws + WS_WPQ), T, D, D, EpiBf16{(u16*)(a.ws + WS_Q)});
    SEAM(8);
    if (IN(9)) phase_route(a, lds);
    SEAM(9);
    if (IN(10)) phase_experts(a);
#ifdef PROBE_REP10
    grid.sync(); phase_experts(a);
#endif
#ifdef PROBE_REP9
    grid.sync(); phase_route(a, lds); grid.sync(); phase_experts(a);
#endif
#undef IN
#undef SEAM
}

#ifndef MK_ONE_LAUNCH
#define MK_ONE_LAUNCH 1
#endif
extern "C" void kernel_launch(void* const* d_in, const int* in_sizes, int n_in, void* d_out, int out_size, void* d_ws, size_t ws_size, hipStream_t stream) {
    static int grid = 0;
    if (grid == 0) {
        if (n_in != 19 || out_size != T * D || ws_size < WS_END) {
            fprintf(stderr, "kernel_launch: unexpected shapes: n_in %d out %d ws %zu (need %zu)\n", n_in, out_size, ws_size, (size_t)WS_END);
            grid = -1; return;
        }
        int dev = 0, cus = 0, per_cu = 0;
        (void)hipGetDevice(&dev);
        (void)hipDeviceGetAttribute(&cus, hipDeviceAttributeMultiprocessorCount, dev);
        (void)hipFuncSetAttribute((const void*)mk_fwd, hipFuncAttributeMaxDynamicSharedMemorySize, LDS_BYTES);
        (void)hipOccupancyMaxActiveBlocksPerMultiprocessor(&per_cu, (const void*)mk_fwd, NTHREADS, LDS_BYTES);
        if (per_cu < 1) { fprintf(stderr, "kernel_launch: occupancy query says %d blocks/CU\n", per_cu); grid = -1; return; }
        grid = cus;
        (void)hipGetLastError();
    }
    if (grid < 0) return;
    Args a{};
    a.x = (const float*)d_in[0]; a.c = (const float*)d_in[1]; a.pos = (const int*)d_in[2]; a.w_ada = (const float*)d_in[3];
    a.b_ada = (const float*)d_in[4]; a.g_mix = (const float*)d_in[5]; a.w_in = (const float*)d_in[6]; a.wgf = (const float*)d_in[7];
    a.bgf = (const float*)d_in[8]; a.wgb = (const float*)d_in[9]; a.bgb = (const float*)d_in[10]; a.g_gla = (const float*)d_in[11];
    a.w_out = (const float*)d_in[12]; a.g_ffn = (const float*)d_in[13]; a.w_pq = (const float*)d_in[14]; a.subk = (const float*)d_in[15];
    a.pu = (const float*)d_in[16]; a.pv = (const float*)d_in[17]; a.g_fin = (const float*)d_in[18];
    a.out = (float*)d_out; a.ws = (unsigned char*)d_ws;
#if MK_ONE_LAUNCH
    (void)hipMemsetAsync((unsigned char*)d_ws + WS_CTL, 0, XCD_BAR_WORDS * 4, stream);
    a.ph_lo = 0; a.ph_hi = NPHASES;
    void* args[] = {&a};
    hipError_t e = hipLaunchCooperativeKernel((const void*)mk_fwd, dim3(grid), dim3(NTHREADS), args, LDS_BYTES, stream);
    if (e != hipSuccess) fprintf(stderr, "cooperative launch failed: %s (grid %d)\n", hipGetErrorString(e), grid);
#else
    for (int p = 0; p < NPHASES; ++p) {
        a.ph_lo = p; a.ph_hi = p + 1;
        hipLaunchKernelGGL(mk_fwd, dim3(grid), dim3(NTHREADS), LDS_BYTES, stream, a);
    }
#endif
}
```

```cpp
#include <hip/hip_runtime.h>
#include <hip/hip_cooperative_groups.h>
#include <cstdio>
#include <cstdint>

namespace cg = cooperative_groups;

typedef unsigned short u16;
typedef __attribute__((ext_vector_type(8))) short bf16x8;
typedef __attribute__((ext_vector_type(4))) float f32x4;
typedef short s16x4 __attribute__((ext_vector_type(4)));
#define TID ((int)threadIdx.x)
#define BID ((int)blockIdx.x)
#define GDIM ((int)gridDim.x)
#define LAS __attribute__((address_space(3)))

constexpr int D = 2048, NB = 4, S = 4096, T = NB * S;
constexpr int INW = 6176;
constexpr int NP = 6144;
constexpr int NPAD = 6208;
constexpr int C_GQ = 0, C_GK = 512, C_GV = 1024, C_GR = 2048, C_DQ = 3072, C_DK = 4096, C_DV = 5120;
constexpr int NTHREADS = 512, NWAVES = 8;
constexpr int LDS_MAIN = 128 * 1024;
constexpr int LDS_BYTES = LDS_MAIN + 16;
constexpr float NORM_EPS = 1e-6f;

constexpr size_t WS_CTL = 0;
constexpr size_t WS_MOD = 65536;
constexpr size_t WS_CS = 524288;
constexpr size_t WS_WIN = WS_CS + (size_t)T * 64 * 8;
constexpr size_t WS_WOUT = WS_WIN + (size_t)NPAD * D * 2;
constexpr size_t WS_WPQ = WS_WOUT + (size_t)D * D * 2;
constexpr size_t WS_ACT = WS_WPQ + (size_t)D * D * 2;
constexpr size_t WS_P = WS_ACT + (size_t)T * D * 2;
constexpr size_t WS_X1 = WS_P;
constexpr size_t WS_Q = WS_P + (size_t)T * D * 4;
constexpr size_t WS_GZ = WS_P + (size_t)T * NP * 2;
constexpr int GLA_NPREP = NB * 4 * 2 * (S / 64);
constexpr size_t WS_QD = WS_GZ + (size_t)T * 32 * 4;
constexpr size_t WS_KE = WS_QD + (size_t)GLA_NPREP * 16384;
constexpr size_t WS_AT = WS_KE + (size_t)GLA_NPREP * 16384;
constexpr size_t WS_DEC = WS_AT + (size_t)GLA_NPREP * 8192;
constexpr size_t WS_OFB = WS_DEC + (size_t)GLA_NPREP * 512;
constexpr size_t WS_IDX = WS_OFB + (size_t)2 * T * 1024 * 2;
constexpr size_t WS_GATE = WS_IDX + (size_t)T * 128 * 4;
constexpr size_t WS_END = WS_GATE + (size_t)T * 128 * 4;
constexpr size_t WS_TU = WS_QD;
constexpr size_t WS_TV = WS_QD + (size_t)16384 * 1152;
static_assert(WS_TV + (size_t)16384 * 1152 <= WS_IDX, "table region");

struct Args {
    const float* x; const float* c; const int* pos; const float* w_ada; const float* b_ada; const float* g_mix;
    const float* w_in; const float* wgf; const float* bgf; const float* wgb; const float* bgb; const float* g_gla;
    const float* w_out; const float* g_ffn; const float* w_pq; const float* subk; const float* pu; const float* pv; const float* g_fin;
    float* out; unsigned char* ws; int ph_lo, ph_hi;
};

__device__ __forceinline__ float bf2f(u16 h) { return __uint_as_float(((unsigned)h) << 16); }
typedef __bf16 hw_bf16x2 __attribute__((ext_vector_type(2)));
typedef float hw_f32x2 __attribute__((ext_vector_type(2)));
__device__ __forceinline__ unsigned pack2(float a, float b) { const hw_f32x2 f = {a, b}; return __builtin_bit_cast(unsigned, __builtin_convertvector(f, hw_bf16x2)); }
__device__ __forceinline__ u16 f2bf(float f) { return (u16)(pack2(f, 0.f) & 0xffffu); }
__device__ __forceinline__ float lo2f(unsigned p) { return __uint_as_float(p << 16); }
__device__ __forceinline__ float hi2f(unsigned p) { return __uint_as_float(p & 0xffff0000u); }
__device__ __forceinline__ float wave_sum(float v) {
#pragma unroll
    for (int o = 32; o > 0; o >>= 1) v += __shfl_xor(v, o);
    return v;
}
__device__ __forceinline__ float wave_max(float v) {
#pragma unroll
    for (int o = 32; o > 0; o >>= 1) v = fmaxf(v, __shfl_xor(v, o));
    return v;
}
__device__ __forceinline__ float silu_f(float v) { return v / (1.f + __expf(-v)); }
__device__ __forceinline__ float gelu_f(float a) { return 0.5f * a * (1.f + erff(a * 0.70710678118654752f)); }
__device__ __forceinline__ float logsigmoid_f(float z) { return z < 0.f ? z - log1pf(expf(z)) : -log1pf(expf(-z)); }

constexpr int MOD_BLOCKS = 96;
__device__ __forceinline__ void p0_mod(const Args& a, unsigned char* lds, int bi) {
    float* sc = (float*)lds;
    float* red = sc + 4 * 2048;
    const int tid = threadIdx.x, lane = tid & 63, wave = tid >> 6;
    for (int i = tid; i < 4 * 2048; i += NTHREADS) sc[i] = silu_f(a.c[i]);
    __syncthreads();
    const int j0 = bi * 128 + lane * 2;
    float acc[4][2];
#pragma unroll
    for (int b = 0; b < 4; ++b) { acc[b][0] = 0.f; acc[b][1] = 0.f; }
    const int k0 = wave * 256;
#pragma unroll 8
    for (int kk = 0; kk < 256; ++kk) {
        const int k = k0 + kk;
        const hw_f32x2 wv_ = __builtin_nontemporal_load((const hw_f32x2*)(a.w_ada + (size_t)k * 12288 + j0)); const float2 w = make_float2(wv_[0], wv_[1]);
#pragma unroll
        for (int b = 0; b < 4; ++b) { const float s = sc[b * 2048 + k]; acc[b][0] += s * w.x; acc[b][1] += s * w.y; }
    }
#pragma unroll
    for (int b = 0; b < 4; ++b) { red[(wave * 4 + b) * 128 + lane * 2] = acc[b][0]; red[(wave * 4 + b) * 128 + lane * 2 + 1] = acc[b][1]; }
    __syncthreads();
    float* mod = (float*)(a.ws + WS_MOD);
    {
        const int b = tid >> 7, jc = tid & 127;
        float s = 0.f;
#pragma unroll
        for (int w = 0; w < 8; ++w) s += red[(w * 4 + b) * 128 + jc];
        mod[b * 12288 + bi * 128 + jc] = s + a.b_ada[bi * 128 + jc];
    }
    __syncthreads();
}

__device__ __forceinline__ void p0_transpose_item(const float* __restrict__ W, int ldw, int k0, int src_col0, int n_valid,
                                                  u16* __restrict__ WT, int ldt, int n_out0, unsigned char* wlds, bool rope_perm = false) {
    u16* tl = (u16*)wlds;
    const int lane = threadIdx.x & 63;
    const int rsub = lane >> 4, nc = (lane & 15) * 4;
    int scol = src_col0 + nc;
    if (rope_perm) { const int p = (n_out0 & 64) + nc, g = p >> 3; scol = (src_col0 - (n_out0 & 64)) + ((p & 4) ? 64 + 4 * g : 4 * g); }
    float4 v[16];
#pragma unroll
    for (int j = 0; j < 16; ++j) {
        const int k = 4 * j + rsub;
        if (nc < n_valid) { const f32x4 q_ = __builtin_nontemporal_load((const f32x4*)(W + (size_t)(k0 + k) * ldw + scol)); v[j] = make_float4(q_[0], q_[1], q_[2], q_[3]); }
        else v[j] = make_float4(0.f, 0.f, 0.f, 0.f);
    }
#pragma unroll
    for (int j = 0; j < 16; ++j) {
        const int k = 4 * j + rsub;
        tl[(nc + 0) * 72 + k] = f2bf(v[j].x); tl[(nc + 1) * 72 + k] = f2bf(v[j].y); tl[(nc + 2) * 72 + k] = f2bf(v[j].z); tl[(nc + 3) * 72 + k] = f2bf(v[j].w);
    }
#pragma unroll
    for (int j = 0; j < 8; ++j) {
        const int c = lane + 64 * j, n = c >> 3, kc = (c & 7) * 8;
        const uint4 o = *(const uint4*)(tl + n * 72 + kc);
        *(uint4*)(WT + (size_t)(n_out0 + n) * ldt + k0 + kc) = o;
    }
}

__device__ __forceinline__ void phase0(const Args& a, unsigned char* lds) {
    const int bi = blockIdx.x, G = gridDim.x, tid = threadIdx.x, wave = tid >> 6;
    const bool modblk = (G > MOD_BLOCKS) && (bi < MOD_BLOCKS);
    if (G > MOD_BLOCKS) { if (modblk) p0_mod(a, lds, bi); }
    else { for (int mb = bi; mb < MOD_BLOCKS; mb += G) p0_mod(a, lds, mb); }
    const int nb = (G > MOD_BLOCKS) ? G - MOD_BLOCKS : G, b0 = (G > MOD_BLOCKS) ? bi - MOD_BLOCKS : bi;
    if (!modblk) {
        constexpr int I_IN = 32 * (NPAD / 64), I_SQ = 32 * 32;
        u16* WinT = (u16*)(a.ws + WS_WIN); u16* WoutT = (u16*)(a.ws + WS_WOUT); u16* WpqT = (u16*)(a.ws + WS_WPQ);
        unsigned char* wlds = lds + wave * 9216;
        for (int it = b0 * NWAVES + wave; it < I_IN + 2 * I_SQ; it += nb * NWAVES) {
            if (it < I_IN) {
                const int kt = it & 31, nt = it >> 5;
                const int n0 = nt * 64;
                int src, nv;
                if (n0 < 3072) { src = n0; nv = 64; }
                else if (n0 < 6144) { src = n0 + 32; nv = 64; }
                else if (n0 == 6144) { src = 3072; nv = 32; }
                else { src = 0; nv = 0; }
                p0_transpose_item(a.w_in, INW, kt * 64, src, nv, WinT, D, n0, wlds, n0 >= C_DQ && n0 < C_DV);
            } else if (it < I_IN + I_SQ) {
                const int r = it - I_IN; const int kt = r & 31, nt = r >> 5;
                p0_transpose_item(a.w_out, D, kt * 64, nt * 64, 64, WoutT, D, nt * 64, wlds);
            } else {
                const int r = it - I_IN - I_SQ; const int kt = r & 31, nt = r >> 5;
                p0_transpose_item(a.w_pq, D, kt * 64, nt * 64, 64, WpqT, D, nt * 64, wlds);
            }
        }
        float2* cs = (float2*)(a.ws + WS_CS);
        for (int i = b0 * NTHREADS + tid; i < T * 64; i += nb * NTHREADS) {
            const int t = i >> 6, f = i & 63;
            const float inv_freq = powf(10000.0f, -(float)f * 2.0f / 128.0f);
            const float ang = (float)a.pos[t] * inv_freq;
            const double rev = (double)ang * 0.15915494309189533577;
            const float fr = (float)(rev - floor(rev));
            cs[i] = make_float2(__builtin_amdgcn_cosf(fr), __builtin_amdgcn_sinf(fr));
        }
    }
    __syncthreads();
}

template <bool BF16IN> __device__ __forceinline__ void norm_mod_phase(const void* __restrict__ xin_, const float* __restrict__ g, const float* __restrict__ mod,
                                               int sh_chunk, int sc_chunk, u16* __restrict__ outp) {
    const int lane = threadIdx.x & 63, wave = threadIdx.x >> 6;
    const int gw = blockIdx.x * NWAVES + wave, NGW = gridDim.x * NWAVES;
    float4 v[8], vn[8];
#define NM_LOAD(dst_, t_) do { if (BF16IN) { const hw_f32x2* xr_ = (const hw_f32x2*)((const u16*)xin_ + (size_t)(t_) * D); \
            _Pragma("unroll") for (int m = 0; m < 8; ++m) { const hw_f32x2 q_ = __builtin_nontemporal_load(xr_ + lane + 64 * m); const unsigned px_ = __float_as_uint(q_[0]), py_ = __float_as_uint(q_[1]); \
                dst_[m] = make_float4(lo2f(px_), hi2f(px_), lo2f(py_), hi2f(py_)); } } \
        else { const f32x4* xr_ = (const f32x4*)((const float*)xin_ + (size_t)(t_) * D); \
            _Pragma("unroll") for (int m = 0; m < 8; ++m) { const f32x4 q_ = __builtin_nontemporal_load(xr_ + lane + 64 * m); dst_[m] = make_float4(q_[0], q_[1], q_[2], q_[3]); } } } while (0)
    if (gw < T) NM_LOAD(v, gw);
    for (int t = gw; t < T; t += NGW) {
        const int b = t / S;
        if (t + NGW < T) NM_LOAD(vn, t + NGW);
        float ss = 0.f;
#pragma unroll
        for (int m = 0; m < 8; ++m) ss += v[m].x * v[m].x + v[m].y * v[m].y + v[m].z * v[m].z + v[m].w * v[m].w;
        ss = wave_sum(ss);
        const float rstd = rsqrtf(ss * (1.f / D) + NORM_EPS);
        const float4* gp = (const float4*)g;
        const float4* shp = (const float4*)(mod + b * 12288 + sh_chunk * 2048);
        const float4* scp = (const float4*)(mod + b * 12288 + sc_chunk * 2048);
        uint2* op = (uint2*)(outp + (size_t)t * D);
#pragma unroll
        for (int m = 0; m < 8; ++m) {
            const int i = lane + 64 * m;
            const float4 gg = gp[i], sh = shp[i], sc = scp[i];
            const float h0 = v[m].x * rstd * gg.x * (1.f + sc.x) + sh.x;
            const float h1 = v[m].y * rstd * gg.y * (1.f + sc.y) + sh.y;
            const float h2 = v[m].z * rstd * gg.z * (1.f + sc.z) + sh.z;
            const float h3 = v[m].w * rstd * gg.w * (1.f + sc.w) + sh.w;
            op[i] = make_uint2(pack2(h0, h1), pack2(h2, h3));
        }
#pragma unroll
        for (int m = 0; m < 8; ++m) v[m] = vn[m];
    }
#undef NM_LOAD
}

namespace pg8 {
#define PG8_LAS __attribute__((address_space(3)))
typedef unsigned short bf16_t;
typedef short bf16x8 __attribute__((ext_vector_type(8)));
typedef float f32x4 __attribute__((ext_vector_type(4)));
typedef unsigned u32x4 __attribute__((ext_vector_type(4)));
constexpr int BM = 256, BK = 64, HALF = 128, HTB = HALF * BK * 2  , STAGE_BYTES = 8 * HTB, NXCD = 8, WGM = 8;

__host__ __device__ __forceinline__ int lds_byte(int r, int c) { const int st = (r >> 4) * 2 + (c >> 5), rr = r & 15, cc = c & 31, ob = rr * 64 + cc * 2; return st * 1024 + (ob ^ (((ob >> 9) & 1) << 5)); }
__host__ __device__ __forceinline__ void stage_rc(int b, int& R, int& C) { const int st = b / 1024, sb = b % 1024, swz = sb ^ (((sb >> 9) & 1) << 5); R = (st >> 1) * 16 + swz / 64; C = (st & 1) * 32 + (swz % 64) / 2; }
__host__ __device__ __forceinline__ int perm32(int rho) { const int n = rho >> 4, i = rho & 15; return 8 * (i >> 2) + 4 * n + (i & 3); }

struct Unit { int pm, pn; };
struct Gemm { const bf16_t* A; const bf16_t* Bt; int M, N, K; };

struct StaticOrder {
    int nM, nN, nwg, G, c;
    __host__ __device__ void init(int M, int N, int G_, int c_) { nM = M / BM; nN = N / BM; nwg = nM * nN; G = G_; c = c_; }
    __host__ __device__ bool next(int i, Unit& u) const {
        const long L = (long)i * G + c; if (L >= nwg) return false;
        int wgid = (int)L; { const int q = nwg / NXCD, r = nwg % NXCD, xcd = wgid % NXCD, off = wgid / NXCD; wgid = (xcd < r ? xcd * (q + 1) : r * (q + 1) + (xcd - r) * q) + off; }
        const int nig = WGM * nN, gid = wgid / nig, fm = gid * WGM, gsz = (nM - fm) < WGM ? (nM - fm) : WGM;
        u.pm = fm + ((wgid % nig) % gsz); u.pn = (wgid % nig) / gsz; return true;
    }
    __device__ __forceinline__ void a_ready(const Unit&) const {}
    __device__ __forceinline__ void done(const Unit&) const {}
};
__device__ __forceinline__ unsigned cvt_pk_bf16(float lo, float hi) { unsigned r; asm volatile("v_cvt_pk_bf16_f32 %0, %1, %2" : "=v"(r) : "v"(lo), "v"(hi)); return r; }
typedef float f32x2 __attribute__((ext_vector_type(2)));
template <class Epi, class Sched, bool STAMP = false>
__device__ __forceinline__ void gemm_phase(PG8_LAS unsigned char* lds, const Gemm g, const Sched& S, const Epi& E, unsigned long long* stamps) {
    const int tid = threadIdx.x, wid = __builtin_amdgcn_readfirstlane(tid >> 6), lane = tid & 63, wr = wid >> 2, wc = wid & 3, fr = lane & 15, fq = lane >> 4;
    const int K = g.K, nt = K / BK;
    int ts_lo = 0, ts_hi = 0, nts = 0; const unsigned long long rt_entry = STAMP ? (unsigned long long)wall_clock64() : 0ull;
#define PG8_STAMP() do { if (STAMP && wid == 0 && nts < 64) { const unsigned long long _c = (unsigned long long)clock64(); \
        ts_lo = (lane == nts) ? (int)(unsigned)_c : ts_lo; ts_hi = (lane == nts) ? (int)(unsigned)(_c >> 32) : ts_hi; ++nts; } } while (0)
    PG8_STAMP();
    unsigned voffA[2], voffB[2];
#pragma unroll
    for (int i = 0; i < 2; ++i) { int R, C; stage_rc(tid * 16 + i * 8192, R, C); const int Rb = Epi::PERM ? ((R & ~31) + perm32(R & 31)) : R;
        voffA[i] = (unsigned)(R * K + C) * 2u; voffB[i] = (unsigned)(Rb * K + C) * 2u; }
    const size_t kstep = (size_t)(BK * 2);
    const size_t hstep = (size_t)HALF * K * 2;
    const size_t tstep = 2 * hstep;
    const unsigned ldsw = (unsigned)wid * 1024u;
    const int aoff = lds_byte(wr * 64 + fr, fq * 8), boff = lds_byte(wc * 32 + fr, fq * 8);
#define PG8_SA(b, h) (((b) * 2 + (h)) * HTB)
#define PG8_SB(b, h) ((4 + (b) * 2 + (h)) * HTB)
#define PG8_STAGE(bufoff, gbase, voff) do { _Pragma("unroll") for (int _i = 0; _i < 2; ++_i) \
        __builtin_amdgcn_global_load_lds((const unsigned*)((const char*)(gbase) + (voff)[_i]), (PG8_LAS unsigned*)(lds + (bufoff) + ldsw + _i * 8192), 16, 0, 0); } while (0)
#define PG8_LDA(dst, b, h) do { _Pragma("unroll") for (int m = 0; m < 4; ++m) _Pragma("unroll") for (int k = 0; k < 2; ++k) dst[m][k] = *(const PG8_LAS bf16x8*)(lds + PG8_SA(b, h) + aoff + m * 2048 + k * 1024); } while (0)
#define PG8_LDB(dst, b, h) do { _Pragma("unroll") for (int n = 0; n < 2; ++n) _Pragma("unroll") for (int k = 0; k < 2; ++k) dst[n][k] = *(const PG8_LAS bf16x8*)(lds + PG8_SB(b, h) + boff + n * 2048 + k * 1024); } while (0)
#define PG8_MMA(ai, bj, At, Bt) do { __builtin_amdgcn_s_setprio(1); _Pragma("unroll") for (int m = 0; m < 4; ++m) _Pragma("unroll") for (int n = 0; n < 2; ++n) _Pragma("unroll") for (int k = 0; k < 2; ++k) \
        acc[ai][bj][m][n] = __builtin_amdgcn_mfma_f32_16x16x32_bf16(Bt[n][k], At[m][k], acc[ai][bj][m][n], 0, 0, 0); __builtin_amdgcn_s_setprio(0); } while (0)
#define PG8_WAIT_V(n) asm volatile("s_waitcnt vmcnt(" #n ")" ::: "memory")
#define PG8_WAIT_L(n) asm volatile("s_waitcnt lgkmcnt(" #n ")" ::: "memory")
#define PG8_BAR __builtin_amdgcn_s_barrier()
#define PG8_SCHED __builtin_amdgcn_sched_barrier(0)
    Unit cur, nxt; int ui = 0;
    if (!S.next(0, cur)) return;
    f32x4 acc[2][2][4][2];
#pragma unroll
    for (int a = 0; a < 2; ++a)
#pragma unroll
        for (int b = 0; b < 2; ++b)
#pragma unroll
            for (int m = 0; m < 4; ++m)
#pragma unroll
                for (int n = 0; n < 2; ++n) acc[a][b][m][n] = (f32x4){0.f, 0.f, 0.f, 0.f};
    bf16x8 At[4][2], B0[2][2], B1[2][2];
    const char* cA = (const char*)g.A + (size_t)cur.pm * tstep; const char* cB = (const char*)g.Bt + (size_t)cur.pn * tstep;
    S.a_ready(cur);
    PG8_STAGE(PG8_SB(0, 0), cB, voffB); PG8_STAGE(PG8_SA(0, 0), cA, voffA); PG8_STAGE(PG8_SB(0, 1), cB + hstep, voffB); PG8_STAGE(PG8_SA(0, 1), cA + hstep, voffA);
    if (wr == 1) PG8_BAR;
    PG8_WAIT_V(4); PG8_BAR;
    PG8_STAGE(PG8_SB(1, 0), cB + kstep, voffB); PG8_STAGE(PG8_SA(1, 0), cA + kstep, voffA); PG8_STAGE(PG8_SB(1, 1), cB + hstep + kstep, voffB);
    PG8_WAIT_V(6); PG8_BAR;
    PG8_STAMP();
    for (;;) {
        const bool has_next = S.next(ui + 1, nxt);
        const char* nA = has_next ? (const char*)g.A + (size_t)nxt.pm * tstep : cA; const char* nB = has_next ? (const char*)g.Bt + (size_t)nxt.pn * tstep : cB;
        for (int t = 0; t < nt; t += 2) {
            const bool last = (t == nt - 2);
            const char* a1 = cA + (size_t)(t + 1) * kstep;
            const char* a2 = last ? nA : cA + (size_t)(t + 2) * kstep; const char* b2 = last ? nB : cB + (size_t)(t + 2) * kstep;
            const char* a3 = a2 + kstep; const char* b3 = b2 + kstep;
            if (last && has_next) S.a_ready(nxt);
            PG8_LDB(B0, 0, 0); PG8_SCHED; PG8_LDA(At, 0, 0); PG8_STAGE(PG8_SA(1, 1), a1 + hstep, voffA);
            PG8_WAIT_L(8); PG8_BAR; PG8_WAIT_L(0); PG8_MMA(0, 0, At, B0); PG8_BAR; PG8_SCHED;
            PG8_LDB(B1, 0, 1); PG8_STAGE(PG8_SB(0, 0), b2, voffB);
            PG8_BAR; PG8_WAIT_L(0); PG8_MMA(0, 1, At, B1); PG8_BAR;
            PG8_LDA(At, 0, 1); PG8_STAGE(PG8_SA(0, 0), a2, voffA);
            PG8_BAR; PG8_WAIT_L(0); PG8_MMA(1, 0, At, B0); PG8_BAR; PG8_SCHED;
            PG8_STAGE(PG8_SB(0, 1), b2 + hstep, voffB);
            PG8_WAIT_V(6); PG8_BAR; PG8_MMA(1, 1, At, B1); PG8_BAR;
            PG8_LDB(B0, 1, 0); PG8_SCHED; PG8_LDA(At, 1, 0); PG8_STAGE(PG8_SA(0, 1), a2 + hstep, voffA);
            PG8_WAIT_L(8); PG8_BAR; PG8_WAIT_L(0); PG8_MMA(0, 0, At, B0); PG8_BAR; PG8_SCHED;
            PG8_LDB(B1, 1, 1); PG8_STAGE(PG8_SB(1, 0), b3, voffB);
            PG8_BAR; PG8_WAIT_L(0); PG8_MMA(0, 1, At, B1); PG8_BAR;
            PG8_LDA(At, 1, 1); PG8_STAGE(PG8_SA(1, 0), a3, voffA);
            PG8_BAR; PG8_WAIT_L(0); PG8_MMA(1, 0, At, B0); PG8_BAR; PG8_SCHED;
            PG8_STAGE(PG8_SB(1, 1), b3 + hstep, voffB);
            PG8_WAIT_V(6); PG8_BAR; PG8_MMA(1, 1, At, B1); PG8_BAR;
        }
        PG8_STAMP();
        if constexpr (!Epi::AFTER_DRAIN) { E(acc, cur, wr, wc, fr, fq); S.done(cur); }
        PG8_STAMP();
        if (!has_next) break;
#pragma unroll
        for (int a = 0; a < 2; ++a)
#pragma unroll
            for (int b = 0; b < 2; ++b)
#pragma unroll
                for (int m = 0; m < 4; ++m)
#pragma unroll
                    for (int n = 0; n < 2; ++n) acc[a][b][m][n] = (f32x4){0.f, 0.f, 0.f, 0.f};
        cur = nxt; cA = nA; cB = nB; ++ui;
    }
    PG8_WAIT_V(0);
    if (wr == 0) PG8_BAR;
    PG8_BAR;
    if constexpr (Epi::AFTER_DRAIN) { E.fused(acc, cur, wr, wc, fr, fq, lds, wid, lane); S.done(cur); }
    PG8_STAMP();
    if (STAMP && wid == 0) { stamps[lane] = lane < nts ? (((unsigned long long)(unsigned)ts_hi << 32) | (unsigned)ts_lo) : 0ull;
        if (lane == 62) stamps[62] = rt_entry; if (lane == 63) stamps[63] = (unsigned long long)wall_clock64(); }
#undef PG8_STAMP
#undef PG8_SA
#undef PG8_SB
#undef PG8_STAGE
#undef PG8_LDA
#undef PG8_LDB
#undef PG8_MMA
#undef PG8_WAIT_V
#undef PG8_WAIT_L
#undef PG8_BAR
#undef PG8_SCHED
}
}

struct EpiProj {
    static constexpr bool PERM = true, AFTER_DRAIN = false;
    u16* P; const float* cs;
    __device__ __forceinline__ void operator()(const pg8::f32x4 (&acc)[2][2][4][2], const pg8::Unit& u, int wr, int wc, int fr, int fq) const {
        const int row0 = u.pm * 256 + wr * 64 + fr;
        const int col0 = u.pn * 256 + wc * 32 + 8 * fq;
        const bool rope = (u.pn >= C_DQ / 256) && (u.pn < C_DV / 256);
#pragma unroll
        for (int ai = 0; ai < 2; ++ai)
#pragma unroll
            for (int m = 0; m < 4; ++m) { const int row = row0 + ai * 128 + m * 16; u16* rowp = P + (size_t)row * NP + col0;
                pg8::f32x4 c01 = (pg8::f32x4){1.f, 0.f, 1.f, 0.f}, c23 = c01;
                if (rope) { const pg8::f32x4* cp = (const pg8::f32x4*)(cs + ((size_t)row * 64 + 4 * (4 * wc + fq)) * 2); c01 = cp[0]; c23 = cp[1]; }
#pragma unroll
                for (int bj = 0; bj < 2; ++bj) { pg8::f32x4 v0 = acc[ai][bj][m][0], v1 = acc[ai][bj][m][1];
                    if (rope) {
                        const pg8::f32x4 cc = {c01[0], c01[2], c23[0], c23[2]}, sn = {c01[1], c01[3], c23[1], c23[3]};
                        const pg8::f32x4 y1 = v0 * cc - v1 * sn, y2 = v0 * sn + v1 * cc; v0 = y1; v1 = y2; }
                    pg8::u32x4 w; w.x = pg8::cvt_pk_bf16(v0[0], v0[1]); w.y = pg8::cvt_pk_bf16(v0[2], v0[3]); w.z = pg8::cvt_pk_bf16(v1[0], v1[1]); w.w = pg8::cvt_pk_bf16(v1[2], v1[3]);
                    *(pg8::u32x4*)(rowp + bj * 128) = w; } }
    }
};
__device__ __forceinline__ void gz_phase(unsigned char* lds, const u16* __restrict__ H1, const u16* __restrict__ Wg, float* __restrict__ gz) {
    const int tid = threadIdx.x, lane = tid & 63, wave = tid >> 6, fr = lane & 15, fq = lane >> 4;
    float* red = (float*)lds;
    for (int rb = blockIdx.x; rb < T / 64; rb += gridDim.x) {
        const int r0 = rb * 64, k0 = wave * 256;
        f32x4 acc[4][2];
#pragma unroll
        for (int m = 0; m < 4; ++m) { acc[m][0] = (f32x4){0.f, 0.f, 0.f, 0.f}; acc[m][1] = (f32x4){0.f, 0.f, 0.f, 0.f}; }
#pragma unroll
        for (int ks = 0; ks < 8; ++ks) {
            bf16x8 af[4], bfr[2];
#pragma unroll
            for (int m = 0; m < 4; ++m) af[m] = *(const bf16x8*)(H1 + (size_t)(r0 + 16 * m + fr) * D + k0 + 32 * ks + 8 * fq);
#pragma unroll
            for (int n = 0; n < 2; ++n) bfr[n] = *(const bf16x8*)(Wg + (size_t)(16 * n + fr) * D + k0 + 32 * ks + 8 * fq);
#pragma unroll
            for (int m = 0; m < 4; ++m)
#pragma unroll
                for (int n = 0; n < 2; ++n) acc[m][n] = __builtin_amdgcn_mfma_f32_16x16x32_bf16(af[m], bfr[n], acc[m][n], 0, 0, 0);
        }
        __syncthreads();
#pragma unroll
        for (int m = 0; m < 4; ++m)
#pragma unroll
            for (int n = 0; n < 2; ++n)
#pragma unroll
                for (int j = 0; j < 4; ++j) red[(wave * 64 + 16 * m + 4 * fq + j) * 32 + 16 * n + fr] = acc[m][n][j];
        __syncthreads();
#pragma unroll
        for (int k = 0; k < 4; ++k) {
            const int e = tid + 512 * k;
            float s = 0.f;
#pragma unroll
            for (int w = 0; w < 8; ++w) s += red[w * 2048 + e];
            gz[(size_t)r0 * 32 + e] = s;
        }
    }
    __syncthreads();
}
struct EpiResid {
    static constexpr bool PERM = true, AFTER_DRAIN = false;
    const float* x; const float* mod; u16* x1;
    __device__ __forceinline__ void operator()(const pg8::f32x4 (&acc)[2][2][4][2], const pg8::Unit& u, int wr, int wc, int fr, int fq) const {
        const int row0 = u.pm * 256 + wr * 64 + fr, col0 = u.pn * 256 + wc * 32 + 8 * fq;
        const int b = (u.pm * 256) / S;
        pg8::f32x4 ga[2][2];
#pragma unroll
        for (int bj = 0; bj < 2; ++bj)
#pragma unroll
            for (int n = 0; n < 2; ++n) ga[bj][n] = *(const pg8::f32x4*)(mod + b * 12288 + 2 * 2048 + col0 + bj * 128 + 4 * n);
#pragma unroll
        for (int ai = 0; ai < 2; ++ai)
#pragma unroll
            for (int m = 0; m < 4; ++m) { const size_t off = (size_t)(row0 + ai * 128 + m * 16) * D + col0;
#pragma unroll
                for (int bj = 0; bj < 2; ++bj) {
                    const pg8::f32x4 x0 = __builtin_nontemporal_load((const pg8::f32x4*)(x + off + bj * 128)), x1v = __builtin_nontemporal_load((const pg8::f32x4*)(x + off + bj * 128 + 4));
                    const pg8::f32x4 v0 = x0 + ga[bj][0] * acc[ai][bj][m][0], v1 = x1v + ga[bj][1] * acc[ai][bj][m][1];
                    pg8::u32x4 w; w.x = pg8::cvt_pk_bf16(v0[0], v0[1]); w.y = pg8::cvt_pk_bf16(v0[2], v0[3]); w.z = pg8::cvt_pk_bf16(v1[0], v1[1]); w.w = pg8::cvt_pk_bf16(v1[2], v1[3]);
                    *(pg8::u32x4*)(x1 + off + bj * 128) = w; } }
    }
};
struct EpiBf16 {
    static constexpr bool PERM = true, AFTER_DRAIN = false;
    u16* Q;
    __device__ __forceinline__ void operator()(const pg8::f32x4 (&acc)[2][2][4][2], const pg8::Unit& u, int wr, int wc, int fr, int fq) const {
        const int row0 = u.pm * 256 + wr * 64 + fr, col0 = u.pn * 256 + wc * 32 + 8 * fq;
#pragma unroll
        for (int ai = 0; ai < 2; ++ai)
#pragma unroll
            for (int m = 0; m < 4; ++m) { u16* rowp = Q + (size_t)(row0 + ai * 128 + m * 16) * D + col0;
#pragma unroll
                for (int bj = 0; bj < 2; ++bj) { const pg8::f32x4 v0 = acc[ai][bj][m][0], v1 = acc[ai][bj][m][1];
                    pg8::u32x4 w; w.x = pg8::cvt_pk_bf16(v0[0], v0[1]); w.y = pg8::cvt_pk_bf16(v0[2], v0[3]); w.z = pg8::cvt_pk_bf16(v1[0], v1[1]); w.w = pg8::cvt_pk_bf16(v1[2], v1[3]);
                    *(pg8::u32x4*)(rowp + bj * 128) = w; } }
    }
};
template <class Epi>
__device__ __forceinline__ void gemm8(unsigned char* lds, const u16* A, const u16* Bt, int M, int N, int K, const Epi& E) {
    pg8::Gemm g{A, Bt, M, N, K}; pg8::StaticOrder So; So.init(M, N, (int)gridDim.x, (int)blockIdx.x);
    pg8::gemm_phase<Epi, pg8::StaticOrder, false>((PG8_LAS unsigned char*)lds, g, So, E, nullptr);
    __syncthreads();
}

#define GLA_QD_BYTES 16384
#define GLA_AT_BYTES 8192
__device__ __forceinline__ float gla_logsigmoid(float z) { return fminf(z, 0.f) - __logf(1.f + __expf(-fabsf(z))); }

__device__ __forceinline__ void gla_prep_item(const u16* __restrict__ P, int ldp, int cq, int ck, const float* __restrict__ gz,
                                              const float* __restrict__ wg_f, const float* __restrict__ bg_f, const float* __restrict__ wg_b, const float* __restrict__ bg_b,
                                              int Sq, unsigned char* __restrict__ QDg, unsigned char* __restrict__ KEg, unsigned char* __restrict__ ATg, float* __restrict__ DECg,
                                              unsigned char* lds, int item) {
    const int nch = Sq / 64;
    const int c = item % nch, dir = (item / nch) & 1, hh = (item / (nch * 2)) & 3, b = item / (nch * 8);
    const int tid = TID, lane = tid & 63, wave = tid >> 6, li = lane & 15, fq = lane >> 4;
    float* gzs = (float*)lds;
    float* segs = gzs + 64 * 16;
    unsigned char* QDs = lds + 8192;
    unsigned char* KIs = QDs + 16384;
    unsigned char* KEs = KIs + 16384;
    float* bmat = (float*)(KEs + 16384);
    const size_t tok0 = (size_t)b * Sq;
    __syncthreads();
    uint4 rq0, rq1, rk0, rk1;
    {
        const int i0 = tid >> 4, i1 = (tid + 512) >> 4, cc = tid & 15;
        const int s0 = dir ? (Sq - 1 - (64 * c + i0)) : (64 * c + i0), s1 = dir ? (Sq - 1 - (64 * c + i1)) : (64 * c + i1);
        rq0 = *(const uint4*)(P + (tok0 + s0) * ldp + cq + hh * 128 + cc * 8); rk0 = *(const uint4*)(P + (tok0 + s0) * ldp + ck + hh * 128 + cc * 8);
        rq1 = *(const uint4*)(P + (tok0 + s1) * ldp + cq + hh * 128 + cc * 8); rk1 = *(const uint4*)(P + (tok0 + s1) * ldp + ck + hh * 128 + cc * 8);
    }
    for (int e = tid; e < 64 * 16; e += 512) {
        const int i = e >> 4, r = e & 15;
        const int s = dir ? (Sq - 1 - (64 * c + i)) : (64 * c + i);
        gzs[e] = gz[(tok0 + s) * 32 + dir * 16 + r];
    }
    const int d = tid & 127, seg = tid >> 7;
    const float* wg = dir ? wg_b : wg_f;
    float wcol[16];
#pragma unroll
    for (int r = 0; r < 16; ++r) wcol[r] = wg[r * 512 + hh * 128 + d];
    const float bias = (dir ? bg_b : bg_f)[hh * 128 + d];
    __syncthreads();
    float run = 0.f;
#pragma unroll
    for (int k = 0; k < 16; ++k) {
        const int i = 16 * seg + k;
        float z = bias;
#pragma unroll
        for (int r = 0; r < 16; ++r) z += gzs[i * 16 + r] * wcol[r];
        run += gla_logsigmoid(z) * (1.f / 16.f);
        bmat[i * 128 + d] = run;
    }
    segs[seg * 128 + d] = run;
    __syncthreads();
    if (seg == 0) {
        const float t0 = segs[d], t1 = segs[128 + d], t2 = segs[256 + d], t3 = segs[384 + d];
        segs[d] = 0.f; segs[128 + d] = t0; segs[256 + d] = t0 + t1; segs[384 + d] = t0 + t1 + t2; segs[512 + d] = t0 + t1 + t2 + t3;
        DECg[(size_t)item * 128 + d] = __expf(t0 + t1 + t2 + t3);
    }
    __syncthreads();
    const float qscale = 0.08838834764831845f;
#pragma unroll
    for (int k = 0; k < 2; ++k) {
        const int id = tid + 512 * k, i = id >> 4, cc = id & 15, d0 = cc * 8, sg = i >> 4;
        const uint4 qv = k ? rq1 : rq0, kv = k ? rk1 : rk0;
        const float qx[8] = {lo2f(qv.x), hi2f(qv.x), lo2f(qv.y), hi2f(qv.y), lo2f(qv.z), hi2f(qv.z), lo2f(qv.w), hi2f(qv.w)};
        const float kx[8] = {lo2f(kv.x), hi2f(kv.x), lo2f(kv.y), hi2f(kv.y), lo2f(kv.z), hi2f(kv.z), lo2f(kv.w), hi2f(kv.w)};
        float qd[8], ki[8], ke[8];
        const float4 bA = *(const float4*)(bmat + i * 128 + d0), bB = *(const float4*)(bmat + i * 128 + d0 + 4);
        const float4 oA = *(const float4*)(segs + sg * 128 + d0), oB = *(const float4*)(segs + sg * 128 + d0 + 4);
        const float4 tA = *(const float4*)(segs + 512 + d0), tB = *(const float4*)(segs + 512 + d0 + 4);
        const float bv[8] = {bA.x + oA.x, bA.y + oA.y, bA.z + oA.z, bA.w + oA.w, bB.x + oB.x, bB.y + oB.y, bB.z + oB.z, bB.w + oB.w};
        const float tv[8] = {tA.x, tA.y, tA.z, tA.w, tB.x, tB.y, tB.z, tB.w};
#pragma unroll
        for (int e = 0; e < 8; ++e) {
            const float bb = bv[e], tot = tv[e];
            qd[e] = qx[e] * qscale * __expf(bb); ki[e] = kx[e] * __expf(-bb); ke[e] = kx[e] * __expf(tot - bb);
        }
        const int o = i * 256 + ((cc ^ (i & 15)) << 4);
        *(uint4*)(QDs + o) = make_uint4(pack2(qd[0], qd[1]), pack2(qd[2], qd[3]), pack2(qd[4], qd[5]), pack2(qd[6], qd[7]));
        *(uint4*)(KIs + o) = make_uint4(pack2(ki[0], ki[1]), pack2(ki[2], ki[3]), pack2(ki[4], ki[5]), pack2(ki[6], ki[7]));
        *(uint4*)(KEs + o) = make_uint4(pack2(ke[0], ke[1]), pack2(ke[2], ke[3]), pack2(ke[4], ke[5]), pack2(ke[6], ke[7]));
    }
    __syncthreads();
    {
        uint4* qo = (uint4*)(QDg + (size_t)item * GLA_QD_BYTES); uint4* ko = (uint4*)(KEg + (size_t)item * GLA_QD_BYTES);
#pragma unroll
        for (int k = 0; k < 2; ++k) { const int e = tid + 512 * k; qo[e] = ((const uint4*)QDs)[e]; ko[e] = ((const uint4*)KEs)[e]; }
    }
#pragma unroll
    for (int tt = 0; tt < 2; ++tt) {
        const int tile = wave + 8 * tt, jt = tile >> 2, it = tile & 3;
        f32x4 acc = (f32x4){0.f, 0.f, 0.f, 0.f};
        if (jt <= it) {
            const int jr = 16 * jt + li, ir = 16 * it + li;
#pragma unroll
            for (int ks = 0; ks < 4; ++ks) {
                const bf16x8 kf = *(const bf16x8*)(KIs + jr * 256 + (((4 * ks + fq) ^ (jr & 15)) << 4));
                const bf16x8 qf = *(const bf16x8*)(QDs + ir * 256 + (((4 * ks + fq) ^ (ir & 15)) << 4));
                acc = __builtin_amdgcn_mfma_f32_16x16x32_bf16(kf, qf, acc, 0, 0, 0);
            }
        }
        const int i = 16 * it + li, j0 = 16 * jt + 4 * fq;
        float v[4];
#pragma unroll
        for (int jj = 0; jj < 4; ++jj) v[jj] = (j0 + jj <= i) ? acc[jj] : 0.f;
        const int chunk = 2 * jt + (fq >> 1), sub = (fq & 1) * 8;
        *(uint2*)(ATg + (size_t)item * GLA_AT_BYTES + i * 128 + ((chunk ^ (i & 7)) << 4) + sub) = make_uint2(pack2(v[0], v[1]), pack2(v[2], v[3]));
    }
}

__device__ __forceinline__ void gla_seq_item(const u16* __restrict__ P, int ldp, int cv, int Sq,
                                             const unsigned char* __restrict__ QDg, const unsigned char* __restrict__ KEg, const unsigned char* __restrict__ ATg, const float* __restrict__ DECg,
                                             u16* __restrict__ Oout  , int Ttot, unsigned char* lds, int item) {
    const int slice = item & 1, dir = (item >> 1) & 1, hh = (item >> 2) & 3, b = item >> 4;
    const int nch = Sq / 64;
    const int tid = TID, lane = tid & 63, wave = tid >> 6, li = lane & 15, fq = lane >> 4;
    const size_t tok0 = (size_t)b * Sq;
    const int pitem0 = ((b * 4 + hh) * 2 + dir) * nch;
    constexpr int BUF = 16384 * 3 + 8192 + 512;
    typedef unsigned gla_u32x4 __attribute__((ext_vector_type(4)));
    gla_u32x4 rq0, rq1, rk0, rk1, rv0, rv1, ra; float rd = 0.f;
#define GLA_VROW(c_, k_) ((tok0 + (size_t)(dir ? (Sq - 1 - (64 * (c_) + ((tid + 512 * (k_)) >> 4))) : (64 * (c_) + ((tid + 512 * (k_)) >> 4)))) * ldp + cv + hh * 256 + slice * 128 + ((tid + 512 * (k_)) & 15) * 8)
#define GLA_ISSUE(c_) do { \
        const gla_u32x4* qsrc_ = (const gla_u32x4*)(QDg + (size_t)(pitem0 + (c_)) * GLA_QD_BYTES); const gla_u32x4* ksrc_ = (const gla_u32x4*)(KEg + (size_t)(pitem0 + (c_)) * GLA_QD_BYTES); \
        rq0 = qsrc_[tid]; rq1 = qsrc_[tid + 512]; rk0 = ksrc_[tid]; rk1 = ksrc_[tid + 512]; \
        ra = ((const gla_u32x4*)(ATg + (size_t)(pitem0 + (c_)) * GLA_AT_BYTES))[tid]; \
        rv0 = *(const gla_u32x4*)(P + GLA_VROW(c_, 0)); rv1 = *(const gla_u32x4*)(P + GLA_VROW(c_, 1)); \
        if (tid < 128) rd = DECg[(size_t)(pitem0 + (c_)) * 128 + tid]; } while (0)
#define GLA_COMMIT(buf_) do { \
        unsigned char* base_ = lds + (buf_) * BUF; \
        ((gla_u32x4*)base_)[tid] = rq0; ((gla_u32x4*)base_)[tid + 512] = rq1; ((gla_u32x4*)(base_ + 16384))[tid] = rk0; ((gla_u32x4*)(base_ + 16384))[tid + 512] = rk1; \
        { const int row_ = tid >> 4, ch_ = tid & 15; *(gla_u32x4*)(base_ + 32768 + row_ * 256 + ((ch_ ^ (row_ & 15)) << 4)) = rv0; } \
        { const int row_ = (tid + 512) >> 4, ch_ = tid & 15; *(gla_u32x4*)(base_ + 32768 + row_ * 256 + ((ch_ ^ (row_ & 15)) << 4)) = rv1; } \
        ((gla_u32x4*)(base_ + 49152))[tid] = ra; \
        if (tid < 128) ((float*)(base_ + 57344))[tid] = rd; } while (0)
    f32x4 st[8];
#pragma unroll
    for (int dt = 0; dt < 8; ++dt) st[dt] = (f32x4){0.f, 0.f, 0.f, 0.f};
    __syncthreads();
    GLA_ISSUE(0); GLA_COMMIT(0);
    __syncthreads();
#pragma unroll 1
    for (int c = 0; c < nch; ++c) {
        const int buf = c & 1;
        if (c + 1 < nch) GLA_ISSUE(c + 1);
        const unsigned char* QDs = lds + buf * BUF; const unsigned char* KEs = QDs + 16384; const unsigned char* Vs = QDs + 32768;
        const unsigned char* ATs = QDs + 49152; const float* DECs = (const float*)(QDs + 57344);
        bf16x8 vf[2];
#pragma unroll
        for (int jp = 0; jp < 2; ++jp) {
            const int rowA = 32 * jp + 8 * fq + (li >> 2), rowB = rowA + 4;
            const int chunk = 2 * wave + ((li & 3) >> 1), sub = ((li & 3) & 1) * 8;
            const s16x4 va = __builtin_amdgcn_ds_read_tr16_b64_v4i16((LAS s16x4*)(Vs + rowA * 256 + ((chunk ^ (rowA & 15)) << 4) + sub));
            const s16x4 vb = __builtin_amdgcn_ds_read_tr16_b64_v4i16((LAS s16x4*)(Vs + rowB * 256 + ((chunk ^ (rowB & 15)) << 4) + sub));
            vf[jp] = __builtin_shufflevector(va, vb, 0, 1, 2, 3, 4, 5, 6, 7);
        }
        bf16x8 sf[4];
#pragma unroll
        for (int dp = 0; dp < 4; ++dp) {
            const gla_u32x4 t_ = {pack2(st[2 * dp][0], st[2 * dp][1]), pack2(st[2 * dp][2], st[2 * dp][3]), pack2(st[2 * dp + 1][0], st[2 * dp + 1][1]), pack2(st[2 * dp + 1][2], st[2 * dp + 1][3])};
            sf[dp] = __builtin_bit_cast(bf16x8, t_);
        }
        f32x4 ot[4];
#pragma unroll
        for (int it = 0; it < 4; ++it) {
            f32x4 acc = (f32x4){0.f, 0.f, 0.f, 0.f};
            const int ir = 16 * it + li;
#pragma unroll
            for (int dp = 0; dp < 4; ++dp) {
                const int c0 = 4 * dp + (fq >> 1), c1 = c0 + 2, sub = (fq & 1) * 8;
                const uint2 lo = *(const uint2*)(QDs + ir * 256 + ((c0 ^ (ir & 15)) << 4) + sub);
                const uint2 hi = *(const uint2*)(QDs + ir * 256 + ((c1 ^ (ir & 15)) << 4) + sub);
                const gla_u32x4 q_ = {lo.x, lo.y, hi.x, hi.y};
                const bf16x8 qf = __builtin_bit_cast(bf16x8, q_);
                acc = __builtin_amdgcn_mfma_f32_16x16x32_bf16(sf[dp], qf, acc, 0, 0, 0);
            }
#pragma unroll
            for (int jp = 0; jp < 2; ++jp) {
                if (32 * jp <= 16 * it + 15) {
                    const bf16x8 af = *(const bf16x8*)(ATs + ir * 128 + (((4 * jp + fq) ^ (ir & 7)) << 4));
                    acc = __builtin_amdgcn_mfma_f32_16x16x32_bf16(vf[jp], af, acc, 0, 0, 0);
                }
            }
            ot[it] = acc;
        }
#pragma unroll
        for (int dt = 0; dt < 8; ++dt) {
            const f32x4 dec = *(const f32x4*)(DECs + 16 * dt + 4 * fq);
            f32x4 acc = st[dt] * dec;
#pragma unroll
            for (int jp = 0; jp < 2; ++jp) {
                const int rowA = 32 * jp + 8 * fq + (li >> 2), rowB = rowA + 4;
                const int chunk = 2 * dt + ((li & 3) >> 1), sub = ((li & 3) & 1) * 8;
                const s16x4 ka = __builtin_amdgcn_ds_read_tr16_b64_v4i16((LAS s16x4*)(KEs + rowA * 256 + ((chunk ^ (rowA & 15)) << 4) + sub));
                const s16x4 kb = __builtin_amdgcn_ds_read_tr16_b64_v4i16((LAS s16x4*)(KEs + rowB * 256 + ((chunk ^ (rowB & 15)) << 4) + sub));
                const bf16x8 kf = __builtin_shufflevector(ka, kb, 0, 1, 2, 3, 4, 5, 6, 7);
                acc = __builtin_amdgcn_mfma_f32_16x16x32_bf16(kf, vf[jp], acc, 0, 0, 0);
            }
            st[dt] = acc;
        }
#pragma unroll
        for (int it = 0; it < 4; ++it) {
            const int i = 16 * it + li;
            const int s = dir ? (Sq - 1 - (64 * c + i)) : (64 * c + i);
            *(uint2*)(Oout + ((size_t)dir * Ttot + tok0 + s) * 1024 + hh * 256 + slice * 128 + 16 * wave + 4 * fq) =
                make_uint2(pack2(ot[it][0], ot[it][1]), pack2(ot[it][2], ot[it][3]));
        }
        if (c + 1 < nch) GLA_COMMIT(buf ^ 1);
        __syncthreads();
    }
}
__device__ __forceinline__ void phase_rope_prep(const Args& a, unsigned char* lds) {
    u16* P = (u16*)(a.ws + WS_P);
    const float2* cs = (const float2*)(a.ws + WS_CS);
    const int gt = blockIdx.x * NTHREADS + threadIdx.x, NT = gridDim.x * NTHREADS;
    for (int item = blockIdx.x; item < GLA_NPREP; item += gridDim.x)
        gla_prep_item(P, NP, C_GQ, C_GK, (const float*)(a.ws + WS_GZ), a.wgf, a.bgf, a.wgb, a.bgb, S,
                      a.ws + WS_QD, a.ws + WS_KE, a.ws + WS_AT, (float*)(a.ws + WS_DEC), lds, item);
}

#define ATTN_DECODE(item_) \
    const int nb_per = Sq / 128; \
    const int within = (item_) % nb_per, hh = ((item_) / nb_per) & 7, b = ((item_) / (nb_per * 8)) & 3, pat = (item_) / (nb_per * 32); \
    const int dil = pat == 0 ? 1 : (pat == 1 ? 4 : 16); \
    const int M = Sq / dil; \
    const int r = within % dil, blk = within / dil; \
    const int p0 = blk * 128, kbase = p0 - 64; \
    const size_t tok0 = (size_t)b * Sq;
typedef unsigned attn_u32x4 __attribute__((ext_vector_type(4)));
__device__ __forceinline__ void attn_phase(const u16* __restrict__ P, int ldp, int cq, int ck, int cv, int Sq,
                                           u16* __restrict__ part_o, float* __restrict__ part_lse, int Ttot,
                                           unsigned char* lds, int first, int stride, int nitems) {
    const int tid = TID, lane = tid & 63, wave = tid >> 6, li = lane & 15, fq = lane >> 4;
    unsigned char* Ks = lds;
    unsigned char* Vs = lds + 65536;
    attn_u32x4 kr0, kr1, kr2, kr3, kr4, kr5, kr6, kr7, vr0, vr1, vr2, vr3, vr4, vr5, vr6, vr7;
    bf16x8 qn0, qn1, qn2, qn3;
#define ATTN_LD1(i_, kreg_, vreg_) { const int id_ = tid + 512 * (i_), row_ = id_ >> 4, c_ = id_ & 15; \
        int kp_ = kbase + row_; kp_ = kp_ < 0 ? 0 : (kp_ > M - 1 ? M - 1 : kp_); \
        const size_t t_ = tok0 + r + (size_t)dil * kp_; \
        kreg_ = *(const attn_u32x4*)(P + t_ * ldp + ck + hh * 128 + c_ * 8); vreg_ = *(const attn_u32x4*)(P + t_ * ldp + cv + hh * 128 + c_ * 8); }
#define ATTN_LOAD(item_) do { ATTN_DECODE(item_) \
        { const size_t tq_ = tok0 + r + (size_t)dil * (p0 + 16 * wave + li); const u16* qp_ = P + tq_ * ldp + cq + hh * 128 + 8 * fq; \
          qn0 = *(const bf16x8*)(qp_); qn1 = *(const bf16x8*)(qp_ + 32); qn2 = *(const bf16x8*)(qp_ + 64); qn3 = *(const bf16x8*)(qp_ + 96); } \
        ATTN_LD1(0, kr0, vr0) ATTN_LD1(1, kr1, vr1) ATTN_LD1(2, kr2, vr2) ATTN_LD1(3, kr3, vr3) ATTN_LD1(4, kr4, vr4) ATTN_LD1(5, kr5, vr5) ATTN_LD1(6, kr6, vr6) ATTN_LD1(7, kr7, vr7) } while (0)
#define ATTN_ST1(i_, kreg_, vreg_) { const int id_ = tid + 512 * (i_), row_ = id_ >> 4, c_ = id_ & 15; const int off_ = row_ * 256 + ((c_ ^ (row_ & 15)) << 4); \
        *(attn_u32x4*)(Ks + off_) = kreg_; *(attn_u32x4*)(Vs + off_) = vreg_; }
#define ATTN_COMMIT() do { ATTN_ST1(0, kr0, vr0) ATTN_ST1(1, kr1, vr1) ATTN_ST1(2, kr2, vr2) ATTN_ST1(3, kr3, vr3) ATTN_ST1(4, kr4, vr4) ATTN_ST1(5, kr5, vr5) ATTN_ST1(6, kr6, vr6) ATTN_ST1(7, kr7, vr7) } while (0)
    int item = first;
    if (item < nitems) ATTN_LOAD(item);
    for (; item < nitems; item += stride) {
        ATTN_DECODE(item)
        __syncthreads();
        ATTN_COMMIT();
        const int qp = p0 + 16 * wave + li;
        const size_t tq = tok0 + r + (size_t)dil * qp;
        const bf16x8 qf[4] = {qn0, qn1, qn2, qn3};
        __syncthreads();
        if (item + stride < nitems) ATTN_LOAD(item + stride);
        const float scale = 0.08838834764831845f;
        float m = -1e30f, l = 0.f;
        f32x4 o[8];
#pragma unroll
        for (int dt = 0; dt < 8; ++dt) o[dt] = (f32x4){0.f, 0.f, 0.f, 0.f};
#pragma unroll 1
        for (int tp = 0; tp < 5; ++tp) {
            float s[8]; bool ok[8];
#pragma unroll
            for (int h2 = 0; h2 < 2; ++h2) {
                const int kk0 = 16 * wave + 16 * (2 * tp + h2);
                int krow = kk0 + li; krow = krow > 255 ? 255 : krow;
                f32x4 acc = (f32x4){0.f, 0.f, 0.f, 0.f};
#pragma unroll
                for (int ks = 0; ks < 4; ++ks) {
                    const bf16x8 kf = *(const bf16x8*)(Ks + krow * 256 + (((4 * ks + fq) ^ (krow & 15)) << 4));
                    acc = __builtin_amdgcn_mfma_f32_16x16x32_bf16(kf, qf[ks], acc, 0, 0, 0);
                }
#pragma unroll
                for (int j = 0; j < 4; ++j) {
                    const int kp = kbase + kk0 + 4 * fq + j;
                    const int rel = kp - qp;
                    ok[4 * h2 + j] = (kp >= 0) && (kp < M) && (rel <= 64) && (rel >= -64);
                    s[4 * h2 + j] = acc[j] * scale;
                }
            }
            float mx = -1e30f;
#pragma unroll
            for (int j = 0; j < 8; ++j) mx = ok[j] ? fmaxf(mx, s[j]) : mx;
            mx = fmaxf(mx, __shfl_xor(mx, 16));
            mx = fmaxf(mx, __shfl_xor(mx, 32));
            const float mn = fmaxf(m, mx);
            const float al = __expf(m - mn);
            float ps = 0.f; float p[8];
#pragma unroll
            for (int j = 0; j < 8; ++j) { p[j] = ok[j] ? __expf(s[j] - mn) : 0.f; ps += p[j]; }
            l = l * al + ps; m = mn;
            const attn_u32x4 p_ = {pack2(p[0], p[1]), pack2(p[2], p[3]), pack2(p[4], p[5]), pack2(p[6], p[7])};
            const bf16x8 pf = __builtin_bit_cast(bf16x8, p_);
#pragma unroll
            for (int dt = 0; dt < 8; ++dt) o[dt] *= al;
            int rowA = 16 * wave + 32 * tp + 4 * fq + (li >> 2); rowA = rowA > 255 ? 255 : rowA;
            int rowB = 16 * wave + 32 * tp + 16 + 4 * fq + (li >> 2); rowB = rowB > 255 ? 255 : rowB;
#pragma unroll
            for (int dt = 0; dt < 8; ++dt) {
                const int chunk = 2 * dt + ((li & 3) >> 1), sub = ((li & 3) & 1) * 8;
                const s16x4 va = __builtin_amdgcn_ds_read_tr16_b64_v4i16((LAS s16x4*)(Vs + rowA * 256 + ((chunk ^ (rowA & 15)) << 4) + sub));
                const s16x4 vb = __builtin_amdgcn_ds_read_tr16_b64_v4i16((LAS s16x4*)(Vs + rowB * 256 + ((chunk ^ (rowB & 15)) << 4) + sub));
                const bf16x8 vf = __builtin_shufflevector(va, vb, 0, 1, 2, 3, 4, 5, 6, 7);
                o[dt] = __builtin_amdgcn_mfma_f32_16x16x32_bf16(vf, pf, o[dt], 0, 0, 0);
            }
        }
        l += __shfl_xor(l, 16);
        l += __shfl_xor(l, 32);
        const float inv = 1.f / l;
        u16* orow = part_o + ((size_t)pat * Ttot + tq) * 1024 + hh * 128 + 4 * fq;
#pragma unroll
        for (int dt = 0; dt < 8; ++dt)
            *(uint2*)(orow + 16 * dt) = make_uint2(pack2(o[dt][0] * inv, o[dt][1] * inv), pack2(o[dt][2] * inv, o[dt][3] * inv));
        if (fq == 0) part_lse[((size_t)pat * Ttot + tq) * 8 + hh] = m + logf(l);
    }
#undef ATTN_LD1
#undef ATTN_LOAD
#undef ATTN_ST1
#undef ATTN_COMMIT
}

__device__ __forceinline__ void attn_merge_token(const u16* __restrict__ part_o, const float* __restrict__ part_lse, int Ttot, size_t t,
                                                 u16* __restrict__ dst  , int lane) {
    const int hh = lane >> 3;
    const float l0 = part_lse[((size_t)0 * Ttot + t) * 8 + hh], l1 = part_lse[((size_t)1 * Ttot + t) * 8 + hh], l2 = part_lse[((size_t)2 * Ttot + t) * 8 + hh];
    const float mx = fmaxf(l0, fmaxf(l1, l2));
    const float e0 = __expf(l0 - mx), e1 = __expf(l1 - mx), e2 = __expf(l2 - mx);
    const float inv = 1.f / (e0 + e1 + e2);
    const float w[3] = {e0 * inv, e1 * inv, e2 * inv};
    float acc[16];
#pragma unroll
    for (int i = 0; i < 16; ++i) acc[i] = 0.f;
#pragma unroll
    for (int p = 0; p < 3; ++p) {
        const uint4* src = (const uint4*)(part_o + ((size_t)p * Ttot + t) * 1024 + lane * 16);
        const uint4 a = src[0], bb = src[1];
        acc[0] += w[p] * lo2f(a.x); acc[1] += w[p] * hi2f(a.x); acc[2] += w[p] * lo2f(a.y); acc[3] += w[p] * hi2f(a.y);
        acc[4] += w[p] * lo2f(a.z); acc[5] += w[p] * hi2f(a.z); acc[6] += w[p] * lo2f(a.w); acc[7] += w[p] * hi2f(a.w);
        acc[8] += w[p] * lo2f(bb.x); acc[9] += w[p] * hi2f(bb.x); acc[10] += w[p] * lo2f(bb.y); acc[11] += w[p] * hi2f(bb.y);
        acc[12] += w[p] * lo2f(bb.z); acc[13] += w[p] * hi2f(bb.z); acc[14] += w[p] * lo2f(bb.w); acc[15] += w[p] * hi2f(bb.w);
    }
    uint4* d = (uint4*)(dst + lane * 16);
    d[0] = make_uint4(pack2(acc[0], acc[1]), pack2(acc[2], acc[3]), pack2(acc[4], acc[5]), pack2(acc[6], acc[7]));
    d[1] = make_uint4(pack2(acc[8], acc[9]), pack2(acc[10], acc[11]), pack2(acc[12], acc[13]), pack2(acc[14], acc[15]));
}

__device__ __forceinline__ void phase_mixers(const Args& a, unsigned char* lds) {
    const int bi = blockIdx.x, G = gridDim.x;
    if (bi < 64) {
        gla_seq_item((const u16*)(a.ws + WS_P), NP, C_GV, S, a.ws + WS_QD, a.ws + WS_KE, a.ws + WS_AT, (const float*)(a.ws + WS_DEC),
                     (u16*)(a.ws + WS_OFB), T, lds, bi);
    } else {
        u16* part_o = (u16*)a.out; float* part_lse = (float*)((unsigned char*)a.out + (size_t)3 * T * 1024 * 2);
        attn_phase((const u16*)(a.ws + WS_P), NP, C_DQ, C_DK, C_DV, S, part_o, part_lse, T, lds, bi - 64, G - 64, 3 * 4 * 8 * (S / 128));
    }
}

__device__ __forceinline__ void phase_gla_fin(const Args& a) {
    const u16* Of = (const u16*)(a.ws + WS_OFB);
    const u16* Ob = Of + (size_t)T * 1024;
    const u16* P = (const u16*)(a.ws + WS_P);
    u16* A2 = (u16*)(a.ws + WS_ACT);
    const u16* part_o = (const u16*)a.out; const float* part_lse = (const float*)((const unsigned char*)a.out + (size_t)3 * T * 1024 * 2);
    const int lane = threadIdx.x & 63, wave = threadIdx.x >> 6;
    const int gw = blockIdx.x * NWAVES + wave, NGW = gridDim.x * NWAVES;
    const int hh = lane >> 4;
    float gg[16];
#pragma unroll
    for (int k = 0; k < 4; ++k) { const float4 g4 = *(const float4*)(a.g_gla + lane * 16 + 4 * k); gg[4 * k] = g4.x; gg[4 * k + 1] = g4.y; gg[4 * k + 2] = g4.z; gg[4 * k + 3] = g4.w; }
    for (int t = gw; t < T; t += NGW) {
        const uint4* fp = (const uint4*)(Of + (size_t)t * 1024 + lane * 16); const uint4* bp = (const uint4*)(Ob + (size_t)t * 1024 + lane * 16);
        const uint4* rp = (const uint4*)(P + (size_t)t * NP + C_GR + lane * 16);
#define NT16(p_) ({ const f32x4 q_ = __builtin_nontemporal_load((const f32x4*)(p_)); make_uint4(__float_as_uint(q_[0]), __float_as_uint(q_[1]), __float_as_uint(q_[2]), __float_as_uint(q_[3])); })
        const uint4 f0 = NT16(fp), f1 = NT16(fp + 1), b0 = NT16(bp), b1 = NT16(bp + 1), r0 = NT16(rp), r1 = NT16(rp + 1);
#undef NT16
        attn_merge_token(part_o, part_lse, T, (size_t)t, A2 + (size_t)t * D + 1024, lane);
        const unsigned fw[8] = {f0.x, f0.y, f0.z, f0.w, f1.x, f1.y, f1.z, f1.w}, bw[8] = {b0.x, b0.y, b0.z, b0.w, b1.x, b1.y, b1.z, b1.w};
        const unsigned rw[8] = {r0.x, r0.y, r0.z, r0.w, r1.x, r1.y, r1.z, r1.w};
        float o[16]; float ss = 0.f;
#pragma unroll
        for (int k = 0; k < 8; ++k) { o[2 * k] = lo2f(fw[k]) + lo2f(bw[k]); o[2 * k + 1] = hi2f(fw[k]) + hi2f(bw[k]); ss += o[2 * k] * o[2 * k] + o[2 * k + 1] * o[2 * k + 1]; }
        ss += __shfl_xor(ss, 1); ss += __shfl_xor(ss, 2); ss += __shfl_xor(ss, 4); ss += __shfl_xor(ss, 8);
        const float rstd = rsqrtf(ss * (1.f / 256.f) + NORM_EPS);
        unsigned y[8];
#pragma unroll
        for (int k = 0; k < 8; ++k) y[k] = pack2(o[2 * k] * rstd * gg[2 * k] * silu_f(lo2f(rw[k])), o[2 * k + 1] * rstd * gg[2 * k + 1] * silu_f(hi2f(rw[k])));
        uint4* dp = (uint4*)(A2 + (size_t)t * D + lane * 16);
        dp[0] = make_uint4(y[0], y[1], y[2], y[3]); dp[1] = make_uint4(y[4], y[5], y[6], y[7]);
    }
    (void)hh;
}

typedef float f32x16 __attribute__((ext_vector_type(16)));
#define RT_CE(a_, b_) do { const float hi_ = fmaxf(a_, b_), lo_ = fminf(a_, b_); a_ = hi_; b_ = lo_; } while (0)
template <int N> __device__ __forceinline__ void rt_sort_desc(float (&v)[N], int base) {
#pragma unroll
    for (int k = 2; k <= 16; k <<= 1)
#pragma unroll
        for (int j = k >> 1; j > 0; j >>= 1)
#pragma unroll
            for (int i = 0; i < 16; ++i) {
                const int l = i ^ j;
                if (l > i) { if ((i & k) == 0) RT_CE(v[base + i], v[base + l]); else RT_CE(v[base + l], v[base + i]); }
            }
}
template <int N> __device__ __forceinline__ void rt_merge_desc(float (&v)[N], int a, int b) {
#pragma unroll
    for (int i = 0; i < 16; ++i) v[a + i] = fmaxf(v[a + i], v[b + 15 - i]);
#pragma unroll
    for (int j = 8; j > 0; j >>= 1)
#pragma unroll
        for (int i = 0; i < 16; ++i) { const int l = i ^ j; if (l > i) RT_CE(v[a + i], v[a + l]); }
}

__device__ __forceinline__ void route_stage_keys(const float* __restrict__ subk, int hh, unsigned char* lds) {
    const int tid = TID;
    __syncthreads();
    for (int e = tid; e < 2 * 128 * 16; e += 512) {
        const int c = e & 15, row = e >> 4;
        const float* src = subk + ((size_t)(hh * 2) * 128 + row) * 128 + c * 8;
        const float4 v0 = *(const float4*)src, v1 = *(const float4*)(src + 4);
        *(uint4*)(lds + row * 256 + ((c ^ (row & 15)) << 4)) = make_uint4(pack2(v0.x, v0.y), pack2(v0.z, v0.w), pack2(v1.x, v1.y), pack2(v1.z, v1.w));
    }
    __syncthreads();
}

__device__ __forceinline__ void route_tile(const u16* __restrict__ Q, int ldq, int hh, int tok_base, const unsigned char* lds,
                                           int* __restrict__ IDX, float* __restrict__ GATE) {
    const int lane = TID & 63, r = lane & 31, h = lane >> 5;
    float sc[128];
    {
        f32x16 X[4], Y[4];
#pragma unroll
        for (int kt = 0; kt < 4; ++kt) {
#pragma unroll
            for (int i = 0; i < 16; ++i) { X[kt][i] = 0.f; Y[kt][i] = 0.f; }
        }
        const u16* qrow = Q + (size_t)(tok_base + r) * ldq + hh * 256;
#pragma unroll
        for (int half = 0; half < 2; ++half) {
            bf16x8 qf[8];
#pragma unroll
            for (int ks = 0; ks < 8; ++ks) qf[ks] = *(const bf16x8*)(qrow + half * 128 + 16 * ks + 8 * h);
#pragma unroll
            for (int kt = 0; kt < 4; ++kt) {
                const int krow = half * 128 + 32 * kt + r;
#pragma unroll
                for (int ks = 0; ks < 8; ++ks) {
                    const bf16x8 kf = *(const bf16x8*)(lds + krow * 256 + (((2 * ks + h) ^ (krow & 15)) << 4));
                    if (half == 0) X[kt] = __builtin_amdgcn_mfma_f32_32x32x16_bf16(kf, qf[ks], X[kt], 0, 0, 0);
                    else Y[kt] = __builtin_amdgcn_mfma_f32_32x32x16_bf16(kf, qf[ks], Y[kt], 0, 0, 0);
                }
            }
        }
#pragma unroll
        for (int kt = 0; kt < 4; ++kt)
#pragma unroll
            for (int i = 0; i < 16; ++i) {
                const auto sw = __builtin_amdgcn_permlane32_swap(__float_as_uint(X[kt][i]), __float_as_uint(Y[kt][i]), false, false);
                const int key0 = 32 * kt + (i & 3) + 8 * (i >> 2);
                sc[kt * 32 + i] = __uint_as_float((sw[0] & 0xffffff80u) | (unsigned)key0);
                sc[kt * 32 + 16 + i] = __uint_as_float((sw[1] & 0xffffff80u) | (unsigned)(key0 + 4));
            }
    }
#pragma unroll
    for (int g = 0; g < 8; ++g) rt_sort_desc(sc, 16 * g);
    rt_merge_desc(sc, 0, 16); rt_merge_desc(sc, 32, 48); rt_merge_desc(sc, 64, 80); rt_merge_desc(sc, 96, 112);
    rt_merge_desc(sc, 0, 32); rt_merge_desc(sc, 64, 96);
    rt_merge_desc(sc, 0, 64);
    float l0[16], l1[16];
#pragma unroll
    for (int i = 0; i < 16; ++i) {
        const auto sw = __builtin_amdgcn_permlane32_swap(__float_as_uint(sc[i]), __float_as_uint(sc[i]), false, false);
        l0[i] = __uint_as_float(sw[0]); l1[i] = __uint_as_float(sw[1]);
    }
    float s0[16], s1[16]; int k0[16], k1[16];
#pragma unroll
    for (int i = 0; i < 16; ++i) {
        const unsigned a = __float_as_uint(l0[i]), b = __float_as_uint(l1[i]);
        s0[i] = __uint_as_float(a & 0xffffff80u); k0[i] = (int)(a & 0x7fu);
        s1[i] = __uint_as_float(b & 0xffffff80u); k1[i] = (int)(b & 0x7fu);
    }
    float cs[64];
    {
        int n = 0;
#pragma unroll
        for (int i = 0; i < 16; ++i)
#pragma unroll
            for (int j = 0; j < 16; ++j)
                if ((i + 1) * (j + 1) <= 16) { cs[n] = s0[i] + s1[j]; ++n; }
#pragma unroll
        for (int q = 50; q < 64; ++q) cs[q] = -3.0e38f;
    }
    float ct[64];
#pragma unroll
    for (int q = 0; q < 64; ++q) ct[q] = cs[q];
#pragma unroll
    for (int g = 0; g < 4; ++g) rt_sort_desc(ct, 16 * g);
    rt_merge_desc(ct, 0, 16); rt_merge_desc(ct, 32, 48); rt_merge_desc(ct, 0, 32);
    const float theta = ct[15], smax = ct[0];
    float den = 0.f;
    {
        int cnt = 0;
#pragma unroll
        for (int q = 0; q < 50; ++q) { const bool sel = (cs[q] >= theta) && (cnt < 16); den += sel ? __expf(cs[q] - smax) : 0.f; cnt += sel ? 1 : 0; }
    }
    const float inv = 1.f / den;
    const size_t obase = (size_t)(tok_base + r) * 128 + hh * 16;
    int pos = 0;
    {
        int n = 0;
#pragma unroll
        for (int i = 0; i < 16; ++i)
#pragma unroll
            for (int j = 0; j < 16; ++j)
                if ((i + 1) * (j + 1) <= 16) {
                    const bool sel = (cs[n] >= theta) && (pos < 16);
                    if (sel) {
                        if (h == 0) IDX[obase + pos] = k0[i] * 128 + k1[j];
                        else GATE[obase + pos] = __expf(cs[n] - smax) * inv;
                        ++pos;
                    }
                    ++n;
                }
    }
}
__device__ __forceinline__ void phase_route(const Args& a, unsigned char* lds) {
    const int hh = BID & 7, grp = BID >> 3, ngrp = GDIM >> 3, wave = TID >> 6;
    route_stage_keys(a.subk, hh, lds);
    int j = 0;
    for (int tile = grp; tile < T / 32; tile += ngrp, ++j)
        if ((j & 7) == wave) route_tile((const u16*)(a.ws + WS_Q), D, hh, tile * 32, lds, (int*)(a.ws + WS_IDX), (float*)(a.ws + WS_GATE));
    __syncthreads();
}

typedef __bf16 bf16x2_t __attribute__((ext_vector_type(2)));
__device__ __forceinline__ float dot2bf(unsigned w, unsigned x, float acc) {
    return __builtin_amdgcn_fdot2_f32_bf16(__builtin_bit_cast(bf16x2_t, w), __builtin_bit_cast(bf16x2_t, x), acc, false);
}
constexpr int TROW = 1152;
typedef float f32x2_t __attribute__((ext_vector_type(2)));
__device__ __forceinline__ void convert_tables(const Args& a) {
    const int lane = threadIdx.x & 63, wave = threadIdx.x >> 6;
    const int gw = blockIdx.x * NWAVES + wave, NGW = gridDim.x * NWAVES;
    for (int row = gw; row < 2 * 16384; row += NGW) {
        const bool isv = row >= 16384; const int e = isv ? row - 16384 : row;
        const f32x4* sp = (const f32x4*)((isv ? a.pv : a.pu) + (size_t)e * D);
        unsigned char* dst = a.ws + (isv ? WS_TV : WS_TU) + (size_t)e * TROW;
        f32x4 v[8];
#pragma unroll
        for (int k = 0; k < 8; ++k) v[k] = __builtin_nontemporal_load(sp + lane + 64 * k);
#pragma unroll
        for (int k = 0; k < 8; ++k) {
            float mx = fmaxf(fmaxf(fabsf(v[k][0]), fabsf(v[k][1])), fmaxf(fabsf(v[k][2]), fabsf(v[k][3])));
            mx = fmaxf(mx, __shfl_xor(mx, 1)); mx = fmaxf(mx, __shfl_xor(mx, 2)); mx = fmaxf(mx, __shfl_xor(mx, 4));
            float s = mx * (isv ? (1.f / 6.f) : (1.f / 7.f)); s = (s > 0.f) ? s : 1.f;
            u16 sb = f2bf(s); if (bf2f(sb) < s) sb += 1;
            const float inv = 1.f / bf2f(sb);
            unsigned p = 0u;
            if (isv) {
                p = __builtin_amdgcn_cvt_scalef32_pk_fp4_f32(p, v[k][0] * inv, v[k][1] * inv, 1.0f, 0);
                p = __builtin_amdgcn_cvt_scalef32_pk_fp4_f32(p, v[k][2] * inv, v[k][3] * inv, 1.0f, 1);
            } else {
#pragma unroll
                for (int j = 0; j < 4; ++j) { int q = (int)rintf(v[k][j] * inv) + 8; q = q < 1 ? 1 : (q > 15 ? 15 : q); p |= (unsigned)q << (4 * j); }
            }
            const int i = lane + 64 * k;
            *(u16*)(dst + 2 * i) = (u16)p;
            if ((lane & 7) == 0) *(u16*)(dst + 1024 + 2 * (i >> 3)) = sb;
        }
    }
}

__device__ __forceinline__ int idot32_i4(const uint4 w, const int (&hq)[8]) {
    const unsigned ww[4] = {w.x, w.y, w.z, w.w};
    int acc = 0;
#pragma unroll
    for (int k = 0; k < 4; ++k) {
        acc = __builtin_amdgcn_sdot4((int)(ww[k] & 0x0f0f0f0fu), hq[2 * k], acc, false);
        acc = __builtin_amdgcn_sdot4((int)((ww[k] >> 4) & 0x0f0f0f0fu), hq[2 * k + 1], acc, false);
    }
    return acc;
}
__device__ __forceinline__ void axpy32_fp4(const uint4 w, const float s, float (&acc)[32]) {
    const unsigned ww[4] = {w.x, w.y, w.z, w.w};
#pragma unroll
    for (int k = 0; k < 4; ++k) {
        const f32x2_t a0 = __builtin_amdgcn_cvt_scalef32_pk_f32_fp4(ww[k], 1.0f, 0), a1 = __builtin_amdgcn_cvt_scalef32_pk_f32_fp4(ww[k], 1.0f, 1);
        const f32x2_t a2 = __builtin_amdgcn_cvt_scalef32_pk_f32_fp4(ww[k], 1.0f, 2), a3 = __builtin_amdgcn_cvt_scalef32_pk_f32_fp4(ww[k], 1.0f, 3);
        acc[8 * k + 0] += s * a0.x; acc[8 * k + 1] += s * a0.y; acc[8 * k + 2] += s * a1.x; acc[8 * k + 3] += s * a1.y;
        acc[8 * k + 4] += s * a2.x; acc[8 * k + 5] += s * a2.y; acc[8 * k + 6] += s * a3.x; acc[8 * k + 7] += s * a3.y;
    }
}
__device__ __forceinline__ void phase_experts(const Args& a) {
    const u16* H2 = (const u16*)(a.ws + WS_ACT);
    const u16* X1 = (const u16*)(a.ws + WS_X1);
    const int* IDX = (const int*)(a.ws + WS_IDX);
    const float* GATE = (const float*)(a.ws + WS_GATE);
    const float* mod = (const float*)(a.ws + WS_MOD);
    const unsigned char* U = a.ws + WS_TU; const unsigned char* V = a.ws + WS_TV;
    const int lane = threadIdx.x & 63, wave = threadIdx.x >> 6;
    const int gw = blockIdx.x * NWAVES + wave, NGW = gridDim.x * NWAVES;
    int iv0 = 0, iv1 = 0; float gv0 = 0.f, gv1 = 0.f;
    int niv0 = 0, niv1 = 0; float ngv0 = 0.f, ngv1 = 0.f;
    uint4 rA[4], rB[4]; u16 sA[4], sB[4];
#define ROW_LOAD(TB_, r_, s_, r0_) do { _Pragma("unroll") for (int q = 0; q < 4; ++q) { \
            const int rr_ = (r0_) + q; const int e_ = __builtin_amdgcn_readlane(rr_ < 64 ? iv0 : iv1, rr_ & 63); \
            const unsigned char* rp_ = TB_ + (size_t)e_ * TROW; \
            r_[q] = *(const uint4*)(rp_ + lane * 16); s_[q] = *(const u16*)(rp_ + 1024 + lane * 2); } } while (0)
#define TOK_FETCH(t_, i0_, i1_, g0_, g1_) do { \
            i0_ = IDX[(size_t)(t_) * 128 + lane]; i1_ = IDX[(size_t)(t_) * 128 + 64 + lane]; \
            g0_ = GATE[(size_t)(t_) * 128 + lane]; g1_ = GATE[(size_t)(t_) * 128 + 64 + lane]; } while (0)
    if (gw < T) { TOK_FETCH(gw, iv0, iv1, gv0, gv1); ROW_LOAD(U, rA, sA, 0); }
    for (int t = gw; t < T; t += NGW) {
        const int b = t / S;
        const bool has_next = (t + NGW) < T;
        int hq[8]; int hsum8; float sh;
        {
            float h[32];
            const f32x4* hp = (const f32x4*)(H2 + (size_t)t * D + lane * 32);
#pragma unroll
            for (int k = 0; k < 4; ++k) { const f32x4 pn = __builtin_nontemporal_load(hp + k);
                const uint4 p = make_uint4(__float_as_uint(pn[0]), __float_as_uint(pn[1]), __float_as_uint(pn[2]), __float_as_uint(pn[3]));
                h[8 * k + 0] = lo2f(p.x); h[8 * k + 1] = hi2f(p.x); h[8 * k + 2] = lo2f(p.y); h[8 * k + 3] = hi2f(p.y);
                h[8 * k + 4] = lo2f(p.z); h[8 * k + 5] = hi2f(p.z); h[8 * k + 6] = lo2f(p.w); h[8 * k + 7] = hi2f(p.w); }
            float mx = 0.f;
#pragma unroll
            for (int i = 0; i < 32; ++i) mx = fmaxf(mx, fabsf(h[i]));
            sh = (mx > 0.f) ? mx * (1.f / 127.f) : 1.f;
            const float inv = 1.f / sh;
            int hs = 0;
#pragma unroll
            for (int k = 0; k < 4; ++k)
#pragma unroll
                for (int par = 0; par < 2; ++par) {
                    const int q0 = (int)rintf(h[8 * k + par] * inv), q1 = (int)rintf(h[8 * k + 2 + par] * inv), q2 = (int)rintf(h[8 * k + 4 + par] * inv), q3 = (int)rintf(h[8 * k + 6 + par] * inv);
                    hs += q0 + q1 + q2 + q3;
                    hq[2 * k + par] = (q0 & 0xff) | ((q1 & 0xff) << 8) | ((q2 & 0xff) << 16) | ((int)((unsigned)(q3 & 0xff) << 24));
                }
            hsum8 = 8 * hs;
        }
        float a0 = 0.f, a1 = 0.f;
#define U_COMPUTE(r_, s_, r0_) do { float d_[4]; \
            _Pragma("unroll") for (int q = 0; q < 4; ++q) d_[q] = (float)(idot32_i4(r_[q], hq) - hsum8) * (bf2f(s_[q]) * sh); \
            _Pragma("unroll") for (int o = 32; o > 0; o >>= 1) { _Pragma("unroll") for (int q = 0; q < 4; ++q) d_[q] += __shfl_xor(d_[q], o); } \
            _Pragma("unroll") for (int q = 0; q < 4; ++q) { const int rr_ = (r0_) + q; \
                if (rr_ < 64) a0 = (lane == rr_) ? d_[q] : a0; else a1 = (lane == rr_ - 64) ? d_[q] : a1; } } while (0)
#pragma unroll 1
        for (int r0 = 0; r0 < 128; r0 += 8) {
            ROW_LOAD(U, rB, sB, r0 + 4);
            U_COMPUTE(rA, sA, r0);
            if (r0 + 8 < 128) ROW_LOAD(U, rA, sA, r0 + 8); else ROW_LOAD(V, rA, sA, 0);
            U_COMPUTE(rB, sB, r0 + 4);
        }
        const float w0 = gv0 * gelu_f(a0), w1 = gv1 * gelu_f(a1);
        float acc[32];
#pragma unroll
        for (int i = 0; i < 32; ++i) acc[i] = 0.f;
#define V_COMPUTE(r_, s_, r0_) do { _Pragma("unroll") for (int q = 0; q < 4; ++q) { const int rr_ = (r0_) + q; \
                const float g_ = __builtin_bit_cast(float, __builtin_amdgcn_readlane(__builtin_bit_cast(int, rr_ < 64 ? w0 : w1), rr_ & 63)); \
                axpy32_fp4(r_[q], g_ * bf2f(s_[q]), acc); } } while (0)
        if (has_next) TOK_FETCH(t + NGW, niv0, niv1, ngv0, ngv1);
#pragma unroll 1
        for (int r0 = 0; r0 < 128; r0 += 8) {
            ROW_LOAD(V, rB, sB, r0 + 4);
            V_COMPUTE(rA, sA, r0);
            if (r0 + 8 < 128) ROW_LOAD(V, rA, sA, r0 + 8);
            else if (has_next) { iv0 = niv0; iv1 = niv1; gv0 = ngv0; gv1 = ngv1; ROW_LOAD(U, rA, sA, 0); }
            V_COMPUTE(rB, sB, r0 + 4);
        }
#undef U_COMPUTE
#undef V_COMPUTE
        float ss = 0.f;
#pragma unroll
        for (int k = 0; k < 8; ++k) {
            const int c0 = lane * 32 + 4 * k;
            const hw_f32x2 xn = __builtin_nontemporal_load((const hw_f32x2*)(X1 + (size_t)t * D + c0));
            const uint2 xp = make_uint2(__float_as_uint(xn[0]), __float_as_uint(xn[1]));
            const float4 xa = make_float4(lo2f(xp.x), hi2f(xp.x), lo2f(xp.y), hi2f(xp.y));
            const float4 ga = *(const float4*)(mod + b * 12288 + 5 * 2048 + c0);
            acc[4 * k + 0] = xa.x + ga.x * acc[4 * k + 0]; acc[4 * k + 1] = xa.y + ga.y * acc[4 * k + 1];
            acc[4 * k + 2] = xa.z + ga.z * acc[4 * k + 2]; acc[4 * k + 3] = xa.w + ga.w * acc[4 * k + 3];
#pragma unroll
            for (int i = 0; i < 4; ++i) ss += acc[4 * k + i] * acc[4 * k + i];
        }
        ss = wave_sum(ss);
        const float rstd = rsqrtf(ss * (1.f / D) + NORM_EPS);
#pragma unroll
        for (int k = 0; k < 8; ++k) {
            const int c0 = lane * 32 + 4 * k;
            const float4 gf = *(const float4*)(a.g_fin + c0);
            *(float4*)(a.out + (size_t)t * D + c0) = make_float4(acc[4 * k + 0] * rstd * gf.x, acc[4 * k + 1] * rstd * gf.y, acc[4 * k + 2] * rstd * gf.z, acc[4 * k + 3] * rstd * gf.w);
        }
    }
#undef ROW_LOAD
#undef TOK_FETCH
}

#define XB_TMO      128
#define XB_XCNT(j)  (256  + 64 * (j))
#define XB_XSUB(j)  (1280 + 64 * (j))
#define XB_XGEN(j)  (2304 + 64 * (j))
#define XB_TOP      3328
#define XB_TOPGEN   3392
#define XCD_BAR_WORDS 3456
#define XB_SPIN_CAP (1u << 18)

__device__ __forceinline__ unsigned xb_ld(unsigned* p)              { return __hip_atomic_load(p, __ATOMIC_RELAXED, __HIP_MEMORY_SCOPE_AGENT); }
__device__ __forceinline__ unsigned xb_add(unsigned* p, unsigned v) { return __hip_atomic_fetch_add(p, v, __ATOMIC_RELAXED, __HIP_MEMORY_SCOPE_AGENT); }
__device__ __forceinline__ unsigned xb_xcc_id() { return (unsigned)__builtin_amdgcn_s_getreg((3 << 11) | 20) & 0xFu; }
#define XB_SPIN(cond, bar) do { unsigned _sp = 0; while (cond) { __builtin_amdgcn_s_sleep(1); \
    if ((++_sp & 255u) == 0u) { if (xb_ld(&(bar)[XB_TMO])) break; if (_sp > XB_SPIN_CAP) { atomicAdd(&(bar)[XB_TMO], 1u); break; } } } } while (0)

struct XcdBarrier {
    unsigned* bar; unsigned x;
    volatile LAS unsigned* st;
};

__device__ __forceinline__ XcdBarrier xcd_barrier_post(unsigned* bar, volatile LAS unsigned* st) {
    XcdBarrier b; b.bar = bar; b.x = xb_xcc_id(); b.st = st;
    if (threadIdx.x == 0) (void)xb_add(&bar[XB_XCNT(b.x)], 1u);
    return b;
}
__device__ __forceinline__ void xcd_barrier_complete(unsigned* bar, unsigned x, unsigned& nloc, unsigned& nx) {
    const unsigned G = gridDim.x * gridDim.y * gridDim.z;
    unsigned sum, cnt, mine, sp = 0u;
    for (;;) {
        sum = 0u; cnt = 0u; mine = 0u;
#pragma unroll
        for (unsigned j = 0; j < 16; ++j) { const unsigned c = xb_ld(&bar[XB_XCNT(j)]); sum += c; cnt += (c > 0u) ? 1u : 0u; mine = (j == x) ? c : mine; }
        if (sum == G) break;
        __builtin_amdgcn_s_sleep(1);
        if ((++sp & 255u) == 0u) { if (xb_ld(&bar[XB_TMO])) break; if (sp > XB_SPIN_CAP) { atomicAdd(&bar[XB_TMO], 1u); break; } }
    }
    nloc = mine > 0u ? mine : 1u; nx = cnt > 0u ? cnt : 1u;
}

__device__ __forceinline__ void xcd_barrier(const XcdBarrier& b) {
    asm volatile("s_waitcnt vmcnt(0)" ::: "memory");
    __syncthreads();
    if (threadIdx.x == 0) {
        unsigned* bar = b.bar;
        __builtin_amdgcn_s_waitcnt(0);
        unsigned nloc = b.st[0], nx = b.st[1];
        if (nloc == 0u) { xcd_barrier_complete(bar, b.x, nloc, nx); b.st[0] = nloc; b.st[1] = nx; }
        const unsigned old = xb_add(&bar[XB_XSUB(b.x)], 1u);
        const unsigned gen = old / nloc;
        if (old + 1u == (gen + 1u) * nloc) {
            __builtin_amdgcn_fence(__ATOMIC_RELEASE, "agent");
            asm volatile("s_waitcnt vmcnt(0)" ::: "memory");
            const unsigned og = xb_add(&bar[XB_TOP], 1u);
            const unsigned tg = og / nx;
            if (og + 1u == (tg + 1u) * nx) xb_add(&bar[XB_TOPGEN], 1u);
            else XB_SPIN(xb_ld(&bar[XB_TOPGEN]) == tg, bar);
            __builtin_amdgcn_fence(__ATOMIC_ACQUIRE, "agent");
            xb_add(&bar[XB_XGEN(b.x)], 1u);
            asm volatile("s_waitcnt vmcnt(0)" ::: "memory");
        } else {
            XB_SPIN(xb_ld(&bar[XB_XGEN(b.x)]) == gen, bar);
            __builtin_amdgcn_fence(__ATOMIC_ACQUIRE, "agent");
            asm volatile("s_waitcnt vmcnt(0)" ::: "memory");
        }
    }
    __syncthreads();
}

constexpr int NPHASES = 11;
__global__ void __launch_bounds__(NTHREADS, 2) mk_fwd(Args a) {
    extern __shared__ __attribute__((aligned(16))) unsigned char lds[];
    cg::grid_group grid = cg::this_grid();
    const int lo = a.ph_lo, hi = a.ph_hi;
    volatile LAS unsigned* xbw = (volatile LAS unsigned*)(lds + LDS_MAIN);
    if (threadIdx.x < 4) xbw[threadIdx.x] = 0u;
    __syncthreads();
    XcdBarrier xbar = xcd_barrier_post((unsigned*)(a.ws + WS_CTL), xbw);
#define IN(k) (lo <= (k) && (k) < hi)
    if (lo < 0) grid.sync();
#define SEAM(k) do { if (IN(k) && IN((k) + 1)) xcd_barrier(xbar); } while (0)
    const float* mod = (const float*)(a.ws + WS_MOD);
    if (IN(0)) phase0(a, lds);
    SEAM(0);
    if (IN(1)) norm_mod_phase<false>(a.x, a.g_mix, mod, 0, 1, (u16*)(a.ws + WS_ACT));
    SEAM(1);
    if (IN(2)) { gemm8(lds, (const u16*)(a.ws + WS_ACT), (const u16*)(a.ws + WS_WIN), T, NP, D, EpiProj{(u16*)(a.ws + WS_P), (const float*)(a.ws + WS_CS)}); gz_phase(lds, (const u16*)(a.ws + WS_ACT), (const u16*)(a.ws + WS_WIN) + (size_t)NP * D, (float*)(a.ws + WS_GZ)); }
    SEAM(2);
    if (IN(3)) phase_rope_prep(a, lds);
    SEAM(3);
    if (IN(4)) phase_mixers(a, lds);
    SEAM(4);
    if (IN(5)) phase_gla_fin(a);
    SEAM(5);
    if (IN(6)) gemm8(lds, (const u16*)(a.ws + WS_ACT), (const u16*)(a.ws + WS_WOUT), T, D, D, EpiResid{a.x, mod, (u16*)(a.ws + WS_X1)});
    SEAM(6);
    if (IN(7)) { norm_mod_phase<true>(a.ws + WS_X1, a.g_ffn, mod, 3, 4, (u16*)(a.ws + WS_ACT)); convert_tables(a); }
    SEAM(7);
    if (IN(8)) gemm8(lds, (const u16*)(a.ws + WS_ACT), (const u16*)(a.ws + WS_WPQ), T, D, D, EpiBf16{(u16*)(a.ws + WS_Q)});
    SEAM(8);
    if (IN(9)) phase_route(a, lds);
    SEAM(9);
    if (IN(10)) phase_experts(a);
#ifdef PROBE_REP10
    grid.sync(); phase_experts(a);
#endif
#ifdef PROBE_REP9
    grid.sync(); phase_route(a, lds); grid.sync(); phase_experts(a);
#endif
#undef IN
#undef SEAM
}

#ifndef MK_ONE_LAUNCH
#define MK_ONE_LAUNCH 1
#endif
extern "C" void kernel_launch(void* const* d_in, const int* in_sizes, int n_in, void* d_out, int out_size, void* d_ws, size_t ws_size, hipStream_t stream) {
    static int grid = 0;
    if (grid == 0) {
        if (n_in != 19 || out_size != T * D || ws_size < WS_END) {
            fprintf(stderr, "kernel_launch: unexpected shapes: n_in %d out %d ws %zu (need %zu)\n", n_in, out_size, ws_size, (size_t)WS_END);
            grid = -1; return;
        }
        int dev = 0, cus = 0, per_cu = 0;
        (void)hipGetDevice(&dev);
        (void)hipDeviceGetAttribute(&cus, hipDeviceAttributeMultiprocessorCount, dev);
        (void)hipFuncSetAttribute((const void*)mk_fwd, hipFuncAttributeMaxDynamicSharedMemorySize, LDS_BYTES);
        (void)hipOccupancyMaxActiveBlocksPerMultiprocessor(&per_cu, (const void*)mk_fwd, NTHREADS, LDS_BYTES);
        if (per_cu < 1) { fprintf(stderr, "kernel_launch: occupancy query says %d blocks/CU\n", per_cu); grid = -1; return; }
        grid = cus;
        (void)hipGetLastError();
    }
    if (grid < 0) return;
    Args a{};
    a.x = (const float*)d_in[0]; a.c = (const float*)d_in[1]; a.pos = (const int*)d_in[2]; a.w_ada = (const float*)d_in[3];
    a.b_ada = (const float*)d_in[4]; a.g_mix = (const float*)d_in[5]; a.w_in = (const float*)d_in[6]; a.wgf = (const float*)d_in[7];
    a.bgf = (const float*)d_in[8]; a.wgb = (const float*)d_in[9]; a.bgb = (const float*)d_in[10]; a.g_gla = (const float*)d_in[11];
    a.w_out = (const float*)d_in[12]; a.g_ffn = (const float*)d_in[13]; a.w_pq = (const float*)d_in[14]; a.subk = (const float*)d_in[15];
    a.pu = (const float*)d_in[16]; a.pv = (const float*)d_in[17]; a.g_fin = (const float*)d_in[18];
    a.out = (float*)d_out; a.ws = (unsigned char*)d_ws;
#if MK_ONE_LAUNCH
    (void)hipMemsetAsync((unsigned char*)d_ws + WS_CTL, 0, XCD_BAR_WORDS * 4, stream);
    a.ph_lo = 0; a.ph_hi = NPHASES;
    void* args[] = {&a};
    hipError_t e = hipLaunchCooperativeKernel((const void*)mk_fwd, dim3(grid), dim3(NTHREADS), args, LDS_BYTES, stream);
    if (e != hipSuccess) fprintf(stderr, "cooperative launch failed: %s (grid %d)\n", hipGetErrorString(e), grid);
#else
    for (int p = 0; p < NPHASES; ++p) {
        a.ph_lo = p; a.ph_hi = p + 1;
        hipLaunchKernelGGL(mk_fwd, dim3(grid), dim3(NTHREADS), LDS_BYTES, stream, a);
    }
#endif
}
```

```cpp
#include <hip/hip_runtime.h>
#include <hip/hip_cooperative_groups.h>
#include <cstdio>
#include <cstdint>

namespace cg = cooperative_groups;

typedef unsigned short u16;
typedef __attribute__((ext_vector_type(8))) short bf16x8;
typedef __attribute__((ext_vector_type(4))) float f32x4;
typedef short s16x4 __attribute__((ext_vector_type(4)));
#define TID ((int)threadIdx.x)
#define BID ((int)blockIdx.x)
#define GDIM ((int)gridDim.x)
#define LAS __attribute__((address_space(3)))

constexpr int D = 2048, NB = 4, S = 4096, T = NB * S;
constexpr int INW = 6176;
constexpr int NP = 6144;
constexpr int NPAD = 6208;
constexpr int C_GQ = 0, C_GK = 512, C_GV = 1024, C_GR = 2048, C_DQ = 3072, C_DK = 4096, C_DV = 5120;
constexpr int NTHREADS = 512, NWAVES = 8;
constexpr int LDS_MAIN = 128 * 1024;
constexpr int LDS_BYTES = LDS_MAIN + 16;
constexpr float NORM_EPS = 1e-6f;

constexpr size_t WS_CTL = 0;
constexpr size_t WS_MOD = 65536;
constexpr size_t WS_CS = 524288;
constexpr size_t WS_WIN = WS_CS + (size_t)T * 64 * 8;
constexpr size_t WS_WOUT = WS_WIN + (size_t)NPAD * D * 2;
constexpr size_t WS_WPQ = WS_WOUT + (size_t)D * D * 2;
constexpr size_t WS_ACT = WS_WPQ + (size_t)D * D * 2;
constexpr size_t WS_P = WS_ACT + (size_t)T * D * 2;
constexpr size_t WS_X1 = WS_P;
constexpr size_t WS_Q = WS_P + (size_t)T * D * 4;
constexpr size_t WS_GZ = WS_P + (size_t)T * NP * 2;
constexpr int GLA_NPREP = NB * 4 * 2 * (S / 64);
constexpr size_t WS_QD = WS_GZ + (size_t)T * 32 * 4;
constexpr size_t WS_KE = WS_QD + (size_t)GLA_NPREP * 16384;
constexpr size_t WS_AT = WS_KE + (size_t)GLA_NPREP * 16384;
constexpr size_t WS_DEC = WS_AT + (size_t)GLA_NPREP * 8192;
constexpr size_t WS_OFB = WS_DEC + (size_t)GLA_NPREP * 512;
constexpr size_t WS_IDX = WS_OFB + (size_t)2 * T * 1024 * 2;
constexpr size_t WS_GATE = WS_IDX + (size_t)T * 128 * 4;
constexpr size_t WS_END = WS_GATE + (size_t)T * 128 * 4;
constexpr size_t WS_TU = WS_QD;
constexpr size_t WS_TV = WS_TU + (size_t)16384 * 1024;
constexpr size_t WS_SU = WS_TV + (size_t)16384 * 1024;
constexpr size_t WS_SV = WS_SU + (size_t)16384 * 128;
static_assert(WS_SV + (size_t)16384 * 128 <= WS_IDX, "table region");

struct Args {
    const float* x; const float* c; const int* pos; const float* w_ada; const float* b_ada; const float* g_mix;
    const float* w_in; const float* wgf; const float* bgf; const float* wgb; const float* bgb; const float* g_gla;
    const float* w_out; const float* g_ffn; const float* w_pq; const float* subk; const float* pu; const float* pv; const float* g_fin;
    float* out; unsigned char* ws; int ph_lo, ph_hi;
};

__device__ __forceinline__ float bf2f(u16 h) { return __uint_as_float(((unsigned)h) << 16); }
typedef __bf16 hw_bf16x2 __attribute__((ext_vector_type(2)));
typedef float hw_f32x2 __attribute__((ext_vector_type(2)));
__device__ __forceinline__ unsigned pack2(float a, float b) { const hw_f32x2 f = {a, b}; return __builtin_bit_cast(unsigned, __builtin_convertvector(f, hw_bf16x2)); }
__device__ __forceinline__ u16 f2bf(float f) { return (u16)(pack2(f, 0.f) & 0xffffu); }
__device__ __forceinline__ float lo2f(unsigned p) { return __uint_as_float(p << 16); }
__device__ __forceinline__ float hi2f(unsigned p) { return __uint_as_float(p & 0xffff0000u); }
__device__ __forceinline__ float wave_sum(float v) {
#pragma unroll
    for (int o = 32; o > 0; o >>= 1) v += __shfl_xor(v, o);
    return v;
}
__device__ __forceinline__ float wave_max(float v) {
#pragma unroll
    for (int o = 32; o > 0; o >>= 1) v = fmaxf(v, __shfl_xor(v, o));
    return v;
}
__device__ __forceinline__ float silu_f(float v) { return v / (1.f + __expf(-v)); }
__device__ __forceinline__ float gelu_f(float a) { return 0.5f * a * (1.f + erff(a * 0.70710678118654752f)); }
__device__ __forceinline__ float logsigmoid_f(float z) { return z < 0.f ? z - log1pf(expf(z)) : -log1pf(expf(-z)); }

constexpr int MOD_BLOCKS = 96;
__device__ __forceinline__ void p0_mod(const Args& a, unsigned char* lds, int bi) {
    float* sc = (float*)lds;
    float* red = sc + 4 * 2048;
    const int tid = threadIdx.x, lane = tid & 63, wave = tid >> 6;
    for (int i = tid; i < 4 * 2048; i += NTHREADS) sc[i] = silu_f(a.c[i]);
    __syncthreads();
    const int j0 = bi * 128 + lane * 2;
    float acc[4][2];
#pragma unroll
    for (int b = 0; b < 4; ++b) { acc[b][0] = 0.f; acc[b][1] = 0.f; }
    const int k0 = wave * 256;
#pragma unroll 8
    for (int kk = 0; kk < 256; ++kk) {
        const int k = k0 + kk;
        const hw_f32x2 wv_ = __builtin_nontemporal_load((const hw_f32x2*)(a.w_ada + (size_t)k * 12288 + j0)); const float2 w = make_float2(wv_[0], wv_[1]);
#pragma unroll
        for (int b = 0; b < 4; ++b) { const float s = sc[b * 2048 + k]; acc[b][0] += s * w.x; acc[b][1] += s * w.y; }
    }
#pragma unroll
    for (int b = 0; b < 4; ++b) { red[(wave * 4 + b) * 128 + lane * 2] = acc[b][0]; red[(wave * 4 + b) * 128 + lane * 2 + 1] = acc[b][1]; }
    __syncthreads();
    float* mod = (float*)(a.ws + WS_MOD);
    {
        const int b = tid >> 7, jc = tid & 127;
        float s = 0.f;
#pragma unroll
        for (int w = 0; w < 8; ++w) s += red[(w * 4 + b) * 128 + jc];
        mod[b * 12288 + bi * 128 + jc] = s + a.b_ada[bi * 128 + jc];
    }
    __syncthreads();
}

__device__ __forceinline__ void p0_transpose_item(const float* __restrict__ W, int ldw, int k0, int src_col0, int n_valid,
                                                  u16* __restrict__ WT, int ldt, int n_out0, unsigned char* wlds, bool rope_perm = false) {
    u16* tl = (u16*)wlds;
    const int lane = threadIdx.x & 63;
    const int rsub = lane >> 4, nc = (lane & 15) * 4;
    int scol = src_col0 + nc;
    if (rope_perm) { const int p = (n_out0 & 64) + nc, g = p >> 3; scol = (src_col0 - (n_out0 & 64)) + ((p & 4) ? 64 + 4 * g : 4 * g); }
    float4 v[16];
#pragma unroll
    for (int j = 0; j < 16; ++j) {
        const int k = 4 * j + rsub;
        if (nc < n_valid) { const f32x4 q_ = __builtin_nontemporal_load((const f32x4*)(W + (size_t)(k0 + k) * ldw + scol)); v[j] = make_float4(q_[0], q_[1], q_[2], q_[3]); }
        else v[j] = make_float4(0.f, 0.f, 0.f, 0.f);
    }
#pragma unroll
    for (int j = 0; j < 16; ++j) {
        const int k = 4 * j + rsub;
        tl[(nc + 0) * 72 + k] = f2bf(v[j].x); tl[(nc + 1) * 72 + k] = f2bf(v[j].y); tl[(nc + 2) * 72 + k] = f2bf(v[j].z); tl[(nc + 3) * 72 + k] = f2bf(v[j].w);
    }
#pragma unroll
    for (int j = 0; j < 8; ++j) {
        const int c = lane + 64 * j, n = c >> 3, kc = (c & 7) * 8;
        const uint4 o = *(const uint4*)(tl + n * 72 + kc);
        *(uint4*)(WT + (size_t)(n_out0 + n) * ldt + k0 + kc) = o;
    }
}

__device__ __forceinline__ void phase0(const Args& a, unsigned char* lds) {
    const int bi = blockIdx.x, G = gridDim.x, tid = threadIdx.x, wave = tid >> 6;
    const bool modblk = (G > MOD_BLOCKS) && (bi < MOD_BLOCKS);
    if (G > MOD_BLOCKS) { if (modblk) p0_mod(a, lds, bi); }
    else { for (int mb = bi; mb < MOD_BLOCKS; mb += G) p0_mod(a, lds, mb); }
    const int nb = (G > MOD_BLOCKS) ? G - MOD_BLOCKS : G, b0 = (G > MOD_BLOCKS) ? bi - MOD_BLOCKS : bi;
    if (!modblk) {
        constexpr int I_IN = 32 * (NPAD / 64), I_SQ = 32 * 32;
        u16* WinT = (u16*)(a.ws + WS_WIN); u16* WoutT = (u16*)(a.ws + WS_WOUT); u16* WpqT = (u16*)(a.ws + WS_WPQ);
        unsigned char* wlds = lds + wave * 9216;
        for (int it = b0 * NWAVES + wave; it < I_IN + 2 * I_SQ; it += nb * NWAVES) {
            if (it < I_IN) {
                const int kt = it & 31, nt = it >> 5;
                const int n0 = nt * 64;
                int src, nv;
                if (n0 < 3072) { src = n0; nv = 64; }
                else if (n0 < 6144) { src = n0 + 32; nv = 64; }
                else if (n0 == 6144) { src = 3072; nv = 32; }
                else { src = 0; nv = 0; }
                p0_transpose_item(a.w_in, INW, kt * 64, src, nv, WinT, D, n0, wlds, n0 >= C_DQ && n0 < C_DV);
            } else if (it < I_IN + I_SQ) {
                const int r = it - I_IN; const int kt = r & 31, nt = r >> 5;
                p0_transpose_item(a.w_out, D, kt * 64, nt * 64, 64, WoutT, D, nt * 64, wlds);
            } else {
                const int r = it - I_IN - I_SQ; const int kt = r & 31, nt = r >> 5;
                p0_transpose_item(a.w_pq, D, kt * 64, nt * 64, 64, WpqT, D, nt * 64, wlds);
            }
        }
        float2* cs = (float2*)(a.ws + WS_CS);
        for (int i = b0 * NTHREADS + tid; i < T * 64; i += nb * NTHREADS) {
            const int t = i >> 6, f = i & 63;
            const float inv_freq = powf(10000.0f, -(float)f * 2.0f / 128.0f);
            const float ang = (float)a.pos[t] * inv_freq;
            const double rev = (double)ang * 0.15915494309189533577;
            const float fr = (float)(rev - floor(rev));
            cs[i] = make_float2(__builtin_amdgcn_cosf(fr), __builtin_amdgcn_sinf(fr));
        }
    }
    __syncthreads();
}

template <bool BF16IN> __device__ __forceinline__ void norm_mod_phase(const void* __restrict__ xin_, const float* __restrict__ g, const float* __restrict__ mod,
                                               int sh_chunk, int sc_chunk, u16* __restrict__ outp) {
    const int lane = threadIdx.x & 63, wave = threadIdx.x >> 6;
    const int gw = blockIdx.x * NWAVES + wave, NGW = gridDim.x * NWAVES;
    float4 v[8], vn[8];
#define NM_LOAD(dst_, t_) do { if (BF16IN) { const hw_f32x2* xr_ = (const hw_f32x2*)((const u16*)xin_ + (size_t)(t_) * D); \
            _Pragma("unroll") for (int m = 0; m < 8; ++m) { const hw_f32x2 q_ = __builtin_nontemporal_load(xr_ + lane + 64 * m); const unsigned px_ = __float_as_uint(q_[0]), py_ = __float_as_uint(q_[1]); \
                dst_[m] = make_float4(lo2f(px_), hi2f(px_), lo2f(py_), hi2f(py_)); } } \
        else { const f32x4* xr_ = (const f32x4*)((const float*)xin_ + (size_t)(t_) * D); \
            _Pragma("unroll") for (int m = 0; m < 8; ++m) { const f32x4 q_ = __builtin_nontemporal_load(xr_ + lane + 64 * m); dst_[m] = make_float4(q_[0], q_[1], q_[2], q_[3]); } } } while (0)
    if (gw < T) NM_LOAD(v, gw);
    for (int t = gw; t < T; t += NGW) {
        const int b = t / S;
        if (t + NGW < T) NM_LOAD(vn, t + NGW);
        float ss = 0.f;
#pragma unroll
        for (int m = 0; m < 8; ++m) ss += v[m].x * v[m].x + v[m].y * v[m].y + v[m].z * v[m].z + v[m].w * v[m].w;
        ss = wave_sum(ss);
        const float rstd = rsqrtf(ss * (1.f / D) + NORM_EPS);
        const float4* gp = (const float4*)g;
        const float4* shp = (const float4*)(mod + b * 12288 + sh_chunk * 2048);
        const float4* scp = (const float4*)(mod + b * 12288 + sc_chunk * 2048);
        uint2* op = (uint2*)(outp + (size_t)t * D);
#pragma unroll
        for (int m = 0; m < 8; ++m) {
            const int i = lane + 64 * m;
            const float4 gg = gp[i], sh = shp[i], sc = scp[i];
            const float h0 = v[m].x * rstd * gg.x * (1.f + sc.x) + sh.x;
            const float h1 = v[m].y * rstd * gg.y * (1.f + sc.y) + sh.y;
            const float h2 = v[m].z * rstd * gg.z * (1.f + sc.z) + sh.z;
            const float h3 = v[m].w * rstd * gg.w * (1.f + sc.w) + sh.w;
            op[i] = make_uint2(pack2(h0, h1), pack2(h2, h3));
        }
#pragma unroll
        for (int m = 0; m < 8; ++m) v[m] = vn[m];
    }
#undef NM_LOAD
}

namespace pg8 {
#define PG8_LAS __attribute__((address_space(3)))
typedef unsigned short bf16_t;
typedef short bf16x8 __attribute__((ext_vector_type(8)));
typedef float f32x4 __attribute__((ext_vector_type(4)));
typedef unsigned u32x4 __attribute__((ext_vector_type(4)));
constexpr int BM = 256, BK = 64, HALF = 128, HTB = HALF * BK * 2  , STAGE_BYTES = 8 * HTB, NXCD = 8, WGM = 8;

__host__ __device__ __forceinline__ int lds_byte(int r, int c) { const int st = (r >> 4) * 2 + (c >> 5), rr = r & 15, cc = c & 31, ob = rr * 64 + cc * 2; return st * 1024 + (ob ^ (((ob >> 9) & 1) << 5)); }
__host__ __device__ __forceinline__ void stage_rc(int b, int& R, int& C) { const int st = b / 1024, sb = b % 1024, swz = sb ^ (((sb >> 9) & 1) << 5); R = (st >> 1) * 16 + swz / 64; C = (st & 1) * 32 + (swz % 64) / 2; }
__host__ __device__ __forceinline__ int perm32(int rho) { const int n = rho >> 4, i = rho & 15; return 8 * (i >> 2) + 4 * n + (i & 3); }

struct Unit { int pm, pn; };
struct Gemm { const bf16_t* A; const bf16_t* Bt; int M, N, K; };

struct StaticOrder {
    int nM, nN, nwg, G, c;
    __host__ __device__ void init(int M, int N, int G_, int c_) { nM = M / BM; nN = N / BM; nwg = nM * nN; G = G_; c = c_; }
    __host__ __device__ bool next(int i, Unit& u) const {
        const long L = (long)i * G + c; if (L >= nwg) return false;
        int wgid = (int)L; { const int q = nwg / NXCD, r = nwg % NXCD, xcd = wgid % NXCD, off = wgid / NXCD; wgid = (xcd < r ? xcd * (q + 1) : r * (q + 1) + (xcd - r) * q) + off; }
        const int nig = WGM * nN, gid = wgid / nig, fm = gid * WGM, gsz = (nM - fm) < WGM ? (nM - fm) : WGM;
        u.pm = fm + ((wgid % nig) % gsz); u.pn = (wgid % nig) / gsz; return true;
    }
    __device__ __forceinline__ void a_ready(const Unit&) const {}
    __device__ __forceinline__ void done(const Unit&) const {}
};
__device__ __forceinline__ unsigned cvt_pk_bf16(float lo, float hi) { unsigned r; asm volatile("v_cvt_pk_bf16_f32 %0, %1, %2" : "=v"(r) : "v"(lo), "v"(hi)); return r; }
typedef float f32x2 __attribute__((ext_vector_type(2)));
template <class Epi, class Sched, bool STAMP = false>
__device__ __forceinline__ void gemm_phase(PG8_LAS unsigned char* lds, const Gemm g, const Sched& S, const Epi& E, unsigned long long* stamps) {
    const int tid = threadIdx.x, wid = __builtin_amdgcn_readfirstlane(tid >> 6), lane = tid & 63, wr = wid >> 2, wc = wid & 3, fr = lane & 15, fq = lane >> 4;
    const int K = g.K, nt = K / BK;
    int ts_lo = 0, ts_hi = 0, nts = 0; const unsigned long long rt_entry = STAMP ? (unsigned long long)wall_clock64() : 0ull;
#define PG8_STAMP() do { if (STAMP && wid == 0 && nts < 64) { const unsigned long long _c = (unsigned long long)clock64(); \
        ts_lo = (lane == nts) ? (int)(unsigned)_c : ts_lo; ts_hi = (lane == nts) ? (int)(unsigned)(_c >> 32) : ts_hi; ++nts; } } while (0)
    PG8_STAMP();
    unsigned voffA[2], voffB[2];
#pragma unroll
    for (int i = 0; i < 2; ++i) { int R, C; stage_rc(tid * 16 + i * 8192, R, C); const int Rb = Epi::PERM ? ((R & ~31) + perm32(R & 31)) : R;
        voffA[i] = (unsigned)(R * K + C) * 2u; voffB[i] = (unsigned)(Rb * K + C) * 2u; }
    const size_t kstep = (size_t)(BK * 2);
    const size_t hstep = (size_t)HALF * K * 2;
    const size_t tstep = 2 * hstep;
    const unsigned ldsw = (unsigned)wid * 1024u;
    const int aoff = lds_byte(wr * 64 + fr, fq * 8), boff = lds_byte(wc * 32 + fr, fq * 8);
#define PG8_SA(b, h) (((b) * 2 + (h)) * HTB)
#define PG8_SB(b, h) ((4 + (b) * 2 + (h)) * HTB)
#define PG8_STAGE(bufoff, gbase, voff) do { _Pragma("unroll") for (int _i = 0; _i < 2; ++_i) \
        __builtin_amdgcn_global_load_lds((const unsigned*)((const char*)(gbase) + (voff)[_i]), (PG8_LAS unsigned*)(lds + (bufoff) + ldsw + _i * 8192), 16, 0, 0); } while (0)
#define PG8_LDA(dst, b, h) do { _Pragma("unroll") for (int m = 0; m < 4; ++m) _Pragma("unroll") for (int k = 0; k < 2; ++k) dst[m][k] = *(const PG8_LAS bf16x8*)(lds + PG8_SA(b, h) + aoff + m * 2048 + k * 1024); } while (0)
#define PG8_LDB(dst, b, h) do { _Pragma("unroll") for (int n = 0; n < 2; ++n) _Pragma("unroll") for (int k = 0; k < 2; ++k) dst[n][k] = *(const PG8_LAS bf16x8*)(lds + PG8_SB(b, h) + boff + n * 2048 + k * 1024); } while (0)
#define PG8_MMA(ai, bj, At, Bt) do { __builtin_amdgcn_s_setprio(1); _Pragma("unroll") for (int m = 0; m < 4; ++m) _Pragma("unroll") for (int n = 0; n < 2; ++n) _Pragma("unroll") for (int k = 0; k < 2; ++k) \
        acc[ai][bj][m][n] = __builtin_amdgcn_mfma_f32_16x16x32_bf16(Bt[n][k], At[m][k], acc[ai][bj][m][n], 0, 0, 0); __builtin_amdgcn_s_setprio(0); } while (0)
#define PG8_WAIT_V(n) asm volatile("s_waitcnt vmcnt(" #n ")" ::: "memory")
#define PG8_WAIT_L(n) asm volatile("s_waitcnt lgkmcnt(" #n ")" ::: "memory")
#define PG8_BAR __builtin_amdgcn_s_barrier()
#define PG8_SCHED __builtin_amdgcn_sched_barrier(0)
    Unit cur, nxt; int ui = 0;
    if (!S.next(0, cur)) return;
    f32x4 acc[2][2][4][2];
#pragma unroll
    for (int a = 0; a < 2; ++a)
#pragma unroll
        for (int b = 0; b < 2; ++b)
#pragma unroll
            for (int m = 0; m < 4; ++m)
#pragma unroll
                for (int n = 0; n < 2; ++n) acc[a][b][m][n] = (f32x4){0.f, 0.f, 0.f, 0.f};
    bf16x8 At[4][2], B0[2][2], B1[2][2];
    const char* cA = (const char*)g.A + (size_t)cur.pm * tstep; const char* cB = (const char*)g.Bt + (size_t)cur.pn * tstep;
    S.a_ready(cur);
    PG8_STAGE(PG8_SB(0, 0), cB, voffB); PG8_STAGE(PG8_SA(0, 0), cA, voffA); PG8_STAGE(PG8_SB(0, 1), cB + hstep, voffB); PG8_STAGE(PG8_SA(0, 1), cA + hstep, voffA);
    if (wr == 1) PG8_BAR;
    PG8_WAIT_V(4); PG8_BAR;
    PG8_STAGE(PG8_SB(1, 0), cB + kstep, voffB); PG8_STAGE(PG8_SA(1, 0), cA + kstep, voffA); PG8_STAGE(PG8_SB(1, 1), cB + hstep + kstep, voffB);
    PG8_WAIT_V(6); PG8_BAR;
    PG8_STAMP();
    for (;;) {
        const bool has_next = S.next(ui + 1, nxt);
        const char* nA = has_next ? (const char*)g.A + (size_t)nxt.pm * tstep : cA; const char* nB = has_next ? (const char*)g.Bt + (size_t)nxt.pn * tstep : cB;
        for (int t = 0; t < nt; t += 2) {
            const bool last = (t == nt - 2);
            const char* a1 = cA + (size_t)(t + 1) * kstep;
            const char* a2 = last ? nA : cA + (size_t)(t + 2) * kstep; const char* b2 = last ? nB : cB + (size_t)(t + 2) * kstep;
            const char* a3 = a2 + kstep; const char* b3 = b2 + kstep;
            if (last && has_next) S.a_ready(nxt);
            PG8_LDB(B0, 0, 0); PG8_SCHED; PG8_LDA(At, 0, 0); PG8_STAGE(PG8_SA(1, 1), a1 + hstep, voffA);
            PG8_WAIT_L(8); PG8_BAR; PG8_WAIT_L(0); PG8_MMA(0, 0, At, B0); PG8_BAR; PG8_SCHED;
            PG8_LDB(B1, 0, 1); PG8_STAGE(PG8_SB(0, 0), b2, voffB);
            PG8_BAR; PG8_WAIT_L(0); PG8_MMA(0, 1, At, B1); PG8_BAR;
            PG8_LDA(At, 0, 1); PG8_STAGE(PG8_SA(0, 0), a2, voffA);
            PG8_BAR; PG8_WAIT_L(0); PG8_MMA(1, 0, At, B0); PG8_BAR; PG8_SCHED;
            PG8_STAGE(PG8_SB(0, 1), b2 + hstep, voffB);
            PG8_WAIT_V(6); PG8_BAR; PG8_MMA(1, 1, At, B1); PG8_BAR;
            PG8_LDB(B0, 1, 0); PG8_SCHED; PG8_LDA(At, 1, 0); PG8_STAGE(PG8_SA(0, 1), a2 + hstep, voffA);
            PG8_WAIT_L(8); PG8_BAR; PG8_WAIT_L(0); PG8_MMA(0, 0, At, B0); PG8_BAR; PG8_SCHED;
            PG8_LDB(B1, 1, 1); PG8_STAGE(PG8_SB(1, 0), b3, voffB);
            PG8_BAR; PG8_WAIT_L(0); PG8_MMA(0, 1, At, B1); PG8_BAR;
            PG8_LDA(At, 1, 1); PG8_STAGE(PG8_SA(1, 0), a3, voffA);
            PG8_BAR; PG8_WAIT_L(0); PG8_MMA(1, 0, At, B0); PG8_BAR; PG8_SCHED;
            PG8_STAGE(PG8_SB(1, 1), b3 + hstep, voffB);
            PG8_WAIT_V(6); PG8_BAR; PG8_MMA(1, 1, At, B1); PG8_BAR;
        }
        PG8_STAMP();
        if constexpr (!Epi::AFTER_DRAIN) { E(acc, cur, wr, wc, fr, fq); S.done(cur); }
        PG8_STAMP();
        if (!has_next) break;
#pragma unroll
        for (int a = 0; a < 2; ++a)
#pragma unroll
            for (int b = 0; b < 2; ++b)
#pragma unroll
                for (int m = 0; m < 4; ++m)
#pragma unroll
                    for (int n = 0; n < 2; ++n) acc[a][b][m][n] = (f32x4){0.f, 0.f, 0.f, 0.f};
        cur = nxt; cA = nA; cB = nB; ++ui;
    }
    PG8_WAIT_V(0);
    if (wr == 0) PG8_BAR;
    PG8_BAR;
    if constexpr (Epi::AFTER_DRAIN) { E.fused(acc, cur, wr, wc, fr, fq, lds, wid, lane); S.done(cur); }
    PG8_STAMP();
    if (STAMP && wid == 0) { stamps[lane] = lane < nts ? (((unsigned long long)(unsigned)ts_hi << 32) | (unsigned)ts_lo) : 0ull;
        if (lane == 62) stamps[62] = rt_entry; if (lane == 63) stamps[63] = (unsigned long long)wall_clock64(); }
#undef PG8_STAMP
#undef PG8_SA
#undef PG8_SB
#undef PG8_STAGE
#undef PG8_LDA
#undef PG8_LDB
#undef PG8_MMA
#undef PG8_WAIT_V
#undef PG8_WAIT_L
#undef PG8_BAR
#undef PG8_SCHED
}
}

struct EpiProj {
    static constexpr bool PERM = true, AFTER_DRAIN = false;
    u16* P; const float* cs;
    __device__ __forceinline__ void operator()(const pg8::f32x4 (&acc)[2][2][4][2], const pg8::Unit& u, int wr, int wc, int fr, int fq) const {
        const int row0 = u.pm * 256 + wr * 64 + fr;
        const int col0 = u.pn * 256 + wc * 32 + 8 * fq;
        const bool rope = (u.pn >= C_DQ / 256) && (u.pn < C_DV / 256);
#pragma unroll
        for (int ai = 0; ai < 2; ++ai)
#pragma unroll
            for (int m = 0; m < 4; ++m) { const int row = row0 + ai * 128 + m * 16; u16* rowp = P + (size_t)row * NP + col0;
                pg8::f32x4 c01 = (pg8::f32x4){1.f, 0.f, 1.f, 0.f}, c23 = c01;
                if (rope) { const pg8::f32x4* cp = (const pg8::f32x4*)(cs + ((size_t)row * 64 + 4 * (4 * wc + fq)) * 2); c01 = cp[0]; c23 = cp[1]; }
#pragma unroll
                for (int bj = 0; bj < 2; ++bj) { pg8::f32x4 v0 = acc[ai][bj][m][0], v1 = acc[ai][bj][m][1];
                    if (rope) {
                        const pg8::f32x4 cc = {c01[0], c01[2], c23[0], c23[2]}, sn = {c01[1], c01[3], c23[1], c23[3]};
                        const pg8::f32x4 y1 = v0 * cc - v1 * sn, y2 = v0 * sn + v1 * cc; v0 = y1; v1 = y2; }
                    pg8::u32x4 w; w.x = pg8::cvt_pk_bf16(v0[0], v0[1]); w.y = pg8::cvt_pk_bf16(v0[2], v0[3]); w.z = pg8::cvt_pk_bf16(v1[0], v1[1]); w.w = pg8::cvt_pk_bf16(v1[2], v1[3]);
                    *(pg8::u32x4*)(rowp + bj * 128) = w; } }
    }
};
__device__ __forceinline__ void gz_phase(unsigned char* lds, const u16* __restrict__ H1, const u16* __restrict__ Wg, float* __restrict__ gz) {
    const int tid = threadIdx.x, lane = tid & 63, wave = tid >> 6, fr = lane & 15, fq = lane >> 4;
    float* red = (float*)lds;
    for (int rb = blockIdx.x; rb < T / 64; rb += gridDim.x) {
        const int r0 = rb * 64, k0 = wave * 256;
        f32x4 acc[4][2];
#pragma unroll
        for (int m = 0; m < 4; ++m) { acc[m][0] = (f32x4){0.f, 0.f, 0.f, 0.f}; acc[m][1] = (f32x4){0.f, 0.f, 0.f, 0.f}; }
#pragma unroll
        for (int ks = 0; ks < 8; ++ks) {
            bf16x8 af[4], bfr[2];
#pragma unroll
            for (int m = 0; m < 4; ++m) af[m] = *(const bf16x8*)(H1 + (size_t)(r0 + 16 * m + fr) * D + k0 + 32 * ks + 8 * fq);
#pragma unroll
            for (int n = 0; n < 2; ++n) bfr[n] = *(const bf16x8*)(Wg + (size_t)(16 * n + fr) * D + k0 + 32 * ks + 8 * fq);
#pragma unroll
            for (int m = 0; m < 4; ++m)
#pragma unroll
                for (int n = 0; n < 2; ++n) acc[m][n] = __builtin_amdgcn_mfma_f32_16x16x32_bf16(af[m], bfr[n], acc[m][n], 0, 0, 0);
        }
        __syncthreads();
#pragma unroll
        for (int m = 0; m < 4; ++m)
#pragma unroll
            for (int n = 0; n < 2; ++n)
#pragma unroll
                for (int j = 0; j < 4; ++j) red[(wave * 64 + 16 * m + 4 * fq + j) * 32 + 16 * n + fr] = acc[m][n][j];
        __syncthreads();
#pragma unroll
        for (int k = 0; k < 4; ++k) {
            const int e = tid + 512 * k;
            float s = 0.f;
#pragma unroll
            for (int w = 0; w < 8; ++w) s += red[w * 2048 + e];
            gz[(size_t)r0 * 32 + e] = s;
        }
    }
    __syncthreads();
}
struct EpiResid {
    static constexpr bool PERM = true, AFTER_DRAIN = false;
    const float* x; const float* mod; u16* x1;
    __device__ __forceinline__ void operator()(const pg8::f32x4 (&acc)[2][2][4][2], const pg8::Unit& u, int wr, int wc, int fr, int fq) const {
        const int row0 = u.pm * 256 + wr * 64 + fr, col0 = u.pn * 256 + wc * 32 + 8 * fq;
        const int b = (u.pm * 256) / S;
        pg8::f32x4 ga[2][2];
#pragma unroll
        for (int bj = 0; bj < 2; ++bj)
#pragma unroll
            for (int n = 0; n < 2; ++n) ga[bj][n] = *(const pg8::f32x4*)(mod + b * 12288 + 2 * 2048 + col0 + bj * 128 + 4 * n);
#pragma unroll
        for (int ai = 0; ai < 2; ++ai)
#pragma unroll
            for (int m = 0; m < 4; ++m) { const size_t off = (size_t)(row0 + ai * 128 + m * 16) * D + col0;
#pragma unroll
                for (int bj = 0; bj < 2; ++bj) {
                    const pg8::f32x4 x0 = __builtin_nontemporal_load((const pg8::f32x4*)(x + off + bj * 128)), x1v = __builtin_nontemporal_load((const pg8::f32x4*)(x + off + bj * 128 + 4));
                    const pg8::f32x4 v0 = x0 + ga[bj][0] * acc[ai][bj][m][0], v1 = x1v + ga[bj][1] * acc[ai][bj][m][1];
                    pg8::u32x4 w; w.x = pg8::cvt_pk_bf16(v0[0], v0[1]); w.y = pg8::cvt_pk_bf16(v0[2], v0[3]); w.z = pg8::cvt_pk_bf16(v1[0], v1[1]); w.w = pg8::cvt_pk_bf16(v1[2], v1[3]);
                    *(pg8::u32x4*)(x1 + off + bj * 128) = w; } }
    }
};
struct EpiBf16 {
    static constexpr bool PERM = true, AFTER_DRAIN = false;
    u16* Q;
    __device__ __forceinline__ void operator()(const pg8::f32x4 (&acc)[2][2][4][2], const pg8::Unit& u, int wr, int wc, int fr, int fq) const {
        const int row0 = u.pm * 256 + wr * 64 + fr, col0 = u.pn * 256 + wc * 32 + 8 * fq;
#pragma unroll
        for (int ai = 0; ai < 2; ++ai)
#pragma unroll
            for (int m = 0; m < 4; ++m) { u16* rowp = Q + (size_t)(row0 + ai * 128 + m * 16) * D + col0;
#pragma unroll
                for (int bj = 0; bj < 2; ++bj) { const pg8::f32x4 v0 = acc[ai][bj][m][0], v1 = acc[ai][bj][m][1];
                    pg8::u32x4 w; w.x = pg8::cvt_pk_bf16(v0[0], v0[1]); w.y = pg8::cvt_pk_bf16(v0[2], v0[3]); w.z = pg8::cvt_pk_bf16(v1[0], v1[1]); w.w = pg8::cvt_pk_bf16(v1[2], v1[3]);
                    *(pg8::u32x4*)(rowp + bj * 128) = w; } }
    }
};
template <class Epi>
__device__ __forceinline__ void gemm8(unsigned char* lds, const u16* A, const u16* Bt, int M, int N, int K, const Epi& E) {
    pg8::Gemm g{A, Bt, M, N, K}; pg8::StaticOrder So; So.init(M, N, (int)gridDim.x, (int)blockIdx.x);
    pg8::gemm_phase<Epi, pg8::StaticOrder, false>((PG8_LAS unsigned char*)lds, g, So, E, nullptr);
    __syncthreads();
}

#define GLA_QD_BYTES 16384
#define GLA_AT_BYTES 8192
__device__ __forceinline__ float gla_logsigmoid(float z) { return fminf(z, 0.f) - __logf(1.f + __expf(-fabsf(z))); }

__device__ __forceinline__ void gla_prep_item(const u16* __restrict__ P, int ldp, int cq, int ck, const float* __restrict__ gz,
                                              const float* __restrict__ wg_f, const float* __restrict__ bg_f, const float* __restrict__ wg_b, const float* __restrict__ bg_b,
                                              int Sq, unsigned char* __restrict__ QDg, unsigned char* __restrict__ KEg, unsigned char* __restrict__ ATg, float* __restrict__ DECg,
                                              unsigned char* lds, int item) {
    const int nch = Sq / 64;
    const int c = item % nch, dir = (item / nch) & 1, hh = (item / (nch * 2)) & 3, b = item / (nch * 8);
    const int tid = TID, lane = tid & 63, wave = tid >> 6, li = lane & 15, fq = lane >> 4;
    float* gzs = (float*)lds;
    float* segs = gzs + 64 * 16;
    unsigned char* QDs = lds + 8192;
    unsigned char* KIs = QDs + 16384;
    unsigned char* KEs = KIs + 16384;
    float* bmat = (float*)(KEs + 16384);
    const size_t tok0 = (size_t)b * Sq;
    __syncthreads();
    uint4 rq0, rq1, rk0, rk1;
    {
        const int i0 = tid >> 4, i1 = (tid + 512) >> 4, cc = tid & 15;
        const int s0 = dir ? (Sq - 1 - (64 * c + i0)) : (64 * c + i0), s1 = dir ? (Sq - 1 - (64 * c + i1)) : (64 * c + i1);
        rq0 = *(const uint4*)(P + (tok0 + s0) * ldp + cq + hh * 128 + cc * 8); rk0 = *(const uint4*)(P + (tok0 + s0) * ldp + ck + hh * 128 + cc * 8);
        rq1 = *(const uint4*)(P + (tok0 + s1) * ldp + cq + hh * 128 + cc * 8); rk1 = *(const uint4*)(P + (tok0 + s1) * ldp + ck + hh * 128 + cc * 8);
    }
    for (int e = tid; e < 64 * 16; e += 512) {
        const int i = e >> 4, r = e & 15;
        const int s = dir ? (Sq - 1 - (64 * c + i)) : (64 * c + i);
        gzs[e] = gz[(tok0 + s) * 32 + dir * 16 + r];
    }
    const int d = tid & 127, seg = tid >> 7;
    const float* wg = dir ? wg_b : wg_f;
    float wcol[16];
#pragma unroll
    for (int r = 0; r < 16; ++r) wcol[r] = wg[r * 512 + hh * 128 + d];
    const float bias = (dir ? bg_b : bg_f)[hh * 128 + d];
    __syncthreads();
    float run = 0.f;
#pragma unroll
    for (int k = 0; k < 16; ++k) {
        const int i = 16 * seg + k;
        float z = bias;
#pragma unroll
        for (int r = 0; r < 16; ++r) z += gzs[i * 16 + r] * wcol[r];
        run += gla_logsigmoid(z) * (1.f / 16.f);
        bmat[i * 128 + d] = run;
    }
    segs[seg * 128 + d] = run;
    __syncthreads();
    if (seg == 0) {
        const float t0 = segs[d], t1 = segs[128 + d], t2 = segs[256 + d], t3 = segs[384 + d];
        segs[d] = 0.f; segs[128 + d] = t0; segs[256 + d] = t0 + t1; segs[384 + d] = t0 + t1 + t2; segs[512 + d] = t0 + t1 + t2 + t3;
        DECg[(size_t)item * 128 + d] = __expf(t0 + t1 + t2 + t3);
    }
    __syncthreads();
    const float qscale = 0.08838834764831845f;
#pragma unroll
    for (int k = 0; k < 2; ++k) {
        const int id = tid + 512 * k, i = id >> 4, cc = id & 15, d0 = cc * 8, sg = i >> 4;
        const uint4 qv = k ? rq1 : rq0, kv = k ? rk1 : rk0;
        const float qx[8] = {lo2f(qv.x), hi2f(qv.x), lo2f(qv.y), hi2f(qv.y), lo2f(qv.z), hi2f(qv.z), lo2f(qv.w), hi2f(qv.w)};
        const float kx[8] = {lo2f(kv.x), hi2f(kv.x), lo2f(kv.y), hi2f(kv.y), lo2f(kv.z), hi2f(kv.z), lo2f(kv.w), hi2f(kv.w)};
        float qd[8], ki[8], ke[8];
        const float4 bA = *(const float4*)(bmat + i * 128 + d0), bB = *(const float4*)(bmat + i * 128 + d0 + 4);
        const float4 oA = *(const float4*)(segs + sg * 128 + d0), oB = *(const float4*)(segs + sg * 128 + d0 + 4);
        const float4 tA = *(const float4*)(segs + 512 + d0), tB = *(const float4*)(segs + 512 + d0 + 4);
        const float bv[8] = {bA.x + oA.x, bA.y + oA.y, bA.z + oA.z, bA.w + oA.w, bB.x + oB.x, bB.y + oB.y, bB.z + oB.z, bB.w + oB.w};
        const float tv[8] = {tA.x, tA.y, tA.z, tA.w, tB.x, tB.y, tB.z, tB.w};
#pragma unroll
        for (int e = 0; e < 8; ++e) {
            const float bb = bv[e], tot = tv[e];
            qd[e] = qx[e] * qscale * __expf(bb); ki[e] = kx[e] * __expf(-bb); ke[e] = kx[e] * __expf(tot - bb);
        }
        const int o = i * 256 + ((cc ^ (i & 15)) << 4);
        *(uint4*)(QDs + o) = make_uint4(pack2(qd[0], qd[1]), pack2(qd[2], qd[3]), pack2(qd[4], qd[5]), pack2(qd[6], qd[7]));
        *(uint4*)(KIs + o) = make_uint4(pack2(ki[0], ki[1]), pack2(ki[2], ki[3]), pack2(ki[4], ki[5]), pack2(ki[6], ki[7]));
        *(uint4*)(KEs + o) = make_uint4(pack2(ke[0], ke[1]), pack2(ke[2], ke[3]), pack2(ke[4], ke[5]), pack2(ke[6], ke[7]));
    }
    __syncthreads();
    {
        uint4* qo = (uint4*)(QDg + (size_t)item * GLA_QD_BYTES); uint4* ko = (uint4*)(KEg + (size_t)item * GLA_QD_BYTES);
#pragma unroll
        for (int k = 0; k < 2; ++k) { const int e = tid + 512 * k; qo[e] = ((const uint4*)QDs)[e]; ko[e] = ((const uint4*)KEs)[e]; }
    }
#pragma unroll
    for (int tt = 0; tt < 2; ++tt) {
        const int tile = wave + 8 * tt, jt = tile >> 2, it = tile & 3;
        f32x4 acc = (f32x4){0.f, 0.f, 0.f, 0.f};
        if (jt <= it) {
            const int jr = 16 * jt + li, ir = 16 * it + li;
#pragma unroll
            for (int ks = 0; ks < 4; ++ks) {
                const bf16x8 kf = *(const bf16x8*)(KIs + jr * 256 + (((4 * ks + fq) ^ (jr & 15)) << 4));
                const bf16x8 qf = *(const bf16x8*)(QDs + ir * 256 + (((4 * ks + fq) ^ (ir & 15)) << 4));
                acc = __builtin_amdgcn_mfma_f32_16x16x32_bf16(kf, qf, acc, 0, 0, 0);
            }
        }
        const int i = 16 * it + li, j0 = 16 * jt + 4 * fq;
        float v[4];
#pragma unroll
        for (int jj = 0; jj < 4; ++jj) v[jj] = (j0 + jj <= i) ? acc[jj] : 0.f;
        const int chunk = 2 * jt + (fq >> 1), sub = (fq & 1) * 8;
        *(uint2*)(ATg + (size_t)item * GLA_AT_BYTES + i * 128 + ((chunk ^ (i & 7)) << 4) + sub) = make_uint2(pack2(v[0], v[1]), pack2(v[2], v[3]));
    }
}

__device__ __forceinline__ void gla_seq_item(const u16* __restrict__ P, int ldp, int cv, int Sq,
                                             const unsigned char* __restrict__ QDg, const unsigned char* __restrict__ KEg, const unsigned char* __restrict__ ATg, const float* __restrict__ DECg,
                                             u16* __restrict__ Oout  , int Ttot, unsigned char* lds, int item) {
    const int slice = item & 1, dir = (item >> 1) & 1, hh = (item >> 2) & 3, b = item >> 4;
    const int nch = Sq / 64;
    const int tid = TID, lane = tid & 63, wave = tid >> 6, li = lane & 15, fq = lane >> 4;
    const size_t tok0 = (size_t)b * Sq;
    const int pitem0 = ((b * 4 + hh) * 2 + dir) * nch;
    constexpr int BUF = 16384 * 3 + 8192 + 512;
    typedef unsigned gla_u32x4 __attribute__((ext_vector_type(4)));
    gla_u32x4 rq0, rq1, rk0, rk1, rv0, rv1, ra; float rd = 0.f;
#define GLA_VROW(c_, k_) ((tok0 + (size_t)(dir ? (Sq - 1 - (64 * (c_) + ((tid + 512 * (k_)) >> 4))) : (64 * (c_) + ((tid + 512 * (k_)) >> 4)))) * ldp + cv + hh * 256 + slice * 128 + ((tid + 512 * (k_)) & 15) * 8)
#define GLA_ISSUE(c_) do { \
        const gla_u32x4* qsrc_ = (const gla_u32x4*)(QDg + (size_t)(pitem0 + (c_)) * GLA_QD_BYTES); const gla_u32x4* ksrc_ = (const gla_u32x4*)(KEg + (size_t)(pitem0 + (c_)) * GLA_QD_BYTES); \
        rq0 = qsrc_[tid]; rq1 = qsrc_[tid + 512]; rk0 = ksrc_[tid]; rk1 = ksrc_[tid + 512]; \
        ra = ((const gla_u32x4*)(ATg + (size_t)(pitem0 + (c_)) * GLA_AT_BYTES))[tid]; \
        rv0 = *(const gla_u32x4*)(P + GLA_VROW(c_, 0)); rv1 = *(const gla_u32x4*)(P + GLA_VROW(c_, 1)); \
        if (tid < 128) rd = DECg[(size_t)(pitem0 + (c_)) * 128 + tid]; } while (0)
#define GLA_COMMIT(buf_) do { \
        unsigned char* base_ = lds + (buf_) * BUF; \
        ((gla_u32x4*)base_)[tid] = rq0; ((gla_u32x4*)base_)[tid + 512] = rq1; ((gla_u32x4*)(base_ + 16384))[tid] = rk0; ((gla_u32x4*)(base_ + 16384))[tid + 512] = rk1; \
        { const int row_ = tid >> 4, ch_ = tid & 15; *(gla_u32x4*)(base_ + 32768 + row_ * 256 + ((ch_ ^ (row_ & 15)) << 4)) = rv0; } \
        { const int row_ = (tid + 512) >> 4, ch_ = tid & 15; *(gla_u32x4*)(base_ + 32768 + row_ * 256 + ((ch_ ^ (row_ & 15)) << 4)) = rv1; } \
        ((gla_u32x4*)(base_ + 49152))[tid] = ra; \
        if (tid < 128) ((float*)(base_ + 57344))[tid] = rd; } while (0)
    f32x4 st[8];
#pragma unroll
    for (int dt = 0; dt < 8; ++dt) st[dt] = (f32x4){0.f, 0.f, 0.f, 0.f};
    __syncthreads();
    GLA_ISSUE(0); GLA_COMMIT(0);
    __syncthreads();
#pragma unroll 1
    for (int c = 0; c < nch; ++c) {
        const int buf = c & 1;
        if (c + 1 < nch) GLA_ISSUE(c + 1);
        const unsigned char* QDs = lds + buf * BUF; const unsigned char* KEs = QDs + 16384; const unsigned char* Vs = QDs + 32768;
        const unsigned char* ATs = QDs + 49152; const float* DECs = (const float*)(QDs + 57344);
        bf16x8 vf[2];
#pragma unroll
        for (int jp = 0; jp < 2; ++jp) {
            const int rowA = 32 * jp + 8 * fq + (li >> 2), rowB = rowA + 4;
            const int chunk = 2 * wave + ((li & 3) >> 1), sub = ((li & 3) & 1) * 8;
            const s16x4 va = __builtin_amdgcn_ds_read_tr16_b64_v4i16((LAS s16x4*)(Vs + rowA * 256 + ((chunk ^ (rowA & 15)) << 4) + sub));
            const s16x4 vb = __builtin_amdgcn_ds_read_tr16_b64_v4i16((LAS s16x4*)(Vs + rowB * 256 + ((chunk ^ (rowB & 15)) << 4) + sub));
            vf[jp] = __builtin_shufflevector(va, vb, 0, 1, 2, 3, 4, 5, 6, 7);
        }
        bf16x8 sf[4];
#pragma unroll
        for (int dp = 0; dp < 4; ++dp) {
            const gla_u32x4 t_ = {pack2(st[2 * dp][0], st[2 * dp][1]), pack2(st[2 * dp][2], st[2 * dp][3]), pack2(st[2 * dp + 1][0], st[2 * dp + 1][1]), pack2(st[2 * dp + 1][2], st[2 * dp + 1][3])};
            sf[dp] = __builtin_bit_cast(bf16x8, t_);
        }
        f32x4 ot[4];
#pragma unroll
        for (int it = 0; it < 4; ++it) {
            f32x4 acc = (f32x4){0.f, 0.f, 0.f, 0.f};
            const int ir = 16 * it + li;
#pragma unroll
            for (int dp = 0; dp < 4; ++dp) {
                const int c0 = 4 * dp + (fq >> 1), c1 = c0 + 2, sub = (fq & 1) * 8;
                const uint2 lo = *(const uint2*)(QDs + ir * 256 + ((c0 ^ (ir & 15)) << 4) + sub);
                const uint2 hi = *(const uint2*)(QDs + ir * 256 + ((c1 ^ (ir & 15)) << 4) + sub);
                const gla_u32x4 q_ = {lo.x, lo.y, hi.x, hi.y};
                const bf16x8 qf = __builtin_bit_cast(bf16x8, q_);
                acc = __builtin_amdgcn_mfma_f32_16x16x32_bf16(sf[dp], qf, acc, 0, 0, 0);
            }
#pragma unroll
            for (int jp = 0; jp < 2; ++jp) {
                if (32 * jp <= 16 * it + 15) {
                    const bf16x8 af = *(const bf16x8*)(ATs + ir * 128 + (((4 * jp + fq) ^ (ir & 7)) << 4));
                    acc = __builtin_amdgcn_mfma_f32_16x16x32_bf16(vf[jp], af, acc, 0, 0, 0);
                }
            }
            ot[it] = acc;
        }
#pragma unroll
        for (int dt = 0; dt < 8; ++dt) {
            const f32x4 dec = *(const f32x4*)(DECs + 16 * dt + 4 * fq);
            f32x4 acc = st[dt] * dec;
#pragma unroll
            for (int jp = 0; jp < 2; ++jp) {
                const int rowA = 32 * jp + 8 * fq + (li >> 2), rowB = rowA + 4;
                const int chunk = 2 * dt + ((li & 3) >> 1), sub = ((li & 3) & 1) * 8;
                const s16x4 ka = __builtin_amdgcn_ds_read_tr16_b64_v4i16((LAS s16x4*)(KEs + rowA * 256 + ((chunk ^ (rowA & 15)) << 4) + sub));
                const s16x4 kb = __builtin_amdgcn_ds_read_tr16_b64_v4i16((LAS s16x4*)(KEs + rowB * 256 + ((chunk ^ (rowB & 15)) << 4) + sub));
                const bf16x8 kf = __builtin_shufflevector(ka, kb, 0, 1, 2, 3, 4, 5, 6, 7);
                acc = __builtin_amdgcn_mfma_f32_16x16x32_bf16(kf, vf[jp], acc, 0, 0, 0);
            }
            st[dt] = acc;
        }
#pragma unroll
        for (int it = 0; it < 4; ++it) {
            const int i = 16 * it + li;
            const int s = dir ? (Sq - 1 - (64 * c + i)) : (64 * c + i);
            *(uint2*)(Oout + ((size_t)dir * Ttot + tok0 + s) * 1024 + hh * 256 + slice * 128 + 16 * wave + 4 * fq) =
                make_uint2(pack2(ot[it][0], ot[it][1]), pack2(ot[it][2], ot[it][3]));
        }
        if (c + 1 < nch) GLA_COMMIT(buf ^ 1);
        __syncthreads();
    }
}
__device__ __forceinline__ void phase_rope_prep(const Args& a, unsigned char* lds) {
    u16* P = (u16*)(a.ws + WS_P);
    const float2* cs = (const float2*)(a.ws + WS_CS);
    const int gt = blockIdx.x * NTHREADS + threadIdx.x, NT = gridDim.x * NTHREADS;
    for (int item = blockIdx.x; item < GLA_NPREP; item += gridDim.x)
        gla_prep_item(P, NP, C_GQ, C_GK, (const float*)(a.ws + WS_GZ), a.wgf, a.bgf, a.wgb, a.bgb, S,
                      a.ws + WS_QD, a.ws + WS_KE, a.ws + WS_AT, (float*)(a.ws + WS_DEC), lds, item);
}

#define ATTN_DECODE(item_) \
    const int nb_per = Sq / 128; \
    const int within = (item_) % nb_per, hh = ((item_) / nb_per) & 7, b = ((item_) / (nb_per * 8)) & 3, pat = (item_) / (nb_per * 32); \
    const int dil = pat == 0 ? 1 : (pat == 1 ? 4 : 16); \
    const int M = Sq / dil; \
    const int r = within % dil, blk = within / dil; \
    const int p0 = blk * 128, kbase = p0 - 64; \
    const size_t tok0 = (size_t)b * Sq;
typedef unsigned attn_u32x4 __attribute__((ext_vector_type(4)));
__device__ __forceinline__ void attn_phase(const u16* __restrict__ P, int ldp, int cq, int ck, int cv, int Sq,
                                           u16* __restrict__ part_o, float* __restrict__ part_lse, int Ttot,
                                           unsigned char* lds, int first, int stride, int nitems) {
    const int tid = TID, lane = tid & 63, wave = tid >> 6, li = lane & 15, fq = lane >> 4;
    unsigned char* Ks = lds;
    unsigned char* Vs = lds + 65536;
    attn_u32x4 kr0, kr1, kr2, kr3, kr4, kr5, kr6, kr7, vr0, vr1, vr2, vr3, vr4, vr5, vr6, vr7;
    bf16x8 qn0, qn1, qn2, qn3;
#define ATTN_LD1(i_, kreg_, vreg_) { const int id_ = tid + 512 * (i_), row_ = id_ >> 4, c_ = id_ & 15; \
        int kp_ = kbase + row_; kp_ = kp_ < 0 ? 0 : (kp_ > M - 1 ? M - 1 : kp_); \
        const size_t t_ = tok0 + r + (size_t)dil * kp_; \
        kreg_ = *(const attn_u32x4*)(P + t_ * ldp + ck + hh * 128 + c_ * 8); vreg_ = *(const attn_u32x4*)(P + t_ * ldp + cv + hh * 128 + c_ * 8); }
#define ATTN_LOAD(item_) do { ATTN_DECODE(item_) \
        { const size_t tq_ = tok0 + r + (size_t)dil * (p0 + 16 * wave + li); const u16* qp_ = P + tq_ * ldp + cq + hh * 128 + 8 * fq; \
          qn0 = *(const bf16x8*)(qp_); qn1 = *(const bf16x8*)(qp_ + 32); qn2 = *(const bf16x8*)(qp_ + 64); qn3 = *(const bf16x8*)(qp_ + 96); } \
        ATTN_LD1(0, kr0, vr0) ATTN_LD1(1, kr1, vr1) ATTN_LD1(2, kr2, vr2) ATTN_LD1(3, kr3, vr3) ATTN_LD1(4, kr4, vr4) ATTN_LD1(5, kr5, vr5) ATTN_LD1(6, kr6, vr6) ATTN_LD1(7, kr7, vr7) } while (0)
#define ATTN_ST1(i_, kreg_, vreg_) { const int id_ = tid + 512 * (i_), row_ = id_ >> 4, c_ = id_ & 15; const int off_ = row_ * 256 + ((c_ ^ (row_ & 15)) << 4); \
        *(attn_u32x4*)(Ks + off_) = kreg_; *(attn_u32x4*)(Vs + off_) = vreg_; }
#define ATTN_COMMIT() do { ATTN_ST1(0, kr0, vr0) ATTN_ST1(1, kr1, vr1) ATTN_ST1(2, kr2, vr2) ATTN_ST1(3, kr3, vr3) ATTN_ST1(4, kr4, vr4) ATTN_ST1(5, kr5, vr5) ATTN_ST1(6, kr6, vr6) ATTN_ST1(7, kr7, vr7) } while (0)
    int item = first;
    if (item < nitems) ATTN_LOAD(item);
    for (; item < nitems; item += stride) {
        ATTN_DECODE(item)
        __syncthreads();
        ATTN_COMMIT();
        const int qp = p0 + 16 * wave + li;
        const size_t tq = tok0 + r + (size_t)dil * qp;
        const bf16x8 qf[4] = {qn0, qn1, qn2, qn3};
        __syncthreads();
        if (item + stride < nitems) ATTN_LOAD(item + stride);
        const float scale = 0.08838834764831845f;
        float m = -1e30f, l = 0.f;
        f32x4 o[8];
#pragma unroll
        for (int dt = 0; dt < 8; ++dt) o[dt] = (f32x4){0.f, 0.f, 0.f, 0.f};
#pragma unroll 1
        for (int tp = 0; tp < 5; ++tp) {
            float s[8]; bool ok[8];
#pragma unroll
            for (int h2 = 0; h2 < 2; ++h2) {
                const int kk0 = 16 * wave + 16 * (2 * tp + h2);
                int krow = kk0 + li; krow = krow > 255 ? 255 : krow;
                f32x4 acc = (f32x4){0.f, 0.f, 0.f, 0.f};
#pragma unroll
                for (int ks = 0; ks < 4; ++ks) {
                    const bf16x8 kf = *(const bf16x8*)(Ks + krow * 256 + (((4 * ks + fq) ^ (krow & 15)) << 4));
                    acc = __builtin_amdgcn_mfma_f32_16x16x32_bf16(kf, qf[ks], acc, 0, 0, 0);
                }
#pragma unroll
                for (int j = 0; j < 4; ++j) {
                    const int kp = kbase + kk0 + 4 * fq + j;
                    const int rel = kp - qp;
                    ok[4 * h2 + j] = (kp >= 0) && (kp < M) && (rel <= 64) && (rel >= -64);
                    s[4 * h2 + j] = acc[j] * scale;
                }
            }
            float mx = -1e30f;
#pragma unroll
            for (int j = 0; j < 8; ++j) mx = ok[j] ? fmaxf(mx, s[j]) : mx;
            mx = fmaxf(mx, __shfl_xor(mx, 16));
            mx = fmaxf(mx, __shfl_xor(mx, 32));
            const float mn = fmaxf(m, mx);
            const float al = __expf(m - mn);
            float ps = 0.f; float p[8];
#pragma unroll
            for (int j = 0; j < 8; ++j) { p[j] = ok[j] ? __expf(s[j] - mn) : 0.f; ps += p[j]; }
            l = l * al + ps; m = mn;
            const attn_u32x4 p_ = {pack2(p[0], p[1]), pack2(p[2], p[3]), pack2(p[4], p[5]), pack2(p[6], p[7])};
            const bf16x8 pf = __builtin_bit_cast(bf16x8, p_);
#pragma unroll
            for (int dt = 0; dt < 8; ++dt) o[dt] *= al;
            int rowA = 16 * wave + 32 * tp + 4 * fq + (li >> 2); rowA = rowA > 255 ? 255 : rowA;
            int rowB = 16 * wave + 32 * tp + 16 + 4 * fq + (li >> 2); rowB = rowB > 255 ? 255 : rowB;
#pragma unroll
            for (int dt = 0; dt < 8; ++dt) {
                const int chunk = 2 * dt + ((li & 3) >> 1), sub = ((li & 3) & 1) * 8;
                const s16x4 va = __builtin_amdgcn_ds_read_tr16_b64_v4i16((LAS s16x4*)(Vs + rowA * 256 + ((chunk ^ (rowA & 15)) << 4) + sub));
                const s16x4 vb = __builtin_amdgcn_ds_read_tr16_b64_v4i16((LAS s16x4*)(Vs + rowB * 256 + ((chunk ^ (rowB & 15)) << 4) + sub));
                const bf16x8 vf = __builtin_shufflevector(va, vb, 0, 1, 2, 3, 4, 5, 6, 7);
                o[dt] = __builtin_amdgcn_mfma_f32_16x16x32_bf16(vf, pf, o[dt], 0, 0, 0);
            }
        }
        l += __shfl_xor(l, 16);
        l += __shfl_xor(l, 32);
        const float inv = 1.f / l;
        u16* orow = part_o + ((size_t)pat * Ttot + tq) * 1024 + hh * 128 + 4 * fq;
#pragma unroll
        for (int dt = 0; dt < 8; ++dt)
            *(uint2*)(orow + 16 * dt) = make_uint2(pack2(o[dt][0] * inv, o[dt][1] * inv), pack2(o[dt][2] * inv, o[dt][3] * inv));
        if (fq == 0) part_lse[((size_t)pat * Ttot + tq) * 8 + hh] = m + logf(l);
    }
#undef ATTN_LD1
#undef ATTN_LOAD
#undef ATTN_ST1
#undef ATTN_COMMIT
}

__device__ __forceinline__ void attn_merge_token(const u16* __restrict__ part_o, const float* __restrict__ part_lse, int Ttot, size_t t,
                                                 u16* __restrict__ dst  , int lane) {
    const int hh = lane >> 3;
    const float l0 = part_lse[((size_t)0 * Ttot + t) * 8 + hh], l1 = part_lse[((size_t)1 * Ttot + t) * 8 + hh], l2 = part_lse[((size_t)2 * Ttot + t) * 8 + hh];
    const float mx = fmaxf(l0, fmaxf(l1, l2));
    const float e0 = __expf(l0 - mx), e1 = __expf(l1 - mx), e2 = __expf(l2 - mx);
    const float inv = 1.f / (e0 + e1 + e2);
    const float w[3] = {e0 * inv, e1 * inv, e2 * inv};
    float acc[16];
#pragma unroll
    for (int i = 0; i < 16; ++i) acc[i] = 0.f;
#pragma unroll
    for (int p = 0; p < 3; ++p) {
        const uint4* src = (const uint4*)(part_o + ((size_t)p * Ttot + t) * 1024 + lane * 16);
        const uint4 a = src[0], bb = src[1];
        acc[0] += w[p] * lo2f(a.x); acc[1] += w[p] * hi2f(a.x); acc[2] += w[p] * lo2f(a.y); acc[3] += w[p] * hi2f(a.y);
        acc[4] += w[p] * lo2f(a.z); acc[5] += w[p] * hi2f(a.z); acc[6] += w[p] * lo2f(a.w); acc[7] += w[p] * hi2f(a.w);
        acc[8] += w[p] * lo2f(bb.x); acc[9] += w[p] * hi2f(bb.x); acc[10] += w[p] * lo2f(bb.y); acc[11] += w[p] * hi2f(bb.y);
        acc[12] += w[p] * lo2f(bb.z); acc[13] += w[p] * hi2f(bb.z); acc[14] += w[p] * lo2f(bb.w); acc[15] += w[p] * hi2f(bb.w);
    }
    uint4* d = (uint4*)(dst + lane * 16);
    d[0] = make_uint4(pack2(acc[0], acc[1]), pack2(acc[2], acc[3]), pack2(acc[4], acc[5]), pack2(acc[6], acc[7]));
    d[1] = make_uint4(pack2(acc[8], acc[9]), pack2(acc[10], acc[11]), pack2(acc[12], acc[13]), pack2(acc[14], acc[15]));
}

__device__ __forceinline__ void phase_mixers(const Args& a, unsigned char* lds) {
    const int bi = blockIdx.x, G = gridDim.x;
    if (bi < 64) {
        gla_seq_item((const u16*)(a.ws + WS_P), NP, C_GV, S, a.ws + WS_QD, a.ws + WS_KE, a.ws + WS_AT, (const float*)(a.ws + WS_DEC),
                     (u16*)(a.ws + WS_OFB), T, lds, bi);
    } else {
        u16* part_o = (u16*)a.out; float* part_lse = (float*)((unsigned char*)a.out + (size_t)3 * T * 1024 * 2);
        attn_phase((const u16*)(a.ws + WS_P), NP, C_DQ, C_DK, C_DV, S, part_o, part_lse, T, lds, bi - 64, G - 64, 3 * 4 * 8 * (S / 128));
    }
}

__device__ __forceinline__ void phase_gla_fin(const Args& a) {
    const u16* Of = (const u16*)(a.ws + WS_OFB);
    const u16* Ob = Of + (size_t)T * 1024;
    const u16* P = (const u16*)(a.ws + WS_P);
    u16* A2 = (u16*)(a.ws + WS_ACT);
    const u16* part_o = (const u16*)a.out; const float* part_lse = (const float*)((const unsigned char*)a.out + (size_t)3 * T * 1024 * 2);
    const int lane = threadIdx.x & 63, wave = threadIdx.x >> 6;
    const int gw = blockIdx.x * NWAVES + wave, NGW = gridDim.x * NWAVES;
    const int hh = lane >> 4;
    float gg[16];
#pragma unroll
    for (int k = 0; k < 4; ++k) { const float4 g4 = *(const float4*)(a.g_gla + lane * 16 + 4 * k); gg[4 * k] = g4.x; gg[4 * k + 1] = g4.y; gg[4 * k + 2] = g4.z; gg[4 * k + 3] = g4.w; }
    for (int t = gw; t < T; t += NGW) {
        const uint4* fp = (const uint4*)(Of + (size_t)t * 1024 + lane * 16); const uint4* bp = (const uint4*)(Ob + (size_t)t * 1024 + lane * 16);
        const uint4* rp = (const uint4*)(P + (size_t)t * NP + C_GR + lane * 16);
#define NT16(p_) ({ const f32x4 q_ = __builtin_nontemporal_load((const f32x4*)(p_)); make_uint4(__float_as_uint(q_[0]), __float_as_uint(q_[1]), __float_as_uint(q_[2]), __float_as_uint(q_[3])); })
        const uint4 f0 = NT16(fp), f1 = NT16(fp + 1), b0 = NT16(bp), b1 = NT16(bp + 1), r0 = NT16(rp), r1 = NT16(rp + 1);
#undef NT16
        attn_merge_token(part_o, part_lse, T, (size_t)t, A2 + (size_t)t * D + 1024, lane);
        const unsigned fw[8] = {f0.x, f0.y, f0.z, f0.w, f1.x, f1.y, f1.z, f1.w}, bw[8] = {b0.x, b0.y, b0.z, b0.w, b1.x, b1.y, b1.z, b1.w};
        const unsigned rw[8] = {r0.x, r0.y, r0.z, r0.w, r1.x, r1.y, r1.z, r1.w};
        float o[16]; float ss = 0.f;
#pragma unroll
        for (int k = 0; k < 8; ++k) { o[2 * k] = lo2f(fw[k]) + lo2f(bw[k]); o[2 * k + 1] = hi2f(fw[k]) + hi2f(bw[k]); ss += o[2 * k] * o[2 * k] + o[2 * k + 1] * o[2 * k + 1]; }
        ss += __shfl_xor(ss, 1); ss += __shfl_xor(ss, 2); ss += __shfl_xor(ss, 4); ss += __shfl_xor(ss, 8);
        const float rstd = rsqrtf(ss * (1.f / 256.f) + NORM_EPS);
        unsigned y[8];
#pragma unroll
        for (int k = 0; k < 8; ++k) y[k] = pack2(o[2 * k] * rstd * gg[2 * k] * silu_f(lo2f(rw[k])), o[2 * k + 1] * rstd * gg[2 * k + 1] * silu_f(hi2f(rw[k])));
        uint4* dp = (uint4*)(A2 + (size_t)t * D + lane * 16);
        dp[0] = make_uint4(y[0], y[1], y[2], y[3]); dp[1] = make_uint4(y[4], y[5], y[6], y[7]);
    }
    (void)hh;
}

typedef float f32x16 __attribute__((ext_vector_type(16)));
#define RT_CE(a_, b_) do { const float hi_ = fmaxf(a_, b_), lo_ = fminf(a_, b_); a_ = hi_; b_ = lo_; } while (0)
template <int N> __device__ __forceinline__ void rt_sort_desc(float (&v)[N], int base) {
#pragma unroll
    for (int k = 2; k <= 16; k <<= 1)
#pragma unroll
        for (int j = k >> 1; j > 0; j >>= 1)
#pragma unroll
            for (int i = 0; i < 16; ++i) {
                const int l = i ^ j;
                if (l > i) { if ((i & k) == 0) RT_CE(v[base + i], v[base + l]); else RT_CE(v[base + l], v[base + i]); }
            }
}
template <int N> __device__ __forceinline__ void rt_merge_desc(float (&v)[N], int a, int b) {
#pragma unroll
    for (int i = 0; i < 16; ++i) v[a + i] = fmaxf(v[a + i], v[b + 15 - i]);
#pragma unroll
    for (int j = 8; j > 0; j >>= 1)
#pragma unroll
        for (int i = 0; i < 16; ++i) { const int l = i ^ j; if (l > i) RT_CE(v[a + i], v[a + l]); }
}

__device__ __forceinline__ void route_stage_keys(const float* __restrict__ subk, int hh, unsigned char* lds) {
    const int tid = TID;
    __syncthreads();
    for (int e = tid; e < 2 * 128 * 16; e += 512) {
        const int c = e & 15, row = e >> 4;
        const float* src = subk + ((size_t)(hh * 2) * 128 + row) * 128 + c * 8;
        const float4 v0 = *(const float4*)src, v1 = *(const float4*)(src + 4);
        *(uint4*)(lds + row * 256 + ((c ^ (row & 15)) << 4)) = make_uint4(pack2(v0.x, v0.y), pack2(v0.z, v0.w), pack2(v1.x, v1.y), pack2(v1.z, v1.w));
    }
    __syncthreads();
}

__device__ __forceinline__ void route_tile(const u16* __restrict__ Q, int ldq, int hh, int tok_base, const unsigned char* lds,
                                           int* __restrict__ IDX, float* __restrict__ GATE) {
    const int lane = TID & 63, r = lane & 31, h = lane >> 5;
    float sc[128];
    {
        f32x16 X[4], Y[4];
#pragma unroll
        for (int kt = 0; kt < 4; ++kt) {
#pragma unroll
            for (int i = 0; i < 16; ++i) { X[kt][i] = 0.f; Y[kt][i] = 0.f; }
        }
        const u16* qrow = Q + (size_t)(tok_base + r) * ldq + hh * 256;
#pragma unroll
        for (int half = 0; half < 2; ++half) {
            bf16x8 qf[8];
#pragma unroll
            for (int ks = 0; ks < 8; ++ks) qf[ks] = *(const bf16x8*)(qrow + half * 128 + 16 * ks + 8 * h);
#pragma unroll
            for (int kt = 0; kt < 4; ++kt) {
                const int krow = half * 128 + 32 * kt + r;
#pragma unroll
                for (int ks = 0; ks < 8; ++ks) {
                    const bf16x8 kf = *(const bf16x8*)(lds + krow * 256 + (((2 * ks + h) ^ (krow & 15)) << 4));
                    if (half == 0) X[kt] = __builtin_amdgcn_mfma_f32_32x32x16_bf16(kf, qf[ks], X[kt], 0, 0, 0);
                    else Y[kt] = __builtin_amdgcn_mfma_f32_32x32x16_bf16(kf, qf[ks], Y[kt], 0, 0, 0);
                }
            }
        }
#pragma unroll
        for (int kt = 0; kt < 4; ++kt)
#pragma unroll
            for (int i = 0; i < 16; ++i) {
                const auto sw = __builtin_amdgcn_permlane32_swap(__float_as_uint(X[kt][i]), __float_as_uint(Y[kt][i]), false, false);
                const int key0 = 32 * kt + (i & 3) + 8 * (i >> 2);
                sc[kt * 32 + i] = __uint_as_float((sw[0] & 0xffffff80u) | (unsigned)key0);
                sc[kt * 32 + 16 + i] = __uint_as_float((sw[1] & 0xffffff80u) | (unsigned)(key0 + 4));
            }
    }
#pragma unroll
    for (int g = 0; g < 8; ++g) rt_sort_desc(sc, 16 * g);
    rt_merge_desc(sc, 0, 16); rt_merge_desc(sc, 32, 48); rt_merge_desc(sc, 64, 80); rt_merge_desc(sc, 96, 112);
    rt_merge_desc(sc, 0, 32); rt_merge_desc(sc, 64, 96);
    rt_merge_desc(sc, 0, 64);
    float l0[16], l1[16];
#pragma unroll
    for (int i = 0; i < 16; ++i) {
        const auto sw = __builtin_amdgcn_permlane32_swap(__float_as_uint(sc[i]), __float_as_uint(sc[i]), false, false);
        l0[i] = __uint_as_float(sw[0]); l1[i] = __uint_as_float(sw[1]);
    }
    float s0[16], s1[16]; int k0[16], k1[16];
#pragma unroll
    for (int i = 0; i < 16; ++i) {
        const unsigned a = __float_as_uint(l0[i]), b = __float_as_uint(l1[i]);
        s0[i] = __uint_as_float(a & 0xffffff80u); k0[i] = (int)(a & 0x7fu);
        s1[i] = __uint_as_float(b & 0xffffff80u); k1[i] = (int)(b & 0x7fu);
    }
    float cs[64];
    {
        int n = 0;
#pragma unroll
        for (int i = 0; i < 16; ++i)
#pragma unroll
            for (int j = 0; j < 16; ++j)
                if ((i + 1) * (j + 1) <= 16) { cs[n] = s0[i] + s1[j]; ++n; }
#pragma unroll
        for (int q = 50; q < 64; ++q) cs[q] = -3.0e38f;
    }
    float ct[64];
#pragma unroll
    for (int q = 0; q < 64; ++q) ct[q] = cs[q];
#pragma unroll
    for (int g = 0; g < 4; ++g) rt_sort_desc(ct, 16 * g);
    rt_merge_desc(ct, 0, 16); rt_merge_desc(ct, 32, 48); rt_merge_desc(ct, 0, 32);
    const float theta = ct[15], smax = ct[0];
    float den = 0.f;
    {
        int cnt = 0;
#pragma unroll
        for (int q = 0; q < 50; ++q) { const bool sel = (cs[q] >= theta) && (cnt < 16); den += sel ? __expf(cs[q] - smax) : 0.f; cnt += sel ? 1 : 0; }
    }
    const float inv = 1.f / den;
    const size_t obase = (size_t)(tok_base + r) * 128 + hh * 16;
    int pos = 0;
    {
        int n = 0;
#pragma unroll
        for (int i = 0; i < 16; ++i)
#pragma unroll
            for (int j = 0; j < 16; ++j)
                if ((i + 1) * (j + 1) <= 16) {
                    const bool sel = (cs[n] >= theta) && (pos < 16);
                    if (sel) {
                        if (h == 0) IDX[obase + pos] = k0[i] * 128 + k1[j];
                        else GATE[obase + pos] = __expf(cs[n] - smax) * inv;
                        ++pos;
                    }
                    ++n;
                }
    }
}
__device__ __forceinline__ void phase_route(const Args& a, unsigned char* lds) {
    const int hh = BID & 7, grp = BID >> 3, ngrp = GDIM >> 3, wave = TID >> 6;
    route_stage_keys(a.subk, hh, lds);
    int j = 0;
    for (int tile = grp; tile < T / 32; tile += ngrp, ++j)
        if ((j & 7) == wave) route_tile((const u16*)(a.ws + WS_Q), D, hh, tile * 32, lds, (int*)(a.ws + WS_IDX), (float*)(a.ws + WS_GATE));
    __syncthreads();
}

typedef __bf16 bf16x2_t __attribute__((ext_vector_type(2)));
__device__ __forceinline__ float dot2bf(unsigned w, unsigned x, float acc) {
    return __builtin_amdgcn_fdot2_f32_bf16(__builtin_bit_cast(bf16x2_t, w), __builtin_bit_cast(bf16x2_t, x), acc, false);
}
constexpr int TROW = 1024;
typedef float f32x2_t __attribute__((ext_vector_type(2)));
__device__ __forceinline__ void convert_tables(const Args& a) {
    const int lane = threadIdx.x & 63, wave = threadIdx.x >> 6;
    const int gw = blockIdx.x * NWAVES + wave, NGW = gridDim.x * NWAVES;
    for (int row = gw; row < 2 * 16384; row += NGW) {
        const bool isv = row >= 16384; const int e = isv ? row - 16384 : row;
        const f32x4* sp = (const f32x4*)((isv ? a.pv : a.pu) + (size_t)e * D);
        unsigned char* dst = a.ws + (isv ? WS_TV : WS_TU) + (size_t)e * TROW;
        unsigned char* sdst = a.ws + (isv ? WS_SV : WS_SU) + (size_t)e * 128;
        f32x4 v[8];
#pragma unroll
        for (int k = 0; k < 8; ++k) v[k] = __builtin_nontemporal_load(sp + lane + 64 * k);
#pragma unroll
        for (int k = 0; k < 8; ++k) {
            float mx = fmaxf(fmaxf(fabsf(v[k][0]), fabsf(v[k][1])), fmaxf(fabsf(v[k][2]), fabsf(v[k][3])));
            mx = fmaxf(mx, __shfl_xor(mx, 1)); mx = fmaxf(mx, __shfl_xor(mx, 2)); mx = fmaxf(mx, __shfl_xor(mx, 4));
            float s = mx * (isv ? (1.f / 6.f) : (1.f / 7.f)); s = (s > 0.f) ? s : 1.f;
            u16 sb = f2bf(s); if (bf2f(sb) < s) sb += 1;
            const float inv = 1.f / bf2f(sb);
            unsigned p = 0u;
            if (isv) {
                p = __builtin_amdgcn_cvt_scalef32_pk_fp4_f32(p, v[k][0] * inv, v[k][1] * inv, 1.0f, 0);
                p = __builtin_amdgcn_cvt_scalef32_pk_fp4_f32(p, v[k][2] * inv, v[k][3] * inv, 1.0f, 1);
            } else {
#pragma unroll
                for (int j = 0; j < 4; ++j) { int q = (int)rintf(v[k][j] * inv) + 8; q = q < 1 ? 1 : (q > 15 ? 15 : q); p |= (unsigned)q << (4 * j); }
            }
            const int i = lane + 64 * k;
            *(u16*)(dst + 2 * i) = (u16)p;
            if ((lane & 7) == 0) *(u16*)(sdst + 2 * (i >> 3)) = sb;
        }
    }
}

__device__ __forceinline__ int idot32_i4(const uint4 w, const int (&hq)[8]) {
    const unsigned ww[4] = {w.x, w.y, w.z, w.w};
    int acc = 0;
#pragma unroll
    for (int k = 0; k < 4; ++k) {
        acc = __builtin_amdgcn_sdot4((int)(ww[k] & 0x0f0f0f0fu), hq[2 * k], acc, false);
        acc = __builtin_amdgcn_sdot4((int)((ww[k] >> 4) & 0x0f0f0f0fu), hq[2 * k + 1], acc, false);
    }
    return acc;
}
__device__ __forceinline__ void axpy32_fp4(const uint4 w, const float s, float (&acc)[32]) {
    const unsigned ww[4] = {w.x, w.y, w.z, w.w};
#pragma unroll
    for (int k = 0; k < 4; ++k) {
        const f32x2_t a0 = __builtin_amdgcn_cvt_scalef32_pk_f32_fp4(ww[k], 1.0f, 0), a1 = __builtin_amdgcn_cvt_scalef32_pk_f32_fp4(ww[k], 1.0f, 1);
        const f32x2_t a2 = __builtin_amdgcn_cvt_scalef32_pk_f32_fp4(ww[k], 1.0f, 2), a3 = __builtin_amdgcn_cvt_scalef32_pk_f32_fp4(ww[k], 1.0f, 3);
        acc[8 * k + 0] += s * a0.x; acc[8 * k + 1] += s * a0.y; acc[8 * k + 2] += s * a1.x; acc[8 * k + 3] += s * a1.y;
        acc[8 * k + 4] += s * a2.x; acc[8 * k + 5] += s * a2.y; acc[8 * k + 6] += s * a3.x; acc[8 * k + 7] += s * a3.y;
    }
}
__device__ __forceinline__ void phase_experts(const Args& a) {
    const u16* H2 = (const u16*)(a.ws + WS_ACT);
    const u16* X1 = (const u16*)(a.ws + WS_X1);
    const int* IDX = (const int*)(a.ws + WS_IDX);
    const float* GATE = (const float*)(a.ws + WS_GATE);
    const float* mod = (const float*)(a.ws + WS_MOD);
    const unsigned char* U = a.ws + WS_TU; const unsigned char* V = a.ws + WS_TV;
    const int lane = threadIdx.x & 63, wave = threadIdx.x >> 6;
    const int gw = blockIdx.x * NWAVES + wave, NGW = gridDim.x * NWAVES;
    int iv0 = 0, iv1 = 0; float gv0 = 0.f, gv1 = 0.f;
    int niv0 = 0, niv1 = 0; float ngv0 = 0.f, ngv1 = 0.f;
    uint4 rA[4], rB[4]; u16 sA[4], sB[4];
#define ROW_LOAD(TB_, r_, s_, r0_) do { _Pragma("unroll") for (int q = 0; q < 4; ++q) { \
            const int rr_ = (r0_) + q; const int e_ = __builtin_amdgcn_readlane(rr_ < 64 ? iv0 : iv1, rr_ & 63); \
            const unsigned char* rp_ = TB_ + (size_t)e_ * TROW; \
            const unsigned char* sp_ = a.ws + ((TB_ == U) ? WS_SU : WS_SV) + (size_t)e_ * 128; \
            r_[q] = *(const uint4*)(rp_ + lane * 16); s_[q] = *(const u16*)(sp_ + lane * 2); } } while (0)
#define TOK_FETCH(t_, i0_, i1_, g0_, g1_) do { \
            i0_ = IDX[(size_t)(t_) * 128 + lane]; i1_ = IDX[(size_t)(t_) * 128 + 64 + lane]; \
            g0_ = GATE[(size_t)(t_) * 128 + lane]; g1_ = GATE[(size_t)(t_) * 128 + 64 + lane]; } while (0)
    if (gw < T) { TOK_FETCH(gw, iv0, iv1, gv0, gv1); ROW_LOAD(U, rA, sA, 0); }
    for (int t = gw; t < T; t += NGW) {
        const int b = t / S;
        const bool has_next = (t + NGW) < T;
        int hq[8]; int hsum8; float sh;
        {
            float h[32];
            const f32x4* hp = (const f32x4*)(H2 + (size_t)t * D + lane * 32);
#pragma unroll
            for (int k = 0; k < 4; ++k) { const f32x4 pn = __builtin_nontemporal_load(hp + k);
                const uint4 p = make_uint4(__float_as_uint(pn[0]), __float_as_uint(pn[1]), __float_as_uint(pn[2]), __float_as_uint(pn[3]));
                h[8 * k + 0] = lo2f(p.x); h[8 * k + 1] = hi2f(p.x); h[8 * k + 2] = lo2f(p.y); h[8 * k + 3] = hi2f(p.y);
                h[8 * k + 4] = lo2f(p.z); h[8 * k + 5] = hi2f(p.z); h[8 * k + 6] = lo2f(p.w); h[8 * k + 7] = hi2f(p.w); }
            float mx = 0.f;
#pragma unroll
            for (int i = 0; i < 32; ++i) mx = fmaxf(mx, fabsf(h[i]));
            sh = (mx > 0.f) ? mx * (1.f / 127.f) : 1.f;
            const float inv = 1.f / sh;
            int hs = 0;
#pragma unroll
            for (int k = 0; k < 4; ++k)
#pragma unroll
                for (int par = 0; par < 2; ++par) {
                    const int q0 = (int)rintf(h[8 * k + par] * inv), q1 = (int)rintf(h[8 * k + 2 + par] * inv), q2 = (int)rintf(h[8 * k + 4 + par] * inv), q3 = (int)rintf(h[8 * k + 6 + par] * inv);
                    hs += q0 + q1 + q2 + q3;
                    hq[2 * k + par] = (q0 & 0xff) | ((q1 & 0xff) << 8) | ((q2 & 0xff) << 16) | ((int)((unsigned)(q3 & 0xff) << 24));
                }
            hsum8 = 8 * hs;
        }
        float a0 = 0.f, a1 = 0.f;
#define U_COMPUTE(r_, s_, r0_) do { float d_[4]; \
            _Pragma("unroll") for (int q = 0; q < 4; ++q) d_[q] = (float)(idot32_i4(r_[q], hq) - hsum8) * (bf2f(s_[q]) * sh); \
            _Pragma("unroll") for (int o = 32; o > 0; o >>= 1) { _Pragma("unroll") for (int q = 0; q < 4; ++q) d_[q] += __shfl_xor(d_[q], o); } \
            _Pragma("unroll") for (int q = 0; q < 4; ++q) { const int rr_ = (r0_) + q; \
                if (rr_ < 64) a0 = (lane == rr_) ? d_[q] : a0; else a1 = (lane == rr_ - 64) ? d_[q] : a1; } } while (0)
#pragma unroll 1
        for (int r0 = 0; r0 < 128; r0 += 8) {
            ROW_LOAD(U, rB, sB, r0 + 4);
            U_COMPUTE(rA, sA, r0);
            if (r0 + 8 < 128) ROW_LOAD(U, rA, sA, r0 + 8); else ROW_LOAD(V, rA, sA, 0);
            U_COMPUTE(rB, sB, r0 + 4);
        }
        const float w0 = gv0 * gelu_f(a0), w1 = gv1 * gelu_f(a1);
        float acc[32];
#pragma unroll
        for (int i = 0; i < 32; ++i) acc[i] = 0.f;
#define V_COMPUTE(r_, s_, r0_) do { _Pragma("unroll") for (int q = 0; q < 4; ++q) { const int rr_ = (r0_) + q; \
                const float g_ = __builtin_bit_cast(float, __builtin_amdgcn_readlane(__builtin_bit_cast(int, rr_ < 64 ? w0 : w1), rr_ & 63)); \
                axpy32_fp4(r_[q], g_ * bf2f(s_[q]), acc); } } while (0)
        if (has_next) TOK_FETCH(t + NGW, niv0, niv1, ngv0, ngv1);
#pragma unroll 1
        for (int r0 = 0; r0 < 128; r0 += 8) {
            ROW_LOAD(V, rB, sB, r0 + 4);
            V_COMPUTE(rA, sA, r0);
            if (r0 + 8 < 128) ROW_LOAD(V, rA, sA, r0 + 8);
            else if (has_next) { iv0 = niv0; iv1 = niv1; gv0 = ngv0; gv1 = ngv1; ROW_LOAD(U, rA, sA, 0); }
            V_COMPUTE(rB, sB, r0 + 4);
        }
#undef U_COMPUTE
#undef V_COMPUTE
        float ss = 0.f;
#pragma unroll
        for (int k = 0; k < 8; ++k) {
            const int c0 = lane * 32 + 4 * k;
            const hw_f32x2 xn = __builtin_nontemporal_load((const hw_f32x2*)(X1 + (size_t)t * D + c0));
            const uint2 xp = make_uint2(__float_as_uint(xn[0]), __float_as_uint(xn[1]));
            const float4 xa = make_float4(lo2f(xp.x), hi2f(xp.x), lo2f(xp.y), hi2f(xp.y));
            const float4 ga = *(const float4*)(mod + b * 12288 + 5 * 2048 + c0);
            acc[4 * k + 0] = xa.x + ga.x * acc[4 * k + 0]; acc[4 * k + 1] = xa.y + ga.y * acc[4 * k + 1];
            acc[4 * k + 2] = xa.z + ga.z * acc[4 * k + 2]; acc[4 * k + 3] = xa.w + ga.w * acc[4 * k + 3];
#pragma unroll
            for (int i = 0; i < 4; ++i) ss += acc[4 * k + i] * acc[4 * k + i];
        }
        ss = wave_sum(ss);
        const float rstd = rsqrtf(ss * (1.f / D) + NORM_EPS);
#pragma unroll
        for (int k = 0; k < 8; ++k) {
            const int c0 = lane * 32 + 4 * k;
            const float4 gf = *(const float4*)(a.g_fin + c0);
            *(float4*)(a.out + (size_t)t * D + c0) = make_float4(acc[4 * k + 0] * rstd * gf.x, acc[4 * k + 1] * rstd * gf.y, acc[4 * k + 2] * rstd * gf.z, acc[4 * k + 3] * rstd * gf.w);
        }
    }
#undef ROW_LOAD
#undef TOK_FETCH
}

#define XB_TMO      128
#define XB_XCNT(j)  (256  + 64 * (j))
#define XB_XSUB(j)  (1280 + 64 * (j))
#define XB_XGEN(j)  (2304 + 64 * (j))
#define XB_TOP      3328
#define XB_TOPGEN   3392
#define XCD_BAR_WORDS 3456
#define XB_SPIN_CAP (1u << 18)

__device__ __forceinline__ unsigned xb_ld(unsigned* p)              { return __hip_atomic_load(p, __ATOMIC_RELAXED, __HIP_MEMORY_SCOPE_AGENT); }
__device__ __forceinline__ unsigned xb_add(unsigned* p, unsigned v) { return __hip_atomic_fetch_add(p, v, __ATOMIC_RELAXED, __HIP_MEMORY_SCOPE_AGENT); }
__device__ __forceinline__ unsigned xb_xcc_id() { return (unsigned)__builtin_amdgcn_s_getreg((3 << 11) | 20) & 0xFu; }
#define XB_SPIN(cond, bar) do { unsigned _sp = 0; while (cond) { __builtin_amdgcn_s_sleep(1); \
    if ((++_sp & 255u) == 0u) { if (xb_ld(&(bar)[XB_TMO])) break; if (_sp > XB_SPIN_CAP) { atomicAdd(&(bar)[XB_TMO], 1u); break; } } } } while (0)

struct XcdBarrier {
    unsigned* bar; unsigned x;
    volatile LAS unsigned* st;
};

__device__ __forceinline__ XcdBarrier xcd_barrier_post(unsigned* bar, volatile LAS unsigned* st) {
    XcdBarrier b; b.bar = bar; b.x = xb_xcc_id(); b.st = st;
    if (threadIdx.x == 0) (void)xb_add(&bar[XB_XCNT(b.x)], 1u);
    return b;
}
__device__ __forceinline__ void xcd_barrier_complete(unsigned* bar, unsigned x, unsigned& nloc, unsigned& nx) {
    const unsigned G = gridDim.x * gridDim.y * gridDim.z;
    unsigned sum, cnt, mine, sp = 0u;
    for (;;) {
        sum = 0u; cnt = 0u; mine = 0u;
#pragma unroll
        for (unsigned j = 0; j < 16; ++j) { const unsigned c = xb_ld(&bar[XB_XCNT(j)]); sum += c; cnt += (c > 0u) ? 1u : 0u; mine = (j == x) ? c : mine; }
        if (sum == G) break;
        __builtin_amdgcn_s_sleep(1);
        if ((++sp & 255u) == 0u) { if (xb_ld(&bar[XB_TMO])) break; if (sp > XB_SPIN_CAP) { atomicAdd(&bar[XB_TMO], 1u); break; } }
    }
    nloc = mine > 0u ? mine : 1u; nx = cnt > 0u ? cnt : 1u;
}

__device__ __forceinline__ void xcd_barrier(const XcdBarrier& b) {
    asm volatile("s_waitcnt vmcnt(0)" ::: "memory");
    __syncthreads();
    if (threadIdx.x == 0) {
        unsigned* bar = b.bar;
        __builtin_amdgcn_s_waitcnt(0);
        unsigned nloc = b.st[0], nx = b.st[1];
        if (nloc == 0u) { xcd_barrier_complete(bar, b.x, nloc, nx); b.st[0] = nloc; b.st[1] = nx; }
        const unsigned old = xb_add(&bar[XB_XSUB(b.x)], 1u);
        const unsigned gen = old / nloc;
        if (old + 1u == (gen + 1u) * nloc) {
            __builtin_amdgcn_fence(__ATOMIC_RELEASE, "agent");
            asm volatile("s_waitcnt vmcnt(0)" ::: "memory");
            const unsigned og = xb_add(&bar[XB_TOP], 1u);
            const unsigned tg = og / nx;
            if (og + 1u == (tg + 1u) * nx) xb_add(&bar[XB_TOPGEN], 1u);
            else XB_SPIN(xb_ld(&bar[XB_TOPGEN]) == tg, bar);
            __builtin_amdgcn_fence(__ATOMIC_ACQUIRE, "agent");
            xb_add(&bar[XB_XGEN(b.x)], 1u);
            asm volatile("s_waitcnt vmcnt(0)" ::: "memory");
        } else {
            XB_SPIN(xb_ld(&bar[XB_XGEN(b.x)]) == gen, bar);
            __builtin_amdgcn_fence(__ATOMIC_ACQUIRE, "agent");
            asm volatile("s_waitcnt vmcnt(0)" ::: "memory");
        }
    }
    __syncthreads();
}

constexpr int NPHASES = 11;
__global__ void __launch_bounds__(NTHREADS, 2) mk_fwd(Args a) {
    extern __shared__ __attribute__((aligned(16))) unsigned char lds[];
    cg::grid_group grid = cg::this_grid();
    const int lo = a.ph_lo, hi = a.ph_hi;
    volatile LAS unsigned* xbw = (volatile LAS unsigned*)(lds + LDS_MAIN);
    if (threadIdx.x < 4) xbw[threadIdx.x] = 0u;
    __syncthreads();
    XcdBarrier xbar = xcd_barrier_post((unsigned*)(a.ws + WS_CTL), xbw);
#define IN(k) (lo <= (k) && (k) < hi)
    if (lo < 0) grid.sync();
#define SEAM(k) do { if (IN(k) && IN((k) + 1)) xcd_barrier(xbar); } while (0)
    const float* mod = (const float*)(a.ws + WS_MOD);
    if (IN(0)) phase0(a, lds);
    SEAM(0);
    if (IN(1)) norm_mod_phase<false>(a.x, a.g_mix, mod, 0, 1, (u16*)(a.ws + WS_ACT));
    SEAM(1);
    if (IN(2)) { gemm8(lds, (const u16*)(a.ws + WS_ACT), (const u16*)(a.ws + WS_WIN), T, NP, D, EpiProj{(u16*)(a.ws + WS_P), (const float*)(a.ws + WS_CS)}); gz_phase(lds, (const u16*)(a.ws + WS_ACT), (const u16*)(a.ws + WS_WIN) + (size_t)NP * D, (float*)(a.ws + WS_GZ)); }
    SEAM(2);
    if (IN(3)) phase_rope_prep(a, lds);
    SEAM(3);
    if (IN(4)) phase_mixers(a, lds);
    SEAM(4);
    if (IN(5)) phase_gla_fin(a);
    SEAM(5);
    if (IN(6)) gemm8(lds, (const u16*)(a.ws + WS_ACT), (const u16*)(a.ws + WS_WOUT), T, D, D, EpiResid{a.x, mod, (u16*)(a.ws + WS_X1)});
    SEAM(6);
    if (IN(7)) { norm_mod_phase<true>(a.ws + WS_X1, a.g_ffn, mod, 3, 4, (u16*)(a.ws + WS_ACT)); convert_tables(a); }
    SEAM(7);
    if (IN(8)) gemm8(lds, (const u16*)(a.ws + WS_ACT), (const u16*)(a.ws + WS_WPQ), T, D, D, EpiBf16{(u16*)(a.ws + WS_Q)});
    SEAM(8);
    if (IN(9)) phase_route(a, lds);
    SEAM(9);
    if (IN(10)) phase_experts(a);
#ifdef PROBE_REP10
    grid.sync(); phase_experts(a);
#endif
#ifdef PROBE_REP9
    grid.sync(); phase_route(a, lds); grid.sync(); phase_experts(a);
#endif
#undef IN
#undef SEAM
}

#ifndef MK_ONE_LAUNCH
#define MK_ONE_LAUNCH 1
#endif
extern "C" void kernel_launch(void* const* d_in, const int* in_sizes, int n_in, void* d_out, int out_size, void* d_ws, size_t ws_size, hipStream_t stream) {
    static int grid = 0;
    if (grid == 0) {
        if (n_in != 19 || out_size != T * D || ws_size < WS_END) {
            fprintf(stderr, "kernel_launch: unexpected shapes: n_in %d out %d ws %zu (need %zu)\n", n_in, out_size, ws_size, (size_t)WS_END);
            grid = -1; return;
        }
        int dev = 0, cus = 0, per_cu = 0;
        (void)hipGetDevice(&dev);
        (void)hipDeviceGetAttribute(&cus, hipDeviceAttributeMultiprocessorCount, dev);
        (void)hipFuncSetAttribute((const void*)mk_fwd, hipFuncAttributeMaxDynamicSharedMemorySize, LDS_BYTES);
        (void)hipOccupancyMaxActiveBlocksPerMultiprocessor(&per_cu, (const void*)mk_fwd, NTHREADS, LDS_BYTES);
        if (per_cu < 1) { fprintf(stderr, "kernel_launch: occupancy query says %d blocks/CU\n", per_cu); grid = -1; return; }
        grid = cus;
        (void)hipGetLastError();
    }
    if (grid < 0) return;
    Args a{};
    a.x = (const float*)d_in[0]; a.c = (const float*)d_in[1]; a.pos = (const int*)d_in[2]; a.w_ada = (const float*)d_in[3];
    a.b_ada = (const float*)d_in[4]; a.g_mix = (const float*)d_in[5]; a.w_in = (const float*)d_in[6]; a.wgf = (const float*)d_in[7];
    a.bgf = (const float*)d_in[8]; a.wgb = (const float*)d_in[9]; a.bgb = (const float*)d_in[10]; a.g_gla = (const float*)d_in[11];
    a.w_out = (const float*)d_in[12]; a.g_ffn = (const float*)d_in[13]; a.w_pq = (const float*)d_in[14]; a.subk = (const float*)d_in[15];
    a.pu = (const float*)d_in[16]; a.pv = (const float*)d_in[17]; a.g_fin = (const float*)d_in[18];
    a.out = (float*)d_out; a.ws = (unsigned char*)d_ws;
#if MK_ONE_LAUNCH
    (void)hipMemsetAsync((unsigned char*)d_ws + WS_CTL, 0, XCD_BAR_WORDS * 4, stream);
    a.ph_lo = 0; a.ph_hi = NPHASES;
    void* args[] = {&a};
    hipError_t e = hipLaunchCooperativeKernel((const void*)mk_fwd, dim3(grid), dim3(NTHREADS), args, LDS_BYTES, stream);
    if (e != hipSuccess) fprintf(stderr, "cooperative launch failed: %s (grid %d)\n", hipGetErrorString(e), grid);
#else
    for (int p = 0; p < NPHASES; ++p) {
        a.ph_lo = p; a.ph_hi = p + 1;
        hipLaunchKernelGGL(mk_fwd, dim3(grid), dim3(NTHREADS), LDS_BYTES, stream, a);
    }
#endif
}
```

```cpp
#include <hip/hip_runtime.h>
#include <hip/hip_cooperative_groups.h>
#include <cstdio>
#include <cstdint>

namespace cg = cooperative_groups;

typedef unsigned short u16;
typedef __attribute__((ext_vector_type(8))) short bf16x8;
typedef __attribute__((ext_vector_type(4))) float f32x4;
typedef short s16x4 __attribute__((ext_vector_type(4)));
#define TID ((int)threadIdx.x)
#define BID ((int)blockIdx.x)
#define GDIM ((int)gridDim.x)
#define LAS __attribute__((address_space(3)))

constexpr int D = 2048, NB = 4, S = 4096, T = NB * S;
constexpr int INW = 6176;
constexpr int NP = 6144;
constexpr int NPAD = 6208;
constexpr int C_GQ = 0, C_GK = 512, C_GV = 1024, C_GR = 2048, C_DQ = 3072, C_DK = 4096, C_DV = 5120;
constexpr int NTHREADS = 512, NWAVES = 8;
constexpr int LDS_MAIN = 128 * 1024;
constexpr int LDS_BYTES = LDS_MAIN + 16;
constexpr float NORM_EPS = 1e-6f;

constexpr size_t WS_CTL = 0;
constexpr size_t WS_MOD = 65536;
constexpr size_t WS_CS = 524288;
constexpr size_t WS_WIN = WS_CS + (size_t)T * 64 * 8;
constexpr size_t WS_WOUT = WS_WIN + (size_t)NPAD * D * 2;
constexpr size_t WS_WPQ = WS_WOUT + (size_t)D * D * 2;
constexpr size_t WS_ACT = WS_WPQ + (size_t)D * D * 2;
constexpr size_t WS_P = WS_ACT + (size_t)T * D * 2;
constexpr size_t WS_X1 = WS_P;
constexpr size_t WS_Q = WS_P + (size_t)T * D * 4;
constexpr size_t WS_GZ = WS_P + (size_t)T * NP * 2;
constexpr int GLA_NPREP = NB * 4 * 2 * (S / 64);
constexpr size_t WS_QD = WS_GZ + (size_t)T * 32 * 4;
constexpr size_t WS_KE = WS_QD + (size_t)GLA_NPREP * 16384;
constexpr size_t WS_AT = WS_KE + (size_t)GLA_NPREP * 16384;
constexpr size_t WS_DEC = WS_AT + (size_t)GLA_NPREP * 8192;
constexpr size_t WS_OFB = WS_DEC + (size_t)GLA_NPREP * 512;
constexpr size_t WS_IDX = WS_OFB + (size_t)2 * T * 1024 * 2;
constexpr size_t WS_GATE = WS_IDX + (size_t)T * 128 * 4;
constexpr size_t WS_END = WS_GATE + (size_t)T * 128 * 4;
constexpr size_t WS_TU = WS_QD;
constexpr size_t WS_TV = WS_TU + (size_t)16384 * 1024;
constexpr size_t WS_SU = WS_TV + (size_t)16384 * 1024;
constexpr size_t WS_SV = WS_SU + (size_t)16384 * 128;
static_assert(WS_SV + (size_t)16384 * 128 <= WS_IDX, "table region");

struct Args {
    const float* x; const float* c; const int* pos; const float* w_ada; const float* b_ada; const float* g_mix;
    const float* w_in; const float* wgf; const float* bgf; const float* wgb; const float* bgb; const float* g_gla;
    const float* w_out; const float* g_ffn; const float* w_pq; const float* subk; const float* pu; const float* pv; const float* g_fin;
    float* out; unsigned char* ws; int ph_lo, ph_hi;
};

__device__ __forceinline__ float bf2f(u16 h) { return __uint_as_float(((unsigned)h) << 16); }
typedef __bf16 hw_bf16x2 __attribute__((ext_vector_type(2)));
typedef float hw_f32x2 __attribute__((ext_vector_type(2)));
__device__ __forceinline__ unsigned pack2(float a, float b) { const hw_f32x2 f = {a, b}; return __builtin_bit_cast(unsigned, __builtin_convertvector(f, hw_bf16x2)); }
__device__ __forceinline__ u16 f2bf(float f) { return (u16)(pack2(f, 0.f) & 0xffffu); }
__device__ __forceinline__ float lo2f(unsigned p) { return __uint_as_float(p << 16); }
__device__ __forceinline__ float hi2f(unsigned p) { return __uint_as_float(p & 0xffff0000u); }
__device__ __forceinline__ float wave_sum(float v) {
#pragma unroll
    for (int o = 32; o > 0; o >>= 1) v += __shfl_xor(v, o);
    return v;
}
__device__ __forceinline__ float wave_max(float v) {
#pragma unroll
    for (int o = 32; o > 0; o >>= 1) v = fmaxf(v, __shfl_xor(v, o));
    return v;
}
__device__ __forceinline__ float silu_f(float v) { return v / (1.f + __expf(-v)); }
__device__ __forceinline__ float gelu_f(float a) { return 0.5f * a * (1.f + erff(a * 0.70710678118654752f)); }
__device__ __forceinline__ float logsigmoid_f(float z) { return z < 0.f ? z - log1pf(expf(z)) : -log1pf(expf(-z)); }

constexpr int MOD_BLOCKS = 96;
__device__ __forceinline__ void p0_mod(const Args& a, unsigned char* lds, int bi) {
    float* sc = (float*)lds;
    float* red = sc + 4 * 2048;
    const int tid = threadIdx.x, lane = tid & 63, wave = tid >> 6;
    for (int i = tid; i < 4 * 2048; i += NTHREADS) sc[i] = silu_f(a.c[i]);
    __syncthreads();
    const int j0 = bi * 128 + lane * 2;
    float acc[4][2];
#pragma unroll
    for (int b = 0; b < 4; ++b) { acc[b][0] = 0.f; acc[b][1] = 0.f; }
    const int k0 = wave * 256;
#pragma unroll 8
    for (int kk = 0; kk < 256; ++kk) {
        const int k = k0 + kk;
        const hw_f32x2 wv_ = __builtin_nontemporal_load((const hw_f32x2*)(a.w_ada + (size_t)k * 12288 + j0)); const float2 w = make_float2(wv_[0], wv_[1]);
#pragma unroll
        for (int b = 0; b < 4; ++b) { const float s = sc[b * 2048 + k]; acc[b][0] += s * w.x; acc[b][1] += s * w.y; }
    }
#pragma unroll
    for (int b = 0; b < 4; ++b) { red[(wave * 4 + b) * 128 + lane * 2] = acc[b][0]; red[(wave * 4 + b) * 128 + lane * 2 + 1] = acc[b][1]; }
    __syncthreads();
    float* mod = (float*)(a.ws + WS_MOD);
    {
        const int b = tid >> 7, jc = tid & 127;
        float s = 0.f;
#pragma unroll
        for (int w = 0; w < 8; ++w) s += red[(w * 4 + b) * 128 + jc];
        mod[b * 12288 + bi * 128 + jc] = s + a.b_ada[bi * 128 + jc];
    }
    __syncthreads();
}

__device__ __forceinline__ void p0_transpose_item(const float* __restrict__ W, int ldw, int k0, int src_col0, int n_valid,
                                                  u16* __restrict__ WT, int ldt, int n_out0, unsigned char* wlds, bool rope_perm = false) {
    u16* tl = (u16*)wlds;
    const int lane = threadIdx.x & 63;
    const int rsub = lane >> 4, nc = (lane & 15) * 4;
    int scol = src_col0 + nc;
    if (rope_perm) { const int p = (n_out0 & 64) + nc, g = p >> 3; scol = (src_col0 - (n_out0 & 64)) + ((p & 4) ? 64 + 4 * g : 4 * g); }
    float4 v[16];
#pragma unroll
    for (int j = 0; j < 16; ++j) {
        const int k = 4 * j + rsub;
        if (nc < n_valid) { const f32x4 q_ = __builtin_nontemporal_load((const f32x4*)(W + (size_t)(k0 + k) * ldw + scol)); v[j] = make_float4(q_[0], q_[1], q_[2], q_[3]); }
        else v[j] = make_float4(0.f, 0.f, 0.f, 0.f);
    }
#pragma unroll
    for (int j = 0; j < 16; ++j) {
        const int k = 4 * j + rsub;
        tl[(nc + 0) * 72 + k] = f2bf(v[j].x); tl[(nc + 1) * 72 + k] = f2bf(v[j].y); tl[(nc + 2) * 72 + k] = f2bf(v[j].z); tl[(nc + 3) * 72 + k] = f2bf(v[j].w);
    }
#pragma unroll
    for (int j = 0; j < 8; ++j) {
        const int c = lane + 64 * j, n = c >> 3, kc = (c & 7) * 8;
        const uint4 o = *(const uint4*)(tl + n * 72 + kc);
        *(uint4*)(WT + (size_t)(n_out0 + n) * ldt + k0 + kc) = o;
    }
}

__device__ __forceinline__ void phase0(const Args& a, unsigned char* lds) {
    const int bi = blockIdx.x, G = gridDim.x, tid = threadIdx.x, wave = tid >> 6;
    const bool modblk = (G > MOD_BLOCKS) && (bi < MOD_BLOCKS);
    if (G > MOD_BLOCKS) { if (modblk) p0_mod(a, lds, bi); }
    else { for (int mb = bi; mb < MOD_BLOCKS; mb += G) p0_mod(a, lds, mb); }
    const int nb = (G > MOD_BLOCKS) ? G - MOD_BLOCKS : G, b0 = (G > MOD_BLOCKS) ? bi - MOD_BLOCKS : bi;
    if (!modblk) {
        constexpr int I_IN = 32 * (NPAD / 64), I_SQ = 32 * 32;
        u16* WinT = (u16*)(a.ws + WS_WIN); u16* WoutT = (u16*)(a.ws + WS_WOUT); u16* WpqT = (u16*)(a.ws + WS_WPQ);
        unsigned char* wlds = lds + wave * 9216;
        for (int it = b0 * NWAVES + wave; it < I_IN + 2 * I_SQ; it += nb * NWAVES) {
            if (it < I_IN) {
                const int kt = it & 31, nt = it >> 5;
                const int n0 = nt * 64;
                int src, nv;
                if (n0 < 3072) { src = n0; nv = 64; }
                else if (n0 < 6144) { src = n0 + 32; nv = 64; }
                else if (n0 == 6144) { src = 3072; nv = 32; }
                else { src = 0; nv = 0; }
                p0_transpose_item(a.w_in, INW, kt * 64, src, nv, WinT, D, n0, wlds, n0 >= C_DQ && n0 < C_DV);
            } else if (it < I_IN + I_SQ) {
                const int r = it - I_IN; const int kt = r & 31, nt = r >> 5;
                p0_transpose_item(a.w_out, D, kt * 64, nt * 64, 64, WoutT, D, nt * 64, wlds);
            } else {
                const int r = it - I_IN - I_SQ; const int kt = r & 31, nt = r >> 5;
                p0_transpose_item(a.w_pq, D, kt * 64, nt * 64, 64, WpqT, D, nt * 64, wlds);
            }
        }
        float2* cs = (float2*)(a.ws + WS_CS);
        for (int i = b0 * NTHREADS + tid; i < T * 64; i += nb * NTHREADS) {
            const int t = i >> 6, f = i & 63;
            const float inv_freq = powf(10000.0f, -(float)f * 2.0f / 128.0f);
            const float ang = (float)a.pos[t] * inv_freq;
            const double rev = (double)ang * 0.15915494309189533577;
            const float fr = (float)(rev - floor(rev));
            cs[i] = make_float2(__builtin_amdgcn_cosf(fr), __builtin_amdgcn_sinf(fr));
        }
    }
    __syncthreads();
}

template <bool BF16IN> __device__ __forceinline__ void norm_mod_phase(const void* __restrict__ xin_, const float* __restrict__ g, const float* __restrict__ mod,
                                               int sh_chunk, int sc_chunk, u16* __restrict__ outp) {
    const int lane = threadIdx.x & 63, wave = threadIdx.x >> 6;
    const int gw = blockIdx.x * NWAVES + wave, NGW = gridDim.x * NWAVES;
    float4 v[8], vn[8];
#define NM_LOAD(dst_, t_) do { if (BF16IN) { const hw_f32x2* xr_ = (const hw_f32x2*)((const u16*)xin_ + (size_t)(t_) * D); \
            _Pragma("unroll") for (int m = 0; m < 8; ++m) { const hw_f32x2 q_ = __builtin_nontemporal_load(xr_ + lane + 64 * m); const unsigned px_ = __float_as_uint(q_[0]), py_ = __float_as_uint(q_[1]); \
                dst_[m] = make_float4(lo2f(px_), hi2f(px_), lo2f(py_), hi2f(py_)); } } \
        else { const f32x4* xr_ = (const f32x4*)((const float*)xin_ + (size_t)(t_) * D); \
            _Pragma("unroll") for (int m = 0; m < 8; ++m) { const f32x4 q_ = __builtin_nontemporal_load(xr_ + lane + 64 * m); dst_[m] = make_float4(q_[0], q_[1], q_[2], q_[3]); } } } while (0)
    if (gw < T) NM_LOAD(v, gw);
    for (int t = gw; t < T; t += NGW) {
        const int b = t / S;
        if (t + NGW < T) NM_LOAD(vn, t + NGW);
        float ss = 0.f;
#pragma unroll
        for (int m = 0; m < 8; ++m) ss += v[m].x * v[m].x + v[m].y * v[m].y + v[m].z * v[m].z + v[m].w * v[m].w;
        ss = wave_sum(ss);
        const float rstd = rsqrtf(ss * (1.f / D) + NORM_EPS);
        const float4* gp = (const float4*)g;
        const float4* shp = (const float4*)(mod + b * 12288 + sh_chunk * 2048);
        const float4* scp = (const float4*)(mod + b * 12288 + sc_chunk * 2048);
        uint2* op = (uint2*)(outp + (size_t)t * D);
#pragma unroll
        for (int m = 0; m < 8; ++m) {
            const int i = lane + 64 * m;
            const float4 gg = gp[i], sh = shp[i], sc = scp[i];
            const float h0 = v[m].x * rstd * gg.x * (1.f + sc.x) + sh.x;
            const float h1 = v[m].y * rstd * gg.y * (1.f + sc.y) + sh.y;
            const float h2 = v[m].z * rstd * gg.z * (1.f + sc.z) + sh.z;
            const float h3 = v[m].w * rstd * gg.w * (1.f + sc.w) + sh.w;
            op[i] = make_uint2(pack2(h0, h1), pack2(h2, h3));
        }
#pragma unroll
        for (int m = 0; m < 8; ++m) v[m] = vn[m];
    }
#undef NM_LOAD
}

namespace pg8 {
#define PG8_LAS __attribute__((address_space(3)))
typedef unsigned short bf16_t;
typedef short bf16x8 __attribute__((ext_vector_type(8)));
typedef float f32x4 __attribute__((ext_vector_type(4)));
typedef unsigned u32x4 __attribute__((ext_vector_type(4)));
constexpr int BM = 256, BK = 64, HALF = 128, HTB = HALF * BK * 2  , STAGE_BYTES = 8 * HTB, NXCD = 8, WGM = 8;

__host__ __device__ __forceinline__ int lds_byte(int r, int c) { const int st = (r >> 4) * 2 + (c >> 5), rr = r & 15, cc = c & 31, ob = rr * 64 + cc * 2; return st * 1024 + (ob ^ (((ob >> 9) & 1) << 5)); }
__host__ __device__ __forceinline__ void stage_rc(int b, int& R, int& C) { const int st = b / 1024, sb = b % 1024, swz = sb ^ (((sb >> 9) & 1) << 5); R = (st >> 1) * 16 + swz / 64; C = (st & 1) * 32 + (swz % 64) / 2; }
__host__ __device__ __forceinline__ int perm32(int rho) { const int n = rho >> 4, i = rho & 15; return 8 * (i >> 2) + 4 * n + (i & 3); }

struct Unit { int pm, pn; };
struct Gemm { const bf16_t* A; const bf16_t* Bt; int M, N, K; };

struct StaticOrder {
    int nM, nN, nwg, G, c;
    __host__ __device__ void init(int M, int N, int G_, int c_) { nM = M / BM; nN = N / BM; nwg = nM * nN; G = G_; c = c_; }
    __host__ __device__ bool next(int i, Unit& u) const {
        const long L = (long)i * G + c; if (L >= nwg) return false;
        int wgid = (int)L; { const int q = nwg / NXCD, r = nwg % NXCD, xcd = wgid % NXCD, off = wgid / NXCD; wgid = (xcd < r ? xcd * (q + 1) : r * (q + 1) + (xcd - r) * q) + off; }
        const int nig = WGM * nN, gid = wgid / nig, fm = gid * WGM, gsz = (nM - fm) < WGM ? (nM - fm) : WGM;
        u.pm = fm + ((wgid % nig) % gsz); u.pn = (wgid % nig) / gsz; return true;
    }
    __device__ __forceinline__ void a_ready(const Unit&) const {}
    __device__ __forceinline__ void done(const Unit&) const {}
};
__device__ __forceinline__ unsigned cvt_pk_bf16(float lo, float hi) { unsigned r; asm volatile("v_cvt_pk_bf16_f32 %0, %1, %2" : "=v"(r) : "v"(lo), "v"(hi)); return r; }
typedef float f32x2 __attribute__((ext_vector_type(2)));
template <class Epi, class Sched, bool STAMP = false>
__device__ __forceinline__ void gemm_phase(PG8_LAS unsigned char* lds, const Gemm g, const Sched& S, const Epi& E, unsigned long long* stamps) {
    const int tid = threadIdx.x, wid = __builtin_amdgcn_readfirstlane(tid >> 6), lane = tid & 63, wr = wid >> 2, wc = wid & 3, fr = lane & 15, fq = lane >> 4;
    const int K = g.K, nt = K / BK;
    int ts_lo = 0, ts_hi = 0, nts = 0; const unsigned long long rt_entry = STAMP ? (unsigned long long)wall_clock64() : 0ull;
#define PG8_STAMP() do { if (STAMP && wid == 0 && nts < 64) { const unsigned long long _c = (unsigned long long)clock64(); \
        ts_lo = (lane == nts) ? (int)(unsigned)_c : ts_lo; ts_hi = (lane == nts) ? (int)(unsigned)(_c >> 32) : ts_hi; ++nts; } } while (0)
    PG8_STAMP();
    unsigned voffA[2], voffB[2];
#pragma unroll
    for (int i = 0; i < 2; ++i) { int R, C; stage_rc(tid * 16 + i * 8192, R, C); const int Rb = Epi::PERM ? ((R & ~31) + perm32(R & 31)) : R;
        voffA[i] = (unsigned)(R * K + C) * 2u; voffB[i] = (unsigned)(Rb * K + C) * 2u; }
    const size_t kstep = (size_t)(BK * 2);
    const size_t hstep = (size_t)HALF * K * 2;
    const size_t tstep = 2 * hstep;
    const unsigned ldsw = (unsigned)wid * 1024u;
    const int aoff = lds_byte(wr * 64 + fr, fq * 8), boff = lds_byte(wc * 32 + fr, fq * 8);
#define PG8_SA(b, h) (((b) * 2 + (h)) * HTB)
#define PG8_SB(b, h) ((4 + (b) * 2 + (h)) * HTB)
#define PG8_STAGE(bufoff, gbase, voff) do { _Pragma("unroll") for (int _i = 0; _i < 2; ++_i) \
        __builtin_amdgcn_global_load_lds((const unsigned*)((const char*)(gbase) + (voff)[_i]), (PG8_LAS unsigned*)(lds + (bufoff) + ldsw + _i * 8192), 16, 0, 0); } while (0)
#define PG8_LDA(dst, b, h) do { _Pragma("unroll") for (int m = 0; m < 4; ++m) _Pragma("unroll") for (int k = 0; k < 2; ++k) dst[m][k] = *(const PG8_LAS bf16x8*)(lds + PG8_SA(b, h) + aoff + m * 2048 + k * 1024); } while (0)
#define PG8_LDB(dst, b, h) do { _Pragma("unroll") for (int n = 0; n < 2; ++n) _Pragma("unroll") for (int k = 0; k < 2; ++k) dst[n][k] = *(const PG8_LAS bf16x8*)(lds + PG8_SB(b, h) + boff + n * 2048 + k * 1024); } while (0)
#define PG8_MMA(ai, bj, At, Bt) do { __builtin_amdgcn_s_setprio(1); _Pragma("unroll") for (int m = 0; m < 4; ++m) _Pragma("unroll") for (int n = 0; n < 2; ++n) _Pragma("unroll") for (int k = 0; k < 2; ++k) \
        acc[ai][bj][m][n] = __builtin_amdgcn_mfma_f32_16x16x32_bf16(Bt[n][k], At[m][k], acc[ai][bj][m][n], 0, 0, 0); __builtin_amdgcn_s_setprio(0); } while (0)
#define PG8_WAIT_V(n) asm volatile("s_waitcnt vmcnt(" #n ")" ::: "memory")
#define PG8_WAIT_L(n) asm volatile("s_waitcnt lgkmcnt(" #n ")" ::: "memory")
#define PG8_BAR __builtin_amdgcn_s_barrier()
#define PG8_SCHED __builtin_amdgcn_sched_barrier(0)
    Unit cur, nxt; int ui = 0;
    if (!S.next(0, cur)) return;
    f32x4 acc[2][2][4][2];
#pragma unroll
    for (int a = 0; a < 2; ++a)
#pragma unroll
        for (int b = 0; b < 2; ++b)
#pragma unroll
            for (int m = 0; m < 4; ++m)
#pragma unroll
                for (int n = 0; n < 2; ++n) acc[a][b][m][n] = (f32x4){0.f, 0.f, 0.f, 0.f};
    bf16x8 At[4][2], B0[2][2], B1[2][2];
    const char* cA = (const char*)g.A + (size_t)cur.pm * tstep; const char* cB = (const char*)g.Bt + (size_t)cur.pn * tstep;
    S.a_ready(cur);
    PG8_STAGE(PG8_SB(0, 0), cB, voffB); PG8_STAGE(PG8_SA(0, 0), cA, voffA); PG8_STAGE(PG8_SB(0, 1), cB + hstep, voffB); PG8_STAGE(PG8_SA(0, 1), cA + hstep, voffA);
    if (wr == 1) PG8_BAR;
    PG8_WAIT_V(4); PG8_BAR;
    PG8_STAGE(PG8_SB(1, 0), cB + kstep, voffB); PG8_STAGE(PG8_SA(1, 0), cA + kstep, voffA); PG8_STAGE(PG8_SB(1, 1), cB + hstep + kstep, voffB);
    PG8_WAIT_V(6); PG8_BAR;
    PG8_STAMP();
    for (;;) {
        const bool has_next = S.next(ui + 1, nxt);
        const char* nA = has_next ? (const char*)g.A + (size_t)nxt.pm * tstep : cA; const char* nB = has_next ? (const char*)g.Bt + (size_t)nxt.pn * tstep : cB;
        for (int t = 0; t < nt; t += 2) {
            const bool last = (t == nt - 2);
            const char* a1 = cA + (size_t)(t + 1) * kstep;
            const char* a2 = last ? nA : cA + (size_t)(t + 2) * kstep; const char* b2 = last ? nB : cB + (size_t)(t + 2) * kstep;
            const char* a3 = a2 + kstep; const char* b3 = b2 + kstep;
            if (last && has_next) S.a_ready(nxt);
            PG8_LDB(B0, 0, 0); PG8_SCHED; PG8_LDA(At, 0, 0); PG8_STAGE(PG8_SA(1, 1), a1 + hstep, voffA);
            PG8_WAIT_L(8); PG8_BAR; PG8_WAIT_L(0); PG8_MMA(0, 0, At, B0); PG8_BAR; PG8_SCHED;
            PG8_LDB(B1, 0, 1); PG8_STAGE(PG8_SB(0, 0), b2, voffB);
            PG8_BAR; PG8_WAIT_L(0); PG8_MMA(0, 1, At, B1); PG8_BAR;
            PG8_LDA(At, 0, 1); PG8_STAGE(PG8_SA(0, 0), a2, voffA);
            PG8_BAR; PG8_WAIT_L(0); PG8_MMA(1, 0, At, B0); PG8_BAR; PG8_SCHED;
            PG8_STAGE(PG8_SB(0, 1), b2 + hstep, voffB);
            PG8_WAIT_V(6); PG8_BAR; PG8_MMA(1, 1, At, B1); PG8_BAR;
            PG8_LDB(B0, 1, 0); PG8_SCHED; PG8_LDA(At, 1, 0); PG8_STAGE(PG8_SA(0, 1), a2 + hstep, voffA);
            PG8_WAIT_L(8); PG8_BAR; PG8_WAIT_L(0); PG8_MMA(0, 0, At, B0); PG8_BAR; PG8_SCHED;
            PG8_LDB(B1, 1, 1); PG8_STAGE(PG8_SB(1, 0), b3, voffB);
            PG8_BAR; PG8_WAIT_L(0); PG8_MMA(0, 1, At, B1); PG8_BAR;
            PG8_LDA(At, 1, 1); PG8_STAGE(PG8_SA(1, 0), a3, voffA);
            PG8_BAR; PG8_WAIT_L(0); PG8_MMA(1, 0, At, B0); PG8_BAR; PG8_SCHED;
            PG8_STAGE(PG8_SB(1, 1), b3 + hstep, voffB);
            PG8_WAIT_V(6); PG8_BAR; PG8_MMA(1, 1, At, B1); PG8_BAR;
        }
        PG8_STAMP();
        if constexpr (!Epi::AFTER_DRAIN) { E(acc, cur, wr, wc, fr, fq); S.done(cur); }
        PG8_STAMP();
        if (!has_next) break;
#pragma unroll
        for (int a = 0; a < 2; ++a)
#pragma unroll
            for (int b = 0; b < 2; ++b)
#pragma unroll
                for (int m = 0; m < 4; ++m)
#pragma unroll
                    for (int n = 0; n < 2; ++n) acc[a][b][m][n] = (f32x4){0.f, 0.f, 0.f, 0.f};
        cur = nxt; cA = nA; cB = nB; ++ui;
    }
    PG8_WAIT_V(0);
    if (wr == 0) PG8_BAR;
    PG8_BAR;
    if constexpr (Epi::AFTER_DRAIN) { E.fused(acc, cur, wr, wc, fr, fq, lds, wid, lane); S.done(cur); }
    PG8_STAMP();
    if (STAMP && wid == 0) { stamps[lane] = lane < nts ? (((unsigned long long)(unsigned)ts_hi << 32) | (unsigned)ts_lo) : 0ull;
        if (lane == 62) stamps[62] = rt_entry; if (lane == 63) stamps[63] = (unsigned long long)wall_clock64(); }
#undef PG8_STAMP
#undef PG8_SA
#undef PG8_SB
#undef PG8_STAGE
#undef PG8_LDA
#undef PG8_LDB
#undef PG8_MMA
#undef PG8_WAIT_V
#undef PG8_WAIT_L
#undef PG8_BAR
#undef PG8_SCHED
}
}

struct EpiProj {
    static constexpr bool PERM = true, AFTER_DRAIN = false;
    u16* P; const float* cs;
    __device__ __forceinline__ void operator()(const pg8::f32x4 (&acc)[2][2][4][2], const pg8::Unit& u, int wr, int wc, int fr, int fq) const {
        const int row0 = u.pm * 256 + wr * 64 + fr;
        const int col0 = u.pn * 256 + wc * 32 + 8 * fq;
        const bool rope = (u.pn >= C_DQ / 256) && (u.pn < C_DV / 256);
#pragma unroll
        for (int ai = 0; ai < 2; ++ai)
#pragma unroll
            for (int m = 0; m < 4; ++m) { const int row = row0 + ai * 128 + m * 16; u16* rowp = P + (size_t)row * NP + col0;
                pg8::f32x4 c01 = (pg8::f32x4){1.f, 0.f, 1.f, 0.f}, c23 = c01;
                if (rope) { const pg8::f32x4* cp = (const pg8::f32x4*)(cs + ((size_t)row * 64 + 4 * (4 * wc + fq)) * 2); c01 = cp[0]; c23 = cp[1]; }
#pragma unroll
                for (int bj = 0; bj < 2; ++bj) { pg8::f32x4 v0 = acc[ai][bj][m][0], v1 = acc[ai][bj][m][1];
                    if (rope) {
                        const pg8::f32x4 cc = {c01[0], c01[2], c23[0], c23[2]}, sn = {c01[1], c01[3], c23[1], c23[3]};
                        const pg8::f32x4 y1 = v0 * cc - v1 * sn, y2 = v0 * sn + v1 * cc; v0 = y1; v1 = y2; }
                    pg8::u32x4 w; w.x = pg8::cvt_pk_bf16(v0[0], v0[1]); w.y = pg8::cvt_pk_bf16(v0[2], v0[3]); w.z = pg8::cvt_pk_bf16(v1[0], v1[1]); w.w = pg8::cvt_pk_bf16(v1[2], v1[3]);
                    *(pg8::u32x4*)(rowp + bj * 128) = w; } }
    }
};
__device__ __forceinline__ void gz_phase(unsigned char* lds, const u16* __restrict__ H1, const u16* __restrict__ Wg, float* __restrict__ gz) {
    const int tid = threadIdx.x, lane = tid & 63, wave = tid >> 6, fr = lane & 15, fq = lane >> 4;
    float* red = (float*)lds;
    for (int rb = blockIdx.x; rb < T / 64; rb += gridDim.x) {
        const int r0 = rb * 64, k0 = wave * 256;
        f32x4 acc[4][2];
#pragma unroll
        for (int m = 0; m < 4; ++m) { acc[m][0] = (f32x4){0.f, 0.f, 0.f, 0.f}; acc[m][1] = (f32x4){0.f, 0.f, 0.f, 0.f}; }
#pragma unroll
        for (int ks = 0; ks < 8; ++ks) {
            bf16x8 af[4], bfr[2];
#pragma unroll
            for (int m = 0; m < 4; ++m) af[m] = *(const bf16x8*)(H1 + (size_t)(r0 + 16 * m + fr) * D + k0 + 32 * ks + 8 * fq);
#pragma unroll
            for (int n = 0; n < 2; ++n) bfr[n] = *(const bf16x8*)(Wg + (size_t)(16 * n + fr) * D + k0 + 32 * ks + 8 * fq);
#pragma unroll
            for (int m = 0; m < 4; ++m)
#pragma unroll
                for (int n = 0; n < 2; ++n) acc[m][n] = __builtin_amdgcn_mfma_f32_16x16x32_bf16(af[m], bfr[n], acc[m][n], 0, 0, 0);
        }
        __syncthreads();
#pragma unroll
        for (int m = 0; m < 4; ++m)
#pragma unroll
            for (int n = 0; n < 2; ++n)
#pragma unroll
                for (int j = 0; j < 4; ++j) red[(wave * 64 + 16 * m + 4 * fq + j) * 32 + 16 * n + fr] = acc[m][n][j];
        __syncthreads();
#pragma unroll
        for (int k = 0; k < 4; ++k) {
            const int e = tid + 512 * k;
            float s = 0.f;
#pragma unroll
            for (int w = 0; w < 8; ++w) s += red[w * 2048 + e];
            gz[(size_t)r0 * 32 + e] = s;
        }
    }
    __syncthreads();
}
struct EpiResid {
    static constexpr bool PERM = true, AFTER_DRAIN = false;
    const float* x; const float* mod; u16* x1;
    __device__ __forceinline__ void operator()(const pg8::f32x4 (&acc)[2][2][4][2], const pg8::Unit& u, int wr, int wc, int fr, int fq) const {
        const int row0 = u.pm * 256 + wr * 64 + fr, col0 = u.pn * 256 + wc * 32 + 8 * fq;
        const int b = (u.pm * 256) / S;
        pg8::f32x4 ga[2][2];
#pragma unroll
        for (int bj = 0; bj < 2; ++bj)
#pragma unroll
            for (int n = 0; n < 2; ++n) ga[bj][n] = *(const pg8::f32x4*)(mod + b * 12288 + 2 * 2048 + col0 + bj * 128 + 4 * n);
#pragma unroll
        for (int ai = 0; ai < 2; ++ai)
#pragma unroll
            for (int m = 0; m < 4; ++m) { const size_t off = (size_t)(row0 + ai * 128 + m * 16) * D + col0;
#pragma unroll
                for (int bj = 0; bj < 2; ++bj) {
                    const pg8::f32x4 x0 = __builtin_nontemporal_load((const pg8::f32x4*)(x + off + bj * 128)), x1v = __builtin_nontemporal_load((const pg8::f32x4*)(x + off + bj * 128 + 4));
                    const pg8::f32x4 v0 = x0 + ga[bj][0] * acc[ai][bj][m][0], v1 = x1v + ga[bj][1] * acc[ai][bj][m][1];
                    pg8::u32x4 w; w.x = pg8::cvt_pk_bf16(v0[0], v0[1]); w.y = pg8::cvt_pk_bf16(v0[2], v0[3]); w.z = pg8::cvt_pk_bf16(v1[0], v1[1]); w.w = pg8::cvt_pk_bf16(v1[2], v1[3]);
                    *(pg8::u32x4*)(x1 + off + bj * 128) = w; } }
    }
};
struct EpiBf16 {
    static constexpr bool PERM = true, AFTER_DRAIN = false;
    u16* Q;
    __device__ __forceinline__ void operator()(const pg8::f32x4 (&acc)[2][2][4][2], const pg8::Unit& u, int wr, int wc, int fr, int fq) const {
        const int row0 = u.pm * 256 + wr * 64 + fr, col0 = u.pn * 256 + wc * 32 + 8 * fq;
#pragma unroll
        for (int ai = 0; ai < 2; ++ai)
#pragma unroll
            for (int m = 0; m < 4; ++m) { u16* rowp = Q + (size_t)(row0 + ai * 128 + m * 16) * D + col0;
#pragma unroll
                for (int bj = 0; bj < 2; ++bj) { const pg8::f32x4 v0 = acc[ai][bj][m][0], v1 = acc[ai][bj][m][1];
                    pg8::u32x4 w; w.x = pg8::cvt_pk_bf16(v0[0], v0[1]); w.y = pg8::cvt_pk_bf16(v0[2], v0[3]); w.z = pg8::cvt_pk_bf16(v1[0], v1[1]); w.w = pg8::cvt_pk_bf16(v1[2], v1[3]);
                    *(pg8::u32x4*)(rowp + bj * 128) = w; } }
    }
};
template <class Epi>
__device__ __forceinline__ void gemm8(unsigned char* lds, const u16* A, const u16* Bt, int M, int N, int K, const Epi& E) {
    pg8::Gemm g{A, Bt, M, N, K}; pg8::StaticOrder So; So.init(M, N, (int)gridDim.x, (int)blockIdx.x);
    pg8::gemm_phase<Epi, pg8::StaticOrder, false>((PG8_LAS unsigned char*)lds, g, So, E, nullptr);
    __syncthreads();
}

#define GLA_QD_BYTES 16384
#define GLA_AT_BYTES 8192
__device__ __forceinline__ float gla_logsigmoid(float z) { return fminf(z, 0.f) - __logf(1.f + __expf(-fabsf(z))); }

__device__ __forceinline__ void gla_prep_item(const u16* __restrict__ P, int ldp, int cq, int ck, const float* __restrict__ gz,
                                              const float* __restrict__ wg_f, const float* __restrict__ bg_f, const float* __restrict__ wg_b, const float* __restrict__ bg_b,
                                              int Sq, unsigned char* __restrict__ QDg, unsigned char* __restrict__ KEg, unsigned char* __restrict__ ATg, float* __restrict__ DECg,
                                              unsigned char* lds, int item) {
    const int nch = Sq / 64;
    const int c = item % nch, dir = (item / nch) & 1, hh = (item / (nch * 2)) & 3, b = item / (nch * 8);
    const int tid = TID, lane = tid & 63, wave = tid >> 6, li = lane & 15, fq = lane >> 4;
    float* gzs = (float*)lds;
    float* segs = gzs + 64 * 16;
    unsigned char* QDs = lds + 8192;
    unsigned char* KIs = QDs + 16384;
    unsigned char* KEs = KIs + 16384;
    float* bmat = (float*)(KEs + 16384);
    const size_t tok0 = (size_t)b * Sq;
    __syncthreads();
    uint4 rq0, rq1, rk0, rk1;
    {
        const int i0 = tid >> 4, i1 = (tid + 512) >> 4, cc = tid & 15;
        const int s0 = dir ? (Sq - 1 - (64 * c + i0)) : (64 * c + i0), s1 = dir ? (Sq - 1 - (64 * c + i1)) : (64 * c + i1);
        rq0 = *(const uint4*)(P + (tok0 + s0) * ldp + cq + hh * 128 + cc * 8); rk0 = *(const uint4*)(P + (tok0 + s0) * ldp + ck + hh * 128 + cc * 8);
        rq1 = *(const uint4*)(P + (tok0 + s1) * ldp + cq + hh * 128 + cc * 8); rk1 = *(const uint4*)(P + (tok0 + s1) * ldp + ck + hh * 128 + cc * 8);
    }
    for (int e = tid; e < 64 * 16; e += 512) {
        const int i = e >> 4, r = e & 15;
        const int s = dir ? (Sq - 1 - (64 * c + i)) : (64 * c + i);
        gzs[e] = gz[(tok0 + s) * 32 + dir * 16 + r];
    }
    const int d = tid & 127, seg = tid >> 7;
    const float* wg = dir ? wg_b : wg_f;
    float wcol[16];
#pragma unroll
    for (int r = 0; r < 16; ++r) wcol[r] = wg[r * 512 + hh * 128 + d];
    const float bias = (dir ? bg_b : bg_f)[hh * 128 + d];
    __syncthreads();
    float run = 0.f;
#pragma unroll
    for (int k = 0; k < 16; ++k) {
        const int i = 16 * seg + k;
        float z = bias;
#pragma unroll
        for (int r = 0; r < 16; ++r) z += gzs[i * 16 + r] * wcol[r];
        run += gla_logsigmoid(z) * (1.f / 16.f);
        bmat[i * 128 + d] = run;
    }
    segs[seg * 128 + d] = run;
    __syncthreads();
    if (seg == 0) {
        const float t0 = segs[d], t1 = segs[128 + d], t2 = segs[256 + d], t3 = segs[384 + d];
        segs[d] = 0.f; segs[128 + d] = t0; segs[256 + d] = t0 + t1; segs[384 + d] = t0 + t1 + t2; segs[512 + d] = t0 + t1 + t2 + t3;
        DECg[(size_t)item * 128 + d] = __expf(t0 + t1 + t2 + t3);
    }
    __syncthreads();
    const float qscale = 0.08838834764831845f;
#pragma unroll
    for (int k = 0; k < 2; ++k) {
        const int id = tid + 512 * k, i = id >> 4, cc = id & 15, d0 = cc * 8, sg = i >> 4;
        const uint4 qv = k ? rq1 : rq0, kv = k ? rk1 : rk0;
        const float qx[8] = {lo2f(qv.x), hi2f(qv.x), lo2f(qv.y), hi2f(qv.y), lo2f(qv.z), hi2f(qv.z), lo2f(qv.w), hi2f(qv.w)};
        const float kx[8] = {lo2f(kv.x), hi2f(kv.x), lo2f(kv.y), hi2f(kv.y), lo2f(kv.z), hi2f(kv.z), lo2f(kv.w), hi2f(kv.w)};
        float qd[8], ki[8], ke[8];
        const float4 bA = *(const float4*)(bmat + i * 128 + d0), bB = *(const float4*)(bmat + i * 128 + d0 + 4);
        const float4 oA = *(const float4*)(segs + sg * 128 + d0), oB = *(const float4*)(segs + sg * 128 + d0 + 4);
        const float4 tA = *(const float4*)(segs + 512 + d0), tB = *(const float4*)(segs + 512 + d0 + 4);
        const float bv[8] = {bA.x + oA.x, bA.y + oA.y, bA.z + oA.z, bA.w + oA.w, bB.x + oB.x, bB.y + oB.y, bB.z + oB.z, bB.w + oB.w};
        const float tv[8] = {tA.x, tA.y, tA.z, tA.w, tB.x, tB.y, tB.z, tB.w};
#pragma unroll
        for (int e = 0; e < 8; ++e) {
            const float bb = bv[e], tot = tv[e];
            qd[e] = qx[e] * qscale * __expf(bb); ki[e] = kx[e] * __expf(-bb); ke[e] = kx[e] * __expf(tot - bb);
        }
        const int o = i * 256 + ((cc ^ (i & 15)) << 4);
        *(uint4*)(QDs + o) = make_uint4(pack2(qd[0], qd[1]), pack2(qd[2], qd[3]), pack2(qd[4], qd[5]), pack2(qd[6], qd[7]));
        *(uint4*)(KIs + o) = make_uint4(pack2(ki[0], ki[1]), pack2(ki[2], ki[3]), pack2(ki[4], ki[5]), pack2(ki[6], ki[7]));
        *(uint4*)(KEs + o) = make_uint4(pack2(ke[0], ke[1]), pack2(ke[2], ke[3]), pack2(ke[4], ke[5]), pack2(ke[6], ke[7]));
    }
    __syncthreads();
    {
        uint4* qo = (uint4*)(QDg + (size_t)item * GLA_QD_BYTES); uint4* ko = (uint4*)(KEg + (size_t)item * GLA_QD_BYTES);
#pragma unroll
        for (int k = 0; k < 2; ++k) { const int e = tid + 512 * k; qo[e] = ((const uint4*)QDs)[e]; ko[e] = ((const uint4*)KEs)[e]; }
    }
#pragma unroll
    for (int tt = 0; tt < 2; ++tt) {
        const int tile = wave + 8 * tt, jt = tile >> 2, it = tile & 3;
        f32x4 acc = (f32x4){0.f, 0.f, 0.f, 0.f};
        if (jt <= it) {
            const int jr = 16 * jt + li, ir = 16 * it + li;
#pragma unroll
            for (int ks = 0; ks < 4; ++ks) {
                const bf16x8 kf = *(const bf16x8*)(KIs + jr * 256 + (((4 * ks + fq) ^ (jr & 15)) << 4));
                const bf16x8 qf = *(const bf16x8*)(QDs + ir * 256 + (((4 * ks + fq) ^ (ir & 15)) << 4));
                acc = __builtin_amdgcn_mfma_f32_16x16x32_bf16(kf, qf, acc, 0, 0, 0);
            }
        }
        const int i = 16 * it + li, j0 = 16 * jt + 4 * fq;
        float v[4];
#pragma unroll
        for (int jj = 0; jj < 4; ++jj) v[jj] = (j0 + jj <= i) ? acc[jj] : 0.f;
        const int chunk = 2 * jt + (fq >> 1), sub = (fq & 1) * 8;
        *(uint2*)(ATg + (size_t)item * GLA_AT_BYTES + i * 128 + ((chunk ^ (i & 7)) << 4) + sub) = make_uint2(pack2(v[0], v[1]), pack2(v[2], v[3]));
    }
}

__device__ __forceinline__ void gla_seq_item(const u16* __restrict__ P, int ldp, int cv, int Sq,
                                             const unsigned char* __restrict__ QDg, const unsigned char* __restrict__ KEg, const unsigned char* __restrict__ ATg, const float* __restrict__ DECg,
                                             u16* __restrict__ Oout  , int Ttot, unsigned char* lds, int item) {
    const int slice = item & 1, dir = (item >> 1) & 1, hh = (item >> 2) & 3, b = item >> 4;
    const int nch = Sq / 64;
    const int tid = TID, lane = tid & 63, wave = tid >> 6, li = lane & 15, fq = lane >> 4;
    const size_t tok0 = (size_t)b * Sq;
    const int pitem0 = ((b * 4 + hh) * 2 + dir) * nch;
    constexpr int BUF = 16384 * 3 + 8192 + 512;
    typedef unsigned gla_u32x4 __attribute__((ext_vector_type(4)));
    gla_u32x4 rq0, rq1, rk0, rk1, rv0, rv1, ra; float rd = 0.f;
#define GLA_VROW(c_, k_) ((tok0 + (size_t)(dir ? (Sq - 1 - (64 * (c_) + ((tid + 512 * (k_)) >> 4))) : (64 * (c_) + ((tid + 512 * (k_)) >> 4)))) * ldp + cv + hh * 256 + slice * 128 + ((tid + 512 * (k_)) & 15) * 8)
#define GLA_ISSUE(c_) do { \
        const gla_u32x4* qsrc_ = (const gla_u32x4*)(QDg + (size_t)(pitem0 + (c_)) * GLA_QD_BYTES); const gla_u32x4* ksrc_ = (const gla_u32x4*)(KEg + (size_t)(pitem0 + (c_)) * GLA_QD_BYTES); \
        rq0 = qsrc_[tid]; rq1 = qsrc_[tid + 512]; rk0 = ksrc_[tid]; rk1 = ksrc_[tid + 512]; \
        ra = ((const gla_u32x4*)(ATg + (size_t)(pitem0 + (c_)) * GLA_AT_BYTES))[tid]; \
        rv0 = *(const gla_u32x4*)(P + GLA_VROW(c_, 0)); rv1 = *(const gla_u32x4*)(P + GLA_VROW(c_, 1)); \
        if (tid < 128) rd = DECg[(size_t)(pitem0 + (c_)) * 128 + tid]; } while (0)
#define GLA_COMMIT(buf_) do { \
        unsigned char* base_ = lds + (buf_) * BUF; \
        ((gla_u32x4*)base_)[tid] = rq0; ((gla_u32x4*)base_)[tid + 512] = rq1; ((gla_u32x4*)(base_ + 16384))[tid] = rk0; ((gla_u32x4*)(base_ + 16384))[tid + 512] = rk1; \
        { const int row_ = tid >> 4, ch_ = tid & 15; *(gla_u32x4*)(base_ + 32768 + row_ * 256 + ((ch_ ^ (row_ & 15)) << 4)) = rv0; } \
        { const int row_ = (tid + 512) >> 4, ch_ = tid & 15; *(gla_u32x4*)(base_ + 32768 + row_ * 256 + ((ch_ ^ (row_ & 15)) << 4)) = rv1; } \
        ((gla_u32x4*)(base_ + 49152))[tid] = ra; \
        if (tid < 128) ((float*)(base_ + 57344))[tid] = rd; } while (0)
    f32x4 st[8];
#pragma unroll
    for (int dt = 0; dt < 8; ++dt) st[dt] = (f32x4){0.f, 0.f, 0.f, 0.f};
    __syncthreads();
    GLA_ISSUE(0); GLA_COMMIT(0);
    __syncthreads();
#pragma unroll 1
    for (int c = 0; c < nch; ++c) {
        const int buf = c & 1;
        if (c + 1 < nch) GLA_ISSUE(c + 1);
        const unsigned char* QDs = lds + buf * BUF; const unsigned char* KEs = QDs + 16384; const unsigned char* Vs = QDs + 32768;
        const unsigned char* ATs = QDs + 49152; const float* DECs = (const float*)(QDs + 57344);
        bf16x8 vf[2];
#pragma unroll
        for (int jp = 0; jp < 2; ++jp) {
            const int rowA = 32 * jp + 8 * fq + (li >> 2), rowB = rowA + 4;
            const int chunk = 2 * wave + ((li & 3) >> 1), sub = ((li & 3) & 1) * 8;
            const s16x4 va = __builtin_amdgcn_ds_read_tr16_b64_v4i16((LAS s16x4*)(Vs + rowA * 256 + ((chunk ^ (rowA & 15)) << 4) + sub));
            const s16x4 vb = __builtin_amdgcn_ds_read_tr16_b64_v4i16((LAS s16x4*)(Vs + rowB * 256 + ((chunk ^ (rowB & 15)) << 4) + sub));
            vf[jp] = __builtin_shufflevector(va, vb, 0, 1, 2, 3, 4, 5, 6, 7);
        }
        bf16x8 sf[4];
#pragma unroll
        for (int dp = 0; dp < 4; ++dp) {
            const gla_u32x4 t_ = {pack2(st[2 * dp][0], st[2 * dp][1]), pack2(st[2 * dp][2], st[2 * dp][3]), pack2(st[2 * dp + 1][0], st[2 * dp + 1][1]), pack2(st[2 * dp + 1][2], st[2 * dp + 1][3])};
            sf[dp] = __builtin_bit_cast(bf16x8, t_);
        }
        f32x4 ot[4];
#pragma unroll
        for (int it = 0; it < 4; ++it) {
            f32x4 acc = (f32x4){0.f, 0.f, 0.f, 0.f};
            const int ir = 16 * it + li;
#pragma unroll
            for (int dp = 0; dp < 4; ++dp) {
                const int c0 = 4 * dp + (fq >> 1), c1 = c0 + 2, sub = (fq & 1) * 8;
                const uint2 lo = *(const uint2*)(QDs + ir * 256 + ((c0 ^ (ir & 15)) << 4) + sub);
                const uint2 hi = *(const uint2*)(QDs + ir * 256 + ((c1 ^ (ir & 15)) << 4) + sub);
                const gla_u32x4 q_ = {lo.x, lo.y, hi.x, hi.y};
                const bf16x8 qf = __builtin_bit_cast(bf16x8, q_);
                acc = __builtin_amdgcn_mfma_f32_16x16x32_bf16(sf[dp], qf, acc, 0, 0, 0);
            }
#pragma unroll
            for (int jp = 0; jp < 2; ++jp) {
                if (32 * jp <= 16 * it + 15) {
                    const bf16x8 af = *(const bf16x8*)(ATs + ir * 128 + (((4 * jp + fq) ^ (ir & 7)) << 4));
                    acc = __builtin_amdgcn_mfma_f32_16x16x32_bf16(vf[jp], af, acc, 0, 0, 0);
                }
            }
            ot[it] = acc;
        }
#pragma unroll
        for (int dt = 0; dt < 8; ++dt) {
            const f32x4 dec = *(const f32x4*)(DECs + 16 * dt + 4 * fq);
            f32x4 acc = st[dt] * dec;
#pragma unroll
            for (int jp = 0; jp < 2; ++jp) {
                const int rowA = 32 * jp + 8 * fq + (li >> 2), rowB = rowA + 4;
                const int chunk = 2 * dt + ((li & 3) >> 1), sub = ((li & 3) & 1) * 8;
                const s16x4 ka = __builtin_amdgcn_ds_read_tr16_b64_v4i16((LAS s16x4*)(KEs + rowA * 256 + ((chunk ^ (rowA & 15)) << 4) + sub));
                const s16x4 kb = __builtin_amdgcn_ds_read_tr16_b64_v4i16((LAS s16x4*)(KEs + rowB * 256 + ((chunk ^ (rowB & 15)) << 4) + sub));
                const bf16x8 kf = __builtin_shufflevector(ka, kb, 0, 1, 2, 3, 4, 5, 6, 7);
                acc = __builtin_amdgcn_mfma_f32_16x16x32_bf16(kf, vf[jp], acc, 0, 0, 0);
            }
            st[dt] = acc;
        }
#pragma unroll
        for (int it = 0; it < 4; ++it) {
            const int i = 16 * it + li;
            const int s = dir ? (Sq - 1 - (64 * c + i)) : (64 * c + i);
            *(uint2*)(Oout + ((size_t)dir * Ttot + tok0 + s) * 1024 + hh * 256 + slice * 128 + 16 * wave + 4 * fq) =
                make_uint2(pack2(ot[it][0], ot[it][1]), pack2(ot[it][2], ot[it][3]));
        }
        if (c + 1 < nch) GLA_COMMIT(buf ^ 1);
        __syncthreads();
    }
}
__device__ __forceinline__ void phase_rope_prep(const Args& a, unsigned char* lds) {
    u16* P = (u16*)(a.ws + WS_P);
    const float2* cs = (const float2*)(a.ws + WS_CS);
    const int gt = blockIdx.x * NTHREADS + threadIdx.x, NT = gridDim.x * NTHREADS;
    for (int item = blockIdx.x; item < GLA_NPREP; item += gridDim.x)
        gla_prep_item(P, NP, C_GQ, C_GK, (const float*)(a.ws + WS_GZ), a.wgf, a.bgf, a.wgb, a.bgb, S,
                      a.ws + WS_QD, a.ws + WS_KE, a.ws + WS_AT, (float*)(a.ws + WS_DEC), lds, item);
}

#define ATTN_DECODE(item_) \
    const int nb_per = Sq / 128; \
    const int within = (item_) % nb_per, hh = ((item_) / nb_per) & 7, b = ((item_) / (nb_per * 8)) & 3, pat = (item_) / (nb_per * 32); \
    const int dil = pat == 0 ? 1 : (pat == 1 ? 4 : 16); \
    const int M = Sq / dil; \
    const int r = within % dil, blk = within / dil; \
    const int p0 = blk * 128, kbase = p0 - 64; \
    const size_t tok0 = (size_t)b * Sq;
typedef unsigned attn_u32x4 __attribute__((ext_vector_type(4)));
__device__ __forceinline__ void attn_phase(const u16* __restrict__ P, int ldp, int cq, int ck, int cv, int Sq,
                                           u16* __restrict__ part_o, float* __restrict__ part_lse, int Ttot,
                                           unsigned char* lds, int first, int stride, int nitems) {
    const int tid = TID, lane = tid & 63, wave = tid >> 6, li = lane & 15, fq = lane >> 4;
    unsigned char* Ks = lds;
    unsigned char* Vs = lds + 65536;
    attn_u32x4 kr0, kr1, kr2, kr3, kr4, kr5, kr6, kr7, vr0, vr1, vr2, vr3, vr4, vr5, vr6, vr7;
    bf16x8 qn0, qn1, qn2, qn3;
#define ATTN_LD1(i_, kreg_, vreg_) { const int id_ = tid + 512 * (i_), row_ = id_ >> 4, c_ = id_ & 15; \
        int kp_ = kbase + row_; kp_ = kp_ < 0 ? 0 : (kp_ > M - 1 ? M - 1 : kp_); \
        const size_t t_ = tok0 + r + (size_t)dil * kp_; \
        kreg_ = *(const attn_u32x4*)(P + t_ * ldp + ck + hh * 128 + c_ * 8); vreg_ = *(const attn_u32x4*)(P + t_ * ldp + cv + hh * 128 + c_ * 8); }
#define ATTN_LOAD(item_) do { ATTN_DECODE(item_) \
        { const size_t tq_ = tok0 + r + (size_t)dil * (p0 + 16 * wave + li); const u16* qp_ = P + tq_ * ldp + cq + hh * 128 + 8 * fq; \
          qn0 = *(const bf16x8*)(qp_); qn1 = *(const bf16x8*)(qp_ + 32); qn2 = *(const bf16x8*)(qp_ + 64); qn3 = *(const bf16x8*)(qp_ + 96); } \
        ATTN_LD1(0, kr0, vr0) ATTN_LD1(1, kr1, vr1) ATTN_LD1(2, kr2, vr2) ATTN_LD1(3, kr3, vr3) ATTN_LD1(4, kr4, vr4) ATTN_LD1(5, kr5, vr5) ATTN_LD1(6, kr6, vr6) ATTN_LD1(7, kr7, vr7) } while (0)
#define ATTN_ST1(i_, kreg_, vreg_) { const int id_ = tid + 512 * (i_), row_ = id_ >> 4, c_ = id_ & 15; const int off_ = row_ * 256 + ((c_ ^ (row_ & 15)) << 4); \
        *(attn_u32x4*)(Ks + off_) = kreg_; *(attn_u32x4*)(Vs + off_) = vreg_; }
#define ATTN_COMMIT() do { ATTN_ST1(0, kr0, vr0) ATTN_ST1(1, kr1, vr1) ATTN_ST1(2, kr2, vr2) ATTN_ST1(3, kr3, vr3) ATTN_ST1(4, kr4, vr4) ATTN_ST1(5, kr5, vr5) ATTN_ST1(6, kr6, vr6) ATTN_ST1(7, kr7, vr7) } while (0)
    int item = first;
    if (item < nitems) ATTN_LOAD(item);
    for (; item < nitems; item += stride) {
        ATTN_DECODE(item)
        __syncthreads();
        ATTN_COMMIT();
        const int qp = p0 + 16 * wave + li;
        const size_t tq = tok0 + r + (size_t)dil * qp;
        const bf16x8 qf[4] = {qn0, qn1, qn2, qn3};
        __syncthreads();
        if (item + stride < nitems) ATTN_LOAD(item + stride);
        const float scale = 0.08838834764831845f;
        float m = -1e30f, l = 0.f;
        f32x4 o[8];
#pragma unroll
        for (int dt = 0; dt < 8; ++dt) o[dt] = (f32x4){0.f, 0.f, 0.f, 0.f};
#pragma unroll 1
        for (int tp = 0; tp < 5; ++tp) {
            float s[8]; bool ok[8];
#pragma unroll
            for (int h2 = 0; h2 < 2; ++h2) {
                const int kk0 = 16 * wave + 16 * (2 * tp + h2);
                int krow = kk0 + li; krow = krow > 255 ? 255 : krow;
                f32x4 acc = (f32x4){0.f, 0.f, 0.f, 0.f};
#pragma unroll
                for (int ks = 0; ks < 4; ++ks) {
                    const bf16x8 kf = *(const bf16x8*)(Ks + krow * 256 + (((4 * ks + fq) ^ (krow & 15)) << 4));
                    acc = __builtin_amdgcn_mfma_f32_16x16x32_bf16(kf, qf[ks], acc, 0, 0, 0);
                }
#pragma unroll
                for (int j = 0; j < 4; ++j) {
                    const int kp = kbase + kk0 + 4 * fq + j;
                    const int rel = kp - qp;
                    ok[4 * h2 + j] = (kp >= 0) && (kp < M) && (rel <= 64) && (rel >= -64);
                    s[4 * h2 + j] = acc[j] * scale;
                }
            }
            float mx = -1e30f;
#pragma unroll
            for (int j = 0; j < 8; ++j) mx = ok[j] ? fmaxf(mx, s[j]) : mx;
            mx = fmaxf(mx, __shfl_xor(mx, 16));
            mx = fmaxf(mx, __shfl_xor(mx, 32));
            const float mn = fmaxf(m, mx);
            const float al = __expf(m - mn);
            float ps = 0.f; float p[8];
#pragma unroll
            for (int j = 0; j < 8; ++j) { p[j] = ok[j] ? __expf(s[j] - mn) : 0.f; ps += p[j]; }
            l = l * al + ps; m = mn;
            const attn_u32x4 p_ = {pack2(p[0], p[1]), pack2(p[2], p[3]), pack2(p[4], p[5]), pack2(p[6], p[7])};
            const bf16x8 pf = __builtin_bit_cast(bf16x8, p_);
#pragma unroll
            for (int dt = 0; dt < 8; ++dt) o[dt] *= al;
            int rowA = 16 * wave + 32 * tp + 4 * fq + (li >> 2); rowA = rowA > 255 ? 255 : rowA;
            int rowB = 16 * wave + 32 * tp + 16 + 4 * fq + (li >> 2); rowB = rowB > 255 ? 255 : rowB;
#pragma unroll
            for (int dt = 0; dt < 8; ++dt) {
                const int chunk = 2 * dt + ((li & 3) >> 1), sub = ((li & 3) & 1) * 8;
                const s16x4 va = __builtin_amdgcn_ds_read_tr16_b64_v4i16((LAS s16x4*)(Vs + rowA * 256 + ((chunk ^ (rowA & 15)) << 4) + sub));
                const s16x4 vb = __builtin_amdgcn_ds_read_tr16_b64_v4i16((LAS s16x4*)(Vs + rowB * 256 + ((chunk ^ (rowB & 15)) << 4) + sub));
                const bf16x8 vf = __builtin_shufflevector(va, vb, 0, 1, 2, 3, 4, 5, 6, 7);
                o[dt] = __builtin_amdgcn_mfma_f32_16x16x32_bf16(vf, pf, o[dt], 0, 0, 0);
            }
        }
        l += __shfl_xor(l, 16);
        l += __shfl_xor(l, 32);
        const float inv = 1.f / l;
        u16* orow = part_o + ((size_t)pat * Ttot + tq) * 1024 + hh * 128 + 4 * fq;
#pragma unroll
        for (int dt = 0; dt < 8; ++dt)
            *(uint2*)(orow + 16 * dt) = make_uint2(pack2(o[dt][0] * inv, o[dt][1] * inv), pack2(o[dt][2] * inv, o[dt][3] * inv));
        if (fq == 0) part_lse[((size_t)pat * Ttot + tq) * 8 + hh] = m + logf(l);
    }
#undef ATTN_LD1
#undef ATTN_LOAD
#undef ATTN_ST1
#undef ATTN_COMMIT
}

__device__ __forceinline__ void attn_merge_token(const u16* __restrict__ part_o, const float* __restrict__ part_lse, int Ttot, size_t t,
                                                 u16* __restrict__ dst  , int lane) {
    const int hh = lane >> 3;
    const float l0 = part_lse[((size_t)0 * Ttot + t) * 8 + hh], l1 = part_lse[((size_t)1 * Ttot + t) * 8 + hh], l2 = part_lse[((size_t)2 * Ttot + t) * 8 + hh];
    const float mx = fmaxf(l0, fmaxf(l1, l2));
    const float e0 = __expf(l0 - mx), e1 = __expf(l1 - mx), e2 = __expf(l2 - mx);
    const float inv = 1.f / (e0 + e1 + e2);
    const float w[3] = {e0 * inv, e1 * inv, e2 * inv};
    float acc[16];
#pragma unroll
    for (int i = 0; i < 16; ++i) acc[i] = 0.f;
#pragma unroll
    for (int p = 0; p < 3; ++p) {
        const uint4* src = (const uint4*)(part_o + ((size_t)p * Ttot + t) * 1024 + lane * 16);
        const uint4 a = src[0], bb = src[1];
        acc[0] += w[p] * lo2f(a.x); acc[1] += w[p] * hi2f(a.x); acc[2] += w[p] * lo2f(a.y); acc[3] += w[p] * hi2f(a.y);
        acc[4] += w[p] * lo2f(a.z); acc[5] += w[p] * hi2f(a.z); acc[6] += w[p] * lo2f(a.w); acc[7] += w[p] * hi2f(a.w);
        acc[8] += w[p] * lo2f(bb.x); acc[9] += w[p] * hi2f(bb.x); acc[10] += w[p] * lo2f(bb.y); acc[11] += w[p] * hi2f(bb.y);
        acc[12] += w[p] * lo2f(bb.z); acc[13] += w[p] * hi2f(bb.z); acc[14] += w[p] * lo2f(bb.w); acc[15] += w[p] * hi2f(bb.w);
    }
    uint4* d = (uint4*)(dst + lane * 16);
    d[0] = make_uint4(pack2(acc[0], acc[1]), pack2(acc[2], acc[3]), pack2(acc[4], acc[5]), pack2(acc[6], acc[7]));
    d[1] = make_uint4(pack2(acc[8], acc[9]), pack2(acc[10], acc[11]), pack2(acc[12], acc[13]), pack2(acc[14], acc[15]));
}

__device__ __forceinline__ void phase_mixers(const Args& a, unsigned char* lds) {
    const int bi = blockIdx.x, G = gridDim.x;
    if (bi < 64) {
        gla_seq_item((const u16*)(a.ws + WS_P), NP, C_GV, S, a.ws + WS_QD, a.ws + WS_KE, a.ws + WS_AT, (const float*)(a.ws + WS_DEC),
                     (u16*)(a.ws + WS_OFB), T, lds, bi);
    } else {
        u16* part_o = (u16*)a.out; float* part_lse = (float*)((unsigned char*)a.out + (size_t)3 * T * 1024 * 2);
        attn_phase((const u16*)(a.ws + WS_P), NP, C_DQ, C_DK, C_DV, S, part_o, part_lse, T, lds, bi - 64, G - 64, 3 * 4 * 8 * (S / 128));
    }
}

__device__ __forceinline__ void phase_gla_fin(const Args& a) {
    const u16* Of = (const u16*)(a.ws + WS_OFB);
    const u16* Ob = Of + (size_t)T * 1024;
    const u16* P = (const u16*)(a.ws + WS_P);
    u16* A2 = (u16*)(a.ws + WS_ACT);
    const u16* part_o = (const u16*)a.out; const float* part_lse = (const float*)((const unsigned char*)a.out + (size_t)3 * T * 1024 * 2);
    const int lane = threadIdx.x & 63, wave = threadIdx.x >> 6;
    const int gw = blockIdx.x * NWAVES + wave, NGW = gridDim.x * NWAVES;
    const int hh = lane >> 4;
    float gg[16];
#pragma unroll
    for (int k = 0; k < 4; ++k) { const float4 g4 = *(const float4*)(a.g_gla + lane * 16 + 4 * k); gg[4 * k] = g4.x; gg[4 * k + 1] = g4.y; gg[4 * k + 2] = g4.z; gg[4 * k + 3] = g4.w; }
    for (int t = gw; t < T; t += NGW) {
        const uint4* fp = (const uint4*)(Of + (size_t)t * 1024 + lane * 16); const uint4* bp = (const uint4*)(Ob + (size_t)t * 1024 + lane * 16);
        const uint4* rp = (const uint4*)(P + (size_t)t * NP + C_GR + lane * 16);
#define NT16(p_) ({ const f32x4 q_ = __builtin_nontemporal_load((const f32x4*)(p_)); make_uint4(__float_as_uint(q_[0]), __float_as_uint(q_[1]), __float_as_uint(q_[2]), __float_as_uint(q_[3])); })
        const uint4 f0 = NT16(fp), f1 = NT16(fp + 1), b0 = NT16(bp), b1 = NT16(bp + 1), r0 = NT16(rp), r1 = NT16(rp + 1);
#undef NT16
        attn_merge_token(part_o, part_lse, T, (size_t)t, A2 + (size_t)t * D + 1024, lane);
        const unsigned fw[8] = {f0.x, f0.y, f0.z, f0.w, f1.x, f1.y, f1.z, f1.w}, bw[8] = {b0.x, b0.y, b0.z, b0.w, b1.x, b1.y, b1.z, b1.w};
        const unsigned rw[8] = {r0.x, r0.y, r0.z, r0.w, r1.x, r1.y, r1.z, r1.w};
        float o[16]; float ss = 0.f;
#pragma unroll
        for (int k = 0; k < 8; ++k) { o[2 * k] = lo2f(fw[k]) + lo2f(bw[k]); o[2 * k + 1] = hi2f(fw[k]) + hi2f(bw[k]); ss += o[2 * k] * o[2 * k] + o[2 * k + 1] * o[2 * k + 1]; }
        ss += __shfl_xor(ss, 1); ss += __shfl_xor(ss, 2); ss += __shfl_xor(ss, 4); ss += __shfl_xor(ss, 8);
        const float rstd = rsqrtf(ss * (1.f / 256.f) + NORM_EPS);
        unsigned y[8];
#pragma unroll
        for (int k = 0; k < 8; ++k) y[k] = pack2(o[2 * k] * rstd * gg[2 * k] * silu_f(lo2f(rw[k])), o[2 * k + 1] * rstd * gg[2 * k + 1] * silu_f(hi2f(rw[k])));
        uint4* dp = (uint4*)(A2 + (size_t)t * D + lane * 16);
        dp[0] = make_uint4(y[0], y[1], y[2], y[3]); dp[1] = make_uint4(y[4], y[5], y[6], y[7]);
    }
    (void)hh;
}

typedef float f32x16 __attribute__((ext_vector_type(16)));
#define RT_CE(a_, b_) do { const float hi_ = fmaxf(a_, b_), lo_ = fminf(a_, b_); a_ = hi_; b_ = lo_; } while (0)
template <int N> __device__ __forceinline__ void rt_sort_desc(float (&v)[N], int base) {
#pragma unroll
    for (int k = 2; k <= 16; k <<= 1)
#pragma unroll
        for (int j = k >> 1; j > 0; j >>= 1)
#pragma unroll
            for (int i = 0; i < 16; ++i) {
                const int l = i ^ j;
                if (l > i) { if ((i & k) == 0) RT_CE(v[base + i], v[base + l]); else RT_CE(v[base + l], v[base + i]); }
            }
}
template <int N> __device__ __forceinline__ void rt_merge_desc(float (&v)[N], int a, int b) {
#pragma unroll
    for (int i = 0; i < 16; ++i) v[a + i] = fmaxf(v[a + i], v[b + 15 - i]);
#pragma unroll
    for (int j = 8; j > 0; j >>= 1)
#pragma unroll
        for (int i = 0; i < 16; ++i) { const int l = i ^ j; if (l > i) RT_CE(v[a + i], v[a + l]); }
}

__device__ __forceinline__ void route_stage_keys(const float* __restrict__ subk, int hh, unsigned char* lds) {
    const int tid = TID;
    __syncthreads();
    for (int e = tid; e < 2 * 128 * 16; e += 512) {
        const int c = e & 15, row = e >> 4;
        const float* src = subk + ((size_t)(hh * 2) * 128 + row) * 128 + c * 8;
        const float4 v0 = *(const float4*)src, v1 = *(const float4*)(src + 4);
        *(uint4*)(lds + row * 256 + ((c ^ (row & 15)) << 4)) = make_uint4(pack2(v0.x, v0.y), pack2(v0.z, v0.w), pack2(v1.x, v1.y), pack2(v1.z, v1.w));
    }
    __syncthreads();
}

__device__ __forceinline__ void route_tile(const u16* __restrict__ Q, int ldq, int hh, int tok_base, const unsigned char* lds,
                                           int* __restrict__ IDX, float* __restrict__ GATE) {
    const int lane = TID & 63, r = lane & 31, h = lane >> 5;
    float sc[128];
    {
        f32x16 X[4], Y[4];
#pragma unroll
        for (int kt = 0; kt < 4; ++kt) {
#pragma unroll
            for (int i = 0; i < 16; ++i) { X[kt][i] = 0.f; Y[kt][i] = 0.f; }
        }
        const u16* qrow = Q + (size_t)(tok_base + r) * ldq + hh * 256;
#pragma unroll
        for (int half = 0; half < 2; ++half) {
            bf16x8 qf[8];
#pragma unroll
            for (int ks = 0; ks < 8; ++ks) qf[ks] = *(const bf16x8*)(qrow + half * 128 + 16 * ks + 8 * h);
#pragma unroll
            for (int kt = 0; kt < 4; ++kt) {
                const int krow = half * 128 + 32 * kt + r;
#pragma unroll
                for (int ks = 0; ks < 8; ++ks) {
                    const bf16x8 kf = *(const bf16x8*)(lds + krow * 256 + (((2 * ks + h) ^ (krow & 15)) << 4));
                    if (half == 0) X[kt] = __builtin_amdgcn_mfma_f32_32x32x16_bf16(kf, qf[ks], X[kt], 0, 0, 0);
                    else Y[kt] = __builtin_amdgcn_mfma_f32_32x32x16_bf16(kf, qf[ks], Y[kt], 0, 0, 0);
                }
            }
        }
#pragma unroll
        for (int kt = 0; kt < 4; ++kt)
#pragma unroll
            for (int i = 0; i < 16; ++i) {
                const auto sw = __builtin_amdgcn_permlane32_swap(__float_as_uint(X[kt][i]), __float_as_uint(Y[kt][i]), false, false);
                const int key0 = 32 * kt + (i & 3) + 8 * (i >> 2);
                sc[kt * 32 + i] = __uint_as_float((sw[0] & 0xffffff80u) | (unsigned)key0);
                sc[kt * 32 + 16 + i] = __uint_as_float((sw[1] & 0xffffff80u) | (unsigned)(key0 + 4));
            }
    }
#pragma unroll
    for (int g = 0; g < 8; ++g) rt_sort_desc(sc, 16 * g);
    rt_merge_desc(sc, 0, 16); rt_merge_desc(sc, 32, 48); rt_merge_desc(sc, 64, 80); rt_merge_desc(sc, 96, 112);
    rt_merge_desc(sc, 0, 32); rt_merge_desc(sc, 64, 96);
    rt_merge_desc(sc, 0, 64);
    float l0[16], l1[16];
#pragma unroll
    for (int i = 0; i < 16; ++i) {
        const auto sw = __builtin_amdgcn_permlane32_swap(__float_as_uint(sc[i]), __float_as_uint(sc[i]), false, false);
        l0[i] = __uint_as_float(sw[0]); l1[i] = __uint_as_float(sw[1]);
    }
    float s0[16], s1[16]; int k0[16], k1[16];
#pragma unroll
    for (int i = 0; i < 16; ++i) {
        const unsigned a = __float_as_uint(l0[i]), b = __float_as_uint(l1[i]);
        s0[i] = __uint_as_float(a & 0xffffff80u); k0[i] = (int)(a & 0x7fu);
        s1[i] = __uint_as_float(b & 0xffffff80u); k1[i] = (int)(b & 0x7fu);
    }
    float cs[64];
    {
        int n = 0;
#pragma unroll
        for (int i = 0; i < 16; ++i)
#pragma unroll
            for (int j = 0; j < 16; ++j)
                if ((i + 1) * (j + 1) <= 16) { cs[n] = s0[i] + s1[j]; ++n; }
#pragma unroll
        for (int q = 50; q < 64; ++q) cs[q] = -3.0e38f;
    }
    float ct[64];
#pragma unroll
    for (int q = 0; q < 64; ++q) ct[q] = cs[q];
#pragma unroll
    for (int g = 0; g < 4; ++g) rt_sort_desc(ct, 16 * g);
    rt_merge_desc(ct, 0, 16); rt_merge_desc(ct, 32, 48); rt_merge_desc(ct, 0, 32);
    const float theta = ct[15], smax = ct[0];
    float den = 0.f;
    {
        int cnt = 0;
#pragma unroll
        for (int q = 0; q < 50; ++q) { const bool sel = (cs[q] >= theta) && (cnt < 16); den += sel ? __expf(cs[q] - smax) : 0.f; cnt += sel ? 1 : 0; }
    }
    const float inv = 1.f / den;
    const size_t obase = (size_t)(tok_base + r) * 128 + hh * 16;
    int pos = 0;
    {
        int n = 0;
#pragma unroll
        for (int i = 0; i < 16; ++i)
#pragma unroll
            for (int j = 0; j < 16; ++j)
                if ((i + 1) * (j + 1) <= 16) {
                    const bool sel = (cs[n] >= theta) && (pos < 16);
                    if (sel) {
                        if (h == 0) IDX[obase + pos] = k0[i] * 128 + k1[j];
                        else GATE[obase + pos] = __expf(cs[n] - smax) * inv;
                        ++pos;
                    }
                    ++n;
                }
    }
}
__device__ __forceinline__ void phase_route(const Args& a, unsigned char* lds) {
    const int hh = BID & 7, grp = BID >> 3, ngrp = GDIM >> 3, wave = TID >> 6;
    route_stage_keys(a.subk, hh, lds);
    int j = 0;
    for (int tile = grp; tile < T / 32; tile += ngrp, ++j)
        if ((j & 7) == wave) route_tile((const u16*)(a.ws + WS_Q), D, hh, tile * 32, lds, (int*)(a.ws + WS_IDX), (float*)(a.ws + WS_GATE));
    __syncthreads();
}

typedef __bf16 bf16x2_t __attribute__((ext_vector_type(2)));
__device__ __forceinline__ float dot2bf(unsigned w, unsigned x, float acc) {
    return __builtin_amdgcn_fdot2_f32_bf16(__builtin_bit_cast(bf16x2_t, w), __builtin_bit_cast(bf16x2_t, x), acc, false);
}
constexpr int TROW = 1024;
typedef float f32x2_t __attribute__((ext_vector_type(2)));
typedef int i32x8 __attribute__((ext_vector_type(8)));
__device__ __forceinline__ void convert_tables(const Args& a) {
    const int lane = threadIdx.x & 63, wave = threadIdx.x >> 6;
    const int gw = blockIdx.x * NWAVES + wave, NGW = gridDim.x * NWAVES;
    for (int row = gw; row < 2 * 16384; row += NGW) {
        const bool isv = row >= 16384; const int e = isv ? row - 16384 : row;
        const f32x4* sp = (const f32x4*)((isv ? a.pv : a.pu) + (size_t)e * D);
        unsigned char* dst = a.ws + (isv ? WS_TV : WS_TU) + (size_t)e * TROW;
        unsigned char* sdst = a.ws + (isv ? WS_SV : WS_SU) + (size_t)e * (isv ? 128 : 64);
        f32x4 v[8];
#pragma unroll
        for (int k = 0; k < 8; ++k) v[k] = __builtin_nontemporal_load(sp + lane + 64 * k);
#pragma unroll
        for (int k = 0; k < 8; ++k) {
            float mx = fmaxf(fmaxf(fabsf(v[k][0]), fabsf(v[k][1])), fmaxf(fabsf(v[k][2]), fabsf(v[k][3])));
            mx = fmaxf(mx, __shfl_xor(mx, 1)); mx = fmaxf(mx, __shfl_xor(mx, 2)); mx = fmaxf(mx, __shfl_xor(mx, 4));
            float inv; u16 sb;
            if (isv) {
                float s = mx * (1.f / 6.f); s = (s > 0.f) ? s : 1.f;
                sb = f2bf(s); if (bf2f(sb) < s) sb += 1;
                inv = 1.f / bf2f(sb);
            } else {
                const unsigned bits = __float_as_uint(mx);
                int kx = (int)(bits >> 23) - 127 - 2 + (((bits & 0x7fffffu) > 0x400000u) ? 1 : 0);
                kx = kx < -126 ? -126 : kx;
                sb = (u16)(kx + 127);
                inv = __uint_as_float((unsigned)(127 - kx) << 23);
            }
            unsigned p = 0u;
            p = __builtin_amdgcn_cvt_scalef32_pk_fp4_f32(p, v[k][0] * inv, v[k][1] * inv, 1.0f, 0);
            p = __builtin_amdgcn_cvt_scalef32_pk_fp4_f32(p, v[k][2] * inv, v[k][3] * inv, 1.0f, 1);
            const int i = lane + 64 * k;
            *(u16*)(dst + 2 * i) = (u16)p;
            if ((lane & 7) == 0) {
                const int blk = i >> 3;
                if (isv) *(u16*)(sdst + 2 * blk) = sb; else sdst[2 * (blk & 31) + (blk >> 5)] = (unsigned char)sb;
            }
        }
    }
}

__device__ __forceinline__ void axpy32_fp4(const uint4 w, const float s, float (&acc)[32]) {
    const unsigned ww[4] = {w.x, w.y, w.z, w.w};
#pragma unroll
    for (int k = 0; k < 4; ++k) {
        const f32x2_t a0 = __builtin_amdgcn_cvt_scalef32_pk_f32_fp4(ww[k], 1.0f, 0), a1 = __builtin_amdgcn_cvt_scalef32_pk_f32_fp4(ww[k], 1.0f, 1);
        const f32x2_t a2 = __builtin_amdgcn_cvt_scalef32_pk_f32_fp4(ww[k], 1.0f, 2), a3 = __builtin_amdgcn_cvt_scalef32_pk_f32_fp4(ww[k], 1.0f, 3);
        acc[8 * k + 0] += s * a0.x; acc[8 * k + 1] += s * a0.y; acc[8 * k + 2] += s * a1.x; acc[8 * k + 3] += s * a1.y;
        acc[8 * k + 4] += s * a2.x; acc[8 * k + 5] += s * a2.y; acc[8 * k + 6] += s * a3.x; acc[8 * k + 7] += s * a3.y;
    }
}
__device__ __forceinline__ void phase_experts(const Args& a) {
    const u16* H2 = (const u16*)(a.ws + WS_ACT);
    const u16* X1 = (const u16*)(a.ws + WS_X1);
    const int* IDX = (const int*)(a.ws + WS_IDX);
    const float* GATE = (const float*)(a.ws + WS_GATE);
    const float* mod = (const float*)(a.ws + WS_MOD);
    const unsigned char* U = a.ws + WS_TU; const unsigned char* V = a.ws + WS_TV;
    const int lane = threadIdx.x & 63, wave = threadIdx.x >> 6;
    const int gw = blockIdx.x * NWAVES + wave, NGW = gridDim.x * NWAVES;
    int iv0 = 0, iv1 = 0; float gv0 = 0.f, gv1 = 0.f;
    int niv0 = 0, niv1 = 0; float ngv0 = 0.f, ngv1 = 0.f;
    uint4 rA[4], rB[4]; u16 sA[4], sB[4];
    const int mrow = lane & 15, kg = lane >> 4, ee2 = mrow >> 3;
    const int loff = 128 * kg + 16 * (mrow & 7), soff = 2 * (8 * kg + (mrow & 7));
    const bool dvalid = ((mrow >> 3) == (kg & 1)); const int jsel = (mrow >> 1) & 3; const bool js1 = jsel == 1, js2 = jsel == 2, js3 = jsel == 3;
    uint4 uA[4], uB[4]; u16 usA[2], usB[2];
#define UP_LOAD(r_, s_, p0_) do { _Pragma("unroll") for (int q = 0; q < 2; ++q) { \
            const int pp_ = (p0_) + q; const int e0_ = __builtin_amdgcn_readlane(iv0, pp_), e1_ = __builtin_amdgcn_readlane(iv1, pp_); const int e_ = ee2 ? e1_ : e0_; \
            const unsigned char* rp_ = U + (size_t)e_ * TROW + loff; \
            r_[2 * q] = *(const uint4*)rp_; r_[2 * q + 1] = *(const uint4*)(rp_ + 512); \
            s_[q] = *(const u16*)(a.ws + WS_SU + (size_t)e_ * 64 + soff); } } while (0)
#define ROW_LOAD(TB_, r_, s_, r0_) do { _Pragma("unroll") for (int q = 0; q < 4; ++q) { \
            const int rr_ = (r0_) + q; const int e_ = __builtin_amdgcn_readlane(rr_ < 64 ? iv0 : iv1, rr_ & 63); \
            const unsigned char* rp_ = TB_ + (size_t)e_ * TROW; \
            const unsigned char* sp_ = a.ws + WS_SV + (size_t)e_ * 128; \
            r_[q] = *(const uint4*)(rp_ + lane * 16); s_[q] = *(const u16*)(sp_ + lane * 2); } } while (0)
#define TOK_FETCH(t_, i0_, i1_, g0_, g1_) do { \
            i0_ = IDX[(size_t)(t_) * 128 + lane]; i1_ = IDX[(size_t)(t_) * 128 + 64 + lane]; \
            g0_ = GATE[(size_t)(t_) * 128 + lane]; g1_ = GATE[(size_t)(t_) * 128 + 64 + lane]; } while (0)
    if (gw < T) { TOK_FETCH(gw, iv0, iv1, gv0, gv1); UP_LOAD(uA, usA, 0); }
    for (int t = gw; t < T; t += NGW) {
        const int b = t / S;
        const bool has_next = (t + NGW) < T;
        int kxt;
        {
            const f32x4* hp_ = (const f32x4*)(H2 + (size_t)t * D + 32 * lane); float mx_ = 0.f;
#pragma unroll
            for (int k = 0; k < 4; ++k) { const f32x4 pn = hp_[k];
                const uint4 p = make_uint4(__float_as_uint(pn[0]), __float_as_uint(pn[1]), __float_as_uint(pn[2]), __float_as_uint(pn[3]));
                mx_ = fmaxf(mx_, fmaxf(fmaxf(fmaxf(fabsf(lo2f(p.x)), fabsf(hi2f(p.x))), fmaxf(fabsf(lo2f(p.y)), fabsf(hi2f(p.y)))), fmaxf(fmaxf(fabsf(lo2f(p.z)), fabsf(hi2f(p.z))), fmaxf(fabsf(lo2f(p.w)), fabsf(hi2f(p.w)))))); }
#pragma unroll
            for (int o = 32; o > 0; o >>= 1) mx_ = fmaxf(mx_, __shfl_xor(mx_, o));
            const unsigned bits_ = __float_as_uint(mx_);
            kxt = (int)(bits_ >> 23) - 127 - 8 + (((bits_ & 0x7fffffu) > 0x600000u) ? 1 : 0); kxt = kxt < -100 ? -100 : kxt;
        }
        const float hinvt = __uint_as_float((unsigned)(127 - kxt) << 23);
        const int sbt = 127 + kxt - ((lane & 1) ? 4 : 0);
#define H_BUILD(HB_, s_, KOF_) do { \
            _Pragma("unroll") for (int i = 0; i < 8; ++i) { \
                const int k_ = KOF_(4 * i); const u16* hq_ = H2 + (size_t)t * D + 1024 * (s_) + 256 * (k_ >> 5) + 32 * (mrow >> 1) + (k_ & 31); \
                const uint2 pr_ = *(const uint2*)hq_; \
                const float x0_ = lo2f(pr_.x) * hinvt, x1_ = hi2f(pr_.x) * hinvt, x2_ = lo2f(pr_.y) * hinvt, x3_ = hi2f(pr_.y) * hinvt; \
                int w_ = __builtin_amdgcn_cvt_pk_fp8_f32(x0_, x1_, 0, false); w_ = __builtin_amdgcn_cvt_pk_fp8_f32(x2_, x3_, w_, true); \
                const f32x2_t d0_ = __builtin_amdgcn_cvt_pk_f32_fp8(w_, false), d1_ = __builtin_amdgcn_cvt_pk_f32_fp8(w_, true); \
                int l_ = __builtin_amdgcn_cvt_pk_fp8_f32((x0_ - d0_[0]) * 16.f, (x1_ - d0_[1]) * 16.f, 0, false); \
                l_ = __builtin_amdgcn_cvt_pk_fp8_f32((x2_ - d1_[0]) * 16.f, (x3_ - d1_[1]) * 16.f, l_, true); \
                HB_[i] = (lane & 1) ? l_ : w_; } } while (0)
#define KOF_H2(b_) (((b_) < 16) ? (16 * kg + (b_)) : (64 + 16 * kg + (b_) - 16))
        i32x8 hB0, hB1;
        H_BUILD(hB0, 0, KOF_H2); H_BUILD(hB1, 1, KOF_H2);
#undef H_BUILD
        float a0 = 0.f, a1 = 0.f;
#define DPP_ADD(v_, ctrl_) v_ += __builtin_bit_cast(float, __builtin_amdgcn_update_dpp(0, __builtin_bit_cast(int, v_), ctrl_, 0xf, 0xf, true))
#define UP_COMPUTE(r_, s_, p0_) do { float v_[2]; \
            _Pragma("unroll") for (int q = 0; q < 2; ++q) { \
                const i32x8 A0_ = {(int)r_[2 * q].x, (int)r_[2 * q].y, (int)r_[2 * q].z, (int)r_[2 * q].w, 0, 0, 0, 0}; \
                const i32x8 A1_ = {(int)r_[2 * q + 1].x, (int)r_[2 * q + 1].y, (int)r_[2 * q + 1].z, (int)r_[2 * q + 1].w, 0, 0, 0, 0}; \
                f32x4 c_ = {0.f, 0.f, 0.f, 0.f}; \
                c_ = __builtin_amdgcn_mfma_scale_f32_16x16x128_f8f6f4(A0_, hB0, c_, 4, 0, 0, (int)s_[q], 0, sbt); \
                c_ = __builtin_amdgcn_mfma_scale_f32_16x16x128_f8f6f4(A1_, hB1, c_, 4, 0, 1, (int)s_[q], 0, sbt); \
                float t_ = c_[0]; t_ = js1 ? c_[1] : t_; t_ = js2 ? c_[2] : t_; t_ = js3 ? c_[3] : t_; v_[q] = dvalid ? t_ : 0.f; } \
            DPP_ADD(v_[0], 0xB1); DPP_ADD(v_[1], 0xB1); DPP_ADD(v_[0], 0x4E); DPP_ADD(v_[1], 0x4E); \
            DPP_ADD(v_[0], 0x141); DPP_ADD(v_[1], 0x141); DPP_ADD(v_[0], 0x140); DPP_ADD(v_[1], 0x140); \
            _Pragma("unroll") for (int q = 0; q < 2; ++q) { const int pp_ = (p0_) + q; \
                const float x0_ = __builtin_bit_cast(float, __builtin_amdgcn_readlane(__builtin_bit_cast(int, v_[q]), 0)) + __builtin_bit_cast(float, __builtin_amdgcn_readlane(__builtin_bit_cast(int, v_[q]), 16)); \
                const float x1_ = __builtin_bit_cast(float, __builtin_amdgcn_readlane(__builtin_bit_cast(int, v_[q]), 32)) + __builtin_bit_cast(float, __builtin_amdgcn_readlane(__builtin_bit_cast(int, v_[q]), 48)); \
                a0 = (lane == pp_) ? x0_ : a0; a1 = (lane == pp_) ? x1_ : a1; } } while (0)
#pragma unroll 1
        for (int p0 = 0; p0 < 64; p0 += 4) {
            UP_LOAD(uB, usB, p0 + 2);
            UP_COMPUTE(uA, usA, p0);
            if (p0 + 4 < 64) UP_LOAD(uA, usA, p0 + 4); else ROW_LOAD(V, rA, sA, 0);
            UP_COMPUTE(uB, usB, p0 + 2);
        }
#undef UP_COMPUTE
#undef DPP_ADD
        const float w0 = gv0 * gelu_f(a0), w1 = gv1 * gelu_f(a1);
        float acc[32];
#pragma unroll
        for (int i = 0; i < 32; ++i) acc[i] = 0.f;
#define V_COMPUTE(r_, s_, r0_) do { _Pragma("unroll") for (int q = 0; q < 4; ++q) { const int rr_ = (r0_) + q; \
                const float g_ = __builtin_bit_cast(float, __builtin_amdgcn_readlane(__builtin_bit_cast(int, rr_ < 64 ? w0 : w1), rr_ & 63)); \
                axpy32_fp4(r_[q], g_ * bf2f(s_[q]), acc); } } while (0)
        if (has_next) TOK_FETCH(t + NGW, niv0, niv1, ngv0, ngv1);
#pragma unroll 1
        for (int r0 = 0; r0 < 128; r0 += 8) {
            ROW_LOAD(V, rB, sB, r0 + 4);
            V_COMPUTE(rA, sA, r0);
            if (r0 + 8 < 128) ROW_LOAD(V, rA, sA, r0 + 8);
            else if (has_next) { iv0 = niv0; iv1 = niv1; gv0 = ngv0; gv1 = ngv1; UP_LOAD(uA, usA, 0); }
            V_COMPUTE(rB, sB, r0 + 4);
        }
#undef V_COMPUTE
        float ss = 0.f;
#pragma unroll
        for (int k = 0; k < 8; ++k) {
            const int c0 = lane * 32 + 4 * k;
            const hw_f32x2 xn = __builtin_nontemporal_load((const hw_f32x2*)(X1 + (size_t)t * D + c0));
            const uint2 xp = make_uint2(__float_as_uint(xn[0]), __float_as_uint(xn[1]));
            const float4 xa = make_float4(lo2f(xp.x), hi2f(xp.x), lo2f(xp.y), hi2f(xp.y));
            const float4 ga = *(const float4*)(mod + b * 12288 + 5 * 2048 + c0);
            acc[4 * k + 0] = xa.x + ga.x * acc[4 * k + 0]; acc[4 * k + 1] = xa.y + ga.y * acc[4 * k + 1];
            acc[4 * k + 2] = xa.z + ga.z * acc[4 * k + 2]; acc[4 * k + 3] = xa.w + ga.w * acc[4 * k + 3];
#pragma unroll
            for (int i = 0; i < 4; ++i) ss += acc[4 * k + i] * acc[4 * k + i];
        }
        ss = wave_sum(ss);
        const float rstd = rsqrtf(ss * (1.f / D) + NORM_EPS);
#pragma unroll
        for (int k = 0; k < 8; ++k) {
            const int c0 = lane * 32 + 4 * k;
            const float4 gf = *(const float4*)(a.g_fin + c0);
            *(float4*)(a.out + (size_t)t * D + c0) = make_float4(acc[4 * k + 0] * rstd * gf.x, acc[4 * k + 1] * rstd * gf.y, acc[4 * k + 2] * rstd * gf.z, acc[4 * k + 3] * rstd * gf.w);
        }
    }
#undef ROW_LOAD
#undef UP_LOAD
#undef TOK_FETCH
}

#define XB_TMO      128
#define XB_XCNT(j)  (256  + 64 * (j))
#define XB_XSUB(j)  (1280 + 64 * (j))
#define XB_XGEN(j)  (2304 + 64 * (j))
#define XB_TOP      3328
#define XB_TOPGEN   3392
#define XCD_BAR_WORDS 3456
#define XB_SPIN_CAP (1u << 18)

__device__ __forceinline__ unsigned xb_ld(unsigned* p)              { return __hip_atomic_load(p, __ATOMIC_RELAXED, __HIP_MEMORY_SCOPE_AGENT); }
__device__ __forceinline__ unsigned xb_add(unsigned* p, unsigned v) { return __hip_atomic_fetch_add(p, v, __ATOMIC_RELAXED, __HIP_MEMORY_SCOPE_AGENT); }
__device__ __forceinline__ unsigned xb_xcc_id() { return (unsigned)__builtin_amdgcn_s_getreg((3 << 11) | 20) & 0xFu; }
#define XB_SPIN(cond, bar) do { unsigned _sp = 0; while (cond) { __builtin_amdgcn_s_sleep(1); \
    if ((++_sp & 255u) == 0u) { if (xb_ld(&(bar)[XB_TMO])) break; if (_sp > XB_SPIN_CAP) { atomicAdd(&(bar)[XB_TMO], 1u); break; } } } } while (0)

struct XcdBarrier {
    unsigned* bar; unsigned x;
    volatile LAS unsigned* st;
};

__device__ __forceinline__ XcdBarrier xcd_barrier_post(unsigned* bar, volatile LAS unsigned* st) {
    XcdBarrier b; b.bar = bar; b.x = xb_xcc_id(); b.st = st;
    if (threadIdx.x == 0) (void)xb_add(&bar[XB_XCNT(b.x)], 1u);
    return b;
}
__device__ __forceinline__ void xcd_barrier_complete(unsigned* bar, unsigned x, unsigned& nloc, unsigned& nx) {
    const unsigned G = gridDim.x * gridDim.y * gridDim.z;
    unsigned sum, cnt, mine, sp = 0u;
    for (;;) {
        sum = 0u; cnt = 0u; mine = 0u;
#pragma unroll
        for (unsigned j = 0; j < 16; ++j) { const unsigned c = xb_ld(&bar[XB_XCNT(j)]); sum += c; cnt += (c > 0u) ? 1u : 0u; mine = (j == x) ? c : mine; }
        if (sum == G) break;
        __builtin_amdgcn_s_sleep(1);
        if ((++sp & 255u) == 0u) { if (xb_ld(&bar[XB_TMO])) break; if (sp > XB_SPIN_CAP) { atomicAdd(&bar[XB_TMO], 1u); break; } }
    }
    nloc = mine > 0u ? mine : 1u; nx = cnt > 0u ? cnt : 1u;
}

__device__ __forceinline__ void xcd_barrier(const XcdBarrier& b) {
    asm volatile("s_waitcnt vmcnt(0)" ::: "memory");
    __syncthreads();
    if (threadIdx.x == 0) {
        unsigned* bar = b.bar;
        __builtin_amdgcn_s_waitcnt(0);
        unsigned nloc = b.st[0], nx = b.st[1];
        if (nloc == 0u) { xcd_barrier_complete(bar, b.x, nloc, nx); b.st[0] = nloc; b.st[1] = nx; }
        const unsigned old = xb_add(&bar[XB_XSUB(b.x)], 1u);
        const unsigned gen = old / nloc;
        if (old + 1u == (gen + 1u) * nloc) {
            __builtin_amdgcn_fence(__ATOMIC_RELEASE, "agent");
            asm volatile("s_waitcnt vmcnt(0)" ::: "memory");
            const unsigned og = xb_add(&bar[XB_TOP], 1u);
            const unsigned tg = og / nx;
            if (og + 1u == (tg + 1u) * nx) xb_add(&bar[XB_TOPGEN], 1u);
            else XB_SPIN(xb_ld(&bar[XB_TOPGEN]) == tg, bar);
            __builtin_amdgcn_fence(__ATOMIC_ACQUIRE, "agent");
            xb_add(&bar[XB_XGEN(b.x)], 1u);
            asm volatile("s_waitcnt vmcnt(0)" ::: "memory");
        } else {
            XB_SPIN(xb_ld(&bar[XB_XGEN(b.x)]) == gen, bar);
            __builtin_amdgcn_fence(__ATOMIC_ACQUIRE, "agent");
            asm volatile("s_waitcnt vmcnt(0)" ::: "memory");
        }
    }
    __syncthreads();
}

constexpr int NPHASES = 11;
__global__ void __launch_bounds__(NTHREADS, 2) mk_fwd(Args a) {
    extern __shared__ __attribute__((aligned(16))) unsigned char lds[];
    cg::grid_group grid = cg::this_grid();
    const int lo = a.ph_lo, hi = a.ph_hi;
    volatile LAS unsigned* xbw = (volatile LAS unsigned*)(lds + LDS_MAIN);
    if (threadIdx.x < 4) xbw[threadIdx.x] = 0u;
    __syncthreads();
    XcdBarrier xbar = xcd_barrier_post((unsigned*)(a.ws + WS_CTL), xbw);
#define IN(k) (lo <= (k) && (k) < hi)
    if (lo < 0) grid.sync();
#define SEAM(k) do { if (IN(k) && IN((k) + 1)) xcd_barrier(xbar); } while (0)
    const float* mod = (const float*)(a.ws + WS_MOD);
    if (IN(0)) phase0(a, lds);
    SEAM(0);
    if (IN(1)) norm_mod_phase<false>(a.x, a.g_mix, mod, 0, 1, (u16*)(a.ws + WS_ACT));
    SEAM(1);
    if (IN(2)) { gemm8(lds, (const u16*)(a.ws + WS_ACT), (const u16*)(a.ws + WS_WIN), T, NP, D, EpiProj{(u16*)(a.ws + WS_P), (const float*)(a.ws + WS_CS)}); gz_phase(lds, (const u16*)(a.ws + WS_ACT), (const u16*)(a.ws + WS_WIN) + (size_t)NP * D, (float*)(a.ws + WS_GZ)); }
    SEAM(2);
    if (IN(3)) phase_rope_prep(a, lds);
    SEAM(3);
    if (IN(4)) phase_mixers(a, lds);
    SEAM(4);
    if (IN(5)) phase_gla_fin(a);
    SEAM(5);
    if (IN(6)) gemm8(lds, (const u16*)(a.ws + WS_ACT), (const u16*)(a.ws + WS_WOUT), T, D, D, EpiResid{a.x, mod, (u16*)(a.ws + WS_X1)});
    SEAM(6);
    if (IN(7)) { norm_mod_phase<true>(a.ws + WS_X1, a.g_ffn, mod, 3, 4, (u16*)(a.ws + WS_ACT)); convert_tables(a); }
    SEAM(7);
    if (IN(8)) gemm8(lds, (const u16*)(a.ws + WS_ACT), (const u16*)(a.ws + WS_WPQ), T, D, D, EpiBf16{(u16*)(a.ws + WS_Q)});
    SEAM(8);
    if (IN(9)) phase_route(a, lds);
    SEAM(9);
    if (IN(10)) phase_experts(a);
#ifdef PROBE_REP10
    grid.sync(); phase_experts(a);
#endif
#ifdef PROBE_REP9
    grid.sync(); phase_route(a, lds); grid.sync(); phase_experts(a);
#endif
#undef IN
#undef SEAM
}

#ifndef MK_ONE_LAUNCH
#define MK_ONE_LAUNCH 1
#endif
extern "C" void kernel_launch(void* const* d_in, const int* in_sizes, int n_in, void* d_out, int out_size, void* d_ws, size_t ws_size, hipStream_t stream) {
    static int grid = 0;
    if (grid == 0) {
        if (n_in != 19 || out_size != T * D || ws_size < WS_END) {
            fprintf(stderr, "kernel_launch: unexpected shapes: n_in %d out %d ws %zu (need %zu)\n", n_in, out_size, ws_size, (size_t)WS_END);
            grid = -1; return;
        }
        int dev = 0, cus = 0, per_cu = 0;
        (void)hipGetDevice(&dev);
        (void)hipDeviceGetAttribute(&cus, hipDeviceAttributeMultiprocessorCount, dev);
        (void)hipFuncSetAttribute((const void*)mk_fwd, hipFuncAttributeMaxDynamicSharedMemorySize, LDS_BYTES);
        (void)hipOccupancyMaxActiveBlocksPerMultiprocessor(&per_cu, (const void*)mk_fwd, NTHREADS, LDS_BYTES);
        if (per_cu < 1) { fprintf(stderr, "kernel_launch: occupancy query says %d blocks/CU\n", per_cu); grid = -1; return; }
        grid = cus;
        (void)hipGetLastError();
    }
    if (grid < 0) return;
    Args a{};
    a.x = (const float*)d_in[0]; a.c = (const float*)d_in[1]; a.pos = (const int*)d_in[2]; a.w_ada = (const float*)d_in[3];
    a.b_ada = (const float*)d_in[4]; a.g_mix = (const float*)d_in[5]; a.w_in = (const float*)d_in[6]; a.wgf = (const float*)d_in[7];
    a.bgf = (const float*)d_in[8]; a.wgb = (const float*)d_in[9]; a.bgb = (const float*)d_in[10]; a.g_gla = (const float*)d_in[11];
    a.w_out = (const float*)d_in[12]; a.g_ffn = (const float*)d_in[13]; a.w_pq = (const float*)d_in[14]; a.subk = (const float*)d_in[15];
    a.pu = (const float*)d_in[16]; a.pv = (const float*)d_in[17]; a.g_fin = (const float*)d_in[18];
    a.out = (float*)d_out; a.ws = (unsigned char*)d_ws;
#if MK_ONE_LAUNCH
    (void)hipMemsetAsync((unsigned char*)d_ws + WS_CTL, 0, XCD_BAR_WORDS * 4, stream);
    a.ph_lo = 0; a.ph_hi = NPHASES;
    void* args[] = {&a};
    hipError_t e = hipLaunchCooperativeKernel((const void*)mk_fwd, dim3(grid), dim3(NTHREADS), args, LDS_BYTES, stream);
    if (e != hipSuccess) fprintf(stderr, "cooperative launch failed: %s (grid %d)\n", hipGetErrorString(e), grid);
#else
    for (int p = 0; p < NPHASES; ++p) {
        a.ph_lo = p; a.ph_hi = p + 1;
        hipLaunchKernelGGL(mk_fwd, dim3(grid), dim3(NTHREADS), LDS_BYTES, stream, a);
    }
#endif
}
```

```cpp
#include <hip/hip_runtime.h>
#include <hip/hip_cooperative_groups.h>
#include <cstdio>
#include <cstdint>

namespace cg = cooperative_groups;

typedef unsigned short u16;
typedef __attribute__((ext_vector_type(8))) short bf16x8;
typedef __attribute__((ext_vector_type(4))) float f32x4;
typedef short s16x4 __attribute__((ext_vector_type(4)));
#define TID ((int)threadIdx.x)
#define BID ((int)blockIdx.x)
#define GDIM ((int)gridDim.x)
#define LAS __attribute__((address_space(3)))

constexpr int D = 2048, NB = 4, S = 4096, T = NB * S;
constexpr int INW = 6176;
constexpr int NP = 6144;
constexpr int NPAD = 6208;
constexpr int C_GQ = 0, C_GK = 512, C_GV = 1024, C_GR = 2048, C_DQ = 3072, C_DK = 4096, C_DV = 5120;
constexpr int NTHREADS = 512, NWAVES = 8;
constexpr int LDS_MAIN = 128 * 1024;
constexpr int LDS_BYTES = LDS_MAIN + 16;
constexpr float NORM_EPS = 1e-6f;

constexpr size_t WS_CTL = 0;
constexpr size_t WS_MOD = 65536;
constexpr size_t WS_CS = 524288;
constexpr size_t WS_WIN = WS_CS + (size_t)T * 64 * 8;
constexpr size_t WS_WOUT = WS_WIN + (size_t)NPAD * D * 2;
constexpr size_t WS_WPQ = WS_WOUT + (size_t)D * D * 2;
constexpr size_t WS_ACT = WS_WPQ + (size_t)D * D * 2;
constexpr size_t WS_P = WS_ACT + (size_t)T * D * 2;
constexpr size_t WS_X1 = WS_P;
constexpr size_t WS_Q = WS_P + (size_t)T * D * 4;
constexpr size_t WS_GZ = WS_P + (size_t)T * NP * 2;
constexpr int GLA_NPREP = NB * 4 * 2 * (S / 64);
constexpr size_t WS_QD = WS_GZ + (size_t)T * 32 * 4;
constexpr size_t WS_KE = WS_QD + (size_t)GLA_NPREP * 16384;
constexpr size_t WS_AT = WS_KE + (size_t)GLA_NPREP * 16384;
constexpr size_t WS_DEC = WS_AT + (size_t)GLA_NPREP * 8192;
constexpr size_t WS_OFB = WS_DEC + (size_t)GLA_NPREP * 512;
constexpr size_t WS_IDX = WS_OFB + (size_t)2 * T * 1024 * 2;
constexpr size_t WS_GATE = WS_IDX + (size_t)T * 128 * 4;
constexpr size_t WS_END = WS_GATE + (size_t)T * 128 * 4;
constexpr size_t WS_TU = WS_QD;
constexpr size_t WS_TV = WS_TU + (size_t)16384 * 1024;
constexpr size_t WS_SU = WS_TV + (size_t)16384 * 1024;
constexpr size_t WS_SV = WS_SU + (size_t)16384 * 128;
static_assert(WS_SV + (size_t)16384 * 128 <= WS_IDX, "table region");

struct Args {
    const float* x; const float* c; const int* pos; const float* w_ada; const float* b_ada; const float* g_mix;
    const float* w_in; const float* wgf; const float* bgf; const float* wgb; const float* bgb; const float* g_gla;
    const float* w_out; const float* g_ffn; const float* w_pq; const float* subk; const float* pu; const float* pv; const float* g_fin;
    float* out; unsigned char* ws; int ph_lo, ph_hi;
};

__device__ __forceinline__ float bf2f(u16 h) { return __uint_as_float(((unsigned)h) << 16); }
typedef __bf16 hw_bf16x2 __attribute__((ext_vector_type(2)));
typedef float hw_f32x2 __attribute__((ext_vector_type(2)));
__device__ __forceinline__ unsigned pack2(float a, float b) { const hw_f32x2 f = {a, b}; return __builtin_bit_cast(unsigned, __builtin_convertvector(f, hw_bf16x2)); }
__device__ __forceinline__ u16 f2bf(float f) { return (u16)(pack2(f, 0.f) & 0xffffu); }
__device__ __forceinline__ float lo2f(unsigned p) { return __uint_as_float(p << 16); }
__device__ __forceinline__ float hi2f(unsigned p) { return __uint_as_float(p & 0xffff0000u); }
__device__ __forceinline__ float wave_sum(float v) {
#pragma unroll
    for (int o = 32; o > 0; o >>= 1) v += __shfl_xor(v, o);
    return v;
}
__device__ __forceinline__ float wave_max(float v) {
#pragma unroll
    for (int o = 32; o > 0; o >>= 1) v = fmaxf(v, __shfl_xor(v, o));
    return v;
}
__device__ __forceinline__ float silu_f(float v) { return v / (1.f + __expf(-v)); }
__device__ __forceinline__ float gelu_f(float a) { return 0.5f * a * (1.f + erff(a * 0.70710678118654752f)); }
__device__ __forceinline__ float logsigmoid_f(float z) { return z < 0.f ? z - log1pf(expf(z)) : -log1pf(expf(-z)); }

constexpr int MOD_BLOCKS = 96;
__device__ __forceinline__ void p0_mod(const Args& a, unsigned char* lds, int bi) {
    float* sc = (float*)lds;
    float* red = sc + 4 * 2048;
    const int tid = threadIdx.x, lane = tid & 63, wave = tid >> 6;
    for (int i = tid; i < 4 * 2048; i += NTHREADS) sc[i] = silu_f(a.c[i]);
    __syncthreads();
    const int j0 = bi * 128 + lane * 2;
    float acc[4][2];
#pragma unroll
    for (int b = 0; b < 4; ++b) { acc[b][0] = 0.f; acc[b][1] = 0.f; }
    const int k0 = wave * 256;
#pragma unroll 8
    for (int kk = 0; kk < 256; ++kk) {
        const int k = k0 + kk;
        const hw_f32x2 wv_ = __builtin_nontemporal_load((const hw_f32x2*)(a.w_ada + (size_t)k * 12288 + j0)); const float2 w = make_float2(wv_[0], wv_[1]);
#pragma unroll
        for (int b = 0; b < 4; ++b) { const float s = sc[b * 2048 + k]; acc[b][0] += s * w.x; acc[b][1] += s * w.y; }
    }
#pragma unroll
    for (int b = 0; b < 4; ++b) { red[(wave * 4 + b) * 128 + lane * 2] = acc[b][0]; red[(wave * 4 + b) * 128 + lane * 2 + 1] = acc[b][1]; }
    __syncthreads();
    float* mod = (float*)(a.ws + WS_MOD);
    {
        const int b = tid >> 7, jc = tid & 127;
        float s = 0.f;
#pragma unroll
        for (int w = 0; w < 8; ++w) s += red[(w * 4 + b) * 128 + jc];
        mod[b * 12288 + bi * 128 + jc] = s + a.b_ada[bi * 128 + jc];
    }
    __syncthreads();
}

__device__ __forceinline__ void p0_transpose_item(const float* __restrict__ W, int ldw, int k0, int src_col0, int n_valid,
                                                  u16* __restrict__ WT, int ldt, int n_out0, unsigned char* wlds, bool rope_perm = false) {
    u16* tl = (u16*)wlds;
    const int lane = threadIdx.x & 63;
    const int rsub = lane >> 4, nc = (lane & 15) * 4;
    int scol = src_col0 + nc;
    if (rope_perm) { const int p = (n_out0 & 64) + nc, g = p >> 3; scol = (src_col0 - (n_out0 & 64)) + ((p & 4) ? 64 + 4 * g : 4 * g); }
    float4 v[16];
#pragma unroll
    for (int j = 0; j < 16; ++j) {
        const int k = 4 * j + rsub;
        if (nc < n_valid) { const f32x4 q_ = __builtin_nontemporal_load((const f32x4*)(W + (size_t)(k0 + k) * ldw + scol)); v[j] = make_float4(q_[0], q_[1], q_[2], q_[3]); }
        else v[j] = make_float4(0.f, 0.f, 0.f, 0.f);
    }
#pragma unroll
    for (int j = 0; j < 16; ++j) {
        const int k = 4 * j + rsub;
        tl[(nc + 0) * 72 + k] = f2bf(v[j].x); tl[(nc + 1) * 72 + k] = f2bf(v[j].y); tl[(nc + 2) * 72 + k] = f2bf(v[j].z); tl[(nc + 3) * 72 + k] = f2bf(v[j].w);
    }
#pragma unroll
    for (int j = 0; j < 8; ++j) {
        const int c = lane + 64 * j, n = c >> 3, kc = (c & 7) * 8;
        const uint4 o = *(const uint4*)(tl + n * 72 + kc);
        *(uint4*)(WT + (size_t)(n_out0 + n) * ldt + k0 + kc) = o;
    }
}

__device__ __forceinline__ void phase0(const Args& a, unsigned char* lds) {
    const int bi = blockIdx.x, G = gridDim.x, tid = threadIdx.x, wave = tid >> 6;
    const bool modblk = (G > MOD_BLOCKS) && (bi < MOD_BLOCKS);
    if (G > MOD_BLOCKS) { if (modblk) p0_mod(a, lds, bi); }
    else { for (int mb = bi; mb < MOD_BLOCKS; mb += G) p0_mod(a, lds, mb); }
    const int nb = (G > MOD_BLOCKS) ? G - MOD_BLOCKS : G, b0 = (G > MOD_BLOCKS) ? bi - MOD_BLOCKS : bi;
    if (!modblk) {
        constexpr int I_IN = 32 * (NPAD / 64), I_SQ = 32 * 32;
        u16* WinT = (u16*)(a.ws + WS_WIN); u16* WoutT = (u16*)(a.ws + WS_WOUT); u16* WpqT = (u16*)(a.ws + WS_WPQ);
        unsigned char* wlds = lds + wave * 9216;
        for (int it = b0 * NWAVES + wave; it < I_IN + 2 * I_SQ; it += nb * NWAVES) {
            if (it < I_IN) {
                const int kt = it & 31, nt = it >> 5;
                const int n0 = nt * 64;
                int src, nv;
                if (n0 < 3072) { src = n0; nv = 64; }
                else if (n0 < 6144) { src = n0 + 32; nv = 64; }
                else if (n0 == 6144) { src = 3072; nv = 32; }
                else { src = 0; nv = 0; }
                p0_transpose_item(a.w_in, INW, kt * 64, src, nv, WinT, D, n0, wlds, n0 >= C_DQ && n0 < C_DV);
            } else if (it < I_IN + I_SQ) {
                const int r = it - I_IN; const int kt = r & 31, nt = r >> 5;
                p0_transpose_item(a.w_out, D, kt * 64, nt * 64, 64, WoutT, D, nt * 64, wlds);
            } else {
                const int r = it - I_IN - I_SQ; const int kt = r & 31, nt = r >> 5;
                p0_transpose_item(a.w_pq, D, kt * 64, nt * 64, 64, WpqT, D, nt * 64, wlds);
            }
        }
        float2* cs = (float2*)(a.ws + WS_CS);
        for (int i = b0 * NTHREADS + tid; i < T * 64; i += nb * NTHREADS) {
            const int t = i >> 6, f = i & 63;
            const float inv_freq = powf(10000.0f, -(float)f * 2.0f / 128.0f);
            const float ang = (float)a.pos[t] * inv_freq;
            const double rev = (double)ang * 0.15915494309189533577;
            const float fr = (float)(rev - floor(rev));
            cs[i] = make_float2(__builtin_amdgcn_cosf(fr), __builtin_amdgcn_sinf(fr));
        }
    }
    __syncthreads();
}

template <bool BF16IN> __device__ __forceinline__ void norm_mod_phase(const void* __restrict__ xin_, const float* __restrict__ g, const float* __restrict__ mod,
                                               int sh_chunk, int sc_chunk, u16* __restrict__ outp) {
    const int lane = threadIdx.x & 63, wave = threadIdx.x >> 6;
    const int gw = blockIdx.x * NWAVES + wave, NGW = gridDim.x * NWAVES;
    float4 v[8], vn[8];
#define NM_LOAD(dst_, t_) do { if (BF16IN) { const hw_f32x2* xr_ = (const hw_f32x2*)((const u16*)xin_ + (size_t)(t_) * D); \
            _Pragma("unroll") for (int m = 0; m < 8; ++m) { const hw_f32x2 q_ = __builtin_nontemporal_load(xr_ + lane + 64 * m); const unsigned px_ = __float_as_uint(q_[0]), py_ = __float_as_uint(q_[1]); \
                dst_[m] = make_float4(lo2f(px_), hi2f(px_), lo2f(py_), hi2f(py_)); } } \
        else { const f32x4* xr_ = (const f32x4*)((const float*)xin_ + (size_t)(t_) * D); \
            _Pragma("unroll") for (int m = 0; m < 8; ++m) { const f32x4 q_ = __builtin_nontemporal_load(xr_ + lane + 64 * m); dst_[m] = make_float4(q_[0], q_[1], q_[2], q_[3]); } } } while (0)
    if (gw < T) NM_LOAD(v, gw);
    for (int t = gw; t < T; t += NGW) {
        const int b = t / S;
        if (t + NGW < T) NM_LOAD(vn, t + NGW);
        float ss = 0.f;
#pragma unroll
        for (int m = 0; m < 8; ++m) ss += v[m].x * v[m].x + v[m].y * v[m].y + v[m].z * v[m].z + v[m].w * v[m].w;
        ss = wave_sum(ss);
        const float rstd = rsqrtf(ss * (1.f / D) + NORM_EPS);
        const float4* gp = (const float4*)g;
        const float4* shp = (const float4*)(mod + b * 12288 + sh_chunk * 2048);
        const float4* scp = (const float4*)(mod + b * 12288 + sc_chunk * 2048);
        uint2* op = (uint2*)(outp + (size_t)t * D);
#pragma unroll
        for (int m = 0; m < 8; ++m) {
            const int i = lane + 64 * m;
            const float4 gg = gp[i], sh = shp[i], sc = scp[i];
            const float h0 = v[m].x * rstd * gg.x * (1.f + sc.x) + sh.x;
            const float h1 = v[m].y * rstd * gg.y * (1.f + sc.y) + sh.y;
            const float h2 = v[m].z * rstd * gg.z * (1.f + sc.z) + sh.z;
            const float h3 = v[m].w * rstd * gg.w * (1.f + sc.w) + sh.w;
            op[i] = make_uint2(pack2(h0, h1), pack2(h2, h3));
        }
#pragma unroll
        for (int m = 0; m < 8; ++m) v[m] = vn[m];
    }
#undef NM_LOAD
}

namespace pg8 {
#define PG8_LAS __attribute__((address_space(3)))
typedef unsigned short bf16_t;
typedef short bf16x8 __attribute__((ext_vector_type(8)));
typedef float f32x4 __attribute__((ext_vector_type(4)));
typedef unsigned u32x4 __attribute__((ext_vector_type(4)));
constexpr int BM = 256, BK = 64, HALF = 128, HTB = HALF * BK * 2  , STAGE_BYTES = 8 * HTB, NXCD = 8, WGM = 8;

__host__ __device__ __forceinline__ int lds_byte(int r, int c) { const int st = (r >> 4) * 2 + (c >> 5), rr = r & 15, cc = c & 31, ob = rr * 64 + cc * 2; return st * 1024 + (ob ^ (((ob >> 9) & 1) << 5)); }
__host__ __device__ __forceinline__ void stage_rc(int b, int& R, int& C) { const int st = b / 1024, sb = b % 1024, swz = sb ^ (((sb >> 9) & 1) << 5); R = (st >> 1) * 16 + swz / 64; C = (st & 1) * 32 + (swz % 64) / 2; }
__host__ __device__ __forceinline__ int perm32(int rho) { const int n = rho >> 4, i = rho & 15; return 8 * (i >> 2) + 4 * n + (i & 3); }

struct Unit { int pm, pn; };
struct Gemm { const bf16_t* A; const bf16_t* Bt; int M, N, K; };

struct StaticOrder {
    int nM, nN, nwg, G, c;
    __host__ __device__ void init(int M, int N, int G_, int c_) { nM = M / BM; nN = N / BM; nwg = nM * nN; G = G_; c = c_; }
    __host__ __device__ bool next(int i, Unit& u) const {
        const long L = (long)i * G + c; if (L >= nwg) return false;
        int wgid = (int)L; { const int q = nwg / NXCD, r = nwg % NXCD, xcd = wgid % NXCD, off = wgid / NXCD; wgid = (xcd < r ? xcd * (q + 1) : r * (q + 1) + (xcd - r) * q) + off; }
        const int nig = WGM * nN, gid = wgid / nig, fm = gid * WGM, gsz = (nM - fm) < WGM ? (nM - fm) : WGM;
        u.pm = fm + ((wgid % nig) % gsz); u.pn = (wgid % nig) / gsz; return true;
    }
    __device__ __forceinline__ void a_ready(const Unit&) const {}
    __device__ __forceinline__ void done(const Unit&) const {}
};
__device__ __forceinline__ unsigned cvt_pk_bf16(float lo, float hi) { unsigned r; asm volatile("v_cvt_pk_bf16_f32 %0, %1, %2" : "=v"(r) : "v"(lo), "v"(hi)); return r; }
typedef float f32x2 __attribute__((ext_vector_type(2)));
template <class Epi, class Sched, bool STAMP = false>
__device__ __forceinline__ void gemm_phase(PG8_LAS unsigned char* lds, const Gemm g, const Sched& S, const Epi& E, unsigned long long* stamps) {
    const int tid = threadIdx.x, wid = __builtin_amdgcn_readfirstlane(tid >> 6), lane = tid & 63, wr = wid >> 2, wc = wid & 3, fr = lane & 15, fq = lane >> 4;
    const int K = g.K, nt = K / BK;
    int ts_lo = 0, ts_hi = 0, nts = 0; const unsigned long long rt_entry = STAMP ? (unsigned long long)wall_clock64() : 0ull;
#define PG8_STAMP() do { if (STAMP && wid == 0 && nts < 64) { const unsigned long long _c = (unsigned long long)clock64(); \
        ts_lo = (lane == nts) ? (int)(unsigned)_c : ts_lo; ts_hi = (lane == nts) ? (int)(unsigned)(_c >> 32) : ts_hi; ++nts; } } while (0)
    PG8_STAMP();
    unsigned voffA[2], voffB[2];
#pragma unroll
    for (int i = 0; i < 2; ++i) { int R, C; stage_rc(tid * 16 + i * 8192, R, C); const int Rb = Epi::PERM ? ((R & ~31) + perm32(R & 31)) : R;
        voffA[i] = (unsigned)(R * K + C) * 2u; voffB[i] = (unsigned)(Rb * K + C) * 2u; }
    const size_t kstep = (size_t)(BK * 2);
    const size_t hstep = (size_t)HALF * K * 2;
    const size_t tstep = 2 * hstep;
    const unsigned ldsw = (unsigned)wid * 1024u;
    const int aoff = lds_byte(wr * 64 + fr, fq * 8), boff = lds_byte(wc * 32 + fr, fq * 8);
#define PG8_SA(b, h) (((b) * 2 + (h)) * HTB)
#define PG8_SB(b, h) ((4 + (b) * 2 + (h)) * HTB)
#define PG8_STAGE(bufoff, gbase, voff) do { _Pragma("unroll") for (int _i = 0; _i < 2; ++_i) \
        __builtin_amdgcn_global_load_lds((const unsigned*)((const char*)(gbase) + (voff)[_i]), (PG8_LAS unsigned*)(lds + (bufoff) + ldsw + _i * 8192), 16, 0, 0); } while (0)
#define PG8_LDA(dst, b, h) do { _Pragma("unroll") for (int m = 0; m < 4; ++m) _Pragma("unroll") for (int k = 0; k < 2; ++k) dst[m][k] = *(const PG8_LAS bf16x8*)(lds + PG8_SA(b, h) + aoff + m * 2048 + k * 1024); } while (0)
#define PG8_LDB(dst, b, h) do { _Pragma("unroll") for (int n = 0; n < 2; ++n) _Pragma("unroll") for (int k = 0; k < 2; ++k) dst[n][k] = *(const PG8_LAS bf16x8*)(lds + PG8_SB(b, h) + boff + n * 2048 + k * 1024); } while (0)
#define PG8_MMA(ai, bj, At, Bt) do { __builtin_amdgcn_s_setprio(1); _Pragma("unroll") for (int m = 0; m < 4; ++m) _Pragma("unroll") for (int n = 0; n < 2; ++n) _Pragma("unroll") for (int k = 0; k < 2; ++k) \
        acc[ai][bj][m][n] = __builtin_amdgcn_mfma_f32_16x16x32_bf16(Bt[n][k], At[m][k], acc[ai][bj][m][n], 0, 0, 0); __builtin_amdgcn_s_setprio(0); } while (0)
#define PG8_WAIT_V(n) asm volatile("s_waitcnt vmcnt(" #n ")" ::: "memory")
#define PG8_WAIT_L(n) asm volatile("s_waitcnt lgkmcnt(" #n ")" ::: "memory")
#define PG8_BAR __builtin_amdgcn_s_barrier()
#define PG8_SCHED __builtin_amdgcn_sched_barrier(0)
    Unit cur, nxt; int ui = 0;
    if (!S.next(0, cur)) return;
    f32x4 acc[2][2][4][2];
#pragma unroll
    for (int a = 0; a < 2; ++a)
#pragma unroll
        for (int b = 0; b < 2; ++b)
#pragma unroll
            for (int m = 0; m < 4; ++m)
#pragma unroll
                for (int n = 0; n < 2; ++n) acc[a][b][m][n] = (f32x4){0.f, 0.f, 0.f, 0.f};
    bf16x8 At[4][2], B0[2][2], B1[2][2];
    const char* cA = (const char*)g.A + (size_t)cur.pm * tstep; const char* cB = (const char*)g.Bt + (size_t)cur.pn * tstep;
    S.a_ready(cur);
    PG8_STAGE(PG8_SB(0, 0), cB, voffB); PG8_STAGE(PG8_SA(0, 0), cA, voffA); PG8_STAGE(PG8_SB(0, 1), cB + hstep, voffB); PG8_STAGE(PG8_SA(0, 1), cA + hstep, voffA);
    if (wr == 1) PG8_BAR;
    PG8_WAIT_V(4); PG8_BAR;
    PG8_STAGE(PG8_SB(1, 0), cB + kstep, voffB); PG8_STAGE(PG8_SA(1, 0), cA + kstep, voffA); PG8_STAGE(PG8_SB(1, 1), cB + hstep + kstep, voffB);
    PG8_WAIT_V(6); PG8_BAR;
    PG8_STAMP();
    for (;;) {
        const bool has_next = S.next(ui + 1, nxt);
        const char* nA = has_next ? (const char*)g.A + (size_t)nxt.pm * tstep : cA; const char* nB = has_next ? (const char*)g.Bt + (size_t)nxt.pn * tstep : cB;
        for (int t = 0; t < nt; t += 2) {
            const bool last = (t == nt - 2);
            const char* a1 = cA + (size_t)(t + 1) * kstep;
            const char* a2 = last ? nA : cA + (size_t)(t + 2) * kstep; const char* b2 = last ? nB : cB + (size_t)(t + 2) * kstep;
            const char* a3 = a2 + kstep; const char* b3 = b2 + kstep;
            if (last && has_next) S.a_ready(nxt);
            PG8_LDB(B0, 0, 0); PG8_SCHED; PG8_LDA(At, 0, 0); PG8_STAGE(PG8_SA(1, 1), a1 + hstep, voffA);
            PG8_WAIT_L(8); PG8_BAR; PG8_WAIT_L(0); PG8_MMA(0, 0, At, B0); PG8_BAR; PG8_SCHED;
            PG8_LDB(B1, 0, 1); PG8_STAGE(PG8_SB(0, 0), b2, voffB);
            PG8_BAR; PG8_WAIT_L(0); PG8_MMA(0, 1, At, B1); PG8_BAR;
            PG8_LDA(At, 0, 1); PG8_STAGE(PG8_SA(0, 0), a2, voffA);
            PG8_BAR; PG8_WAIT_L(0); PG8_MMA(1, 0, At, B0); PG8_BAR; PG8_SCHED;
            PG8_STAGE(PG8_SB(0, 1), b2 + hstep, voffB);
            PG8_WAIT_V(6); PG8_BAR; PG8_MMA(1, 1, At, B1); PG8_BAR;
            PG8_LDB(B0, 1, 0); PG8_SCHED; PG8_LDA(At, 1, 0); PG8_STAGE(PG8_SA(0, 1), a2 + hstep, voffA);
            PG8_WAIT_L(8); PG8_BAR; PG8_WAIT_L(0); PG8_MMA(0, 0, At, B0); PG8_BAR; PG8_SCHED;
            PG8_LDB(B1, 1, 1); PG8_STAGE(PG8_SB(1, 0), b3, voffB);
            PG8_BAR; PG8_WAIT_L(0); PG8_MMA(0, 1, At, B1); PG8_BAR;
            PG8_LDA(At, 1, 1); PG8_STAGE(PG8_SA(1, 0), a3, voffA);
            PG8_BAR; PG8_WAIT_L(0); PG8_MMA(1, 0, At, B0); PG8_BAR; PG8_SCHED;
            PG8_STAGE(PG8_SB(1, 1), b3 + hstep, voffB);
            PG8_WAIT_V(6); PG8_BAR; PG8_MMA(1, 1, At, B1); PG8_BAR;
        }
        PG8_STAMP();
        if constexpr (!Epi::AFTER_DRAIN) { E(acc, cur, wr, wc, fr, fq); S.done(cur); }
        PG8_STAMP();
        if (!has_next) break;
#pragma unroll
        for (int a = 0; a < 2; ++a)
#pragma unroll
            for (int b = 0; b < 2; ++b)
#pragma unroll
                for (int m = 0; m < 4; ++m)
#pragma unroll
                    for (int n = 0; n < 2; ++n) acc[a][b][m][n] = (f32x4){0.f, 0.f, 0.f, 0.f};
        cur = nxt; cA = nA; cB = nB; ++ui;
    }
    PG8_WAIT_V(0);
    if (wr == 0) PG8_BAR;
    PG8_BAR;
    if constexpr (Epi::AFTER_DRAIN) { E.fused(acc, cur, wr, wc, fr, fq, lds, wid, lane); S.done(cur); }
    PG8_STAMP();
    if (STAMP && wid == 0) { stamps[lane] = lane < nts ? (((unsigned long long)(unsigned)ts_hi << 32) | (unsigned)ts_lo) : 0ull;
        if (lane == 62) stamps[62] = rt_entry; if (lane == 63) stamps[63] = (unsigned long long)wall_clock64(); }
#undef PG8_STAMP
#undef PG8_SA
#undef PG8_SB
#undef PG8_STAGE
#undef PG8_LDA
#undef PG8_LDB
#undef PG8_MMA
#undef PG8_WAIT_V
#undef PG8_WAIT_L
#undef PG8_BAR
#undef PG8_SCHED
}
}

struct EpiProj {
    static constexpr bool PERM = true, AFTER_DRAIN = false;
    u16* P; const float* cs;
    __device__ __forceinline__ void operator()(const pg8::f32x4 (&acc)[2][2][4][2], const pg8::Unit& u, int wr, int wc, int fr, int fq) const {
        const int row0 = u.pm * 256 + wr * 64 + fr;
        const int col0 = u.pn * 256 + wc * 32 + 8 * fq;
        const bool rope = (u.pn >= C_DQ / 256) && (u.pn < C_DV / 256);
#pragma unroll
        for (int ai = 0; ai < 2; ++ai)
#pragma unroll
            for (int m = 0; m < 4; ++m) { const int row = row0 + ai * 128 + m * 16; u16* rowp = P + (size_t)row * NP + col0;
                pg8::f32x4 c01 = (pg8::f32x4){1.f, 0.f, 1.f, 0.f}, c23 = c01;
                if (rope) { const pg8::f32x4* cp = (const pg8::f32x4*)(cs + ((size_t)row * 64 + 4 * (4 * wc + fq)) * 2); c01 = cp[0]; c23 = cp[1]; }
#pragma unroll
                for (int bj = 0; bj < 2; ++bj) { pg8::f32x4 v0 = acc[ai][bj][m][0], v1 = acc[ai][bj][m][1];
                    if (rope) {
                        const pg8::f32x4 cc = {c01[0], c01[2], c23[0], c23[2]}, sn = {c01[1], c01[3], c23[1], c23[3]};
                        const pg8::f32x4 y1 = v0 * cc - v1 * sn, y2 = v0 * sn + v1 * cc; v0 = y1; v1 = y2; }
                    pg8::u32x4 w; w.x = pg8::cvt_pk_bf16(v0[0], v0[1]); w.y = pg8::cvt_pk_bf16(v0[2], v0[3]); w.z = pg8::cvt_pk_bf16(v1[0], v1[1]); w.w = pg8::cvt_pk_bf16(v1[2], v1[3]);
                    *(pg8::u32x4*)(rowp + bj * 128) = w; } }
    }
};
__device__ __forceinline__ void gz_phase(unsigned char* lds, const u16* __restrict__ H1, const u16* __restrict__ Wg, float* __restrict__ gz) {
    const int tid = threadIdx.x, lane = tid & 63, wave = tid >> 6, fr = lane & 15, fq = lane >> 4;
    float* red = (float*)lds;
    for (int rb = blockIdx.x; rb < T / 64; rb += gridDim.x) {
        const int r0 = rb * 64, k0 = wave * 256;
        f32x4 acc[4][2];
#pragma unroll
        for (int m = 0; m < 4; ++m) { acc[m][0] = (f32x4){0.f, 0.f, 0.f, 0.f}; acc[m][1] = (f32x4){0.f, 0.f, 0.f, 0.f}; }
#pragma unroll
        for (int ks = 0; ks < 8; ++ks) {
            bf16x8 af[4], bfr[2];
#pragma unroll
            for (int m = 0; m < 4; ++m) af[m] = *(const bf16x8*)(H1 + (size_t)(r0 + 16 * m + fr) * D + k0 + 32 * ks + 8 * fq);
#pragma unroll
            for (int n = 0; n < 2; ++n) bfr[n] = *(const bf16x8*)(Wg + (size_t)(16 * n + fr) * D + k0 + 32 * ks + 8 * fq);
#pragma unroll
            for (int m = 0; m < 4; ++m)
#pragma unroll
                for (int n = 0; n < 2; ++n) acc[m][n] = __builtin_amdgcn_mfma_f32_16x16x32_bf16(af[m], bfr[n], acc[m][n], 0, 0, 0);
        }
        __syncthreads();
#pragma unroll
        for (int m = 0; m < 4; ++m)
#pragma unroll
            for (int n = 0; n < 2; ++n)
#pragma unroll
                for (int j = 0; j < 4; ++j) red[(wave * 64 + 16 * m + 4 * fq + j) * 32 + 16 * n + fr] = acc[m][n][j];
        __syncthreads();
#pragma unroll
        for (int k = 0; k < 4; ++k) {
            const int e = tid + 512 * k;
            float s = 0.f;
#pragma unroll
            for (int w = 0; w < 8; ++w) s += red[w * 2048 + e];
            gz[(size_t)r0 * 32 + e] = s;
        }
    }
    __syncthreads();
}
struct EpiResid {
    static constexpr bool PERM = true, AFTER_DRAIN = false;
    const float* x; const float* mod; u16* x1;
    __device__ __forceinline__ void operator()(const pg8::f32x4 (&acc)[2][2][4][2], const pg8::Unit& u, int wr, int wc, int fr, int fq) const {
        const int row0 = u.pm * 256 + wr * 64 + fr, col0 = u.pn * 256 + wc * 32 + 8 * fq;
        const int b = (u.pm * 256) / S;
        pg8::f32x4 ga[2][2];
#pragma unroll
        for (int bj = 0; bj < 2; ++bj)
#pragma unroll
            for (int n = 0; n < 2; ++n) ga[bj][n] = *(const pg8::f32x4*)(mod + b * 12288 + 2 * 2048 + col0 + bj * 128 + 4 * n);
#pragma unroll
        for (int ai = 0; ai < 2; ++ai)
#pragma unroll
            for (int m = 0; m < 4; ++m) { const size_t off = (size_t)(row0 + ai * 128 + m * 16) * D + col0;
#pragma unroll
                for (int bj = 0; bj < 2; ++bj) {
                    const pg8::f32x4 x0 = __builtin_nontemporal_load((const pg8::f32x4*)(x + off + bj * 128)), x1v = __builtin_nontemporal_load((const pg8::f32x4*)(x + off + bj * 128 + 4));
                    const pg8::f32x4 v0 = x0 + ga[bj][0] * acc[ai][bj][m][0], v1 = x1v + ga[bj][1] * acc[ai][bj][m][1];
                    pg8::u32x4 w; w.x = pg8::cvt_pk_bf16(v0[0], v0[1]); w.y = pg8::cvt_pk_bf16(v0[2], v0[3]); w.z = pg8::cvt_pk_bf16(v1[0], v1[1]); w.w = pg8::cvt_pk_bf16(v1[2], v1[3]);
                    *(pg8::u32x4*)(x1 + off + bj * 128) = w; } }
    }
};
struct EpiBf16 {
    static constexpr bool PERM = true, AFTER_DRAIN = false;
    u16* Q;
    __device__ __forceinline__ void operator()(const pg8::f32x4 (&acc)[2][2][4][2], const pg8::Unit& u, int wr, int wc, int fr, int fq) const {
        const int row0 = u.pm * 256 + wr * 64 + fr, col0 = u.pn * 256 + wc * 32 + 8 * fq;
#pragma unroll
        for (int ai = 0; ai < 2; ++ai)
#pragma unroll
            for (int m = 0; m < 4; ++m) { u16* rowp = Q + (size_t)(row0 + ai * 128 + m * 16) * D + col0;
#pragma unroll
                for (int bj = 0; bj < 2; ++bj) { const pg8::f32x4 v0 = acc[ai][bj][m][0], v1 = acc[ai][bj][m][1];
                    pg8::u32x4 w; w.x = pg8::cvt_pk_bf16(v0[0], v0[1]); w.y = pg8::cvt_pk_bf16(v0[2], v0[3]); w.z = pg8::cvt_pk_bf16(v1[0], v1[1]); w.w = pg8::cvt_pk_bf16(v1[2], v1[3]);
                    *(pg8::u32x4*)(rowp + bj * 128) = w; } }
    }
};
template <class Epi>
__device__ __forceinline__ void gemm8(unsigned char* lds, const u16* A, const u16* Bt, int M, int N, int K, const Epi& E) {
    pg8::Gemm g{A, Bt, M, N, K}; pg8::StaticOrder So; So.init(M, N, (int)gridDim.x, (int)blockIdx.x);
    pg8::gemm_phase<Epi, pg8::StaticOrder, false>((PG8_LAS unsigned char*)lds, g, So, E, nullptr);
    __syncthreads();
}

#define GLA_QD_BYTES 16384
#define GLA_AT_BYTES 8192
__device__ __forceinline__ float gla_logsigmoid(float z) { return fminf(z, 0.f) - __logf(1.f + __expf(-fabsf(z))); }

__device__ __forceinline__ void gla_prep_item(const u16* __restrict__ P, int ldp, int cq, int ck, const float* __restrict__ gz,
                                              const float* __restrict__ wg_f, const float* __restrict__ bg_f, const float* __restrict__ wg_b, const float* __restrict__ bg_b,
                                              int Sq, unsigned char* __restrict__ QDg, unsigned char* __restrict__ KEg, unsigned char* __restrict__ ATg, float* __restrict__ DECg,
                                              unsigned char* lds, int item) {
    const int nch = Sq / 64;
    const int c = item % nch, dir = (item / nch) & 1, hh = (item / (nch * 2)) & 3, b = item / (nch * 8);
    const int tid = TID, lane = tid & 63, wave = tid >> 6, li = lane & 15, fq = lane >> 4;
    float* gzs = (float*)lds;
    float* segs = gzs + 64 * 16;
    unsigned char* QDs = lds + 8192;
    unsigned char* KIs = QDs + 16384;
    unsigned char* KEs = KIs + 16384;
    float* bmat = (float*)(KEs + 16384);
    const size_t tok0 = (size_t)b * Sq;
    __syncthreads();
    uint4 rq0, rq1, rk0, rk1;
    {
        const int i0 = tid >> 4, i1 = (tid + 512) >> 4, cc = tid & 15;
        const int s0 = dir ? (Sq - 1 - (64 * c + i0)) : (64 * c + i0), s1 = dir ? (Sq - 1 - (64 * c + i1)) : (64 * c + i1);
        rq0 = *(const uint4*)(P + (tok0 + s0) * ldp + cq + hh * 128 + cc * 8); rk0 = *(const uint4*)(P + (tok0 + s0) * ldp + ck + hh * 128 + cc * 8);
        rq1 = *(const uint4*)(P + (tok0 + s1) * ldp + cq + hh * 128 + cc * 8); rk1 = *(const uint4*)(P + (tok0 + s1) * ldp + ck + hh * 128 + cc * 8);
    }
    for (int e = tid; e < 64 * 16; e += 512) {
        const int i = e >> 4, r = e & 15;
        const int s = dir ? (Sq - 1 - (64 * c + i)) : (64 * c + i);
        gzs[e] = gz[(tok0 + s) * 32 + dir * 16 + r];
    }
    const int d = tid & 127, seg = tid >> 7;
    const float* wg = dir ? wg_b : wg_f;
    float wcol[16];
#pragma unroll
    for (int r = 0; r < 16; ++r) wcol[r] = wg[r * 512 + hh * 128 + d];
    const float bias = (dir ? bg_b : bg_f)[hh * 128 + d];
    __syncthreads();
    float run = 0.f;
#pragma unroll
    for (int k = 0; k < 16; ++k) {
        const int i = 16 * seg + k;
        float z = bias;
#pragma unroll
        for (int r = 0; r < 16; ++r) z += gzs[i * 16 + r] * wcol[r];
        run += gla_logsigmoid(z) * (1.f / 16.f);
        bmat[i * 128 + d] = run;
    }
    segs[seg * 128 + d] = run;
    __syncthreads();
    if (seg == 0) {
        const float t0 = segs[d], t1 = segs[128 + d], t2 = segs[256 + d], t3 = segs[384 + d];
        segs[d] = 0.f; segs[128 + d] = t0; segs[256 + d] = t0 + t1; segs[384 + d] = t0 + t1 + t2; segs[512 + d] = t0 + t1 + t2 + t3;
        DECg[(size_t)item * 128 + d] = __expf(t0 + t1 + t2 + t3);
    }
    __syncthreads();
    const float qscale = 0.08838834764831845f;
#pragma unroll
    for (int k = 0; k < 2; ++k) {
        const int id = tid + 512 * k, i = id >> 4, cc = id & 15, d0 = cc * 8, sg = i >> 4;
        const uint4 qv = k ? rq1 : rq0, kv = k ? rk1 : rk0;
        const float qx[8] = {lo2f(qv.x), hi2f(qv.x), lo2f(qv.y), hi2f(qv.y), lo2f(qv.z), hi2f(qv.z), lo2f(qv.w), hi2f(qv.w)};
        const float kx[8] = {lo2f(kv.x), hi2f(kv.x), lo2f(kv.y), hi2f(kv.y), lo2f(kv.z), hi2f(kv.z), lo2f(kv.w), hi2f(kv.w)};
        float qd[8], ki[8], ke[8];
        const float4 bA = *(const float4*)(bmat + i * 128 + d0), bB = *(const float4*)(bmat + i * 128 + d0 + 4);
        const float4 oA = *(const float4*)(segs + sg * 128 + d0), oB = *(const float4*)(segs + sg * 128 + d0 + 4);
        const float4 tA = *(const float4*)(segs + 512 + d0), tB = *(const float4*)(segs + 512 + d0 + 4);
        const float bv[8] = {bA.x + oA.x, bA.y + oA.y, bA.z + oA.z, bA.w + oA.w, bB.x + oB.x, bB.y + oB.y, bB.z + oB.z, bB.w + oB.w};
        const float tv[8] = {tA.x, tA.y, tA.z, tA.w, tB.x, tB.y, tB.z, tB.w};
#pragma unroll
        for (int e = 0; e < 8; ++e) {
            const float bb = bv[e], tot = tv[e];
            qd[e] = qx[e] * qscale * __expf(bb); ki[e] = kx[e] * __expf(-bb); ke[e] = kx[e] * __expf(tot - bb);
        }
        const int o = i * 256 + ((cc ^ (i & 15)) << 4);
        *(uint4*)(QDs + o) = make_uint4(pack2(qd[0], qd[1]), pack2(qd[2], qd[3]), pack2(qd[4], qd[5]), pack2(qd[6], qd[7]));
        *(uint4*)(KIs + o) = make_uint4(pack2(ki[0], ki[1]), pack2(ki[2], ki[3]), pack2(ki[4], ki[5]), pack2(ki[6], ki[7]));
        *(uint4*)(KEs + o) = make_uint4(pack2(ke[0], ke[1]), pack2(ke[2], ke[3]), pack2(ke[4], ke[5]), pack2(ke[6], ke[7]));
    }
    __syncthreads();
    {
        uint4* qo = (uint4*)(QDg + (size_t)item * GLA_QD_BYTES); uint4* ko = (uint4*)(KEg + (size_t)item * GLA_QD_BYTES);
#pragma unroll
        for (int k = 0; k < 2; ++k) { const int e = tid + 512 * k; qo[e] = ((const uint4*)QDs)[e]; ko[e] = ((const uint4*)KEs)[e]; }
    }
#pragma unroll
    for (int tt = 0; tt < 2; ++tt) {
        const int tile = wave + 8 * tt, jt = tile >> 2, it = tile & 3;
        f32x4 acc = (f32x4){0.f, 0.f, 0.f, 0.f};
        if (jt <= it) {
            const int jr = 16 * jt + li, ir = 16 * it + li;
#pragma unroll
            for (int ks = 0; ks < 4; ++ks) {
                const bf16x8 kf = *(const bf16x8*)(KIs + jr * 256 + (((4 * ks + fq) ^ (jr & 15)) << 4));
                const bf16x8 qf = *(const bf16x8*)(QDs + ir * 256 + (((4 * ks + fq) ^ (ir & 15)) << 4));
                acc = __builtin_amdgcn_mfma_f32_16x16x32_bf16(kf, qf, acc, 0, 0, 0);
            }
        }
        const int i = 16 * it + li, j0 = 16 * jt + 4 * fq;
        float v[4];
#pragma unroll
        for (int jj = 0; jj < 4; ++jj) v[jj] = (j0 + jj <= i) ? acc[jj] : 0.f;
        const int chunk = 2 * jt + (fq >> 1), sub = (fq & 1) * 8;
        *(uint2*)(ATg + (size_t)item * GLA_AT_BYTES + i * 128 + ((chunk ^ (i & 7)) << 4) + sub) = make_uint2(pack2(v[0], v[1]), pack2(v[2], v[3]));
    }
}

__device__ __forceinline__ void gla_seq_item(const u16* __restrict__ P, int ldp, int cv, int Sq,
                                             const unsigned char* __restrict__ QDg, const unsigned char* __restrict__ KEg, const unsigned char* __restrict__ ATg, const float* __restrict__ DECg,
                                             u16* __restrict__ Oout  , int Ttot, unsigned char* lds, int item) {
    const int slice = item & 1, dir = (item >> 1) & 1, hh = (item >> 2) & 3, b = item >> 4;
    const int nch = Sq / 64;
    const int tid = TID, lane = tid & 63, wave = tid >> 6, li = lane & 15, fq = lane >> 4;
    const size_t tok0 = (size_t)b * Sq;
    const int pitem0 = ((b * 4 + hh) * 2 + dir) * nch;
    constexpr int BUF = 16384 * 3 + 8192 + 512;
    typedef unsigned gla_u32x4 __attribute__((ext_vector_type(4)));
    gla_u32x4 rq0, rq1, rk0, rk1, rv0, rv1, ra; float rd = 0.f;
#define GLA_VROW(c_, k_) ((tok0 + (size_t)(dir ? (Sq - 1 - (64 * (c_) + ((tid + 512 * (k_)) >> 4))) : (64 * (c_) + ((tid + 512 * (k_)) >> 4)))) * ldp + cv + hh * 256 + slice * 128 + ((tid + 512 * (k_)) & 15) * 8)
#define GLA_ISSUE(c_) do { \
        const gla_u32x4* qsrc_ = (const gla_u32x4*)(QDg + (size_t)(pitem0 + (c_)) * GLA_QD_BYTES); const gla_u32x4* ksrc_ = (const gla_u32x4*)(KEg + (size_t)(pitem0 + (c_)) * GLA_QD_BYTES); \
        rq0 = qsrc_[tid]; rq1 = qsrc_[tid + 512]; rk0 = ksrc_[tid]; rk1 = ksrc_[tid + 512]; \
        ra = ((const gla_u32x4*)(ATg + (size_t)(pitem0 + (c_)) * GLA_AT_BYTES))[tid]; \
        rv0 = *(const gla_u32x4*)(P + GLA_VROW(c_, 0)); rv1 = *(const gla_u32x4*)(P + GLA_VROW(c_, 1)); \
        if (tid < 128) rd = DECg[(size_t)(pitem0 + (c_)) * 128 + tid]; } while (0)
#define GLA_COMMIT(buf_) do { \
        unsigned char* base_ = lds + (buf_) * BUF; \
        ((gla_u32x4*)base_)[tid] = rq0; ((gla_u32x4*)base_)[tid + 512] = rq1; ((gla_u32x4*)(base_ + 16384))[tid] = rk0; ((gla_u32x4*)(base_ + 16384))[tid + 512] = rk1; \
        { const int row_ = tid >> 4, ch_ = tid & 15; *(gla_u32x4*)(base_ + 32768 + row_ * 256 + ((ch_ ^ (row_ & 15)) << 4)) = rv0; } \
        { const int row_ = (tid + 512) >> 4, ch_ = tid & 15; *(gla_u32x4*)(base_ + 32768 + row_ * 256 + ((ch_ ^ (row_ & 15)) << 4)) = rv1; } \
        ((gla_u32x4*)(base_ + 49152))[tid] = ra; \
        if (tid < 128) ((float*)(base_ + 57344))[tid] = rd; } while (0)
    f32x4 st[8];
#pragma unroll
    for (int dt = 0; dt < 8; ++dt) st[dt] = (f32x4){0.f, 0.f, 0.f, 0.f};
    __syncthreads();
    GLA_ISSUE(0); GLA_COMMIT(0);
    __syncthreads();
#pragma unroll 1
    for (int c = 0; c < nch; ++c) {
        const int buf = c & 1;
        if (c + 1 < nch) GLA_ISSUE(c + 1);
        const unsigned char* QDs = lds + buf * BUF; const unsigned char* KEs = QDs + 16384; const unsigned char* Vs = QDs + 32768;
        const unsigned char* ATs = QDs + 49152; const float* DECs = (const float*)(QDs + 57344);
        bf16x8 vf[2];
#pragma unroll
        for (int jp = 0; jp < 2; ++jp) {
            const int rowA = 32 * jp + 8 * fq + (li >> 2), rowB = rowA + 4;
            const int chunk = 2 * wave + ((li & 3) >> 1), sub = ((li & 3) & 1) * 8;
            const s16x4 va = __builtin_amdgcn_ds_read_tr16_b64_v4i16((LAS s16x4*)(Vs + rowA * 256 + ((chunk ^ (rowA & 15)) << 4) + sub));
            const s16x4 vb = __builtin_amdgcn_ds_read_tr16_b64_v4i16((LAS s16x4*)(Vs + rowB * 256 + ((chunk ^ (rowB & 15)) << 4) + sub));
            vf[jp] = __builtin_shufflevector(va, vb, 0, 1, 2, 3, 4, 5, 6, 7);
        }
        bf16x8 sf[4];
#pragma unroll
        for (int dp = 0; dp < 4; ++dp) {
            const gla_u32x4 t_ = {pack2(st[2 * dp][0], st[2 * dp][1]), pack2(st[2 * dp][2], st[2 * dp][3]), pack2(st[2 * dp + 1][0], st[2 * dp + 1][1]), pack2(st[2 * dp + 1][2], st[2 * dp + 1][3])};
            sf[dp] = __builtin_bit_cast(bf16x8, t_);
        }
        f32x4 ot[4];
#pragma unroll
        for (int it = 0; it < 4; ++it) {
            f32x4 acc = (f32x4){0.f, 0.f, 0.f, 0.f};
            const int ir = 16 * it + li;
#pragma unroll
            for (int dp = 0; dp < 4; ++dp) {
                const int c0 = 4 * dp + (fq >> 1), c1 = c0 + 2, sub = (fq & 1) * 8;
                const uint2 lo = *(const uint2*)(QDs + ir * 256 + ((c0 ^ (ir & 15)) << 4) + sub);
                const uint2 hi = *(const uint2*)(QDs + ir * 256 + ((c1 ^ (ir & 15)) << 4) + sub);
                const gla_u32x4 q_ = {lo.x, lo.y, hi.x, hi.y};
                const bf16x8 qf = __builtin_bit_cast(bf16x8, q_);
                acc = __builtin_amdgcn_mfma_f32_16x16x32_bf16(sf[dp], qf, acc, 0, 0, 0);
            }
#pragma unroll
            for (int jp = 0; jp < 2; ++jp) {
                if (32 * jp <= 16 * it + 15) {
                    const bf16x8 af = *(const bf16x8*)(ATs + ir * 128 + (((4 * jp + fq) ^ (ir & 7)) << 4));
                    acc = __builtin_amdgcn_mfma_f32_16x16x32_bf16(vf[jp], af, acc, 0, 0, 0);
                }
            }
            ot[it] = acc;
        }
#pragma unroll
        for (int dt = 0; dt < 8; ++dt) {
            const f32x4 dec = *(const f32x4*)(DECs + 16 * dt + 4 * fq);
            f32x4 acc = st[dt] * dec;
#pragma unroll
            for (int jp = 0; jp < 2; ++jp) {
                const int rowA = 32 * jp + 8 * fq + (li >> 2), rowB = rowA + 4;
                const int chunk = 2 * dt + ((li & 3) >> 1), sub = ((li & 3) & 1) * 8;
                const s16x4 ka = __builtin_amdgcn_ds_read_tr16_b64_v4i16((LAS s16x4*)(KEs + rowA * 256 + ((chunk ^ (rowA & 15)) << 4) + sub));
                const s16x4 kb = __builtin_amdgcn_ds_read_tr16_b64_v4i16((LAS s16x4*)(KEs + rowB * 256 + ((chunk ^ (rowB & 15)) << 4) + sub));
                const bf16x8 kf = __builtin_shufflevector(ka, kb, 0, 1, 2, 3, 4, 5, 6, 7);
                acc = __builtin_amdgcn_mfma_f32_16x16x32_bf16(kf, vf[jp], acc, 0, 0, 0);
            }
            st[dt] = acc;
        }
#pragma unroll
        for (int it = 0; it < 4; ++it) {
            const int i = 16 * it + li;
            const int s = dir ? (Sq - 1 - (64 * c + i)) : (64 * c + i);
            *(uint2*)(Oout + ((size_t)dir * Ttot + tok0 + s) * 1024 + hh * 256 + slice * 128 + 16 * wave + 4 * fq) =
                make_uint2(pack2(ot[it][0], ot[it][1]), pack2(ot[it][2], ot[it][3]));
        }
        if (c + 1 < nch) GLA_COMMIT(buf ^ 1);
        __syncthreads();
    }
}
__device__ __forceinline__ void phase_rope_prep(const Args& a, unsigned char* lds) {
    u16* P = (u16*)(a.ws + WS_P);
    const float2* cs = (const float2*)(a.ws + WS_CS);
    const int gt = blockIdx.x * NTHREADS + threadIdx.x, NT = gridDim.x * NTHREADS;
    for (int item = blockIdx.x; item < GLA_NPREP; item += gridDim.x)
        gla_prep_item(P, NP, C_GQ, C_GK, (const float*)(a.ws + WS_GZ), a.wgf, a.bgf, a.wgb, a.bgb, S,
                      a.ws + WS_QD, a.ws + WS_KE, a.ws + WS_AT, (float*)(a.ws + WS_DEC), lds, item);
}

#define ATTN_DECODE(item_) \
    const int nb_per = Sq / 128; \
    const int within = (item_) % nb_per, hh = ((item_) / nb_per) & 7, b = ((item_) / (nb_per * 8)) & 3, pat = (item_) / (nb_per * 32); \
    const int dil = pat == 0 ? 1 : (pat == 1 ? 4 : 16); \
    const int M = Sq / dil; \
    const int r = within % dil, blk = within / dil; \
    const int p0 = blk * 128, kbase = p0 - 64; \
    const size_t tok0 = (size_t)b * Sq;
typedef unsigned attn_u32x4 __attribute__((ext_vector_type(4)));
__device__ __forceinline__ void attn_phase(const u16* __restrict__ P, int ldp, int cq, int ck, int cv, int Sq,
                                           u16* __restrict__ part_o, float* __restrict__ part_lse, int Ttot,
                                           unsigned char* lds, int first, int stride, int nitems) {
    const int tid = TID, lane = tid & 63, wave = tid >> 6, li = lane & 15, fq = lane >> 4;
    unsigned char* Ks = lds;
    unsigned char* Vs = lds + 65536;
    attn_u32x4 kr0, kr1, kr2, kr3, kr4, kr5, kr6, kr7, vr0, vr1, vr2, vr3, vr4, vr5, vr6, vr7;
    bf16x8 qn0, qn1, qn2, qn3;
#define ATTN_LD1(i_, kreg_, vreg_) { const int id_ = tid + 512 * (i_), row_ = id_ >> 4, c_ = id_ & 15; \
        int kp_ = kbase + row_; kp_ = kp_ < 0 ? 0 : (kp_ > M - 1 ? M - 1 : kp_); \
        const size_t t_ = tok0 + r + (size_t)dil * kp_; \
        kreg_ = *(const attn_u32x4*)(P + t_ * ldp + ck + hh * 128 + c_ * 8); vreg_ = *(const attn_u32x4*)(P + t_ * ldp + cv + hh * 128 + c_ * 8); }
#define ATTN_LOAD(item_) do { ATTN_DECODE(item_) \
        { const size_t tq_ = tok0 + r + (size_t)dil * (p0 + 16 * wave + li); const u16* qp_ = P + tq_ * ldp + cq + hh * 128 + 8 * fq; \
          qn0 = *(const bf16x8*)(qp_); qn1 = *(const bf16x8*)(qp_ + 32); qn2 = *(const bf16x8*)(qp_ + 64); qn3 = *(const bf16x8*)(qp_ + 96); } \
        ATTN_LD1(0, kr0, vr0) ATTN_LD1(1, kr1, vr1) ATTN_LD1(2, kr2, vr2) ATTN_LD1(3, kr3, vr3) ATTN_LD1(4, kr4, vr4) ATTN_LD1(5, kr5, vr5) ATTN_LD1(6, kr6, vr6) ATTN_LD1(7, kr7, vr7) } while (0)
#define ATTN_ST1(i_, kreg_, vreg_) { const int id_ = tid + 512 * (i_), row_ = id_ >> 4, c_ = id_ & 15; const int off_ = row_ * 256 + ((c_ ^ (row_ & 15)) << 4); \
        *(attn_u32x4*)(Ks + off_) = kreg_; *(attn_u32x4*)(Vs + off_) = vreg_; }
#define ATTN_COMMIT() do { ATTN_ST1(0, kr0, vr0) ATTN_ST1(1, kr1, vr1) ATTN_ST1(2, kr2, vr2) ATTN_ST1(3, kr3, vr3) ATTN_ST1(4, kr4, vr4) ATTN_ST1(5, kr5, vr5) ATTN_ST1(6, kr6, vr6) ATTN_ST1(7, kr7, vr7) } while (0)
    int item = first;
    if (item < nitems) ATTN_LOAD(item);
    for (; item < nitems; item += stride) {
        ATTN_DECODE(item)
        __syncthreads();
        ATTN_COMMIT();
        const int qp = p0 + 16 * wave + li;
        const size_t tq = tok0 + r + (size_t)dil * qp;
        const bf16x8 qf[4] = {qn0, qn1, qn2, qn3};
        __syncthreads();
        if (item + stride < nitems) ATTN_LOAD(item + stride);
        const float scale = 0.08838834764831845f;
        float m = -1e30f, l = 0.f;
        f32x4 o[8];
#pragma unroll
        for (int dt = 0; dt < 8; ++dt) o[dt] = (f32x4){0.f, 0.f, 0.f, 0.f};
#pragma unroll 1
        for (int tp = 0; tp < 5; ++tp) {
            float s[8]; bool ok[8];
#pragma unroll
            for (int h2 = 0; h2 < 2; ++h2) {
                const int kk0 = 16 * wave + 16 * (2 * tp + h2);
                int krow = kk0 + li; krow = krow > 255 ? 255 : krow;
                f32x4 acc = (f32x4){0.f, 0.f, 0.f, 0.f};
#pragma unroll
                for (int ks = 0; ks < 4; ++ks) {
                    const bf16x8 kf = *(const bf16x8*)(Ks + krow * 256 + (((4 * ks + fq) ^ (krow & 15)) << 4));
                    acc = __builtin_amdgcn_mfma_f32_16x16x32_bf16(kf, qf[ks], acc, 0, 0, 0);
                }
#pragma unroll
                for (int j = 0; j < 4; ++j) {
                    const int kp = kbase + kk0 + 4 * fq + j;
                    const int rel = kp - qp;
                    ok[4 * h2 + j] = (kp >= 0) && (kp < M) && (rel <= 64) && (rel >= -64);
                    s[4 * h2 + j] = acc[j] * scale;
                }
            }
            float mx = -1e30f;
#pragma unroll
            for (int j = 0; j < 8; ++j) mx = ok[j] ? fmaxf(mx, s[j]) : mx;
            mx = fmaxf(mx, __shfl_xor(mx, 16));
            mx = fmaxf(mx, __shfl_xor(mx, 32));
            const float mn = fmaxf(m, mx);
            const float al = __expf(m - mn);
            float ps = 0.f; float p[8];
#pragma unroll
            for (int j = 0; j < 8; ++j) { p[j] = ok[j] ? __expf(s[j] - mn) : 0.f; ps += p[j]; }
            l = l * al + ps; m = mn;
            const attn_u32x4 p_ = {pack2(p[0], p[1]), pack2(p[2], p[3]), pack2(p[4], p[5]), pack2(p[6], p[7])};
            const bf16x8 pf = __builtin_bit_cast(bf16x8, p_);
#pragma unroll
            for (int dt = 0; dt < 8; ++dt) o[dt] *= al;
            int rowA = 16 * wave + 32 * tp + 4 * fq + (li >> 2); rowA = rowA > 255 ? 255 : rowA;
            int rowB = 16 * wave + 32 * tp + 16 + 4 * fq + (li >> 2); rowB = rowB > 255 ? 255 : rowB;
#pragma unroll
            for (int dt = 0; dt < 8; ++dt) {
                const int chunk = 2 * dt + ((li & 3) >> 1), sub = ((li & 3) & 1) * 8;
                const s16x4 va = __builtin_amdgcn_ds_read_tr16_b64_v4i16((LAS s16x4*)(Vs + rowA * 256 + ((chunk ^ (rowA & 15)) << 4) + sub));
                const s16x4 vb = __builtin_amdgcn_ds_read_tr16_b64_v4i16((LAS s16x4*)(Vs + rowB * 256 + ((chunk ^ (rowB & 15)) << 4) + sub));
                const bf16x8 vf = __builtin_shufflevector(va, vb, 0, 1, 2, 3, 4, 5, 6, 7);
                o[dt] = __builtin_amdgcn_mfma_f32_16x16x32_bf16(vf, pf, o[dt], 0, 0, 0);
            }
        }
        l += __shfl_xor(l, 16);
        l += __shfl_xor(l, 32);
        const float inv = 1.f / l;
        u16* orow = part_o + ((size_t)pat * Ttot + tq) * 1024 + hh * 128 + 4 * fq;
#pragma unroll
        for (int dt = 0; dt < 8; ++dt)
            *(uint2*)(orow + 16 * dt) = make_uint2(pack2(o[dt][0] * inv, o[dt][1] * inv), pack2(o[dt][2] * inv, o[dt][3] * inv));
        if (fq == 0) part_lse[((size_t)pat * Ttot + tq) * 8 + hh] = m + logf(l);
    }
#undef ATTN_LD1
#undef ATTN_LOAD
#undef ATTN_ST1
#undef ATTN_COMMIT
}

__device__ __forceinline__ void attn_merge_token(const u16* __restrict__ part_o, const float* __restrict__ part_lse, int Ttot, size_t t,
                                                 u16* __restrict__ dst  , int lane) {
    const int hh = lane >> 3;
    const float l0 = part_lse[((size_t)0 * Ttot + t) * 8 + hh], l1 = part_lse[((size_t)1 * Ttot + t) * 8 + hh], l2 = part_lse[((size_t)2 * Ttot + t) * 8 + hh];
    const float mx = fmaxf(l0, fmaxf(l1, l2));
    const float e0 = __expf(l0 - mx), e1 = __expf(l1 - mx), e2 = __expf(l2 - mx);
    const float inv = 1.f / (e0 + e1 + e2);
    const float w[3] = {e0 * inv, e1 * inv, e2 * inv};
    float acc[16];
#pragma unroll
    for (int i = 0; i < 16; ++i) acc[i] = 0.f;
#pragma unroll
    for (int p = 0; p < 3; ++p) {
        const uint4* src = (const uint4*)(part_o + ((size_t)p * Ttot + t) * 1024 + lane * 16);
        const uint4 a = src[0], bb = src[1];
        acc[0] += w[p] * lo2f(a.x); acc[1] += w[p] * hi2f(a.x); acc[2] += w[p] * lo2f(a.y); acc[3] += w[p] * hi2f(a.y);
        acc[4] += w[p] * lo2f(a.z); acc[5] += w[p] * hi2f(a.z); acc[6] += w[p] * lo2f(a.w); acc[7] += w[p] * hi2f(a.w);
        acc[8] += w[p] * lo2f(bb.x); acc[9] += w[p] * hi2f(bb.x); acc[10] += w[p] * lo2f(bb.y); acc[11] += w[p] * hi2f(bb.y);
        acc[12] += w[p] * lo2f(bb.z); acc[13] += w[p] * hi2f(bb.z); acc[14] += w[p] * lo2f(bb.w); acc[15] += w[p] * hi2f(bb.w);
    }
    uint4* d = (uint4*)(dst + lane * 16);
    d[0] = make_uint4(pack2(acc[0], acc[1]), pack2(acc[2], acc[3]), pack2(acc[4], acc[5]), pack2(acc[6], acc[7]));
    d[1] = make_uint4(pack2(acc[8], acc[9]), pack2(acc[10], acc[11]), pack2(acc[12], acc[13]), pack2(acc[14], acc[15]));
}

__device__ __forceinline__ void phase_mixers(const Args& a, unsigned char* lds) {
    const int bi = blockIdx.x, G = gridDim.x;
    if (bi < 64) {
        gla_seq_item((const u16*)(a.ws + WS_P), NP, C_GV, S, a.ws + WS_QD, a.ws + WS_KE, a.ws + WS_AT, (const float*)(a.ws + WS_DEC),
                     (u16*)(a.ws + WS_OFB), T, lds, bi);
    } else {
        u16* part_o = (u16*)a.out; float* part_lse = (float*)((unsigned char*)a.out + (size_t)3 * T * 1024 * 2);
        attn_phase((const u16*)(a.ws + WS_P), NP, C_DQ, C_DK, C_DV, S, part_o, part_lse, T, lds, bi - 64, G - 64, 3 * 4 * 8 * (S / 128));
    }
}

__device__ __forceinline__ void phase_gla_fin(const Args& a) {
    const u16* Of = (const u16*)(a.ws + WS_OFB);
    const u16* Ob = Of + (size_t)T * 1024;
    const u16* P = (const u16*)(a.ws + WS_P);
    u16* A2 = (u16*)(a.ws + WS_ACT);
    const u16* part_o = (const u16*)a.out; const float* part_lse = (const float*)((const unsigned char*)a.out + (size_t)3 * T * 1024 * 2);
    const int lane = threadIdx.x & 63, wave = threadIdx.x >> 6;
    const int gw = blockIdx.x * NWAVES + wave, NGW = gridDim.x * NWAVES;
    const int hh = lane >> 4;
    float gg[16];
#pragma unroll
    for (int k = 0; k < 4; ++k) { const float4 g4 = *(const float4*)(a.g_gla + lane * 16 + 4 * k); gg[4 * k] = g4.x; gg[4 * k + 1] = g4.y; gg[4 * k + 2] = g4.z; gg[4 * k + 3] = g4.w; }
    for (int t = gw; t < T; t += NGW) {
        const uint4* fp = (const uint4*)(Of + (size_t)t * 1024 + lane * 16); const uint4* bp = (const uint4*)(Ob + (size_t)t * 1024 + lane * 16);
        const uint4* rp = (const uint4*)(P + (size_t)t * NP + C_GR + lane * 16);
#define NT16(p_) ({ const f32x4 q_ = __builtin_nontemporal_load((const f32x4*)(p_)); make_uint4(__float_as_uint(q_[0]), __float_as_uint(q_[1]), __float_as_uint(q_[2]), __float_as_uint(q_[3])); })
        const uint4 f0 = NT16(fp), f1 = NT16(fp + 1), b0 = NT16(bp), b1 = NT16(bp + 1), r0 = NT16(rp), r1 = NT16(rp + 1);
#undef NT16
        attn_merge_token(part_o, part_lse, T, (size_t)t, A2 + (size_t)t * D + 1024, lane);
        const unsigned fw[8] = {f0.x, f0.y, f0.z, f0.w, f1.x, f1.y, f1.z, f1.w}, bw[8] = {b0.x, b0.y, b0.z, b0.w, b1.x, b1.y, b1.z, b1.w};
        const unsigned rw[8] = {r0.x, r0.y, r0.z, r0.w, r1.x, r1.y, r1.z, r1.w};
        float o[16]; float ss = 0.f;
#pragma unroll
        for (int k = 0; k < 8; ++k) { o[2 * k] = lo2f(fw[k]) + lo2f(bw[k]); o[2 * k + 1] = hi2f(fw[k]) + hi2f(bw[k]); ss += o[2 * k] * o[2 * k] + o[2 * k + 1] * o[2 * k + 1]; }
        ss += __shfl_xor(ss, 1); ss += __shfl_xor(ss, 2); ss += __shfl_xor(ss, 4); ss += __shfl_xor(ss, 8);
        const float rstd = rsqrtf(ss * (1.f / 256.f) + NORM_EPS);
        unsigned y[8];
#pragma unroll
        for (int k = 0; k < 8; ++k) y[k] = pack2(o[2 * k] * rstd * gg[2 * k] * silu_f(lo2f(rw[k])), o[2 * k + 1] * rstd * gg[2 * k + 1] * silu_f(hi2f(rw[k])));
        uint4* dp = (uint4*)(A2 + (size_t)t * D + lane * 16);
        dp[0] = make_uint4(y[0], y[1], y[2], y[3]); dp[1] = make_uint4(y[4], y[5], y[6], y[7]);
    }
    (void)hh;
}

typedef float f32x16 __attribute__((ext_vector_type(16)));
#define RT_CE(a_, b_) do { const float hi_ = fmaxf(a_, b_), lo_ = fminf(a_, b_); a_ = hi_; b_ = lo_; } while (0)
template <int N> __device__ __forceinline__ void rt_sort_desc(float (&v)[N], int base) {
#pragma unroll
    for (int k = 2; k <= 16; k <<= 1)
#pragma unroll
        for (int j = k >> 1; j > 0; j >>= 1)
#pragma unroll
            for (int i = 0; i < 16; ++i) {
                const int l = i ^ j;
                if (l > i) { if ((i & k) == 0) RT_CE(v[base + i], v[base + l]); else RT_CE(v[base + l], v[base + i]); }
            }
}
template <int N> __device__ __forceinline__ void rt_merge_desc(float (&v)[N], int a, int b) {
#pragma unroll
    for (int i = 0; i < 16; ++i) v[a + i] = fmaxf(v[a + i], v[b + 15 - i]);
#pragma unroll
    for (int j = 8; j > 0; j >>= 1)
#pragma unroll
        for (int i = 0; i < 16; ++i) { const int l = i ^ j; if (l > i) RT_CE(v[a + i], v[a + l]); }
}

__device__ __forceinline__ void route_stage_keys(const float* __restrict__ subk, int hh, unsigned char* lds) {
    const int tid = TID;
    __syncthreads();
    for (int e = tid; e < 2 * 128 * 16; e += 512) {
        const int c = e & 15, row = e >> 4;
        const float* src = subk + ((size_t)(hh * 2) * 128 + row) * 128 + c * 8;
        const float4 v0 = *(const float4*)src, v1 = *(const float4*)(src + 4);
        *(uint4*)(lds + row * 256 + ((c ^ (row & 15)) << 4)) = make_uint4(pack2(v0.x, v0.y), pack2(v0.z, v0.w), pack2(v1.x, v1.y), pack2(v1.z, v1.w));
    }
    __syncthreads();
}

__device__ __forceinline__ void route_tile(const u16* __restrict__ Q, int ldq, int hh, int tok_base, const unsigned char* lds,
                                           int* __restrict__ IDX, float* __restrict__ GATE) {
    const int lane = TID & 63, r = lane & 31, h = lane >> 5;
    float sc[128];
    {
        f32x16 X[4], Y[4];
#pragma unroll
        for (int kt = 0; kt < 4; ++kt) {
#pragma unroll
            for (int i = 0; i < 16; ++i) { X[kt][i] = 0.f; Y[kt][i] = 0.f; }
        }
        const u16* qrow = Q + (size_t)(tok_base + r) * ldq + hh * 256;
#pragma unroll
        for (int half = 0; half < 2; ++half) {
            bf16x8 qf[8];
#pragma unroll
            for (int ks = 0; ks < 8; ++ks) qf[ks] = *(const bf16x8*)(qrow + half * 128 + 16 * ks + 8 * h);
#pragma unroll
            for (int kt = 0; kt < 4; ++kt) {
                const int krow = half * 128 + 32 * kt + r;
#pragma unroll
                for (int ks = 0; ks < 8; ++ks) {
                    const bf16x8 kf = *(const bf16x8*)(lds + krow * 256 + (((2 * ks + h) ^ (krow & 15)) << 4));
                    if (half == 0) X[kt] = __builtin_amdgcn_mfma_f32_32x32x16_bf16(kf, qf[ks], X[kt], 0, 0, 0);
                    else Y[kt] = __builtin_amdgcn_mfma_f32_32x32x16_bf16(kf, qf[ks], Y[kt], 0, 0, 0);
                }
            }
        }
#pragma unroll
        for (int kt = 0; kt < 4; ++kt)
#pragma unroll
            for (int i = 0; i < 16; ++i) {
                const auto sw = __builtin_amdgcn_permlane32_swap(__float_as_uint(X[kt][i]), __float_as_uint(Y[kt][i]), false, false);
                const int key0 = 32 * kt + (i & 3) + 8 * (i >> 2);
                sc[kt * 32 + i] = __uint_as_float((sw[0] & 0xffffff80u) | (unsigned)key0);
                sc[kt * 32 + 16 + i] = __uint_as_float((sw[1] & 0xffffff80u) | (unsigned)(key0 + 4));
            }
    }
#pragma unroll
    for (int g = 0; g < 8; ++g) rt_sort_desc(sc, 16 * g);
    rt_merge_desc(sc, 0, 16); rt_merge_desc(sc, 32, 48); rt_merge_desc(sc, 64, 80); rt_merge_desc(sc, 96, 112);
    rt_merge_desc(sc, 0, 32); rt_merge_desc(sc, 64, 96);
    rt_merge_desc(sc, 0, 64);
    float l0[16], l1[16];
#pragma unroll
    for (int i = 0; i < 16; ++i) {
        const auto sw = __builtin_amdgcn_permlane32_swap(__float_as_uint(sc[i]), __float_as_uint(sc[i]), false, false);
        l0[i] = __uint_as_float(sw[0]); l1[i] = __uint_as_float(sw[1]);
    }
    float s0[16], s1[16]; int k0[16], k1[16];
#pragma unroll
    for (int i = 0; i < 16; ++i) {
        const unsigned a = __float_as_uint(l0[i]), b = __float_as_uint(l1[i]);
        s0[i] = __uint_as_float(a & 0xffffff80u); k0[i] = (int)(a & 0x7fu);
        s1[i] = __uint_as_float(b & 0xffffff80u); k1[i] = (int)(b & 0x7fu);
    }
    float cs[64];
    {
        int n = 0;
#pragma unroll
        for (int i = 0; i < 16; ++i)
#pragma unroll
            for (int j = 0; j < 16; ++j)
                if ((i + 1) * (j + 1) <= 16) { cs[n] = s0[i] + s1[j]; ++n; }
#pragma unroll
        for (int q = 50; q < 64; ++q) cs[q] = -3.0e38f;
    }
    float ct[64];
#pragma unroll
    for (int q = 0; q < 64; ++q) ct[q] = cs[q];
#pragma unroll
    for (int g = 0; g < 4; ++g) rt_sort_desc(ct, 16 * g);
    rt_merge_desc(ct, 0, 16); rt_merge_desc(ct, 32, 48); rt_merge_desc(ct, 0, 32);
    const float theta = ct[15], smax = ct[0];
    float den = 0.f;
    {
        int cnt = 0;
#pragma unroll
        for (int q = 0; q < 50; ++q) { const bool sel = (cs[q] >= theta) && (cnt < 16); den += sel ? __expf(cs[q] - smax) : 0.f; cnt += sel ? 1 : 0; }
    }
    const float inv = 1.f / den;
    const size_t obase = (size_t)(tok_base + r) * 128 + hh * 16;
    int pos = 0;
    {
        int n = 0;
#pragma unroll
        for (int i = 0; i < 16; ++i)
#pragma unroll
            for (int j = 0; j < 16; ++j)
                if ((i + 1) * (j + 1) <= 16) {
                    const bool sel = (cs[n] >= theta) && (pos < 16);
                    if (sel) {
                        if (h == 0) IDX[obase + pos] = k0[i] * 128 + k1[j];
                        else GATE[obase + pos] = __expf(cs[n] - smax) * inv;
                        ++pos;
                    }
                    ++n;
                }
    }
}
__device__ __forceinline__ void phase_route(const Args& a, unsigned char* lds) {
    const int hh = BID & 7, grp = BID >> 3, ngrp = GDIM >> 3, wave = TID >> 6;
    route_stage_keys(a.subk, hh, lds);
    int j = 0;
    for (int tile = grp; tile < T / 32; tile += ngrp, ++j)
        if ((j & 7) == wave) route_tile((const u16*)(a.ws + WS_Q), D, hh, tile * 32, lds, (int*)(a.ws + WS_IDX), (float*)(a.ws + WS_GATE));
    __syncthreads();
}

typedef __bf16 bf16x2_t __attribute__((ext_vector_type(2)));
__device__ __forceinline__ float dot2bf(unsigned w, unsigned x, float acc) {
    return __builtin_amdgcn_fdot2_f32_bf16(__builtin_bit_cast(bf16x2_t, w), __builtin_bit_cast(bf16x2_t, x), acc, false);
}
constexpr int TROW = 1024;
typedef float f32x2_t __attribute__((ext_vector_type(2)));
typedef int i32x8 __attribute__((ext_vector_type(8)));
__device__ __forceinline__ void convert_tables(const Args& a) {
    const int lane = threadIdx.x & 63, wave = threadIdx.x >> 6;
    const int gw = blockIdx.x * NWAVES + wave, NGW = gridDim.x * NWAVES;
    for (int row = gw; row < 2 * 16384; row += NGW) {
        const bool isv = row >= 16384; const int e = isv ? row - 16384 : row;
        const f32x4* sp = (const f32x4*)((isv ? a.pv : a.pu) + (size_t)e * D);
        unsigned char* dst = a.ws + (isv ? WS_TV : WS_TU) + (size_t)e * TROW;
        unsigned char* sdst = a.ws + (isv ? WS_SV : WS_SU) + (size_t)e * 64;
        f32x4 v[8];
#pragma unroll
        for (int k = 0; k < 8; ++k) v[k] = __builtin_nontemporal_load(sp + lane + 64 * k);
#pragma unroll
        for (int k = 0; k < 8; ++k) {
            float mx = fmaxf(fmaxf(fabsf(v[k][0]), fabsf(v[k][1])), fmaxf(fabsf(v[k][2]), fabsf(v[k][3])));
            mx = fmaxf(mx, __shfl_xor(mx, 1)); mx = fmaxf(mx, __shfl_xor(mx, 2)); mx = fmaxf(mx, __shfl_xor(mx, 4));
            float inv; u16 sb;
            {
                const unsigned bits = __float_as_uint(mx);
                int kx = (int)(bits >> 23) - 127 - 2 + (((bits & 0x7fffffu) > 0x400000u) ? 1 : 0);
                kx = kx < -126 ? -126 : kx;
                sb = (u16)(kx + 127);
                inv = __uint_as_float((unsigned)(127 - kx) << 23);
            }
            unsigned p = 0u;
            p = __builtin_amdgcn_cvt_scalef32_pk_fp4_f32(p, v[k][0] * inv, v[k][1] * inv, 1.0f, 0);
            p = __builtin_amdgcn_cvt_scalef32_pk_fp4_f32(p, v[k][2] * inv, v[k][3] * inv, 1.0f, 1);
            const int i = lane + 64 * k;
            *(u16*)(dst + 2 * i) = (u16)p;
            if ((lane & 7) == 0) {
                const int blk = i >> 3;
                if (isv) sdst[blk] = (unsigned char)sb; else sdst[2 * (blk & 31) + (blk >> 5)] = (unsigned char)sb;
            }
        }
    }
}

__device__ __forceinline__ void axpy32_fp4(const uint4 w, const float s, float (&acc)[32]) {
    const unsigned ww[4] = {w.x, w.y, w.z, w.w};
#pragma unroll
    for (int k = 0; k < 4; ++k) {
        const f32x2_t a0 = __builtin_amdgcn_cvt_scalef32_pk_f32_fp4(ww[k], 1.0f, 0), a1 = __builtin_amdgcn_cvt_scalef32_pk_f32_fp4(ww[k], 1.0f, 1);
        const f32x2_t a2 = __builtin_amdgcn_cvt_scalef32_pk_f32_fp4(ww[k], 1.0f, 2), a3 = __builtin_amdgcn_cvt_scalef32_pk_f32_fp4(ww[k], 1.0f, 3);
        acc[8 * k + 0] += s * a0.x; acc[8 * k + 1] += s * a0.y; acc[8 * k + 2] += s * a1.x; acc[8 * k + 3] += s * a1.y;
        acc[8 * k + 4] += s * a2.x; acc[8 * k + 5] += s * a2.y; acc[8 * k + 6] += s * a3.x; acc[8 * k + 7] += s * a3.y;
    }
}
__device__ __forceinline__ void phase_experts(const Args& a) {
    const u16* H2 = (const u16*)(a.ws + WS_ACT);
    const u16* X1 = (const u16*)(a.ws + WS_X1);
    const int* IDX = (const int*)(a.ws + WS_IDX);
    const float* GATE = (const float*)(a.ws + WS_GATE);
    const float* mod = (const float*)(a.ws + WS_MOD);
    const unsigned char* U = a.ws + WS_TU; const unsigned char* V = a.ws + WS_TV;
    const int lane = threadIdx.x & 63, wave = threadIdx.x >> 6;
    const int gw = blockIdx.x * NWAVES + wave, NGW = gridDim.x * NWAVES;
    int iv0 = 0, iv1 = 0; float gv0 = 0.f, gv1 = 0.f;
    int niv0 = 0, niv1 = 0; float ngv0 = 0.f, ngv1 = 0.f;
    uint4 rA[4], rB[4]; u16 sA[4], sB[4];
    const int mrow = lane & 15, kg = lane >> 4, ee2 = mrow >> 3;
    const int loff = 128 * kg + 16 * (mrow & 7), soff = 2 * (8 * kg + (mrow & 7));
    const bool dvalid = ((mrow >> 3) == (kg & 1)); const int jsel = (mrow >> 1) & 3; const bool js1 = jsel == 1, js2 = jsel == 2, js3 = jsel == 3;
    uint4 uA[4], uB[4]; u16 usA[2], usB[2];
#define UP_LOAD(r_, s_, p0_) do { _Pragma("unroll") for (int q = 0; q < 2; ++q) { \
            const int pp_ = (p0_) + q; const int e0_ = __builtin_amdgcn_readlane(iv0, pp_), e1_ = __builtin_amdgcn_readlane(iv1, pp_); const int e_ = ee2 ? e1_ : e0_; \
            const unsigned char* rp_ = U + (size_t)e_ * TROW + loff; \
            r_[2 * q] = *(const uint4*)rp_; r_[2 * q + 1] = *(const uint4*)(rp_ + 512); \
            s_[q] = *(const u16*)(a.ws + WS_SU + (size_t)e_ * 64 + soff); } } while (0)
#define ROW_LOAD(TB_, r_, s_, r0_) do { _Pragma("unroll") for (int q = 0; q < 4; ++q) { \
            const int rr_ = (r0_) + q; const int e_ = __builtin_amdgcn_readlane(rr_ < 64 ? iv0 : iv1, rr_ & 63); \
            const unsigned char* rp_ = TB_ + (size_t)e_ * TROW; \
            const unsigned char* sp_ = a.ws + WS_SV + (size_t)e_ * 64; \
            r_[q] = *(const uint4*)(rp_ + lane * 16); s_[q] = (u16)*(sp_ + lane); } } while (0)
#define TOK_FETCH(t_, i0_, i1_, g0_, g1_) do { \
            i0_ = IDX[(size_t)(t_) * 128 + lane]; i1_ = IDX[(size_t)(t_) * 128 + 64 + lane]; \
            g0_ = GATE[(size_t)(t_) * 128 + lane]; g1_ = GATE[(size_t)(t_) * 128 + 64 + lane]; } while (0)
    if (gw < T) { TOK_FETCH(gw, iv0, iv1, gv0, gv1); UP_LOAD(uA, usA, 0); }
    for (int t = gw; t < T; t += NGW) {
        const int b = t / S;
        const bool has_next = (t + NGW) < T;
        int kxt;
        {
            const f32x4* hp_ = (const f32x4*)(H2 + (size_t)t * D + 32 * lane); float mx_ = 0.f;
#pragma unroll
            for (int k = 0; k < 4; ++k) { const f32x4 pn = hp_[k];
                const uint4 p = make_uint4(__float_as_uint(pn[0]), __float_as_uint(pn[1]), __float_as_uint(pn[2]), __float_as_uint(pn[3]));
                mx_ = fmaxf(mx_, fmaxf(fmaxf(fmaxf(fabsf(lo2f(p.x)), fabsf(hi2f(p.x))), fmaxf(fabsf(lo2f(p.y)), fabsf(hi2f(p.y)))), fmaxf(fmaxf(fabsf(lo2f(p.z)), fabsf(hi2f(p.z))), fmaxf(fabsf(lo2f(p.w)), fabsf(hi2f(p.w)))))); }
#pragma unroll
            for (int o = 32; o > 0; o >>= 1) mx_ = fmaxf(mx_, __shfl_xor(mx_, o));
            const unsigned bits_ = __float_as_uint(mx_);
            kxt = (int)(bits_ >> 23) - 127 - 8 + (((bits_ & 0x7fffffu) > 0x600000u) ? 1 : 0); kxt = kxt < -100 ? -100 : kxt;
        }
        const float hinvt = __uint_as_float((unsigned)(127 - kxt) << 23);
        const int sbt = 127 + kxt - ((lane & 1) ? 4 : 0);
#define H_BUILD(HB_, s_, KOF_) do { \
            _Pragma("unroll") for (int i = 0; i < 8; ++i) { \
                const int k_ = KOF_(4 * i); const u16* hq_ = H2 + (size_t)t * D + 1024 * (s_) + 256 * (k_ >> 5) + 32 * (mrow >> 1) + (k_ & 31); \
                const uint2 pr_ = *(const uint2*)hq_; \
                const float x0_ = lo2f(pr_.x) * hinvt, x1_ = hi2f(pr_.x) * hinvt, x2_ = lo2f(pr_.y) * hinvt, x3_ = hi2f(pr_.y) * hinvt; \
                int w_ = __builtin_amdgcn_cvt_pk_fp8_f32(x0_, x1_, 0, false); w_ = __builtin_amdgcn_cvt_pk_fp8_f32(x2_, x3_, w_, true); \
                const f32x2_t d0_ = __builtin_amdgcn_cvt_pk_f32_fp8(w_, false), d1_ = __builtin_amdgcn_cvt_pk_f32_fp8(w_, true); \
                int l_ = __builtin_amdgcn_cvt_pk_fp8_f32((x0_ - d0_[0]) * 16.f, (x1_ - d0_[1]) * 16.f, 0, false); \
                l_ = __builtin_amdgcn_cvt_pk_fp8_f32((x2_ - d1_[0]) * 16.f, (x3_ - d1_[1]) * 16.f, l_, true); \
                HB_[i] = (lane & 1) ? l_ : w_; } } while (0)
#define KOF_H2(b_) (((b_) < 16) ? (16 * kg + (b_)) : (64 + 16 * kg + (b_) - 16))
        i32x8 hB0, hB1;
        H_BUILD(hB0, 0, KOF_H2); H_BUILD(hB1, 1, KOF_H2);
#undef H_BUILD
        float a0 = 0.f, a1 = 0.f;
#define DPP_ADD(v_, ctrl_) v_ += __builtin_bit_cast(float, __builtin_amdgcn_update_dpp(0, __builtin_bit_cast(int, v_), ctrl_, 0xf, 0xf, true))
#define UP_COMPUTE(r_, s_, p0_) do { float v_[2]; \
            _Pragma("unroll") for (int q = 0; q < 2; ++q) { \
                const i32x8 A0_ = {(int)r_[2 * q].x, (int)r_[2 * q].y, (int)r_[2 * q].z, (int)r_[2 * q].w, 0, 0, 0, 0}; \
                const i32x8 A1_ = {(int)r_[2 * q + 1].x, (int)r_[2 * q + 1].y, (int)r_[2 * q + 1].z, (int)r_[2 * q + 1].w, 0, 0, 0, 0}; \
                f32x4 c_ = {0.f, 0.f, 0.f, 0.f}; \
                c_ = __builtin_amdgcn_mfma_scale_f32_16x16x128_f8f6f4(A0_, hB0, c_, 4, 0, 0, (int)s_[q], 0, sbt); \
                c_ = __builtin_amdgcn_mfma_scale_f32_16x16x128_f8f6f4(A1_, hB1, c_, 4, 0, 1, (int)s_[q], 0, sbt); \
                float t_ = c_[0]; t_ = js1 ? c_[1] : t_; t_ = js2 ? c_[2] : t_; t_ = js3 ? c_[3] : t_; v_[q] = dvalid ? t_ : 0.f; } \
            DPP_ADD(v_[0], 0xB1); DPP_ADD(v_[1], 0xB1); DPP_ADD(v_[0], 0x4E); DPP_ADD(v_[1], 0x4E); \
            DPP_ADD(v_[0], 0x141); DPP_ADD(v_[1], 0x141); DPP_ADD(v_[0], 0x140); DPP_ADD(v_[1], 0x140); \
            _Pragma("unroll") for (int q = 0; q < 2; ++q) { const int pp_ = (p0_) + q; \
                const float x0_ = __builtin_bit_cast(float, __builtin_amdgcn_readlane(__builtin_bit_cast(int, v_[q]), 0)) + __builtin_bit_cast(float, __builtin_amdgcn_readlane(__builtin_bit_cast(int, v_[q]), 16)); \
                const float x1_ = __builtin_bit_cast(float, __builtin_amdgcn_readlane(__builtin_bit_cast(int, v_[q]), 32)) + __builtin_bit_cast(float, __builtin_amdgcn_readlane(__builtin_bit_cast(int, v_[q]), 48)); \
                a0 = (lane == pp_) ? x0_ : a0; a1 = (lane == pp_) ? x1_ : a1; } } while (0)
#pragma unroll 1
        for (int p0 = 0; p0 < 64; p0 += 4) {
            UP_LOAD(uB, usB, p0 + 2);
            UP_COMPUTE(uA, usA, p0);
            if (p0 + 4 < 64) UP_LOAD(uA, usA, p0 + 4); else ROW_LOAD(V, rA, sA, 0);
            UP_COMPUTE(uB, usB, p0 + 2);
        }
#undef UP_COMPUTE
#undef DPP_ADD
        const float w0 = gv0 * gelu_f(a0), w1 = gv1 * gelu_f(a1);
        float acc[32];
#pragma unroll
        for (int i = 0; i < 32; ++i) acc[i] = 0.f;
#define V_COMPUTE(r_, s_, r0_) do { _Pragma("unroll") for (int q = 0; q < 4; ++q) { const int rr_ = (r0_) + q; \
                const float g_ = __builtin_bit_cast(float, __builtin_amdgcn_readlane(__builtin_bit_cast(int, rr_ < 64 ? w0 : w1), rr_ & 63)); \
                axpy32_fp4(r_[q], g_ * __uint_as_float((unsigned)s_[q] << 23), acc); } } while (0)
        if (has_next) TOK_FETCH(t + NGW, niv0, niv1, ngv0, ngv1);
#pragma unroll 1
        for (int r0 = 0; r0 < 128; r0 += 8) {
            ROW_LOAD(V, rB, sB, r0 + 4);
            V_COMPUTE(rA, sA, r0);
            if (r0 + 8 < 128) ROW_LOAD(V, rA, sA, r0 + 8);
            else if (has_next) { iv0 = niv0; iv1 = niv1; gv0 = ngv0; gv1 = ngv1; UP_LOAD(uA, usA, 0); }
            V_COMPUTE(rB, sB, r0 + 4);
        }
#undef V_COMPUTE
        float ss = 0.f;
#pragma unroll
        for (int k = 0; k < 8; ++k) {
            const int c0 = lane * 32 + 4 * k;
            const hw_f32x2 xn = __builtin_nontemporal_load((const hw_f32x2*)(X1 + (size_t)t * D + c0));
            const uint2 xp = make_uint2(__float_as_uint(xn[0]), __float_as_uint(xn[1]));
            const float4 xa = make_float4(lo2f(xp.x), hi2f(xp.x), lo2f(xp.y), hi2f(xp.y));
            const float4 ga = *(const float4*)(mod + b * 12288 + 5 * 2048 + c0);
            acc[4 * k + 0] = xa.x + ga.x * acc[4 * k + 0]; acc[4 * k + 1] = xa.y + ga.y * acc[4 * k + 1];
            acc[4 * k + 2] = xa.z + ga.z * acc[4 * k + 2]; acc[4 * k + 3] = xa.w + ga.w * acc[4 * k + 3];
#pragma unroll
            for (int i = 0; i < 4; ++i) ss += acc[4 * k + i] * acc[4 * k + i];
        }
        ss = wave_sum(ss);
        const float rstd = rsqrtf(ss * (1.f / D) + NORM_EPS);
#pragma unroll
        for (int k = 0; k < 8; ++k) {
            const int c0 = lane * 32 + 4 * k;
            const float4 gf = *(const float4*)(a.g_fin + c0);
            *(float4*)(a.out + (size_t)t * D + c0) = make_float4(acc[4 * k + 0] * rstd * gf.x, acc[4 * k + 1] * rstd * gf.y, acc[4 * k + 2] * rstd * gf.z, acc[4 * k + 3] * rstd * gf.w);
        }
    }
#undef ROW_LOAD
#undef UP_LOAD
#undef TOK_FETCH
}

#define XB_TMO      128
#define XB_XCNT(j)  (256  + 64 * (j))
#define XB_XSUB(j)  (1280 + 64 * (j))
#define XB_XGEN(j)  (2304 + 64 * (j))
#define XB_TOP      3328
#define XB_TOPGEN   3392
#define XCD_BAR_WORDS 3456
#define XB_SPIN_CAP (1u << 18)

__device__ __forceinline__ unsigned xb_ld(unsigned* p)              { return __hip_atomic_load(p, __ATOMIC_RELAXED, __HIP_MEMORY_SCOPE_AGENT); }
__device__ __forceinline__ unsigned xb_add(unsigned* p, unsigned v) { return __hip_atomic_fetch_add(p, v, __ATOMIC_RELAXED, __HIP_MEMORY_SCOPE_AGENT); }
__device__ __forceinline__ unsigned xb_xcc_id() { return (unsigned)__builtin_amdgcn_s_getreg((3 << 11) | 20) & 0xFu; }
#define XB_SPIN(cond, bar) do { unsigned _sp = 0; while (cond) { __builtin_amdgcn_s_sleep(1); \
    if ((++_sp & 255u) == 0u) { if (xb_ld(&(bar)[XB_TMO])) break; if (_sp > XB_SPIN_CAP) { atomicAdd(&(bar)[XB_TMO], 1u); break; } } } } while (0)

struct XcdBarrier {
    unsigned* bar; unsigned x;
    volatile LAS unsigned* st;
};

__device__ __forceinline__ XcdBarrier xcd_barrier_post(unsigned* bar, volatile LAS unsigned* st) {
    XcdBarrier b; b.bar = bar; b.x = xb_xcc_id(); b.st = st;
    if (threadIdx.x == 0) (void)xb_add(&bar[XB_XCNT(b.x)], 1u);
    return b;
}
__device__ __forceinline__ void xcd_barrier_complete(unsigned* bar, unsigned x, unsigned& nloc, unsigned& nx) {
    const unsigned G = gridDim.x * gridDim.y * gridDim.z;
    unsigned sum, cnt, mine, sp = 0u;
    for (;;) {
        sum = 0u; cnt = 0u; mine = 0u;
#pragma unroll
        for (unsigned j = 0; j < 16; ++j) { const unsigned c = xb_ld(&bar[XB_XCNT(j)]); sum += c; cnt += (c > 0u) ? 1u : 0u; mine = (j == x) ? c : mine; }
        if (sum == G) break;
        __builtin_amdgcn_s_sleep(1);
        if ((++sp & 255u) == 0u) { if (xb_ld(&bar[XB_TMO])) break; if (sp > XB_SPIN_CAP) { atomicAdd(&bar[XB_TMO], 1u); break; } }
    }
    nloc = mine > 0u ? mine : 1u; nx = cnt > 0u ? cnt : 1u;
}

__device__ __forceinline__ void xcd_barrier(const XcdBarrier& b) {
    asm volatile("s_waitcnt vmcnt(0)" ::: "memory");
    __syncthreads();
    if (threadIdx.x == 0) {
        unsigned* bar = b.bar;
        __builtin_amdgcn_s_waitcnt(0);
        unsigned nloc = b.st[0], nx = b.st[1];
        if (nloc == 0u) { xcd_barrier_complete(bar, b.x, nloc, nx); b.st[0] = nloc; b.st[1] = nx; }
        const unsigned old = xb_add(&bar[XB_XSUB(b.x)], 1u);
        const unsigned gen = old / nloc;
        if (old + 1u == (gen + 1u) * nloc) {
            __builtin_amdgcn_fence(__ATOMIC_RELEASE, "agent");
            asm volatile("s_waitcnt vmcnt(0)" ::: "memory");
            const unsigned og = xb_add(&bar[XB_TOP], 1u);
            const unsigned tg = og / nx;
            if (og + 1u == (tg + 1u) * nx) xb_add(&bar[XB_TOPGEN], 1u);
            else XB_SPIN(xb_ld(&bar[XB_TOPGEN]) == tg, bar);
            __builtin_amdgcn_fence(__ATOMIC_ACQUIRE, "agent");
            xb_add(&bar[XB_XGEN(b.x)], 1u);
            asm volatile("s_waitcnt vmcnt(0)" ::: "memory");
        } else {
            XB_SPIN(xb_ld(&bar[XB_XGEN(b.x)]) == gen, bar);
            __builtin_amdgcn_fence(__ATOMIC_ACQUIRE, "agent");
            asm volatile("s_waitcnt vmcnt(0)" ::: "memory");
        }
    }
    __syncthreads();
}

constexpr int NPHASES = 11;
__global__ void __launch_bounds__(NTHREADS, 2) mk_fwd(Args a) {
    extern __shared__ __attribute__((aligned(16))) unsigned char lds[];
    cg::grid_group grid = cg::this_grid();
    const int lo = a.ph_lo, hi = a.ph_hi;
    volatile LAS unsigned* xbw = (volatile LAS unsigned*)(lds + LDS_MAIN);
    if (threadIdx.x < 4) xbw[threadIdx.x] = 0u;
    __syncthreads();
    XcdBarrier xbar = xcd_barrier_post((unsigned*)(a.ws + WS_CTL), xbw);
#define IN(k) (lo <= (k) && (k) < hi)
    if (lo < 0) grid.sync();
#define SEAM(k) do { if (IN(k) && IN((k) + 1)) xcd_barrier(xbar); } while (0)
    const float* mod = (const float*)(a.ws + WS_MOD);
    if (IN(0)) phase0(a, lds);
    SEAM(0);
    if (IN(1)) norm_mod_phase<false>(a.x, a.g_mix, mod, 0, 1, (u16*)(a.ws + WS_ACT));
    SEAM(1);
    if (IN(2)) { gemm8(lds, (const u16*)(a.ws + WS_ACT), (const u16*)(a.ws + WS_WIN), T, NP, D, EpiProj{(u16*)(a.ws + WS_P), (const float*)(a.ws + WS_CS)}); gz_phase(lds, (const u16*)(a.ws + WS_ACT), (const u16*)(a.ws + WS_WIN) + (size_t)NP * D, (float*)(a.ws + WS_GZ)); }
    SEAM(2);
    if (IN(3)) phase_rope_prep(a, lds);
    SEAM(3);
    if (IN(4)) phase_mixers(a, lds);
    SEAM(4);
    if (IN(5)) phase_gla_fin(a);
    SEAM(5);
    if (IN(6)) gemm8(lds, (const u16*)(a.ws + WS_ACT), (const u16*)(a.ws + WS_WOUT), T, D, D, EpiResid{a.x, mod, (u16*)(a.ws + WS_X1)});
    SEAM(6);
    if (IN(7)) { norm_mod_phase<true>(a.ws + WS_X1, a.g_ffn, mod, 3, 4, (u16*)(a.ws + WS_ACT)); convert_tables(a); }
    SEAM(7);
    if (IN(8)) gemm8(lds, (const u16*)(a.ws + WS_ACT), (const u16*)(a.ws + WS_WPQ), T, D, D, EpiBf16{(u16*)(a.ws + WS_Q)});
    SEAM(8);
    if (IN(9)) phase_route(a, lds);
    SEAM(9);
    if (IN(10)) phase_experts(a);
#ifdef PROBE_REP10
    grid.sync(); phase_experts(a);
#endif
#ifdef PROBE_REP9
    grid.sync(); phase_route(a, lds); grid.sync(); phase_experts(a);
#endif
#undef IN
#undef SEAM
}

#ifndef MK_ONE_LAUNCH
#define MK_ONE_LAUNCH 1
#endif
extern "C" void kernel_launch(void* const* d_in, const int* in_sizes, int n_in, void* d_out, int out_size, void* d_ws, size_t ws_size, hipStream_t stream) {
    static int grid = 0;
    if (grid == 0) {
        if (n_in != 19 || out_size != T * D || ws_size < WS_END) {
            fprintf(stderr, "kernel_launch: unexpected shapes: n_in %d out %d ws %zu (need %zu)\n", n_in, out_size, ws_size, (size_t)WS_END);
            grid = -1; return;
        }
        int dev = 0, cus = 0, per_cu = 0;
        (void)hipGetDevice(&dev);
        (void)hipDeviceGetAttribute(&cus, hipDeviceAttributeMultiprocessorCount, dev);
        (void)hipFuncSetAttribute((const void*)mk_fwd, hipFuncAttributeMaxDynamicSharedMemorySize, LDS_BYTES);
        (void)hipOccupancyMaxActiveBlocksPerMultiprocessor(&per_cu, (const void*)mk_fwd, NTHREADS, LDS_BYTES);
        if (per_cu < 1) { fprintf(stderr, "kernel_launch: occupancy query says %d blocks/CU\n", per_cu); grid = -1; return; }
        grid = cus;
        (void)hipGetLastError();
    }
    if (grid < 0) return;
    Args a{};
    a.x = (const float*)d_in[0]; a.c = (const float*)d_in[1]; a.pos = (const int*)d_in[2]; a.w_ada = (const float*)d_in[3];
    a.b_ada = (const float*)d_in[4]; a.g_mix = (const float*)d_in[5]; a.w_in = (const float*)d_in[6]; a.wgf = (const float*)d_in[7];
    a.bgf = (const float*)d_in[8]; a.wgb = (const float*)d_in[9]; a.bgb = (const float*)d_in[10]; a.g_gla = (const float*)d_in[11];
    a.w_out = (const float*)d_in[12]; a.g_ffn = (const float*)d_in[13]; a.w_pq = (const float*)d_in[14]; a.subk = (const float*)d_in[15];
    a.pu = (const float*)d_in[16]; a.pv = (const float*)d_in[17]; a.g_fin = (const float*)d_in[18];
    a.out = (float*)d_out; a.ws = (unsigned char*)d_ws;
#if MK_ONE_LAUNCH
    (void)hipMemsetAsync((unsigned char*)d_ws + WS_CTL, 0, XCD_BAR_WORDS * 4, stream);
    a.ph_lo = 0; a.ph_hi = NPHASES;
    void* args[] = {&a};
    hipError_t e = hipLaunchCooperativeKernel((const void*)mk_fwd, dim3(grid), dim3(NTHREADS), args, LDS_BYTES, stream);
    if (e != hipSuccess) fprintf(stderr, "cooperative launch failed: %s (grid %d)\n", hipGetErrorString(e), grid);
#else
    for (int p = 0; p < NPHASES; ++p) {
        a.ph_lo = p; a.ph_hi = p + 1;
        hipLaunchKernelGGL(mk_fwd, dim3(grid), dim3(NTHREADS), LDS_BYTES, stream, a);
    }
#endif
}
```

```cpp
#include <hip/hip_runtime.h>
#include <hip/hip_cooperative_groups.h>
#include <cstdio>
#include <cstdint>

namespace cg = cooperative_groups;

typedef unsigned short u16;
typedef __attribute__((ext_vector_type(8))) short bf16x8;
typedef __attribute__((ext_vector_type(4))) float f32x4;
typedef short s16x4 __attribute__((ext_vector_type(4)));
#define TID ((int)threadIdx.x)
#define BID ((int)blockIdx.x)
#define GDIM ((int)gridDim.x)
#define LAS __attribute__((address_space(3)))

constexpr int D = 2048, NB = 4, S = 4096, T = NB * S;
constexpr int INW = 6176;
constexpr int NP = 6144;
constexpr int NPAD = 6208;
constexpr int C_GQ = 0, C_GK = 512, C_GV = 1024, C_GR = 2048, C_DQ = 3072, C_DK = 4096, C_DV = 5120;
constexpr int NTHREADS = 512, NWAVES = 8;
constexpr int LDS_MAIN = 128 * 1024;
constexpr int LDS_STAGE = 16 * 1024;
constexpr int LDS_BYTES = LDS_MAIN + 16 + LDS_STAGE;
constexpr float NORM_EPS = 1e-6f;

constexpr size_t WS_CTL = 0;
constexpr size_t WS_MOD = 65536;
constexpr size_t WS_CS = 524288;
constexpr size_t WS_WIN = WS_CS + (size_t)T * 64 * 8;
constexpr size_t WS_WOUT = WS_WIN + (size_t)NPAD * D * 2;
constexpr size_t WS_WPQ = WS_WOUT + (size_t)D * D * 2;
constexpr size_t WS_ACT = WS_WPQ + (size_t)D * D * 2;
constexpr size_t WS_P = WS_ACT + (size_t)T * D * 2;
constexpr size_t WS_X1 = WS_P;
constexpr size_t WS_Q = WS_P + (size_t)T * D * 4;
constexpr size_t WS_GZ = WS_P + (size_t)T * NP * 2;
constexpr int GLA_NPREP = NB * 4 * 2 * (S / 64);
constexpr size_t WS_QD = WS_GZ + (size_t)T * 32 * 4;
constexpr size_t WS_KE = WS_QD + (size_t)GLA_NPREP * 16384;
constexpr size_t WS_AT = WS_KE + (size_t)GLA_NPREP * 16384;
constexpr size_t WS_DEC = WS_AT + (size_t)GLA_NPREP * 8192;
constexpr size_t WS_OFB = WS_DEC + (size_t)GLA_NPREP * 512;
constexpr size_t WS_IDX = WS_OFB + (size_t)2 * T * 1024 * 2;
constexpr size_t WS_GATE = WS_IDX + (size_t)T * 128 * 4;
constexpr size_t WS_SS = WS_GATE + (size_t)T * 128 * 4;
constexpr size_t WS_KXS = WS_SS + (size_t)T * 8 * 4;
constexpr size_t WS_END = WS_KXS + (size_t)T * 8 * 4;
constexpr size_t WS_IMG = WS_OFB;
constexpr size_t WS_AP = WS_P + (size_t)T * D * 2;
constexpr size_t SLICE_T = (size_t)16384 * 128, SLICE_S = (size_t)16384 * 8;
constexpr size_t WS_TU = WS_QD;
constexpr size_t WS_TV = WS_TU + (size_t)16384 * 1024;
constexpr size_t WS_SU = WS_TV + (size_t)16384 * 1024;
constexpr size_t WS_SV = WS_SU + (size_t)16384 * 128;
static_assert(WS_SV + (size_t)16384 * 128 <= WS_IDX, "table region");

struct Args {
    const float* x; const float* c; const int* pos; const float* w_ada; const float* b_ada; const float* g_mix;
    const float* w_in; const float* wgf; const float* bgf; const float* wgb; const float* bgb; const float* g_gla;
    const float* w_out; const float* g_ffn; const float* w_pq; const float* subk; const float* pu; const float* pv; const float* g_fin;
    float* out; unsigned char* ws; int ph_lo, ph_hi;
};

__device__ __forceinline__ float bf2f(u16 h) { return __uint_as_float(((unsigned)h) << 16); }
typedef __bf16 hw_bf16x2 __attribute__((ext_vector_type(2)));
typedef float hw_f32x2 __attribute__((ext_vector_type(2)));
typedef unsigned u32x2_t __attribute__((ext_vector_type(2)));
__device__ __forceinline__ unsigned pack2(float a, float b) { const hw_f32x2 f = {a, b}; return __builtin_bit_cast(unsigned, __builtin_convertvector(f, hw_bf16x2)); }
__device__ __forceinline__ u16 f2bf(float f) { return (u16)(pack2(f, 0.f) & 0xffffu); }
__device__ __forceinline__ float lo2f(unsigned p) { return __uint_as_float(p << 16); }
__device__ __forceinline__ float hi2f(unsigned p) { return __uint_as_float(p & 0xffff0000u); }
__device__ __forceinline__ float wave_sum(float v) {
#pragma unroll
    for (int o = 32; o > 0; o >>= 1) v += __shfl_xor(v, o);
    return v;
}
__device__ __forceinline__ float wave_max(float v) {
#pragma unroll
    for (int o = 32; o > 0; o >>= 1) v = fmaxf(v, __shfl_xor(v, o));
    return v;
}
__device__ __forceinline__ float silu_f(float v) { return v / (1.f + __expf(-v)); }
__device__ __forceinline__ float gelu_f(float a) { return 0.5f * a * (1.f + erff(a * 0.70710678118654752f)); }
__device__ __forceinline__ float logsigmoid_f(float z) { return z < 0.f ? z - log1pf(expf(z)) : -log1pf(expf(-z)); }

constexpr int MOD_BLOCKS = 96;
__device__ __forceinline__ void p0_mod(const Args& a, unsigned char* lds, int bi) {
    float* sc = (float*)lds;
    float* red = sc + 4 * 2048;
    const int tid = threadIdx.x, lane = tid & 63, wave = tid >> 6;
    for (int i = tid; i < 4 * 2048; i += NTHREADS) sc[i] = silu_f(a.c[i]);
    __syncthreads();
    const int j0 = bi * 128 + lane * 2;
    float acc[4][2];
#pragma unroll
    for (int b = 0; b < 4; ++b) { acc[b][0] = 0.f; acc[b][1] = 0.f; }
    const int k0 = wave * 256;
#pragma unroll 8
    for (int kk = 0; kk < 256; ++kk) {
        const int k = k0 + kk;
        const hw_f32x2 wv_ = __builtin_nontemporal_load((const hw_f32x2*)(a.w_ada + (size_t)k * 12288 + j0)); const float2 w = make_float2(wv_[0], wv_[1]);
#pragma unroll
        for (int b = 0; b < 4; ++b) { const float s = sc[b * 2048 + k]; acc[b][0] += s * w.x; acc[b][1] += s * w.y; }
    }
#pragma unroll
    for (int b = 0; b < 4; ++b) { red[(wave * 4 + b) * 128 + lane * 2] = acc[b][0]; red[(wave * 4 + b) * 128 + lane * 2 + 1] = acc[b][1]; }
    __syncthreads();
    float* mod = (float*)(a.ws + WS_MOD);
    {
        const int b = tid >> 7, jc = tid & 127;
        float s = 0.f;
#pragma unroll
        for (int w = 0; w < 8; ++w) s += red[(w * 4 + b) * 128 + jc];
        mod[b * 12288 + bi * 128 + jc] = s + a.b_ada[bi * 128 + jc];
    }
    __syncthreads();
}

__device__ __forceinline__ void p0_transpose_item(const float* __restrict__ W, int ldw, int k0, int src_col0, int n_valid,
                                                  u16* __restrict__ WT, int ldt, int n_out0, unsigned char* wlds, bool rope_perm = false) {
    u16* tl = (u16*)wlds;
    const int lane = threadIdx.x & 63;
    const int rsub = lane >> 4, nc = (lane & 15) * 4;
    int scol = src_col0 + nc;
    if (rope_perm) { const int p = (n_out0 & 64) + nc, g = p >> 3; scol = (src_col0 - (n_out0 & 64)) + ((p & 4) ? 64 + 4 * g : 4 * g); }
    float4 v[16];
#pragma unroll
    for (int j = 0; j < 16; ++j) {
        const int k = 4 * j + rsub;
        if (nc < n_valid) { const f32x4 q_ = __builtin_nontemporal_load((const f32x4*)(W + (size_t)(k0 + k) * ldw + scol)); v[j] = make_float4(q_[0], q_[1], q_[2], q_[3]); }
        else v[j] = make_float4(0.f, 0.f, 0.f, 0.f);
    }
#pragma unroll
    for (int j = 0; j < 16; ++j) {
        const int k = 4 * j + rsub;
        tl[(nc + 0) * 72 + k] = f2bf(v[j].x); tl[(nc + 1) * 72 + k] = f2bf(v[j].y); tl[(nc + 2) * 72 + k] = f2bf(v[j].z); tl[(nc + 3) * 72 + k] = f2bf(v[j].w);
    }
#pragma unroll
    for (int j = 0; j < 8; ++j) {
        const int c = lane + 64 * j, n = c >> 3, kc = (c & 7) * 8;
        const uint4 o = *(const uint4*)(tl + n * 72 + kc);
        *(uint4*)(WT + (size_t)(n_out0 + n) * ldt + k0 + kc) = o;
    }
}

__device__ __forceinline__ void phase0(const Args& a, unsigned char* lds) {
    const int bi = blockIdx.x, G = gridDim.x, tid = threadIdx.x, wave = tid >> 6;
    const bool modblk = (G > MOD_BLOCKS) && (bi < MOD_BLOCKS);
    if (G > MOD_BLOCKS) { if (modblk) p0_mod(a, lds, bi); }
    else { for (int mb = bi; mb < MOD_BLOCKS; mb += G) p0_mod(a, lds, mb); }
    const int nb = (G > MOD_BLOCKS) ? G - MOD_BLOCKS : G, b0 = (G > MOD_BLOCKS) ? bi - MOD_BLOCKS : bi;
    if (!modblk) {
        constexpr int I_IN = 32 * (NPAD / 64), I_SQ = 32 * 32;
        u16* WinT = (u16*)(a.ws + WS_WIN); u16* WoutT = (u16*)(a.ws + WS_WOUT); u16* WpqT = (u16*)(a.ws + WS_WPQ);
        unsigned char* wlds = lds + wave * 9216;
        for (int it = b0 * NWAVES + wave; it < I_IN + 2 * I_SQ; it += nb * NWAVES) {
            if (it < I_IN) {
                const int kt = it & 31, nt = it >> 5;
                const int n0 = nt * 64;
                int src, nv;
                if (n0 < 3072) { src = n0; nv = 64; }
                else if (n0 < 6144) { src = n0 + 32; nv = 64; }
                else if (n0 == 6144) { src = 3072; nv = 32; }
                else { src = 0; nv = 0; }
                p0_transpose_item(a.w_in, INW, kt * 64, src, nv, WinT, D, n0, wlds, n0 >= C_DQ && n0 < C_DV);
            } else if (it < I_IN + I_SQ) {
                const int r = it - I_IN; const int kt = r & 31, nt = r >> 5;
                p0_transpose_item(a.w_out, D, kt * 64, nt * 64, 64, WoutT, D, nt * 64, wlds);
            } else {
                const int r = it - I_IN - I_SQ; const int kt = r & 31, nt = r >> 5;
                p0_transpose_item(a.w_pq, D, kt * 64, nt * 64, 64, WpqT, D, nt * 64, wlds);
            }
        }
        float2* cs = (float2*)(a.ws + WS_CS);
        for (int i = b0 * NTHREADS + tid; i < T * 64; i += nb * NTHREADS) {
            const int t = i >> 6, f = i & 63;
            const float inv_freq = powf(10000.0f, -(float)f * 2.0f / 128.0f);
            const float ang = (float)a.pos[t] * inv_freq;
            const double rev = (double)ang * 0.15915494309189533577;
            const float fr = (float)(rev - floor(rev));
            cs[i] = make_float2(__builtin_amdgcn_cosf(fr), __builtin_amdgcn_sinf(fr));
        }
    }
    __syncthreads();
}

template <bool BF16IN> __device__ __forceinline__ void norm_mod_phase(const void* __restrict__ xin_, const float* __restrict__ g, const float* __restrict__ mod,
                                               int sh_chunk, int sc_chunk, u16* __restrict__ outp, unsigned char* __restrict__ img = nullptr, int* __restrict__ kxs = nullptr) {
    const int lane = threadIdx.x & 63, wave = threadIdx.x >> 6;
    const int gw = blockIdx.x * NWAVES + wave, NGW = gridDim.x * NWAVES;
    float4 v[8], vn[8];
#define NM_LOAD(dst_, t_) do { if (BF16IN) { const hw_f32x2* xr_ = (const hw_f32x2*)((const u16*)xin_ + (size_t)(t_) * D); \
            _Pragma("unroll") for (int m = 0; m < 8; ++m) { const hw_f32x2 q_ = __builtin_nontemporal_load(xr_ + lane + 64 * m); const unsigned px_ = __float_as_uint(q_[0]), py_ = __float_as_uint(q_[1]); \
                dst_[m] = make_float4(lo2f(px_), hi2f(px_), lo2f(py_), hi2f(py_)); } } \
        else { const f32x4* xr_ = (const f32x4*)((const float*)xin_ + (size_t)(t_) * D); \
            _Pragma("unroll") for (int m = 0; m < 8; ++m) { const f32x4 q_ = __builtin_nontemporal_load(xr_ + lane + 64 * m); dst_[m] = make_float4(q_[0], q_[1], q_[2], q_[3]); } } } while (0)
    if (gw < T) NM_LOAD(v, gw);
    for (int t = gw; t < T; t += NGW) {
        const int b = t / S;
        if (t + NGW < T) NM_LOAD(vn, t + NGW);
        float ss = 0.f;
#pragma unroll
        for (int m = 0; m < 8; ++m) ss += v[m].x * v[m].x + v[m].y * v[m].y + v[m].z * v[m].z + v[m].w * v[m].w;
        ss = wave_sum(ss);
        const float rstd = rsqrtf(ss * (1.f / D) + NORM_EPS);
        const float4* gp = (const float4*)g;
        const float4* shp = (const float4*)(mod + b * 12288 + sh_chunk * 2048);
        const float4* scp = (const float4*)(mod + b * 12288 + sc_chunk * 2048);
        uint2* op = (uint2*)(outp + (size_t)t * D);
#pragma unroll
        for (int m = 0; m < 8; ++m) {
            const int i = lane + 64 * m;
            const float4 gg = gp[i], sh = shp[i], sc = scp[i];
            const float h0 = v[m].x * rstd * gg.x * (1.f + sc.x) + sh.x;
            const float h1 = v[m].y * rstd * gg.y * (1.f + sc.y) + sh.y;
            const float h2 = v[m].z * rstd * gg.z * (1.f + sc.z) + sh.z;
            const float h3 = v[m].w * rstd * gg.w * (1.f + sc.w) + sh.w;
            const uint2 pk = make_uint2(pack2(h0, h1), pack2(h2, h3));
            op[i] = pk;
            if (BF16IN) {
                const float e0 = lo2f(pk.x), e1 = hi2f(pk.x), e2 = lo2f(pk.y), e3 = hi2f(pk.y);
                float amx = fmaxf(fmaxf(fabsf(e0), fabsf(e1)), fmaxf(fabsf(e2), fabsf(e3)));
#pragma unroll
                for (int o = 32; o > 0; o >>= 1) amx = fmaxf(amx, __shfl_xor(amx, o));
                const unsigned bits = __float_as_uint(amx);
                int kx = (int)(bits >> 23) - 127 - 8 + (((bits & 0x7fffffu) > 0x600000u) ? 1 : 0); kx = kx < -100 ? -100 : kx;
                const float hinv = __uint_as_float((unsigned)(127 - kx) << 23);
                const float x0 = e0 * hinv, x1 = e1 * hinv, x2 = e2 * hinv, x3 = e3 * hinv;
                int w = __builtin_amdgcn_cvt_pk_fp8_f32(x0, x1, 0, false); w = __builtin_amdgcn_cvt_pk_fp8_f32(x2, x3, w, true);
                const hw_f32x2 d0 = __builtin_amdgcn_cvt_pk_f32_fp8(w, false), d1 = __builtin_amdgcn_cvt_pk_f32_fp8(w, true);
                int l = __builtin_amdgcn_cvt_pk_fp8_f32((x0 - d0[0]) * 16.f, (x1 - d0[1]) * 16.f, 0, false);
                l = __builtin_amdgcn_cvt_pk_fp8_f32((x2 - d1[0]) * 16.f, (x3 - d1[1]) * 16.f, l, true);
                const int ei = 4 * lane, s = ei >> 7, k = ei & 127, g = (k & 63) >> 4, bb = (k & 15) + 16 * (k >> 6);
                unsigned char* ip = img + (((size_t)t * 8 + m) * 8 + 2 * g) * 64 + s * 32 + bb;
                *(int*)ip = w; *(int*)(ip + 64) = l;
                if (lane == 0) kxs[(size_t)t * 8 + m] = kx;
            }
        }
#pragma unroll
        for (int m = 0; m < 8; ++m) v[m] = vn[m];
    }
#undef NM_LOAD
}

namespace pg8 {
#define PG8_LAS __attribute__((address_space(3)))
typedef unsigned short bf16_t;
typedef short bf16x8 __attribute__((ext_vector_type(8)));
typedef float f32x4 __attribute__((ext_vector_type(4)));
typedef unsigned u32x4 __attribute__((ext_vector_type(4)));
constexpr int BM = 256, BK = 64, HALF = 128, HTB = HALF * BK * 2  , STAGE_BYTES = 8 * HTB, NXCD = 8, WGM = 8;

__host__ __device__ __forceinline__ int lds_byte(int r, int c) { const int st = (r >> 4) * 2 + (c >> 5), rr = r & 15, cc = c & 31, ob = rr * 64 + cc * 2; return st * 1024 + (ob ^ (((ob >> 9) & 1) << 5)); }
__host__ __device__ __forceinline__ void stage_rc(int b, int& R, int& C) { const int st = b / 1024, sb = b % 1024, swz = sb ^ (((sb >> 9) & 1) << 5); R = (st >> 1) * 16 + swz / 64; C = (st & 1) * 32 + (swz % 64) / 2; }
__host__ __device__ __forceinline__ int perm32(int rho) { const int n = rho >> 4, i = rho & 15; return 8 * (i >> 2) + 4 * n + (i & 3); }

struct Unit { int pm, pn; };
struct Gemm { const bf16_t* A; const bf16_t* Bt; int M, N, K; };

struct StaticOrder {
    int nM, nN, nwg, G, c;
    __host__ __device__ void init(int M, int N, int G_, int c_) { nM = M / BM; nN = N / BM; nwg = nM * nN; G = G_; c = c_; }
    __host__ __device__ bool next(int i, Unit& u) const {
        const long L = (long)i * G + c; if (L >= nwg) return false;
        int wgid = (int)L; { const int q = nwg / NXCD, r = nwg % NXCD, xcd = wgid % NXCD, off = wgid / NXCD; wgid = (xcd < r ? xcd * (q + 1) : r * (q + 1) + (xcd - r) * q) + off; }
        const int nig = WGM * nN, gid = wgid / nig, fm = gid * WGM, gsz = (nM - fm) < WGM ? (nM - fm) : WGM;
        u.pm = fm + ((wgid % nig) % gsz); u.pn = (wgid % nig) / gsz; return true;
    }
    __device__ __forceinline__ void a_ready(const Unit&) const {}
    __device__ __forceinline__ void done(const Unit&) const {}
};
__device__ __forceinline__ unsigned cvt_pk_bf16(float lo, float hi) { unsigned r; asm volatile("v_cvt_pk_bf16_f32 %0, %1, %2" : "=v"(r) : "v"(lo), "v"(hi)); return r; }
typedef float f32x2 __attribute__((ext_vector_type(2)));
template <class Epi, class Sched, bool STAMP = false>
__device__ __forceinline__ void gemm_phase(PG8_LAS unsigned char* lds, const Gemm g, const Sched& S, const Epi& E, unsigned long long* stamps) {
    const int tid = threadIdx.x, wid = __builtin_amdgcn_readfirstlane(tid >> 6), lane = tid & 63, wr = wid >> 2, wc = wid & 3, fr = lane & 15, fq = lane >> 4;
    const int K = g.K, nt = K / BK;
    int ts_lo = 0, ts_hi = 0, nts = 0; const unsigned long long rt_entry = STAMP ? (unsigned long long)wall_clock64() : 0ull;
#define PG8_STAMP() do { if (STAMP && wid == 0 && nts < 64) { const unsigned long long _c = (unsigned long long)clock64(); \
        ts_lo = (lane == nts) ? (int)(unsigned)_c : ts_lo; ts_hi = (lane == nts) ? (int)(unsigned)(_c >> 32) : ts_hi; ++nts; } } while (0)
    PG8_STAMP();
    unsigned voffA[2], voffB[2];
#pragma unroll
    for (int i = 0; i < 2; ++i) { int R, C; stage_rc(tid * 16 + i * 8192, R, C); const int Rb = Epi::PERM ? ((R & ~31) + perm32(R & 31)) : R;
        voffA[i] = (unsigned)(R * K + C) * 2u; voffB[i] = (unsigned)(Rb * K + C) * 2u; }
    const size_t kstep = (size_t)(BK * 2);
    const size_t hstep = (size_t)HALF * K * 2;
    const size_t tstep = 2 * hstep;
    const unsigned ldsw = (unsigned)wid * 1024u;
    const int aoff = lds_byte(wr * 64 + fr, fq * 8), boff = lds_byte(wc * 32 + fr, fq * 8);
#define PG8_SA(b, h) (((b) * 2 + (h)) * HTB)
#define PG8_SB(b, h) ((4 + (b) * 2 + (h)) * HTB)
#define PG8_STAGE(bufoff, gbase, voff) do { _Pragma("unroll") for (int _i = 0; _i < 2; ++_i) \
        __builtin_amdgcn_global_load_lds((const unsigned*)((const char*)(gbase) + (voff)[_i]), (PG8_LAS unsigned*)(lds + (bufoff) + ldsw + _i * 8192), 16, 0, 0); } while (0)
#define PG8_LDA(dst, b, h) do { _Pragma("unroll") for (int m = 0; m < 4; ++m) _Pragma("unroll") for (int k = 0; k < 2; ++k) dst[m][k] = *(const PG8_LAS bf16x8*)(lds + PG8_SA(b, h) + aoff + m * 2048 + k * 1024); } while (0)
#define PG8_LDB(dst, b, h) do { _Pragma("unroll") for (int n = 0; n < 2; ++n) _Pragma("unroll") for (int k = 0; k < 2; ++k) dst[n][k] = *(const PG8_LAS bf16x8*)(lds + PG8_SB(b, h) + boff + n * 2048 + k * 1024); } while (0)
#define PG8_MMA(ai, bj, At, Bt) do { __builtin_amdgcn_s_setprio(1); _Pragma("unroll") for (int m = 0; m < 4; ++m) _Pragma("unroll") for (int n = 0; n < 2; ++n) _Pragma("unroll") for (int k = 0; k < 2; ++k) \
        acc[ai][bj][m][n] = __builtin_amdgcn_mfma_f32_16x16x32_bf16(Bt[n][k], At[m][k], acc[ai][bj][m][n], 0, 0, 0); __builtin_amdgcn_s_setprio(0); } while (0)
#define PG8_WAIT_V(n) asm volatile("s_waitcnt vmcnt(" #n ")" ::: "memory")
#define PG8_WAIT_L(n) asm volatile("s_waitcnt lgkmcnt(" #n ")" ::: "memory")
#define PG8_BAR __builtin_amdgcn_s_barrier()
#define PG8_SCHED __builtin_amdgcn_sched_barrier(0)
    Unit cur, nxt; int ui = 0;
    if (!S.next(0, cur)) return;
    f32x4 acc[2][2][4][2];
#pragma unroll
    for (int a = 0; a < 2; ++a)
#pragma unroll
        for (int b = 0; b < 2; ++b)
#pragma unroll
            for (int m = 0; m < 4; ++m)
#pragma unroll
                for (int n = 0; n < 2; ++n) acc[a][b][m][n] = (f32x4){0.f, 0.f, 0.f, 0.f};
    bf16x8 At[4][2], B0[2][2], B1[2][2];
    const char* cA = (const char*)g.A + (size_t)cur.pm * tstep; const char* cB = (const char*)g.Bt + (size_t)cur.pn * tstep;
    S.a_ready(cur);
    PG8_STAGE(PG8_SB(0, 0), cB, voffB); PG8_STAGE(PG8_SA(0, 0), cA, voffA); PG8_STAGE(PG8_SB(0, 1), cB + hstep, voffB); PG8_STAGE(PG8_SA(0, 1), cA + hstep, voffA);
    if (wr == 1) PG8_BAR;
    PG8_WAIT_V(4); PG8_BAR;
    PG8_STAGE(PG8_SB(1, 0), cB + kstep, voffB); PG8_STAGE(PG8_SA(1, 0), cA + kstep, voffA); PG8_STAGE(PG8_SB(1, 1), cB + hstep + kstep, voffB);
    PG8_WAIT_V(6); PG8_BAR;
    PG8_STAMP();
    for (;;) {
        const bool has_next = S.next(ui + 1, nxt);
        const char* nA = has_next ? (const char*)g.A + (size_t)nxt.pm * tstep : cA; const char* nB = has_next ? (const char*)g.Bt + (size_t)nxt.pn * tstep : cB;
        for (int t = 0; t < nt; t += 2) {
            const bool last = (t == nt - 2);
            const char* a1 = cA + (size_t)(t + 1) * kstep;
            const char* a2 = last ? nA : cA + (size_t)(t + 2) * kstep; const char* b2 = last ? nB : cB + (size_t)(t + 2) * kstep;
            const char* a3 = a2 + kstep; const char* b3 = b2 + kstep;
            if (last && has_next) S.a_ready(nxt);
            PG8_LDB(B0, 0, 0); PG8_SCHED; PG8_LDA(At, 0, 0); PG8_STAGE(PG8_SA(1, 1), a1 + hstep, voffA);
            PG8_WAIT_L(8); PG8_BAR; PG8_WAIT_L(0); PG8_MMA(0, 0, At, B0); PG8_BAR; PG8_SCHED;
            PG8_LDB(B1, 0, 1); PG8_STAGE(PG8_SB(0, 0), b2, voffB);
            PG8_BAR; PG8_WAIT_L(0); PG8_MMA(0, 1, At, B1); PG8_BAR;
            PG8_LDA(At, 0, 1); PG8_STAGE(PG8_SA(0, 0), a2, voffA);
            PG8_BAR; PG8_WAIT_L(0); PG8_MMA(1, 0, At, B0); PG8_BAR; PG8_SCHED;
            PG8_STAGE(PG8_SB(0, 1), b2 + hstep, voffB);
            PG8_WAIT_V(6); PG8_BAR; PG8_MMA(1, 1, At, B1); PG8_BAR;
            PG8_LDB(B0, 1, 0); PG8_SCHED; PG8_LDA(At, 1, 0); PG8_STAGE(PG8_SA(0, 1), a2 + hstep, voffA);
            PG8_WAIT_L(8); PG8_BAR; PG8_WAIT_L(0); PG8_MMA(0, 0, At, B0); PG8_BAR; PG8_SCHED;
            PG8_LDB(B1, 1, 1); PG8_STAGE(PG8_SB(1, 0), b3, voffB);
            PG8_BAR; PG8_WAIT_L(0); PG8_MMA(0, 1, At, B1); PG8_BAR;
            PG8_LDA(At, 1, 1); PG8_STAGE(PG8_SA(1, 0), a3, voffA);
            PG8_BAR; PG8_WAIT_L(0); PG8_MMA(1, 0, At, B0); PG8_BAR; PG8_SCHED;
            PG8_STAGE(PG8_SB(1, 1), b3 + hstep, voffB);
            PG8_WAIT_V(6); PG8_BAR; PG8_MMA(1, 1, At, B1); PG8_BAR;
        }
        PG8_STAMP();
        if constexpr (!Epi::AFTER_DRAIN) { E(acc, cur, wr, wc, fr, fq); S.done(cur); }
        PG8_STAMP();
        if (!has_next) break;
#pragma unroll
        for (int a = 0; a < 2; ++a)
#pragma unroll
            for (int b = 0; b < 2; ++b)
#pragma unroll
                for (int m = 0; m < 4; ++m)
#pragma unroll
                    for (int n = 0; n < 2; ++n) acc[a][b][m][n] = (f32x4){0.f, 0.f, 0.f, 0.f};
        cur = nxt; cA = nA; cB = nB; ++ui;
    }
    PG8_WAIT_V(0);
    if (wr == 0) PG8_BAR;
    PG8_BAR;
    if constexpr (Epi::AFTER_DRAIN) { E.fused(acc, cur, wr, wc, fr, fq, lds, wid, lane); S.done(cur); }
    PG8_STAMP();
    if (STAMP && wid == 0) { stamps[lane] = lane < nts ? (((unsigned long long)(unsigned)ts_hi << 32) | (unsigned)ts_lo) : 0ull;
        if (lane == 62) stamps[62] = rt_entry; if (lane == 63) stamps[63] = (unsigned long long)wall_clock64(); }
#undef PG8_STAMP
#undef PG8_SA
#undef PG8_SB
#undef PG8_STAGE
#undef PG8_LDA
#undef PG8_LDB
#undef PG8_MMA
#undef PG8_WAIT_V
#undef PG8_WAIT_L
#undef PG8_BAR
#undef PG8_SCHED
}
}

struct EpiProj {
    static constexpr bool PERM = true, AFTER_DRAIN = false;
    u16* P; const float* cs;
    __device__ __forceinline__ void operator()(const pg8::f32x4 (&acc)[2][2][4][2], const pg8::Unit& u, int wr, int wc, int fr, int fq) const {
        const int row0 = u.pm * 256 + wr * 64 + fr;
        const int col0 = u.pn * 256 + wc * 32 + 8 * fq;
        const bool rope = (u.pn >= C_DQ / 256) && (u.pn < C_DV / 256);
#pragma unroll
        for (int ai = 0; ai < 2; ++ai)
#pragma unroll
            for (int m = 0; m < 4; ++m) { const int row = row0 + ai * 128 + m * 16; u16* rowp = P + (size_t)row * NP + col0;
                pg8::f32x4 c01 = (pg8::f32x4){1.f, 0.f, 1.f, 0.f}, c23 = c01;
                if (rope) { const pg8::f32x4* cp = (const pg8::f32x4*)(cs + ((size_t)row * 64 + 4 * (4 * wc + fq)) * 2); c01 = cp[0]; c23 = cp[1]; }
#pragma unroll
                for (int bj = 0; bj < 2; ++bj) { pg8::f32x4 v0 = acc[ai][bj][m][0], v1 = acc[ai][bj][m][1];
                    if (rope) {
                        const pg8::f32x4 cc = {c01[0], c01[2], c23[0], c23[2]}, sn = {c01[1], c01[3], c23[1], c23[3]};
                        const pg8::f32x4 y1 = v0 * cc - v1 * sn, y2 = v0 * sn + v1 * cc; v0 = y1; v1 = y2; }
                    pg8::u32x4 w; w.x = pg8::cvt_pk_bf16(v0[0], v0[1]); w.y = pg8::cvt_pk_bf16(v0[2], v0[3]); w.z = pg8::cvt_pk_bf16(v1[0], v1[1]); w.w = pg8::cvt_pk_bf16(v1[2], v1[3]);
                    *(pg8::u32x4*)(rowp + bj * 128) = w; } }
    }
};
__device__ __forceinline__ void gz_phase(unsigned char* lds, const u16* __restrict__ H1, const u16* __restrict__ Wg, float* __restrict__ gz) {
    const int tid = threadIdx.x, lane = tid & 63, wave = tid >> 6, fr = lane & 15, fq = lane >> 4;
    float* red = (float*)lds;
    for (int rb = blockIdx.x; rb < T / 64; rb += gridDim.x) {
        const int r0 = rb * 64, k0 = wave * 256;
        f32x4 acc[4][2];
#pragma unroll
        for (int m = 0; m < 4; ++m) { acc[m][0] = (f32x4){0.f, 0.f, 0.f, 0.f}; acc[m][1] = (f32x4){0.f, 0.f, 0.f, 0.f}; }
#pragma unroll
        for (int ks = 0; ks < 8; ++ks) {
            bf16x8 af[4], bfr[2];
#pragma unroll
            for (int m = 0; m < 4; ++m) af[m] = *(const bf16x8*)(H1 + (size_t)(r0 + 16 * m + fr) * D + k0 + 32 * ks + 8 * fq);
#pragma unroll
            for (int n = 0; n < 2; ++n) bfr[n] = *(const bf16x8*)(Wg + (size_t)(16 * n + fr) * D + k0 + 32 * ks + 8 * fq);
#pragma unroll
            for (int m = 0; m < 4; ++m)
#pragma unroll
                for (int n = 0; n < 2; ++n) acc[m][n] = __builtin_amdgcn_mfma_f32_16x16x32_bf16(af[m], bfr[n], acc[m][n], 0, 0, 0);
        }
        __syncthreads();
#pragma unroll
        for (int m = 0; m < 4; ++m)
#pragma unroll
            for (int n = 0; n < 2; ++n)
#pragma unroll
                for (int j = 0; j < 4; ++j) red[(wave * 64 + 16 * m + 4 * fq + j) * 32 + 16 * n + fr] = acc[m][n][j];
        __syncthreads();
#pragma unroll
        for (int k = 0; k < 4; ++k) {
            const int e = tid + 512 * k;
            float s = 0.f;
#pragma unroll
            for (int w = 0; w < 8; ++w) s += red[w * 2048 + e];
            gz[(size_t)r0 * 32 + e] = s;
        }
    }
    __syncthreads();
}
struct EpiResid {
    static constexpr bool PERM = true, AFTER_DRAIN = false;
    const float* x; const float* mod; u16* x1;
    __device__ __forceinline__ void operator()(const pg8::f32x4 (&acc)[2][2][4][2], const pg8::Unit& u, int wr, int wc, int fr, int fq) const {
        const int row0 = u.pm * 256 + wr * 64 + fr, col0 = u.pn * 256 + wc * 32 + 8 * fq;
        const int b = (u.pm * 256) / S;
        pg8::f32x4 ga[2][2];
#pragma unroll
        for (int bj = 0; bj < 2; ++bj)
#pragma unroll
            for (int n = 0; n < 2; ++n) ga[bj][n] = *(const pg8::f32x4*)(mod + b * 12288 + 2 * 2048 + col0 + bj * 128 + 4 * n);
#pragma unroll
        for (int ai = 0; ai < 2; ++ai)
#pragma unroll
            for (int m = 0; m < 4; ++m) { const size_t off = (size_t)(row0 + ai * 128 + m * 16) * D + col0;
#pragma unroll
                for (int bj = 0; bj < 2; ++bj) {
                    const pg8::f32x4 x0 = __builtin_nontemporal_load((const pg8::f32x4*)(x + off + bj * 128)), x1v = __builtin_nontemporal_load((const pg8::f32x4*)(x + off + bj * 128 + 4));
                    const pg8::f32x4 v0 = x0 + ga[bj][0] * acc[ai][bj][m][0], v1 = x1v + ga[bj][1] * acc[ai][bj][m][1];
                    pg8::u32x4 w; w.x = pg8::cvt_pk_bf16(v0[0], v0[1]); w.y = pg8::cvt_pk_bf16(v0[2], v0[3]); w.z = pg8::cvt_pk_bf16(v1[0], v1[1]); w.w = pg8::cvt_pk_bf16(v1[2], v1[3]);
                    *(pg8::u32x4*)(x1 + off + bj * 128) = w; } }
    }
};
struct EpiBf16 {
    static constexpr bool PERM = true, AFTER_DRAIN = false;
    u16* Q;
    __device__ __forceinline__ void operator()(const pg8::f32x4 (&acc)[2][2][4][2], const pg8::Unit& u, int wr, int wc, int fr, int fq) const {
        const int row0 = u.pm * 256 + wr * 64 + fr, col0 = u.pn * 256 + wc * 32 + 8 * fq;
#pragma unroll
        for (int ai = 0; ai < 2; ++ai)
#pragma unroll
            for (int m = 0; m < 4; ++m) { u16* rowp = Q + (size_t)(row0 + ai * 128 + m * 16) * D + col0;
#pragma unroll
                for (int bj = 0; bj < 2; ++bj) { const pg8::f32x4 v0 = acc[ai][bj][m][0], v1 = acc[ai][bj][m][1];
                    pg8::u32x4 w; w.x = pg8::cvt_pk_bf16(v0[0], v0[1]); w.y = pg8::cvt_pk_bf16(v0[2], v0[3]); w.z = pg8::cvt_pk_bf16(v1[0], v1[1]); w.w = pg8::cvt_pk_bf16(v1[2], v1[3]);
                    *(pg8::u32x4*)(rowp + bj * 128) = w; } }
    }
};
template <class Epi>
__device__ __forceinline__ void gemm8(unsigned char* lds, const u16* A, const u16* Bt, int M, int N, int K, const Epi& E) {
    pg8::Gemm g{A, Bt, M, N, K}; pg8::StaticOrder So; So.init(M, N, (int)gridDim.x, (int)blockIdx.x);
    pg8::gemm_phase<Epi, pg8::StaticOrder, false>((PG8_LAS unsigned char*)lds, g, So, E, nullptr);
    __syncthreads();
}

#define GLA_QD_BYTES 16384
#define GLA_AT_BYTES 8192
__device__ __forceinline__ float gla_logsigmoid(float z) { return fminf(z, 0.f) - __logf(1.f + __expf(-fabsf(z))); }

__device__ __forceinline__ void gla_prep_item(const u16* __restrict__ P, int ldp, int cq, int ck, const float* __restrict__ gz,
                                              const float* __restrict__ wg_f, const float* __restrict__ bg_f, const float* __restrict__ wg_b, const float* __restrict__ bg_b,
                                              int Sq, unsigned char* __restrict__ QDg, unsigned char* __restrict__ KEg, unsigned char* __restrict__ ATg, float* __restrict__ DECg,
                                              unsigned char* lds, int item) {
    const int nch = Sq / 64;
    const int c = item % nch, dir = (item / nch) & 1, hh = (item / (nch * 2)) & 3, b = item / (nch * 8);
    const int tid = TID, lane = tid & 63, wave = tid >> 6, li = lane & 15, fq = lane >> 4;
    float* gzs = (float*)lds;
    float* segs = gzs + 64 * 16;
    unsigned char* QDs = lds + 8192;
    unsigned char* KIs = QDs + 16384;
    unsigned char* KEs = KIs + 16384;
    float* bmat = (float*)(KEs + 16384);
    const size_t tok0 = (size_t)b * Sq;
    __syncthreads();
    uint4 rq0, rq1, rk0, rk1;
    {
        const int i0 = tid >> 4, i1 = (tid + 512) >> 4, cc = tid & 15;
        const int s0 = dir ? (Sq - 1 - (64 * c + i0)) : (64 * c + i0), s1 = dir ? (Sq - 1 - (64 * c + i1)) : (64 * c + i1);
        rq0 = *(const uint4*)(P + (tok0 + s0) * ldp + cq + hh * 128 + cc * 8); rk0 = *(const uint4*)(P + (tok0 + s0) * ldp + ck + hh * 128 + cc * 8);
        rq1 = *(const uint4*)(P + (tok0 + s1) * ldp + cq + hh * 128 + cc * 8); rk1 = *(const uint4*)(P + (tok0 + s1) * ldp + ck + hh * 128 + cc * 8);
    }
    for (int e = tid; e < 64 * 16; e += 512) {
        const int i = e >> 4, r = e & 15;
        const int s = dir ? (Sq - 1 - (64 * c + i)) : (64 * c + i);
        gzs[e] = gz[(tok0 + s) * 32 + dir * 16 + r];
    }
    const int d = tid & 127, seg = tid >> 7;
    const float* wg = dir ? wg_b : wg_f;
    float wcol[16];
#pragma unroll
    for (int r = 0; r < 16; ++r) wcol[r] = wg[r * 512 + hh * 128 + d];
    const float bias = (dir ? bg_b : bg_f)[hh * 128 + d];
    __syncthreads();
    float run = 0.f;
#pragma unroll
    for (int k = 0; k < 16; ++k) {
        const int i = 16 * seg + k;
        float z = bias;
#pragma unroll
        for (int r = 0; r < 16; ++r) z += gzs[i * 16 + r] * wcol[r];
        run += gla_logsigmoid(z) * (1.f / 16.f);
        bmat[i * 128 + d] = run;
    }
    segs[seg * 128 + d] = run;
    __syncthreads();
    if (seg == 0) {
        const float t0 = segs[d], t1 = segs[128 + d], t2 = segs[256 + d], t3 = segs[384 + d];
        segs[d] = 0.f; segs[128 + d] = t0; segs[256 + d] = t0 + t1; segs[384 + d] = t0 + t1 + t2; segs[512 + d] = t0 + t1 + t2 + t3;
        DECg[(size_t)item * 128 + d] = __expf(t0 + t1 + t2 + t3);
    }
    __syncthreads();
    const float qscale = 0.08838834764831845f;
#pragma unroll
    for (int k = 0; k < 2; ++k) {
        const int id = tid + 512 * k, i = id >> 4, cc = id & 15, d0 = cc * 8, sg = i >> 4;
        const uint4 qv = k ? rq1 : rq0, kv = k ? rk1 : rk0;
        const float qx[8] = {lo2f(qv.x), hi2f(qv.x), lo2f(qv.y), hi2f(qv.y), lo2f(qv.z), hi2f(qv.z), lo2f(qv.w), hi2f(qv.w)};
        const float kx[8] = {lo2f(kv.x), hi2f(kv.x), lo2f(kv.y), hi2f(kv.y), lo2f(kv.z), hi2f(kv.z), lo2f(kv.w), hi2f(kv.w)};
        float qd[8], ki[8], ke[8];
        const float4 bA = *(const float4*)(bmat + i * 128 + d0), bB = *(const float4*)(bmat + i * 128 + d0 + 4);
        const float4 oA = *(const float4*)(segs + sg * 128 + d0), oB = *(const float4*)(segs + sg * 128 + d0 + 4);
        const float4 tA = *(const float4*)(segs + 512 + d0), tB = *(const float4*)(segs + 512 + d0 + 4);
        const float bv[8] = {bA.x + oA.x, bA.y + oA.y, bA.z + oA.z, bA.w + oA.w, bB.x + oB.x, bB.y + oB.y, bB.z + oB.z, bB.w + oB.w};
        const float tv[8] = {tA.x, tA.y, tA.z, tA.w, tB.x, tB.y, tB.z, tB.w};
#pragma unroll
        for (int e = 0; e < 8; ++e) {
            const float bb = bv[e], tot = tv[e];
            qd[e] = qx[e] * qscale * __expf(bb); ki[e] = kx[e] * __expf(-bb); ke[e] = kx[e] * __expf(tot - bb);
        }
        const int o = i * 256 + ((cc ^ (i & 15)) << 4);
        *(uint4*)(QDs + o) = make_uint4(pack2(qd[0], qd[1]), pack2(qd[2], qd[3]), pack2(qd[4], qd[5]), pack2(qd[6], qd[7]));
        *(uint4*)(KIs + o) = make_uint4(pack2(ki[0], ki[1]), pack2(ki[2], ki[3]), pack2(ki[4], ki[5]), pack2(ki[6], ki[7]));
        *(uint4*)(KEs + o) = make_uint4(pack2(ke[0], ke[1]), pack2(ke[2], ke[3]), pack2(ke[4], ke[5]), pack2(ke[6], ke[7]));
    }
    __syncthreads();
    {
        uint4* qo = (uint4*)(QDg + (size_t)item * GLA_QD_BYTES); uint4* ko = (uint4*)(KEg + (size_t)item * GLA_QD_BYTES);
#pragma unroll
        for (int k = 0; k < 2; ++k) { const int e = tid + 512 * k; qo[e] = ((const uint4*)QDs)[e]; ko[e] = ((const uint4*)KEs)[e]; }
    }
#pragma unroll
    for (int tt = 0; tt < 2; ++tt) {
        const int tile = wave + 8 * tt, jt = tile >> 2, it = tile & 3;
        f32x4 acc = (f32x4){0.f, 0.f, 0.f, 0.f};
        if (jt <= it) {
            const int jr = 16 * jt + li, ir = 16 * it + li;
#pragma unroll
            for (int ks = 0; ks < 4; ++ks) {
                const bf16x8 kf = *(const bf16x8*)(KIs + jr * 256 + (((4 * ks + fq) ^ (jr & 15)) << 4));
                const bf16x8 qf = *(const bf16x8*)(QDs + ir * 256 + (((4 * ks + fq) ^ (ir & 15)) << 4));
                acc = __builtin_amdgcn_mfma_f32_16x16x32_bf16(kf, qf, acc, 0, 0, 0);
            }
        }
        const int i = 16 * it + li, j0 = 16 * jt + 4 * fq;
        float v[4];
#pragma unroll
        for (int jj = 0; jj < 4; ++jj) v[jj] = (j0 + jj <= i) ? acc[jj] : 0.f;
        const int chunk = 2 * jt + (fq >> 1), sub = (fq & 1) * 8;
        *(uint2*)(ATg + (size_t)item * GLA_AT_BYTES + i * 128 + ((chunk ^ (i & 7)) << 4) + sub) = make_uint2(pack2(v[0], v[1]), pack2(v[2], v[3]));
    }
}

__device__ __forceinline__ void gla_seq_item(const u16* __restrict__ P, int ldp, int cv, int Sq,
                                             const unsigned char* __restrict__ QDg, const unsigned char* __restrict__ KEg, const unsigned char* __restrict__ ATg, const float* __restrict__ DECg,
                                             u16* __restrict__ Oout  , int Ttot, unsigned char* lds, int item) {
    const int slice = item & 1, dir = (item >> 1) & 1, hh = (item >> 2) & 3, b = item >> 4;
    const int nch = Sq / 64;
    const int tid = TID, lane = tid & 63, wave = tid >> 6, li = lane & 15, fq = lane >> 4;
    const size_t tok0 = (size_t)b * Sq;
    const int pitem0 = ((b * 4 + hh) * 2 + dir) * nch;
    constexpr int BUF = 16384 * 3 + 8192 + 512;
    typedef unsigned gla_u32x4 __attribute__((ext_vector_type(4)));
    gla_u32x4 rq0, rq1, rk0, rk1, rv0, rv1, ra; float rd = 0.f;
#define GLA_VROW(c_, k_) ((tok0 + (size_t)(dir ? (Sq - 1 - (64 * (c_) + ((tid + 512 * (k_)) >> 4))) : (64 * (c_) + ((tid + 512 * (k_)) >> 4)))) * ldp + cv + hh * 256 + slice * 128 + ((tid + 512 * (k_)) & 15) * 8)
#define GLA_ISSUE(c_) do { \
        const gla_u32x4* qsrc_ = (const gla_u32x4*)(QDg + (size_t)(pitem0 + (c_)) * GLA_QD_BYTES); const gla_u32x4* ksrc_ = (const gla_u32x4*)(KEg + (size_t)(pitem0 + (c_)) * GLA_QD_BYTES); \
        rq0 = qsrc_[tid]; rq1 = qsrc_[tid + 512]; rk0 = ksrc_[tid]; rk1 = ksrc_[tid + 512]; \
        ra = ((const gla_u32x4*)(ATg + (size_t)(pitem0 + (c_)) * GLA_AT_BYTES))[tid]; \
        rv0 = *(const gla_u32x4*)(P + GLA_VROW(c_, 0)); rv1 = *(const gla_u32x4*)(P + GLA_VROW(c_, 1)); \
        if (tid < 128) rd = DECg[(size_t)(pitem0 + (c_)) * 128 + tid]; } while (0)
#define GLA_COMMIT(buf_) do { \
        unsigned char* base_ = lds + (buf_) * BUF; \
        ((gla_u32x4*)base_)[tid] = rq0; ((gla_u32x4*)base_)[tid + 512] = rq1; ((gla_u32x4*)(base_ + 16384))[tid] = rk0; ((gla_u32x4*)(base_ + 16384))[tid + 512] = rk1; \
        { const int row_ = tid >> 4, ch_ = tid & 15; *(gla_u32x4*)(base_ + 32768 + row_ * 256 + ((ch_ ^ (row_ & 15)) << 4)) = rv0; } \
        { const int row_ = (tid + 512) >> 4, ch_ = tid & 15; *(gla_u32x4*)(base_ + 32768 + row_ * 256 + ((ch_ ^ (row_ & 15)) << 4)) = rv1; } \
        ((gla_u32x4*)(base_ + 49152))[tid] = ra; \
        if (tid < 128) ((float*)(base_ + 57344))[tid] = rd; } while (0)
    f32x4 st[8];
#pragma unroll
    for (int dt = 0; dt < 8; ++dt) st[dt] = (f32x4){0.f, 0.f, 0.f, 0.f};
    __syncthreads();
    GLA_ISSUE(0); GLA_COMMIT(0);
    __syncthreads();
#pragma unroll 1
    for (int c = 0; c < nch; ++c) {
        const int buf = c & 1;
        if (c + 1 < nch) GLA_ISSUE(c + 1);
        const unsigned char* QDs = lds + buf * BUF; const unsigned char* KEs = QDs + 16384; const unsigned char* Vs = QDs + 32768;
        const unsigned char* ATs = QDs + 49152; const float* DECs = (const float*)(QDs + 57344);
        bf16x8 vf[2];
#pragma unroll
        for (int jp = 0; jp < 2; ++jp) {
            const int rowA = 32 * jp + 8 * fq + (li >> 2), rowB = rowA + 4;
            const int chunk = 2 * wave + ((li & 3) >> 1), sub = ((li & 3) & 1) * 8;
            const s16x4 va = __builtin_amdgcn_ds_read_tr16_b64_v4i16((LAS s16x4*)(Vs + rowA * 256 + ((chunk ^ (rowA & 15)) << 4) + sub));
            const s16x4 vb = __builtin_amdgcn_ds_read_tr16_b64_v4i16((LAS s16x4*)(Vs + rowB * 256 + ((chunk ^ (rowB & 15)) << 4) + sub));
            vf[jp] = __builtin_shufflevector(va, vb, 0, 1, 2, 3, 4, 5, 6, 7);
        }
        bf16x8 sf[4];
#pragma unroll
        for (int dp = 0; dp < 4; ++dp) {
            const gla_u32x4 t_ = {pack2(st[2 * dp][0], st[2 * dp][1]), pack2(st[2 * dp][2], st[2 * dp][3]), pack2(st[2 * dp + 1][0], st[2 * dp + 1][1]), pack2(st[2 * dp + 1][2], st[2 * dp + 1][3])};
            sf[dp] = __builtin_bit_cast(bf16x8, t_);
        }
        f32x4 ot[4];
#pragma unroll
        for (int it = 0; it < 4; ++it) {
            f32x4 acc = (f32x4){0.f, 0.f, 0.f, 0.f};
            const int ir = 16 * it + li;
#pragma unroll
            for (int dp = 0; dp < 4; ++dp) {
                const int c0 = 4 * dp + (fq >> 1), c1 = c0 + 2, sub = (fq & 1) * 8;
                const uint2 lo = *(const uint2*)(QDs + ir * 256 + ((c0 ^ (ir & 15)) << 4) + sub);
                const uint2 hi = *(const uint2*)(QDs + ir * 256 + ((c1 ^ (ir & 15)) << 4) + sub);
                const gla_u32x4 q_ = {lo.x, lo.y, hi.x, hi.y};
                const bf16x8 qf = __builtin_bit_cast(bf16x8, q_);
                acc = __builtin_amdgcn_mfma_f32_16x16x32_bf16(sf[dp], qf, acc, 0, 0, 0);
            }
#pragma unroll
            for (int jp = 0; jp < 2; ++jp) {
                if (32 * jp <= 16 * it + 15) {
                    const bf16x8 af = *(const bf16x8*)(ATs + ir * 128 + (((4 * jp + fq) ^ (ir & 7)) << 4));
                    acc = __builtin_amdgcn_mfma_f32_16x16x32_bf16(vf[jp], af, acc, 0, 0, 0);
                }
            }
            ot[it] = acc;
        }
#pragma unroll
        for (int dt = 0; dt < 8; ++dt) {
            const f32x4 dec = *(const f32x4*)(DECs + 16 * dt + 4 * fq);
            f32x4 acc = st[dt] * dec;
#pragma unroll
            for (int jp = 0; jp < 2; ++jp) {
                const int rowA = 32 * jp + 8 * fq + (li >> 2), rowB = rowA + 4;
                const int chunk = 2 * dt + ((li & 3) >> 1), sub = ((li & 3) & 1) * 8;
                const s16x4 ka = __builtin_amdgcn_ds_read_tr16_b64_v4i16((LAS s16x4*)(KEs + rowA * 256 + ((chunk ^ (rowA & 15)) << 4) + sub));
                const s16x4 kb = __builtin_amdgcn_ds_read_tr16_b64_v4i16((LAS s16x4*)(KEs + rowB * 256 + ((chunk ^ (rowB & 15)) << 4) + sub));
                const bf16x8 kf = __builtin_shufflevector(ka, kb, 0, 1, 2, 3, 4, 5, 6, 7);
                acc = __builtin_amdgcn_mfma_f32_16x16x32_bf16(kf, vf[jp], acc, 0, 0, 0);
            }
            st[dt] = acc;
        }
#pragma unroll
        for (int it = 0; it < 4; ++it) {
            const int i = 16 * it + li;
            const int s = dir ? (Sq - 1 - (64 * c + i)) : (64 * c + i);
            *(uint2*)(Oout + ((size_t)dir * Ttot + tok0 + s) * 1024 + hh * 256 + slice * 128 + 16 * wave + 4 * fq) =
                make_uint2(pack2(ot[it][0], ot[it][1]), pack2(ot[it][2], ot[it][3]));
        }
        if (c + 1 < nch) GLA_COMMIT(buf ^ 1);
        __syncthreads();
    }
}
__device__ __forceinline__ void phase_rope_prep(const Args& a, unsigned char* lds) {
    u16* P = (u16*)(a.ws + WS_P);
    const float2* cs = (const float2*)(a.ws + WS_CS);
    const int gt = blockIdx.x * NTHREADS + threadIdx.x, NT = gridDim.x * NTHREADS;
    for (int item = blockIdx.x; item < GLA_NPREP; item += gridDim.x)
        gla_prep_item(P, NP, C_GQ, C_GK, (const float*)(a.ws + WS_GZ), a.wgf, a.bgf, a.wgb, a.bgb, S,
                      a.ws + WS_QD, a.ws + WS_KE, a.ws + WS_AT, (float*)(a.ws + WS_DEC), lds, item);
}

#define ATTN_DECODE(item_) \
    const int nb_per = Sq / 128; \
    const int within = (item_) % nb_per, hh = ((item_) / nb_per) & 7, b = ((item_) / (nb_per * 8)) & 3, pat = (item_) / (nb_per * 32); \
    const int dil = pat == 0 ? 1 : (pat == 1 ? 4 : 16); \
    const int M = Sq / dil; \
    const int r = within % dil, blk = within / dil; \
    const int p0 = blk * 128, kbase = p0 - 64; \
    const size_t tok0 = (size_t)b * Sq;
typedef unsigned attn_u32x4 __attribute__((ext_vector_type(4)));
__device__ __forceinline__ void attn_phase(const u16* __restrict__ P, int ldp, int cq, int ck, int cv, int Sq,
                                           u16* __restrict__ part_o, float* __restrict__ part_lse, int Ttot,
                                           unsigned char* lds, int first, int stride, int nitems) {
    const int tid = TID, lane = tid & 63, wave = tid >> 6, li = lane & 15, fq = lane >> 4;
    unsigned char* Ks = lds;
    unsigned char* Vs = lds + 65536;
    attn_u32x4 kr0, kr1, kr2, kr3, kr4, kr5, kr6, kr7, vr0, vr1, vr2, vr3, vr4, vr5, vr6, vr7;
    bf16x8 qn0, qn1, qn2, qn3;
#define ATTN_LD1(i_, kreg_, vreg_) { const int id_ = tid + 512 * (i_), row_ = id_ >> 4, c_ = id_ & 15; \
        int kp_ = kbase + row_; kp_ = kp_ < 0 ? 0 : (kp_ > M - 1 ? M - 1 : kp_); \
        const size_t t_ = tok0 + r + (size_t)dil * kp_; \
        kreg_ = *(const attn_u32x4*)(P + t_ * ldp + ck + hh * 128 + c_ * 8); vreg_ = *(const attn_u32x4*)(P + t_ * ldp + cv + hh * 128 + c_ * 8); }
#define ATTN_LOAD(item_) do { ATTN_DECODE(item_) \
        { const size_t tq_ = tok0 + r + (size_t)dil * (p0 + 16 * wave + li); const u16* qp_ = P + tq_ * ldp + cq + hh * 128 + 8 * fq; \
          qn0 = *(const bf16x8*)(qp_); qn1 = *(const bf16x8*)(qp_ + 32); qn2 = *(const bf16x8*)(qp_ + 64); qn3 = *(const bf16x8*)(qp_ + 96); } \
        ATTN_LD1(0, kr0, vr0) ATTN_LD1(1, kr1, vr1) ATTN_LD1(2, kr2, vr2) ATTN_LD1(3, kr3, vr3) ATTN_LD1(4, kr4, vr4) ATTN_LD1(5, kr5, vr5) ATTN_LD1(6, kr6, vr6) ATTN_LD1(7, kr7, vr7) } while (0)
#define ATTN_ST1(i_, kreg_, vreg_) { const int id_ = tid + 512 * (i_), row_ = id_ >> 4, c_ = id_ & 15; const int off_ = row_ * 256 + ((c_ ^ (row_ & 15)) << 4); \
        *(attn_u32x4*)(Ks + off_) = kreg_; *(attn_u32x4*)(Vs + off_) = vreg_; }
#define ATTN_COMMIT() do { ATTN_ST1(0, kr0, vr0) ATTN_ST1(1, kr1, vr1) ATTN_ST1(2, kr2, vr2) ATTN_ST1(3, kr3, vr3) ATTN_ST1(4, kr4, vr4) ATTN_ST1(5, kr5, vr5) ATTN_ST1(6, kr6, vr6) ATTN_ST1(7, kr7, vr7) } while (0)
    int item = first;
    if (item < nitems) ATTN_LOAD(item);
    for (; item < nitems; item += stride) {
        ATTN_DECODE(item)
        __syncthreads();
        ATTN_COMMIT();
        const int qp = p0 + 16 * wave + li;
        const size_t tq = tok0 + r + (size_t)dil * qp;
        const bf16x8 qf[4] = {qn0, qn1, qn2, qn3};
        __syncthreads();
        if (item + stride < nitems) ATTN_LOAD(item + stride);
        const float scale = 0.08838834764831845f;
        float m = -1e30f, l = 0.f;
        f32x4 o[8];
#pragma unroll
        for (int dt = 0; dt < 8; ++dt) o[dt] = (f32x4){0.f, 0.f, 0.f, 0.f};
#pragma unroll 1
        for (int tp = 0; tp < 5; ++tp) {
            float s[8]; bool ok[8];
#pragma unroll
            for (int h2 = 0; h2 < 2; ++h2) {
                const int kk0 = 16 * wave + 16 * (2 * tp + h2);
                int krow = kk0 + li; krow = krow > 255 ? 255 : krow;
                f32x4 acc = (f32x4){0.f, 0.f, 0.f, 0.f};
#pragma unroll
                for (int ks = 0; ks < 4; ++ks) {
                    const bf16x8 kf = *(const bf16x8*)(Ks + krow * 256 + (((4 * ks + fq) ^ (krow & 15)) << 4));
                    acc = __builtin_amdgcn_mfma_f32_16x16x32_bf16(kf, qf[ks], acc, 0, 0, 0);
                }
#pragma unroll
                for (int j = 0; j < 4; ++j) {
                    const int kp = kbase + kk0 + 4 * fq + j;
                    const int rel = kp - qp;
                    ok[4 * h2 + j] = (kp >= 0) && (kp < M) && (rel <= 64) && (rel >= -64);
                    s[4 * h2 + j] = acc[j] * scale;
                }
            }
            float mx = -1e30f;
#pragma unroll
            for (int j = 0; j < 8; ++j) mx = ok[j] ? fmaxf(mx, s[j]) : mx;
            mx = fmaxf(mx, __shfl_xor(mx, 16));
            mx = fmaxf(mx, __shfl_xor(mx, 32));
            const float mn = fmaxf(m, mx);
            const float al = __expf(m - mn);
            float ps = 0.f; float p[8];
#pragma unroll
            for (int j = 0; j < 8; ++j) { p[j] = ok[j] ? __expf(s[j] - mn) : 0.f; ps += p[j]; }
            l = l * al + ps; m = mn;
            const attn_u32x4 p_ = {pack2(p[0], p[1]), pack2(p[2], p[3]), pack2(p[4], p[5]), pack2(p[6], p[7])};
            const bf16x8 pf = __builtin_bit_cast(bf16x8, p_);
#pragma unroll
            for (int dt = 0; dt < 8; ++dt) o[dt] *= al;
            int rowA = 16 * wave + 32 * tp + 4 * fq + (li >> 2); rowA = rowA > 255 ? 255 : rowA;
            int rowB = 16 * wave + 32 * tp + 16 + 4 * fq + (li >> 2); rowB = rowB > 255 ? 255 : rowB;
#pragma unroll
            for (int dt = 0; dt < 8; ++dt) {
                const int chunk = 2 * dt + ((li & 3) >> 1), sub = ((li & 3) & 1) * 8;
                const s16x4 va = __builtin_amdgcn_ds_read_tr16_b64_v4i16((LAS s16x4*)(Vs + rowA * 256 + ((chunk ^ (rowA & 15)) << 4) + sub));
                const s16x4 vb = __builtin_amdgcn_ds_read_tr16_b64_v4i16((LAS s16x4*)(Vs + rowB * 256 + ((chunk ^ (rowB & 15)) << 4) + sub));
                const bf16x8 vf = __builtin_shufflevector(va, vb, 0, 1, 2, 3, 4, 5, 6, 7);
                o[dt] = __builtin_amdgcn_mfma_f32_16x16x32_bf16(vf, pf, o[dt], 0, 0, 0);
            }
        }
        l += __shfl_xor(l, 16);
        l += __shfl_xor(l, 32);
        const float inv = 1.f / l;
        u16* orow = part_o + ((size_t)pat * Ttot + tq) * 1024 + hh * 128 + 4 * fq;
#pragma unroll
        for (int dt = 0; dt < 8; ++dt)
            *(uint2*)(orow + 16 * dt) = make_uint2(pack2(o[dt][0] * inv, o[dt][1] * inv), pack2(o[dt][2] * inv, o[dt][3] * inv));
        if (fq == 0) part_lse[((size_t)pat * Ttot + tq) * 8 + hh] = m + logf(l);
    }
#undef ATTN_LD1
#undef ATTN_LOAD
#undef ATTN_ST1
#undef ATTN_COMMIT
}

__device__ __forceinline__ void attn_merge_token(const u16* __restrict__ part_o, const float* __restrict__ part_lse, int Ttot, size_t t,
                                                 u16* __restrict__ dst  , int lane) {
    const int hh = lane >> 3;
    const float l0 = part_lse[((size_t)0 * Ttot + t) * 8 + hh], l1 = part_lse[((size_t)1 * Ttot + t) * 8 + hh], l2 = part_lse[((size_t)2 * Ttot + t) * 8 + hh];
    const float mx = fmaxf(l0, fmaxf(l1, l2));
    const float e0 = __expf(l0 - mx), e1 = __expf(l1 - mx), e2 = __expf(l2 - mx);
    const float inv = 1.f / (e0 + e1 + e2);
    const float w[3] = {e0 * inv, e1 * inv, e2 * inv};
    float acc[16];
#pragma unroll
    for (int i = 0; i < 16; ++i) acc[i] = 0.f;
#pragma unroll
    for (int p = 0; p < 3; ++p) {
        const uint4* src = (const uint4*)(part_o + ((size_t)p * Ttot + t) * 1024 + lane * 16);
        const uint4 a = src[0], bb = src[1];
        acc[0] += w[p] * lo2f(a.x); acc[1] += w[p] * hi2f(a.x); acc[2] += w[p] * lo2f(a.y); acc[3] += w[p] * hi2f(a.y);
        acc[4] += w[p] * lo2f(a.z); acc[5] += w[p] * hi2f(a.z); acc[6] += w[p] * lo2f(a.w); acc[7] += w[p] * hi2f(a.w);
        acc[8] += w[p] * lo2f(bb.x); acc[9] += w[p] * hi2f(bb.x); acc[10] += w[p] * lo2f(bb.y); acc[11] += w[p] * hi2f(bb.y);
        acc[12] += w[p] * lo2f(bb.z); acc[13] += w[p] * hi2f(bb.z); acc[14] += w[p] * lo2f(bb.w); acc[15] += w[p] * hi2f(bb.w);
    }
    uint4* d = (uint4*)(dst + lane * 16);
    d[0] = make_uint4(pack2(acc[0], acc[1]), pack2(acc[2], acc[3]), pack2(acc[4], acc[5]), pack2(acc[6], acc[7]));
    d[1] = make_uint4(pack2(acc[8], acc[9]), pack2(acc[10], acc[11]), pack2(acc[12], acc[13]), pack2(acc[14], acc[15]));
}

__device__ __forceinline__ void phase_mixers(const Args& a, unsigned char* lds) {
    const int bi = blockIdx.x, G = gridDim.x;
    if (bi < 64) {
        gla_seq_item((const u16*)(a.ws + WS_P), NP, C_GV, S, a.ws + WS_QD, a.ws + WS_KE, a.ws + WS_AT, (const float*)(a.ws + WS_DEC),
                     (u16*)(a.ws + WS_OFB), T, lds, bi);
    } else {
        u16* part_o = (u16*)a.out; float* part_lse = (float*)((unsigned char*)a.out + (size_t)3 * T * 1024 * 2);
        attn_phase((const u16*)(a.ws + WS_P), NP, C_DQ, C_DK, C_DV, S, part_o, part_lse, T, lds, bi - 64, G - 64, 3 * 4 * 8 * (S / 128));
    }
}

__device__ __forceinline__ void phase_gla_fin(const Args& a) {
    const u16* Of = (const u16*)(a.ws + WS_OFB);
    const u16* Ob = Of + (size_t)T * 1024;
    const u16* P = (const u16*)(a.ws + WS_P);
    u16* A2 = (u16*)(a.ws + WS_ACT);
    const u16* part_o = (const u16*)a.out; const float* part_lse = (const float*)((const unsigned char*)a.out + (size_t)3 * T * 1024 * 2);
    const int lane = threadIdx.x & 63, wave = threadIdx.x >> 6;
    const int gw = blockIdx.x * NWAVES + wave, NGW = gridDim.x * NWAVES;
    const int hh = lane >> 4;
    float gg[16];
#pragma unroll
    for (int k = 0; k < 4; ++k) { const float4 g4 = *(const float4*)(a.g_gla + lane * 16 + 4 * k); gg[4 * k] = g4.x; gg[4 * k + 1] = g4.y; gg[4 * k + 2] = g4.z; gg[4 * k + 3] = g4.w; }
    for (int t = gw; t < T; t += NGW) {
        const uint4* fp = (const uint4*)(Of + (size_t)t * 1024 + lane * 16); const uint4* bp = (const uint4*)(Ob + (size_t)t * 1024 + lane * 16);
        const uint4* rp = (const uint4*)(P + (size_t)t * NP + C_GR + lane * 16);
#define NT16(p_) ({ const f32x4 q_ = __builtin_nontemporal_load((const f32x4*)(p_)); make_uint4(__float_as_uint(q_[0]), __float_as_uint(q_[1]), __float_as_uint(q_[2]), __float_as_uint(q_[3])); })
        const uint4 f0 = NT16(fp), f1 = NT16(fp + 1), b0 = NT16(bp), b1 = NT16(bp + 1), r0 = NT16(rp), r1 = NT16(rp + 1);
#undef NT16
        attn_merge_token(part_o, part_lse, T, (size_t)t, A2 + (size_t)t * D + 1024, lane);
        const unsigned fw[8] = {f0.x, f0.y, f0.z, f0.w, f1.x, f1.y, f1.z, f1.w}, bw[8] = {b0.x, b0.y, b0.z, b0.w, b1.x, b1.y, b1.z, b1.w};
        const unsigned rw[8] = {r0.x, r0.y, r0.z, r0.w, r1.x, r1.y, r1.z, r1.w};
        float o[16]; float ss = 0.f;
#pragma unroll
        for (int k = 0; k < 8; ++k) { o[2 * k] = lo2f(fw[k]) + lo2f(bw[k]); o[2 * k + 1] = hi2f(fw[k]) + hi2f(bw[k]); ss += o[2 * k] * o[2 * k] + o[2 * k + 1] * o[2 * k + 1]; }
        ss += __shfl_xor(ss, 1); ss += __shfl_xor(ss, 2); ss += __shfl_xor(ss, 4); ss += __shfl_xor(ss, 8);
        const float rstd = rsqrtf(ss * (1.f / 256.f) + NORM_EPS);
        unsigned y[8];
#pragma unroll
        for (int k = 0; k < 8; ++k) y[k] = pack2(o[2 * k] * rstd * gg[2 * k] * silu_f(lo2f(rw[k])), o[2 * k + 1] * rstd * gg[2 * k + 1] * silu_f(hi2f(rw[k])));
        uint4* dp = (uint4*)(A2 + (size_t)t * D + lane * 16);
        dp[0] = make_uint4(y[0], y[1], y[2], y[3]); dp[1] = make_uint4(y[4], y[5], y[6], y[7]);
    }
    (void)hh;
}

typedef float f32x16 __attribute__((ext_vector_type(16)));
#define RT_CE(a_, b_) do { const float hi_ = fmaxf(a_, b_), lo_ = fminf(a_, b_); a_ = hi_; b_ = lo_; } while (0)
template <int N> __device__ __forceinline__ void rt_sort_desc(float (&v)[N], int base) {
#pragma unroll
    for (int k = 2; k <= 16; k <<= 1)
#pragma unroll
        for (int j = k >> 1; j > 0; j >>= 1)
#pragma unroll
            for (int i = 0; i < 16; ++i) {
                const int l = i ^ j;
                if (l > i) { if ((i & k) == 0) RT_CE(v[base + i], v[base + l]); else RT_CE(v[base + l], v[base + i]); }
            }
}
template <int N> __device__ __forceinline__ void rt_merge_desc(float (&v)[N], int a, int b) {
#pragma unroll
    for (int i = 0; i < 16; ++i) v[a + i] = fmaxf(v[a + i], v[b + 15 - i]);
#pragma unroll
    for (int j = 8; j > 0; j >>= 1)
#pragma unroll
        for (int i = 0; i < 16; ++i) { const int l = i ^ j; if (l > i) RT_CE(v[a + i], v[a + l]); }
}

__device__ __forceinline__ void route_stage_keys(const float* __restrict__ subk, int hh, unsigned char* lds) {
    const int tid = TID;
    __syncthreads();
    for (int e = tid; e < 2 * 128 * 16; e += 512) {
        const int c = e & 15, row = e >> 4;
        const float* src = subk + ((size_t)(hh * 2) * 128 + row) * 128 + c * 8;
        const float4 v0 = *(const float4*)src, v1 = *(const float4*)(src + 4);
        *(uint4*)(lds + row * 256 + ((c ^ (row & 15)) << 4)) = make_uint4(pack2(v0.x, v0.y), pack2(v0.z, v0.w), pack2(v1.x, v1.y), pack2(v1.z, v1.w));
    }
    __syncthreads();
}

__device__ __forceinline__ void route_tile(const u16* __restrict__ Q, int ldq, int hh, int tok_base, const unsigned char* lds,
                                           int* __restrict__ IDX, float* __restrict__ GATE) {
    const int lane = TID & 63, r = lane & 31, h = lane >> 5;
    float sc[128];
    {
        f32x16 X[4], Y[4];
#pragma unroll
        for (int kt = 0; kt < 4; ++kt) {
#pragma unroll
            for (int i = 0; i < 16; ++i) { X[kt][i] = 0.f; Y[kt][i] = 0.f; }
        }
        const u16* qrow = Q + (size_t)(tok_base + r) * ldq + hh * 256;
#pragma unroll
        for (int half = 0; half < 2; ++half) {
            bf16x8 qf[8];
#pragma unroll
            for (int ks = 0; ks < 8; ++ks) qf[ks] = *(const bf16x8*)(qrow + half * 128 + 16 * ks + 8 * h);
#pragma unroll
            for (int kt = 0; kt < 4; ++kt) {
                const int krow = half * 128 + 32 * kt + r;
#pragma unroll
                for (int ks = 0; ks < 8; ++ks) {
                    const bf16x8 kf = *(const bf16x8*)(lds + krow * 256 + (((2 * ks + h) ^ (krow & 15)) << 4));
                    if (half == 0) X[kt] = __builtin_amdgcn_mfma_f32_32x32x16_bf16(kf, qf[ks], X[kt], 0, 0, 0);
                    else Y[kt] = __builtin_amdgcn_mfma_f32_32x32x16_bf16(kf, qf[ks], Y[kt], 0, 0, 0);
                }
            }
        }
#pragma unroll
        for (int kt = 0; kt < 4; ++kt)
#pragma unroll
            for (int i = 0; i < 16; ++i) {
                const auto sw = __builtin_amdgcn_permlane32_swap(__float_as_uint(X[kt][i]), __float_as_uint(Y[kt][i]), false, false);
                const int key0 = 32 * kt + (i & 3) + 8 * (i >> 2);
                sc[kt * 32 + i] = __uint_as_float((sw[0] & 0xffffff80u) | (unsigned)key0);
                sc[kt * 32 + 16 + i] = __uint_as_float((sw[1] & 0xffffff80u) | (unsigned)(key0 + 4));
            }
    }
#pragma unroll
    for (int g = 0; g < 8; ++g) rt_sort_desc(sc, 16 * g);
    rt_merge_desc(sc, 0, 16); rt_merge_desc(sc, 32, 48); rt_merge_desc(sc, 64, 80); rt_merge_desc(sc, 96, 112);
    rt_merge_desc(sc, 0, 32); rt_merge_desc(sc, 64, 96);
    rt_merge_desc(sc, 0, 64);
    float l0[16], l1[16];
#pragma unroll
    for (int i = 0; i < 16; ++i) {
        const auto sw = __builtin_amdgcn_permlane32_swap(__float_as_uint(sc[i]), __float_as_uint(sc[i]), false, false);
        l0[i] = __uint_as_float(sw[0]); l1[i] = __uint_as_float(sw[1]);
    }
    float s0[16], s1[16]; int k0[16], k1[16];
#pragma unroll
    for (int i = 0; i < 16; ++i) {
        const unsigned a = __float_as_uint(l0[i]), b = __float_as_uint(l1[i]);
        s0[i] = __uint_as_float(a & 0xffffff80u); k0[i] = (int)(a & 0x7fu);
        s1[i] = __uint_as_float(b & 0xffffff80u); k1[i] = (int)(b & 0x7fu);
    }
    float cs[64];
    {
        int n = 0;
#pragma unroll
        for (int i = 0; i < 16; ++i)
#pragma unroll
            for (int j = 0; j < 16; ++j)
                if ((i + 1) * (j + 1) <= 16) { cs[n] = s0[i] + s1[j]; ++n; }
#pragma unroll
        for (int q = 50; q < 64; ++q) cs[q] = -3.0e38f;
    }
    float ct[64];
#pragma unroll
    for (int q = 0; q < 64; ++q) ct[q] = cs[q];
#pragma unroll
    for (int g = 0; g < 4; ++g) rt_sort_desc(ct, 16 * g);
    rt_merge_desc(ct, 0, 16); rt_merge_desc(ct, 32, 48); rt_merge_desc(ct, 0, 32);
    const float theta = ct[15], smax = ct[0];
    float den = 0.f;
    {
        int cnt = 0;
#pragma unroll
        for (int q = 0; q < 50; ++q) { const bool sel = (cs[q] >= theta) && (cnt < 16); den += sel ? __expf(cs[q] - smax) : 0.f; cnt += sel ? 1 : 0; }
    }
    const float inv = 1.f / den;
    const size_t obase = (size_t)(tok_base + r) * 128 + hh * 16;
    int pos = 0;
    {
        int n = 0;
#pragma unroll
        for (int i = 0; i < 16; ++i)
#pragma unroll
            for (int j = 0; j < 16; ++j)
                if ((i + 1) * (j + 1) <= 16) {
                    const bool sel = (cs[n] >= theta) && (pos < 16);
                    if (sel) {
                        if (h == 0) IDX[obase + pos] = k0[i] * 128 + k1[j];
                        else GATE[obase + pos] = __expf(cs[n] - smax) * inv;
                        ++pos;
                    }
                    ++n;
                }
    }
}
__device__ __forceinline__ void phase_route(const Args& a, unsigned char* lds) {
    const int hh = BID & 7, grp = BID >> 3, ngrp = GDIM >> 3, wave = TID >> 6;
    route_stage_keys(a.subk, hh, lds);
    int j = 0;
    for (int tile = grp; tile < T / 32; tile += ngrp, ++j)
        if ((j & 7) == wave) route_tile((const u16*)(a.ws + WS_Q), D, hh, tile * 32, lds, (int*)(a.ws + WS_IDX), (float*)(a.ws + WS_GATE));
    __syncthreads();
}

typedef __bf16 bf16x2_t __attribute__((ext_vector_type(2)));
__device__ __forceinline__ float dot2bf(unsigned w, unsigned x, float acc) {
    return __builtin_amdgcn_fdot2_f32_bf16(__builtin_bit_cast(bf16x2_t, w), __builtin_bit_cast(bf16x2_t, x), acc, false);
}
constexpr int TROW = 1024;
typedef float f32x2_t __attribute__((ext_vector_type(2)));
typedef int i32x8 __attribute__((ext_vector_type(8)));
__device__ __forceinline__ void convert_tables(const Args& a) {
    const int lane = threadIdx.x & 63, wave = threadIdx.x >> 6;
    const int gw = blockIdx.x * NWAVES + wave, NGW = gridDim.x * NWAVES;
    for (int row = gw; row < 2 * 16384; row += NGW) {
        const bool isv = row >= 16384; const int e = isv ? row - 16384 : row;
        const f32x4* sp = (const f32x4*)((isv ? a.pv : a.pu) + (size_t)e * D);
        unsigned char* dst = a.ws + (isv ? WS_TV + (size_t)e * 1024 : WS_TU + (size_t)e * 128);
        unsigned char* sdst = a.ws + (isv ? WS_SV + (size_t)e * 64 : WS_SU + (size_t)e * 8);
        f32x4 v[8];
#pragma unroll
        for (int k = 0; k < 8; ++k) v[k] = __builtin_nontemporal_load(sp + lane + 64 * k);
#pragma unroll
        for (int k = 0; k < 8; ++k) {
            float mx = fmaxf(fmaxf(fabsf(v[k][0]), fabsf(v[k][1])), fmaxf(fabsf(v[k][2]), fabsf(v[k][3])));
            mx = fmaxf(mx, __shfl_xor(mx, 1)); mx = fmaxf(mx, __shfl_xor(mx, 2)); mx = fmaxf(mx, __shfl_xor(mx, 4));
            const unsigned bits = __float_as_uint(mx);
            int kx = (int)(bits >> 23) - 127 - 2 + (((bits & 0x7fffffu) > 0x400000u) ? 1 : 0);
            kx = kx < -126 ? -126 : kx;
            const float inv = __uint_as_float((unsigned)(127 - kx) << 23);
            unsigned p = 0u;
            p = __builtin_amdgcn_cvt_scalef32_pk_fp4_f32(p, v[k][0] * inv, v[k][1] * inv, 1.0f, 0);
            p = __builtin_amdgcn_cvt_scalef32_pk_fp4_f32(p, v[k][2] * inv, v[k][3] * inv, 1.0f, 1);
            *(u16*)(dst + (isv ? (size_t)k * 128 : (size_t)k * SLICE_T) + 2 * lane) = (u16)p;
            if ((lane & 7) == 0) {
                const int c = lane >> 3;
                if (isv) sdst[8 * k + c] = (unsigned char)(kx + 127); else sdst[(size_t)k * SLICE_S + 2 * (c & 3) + (c >> 2)] = (unsigned char)(kx + 127);
            }
        }
    }
}

__device__ __forceinline__ void axpy32_fp4(const uint4 w, const float s, float (&acc)[32]) {
    const unsigned ww[4] = {w.x, w.y, w.z, w.w};
#pragma unroll
    for (int k = 0; k < 4; ++k) {
        const f32x2_t a0 = __builtin_amdgcn_cvt_scalef32_pk_f32_fp4(ww[k], 1.0f, 0), a1 = __builtin_amdgcn_cvt_scalef32_pk_f32_fp4(ww[k], 1.0f, 1);
        const f32x2_t a2 = __builtin_amdgcn_cvt_scalef32_pk_f32_fp4(ww[k], 1.0f, 2), a3 = __builtin_amdgcn_cvt_scalef32_pk_f32_fp4(ww[k], 1.0f, 3);
        acc[8 * k + 0] += s * a0.x; acc[8 * k + 1] += s * a0.y; acc[8 * k + 2] += s * a1.x; acc[8 * k + 3] += s * a1.y;
        acc[8 * k + 4] += s * a2.x; acc[8 * k + 5] += s * a2.y; acc[8 * k + 6] += s * a3.x; acc[8 * k + 7] += s * a3.y;
    }
}
#define DPP_F(v_, ctrl_) __builtin_bit_cast(float, __builtin_amdgcn_update_dpp(0, __builtin_bit_cast(int, v_), ctrl_, 0xf, 0xf, true))
__device__ __forceinline__ void phase_eu(const Args& a, unsigned char* lds) {
    const int* IDX = (const int*)(a.ws + WS_IDX);
    float* AP = (float*)(a.ws + WS_AP);
    const int lane = threadIdx.x & 63, wave = threadIdx.x >> 6;
    const int x = blockIdx.x & 7, gw = (blockIdx.x >> 3) * NWAVES + wave, NGW = (((int)gridDim.x - x + 7) >> 3) * NWAVES;
    const unsigned char* TUx = a.ws + WS_TU + (size_t)x * SLICE_T;
    const int m = lane & 15, g = lane >> 4;
    typedef unsigned eu_u32x4 __attribute__((ext_vector_type(4)));
    eu_u32x4 rA[8], rB[8]; u16 sA[4], sB[4];
    { const uint4* ssrc = (const uint4*)(a.ws + WS_SU + (size_t)x * SLICE_S);
      for (int i = threadIdx.x; i < (int)(SLICE_S / 16); i += NTHREADS) ((uint4*)lds)[i] = ssrc[i];
      __syncthreads(); }
    i32x8 hB0, hB1, nB0, nB1; int sbt = 127, nkx = 0, ckx = 0;
    int iv0 = 0, iv1 = 0, niv0 = 0, niv1 = 0;
    const int j8 = lane >> 3, c8 = lane & 7;
    LAS unsigned char* ldsl = (LAS unsigned char*)lds;
    LAS unsigned char* stg = ldsl + LDS_MAIN + 16 + wave * 2048;
#define EU_LOAD(r_, s_, ivh_) do { _Pragma("unroll") for (int q = 0; q < 8; ++q) { \
            const int e_ = __shfl(ivh_, 8 * q + j8); \
            r_[q] = *(const eu_u32x4*)(TUx + ((unsigned)e_ * 128u + 16u * (unsigned)(c8 ^ j8))); } \
        _Pragma("unroll") for (int q = 0; q < 4; ++q) { const int e_ = __shfl(ivh_, 16 * q + m); s_[q] = *(const LAS u16*)(ldsl + e_ * 8 + 2 * g); } } while (0)
    const unsigned char* IMG = a.ws + WS_IMG; const int* KXS = (const int*)(a.ws + WS_KXS);
#define EU_BLOAD(t_, B0_, B1_, kx_) do { const eu_u32x4* ip_ = (const eu_u32x4*)(IMG + (((size_t)(t_) * 8 + x) * 8 + 2 * g + (lane & 1)) * 64); \
            const eu_u32x4 q0_ = ip_[0], q1_ = ip_[1], q2_ = ip_[2], q3_ = ip_[3]; \
            B0_ = (i32x8){(int)q0_[0], (int)q0_[1], (int)q0_[2], (int)q0_[3], (int)q1_[0], (int)q1_[1], (int)q1_[2], (int)q1_[3]}; \
            B1_ = (i32x8){(int)q2_[0], (int)q2_[1], (int)q2_[2], (int)q2_[3], (int)q3_[0], (int)q3_[1], (int)q3_[2], (int)q3_[3]}; \
            kx_ = KXS[(size_t)(t_) * 8 + x]; } while (0)
#define EU_COMPUTE(r_, s_, kb_, t_) do { _Pragma("unroll") for (int q = 0; q < 4; ++q) { \
            *(LAS eu_u32x4*)(stg + lane * 16) = r_[2 * q]; *(LAS eu_u32x4*)(stg + 1024 + lane * 16) = r_[2 * q + 1]; \
            const eu_u32x4 f0_ = *(const LAS eu_u32x4*)(stg + m * 128 + 16 * (g ^ (m & 7))), f1_ = *(const LAS eu_u32x4*)(stg + m * 128 + 16 * ((4 + g) ^ (m & 7))); \
            const i32x8 A0_ = {(int)f0_[0], (int)f0_[1], (int)f0_[2], (int)f0_[3], 0, 0, 0, 0}; \
            const i32x8 A1_ = {(int)f1_[0], (int)f1_[1], (int)f1_[2], (int)f1_[3], 0, 0, 0, 0}; \
            f32x4 c_ = {0.f, 0.f, 0.f, 0.f}; \
            c_ = __builtin_amdgcn_mfma_scale_f32_16x16x128_f8f6f4(A0_, hB0, c_, 4, 0, 0, (int)s_[q], 0, sbt); \
            c_ = __builtin_amdgcn_mfma_scale_f32_16x16x128_f8f6f4(A1_, hB1, c_, 4, 0, 1, (int)s_[q], 0, sbt); \
            f32x4 o_; _Pragma("unroll") for (int j = 0; j < 4; ++j) o_[j] = c_[j] + DPP_F(c_[j], 0xB1); \
            if (m == 0) *(f32x4*)(AP + ((size_t)(t_) * 8 + x) * 128 + (kb_) + 16 * q + 4 * g) = o_; } } while (0)
#define EU_IDX(t_, i0_, i1_) do { i0_ = IDX[(size_t)(t_) * 128 + lane]; i1_ = IDX[(size_t)(t_) * 128 + 64 + lane]; } while (0)
    if (gw < T) { EU_IDX(gw, iv0, iv1); EU_BLOAD(gw, hB0, hB1, ckx); const int t1 = (gw + NGW < T) ? gw + NGW : gw; EU_IDX(t1, niv0, niv1); EU_LOAD(rA, sA, iv0); sbt = 127 + ckx - ((lane & 1) ? 4 : 0); }
    for (int t = gw; t < T; t += NGW) {
        const int tn = (t + NGW < T) ? t + NGW : t, tnn = (t + 2 * NGW < T) ? t + 2 * NGW : t;
        EU_LOAD(rB, sB, iv1);
        EU_BLOAD(tn, nB0, nB1, nkx);
        int nn0, nn1; EU_IDX(tnn, nn0, nn1);
        EU_COMPUTE(rA, sA, 0, t);
        EU_LOAD(rA, sA, niv0);
        EU_COMPUTE(rB, sB, 64, t);
        hB0 = nB0; hB1 = nB1; sbt = 127 + nkx - ((lane & 1) ? 4 : 0);
        iv0 = niv0; iv1 = niv1; niv0 = nn0; niv1 = nn1;
    }
#undef EU_LOAD
#undef EU_BLOAD
#undef EU_COMPUTE
#undef EU_IDX
}

__device__ __forceinline__ void phase_ev(const Args& a) {
    const u16* X1 = (const u16*)(a.ws + WS_X1);
    const int* IDX = (const int*)(a.ws + WS_IDX);
    const float* GATE = (const float*)(a.ws + WS_GATE);
    const float* mod = (const float*)(a.ws + WS_MOD);
    const unsigned char* V = a.ws + WS_TV;
    const int lane = threadIdx.x & 63, wave = threadIdx.x >> 6;
    const int gw = blockIdx.x * NWAVES + wave, NGW = gridDim.x * NWAVES;
    int iv0 = 0, iv1 = 0; float gv0 = 0.f, gv1 = 0.f;
    int niv0 = 0, niv1 = 0; float ngv0 = 0.f, ngv1 = 0.f;
    uint4 rA[4], rB[4]; u16 sA[4], sB[4];
#define ROW_LOAD(TB_, r_, s_, r0_) do { _Pragma("unroll") for (int q = 0; q < 4; ++q) { \
            const int rr_ = (r0_) + q; const int e_ = __builtin_amdgcn_readlane(rr_ < 64 ? iv0 : iv1, rr_ & 63); \
            const unsigned char* rp_ = TB_ + (size_t)e_ * TROW; \
            const unsigned char* sp_ = a.ws + WS_SV + (size_t)e_ * 64; \
            r_[q] = *(const uint4*)(rp_ + lane * 16); s_[q] = (u16)*(sp_ + lane); } } while (0)
#define TOK_FETCH(t_, i0_, i1_, g0_, g1_) do { \
            i0_ = IDX[(size_t)(t_) * 128 + lane]; i1_ = IDX[(size_t)(t_) * 128 + 64 + lane]; \
            g0_ = GATE[(size_t)(t_) * 128 + lane]; g1_ = GATE[(size_t)(t_) * 128 + 64 + lane]; } while (0)
    if (gw < T) { TOK_FETCH(gw, iv0, iv1, gv0, gv1); ROW_LOAD(V, rA, sA, 0); }
    for (int t = gw; t < T; t += NGW) {
        const int b = t / S;
        const bool has_next = (t + NGW) < T;
        const float w0 = gv0, w1 = gv1;
        float acc[32];
#pragma unroll
        for (int i = 0; i < 32; ++i) acc[i] = 0.f;
#define V_COMPUTE(r_, s_, r0_) do { _Pragma("unroll") for (int q = 0; q < 4; ++q) { const int rr_ = (r0_) + q; \
                const float g_ = __builtin_bit_cast(float, __builtin_amdgcn_readlane(__builtin_bit_cast(int, rr_ < 64 ? w0 : w1), rr_ & 63)); \
                axpy32_fp4(r_[q], g_ * __uint_as_float((unsigned)s_[q] << 23), acc); } } while (0)
        if (has_next) TOK_FETCH(t + NGW, niv0, niv1, ngv0, ngv1);
#pragma unroll 1
        for (int r0 = 0; r0 < 128; r0 += 8) {
            ROW_LOAD(V, rB, sB, r0 + 4);
            V_COMPUTE(rA, sA, r0);
            if (r0 + 8 < 128) ROW_LOAD(V, rA, sA, r0 + 8);
            else if (has_next) { iv0 = niv0; iv1 = niv1; gv0 = ngv0; gv1 = ngv1; ROW_LOAD(V, rA, sA, 0); }
            V_COMPUTE(rB, sB, r0 + 4);
        }
#undef V_COMPUTE
        float ss = 0.f;
#pragma unroll
        for (int k = 0; k < 8; ++k) {
            const int c0 = lane * 32 + 4 * k;
            const hw_f32x2 xn = __builtin_nontemporal_load((const hw_f32x2*)(X1 + (size_t)t * D + c0));
            const uint2 xp = make_uint2(__float_as_uint(xn[0]), __float_as_uint(xn[1]));
            const float4 xa = make_float4(lo2f(xp.x), hi2f(xp.x), lo2f(xp.y), hi2f(xp.y));
            const float4 ga = *(const float4*)(mod + b * 12288 + 5 * 2048 + c0);
            acc[4 * k + 0] = xa.x + ga.x * acc[4 * k + 0]; acc[4 * k + 1] = xa.y + ga.y * acc[4 * k + 1];
            acc[4 * k + 2] = xa.z + ga.z * acc[4 * k + 2]; acc[4 * k + 3] = xa.w + ga.w * acc[4 * k + 3];
#pragma unroll
            for (int i = 0; i < 4; ++i) ss += acc[4 * k + i] * acc[4 * k + i];
        }
        ss = wave_sum(ss);
        const float rstd = rsqrtf(ss * (1.f / D) + NORM_EPS);
#pragma unroll
        for (int k = 0; k < 8; ++k) {
            const int c0 = lane * 32 + 4 * k;
            const float4 gf = *(const float4*)(a.g_fin + c0);
            *(float4*)(a.out + (size_t)t * D + c0) = make_float4(acc[4 * k + 0] * rstd * gf.x, acc[4 * k + 1] * rstd * gf.y, acc[4 * k + 2] * rstd * gf.z, acc[4 * k + 3] * rstd * gf.w);
        }
    }
#undef ROW_LOAD
#undef TOK_FETCH
}

__device__ __forceinline__ void phase_ew(const Args& a) {
    const float* AP = (const float*)(a.ws + WS_AP);
    float* GATE = (float*)(a.ws + WS_GATE);
    const int lane = threadIdx.x & 63, wave = threadIdx.x >> 6;
    const int gw = blockIdx.x * NWAVES + wave, NGW = gridDim.x * NWAVES;
    for (int t = gw; t < T; t += NGW) {
        float a0 = 0.f, a1 = 0.f;
#pragma unroll
        for (int xx = 0; xx < 8; ++xx) { a0 += AP[((size_t)t * 8 + xx) * 128 + lane]; a1 += AP[((size_t)t * 8 + xx) * 128 + 64 + lane]; }
        GATE[(size_t)t * 128 + lane] *= gelu_f(a0); GATE[(size_t)t * 128 + 64 + lane] *= gelu_f(a1);
    }
}

#undef DPP_F

#define XB_TMO      128
#define XB_XCNT(j)  (256  + 64 * (j))
#define XB_XSUB(j)  (1280 + 64 * (j))
#define XB_XGEN(j)  (2304 + 64 * (j))
#define XB_TOP      3328
#define XB_TOPGEN   3392
#define XCD_BAR_WORDS 3456
#define XB_SPIN_CAP (1u << 18)

__device__ __forceinline__ unsigned xb_ld(unsigned* p)              { return __hip_atomic_load(p, __ATOMIC_RELAXED, __HIP_MEMORY_SCOPE_AGENT); }
__device__ __forceinline__ unsigned xb_add(unsigned* p, unsigned v) { return __hip_atomic_fetch_add(p, v, __ATOMIC_RELAXED, __HIP_MEMORY_SCOPE_AGENT); }
__device__ __forceinline__ unsigned xb_xcc_id() { return (unsigned)__builtin_amdgcn_s_getreg((3 << 11) | 20) & 0xFu; }
#define XB_SPIN(cond, bar) do { unsigned _sp = 0; while (cond) { __builtin_amdgcn_s_sleep(1); \
    if ((++_sp & 255u) == 0u) { if (xb_ld(&(bar)[XB_TMO])) break; if (_sp > XB_SPIN_CAP) { atomicAdd(&(bar)[XB_TMO], 1u); break; } } } } while (0)

struct XcdBarrier {
    unsigned* bar; unsigned x;
    volatile LAS unsigned* st;
};

__device__ __forceinline__ XcdBarrier xcd_barrier_post(unsigned* bar, volatile LAS unsigned* st) {
    XcdBarrier b; b.bar = bar; b.x = xb_xcc_id(); b.st = st;
    if (threadIdx.x == 0) (void)xb_add(&bar[XB_XCNT(b.x)], 1u);
    return b;
}
__device__ __forceinline__ void xcd_barrier_complete(unsigned* bar, unsigned x, unsigned& nloc, unsigned& nx) {
    const unsigned G = gridDim.x * gridDim.y * gridDim.z;
    unsigned sum, cnt, mine, sp = 0u;
    for (;;) {
        sum = 0u; cnt = 0u; mine = 0u;
#pragma unroll
        for (unsigned j = 0; j < 16; ++j) { const unsigned c = xb_ld(&bar[XB_XCNT(j)]); sum += c; cnt += (c > 0u) ? 1u : 0u; mine = (j == x) ? c : mine; }
        if (sum == G) break;
        __builtin_amdgcn_s_sleep(1);
        if ((++sp & 255u) == 0u) { if (xb_ld(&bar[XB_TMO])) break; if (sp > XB_SPIN_CAP) { atomicAdd(&bar[XB_TMO], 1u); break; } }
    }
    nloc = mine > 0u ? mine : 1u; nx = cnt > 0u ? cnt : 1u;
}

__device__ __forceinline__ void xcd_barrier(const XcdBarrier& b) {
    asm volatile("s_waitcnt vmcnt(0)" ::: "memory");
    __syncthreads();
    if (threadIdx.x == 0) {
        unsigned* bar = b.bar;
        __builtin_amdgcn_s_waitcnt(0);
        unsigned nloc = b.st[0], nx = b.st[1];
        if (nloc == 0u) { xcd_barrier_complete(bar, b.x, nloc, nx); b.st[0] = nloc; b.st[1] = nx; }
        const unsigned old = xb_add(&bar[XB_XSUB(b.x)], 1u);
        const unsigned gen = old / nloc;
        if (old + 1u == (gen + 1u) * nloc) {
            __builtin_amdgcn_fence(__ATOMIC_RELEASE, "agent");
            asm volatile("s_waitcnt vmcnt(0)" ::: "memory");
            const unsigned og = xb_add(&bar[XB_TOP], 1u);
            const unsigned tg = og / nx;
            if (og + 1u == (tg + 1u) * nx) xb_add(&bar[XB_TOPGEN], 1u);
            else XB_SPIN(xb_ld(&bar[XB_TOPGEN]) == tg, bar);
            __builtin_amdgcn_fence(__ATOMIC_ACQUIRE, "agent");
            xb_add(&bar[XB_XGEN(b.x)], 1u);
            asm volatile("s_waitcnt vmcnt(0)" ::: "memory");
        } else {
            XB_SPIN(xb_ld(&bar[XB_XGEN(b.x)]) == gen, bar);
            __builtin_amdgcn_fence(__ATOMIC_ACQUIRE, "agent");
            asm volatile("s_waitcnt vmcnt(0)" ::: "memory");
        }
    }
    __syncthreads();
}

constexpr int NPHASES = 13;
__global__ void __launch_bounds__(NTHREADS, 2) mk_fwd(Args a) {
    extern __shared__ __attribute__((aligned(16))) unsigned char lds[];
    cg::grid_group grid = cg::this_grid();
    const int lo = a.ph_lo, hi = a.ph_hi;
    volatile LAS unsigned* xbw = (volatile LAS unsigned*)(lds + LDS_MAIN);
    if (threadIdx.x < 4) xbw[threadIdx.x] = 0u;
    __syncthreads();
    XcdBarrier xbar = xcd_barrier_post((unsigned*)(a.ws + WS_CTL), xbw);
#define IN(k) (lo <= (k) && (k) < hi)
    if (lo < 0) grid.sync();
#define SEAM(k) do { if (IN(k) && IN((k) + 1)) xcd_barrier(xbar); } while (0)
    const float* mod = (const float*)(a.ws + WS_MOD);
    if (IN(0)) phase0(a, lds);
    SEAM(0);
    if (IN(1)) norm_mod_phase<false>(a.x, a.g_mix, mod, 0, 1, (u16*)(a.ws + WS_ACT));
    SEAM(1);
    if (IN(2)) { gemm8(lds, (const u16*)(a.ws + WS_ACT), (const u16*)(a.ws + WS_WIN), T, NP, D, EpiProj{(u16*)(a.ws + WS_P), (const float*)(a.ws + WS_CS)}); gz_phase(lds, (const u16*)(a.ws + WS_ACT), (const u16*)(a.ws + WS_WIN) + (size_t)NP * D, (float*)(a.ws + WS_GZ)); }
    SEAM(2);
    if (IN(3)) phase_rope_prep(a, lds);
    SEAM(3);
    if (IN(4)) phase_mixers(a, lds);
    SEAM(4);
    if (IN(5)) phase_gla_fin(a);
    SEAM(5);
    if (IN(6)) gemm8(lds, (const u16*)(a.ws + WS_ACT), (const u16*)(a.ws + WS_WOUT), T, D, D, EpiResid{a.x, mod, (u16*)(a.ws + WS_X1)});
    SEAM(6);
    if (IN(7)) { norm_mod_phase<true>(a.ws + WS_X1, a.g_ffn, mod, 3, 4, (u16*)(a.ws + WS_ACT), a.ws + WS_IMG, (int*)(a.ws + WS_KXS)); convert_tables(a); }
    SEAM(7);
    if (IN(8)) gemm8(lds, (const u16*)(a.ws + WS_ACT), (const u16*)(a.ws + WS_WPQ), T, D, D, EpiBf16{(u16*)(a.ws + WS_Q)});
    SEAM(8);
    if (IN(9)) phase_route(a, lds);
    SEAM(9);
    if (IN(10)) phase_eu(a, lds);
    SEAM(10);
    if (IN(11)) phase_ew(a);
    SEAM(11);
    if (IN(12)) phase_ev(a);
#undef IN
#undef SEAM
}

#ifndef MK_ONE_LAUNCH
#define MK_ONE_LAUNCH 1
#endif
extern "C" void kernel_launch(void* const* d_in, const int* in_sizes, int n_in, void* d_out, int out_size, void* d_ws, size_t ws_size, hipStream_t stream) {
    static int grid = 0;
    if (grid == 0) {
        if (n_in != 19 || out_size != T * D || ws_size < WS_END) {
            fprintf(stderr, "kernel_launch: unexpected shapes: n_in %d out %d ws %zu (need %zu)\n", n_in, out_size, ws_size, (size_t)WS_END);
            grid = -1; return;
        }
        int dev = 0, cus = 0, per_cu = 0;
        (void)hipGetDevice(&dev);
        (void)hipDeviceGetAttribute(&cus, hipDeviceAttributeMultiprocessorCount, dev);
        (void)hipFuncSetAttribute((const void*)mk_fwd, hipFuncAttributeMaxDynamicSharedMemorySize, LDS_BYTES);
        (void)hipOccupancyMaxActiveBlocksPerMultiprocessor(&per_cu, (const void*)mk_fwd, NTHREADS, LDS_BYTES);
        if (per_cu < 1) { fprintf(stderr, "kernel_launch: occupancy query says %d blocks/CU\n", per_cu); grid = -1; return; }
        grid = cus;
        (void)hipGetLastError();
    }
    if (grid < 0) return;
    Args a{};
    a.x = (const float*)d_in[0]; a.c = (const float*)d_in[1]; a.pos = (const int*)d_in[2]; a.w_ada = (const float*)d_in[3];
    a.b_ada = (const float*)d_in[4]; a.g_mix = (const float*)d_in[5]; a.w_in = (const float*)d_in[6]; a.wgf = (const float*)d_in[7];
    a.bgf = (const float*)d_in[8]; a.wgb = (const float*)d_in[9]; a.bgb = (const float*)d_in[10]; a.g_gla = (const float*)d_in[11];
    a.w_out = (const float*)d_in[12]; a.g_ffn = (const float*)d_in[13]; a.w_pq = (const float*)d_in[14]; a.subk = (const float*)d_in[15];
    a.pu = (const float*)d_in[16]; a.pv = (const float*)d_in[17]; a.g_fin = (const float*)d_in[18];
    a.out = (float*)d_out; a.ws = (unsigned char*)d_ws;
#if MK_ONE_LAUNCH
    (void)hipMemsetAsync((unsigned char*)d_ws + WS_CTL, 0, XCD_BAR_WORDS * 4, stream);
    a.ph_lo = 0; a.ph_hi = NPHASES;
    void* args[] = {&a};
    hipError_t e = hipLaunchCooperativeKernel((const void*)mk_fwd, dim3(grid), dim3(NTHREADS), args, LDS_BYTES, stream);
    if (e != hipSuccess) fprintf(stderr, "cooperative launch failed: %s (grid %d)\n", hipGetErrorString(e), grid);
#else
    for (int p = 0; p < NPHASES; ++p) {
        a.ph_lo = p; a.ph_hi = p + 1;
        hipLaunchKernelGGL(mk_fwd, dim3(grid), dim3(NTHREADS), LDS_BYTES, stream, a);
    }
#endif
}
```

```cpp
#include <hip/hip_runtime.h>
#include <hip/hip_cooperative_groups.h>
#include <cstdio>
#include <cstdint>

namespace cg = cooperative_groups;

typedef unsigned short u16;
typedef __attribute__((ext_vector_type(8))) short bf16x8;
typedef __attribute__((ext_vector_type(4))) float f32x4;
typedef short s16x4 __attribute__((ext_vector_type(4)));
#define TID ((int)threadIdx.x)
#define BID ((int)blockIdx.x)
#define GDIM ((int)gridDim.x)
#define LAS __attribute__((address_space(3)))

constexpr int D = 2048, NB = 4, S = 4096, T = NB * S;
constexpr int INW = 6176;
constexpr int NP = 6144;
constexpr int NPAD = 6208;
constexpr int C_GQ = 0, C_GK = 512, C_GV = 1024, C_GR = 2048, C_DQ = 3072, C_DK = 4096, C_DV = 5120;
constexpr int NTHREADS = 512, NWAVES = 8;
constexpr int LDS_MAIN = 128 * 1024;
constexpr int LDS_STAGE = 16 * 1024;
constexpr int LDS_BYTES = LDS_MAIN + 16 + LDS_STAGE;
constexpr float NORM_EPS = 1e-6f;

constexpr size_t WS_CTL = 0;
constexpr size_t WS_MOD = 65536;
constexpr size_t WS_CS = 524288;
constexpr size_t WS_WIN = WS_CS + (size_t)T * 64 * 8;
constexpr size_t WS_WOUT = WS_WIN + (size_t)NPAD * D * 2;
constexpr size_t WS_WPQ = WS_WOUT + (size_t)D * D * 2;
constexpr size_t WS_ACT = WS_WPQ + (size_t)D * D * 2;
constexpr size_t WS_P = WS_ACT + (size_t)T * D * 2;
constexpr size_t WS_X1 = WS_P;
constexpr size_t WS_Q = WS_P + (size_t)T * D * 4;
constexpr size_t WS_GZ = WS_P + (size_t)T * NP * 2;
constexpr int GLA_NPREP = NB * 4 * 2 * (S / 64);
constexpr size_t WS_QD = WS_GZ + (size_t)T * 32 * 4;
constexpr size_t WS_KE = WS_QD + (size_t)GLA_NPREP * 16384;
constexpr size_t WS_AT = WS_KE + (size_t)GLA_NPREP * 16384;
constexpr size_t WS_DEC = WS_AT + (size_t)GLA_NPREP * 8192;
constexpr size_t WS_OFB = WS_DEC + (size_t)GLA_NPREP * 512;
constexpr size_t WS_IDX = WS_OFB + (size_t)2 * T * 1024 * 2;
constexpr size_t WS_GATE = WS_IDX + (size_t)T * 128 * 4;
constexpr size_t WS_SS = WS_GATE + (size_t)T * 128 * 4;
constexpr size_t WS_KXS = WS_SS + (size_t)T * 8 * 4;
constexpr size_t WS_END = WS_KXS + (size_t)T * 8 * 4;
constexpr size_t WS_IMG = WS_OFB;
constexpr size_t WS_AP = WS_P + (size_t)T * D * 2;
constexpr size_t SLICE_T = (size_t)16384 * 128, SLICE_S = (size_t)16384 * 8;
constexpr size_t WS_TU = WS_QD;
constexpr size_t WS_TV = WS_TU + (size_t)16384 * 1024;
constexpr size_t WS_SU = WS_TV + (size_t)16384 * 1024;
constexpr size_t WS_SV = WS_SU + (size_t)16384 * 128;
static_assert(WS_SV + (size_t)16384 * 128 <= WS_IDX, "table region");

struct Args {
    const float* x; const float* c; const int* pos; const float* w_ada; const float* b_ada; const float* g_mix;
    const float* w_in; const float* wgf; const float* bgf; const float* wgb; const float* bgb; const float* g_gla;
    const float* w_out; const float* g_ffn; const float* w_pq; const float* subk; const float* pu; const float* pv; const float* g_fin;
    float* out; unsigned char* ws; int ph_lo, ph_hi;
};

__device__ __forceinline__ float bf2f(u16 h) { return __uint_as_float(((unsigned)h) << 16); }
typedef __bf16 hw_bf16x2 __attribute__((ext_vector_type(2)));
typedef float hw_f32x2 __attribute__((ext_vector_type(2)));
typedef unsigned u32x2_t __attribute__((ext_vector_type(2)));
__device__ __forceinline__ unsigned pack2(float a, float b) { const hw_f32x2 f = {a, b}; return __builtin_bit_cast(unsigned, __builtin_convertvector(f, hw_bf16x2)); }
__device__ __forceinline__ u16 f2bf(float f) { return (u16)(pack2(f, 0.f) & 0xffffu); }
__device__ __forceinline__ float lo2f(unsigned p) { return __uint_as_float(p << 16); }
__device__ __forceinline__ float hi2f(unsigned p) { return __uint_as_float(p & 0xffff0000u); }
__device__ __forceinline__ float wave_sum(float v) {
#pragma unroll
    for (int o = 32; o > 0; o >>= 1) v += __shfl_xor(v, o);
    return v;
}
__device__ __forceinline__ float wave_max(float v) {
#pragma unroll
    for (int o = 32; o > 0; o >>= 1) v = fmaxf(v, __shfl_xor(v, o));
    return v;
}
__device__ __forceinline__ float silu_f(float v) { return v / (1.f + __expf(-v)); }
__device__ __forceinline__ float gelu_f(float a) { return 0.5f * a * (1.f + erff(a * 0.70710678118654752f)); }
__device__ __forceinline__ float logsigmoid_f(float z) { return z < 0.f ? z - log1pf(expf(z)) : -log1pf(expf(-z)); }

constexpr int MOD_BLOCKS = 96;
__device__ __forceinline__ void p0_mod(const Args& a, unsigned char* lds, int bi) {
    float* sc = (float*)lds;
    float* red = sc + 4 * 2048;
    const int tid = threadIdx.x, lane = tid & 63, wave = tid >> 6;
    for (int i = tid; i < 4 * 2048; i += NTHREADS) sc[i] = silu_f(a.c[i]);
    __syncthreads();
    const int j0 = bi * 128 + lane * 2;
    float acc[4][2];
#pragma unroll
    for (int b = 0; b < 4; ++b) { acc[b][0] = 0.f; acc[b][1] = 0.f; }
    const int k0 = wave * 256;
#pragma unroll 8
    for (int kk = 0; kk < 256; ++kk) {
        const int k = k0 + kk;
        const hw_f32x2 wv_ = __builtin_nontemporal_load((const hw_f32x2*)(a.w_ada + (size_t)k * 12288 + j0)); const float2 w = make_float2(wv_[0], wv_[1]);
#pragma unroll
        for (int b = 0; b < 4; ++b) { const float s = sc[b * 2048 + k]; acc[b][0] += s * w.x; acc[b][1] += s * w.y; }
    }
#pragma unroll
    for (int b = 0; b < 4; ++b) { red[(wave * 4 + b) * 128 + lane * 2] = acc[b][0]; red[(wave * 4 + b) * 128 + lane * 2 + 1] = acc[b][1]; }
    __syncthreads();
    float* mod = (float*)(a.ws + WS_MOD);
    {
        const int b = tid >> 7, jc = tid & 127;
        float s = 0.f;
#pragma unroll
        for (int w = 0; w < 8; ++w) s += red[(w * 4 + b) * 128 + jc];
        mod[b * 12288 + bi * 128 + jc] = s + a.b_ada[bi * 128 + jc];
    }
    __syncthreads();
}

__device__ __forceinline__ void p0_transpose_item(const float* __restrict__ W, int ldw, int k0, int src_col0, int n_valid,
                                                  u16* __restrict__ WT, int ldt, int n_out0, unsigned char* wlds, bool rope_perm = false) {
    u16* tl = (u16*)wlds;
    const int lane = threadIdx.x & 63;
    const int rsub = lane >> 4, nc = (lane & 15) * 4;
    int scol = src_col0 + nc;
    if (rope_perm) { const int p = (n_out0 & 64) + nc, g = p >> 3; scol = (src_col0 - (n_out0 & 64)) + ((p & 4) ? 64 + 4 * g : 4 * g); }
    float4 v[16];
#pragma unroll
    for (int j = 0; j < 16; ++j) {
        const int k = 4 * j + rsub;
        if (nc < n_valid) { const f32x4 q_ = __builtin_nontemporal_load((const f32x4*)(W + (size_t)(k0 + k) * ldw + scol)); v[j] = make_float4(q_[0], q_[1], q_[2], q_[3]); }
        else v[j] = make_float4(0.f, 0.f, 0.f, 0.f);
    }
#pragma unroll
    for (int j = 0; j < 16; ++j) {
        const int k = 4 * j + rsub;
        tl[(nc + 0) * 72 + k] = f2bf(v[j].x); tl[(nc + 1) * 72 + k] = f2bf(v[j].y); tl[(nc + 2) * 72 + k] = f2bf(v[j].z); tl[(nc + 3) * 72 + k] = f2bf(v[j].w);
    }
#pragma unroll
    for (int j = 0; j < 8; ++j) {
        const int c = lane + 64 * j, n = c >> 3, kc = (c & 7) * 8;
        const uint4 o = *(const uint4*)(tl + n * 72 + kc);
        *(uint4*)(WT + (size_t)(n_out0 + n) * ldt + k0 + kc) = o;
    }
}

__device__ __forceinline__ void phase0(const Args& a, unsigned char* lds) {
    const int bi = blockIdx.x, G = gridDim.x, tid = threadIdx.x, wave = tid >> 6;
    const bool modblk = (G > MOD_BLOCKS) && (bi < MOD_BLOCKS);
    if (G > MOD_BLOCKS) { if (modblk) p0_mod(a, lds, bi); }
    else { for (int mb = bi; mb < MOD_BLOCKS; mb += G) p0_mod(a, lds, mb); }
    const int nb = (G > MOD_BLOCKS) ? G - MOD_BLOCKS : G, b0 = (G > MOD_BLOCKS) ? bi - MOD_BLOCKS : bi;
    if (!modblk) {
        constexpr int I_IN = 32 * (NPAD / 64), I_SQ = 32 * 32;
        u16* WinT = (u16*)(a.ws + WS_WIN); u16* WoutT = (u16*)(a.ws + WS_WOUT); u16* WpqT = (u16*)(a.ws + WS_WPQ);
        unsigned char* wlds = lds + wave * 9216;
        for (int it = b0 * NWAVES + wave; it < I_IN + 2 * I_SQ; it += nb * NWAVES) {
            if (it < I_IN) {
                const int kt = it & 31, nt = it >> 5;
                const int n0 = nt * 64;
                int src, nv;
                if (n0 < 3072) { src = n0; nv = 64; }
                else if (n0 < 6144) { src = n0 + 32; nv = 64; }
                else if (n0 == 6144) { src = 3072; nv = 32; }
                else { src = 0; nv = 0; }
                p0_transpose_item(a.w_in, INW, kt * 64, src, nv, WinT, D, n0, wlds, n0 >= C_DQ && n0 < C_DV);
            } else if (it < I_IN + I_SQ) {
                const int r = it - I_IN; const int kt = r & 31, nt = r >> 5;
                p0_transpose_item(a.w_out, D, kt * 64, nt * 64, 64, WoutT, D, nt * 64, wlds);
            } else {
                const int r = it - I_IN - I_SQ; const int kt = r & 31, nt = r >> 5;
                p0_transpose_item(a.w_pq, D, kt * 64, nt * 64, 64, WpqT, D, nt * 64, wlds);
            }
        }
        float2* cs = (float2*)(a.ws + WS_CS);
        for (int i = b0 * NTHREADS + tid; i < T * 64; i += nb * NTHREADS) {
            const int t = i >> 6, f = i & 63;
            const float inv_freq = powf(10000.0f, -(float)f * 2.0f / 128.0f);
            const float ang = (float)a.pos[t] * inv_freq;
            const double rev = (double)ang * 0.15915494309189533577;
            const float fr = (float)(rev - floor(rev));
            cs[i] = make_float2(__builtin_amdgcn_cosf(fr), __builtin_amdgcn_sinf(fr));
        }
    }
    __syncthreads();
}

template <bool BF16IN> __device__ __forceinline__ void norm_mod_phase(const void* __restrict__ xin_, const float* __restrict__ g, const float* __restrict__ mod,
                                               int sh_chunk, int sc_chunk, u16* __restrict__ outp, unsigned char* __restrict__ img = nullptr, int* __restrict__ kxs = nullptr) {
    const int lane = threadIdx.x & 63, wave = threadIdx.x >> 6;
    const int gw = blockIdx.x * NWAVES + wave, NGW = gridDim.x * NWAVES;
    float4 v[8], vn[8];
#define NM_LOAD(dst_, t_) do { if (BF16IN) { const hw_f32x2* xr_ = (const hw_f32x2*)((const u16*)xin_ + (size_t)(t_) * D); \
            _Pragma("unroll") for (int m = 0; m < 8; ++m) { const hw_f32x2 q_ = __builtin_nontemporal_load(xr_ + lane + 64 * m); const unsigned px_ = __float_as_uint(q_[0]), py_ = __float_as_uint(q_[1]); \
                dst_[m] = make_float4(lo2f(px_), hi2f(px_), lo2f(py_), hi2f(py_)); } } \
        else { const f32x4* xr_ = (const f32x4*)((const float*)xin_ + (size_t)(t_) * D); \
            _Pragma("unroll") for (int m = 0; m < 8; ++m) { const f32x4 q_ = __builtin_nontemporal_load(xr_ + lane + 64 * m); dst_[m] = make_float4(q_[0], q_[1], q_[2], q_[3]); } } } while (0)
    if (gw < T) NM_LOAD(v, gw);
    for (int t = gw; t < T; t += NGW) {
        const int b = t / S;
        if (t + NGW < T) NM_LOAD(vn, t + NGW);
        float ss = 0.f;
#pragma unroll
        for (int m = 0; m < 8; ++m) ss += v[m].x * v[m].x + v[m].y * v[m].y + v[m].z * v[m].z + v[m].w * v[m].w;
        ss = wave_sum(ss);
        const float rstd = rsqrtf(ss * (1.f / D) + NORM_EPS);
        const float4* gp = (const float4*)g;
        const float4* shp = (const float4*)(mod + b * 12288 + sh_chunk * 2048);
        const float4* scp = (const float4*)(mod + b * 12288 + sc_chunk * 2048);
        uint2* op = (uint2*)(outp + (size_t)t * D);
#pragma unroll
        for (int m = 0; m < 8; ++m) {
            const int i = lane + 64 * m;
            const float4 gg = gp[i], sh = shp[i], sc = scp[i];
            const float h0 = v[m].x * rstd * gg.x * (1.f + sc.x) + sh.x;
            const float h1 = v[m].y * rstd * gg.y * (1.f + sc.y) + sh.y;
            const float h2 = v[m].z * rstd * gg.z * (1.f + sc.z) + sh.z;
            const float h3 = v[m].w * rstd * gg.w * (1.f + sc.w) + sh.w;
            const uint2 pk = make_uint2(pack2(h0, h1), pack2(h2, h3));
            op[i] = pk;
            if (BF16IN) {
                const float e0 = lo2f(pk.x), e1 = hi2f(pk.x), e2 = lo2f(pk.y), e3 = hi2f(pk.y);
                float amx = fmaxf(fmaxf(fabsf(e0), fabsf(e1)), fmaxf(fabsf(e2), fabsf(e3)));
#pragma unroll
                for (int o = 32; o > 0; o >>= 1) amx = fmaxf(amx, __shfl_xor(amx, o));
                const unsigned bits = __float_as_uint(amx);
                int kx = (int)(bits >> 23) - 127 - 8 + (((bits & 0x7fffffu) > 0x600000u) ? 1 : 0); kx = kx < -100 ? -100 : kx;
                const float hinv = __uint_as_float((unsigned)(127 - kx) << 23);
                const float x0 = e0 * hinv, x1 = e1 * hinv, x2 = e2 * hinv, x3 = e3 * hinv;
                int w = __builtin_amdgcn_cvt_pk_fp8_f32(x0, x1, 0, false); w = __builtin_amdgcn_cvt_pk_fp8_f32(x2, x3, w, true);
                const hw_f32x2 d0 = __builtin_amdgcn_cvt_pk_f32_fp8(w, false), d1 = __builtin_amdgcn_cvt_pk_f32_fp8(w, true);
                int l = __builtin_amdgcn_cvt_pk_fp8_f32((x0 - d0[0]) * 16.f, (x1 - d0[1]) * 16.f, 0, false);
                l = __builtin_amdgcn_cvt_pk_fp8_f32((x2 - d1[0]) * 16.f, (x3 - d1[1]) * 16.f, l, true);
                const int ei = 4 * lane, s = ei >> 7, k = ei & 127, g = (k & 63) >> 4, bb = (k & 15) + 16 * (k >> 6);
                unsigned char* ip = img + (((size_t)t * 8 + m) * 8 + 2 * g) * 64 + s * 32 + bb;
                *(int*)ip = w; *(int*)(ip + 64) = l;
                if (lane == 0) kxs[(size_t)t * 8 + m] = kx;
            }
        }
#pragma unroll
        for (int m = 0; m < 8; ++m) v[m] = vn[m];
    }
#undef NM_LOAD
}

namespace pg8 {
#define PG8_LAS __attribute__((address_space(3)))
typedef unsigned short bf16_t;
typedef short bf16x8 __attribute__((ext_vector_type(8)));
typedef float f32x4 __attribute__((ext_vector_type(4)));
typedef unsigned u32x4 __attribute__((ext_vector_type(4)));
constexpr int BM = 256, BK = 64, HALF = 128, HTB = HALF * BK * 2  , STAGE_BYTES = 8 * HTB, NXCD = 8, WGM = 8;

__host__ __device__ __forceinline__ int lds_byte(int r, int c) { const int st = (r >> 4) * 2 + (c >> 5), rr = r & 15, cc = c & 31, ob = rr * 64 + cc * 2; return st * 1024 + (ob ^ (((ob >> 9) & 1) << 5)); }
__host__ __device__ __forceinline__ void stage_rc(int b, int& R, int& C) { const int st = b / 1024, sb = b % 1024, swz = sb ^ (((sb >> 9) & 1) << 5); R = (st >> 1) * 16 + swz / 64; C = (st & 1) * 32 + (swz % 64) / 2; }
__host__ __device__ __forceinline__ int perm32(int rho) { const int n = rho >> 4, i = rho & 15; return 8 * (i >> 2) + 4 * n + (i & 3); }

struct Unit { int pm, pn; };
struct Gemm { const bf16_t* A; const bf16_t* Bt; int M, N, K; };

struct StaticOrder {
    int nM, nN, nwg, G, c;
    __host__ __device__ void init(int M, int N, int G_, int c_) { nM = M / BM; nN = N / BM; nwg = nM * nN; G = G_; c = c_; }
    __host__ __device__ bool next(int i, Unit& u) const {
        const long L = (long)i * G + c; if (L >= nwg) return false;
        int wgid = (int)L; { const int q = nwg / NXCD, r = nwg % NXCD, xcd = wgid % NXCD, off = wgid / NXCD; wgid = (xcd < r ? xcd * (q + 1) : r * (q + 1) + (xcd - r) * q) + off; }
        const int nig = WGM * nN, gid = wgid / nig, fm = gid * WGM, gsz = (nM - fm) < WGM ? (nM - fm) : WGM;
        u.pm = fm + ((wgid % nig) % gsz); u.pn = (wgid % nig) / gsz; return true;
    }
    __device__ __forceinline__ void a_ready(const Unit&) const {}
    __device__ __forceinline__ void done(const Unit&) const {}
};
__device__ __forceinline__ unsigned cvt_pk_bf16(float lo, float hi) { unsigned r; asm volatile("v_cvt_pk_bf16_f32 %0, %1, %2" : "=v"(r) : "v"(lo), "v"(hi)); return r; }
typedef float f32x2 __attribute__((ext_vector_type(2)));
template <class Epi, class Sched, bool STAMP = false>
__device__ __forceinline__ void gemm_phase(PG8_LAS unsigned char* lds, const Gemm g, const Sched& S, const Epi& E, unsigned long long* stamps) {
    const int tid = threadIdx.x, wid = __builtin_amdgcn_readfirstlane(tid >> 6), lane = tid & 63, wr = wid >> 2, wc = wid & 3, fr = lane & 15, fq = lane >> 4;
    const int K = g.K, nt = K / BK;
    int ts_lo = 0, ts_hi = 0, nts = 0; const unsigned long long rt_entry = STAMP ? (unsigned long long)wall_clock64() : 0ull;
#define PG8_STAMP() do { if (STAMP && wid == 0 && nts < 64) { const unsigned long long _c = (unsigned long long)clock64(); \
        ts_lo = (lane == nts) ? (int)(unsigned)_c : ts_lo; ts_hi = (lane == nts) ? (int)(unsigned)(_c >> 32) : ts_hi; ++nts; } } while (0)
    PG8_STAMP();
    unsigned voffA[2], voffB[2];
#pragma unroll
    for (int i = 0; i < 2; ++i) { int R, C; stage_rc(tid * 16 + i * 8192, R, C); const int Rb = Epi::PERM ? ((R & ~31) + perm32(R & 31)) : R;
        voffA[i] = (unsigned)(R * K + C) * 2u; voffB[i] = (unsigned)(Rb * K + C) * 2u; }
    const size_t kstep = (size_t)(BK * 2);
    const size_t hstep = (size_t)HALF * K * 2;
    const size_t tstep = 2 * hstep;
    const unsigned ldsw = (unsigned)wid * 1024u;
    const int aoff = lds_byte(wr * 64 + fr, fq * 8), boff = lds_byte(wc * 32 + fr, fq * 8);
#define PG8_SA(b, h) (((b) * 2 + (h)) * HTB)
#define PG8_SB(b, h) ((4 + (b) * 2 + (h)) * HTB)
#define PG8_STAGE(bufoff, gbase, voff) do { _Pragma("unroll") for (int _i = 0; _i < 2; ++_i) \
        __builtin_amdgcn_global_load_lds((const unsigned*)((const char*)(gbase) + (voff)[_i]), (PG8_LAS unsigned*)(lds + (bufoff) + ldsw + _i * 8192), 16, 0, 0); } while (0)
#define PG8_LDA(dst, b, h) do { _Pragma("unroll") for (int m = 0; m < 4; ++m) _Pragma("unroll") for (int k = 0; k < 2; ++k) dst[m][k] = *(const PG8_LAS bf16x8*)(lds + PG8_SA(b, h) + aoff + m * 2048 + k * 1024); } while (0)
#define PG8_LDB(dst, b, h) do { _Pragma("unroll") for (int n = 0; n < 2; ++n) _Pragma("unroll") for (int k = 0; k < 2; ++k) dst[n][k] = *(const PG8_LAS bf16x8*)(lds + PG8_SB(b, h) + boff + n * 2048 + k * 1024); } while (0)
#define PG8_MMA(ai, bj, At, Bt) do { __builtin_amdgcn_s_setprio(1); _Pragma("unroll") for (int m = 0; m < 4; ++m) _Pragma("unroll") for (int n = 0; n < 2; ++n) _Pragma("unroll") for (int k = 0; k < 2; ++k) \
        acc[ai][bj][m][n] = __builtin_amdgcn_mfma_f32_16x16x32_bf16(Bt[n][k], At[m][k], acc[ai][bj][m][n], 0, 0, 0); __builtin_amdgcn_s_setprio(0); } while (0)
#define PG8_WAIT_V(n) asm volatile("s_waitcnt vmcnt(" #n ")" ::: "memory")
#define PG8_WAIT_L(n) asm volatile("s_waitcnt lgkmcnt(" #n ")" ::: "memory")
#define PG8_BAR __builtin_amdgcn_s_barrier()
#define PG8_SCHED __builtin_amdgcn_sched_barrier(0)
    Unit cur, nxt; int ui = 0;
    if (!S.next(0, cur)) return;
    f32x4 acc[2][2][4][2];
#pragma unroll
    for (int a = 0; a < 2; ++a)
#pragma unroll
        for (int b = 0; b < 2; ++b)
#pragma unroll
            for (int m = 0; m < 4; ++m)
#pragma unroll
                for (int n = 0; n < 2; ++n) acc[a][b][m][n] = (f32x4){0.f, 0.f, 0.f, 0.f};
    bf16x8 At[4][2], B0[2][2], B1[2][2];
    const char* cA = (const char*)g.A + (size_t)cur.pm * tstep; const char* cB = (const char*)g.Bt + (size_t)cur.pn * tstep;
    S.a_ready(cur);
    PG8_STAGE(PG8_SB(0, 0), cB, voffB); PG8_STAGE(PG8_SA(0, 0), cA, voffA); PG8_STAGE(PG8_SB(0, 1), cB + hstep, voffB); PG8_STAGE(PG8_SA(0, 1), cA + hstep, voffA);
    if (wr == 1) PG8_BAR;
    PG8_WAIT_V(4); PG8_BAR;
    PG8_STAGE(PG8_SB(1, 0), cB + kstep, voffB); PG8_STAGE(PG8_SA(1, 0), cA + kstep, voffA); PG8_STAGE(PG8_SB(1, 1), cB + hstep + kstep, voffB);
    PG8_WAIT_V(6); PG8_BAR;
    PG8_STAMP();
    for (;;) {
        const bool has_next = S.next(ui + 1, nxt);
        const char* nA = has_next ? (const char*)g.A + (size_t)nxt.pm * tstep : cA; const char* nB = has_next ? (const char*)g.Bt + (size_t)nxt.pn * tstep : cB;
        for (int t = 0; t < nt; t += 2) {
            const bool last = (t == nt - 2);
            const char* a1 = cA + (size_t)(t + 1) * kstep;
            const char* a2 = last ? nA : cA + (size_t)(t + 2) * kstep; const char* b2 = last ? nB : cB + (size_t)(t + 2) * kstep;
            const char* a3 = a2 + kstep; const char* b3 = b2 + kstep;
            if (last && has_next) S.a_ready(nxt);
            PG8_LDB(B0, 0, 0); PG8_SCHED; PG8_LDA(At, 0, 0); PG8_STAGE(PG8_SA(1, 1), a1 + hstep, voffA);
            PG8_WAIT_L(8); PG8_BAR; PG8_WAIT_L(0); PG8_MMA(0, 0, At, B0); PG8_BAR; PG8_SCHED;
            PG8_LDB(B1, 0, 1); PG8_STAGE(PG8_SB(0, 0), b2, voffB);
            PG8_BAR; PG8_WAIT_L(0); PG8_MMA(0, 1, At, B1); PG8_BAR;
            PG8_LDA(At, 0, 1); PG8_STAGE(PG8_SA(0, 0), a2, voffA);
            PG8_BAR; PG8_WAIT_L(0); PG8_MMA(1, 0, At, B0); PG8_BAR; PG8_SCHED;
            PG8_STAGE(PG8_SB(0, 1), b2 + hstep, voffB);
            PG8_WAIT_V(6); PG8_BAR; PG8_MMA(1, 1, At, B1); PG8_BAR;
            PG8_LDB(B0, 1, 0); PG8_SCHED; PG8_LDA(At, 1, 0); PG8_STAGE(PG8_SA(0, 1), a2 + hstep, voffA);
            PG8_WAIT_L(8); PG8_BAR; PG8_WAIT_L(0); PG8_MMA(0, 0, At, B0); PG8_BAR; PG8_SCHED;
            PG8_LDB(B1, 1, 1); PG8_STAGE(PG8_SB(1, 0), b3, voffB);
            PG8_BAR; PG8_WAIT_L(0); PG8_MMA(0, 1, At, B1); PG8_BAR;
            PG8_LDA(At, 1, 1); PG8_STAGE(PG8_SA(1, 0), a3, voffA);
            PG8_BAR; PG8_WAIT_L(0); PG8_MMA(1, 0, At, B0); PG8_BAR; PG8_SCHED;
            PG8_STAGE(PG8_SB(1, 1), b3 + hstep, voffB);
            PG8_WAIT_V(6); PG8_BAR; PG8_MMA(1, 1, At, B1); PG8_BAR;
        }
        PG8_STAMP();
        if constexpr (!Epi::AFTER_DRAIN) { E(acc, cur, wr, wc, fr, fq); S.done(cur); }
        PG8_STAMP();
        if (!has_next) break;
#pragma unroll
        for (int a = 0; a < 2; ++a)
#pragma unroll
            for (int b = 0; b < 2; ++b)
#pragma unroll
                for (int m = 0; m < 4; ++m)
#pragma unroll
                    for (int n = 0; n < 2; ++n) acc[a][b][m][n] = (f32x4){0.f, 0.f, 0.f, 0.f};
        cur = nxt; cA = nA; cB = nB; ++ui;
    }
    PG8_WAIT_V(0);
    if (wr == 0) PG8_BAR;
    PG8_BAR;
    if constexpr (Epi::AFTER_DRAIN) { E.fused(acc, cur, wr, wc, fr, fq, lds, wid, lane); S.done(cur); }
    PG8_STAMP();
    if (STAMP && wid == 0) { stamps[lane] = lane < nts ? (((unsigned long long)(unsigned)ts_hi << 32) | (unsigned)ts_lo) : 0ull;
        if (lane == 62) stamps[62] = rt_entry; if (lane == 63) stamps[63] = (unsigned long long)wall_clock64(); }
#undef PG8_STAMP
#undef PG8_SA
#undef PG8_SB
#undef PG8_STAGE
#undef PG8_LDA
#undef PG8_LDB
#undef PG8_MMA
#undef PG8_WAIT_V
#undef PG8_WAIT_L
#undef PG8_BAR
#undef PG8_SCHED
}
}

struct EpiProj {
    static constexpr bool PERM = true, AFTER_DRAIN = false;
    u16* P; const float* cs;
    __device__ __forceinline__ void operator()(const pg8::f32x4 (&acc)[2][2][4][2], const pg8::Unit& u, int wr, int wc, int fr, int fq) const {
        const int row0 = u.pm * 256 + wr * 64 + fr;
        const int col0 = u.pn * 256 + wc * 32 + 8 * fq;
        const bool rope = (u.pn >= C_DQ / 256) && (u.pn < C_DV / 256);
#pragma unroll
        for (int ai = 0; ai < 2; ++ai)
#pragma unroll
            for (int m = 0; m < 4; ++m) { const int row = row0 + ai * 128 + m * 16; u16* rowp = P + (size_t)row * NP + col0;
                pg8::f32x4 c01 = (pg8::f32x4){1.f, 0.f, 1.f, 0.f}, c23 = c01;
                if (rope) { const pg8::f32x4* cp = (const pg8::f32x4*)(cs + ((size_t)row * 64 + 4 * (4 * wc + fq)) * 2); c01 = cp[0]; c23 = cp[1]; }
#pragma unroll
                for (int bj = 0; bj < 2; ++bj) { pg8::f32x4 v0 = acc[ai][bj][m][0], v1 = acc[ai][bj][m][1];
                    if (rope) {
                        const pg8::f32x4 cc = {c01[0], c01[2], c23[0], c23[2]}, sn = {c01[1], c01[3], c23[1], c23[3]};
                        const pg8::f32x4 y1 = v0 * cc - v1 * sn, y2 = v0 * sn + v1 * cc; v0 = y1; v1 = y2; }
                    pg8::u32x4 w; w.x = pg8::cvt_pk_bf16(v0[0], v0[1]); w.y = pg8::cvt_pk_bf16(v0[2], v0[3]); w.z = pg8::cvt_pk_bf16(v1[0], v1[1]); w.w = pg8::cvt_pk_bf16(v1[2], v1[3]);
                    *(pg8::u32x4*)(rowp + bj * 128) = w; } }
    }
};
__device__ __forceinline__ void gz_phase(unsigned char* lds, const u16* __restrict__ H1, const u16* __restrict__ Wg, float* __restrict__ gz) {
    const int tid = threadIdx.x, lane = tid & 63, wave = tid >> 6, fr = lane & 15, fq = lane >> 4;
    float* red = (float*)lds;
    for (int rb = blockIdx.x; rb < T / 64; rb += gridDim.x) {
        const int r0 = rb * 64, k0 = wave * 256;
        f32x4 acc[4][2];
#pragma unroll
        for (int m = 0; m < 4; ++m) { acc[m][0] = (f32x4){0.f, 0.f, 0.f, 0.f}; acc[m][1] = (f32x4){0.f, 0.f, 0.f, 0.f}; }
#pragma unroll
        for (int ks = 0; ks < 8; ++ks) {
            bf16x8 af[4], bfr[2];
#pragma unroll
            for (int m = 0; m < 4; ++m) af[m] = *(const bf16x8*)(H1 + (size_t)(r0 + 16 * m + fr) * D + k0 + 32 * ks + 8 * fq);
#pragma unroll
            for (int n = 0; n < 2; ++n) bfr[n] = *(const bf16x8*)(Wg + (size_t)(16 * n + fr) * D + k0 + 32 * ks + 8 * fq);
#pragma unroll
            for (int m = 0; m < 4; ++m)
#pragma unroll
                for (int n = 0; n < 2; ++n) acc[m][n] = __builtin_amdgcn_mfma_f32_16x16x32_bf16(af[m], bfr[n], acc[m][n], 0, 0, 0);
        }
        __syncthreads();
#pragma unroll
        for (int m = 0; m < 4; ++m)
#pragma unroll
            for (int n = 0; n < 2; ++n)
#pragma unroll
                for (int j = 0; j < 4; ++j) red[(wave * 64 + 16 * m + 4 * fq + j) * 32 + 16 * n + fr] = acc[m][n][j];
        __syncthreads();
#pragma unroll
        for (int k = 0; k < 4; ++k) {
            const int e = tid + 512 * k;
            float s = 0.f;
#pragma unroll
            for (int w = 0; w < 8; ++w) s += red[w * 2048 + e];
            gz[(size_t)r0 * 32 + e] = s;
        }
    }
    __syncthreads();
}
struct EpiResid {
    static constexpr bool PERM = true, AFTER_DRAIN = false;
    const float* x; const float* mod; u16* x1;
    __device__ __forceinline__ void operator()(const pg8::f32x4 (&acc)[2][2][4][2], const pg8::Unit& u, int wr, int wc, int fr, int fq) const {
        const int row0 = u.pm * 256 + wr * 64 + fr, col0 = u.pn * 256 + wc * 32 + 8 * fq;
        const int b = (u.pm * 256) / S;
        pg8::f32x4 ga[2][2];
#pragma unroll
        for (int bj = 0; bj < 2; ++bj)
#pragma unroll
            for (int n = 0; n < 2; ++n) ga[bj][n] = *(const pg8::f32x4*)(mod + b * 12288 + 2 * 2048 + col0 + bj * 128 + 4 * n);
#pragma unroll
        for (int ai = 0; ai < 2; ++ai)
#pragma unroll
            for (int m = 0; m < 4; ++m) { const size_t off = (size_t)(row0 + ai * 128 + m * 16) * D + col0;
#pragma unroll
                for (int bj = 0; bj < 2; ++bj) {
                    const pg8::f32x4 x0 = __builtin_nontemporal_load((const pg8::f32x4*)(x + off + bj * 128)), x1v = __builtin_nontemporal_load((const pg8::f32x4*)(x + off + bj * 128 + 4));
                    const pg8::f32x4 v0 = x0 + ga[bj][0] * acc[ai][bj][m][0], v1 = x1v + ga[bj][1] * acc[ai][bj][m][1];
                    pg8::u32x4 w; w.x = pg8::cvt_pk_bf16(v0[0], v0[1]); w.y = pg8::cvt_pk_bf16(v0[2], v0[3]); w.z = pg8::cvt_pk_bf16(v1[0], v1[1]); w.w = pg8::cvt_pk_bf16(v1[2], v1[3]);
                    *(pg8::u32x4*)(x1 + off + bj * 128) = w; } }
    }
};
struct EpiBf16 {
    static constexpr bool PERM = true, AFTER_DRAIN = false;
    u16* Q;
    __device__ __forceinline__ void operator()(const pg8::f32x4 (&acc)[2][2][4][2], const pg8::Unit& u, int wr, int wc, int fr, int fq) const {
        const int row0 = u.pm * 256 + wr * 64 + fr, col0 = u.pn * 256 + wc * 32 + 8 * fq;
#pragma unroll
        for (int ai = 0; ai < 2; ++ai)
#pragma unroll
            for (int m = 0; m < 4; ++m) { u16* rowp = Q + (size_t)(row0 + ai * 128 + m * 16) * D + col0;
#pragma unroll
                for (int bj = 0; bj < 2; ++bj) { const pg8::f32x4 v0 = acc[ai][bj][m][0], v1 = acc[ai][bj][m][1];
                    pg8::u32x4 w; w.x = pg8::cvt_pk_bf16(v0[0], v0[1]); w.y = pg8::cvt_pk_bf16(v0[2], v0[3]); w.z = pg8::cvt_pk_bf16(v1[0], v1[1]); w.w = pg8::cvt_pk_bf16(v1[2], v1[3]);
                    *(pg8::u32x4*)(rowp + bj * 128) = w; } }
    }
};
template <class Epi>
__device__ __forceinline__ void gemm8(unsigned char* lds, const u16* A, const u16* Bt, int M, int N, int K, const Epi& E) {
    pg8::Gemm g{A, Bt, M, N, K}; pg8::StaticOrder So; So.init(M, N, (int)gridDim.x, (int)blockIdx.x);
    pg8::gemm_phase<Epi, pg8::StaticOrder, false>((PG8_LAS unsigned char*)lds, g, So, E, nullptr);
    __syncthreads();
}

#define GLA_QD_BYTES 16384
#define GLA_AT_BYTES 8192
__device__ __forceinline__ float gla_logsigmoid(float z) { return fminf(z, 0.f) - __logf(1.f + __expf(-fabsf(z))); }

__device__ __forceinline__ void gla_prep_item(const u16* __restrict__ P, int ldp, int cq, int ck, const float* __restrict__ gz,
                                              const float* __restrict__ wg_f, const float* __restrict__ bg_f, const float* __restrict__ wg_b, const float* __restrict__ bg_b,
                                              int Sq, unsigned char* __restrict__ QDg, unsigned char* __restrict__ KEg, unsigned char* __restrict__ ATg, float* __restrict__ DECg,
                                              unsigned char* lds, int item) {
    const int nch = Sq / 64;
    const int c = item % nch, dir = (item / nch) & 1, hh = (item / (nch * 2)) & 3, b = item / (nch * 8);
    const int tid = TID, lane = tid & 63, wave = tid >> 6, li = lane & 15, fq = lane >> 4;
    float* gzs = (float*)lds;
    float* segs = gzs + 64 * 16;
    unsigned char* QDs = lds + 8192;
    unsigned char* KIs = QDs + 16384;
    unsigned char* KEs = KIs + 16384;
    float* bmat = (float*)(KEs + 16384);
    const size_t tok0 = (size_t)b * Sq;
    __syncthreads();
    uint4 rq0, rq1, rk0, rk1;
    {
        const int i0 = tid >> 4, i1 = (tid + 512) >> 4, cc = tid & 15;
        const int s0 = dir ? (Sq - 1 - (64 * c + i0)) : (64 * c + i0), s1 = dir ? (Sq - 1 - (64 * c + i1)) : (64 * c + i1);
        rq0 = *(const uint4*)(P + (tok0 + s0) * ldp + cq + hh * 128 + cc * 8); rk0 = *(const uint4*)(P + (tok0 + s0) * ldp + ck + hh * 128 + cc * 8);
        rq1 = *(const uint4*)(P + (tok0 + s1) * ldp + cq + hh * 128 + cc * 8); rk1 = *(const uint4*)(P + (tok0 + s1) * ldp + ck + hh * 128 + cc * 8);
    }
    for (int e = tid; e < 64 * 16; e += 512) {
        const int i = e >> 4, r = e & 15;
        const int s = dir ? (Sq - 1 - (64 * c + i)) : (64 * c + i);
        gzs[e] = gz[(tok0 + s) * 32 + dir * 16 + r];
    }
    const int d = tid & 127, seg = tid >> 7;
    const float* wg = dir ? wg_b : wg_f;
    float wcol[16];
#pragma unroll
    for (int r = 0; r < 16; ++r) wcol[r] = wg[r * 512 + hh * 128 + d];
    const float bias = (dir ? bg_b : bg_f)[hh * 128 + d];
    __syncthreads();
    float run = 0.f;
#pragma unroll
    for (int k = 0; k < 16; ++k) {
        const int i = 16 * seg + k;
        float z = bias;
#pragma unroll
        for (int r = 0; r < 16; ++r) z += gzs[i * 16 + r] * wcol[r];
        run += gla_logsigmoid(z) * (1.f / 16.f);
        bmat[i * 128 + d] = run;
    }
    segs[seg * 128 + d] = run;
    __syncthreads();
    if (seg == 0) {
        const float t0 = segs[d], t1 = segs[128 + d], t2 = segs[256 + d], t3 = segs[384 + d];
        segs[d] = 0.f; segs[128 + d] = t0; segs[256 + d] = t0 + t1; segs[384 + d] = t0 + t1 + t2; segs[512 + d] = t0 + t1 + t2 + t3;
        DECg[(size_t)item * 128 + d] = __expf(t0 + t1 + t2 + t3);
    }
    __syncthreads();
    const float qscale = 0.08838834764831845f;
#pragma unroll
    for (int k = 0; k < 2; ++k) {
        const int id = tid + 512 * k, i = id >> 4, cc = id & 15, d0 = cc * 8, sg = i >> 4;
        const uint4 qv = k ? rq1 : rq0, kv = k ? rk1 : rk0;
        const float qx[8] = {lo2f(qv.x), hi2f(qv.x), lo2f(qv.y), hi2f(qv.y), lo2f(qv.z), hi2f(qv.z), lo2f(qv.w), hi2f(qv.w)};
        const float kx[8] = {lo2f(kv.x), hi2f(kv.x), lo2f(kv.y), hi2f(kv.y), lo2f(kv.z), hi2f(kv.z), lo2f(kv.w), hi2f(kv.w)};
        float qd[8], ki[8], ke[8];
        const float4 bA = *(const float4*)(bmat + i * 128 + d0), bB = *(const float4*)(bmat + i * 128 + d0 + 4);
        const float4 oA = *(const float4*)(segs + sg * 128 + d0), oB = *(const float4*)(segs + sg * 128 + d0 + 4);
        const float4 tA = *(const float4*)(segs + 512 + d0), tB = *(const float4*)(segs + 512 + d0 + 4);
        const float bv[8] = {bA.x + oA.x, bA.y + oA.y, bA.z + oA.z, bA.w + oA.w, bB.x + oB.x, bB.y + oB.y, bB.z + oB.z, bB.w + oB.w};
        const float tv[8] = {tA.x, tA.y, tA.z, tA.w, tB.x, tB.y, tB.z, tB.w};
#pragma unroll
        for (int e = 0; e < 8; ++e) {
            const float bb = bv[e], tot = tv[e];
            qd[e] = qx[e] * qscale * __expf(bb); ki[e] = kx[e] * __expf(-bb); ke[e] = kx[e] * __expf(tot - bb);
        }
        const int o = i * 256 + ((cc ^ (i & 15)) << 4);
        *(uint4*)(QDs + o) = make_uint4(pack2(qd[0], qd[1]), pack2(qd[2], qd[3]), pack2(qd[4], qd[5]), pack2(qd[6], qd[7]));
        *(uint4*)(KIs + o) = make_uint4(pack2(ki[0], ki[1]), pack2(ki[2], ki[3]), pack2(ki[4], ki[5]), pack2(ki[6], ki[7]));
        *(uint4*)(KEs + o) = make_uint4(pack2(ke[0], ke[1]), pack2(ke[2], ke[3]), pack2(ke[4], ke[5]), pack2(ke[6], ke[7]));
    }
    __syncthreads();
    {
        uint4* qo = (uint4*)(QDg + (size_t)item * GLA_QD_BYTES); uint4* ko = (uint4*)(KEg + (size_t)item * GLA_QD_BYTES);
#pragma unroll
        for (int k = 0; k < 2; ++k) { const int e = tid + 512 * k; qo[e] = ((const uint4*)QDs)[e]; ko[e] = ((const uint4*)KEs)[e]; }
    }
#pragma unroll
    for (int tt = 0; tt < 2; ++tt) {
        const int tile = wave + 8 * tt, jt = tile >> 2, it = tile & 3;
        f32x4 acc = (f32x4){0.f, 0.f, 0.f, 0.f};
        if (jt <= it) {
            const int jr = 16 * jt + li, ir = 16 * it + li;
#pragma unroll
            for (int ks = 0; ks < 4; ++ks) {
                const bf16x8 kf = *(const bf16x8*)(KIs + jr * 256 + (((4 * ks + fq) ^ (jr & 15)) << 4));
                const bf16x8 qf = *(const bf16x8*)(QDs + ir * 256 + (((4 * ks + fq) ^ (ir & 15)) << 4));
                acc = __builtin_amdgcn_mfma_f32_16x16x32_bf16(kf, qf, acc, 0, 0, 0);
            }
        }
        const int i = 16 * it + li, j0 = 16 * jt + 4 * fq;
        float v[4];
#pragma unroll
        for (int jj = 0; jj < 4; ++jj) v[jj] = (j0 + jj <= i) ? acc[jj] : 0.f;
        const int chunk = 2 * jt + (fq >> 1), sub = (fq & 1) * 8;
        *(uint2*)(ATg + (size_t)item * GLA_AT_BYTES + i * 128 + ((chunk ^ (i & 7)) << 4) + sub) = make_uint2(pack2(v[0], v[1]), pack2(v[2], v[3]));
    }
}

__device__ __forceinline__ void gla_seq_item(const u16* __restrict__ P, int ldp, int cv, int Sq,
                                             const unsigned char* __restrict__ QDg, const unsigned char* __restrict__ KEg, const unsigned char* __restrict__ ATg, const float* __restrict__ DECg,
                                             u16* __restrict__ Oout  , int Ttot, unsigned char* lds, int item) {
    const int slice = item & 1, dir = (item >> 1) & 1, hh = (item >> 2) & 3, b = item >> 4;
    const int nch = Sq / 64;
    const int tid = TID, lane = tid & 63, wave = tid >> 6, li = lane & 15, fq = lane >> 4;
    const size_t tok0 = (size_t)b * Sq;
    const int pitem0 = ((b * 4 + hh) * 2 + dir) * nch;
    constexpr int BUF = 16384 * 3 + 8192 + 512;
    typedef unsigned gla_u32x4 __attribute__((ext_vector_type(4)));
    gla_u32x4 rq0, rq1, rk0, rk1, rv0, rv1, ra; float rd = 0.f;
#define GLA_VROW(c_, k_) ((tok0 + (size_t)(dir ? (Sq - 1 - (64 * (c_) + ((tid + 512 * (k_)) >> 4))) : (64 * (c_) + ((tid + 512 * (k_)) >> 4)))) * ldp + cv + hh * 256 + slice * 128 + ((tid + 512 * (k_)) & 15) * 8)
#define GLA_ISSUE(c_) do { \
        const gla_u32x4* qsrc_ = (const gla_u32x4*)(QDg + (size_t)(pitem0 + (c_)) * GLA_QD_BYTES); const gla_u32x4* ksrc_ = (const gla_u32x4*)(KEg + (size_t)(pitem0 + (c_)) * GLA_QD_BYTES); \
        rq0 = qsrc_[tid]; rq1 = qsrc_[tid + 512]; rk0 = ksrc_[tid]; rk1 = ksrc_[tid + 512]; \
        ra = ((const gla_u32x4*)(ATg + (size_t)(pitem0 + (c_)) * GLA_AT_BYTES))[tid]; \
        rv0 = *(const gla_u32x4*)(P + GLA_VROW(c_, 0)); rv1 = *(const gla_u32x4*)(P + GLA_VROW(c_, 1)); \
        if (tid < 128) rd = DECg[(size_t)(pitem0 + (c_)) * 128 + tid]; } while (0)
#define GLA_COMMIT(buf_) do { \
        unsigned char* base_ = lds + (buf_) * BUF; \
        ((gla_u32x4*)base_)[tid] = rq0; ((gla_u32x4*)base_)[tid + 512] = rq1; ((gla_u32x4*)(base_ + 16384))[tid] = rk0; ((gla_u32x4*)(base_ + 16384))[tid + 512] = rk1; \
        { const int row_ = tid >> 4, ch_ = tid & 15; *(gla_u32x4*)(base_ + 32768 + row_ * 256 + ((ch_ ^ (row_ & 15)) << 4)) = rv0; } \
        { const int row_ = (tid + 512) >> 4, ch_ = tid & 15; *(gla_u32x4*)(base_ + 32768 + row_ * 256 + ((ch_ ^ (row_ & 15)) << 4)) = rv1; } \
        ((gla_u32x4*)(base_ + 49152))[tid] = ra; \
        if (tid < 128) ((float*)(base_ + 57344))[tid] = rd; } while (0)
    f32x4 st[8];
#pragma unroll
    for (int dt = 0; dt < 8; ++dt) st[dt] = (f32x4){0.f, 0.f, 0.f, 0.f};
    __syncthreads();
    GLA_ISSUE(0); GLA_COMMIT(0);
    __syncthreads();
#pragma unroll 1
    for (int c = 0; c < nch; ++c) {
        const int buf = c & 1;
        if (c + 1 < nch) GLA_ISSUE(c + 1);
        const unsigned char* QDs = lds + buf * BUF; const unsigned char* KEs = QDs + 16384; const unsigned char* Vs = QDs + 32768;
        const unsigned char* ATs = QDs + 49152; const float* DECs = (const float*)(QDs + 57344);
        bf16x8 vf[2];
#pragma unroll
        for (int jp = 0; jp < 2; ++jp) {
            const int rowA = 32 * jp + 8 * fq + (li >> 2), rowB = rowA + 4;
            const int chunk = 2 * wave + ((li & 3) >> 1), sub = ((li & 3) & 1) * 8;
            const s16x4 va = __builtin_amdgcn_ds_read_tr16_b64_v4i16((LAS s16x4*)(Vs + rowA * 256 + ((chunk ^ (rowA & 15)) << 4) + sub));
            const s16x4 vb = __builtin_amdgcn_ds_read_tr16_b64_v4i16((LAS s16x4*)(Vs + rowB * 256 + ((chunk ^ (rowB & 15)) << 4) + sub));
            vf[jp] = __builtin_shufflevector(va, vb, 0, 1, 2, 3, 4, 5, 6, 7);
        }
        bf16x8 sf[4];
#pragma unroll
        for (int dp = 0; dp < 4; ++dp) {
            const gla_u32x4 t_ = {pack2(st[2 * dp][0], st[2 * dp][1]), pack2(st[2 * dp][2], st[2 * dp][3]), pack2(st[2 * dp + 1][0], st[2 * dp + 1][1]), pack2(st[2 * dp + 1][2], st[2 * dp + 1][3])};
            sf[dp] = __builtin_bit_cast(bf16x8, t_);
        }
        f32x4 ot[4];
#pragma unroll
        for (int it = 0; it < 4; ++it) {
            f32x4 acc = (f32x4){0.f, 0.f, 0.f, 0.f};
            const int ir = 16 * it + li;
#pragma unroll
            for (int dp = 0; dp < 4; ++dp) {
                const int c0 = 4 * dp + (fq >> 1), c1 = c0 + 2, sub = (fq & 1) * 8;
                const uint2 lo = *(const uint2*)(QDs + ir * 256 + ((c0 ^ (ir & 15)) << 4) + sub);
                const uint2 hi = *(const uint2*)(QDs + ir * 256 + ((c1 ^ (ir & 15)) << 4) + sub);
                const gla_u32x4 q_ = {lo.x, lo.y, hi.x, hi.y};
                const bf16x8 qf = __builtin_bit_cast(bf16x8, q_);
                acc = __builtin_amdgcn_mfma_f32_16x16x32_bf16(sf[dp], qf, acc, 0, 0, 0);
            }
#pragma unroll
            for (int jp = 0; jp < 2; ++jp) {
                if (32 * jp <= 16 * it + 15) {
                    const bf16x8 af = *(const bf16x8*)(ATs + ir * 128 + (((4 * jp + fq) ^ (ir & 7)) << 4));
                    acc = __builtin_amdgcn_mfma_f32_16x16x32_bf16(vf[jp], af, acc, 0, 0, 0);
                }
            }
            ot[it] = acc;
        }
#pragma unroll
        for (int dt = 0; dt < 8; ++dt) {
            const f32x4 dec = *(const f32x4*)(DECs + 16 * dt + 4 * fq);
            f32x4 acc = st[dt] * dec;
#pragma unroll
            for (int jp = 0; jp < 2; ++jp) {
                const int rowA = 32 * jp + 8 * fq + (li >> 2), rowB = rowA + 4;
                const int chunk = 2 * dt + ((li & 3) >> 1), sub = ((li & 3) & 1) * 8;
                const s16x4 ka = __builtin_amdgcn_ds_read_tr16_b64_v4i16((LAS s16x4*)(KEs + rowA * 256 + ((chunk ^ (rowA & 15)) << 4) + sub));
                const s16x4 kb = __builtin_amdgcn_ds_read_tr16_b64_v4i16((LAS s16x4*)(KEs + rowB * 256 + ((chunk ^ (rowB & 15)) << 4) + sub));
                const bf16x8 kf = __builtin_shufflevector(ka, kb, 0, 1, 2, 3, 4, 5, 6, 7);
                acc = __builtin_amdgcn_mfma_f32_16x16x32_bf16(kf, vf[jp], acc, 0, 0, 0);
            }
            st[dt] = acc;
        }
#pragma unroll
        for (int it = 0; it < 4; ++it) {
            const int i = 16 * it + li;
            const int s = dir ? (Sq - 1 - (64 * c + i)) : (64 * c + i);
            *(uint2*)(Oout + ((size_t)dir * Ttot + tok0 + s) * 1024 + hh * 256 + slice * 128 + 16 * wave + 4 * fq) =
                make_uint2(pack2(ot[it][0], ot[it][1]), pack2(ot[it][2], ot[it][3]));
        }
        if (c + 1 < nch) GLA_COMMIT(buf ^ 1);
        __syncthreads();
    }
}
__device__ __forceinline__ void phase_rope_prep(const Args& a, unsigned char* lds) {
    u16* P = (u16*)(a.ws + WS_P);
    const float2* cs = (const float2*)(a.ws + WS_CS);
    const int gt = blockIdx.x * NTHREADS + threadIdx.x, NT = gridDim.x * NTHREADS;
    for (int item = blockIdx.x; item < GLA_NPREP; item += gridDim.x)
        gla_prep_item(P, NP, C_GQ, C_GK, (const float*)(a.ws + WS_GZ), a.wgf, a.bgf, a.wgb, a.bgb, S,
                      a.ws + WS_QD, a.ws + WS_KE, a.ws + WS_AT, (float*)(a.ws + WS_DEC), lds, item);
}

#define ATTN_DECODE(item_) \
    const int nb_per = Sq / 128; \
    const int within = (item_) % nb_per, hh = ((item_) / nb_per) & 7, b = ((item_) / (nb_per * 8)) & 3, pat = (item_) / (nb_per * 32); \
    const int dil = pat == 0 ? 1 : (pat == 1 ? 4 : 16); \
    const int M = Sq / dil; \
    const int r = within % dil, blk = within / dil; \
    const int p0 = blk * 128, kbase = p0 - 64; \
    const size_t tok0 = (size_t)b * Sq;
typedef unsigned attn_u32x4 __attribute__((ext_vector_type(4)));
__device__ __forceinline__ void attn_phase(const u16* __restrict__ P, int ldp, int cq, int ck, int cv, int Sq,
                                           u16* __restrict__ part_o, float* __restrict__ part_lse, int Ttot,
                                           unsigned char* lds, int first, int stride, int nitems) {
    const int tid = TID, lane = tid & 63, wave = tid >> 6, li = lane & 15, fq = lane >> 4;
    unsigned char* Ks = lds;
    unsigned char* Vs = lds + 65536;
    attn_u32x4 kr0, kr1, kr2, kr3, kr4, kr5, kr6, kr7, vr0, vr1, vr2, vr3, vr4, vr5, vr6, vr7;
    bf16x8 qn0, qn1, qn2, qn3;
#define ATTN_LD1(i_, kreg_, vreg_) { const int id_ = tid + 512 * (i_), row_ = id_ >> 4, c_ = id_ & 15; \
        int kp_ = kbase + row_; kp_ = kp_ < 0 ? 0 : (kp_ > M - 1 ? M - 1 : kp_); \
        const size_t t_ = tok0 + r + (size_t)dil * kp_; \
        kreg_ = *(const attn_u32x4*)(P + t_ * ldp + ck + hh * 128 + c_ * 8); vreg_ = *(const attn_u32x4*)(P + t_ * ldp + cv + hh * 128 + c_ * 8); }
#define ATTN_LOAD(item_) do { ATTN_DECODE(item_) \
        { const size_t tq_ = tok0 + r + (size_t)dil * (p0 + 16 * wave + li); const u16* qp_ = P + tq_ * ldp + cq + hh * 128 + 8 * fq; \
          qn0 = *(const bf16x8*)(qp_); qn1 = *(const bf16x8*)(qp_ + 32); qn2 = *(const bf16x8*)(qp_ + 64); qn3 = *(const bf16x8*)(qp_ + 96); } \
        ATTN_LD1(0, kr0, vr0) ATTN_LD1(1, kr1, vr1) ATTN_LD1(2, kr2, vr2) ATTN_LD1(3, kr3, vr3) ATTN_LD1(4, kr4, vr4) ATTN_LD1(5, kr5, vr5) ATTN_LD1(6, kr6, vr6) ATTN_LD1(7, kr7, vr7) } while (0)
#define ATTN_ST1(i_, kreg_, vreg_) { const int id_ = tid + 512 * (i_), row_ = id_ >> 4, c_ = id_ & 15; const int off_ = row_ * 256 + ((c_ ^ (row_ & 15)) << 4); \
        *(attn_u32x4*)(Ks + off_) = kreg_; *(attn_u32x4*)(Vs + off_) = vreg_; }
#define ATTN_COMMIT() do { ATTN_ST1(0, kr0, vr0) ATTN_ST1(1, kr1, vr1) ATTN_ST1(2, kr2, vr2) ATTN_ST1(3, kr3, vr3) ATTN_ST1(4, kr4, vr4) ATTN_ST1(5, kr5, vr5) ATTN_ST1(6, kr6, vr6) ATTN_ST1(7, kr7, vr7) } while (0)
    int item = first;
    if (item < nitems) ATTN_LOAD(item);
    for (; item < nitems; item += stride) {
        ATTN_DECODE(item)
        __syncthreads();
        ATTN_COMMIT();
        const int qp = p0 + 16 * wave + li;
        const size_t tq = tok0 + r + (size_t)dil * qp;
        const bf16x8 qf[4] = {qn0, qn1, qn2, qn3};
        __syncthreads();
        if (item + stride < nitems) ATTN_LOAD(item + stride);
        const float scale = 0.08838834764831845f;
        float m = -1e30f, l = 0.f;
        f32x4 o[8];
#pragma unroll
        for (int dt = 0; dt < 8; ++dt) o[dt] = (f32x4){0.f, 0.f, 0.f, 0.f};
#pragma unroll 1
        for (int tp = 0; tp < 5; ++tp) {
            float s[8]; bool ok[8];
#pragma unroll
            for (int h2 = 0; h2 < 2; ++h2) {
                const int kk0 = 16 * wave + 16 * (2 * tp + h2);
                int krow = kk0 + li; krow = krow > 255 ? 255 : krow;
                f32x4 acc = (f32x4){0.f, 0.f, 0.f, 0.f};
#pragma unroll
                for (int ks = 0; ks < 4; ++ks) {
                    const bf16x8 kf = *(const bf16x8*)(Ks + krow * 256 + (((4 * ks + fq) ^ (krow & 15)) << 4));
                    acc = __builtin_amdgcn_mfma_f32_16x16x32_bf16(kf, qf[ks], acc, 0, 0, 0);
                }
#pragma unroll
                for (int j = 0; j < 4; ++j) {
                    const int kp = kbase + kk0 + 4 * fq + j;
                    const int rel = kp - qp;
                    ok[4 * h2 + j] = (kp >= 0) && (kp < M) && (rel <= 64) && (rel >= -64);
                    s[4 * h2 + j] = acc[j] * scale;
                }
            }
            float mx = -1e30f;
#pragma unroll
            for (int j = 0; j < 8; ++j) mx = ok[j] ? fmaxf(mx, s[j]) : mx;
            mx = fmaxf(mx, __shfl_xor(mx, 16));
            mx = fmaxf(mx, __shfl_xor(mx, 32));
            const float mn = fmaxf(m, mx);
            const float al = __expf(m - mn);
            float ps = 0.f; float p[8];
#pragma unroll
            for (int j = 0; j < 8; ++j) { p[j] = ok[j] ? __expf(s[j] - mn) : 0.f; ps += p[j]; }
            l = l * al + ps; m = mn;
            const attn_u32x4 p_ = {pack2(p[0], p[1]), pack2(p[2], p[3]), pack2(p[4], p[5]), pack2(p[6], p[7])};
            const bf16x8 pf = __builtin_bit_cast(bf16x8, p_);
#pragma unroll
            for (int dt = 0; dt < 8; ++dt) o[dt] *= al;
            int rowA = 16 * wave + 32 * tp + 4 * fq + (li >> 2); rowA = rowA > 255 ? 255 : rowA;
            int rowB = 16 * wave + 32 * tp + 16 + 4 * fq + (li >> 2); rowB = rowB > 255 ? 255 : rowB;
#pragma unroll
            for (int dt = 0; dt < 8; ++dt) {
                const int chunk = 2 * dt + ((li & 3) >> 1), sub = ((li & 3) & 1) * 8;
                const s16x4 va = __builtin_amdgcn_ds_read_tr16_b64_v4i16((LAS s16x4*)(Vs + rowA * 256 + ((chunk ^ (rowA & 15)) << 4) + sub));
                const s16x4 vb = __builtin_amdgcn_ds_read_tr16_b64_v4i16((LAS s16x4*)(Vs + rowB * 256 + ((chunk ^ (rowB & 15)) << 4) + sub));
                const bf16x8 vf = __builtin_shufflevector(va, vb, 0, 1, 2, 3, 4, 5, 6, 7);
                o[dt] = __builtin_amdgcn_mfma_f32_16x16x32_bf16(vf, pf, o[dt], 0, 0, 0);
            }
        }
        l += __shfl_xor(l, 16);
        l += __shfl_xor(l, 32);
        const float inv = 1.f / l;
        u16* orow = part_o + ((size_t)pat * Ttot + tq) * 1024 + hh * 128 + 4 * fq;
#pragma unroll
        for (int dt = 0; dt < 8; ++dt)
            *(uint2*)(orow + 16 * dt) = make_uint2(pack2(o[dt][0] * inv, o[dt][1] * inv), pack2(o[dt][2] * inv, o[dt][3] * inv));
        if (fq == 0) part_lse[((size_t)pat * Ttot + tq) * 8 + hh] = m + logf(l);
    }
#undef ATTN_LD1
#undef ATTN_LOAD
#undef ATTN_ST1
#undef ATTN_COMMIT
}

__device__ __forceinline__ void attn_merge_token(const u16* __restrict__ part_o, const float* __restrict__ part_lse, int Ttot, size_t t,
                                                 u16* __restrict__ dst  , int lane) {
    const int hh = lane >> 3;
    const float l0 = part_lse[((size_t)0 * Ttot + t) * 8 + hh], l1 = part_lse[((size_t)1 * Ttot + t) * 8 + hh], l2 = part_lse[((size_t)2 * Ttot + t) * 8 + hh];
    const float mx = fmaxf(l0, fmaxf(l1, l2));
    const float e0 = __expf(l0 - mx), e1 = __expf(l1 - mx), e2 = __expf(l2 - mx);
    const float inv = 1.f / (e0 + e1 + e2);
    const float w[3] = {e0 * inv, e1 * inv, e2 * inv};
    float acc[16];
#pragma unroll
    for (int i = 0; i < 16; ++i) acc[i] = 0.f;
#pragma unroll
    for (int p = 0; p < 3; ++p) {
        const uint4* src = (const uint4*)(part_o + ((size_t)p * Ttot + t) * 1024 + lane * 16);
        const uint4 a = src[0], bb = src[1];
        acc[0] += w[p] * lo2f(a.x); acc[1] += w[p] * hi2f(a.x); acc[2] += w[p] * lo2f(a.y); acc[3] += w[p] * hi2f(a.y);
        acc[4] += w[p] * lo2f(a.z); acc[5] += w[p] * hi2f(a.z); acc[6] += w[p] * lo2f(a.w); acc[7] += w[p] * hi2f(a.w);
        acc[8] += w[p] * lo2f(bb.x); acc[9] += w[p] * hi2f(bb.x); acc[10] += w[p] * lo2f(bb.y); acc[11] += w[p] * hi2f(bb.y);
        acc[12] += w[p] * lo2f(bb.z); acc[13] += w[p] * hi2f(bb.z); acc[14] += w[p] * lo2f(bb.w); acc[15] += w[p] * hi2f(bb.w);
    }
    uint4* d = (uint4*)(dst + lane * 16);
    d[0] = make_uint4(pack2(acc[0], acc[1]), pack2(acc[2], acc[3]), pack2(acc[4], acc[5]), pack2(acc[6], acc[7]));
    d[1] = make_uint4(pack2(acc[8], acc[9]), pack2(acc[10], acc[11]), pack2(acc[12], acc[13]), pack2(acc[14], acc[15]));
}

__device__ __forceinline__ void phase_mixers(const Args& a, unsigned char* lds) {
    const int bi = blockIdx.x, G = gridDim.x;
    if (bi < 64) {
        gla_seq_item((const u16*)(a.ws + WS_P), NP, C_GV, S, a.ws + WS_QD, a.ws + WS_KE, a.ws + WS_AT, (const float*)(a.ws + WS_DEC),
                     (u16*)(a.ws + WS_OFB), T, lds, bi);
    } else {
        u16* part_o = (u16*)a.out; float* part_lse = (float*)((unsigned char*)a.out + (size_t)3 * T * 1024 * 2);
        attn_phase((const u16*)(a.ws + WS_P), NP, C_DQ, C_DK, C_DV, S, part_o, part_lse, T, lds, bi - 64, G - 64, 3 * 4 * 8 * (S / 128));
    }
}

__device__ __forceinline__ void phase_gla_fin(const Args& a) {
    const u16* Of = (const u16*)(a.ws + WS_OFB);
    const u16* Ob = Of + (size_t)T * 1024;
    const u16* P = (const u16*)(a.ws + WS_P);
    u16* A2 = (u16*)(a.ws + WS_ACT);
    const u16* part_o = (const u16*)a.out; const float* part_lse = (const float*)((const unsigned char*)a.out + (size_t)3 * T * 1024 * 2);
    const int lane = threadIdx.x & 63, wave = threadIdx.x >> 6;
    const int gw = blockIdx.x * NWAVES + wave, NGW = gridDim.x * NWAVES;
    const int hh = lane >> 4;
    float gg[16];
#pragma unroll
    for (int k = 0; k < 4; ++k) { const float4 g4 = *(const float4*)(a.g_gla + lane * 16 + 4 * k); gg[4 * k] = g4.x; gg[4 * k + 1] = g4.y; gg[4 * k + 2] = g4.z; gg[4 * k + 3] = g4.w; }
    for (int t = gw; t < T; t += NGW) {
        const uint4* fp = (const uint4*)(Of + (size_t)t * 1024 + lane * 16); const uint4* bp = (const uint4*)(Ob + (size_t)t * 1024 + lane * 16);
        const uint4* rp = (const uint4*)(P + (size_t)t * NP + C_GR + lane * 16);
#define NT16(p_) ({ const f32x4 q_ = __builtin_nontemporal_load((const f32x4*)(p_)); make_uint4(__float_as_uint(q_[0]), __float_as_uint(q_[1]), __float_as_uint(q_[2]), __float_as_uint(q_[3])); })
        const uint4 f0 = NT16(fp), f1 = NT16(fp + 1), b0 = NT16(bp), b1 = NT16(bp + 1), r0 = NT16(rp), r1 = NT16(rp + 1);
#undef NT16
        attn_merge_token(part_o, part_lse, T, (size_t)t, A2 + (size_t)t * D + 1024, lane);
        const unsigned fw[8] = {f0.x, f0.y, f0.z, f0.w, f1.x, f1.y, f1.z, f1.w}, bw[8] = {b0.x, b0.y, b0.z, b0.w, b1.x, b1.y, b1.z, b1.w};
        const unsigned rw[8] = {r0.x, r0.y, r0.z, r0.w, r1.x, r1.y, r1.z, r1.w};
        float o[16]; float ss = 0.f;
#pragma unroll
        for (int k = 0; k < 8; ++k) { o[2 * k] = lo2f(fw[k]) + lo2f(bw[k]); o[2 * k + 1] = hi2f(fw[k]) + hi2f(bw[k]); ss += o[2 * k] * o[2 * k] + o[2 * k + 1] * o[2 * k + 1]; }
        ss += __shfl_xor(ss, 1); ss += __shfl_xor(ss, 2); ss += __shfl_xor(ss, 4); ss += __shfl_xor(ss, 8);
        const float rstd = rsqrtf(ss * (1.f / 256.f) + NORM_EPS);
        unsigned y[8];
#pragma unroll
        for (int k = 0; k < 8; ++k) y[k] = pack2(o[2 * k] * rstd * gg[2 * k] * silu_f(lo2f(rw[k])), o[2 * k + 1] * rstd * gg[2 * k + 1] * silu_f(hi2f(rw[k])));
        uint4* dp = (uint4*)(A2 + (size_t)t * D + lane * 16);
        dp[0] = make_uint4(y[0], y[1], y[2], y[3]); dp[1] = make_uint4(y[4], y[5], y[6], y[7]);
    }
    (void)hh;
}

typedef float f32x16 __attribute__((ext_vector_type(16)));
#define RT_CE(a_, b_) do { const float hi_ = fmaxf(a_, b_), lo_ = fminf(a_, b_); a_ = hi_; b_ = lo_; } while (0)
template <int N> __device__ __forceinline__ void rt_sort_desc(float (&v)[N], int base) {
#pragma unroll
    for (int k = 2; k <= 16; k <<= 1)
#pragma unroll
        for (int j = k >> 1; j > 0; j >>= 1)
#pragma unroll
            for (int i = 0; i < 16; ++i) {
                const int l = i ^ j;
                if (l > i) { if ((i & k) == 0) RT_CE(v[base + i], v[base + l]); else RT_CE(v[base + l], v[base + i]); }
            }
}
template <int N> __device__ __forceinline__ void rt_merge_desc(float (&v)[N], int a, int b) {
#pragma unroll
    for (int i = 0; i < 16; ++i) v[a + i] = fmaxf(v[a + i], v[b + 15 - i]);
#pragma unroll
    for (int j = 8; j > 0; j >>= 1)
#pragma unroll
        for (int i = 0; i < 16; ++i) { const int l = i ^ j; if (l > i) RT_CE(v[a + i], v[a + l]); }
}

__device__ __forceinline__ void route_stage_keys(const float* __restrict__ subk, int hh, unsigned char* lds) {
    const int tid = TID;
    __syncthreads();
    for (int e = tid; e < 2 * 128 * 16; e += 512) {
        const int c = e & 15, row = e >> 4;
        const float* src = subk + ((size_t)(hh * 2) * 128 + row) * 128 + c * 8;
        const float4 v0 = *(const float4*)src, v1 = *(const float4*)(src + 4);
        *(uint4*)(lds + row * 256 + ((c ^ (row & 15)) << 4)) = make_uint4(pack2(v0.x, v0.y), pack2(v0.z, v0.w), pack2(v1.x, v1.y), pack2(v1.z, v1.w));
    }
    __syncthreads();
}

__device__ __forceinline__ void route_tile(const u16* __restrict__ Q, int ldq, int hh, int tok_base, const unsigned char* lds,
                                           int* __restrict__ IDX, float* __restrict__ GATE) {
    const int lane = TID & 63, r = lane & 31, h = lane >> 5;
    float sc[128];
    {
        f32x16 X[4], Y[4];
#pragma unroll
        for (int kt = 0; kt < 4; ++kt) {
#pragma unroll
            for (int i = 0; i < 16; ++i) { X[kt][i] = 0.f; Y[kt][i] = 0.f; }
        }
        const u16* qrow = Q + (size_t)(tok_base + r) * ldq + hh * 256;
#pragma unroll
        for (int half = 0; half < 2; ++half) {
            bf16x8 qf[8];
#pragma unroll
            for (int ks = 0; ks < 8; ++ks) qf[ks] = *(const bf16x8*)(qrow + half * 128 + 16 * ks + 8 * h);
#pragma unroll
            for (int kt = 0; kt < 4; ++kt) {
                const int krow = half * 128 + 32 * kt + r;
#pragma unroll
                for (int ks = 0; ks < 8; ++ks) {
                    const bf16x8 kf = *(const bf16x8*)(lds + krow * 256 + (((2 * ks + h) ^ (krow & 15)) << 4));
                    if (half == 0) X[kt] = __builtin_amdgcn_mfma_f32_32x32x16_bf16(kf, qf[ks], X[kt], 0, 0, 0);
                    else Y[kt] = __builtin_amdgcn_mfma_f32_32x32x16_bf16(kf, qf[ks], Y[kt], 0, 0, 0);
                }
            }
        }
#pragma unroll
        for (int kt = 0; kt < 4; ++kt)
#pragma unroll
            for (int i = 0; i < 16; ++i) {
                const auto sw = __builtin_amdgcn_permlane32_swap(__float_as_uint(X[kt][i]), __float_as_uint(Y[kt][i]), false, false);
                const int key0 = 32 * kt + (i & 3) + 8 * (i >> 2);
                sc[kt * 32 + i] = __uint_as_float((sw[0] & 0xffffff80u) | (unsigned)key0);
                sc[kt * 32 + 16 + i] = __uint_as_float((sw[1] & 0xffffff80u) | (unsigned)(key0 + 4));
            }
    }
#pragma unroll
    for (int g = 0; g < 8; ++g) rt_sort_desc(sc, 16 * g);
    rt_merge_desc(sc, 0, 16); rt_merge_desc(sc, 32, 48); rt_merge_desc(sc, 64, 80); rt_merge_desc(sc, 96, 112);
    rt_merge_desc(sc, 0, 32); rt_merge_desc(sc, 64, 96);
    rt_merge_desc(sc, 0, 64);
    float l0[16], l1[16];
#pragma unroll
    for (int i = 0; i < 16; ++i) {
        const auto sw = __builtin_amdgcn_permlane32_swap(__float_as_uint(sc[i]), __float_as_uint(sc[i]), false, false);
        l0[i] = __uint_as_float(sw[0]); l1[i] = __uint_as_float(sw[1]);
    }
    float s0[16], s1[16]; int k0[16], k1[16];
#pragma unroll
    for (int i = 0; i < 16; ++i) {
        const unsigned a = __float_as_uint(l0[i]), b = __float_as_uint(l1[i]);
        s0[i] = __uint_as_float(a & 0xffffff80u); k0[i] = (int)(a & 0x7fu);
        s1[i] = __uint_as_float(b & 0xffffff80u); k1[i] = (int)(b & 0x7fu);
    }
    float cs[64];
    {
        int n = 0;
#pragma unroll
        for (int i = 0; i < 16; ++i)
#pragma unroll
            for (int j = 0; j < 16; ++j)
                if ((i + 1) * (j + 1) <= 16) { cs[n] = s0[i] + s1[j]; ++n; }
#pragma unroll
        for (int q = 50; q < 64; ++q) cs[q] = -3.0e38f;
    }
    float ct[64];
#pragma unroll
    for (int q = 0; q < 64; ++q) ct[q] = cs[q];
#pragma unroll
    for (int g = 0; g < 4; ++g) rt_sort_desc(ct, 16 * g);
    rt_merge_desc(ct, 0, 16); rt_merge_desc(ct, 32, 48); rt_merge_desc(ct, 0, 32);
    const float theta = ct[15], smax = ct[0];
    float den = 0.f;
    {
        int cnt = 0;
#pragma unroll
        for (int q = 0; q < 50; ++q) { const bool sel = (cs[q] >= theta) && (cnt < 16); den += sel ? __expf(cs[q] - smax) : 0.f; cnt += sel ? 1 : 0; }
    }
    const float inv = 1.f / den;
    const size_t obase = (size_t)(tok_base + r) * 128 + hh * 16;
    int pos = 0;
    {
        int n = 0;
#pragma unroll
        for (int i = 0; i < 16; ++i)
#pragma unroll
            for (int j = 0; j < 16; ++j)
                if ((i + 1) * (j + 1) <= 16) {
                    const bool sel = (cs[n] >= theta) && (pos < 16);
                    if (sel) {
                        if (h == 0) IDX[obase + pos] = k0[i] * 128 + k1[j];
                        else GATE[obase + pos] = __expf(cs[n] - smax) * inv;
                        ++pos;
                    }
                    ++n;
                }
    }
}
__device__ __forceinline__ void phase_route(const Args& a, unsigned char* lds) {
    const int hh = BID & 7, grp = BID >> 3, ngrp = GDIM >> 3, wave = TID >> 6;
    route_stage_keys(a.subk, hh, lds);
    int j = 0;
    for (int tile = grp; tile < T / 32; tile += ngrp, ++j)
        if ((j & 7) == wave) route_tile((const u16*)(a.ws + WS_Q), D, hh, tile * 32, lds, (int*)(a.ws + WS_IDX), (float*)(a.ws + WS_GATE));
    __syncthreads();
}

typedef __bf16 bf16x2_t __attribute__((ext_vector_type(2)));
__device__ __forceinline__ float dot2bf(unsigned w, unsigned x, float acc) {
    return __builtin_amdgcn_fdot2_f32_bf16(__builtin_bit_cast(bf16x2_t, w), __builtin_bit_cast(bf16x2_t, x), acc, false);
}
constexpr int TROW = 1024;
typedef float f32x2_t __attribute__((ext_vector_type(2)));
typedef int i32x8 __attribute__((ext_vector_type(8)));
__device__ __forceinline__ void convert_tables(const Args& a) {
    const int lane = threadIdx.x & 63, wave = threadIdx.x >> 6;
    const int gw = blockIdx.x * NWAVES + wave, NGW = gridDim.x * NWAVES;
    for (int row = gw; row < 2 * 16384; row += NGW) {
        const bool isv = row >= 16384; const int e = isv ? row - 16384 : row;
        const f32x4* sp = (const f32x4*)((isv ? a.pv : a.pu) + (size_t)e * D);
        unsigned char* dst = a.ws + (isv ? WS_TV + (size_t)e * 1024 : WS_TU + (size_t)e * 128);
        unsigned char* sdst = a.ws + (isv ? WS_SV + (size_t)e * 64 : WS_SU + (size_t)e * 8);
        f32x4 v[8];
#pragma unroll
        for (int k = 0; k < 8; ++k) v[k] = __builtin_nontemporal_load(sp + lane + 64 * k);
#pragma unroll
        for (int k = 0; k < 8; ++k) {
            float mx = fmaxf(fmaxf(fabsf(v[k][0]), fabsf(v[k][1])), fmaxf(fabsf(v[k][2]), fabsf(v[k][3])));
            mx = fmaxf(mx, __shfl_xor(mx, 1)); mx = fmaxf(mx, __shfl_xor(mx, 2)); mx = fmaxf(mx, __shfl_xor(mx, 4));
            const unsigned bits = __float_as_uint(mx);
            int kx = (int)(bits >> 23) - 127 - 2 + (((bits & 0x7fffffu) > 0x400000u) ? 1 : 0);
            kx = kx < -126 ? -126 : kx;
            const float inv = __uint_as_float((unsigned)(127 - kx) << 23);
            unsigned p = 0u;
            p = __builtin_amdgcn_cvt_scalef32_pk_fp4_f32(p, v[k][0] * inv, v[k][1] * inv, 1.0f, 0);
            p = __builtin_amdgcn_cvt_scalef32_pk_fp4_f32(p, v[k][2] * inv, v[k][3] * inv, 1.0f, 1);
            *(u16*)(dst + (isv ? (size_t)k * 128 : (size_t)k * SLICE_T) + 2 * lane) = (u16)p;
            if ((lane & 7) == 0) {
                const int c = lane >> 3;
                if (isv) sdst[8 * k + c] = (unsigned char)(kx + 127); else sdst[(size_t)k * SLICE_S + 2 * (c & 3) + (c >> 2)] = (unsigned char)(kx + 127);
            }
        }
    }
}

__device__ __forceinline__ void axpy32_fp4(const uint4 w, const float s, float (&acc)[32]) {
    const unsigned ww[4] = {w.x, w.y, w.z, w.w};
#pragma unroll
    for (int k = 0; k < 4; ++k) {
        const f32x2_t a0 = __builtin_amdgcn_cvt_scalef32_pk_f32_fp4(ww[k], 1.0f, 0), a1 = __builtin_amdgcn_cvt_scalef32_pk_f32_fp4(ww[k], 1.0f, 1);
        const f32x2_t a2 = __builtin_amdgcn_cvt_scalef32_pk_f32_fp4(ww[k], 1.0f, 2), a3 = __builtin_amdgcn_cvt_scalef32_pk_f32_fp4(ww[k], 1.0f, 3);
        acc[8 * k + 0] += s * a0.x; acc[8 * k + 1] += s * a0.y; acc[8 * k + 2] += s * a1.x; acc[8 * k + 3] += s * a1.y;
        acc[8 * k + 4] += s * a2.x; acc[8 * k + 5] += s * a2.y; acc[8 * k + 6] += s * a3.x; acc[8 * k + 7] += s * a3.y;
    }
}
#define DPP_F(v_, ctrl_) __builtin_bit_cast(float, __builtin_amdgcn_update_dpp(0, __builtin_bit_cast(int, v_), ctrl_, 0xf, 0xf, true))
__device__ __forceinline__ void phase_eu(const Args& a, unsigned char* lds) {
    const int* IDX = (const int*)(a.ws + WS_IDX);
    float* AP = (float*)(a.ws + WS_AP);
    const int lane = threadIdx.x & 63, wave = threadIdx.x >> 6;
    const int x = blockIdx.x & 7, gw = (blockIdx.x >> 3) * NWAVES + wave, NGW = (((int)gridDim.x - x + 7) >> 3) * NWAVES;
    const unsigned char* TUx = a.ws + WS_TU + (size_t)x * SLICE_T;
    const int m = lane & 15, g = lane >> 4;
    typedef unsigned eu_u32x4 __attribute__((ext_vector_type(4)));
    eu_u32x4 rA[8], rB[8]; u16 sA[4], sB[4];
    { const uint4* ssrc = (const uint4*)(a.ws + WS_SU + (size_t)x * SLICE_S);
      for (int i = threadIdx.x; i < (int)(SLICE_S / 16); i += NTHREADS) ((uint4*)lds)[i] = ssrc[i];
      __syncthreads(); }
    i32x8 hB0, hB1, nB0, nB1; int sbt = 127, nkx = 0, ckx = 0;
    int iv0 = 0, iv1 = 0, niv0 = 0, niv1 = 0;
    const int j8 = lane >> 3, c8 = lane & 7;
    LAS unsigned char* ldsl = (LAS unsigned char*)lds;
    LAS unsigned char* stg = ldsl + LDS_MAIN + 16 + wave * 2048;
#define EU_LOAD(r_, s_, ivh_) do { _Pragma("unroll") for (int q = 0; q < 8; ++q) { \
            const int e_ = __shfl(ivh_, 8 * q + j8); \
            r_[q] = *(const eu_u32x4*)(TUx + ((unsigned)e_ * 128u + 16u * (unsigned)(c8 ^ j8))); } \
        _Pragma("unroll") for (int q = 0; q < 4; ++q) { const int e_ = __shfl(ivh_, 16 * q + m); s_[q] = *(const LAS u16*)(ldsl + e_ * 8 + 2 * g); } } while (0)
    const unsigned char* IMG = a.ws + WS_IMG; const int* KXS = (const int*)(a.ws + WS_KXS);
#define EU_BLOAD(t_, B0_, B1_, kx_) do { const eu_u32x4* ip_ = (const eu_u32x4*)(IMG + (((size_t)(t_) * 8 + x) * 8 + 2 * g + (lane & 1)) * 64); \
            const eu_u32x4 q0_ = ip_[0], q1_ = ip_[1], q2_ = ip_[2], q3_ = ip_[3]; \
            B0_ = (i32x8){(int)q0_[0], (int)q0_[1], (int)q0_[2], (int)q0_[3], (int)q1_[0], (int)q1_[1], (int)q1_[2], (int)q1_[3]}; \
            B1_ = (i32x8){(int)q2_[0], (int)q2_[1], (int)q2_[2], (int)q2_[3], (int)q3_[0], (int)q3_[1], (int)q3_[2], (int)q3_[3]}; \
            kx_ = KXS[(size_t)(t_) * 8 + x]; } while (0)
#define EU_COMPUTE(r_, s_, kb_, t_) do { _Pragma("unroll") for (int q = 0; q < 4; ++q) { \
            *(LAS eu_u32x4*)(stg + lane * 16) = r_[2 * q]; *(LAS eu_u32x4*)(stg + 1024 + lane * 16) = r_[2 * q + 1]; \
            const eu_u32x4 f0_ = *(const LAS eu_u32x4*)(stg + m * 128 + 16 * (g ^ (m & 7))), f1_ = *(const LAS eu_u32x4*)(stg + m * 128 + 16 * ((4 + g) ^ (m & 7))); \
            const i32x8 A0_ = {(int)f0_[0], (int)f0_[1], (int)f0_[2], (int)f0_[3], 0, 0, 0, 0}; \
            const i32x8 A1_ = {(int)f1_[0], (int)f1_[1], (int)f1_[2], (int)f1_[3], 0, 0, 0, 0}; \
            f32x4 c_ = {0.f, 0.f, 0.f, 0.f}; \
            c_ = __builtin_amdgcn_mfma_scale_f32_16x16x128_f8f6f4(A0_, hB0, c_, 4, 0, 0, (int)s_[q], 0, sbt); \
            c_ = __builtin_amdgcn_mfma_scale_f32_16x16x128_f8f6f4(A1_, hB1, c_, 4, 0, 1, (int)s_[q], 0, sbt); \
            f32x4 o_; _Pragma("unroll") for (int j = 0; j < 4; ++j) o_[j] = c_[j] + DPP_F(c_[j], 0xB1); \
            if (m == 0) *(f32x4*)(AP + ((size_t)(t_) * 8 + x) * 128 + (kb_) + 16 * q + 4 * g) = o_; } } while (0)
#define EU_IDX(t_, i0_, i1_) do { i0_ = IDX[(size_t)(t_) * 128 + lane]; i1_ = IDX[(size_t)(t_) * 128 + 64 + lane]; } while (0)
    if (gw < T) { EU_IDX(gw, iv0, iv1); EU_BLOAD(gw, hB0, hB1, ckx); const int t1 = (gw + NGW < T) ? gw + NGW : gw; EU_IDX(t1, niv0, niv1); EU_LOAD(rA, sA, iv0); sbt = 127 + ckx - ((lane & 1) ? 4 : 0); }
    for (int t = gw; t < T; t += NGW) {
        const int tn = (t + NGW < T) ? t + NGW : t, tnn = (t + 2 * NGW < T) ? t + 2 * NGW : t;
        EU_LOAD(rB, sB, iv1);
        EU_BLOAD(tn, nB0, nB1, nkx);
        int nn0, nn1; EU_IDX(tnn, nn0, nn1);
        EU_COMPUTE(rA, sA, 0, t);
        EU_LOAD(rA, sA, niv0);
        EU_COMPUTE(rB, sB, 64, t);
        hB0 = nB0; hB1 = nB1; sbt = 127 + nkx - ((lane & 1) ? 4 : 0);
        iv0 = niv0; iv1 = niv1; niv0 = nn0; niv1 = nn1;
    }
#undef EU_LOAD
#undef EU_BLOAD
#undef EU_COMPUTE
#undef EU_IDX
}

__device__ __forceinline__ void phase_ev(const Args& a) {
    const u16* X1 = (const u16*)(a.ws + WS_X1);
    const int* IDX = (const int*)(a.ws + WS_IDX);
    const float* GATE = (const float*)(a.ws + WS_GATE);
    const float* AP = (const float*)(a.ws + WS_AP);
    const float* mod = (const float*)(a.ws + WS_MOD);
    const unsigned char* V = a.ws + WS_TV;
    const int lane = threadIdx.x & 63, wave = threadIdx.x >> 6;
    const int gw = blockIdx.x * NWAVES + wave, NGW = gridDim.x * NWAVES;
    int iv0 = 0, iv1 = 0; float gv0 = 0.f, gv1 = 0.f;
    int niv0 = 0, niv1 = 0; float ngv0 = 0.f, ngv1 = 0.f;
    uint4 rA[4], rB[4]; u16 sA[4], sB[4];
#define ROW_LOAD(TB_, r_, s_, r0_) do { _Pragma("unroll") for (int q = 0; q < 4; ++q) { \
            const int rr_ = (r0_) + q; const int e_ = __builtin_amdgcn_readlane(rr_ < 64 ? iv0 : iv1, rr_ & 63); \
            const unsigned char* rp_ = TB_ + (size_t)e_ * TROW; \
            const unsigned char* sp_ = a.ws + WS_SV + (size_t)e_ * 64; \
            r_[q] = *(const uint4*)(rp_ + lane * 16); s_[q] = (u16)*(sp_ + lane); } } while (0)
#define TOK_FETCH(t_, i0_, i1_, g0_, g1_, ap_) do { \
            i0_ = IDX[(size_t)(t_) * 128 + lane]; i1_ = IDX[(size_t)(t_) * 128 + 64 + lane]; \
            g0_ = GATE[(size_t)(t_) * 128 + lane]; g1_ = GATE[(size_t)(t_) * 128 + 64 + lane]; \
            _Pragma("unroll") for (int xx = 0; xx < 8; ++xx) { ap_[xx] = AP[((size_t)(t_) * 8 + xx) * 128 + lane]; ap_[8 + xx] = AP[((size_t)(t_) * 8 + xx) * 128 + 64 + lane]; } } while (0)
    float ap[16], nap[16];
    if (gw < T) { TOK_FETCH(gw, iv0, iv1, gv0, gv1, ap); ROW_LOAD(V, rA, sA, 0); }
    for (int t = gw; t < T; t += NGW) {
        const int b = t / S;
        const bool has_next = (t + NGW) < T;
        float a0 = 0.f, a1 = 0.f;
#pragma unroll
        for (int xx = 0; xx < 8; ++xx) { a0 += ap[xx]; a1 += ap[8 + xx]; }
        const float w0 = gv0 * gelu_f(a0), w1 = gv1 * gelu_f(a1);
        float acc[32];
#pragma unroll
        for (int i = 0; i < 32; ++i) acc[i] = 0.f;
#define V_COMPUTE(r_, s_, r0_) do { _Pragma("unroll") for (int q = 0; q < 4; ++q) { const int rr_ = (r0_) + q; \
                const float g_ = __builtin_bit_cast(float, __builtin_amdgcn_readlane(__builtin_bit_cast(int, rr_ < 64 ? w0 : w1), rr_ & 63)); \
                axpy32_fp4(r_[q], g_ * __uint_as_float((unsigned)s_[q] << 23), acc); } } while (0)
        { const int tn = has_next ? t + NGW : t; TOK_FETCH(tn, niv0, niv1, ngv0, ngv1, nap); }
#pragma unroll 1
        for (int r0 = 0; r0 < 128; r0 += 8) {
            ROW_LOAD(V, rB, sB, r0 + 4);
            V_COMPUTE(rA, sA, r0);
            if (r0 + 8 < 128) ROW_LOAD(V, rA, sA, r0 + 8);
            else { iv0 = niv0; iv1 = niv1; gv0 = ngv0; gv1 = ngv1;
                _Pragma("unroll") for (int i = 0; i < 16; ++i) ap[i] = nap[i];
                if (has_next) ROW_LOAD(V, rA, sA, 0); }
            V_COMPUTE(rB, sB, r0 + 4);
        }
#undef V_COMPUTE
        float ss = 0.f;
#pragma unroll
        for (int k = 0; k < 8; ++k) {
            const int c0 = lane * 32 + 4 * k;
            const hw_f32x2 xn = __builtin_nontemporal_load((const hw_f32x2*)(X1 + (size_t)t * D + c0));
            const uint2 xp = make_uint2(__float_as_uint(xn[0]), __float_as_uint(xn[1]));
            const float4 xa = make_float4(lo2f(xp.x), hi2f(xp.x), lo2f(xp.y), hi2f(xp.y));
            const float4 ga = *(const float4*)(mod + b * 12288 + 5 * 2048 + c0);
            acc[4 * k + 0] = xa.x + ga.x * acc[4 * k + 0]; acc[4 * k + 1] = xa.y + ga.y * acc[4 * k + 1];
            acc[4 * k + 2] = xa.z + ga.z * acc[4 * k + 2]; acc[4 * k + 3] = xa.w + ga.w * acc[4 * k + 3];
#pragma unroll
            for (int i = 0; i < 4; ++i) ss += acc[4 * k + i] * acc[4 * k + i];
        }
        ss = wave_sum(ss);
        const float rstd = rsqrtf(ss * (1.f / D) + NORM_EPS);
#pragma unroll
        for (int k = 0; k < 8; ++k) {
            const int c0 = lane * 32 + 4 * k;
            const float4 gf = *(const float4*)(a.g_fin + c0);
            *(float4*)(a.out + (size_t)t * D + c0) = make_float4(acc[4 * k + 0] * rstd * gf.x, acc[4 * k + 1] * rstd * gf.y, acc[4 * k + 2] * rstd * gf.z, acc[4 * k + 3] * rstd * gf.w);
        }
    }
#undef ROW_LOAD
#undef TOK_FETCH
}

#undef DPP_F

#define XB_TMO      128
#define XB_XCNT(j)  (256  + 64 * (j))
#define XB_XSUB(j)  (1280 + 64 * (j))
#define XB_XGEN(j)  (2304 + 64 * (j))
#define XB_TOP      3328
#define XB_TOPGEN   3392
#define XCD_BAR_WORDS 3456
#define XB_SPIN_CAP (1u << 18)

__device__ __forceinline__ unsigned xb_ld(unsigned* p)              { return __hip_atomic_load(p, __ATOMIC_RELAXED, __HIP_MEMORY_SCOPE_AGENT); }
__device__ __forceinline__ unsigned xb_add(unsigned* p, unsigned v) { return __hip_atomic_fetch_add(p, v, __ATOMIC_RELAXED, __HIP_MEMORY_SCOPE_AGENT); }
__device__ __forceinline__ unsigned xb_xcc_id() { return (unsigned)__builtin_amdgcn_s_getreg((3 << 11) | 20) & 0xFu; }
#define XB_SPIN(cond, bar) do { unsigned _sp = 0; while (cond) { __builtin_amdgcn_s_sleep(1); \
    if ((++_sp & 255u) == 0u) { if (xb_ld(&(bar)[XB_TMO])) break; if (_sp > XB_SPIN_CAP) { atomicAdd(&(bar)[XB_TMO], 1u); break; } } } } while (0)

struct XcdBarrier {
    unsigned* bar; unsigned x;
    volatile LAS unsigned* st;
};

__device__ __forceinline__ XcdBarrier xcd_barrier_post(unsigned* bar, volatile LAS unsigned* st) {
    XcdBarrier b; b.bar = bar; b.x = xb_xcc_id(); b.st = st;
    if (threadIdx.x == 0) (void)xb_add(&bar[XB_XCNT(b.x)], 1u);
    return b;
}
__device__ __forceinline__ void xcd_barrier_complete(unsigned* bar, unsigned x, unsigned& nloc, unsigned& nx) {
    const unsigned G = gridDim.x * gridDim.y * gridDim.z;
    unsigned sum, cnt, mine, sp = 0u;
    for (;;) {
        sum = 0u; cnt = 0u; mine = 0u;
#pragma unroll
        for (unsigned j = 0; j < 16; ++j) { const unsigned c = xb_ld(&bar[XB_XCNT(j)]); sum += c; cnt += (c > 0u) ? 1u : 0u; mine = (j == x) ? c : mine; }
        if (sum == G) break;
        __builtin_amdgcn_s_sleep(1);
        if ((++sp & 255u) == 0u) { if (xb_ld(&bar[XB_TMO])) break; if (sp > XB_SPIN_CAP) { atomicAdd(&bar[XB_TMO], 1u); break; } }
    }
    nloc = mine > 0u ? mine : 1u; nx = cnt > 0u ? cnt : 1u;
}

__device__ __forceinline__ void xcd_barrier(const XcdBarrier& b) {
    asm volatile("s_waitcnt vmcnt(0)" ::: "memory");
    __syncthreads();
    if (threadIdx.x == 0) {
        unsigned* bar = b.bar;
        __builtin_amdgcn_s_waitcnt(0);
        unsigned nloc = b.st[0], nx = b.st[1];
        if (nloc == 0u) { xcd_barrier_complete(bar, b.x, nloc, nx); b.st[0] = nloc; b.st[1] = nx; }
        const unsigned old = xb_add(&bar[XB_XSUB(b.x)], 1u);
        const unsigned gen = old / nloc;
        if (old + 1u == (gen + 1u) * nloc) {
            __builtin_amdgcn_fence(__ATOMIC_RELEASE, "agent");
            asm volatile("s_waitcnt vmcnt(0)" ::: "memory");
            const unsigned og = xb_add(&bar[XB_TOP], 1u);
            const unsigned tg = og / nx;
            if (og + 1u == (tg + 1u) * nx) xb_add(&bar[XB_TOPGEN], 1u);
            else XB_SPIN(xb_ld(&bar[XB_TOPGEN]) == tg, bar);
            __builtin_amdgcn_fence(__ATOMIC_ACQUIRE, "agent");
            xb_add(&bar[XB_XGEN(b.x)], 1u);
            asm volatile("s_waitcnt vmcnt(0)" ::: "memory");
        } else {
            XB_SPIN(xb_ld(&bar[XB_XGEN(b.x)]) == gen, bar);
            __builtin_amdgcn_fence(__ATOMIC_ACQUIRE, "agent");
            asm volatile("s_waitcnt vmcnt(0)" ::: "memory");
        }
    }
    __syncthreads();
}

constexpr int NPHASES = 12;
__global__ void __launch_bounds__(NTHREADS, 2) mk_fwd(Args a) {
    extern __shared__ __attribute__((aligned(16))) unsigned char lds[];
    cg::grid_group grid = cg::this_grid();
    const int lo = a.ph_lo, hi = a.ph_hi;
    volatile LAS unsigned* xbw = (volatile LAS unsigned*)(lds + LDS_MAIN);
    if (threadIdx.x < 4) xbw[threadIdx.x] = 0u;
    __syncthreads();
    XcdBarrier xbar = xcd_barrier_post((unsigned*)(a.ws + WS_CTL), xbw);
#define IN(k) (lo <= (k) && (k) < hi)
    if (lo < 0) grid.sync();
#define SEAM(k) do { if (IN(k) && IN((k) + 1)) xcd_barrier(xbar); } while (0)
    const float* mod = (const float*)(a.ws + WS_MOD);
    if (IN(0)) phase0(a, lds);
    SEAM(0);
    if (IN(1)) norm_mod_phase<false>(a.x, a.g_mix, mod, 0, 1, (u16*)(a.ws + WS_ACT));
    SEAM(1);
    if (IN(2)) { gemm8(lds, (const u16*)(a.ws + WS_ACT), (const u16*)(a.ws + WS_WIN), T, NP, D, EpiProj{(u16*)(a.ws + WS_P), (const float*)(a.ws + WS_CS)}); gz_phase(lds, (const u16*)(a.ws + WS_ACT), (const u16*)(a.ws + WS_WIN) + (size_t)NP * D, (float*)(a.ws + WS_GZ)); }
    SEAM(2);
    if (IN(3)) phase_rope_prep(a, lds);
    SEAM(3);
    if (IN(4)) phase_mixers(a, lds);
    SEAM(4);
    if (IN(5)) phase_gla_fin(a);
    SEAM(5);
    if (IN(6)) gemm8(lds, (const u16*)(a.ws + WS_ACT), (const u16*)(a.ws + WS_WOUT), T, D, D, EpiResid{a.x, mod, (u16*)(a.ws + WS_X1)});
    SEAM(6);
    if (IN(7)) { norm_mod_phase<true>(a.ws + WS_X1, a.g_ffn, mod, 3, 4, (u16*)(a.ws + WS_ACT), a.ws + WS_IMG, (int*)(a.ws + WS_KXS)); convert_tables(a); }
    SEAM(7);
    if (IN(8)) gemm8(lds, (const u16*)(a.ws + WS_ACT), (const u16*)(a.ws + WS_WPQ), T, D, D, EpiBf16{(u16*)(a.ws + WS_Q)});
    SEAM(8);
    if (IN(9)) phase_route(a, lds);
    SEAM(9);
    if (IN(10)) phase_eu(a, lds);
    SEAM(10);
    if (IN(11)) phase_ev(a);
#undef IN
#undef SEAM
}

#ifndef MK_ONE_LAUNCH
#define MK_ONE_LAUNCH 1
#endif
extern "C" void kernel_launch(void* const* d_in, const int* in_sizes, int n_in, void* d_out, int out_size, void* d_ws, size_t ws_size, hipStream_t stream) {
    static int grid = 0;
    if (grid == 0) {
        if (n_in != 19 || out_size != T * D || ws_size < WS_END) {
            fprintf(stderr, "kernel_launch: unexpected shapes: n_in %d out %d ws %zu (need %zu)\n", n_in, out_size, ws_size, (size_t)WS_END);
            grid = -1; return;
        }
        int dev = 0, cus = 0, per_cu = 0;
        (void)hipGetDevice(&dev);
        (void)hipDeviceGetAttribute(&cus, hipDeviceAttributeMultiprocessorCount, dev);
        (void)hipFuncSetAttribute((const void*)mk_fwd, hipFuncAttributeMaxDynamicSharedMemorySize, LDS_BYTES);
        (void)hipOccupancyMaxActiveBlocksPerMultiprocessor(&per_cu, (const void*)mk_fwd, NTHREADS, LDS_BYTES);
        if (per_cu < 1) { fprintf(stderr, "kernel_launch: occupancy query says %d blocks/CU\n", per_cu); grid = -1; return; }
        grid = cus;
        (void)hipGetLastError();
    }
    if (grid < 0) return;
    Args a{};
    a.x = (const float*)d_in[0]; a.c = (const float*)d_in[1]; a.pos = (const int*)d_in[2]; a.w_ada = (const float*)d_in[3];
    a.b_ada = (const float*)d_in[4]; a.g_mix = (const float*)d_in[5]; a.w_in = (const float*)d_in[6]; a.wgf = (const float*)d_in[7];
    a.bgf = (const float*)d_in[8]; a.wgb = (const float*)d_in[9]; a.bgb = (const float*)d_in[10]; a.g_gla = (const float*)d_in[11];
    a.w_out = (const float*)d_in[12]; a.g_ffn = (const float*)d_in[13]; a.w_pq = (const float*)d_in[14]; a.subk = (const float*)d_in[15];
    a.pu = (const float*)d_in[16]; a.pv = (const float*)d_in[17]; a.g_fin = (const float*)d_in[18];
    a.out = (float*)d_out; a.ws = (unsigned char*)d_ws;
#if MK_ONE_LAUNCH
    (void)hipMemsetAsync((unsigned char*)d_ws + WS_CTL, 0, XCD_BAR_WORDS * 4, stream);
    a.ph_lo = 0; a.ph_hi = NPHASES;
    void* args[] = {&a};
    hipError_t e = hipLaunchCooperativeKernel((const void*)mk_fwd, dim3(grid), dim3(NTHREADS), args, LDS_BYTES, stream);
    if (e != hipSuccess) fprintf(stderr, "cooperative launch failed: %s (grid %d)\n", hipGetErrorString(e), grid);
#else
    for (int p = 0; p < NPHASES; ++p) {
        a.ph_lo = p; a.ph_hi = p + 1;
        hipLaunchKernelGGL(mk_fwd, dim3(grid), dim3(NTHREADS), LDS_BYTES, stream, a);
    }
#endif
}
```

```cpp
#include <hip/hip_runtime.h>
#include <hip/hip_cooperative_groups.h>
#include <cstdio>
#include <cstdint>

namespace cg = cooperative_groups;

typedef unsigned short u16;
typedef __attribute__((ext_vector_type(8))) short bf16x8;
typedef __attribute__((ext_vector_type(4))) float f32x4;
typedef short s16x4 __attribute__((ext_vector_type(4)));
#define TID ((int)threadIdx.x)
#define BID ((int)blockIdx.x)
#define GDIM ((int)gridDim.x)
#define LAS __attribute__((address_space(3)))

constexpr int D = 2048, NB = 4, S = 4096, T = NB * S;
constexpr int INW = 6176;
constexpr int NP = 6144;
constexpr int NPAD = 6208;
constexpr int C_GQ = 0, C_GK = 512, C_GV = 1024, C_GR = 2048, C_DQ = 3072, C_DK = 4096, C_DV = 5120;
constexpr int NTHREADS = 512, NWAVES = 8;
constexpr int LDS_MAIN = 128 * 1024;
constexpr int LDS_STAGE = 16 * 1024;
constexpr int LDS_BYTES = LDS_MAIN + 16 + LDS_STAGE;
constexpr float NORM_EPS = 1e-6f;

constexpr size_t WS_CTL = 0;
constexpr size_t WS_MOD = 65536;
constexpr size_t WS_CS = 524288;
constexpr size_t WS_WIN = WS_CS + (size_t)T * 64 * 8;
constexpr size_t WS_WOUT = WS_WIN + (size_t)NPAD * D * 2;
constexpr size_t WS_WPQ = WS_WOUT + (size_t)D * D * 2;
constexpr size_t WS_ACT = WS_WPQ + (size_t)D * D * 2;
constexpr size_t WS_P = WS_ACT + (size_t)T * D * 2;
constexpr size_t WS_X1 = WS_P;
constexpr size_t WS_Q = WS_P + (size_t)T * D * 4;
constexpr size_t WS_GZ = WS_P + (size_t)T * NP * 2;
constexpr int GLA_NPREP = NB * 4 * 2 * (S / 64);
constexpr size_t WS_QD = WS_GZ + (size_t)T * 32 * 4;
constexpr size_t WS_KE = WS_QD + (size_t)GLA_NPREP * 16384;
constexpr size_t WS_AT = WS_KE + (size_t)GLA_NPREP * 16384;
constexpr size_t WS_DEC = WS_AT + (size_t)GLA_NPREP * 8192;
constexpr size_t WS_OFB = WS_DEC + (size_t)GLA_NPREP * 512;
constexpr size_t WS_IDX = WS_OFB + (size_t)2 * T * 1024 * 2;
constexpr size_t WS_GATE = WS_IDX + (size_t)T * 128 * 4;
constexpr size_t WS_SS = WS_GATE + (size_t)T * 128 * 4;
constexpr size_t WS_KXS = WS_SS + (size_t)T * 8 * 4;
constexpr size_t WS_END = WS_KXS + (size_t)T * 8 * 4;
constexpr size_t WS_IMG = WS_OFB;
constexpr size_t WS_AP = WS_P + (size_t)T * D * 2;
constexpr size_t SLICE_T = (size_t)16384 * 128, SLICE_S = (size_t)16384 * 8;
constexpr size_t WS_TU = WS_QD;
constexpr size_t WS_TV = WS_TU + (size_t)16384 * 1024;
constexpr size_t WS_SU = WS_TV + (size_t)16384 * 1024;
constexpr size_t WS_SV = WS_SU + (size_t)16384 * 128;
static_assert(WS_SV + (size_t)16384 * 128 <= WS_IDX, "table region");

struct Args {
    const float* x; const float* c; const int* pos; const float* w_ada; const float* b_ada; const float* g_mix;
    const float* w_in; const float* wgf; const float* bgf; const float* wgb; const float* bgb; const float* g_gla;
    const float* w_out; const float* g_ffn; const float* w_pq; const float* subk; const float* pu; const float* pv; const float* g_fin;
    float* out; unsigned char* ws; int ph_lo, ph_hi;
};

__device__ __forceinline__ float bf2f(u16 h) { return __uint_as_float(((unsigned)h) << 16); }
typedef __bf16 hw_bf16x2 __attribute__((ext_vector_type(2)));
typedef float hw_f32x2 __attribute__((ext_vector_type(2)));
typedef unsigned u32x2_t __attribute__((ext_vector_type(2)));
__device__ __forceinline__ unsigned pack2(float a, float b) { const hw_f32x2 f = {a, b}; return __builtin_bit_cast(unsigned, __builtin_convertvector(f, hw_bf16x2)); }
__device__ __forceinline__ u16 f2bf(float f) { return (u16)(pack2(f, 0.f) & 0xffffu); }
__device__ __forceinline__ float lo2f(unsigned p) { return __uint_as_float(p << 16); }
__device__ __forceinline__ float hi2f(unsigned p) { return __uint_as_float(p & 0xffff0000u); }
__device__ __forceinline__ float wave_sum(float v) {
#pragma unroll
    for (int o = 32; o > 0; o >>= 1) v += __shfl_xor(v, o);
    return v;
}
__device__ __forceinline__ float wave_max(float v) {
#pragma unroll
    for (int o = 32; o > 0; o >>= 1) v = fmaxf(v, __shfl_xor(v, o));
    return v;
}
__device__ __forceinline__ float silu_f(float v) { return v / (1.f + __expf(-v)); }
__device__ __forceinline__ float gelu_f(float a) { return 0.5f * a * (1.f + erff(a * 0.70710678118654752f)); }
__device__ __forceinline__ float logsigmoid_f(float z) { return z < 0.f ? z - log1pf(expf(z)) : -log1pf(expf(-z)); }

constexpr int MOD_BLOCKS = 96;
__device__ __forceinline__ void p0_mod(const Args& a, unsigned char* lds, int bi) {
    float* sc = (float*)lds;
    float* red = sc + 4 * 2048;
    const int tid = threadIdx.x, lane = tid & 63, wave = tid >> 6;
    for (int i = tid; i < 4 * 2048; i += NTHREADS) sc[i] = silu_f(a.c[i]);
    __syncthreads();
    const int j0 = bi * 128 + lane * 2;
    float acc[4][2];
#pragma unroll
    for (int b = 0; b < 4; ++b) { acc[b][0] = 0.f; acc[b][1] = 0.f; }
    const int k0 = wave * 256;
#pragma unroll 8
    for (int kk = 0; kk < 256; ++kk) {
        const int k = k0 + kk;
        const hw_f32x2 wv_ = __builtin_nontemporal_load((const hw_f32x2*)(a.w_ada + (size_t)k * 12288 + j0)); const float2 w = make_float2(wv_[0], wv_[1]);
#pragma unroll
        for (int b = 0; b < 4; ++b) { const float s = sc[b * 2048 + k]; acc[b][0] += s * w.x; acc[b][1] += s * w.y; }
    }
#pragma unroll
    for (int b = 0; b < 4; ++b) { red[(wave * 4 + b) * 128 + lane * 2] = acc[b][0]; red[(wave * 4 + b) * 128 + lane * 2 + 1] = acc[b][1]; }
    __syncthreads();
    float* mod = (float*)(a.ws + WS_MOD);
    {
        const int b = tid >> 7, jc = tid & 127;
        float s = 0.f;
#pragma unroll
        for (int w = 0; w < 8; ++w) s += red[(w * 4 + b) * 128 + jc];
        mod[b * 12288 + bi * 128 + jc] = s + a.b_ada[bi * 128 + jc];
    }
    __syncthreads();
}

__device__ __forceinline__ void p0_transpose_item(const float* __restrict__ W, int ldw, int k0, int src_col0, int n_valid,
                                                  u16* __restrict__ WT, int ldt, int n_out0, unsigned char* wlds, bool rope_perm = false) {
    u16* tl = (u16*)wlds;
    const int lane = threadIdx.x & 63;
    const int rsub = lane >> 4, nc = (lane & 15) * 4;
    int scol = src_col0 + nc;
    if (rope_perm) { const int p = (n_out0 & 64) + nc, g = p >> 3; scol = (src_col0 - (n_out0 & 64)) + ((p & 4) ? 64 + 4 * g : 4 * g); }
    float4 v[16];
#pragma unroll
    for (int j = 0; j < 16; ++j) {
        const int k = 4 * j + rsub;
        if (nc < n_valid) { const f32x4 q_ = __builtin_nontemporal_load((const f32x4*)(W + (size_t)(k0 + k) * ldw + scol)); v[j] = make_float4(q_[0], q_[1], q_[2], q_[3]); }
        else v[j] = make_float4(0.f, 0.f, 0.f, 0.f);
    }
#pragma unroll
    for (int j = 0; j < 16; ++j) {
        const int k = 4 * j + rsub;
        tl[(nc + 0) * 72 + k] = f2bf(v[j].x); tl[(nc + 1) * 72 + k] = f2bf(v[j].y); tl[(nc + 2) * 72 + k] = f2bf(v[j].z); tl[(nc + 3) * 72 + k] = f2bf(v[j].w);
    }
#pragma unroll
    for (int j = 0; j < 8; ++j) {
        const int c = lane + 64 * j, n = c >> 3, kc = (c & 7) * 8;
        const uint4 o = *(const uint4*)(tl + n * 72 + kc);
        *(uint4*)(WT + (size_t)(n_out0 + n) * ldt + k0 + kc) = o;
    }
}

__device__ __forceinline__ void phase0(const Args& a, unsigned char* lds) {
    const int bi = blockIdx.x, G = gridDim.x, tid = threadIdx.x, wave = tid >> 6;
    const bool modblk = (G > MOD_BLOCKS) && (bi < MOD_BLOCKS);
    if (G > MOD_BLOCKS) { if (modblk) p0_mod(a, lds, bi); }
    else { for (int mb = bi; mb < MOD_BLOCKS; mb += G) p0_mod(a, lds, mb); }
    const int nb = (G > MOD_BLOCKS) ? G - MOD_BLOCKS : G, b0 = (G > MOD_BLOCKS) ? bi - MOD_BLOCKS : bi;
    if (!modblk) {
        constexpr int I_IN = 32 * (NPAD / 64), I_SQ = 32 * 32;
        u16* WinT = (u16*)(a.ws + WS_WIN); u16* WoutT = (u16*)(a.ws + WS_WOUT); u16* WpqT = (u16*)(a.ws + WS_WPQ);
        unsigned char* wlds = lds + wave * 9216;
        for (int it = b0 * NWAVES + wave; it < I_IN + 2 * I_SQ; it += nb * NWAVES) {
            if (it < I_IN) {
                const int kt = it & 31, nt = it >> 5;
                const int n0 = nt * 64;
                int src, nv;
                if (n0 < 3072) { src = n0; nv = 64; }
                else if (n0 < 6144) { src = n0 + 32; nv = 64; }
                else if (n0 == 6144) { src = 3072; nv = 32; }
                else { src = 0; nv = 0; }
                p0_transpose_item(a.w_in, INW, kt * 64, src, nv, WinT, D, n0, wlds, n0 >= C_DQ && n0 < C_DV);
            } else if (it < I_IN + I_SQ) {
                const int r = it - I_IN; const int kt = r & 31, nt = r >> 5;
                p0_transpose_item(a.w_out, D, kt * 64, nt * 64, 64, WoutT, D, nt * 64, wlds);
            } else {
                const int r = it - I_IN - I_SQ; const int kt = r & 31, nt = r >> 5;
                p0_transpose_item(a.w_pq, D, kt * 64, nt * 64, 64, WpqT, D, nt * 64, wlds);
            }
        }
        float2* cs = (float2*)(a.ws + WS_CS);
        for (int i = b0 * NTHREADS + tid; i < T * 64; i += nb * NTHREADS) {
            const int t = i >> 6, f = i & 63;
            const float inv_freq = powf(10000.0f, -(float)f * 2.0f / 128.0f);
            const float ang = (float)a.pos[t] * inv_freq;
            const double rev = (double)ang * 0.15915494309189533577;
            const float fr = (float)(rev - floor(rev));
            cs[i] = make_float2(__builtin_amdgcn_cosf(fr), __builtin_amdgcn_sinf(fr));
        }
    }
    __syncthreads();
}

template <bool BF16IN> __device__ __forceinline__ void norm_mod_phase(const void* __restrict__ xin_, const float* __restrict__ g, const float* __restrict__ mod,
                                               int sh_chunk, int sc_chunk, u16* __restrict__ outp, unsigned char* __restrict__ img = nullptr, int* __restrict__ kxs = nullptr) {
    const int lane = threadIdx.x & 63, wave = threadIdx.x >> 6;
    const int gw = blockIdx.x * NWAVES + wave, NGW = gridDim.x * NWAVES;
    float4 v[8], vn[8];
#define NM_LOAD(dst_, t_) do { if (BF16IN) { const hw_f32x2* xr_ = (const hw_f32x2*)((const u16*)xin_ + (size_t)(t_) * D); \
            _Pragma("unroll") for (int m = 0; m < 8; ++m) { const hw_f32x2 q_ = __builtin_nontemporal_load(xr_ + lane + 64 * m); const unsigned px_ = __float_as_uint(q_[0]), py_ = __float_as_uint(q_[1]); \
                dst_[m] = make_float4(lo2f(px_), hi2f(px_), lo2f(py_), hi2f(py_)); } } \
        else { const f32x4* xr_ = (const f32x4*)((const float*)xin_ + (size_t)(t_) * D); \
            _Pragma("unroll") for (int m = 0; m < 8; ++m) { const f32x4 q_ = __builtin_nontemporal_load(xr_ + lane + 64 * m); dst_[m] = make_float4(q_[0], q_[1], q_[2], q_[3]); } } } while (0)
    if (gw < T) NM_LOAD(v, gw);
    for (int t = gw; t < T; t += NGW) {
        const int b = t / S;
        if (t + NGW < T) NM_LOAD(vn, t + NGW);
        float ss = 0.f;
#pragma unroll
        for (int m = 0; m < 8; ++m) ss += v[m].x * v[m].x + v[m].y * v[m].y + v[m].z * v[m].z + v[m].w * v[m].w;
        ss = wave_sum(ss);
        const float rstd = rsqrtf(ss * (1.f / D) + NORM_EPS);
        const float4* gp = (const float4*)g;
        const float4* shp = (const float4*)(mod + b * 12288 + sh_chunk * 2048);
        const float4* scp = (const float4*)(mod + b * 12288 + sc_chunk * 2048);
        uint2* op = (uint2*)(outp + (size_t)t * D);
#pragma unroll
        for (int m = 0; m < 8; ++m) {
            const int i = lane + 64 * m;
            const float4 gg = gp[i], sh = shp[i], sc = scp[i];
            const float h0 = v[m].x * rstd * gg.x * (1.f + sc.x) + sh.x;
            const float h1 = v[m].y * rstd * gg.y * (1.f + sc.y) + sh.y;
            const float h2 = v[m].z * rstd * gg.z * (1.f + sc.z) + sh.z;
            const float h3 = v[m].w * rstd * gg.w * (1.f + sc.w) + sh.w;
            const uint2 pk = make_uint2(pack2(h0, h1), pack2(h2, h3));
            op[i] = pk;
            if (BF16IN) {
                const float e0 = lo2f(pk.x), e1 = hi2f(pk.x), e2 = lo2f(pk.y), e3 = hi2f(pk.y);
                float amx = fmaxf(fmaxf(fabsf(e0), fabsf(e1)), fmaxf(fabsf(e2), fabsf(e3)));
#pragma unroll
                for (int o = 32; o > 0; o >>= 1) amx = fmaxf(amx, __shfl_xor(amx, o));
                const unsigned bits = __float_as_uint(amx);
                int kx = (int)(bits >> 23) - 127 - 8 + (((bits & 0x7fffffu) > 0x600000u) ? 1 : 0); kx = kx < -100 ? -100 : kx;
                const float hinv = __uint_as_float((unsigned)(127 - kx) << 23);
                const float x0 = e0 * hinv, x1 = e1 * hinv, x2 = e2 * hinv, x3 = e3 * hinv;
                int w = __builtin_amdgcn_cvt_pk_fp8_f32(x0, x1, 0, false); w = __builtin_amdgcn_cvt_pk_fp8_f32(x2, x3, w, true);
                const hw_f32x2 d0 = __builtin_amdgcn_cvt_pk_f32_fp8(w, false), d1 = __builtin_amdgcn_cvt_pk_f32_fp8(w, true);
                int l = __builtin_amdgcn_cvt_pk_fp8_f32((x0 - d0[0]) * 16.f, (x1 - d0[1]) * 16.f, 0, false);
                l = __builtin_amdgcn_cvt_pk_fp8_f32((x2 - d1[0]) * 16.f, (x3 - d1[1]) * 16.f, l, true);
                const int ei = 4 * lane, s = ei >> 7, k = ei & 127, g = (k & 63) >> 4, bb = (k & 15) + 16 * (k >> 6);
                unsigned char* ip = img + (((size_t)t * 8 + m) * 8 + 2 * g) * 64 + s * 32 + bb;
                *(int*)ip = w; *(int*)(ip + 64) = l;
                if (lane == 0) kxs[(size_t)t * 8 + m] = kx;
            }
        }
#pragma unroll
        for (int m = 0; m < 8; ++m) v[m] = vn[m];
    }
#undef NM_LOAD
}

namespace pg8 {
#define PG8_LAS __attribute__((address_space(3)))
typedef unsigned short bf16_t;
typedef short bf16x8 __attribute__((ext_vector_type(8)));
typedef float f32x4 __attribute__((ext_vector_type(4)));
typedef unsigned u32x4 __attribute__((ext_vector_type(4)));
constexpr int BM = 256, BK = 64, HALF = 128, HTB = HALF * BK * 2  , STAGE_BYTES = 8 * HTB, NXCD = 8, WGM = 8;

__host__ __device__ __forceinline__ int lds_byte(int r, int c) { const int st = (r >> 4) * 2 + (c >> 5), rr = r & 15, cc = c & 31, ob = rr * 64 + cc * 2; return st * 1024 + (ob ^ (((ob >> 9) & 1) << 5)); }
__host__ __device__ __forceinline__ void stage_rc(int b, int& R, int& C) { const int st = b / 1024, sb = b % 1024, swz = sb ^ (((sb >> 9) & 1) << 5); R = (st >> 1) * 16 + swz / 64; C = (st & 1) * 32 + (swz % 64) / 2; }
__host__ __device__ __forceinline__ int perm32(int rho) { const int n = rho >> 4, i = rho & 15; return 8 * (i >> 2) + 4 * n + (i & 3); }

struct Unit { int pm, pn; };
struct Gemm { const bf16_t* A; const bf16_t* Bt; int M, N, K; };

struct StaticOrder {
    int nM, nN, nwg, G, c;
    __host__ __device__ void init(int M, int N, int G_, int c_) { nM = M / BM; nN = N / BM; nwg = nM * nN; G = G_; c = c_; }
    __host__ __device__ bool next(int i, Unit& u) const {
        const long L = (long)i * G + c; if (L >= nwg) return false;
        int wgid = (int)L; { const int q = nwg / NXCD, r = nwg % NXCD, xcd = wgid % NXCD, off = wgid / NXCD; wgid = (xcd < r ? xcd * (q + 1) : r * (q + 1) + (xcd - r) * q) + off; }
        const int nig = WGM * nN, gid = wgid / nig, fm = gid * WGM, gsz = (nM - fm) < WGM ? (nM - fm) : WGM;
        u.pm = fm + ((wgid % nig) % gsz); u.pn = (wgid % nig) / gsz; return true;
    }
    __device__ __forceinline__ void a_ready(const Unit&) const {}
    __device__ __forceinline__ void done(const Unit&) const {}
};
__device__ __forceinline__ unsigned cvt_pk_bf16(float lo, float hi) { unsigned r; asm volatile("v_cvt_pk_bf16_f32 %0, %1, %2" : "=v"(r) : "v"(lo), "v"(hi)); return r; }
typedef float f32x2 __attribute__((ext_vector_type(2)));
template <class Epi, class Sched, bool STAMP = false>
__device__ __forceinline__ void gemm_phase(PG8_LAS unsigned char* lds, const Gemm g, const Sched& S, const Epi& E, unsigned long long* stamps) {
    const int tid = threadIdx.x, wid = __builtin_amdgcn_readfirstlane(tid >> 6), lane = tid & 63, wr = wid >> 2, wc = wid & 3, fr = lane & 15, fq = lane >> 4;
    const int K = g.K, nt = K / BK;
    int ts_lo = 0, ts_hi = 0, nts = 0; const unsigned long long rt_entry = STAMP ? (unsigned long long)wall_clock64() : 0ull;
#define PG8_STAMP() do { if (STAMP && wid == 0 && nts < 64) { const unsigned long long _c = (unsigned long long)clock64(); \
        ts_lo = (lane == nts) ? (int)(unsigned)_c : ts_lo; ts_hi = (lane == nts) ? (int)(unsigned)(_c >> 32) : ts_hi; ++nts; } } while (0)
    PG8_STAMP();
    unsigned voffA[2], voffB[2];
#pragma unroll
    for (int i = 0; i < 2; ++i) { int R, C; stage_rc(tid * 16 + i * 8192, R, C); const int Rb = Epi::PERM ? ((R & ~31) + perm32(R & 31)) : R;
        voffA[i] = (unsigned)(R * K + C) * 2u; voffB[i] = (unsigned)(Rb * K + C) * 2u; }
    const size_t kstep = (size_t)(BK * 2);
    const size_t hstep = (size_t)HALF * K * 2;
    const size_t tstep = 2 * hstep;
    const unsigned ldsw = (unsigned)wid * 1024u;
    const int aoff = lds_byte(wr * 64 + fr, fq * 8), boff = lds_byte(wc * 32 + fr, fq * 8);
#define PG8_SA(b, h) (((b) * 2 + (h)) * HTB)
#define PG8_SB(b, h) ((4 + (b) * 2 + (h)) * HTB)
#define PG8_STAGE(bufoff, gbase, voff) do { _Pragma("unroll") for (int _i = 0; _i < 2; ++_i) \
        __builtin_amdgcn_global_load_lds((const unsigned*)((const char*)(gbase) + (voff)[_i]), (PG8_LAS unsigned*)(lds + (bufoff) + ldsw + _i * 8192), 16, 0, 0); } while (0)
#define PG8_LDA(dst, b, h) do { _Pragma("unroll") for (int m = 0; m < 4; ++m) _Pragma("unroll") for (int k = 0; k < 2; ++k) dst[m][k] = *(const PG8_LAS bf16x8*)(lds + PG8_SA(b, h) + aoff + m * 2048 + k * 1024); } while (0)
#define PG8_LDB(dst, b, h) do { _Pragma("unroll") for (int n = 0; n < 2; ++n) _Pragma("unroll") for (int k = 0; k < 2; ++k) dst[n][k] = *(const PG8_LAS bf16x8*)(lds + PG8_SB(b, h) + boff + n * 2048 + k * 1024); } while (0)
#define PG8_MMA(ai, bj, At, Bt) do { __builtin_amdgcn_s_setprio(1); _Pragma("unroll") for (int m = 0; m < 4; ++m) _Pragma("unroll") for (int n = 0; n < 2; ++n) _Pragma("unroll") for (int k = 0; k < 2; ++k) \
        acc[ai][bj][m][n] = __builtin_amdgcn_mfma_f32_16x16x32_bf16(Bt[n][k], At[m][k], acc[ai][bj][m][n], 0, 0, 0); __builtin_amdgcn_s_setprio(0); } while (0)
#define PG8_WAIT_V(n) asm volatile("s_waitcnt vmcnt(" #n ")" ::: "memory")
#define PG8_WAIT_L(n) asm volatile("s_waitcnt lgkmcnt(" #n ")" ::: "memory")
#define PG8_BAR __builtin_amdgcn_s_barrier()
#define PG8_SCHED __builtin_amdgcn_sched_barrier(0)
    Unit cur, nxt; int ui = 0;
    if (!S.next(0, cur)) return;
    f32x4 acc[2][2][4][2];
#pragma unroll
    for (int a = 0; a < 2; ++a)
#pragma unroll
        for (int b = 0; b < 2; ++b)
#pragma unroll
            for (int m = 0; m < 4; ++m)
#pragma unroll
                for (int n = 0; n < 2; ++n) acc[a][b][m][n] = (f32x4){0.f, 0.f, 0.f, 0.f};
    bf16x8 At[4][2], B0[2][2], B1[2][2];
    const char* cA = (const char*)g.A + (size_t)cur.pm * tstep; const char* cB = (const char*)g.Bt + (size_t)cur.pn * tstep;
    S.a_ready(cur);
    PG8_STAGE(PG8_SB(0, 0), cB, voffB); PG8_STAGE(PG8_SA(0, 0), cA, voffA); PG8_STAGE(PG8_SB(0, 1), cB + hstep, voffB); PG8_STAGE(PG8_SA(0, 1), cA + hstep, voffA);
    if (wr == 1) PG8_BAR;
    PG8_WAIT_V(4); PG8_BAR;
    PG8_STAGE(PG8_SB(1, 0), cB + kstep, voffB); PG8_STAGE(PG8_SA(1, 0), cA + kstep, voffA); PG8_STAGE(PG8_SB(1, 1), cB + hstep + kstep, voffB);
    PG8_WAIT_V(6); PG8_BAR;
    PG8_STAMP();
    for (;;) {
        const bool has_next = S.next(ui + 1, nxt);
        const char* nA = has_next ? (const char*)g.A + (size_t)nxt.pm * tstep : cA; const char* nB = has_next ? (const char*)g.Bt + (size_t)nxt.pn * tstep : cB;
        for (int t = 0; t < nt; t += 2) {
            const bool last = (t == nt - 2);
            const char* a1 = cA + (size_t)(t + 1) * kstep;
            const char* a2 = last ? nA : cA + (size_t)(t + 2) * kstep; const char* b2 = last ? nB : cB + (size_t)(t + 2) * kstep;
            const char* a3 = a2 + kstep; const char* b3 = b2 + kstep;
            if (last && has_next) S.a_ready(nxt);
            PG8_LDB(B0, 0, 0); PG8_SCHED; PG8_LDA(At, 0, 0); PG8_STAGE(PG8_SA(1, 1), a1 + hstep, voffA);
            PG8_WAIT_L(8); PG8_BAR; PG8_WAIT_L(0); PG8_MMA(0, 0, At, B0); PG8_BAR; PG8_SCHED;
            PG8_LDB(B1, 0, 1); PG8_STAGE(PG8_SB(0, 0), b2, voffB);
            PG8_BAR; PG8_WAIT_L(0); PG8_MMA(0, 1, At, B1); PG8_BAR;
            PG8_LDA(At, 0, 1); PG8_STAGE(PG8_SA(0, 0), a2, voffA);
            PG8_BAR; PG8_WAIT_L(0); PG8_MMA(1, 0, At, B0); PG8_BAR; PG8_SCHED;
            PG8_STAGE(PG8_SB(0, 1), b2 + hstep, voffB);
            PG8_WAIT_V(6); PG8_BAR; PG8_MMA(1, 1, At, B1); PG8_BAR;
            PG8_LDB(B0, 1, 0); PG8_SCHED; PG8_LDA(At, 1, 0); PG8_STAGE(PG8_SA(0, 1), a2 + hstep, voffA);
            PG8_WAIT_L(8); PG8_BAR; PG8_WAIT_L(0); PG8_MMA(0, 0, At, B0); PG8_BAR; PG8_SCHED;
            PG8_LDB(B1, 1, 1); PG8_STAGE(PG8_SB(1, 0), b3, voffB);
            PG8_BAR; PG8_WAIT_L(0); PG8_MMA(0, 1, At, B1); PG8_BAR;
            PG8_LDA(At, 1, 1); PG8_STAGE(PG8_SA(1, 0), a3, voffA);
            PG8_BAR; PG8_WAIT_L(0); PG8_MMA(1, 0, At, B0); PG8_BAR; PG8_SCHED;
            PG8_STAGE(PG8_SB(1, 1), b3 + hstep, voffB);
            PG8_WAIT_V(6); PG8_BAR; PG8_MMA(1, 1, At, B1); PG8_BAR;
        }
        PG8_STAMP();
        if constexpr (!Epi::AFTER_DRAIN) { E(acc, cur, wr, wc, fr, fq); S.done(cur); }
        PG8_STAMP();
        if (!has_next) break;
#pragma unroll
        for (int a = 0; a < 2; ++a)
#pragma unroll
            for (int b = 0; b < 2; ++b)
#pragma unroll
                for (int m = 0; m < 4; ++m)
#pragma unroll
                    for (int n = 0; n < 2; ++n) acc[a][b][m][n] = (f32x4){0.f, 0.f, 0.f, 0.f};
        cur = nxt; cA = nA; cB = nB; ++ui;
    }
    PG8_WAIT_V(0);
    if (wr == 0) PG8_BAR;
    PG8_BAR;
    if constexpr (Epi::AFTER_DRAIN) { E.fused(acc, cur, wr, wc, fr, fq, lds, wid, lane); S.done(cur); }
    PG8_STAMP();
    if (STAMP && wid == 0) { stamps[lane] = lane < nts ? (((unsigned long long)(unsigned)ts_hi << 32) | (unsigned)ts_lo) : 0ull;
        if (lane == 62) stamps[62] = rt_entry; if (lane == 63) stamps[63] = (unsigned long long)wall_clock64(); }
#undef PG8_STAMP
#undef PG8_SA
#undef PG8_SB
#undef PG8_STAGE
#undef PG8_LDA
#undef PG8_LDB
#undef PG8_MMA
#undef PG8_WAIT_V
#undef PG8_WAIT_L
#undef PG8_BAR
#undef PG8_SCHED
}
}

struct EpiProj {
    static constexpr bool PERM = true, AFTER_DRAIN = false;
    u16* P; const float* cs;
    __device__ __forceinline__ void operator()(const pg8::f32x4 (&acc)[2][2][4][2], const pg8::Unit& u, int wr, int wc, int fr, int fq) const {
        const int row0 = u.pm * 256 + wr * 64 + fr;
        const int col0 = u.pn * 256 + wc * 32 + 8 * fq;
        const bool rope = (u.pn >= C_DQ / 256) && (u.pn < C_DV / 256);
#pragma unroll
        for (int ai = 0; ai < 2; ++ai)
#pragma unroll
            for (int m = 0; m < 4; ++m) { const int row = row0 + ai * 128 + m * 16; u16* rowp = P + (size_t)row * NP + col0;
                pg8::f32x4 c01 = (pg8::f32x4){1.f, 0.f, 1.f, 0.f}, c23 = c01;
                if (rope) { const pg8::f32x4* cp = (const pg8::f32x4*)(cs + ((size_t)row * 64 + 4 * (4 * wc + fq)) * 2); c01 = cp[0]; c23 = cp[1]; }
#pragma unroll
                for (int bj = 0; bj < 2; ++bj) { pg8::f32x4 v0 = acc[ai][bj][m][0], v1 = acc[ai][bj][m][1];
                    if (rope) {
                        const pg8::f32x4 cc = {c01[0], c01[2], c23[0], c23[2]}, sn = {c01[1], c01[3], c23[1], c23[3]};
                        const pg8::f32x4 y1 = v0 * cc - v1 * sn, y2 = v0 * sn + v1 * cc; v0 = y1; v1 = y2; }
                    pg8::u32x4 w; w.x = pg8::cvt_pk_bf16(v0[0], v0[1]); w.y = pg8::cvt_pk_bf16(v0[2], v0[3]); w.z = pg8::cvt_pk_bf16(v1[0], v1[1]); w.w = pg8::cvt_pk_bf16(v1[2], v1[3]);
                    *(pg8::u32x4*)(rowp + bj * 128) = w; } }
    }
};
__device__ __forceinline__ void gz_phase(unsigned char* lds, const u16* __restrict__ H1, const u16* __restrict__ Wg, float* __restrict__ gz) {
    const int tid = threadIdx.x, lane = tid & 63, wave = tid >> 6, fr = lane & 15, fq = lane >> 4;
    float* red = (float*)lds;
    for (int rb = blockIdx.x; rb < T / 64; rb += gridDim.x) {
        const int r0 = rb * 64, k0 = wave * 256;
        f32x4 acc[4][2];
#pragma unroll
        for (int m = 0; m < 4; ++m) { acc[m][0] = (f32x4){0.f, 0.f, 0.f, 0.f}; acc[m][1] = (f32x4){0.f, 0.f, 0.f, 0.f}; }
#pragma unroll
        for (int ks = 0; ks < 8; ++ks) {
            bf16x8 af[4], bfr[2];
#pragma unroll
            for (int m = 0; m < 4; ++m) af[m] = *(const bf16x8*)(H1 + (size_t)(r0 + 16 * m + fr) * D + k0 + 32 * ks + 8 * fq);
#pragma unroll
            for (int n = 0; n < 2; ++n) bfr[n] = *(const bf16x8*)(Wg + (size_t)(16 * n + fr) * D + k0 + 32 * ks + 8 * fq);
#pragma unroll
            for (int m = 0; m < 4; ++m)
#pragma unroll
                for (int n = 0; n < 2; ++n) acc[m][n] = __builtin_amdgcn_mfma_f32_16x16x32_bf16(af[m], bfr[n], acc[m][n], 0, 0, 0);
        }
        __syncthreads();
#pragma unroll
        for (int m = 0; m < 4; ++m)
#pragma unroll
            for (int n = 0; n < 2; ++n)
#pragma unroll
                for (int j = 0; j < 4; ++j) red[(wave * 64 + 16 * m + 4 * fq + j) * 32 + 16 * n + fr] = acc[m][n][j];
        __syncthreads();
#pragma unroll
        for (int k = 0; k < 4; ++k) {
            const int e = tid + 512 * k;
            float s = 0.f;
#pragma unroll
            for (int w = 0; w < 8; ++w) s += red[w * 2048 + e];
            gz[(size_t)r0 * 32 + e] = s;
        }
    }
    __syncthreads();
}
struct EpiResid {
    static constexpr bool PERM = true, AFTER_DRAIN = false;
    const float* x; const float* mod; u16* x1;
    __device__ __forceinline__ void operator()(const pg8::f32x4 (&acc)[2][2][4][2], const pg8::Unit& u, int wr, int wc, int fr, int fq) const {
        const int row0 = u.pm * 256 + wr * 64 + fr, col0 = u.pn * 256 + wc * 32 + 8 * fq;
        const int b = (u.pm * 256) / S;
        pg8::f32x4 ga[2][2];
#pragma unroll
        for (int bj = 0; bj < 2; ++bj)
#pragma unroll
            for (int n = 0; n < 2; ++n) ga[bj][n] = *(const pg8::f32x4*)(mod + b * 12288 + 2 * 2048 + col0 + bj * 128 + 4 * n);
#pragma unroll
        for (int ai = 0; ai < 2; ++ai)
#pragma unroll
            for (int m = 0; m < 4; ++m) { const size_t off = (size_t)(row0 + ai * 128 + m * 16) * D + col0;
#pragma unroll
                for (int bj = 0; bj < 2; ++bj) {
                    const pg8::f32x4 x0 = __builtin_nontemporal_load((const pg8::f32x4*)(x + off + bj * 128)), x1v = __builtin_nontemporal_load((const pg8::f32x4*)(x + off + bj * 128 + 4));
                    const pg8::f32x4 v0 = x0 + ga[bj][0] * acc[ai][bj][m][0], v1 = x1v + ga[bj][1] * acc[ai][bj][m][1];
                    pg8::u32x4 w; w.x = pg8::cvt_pk_bf16(v0[0], v0[1]); w.y = pg8::cvt_pk_bf16(v0[2], v0[3]); w.z = pg8::cvt_pk_bf16(v1[0], v1[1]); w.w = pg8::cvt_pk_bf16(v1[2], v1[3]);
                    *(pg8::u32x4*)(x1 + off + bj * 128) = w; } }
    }
};
struct EpiBf16 {
    static constexpr bool PERM = true, AFTER_DRAIN = false;
    u16* Q;
    __device__ __forceinline__ void operator()(const pg8::f32x4 (&acc)[2][2][4][2], const pg8::Unit& u, int wr, int wc, int fr, int fq) const {
        const int row0 = u.pm * 256 + wr * 64 + fr, col0 = u.pn * 256 + wc * 32 + 8 * fq;
#pragma unroll
        for (int ai = 0; ai < 2; ++ai)
#pragma unroll
            for (int m = 0; m < 4; ++m) { u16* rowp = Q + (size_t)(row0 + ai * 128 + m * 16) * D + col0;
#pragma unroll
                for (int bj = 0; bj < 2; ++bj) { const pg8::f32x4 v0 = acc[ai][bj][m][0], v1 = acc[ai][bj][m][1];
                    pg8::u32x4 w; w.x = pg8::cvt_pk_bf16(v0[0], v0[1]); w.y = pg8::cvt_pk_bf16(v0[2], v0[3]); w.z = pg8::cvt_pk_bf16(v1[0], v1[1]); w.w = pg8::cvt_pk_bf16(v1[2], v1[3]);
                    *(pg8::u32x4*)(rowp + bj * 128) = w; } }
    }
};
template <class Epi>
__device__ __forceinline__ void gemm8(unsigned char* lds, const u16* A, const u16* Bt, int M, int N, int K, const Epi& E) {
    pg8::Gemm g{A, Bt, M, N, K}; pg8::StaticOrder So; So.init(M, N, (int)gridDim.x, (int)blockIdx.x);
    pg8::gemm_phase<Epi, pg8::StaticOrder, false>((PG8_LAS unsigned char*)lds, g, So, E, nullptr);
    __syncthreads();
}

#define GLA_QD_BYTES 16384
#define GLA_AT_BYTES 8192
__device__ __forceinline__ float gla_logsigmoid(float z) { return fminf(z, 0.f) - __logf(1.f + __expf(-fabsf(z))); }

__device__ __forceinline__ void gla_prep_item(const u16* __restrict__ P, int ldp, int cq, int ck, const float* __restrict__ gz,
                                              const float* __restrict__ wg_f, const float* __restrict__ bg_f, const float* __restrict__ wg_b, const float* __restrict__ bg_b,
                                              int Sq, unsigned char* __restrict__ QDg, unsigned char* __restrict__ KEg, unsigned char* __restrict__ ATg, float* __restrict__ DECg,
                                              unsigned char* lds, int item) {
    const int nch = Sq / 64;
    const int c = item % nch, dir = (item / nch) & 1, hh = (item / (nch * 2)) & 3, b = item / (nch * 8);
    const int tid = TID, lane = tid & 63, wave = tid >> 6, li = lane & 15, fq = lane >> 4;
    float* gzs = (float*)lds;
    float* segs = gzs + 64 * 16;
    unsigned char* QDs = lds + 8192;
    unsigned char* KIs = QDs + 16384;
    unsigned char* KEs = KIs + 16384;
    float* bmat = (float*)(KEs + 16384);
    const size_t tok0 = (size_t)b * Sq;
    __syncthreads();
    uint4 rq0, rq1, rk0, rk1;
    {
        const int i0 = tid >> 4, i1 = (tid + 512) >> 4, cc = tid & 15;
        const int s0 = dir ? (Sq - 1 - (64 * c + i0)) : (64 * c + i0), s1 = dir ? (Sq - 1 - (64 * c + i1)) : (64 * c + i1);
        rq0 = *(const uint4*)(P + (tok0 + s0) * ldp + cq + hh * 128 + cc * 8); rk0 = *(const uint4*)(P + (tok0 + s0) * ldp + ck + hh * 128 + cc * 8);
        rq1 = *(const uint4*)(P + (tok0 + s1) * ldp + cq + hh * 128 + cc * 8); rk1 = *(const uint4*)(P + (tok0 + s1) * ldp + ck + hh * 128 + cc * 8);
    }
    for (int e = tid; e < 64 * 16; e += 512) {
        const int i = e >> 4, r = e & 15;
        const int s = dir ? (Sq - 1 - (64 * c + i)) : (64 * c + i);
        gzs[e] = gz[(tok0 + s) * 32 + dir * 16 + r];
    }
    const int d = tid & 127, seg = tid >> 7;
    const float* wg = dir ? wg_b : wg_f;
    float wcol[16];
#pragma unroll
    for (int r = 0; r < 16; ++r) wcol[r] = wg[r * 512 + hh * 128 + d];
    const float bias = (dir ? bg_b : bg_f)[hh * 128 + d];
    __syncthreads();
    float run = 0.f;
#pragma unroll
    for (int k = 0; k < 16; ++k) {
        const int i = 16 * seg + k;
        float z = bias;
#pragma unroll
        for (int r = 0; r < 16; ++r) z += gzs[i * 16 + r] * wcol[r];
        run += gla_logsigmoid(z) * (1.f / 16.f);
        bmat[i * 128 + d] = run;
    }
    segs[seg * 128 + d] = run;
    __syncthreads();
    if (seg == 0) {
        const float t0 = segs[d], t1 = segs[128 + d], t2 = segs[256 + d], t3 = segs[384 + d];
        segs[d] = 0.f; segs[128 + d] = t0; segs[256 + d] = t0 + t1; segs[384 + d] = t0 + t1 + t2; segs[512 + d] = t0 + t1 + t2 + t3;
        DECg[(size_t)item * 128 + d] = __expf(t0 + t1 + t2 + t3);
    }
    __syncthreads();
    const float qscale = 0.08838834764831845f;
#pragma unroll
    for (int k = 0; k < 2; ++k) {
        const int id = tid + 512 * k, i = id >> 4, cc = id & 15, d0 = cc * 8, sg = i >> 4;
        const uint4 qv = k ? rq1 : rq0, kv = k ? rk1 : rk0;
        const float qx[8] = {lo2f(qv.x), hi2f(qv.x), lo2f(qv.y), hi2f(qv.y), lo2f(qv.z), hi2f(qv.z), lo2f(qv.w), hi2f(qv.w)};
        const float kx[8] = {lo2f(kv.x), hi2f(kv.x), lo2f(kv.y), hi2f(kv.y), lo2f(kv.z), hi2f(kv.z), lo2f(kv.w), hi2f(kv.w)};
        float qd[8], ki[8], ke[8];
        const float4 bA = *(const float4*)(bmat + i * 128 + d0), bB = *(const float4*)(bmat + i * 128 + d0 + 4);
        const float4 oA = *(const float4*)(segs + sg * 128 + d0), oB = *(const float4*)(segs + sg * 128 + d0 + 4);
        const float4 tA = *(const float4*)(segs + 512 + d0), tB = *(const float4*)(segs + 512 + d0 + 4);
        const float bv[8] = {bA.x + oA.x, bA.y + oA.y, bA.z + oA.z, bA.w + oA.w, bB.x + oB.x, bB.y + oB.y, bB.z + oB.z, bB.w + oB.w};
        const float tv[8] = {tA.x, tA.y, tA.z, tA.w, tB.x, tB.y, tB.z, tB.w};
#pragma unroll
        for (int e = 0; e < 8; ++e) {
            const float bb = bv[e], tot = tv[e];
            qd[e] = qx[e] * qscale * __expf(bb); ki[e] = kx[e] * __expf(-bb); ke[e] = kx[e] * __expf(tot - bb);
        }
        const int o = i * 256 + ((cc ^ (i & 15)) << 4);
        *(uint4*)(QDs + o) = make_uint4(pack2(qd[0], qd[1]), pack2(qd[2], qd[3]), pack2(qd[4], qd[5]), pack2(qd[6], qd[7]));
        *(uint4*)(KIs + o) = make_uint4(pack2(ki[0], ki[1]), pack2(ki[2], ki[3]), pack2(ki[4], ki[5]), pack2(ki[6], ki[7]));
        *(uint4*)(KEs + o) = make_uint4(pack2(ke[0], ke[1]), pack2(ke[2], ke[3]), pack2(ke[4], ke[5]), pack2(ke[6], ke[7]));
    }
    __syncthreads();
    {
        uint4* qo = (uint4*)(QDg + (size_t)item * GLA_QD_BYTES); uint4* ko = (uint4*)(KEg + (size_t)item * GLA_QD_BYTES);
#pragma unroll
        for (int k = 0; k < 2; ++k) { const int e = tid + 512 * k; qo[e] = ((const uint4*)QDs)[e]; ko[e] = ((const uint4*)KEs)[e]; }
    }
#pragma unroll
    for (int tt = 0; tt < 2; ++tt) {
        const int tile = wave + 8 * tt, jt = tile >> 2, it = tile & 3;
        f32x4 acc = (f32x4){0.f, 0.f, 0.f, 0.f};
        if (jt <= it) {
            const int jr = 16 * jt + li, ir = 16 * it + li;
#pragma unroll
            for (int ks = 0; ks < 4; ++ks) {
                const bf16x8 kf = *(const bf16x8*)(KIs + jr * 256 + (((4 * ks + fq) ^ (jr & 15)) << 4));
                const bf16x8 qf = *(const bf16x8*)(QDs + ir * 256 + (((4 * ks + fq) ^ (ir & 15)) << 4));
                acc = __builtin_amdgcn_mfma_f32_16x16x32_bf16(kf, qf, acc, 0, 0, 0);
            }
        }
        const int i = 16 * it + li, j0 = 16 * jt + 4 * fq;
        float v[4];
#pragma unroll
        for (int jj = 0; jj < 4; ++jj) v[jj] = (j0 + jj <= i) ? acc[jj] : 0.f;
        const int chunk = 2 * jt + (fq >> 1), sub = (fq & 1) * 8;
        *(uint2*)(ATg + (size_t)item * GLA_AT_BYTES + i * 128 + ((chunk ^ (i & 7)) << 4) + sub) = make_uint2(pack2(v[0], v[1]), pack2(v[2], v[3]));
    }
}

__device__ __forceinline__ void gla_seq_item(const u16* __restrict__ P, int ldp, int cv, int Sq,
                                             const unsigned char* __restrict__ QDg, const unsigned char* __restrict__ KEg, const unsigned char* __restrict__ ATg, const float* __restrict__ DECg,
                                             u16* __restrict__ Oout  , int Ttot, unsigned char* lds, int item) {
    const int slice = item & 1, dir = (item >> 1) & 1, hh = (item >> 2) & 3, b = item >> 4;
    const int nch = Sq / 64;
    const int tid = TID, lane = tid & 63, wave = tid >> 6, li = lane & 15, fq = lane >> 4;
    const size_t tok0 = (size_t)b * Sq;
    const int pitem0 = ((b * 4 + hh) * 2 + dir) * nch;
    constexpr int BUF = 16384 * 3 + 8192 + 512;
    typedef unsigned gla_u32x4 __attribute__((ext_vector_type(4)));
    gla_u32x4 rq0, rq1, rk0, rk1, rv0, rv1, ra; float rd = 0.f;
#define GLA_VROW(c_, k_) ((tok0 + (size_t)(dir ? (Sq - 1 - (64 * (c_) + ((tid + 512 * (k_)) >> 4))) : (64 * (c_) + ((tid + 512 * (k_)) >> 4)))) * ldp + cv + hh * 256 + slice * 128 + ((tid + 512 * (k_)) & 15) * 8)
#define GLA_ISSUE(c_) do { \
        const gla_u32x4* qsrc_ = (const gla_u32x4*)(QDg + (size_t)(pitem0 + (c_)) * GLA_QD_BYTES); const gla_u32x4* ksrc_ = (const gla_u32x4*)(KEg + (size_t)(pitem0 + (c_)) * GLA_QD_BYTES); \
        rq0 = qsrc_[tid]; rq1 = qsrc_[tid + 512]; rk0 = ksrc_[tid]; rk1 = ksrc_[tid + 512]; \
        ra = ((const gla_u32x4*)(ATg + (size_t)(pitem0 + (c_)) * GLA_AT_BYTES))[tid]; \
        rv0 = *(const gla_u32x4*)(P + GLA_VROW(c_, 0)); rv1 = *(const gla_u32x4*)(P + GLA_VROW(c_, 1)); \
        if (tid < 128) rd = DECg[(size_t)(pitem0 + (c_)) * 128 + tid]; } while (0)
#define GLA_COMMIT(buf_) do { \
        unsigned char* base_ = lds + (buf_) * BUF; \
        ((gla_u32x4*)base_)[tid] = rq0; ((gla_u32x4*)base_)[tid + 512] = rq1; ((gla_u32x4*)(base_ + 16384))[tid] = rk0; ((gla_u32x4*)(base_ + 16384))[tid + 512] = rk1; \
        { const int row_ = tid >> 4, ch_ = tid & 15; *(gla_u32x4*)(base_ + 32768 + row_ * 256 + ((ch_ ^ (row_ & 15)) << 4)) = rv0; } \
        { const int row_ = (tid + 512) >> 4, ch_ = tid & 15; *(gla_u32x4*)(base_ + 32768 + row_ * 256 + ((ch_ ^ (row_ & 15)) << 4)) = rv1; } \
        ((gla_u32x4*)(base_ + 49152))[tid] = ra; \
        if (tid < 128) ((float*)(base_ + 57344))[tid] = rd; } while (0)
    f32x4 st[8];
#pragma unroll
    for (int dt = 0; dt < 8; ++dt) st[dt] = (f32x4){0.f, 0.f, 0.f, 0.f};
    __syncthreads();
    GLA_ISSUE(0); GLA_COMMIT(0);
    __syncthreads();
#pragma unroll 1
    for (int c = 0; c < nch; ++c) {
        const int buf = c & 1;
        if (c + 1 < nch) GLA_ISSUE(c + 1);
        const unsigned char* QDs = lds + buf * BUF; const unsigned char* KEs = QDs + 16384; const unsigned char* Vs = QDs + 32768;
        const unsigned char* ATs = QDs + 49152; const float* DECs = (const float*)(QDs + 57344);
        bf16x8 vf[2];
#pragma unroll
        for (int jp = 0; jp < 2; ++jp) {
            const int rowA = 32 * jp + 8 * fq + (li >> 2), rowB = rowA + 4;
            const int chunk = 2 * wave + ((li & 3) >> 1), sub = ((li & 3) & 1) * 8;
            const s16x4 va = __builtin_amdgcn_ds_read_tr16_b64_v4i16((LAS s16x4*)(Vs + rowA * 256 + ((chunk ^ (rowA & 15)) << 4) + sub));
            const s16x4 vb = __builtin_amdgcn_ds_read_tr16_b64_v4i16((LAS s16x4*)(Vs + rowB * 256 + ((chunk ^ (rowB & 15)) << 4) + sub));
            vf[jp] = __builtin_shufflevector(va, vb, 0, 1, 2, 3, 4, 5, 6, 7);
        }
        bf16x8 sf[4];
#pragma unroll
        for (int dp = 0; dp < 4; ++dp) {
            const gla_u32x4 t_ = {pack2(st[2 * dp][0], st[2 * dp][1]), pack2(st[2 * dp][2], st[2 * dp][3]), pack2(st[2 * dp + 1][0], st[2 * dp + 1][1]), pack2(st[2 * dp + 1][2], st[2 * dp + 1][3])};
            sf[dp] = __builtin_bit_cast(bf16x8, t_);
        }
        f32x4 ot[4];
#pragma unroll
        for (int it = 0; it < 4; ++it) {
            f32x4 acc = (f32x4){0.f, 0.f, 0.f, 0.f};
            const int ir = 16 * it + li;
#pragma unroll
            for (int dp = 0; dp < 4; ++dp) {
                const int c0 = 4 * dp + (fq >> 1), c1 = c0 + 2, sub = (fq & 1) * 8;
                const uint2 lo = *(const uint2*)(QDs + ir * 256 + ((c0 ^ (ir & 15)) << 4) + sub);
                const uint2 hi = *(const uint2*)(QDs + ir * 256 + ((c1 ^ (ir & 15)) << 4) + sub);
                const gla_u32x4 q_ = {lo.x, lo.y, hi.x, hi.y};
                const bf16x8 qf = __builtin_bit_cast(bf16x8, q_);
                acc = __builtin_amdgcn_mfma_f32_16x16x32_bf16(sf[dp], qf, acc, 0, 0, 0);
            }
#pragma unroll
            for (int jp = 0; jp < 2; ++jp) {
                if (32 * jp <= 16 * it + 15) {
                    const bf16x8 af = *(const bf16x8*)(ATs + ir * 128 + (((4 * jp + fq) ^ (ir & 7)) << 4));
                    acc = __builtin_amdgcn_mfma_f32_16x16x32_bf16(vf[jp], af, acc, 0, 0, 0);
                }
            }
            ot[it] = acc;
        }
#pragma unroll
        for (int dt = 0; dt < 8; ++dt) {
            const f32x4 dec = *(const f32x4*)(DECs + 16 * dt + 4 * fq);
            f32x4 acc = st[dt] * dec;
#pragma unroll
            for (int jp = 0; jp < 2; ++jp) {
                const int rowA = 32 * jp + 8 * fq + (li >> 2), rowB = rowA + 4;
                const int chunk = 2 * dt + ((li & 3) >> 1), sub = ((li & 3) & 1) * 8;
                const s16x4 ka = __builtin_amdgcn_ds_read_tr16_b64_v4i16((LAS s16x4*)(KEs + rowA * 256 + ((chunk ^ (rowA & 15)) << 4) + sub));
                const s16x4 kb = __builtin_amdgcn_ds_read_tr16_b64_v4i16((LAS s16x4*)(KEs + rowB * 256 + ((chunk ^ (rowB & 15)) << 4) + sub));
                const bf16x8 kf = __builtin_shufflevector(ka, kb, 0, 1, 2, 3, 4, 5, 6, 7);
                acc = __builtin_amdgcn_mfma_f32_16x16x32_bf16(kf, vf[jp], acc, 0, 0, 0);
            }
            st[dt] = acc;
        }
#pragma unroll
        for (int it = 0; it < 4; ++it) {
            const int i = 16 * it + li;
            const int s = dir ? (Sq - 1 - (64 * c + i)) : (64 * c + i);
            *(uint2*)(Oout + ((size_t)dir * Ttot + tok0 + s) * 1024 + hh * 256 + slice * 128 + 16 * wave + 4 * fq) =
                make_uint2(pack2(ot[it][0], ot[it][1]), pack2(ot[it][2], ot[it][3]));
        }
        if (c + 1 < nch) GLA_COMMIT(buf ^ 1);
        __syncthreads();
    }
}
__device__ __forceinline__ void phase_rope_prep(const Args& a, unsigned char* lds) {
    u16* P = (u16*)(a.ws + WS_P);
    const float2* cs = (const float2*)(a.ws + WS_CS);
    const int gt = blockIdx.x * NTHREADS + threadIdx.x, NT = gridDim.x * NTHREADS;
    for (int item = blockIdx.x; item < GLA_NPREP; item += gridDim.x)
        gla_prep_item(P, NP, C_GQ, C_GK, (const float*)(a.ws + WS_GZ), a.wgf, a.bgf, a.wgb, a.bgb, S,
                      a.ws + WS_QD, a.ws + WS_KE, a.ws + WS_AT, (float*)(a.ws + WS_DEC), lds, item);
}

#define ATTN_DECODE(item_) \
    const int nb_per = Sq / 128; \
    const int within = (item_) % nb_per, hh = ((item_) / nb_per) & 7, b = ((item_) / (nb_per * 8)) & 3, pat = (item_) / (nb_per * 32); \
    const int dil = pat == 0 ? 1 : (pat == 1 ? 4 : 16); \
    const int M = Sq / dil; \
    const int r = within % dil, blk = within / dil; \
    const int p0 = blk * 128, kbase = p0 - 64; \
    const size_t tok0 = (size_t)b * Sq;
typedef unsigned attn_u32x4 __attribute__((ext_vector_type(4)));
__device__ __forceinline__ void attn_phase(const u16* __restrict__ P, int ldp, int cq, int ck, int cv, int Sq,
                                           u16* __restrict__ part_o, float* __restrict__ part_lse, int Ttot,
                                           unsigned char* lds, int first, int stride, int nitems) {
    const int tid = TID, lane = tid & 63, wave = tid >> 6, li = lane & 15, fq = lane >> 4;
    unsigned char* Ks = lds;
    unsigned char* Vs = lds + 65536;
    attn_u32x4 kr0, kr1, kr2, kr3, kr4, kr5, kr6, kr7, vr0, vr1, vr2, vr3, vr4, vr5, vr6, vr7;
    bf16x8 qn0, qn1, qn2, qn3;
#define ATTN_LD1(i_, kreg_, vreg_) { const int id_ = tid + 512 * (i_), row_ = id_ >> 4, c_ = id_ & 15; \
        int kp_ = kbase + row_; kp_ = kp_ < 0 ? 0 : (kp_ > M - 1 ? M - 1 : kp_); \
        const size_t t_ = tok0 + r + (size_t)dil * kp_; \
        kreg_ = *(const attn_u32x4*)(P + t_ * ldp + ck + hh * 128 + c_ * 8); vreg_ = *(const attn_u32x4*)(P + t_ * ldp + cv + hh * 128 + c_ * 8); }
#define ATTN_LOAD(item_) do { ATTN_DECODE(item_) \
        { const size_t tq_ = tok0 + r + (size_t)dil * (p0 + 16 * wave + li); const u16* qp_ = P + tq_ * ldp + cq + hh * 128 + 8 * fq; \
          qn0 = *(const bf16x8*)(qp_); qn1 = *(const bf16x8*)(qp_ + 32); qn2 = *(const bf16x8*)(qp_ + 64); qn3 = *(const bf16x8*)(qp_ + 96); } \
        ATTN_LD1(0, kr0, vr0) ATTN_LD1(1, kr1, vr1) ATTN_LD1(2, kr2, vr2) ATTN_LD1(3, kr3, vr3) ATTN_LD1(4, kr4, vr4) ATTN_LD1(5, kr5, vr5) ATTN_LD1(6, kr6, vr6) ATTN_LD1(7, kr7, vr7) } while (0)
#define ATTN_ST1(i_, kreg_, vreg_) { const int id_ = tid + 512 * (i_), row_ = id_ >> 4, c_ = id_ & 15; const int off_ = row_ * 256 + ((c_ ^ (row_ & 15)) << 4); \
        *(attn_u32x4*)(Ks + off_) = kreg_; *(attn_u32x4*)(Vs + off_) = vreg_; }
#define ATTN_COMMIT() do { ATTN_ST1(0, kr0, vr0) ATTN_ST1(1, kr1, vr1) ATTN_ST1(2, kr2, vr2) ATTN_ST1(3, kr3, vr3) ATTN_ST1(4, kr4, vr4) ATTN_ST1(5, kr5, vr5) ATTN_ST1(6, kr6, vr6) ATTN_ST1(7, kr7, vr7) } while (0)
    int item = first;
    if (item < nitems) ATTN_LOAD(item);
    for (; item < nitems; item += stride) {
        ATTN_DECODE(item)
        __syncthreads();
        ATTN_COMMIT();
        const int qp = p0 + 16 * wave + li;
        const size_t tq = tok0 + r + (size_t)dil * qp;
        const bf16x8 qf[4] = {qn0, qn1, qn2, qn3};
        __syncthreads();
        if (item + stride < nitems) ATTN_LOAD(item + stride);
        const float scale = 0.08838834764831845f;
        float m = -1e30f, l = 0.f;
        f32x4 o[8];
#pragma unroll
        for (int dt = 0; dt < 8; ++dt) o[dt] = (f32x4){0.f, 0.f, 0.f, 0.f};
#pragma unroll 1
        for (int tp = 0; tp < 5; ++tp) {
            float s[8]; bool ok[8];
#pragma unroll
            for (int h2 = 0; h2 < 2; ++h2) {
                const int kk0 = 16 * wave + 16 * (2 * tp + h2);
                int krow = kk0 + li; krow = krow > 255 ? 255 : krow;
                f32x4 acc = (f32x4){0.f, 0.f, 0.f, 0.f};
#pragma unroll
                for (int ks = 0; ks < 4; ++ks) {
                    const bf16x8 kf = *(const bf16x8*)(Ks + krow * 256 + (((4 * ks + fq) ^ (krow & 15)) << 4));
                    acc = __builtin_amdgcn_mfma_f32_16x16x32_bf16(kf, qf[ks], acc, 0, 0, 0);
                }
#pragma unroll
                for (int j = 0; j < 4; ++j) {
                    const int kp = kbase + kk0 + 4 * fq + j;
                    const int rel = kp - qp;
                    ok[4 * h2 + j] = (kp >= 0) && (kp < M) && (rel <= 64) && (rel >= -64);
                    s[4 * h2 + j] = acc[j] * scale;
                }
            }
            float mx = -1e30f;
#pragma unroll
            for (int j = 0; j < 8; ++j) mx = ok[j] ? fmaxf(mx, s[j]) : mx;
            mx = fmaxf(mx, __shfl_xor(mx, 16));
            mx = fmaxf(mx, __shfl_xor(mx, 32));
            const float mn = fmaxf(m, mx);
            const float al = __expf(m - mn);
            float ps = 0.f; float p[8];
#pragma unroll
            for (int j = 0; j < 8; ++j) { p[j] = ok[j] ? __expf(s[j] - mn) : 0.f; ps += p[j]; }
            l = l * al + ps; m = mn;
            const attn_u32x4 p_ = {pack2(p[0], p[1]), pack2(p[2], p[3]), pack2(p[4], p[5]), pack2(p[6], p[7])};
            const bf16x8 pf = __builtin_bit_cast(bf16x8, p_);
#pragma unroll
            for (int dt = 0; dt < 8; ++dt) o[dt] *= al;
            int rowA = 16 * wave + 32 * tp + 4 * fq + (li >> 2); rowA = rowA > 255 ? 255 : rowA;
            int rowB = 16 * wave + 32 * tp + 16 + 4 * fq + (li >> 2); rowB = rowB > 255 ? 255 : rowB;
#pragma unroll
            for (int dt = 0; dt < 8; ++dt) {
                const int chunk = 2 * dt + ((li & 3) >> 1), sub = ((li & 3) & 1) * 8;
                const s16x4 va = __builtin_amdgcn_ds_read_tr16_b64_v4i16((LAS s16x4*)(Vs + rowA * 256 + ((chunk ^ (rowA & 15)) << 4) + sub));
                const s16x4 vb = __builtin_amdgcn_ds_read_tr16_b64_v4i16((LAS s16x4*)(Vs + rowB * 256 + ((chunk ^ (rowB & 15)) << 4) + sub));
                const bf16x8 vf = __builtin_shufflevector(va, vb, 0, 1, 2, 3, 4, 5, 6, 7);
                o[dt] = __builtin_amdgcn_mfma_f32_16x16x32_bf16(vf, pf, o[dt], 0, 0, 0);
            }
        }
        l += __shfl_xor(l, 16);
        l += __shfl_xor(l, 32);
        const float inv = 1.f / l;
        u16* orow = part_o + ((size_t)pat * Ttot + tq) * 1024 + hh * 128 + 4 * fq;
#pragma unroll
        for (int dt = 0; dt < 8; ++dt)
            *(uint2*)(orow + 16 * dt) = make_uint2(pack2(o[dt][0] * inv, o[dt][1] * inv), pack2(o[dt][2] * inv, o[dt][3] * inv));
        if (fq == 0) part_lse[((size_t)pat * Ttot + tq) * 8 + hh] = m + logf(l);
    }
#undef ATTN_LD1
#undef ATTN_LOAD
#undef ATTN_ST1
#undef ATTN_COMMIT
}

__device__ __forceinline__ void attn_merge_token(const u16* __restrict__ part_o, const float* __restrict__ part_lse, int Ttot, size_t t,
                                                 u16* __restrict__ dst  , int lane) {
    const int hh = lane >> 3;
    const float l0 = part_lse[((size_t)0 * Ttot + t) * 8 + hh], l1 = part_lse[((size_t)1 * Ttot + t) * 8 + hh], l2 = part_lse[((size_t)2 * Ttot + t) * 8 + hh];
    const float mx = fmaxf(l0, fmaxf(l1, l2));
    const float e0 = __expf(l0 - mx), e1 = __expf(l1 - mx), e2 = __expf(l2 - mx);
    const float inv = 1.f / (e0 + e1 + e2);
    const float w[3] = {e0 * inv, e1 * inv, e2 * inv};
    float acc[16];
#pragma unroll
    for (int i = 0; i < 16; ++i) acc[i] = 0.f;
#pragma unroll
    for (int p = 0; p < 3; ++p) {
        const uint4* src = (const uint4*)(part_o + ((size_t)p * Ttot + t) * 1024 + lane * 16);
        const uint4 a = src[0], bb = src[1];
        acc[0] += w[p] * lo2f(a.x); acc[1] += w[p] * hi2f(a.x); acc[2] += w[p] * lo2f(a.y); acc[3] += w[p] * hi2f(a.y);
        acc[4] += w[p] * lo2f(a.z); acc[5] += w[p] * hi2f(a.z); acc[6] += w[p] * lo2f(a.w); acc[7] += w[p] * hi2f(a.w);
        acc[8] += w[p] * lo2f(bb.x); acc[9] += w[p] * hi2f(bb.x); acc[10] += w[p] * lo2f(bb.y); acc[11] += w[p] * hi2f(bb.y);
        acc[12] += w[p] * lo2f(bb.z); acc[13] += w[p] * hi2f(bb.z); acc[14] += w[p] * lo2f(bb.w); acc[15] += w[p] * hi2f(bb.w);
    }
    uint4* d = (uint4*)(dst + lane * 16);
    d[0] = make_uint4(pack2(acc[0], acc[1]), pack2(acc[2], acc[3]), pack2(acc[4], acc[5]), pack2(acc[6], acc[7]));
    d[1] = make_uint4(pack2(acc[8], acc[9]), pack2(acc[10], acc[11]), pack2(acc[12], acc[13]), pack2(acc[14], acc[15]));
}

__device__ __forceinline__ void phase_mixers(const Args& a, unsigned char* lds) {
    const int bi = blockIdx.x, G = gridDim.x;
    if (bi < 64) {
        gla_seq_item((const u16*)(a.ws + WS_P), NP, C_GV, S, a.ws + WS_QD, a.ws + WS_KE, a.ws + WS_AT, (const float*)(a.ws + WS_DEC),
                     (u16*)(a.ws + WS_OFB), T, lds, bi);
    } else {
        u16* part_o = (u16*)a.out; float* part_lse = (float*)((unsigned char*)a.out + (size_t)3 * T * 1024 * 2);
        attn_phase((const u16*)(a.ws + WS_P), NP, C_DQ, C_DK, C_DV, S, part_o, part_lse, T, lds, bi - 64, G - 64, 3 * 4 * 8 * (S / 128));
    }
}

__device__ __forceinline__ void phase_gla_fin(const Args& a) {
    const u16* Of = (const u16*)(a.ws + WS_OFB);
    const u16* Ob = Of + (size_t)T * 1024;
    const u16* P = (const u16*)(a.ws + WS_P);
    u16* A2 = (u16*)(a.ws + WS_ACT);
    const u16* part_o = (const u16*)a.out; const float* part_lse = (const float*)((const unsigned char*)a.out + (size_t)3 * T * 1024 * 2);
    const int lane = threadIdx.x & 63, wave = threadIdx.x >> 6;
    const int gw = blockIdx.x * NWAVES + wave, NGW = gridDim.x * NWAVES;
    const int hh = lane >> 4;
    float gg[16];
#pragma unroll
    for (int k = 0; k < 4; ++k) { const float4 g4 = *(const float4*)(a.g_gla + lane * 16 + 4 * k); gg[4 * k] = g4.x; gg[4 * k + 1] = g4.y; gg[4 * k + 2] = g4.z; gg[4 * k + 3] = g4.w; }
    for (int t = gw; t < T; t += NGW) {
        const uint4* fp = (const uint4*)(Of + (size_t)t * 1024 + lane * 16); const uint4* bp = (const uint4*)(Ob + (size_t)t * 1024 + lane * 16);
        const uint4* rp = (const uint4*)(P + (size_t)t * NP + C_GR + lane * 16);
#define NT16(p_) ({ const f32x4 q_ = __builtin_nontemporal_load((const f32x4*)(p_)); make_uint4(__float_as_uint(q_[0]), __float_as_uint(q_[1]), __float_as_uint(q_[2]), __float_as_uint(q_[3])); })
        const uint4 f0 = NT16(fp), f1 = NT16(fp + 1), b0 = NT16(bp), b1 = NT16(bp + 1), r0 = NT16(rp), r1 = NT16(rp + 1);
#undef NT16
        attn_merge_token(part_o, part_lse, T, (size_t)t, A2 + (size_t)t * D + 1024, lane);
        const unsigned fw[8] = {f0.x, f0.y, f0.z, f0.w, f1.x, f1.y, f1.z, f1.w}, bw[8] = {b0.x, b0.y, b0.z, b0.w, b1.x, b1.y, b1.z, b1.w};
        const unsigned rw[8] = {r0.x, r0.y, r0.z, r0.w, r1.x, r1.y, r1.z, r1.w};
        float o[16]; float ss = 0.f;
#pragma unroll
        for (int k = 0; k < 8; ++k) { o[2 * k] = lo2f(fw[k]) + lo2f(bw[k]); o[2 * k + 1] = hi2f(fw[k]) + hi2f(bw[k]); ss += o[2 * k] * o[2 * k] + o[2 * k + 1] * o[2 * k + 1]; }
        ss += __shfl_xor(ss, 1); ss += __shfl_xor(ss, 2); ss += __shfl_xor(ss, 4); ss += __shfl_xor(ss, 8);
        const float rstd = rsqrtf(ss * (1.f / 256.f) + NORM_EPS);
        unsigned y[8];
#pragma unroll
        for (int k = 0; k < 8; ++k) y[k] = pack2(o[2 * k] * rstd * gg[2 * k] * silu_f(lo2f(rw[k])), o[2 * k + 1] * rstd * gg[2 * k + 1] * silu_f(hi2f(rw[k])));
        uint4* dp = (uint4*)(A2 + (size_t)t * D + lane * 16);
        dp[0] = make_uint4(y[0], y[1], y[2], y[3]); dp[1] = make_uint4(y[4], y[5], y[6], y[7]);
    }
    (void)hh;
}

typedef float f32x16 __attribute__((ext_vector_type(16)));
#define RT_CE(a_, b_) do { const float hi_ = fmaxf(a_, b_), lo_ = fminf(a_, b_); a_ = hi_; b_ = lo_; } while (0)
template <int N> __device__ __forceinline__ void rt_sort_desc(float (&v)[N], int base) {
#pragma unroll
    for (int k = 2; k <= 16; k <<= 1)
#pragma unroll
        for (int j = k >> 1; j > 0; j >>= 1)
#pragma unroll
            for (int i = 0; i < 16; ++i) {
                const int l = i ^ j;
                if (l > i) { if ((i & k) == 0) RT_CE(v[base + i], v[base + l]); else RT_CE(v[base + l], v[base + i]); }
            }
}
template <int N> __device__ __forceinline__ void rt_merge_desc(float (&v)[N], int a, int b) {
#pragma unroll
    for (int i = 0; i < 16; ++i) v[a + i] = fmaxf(v[a + i], v[b + 15 - i]);
#pragma unroll
    for (int j = 8; j > 0; j >>= 1)
#pragma unroll
        for (int i = 0; i < 16; ++i) { const int l = i ^ j; if (l > i) RT_CE(v[a + i], v[a + l]); }
}

__device__ __forceinline__ void route_stage_keys(const float* __restrict__ subk, int hh, unsigned char* lds) {
    const int tid = TID;
    __syncthreads();
    for (int e = tid; e < 2 * 128 * 16; e += 512) {
        const int c = e & 15, row = e >> 4;
        const float* src = subk + ((size_t)(hh * 2) * 128 + row) * 128 + c * 8;
        const float4 v0 = *(const float4*)src, v1 = *(const float4*)(src + 4);
        *(uint4*)(lds + row * 256 + ((c ^ (row & 15)) << 4)) = make_uint4(pack2(v0.x, v0.y), pack2(v0.z, v0.w), pack2(v1.x, v1.y), pack2(v1.z, v1.w));
    }
    __syncthreads();
}

__device__ __forceinline__ void route_tile(const u16* __restrict__ Q, int ldq, int hh, int tok_base, const unsigned char* lds,
                                           int* __restrict__ IDX, float* __restrict__ GATE) {
    const int lane = TID & 63, r = lane & 31, h = lane >> 5;
    float sc[128];
    {
        f32x16 X[4], Y[4];
#pragma unroll
        for (int kt = 0; kt < 4; ++kt) {
#pragma unroll
            for (int i = 0; i < 16; ++i) { X[kt][i] = 0.f; Y[kt][i] = 0.f; }
        }
        const u16* qrow = Q + (size_t)(tok_base + r) * ldq + hh * 256;
#pragma unroll
        for (int half = 0; half < 2; ++half) {
            bf16x8 qf[8];
#pragma unroll
            for (int ks = 0; ks < 8; ++ks) qf[ks] = *(const bf16x8*)(qrow + half * 128 + 16 * ks + 8 * h);
#pragma unroll
            for (int kt = 0; kt < 4; ++kt) {
                const int krow = half * 128 + 32 * kt + r;
#pragma unroll
                for (int ks = 0; ks < 8; ++ks) {
                    const bf16x8 kf = *(const bf16x8*)(lds + krow * 256 + (((2 * ks + h) ^ (krow & 15)) << 4));
                    if (half == 0) X[kt] = __builtin_amdgcn_mfma_f32_32x32x16_bf16(kf, qf[ks], X[kt], 0, 0, 0);
                    else Y[kt] = __builtin_amdgcn_mfma_f32_32x32x16_bf16(kf, qf[ks], Y[kt], 0, 0, 0);
                }
            }
        }
#pragma unroll
        for (int kt = 0; kt < 4; ++kt)
#pragma unroll
            for (int i = 0; i < 16; ++i) {
                const auto sw = __builtin_amdgcn_permlane32_swap(__float_as_uint(X[kt][i]), __float_as_uint(Y[kt][i]), false, false);
                const int key0 = 32 * kt + (i & 3) + 8 * (i >> 2);
                sc[kt * 32 + i] = __uint_as_float((sw[0] & 0xffffff80u) | (unsigned)key0);
                sc[kt * 32 + 16 + i] = __uint_as_float((sw[1] & 0xffffff80u) | (unsigned)(key0 + 4));
            }
    }
#pragma unroll
    for (int g = 0; g < 8; ++g) rt_sort_desc(sc, 16 * g);
    rt_merge_desc(sc, 0, 16); rt_merge_desc(sc, 32, 48); rt_merge_desc(sc, 64, 80); rt_merge_desc(sc, 96, 112);
    rt_merge_desc(sc, 0, 32); rt_merge_desc(sc, 64, 96);
    rt_merge_desc(sc, 0, 64);
    float l0[16], l1[16];
#pragma unroll
    for (int i = 0; i < 16; ++i) {
        const auto sw = __builtin_amdgcn_permlane32_swap(__float_as_uint(sc[i]), __float_as_uint(sc[i]), false, false);
        l0[i] = __uint_as_float(sw[0]); l1[i] = __uint_as_float(sw[1]);
    }
    float s0[16], s1[16]; int k0[16], k1[16];
#pragma unroll
    for (int i = 0; i < 16; ++i) {
        const unsigned a = __float_as_uint(l0[i]), b = __float_as_uint(l1[i]);
        s0[i] = __uint_as_float(a & 0xffffff80u); k0[i] = (int)(a & 0x7fu);
        s1[i] = __uint_as_float(b & 0xffffff80u); k1[i] = (int)(b & 0x7fu);
    }
    float cs[64];
    {
        int n = 0;
#pragma unroll
        for (int i = 0; i < 16; ++i)
#pragma unroll
            for (int j = 0; j < 16; ++j)
                if ((i + 1) * (j + 1) <= 16) { cs[n] = s0[i] + s1[j]; ++n; }
#pragma unroll
        for (int q = 50; q < 64; ++q) cs[q] = -3.0e38f;
    }
    float ct[64];
#pragma unroll
    for (int q = 0; q < 64; ++q) ct[q] = cs[q];
#pragma unroll
    for (int g = 0; g < 4; ++g) rt_sort_desc(ct, 16 * g);
    rt_merge_desc(ct, 0, 16); rt_merge_desc(ct, 32, 48); rt_merge_desc(ct, 0, 32);
    const float theta = ct[15], smax = ct[0];
    float den = 0.f;
    {
        int cnt = 0;
#pragma unroll
        for (int q = 0; q < 50; ++q) { const bool sel = (cs[q] >= theta) && (cnt < 16); den += sel ? __expf(cs[q] - smax) : 0.f; cnt += sel ? 1 : 0; }
    }
    const float inv = 1.f / den;
    const size_t obase = (size_t)(tok_base + r) * 128 + hh * 16;
    int pos = 0;
    {
        int n = 0;
#pragma unroll
        for (int i = 0; i < 16; ++i)
#pragma unroll
            for (int j = 0; j < 16; ++j)
                if ((i + 1) * (j + 1) <= 16) {
                    const bool sel = (cs[n] >= theta) && (pos < 16);
                    if (sel) {
                        if (h == 0) IDX[obase + pos] = k0[i] * 128 + k1[j];
                        else GATE[obase + pos] = __expf(cs[n] - smax) * inv;
                        ++pos;
                    }
                    ++n;
                }
    }
}
__device__ __forceinline__ void phase_route(const Args& a, unsigned char* lds) {
    const int hh = BID & 7, grp = BID >> 3, ngrp = GDIM >> 3, wave = TID >> 6;
    route_stage_keys(a.subk, hh, lds);
    int j = 0;
    for (int tile = grp; tile < T / 32; tile += ngrp, ++j)
        if ((j & 7) == wave) route_tile((const u16*)(a.ws + WS_Q), D, hh, tile * 32, lds, (int*)(a.ws + WS_IDX), (float*)(a.ws + WS_GATE));
    __syncthreads();
}

typedef __bf16 bf16x2_t __attribute__((ext_vector_type(2)));
__device__ __forceinline__ float dot2bf(unsigned w, unsigned x, float acc) {
    return __builtin_amdgcn_fdot2_f32_bf16(__builtin_bit_cast(bf16x2_t, w), __builtin_bit_cast(bf16x2_t, x), acc, false);
}
constexpr int TROW = 1024;
typedef float f32x2_t __attribute__((ext_vector_type(2)));
typedef int i32x8 __attribute__((ext_vector_type(8)));
__device__ __forceinline__ void convert_tables(const Args& a) {
    const int lane = threadIdx.x & 63, wave = threadIdx.x >> 6;
    const int gw = blockIdx.x * NWAVES + wave, NGW = gridDim.x * NWAVES;
    for (int row = gw; row < 2 * 16384; row += NGW) {
        const bool isv = row >= 16384; const int e = isv ? row - 16384 : row;
        const f32x4* sp = (const f32x4*)((isv ? a.pv : a.pu) + (size_t)e * D);
        unsigned char* dst = a.ws + (isv ? WS_TV + (size_t)e * 1024 : WS_TU + (size_t)e * 128);
        unsigned char* sdst = a.ws + (isv ? WS_SV + (size_t)e * 64 : WS_SU + (size_t)e * 8);
        f32x4 v[8];
#pragma unroll
        for (int k = 0; k < 8; ++k) v[k] = __builtin_nontemporal_load(sp + lane + 64 * k);
#pragma unroll
        for (int k = 0; k < 8; ++k) {
            float mx = fmaxf(fmaxf(fabsf(v[k][0]), fabsf(v[k][1])), fmaxf(fabsf(v[k][2]), fabsf(v[k][3])));
            mx = fmaxf(mx, __shfl_xor(mx, 1)); mx = fmaxf(mx, __shfl_xor(mx, 2)); mx = fmaxf(mx, __shfl_xor(mx, 4));
            const unsigned bits = __float_as_uint(mx);
            int kx = (int)(bits >> 23) - 127 - 2 + (((bits & 0x7fffffu) > 0x400000u) ? 1 : 0);
            kx = kx < -126 ? -126 : kx;
            const float inv = __uint_as_float((unsigned)(127 - kx) << 23);
            unsigned p = 0u;
            p = __builtin_amdgcn_cvt_scalef32_pk_fp4_f32(p, v[k][0] * inv, v[k][1] * inv, 1.0f, 0);
            p = __builtin_amdgcn_cvt_scalef32_pk_fp4_f32(p, v[k][2] * inv, v[k][3] * inv, 1.0f, 1);
            *(u16*)(dst + (isv ? (size_t)k * 128 : (size_t)k * SLICE_T) + 2 * lane) = (u16)p;
            if ((lane & 7) == 0) {
                const int c = lane >> 3;
                if (isv) sdst[8 * k + c] = (unsigned char)(kx + 127); else sdst[(size_t)k * SLICE_S + 2 * (c & 3) + (c >> 2)] = (unsigned char)(kx + 127);
            }
        }
    }
}

__device__ __forceinline__ void axpy32_fp4(const uint4 w, const float s, float (&acc)[32]) {
    const unsigned ww[4] = {w.x, w.y, w.z, w.w};
#pragma unroll
    for (int k = 0; k < 4; ++k) {
        const f32x2_t a0 = __builtin_amdgcn_cvt_scalef32_pk_f32_fp4(ww[k], 1.0f, 0), a1 = __builtin_amdgcn_cvt_scalef32_pk_f32_fp4(ww[k], 1.0f, 1);
        const f32x2_t a2 = __builtin_amdgcn_cvt_scalef32_pk_f32_fp4(ww[k], 1.0f, 2), a3 = __builtin_amdgcn_cvt_scalef32_pk_f32_fp4(ww[k], 1.0f, 3);
        acc[8 * k + 0] += s * a0.x; acc[8 * k + 1] += s * a0.y; acc[8 * k + 2] += s * a1.x; acc[8 * k + 3] += s * a1.y;
        acc[8 * k + 4] += s * a2.x; acc[8 * k + 5] += s * a2.y; acc[8 * k + 6] += s * a3.x; acc[8 * k + 7] += s * a3.y;
    }
}
#define DPP_F(v_, ctrl_) __builtin_bit_cast(float, __builtin_amdgcn_update_dpp(0, __builtin_bit_cast(int, v_), ctrl_, 0xf, 0xf, true))
__device__ __forceinline__ void phase_eu(const Args& a, unsigned char* lds) {
    const int* IDX = (const int*)(a.ws + WS_IDX);
    u16* AP = (u16*)(a.ws + WS_AP);
    const int lane = threadIdx.x & 63, wave = threadIdx.x >> 6;
    const int x = blockIdx.x & 7, gw = (blockIdx.x >> 3) * NWAVES + wave, NGW = (((int)gridDim.x - x + 7) >> 3) * NWAVES;
    const unsigned char* TUx = a.ws + WS_TU + (size_t)x * SLICE_T;
    const int m = lane & 15, g = lane >> 4;
    typedef unsigned eu_u32x4 __attribute__((ext_vector_type(4)));
    eu_u32x4 rA[8], rB[8]; u16 sA[4], sB[4];
    { const uint4* ssrc = (const uint4*)(a.ws + WS_SU + (size_t)x * SLICE_S);
      for (int i = threadIdx.x; i < (int)(SLICE_S / 16); i += NTHREADS) ((uint4*)lds)[i] = ssrc[i];
      __syncthreads(); }
    i32x8 hB0, hB1, nB0, nB1; int sbt = 127, nkx = 0, ckx = 0;
    int iv0 = 0, iv1 = 0, niv0 = 0, niv1 = 0;
    const int j8 = lane >> 3, c8 = lane & 7;
    LAS unsigned char* ldsl = (LAS unsigned char*)lds;
    LAS unsigned char* stg = ldsl + LDS_MAIN + 16 + wave * 2048;
#define EU_LOAD(r_, s_, ivh_) do { _Pragma("unroll") for (int q = 0; q < 8; ++q) { \
            const int e_ = __shfl(ivh_, 8 * q + j8); \
            r_[q] = *(const eu_u32x4*)(TUx + ((unsigned)e_ * 128u + 16u * (unsigned)(c8 ^ j8))); } \
        _Pragma("unroll") for (int q = 0; q < 4; ++q) { const int e_ = __shfl(ivh_, 16 * q + m); s_[q] = *(const LAS u16*)(ldsl + e_ * 8 + 2 * g); } } while (0)
    const unsigned char* IMG = a.ws + WS_IMG; const int* KXS = (const int*)(a.ws + WS_KXS);
#define EU_BLOAD(t_, B0_, B1_, kx_) do { const eu_u32x4* ip_ = (const eu_u32x4*)(IMG + (((size_t)(t_) * 8 + x) * 8 + 2 * g + (lane & 1)) * 64); \
            const eu_u32x4 q0_ = ip_[0], q1_ = ip_[1], q2_ = ip_[2], q3_ = ip_[3]; \
            B0_ = (i32x8){(int)q0_[0], (int)q0_[1], (int)q0_[2], (int)q0_[3], (int)q1_[0], (int)q1_[1], (int)q1_[2], (int)q1_[3]}; \
            B1_ = (i32x8){(int)q2_[0], (int)q2_[1], (int)q2_[2], (int)q2_[3], (int)q3_[0], (int)q3_[1], (int)q3_[2], (int)q3_[3]}; \
            kx_ = KXS[(size_t)(t_) * 8 + x]; } while (0)
#define EU_COMPUTE(r_, s_, kb_, t_) do { _Pragma("unroll") for (int q = 0; q < 4; ++q) { \
            *(LAS eu_u32x4*)(stg + lane * 16) = r_[2 * q]; *(LAS eu_u32x4*)(stg + 1024 + lane * 16) = r_[2 * q + 1]; \
            const eu_u32x4 f0_ = *(const LAS eu_u32x4*)(stg + m * 128 + 16 * (g ^ (m & 7))), f1_ = *(const LAS eu_u32x4*)(stg + m * 128 + 16 * ((4 + g) ^ (m & 7))); \
            const i32x8 A0_ = {(int)f0_[0], (int)f0_[1], (int)f0_[2], (int)f0_[3], 0, 0, 0, 0}; \
            const i32x8 A1_ = {(int)f1_[0], (int)f1_[1], (int)f1_[2], (int)f1_[3], 0, 0, 0, 0}; \
            f32x4 c_ = {0.f, 0.f, 0.f, 0.f}; \
            c_ = __builtin_amdgcn_mfma_scale_f32_16x16x128_f8f6f4(A0_, hB0, c_, 4, 0, 0, (int)s_[q], 0, sbt); \
            c_ = __builtin_amdgcn_mfma_scale_f32_16x16x128_f8f6f4(A1_, hB1, c_, 4, 0, 1, (int)s_[q], 0, sbt); \
            f32x4 o_; _Pragma("unroll") for (int j = 0; j < 4; ++j) o_[j] = c_[j] + DPP_F(c_[j], 0xB1); \
            if (m == 0) *(uint2*)(AP + ((size_t)(t_) * 8 + x) * 128 + (kb_) + 16 * q + 4 * g) = make_uint2(pack2(o_[0], o_[1]), pack2(o_[2], o_[3])); } } while (0)
#define EU_IDX(t_, i0_, i1_) do { i0_ = IDX[(size_t)(t_) * 128 + lane]; i1_ = IDX[(size_t)(t_) * 128 + 64 + lane]; } while (0)
    if (gw < T) { EU_IDX(gw, iv0, iv1); EU_BLOAD(gw, hB0, hB1, ckx); const int t1 = (gw + NGW < T) ? gw + NGW : gw; EU_IDX(t1, niv0, niv1); EU_LOAD(rA, sA, iv0); sbt = 127 + ckx - ((lane & 1) ? 4 : 0); }
    for (int t = gw; t < T; t += NGW) {
        const int tn = (t + NGW < T) ? t + NGW : t, tnn = (t + 2 * NGW < T) ? t + 2 * NGW : t;
        EU_LOAD(rB, sB, iv1);
        EU_BLOAD(tn, nB0, nB1, nkx);
        int nn0, nn1; EU_IDX(tnn, nn0, nn1);
        EU_COMPUTE(rA, sA, 0, t);
        EU_LOAD(rA, sA, niv0);
        EU_COMPUTE(rB, sB, 64, t);
        hB0 = nB0; hB1 = nB1; sbt = 127 + nkx - ((lane & 1) ? 4 : 0);
        iv0 = niv0; iv1 = niv1; niv0 = nn0; niv1 = nn1;
    }
#undef EU_LOAD
#undef EU_BLOAD
#undef EU_COMPUTE
#undef EU_IDX
}

__device__ __forceinline__ void phase_ev(const Args& a) {
    const u16* X1 = (const u16*)(a.ws + WS_X1);
    const int* IDX = (const int*)(a.ws + WS_IDX);
    const float* GATE = (const float*)(a.ws + WS_GATE);
    const u16* AP = (const u16*)(a.ws + WS_AP);
    const float* mod = (const float*)(a.ws + WS_MOD);
    const unsigned char* V = a.ws + WS_TV;
    const int lane = threadIdx.x & 63, wave = threadIdx.x >> 6;
    const int gw = blockIdx.x * NWAVES + wave, NGW = gridDim.x * NWAVES;
    int iv0 = 0, iv1 = 0; float gv0 = 0.f, gv1 = 0.f;
    int niv0 = 0, niv1 = 0; float ngv0 = 0.f, ngv1 = 0.f;
    uint4 rA[4], rB[4]; u16 sA[4], sB[4];
#define ROW_LOAD(TB_, r_, s_, r0_) do { _Pragma("unroll") for (int q = 0; q < 4; ++q) { \
            const int rr_ = (r0_) + q; const int e_ = __builtin_amdgcn_readlane(rr_ < 64 ? iv0 : iv1, rr_ & 63); \
            const unsigned char* rp_ = TB_ + (size_t)e_ * TROW; \
            const unsigned char* sp_ = a.ws + WS_SV + (size_t)e_ * 64; \
            r_[q] = *(const uint4*)(rp_ + lane * 16); s_[q] = (u16)*(sp_ + lane); } } while (0)
#define TOK_FETCH(t_, i0_, i1_, g0_, g1_, ap_) do { \
            i0_ = IDX[(size_t)(t_) * 128 + lane]; i1_ = IDX[(size_t)(t_) * 128 + 64 + lane]; \
            g0_ = GATE[(size_t)(t_) * 128 + lane]; g1_ = GATE[(size_t)(t_) * 128 + 64 + lane]; \
            _Pragma("unroll") for (int xx = 0; xx < 8; ++xx) { ap_[xx] = AP[((size_t)(t_) * 8 + xx) * 128 + lane]; ap_[8 + xx] = AP[((size_t)(t_) * 8 + xx) * 128 + 64 + lane]; } } while (0)
    u16 ap[16], nap[16];
    if (gw < T) { TOK_FETCH(gw, iv0, iv1, gv0, gv1, ap); ROW_LOAD(V, rA, sA, 0); }
    for (int t = gw; t < T; t += NGW) {
        const int b = t / S;
        const bool has_next = (t + NGW) < T;
        float a0 = 0.f, a1 = 0.f;
#pragma unroll
        for (int xx = 0; xx < 8; ++xx) { a0 += bf2f(ap[xx]); a1 += bf2f(ap[8 + xx]); }
        const float w0 = gv0 * gelu_f(a0), w1 = gv1 * gelu_f(a1);
        float acc[32];
#pragma unroll
        for (int i = 0; i < 32; ++i) acc[i] = 0.f;
#define V_COMPUTE(r_, s_, r0_) do { _Pragma("unroll") for (int q = 0; q < 4; ++q) { const int rr_ = (r0_) + q; \
                const float g_ = __builtin_bit_cast(float, __builtin_amdgcn_readlane(__builtin_bit_cast(int, rr_ < 64 ? w0 : w1), rr_ & 63)); \
                axpy32_fp4(r_[q], g_ * __uint_as_float((unsigned)s_[q] << 23), acc); } } while (0)
        { const int tn = has_next ? t + NGW : t; TOK_FETCH(tn, niv0, niv1, ngv0, ngv1, nap); }
#pragma unroll 1
        for (int r0 = 0; r0 < 128; r0 += 8) {
            ROW_LOAD(V, rB, sB, r0 + 4);
            V_COMPUTE(rA, sA, r0);
            if (r0 + 8 < 128) ROW_LOAD(V, rA, sA, r0 + 8);
            else { iv0 = niv0; iv1 = niv1; gv0 = ngv0; gv1 = ngv1;
                _Pragma("unroll") for (int i = 0; i < 16; ++i) ap[i] = nap[i];
                if (has_next) ROW_LOAD(V, rA, sA, 0); }
            V_COMPUTE(rB, sB, r0 + 4);
        }
#undef V_COMPUTE
        float ss = 0.f;
#pragma unroll
        for (int k = 0; k < 8; ++k) {
            const int c0 = lane * 32 + 4 * k;
            const hw_f32x2 xn = __builtin_nontemporal_load((const hw_f32x2*)(X1 + (size_t)t * D + c0));
            const uint2 xp = make_uint2(__float_as_uint(xn[0]), __float_as_uint(xn[1]));
            const float4 xa = make_float4(lo2f(xp.x), hi2f(xp.x), lo2f(xp.y), hi2f(xp.y));
            const float4 ga = *(const float4*)(mod + b * 12288 + 5 * 2048 + c0);
            acc[4 * k + 0] = xa.x + ga.x * acc[4 * k + 0]; acc[4 * k + 1] = xa.y + ga.y * acc[4 * k + 1];
            acc[4 * k + 2] = xa.z + ga.z * acc[4 * k + 2]; acc[4 * k + 3] = xa.w + ga.w * acc[4 * k + 3];
#pragma unroll
            for (int i = 0; i < 4; ++i) ss += acc[4 * k + i] * acc[4 * k + i];
        }
        ss = wave_sum(ss);
        const float rstd = rsqrtf(ss * (1.f / D) + NORM_EPS);
#pragma unroll
        for (int k = 0; k < 8; ++k) {
            const int c0 = lane * 32 + 4 * k;
            const float4 gf = *(const float4*)(a.g_fin + c0);
            *(float4*)(a.out + (size_t)t * D + c0) = make_float4(acc[4 * k + 0] * rstd * gf.x, acc[4 * k + 1] * rstd * gf.y, acc[4 * k + 2] * rstd * gf.z, acc[4 * k + 3] * rstd * gf.w);
        }
    }
#undef ROW_LOAD
#undef TOK_FETCH
}

#undef DPP_F

#define XB_TMO      128
#define XB_XCNT(j)  (256  + 64 * (j))
#define XB_XSUB(j)  (1280 + 64 * (j))
#define XB_XGEN(j)  (2304 + 64 * (j))
#define XB_TOP      3328
#define XB_TOPGEN   3392
#define XCD_BAR_WORDS 3456
#define XB_SPIN_CAP (1u << 18)

__device__ __forceinline__ unsigned xb_ld(unsigned* p)              { return __hip_atomic_load(p, __ATOMIC_RELAXED, __HIP_MEMORY_SCOPE_AGENT); }
__device__ __forceinline__ unsigned xb_add(unsigned* p, unsigned v) { return __hip_atomic_fetch_add(p, v, __ATOMIC_RELAXED, __HIP_MEMORY_SCOPE_AGENT); }
__device__ __forceinline__ unsigned xb_xcc_id() { return (unsigned)__builtin_amdgcn_s_getreg((3 << 11) | 20) & 0xFu; }
#define XB_SPIN(cond, bar) do { unsigned _sp = 0; while (cond) { __builtin_amdgcn_s_sleep(1); \
    if ((++_sp & 255u) == 0u) { if (xb_ld(&(bar)[XB_TMO])) break; if (_sp > XB_SPIN_CAP) { atomicAdd(&(bar)[XB_TMO], 1u); break; } } } } while (0)

struct XcdBarrier {
    unsigned* bar; unsigned x;
    volatile LAS unsigned* st;
};

__device__ __forceinline__ XcdBarrier xcd_barrier_post(unsigned* bar, volatile LAS unsigned* st) {
    XcdBarrier b; b.bar = bar; b.x = xb_xcc_id(); b.st = st;
    if (threadIdx.x == 0) (void)xb_add(&bar[XB_XCNT(b.x)], 1u);
    return b;
}
__device__ __forceinline__ void xcd_barrier_complete(unsigned* bar, unsigned x, unsigned& nloc, unsigned& nx) {
    const unsigned G = gridDim.x * gridDim.y * gridDim.z;
    unsigned sum, cnt, mine, sp = 0u;
    for (;;) {
        sum = 0u; cnt = 0u; mine = 0u;
#pragma unroll
        for (unsigned j = 0; j < 16; ++j) { const unsigned c = xb_ld(&bar[XB_XCNT(j)]); sum += c; cnt += (c > 0u) ? 1u : 0u; mine = (j == x) ? c : mine; }
        if (sum == G) break;
        __builtin_amdgcn_s_sleep(1);
        if ((++sp & 255u) == 0u) { if (xb_ld(&bar[XB_TMO])) break; if (sp > XB_SPIN_CAP) { atomicAdd(&bar[XB_TMO], 1u); break; } }
    }
    nloc = mine > 0u ? mine : 1u; nx = cnt > 0u ? cnt : 1u;
}

__device__ __forceinline__ void xcd_barrier(const XcdBarrier& b) {
    asm volatile("s_waitcnt vmcnt(0)" ::: "memory");
    __syncthreads();
    if (threadIdx.x == 0) {
        unsigned* bar = b.bar;
        __builtin_amdgcn_s_waitcnt(0);
        unsigned nloc = b.st[0], nx = b.st[1];
        if (nloc == 0u) { xcd_barrier_complete(bar, b.x, nloc, nx); b.st[0] = nloc; b.st[1] = nx; }
        const unsigned old = xb_add(&bar[XB_XSUB(b.x)], 1u);
        const unsigned gen = old / nloc;
        if (old + 1u == (gen + 1u) * nloc) {
            __builtin_amdgcn_fence(__ATOMIC_RELEASE, "agent");
            asm volatile("s_waitcnt vmcnt(0)" ::: "memory");
            const unsigned og = xb_add(&bar[XB_TOP], 1u);
            const unsigned tg = og / nx;
            if (og + 1u == (tg + 1u) * nx) xb_add(&bar[XB_TOPGEN], 1u);
            else XB_SPIN(xb_ld(&bar[XB_TOPGEN]) == tg, bar);
            __builtin_amdgcn_fence(__ATOMIC_ACQUIRE, "agent");
            xb_add(&bar[XB_XGEN(b.x)], 1u);
            asm volatile("s_waitcnt vmcnt(0)" ::: "memory");
        } else {
            XB_SPIN(xb_ld(&bar[XB_XGEN(b.x)]) == gen, bar);
            __builtin_amdgcn_fence(__ATOMIC_ACQUIRE, "agent");
            asm volatile("s_waitcnt vmcnt(0)" ::: "memory");
        }
    }
    __syncthreads();
}

constexpr int NPHASES = 12;
__global__ void __launch_bounds__(NTHREADS, 2) mk_fwd(Args a) {
    extern __shared__ __attribute__((aligned(16))) unsigned char lds[];
    cg::grid_group grid = cg::this_grid();
    const int lo = a.ph_lo, hi = a.ph_hi;
    volatile LAS unsigned* xbw = (volatile LAS unsigned*)(lds + LDS_MAIN);
    if (threadIdx.x < 4) xbw[threadIdx.x] = 0u;
    __syncthreads();
    XcdBarrier xbar = xcd_barrier_post((unsigned*)(a.ws + WS_CTL), xbw);
#define IN(k) (lo <= (k) && (k) < hi)
    if (lo < 0) grid.sync();
#define SEAM(k) do { if (IN(k) && IN((k) + 1)) xcd_barrier(xbar); } while (0)
    const float* mod = (const float*)(a.ws + WS_MOD);
    if (IN(0)) phase0(a, lds);
    SEAM(0);
    if (IN(1)) norm_mod_phase<false>(a.x, a.g_mix, mod, 0, 1, (u16*)(a.ws + WS_ACT));
    SEAM(1);
    if (IN(2)) { gemm8(lds, (const u16*)(a.ws + WS_ACT), (const u16*)(a.ws + WS_WIN), T, NP, D, EpiProj{(u16*)(a.ws + WS_P), (const float*)(a.ws + WS_CS)}); gz_phase(lds, (const u16*)(a.ws + WS_ACT), (const u16*)(a.ws + WS_WIN) + (size_t)NP * D, (float*)(a.ws + WS_GZ)); }
    SEAM(2);
    if (IN(3)) phase_rope_prep(a, lds);
    SEAM(3);
    if (IN(4)) phase_mixers(a, lds);
    SEAM(4);
    if (IN(5)) phase_gla_fin(a);
    SEAM(5);
    if (IN(6)) gemm8(lds, (const u16*)(a.ws + WS_ACT), (const u16*)(a.ws + WS_WOUT), T, D, D, EpiResid{a.x, mod, (u16*)(a.ws + WS_X1)});
    SEAM(6);
    if (IN(7)) { norm_mod_phase<true>(a.ws + WS_X1, a.g_ffn, mod, 3, 4, (u16*)(a.ws + WS_ACT), a.ws + WS_IMG, (int*)(a.ws + WS_KXS)); convert_tables(a); }
    SEAM(7);
    if (IN(8)) gemm8(lds, (const u16*)(a.ws + WS_ACT), (const u16*)(a.ws + WS_WPQ), T, D, D, EpiBf16{(u16*)(a.ws + WS_Q)});
    SEAM(8);
    if (IN(9)) phase_route(a, lds);
    SEAM(9);
    if (IN(10)) phase_eu(a, lds);
    SEAM(10);
    if (IN(11)) phase_ev(a);
#undef IN
#undef SEAM
}

#ifndef MK_ONE_LAUNCH
#define MK_ONE_LAUNCH 1
#endif
extern "C" void kernel_launch(void* const* d_in, const int* in_sizes, int n_in, void* d_out, int out_size, void* d_ws, size_t ws_size, hipStream_t stream) {
    static int grid = 0;
    if (grid == 0) {
        if (n_in != 19 || out_size != T * D || ws_size < WS_END) {
            fprintf(stderr, "kernel_launch: unexpected shapes: n_in %d out %d ws %zu (need %zu)\n", n_in, out_size, ws_size, (size_t)WS_END);
            grid = -1; return;
        }
        int dev = 0, cus = 0, per_cu = 0;
        (void)hipGetDevice(&dev);
        (void)hipDeviceGetAttribute(&cus, hipDeviceAttributeMultiprocessorCount, dev);
        (void)hipFuncSetAttribute((const void*)mk_fwd, hipFuncAttributeMaxDynamicSharedMemorySize, LDS_BYTES);
        (void)hipOccupancyMaxActiveBlocksPerMultiprocessor(&per_cu, (const void*)mk_fwd, NTHREADS, LDS_BYTES);
        if (per_cu < 1) { fprintf(stderr, "kernel_launch: occupancy query says %d blocks/CU\n", per_cu); grid = -1; return; }
        grid = cus;
        (void)hipGetLastError();
    }
    if (grid < 0) return;
    Args a{};
    a.x = (const float*)d_in[0]; a.c = (const float*)d_in[1]; a.pos = (const int*)d_in[2]; a.w_ada = (const float*)d_in[3];
    a.b_ada = (const float*)d_in[4]; a.g_mix = (const float*)d_in[5]; a.w_in = (const float*)d_in[6]; a.wgf = (const float*)d_in[7];
    a.bgf = (const float*)d_in[8]; a.wgb = (const float*)d_in[9]; a.bgb = (const float*)d_in[10]; a.g_gla = (const float*)d_in[11];
    a.w_out = (const float*)d_in[12]; a.g_ffn = (const float*)d_in[13]; a.w_pq = (const float*)d_in[14]; a.subk = (const float*)d_in[15];
    a.pu = (const float*)d_in[16]; a.pv = (const float*)d_in[17]; a.g_fin = (const float*)d_in[18];
    a.out = (float*)d_out; a.ws = (unsigned char*)d_ws;
#if MK_ONE_LAUNCH
    (void)hipMemsetAsync((unsigned char*)d_ws + WS_CTL, 0, XCD_BAR_WORDS * 4, stream);
    a.ph_lo = 0; a.ph_hi = NPHASES;
    void* args[] = {&a};
    hipError_t e = hipLaunchCooperativeKernel((const void*)mk_fwd, dim3(grid), dim3(NTHREADS), args, LDS_BYTES, stream);
    if (e != hipSuccess) fprintf(stderr, "cooperative launch failed: %s (grid %d)\n", hipGetErrorString(e), grid);
#else
    for (int p = 0; p < NPHASES; ++p) {
        a.ph_lo = p; a.ph_hi = p + 1;
        hipLaunchKernelGGL(mk_fwd, dim3(grid), dim3(NTHREADS), LDS_BYTES, stream, a);
    }
#endif
}
```

```cpp
#include <hip/hip_runtime.h>
#include <hip/hip_cooperative_groups.h>
#include <cstdio>
#include <cstdint>

namespace cg = cooperative_groups;

typedef unsigned short u16;
typedef __attribute__((ext_vector_type(8))) short bf16x8;
typedef __attribute__((ext_vector_type(4))) float f32x4;
typedef short s16x4 __attribute__((ext_vector_type(4)));
#define TID ((int)threadIdx.x)
#define BID ((int)blockIdx.x)
#define GDIM ((int)gridDim.x)
#define LAS __attribute__((address_space(3)))

constexpr int D = 2048, NB = 4, S = 4096, T = NB * S;
constexpr int INW = 6176;
constexpr int NP = 6144;
constexpr int NPAD = 6208;
constexpr int C_GQ = 0, C_GK = 512, C_GV = 1024, C_GR = 2048, C_DQ = 3072, C_DK = 4096, C_DV = 5120;
constexpr int NTHREADS = 512, NWAVES = 8;
constexpr int LDS_MAIN = 128 * 1024;
constexpr int LDS_STAGE = 16 * 1024;
constexpr int LDS_BYTES = LDS_MAIN + 16 + LDS_STAGE;
constexpr float NORM_EPS = 1e-6f;

constexpr size_t WS_CTL = 0;
constexpr size_t WS_MOD = 65536;
constexpr size_t WS_CS = 524288;
constexpr size_t WS_WIN = WS_CS + (size_t)T * 64 * 8;
constexpr size_t WS_WOUT = WS_WIN + (size_t)NPAD * D * 2;
constexpr size_t WS_WPQ = WS_WOUT + (size_t)D * D * 2;
constexpr size_t WS_ACT = WS_WPQ + (size_t)D * D * 2;
constexpr size_t WS_P = WS_ACT + (size_t)T * D * 2;
constexpr size_t WS_X1 = WS_P;
constexpr size_t WS_Q = WS_P + (size_t)T * D * 4;
constexpr size_t WS_GZ = WS_P + (size_t)T * NP * 2;
constexpr int GLA_NPREP = NB * 4 * 2 * (S / 64);
constexpr size_t WS_QD = WS_GZ + (size_t)T * 32 * 4;
constexpr size_t WS_KE = WS_QD + (size_t)GLA_NPREP * 16384;
constexpr size_t WS_AT = WS_KE + (size_t)GLA_NPREP * 16384;
constexpr size_t WS_DEC = WS_AT + (size_t)GLA_NPREP * 8192;
constexpr size_t WS_OFB = WS_DEC + (size_t)GLA_NPREP * 512;
constexpr size_t WS_IDX = WS_OFB + (size_t)2 * T * 1024 * 2;
constexpr size_t WS_GATE = WS_IDX + (size_t)T * 128 * 4;
constexpr size_t WS_SS = WS_GATE + (size_t)T * 128 * 4;
constexpr size_t WS_KXS = WS_SS + (size_t)T * 8 * 4;
constexpr size_t WS_END = WS_KXS + (size_t)T * 8 * 4;
constexpr size_t WS_IMG = WS_OFB;
constexpr size_t WS_AP = WS_P + (size_t)T * D * 2;
constexpr size_t SLICE_T = (size_t)16384 * 128, SLICE_S = (size_t)16384 * 8;
constexpr size_t WS_TU = WS_QD;
constexpr size_t WS_TV = WS_TU + (size_t)16384 * 1024;
constexpr size_t WS_SU = WS_TV + (size_t)16384 * 1024;
constexpr size_t WS_SV = WS_SU + (size_t)16384 * 128;
static_assert(WS_SV + (size_t)16384 * 128 <= WS_IDX, "table region");

struct Args {
    const float* x; const float* c; const int* pos; const float* w_ada; const float* b_ada; const float* g_mix;
    const float* w_in; const float* wgf; const float* bgf; const float* wgb; const float* bgb; const float* g_gla;
    const float* w_out; const float* g_ffn; const float* w_pq; const float* subk; const float* pu; const float* pv; const float* g_fin;
    float* out; unsigned char* ws; int ph_lo, ph_hi;
};

__device__ __forceinline__ float bf2f(u16 h) { return __uint_as_float(((unsigned)h) << 16); }
typedef __bf16 hw_bf16x2 __attribute__((ext_vector_type(2)));
typedef float hw_f32x2 __attribute__((ext_vector_type(2)));
typedef unsigned u32x2_t __attribute__((ext_vector_type(2)));
__device__ __forceinline__ unsigned pack2(float a, float b) { const hw_f32x2 f = {a, b}; return __builtin_bit_cast(unsigned, __builtin_convertvector(f, hw_bf16x2)); }
__device__ __forceinline__ u16 f2bf(float f) { return (u16)(pack2(f, 0.f) & 0xffffu); }
__device__ __forceinline__ float lo2f(unsigned p) { return __uint_as_float(p << 16); }
__device__ __forceinline__ float hi2f(unsigned p) { return __uint_as_float(p & 0xffff0000u); }
__device__ __forceinline__ float wave_sum(float v) {
#pragma unroll
    for (int o = 32; o > 0; o >>= 1) v += __shfl_xor(v, o);
    return v;
}
__device__ __forceinline__ float wave_max(float v) {
#pragma unroll
    for (int o = 32; o > 0; o >>= 1) v = fmaxf(v, __shfl_xor(v, o));
    return v;
}
__device__ __forceinline__ float silu_f(float v) { return v / (1.f + __expf(-v)); }
__device__ __forceinline__ float gelu_f(float a) { return 0.5f * a * (1.f + erff(a * 0.70710678118654752f)); }
__device__ __forceinline__ float logsigmoid_f(float z) { return z < 0.f ? z - log1pf(expf(z)) : -log1pf(expf(-z)); }

constexpr int MOD_BLOCKS = 96;
__device__ __forceinline__ void p0_mod(const Args& a, unsigned char* lds, int bi) {
    float* sc = (float*)lds;
    float* red = sc + 4 * 2048;
    const int tid = threadIdx.x, lane = tid & 63, wave = tid >> 6;
    for (int i = tid; i < 4 * 2048; i += NTHREADS) sc[i] = silu_f(a.c[i]);
    __syncthreads();
    const int j0 = bi * 128 + lane * 2;
    float acc[4][2];
#pragma unroll
    for (int b = 0; b < 4; ++b) { acc[b][0] = 0.f; acc[b][1] = 0.f; }
    const int k0 = wave * 256;
#pragma unroll 8
    for (int kk = 0; kk < 256; ++kk) {
        const int k = k0 + kk;
        const hw_f32x2 wv_ = __builtin_nontemporal_load((const hw_f32x2*)(a.w_ada + (size_t)k * 12288 + j0)); const float2 w = make_float2(wv_[0], wv_[1]);
#pragma unroll
        for (int b = 0; b < 4; ++b) { const float s = sc[b * 2048 + k]; acc[b][0] += s * w.x; acc[b][1] += s * w.y; }
    }
#pragma unroll
    for (int b = 0; b < 4; ++b) { red[(wave * 4 + b) * 128 + lane * 2] = acc[b][0]; red[(wave * 4 + b) * 128 + lane * 2 + 1] = acc[b][1]; }
    __syncthreads();
    float* mod = (float*)(a.ws + WS_MOD);
    {
        const int b = tid >> 7, jc = tid & 127;
        float s = 0.f;
#pragma unroll
        for (int w = 0; w < 8; ++w) s += red[(w * 4 + b) * 128 + jc];
        mod[b * 12288 + bi * 128 + jc] = s + a.b_ada[bi * 128 + jc];
    }
    __syncthreads();
}

__device__ __forceinline__ void p0_transpose_item(const float* __restrict__ W, int ldw, int k0, int src_col0, int n_valid,
                                                  u16* __restrict__ WT, int ldt, int n_out0, unsigned char* wlds, bool rope_perm = false) {
    u16* tl = (u16*)wlds;
    const int lane = threadIdx.x & 63;
    const int rsub = lane >> 4, nc = (lane & 15) * 4;
    int scol = src_col0 + nc;
    if (rope_perm) { const int p = (n_out0 & 64) + nc, g = p >> 3; scol = (src_col0 - (n_out0 & 64)) + ((p & 4) ? 64 + 4 * g : 4 * g); }
    float4 v[16];
#pragma unroll
    for (int j = 0; j < 16; ++j) {
        const int k = 4 * j + rsub;
        if (nc < n_valid) { const f32x4 q_ = __builtin_nontemporal_load((const f32x4*)(W + (size_t)(k0 + k) * ldw + scol)); v[j] = make_float4(q_[0], q_[1], q_[2], q_[3]); }
        else v[j] = make_float4(0.f, 0.f, 0.f, 0.f);
    }
#pragma unroll
    for (int j = 0; j < 16; ++j) {
        const int k = 4 * j + rsub;
        tl[(nc + 0) * 72 + k] = f2bf(v[j].x); tl[(nc + 1) * 72 + k] = f2bf(v[j].y); tl[(nc + 2) * 72 + k] = f2bf(v[j].z); tl[(nc + 3) * 72 + k] = f2bf(v[j].w);
    }
#pragma unroll
    for (int j = 0; j < 8; ++j) {
        const int c = lane + 64 * j, n = c >> 3, kc = (c & 7) * 8;
        const uint4 o = *(const uint4*)(tl + n * 72 + kc);
        *(uint4*)(WT + (size_t)(n_out0 + n) * ldt + k0 + kc) = o;
    }
}

__device__ __forceinline__ void phase0(const Args& a, unsigned char* lds) {
    const int bi = blockIdx.x, G = gridDim.x, tid = threadIdx.x, wave = tid >> 6;
    const bool modblk = (G > MOD_BLOCKS) && (bi < MOD_BLOCKS);
    if (G > MOD_BLOCKS) { if (modblk) p0_mod(a, lds, bi); }
    else { for (int mb = bi; mb < MOD_BLOCKS; mb += G) p0_mod(a, lds, mb); }
    const int nb = (G > MOD_BLOCKS) ? G - MOD_BLOCKS : G, b0 = (G > MOD_BLOCKS) ? bi - MOD_BLOCKS : bi;
    if (!modblk) {
        constexpr int I_IN = 32 * (NPAD / 64), I_SQ = 32 * 32;
        u16* WinT = (u16*)(a.ws + WS_WIN); u16* WoutT = (u16*)(a.ws + WS_WOUT); u16* WpqT = (u16*)(a.ws + WS_WPQ);
        unsigned char* wlds = lds + wave * 9216;
        for (int it = b0 * NWAVES + wave; it < I_IN + 2 * I_SQ; it += nb * NWAVES) {
            if (it < I_IN) {
                const int kt = it & 31, nt = it >> 5;
                const int n0 = nt * 64;
                int src, nv;
                if (n0 < 3072) { src = n0; nv = 64; }
                else if (n0 < 6144) { src = n0 + 32; nv = 64; }
                else if (n0 == 6144) { src = 3072; nv = 32; }
                else { src = 0; nv = 0; }
                p0_transpose_item(a.w_in, INW, kt * 64, src, nv, WinT, D, n0, wlds, n0 >= C_DQ && n0 < C_DV);
            } else if (it < I_IN + I_SQ) {
                const int r = it - I_IN; const int kt = r & 31, nt = r >> 5;
                p0_transpose_item(a.w_out, D, kt * 64, nt * 64, 64, WoutT, D, nt * 64, wlds);
            } else {
                const int r = it - I_IN - I_SQ; const int kt = r & 31, nt = r >> 5;
                p0_transpose_item(a.w_pq, D, kt * 64, nt * 64, 64, WpqT, D, nt * 64, wlds);
            }
        }
        float2* cs = (float2*)(a.ws + WS_CS);
        for (int i = b0 * NTHREADS + tid; i < T * 64; i += nb * NTHREADS) {
            const int t = i >> 6, f = i & 63;
            const float inv_freq = powf(10000.0f, -(float)f * 2.0f / 128.0f);
            const float ang = (float)a.pos[t] * inv_freq;
            const double rev = (double)ang * 0.15915494309189533577;
            const float fr = (float)(rev - floor(rev));
            cs[i] = make_float2(__builtin_amdgcn_cosf(fr), __builtin_amdgcn_sinf(fr));
        }
    }
    __syncthreads();
}

template <bool BF16IN> __device__ __forceinline__ void norm_mod_phase(const void* __restrict__ xin_, const float* __restrict__ g, const float* __restrict__ mod,
                                               int sh_chunk, int sc_chunk, u16* __restrict__ outp, unsigned char* __restrict__ img = nullptr, int* __restrict__ kxs = nullptr) {
    const int lane = threadIdx.x & 63, wave = threadIdx.x >> 6;
    const int gw = blockIdx.x * NWAVES + wave, NGW = gridDim.x * NWAVES;
    float4 v[8], vn[8];
#define NM_LOAD(dst_, t_) do { if (BF16IN) { const hw_f32x2* xr_ = (const hw_f32x2*)((const u16*)xin_ + (size_t)(t_) * D); \
            _Pragma("unroll") for (int m = 0; m < 8; ++m) { const hw_f32x2 q_ = __builtin_nontemporal_load(xr_ + lane + 64 * m); const unsigned px_ = __float_as_uint(q_[0]), py_ = __float_as_uint(q_[1]); \
                dst_[m] = make_float4(lo2f(px_), hi2f(px_), lo2f(py_), hi2f(py_)); } } \
        else { const f32x4* xr_ = (const f32x4*)((const float*)xin_ + (size_t)(t_) * D); \
            _Pragma("unroll") for (int m = 0; m < 8; ++m) { const f32x4 q_ = __builtin_nontemporal_load(xr_ + lane + 64 * m); dst_[m] = make_float4(q_[0], q_[1], q_[2], q_[3]); } } } while (0)
    if (gw < T) NM_LOAD(v, gw);
    for (int t = gw; t < T; t += NGW) {
        const int b = t / S;
        if (t + NGW < T) NM_LOAD(vn, t + NGW);
        float ss = 0.f;
#pragma unroll
        for (int m = 0; m < 8; ++m) ss += v[m].x * v[m].x + v[m].y * v[m].y + v[m].z * v[m].z + v[m].w * v[m].w;
        ss = wave_sum(ss);
        const float rstd = rsqrtf(ss * (1.f / D) + NORM_EPS);
        const float4* gp = (const float4*)g;
        const float4* shp = (const float4*)(mod + b * 12288 + sh_chunk * 2048);
        const float4* scp = (const float4*)(mod + b * 12288 + sc_chunk * 2048);
        uint2* op = (uint2*)(outp + (size_t)t * D);
#pragma unroll
        for (int m = 0; m < 8; ++m) {
            const int i = lane + 64 * m;
            const float4 gg = gp[i], sh = shp[i], sc = scp[i];
            const float h0 = v[m].x * rstd * gg.x * (1.f + sc.x) + sh.x;
            const float h1 = v[m].y * rstd * gg.y * (1.f + sc.y) + sh.y;
            const float h2 = v[m].z * rstd * gg.z * (1.f + sc.z) + sh.z;
            const float h3 = v[m].w * rstd * gg.w * (1.f + sc.w) + sh.w;
            const uint2 pk = make_uint2(pack2(h0, h1), pack2(h2, h3));
            op[i] = pk;
            if (BF16IN) {
                const float e0 = lo2f(pk.x), e1 = hi2f(pk.x), e2 = lo2f(pk.y), e3 = hi2f(pk.y);
                float amx = fmaxf(fmaxf(fabsf(e0), fabsf(e1)), fmaxf(fabsf(e2), fabsf(e3)));
#pragma unroll
                for (int o = 32; o > 0; o >>= 1) amx = fmaxf(amx, __shfl_xor(amx, o));
                const unsigned bits = __float_as_uint(amx);
                int kx = (int)(bits >> 23) - 127 - 8 + (((bits & 0x7fffffu) > 0x600000u) ? 1 : 0); kx = kx < -100 ? -100 : kx;
                const float hinv = __uint_as_float((unsigned)(127 - kx) << 23);
                const float x0 = e0 * hinv, x1 = e1 * hinv, x2 = e2 * hinv, x3 = e3 * hinv;
                int w = __builtin_amdgcn_cvt_pk_fp8_f32(x0, x1, 0, false); w = __builtin_amdgcn_cvt_pk_fp8_f32(x2, x3, w, true);
                const hw_f32x2 d0 = __builtin_amdgcn_cvt_pk_f32_fp8(w, false), d1 = __builtin_amdgcn_cvt_pk_f32_fp8(w, true);
                int l = __builtin_amdgcn_cvt_pk_fp8_f32((x0 - d0[0]) * 16.f, (x1 - d0[1]) * 16.f, 0, false);
                l = __builtin_amdgcn_cvt_pk_fp8_f32((x2 - d1[0]) * 16.f, (x3 - d1[1]) * 16.f, l, true);
                const int ei = 4 * lane, s = ei >> 7, k = ei & 127, g = (k & 63) >> 4, bb = (k & 15) + 16 * (k >> 6);
                unsigned char* ip = img + (((size_t)t * 8 + m) * 8 + 2 * g) * 64 + s * 32 + bb;
                *(int*)ip = w; *(int*)(ip + 64) = l;
                if (lane == 0) kxs[(size_t)t * 8 + m] = kx;
            }
        }
#pragma unroll
        for (int m = 0; m < 8; ++m) v[m] = vn[m];
    }
#undef NM_LOAD
}

namespace pg8 {
#define PG8_LAS __attribute__((address_space(3)))
typedef unsigned short bf16_t;
typedef short bf16x8 __attribute__((ext_vector_type(8)));
typedef float f32x4 __attribute__((ext_vector_type(4)));
typedef unsigned u32x4 __attribute__((ext_vector_type(4)));
constexpr int BM = 256, BK = 64, HALF = 128, HTB = HALF * BK * 2  , STAGE_BYTES = 8 * HTB, NXCD = 8, WGM = 8;

__host__ __device__ __forceinline__ int lds_byte(int r, int c) { const int st = (r >> 4) * 2 + (c >> 5), rr = r & 15, cc = c & 31, ob = rr * 64 + cc * 2; return st * 1024 + (ob ^ (((ob >> 9) & 1) << 5)); }
__host__ __device__ __forceinline__ void stage_rc(int b, int& R, int& C) { const int st = b / 1024, sb = b % 1024, swz = sb ^ (((sb >> 9) & 1) << 5); R = (st >> 1) * 16 + swz / 64; C = (st & 1) * 32 + (swz % 64) / 2; }
__host__ __device__ __forceinline__ int perm32(int rho) { const int n = rho >> 4, i = rho & 15; return 8 * (i >> 2) + 4 * n + (i & 3); }

struct Unit { int pm, pn; };
struct Gemm { const bf16_t* A; const bf16_t* Bt; int M, N, K; };

struct StaticOrder {
    int nM, nN, nwg, G, c;
    __host__ __device__ void init(int M, int N, int G_, int c_) { nM = M / BM; nN = N / BM; nwg = nM * nN; G = G_; c = c_; }
    __host__ __device__ bool next(int i, Unit& u) const {
        const long L = (long)i * G + c; if (L >= nwg) return false;
        int wgid = (int)L; { const int q = nwg / NXCD, r = nwg % NXCD, xcd = wgid % NXCD, off = wgid / NXCD; wgid = (xcd < r ? xcd * (q + 1) : r * (q + 1) + (xcd - r) * q) + off; }
        const int nig = WGM * nN, gid = wgid / nig, fm = gid * WGM, gsz = (nM - fm) < WGM ? (nM - fm) : WGM;
        u.pm = fm + ((wgid % nig) % gsz); u.pn = (wgid % nig) / gsz; return true;
    }
    __device__ __forceinline__ void a_ready(const Unit&) const {}
    __device__ __forceinline__ void done(const Unit&) const {}
};
__device__ __forceinline__ unsigned cvt_pk_bf16(float lo, float hi) { unsigned r; asm volatile("v_cvt_pk_bf16_f32 %0, %1, %2" : "=v"(r) : "v"(lo), "v"(hi)); return r; }
typedef float f32x2 __attribute__((ext_vector_type(2)));
template <class Epi, class Sched, bool STAMP = false>
__device__ __forceinline__ void gemm_phase(PG8_LAS unsigned char* lds, const Gemm g, const Sched& S, const Epi& E, unsigned long long* stamps) {
    const int tid = threadIdx.x, wid = __builtin_amdgcn_readfirstlane(tid >> 6), lane = tid & 63, wr = wid >> 2, wc = wid & 3, fr = lane & 15, fq = lane >> 4;
    const int K = g.K, nt = K / BK;
    int ts_lo = 0, ts_hi = 0, nts = 0; const unsigned long long rt_entry = STAMP ? (unsigned long long)wall_clock64() : 0ull;
#define PG8_STAMP() do { if (STAMP && wid == 0 && nts < 64) { const unsigned long long _c = (unsigned long long)clock64(); \
        ts_lo = (lane == nts) ? (int)(unsigned)_c : ts_lo; ts_hi = (lane == nts) ? (int)(unsigned)(_c >> 32) : ts_hi; ++nts; } } while (0)
    PG8_STAMP();
    unsigned voffA[2], voffB[2];
#pragma unroll
    for (int i = 0; i < 2; ++i) { int R, C; stage_rc(tid * 16 + i * 8192, R, C); const int Rb = Epi::PERM ? ((R & ~31) + perm32(R & 31)) : R;
        voffA[i] = (unsigned)(R * K + C) * 2u; voffB[i] = (unsigned)(Rb * K + C) * 2u; }
    const size_t kstep = (size_t)(BK * 2);
    const size_t hstep = (size_t)HALF * K * 2;
    const size_t tstep = 2 * hstep;
    const unsigned ldsw = (unsigned)wid * 1024u;
    const int aoff = lds_byte(wr * 64 + fr, fq * 8), boff = lds_byte(wc * 32 + fr, fq * 8);
#define PG8_SA(b, h) (((b) * 2 + (h)) * HTB)
#define PG8_SB(b, h) ((4 + (b) * 2 + (h)) * HTB)
#define PG8_STAGE(bufoff, gbase, voff) do { _Pragma("unroll") for (int _i = 0; _i < 2; ++_i) \
        __builtin_amdgcn_global_load_lds((const unsigned*)((const char*)(gbase) + (voff)[_i]), (PG8_LAS unsigned*)(lds + (bufoff) + ldsw + _i * 8192), 16, 0, 0); } while (0)
#define PG8_LDA(dst, b, h) do { _Pragma("unroll") for (int m = 0; m < 4; ++m) _Pragma("unroll") for (int k = 0; k < 2; ++k) dst[m][k] = *(const PG8_LAS bf16x8*)(lds + PG8_SA(b, h) + aoff + m * 2048 + k * 1024); } while (0)
#define PG8_LDB(dst, b, h) do { _Pragma("unroll") for (int n = 0; n < 2; ++n) _Pragma("unroll") for (int k = 0; k < 2; ++k) dst[n][k] = *(const PG8_LAS bf16x8*)(lds + PG8_SB(b, h) + boff + n * 2048 + k * 1024); } while (0)
#define PG8_MMA(ai, bj, At, Bt) do { __builtin_amdgcn_s_setprio(1); _Pragma("unroll") for (int m = 0; m < 4; ++m) _Pragma("unroll") for (int n = 0; n < 2; ++n) _Pragma("unroll") for (int k = 0; k < 2; ++k) \
        acc[ai][bj][m][n] = __builtin_amdgcn_mfma_f32_16x16x32_bf16(Bt[n][k], At[m][k], acc[ai][bj][m][n], 0, 0, 0); __builtin_amdgcn_s_setprio(0); } while (0)
#define PG8_WAIT_V(n) asm volatile("s_waitcnt vmcnt(" #n ")" ::: "memory")
#define PG8_WAIT_L(n) asm volatile("s_waitcnt lgkmcnt(" #n ")" ::: "memory")
#define PG8_BAR __builtin_amdgcn_s_barrier()
#define PG8_SCHED __builtin_amdgcn_sched_barrier(0)
    Unit cur, nxt; int ui = 0;
    if (!S.next(0, cur)) return;
    f32x4 acc[2][2][4][2];
#pragma unroll
    for (int a = 0; a < 2; ++a)
#pragma unroll
        for (int b = 0; b < 2; ++b)
#pragma unroll
            for (int m = 0; m < 4; ++m)
#pragma unroll
                for (int n = 0; n < 2; ++n) acc[a][b][m][n] = (f32x4){0.f, 0.f, 0.f, 0.f};
    bf16x8 At[4][2], B0[2][2], B1[2][2];
    const char* cA = (const char*)g.A + (size_t)cur.pm * tstep; const char* cB = (const char*)g.Bt + (size_t)cur.pn * tstep;
    S.a_ready(cur);
    PG8_STAGE(PG8_SB(0, 0), cB, voffB); PG8_STAGE(PG8_SA(0, 0), cA, voffA); PG8_STAGE(PG8_SB(0, 1), cB + hstep, voffB); PG8_STAGE(PG8_SA(0, 1), cA + hstep, voffA);
    if (wr == 1) PG8_BAR;
    PG8_WAIT_V(4); PG8_BAR;
    PG8_STAGE(PG8_SB(1, 0), cB + kstep, voffB); PG8_STAGE(PG8_SA(1, 0), cA + kstep, voffA); PG8_STAGE(PG8_SB(1, 1), cB + hstep + kstep, voffB);
    PG8_WAIT_V(6); PG8_BAR;
    PG8_STAMP();
    for (;;) {
        const bool has_next = S.next(ui + 1, nxt);
        const char* nA = has_next ? (const char*)g.A + (size_t)nxt.pm * tstep : cA; const char* nB = has_next ? (const char*)g.Bt + (size_t)nxt.pn * tstep : cB;
        for (int t = 0; t < nt; t += 2) {
            const bool last = (t == nt - 2);
            const char* a1 = cA + (size_t)(t + 1) * kstep;
            const char* a2 = last ? nA : cA + (size_t)(t + 2) * kstep; const char* b2 = last ? nB : cB + (size_t)(t + 2) * kstep;
            const char* a3 = a2 + kstep; const char* b3 = b2 + kstep;
            if (last && has_next) S.a_ready(nxt);
            PG8_LDB(B0, 0, 0); PG8_SCHED; PG8_LDA(At, 0, 0); PG8_STAGE(PG8_SA(1, 1), a1 + hstep, voffA);
            PG8_WAIT_L(8); PG8_BAR; PG8_WAIT_L(0); PG8_MMA(0, 0, At, B0); PG8_BAR; PG8_SCHED;
            PG8_LDB(B1, 0, 1); PG8_STAGE(PG8_SB(0, 0), b2, voffB);
            PG8_BAR; PG8_WAIT_L(0); PG8_MMA(0, 1, At, B1); PG8_BAR;
            PG8_LDA(At, 0, 1); PG8_STAGE(PG8_SA(0, 0), a2, voffA);
            PG8_BAR; PG8_WAIT_L(0); PG8_MMA(1, 0, At, B0); PG8_BAR; PG8_SCHED;
            PG8_STAGE(PG8_SB(0, 1), b2 + hstep, voffB);
            PG8_WAIT_V(6); PG8_BAR; PG8_MMA(1, 1, At, B1); PG8_BAR;
            PG8_LDB(B0, 1, 0); PG8_SCHED; PG8_LDA(At, 1, 0); PG8_STAGE(PG8_SA(0, 1), a2 + hstep, voffA);
            PG8_WAIT_L(8); PG8_BAR; PG8_WAIT_L(0); PG8_MMA(0, 0, At, B0); PG8_BAR; PG8_SCHED;
            PG8_LDB(B1, 1, 1); PG8_STAGE(PG8_SB(1, 0), b3, voffB);
            PG8_BAR; PG8_WAIT_L(0); PG8_MMA(0, 1, At, B1); PG8_BAR;
            PG8_LDA(At, 1, 1); PG8_STAGE(PG8_SA(1, 0), a3, voffA);
            PG8_BAR; PG8_WAIT_L(0); PG8_MMA(1, 0, At, B0); PG8_BAR; PG8_SCHED;
            PG8_STAGE(PG8_SB(1, 1), b3 + hstep, voffB);
            PG8_WAIT_V(6); PG8_BAR; PG8_MMA(1, 1, At, B1); PG8_BAR;
        }
        PG8_STAMP();
        if constexpr (!Epi::AFTER_DRAIN) { E(acc, cur, wr, wc, fr, fq); S.done(cur); }
        PG8_STAMP();
        if (!has_next) break;
#pragma unroll
        for (int a = 0; a < 2; ++a)
#pragma unroll
            for (int b = 0; b < 2; ++b)
#pragma unroll
                for (int m = 0; m < 4; ++m)
#pragma unroll
                    for (int n = 0; n < 2; ++n) acc[a][b][m][n] = (f32x4){0.f, 0.f, 0.f, 0.f};
        cur = nxt; cA = nA; cB = nB; ++ui;
    }
    PG8_WAIT_V(0);
    if (wr == 0) PG8_BAR;
    PG8_BAR;
    if constexpr (Epi::AFTER_DRAIN) { E.fused(acc, cur, wr, wc, fr, fq, lds, wid, lane); S.done(cur); }
    PG8_STAMP();
    if (STAMP && wid == 0) { stamps[lane] = lane < nts ? (((unsigned long long)(unsigned)ts_hi << 32) | (unsigned)ts_lo) : 0ull;
        if (lane == 62) stamps[62] = rt_entry; if (lane == 63) stamps[63] = (unsigned long long)wall_clock64(); }
#undef PG8_STAMP
#undef PG8_SA
#undef PG8_SB
#undef PG8_STAGE
#undef PG8_LDA
#undef PG8_LDB
#undef PG8_MMA
#undef PG8_WAIT_V
#undef PG8_WAIT_L
#undef PG8_BAR
#undef PG8_SCHED
}
}

struct EpiProj {
    static constexpr bool PERM = true, AFTER_DRAIN = false;
    u16* P; const float* cs;
    __device__ __forceinline__ void operator()(const pg8::f32x4 (&acc)[2][2][4][2], const pg8::Unit& u, int wr, int wc, int fr, int fq) const {
        const int row0 = u.pm * 256 + wr * 64 + fr;
        const int col0 = u.pn * 256 + wc * 32 + 8 * fq;
        const bool rope = (u.pn >= C_DQ / 256) && (u.pn < C_DV / 256);
#pragma unroll
        for (int ai = 0; ai < 2; ++ai)
#pragma unroll
            for (int m = 0; m < 4; ++m) { const int row = row0 + ai * 128 + m * 16; u16* rowp = P + (size_t)row * NP + col0;
                pg8::f32x4 c01 = (pg8::f32x4){1.f, 0.f, 1.f, 0.f}, c23 = c01;
                if (rope) { const pg8::f32x4* cp = (const pg8::f32x4*)(cs + ((size_t)row * 64 + 4 * (4 * wc + fq)) * 2); c01 = cp[0]; c23 = cp[1]; }
#pragma unroll
                for (int bj = 0; bj < 2; ++bj) { pg8::f32x4 v0 = acc[ai][bj][m][0], v1 = acc[ai][bj][m][1];
                    if (rope) {
                        const pg8::f32x4 cc = {c01[0], c01[2], c23[0], c23[2]}, sn = {c01[1], c01[3], c23[1], c23[3]};
                        const pg8::f32x4 y1 = v0 * cc - v1 * sn, y2 = v0 * sn + v1 * cc; v0 = y1; v1 = y2; }
                    pg8::u32x4 w; w.x = pg8::cvt_pk_bf16(v0[0], v0[1]); w.y = pg8::cvt_pk_bf16(v0[2], v0[3]); w.z = pg8::cvt_pk_bf16(v1[0], v1[1]); w.w = pg8::cvt_pk_bf16(v1[2], v1[3]);
                    *(pg8::u32x4*)(rowp + bj * 128) = w; } }
    }
};
__device__ __forceinline__ void gz_phase(unsigned char* lds, const u16* __restrict__ H1, const u16* __restrict__ Wg, float* __restrict__ gz) {
    const int tid = threadIdx.x, lane = tid & 63, wave = tid >> 6, fr = lane & 15, fq = lane >> 4;
    float* red = (float*)lds;
    for (int rb = blockIdx.x; rb < T / 64; rb += gridDim.x) {
        const int r0 = rb * 64, k0 = wave * 256;
        f32x4 acc[4][2];
#pragma unroll
        for (int m = 0; m < 4; ++m) { acc[m][0] = (f32x4){0.f, 0.f, 0.f, 0.f}; acc[m][1] = (f32x4){0.f, 0.f, 0.f, 0.f}; }
#pragma unroll
        for (int ks = 0; ks < 8; ++ks) {
            bf16x8 af[4], bfr[2];
#pragma unroll
            for (int m = 0; m < 4; ++m) af[m] = *(const bf16x8*)(H1 + (size_t)(r0 + 16 * m + fr) * D + k0 + 32 * ks + 8 * fq);
#pragma unroll
            for (int n = 0; n < 2; ++n) bfr[n] = *(const bf16x8*)(Wg + (size_t)(16 * n + fr) * D + k0 + 32 * ks + 8 * fq);
#pragma unroll
            for (int m = 0; m < 4; ++m)
#pragma unroll
                for (int n = 0; n < 2; ++n) acc[m][n] = __builtin_amdgcn_mfma_f32_16x16x32_bf16(af[m], bfr[n], acc[m][n], 0, 0, 0);
        }
        __syncthreads();
#pragma unroll
        for (int m = 0; m < 4; ++m)
#pragma unroll
            for (int n = 0; n < 2; ++n)
#pragma unroll
                for (int j = 0; j < 4; ++j) red[(wave * 64 + 16 * m + 4 * fq + j) * 32 + 16 * n + fr] = acc[m][n][j];
        __syncthreads();
#pragma unroll
        for (int k = 0; k < 4; ++k) {
            const int e = tid + 512 * k;
            float s = 0.f;
#pragma unroll
            for (int w = 0; w < 8; ++w) s += red[w * 2048 + e];
            gz[(size_t)r0 * 32 + e] = s;
        }
    }
    __syncthreads();
}
struct EpiResid {
    static constexpr bool PERM = true, AFTER_DRAIN = false;
    const float* x; const float* mod; u16* x1;
    __device__ __forceinline__ void operator()(const pg8::f32x4 (&acc)[2][2][4][2], const pg8::Unit& u, int wr, int wc, int fr, int fq) const {
        const int row0 = u.pm * 256 + wr * 64 + fr, col0 = u.pn * 256 + wc * 32 + 8 * fq;
        const int b = (u.pm * 256) / S;
        pg8::f32x4 ga[2][2];
#pragma unroll
        for (int bj = 0; bj < 2; ++bj)
#pragma unroll
            for (int n = 0; n < 2; ++n) ga[bj][n] = *(const pg8::f32x4*)(mod + b * 12288 + 2 * 2048 + col0 + bj * 128 + 4 * n);
#pragma unroll
        for (int ai = 0; ai < 2; ++ai)
#pragma unroll
            for (int m = 0; m < 4; ++m) { const size_t off = (size_t)(row0 + ai * 128 + m * 16) * D + col0;
#pragma unroll
                for (int bj = 0; bj < 2; ++bj) {
                    const pg8::f32x4 x0 = __builtin_nontemporal_load((const pg8::f32x4*)(x + off + bj * 128)), x1v = __builtin_nontemporal_load((const pg8::f32x4*)(x + off + bj * 128 + 4));
                    const pg8::f32x4 v0 = x0 + ga[bj][0] * acc[ai][bj][m][0], v1 = x1v + ga[bj][1] * acc[ai][bj][m][1];
                    pg8::u32x4 w; w.x = pg8::cvt_pk_bf16(v0[0], v0[1]); w.y = pg8::cvt_pk_bf16(v0[2], v0[3]); w.z = pg8::cvt_pk_bf16(v1[0], v1[1]); w.w = pg8::cvt_pk_bf16(v1[2], v1[3]);
                    *(pg8::u32x4*)(x1 + off + bj * 128) = w; } }
    }
};
struct EpiBf16 {
    static constexpr bool PERM = true, AFTER_DRAIN = false;
    u16* Q;
    __device__ __forceinline__ void operator()(const pg8::f32x4 (&acc)[2][2][4][2], const pg8::Unit& u, int wr, int wc, int fr, int fq) const {
        const int row0 = u.pm * 256 + wr * 64 + fr, col0 = u.pn * 256 + wc * 32 + 8 * fq;
#pragma unroll
        for (int ai = 0; ai < 2; ++ai)
#pragma unroll
            for (int m = 0; m < 4; ++m) { u16* rowp = Q + (size_t)(row0 + ai * 128 + m * 16) * D + col0;
#pragma unroll
                for (int bj = 0; bj < 2; ++bj) { const pg8::f32x4 v0 = acc[ai][bj][m][0], v1 = acc[ai][bj][m][1];
                    pg8::u32x4 w; w.x = pg8::cvt_pk_bf16(v0[0], v0[1]); w.y = pg8::cvt_pk_bf16(v0[2], v0[3]); w.z = pg8::cvt_pk_bf16(v1[0], v1[1]); w.w = pg8::cvt_pk_bf16(v1[2], v1[3]);
                    *(pg8::u32x4*)(rowp + bj * 128) = w; } }
    }
};
template <class Epi>
__device__ __forceinline__ void gemm8(unsigned char* lds, const u16* A, const u16* Bt, int M, int N, int K, const Epi& E) {
    pg8::Gemm g{A, Bt, M, N, K}; pg8::StaticOrder So; So.init(M, N, (int)gridDim.x, (int)blockIdx.x);
    pg8::gemm_phase<Epi, pg8::StaticOrder, false>((PG8_LAS unsigned char*)lds, g, So, E, nullptr);
    __syncthreads();
}

#define GLA_QD_BYTES 16384
#define GLA_AT_BYTES 8192
__device__ __forceinline__ float gla_logsigmoid(float z) { return fminf(z, 0.f) - __logf(1.f + __expf(-fabsf(z))); }

__device__ __forceinline__ void gla_prep_item(const u16* __restrict__ P, int ldp, int cq, int ck, const float* __restrict__ gz,
                                              const float* __restrict__ wg_f, const float* __restrict__ bg_f, const float* __restrict__ wg_b, const float* __restrict__ bg_b,
                                              int Sq, unsigned char* __restrict__ QDg, unsigned char* __restrict__ KEg, unsigned char* __restrict__ ATg, float* __restrict__ DECg,
                                              unsigned char* lds, int item) {
    const int nch = Sq / 64;
    const int c = item % nch, dir = (item / nch) & 1, hh = (item / (nch * 2)) & 3, b = item / (nch * 8);
    const int tid = TID, lane = tid & 63, wave = tid >> 6, li = lane & 15, fq = lane >> 4;
    float* gzs = (float*)lds;
    float* segs = gzs + 64 * 16;
    unsigned char* QDs = lds + 8192;
    unsigned char* KIs = QDs + 16384;
    unsigned char* KEs = KIs + 16384;
    float* bmat = (float*)(KEs + 16384);
    const size_t tok0 = (size_t)b * Sq;
    __syncthreads();
    uint4 rq0, rq1, rk0, rk1;
    {
        const int i0 = tid >> 4, i1 = (tid + 512) >> 4, cc = tid & 15;
        const int s0 = dir ? (Sq - 1 - (64 * c + i0)) : (64 * c + i0), s1 = dir ? (Sq - 1 - (64 * c + i1)) : (64 * c + i1);
        rq0 = *(const uint4*)(P + (tok0 + s0) * ldp + cq + hh * 128 + cc * 8); rk0 = *(const uint4*)(P + (tok0 + s0) * ldp + ck + hh * 128 + cc * 8);
        rq1 = *(const uint4*)(P + (tok0 + s1) * ldp + cq + hh * 128 + cc * 8); rk1 = *(const uint4*)(P + (tok0 + s1) * ldp + ck + hh * 128 + cc * 8);
    }
    for (int e = tid; e < 64 * 16; e += 512) {
        const int i = e >> 4, r = e & 15;
        const int s = dir ? (Sq - 1 - (64 * c + i)) : (64 * c + i);
        gzs[e] = gz[(tok0 + s) * 32 + dir * 16 + r];
    }
    const int d = tid & 127, seg = tid >> 7;
    const float* wg = dir ? wg_b : wg_f;
    float wcol[16];
#pragma unroll
    for (int r = 0; r < 16; ++r) wcol[r] = wg[r * 512 + hh * 128 + d];
    const float bias = (dir ? bg_b : bg_f)[hh * 128 + d];
    __syncthreads();
    float run = 0.f;
#pragma unroll
    for (int k = 0; k < 16; ++k) {
        const int i = 16 * seg + k;
        float z = bias;
#pragma unroll
        for (int r = 0; r < 16; ++r) z += gzs[i * 16 + r] * wcol[r];
        run += gla_logsigmoid(z) * (1.f / 16.f);
        bmat[i * 128 + d] = run;
    }
    segs[seg * 128 + d] = run;
    __syncthreads();
    if (seg == 0) {
        const float t0 = segs[d], t1 = segs[128 + d], t2 = segs[256 + d], t3 = segs[384 + d];
        segs[d] = 0.f; segs[128 + d] = t0; segs[256 + d] = t0 + t1; segs[384 + d] = t0 + t1 + t2; segs[512 + d] = t0 + t1 + t2 + t3;
        DECg[(size_t)item * 128 + d] = __expf(t0 + t1 + t2 + t3);
    }
    __syncthreads();
    const float qscale = 0.08838834764831845f;
#pragma unroll
    for (int k = 0; k < 2; ++k) {
        const int id = tid + 512 * k, i = id >> 4, cc = id & 15, d0 = cc * 8, sg = i >> 4;
        const uint4 qv = k ? rq1 : rq0, kv = k ? rk1 : rk0;
        const float qx[8] = {lo2f(qv.x), hi2f(qv.x), lo2f(qv.y), hi2f(qv.y), lo2f(qv.z), hi2f(qv.z), lo2f(qv.w), hi2f(qv.w)};
        const float kx[8] = {lo2f(kv.x), hi2f(kv.x), lo2f(kv.y), hi2f(kv.y), lo2f(kv.z), hi2f(kv.z), lo2f(kv.w), hi2f(kv.w)};
        float qd[8], ki[8], ke[8];
        const float4 bA = *(const float4*)(bmat + i * 128 + d0), bB = *(const float4*)(bmat + i * 128 + d0 + 4);
        const float4 oA = *(const float4*)(segs + sg * 128 + d0), oB = *(const float4*)(segs + sg * 128 + d0 + 4);
        const float4 tA = *(const float4*)(segs + 512 + d0), tB = *(const float4*)(segs + 512 + d0 + 4);
        const float bv[8] = {bA.x + oA.x, bA.y + oA.y, bA.z + oA.z, bA.w + oA.w, bB.x + oB.x, bB.y + oB.y, bB.z + oB.z, bB.w + oB.w};
        const float tv[8] = {tA.x, tA.y, tA.z, tA.w, tB.x, tB.y, tB.z, tB.w};
#pragma unroll
        for (int e = 0; e < 8; ++e) {
            const float bb = bv[e], tot = tv[e];
            qd[e] = qx[e] * qscale * __expf(bb); ki[e] = kx[e] * __expf(-bb); ke[e] = kx[e] * __expf(tot - bb);
        }
        const int o = i * 256 + ((cc ^ (i & 15)) << 4);
        *(uint4*)(QDs + o) = make_uint4(pack2(qd[0], qd[1]), pack2(qd[2], qd[3]), pack2(qd[4], qd[5]), pack2(qd[6], qd[7]));
        *(uint4*)(KIs + o) = make_uint4(pack2(ki[0], ki[1]), pack2(ki[2], ki[3]), pack2(ki[4], ki[5]), pack2(ki[6], ki[7]));
        *(uint4*)(KEs + o) = make_uint4(pack2(ke[0], ke[1]), pack2(ke[2], ke[3]), pack2(ke[4], ke[5]), pack2(ke[6], ke[7]));
    }
    __syncthreads();
    {
        uint4* qo = (uint4*)(QDg + (size_t)item * GLA_QD_BYTES); uint4* ko = (uint4*)(KEg + (size_t)item * GLA_QD_BYTES);
#pragma unroll
        for (int k = 0; k < 2; ++k) { const int e = tid + 512 * k; qo[e] = ((const uint4*)QDs)[e]; ko[e] = ((const uint4*)KEs)[e]; }
    }
#pragma unroll
    for (int tt = 0; tt < 2; ++tt) {
        const int tile = wave + 8 * tt, jt = tile >> 2, it = tile & 3;
        f32x4 acc = (f32x4){0.f, 0.f, 0.f, 0.f};
        if (jt <= it) {
            const int jr = 16 * jt + li, ir = 16 * it + li;
#pragma unroll
            for (int ks = 0; ks < 4; ++ks) {
                const bf16x8 kf = *(const bf16x8*)(KIs + jr * 256 + (((4 * ks + fq) ^ (jr & 15)) << 4));
                const bf16x8 qf = *(const bf16x8*)(QDs + ir * 256 + (((4 * ks + fq) ^ (ir & 15)) << 4));
                acc = __builtin_amdgcn_mfma_f32_16x16x32_bf16(kf, qf, acc, 0, 0, 0);
            }
        }
        const int i = 16 * it + li, j0 = 16 * jt + 4 * fq;
        float v[4];
#pragma unroll
        for (int jj = 0; jj < 4; ++jj) v[jj] = (j0 + jj <= i) ? acc[jj] : 0.f;
        const int chunk = 2 * jt + (fq >> 1), sub = (fq & 1) * 8;
        *(uint2*)(ATg + (size_t)item * GLA_AT_BYTES + i * 128 + ((chunk ^ (i & 7)) << 4) + sub) = make_uint2(pack2(v[0], v[1]), pack2(v[2], v[3]));
    }
}

__device__ __forceinline__ void gla_seq_item(const u16* __restrict__ P, int ldp, int cv, int Sq,
                                             const unsigned char* __restrict__ QDg, const unsigned char* __restrict__ KEg, const unsigned char* __restrict__ ATg, const float* __restrict__ DECg,
                                             u16* __restrict__ Oout  , int Ttot, unsigned char* lds, int item) {
    const int slice = item & 1, dir = (item >> 1) & 1, hh = (item >> 2) & 3, b = item >> 4;
    const int nch = Sq / 64;
    const int tid = TID, lane = tid & 63, wave = tid >> 6, li = lane & 15, fq = lane >> 4;
    const size_t tok0 = (size_t)b * Sq;
    const int pitem0 = ((b * 4 + hh) * 2 + dir) * nch;
    constexpr int BUF = 16384 * 3 + 8192 + 512;
    typedef unsigned gla_u32x4 __attribute__((ext_vector_type(4)));
    gla_u32x4 rq0, rq1, rk0, rk1, rv0, rv1, ra; float rd = 0.f;
#define GLA_VROW(c_, k_) ((tok0 + (size_t)(dir ? (Sq - 1 - (64 * (c_) + ((tid + 512 * (k_)) >> 4))) : (64 * (c_) + ((tid + 512 * (k_)) >> 4)))) * ldp + cv + hh * 256 + slice * 128 + ((tid + 512 * (k_)) & 15) * 8)
#define GLA_ISSUE(c_) do { \
        const gla_u32x4* qsrc_ = (const gla_u32x4*)(QDg + (size_t)(pitem0 + (c_)) * GLA_QD_BYTES); const gla_u32x4* ksrc_ = (const gla_u32x4*)(KEg + (size_t)(pitem0 + (c_)) * GLA_QD_BYTES); \
        rq0 = qsrc_[tid]; rq1 = qsrc_[tid + 512]; rk0 = ksrc_[tid]; rk1 = ksrc_[tid + 512]; \
        ra = ((const gla_u32x4*)(ATg + (size_t)(pitem0 + (c_)) * GLA_AT_BYTES))[tid]; \
        rv0 = *(const gla_u32x4*)(P + GLA_VROW(c_, 0)); rv1 = *(const gla_u32x4*)(P + GLA_VROW(c_, 1)); \
        if (tid < 128) rd = DECg[(size_t)(pitem0 + (c_)) * 128 + tid]; } while (0)
#define GLA_COMMIT(buf_) do { \
        unsigned char* base_ = lds + (buf_) * BUF; \
        ((gla_u32x4*)base_)[tid] = rq0; ((gla_u32x4*)base_)[tid + 512] = rq1; ((gla_u32x4*)(base_ + 16384))[tid] = rk0; ((gla_u32x4*)(base_ + 16384))[tid + 512] = rk1; \
        { const int row_ = tid >> 4, ch_ = tid & 15; *(gla_u32x4*)(base_ + 32768 + row_ * 256 + ((ch_ ^ (row_ & 15)) << 4)) = rv0; } \
        { const int row_ = (tid + 512) >> 4, ch_ = tid & 15; *(gla_u32x4*)(base_ + 32768 + row_ * 256 + ((ch_ ^ (row_ & 15)) << 4)) = rv1; } \
        ((gla_u32x4*)(base_ + 49152))[tid] = ra; \
        if (tid < 128) ((float*)(base_ + 57344))[tid] = rd; } while (0)
    f32x4 st[8];
#pragma unroll
    for (int dt = 0; dt < 8; ++dt) st[dt] = (f32x4){0.f, 0.f, 0.f, 0.f};
    __syncthreads();
    GLA_ISSUE(0); GLA_COMMIT(0);
    __syncthreads();
#pragma unroll 1
    for (int c = 0; c < nch; ++c) {
        const int buf = c & 1;
        if (c + 1 < nch) GLA_ISSUE(c + 1);
        const unsigned char* QDs = lds + buf * BUF; const unsigned char* KEs = QDs + 16384; const unsigned char* Vs = QDs + 32768;
        const unsigned char* ATs = QDs + 49152; const float* DECs = (const float*)(QDs + 57344);
        bf16x8 vf[2];
#pragma unroll
        for (int jp = 0; jp < 2; ++jp) {
            const int rowA = 32 * jp + 8 * fq + (li >> 2), rowB = rowA + 4;
            const int chunk = 2 * wave + ((li & 3) >> 1), sub = ((li & 3) & 1) * 8;
            const s16x4 va = __builtin_amdgcn_ds_read_tr16_b64_v4i16((LAS s16x4*)(Vs + rowA * 256 + ((chunk ^ (rowA & 15)) << 4) + sub));
            const s16x4 vb = __builtin_amdgcn_ds_read_tr16_b64_v4i16((LAS s16x4*)(Vs + rowB * 256 + ((chunk ^ (rowB & 15)) << 4) + sub));
            vf[jp] = __builtin_shufflevector(va, vb, 0, 1, 2, 3, 4, 5, 6, 7);
        }
        bf16x8 sf[4];
#pragma unroll
        for (int dp = 0; dp < 4; ++dp) {
            const gla_u32x4 t_ = {pack2(st[2 * dp][0], st[2 * dp][1]), pack2(st[2 * dp][2], st[2 * dp][3]), pack2(st[2 * dp + 1][0], st[2 * dp + 1][1]), pack2(st[2 * dp + 1][2], st[2 * dp + 1][3])};
            sf[dp] = __builtin_bit_cast(bf16x8, t_);
        }
        f32x4 ot[4];
#pragma unroll
        for (int it = 0; it < 4; ++it) {
            f32x4 acc = (f32x4){0.f, 0.f, 0.f, 0.f};
            const int ir = 16 * it + li;
#pragma unroll
            for (int dp = 0; dp < 4; ++dp) {
                const int c0 = 4 * dp + (fq >> 1), c1 = c0 + 2, sub = (fq & 1) * 8;
                const uint2 lo = *(const uint2*)(QDs + ir * 256 + ((c0 ^ (ir & 15)) << 4) + sub);
                const uint2 hi = *(const uint2*)(QDs + ir * 256 + ((c1 ^ (ir & 15)) << 4) + sub);
                const gla_u32x4 q_ = {lo.x, lo.y, hi.x, hi.y};
                const bf16x8 qf = __builtin_bit_cast(bf16x8, q_);
                acc = __builtin_amdgcn_mfma_f32_16x16x32_bf16(sf[dp], qf, acc, 0, 0, 0);
            }
#pragma unroll
            for (int jp = 0; jp < 2; ++jp) {
                if (32 * jp <= 16 * it + 15) {
                    const bf16x8 af = *(const bf16x8*)(ATs + ir * 128 + (((4 * jp + fq) ^ (ir & 7)) << 4));
                    acc = __builtin_amdgcn_mfma_f32_16x16x32_bf16(vf[jp], af, acc, 0, 0, 0);
                }
            }
            ot[it] = acc;
        }
#pragma unroll
        for (int dt = 0; dt < 8; ++dt) {
            const f32x4 dec = *(const f32x4*)(DECs + 16 * dt + 4 * fq);
            f32x4 acc = st[dt] * dec;
#pragma unroll
            for (int jp = 0; jp < 2; ++jp) {
                const int rowA = 32 * jp + 8 * fq + (li >> 2), rowB = rowA + 4;
                const int chunk = 2 * dt + ((li & 3) >> 1), sub = ((li & 3) & 1) * 8;
                const s16x4 ka = __builtin_amdgcn_ds_read_tr16_b64_v4i16((LAS s16x4*)(KEs + rowA * 256 + ((chunk ^ (rowA & 15)) << 4) + sub));
                const s16x4 kb = __builtin_amdgcn_ds_read_tr16_b64_v4i16((LAS s16x4*)(KEs + rowB * 256 + ((chunk ^ (rowB & 15)) << 4) + sub));
                const bf16x8 kf = __builtin_shufflevector(ka, kb, 0, 1, 2, 3, 4, 5, 6, 7);
                acc = __builtin_amdgcn_mfma_f32_16x16x32_bf16(kf, vf[jp], acc, 0, 0, 0);
            }
            st[dt] = acc;
        }
#pragma unroll
        for (int it = 0; it < 4; ++it) {
            const int i = 16 * it + li;
            const int s = dir ? (Sq - 1 - (64 * c + i)) : (64 * c + i);
            *(uint2*)(Oout + ((size_t)dir * Ttot + tok0 + s) * 1024 + hh * 256 + slice * 128 + 16 * wave + 4 * fq) =
                make_uint2(pack2(ot[it][0], ot[it][1]), pack2(ot[it][2], ot[it][3]));
        }
        if (c + 1 < nch) GLA_COMMIT(buf ^ 1);
        __syncthreads();
    }
}
__device__ __forceinline__ void phase_rope_prep(const Args& a, unsigned char* lds) {
    u16* P = (u16*)(a.ws + WS_P);
    const float2* cs = (const float2*)(a.ws + WS_CS);
    const int gt = blockIdx.x * NTHREADS + threadIdx.x, NT = gridDim.x * NTHREADS;
    for (int item = blockIdx.x; item < GLA_NPREP; item += gridDim.x)
        gla_prep_item(P, NP, C_GQ, C_GK, (const float*)(a.ws + WS_GZ), a.wgf, a.bgf, a.wgb, a.bgb, S,
                      a.ws + WS_QD, a.ws + WS_KE, a.ws + WS_AT, (float*)(a.ws + WS_DEC), lds, item);
}

#define ATTN_DECODE(item_) \
    const int nb_per = Sq / 128; \
    const int within = (item_) % nb_per, hh = ((item_) / nb_per) & 7, b = ((item_) / (nb_per * 8)) & 3, pat = (item_) / (nb_per * 32); \
    const int dil = pat == 0 ? 1 : (pat == 1 ? 4 : 16); \
    const int M = Sq / dil; \
    const int r = within % dil, blk = within / dil; \
    const int p0 = blk * 128, kbase = p0 - 64; \
    const size_t tok0 = (size_t)b * Sq;
typedef unsigned attn_u32x4 __attribute__((ext_vector_type(4)));
__device__ __forceinline__ void attn_phase(const u16* __restrict__ P, int ldp, int cq, int ck, int cv, int Sq,
                                           u16* __restrict__ part_o, float* __restrict__ part_lse, int Ttot,
                                           unsigned char* lds, int first, int stride, int nitems) {
    const int tid = TID, lane = tid & 63, wave = tid >> 6, li = lane & 15, fq = lane >> 4;
    unsigned char* Ks = lds;
    unsigned char* Vs = lds + 65536;
    attn_u32x4 kr0, kr1, kr2, kr3, kr4, kr5, kr6, kr7, vr0, vr1, vr2, vr3, vr4, vr5, vr6, vr7;
    bf16x8 qn0, qn1, qn2, qn3;
#define ATTN_LD1(i_, kreg_, vreg_) { const int id_ = tid + 512 * (i_), row_ = id_ >> 4, c_ = id_ & 15; \
        int kp_ = kbase + row_; kp_ = kp_ < 0 ? 0 : (kp_ > M - 1 ? M - 1 : kp_); \
        const size_t t_ = tok0 + r + (size_t)dil * kp_; \
        kreg_ = *(const attn_u32x4*)(P + t_ * ldp + ck + hh * 128 + c_ * 8); vreg_ = *(const attn_u32x4*)(P + t_ * ldp + cv + hh * 128 + c_ * 8); }
#define ATTN_LOAD(item_) do { ATTN_DECODE(item_) \
        { const size_t tq_ = tok0 + r + (size_t)dil * (p0 + 16 * wave + li); const u16* qp_ = P + tq_ * ldp + cq + hh * 128 + 8 * fq; \
          qn0 = *(const bf16x8*)(qp_); qn1 = *(const bf16x8*)(qp_ + 32); qn2 = *(const bf16x8*)(qp_ + 64); qn3 = *(const bf16x8*)(qp_ + 96); } \
        ATTN_LD1(0, kr0, vr0) ATTN_LD1(1, kr1, vr1) ATTN_LD1(2, kr2, vr2) ATTN_LD1(3, kr3, vr3) ATTN_LD1(4, kr4, vr4) ATTN_LD1(5, kr5, vr5) ATTN_LD1(6, kr6, vr6) ATTN_LD1(7, kr7, vr7) } while (0)
#define ATTN_ST1(i_, kreg_, vreg_) { const int id_ = tid + 512 * (i_), row_ = id_ >> 4, c_ = id_ & 15; const int off_ = row_ * 256 + ((c_ ^ (row_ & 15)) << 4); \
        *(attn_u32x4*)(Ks + off_) = kreg_; *(attn_u32x4*)(Vs + off_) = vreg_; }
#define ATTN_COMMIT() do { ATTN_ST1(0, kr0, vr0) ATTN_ST1(1, kr1, vr1) ATTN_ST1(2, kr2, vr2) ATTN_ST1(3, kr3, vr3) ATTN_ST1(4, kr4, vr4) ATTN_ST1(5, kr5, vr5) ATTN_ST1(6, kr6, vr6) ATTN_ST1(7, kr7, vr7) } while (0)
    int item = first;
    if (item < nitems) ATTN_LOAD(item);
    for (; item < nitems; item += stride) {
        ATTN_DECODE(item)
        __syncthreads();
        ATTN_COMMIT();
        const int qp = p0 + 16 * wave + li;
        const size_t tq = tok0 + r + (size_t)dil * qp;
        const bf16x8 qf[4] = {qn0, qn1, qn2, qn3};
        __syncthreads();
        if (item + stride < nitems) ATTN_LOAD(item + stride);
        const float scale = 0.08838834764831845f;
        float m = -1e30f, l = 0.f;
        f32x4 o[8];
#pragma unroll
        for (int dt = 0; dt < 8; ++dt) o[dt] = (f32x4){0.f, 0.f, 0.f, 0.f};
        const bool edge = (blk == 0) || (p0 + 128 >= M);
#define ATTN_SOFTMAX_PV(MASKED_) do { \
            float mx = -1e30f; \
            _Pragma("unroll") for (int j = 0; j < 8; ++j) mx = ((MASKED_) && !ok[j]) ? mx : fmaxf(mx, s[j]); \
            mx = fmaxf(mx, __shfl_xor(mx, 16)); \
            mx = fmaxf(mx, __shfl_xor(mx, 32)); \
            const float mn = fmaxf(m, mx); \
            const float al = __expf(m - mn); \
            float ps = 0.f; float p[8]; \
            _Pragma("unroll") for (int j = 0; j < 8; ++j) { p[j] = ((MASKED_) && !ok[j]) ? 0.f : __expf(s[j] - mn); ps += p[j]; } \
            l = l * al + ps; m = mn; \
            const attn_u32x4 p_ = {pack2(p[0], p[1]), pack2(p[2], p[3]), pack2(p[4], p[5]), pack2(p[6], p[7])}; \
            const bf16x8 pf = __builtin_bit_cast(bf16x8, p_); \
            _Pragma("unroll") for (int dt = 0; dt < 8; ++dt) o[dt] *= al; \
            int rowA = 16 * wave + 32 * tp + 4 * fq + (li >> 2); rowA = rowA > 255 ? 255 : rowA; \
            int rowB = 16 * wave + 32 * tp + 16 + 4 * fq + (li >> 2); rowB = rowB > 255 ? 255 : rowB; \
            _Pragma("unroll") for (int dt = 0; dt < 8; ++dt) { \
                const int chunk = 2 * dt + ((li & 3) >> 1), sub = ((li & 3) & 1) * 8; \
                const s16x4 va = __builtin_amdgcn_ds_read_tr16_b64_v4i16((LAS s16x4*)(Vs + rowA * 256 + ((chunk ^ (rowA & 15)) << 4) + sub)); \
                s16x4 vb = va; \
                if (!lastt) vb = __builtin_amdgcn_ds_read_tr16_b64_v4i16((LAS s16x4*)(Vs + rowB * 256 + ((chunk ^ (rowB & 15)) << 4) + sub)); \
                const bf16x8 vf = __builtin_shufflevector(va, vb, 0, 1, 2, 3, 4, 5, 6, 7); \
                o[dt] = __builtin_amdgcn_mfma_f32_16x16x32_bf16(vf, pf, o[dt], 0, 0, 0); } } while (0)
#define ATTN_QK(tp_, sdst_) do { _Pragma("unroll") for (int h2 = 0; h2 < 2; ++h2) { \
                const int kk0 = 16 * wave + 16 * (2 * (tp_) + h2); \
                int krow = kk0 + li; krow = krow > 255 ? 255 : krow; \
                f32x4 acc = (f32x4){0.f, 0.f, 0.f, 0.f}; \
                if (!((tp_) == 4 && h2 == 1)) {            \
                    _Pragma("unroll") for (int ks = 0; ks < 4; ++ks) { \
                        const bf16x8 kf = *(const bf16x8*)(Ks + krow * 256 + (((4 * ks + fq) ^ (krow & 15)) << 4)); \
                        acc = __builtin_amdgcn_mfma_f32_16x16x32_bf16(kf, qf[ks], acc, 0, 0, 0); } } \
                _Pragma("unroll") for (int j = 0; j < 4; ++j) sdst_[4 * h2 + j] = acc[j] * scale; } } while (0)
        float sn[8];
        ATTN_QK(0, sn);
#pragma unroll 1
        for (int tp = 0; tp < 5; ++tp) {
            const bool lastt = (tp == 4);
            float s[8]; bool ok[8];
#pragma unroll
            for (int j = 0; j < 8; ++j) s[j] = sn[j];
            if (!lastt) ATTN_QK(tp + 1, sn);
            if (edge || tp == 0 || lastt) {
#pragma unroll
                for (int h2 = 0; h2 < 2; ++h2)
#pragma unroll
                    for (int j = 0; j < 4; ++j) {
                        const int kp = kbase + 16 * wave + 16 * (2 * tp + h2) + 4 * fq + j;
                        const int rel = kp - qp;
                        ok[4 * h2 + j] = (kp >= 0) && (kp < M) && (rel <= 64) && (rel >= -64);
                    }
                ATTN_SOFTMAX_PV(1);
            } else {
#pragma unroll
                for (int j = 0; j < 8; ++j) ok[j] = true;
                ATTN_SOFTMAX_PV(0);
            }
        }
#undef ATTN_QK
#undef ATTN_SOFTMAX_PV
        l += __shfl_xor(l, 16);
        l += __shfl_xor(l, 32);
        const float inv = 1.f / l;
        u16* orow = part_o + ((size_t)pat * Ttot + tq) * 1024 + hh * 128 + 4 * fq;
#pragma unroll
        for (int dt = 0; dt < 8; ++dt)
            *(uint2*)(orow + 16 * dt) = make_uint2(pack2(o[dt][0] * inv, o[dt][1] * inv), pack2(o[dt][2] * inv, o[dt][3] * inv));
        if (fq == 0) part_lse[((size_t)pat * Ttot + tq) * 8 + hh] = m + logf(l);
    }
#undef ATTN_LD1
#undef ATTN_LOAD
#undef ATTN_ST1
#undef ATTN_COMMIT
}

__device__ __forceinline__ void attn_merge_token(const u16* __restrict__ part_o, const float* __restrict__ part_lse, int Ttot, size_t t,
                                                 u16* __restrict__ dst  , int lane) {
    const int hh = lane >> 3;
    const float l0 = part_lse[((size_t)0 * Ttot + t) * 8 + hh], l1 = part_lse[((size_t)1 * Ttot + t) * 8 + hh], l2 = part_lse[((size_t)2 * Ttot + t) * 8 + hh];
    const float mx = fmaxf(l0, fmaxf(l1, l2));
    const float e0 = __expf(l0 - mx), e1 = __expf(l1 - mx), e2 = __expf(l2 - mx);
    const float inv = 1.f / (e0 + e1 + e2);
    const float w[3] = {e0 * inv, e1 * inv, e2 * inv};
    float acc[16];
#pragma unroll
    for (int i = 0; i < 16; ++i) acc[i] = 0.f;
#pragma unroll
    for (int p = 0; p < 3; ++p) {
        const uint4* src = (const uint4*)(part_o + ((size_t)p * Ttot + t) * 1024 + lane * 16);
        const uint4 a = src[0], bb = src[1];
        acc[0] += w[p] * lo2f(a.x); acc[1] += w[p] * hi2f(a.x); acc[2] += w[p] * lo2f(a.y); acc[3] += w[p] * hi2f(a.y);
        acc[4] += w[p] * lo2f(a.z); acc[5] += w[p] * hi2f(a.z); acc[6] += w[p] * lo2f(a.w); acc[7] += w[p] * hi2f(a.w);
        acc[8] += w[p] * lo2f(bb.x); acc[9] += w[p] * hi2f(bb.x); acc[10] += w[p] * lo2f(bb.y); acc[11] += w[p] * hi2f(bb.y);
        acc[12] += w[p] * lo2f(bb.z); acc[13] += w[p] * hi2f(bb.z); acc[14] += w[p] * lo2f(bb.w); acc[15] += w[p] * hi2f(bb.w);
    }
    uint4* d = (uint4*)(dst + lane * 16);
    d[0] = make_uint4(pack2(acc[0], acc[1]), pack2(acc[2], acc[3]), pack2(acc[4], acc[5]), pack2(acc[6], acc[7]));
    d[1] = make_uint4(pack2(acc[8], acc[9]), pack2(acc[10], acc[11]), pack2(acc[12], acc[13]), pack2(acc[14], acc[15]));
}

__device__ __forceinline__ void phase_mixers(const Args& a, unsigned char* lds) {
    const int bi = blockIdx.x, G = gridDim.x;
    if (bi < 64) {
        gla_seq_item((const u16*)(a.ws + WS_P), NP, C_GV, S, a.ws + WS_QD, a.ws + WS_KE, a.ws + WS_AT, (const float*)(a.ws + WS_DEC),
                     (u16*)(a.ws + WS_OFB), T, lds, bi);
    } else {
        u16* part_o = (u16*)a.out; float* part_lse = (float*)((unsigned char*)a.out + (size_t)3 * T * 1024 * 2);
        attn_phase((const u16*)(a.ws + WS_P), NP, C_DQ, C_DK, C_DV, S, part_o, part_lse, T, lds, bi - 64, G - 64, 3 * 4 * 8 * (S / 128));
    }
}

__device__ __forceinline__ void phase_gla_fin(const Args& a) {
    const u16* Of = (const u16*)(a.ws + WS_OFB);
    const u16* Ob = Of + (size_t)T * 1024;
    const u16* P = (const u16*)(a.ws + WS_P);
    u16* A2 = (u16*)(a.ws + WS_ACT);
    const u16* part_o = (const u16*)a.out; const float* part_lse = (const float*)((const unsigned char*)a.out + (size_t)3 * T * 1024 * 2);
    const int lane = threadIdx.x & 63, wave = threadIdx.x >> 6;
    const int gw = blockIdx.x * NWAVES + wave, NGW = gridDim.x * NWAVES;
    const int hh = lane >> 4;
    float gg[16];
#pragma unroll
    for (int k = 0; k < 4; ++k) { const float4 g4 = *(const float4*)(a.g_gla + lane * 16 + 4 * k); gg[4 * k] = g4.x; gg[4 * k + 1] = g4.y; gg[4 * k + 2] = g4.z; gg[4 * k + 3] = g4.w; }
    for (int t = gw; t < T; t += NGW) {
        const uint4* fp = (const uint4*)(Of + (size_t)t * 1024 + lane * 16); const uint4* bp = (const uint4*)(Ob + (size_t)t * 1024 + lane * 16);
        const uint4* rp = (const uint4*)(P + (size_t)t * NP + C_GR + lane * 16);
#define NT16(p_) ({ const f32x4 q_ = __builtin_nontemporal_load((const f32x4*)(p_)); make_uint4(__float_as_uint(q_[0]), __float_as_uint(q_[1]), __float_as_uint(q_[2]), __float_as_uint(q_[3])); })
        const uint4 f0 = NT16(fp), f1 = NT16(fp + 1), b0 = NT16(bp), b1 = NT16(bp + 1), r0 = NT16(rp), r1 = NT16(rp + 1);
#undef NT16
        attn_merge_token(part_o, part_lse, T, (size_t)t, A2 + (size_t)t * D + 1024, lane);
        const unsigned fw[8] = {f0.x, f0.y, f0.z, f0.w, f1.x, f1.y, f1.z, f1.w}, bw[8] = {b0.x, b0.y, b0.z, b0.w, b1.x, b1.y, b1.z, b1.w};
        const unsigned rw[8] = {r0.x, r0.y, r0.z, r0.w, r1.x, r1.y, r1.z, r1.w};
        float o[16]; float ss = 0.f;
#pragma unroll
        for (int k = 0; k < 8; ++k) { o[2 * k] = lo2f(fw[k]) + lo2f(bw[k]); o[2 * k + 1] = hi2f(fw[k]) + hi2f(bw[k]); ss += o[2 * k] * o[2 * k] + o[2 * k + 1] * o[2 * k + 1]; }
        ss += __shfl_xor(ss, 1); ss += __shfl_xor(ss, 2); ss += __shfl_xor(ss, 4); ss += __shfl_xor(ss, 8);
        const float rstd = rsqrtf(ss * (1.f / 256.f) + NORM_EPS);
        unsigned y[8];
#pragma unroll
        for (int k = 0; k < 8; ++k) y[k] = pack2(o[2 * k] * rstd * gg[2 * k] * silu_f(lo2f(rw[k])), o[2 * k + 1] * rstd * gg[2 * k + 1] * silu_f(hi2f(rw[k])));
        uint4* dp = (uint4*)(A2 + (size_t)t * D + lane * 16);
        dp[0] = make_uint4(y[0], y[1], y[2], y[3]); dp[1] = make_uint4(y[4], y[5], y[6], y[7]);
    }
    (void)hh;
}

typedef float f32x16 __attribute__((ext_vector_type(16)));
#define RT_CE(a_, b_) do { const float hi_ = fmaxf(a_, b_), lo_ = fminf(a_, b_); a_ = hi_; b_ = lo_; } while (0)
template <int N> __device__ __forceinline__ void rt_sort_desc(float (&v)[N], int base) {
#pragma unroll
    for (int k = 2; k <= 16; k <<= 1)
#pragma unroll
        for (int j = k >> 1; j > 0; j >>= 1)
#pragma unroll
            for (int i = 0; i < 16; ++i) {
                const int l = i ^ j;
                if (l > i) { if ((i & k) == 0) RT_CE(v[base + i], v[base + l]); else RT_CE(v[base + l], v[base + i]); }
            }
}
template <int N> __device__ __forceinline__ void rt_merge_desc(float (&v)[N], int a, int b) {
#pragma unroll
    for (int i = 0; i < 16; ++i) v[a + i] = fmaxf(v[a + i], v[b + 15 - i]);
#pragma unroll
    for (int j = 8; j > 0; j >>= 1)
#pragma unroll
        for (int i = 0; i < 16; ++i) { const int l = i ^ j; if (l > i) RT_CE(v[a + i], v[a + l]); }
}

__device__ __forceinline__ void route_stage_keys(const float* __restrict__ subk, int hh, unsigned char* lds) {
    const int tid = TID;
    __syncthreads();
    for (int e = tid; e < 2 * 128 * 16; e += 512) {
        const int c = e & 15, row = e >> 4;
        const float* src = subk + ((size_t)(hh * 2) * 128 + row) * 128 + c * 8;
        const float4 v0 = *(const float4*)src, v1 = *(const float4*)(src + 4);
        *(uint4*)(lds + row * 256 + ((c ^ (row & 15)) << 4)) = make_uint4(pack2(v0.x, v0.y), pack2(v0.z, v0.w), pack2(v1.x, v1.y), pack2(v1.z, v1.w));
    }
    __syncthreads();
}

__device__ __forceinline__ void route_tile(const u16* __restrict__ Q, int ldq, int hh, int tok_base, const unsigned char* lds,
                                           int* __restrict__ IDX, float* __restrict__ GATE) {
    const int lane = TID & 63, r = lane & 31, h = lane >> 5;
    float sc[128];
    {
        f32x16 X[4], Y[4];
#pragma unroll
        for (int kt = 0; kt < 4; ++kt) {
#pragma unroll
            for (int i = 0; i < 16; ++i) { X[kt][i] = 0.f; Y[kt][i] = 0.f; }
        }
        const u16* qrow = Q + (size_t)(tok_base + r) * ldq + hh * 256;
#pragma unroll
        for (int half = 0; half < 2; ++half) {
            bf16x8 qf[8];
#pragma unroll
            for (int ks = 0; ks < 8; ++ks) qf[ks] = *(const bf16x8*)(qrow + half * 128 + 16 * ks + 8 * h);
#pragma unroll
            for (int kt = 0; kt < 4; ++kt) {
                const int krow = half * 128 + 32 * kt + r;
#pragma unroll
                for (int ks = 0; ks < 8; ++ks) {
                    const bf16x8 kf = *(const bf16x8*)(lds + krow * 256 + (((2 * ks + h) ^ (krow & 15)) << 4));
                    if (half == 0) X[kt] = __builtin_amdgcn_mfma_f32_32x32x16_bf16(kf, qf[ks], X[kt], 0, 0, 0);
                    else Y[kt] = __builtin_amdgcn_mfma_f32_32x32x16_bf16(kf, qf[ks], Y[kt], 0, 0, 0);
                }
            }
        }
#pragma unroll
        for (int kt = 0; kt < 4; ++kt)
#pragma unroll
            for (int i = 0; i < 16; ++i) {
                const auto sw = __builtin_amdgcn_permlane32_swap(__float_as_uint(X[kt][i]), __float_as_uint(Y[kt][i]), false, false);
                const int key0 = 32 * kt + (i & 3) + 8 * (i >> 2);
                sc[kt * 32 + i] = __uint_as_float((sw[0] & 0xffffff80u) | (unsigned)key0);
                sc[kt * 32 + 16 + i] = __uint_as_float((sw[1] & 0xffffff80u) | (unsigned)(key0 + 4));
            }
    }
#pragma unroll
    for (int g = 0; g < 8; ++g) rt_sort_desc(sc, 16 * g);
    rt_merge_desc(sc, 0, 16); rt_merge_desc(sc, 32, 48); rt_merge_desc(sc, 64, 80); rt_merge_desc(sc, 96, 112);
    rt_merge_desc(sc, 0, 32); rt_merge_desc(sc, 64, 96);
    rt_merge_desc(sc, 0, 64);
    float l0[16], l1[16];
#pragma unroll
    for (int i = 0; i < 16; ++i) {
        const auto sw = __builtin_amdgcn_permlane32_swap(__float_as_uint(sc[i]), __float_as_uint(sc[i]), false, false);
        l0[i] = __uint_as_float(sw[0]); l1[i] = __uint_as_float(sw[1]);
    }
    float s0[16], s1[16]; int k0[16], k1[16];
#pragma unroll
    for (int i = 0; i < 16; ++i) {
        const unsigned a = __float_as_uint(l0[i]), b = __float_as_uint(l1[i]);
        s0[i] = __uint_as_float(a & 0xffffff80u); k0[i] = (int)(a & 0x7fu);
        s1[i] = __uint_as_float(b & 0xffffff80u); k1[i] = (int)(b & 0x7fu);
    }
    float cs[64];
    {
        int n = 0;
#pragma unroll
        for (int i = 0; i < 16; ++i)
#pragma unroll
            for (int j = 0; j < 16; ++j)
                if ((i + 1) * (j + 1) <= 16) { cs[n] = s0[i] + s1[j]; ++n; }
#pragma unroll
        for (int q = 50; q < 64; ++q) cs[q] = -3.0e38f;
    }
    float ct[64];
#pragma unroll
    for (int q = 0; q < 64; ++q) ct[q] = cs[q];
#pragma unroll
    for (int g = 0; g < 4; ++g) rt_sort_desc(ct, 16 * g);
    rt_merge_desc(ct, 0, 16); rt_merge_desc(ct, 32, 48); rt_merge_desc(ct, 0, 32);
    const float theta = ct[15], smax = ct[0];
    float den = 0.f;
    {
        int cnt = 0;
#pragma unroll
        for (int q = 0; q < 50; ++q) { const bool sel = (cs[q] >= theta) && (cnt < 16); den += sel ? __expf(cs[q] - smax) : 0.f; cnt += sel ? 1 : 0; }
    }
    const float inv = 1.f / den;
    const size_t obase = (size_t)(tok_base + r) * 128 + hh * 16;
    int pos = 0;
    {
        int n = 0;
#pragma unroll
        for (int i = 0; i < 16; ++i)
#pragma unroll
            for (int j = 0; j < 16; ++j)
                if ((i + 1) * (j + 1) <= 16) {
                    const bool sel = (cs[n] >= theta) && (pos < 16);
                    if (sel) {
                        if (h == 0) IDX[obase + pos] = k0[i] * 128 + k1[j];
                        else GATE[obase + pos] = __expf(cs[n] - smax) * inv;
                        ++pos;
                    }
                    ++n;
                }
    }
}
__device__ __forceinline__ void phase_route(const Args& a, unsigned char* lds) {
    const int hh = BID & 7, grp = BID >> 3, ngrp = GDIM >> 3, wave = TID >> 6;
    route_stage_keys(a.subk, hh, lds);
    int j = 0;
    for (int tile = grp; tile < T / 32; tile += ngrp, ++j)
        if ((j & 7) == wave) route_tile((const u16*)(a.ws + WS_Q), D, hh, tile * 32, lds, (int*)(a.ws + WS_IDX), (float*)(a.ws + WS_GATE));
    __syncthreads();
}

typedef __bf16 bf16x2_t __attribute__((ext_vector_type(2)));
__device__ __forceinline__ float dot2bf(unsigned w, unsigned x, float acc) {
    return __builtin_amdgcn_fdot2_f32_bf16(__builtin_bit_cast(bf16x2_t, w), __builtin_bit_cast(bf16x2_t, x), acc, false);
}
constexpr int TROW = 1024;
typedef float f32x2_t __attribute__((ext_vector_type(2)));
typedef int i32x8 __attribute__((ext_vector_type(8)));
__device__ __forceinline__ void convert_tables(const Args& a) {
    const int lane = threadIdx.x & 63, wave = threadIdx.x >> 6;
    const int gw = blockIdx.x * NWAVES + wave, NGW = gridDim.x * NWAVES;
    for (int row = gw; row < 2 * 16384; row += NGW) {
        const bool isv = row >= 16384; const int e = isv ? row - 16384 : row;
        const f32x4* sp = (const f32x4*)((isv ? a.pv : a.pu) + (size_t)e * D);
        unsigned char* dst = a.ws + (isv ? WS_TV + (size_t)e * 1024 : WS_TU + (size_t)e * 128);
        unsigned char* sdst = a.ws + (isv ? WS_SV + (size_t)e * 64 : WS_SU + (size_t)e * 8);
        f32x4 v[8];
#pragma unroll
        for (int k = 0; k < 8; ++k) v[k] = __builtin_nontemporal_load(sp + lane + 64 * k);
#pragma unroll
        for (int k = 0; k < 8; ++k) {
            float mx = fmaxf(fmaxf(fabsf(v[k][0]), fabsf(v[k][1])), fmaxf(fabsf(v[k][2]), fabsf(v[k][3])));
            mx = fmaxf(mx, __shfl_xor(mx, 1)); mx = fmaxf(mx, __shfl_xor(mx, 2)); mx = fmaxf(mx, __shfl_xor(mx, 4));
            const unsigned bits = __float_as_uint(mx);
            int kx = (int)(bits >> 23) - 127 - 2 + (((bits & 0x7fffffu) > 0x400000u) ? 1 : 0);
            kx = kx < -126 ? -126 : kx;
            const float inv = __uint_as_float((unsigned)(127 - kx) << 23);
            unsigned p = 0u;
            p = __builtin_amdgcn_cvt_scalef32_pk_fp4_f32(p, v[k][0] * inv, v[k][1] * inv, 1.0f, 0);
            p = __builtin_amdgcn_cvt_scalef32_pk_fp4_f32(p, v[k][2] * inv, v[k][3] * inv, 1.0f, 1);
            *(u16*)(dst + (isv ? (size_t)k * 128 : (size_t)k * SLICE_T) + 2 * lane) = (u16)p;
            if ((lane & 7) == 0) {
                const int c = lane >> 3;
                if (isv) sdst[8 * k + c] = (unsigned char)(kx + 127); else sdst[(size_t)k * SLICE_S + 2 * (c & 3) + (c >> 2)] = (unsigned char)(kx + 127);
            }
        }
    }
}

__device__ __forceinline__ void axpy32_fp4(const uint4 w, const float s, float (&acc)[32]) {
    const unsigned ww[4] = {w.x, w.y, w.z, w.w};
#pragma unroll
    for (int k = 0; k < 4; ++k) {
        const f32x2_t a0 = __builtin_amdgcn_cvt_scalef32_pk_f32_fp4(ww[k], 1.0f, 0), a1 = __builtin_amdgcn_cvt_scalef32_pk_f32_fp4(ww[k], 1.0f, 1);
        const f32x2_t a2 = __builtin_amdgcn_cvt_scalef32_pk_f32_fp4(ww[k], 1.0f, 2), a3 = __builtin_amdgcn_cvt_scalef32_pk_f32_fp4(ww[k], 1.0f, 3);
        acc[8 * k + 0] += s * a0.x; acc[8 * k + 1] += s * a0.y; acc[8 * k + 2] += s * a1.x; acc[8 * k + 3] += s * a1.y;
        acc[8 * k + 4] += s * a2.x; acc[8 * k + 5] += s * a2.y; acc[8 * k + 6] += s * a3.x; acc[8 * k + 7] += s * a3.y;
    }
}
#define DPP_F(v_, ctrl_) __builtin_bit_cast(float, __builtin_amdgcn_update_dpp(0, __builtin_bit_cast(int, v_), ctrl_, 0xf, 0xf, true))
__device__ __forceinline__ void phase_eu(const Args& a, unsigned char* lds) {
    const int* IDX = (const int*)(a.ws + WS_IDX);
    u16* AP = (u16*)(a.ws + WS_AP);
    const int lane = threadIdx.x & 63, wave = threadIdx.x >> 6;
    const int x = blockIdx.x & 7, gw = (blockIdx.x >> 3) * NWAVES + wave, NGW = (((int)gridDim.x - x + 7) >> 3) * NWAVES;
    const unsigned char* TUx = a.ws + WS_TU + (size_t)x * SLICE_T;
    const int m = lane & 15, g = lane >> 4;
    typedef unsigned eu_u32x4 __attribute__((ext_vector_type(4)));
    eu_u32x4 rA[8], rB[8]; u16 sA[4], sB[4];
    { const uint4* ssrc = (const uint4*)(a.ws + WS_SU + (size_t)x * SLICE_S);
      for (int i = threadIdx.x; i < (int)(SLICE_S / 16); i += NTHREADS) ((uint4*)lds)[i] = ssrc[i];
      __syncthreads(); }
    i32x8 hB0, hB1, nB0, nB1; int sbt = 127, nkx = 0, ckx = 0;
    int iv0 = 0, iv1 = 0, niv0 = 0, niv1 = 0;
    const int j8 = lane >> 3, c8 = lane & 7;
    LAS unsigned char* ldsl = (LAS unsigned char*)lds;
    LAS unsigned char* stg = ldsl + LDS_MAIN + 16 + wave * 2048;
#define EU_LOAD(r_, s_, ivh_) do { _Pragma("unroll") for (int q = 0; q < 8; ++q) { \
            const int e_ = __shfl(ivh_, 8 * q + j8); \
            r_[q] = *(const eu_u32x4*)(TUx + ((unsigned)e_ * 128u + 16u * (unsigned)(c8 ^ j8))); } \
        _Pragma("unroll") for (int q = 0; q < 4; ++q) { const int e_ = __shfl(ivh_, 16 * q + m); s_[q] = *(const LAS u16*)(ldsl + e_ * 8 + 2 * g); } } while (0)
    const unsigned char* IMG = a.ws + WS_IMG; const int* KXS = (const int*)(a.ws + WS_KXS);
#define EU_BLOAD(t_, B0_, B1_, kx_) do { const eu_u32x4* ip_ = (const eu_u32x4*)(IMG + (((size_t)(t_) * 8 + x) * 8 + 2 * g + (lane & 1)) * 64); \
            const eu_u32x4 q0_ = ip_[0], q1_ = ip_[1], q2_ = ip_[2], q3_ = ip_[3]; \
            B0_ = (i32x8){(int)q0_[0], (int)q0_[1], (int)q0_[2], (int)q0_[3], (int)q1_[0], (int)q1_[1], (int)q1_[2], (int)q1_[3]}; \
            B1_ = (i32x8){(int)q2_[0], (int)q2_[1], (int)q2_[2], (int)q2_[3], (int)q3_[0], (int)q3_[1], (int)q3_[2], (int)q3_[3]}; \
            kx_ = KXS[(size_t)(t_) * 8 + x]; } while (0)
#define EU_COMPUTE(r_, s_, kb_, t_) do { _Pragma("unroll") for (int q = 0; q < 4; ++q) { \
            *(LAS eu_u32x4*)(stg + lane * 16) = r_[2 * q]; *(LAS eu_u32x4*)(stg + 1024 + lane * 16) = r_[2 * q + 1]; \
            const eu_u32x4 f0_ = *(const LAS eu_u32x4*)(stg + m * 128 + 16 * (g ^ (m & 7))), f1_ = *(const LAS eu_u32x4*)(stg + m * 128 + 16 * ((4 + g) ^ (m & 7))); \
            const i32x8 A0_ = {(int)f0_[0], (int)f0_[1], (int)f0_[2], (int)f0_[3], 0, 0, 0, 0}; \
            const i32x8 A1_ = {(int)f1_[0], (int)f1_[1], (int)f1_[2], (int)f1_[3], 0, 0, 0, 0}; \
            f32x4 c_ = {0.f, 0.f, 0.f, 0.f}; \
            c_ = __builtin_amdgcn_mfma_scale_f32_16x16x128_f8f6f4(A0_, hB0, c_, 4, 0, 0, (int)s_[q], 0, sbt); \
            c_ = __builtin_amdgcn_mfma_scale_f32_16x16x128_f8f6f4(A1_, hB1, c_, 4, 0, 1, (int)s_[q], 0, sbt); \
            f32x4 o_; _Pragma("unroll") for (int j = 0; j < 4; ++j) o_[j] = c_[j] + DPP_F(c_[j], 0xB1); \
            if (m == 0) *(uint2*)(AP + ((size_t)(t_) * 8 + x) * 128 + (kb_) + 16 * q + 4 * g) = make_uint2(pack2(o_[0], o_[1]), pack2(o_[2], o_[3])); } } while (0)
#define EU_IDX(t_, i0_, i1_) do { i0_ = IDX[(size_t)(t_) * 128 + lane]; i1_ = IDX[(size_t)(t_) * 128 + 64 + lane]; } while (0)
    if (gw < T) { EU_IDX(gw, iv0, iv1); EU_BLOAD(gw, hB0, hB1, ckx); const int t1 = (gw + NGW < T) ? gw + NGW : gw; EU_IDX(t1, niv0, niv1); EU_LOAD(rA, sA, iv0); sbt = 127 + ckx - ((lane & 1) ? 4 : 0); }
    for (int t = gw; t < T; t += NGW) {
        const int tn = (t + NGW < T) ? t + NGW : t, tnn = (t + 2 * NGW < T) ? t + 2 * NGW : t;
        EU_LOAD(rB, sB, iv1);
        EU_BLOAD(tn, nB0, nB1, nkx);
        int nn0, nn1; EU_IDX(tnn, nn0, nn1);
        EU_COMPUTE(rA, sA, 0, t);
        EU_LOAD(rA, sA, niv0);
        EU_COMPUTE(rB, sB, 64, t);
        hB0 = nB0; hB1 = nB1; sbt = 127 + nkx - ((lane & 1) ? 4 : 0);
        iv0 = niv0; iv1 = niv1; niv0 = nn0; niv1 = nn1;
    }
#undef EU_LOAD
#undef EU_BLOAD
#undef EU_COMPUTE
#undef EU_IDX
}

__device__ __forceinline__ void phase_ev(const Args& a) {
    const u16* X1 = (const u16*)(a.ws + WS_X1);
    const int* IDX = (const int*)(a.ws + WS_IDX);
    const float* GATE = (const float*)(a.ws + WS_GATE);
    const u16* AP = (const u16*)(a.ws + WS_AP);
    const float* mod = (const float*)(a.ws + WS_MOD);
    const unsigned char* V = a.ws + WS_TV;
    const int lane = threadIdx.x & 63, wave = threadIdx.x >> 6;
    const int gw = blockIdx.x * NWAVES + wave, NGW = gridDim.x * NWAVES;
    int iv0 = 0, iv1 = 0; float gv0 = 0.f, gv1 = 0.f;
    int niv0 = 0, niv1 = 0; float ngv0 = 0.f, ngv1 = 0.f;
    uint4 rA[4], rB[4]; u16 sA[4], sB[4];
#define ROW_LOAD(TB_, r_, s_, r0_) do { _Pragma("unroll") for (int q = 0; q < 4; ++q) { \
            const int rr_ = (r0_) + q; const int e_ = __builtin_amdgcn_readlane(rr_ < 64 ? iv0 : iv1, rr_ & 63); \
            const unsigned char* rp_ = TB_ + (size_t)e_ * TROW; \
            const unsigned char* sp_ = a.ws + WS_SV + (size_t)e_ * 64; \
            r_[q] = *(const uint4*)(rp_ + lane * 16); s_[q] = (u16)*(sp_ + lane); } } while (0)
#define TOK_FETCH(t_, i0_, i1_, g0_, g1_, ap_) do { \
            i0_ = IDX[(size_t)(t_) * 128 + lane]; i1_ = IDX[(size_t)(t_) * 128 + 64 + lane]; \
            g0_ = GATE[(size_t)(t_) * 128 + lane]; g1_ = GATE[(size_t)(t_) * 128 + 64 + lane]; \
            _Pragma("unroll") for (int xx = 0; xx < 8; ++xx) { ap_[xx] = AP[((size_t)(t_) * 8 + xx) * 128 + lane]; ap_[8 + xx] = AP[((size_t)(t_) * 8 + xx) * 128 + 64 + lane]; } } while (0)
    u16 ap[16], nap[16];
    if (gw < T) { TOK_FETCH(gw, iv0, iv1, gv0, gv1, ap); ROW_LOAD(V, rA, sA, 0); }
    for (int t = gw; t < T; t += NGW) {
        const int b = t / S;
        const bool has_next = (t + NGW) < T;
        float a0 = 0.f, a1 = 0.f;
#pragma unroll
        for (int xx = 0; xx < 8; ++xx) { a0 += bf2f(ap[xx]); a1 += bf2f(ap[8 + xx]); }
        const float w0 = gv0 * gelu_f(a0), w1 = gv1 * gelu_f(a1);
        float acc[32];
#pragma unroll
        for (int i = 0; i < 32; ++i) acc[i] = 0.f;
#define V_COMPUTE(r_, s_, r0_) do { _Pragma("unroll") for (int q = 0; q < 4; ++q) { const int rr_ = (r0_) + q; \
                const float g_ = __builtin_bit_cast(float, __builtin_amdgcn_readlane(__builtin_bit_cast(int, rr_ < 64 ? w0 : w1), rr_ & 63)); \
                axpy32_fp4(r_[q], g_ * __uint_as_float((unsigned)s_[q] << 23), acc); } } while (0)
        { const int tn = has_next ? t + NGW : t; TOK_FETCH(tn, niv0, niv1, ngv0, ngv1, nap); }
#pragma unroll 1
        for (int r0 = 0; r0 < 128; r0 += 8) {
            ROW_LOAD(V, rB, sB, r0 + 4);
            V_COMPUTE(rA, sA, r0);
            if (r0 + 8 < 128) ROW_LOAD(V, rA, sA, r0 + 8);
            else { iv0 = niv0; iv1 = niv1; gv0 = ngv0; gv1 = ngv1;
                _Pragma("unroll") for (int i = 0; i < 16; ++i) ap[i] = nap[i];
                if (has_next) ROW_LOAD(V, rA, sA, 0); }
            V_COMPUTE(rB, sB, r0 + 4);
        }
#undef V_COMPUTE
        float ss = 0.f;
#pragma unroll
        for (int k = 0; k < 8; ++k) {
            const int c0 = lane * 32 + 4 * k;
            const hw_f32x2 xn = __builtin_nontemporal_load((const hw_f32x2*)(X1 + (size_t)t * D + c0));
            const uint2 xp = make_uint2(__float_as_uint(xn[0]), __float_as_uint(xn[1]));
            const float4 xa = make_float4(lo2f(xp.x), hi2f(xp.x), lo2f(xp.y), hi2f(xp.y));
            const float4 ga = *(const float4*)(mod + b * 12288 + 5 * 2048 + c0);
            acc[4 * k + 0] = xa.x + ga.x * acc[4 * k + 0]; acc[4 * k + 1] = xa.y + ga.y * acc[4 * k + 1];
            acc[4 * k + 2] = xa.z + ga.z * acc[4 * k + 2]; acc[4 * k + 3] = xa.w + ga.w * acc[4 * k + 3];
#pragma unroll
            for (int i = 0; i < 4; ++i) ss += acc[4 * k + i] * acc[4 * k + i];
        }
        ss = wave_sum(ss);
        const float rstd = rsqrtf(ss * (1.f / D) + NORM_EPS);
#pragma unroll
        for (int k = 0; k < 8; ++k) {
            const int c0 = lane * 32 + 4 * k;
            const float4 gf = *(const float4*)(a.g_fin + c0);
            *(float4*)(a.out + (size_t)t * D + c0) = make_float4(acc[4 * k + 0] * rstd * gf.x, acc[4 * k + 1] * rstd * gf.y, acc[4 * k + 2] * rstd * gf.z, acc[4 * k + 3] * rstd * gf.w);
        }
    }
#undef ROW_LOAD
#undef TOK_FETCH
}

#undef DPP_F

#define XB_TMO      128
#define XB_XCNT(j)  (256  + 64 * (j))
#define XB_XSUB(j)  (1280 + 64 * (j))
#define XB_XGEN(j)  (2304 + 64 * (j))
#define XB_TOP      3328
#define XB_TOPGEN   3392
#define XCD_BAR_WORDS 3456
#define XB_SPIN_CAP (1u << 18)

__device__ __forceinline__ unsigned xb_ld(unsigned* p)              { return __hip_atomic_load(p, __ATOMIC_RELAXED, __HIP_MEMORY_SCOPE_AGENT); }
__device__ __forceinline__ unsigned xb_add(unsigned* p, unsigned v) { return __hip_atomic_fetch_add(p, v, __ATOMIC_RELAXED, __HIP_MEMORY_SCOPE_AGENT); }
__device__ __forceinline__ unsigned xb_xcc_id() { return (unsigned)__builtin_amdgcn_s_getreg((3 << 11) | 20) & 0xFu; }
#define XB_SPIN(cond, bar) do { unsigned _sp = 0; while (cond) { __builtin_amdgcn_s_sleep(1); \
    if ((++_sp & 255u) == 0u) { if (xb_ld(&(bar)[XB_TMO])) break; if (_sp > XB_SPIN_CAP) { atomicAdd(&(bar)[XB_TMO], 1u); break; } } } } while (0)

struct XcdBarrier {
    unsigned* bar; unsigned x;
    volatile LAS unsigned* st;
};

__device__ __forceinline__ XcdBarrier xcd_barrier_post(unsigned* bar, volatile LAS unsigned* st) {
    XcdBarrier b; b.bar = bar; b.x = xb_xcc_id(); b.st = st;
    if (threadIdx.x == 0) (void)xb_add(&bar[XB_XCNT(b.x)], 1u);
    return b;
}
__device__ __forceinline__ void xcd_barrier_complete(unsigned* bar, unsigned x, unsigned& nloc, unsigned& nx) {
    const unsigned G = gridDim.x * gridDim.y * gridDim.z;
    unsigned sum, cnt, mine, sp = 0u;
    for (;;) {
        sum = 0u; cnt = 0u; mine = 0u;
#pragma unroll
        for (unsigned j = 0; j < 16; ++j) { const unsigned c = xb_ld(&bar[XB_XCNT(j)]); sum += c; cnt += (c > 0u) ? 1u : 0u; mine = (j == x) ? c : mine; }
        if (sum == G) break;
        __builtin_amdgcn_s_sleep(1);
        if ((++sp & 255u) == 0u) { if (xb_ld(&bar[XB_TMO])) break; if (sp > XB_SPIN_CAP) { atomicAdd(&bar[XB_TMO], 1u); break; } }
    }
    nloc = mine > 0u ? mine : 1u; nx = cnt > 0u ? cnt : 1u;
}

__device__ __forceinline__ void xcd_barrier(const XcdBarrier& b) {
    asm volatile("s_waitcnt vmcnt(0)" ::: "memory");
    __syncthreads();
    if (threadIdx.x == 0) {
        unsigned* bar = b.bar;
        __builtin_amdgcn_s_waitcnt(0);
        unsigned nloc = b.st[0], nx = b.st[1];
        if (nloc == 0u) { xcd_barrier_complete(bar, b.x, nloc, nx); b.st[0] = nloc; b.st[1] = nx; }
        const unsigned old = xb_add(&bar[XB_XSUB(b.x)], 1u);
        const unsigned gen = old / nloc;
        if (old + 1u == (gen + 1u) * nloc) {
            __builtin_amdgcn_fence(__ATOMIC_RELEASE, "agent");
            asm volatile("s_waitcnt vmcnt(0)" ::: "memory");
            const unsigned og = xb_add(&bar[XB_TOP], 1u);
            const unsigned tg = og / nx;
            if (og + 1u == (tg + 1u) * nx) xb_add(&bar[XB_TOPGEN], 1u);
            else XB_SPIN(xb_ld(&bar[XB_TOPGEN]) == tg, bar);
            __builtin_amdgcn_fence(__ATOMIC_ACQUIRE, "agent");
            xb_add(&bar[XB_XGEN(b.x)], 1u);
            asm volatile("s_waitcnt vmcnt(0)" ::: "memory");
        } else {
            XB_SPIN(xb_ld(&bar[XB_XGEN(b.x)]) == gen, bar);
            __builtin_amdgcn_fence(__ATOMIC_ACQUIRE, "agent");
            asm volatile("s_waitcnt vmcnt(0)" ::: "memory");
        }
    }
    __syncthreads();
}

constexpr int NPHASES = 12;
__global__ void __launch_bounds__(NTHREADS, 2) mk_fwd(Args a) {
    extern __shared__ __attribute__((aligned(16))) unsigned char lds[];
    cg::grid_group grid = cg::this_grid();
    const int lo = a.ph_lo, hi = a.ph_hi;
    volatile LAS unsigned* xbw = (volatile LAS unsigned*)(lds + LDS_MAIN);
    if (threadIdx.x < 4) xbw[threadIdx.x] = 0u;
    __syncthreads();
    XcdBarrier xbar = xcd_barrier_post((unsigned*)(a.ws + WS_CTL), xbw);
#define IN(k) (lo <= (k) && (k) < hi)
    if (lo < 0) grid.sync();
#define SEAM(k) do { if (IN(k) && IN((k) + 1)) xcd_barrier(xbar); } while (0)
    const float* mod = (const float*)(a.ws + WS_MOD);
    if (IN(0)) phase0(a, lds);
    SEAM(0);
    if (IN(1)) norm_mod_phase<false>(a.x, a.g_mix, mod, 0, 1, (u16*)(a.ws + WS_ACT));
    SEAM(1);
    if (IN(2)) { gemm8(lds, (const u16*)(a.ws + WS_ACT), (const u16*)(a.ws + WS_WIN), T, NP, D, EpiProj{(u16*)(a.ws + WS_P), (const float*)(a.ws + WS_CS)}); gz_phase(lds, (const u16*)(a.ws + WS_ACT), (const u16*)(a.ws + WS_WIN) + (size_t)NP * D, (float*)(a.ws + WS_GZ)); }
    SEAM(2);
    if (IN(3)) phase_rope_prep(a, lds);
    SEAM(3);
    if (IN(4)) phase_mixers(a, lds);
    SEAM(4);
    if (IN(5)) phase_gla_fin(a);
    SEAM(5);
    if (IN(6)) gemm8(lds, (const u16*)(a.ws + WS_ACT), (const u16*)(a.ws + WS_WOUT), T, D, D, EpiResid{a.x, mod, (u16*)(a.ws + WS_X1)});
    SEAM(6);
    if (IN(7)) { norm_mod_phase<true>(a.ws + WS_X1, a.g_ffn, mod, 3, 4, (u16*)(a.ws + WS_ACT), a.ws + WS_IMG, (int*)(a.ws + WS_KXS)); convert_tables(a); }
    SEAM(7);
    if (IN(8)) gemm8(lds, (const u16*)(a.ws + WS_ACT), (const u16*)(a.ws + WS_WPQ), T, D, D, EpiBf16{(u16*)(a.ws + WS_Q)});
    SEAM(8);
    if (IN(9)) phase_route(a, lds);
    SEAM(9);
    if (IN(10)) phase_eu(a, lds);
    SEAM(10);
    if (IN(11)) phase_ev(a);
#undef IN
#undef SEAM
}

#ifndef MK_ONE_LAUNCH
#define MK_ONE_LAUNCH 1
#endif
extern "C" void kernel_launch(void* const* d_in, const int* in_sizes, int n_in, void* d_out, int out_size, void* d_ws, size_t ws_size, hipStream_t stream) {
    static int grid = 0;
    if (grid == 0) {
        if (n_in != 19 || out_size != T * D || ws_size < WS_END) {
            fprintf(stderr, "kernel_launch: unexpected shapes: n_in %d out %d ws %zu (need %zu)\n", n_in, out_size, ws_size, (size_t)WS_END);
            grid = -1; return;
        }
        int dev = 0, cus = 0, per_cu = 0;
        (void)hipGetDevice(&dev);
        (void)hipDeviceGetAttribute(&cus, hipDeviceAttributeMultiprocessorCount, dev);
        (void)hipFuncSetAttribute((const void*)mk_fwd, hipFuncAttributeMaxDynamicSharedMemorySize, LDS_BYTES);
        (void)hipOccupancyMaxActiveBlocksPerMultiprocessor(&per_cu, (const void*)mk_fwd, NTHREADS, LDS_BYTES);
        if (per_cu < 1) { fprintf(stderr, "kernel_launch: occupancy query says %d blocks/CU\n", per_cu); grid = -1; return; }
        grid = cus;
        (void)hipGetLastError();
    }
    if (grid < 0) return;
    Args a{};
    a.x = (const float*)d_in[0]; a.c = (const float*)d_in[1]; a.pos = (const int*)d_in[2]; a.w_ada = (const float*)d_in[3];
    a.b_ada = (const float*)d_in[4]; a.g_mix = (const float*)d_in[5]; a.w_in = (const float*)d_in[6]; a.wgf = (const float*)d_in[7];
    a.bgf = (const float*)d_in[8]; a.wgb = (const float*)d_in[9]; a.bgb = (const float*)d_in[10]; a.g_gla = (const float*)d_in[11];
    a.w_out = (const float*)d_in[12]; a.g_ffn = (const float*)d_in[13]; a.w_pq = (const float*)d_in[14]; a.subk = (const float*)d_in[15];
    a.pu = (const float*)d_in[16]; a.pv = (const float*)d_in[17]; a.g_fin = (const float*)d_in[18];
    a.out = (float*)d_out; a.ws = (unsigned char*)d_ws;
#if MK_ONE_LAUNCH
    (void)hipMemsetAsync((unsigned char*)d_ws + WS_CTL, 0, XCD_BAR_WORDS * 4, stream);
    a.ph_lo = 0; a.ph_hi = NPHASES;
    void* args[] = {&a};
    hipError_t e = hipLaunchCooperativeKernel((const void*)mk_fwd, dim3(grid), dim3(NTHREADS), args, LDS_BYTES, stream);
    if (e != hipSuccess) fprintf(stderr, "cooperative launch failed: %s (grid %d)\n", hipGetErrorString(e), grid);
#else
    for (int p = 0; p < NPHASES; ++p) {
        a.ph_lo = p; a.ph_hi = p + 1;
        hipLaunchKernelGGL(mk_fwd, dim3(grid), dim3(NTHREADS), LDS_BYTES, stream, a);
    }
#endif
}
```

```cpp
#include <hip/hip_runtime.h>
#include <hip/hip_cooperative_groups.h>
#include <cstdio>
#include <cstdint>

namespace cg = cooperative_groups;

typedef unsigned short u16;
typedef __attribute__((ext_vector_type(8))) short bf16x8;
typedef __attribute__((ext_vector_type(4))) float f32x4;
typedef short s16x4 __attribute__((ext_vector_type(4)));
#define TID ((int)threadIdx.x)
#define BID ((int)blockIdx.x)
#define GDIM ((int)gridDim.x)
#define LAS __attribute__((address_space(3)))

constexpr int D = 2048, NB = 4, S = 4096, T = NB * S;
constexpr int INW = 6176;
constexpr int NP = 6144;
constexpr int NPAD = 6208;
constexpr int C_GQ = 0, C_GK = 512, C_GV = 1024, C_GR = 2048, C_DQ = 3072, C_DK = 4096, C_DV = 5120;
constexpr int NTHREADS = 512, NWAVES = 8;
constexpr int LDS_MAIN = 128 * 1024;
constexpr int LDS_STAGE = 16 * 1024;
constexpr int LDS_BYTES = LDS_MAIN + 16 + LDS_STAGE;
constexpr float NORM_EPS = 1e-6f;

constexpr size_t WS_CTL = 0;
constexpr size_t WS_MOD = 65536;
constexpr size_t WS_CS = 524288;
constexpr size_t WS_WIN = WS_CS + (size_t)T * 64 * 8;
constexpr size_t WS_WOUT = WS_WIN + (size_t)NPAD * D * 2;
constexpr size_t WS_WPQ = WS_WOUT + (size_t)D * D * 2;
constexpr size_t WS_ACT = WS_WPQ + (size_t)D * D * 2;
constexpr size_t WS_P = WS_ACT + (size_t)T * D * 2;
constexpr size_t WS_X1 = WS_P;
constexpr size_t WS_Q = WS_P + (size_t)T * D * 4;
constexpr size_t WS_GZ = WS_P + (size_t)T * NP * 2;
constexpr int GLA_NPREP = NB * 4 * 2 * (S / 64);
constexpr size_t WS_QD = WS_GZ + (size_t)T * 32 * 4;
constexpr size_t WS_KE = WS_QD + (size_t)GLA_NPREP * 16384;
constexpr size_t WS_AT = WS_KE + (size_t)GLA_NPREP * 16384;
constexpr size_t WS_DEC = WS_AT + (size_t)GLA_NPREP * 8192;
constexpr size_t WS_OFB = WS_DEC + (size_t)GLA_NPREP * 512;
constexpr size_t WS_IDX = WS_OFB + (size_t)2 * T * 1024 * 2;
constexpr size_t WS_GATE = WS_IDX + (size_t)T * 128 * 4;
constexpr size_t WS_SS = WS_GATE + (size_t)T * 128 * 4;
constexpr size_t WS_KXS = WS_SS + (size_t)T * 8 * 4;
constexpr size_t WS_END = WS_KXS + (size_t)T * 8 * 4;
constexpr size_t WS_IMG = WS_OFB;
constexpr size_t WS_AP = WS_P + (size_t)T * D * 2;
constexpr size_t SLICE_T = (size_t)16384 * 128, SLICE_S = (size_t)16384 * 8;
constexpr size_t WS_TU = WS_QD;
constexpr size_t WS_TV = WS_TU + (size_t)16384 * 1024;
constexpr size_t WS_SU = WS_TV + (size_t)16384 * 1024;
constexpr size_t WS_SV = WS_SU + (size_t)16384 * 128;
static_assert(WS_SV + (size_t)16384 * 128 <= WS_IDX, "table region");

struct Args {
    const float* x; const float* c; const int* pos; const float* w_ada; const float* b_ada; const float* g_mix;
    const float* w_in; const float* wgf; const float* bgf; const float* wgb; const float* bgb; const float* g_gla;
    const float* w_out; const float* g_ffn; const float* w_pq; const float* subk; const float* pu; const float* pv; const float* g_fin;
    float* out; unsigned char* ws; int ph_lo, ph_hi;
};

__device__ __forceinline__ float bf2f(u16 h) { return __uint_as_float(((unsigned)h) << 16); }
typedef __bf16 hw_bf16x2 __attribute__((ext_vector_type(2)));
typedef float hw_f32x2 __attribute__((ext_vector_type(2)));
typedef unsigned u32x2_t __attribute__((ext_vector_type(2)));
__device__ __forceinline__ unsigned pack2(float a, float b) { const hw_f32x2 f = {a, b}; return __builtin_bit_cast(unsigned, __builtin_convertvector(f, hw_bf16x2)); }
__device__ __forceinline__ u16 f2bf(float f) { return (u16)(pack2(f, 0.f) & 0xffffu); }
__device__ __forceinline__ float lo2f(unsigned p) { return __uint_as_float(p << 16); }
__device__ __forceinline__ float hi2f(unsigned p) { return __uint_as_float(p & 0xffff0000u); }
__device__ __forceinline__ float wave_sum(float v) {
#pragma unroll
    for (int o = 32; o > 0; o >>= 1) v += __shfl_xor(v, o);
    return v;
}
__device__ __forceinline__ float wave_max(float v) {
#pragma unroll
    for (int o = 32; o > 0; o >>= 1) v = fmaxf(v, __shfl_xor(v, o));
    return v;
}
__device__ __forceinline__ float silu_f(float v) { return v / (1.f + __expf(-v)); }
__device__ __forceinline__ float gelu_f(float a) { return 0.5f * a * (1.f + erff(a * 0.70710678118654752f)); }
__device__ __forceinline__ float logsigmoid_f(float z) { return z < 0.f ? z - log1pf(expf(z)) : -log1pf(expf(-z)); }

constexpr int MOD_BLOCKS = 96;
__device__ __forceinline__ void p0_mod(const Args& a, unsigned char* lds, int bi) {
    float* sc = (float*)lds;
    float* red = sc + 4 * 2048;
    const int tid = threadIdx.x, lane = tid & 63, wave = tid >> 6;
    for (int i = tid; i < 4 * 2048; i += NTHREADS) sc[i] = silu_f(a.c[i]);
    __syncthreads();
    const int j0 = bi * 128 + lane * 2;
    float acc[4][2];
#pragma unroll
    for (int b = 0; b < 4; ++b) { acc[b][0] = 0.f; acc[b][1] = 0.f; }
    const int k0 = wave * 256;
#pragma unroll 8
    for (int kk = 0; kk < 256; ++kk) {
        const int k = k0 + kk;
        const hw_f32x2 wv_ = __builtin_nontemporal_load((const hw_f32x2*)(a.w_ada + (size_t)k * 12288 + j0)); const float2 w = make_float2(wv_[0], wv_[1]);
#pragma unroll
        for (int b = 0; b < 4; ++b) { const float s = sc[b * 2048 + k]; acc[b][0] += s * w.x; acc[b][1] += s * w.y; }
    }
#pragma unroll
    for (int b = 0; b < 4; ++b) { red[(wave * 4 + b) * 128 + lane * 2] = acc[b][0]; red[(wave * 4 + b) * 128 + lane * 2 + 1] = acc[b][1]; }
    __syncthreads();
    float* mod = (float*)(a.ws + WS_MOD);
    {
        const int b = tid >> 7, jc = tid & 127;
        float s = 0.f;
#pragma unroll
        for (int w = 0; w < 8; ++w) s += red[(w * 4 + b) * 128 + jc];
        mod[b * 12288 + bi * 128 + jc] = s + a.b_ada[bi * 128 + jc];
    }
    __syncthreads();
}

__device__ __forceinline__ void p0_transpose_item(const float* __restrict__ W, int ldw, int k0, int src_col0, int n_valid,
                                                  u16* __restrict__ WT, int ldt, int n_out0, unsigned char* wlds, bool rope_perm = false) {
    u16* tl = (u16*)wlds;
    const int lane = threadIdx.x & 63;
    const int rsub = lane >> 4, nc = (lane & 15) * 4;
    int scol = src_col0 + nc;
    if (rope_perm) { const int p = (n_out0 & 64) + nc, g = p >> 3; scol = (src_col0 - (n_out0 & 64)) + ((p & 4) ? 64 + 4 * g : 4 * g); }
    float4 v[16];
#pragma unroll
    for (int j = 0; j < 16; ++j) {
        const int k = 4 * j + rsub;
        if (nc < n_valid) { const f32x4 q_ = __builtin_nontemporal_load((const f32x4*)(W + (size_t)(k0 + k) * ldw + scol)); v[j] = make_float4(q_[0], q_[1], q_[2], q_[3]); }
        else v[j] = make_float4(0.f, 0.f, 0.f, 0.f);
    }
#pragma unroll
    for (int j = 0; j < 16; ++j) {
        const int k = 4 * j + rsub;
        tl[(nc + 0) * 72 + k] = f2bf(v[j].x); tl[(nc + 1) * 72 + k] = f2bf(v[j].y); tl[(nc + 2) * 72 + k] = f2bf(v[j].z); tl[(nc + 3) * 72 + k] = f2bf(v[j].w);
    }
#pragma unroll
    for (int j = 0; j < 8; ++j) {
        const int c = lane + 64 * j, n = c >> 3, kc = (c & 7) * 8;
        const uint4 o = *(const uint4*)(tl + n * 72 + kc);
        *(uint4*)(WT + (size_t)(n_out0 + n) * ldt + k0 + kc) = o;
    }
}

__device__ __forceinline__ void phase0(const Args& a, unsigned char* lds) {
    const int bi = blockIdx.x, G = gridDim.x, tid = threadIdx.x, wave = tid >> 6;
    const bool modblk = (G > MOD_BLOCKS) && (bi < MOD_BLOCKS);
    if (G > MOD_BLOCKS) { if (modblk) p0_mod(a, lds, bi); }
    else { for (int mb = bi; mb < MOD_BLOCKS; mb += G) p0_mod(a, lds, mb); }
    const int nb = (G > MOD_BLOCKS) ? G - MOD_BLOCKS : G, b0 = (G > MOD_BLOCKS) ? bi - MOD_BLOCKS : bi;
    if (!modblk) {
        constexpr int I_IN = 32 * (NPAD / 64), I_SQ = 32 * 32;
        u16* WinT = (u16*)(a.ws + WS_WIN); u16* WoutT = (u16*)(a.ws + WS_WOUT); u16* WpqT = (u16*)(a.ws + WS_WPQ);
        unsigned char* wlds = lds + wave * 9216;
        for (int it = b0 * NWAVES + wave; it < I_IN + 2 * I_SQ; it += nb * NWAVES) {
            if (it < I_IN) {
                const int kt = it & 31, nt = it >> 5;
                const int n0 = nt * 64;
                int src, nv;
                if (n0 < 3072) { src = n0; nv = 64; }
                else if (n0 < 6144) { src = n0 + 32; nv = 64; }
                else if (n0 == 6144) { src = 3072; nv = 32; }
                else { src = 0; nv = 0; }
                p0_transpose_item(a.w_in, INW, kt * 64, src, nv, WinT, D, n0, wlds, n0 >= C_DQ && n0 < C_DV);
            } else if (it < I_IN + I_SQ) {
                const int r = it - I_IN; const int kt = r & 31, nt = r >> 5;
                p0_transpose_item(a.w_out, D, kt * 64, nt * 64, 64, WoutT, D, nt * 64, wlds);
            } else {
                const int r = it - I_IN - I_SQ; const int kt = r & 31, nt = r >> 5;
                p0_transpose_item(a.w_pq, D, kt * 64, nt * 64, 64, WpqT, D, nt * 64, wlds);
            }
        }
        float2* cs = (float2*)(a.ws + WS_CS);
        for (int i = b0 * NTHREADS + tid; i < T * 64; i += nb * NTHREADS) {
            const int t = i >> 6, f = i & 63;
            const float inv_freq = powf(10000.0f, -(float)f * 2.0f / 128.0f);
            const float ang = (float)a.pos[t] * inv_freq;
            const double rev = (double)ang * 0.15915494309189533577;
            const float fr = (float)(rev - floor(rev));
            cs[i] = make_float2(__builtin_amdgcn_cosf(fr), __builtin_amdgcn_sinf(fr));
        }
    }
    __syncthreads();
}

template <bool BF16IN> __device__ __forceinline__ void norm_mod_phase(const void* __restrict__ xin_, const float* __restrict__ g, const float* __restrict__ mod,
                                               int sh_chunk, int sc_chunk, u16* __restrict__ outp, unsigned char* __restrict__ img = nullptr, int* __restrict__ kxs = nullptr) {
    const int lane = threadIdx.x & 63, wave = threadIdx.x >> 6;
    const int gw = blockIdx.x * NWAVES + wave, NGW = gridDim.x * NWAVES;
    float4 v[8], vn[8];
#define NM_LOAD(dst_, t_) do { if (BF16IN) { const hw_f32x2* xr_ = (const hw_f32x2*)((const u16*)xin_ + (size_t)(t_) * D); \
            _Pragma("unroll") for (int m = 0; m < 8; ++m) { const hw_f32x2 q_ = __builtin_nontemporal_load(xr_ + lane + 64 * m); const unsigned px_ = __float_as_uint(q_[0]), py_ = __float_as_uint(q_[1]); \
                dst_[m] = make_float4(lo2f(px_), hi2f(px_), lo2f(py_), hi2f(py_)); } } \
        else { const f32x4* xr_ = (const f32x4*)((const float*)xin_ + (size_t)(t_) * D); \
            _Pragma("unroll") for (int m = 0; m < 8; ++m) { const f32x4 q_ = __builtin_nontemporal_load(xr_ + lane + 64 * m); dst_[m] = make_float4(q_[0], q_[1], q_[2], q_[3]); } } } while (0)
    if (gw < T) NM_LOAD(v, gw);
    for (int t = gw; t < T; t += NGW) {
        const int b = t / S;
        if (t + NGW < T) NM_LOAD(vn, t + NGW);
        float ss = 0.f;
#pragma unroll
        for (int m = 0; m < 8; ++m) ss += v[m].x * v[m].x + v[m].y * v[m].y + v[m].z * v[m].z + v[m].w * v[m].w;
        ss = wave_sum(ss);
        const float rstd = rsqrtf(ss * (1.f / D) + NORM_EPS);
        const float4* gp = (const float4*)g;
        const float4* shp = (const float4*)(mod + b * 12288 + sh_chunk * 2048);
        const float4* scp = (const float4*)(mod + b * 12288 + sc_chunk * 2048);
        uint2* op = (uint2*)(outp + (size_t)t * D);
#pragma unroll
        for (int m = 0; m < 8; ++m) {
            const int i = lane + 64 * m;
            const float4 gg = gp[i], sh = shp[i], sc = scp[i];
            const float h0 = v[m].x * rstd * gg.x * (1.f + sc.x) + sh.x;
            const float h1 = v[m].y * rstd * gg.y * (1.f + sc.y) + sh.y;
            const float h2 = v[m].z * rstd * gg.z * (1.f + sc.z) + sh.z;
            const float h3 = v[m].w * rstd * gg.w * (1.f + sc.w) + sh.w;
            const uint2 pk = make_uint2(pack2(h0, h1), pack2(h2, h3));
            op[i] = pk;
            if (BF16IN) {
                const float e0 = lo2f(pk.x), e1 = hi2f(pk.x), e2 = lo2f(pk.y), e3 = hi2f(pk.y);
                float amx = fmaxf(fmaxf(fabsf(e0), fabsf(e1)), fmaxf(fabsf(e2), fabsf(e3)));
#pragma unroll
                for (int o = 32; o > 0; o >>= 1) amx = fmaxf(amx, __shfl_xor(amx, o));
                const unsigned bits = __float_as_uint(amx);
                int kx = (int)(bits >> 23) - 127 - 8 + (((bits & 0x7fffffu) > 0x600000u) ? 1 : 0); kx = kx < -100 ? -100 : kx;
                const float hinv = __uint_as_float((unsigned)(127 - kx) << 23);
                const float x0 = e0 * hinv, x1 = e1 * hinv, x2 = e2 * hinv, x3 = e3 * hinv;
                int w = __builtin_amdgcn_cvt_pk_fp8_f32(x0, x1, 0, false); w = __builtin_amdgcn_cvt_pk_fp8_f32(x2, x3, w, true);
                const hw_f32x2 d0 = __builtin_amdgcn_cvt_pk_f32_fp8(w, false), d1 = __builtin_amdgcn_cvt_pk_f32_fp8(w, true);
                int l = __builtin_amdgcn_cvt_pk_fp8_f32((x0 - d0[0]) * 16.f, (x1 - d0[1]) * 16.f, 0, false);
                l = __builtin_amdgcn_cvt_pk_fp8_f32((x2 - d1[0]) * 16.f, (x3 - d1[1]) * 16.f, l, true);
                const int ei = 4 * lane, s = ei >> 7, k = ei & 127, g = (k & 63) >> 4, bb = (k & 15) + 16 * (k >> 6);
                unsigned char* ip = img + (((size_t)t * 8 + m) * 8 + 2 * g) * 64 + s * 32 + bb;
                *(int*)ip = w; *(int*)(ip + 64) = l;
                if (lane == 0) kxs[(size_t)t * 8 + m] = kx;
            }
        }
#pragma unroll
        for (int m = 0; m < 8; ++m) v[m] = vn[m];
    }
#undef NM_LOAD
}

namespace pg8 {
#define PG8_LAS __attribute__((address_space(3)))
typedef unsigned short bf16_t;
typedef short bf16x8 __attribute__((ext_vector_type(8)));
typedef float f32x4 __attribute__((ext_vector_type(4)));
typedef unsigned u32x4 __attribute__((ext_vector_type(4)));
constexpr int BM = 256, BK = 64, HALF = 128, HTB = HALF * BK * 2  , STAGE_BYTES = 8 * HTB, NXCD = 8, WGM = 8;

__host__ __device__ __forceinline__ int lds_byte(int r, int c) { const int st = (r >> 4) * 2 + (c >> 5), rr = r & 15, cc = c & 31, ob = rr * 64 + cc * 2; return st * 1024 + (ob ^ (((ob >> 9) & 1) << 5)); }
__host__ __device__ __forceinline__ void stage_rc(int b, int& R, int& C) { const int st = b / 1024, sb = b % 1024, swz = sb ^ (((sb >> 9) & 1) << 5); R = (st >> 1) * 16 + swz / 64; C = (st & 1) * 32 + (swz % 64) / 2; }
__host__ __device__ __forceinline__ int perm32(int rho) { const int n = rho >> 4, i = rho & 15; return 8 * (i >> 2) + 4 * n + (i & 3); }

struct Unit { int pm, pn; };
struct Gemm { const bf16_t* A; const bf16_t* Bt; int M, N, K; };

struct StaticOrder {
    int nM, nN, nwg, G, c;
    __host__ __device__ void init(int M, int N, int G_, int c_) { nM = M / BM; nN = N / BM; nwg = nM * nN; G = G_; c = c_; }
    __host__ __device__ bool next(int i, Unit& u) const {
        const long L = (long)i * G + c; if (L >= nwg) return false;
        int wgid = (int)L; { const int q = nwg / NXCD, r = nwg % NXCD, xcd = wgid % NXCD, off = wgid / NXCD; wgid = (xcd < r ? xcd * (q + 1) : r * (q + 1) + (xcd - r) * q) + off; }
        const int nig = WGM * nN, gid = wgid / nig, fm = gid * WGM, gsz = (nM - fm) < WGM ? (nM - fm) : WGM;
        u.pm = fm + ((wgid % nig) % gsz); u.pn = (wgid % nig) / gsz; return true;
    }
    __device__ __forceinline__ void a_ready(const Unit&) const {}
    __device__ __forceinline__ void done(const Unit&) const {}
};
__device__ __forceinline__ unsigned cvt_pk_bf16(float lo, float hi) { unsigned r; asm volatile("v_cvt_pk_bf16_f32 %0, %1, %2" : "=v"(r) : "v"(lo), "v"(hi)); return r; }
typedef float f32x2 __attribute__((ext_vector_type(2)));
template <class Epi, class Sched, bool STAMP = false>
__device__ __forceinline__ void gemm_phase(PG8_LAS unsigned char* lds, const Gemm g, const Sched& S, const Epi& E, unsigned long long* stamps) {
    const int tid = threadIdx.x, wid = __builtin_amdgcn_readfirstlane(tid >> 6), lane = tid & 63, wr = wid >> 2, wc = wid & 3, fr = lane & 15, fq = lane >> 4;
    const int K = g.K, nt = K / BK;
    int ts_lo = 0, ts_hi = 0, nts = 0; const unsigned long long rt_entry = STAMP ? (unsigned long long)wall_clock64() : 0ull;
#define PG8_STAMP() do { if (STAMP && wid == 0 && nts < 64) { const unsigned long long _c = (unsigned long long)clock64(); \
        ts_lo = (lane == nts) ? (int)(unsigned)_c : ts_lo; ts_hi = (lane == nts) ? (int)(unsigned)(_c >> 32) : ts_hi; ++nts; } } while (0)
    PG8_STAMP();
    unsigned voffA[2], voffB[2];
#pragma unroll
    for (int i = 0; i < 2; ++i) { int R, C; stage_rc(tid * 16 + i * 8192, R, C); const int Rb = Epi::PERM ? ((R & ~31) + perm32(R & 31)) : R;
        voffA[i] = (unsigned)(R * K + C) * 2u; voffB[i] = (unsigned)(Rb * K + C) * 2u; }
    const size_t kstep = (size_t)(BK * 2);
    const size_t hstep = (size_t)HALF * K * 2;
    const size_t tstep = 2 * hstep;
    const unsigned ldsw = (unsigned)wid * 1024u;
    const int aoff = lds_byte(wr * 64 + fr, fq * 8), boff = lds_byte(wc * 32 + fr, fq * 8);
#define PG8_SA(b, h) (((b) * 2 + (h)) * HTB)
#define PG8_SB(b, h) ((4 + (b) * 2 + (h)) * HTB)
#define PG8_STAGE(bufoff, gbase, voff) do { _Pragma("unroll") for (int _i = 0; _i < 2; ++_i) \
        __builtin_amdgcn_global_load_lds((const unsigned*)((const char*)(gbase) + (voff)[_i]), (PG8_LAS unsigned*)(lds + (bufoff) + ldsw + _i * 8192), 16, 0, 0); } while (0)
#define PG8_LDA(dst, b, h) do { _Pragma("unroll") for (int m = 0; m < 4; ++m) _Pragma("unroll") for (int k = 0; k < 2; ++k) dst[m][k] = *(const PG8_LAS bf16x8*)(lds + PG8_SA(b, h) + aoff + m * 2048 + k * 1024); } while (0)
#define PG8_LDB(dst, b, h) do { _Pragma("unroll") for (int n = 0; n < 2; ++n) _Pragma("unroll") for (int k = 0; k < 2; ++k) dst[n][k] = *(const PG8_LAS bf16x8*)(lds + PG8_SB(b, h) + boff + n * 2048 + k * 1024); } while (0)
#define PG8_MMA(ai, bj, At, Bt) do { __builtin_amdgcn_s_setprio(1); _Pragma("unroll") for (int m = 0; m < 4; ++m) _Pragma("unroll") for (int n = 0; n < 2; ++n) _Pragma("unroll") for (int k = 0; k < 2; ++k) \
        acc[ai][bj][m][n] = __builtin_amdgcn_mfma_f32_16x16x32_bf16(Bt[n][k], At[m][k], acc[ai][bj][m][n], 0, 0, 0); __builtin_amdgcn_s_setprio(0); } while (0)
#define PG8_WAIT_V(n) asm volatile("s_waitcnt vmcnt(" #n ")" ::: "memory")
#define PG8_WAIT_L(n) asm volatile("s_waitcnt lgkmcnt(" #n ")" ::: "memory")
#define PG8_BAR __builtin_amdgcn_s_barrier()
#define PG8_SCHED __builtin_amdgcn_sched_barrier(0)
    Unit cur, nxt; int ui = 0;
    if (!S.next(0, cur)) return;
    f32x4 acc[2][2][4][2];
#pragma unroll
    for (int a = 0; a < 2; ++a)
#pragma unroll
        for (int b = 0; b < 2; ++b)
#pragma unroll
            for (int m = 0; m < 4; ++m)
#pragma unroll
                for (int n = 0; n < 2; ++n) acc[a][b][m][n] = (f32x4){0.f, 0.f, 0.f, 0.f};
    bf16x8 At[4][2], B0[2][2], B1[2][2];
    const char* cA = (const char*)g.A + (size_t)cur.pm * tstep; const char* cB = (const char*)g.Bt + (size_t)cur.pn * tstep;
    S.a_ready(cur);
    PG8_STAGE(PG8_SB(0, 0), cB, voffB); PG8_STAGE(PG8_SA(0, 0), cA, voffA); PG8_STAGE(PG8_SB(0, 1), cB + hstep, voffB); PG8_STAGE(PG8_SA(0, 1), cA + hstep, voffA);
    if (wr == 1) PG8_BAR;
    PG8_WAIT_V(4); PG8_BAR;
    PG8_STAGE(PG8_SB(1, 0), cB + kstep, voffB); PG8_STAGE(PG8_SA(1, 0), cA + kstep, voffA); PG8_STAGE(PG8_SB(1, 1), cB + hstep + kstep, voffB);
    PG8_WAIT_V(6); PG8_BAR;
    PG8_STAMP();
    for (;;) {
        const bool has_next = S.next(ui + 1, nxt);
        const char* nA = has_next ? (const char*)g.A + (size_t)nxt.pm * tstep : cA; const char* nB = has_next ? (const char*)g.Bt + (size_t)nxt.pn * tstep : cB;
        for (int t = 0; t < nt; t += 2) {
            const bool last = (t == nt - 2);
            const char* a1 = cA + (size_t)(t + 1) * kstep;
            const char* a2 = last ? nA : cA + (size_t)(t + 2) * kstep; const char* b2 = last ? nB : cB + (size_t)(t + 2) * kstep;
            const char* a3 = a2 + kstep; const char* b3 = b2 + kstep;
            if (last && has_next) S.a_ready(nxt);
            PG8_LDB(B0, 0, 0); PG8_SCHED; PG8_LDA(At, 0, 0); PG8_STAGE(PG8_SA(1, 1), a1 + hstep, voffA);
            PG8_WAIT_L(8); PG8_BAR; PG8_WAIT_L(0); PG8_MMA(0, 0, At, B0); PG8_BAR; PG8_SCHED;
            PG8_LDB(B1, 0, 1); PG8_STAGE(PG8_SB(0, 0), b2, voffB);
            PG8_BAR; PG8_WAIT_L(0); PG8_MMA(0, 1, At, B1); PG8_BAR;
            PG8_LDA(At, 0, 1); PG8_STAGE(PG8_SA(0, 0), a2, voffA);
            PG8_BAR; PG8_WAIT_L(0); PG8_MMA(1, 0, At, B0); PG8_BAR; PG8_SCHED;
            PG8_STAGE(PG8_SB(0, 1), b2 + hstep, voffB);
            PG8_WAIT_V(6); PG8_BAR; PG8_MMA(1, 1, At, B1); PG8_BAR;
            PG8_LDB(B0, 1, 0); PG8_SCHED; PG8_LDA(At, 1, 0); PG8_STAGE(PG8_SA(0, 1), a2 + hstep, voffA);
            PG8_WAIT_L(8); PG8_BAR; PG8_WAIT_L(0); PG8_MMA(0, 0, At, B0); PG8_BAR; PG8_SCHED;
            PG8_LDB(B1, 1, 1); PG8_STAGE(PG8_SB(1, 0), b3, voffB);
            PG8_BAR; PG8_WAIT_L(0); PG8_MMA(0, 1, At, B1); PG8_BAR;
            PG8_LDA(At, 1, 1); PG8_STAGE(PG8_SA(1, 0), a3, voffA);
            PG8_BAR; PG8_WAIT_L(0); PG8_MMA(1, 0, At, B0); PG8_BAR; PG8_SCHED;
            PG8_STAGE(PG8_SB(1, 1), b3 + hstep, voffB);
            PG8_WAIT_V(6); PG8_BAR; PG8_MMA(1, 1, At, B1); PG8_BAR;
        }
        PG8_STAMP();
        if constexpr (!Epi::AFTER_DRAIN) { E(acc, cur, wr, wc, fr, fq); S.done(cur); }
        PG8_STAMP();
        if (!has_next) break;
#pragma unroll
        for (int a = 0; a < 2; ++a)
#pragma unroll
            for (int b = 0; b < 2; ++b)
#pragma unroll
                for (int m = 0; m < 4; ++m)
#pragma unroll
                    for (int n = 0; n < 2; ++n) acc[a][b][m][n] = (f32x4){0.f, 0.f, 0.f, 0.f};
        cur = nxt; cA = nA; cB = nB; ++ui;
    }
    PG8_WAIT_V(0);
    if (wr == 0) PG8_BAR;
    PG8_BAR;
    if constexpr (Epi::AFTER_DRAIN) { E.fused(acc, cur, wr, wc, fr, fq, lds, wid, lane); S.done(cur); }
    PG8_STAMP();
    if (STAMP && wid == 0) { stamps[lane] = lane < nts ? (((unsigned long long)(unsigned)ts_hi << 32) | (unsigned)ts_lo) : 0ull;
        if (lane == 62) stamps[62] = rt_entry; if (lane == 63) stamps[63] = (unsigned long long)wall_clock64(); }
#undef PG8_STAMP
#undef PG8_SA
#undef PG8_SB
#undef PG8_STAGE
#undef PG8_LDA
#undef PG8_LDB
#undef PG8_MMA
#undef PG8_WAIT_V
#undef PG8_WAIT_L
#undef PG8_BAR
#undef PG8_SCHED
}
}

struct EpiProj {
    static constexpr bool PERM = true, AFTER_DRAIN = false;
    u16* P; const float* cs;
    __device__ __forceinline__ void operator()(const pg8::f32x4 (&acc)[2][2][4][2], const pg8::Unit& u, int wr, int wc, int fr, int fq) const {
        const int row0 = u.pm * 256 + wr * 64 + fr;
        const int col0 = u.pn * 256 + wc * 32 + 8 * fq;
        const bool rope = (u.pn >= C_DQ / 256) && (u.pn < C_DV / 256);
#pragma unroll
        for (int ai = 0; ai < 2; ++ai)
#pragma unroll
            for (int m = 0; m < 4; ++m) { const int row = row0 + ai * 128 + m * 16; u16* rowp = P + (size_t)row * NP + col0;
                pg8::f32x4 c01 = (pg8::f32x4){1.f, 0.f, 1.f, 0.f}, c23 = c01;
                if (rope) { const pg8::f32x4* cp = (const pg8::f32x4*)(cs + ((size_t)row * 64 + 4 * (4 * wc + fq)) * 2); c01 = cp[0]; c23 = cp[1]; }
#pragma unroll
                for (int bj = 0; bj < 2; ++bj) { pg8::f32x4 v0 = acc[ai][bj][m][0], v1 = acc[ai][bj][m][1];
                    if (rope) {
                        const pg8::f32x4 cc = {c01[0], c01[2], c23[0], c23[2]}, sn = {c01[1], c01[3], c23[1], c23[3]};
                        const pg8::f32x4 y1 = v0 * cc - v1 * sn, y2 = v0 * sn + v1 * cc; v0 = y1; v1 = y2; }
                    pg8::u32x4 w; w.x = pg8::cvt_pk_bf16(v0[0], v0[1]); w.y = pg8::cvt_pk_bf16(v0[2], v0[3]); w.z = pg8::cvt_pk_bf16(v1[0], v1[1]); w.w = pg8::cvt_pk_bf16(v1[2], v1[3]);
                    *(pg8::u32x4*)(rowp + bj * 128) = w; } }
    }
};
__device__ __forceinline__ void gz_phase(unsigned char* lds, const u16* __restrict__ H1, const u16* __restrict__ Wg, float* __restrict__ gz) {
    const int tid = threadIdx.x, lane = tid & 63, wave = tid >> 6, fr = lane & 15, fq = lane >> 4;
    float* red = (float*)lds;
    for (int rb = blockIdx.x; rb < T / 64; rb += gridDim.x) {
        const int r0 = rb * 64, k0 = wave * 256;
        f32x4 acc[4][2];
#pragma unroll
        for (int m = 0; m < 4; ++m) { acc[m][0] = (f32x4){0.f, 0.f, 0.f, 0.f}; acc[m][1] = (f32x4){0.f, 0.f, 0.f, 0.f}; }
#pragma unroll
        for (int ks = 0; ks < 8; ++ks) {
            bf16x8 af[4], bfr[2];
#pragma unroll
            for (int m = 0; m < 4; ++m) af[m] = *(const bf16x8*)(H1 + (size_t)(r0 + 16 * m + fr) * D + k0 + 32 * ks + 8 * fq);
#pragma unroll
            for (int n = 0; n < 2; ++n) bfr[n] = *(const bf16x8*)(Wg + (size_t)(16 * n + fr) * D + k0 + 32 * ks + 8 * fq);
#pragma unroll
            for (int m = 0; m < 4; ++m)
#pragma unroll
                for (int n = 0; n < 2; ++n) acc[m][n] = __builtin_amdgcn_mfma_f32_16x16x32_bf16(af[m], bfr[n], acc[m][n], 0, 0, 0);
        }
        __syncthreads();
#pragma unroll
        for (int m = 0; m < 4; ++m)
#pragma unroll
            for (int n = 0; n < 2; ++n)
#pragma unroll
                for (int j = 0; j < 4; ++j) red[(wave * 64 + 16 * m + 4 * fq + j) * 32 + 16 * n + fr] = acc[m][n][j];
        __syncthreads();
#pragma unroll
        for (int k = 0; k < 4; ++k) {
            const int e = tid + 512 * k;
            float s = 0.f;
#pragma unroll
            for (int w = 0; w < 8; ++w) s += red[w * 2048 + e];
            gz[(size_t)r0 * 32 + e] = s;
        }
    }
    __syncthreads();
}
struct EpiResid {
    static constexpr bool PERM = true, AFTER_DRAIN = false;
    const float* x; const float* mod; u16* x1;
    __device__ __forceinline__ void operator()(const pg8::f32x4 (&acc)[2][2][4][2], const pg8::Unit& u, int wr, int wc, int fr, int fq) const {
        const int row0 = u.pm * 256 + wr * 64 + fr, col0 = u.pn * 256 + wc * 32 + 8 * fq;
        const int b = (u.pm * 256) / S;
        pg8::f32x4 ga[2][2];
#pragma unroll
        for (int bj = 0; bj < 2; ++bj)
#pragma unroll
            for (int n = 0; n < 2; ++n) ga[bj][n] = *(const pg8::f32x4*)(mod + b * 12288 + 2 * 2048 + col0 + bj * 128 + 4 * n);
#pragma unroll
        for (int ai = 0; ai < 2; ++ai)
#pragma unroll
            for (int m = 0; m < 4; ++m) { const size_t off = (size_t)(row0 + ai * 128 + m * 16) * D + col0;
#pragma unroll
                for (int bj = 0; bj < 2; ++bj) {
                    const pg8::f32x4 x0 = __builtin_nontemporal_load((const pg8::f32x4*)(x + off + bj * 128)), x1v = __builtin_nontemporal_load((const pg8::f32x4*)(x + off + bj * 128 + 4));
                    const pg8::f32x4 v0 = x0 + ga[bj][0] * acc[ai][bj][m][0], v1 = x1v + ga[bj][1] * acc[ai][bj][m][1];
                    pg8::u32x4 w; w.x = pg8::cvt_pk_bf16(v0[0], v0[1]); w.y = pg8::cvt_pk_bf16(v0[2], v0[3]); w.z = pg8::cvt_pk_bf16(v1[0], v1[1]); w.w = pg8::cvt_pk_bf16(v1[2], v1[3]);
                    *(pg8::u32x4*)(x1 + off + bj * 128) = w; } }
    }
};
struct EpiBf16 {
    static constexpr bool PERM = true, AFTER_DRAIN = false;
    u16* Q;
    __device__ __forceinline__ void operator()(const pg8::f32x4 (&acc)[2][2][4][2], const pg8::Unit& u, int wr, int wc, int fr, int fq) const {
        const int row0 = u.pm * 256 + wr * 64 + fr, col0 = u.pn * 256 + wc * 32 + 8 * fq;
#pragma unroll
        for (int ai = 0; ai < 2; ++ai)
#pragma unroll
            for (int m = 0; m < 4; ++m) { u16* rowp = Q + (size_t)(row0 + ai * 128 + m * 16) * D + col0;
#pragma unroll
                for (int bj = 0; bj < 2; ++bj) { const pg8::f32x4 v0 = acc[ai][bj][m][0], v1 = acc[ai][bj][m][1];
                    pg8::u32x4 w; w.x = pg8::cvt_pk_bf16(v0[0], v0[1]); w.y = pg8::cvt_pk_bf16(v0[2], v0[3]); w.z = pg8::cvt_pk_bf16(v1[0], v1[1]); w.w = pg8::cvt_pk_bf16(v1[2], v1[3]);
                    *(pg8::u32x4*)(rowp + bj * 128) = w; } }
    }
};
template <class Epi>
__device__ __forceinline__ void gemm8(unsigned char* lds, const u16* A, const u16* Bt, int M, int N, int K, const Epi& E) {
    pg8::Gemm g{A, Bt, M, N, K}; pg8::StaticOrder So; So.init(M, N, (int)gridDim.x, (int)blockIdx.x);
    pg8::gemm_phase<Epi, pg8::StaticOrder, false>((PG8_LAS unsigned char*)lds, g, So, E, nullptr);
    __syncthreads();
}

#define GLA_QD_BYTES 16384
#define GLA_AT_BYTES 8192
__device__ __forceinline__ float gla_logsigmoid(float z) { return fminf(z, 0.f) - __logf(1.f + __expf(-fabsf(z))); }

__device__ __forceinline__ void gla_prep_item(const u16* __restrict__ P, int ldp, int cq, int ck, const float* __restrict__ gz,
                                              const float* __restrict__ wg_f, const float* __restrict__ bg_f, const float* __restrict__ wg_b, const float* __restrict__ bg_b,
                                              int Sq, unsigned char* __restrict__ QDg, unsigned char* __restrict__ KEg, unsigned char* __restrict__ ATg, float* __restrict__ DECg,
                                              unsigned char* lds, int item) {
    const int nch = Sq / 64;
    const int c = item % nch, dir = (item / nch) & 1, hh = (item / (nch * 2)) & 3, b = item / (nch * 8);
    const int tid = TID, lane = tid & 63, wave = tid >> 6, li = lane & 15, fq = lane >> 4;
    float* gzs = (float*)lds;
    float* segs = gzs + 64 * 16;
    unsigned char* QDs = lds + 8192;
    unsigned char* KIs = QDs + 16384;
    unsigned char* KEs = KIs + 16384;
    float* bmat = (float*)(KEs + 16384);
    const size_t tok0 = (size_t)b * Sq;
    __syncthreads();
    uint4 rq0, rq1, rk0, rk1;
    {
        const int i0 = tid >> 4, i1 = (tid + 512) >> 4, cc = tid & 15;
        const int s0 = dir ? (Sq - 1 - (64 * c + i0)) : (64 * c + i0), s1 = dir ? (Sq - 1 - (64 * c + i1)) : (64 * c + i1);
        rq0 = *(const uint4*)(P + (tok0 + s0) * ldp + cq + hh * 128 + cc * 8); rk0 = *(const uint4*)(P + (tok0 + s0) * ldp + ck + hh * 128 + cc * 8);
        rq1 = *(const uint4*)(P + (tok0 + s1) * ldp + cq + hh * 128 + cc * 8); rk1 = *(const uint4*)(P + (tok0 + s1) * ldp + ck + hh * 128 + cc * 8);
    }
    for (int e = tid; e < 64 * 16; e += 512) {
        const int i = e >> 4, r = e & 15;
        const int s = dir ? (Sq - 1 - (64 * c + i)) : (64 * c + i);
        gzs[e] = gz[(tok0 + s) * 32 + dir * 16 + r];
    }
    const int d = tid & 127, seg = tid >> 7;
    const float* wg = dir ? wg_b : wg_f;
    float wcol[16];
#pragma unroll
    for (int r = 0; r < 16; ++r) wcol[r] = wg[r * 512 + hh * 128 + d];
    const float bias = (dir ? bg_b : bg_f)[hh * 128 + d];
    __syncthreads();
    float run = 0.f;
#pragma unroll
    for (int k = 0; k < 16; ++k) {
        const int i = 16 * seg + k;
        float z = bias;
#pragma unroll
        for (int r = 0; r < 16; ++r) z += gzs[i * 16 + r] * wcol[r];
        run += gla_logsigmoid(z) * (1.f / 16.f);
        bmat[i * 128 + d] = run;
    }
    segs[seg * 128 + d] = run;
    __syncthreads();
    if (seg == 0) {
        const float t0 = segs[d], t1 = segs[128 + d], t2 = segs[256 + d], t3 = segs[384 + d];
        segs[d] = 0.f; segs[128 + d] = t0; segs[256 + d] = t0 + t1; segs[384 + d] = t0 + t1 + t2; segs[512 + d] = t0 + t1 + t2 + t3;
        DECg[(size_t)item * 128 + d] = __expf(t0 + t1 + t2 + t3);
    }
    __syncthreads();
    const float qscale = 0.08838834764831845f;
#pragma unroll
    for (int k = 0; k < 2; ++k) {
        const int id = tid + 512 * k, i = id >> 4, cc = id & 15, d0 = cc * 8, sg = i >> 4;
        const uint4 qv = k ? rq1 : rq0, kv = k ? rk1 : rk0;
        const float qx[8] = {lo2f(qv.x), hi2f(qv.x), lo2f(qv.y), hi2f(qv.y), lo2f(qv.z), hi2f(qv.z), lo2f(qv.w), hi2f(qv.w)};
        const float kx[8] = {lo2f(kv.x), hi2f(kv.x), lo2f(kv.y), hi2f(kv.y), lo2f(kv.z), hi2f(kv.z), lo2f(kv.w), hi2f(kv.w)};
        float qd[8], ki[8], ke[8];
        const float4 bA = *(const float4*)(bmat + i * 128 + d0), bB = *(const float4*)(bmat + i * 128 + d0 + 4);
        const float4 oA = *(const float4*)(segs + sg * 128 + d0), oB = *(const float4*)(segs + sg * 128 + d0 + 4);
        const float4 tA = *(const float4*)(segs + 512 + d0), tB = *(const float4*)(segs + 512 + d0 + 4);
        const float bv[8] = {bA.x + oA.x, bA.y + oA.y, bA.z + oA.z, bA.w + oA.w, bB.x + oB.x, bB.y + oB.y, bB.z + oB.z, bB.w + oB.w};
        const float tv[8] = {tA.x, tA.y, tA.z, tA.w, tB.x, tB.y, tB.z, tB.w};
#pragma unroll
        for (int e = 0; e < 8; ++e) {
            const float bb = bv[e], tot = tv[e];
            qd[e] = qx[e] * qscale * __expf(bb); ki[e] = kx[e] * __expf(-bb); ke[e] = kx[e] * __expf(tot - bb);
        }
        const int o = i * 256 + ((cc ^ (i & 15)) << 4);
        *(uint4*)(QDs + o) = make_uint4(pack2(qd[0], qd[1]), pack2(qd[2], qd[3]), pack2(qd[4], qd[5]), pack2(qd[6], qd[7]));
        *(uint4*)(KIs + o) = make_uint4(pack2(ki[0], ki[1]), pack2(ki[2], ki[3]), pack2(ki[4], ki[5]), pack2(ki[6], ki[7]));
        *(uint4*)(KEs + o) = make_uint4(pack2(ke[0], ke[1]), pack2(ke[2], ke[3]), pack2(ke[4], ke[5]), pack2(ke[6], ke[7]));
    }
    __syncthreads();
    {
        uint4* qo = (uint4*)(QDg + (size_t)item * GLA_QD_BYTES); uint4* ko = (uint4*)(KEg + (size_t)item * GLA_QD_BYTES);
#pragma unroll
        for (int k = 0; k < 2; ++k) { const int e = tid + 512 * k; qo[e] = ((const uint4*)QDs)[e]; ko[e] = ((const uint4*)KEs)[e]; }
    }
#pragma unroll
    for (int tt = 0; tt < 2; ++tt) {
        const int tile = wave + 8 * tt, jt = tile >> 2, it = tile & 3;
        f32x4 acc = (f32x4){0.f, 0.f, 0.f, 0.f};
        if (jt <= it) {
            const int jr = 16 * jt + li, ir = 16 * it + li;
#pragma unroll
            for (int ks = 0; ks < 4; ++ks) {
                const bf16x8 kf = *(const bf16x8*)(KIs + jr * 256 + (((4 * ks + fq) ^ (jr & 15)) << 4));
                const bf16x8 qf = *(const bf16x8*)(QDs + ir * 256 + (((4 * ks + fq) ^ (ir & 15)) << 4));
                acc = __builtin_amdgcn_mfma_f32_16x16x32_bf16(kf, qf, acc, 0, 0, 0);
            }
        }
        const int i = 16 * it + li, j0 = 16 * jt + 4 * fq;
        float v[4];
#pragma unroll
        for (int jj = 0; jj < 4; ++jj) v[jj] = (j0 + jj <= i) ? acc[jj] : 0.f;
        const int chunk = 2 * jt + (fq >> 1), sub = (fq & 1) * 8;
        *(uint2*)(ATg + (size_t)item * GLA_AT_BYTES + i * 128 + ((chunk ^ (i & 7)) << 4) + sub) = make_uint2(pack2(v[0], v[1]), pack2(v[2], v[3]));
    }
}

__device__ __forceinline__ void gla_seq_item(const u16* __restrict__ P, int ldp, int cv, int Sq,
                                             const unsigned char* __restrict__ QDg, const unsigned char* __restrict__ KEg, const unsigned char* __restrict__ ATg, const float* __restrict__ DECg,
                                             u16* __restrict__ Oout  , int Ttot, unsigned char* lds, int item) {
    const int slice = item & 1, dir = (item >> 1) & 1, hh = (item >> 2) & 3, b = item >> 4;
    const int nch = Sq / 64;
    const int tid = TID, lane = tid & 63, wave = tid >> 6, li = lane & 15, fq = lane >> 4;
    const size_t tok0 = (size_t)b * Sq;
    const int pitem0 = ((b * 4 + hh) * 2 + dir) * nch;
    constexpr int BUF = 16384 * 3 + 8192 + 512;
    typedef unsigned gla_u32x4 __attribute__((ext_vector_type(4)));
    gla_u32x4 rq0, rq1, rk0, rk1, rv0, rv1, ra; float rd = 0.f;
#define GLA_VROW(c_, k_) ((tok0 + (size_t)(dir ? (Sq - 1 - (64 * (c_) + ((tid + 512 * (k_)) >> 4))) : (64 * (c_) + ((tid + 512 * (k_)) >> 4)))) * ldp + cv + hh * 256 + slice * 128 + ((tid + 512 * (k_)) & 15) * 8)
#define GLA_ISSUE(c_) do { \
        const gla_u32x4* qsrc_ = (const gla_u32x4*)(QDg + (size_t)(pitem0 + (c_)) * GLA_QD_BYTES); const gla_u32x4* ksrc_ = (const gla_u32x4*)(KEg + (size_t)(pitem0 + (c_)) * GLA_QD_BYTES); \
        rq0 = qsrc_[tid]; rq1 = qsrc_[tid + 512]; rk0 = ksrc_[tid]; rk1 = ksrc_[tid + 512]; \
        ra = ((const gla_u32x4*)(ATg + (size_t)(pitem0 + (c_)) * GLA_AT_BYTES))[tid]; \
        rv0 = *(const gla_u32x4*)(P + GLA_VROW(c_, 0)); rv1 = *(const gla_u32x4*)(P + GLA_VROW(c_, 1)); \
        if (tid < 128) rd = DECg[(size_t)(pitem0 + (c_)) * 128 + tid]; } while (0)
#define GLA_COMMIT(buf_) do { \
        unsigned char* base_ = lds + (buf_) * BUF; \
        ((gla_u32x4*)base_)[tid] = rq0; ((gla_u32x4*)base_)[tid + 512] = rq1; ((gla_u32x4*)(base_ + 16384))[tid] = rk0; ((gla_u32x4*)(base_ + 16384))[tid + 512] = rk1; \
        { const int row_ = tid >> 4, ch_ = tid & 15; *(gla_u32x4*)(base_ + 32768 + row_ * 256 + ((ch_ ^ (row_ & 15)) << 4)) = rv0; } \
        { const int row_ = (tid + 512) >> 4, ch_ = tid & 15; *(gla_u32x4*)(base_ + 32768 + row_ * 256 + ((ch_ ^ (row_ & 15)) << 4)) = rv1; } \
        ((gla_u32x4*)(base_ + 49152))[tid] = ra; \
        if (tid < 128) ((float*)(base_ + 57344))[tid] = rd; } while (0)
    f32x4 st[8];
#pragma unroll
    for (int dt = 0; dt < 8; ++dt) st[dt] = (f32x4){0.f, 0.f, 0.f, 0.f};
    __syncthreads();
    GLA_ISSUE(0); GLA_COMMIT(0);
    __syncthreads();
#pragma unroll 1
    for (int c = 0; c < nch; ++c) {
        const int buf = c & 1;
        if (c + 1 < nch) GLA_ISSUE(c + 1);
        const unsigned char* QDs = lds + buf * BUF; const unsigned char* KEs = QDs + 16384; const unsigned char* Vs = QDs + 32768;
        const unsigned char* ATs = QDs + 49152; const float* DECs = (const float*)(QDs + 57344);
        bf16x8 vf[2];
#pragma unroll
        for (int jp = 0; jp < 2; ++jp) {
            const int rowA = 32 * jp + 8 * fq + (li >> 2), rowB = rowA + 4;
            const int chunk = 2 * wave + ((li & 3) >> 1), sub = ((li & 3) & 1) * 8;
            const s16x4 va = __builtin_amdgcn_ds_read_tr16_b64_v4i16((LAS s16x4*)(Vs + rowA * 256 + ((chunk ^ (rowA & 15)) << 4) + sub));
            const s16x4 vb = __builtin_amdgcn_ds_read_tr16_b64_v4i16((LAS s16x4*)(Vs + rowB * 256 + ((chunk ^ (rowB & 15)) << 4) + sub));
            vf[jp] = __builtin_shufflevector(va, vb, 0, 1, 2, 3, 4, 5, 6, 7);
        }
        bf16x8 sf[4];
#pragma unroll
        for (int dp = 0; dp < 4; ++dp) {
            const gla_u32x4 t_ = {pack2(st[2 * dp][0], st[2 * dp][1]), pack2(st[2 * dp][2], st[2 * dp][3]), pack2(st[2 * dp + 1][0], st[2 * dp + 1][1]), pack2(st[2 * dp + 1][2], st[2 * dp + 1][3])};
            sf[dp] = __builtin_bit_cast(bf16x8, t_);
        }
        f32x4 ot[4];
#pragma unroll
        for (int it = 0; it < 4; ++it) {
            f32x4 acc = (f32x4){0.f, 0.f, 0.f, 0.f};
            const int ir = 16 * it + li;
#pragma unroll
            for (int dp = 0; dp < 4; ++dp) {
                const int c0 = 4 * dp + (fq >> 1), c1 = c0 + 2, sub = (fq & 1) * 8;
                const uint2 lo = *(const uint2*)(QDs + ir * 256 + ((c0 ^ (ir & 15)) << 4) + sub);
                const uint2 hi = *(const uint2*)(QDs + ir * 256 + ((c1 ^ (ir & 15)) << 4) + sub);
                const gla_u32x4 q_ = {lo.x, lo.y, hi.x, hi.y};
                const bf16x8 qf = __builtin_bit_cast(bf16x8, q_);
                acc = __builtin_amdgcn_mfma_f32_16x16x32_bf16(sf[dp], qf, acc, 0, 0, 0);
            }
#pragma unroll
            for (int jp = 0; jp < 2; ++jp) {
                if (32 * jp <= 16 * it + 15) {
                    const bf16x8 af = *(const bf16x8*)(ATs + ir * 128 + (((4 * jp + fq) ^ (ir & 7)) << 4));
                    acc = __builtin_amdgcn_mfma_f32_16x16x32_bf16(vf[jp], af, acc, 0, 0, 0);
                }
            }
            ot[it] = acc;
        }
#pragma unroll
        for (int dt = 0; dt < 8; ++dt) {
            const f32x4 dec = *(const f32x4*)(DECs + 16 * dt + 4 * fq);
            f32x4 acc = st[dt] * dec;
#pragma unroll
            for (int jp = 0; jp < 2; ++jp) {
                const int rowA = 32 * jp + 8 * fq + (li >> 2), rowB = rowA + 4;
                const int chunk = 2 * dt + ((li & 3) >> 1), sub = ((li & 3) & 1) * 8;
                const s16x4 ka = __builtin_amdgcn_ds_read_tr16_b64_v4i16((LAS s16x4*)(KEs + rowA * 256 + ((chunk ^ (rowA & 15)) << 4) + sub));
                const s16x4 kb = __builtin_amdgcn_ds_read_tr16_b64_v4i16((LAS s16x4*)(KEs + rowB * 256 + ((chunk ^ (rowB & 15)) << 4) + sub));
                const bf16x8 kf = __builtin_shufflevector(ka, kb, 0, 1, 2, 3, 4, 5, 6, 7);
                acc = __builtin_amdgcn_mfma_f32_16x16x32_bf16(kf, vf[jp], acc, 0, 0, 0);
            }
            st[dt] = acc;
        }
#pragma unroll
        for (int it = 0; it < 4; ++it) {
            const int i = 16 * it + li;
            const int s = dir ? (Sq - 1 - (64 * c + i)) : (64 * c + i);
            *(uint2*)(Oout + ((size_t)dir * Ttot + tok0 + s) * 1024 + hh * 256 + slice * 128 + 16 * wave + 4 * fq) =
                make_uint2(pack2(ot[it][0], ot[it][1]), pack2(ot[it][2], ot[it][3]));
        }
        if (c + 1 < nch) GLA_COMMIT(buf ^ 1);
        __syncthreads();
    }
}
__device__ __forceinline__ void phase_rope_prep(const Args& a, unsigned char* lds) {
    u16* P = (u16*)(a.ws + WS_P);
    const float2* cs = (const float2*)(a.ws + WS_CS);
    const int gt = blockIdx.x * NTHREADS + threadIdx.x, NT = gridDim.x * NTHREADS;
    for (int item = blockIdx.x; item < GLA_NPREP; item += gridDim.x)
        gla_prep_item(P, NP, C_GQ, C_GK, (const float*)(a.ws + WS_GZ), a.wgf, a.bgf, a.wgb, a.bgb, S,
                      a.ws + WS_QD, a.ws + WS_KE, a.ws + WS_AT, (float*)(a.ws + WS_DEC), lds, item);
}

#define ATTN_DECODE(item_) \
    const int nb_per = Sq / 128; \
    const int within = (item_) % nb_per, hh = ((item_) / nb_per) & 7, b = ((item_) / (nb_per * 8)) & 3, pat = (item_) / (nb_per * 32); \
    const int dil = pat == 0 ? 1 : (pat == 1 ? 4 : 16); \
    const int M = Sq / dil; \
    const int r = within % dil, blk = within / dil; \
    const int p0 = blk * 128, kbase = p0 - 64; \
    const size_t tok0 = (size_t)b * Sq;
typedef unsigned attn_u32x4 __attribute__((ext_vector_type(4)));
__device__ __forceinline__ void attn_phase(const u16* __restrict__ P, int ldp, int cq, int ck, int cv, int Sq,
                                           u16* __restrict__ part_o, float* __restrict__ part_lse, int Ttot,
                                           unsigned char* lds, int first, int stride, int nitems) {
    const int tid = TID, lane = tid & 63, wave = tid >> 6, li = lane & 15, fq = lane >> 4;
    unsigned char* Ks = lds;
    unsigned char* Vs = lds + 65536;
    attn_u32x4 kr0, kr1, kr2, kr3, kr4, kr5, kr6, kr7, vr0, vr1, vr2, vr3, vr4, vr5, vr6, vr7;
    bf16x8 qn0, qn1, qn2, qn3;
#define ATTN_LD1(i_, kreg_, vreg_) { const int id_ = tid + 512 * (i_), row_ = id_ >> 4, c_ = id_ & 15; \
        int kp_ = kbase + row_; kp_ = kp_ < 0 ? 0 : (kp_ > M - 1 ? M - 1 : kp_); \
        const size_t t_ = tok0 + r + (size_t)dil * kp_; \
        kreg_ = *(const attn_u32x4*)(P + t_ * ldp + ck + hh * 128 + c_ * 8); vreg_ = *(const attn_u32x4*)(P + t_ * ldp + cv + hh * 128 + c_ * 8); }
#define ATTN_LOAD(item_) do { ATTN_DECODE(item_) \
        { const size_t tq_ = tok0 + r + (size_t)dil * (p0 + 16 * wave + li); const u16* qp_ = P + tq_ * ldp + cq + hh * 128 + 8 * fq; \
          qn0 = *(const bf16x8*)(qp_); qn1 = *(const bf16x8*)(qp_ + 32); qn2 = *(const bf16x8*)(qp_ + 64); qn3 = *(const bf16x8*)(qp_ + 96); } \
        ATTN_LD1(0, kr0, vr0) ATTN_LD1(1, kr1, vr1) ATTN_LD1(2, kr2, vr2) ATTN_LD1(3, kr3, vr3) ATTN_LD1(4, kr4, vr4) ATTN_LD1(5, kr5, vr5) ATTN_LD1(6, kr6, vr6) ATTN_LD1(7, kr7, vr7) } while (0)
#define ATTN_ST1(i_, kreg_, vreg_) { const int id_ = tid + 512 * (i_), row_ = id_ >> 4, c_ = id_ & 15; const int off_ = row_ * 256 + ((c_ ^ (row_ & 15)) << 4); \
        *(attn_u32x4*)(Ks + off_) = kreg_; *(attn_u32x4*)(Vs + off_) = vreg_; }
#define ATTN_COMMIT() do { ATTN_ST1(0, kr0, vr0) ATTN_ST1(1, kr1, vr1) ATTN_ST1(2, kr2, vr2) ATTN_ST1(3, kr3, vr3) ATTN_ST1(4, kr4, vr4) ATTN_ST1(5, kr5, vr5) ATTN_ST1(6, kr6, vr6) ATTN_ST1(7, kr7, vr7) } while (0)
    int item = first;
    if (item < nitems) ATTN_LOAD(item);
    for (; item < nitems; item += stride) {
        ATTN_DECODE(item)
        __syncthreads();
        ATTN_COMMIT();
        const int qp = p0 + 16 * wave + li;
        const size_t tq = tok0 + r + (size_t)dil * qp;
        const bf16x8 qf[4] = {qn0, qn1, qn2, qn3};
        __syncthreads();
        if (item + stride < nitems) ATTN_LOAD(item + stride);
        const float scale = 0.08838834764831845f;
        float m = -1e30f, l = 0.f;
        f32x4 o[8];
#pragma unroll
        for (int dt = 0; dt < 8; ++dt) o[dt] = (f32x4){0.f, 0.f, 0.f, 0.f};
        const bool edge = (blk == 0) || (p0 + 128 >= M);
#define ATTN_SOFTMAX_PV(MASKED_) do { \
            float mx = -1e30f; \
            _Pragma("unroll") for (int j = 0; j < 8; ++j) mx = ((MASKED_) && !ok[j]) ? mx : fmaxf(mx, s[j]); \
            mx = fmaxf(mx, __shfl_xor(mx, 16)); \
            mx = fmaxf(mx, __shfl_xor(mx, 32)); \
            const float mn = fmaxf(m, mx); \
            const float al = __expf(m - mn); \
            float ps = 0.f; float p[8]; \
            _Pragma("unroll") for (int j = 0; j < 8; ++j) { p[j] = ((MASKED_) && !ok[j]) ? 0.f : __expf(s[j] - mn); ps += p[j]; } \
            l = l * al + ps; m = mn; \
            const attn_u32x4 p_ = {pack2(p[0], p[1]), pack2(p[2], p[3]), pack2(p[4], p[5]), pack2(p[6], p[7])}; \
            const bf16x8 pf = __builtin_bit_cast(bf16x8, p_); \
            _Pragma("unroll") for (int dt = 0; dt < 8; ++dt) o[dt] *= al; \
            int rowA = 16 * wave + 32 * tp + 4 * fq + (li >> 2); rowA = rowA > 255 ? 255 : rowA; \
            int rowB = 16 * wave + 32 * tp + 16 + 4 * fq + (li >> 2); rowB = rowB > 255 ? 255 : rowB; \
            _Pragma("unroll") for (int dt = 0; dt < 8; ++dt) { \
                const int chunk = 2 * dt + ((li & 3) >> 1), sub = ((li & 3) & 1) * 8; \
                const s16x4 va = __builtin_amdgcn_ds_read_tr16_b64_v4i16((LAS s16x4*)(Vs + rowA * 256 + ((chunk ^ (rowA & 15)) << 4) + sub)); \
                s16x4 vb = va; \
                if (!lastt) vb = __builtin_amdgcn_ds_read_tr16_b64_v4i16((LAS s16x4*)(Vs + rowB * 256 + ((chunk ^ (rowB & 15)) << 4) + sub)); \
                const bf16x8 vf = __builtin_shufflevector(va, vb, 0, 1, 2, 3, 4, 5, 6, 7); \
                o[dt] = __builtin_amdgcn_mfma_f32_16x16x32_bf16(vf, pf, o[dt], 0, 0, 0); } } while (0)
#define ATTN_QK(tp_, sdst_) do { _Pragma("unroll") for (int h2 = 0; h2 < 2; ++h2) { \
                const int kk0 = 16 * wave + 16 * (2 * (tp_) + h2); \
                int krow = kk0 + li; krow = krow > 255 ? 255 : krow; \
                f32x4 acc = (f32x4){0.f, 0.f, 0.f, 0.f}; \
                if (!((tp_) == 4 && h2 == 1)) {            \
                    _Pragma("unroll") for (int ks = 0; ks < 4; ++ks) { \
                        const bf16x8 kf = *(const bf16x8*)(Ks + krow * 256 + (((4 * ks + fq) ^ (krow & 15)) << 4)); \
                        acc = __builtin_amdgcn_mfma_f32_16x16x32_bf16(kf, qf[ks], acc, 0, 0, 0); } } \
                _Pragma("unroll") for (int j = 0; j < 4; ++j) sdst_[4 * h2 + j] = acc[j] * scale; } } while (0)
        float sn[8];
        ATTN_QK(0, sn);
#pragma unroll 1
        for (int tp = 0; tp < 5; ++tp) {
            const bool lastt = (tp == 4);
            float s[8]; bool ok[8];
#pragma unroll
            for (int j = 0; j < 8; ++j) s[j] = sn[j];
            if (!lastt) ATTN_QK(tp + 1, sn);
            if (edge || tp == 0 || lastt) {
#pragma unroll
                for (int h2 = 0; h2 < 2; ++h2)
#pragma unroll
                    for (int j = 0; j < 4; ++j) {
                        const int kp = kbase + 16 * wave + 16 * (2 * tp + h2) + 4 * fq + j;
                        const int rel = kp - qp;
                        ok[4 * h2 + j] = (kp >= 0) && (kp < M) && (rel <= 64) && (rel >= -64);
                    }
                ATTN_SOFTMAX_PV(1);
            } else {
#pragma unroll
                for (int j = 0; j < 8; ++j) ok[j] = true;
                ATTN_SOFTMAX_PV(0);
            }
        }
#undef ATTN_QK
#undef ATTN_SOFTMAX_PV
        l += __shfl_xor(l, 16);
        l += __shfl_xor(l, 32);
        const float inv = 1.f / l;
        u16* orow = part_o + ((size_t)pat * Ttot + tq) * 1024 + hh * 128 + 4 * fq;
#pragma unroll
        for (int dt = 0; dt < 8; ++dt)
            *(uint2*)(orow + 16 * dt) = make_uint2(pack2(o[dt][0] * inv, o[dt][1] * inv), pack2(o[dt][2] * inv, o[dt][3] * inv));
        if (fq == 0) part_lse[((size_t)pat * Ttot + tq) * 8 + hh] = m + logf(l);
    }
#undef ATTN_LD1
#undef ATTN_LOAD
#undef ATTN_ST1
#undef ATTN_COMMIT
}

__device__ __forceinline__ void attn_merge_token(const u16* __restrict__ part_o, const float* __restrict__ part_lse, int Ttot, size_t t,
                                                 u16* __restrict__ dst  , int lane) {
    const int hh = lane >> 3;
    const float l0 = part_lse[((size_t)0 * Ttot + t) * 8 + hh], l1 = part_lse[((size_t)1 * Ttot + t) * 8 + hh], l2 = part_lse[((size_t)2 * Ttot + t) * 8 + hh];
    const float mx = fmaxf(l0, fmaxf(l1, l2));
    const float e0 = __expf(l0 - mx), e1 = __expf(l1 - mx), e2 = __expf(l2 - mx);
    const float inv = 1.f / (e0 + e1 + e2);
    const float w[3] = {e0 * inv, e1 * inv, e2 * inv};
    float acc[16];
#pragma unroll
    for (int i = 0; i < 16; ++i) acc[i] = 0.f;
#pragma unroll
    for (int p = 0; p < 3; ++p) {
        const uint4* src = (const uint4*)(part_o + ((size_t)p * Ttot + t) * 1024 + lane * 16);
        const uint4 a = src[0], bb = src[1];
        acc[0] += w[p] * lo2f(a.x); acc[1] += w[p] * hi2f(a.x); acc[2] += w[p] * lo2f(a.y); acc[3] += w[p] * hi2f(a.y);
        acc[4] += w[p] * lo2f(a.z); acc[5] += w[p] * hi2f(a.z); acc[6] += w[p] * lo2f(a.w); acc[7] += w[p] * hi2f(a.w);
        acc[8] += w[p] * lo2f(bb.x); acc[9] += w[p] * hi2f(bb.x); acc[10] += w[p] * lo2f(bb.y); acc[11] += w[p] * hi2f(bb.y);
        acc[12] += w[p] * lo2f(bb.z); acc[13] += w[p] * hi2f(bb.z); acc[14] += w[p] * lo2f(bb.w); acc[15] += w[p] * hi2f(bb.w);
    }
    uint4* d = (uint4*)(dst + lane * 16);
    d[0] = make_uint4(pack2(acc[0], acc[1]), pack2(acc[2], acc[3]), pack2(acc[4], acc[5]), pack2(acc[6], acc[7]));
    d[1] = make_uint4(pack2(acc[8], acc[9]), pack2(acc[10], acc[11]), pack2(acc[12], acc[13]), pack2(acc[14], acc[15]));
}

__device__ __forceinline__ void phase_mixers(const Args& a, unsigned char* lds) {
    const int bi = blockIdx.x, G = gridDim.x;
    if (bi < 64) {
        gla_seq_item((const u16*)(a.ws + WS_P), NP, C_GV, S, a.ws + WS_QD, a.ws + WS_KE, a.ws + WS_AT, (const float*)(a.ws + WS_DEC),
                     (u16*)(a.ws + WS_OFB), T, lds, bi);
    } else {
        u16* part_o = (u16*)a.out; float* part_lse = (float*)((unsigned char*)a.out + (size_t)3 * T * 1024 * 2);
        attn_phase((const u16*)(a.ws + WS_P), NP, C_DQ, C_DK, C_DV, S, part_o, part_lse, T, lds, bi - 64, G - 64, 3 * 4 * 8 * (S / 128));
    }
}

__device__ __forceinline__ void phase_gla_fin(const Args& a) {
    const u16* Of = (const u16*)(a.ws + WS_OFB);
    const u16* Ob = Of + (size_t)T * 1024;
    const u16* P = (const u16*)(a.ws + WS_P);
    u16* A2 = (u16*)(a.ws + WS_ACT);
    const u16* part_o = (const u16*)a.out; const float* part_lse = (const float*)((const unsigned char*)a.out + (size_t)3 * T * 1024 * 2);
    const int lane = threadIdx.x & 63, wave = threadIdx.x >> 6;
    const int gw = blockIdx.x * NWAVES + wave, NGW = gridDim.x * NWAVES;
    const int hh = lane >> 4;
    float gg[16];
#pragma unroll
    for (int k = 0; k < 4; ++k) { const float4 g4 = *(const float4*)(a.g_gla + lane * 16 + 4 * k); gg[4 * k] = g4.x; gg[4 * k + 1] = g4.y; gg[4 * k + 2] = g4.z; gg[4 * k + 3] = g4.w; }
    for (int t = gw; t < T; t += NGW) {
        const uint4* fp = (const uint4*)(Of + (size_t)t * 1024 + lane * 16); const uint4* bp = (const uint4*)(Ob + (size_t)t * 1024 + lane * 16);
        const uint4* rp = (const uint4*)(P + (size_t)t * NP + C_GR + lane * 16);
#define NT16(p_) ({ const f32x4 q_ = __builtin_nontemporal_load((const f32x4*)(p_)); make_uint4(__float_as_uint(q_[0]), __float_as_uint(q_[1]), __float_as_uint(q_[2]), __float_as_uint(q_[3])); })
        const uint4 f0 = NT16(fp), f1 = NT16(fp + 1), b0 = NT16(bp), b1 = NT16(bp + 1), r0 = NT16(rp), r1 = NT16(rp + 1);
#undef NT16
        attn_merge_token(part_o, part_lse, T, (size_t)t, A2 + (size_t)t * D + 1024, lane);
        const unsigned fw[8] = {f0.x, f0.y, f0.z, f0.w, f1.x, f1.y, f1.z, f1.w}, bw[8] = {b0.x, b0.y, b0.z, b0.w, b1.x, b1.y, b1.z, b1.w};
        const unsigned rw[8] = {r0.x, r0.y, r0.z, r0.w, r1.x, r1.y, r1.z, r1.w};
        float o[16]; float ss = 0.f;
#pragma unroll
        for (int k = 0; k < 8; ++k) { o[2 * k] = lo2f(fw[k]) + lo2f(bw[k]); o[2 * k + 1] = hi2f(fw[k]) + hi2f(bw[k]); ss += o[2 * k] * o[2 * k] + o[2 * k + 1] * o[2 * k + 1]; }
        ss += __shfl_xor(ss, 1); ss += __shfl_xor(ss, 2); ss += __shfl_xor(ss, 4); ss += __shfl_xor(ss, 8);
        const float rstd = rsqrtf(ss * (1.f / 256.f) + NORM_EPS);
        unsigned y[8];
#pragma unroll
        for (int k = 0; k < 8; ++k) y[k] = pack2(o[2 * k] * rstd * gg[2 * k] * silu_f(lo2f(rw[k])), o[2 * k + 1] * rstd * gg[2 * k + 1] * silu_f(hi2f(rw[k])));
        uint4* dp = (uint4*)(A2 + (size_t)t * D + lane * 16);
        dp[0] = make_uint4(y[0], y[1], y[2], y[3]); dp[1] = make_uint4(y[4], y[5], y[6], y[7]);
    }
    (void)hh;
}

typedef float f32x16 __attribute__((ext_vector_type(16)));
#define RT_CE(a_, b_) do { const float hi_ = fmaxf(a_, b_), lo_ = fminf(a_, b_); a_ = hi_; b_ = lo_; } while (0)
template <int N> __device__ __forceinline__ void rt_sort_desc(float (&v)[N], int base) {
#pragma unroll
    for (int k = 2; k <= 16; k <<= 1)
#pragma unroll
        for (int j = k >> 1; j > 0; j >>= 1)
#pragma unroll
            for (int i = 0; i < 16; ++i) {
                const int l = i ^ j;
                if (l > i) { if ((i & k) == 0) RT_CE(v[base + i], v[base + l]); else RT_CE(v[base + l], v[base + i]); }
            }
}
template <int N> __device__ __forceinline__ void rt_merge_desc(float (&v)[N], int a, int b) {
#pragma unroll
    for (int i = 0; i < 16; ++i) v[a + i] = fmaxf(v[a + i], v[b + 15 - i]);
#pragma unroll
    for (int j = 8; j > 0; j >>= 1)
#pragma unroll
        for (int i = 0; i < 16; ++i) { const int l = i ^ j; if (l > i) RT_CE(v[a + i], v[a + l]); }
}

__device__ __forceinline__ void route_stage_keys(const float* __restrict__ subk, int hh, unsigned char* lds) {
    const int tid = TID;
    __syncthreads();
    for (int e = tid; e < 2 * 128 * 16; e += 512) {
        const int c = e & 15, row = e >> 4;
        const float* src = subk + ((size_t)(hh * 2) * 128 + row) * 128 + c * 8;
        const float4 v0 = *(const float4*)src, v1 = *(const float4*)(src + 4);
        *(uint4*)(lds + row * 256 + ((c ^ (row & 15)) << 4)) = make_uint4(pack2(v0.x, v0.y), pack2(v0.z, v0.w), pack2(v1.x, v1.y), pack2(v1.z, v1.w));
    }
    __syncthreads();
}

__device__ __forceinline__ void route_tile(const u16* __restrict__ Q, int ldq, int hh, int tok_base, const unsigned char* lds,
                                           int* __restrict__ IDX, float* __restrict__ GATE) {
    const int lane = TID & 63, r = lane & 31, h = lane >> 5;
    float sc[128];
    {
        f32x16 X[4], Y[4];
#pragma unroll
        for (int kt = 0; kt < 4; ++kt) {
#pragma unroll
            for (int i = 0; i < 16; ++i) { X[kt][i] = 0.f; Y[kt][i] = 0.f; }
        }
        const u16* qrow = Q + (size_t)(tok_base + r) * ldq + hh * 256;
#pragma unroll
        for (int half = 0; half < 2; ++half) {
            bf16x8 qf[8];
#pragma unroll
            for (int ks = 0; ks < 8; ++ks) qf[ks] = *(const bf16x8*)(qrow + half * 128 + 16 * ks + 8 * h);
#pragma unroll
            for (int kt = 0; kt < 4; ++kt) {
                const int krow = half * 128 + 32 * kt + r;
#pragma unroll
                for (int ks = 0; ks < 8; ++ks) {
                    const bf16x8 kf = *(const bf16x8*)(lds + krow * 256 + (((2 * ks + h) ^ (krow & 15)) << 4));
                    if (half == 0) X[kt] = __builtin_amdgcn_mfma_f32_32x32x16_bf16(kf, qf[ks], X[kt], 0, 0, 0);
                    else Y[kt] = __builtin_amdgcn_mfma_f32_32x32x16_bf16(kf, qf[ks], Y[kt], 0, 0, 0);
                }
            }
        }
#pragma unroll
        for (int kt = 0; kt < 4; ++kt)
#pragma unroll
            for (int i = 0; i < 16; ++i) {
                const auto sw = __builtin_amdgcn_permlane32_swap(__float_as_uint(X[kt][i]), __float_as_uint(Y[kt][i]), false, false);
                const int key0 = 32 * kt + (i & 3) + 8 * (i >> 2);
                sc[kt * 32 + i] = __uint_as_float((sw[0] & 0xffffff80u) | (unsigned)key0);
                sc[kt * 32 + 16 + i] = __uint_as_float((sw[1] & 0xffffff80u) | (unsigned)(key0 + 4));
            }
    }
#pragma unroll
    for (int g = 0; g < 8; ++g) rt_sort_desc(sc, 16 * g);
    rt_merge_desc(sc, 0, 16); rt_merge_desc(sc, 32, 48); rt_merge_desc(sc, 64, 80); rt_merge_desc(sc, 96, 112);
    rt_merge_desc(sc, 0, 32); rt_merge_desc(sc, 64, 96);
    rt_merge_desc(sc, 0, 64);
    float l0[16], l1[16];
#pragma unroll
    for (int i = 0; i < 16; ++i) {
        const auto sw = __builtin_amdgcn_permlane32_swap(__float_as_uint(sc[i]), __float_as_uint(sc[i]), false, false);
        l0[i] = __uint_as_float(sw[0]); l1[i] = __uint_as_float(sw[1]);
    }
    float s0[16], s1[16]; int k0[16], k1[16];
#pragma unroll
    for (int i = 0; i < 16; ++i) {
        const unsigned a = __float_as_uint(l0[i]), b = __float_as_uint(l1[i]);
        s0[i] = __uint_as_float(a & 0xffffff80u); k0[i] = (int)(a & 0x7fu);
        s1[i] = __uint_as_float(b & 0xffffff80u); k1[i] = (int)(b & 0x7fu);
    }
    float cs[64];
    {
        int n = 0;
#pragma unroll
        for (int i = 0; i < 16; ++i)
#pragma unroll
            for (int j = 0; j < 16; ++j)
                if ((i + 1) * (j + 1) <= 16) { cs[n] = s0[i] + s1[j]; ++n; }
#pragma unroll
        for (int q = 50; q < 64; ++q) cs[q] = -3.0e38f;
    }
    float ct[64];
#pragma unroll
    for (int q = 0; q < 64; ++q) ct[q] = cs[q];
#pragma unroll
    for (int g = 0; g < 4; ++g) rt_sort_desc(ct, 16 * g);
    rt_merge_desc(ct, 0, 16); rt_merge_desc(ct, 32, 48); rt_merge_desc(ct, 0, 32);
    const float theta = ct[15], smax = ct[0];
    float den = 0.f;
    {
        int cnt = 0;
#pragma unroll
        for (int q = 0; q < 50; ++q) { const bool sel = (cs[q] >= theta) && (cnt < 16); den += sel ? __expf(cs[q] - smax) : 0.f; cnt += sel ? 1 : 0; }
    }
    const float inv = 1.f / den;
    const size_t obase = (size_t)(tok_base + r) * 128 + hh * 16;
    int pos = 0;
    {
        int n = 0;
#pragma unroll
        for (int i = 0; i < 16; ++i)
#pragma unroll
            for (int j = 0; j < 16; ++j)
                if ((i + 1) * (j + 1) <= 16) {
                    const bool sel = (cs[n] >= theta) && (pos < 16);
                    if (sel) {
                        if (h == 0) IDX[obase + pos] = k0[i] * 128 + k1[j];
                        else GATE[obase + pos] = __expf(cs[n] - smax) * inv;
                        ++pos;
                    }
                    ++n;
                }
    }
}
__device__ __forceinline__ void phase_route(const Args& a, unsigned char* lds) {
    const int hh = BID & 7, grp = BID >> 3, ngrp = GDIM >> 3, wave = TID >> 6;
    route_stage_keys(a.subk, hh, lds);
    int j = 0;
    for (int tile = grp; tile < T / 32; tile += ngrp, ++j)
        if ((j & 7) == wave) route_tile((const u16*)(a.ws + WS_Q), D, hh, tile * 32, lds, (int*)(a.ws + WS_IDX), (float*)(a.ws + WS_GATE));
    __syncthreads();
}

typedef __bf16 bf16x2_t __attribute__((ext_vector_type(2)));
__device__ __forceinline__ float dot2bf(unsigned w, unsigned x, float acc) {
    return __builtin_amdgcn_fdot2_f32_bf16(__builtin_bit_cast(bf16x2_t, w), __builtin_bit_cast(bf16x2_t, x), acc, false);
}
constexpr int TROW = 1024;
typedef float f32x2_t __attribute__((ext_vector_type(2)));
typedef int i32x8 __attribute__((ext_vector_type(8)));
__device__ __forceinline__ void convert_tables(const Args& a) {
    const int lane = threadIdx.x & 63, wave = threadIdx.x >> 6;
    const int gw = blockIdx.x * NWAVES + wave, NGW = gridDim.x * NWAVES;
    for (int row = gw; row < 2 * 16384; row += NGW) {
        const bool isv = row >= 16384; const int e = isv ? row - 16384 : row;
        const f32x4* sp = (const f32x4*)((isv ? a.pv : a.pu) + (size_t)e * D);
        unsigned char* dst = a.ws + (isv ? WS_TV + (size_t)e * 1024 : WS_TU + (size_t)e * 128);
        unsigned char* sdst = a.ws + (isv ? WS_SV + (size_t)e * 64 : WS_SU + (size_t)e * 8);
        f32x4 v[8];
#pragma unroll
        for (int k = 0; k < 8; ++k) v[k] = __builtin_nontemporal_load(sp + lane + 64 * k);
#pragma unroll
        for (int k = 0; k < 8; ++k) {
            float mx = fmaxf(fmaxf(fabsf(v[k][0]), fabsf(v[k][1])), fmaxf(fabsf(v[k][2]), fabsf(v[k][3])));
            mx = fmaxf(mx, __shfl_xor(mx, 1)); mx = fmaxf(mx, __shfl_xor(mx, 2)); mx = fmaxf(mx, __shfl_xor(mx, 4));
            const unsigned bits = __float_as_uint(mx);
            int kx = (int)(bits >> 23) - 127 - 2 + (((bits & 0x7fffffu) > 0x400000u) ? 1 : 0);
            kx = kx < -126 ? -126 : kx;
            const float inv = __uint_as_float((unsigned)(127 - kx) << 23);
            unsigned p = 0u;
            p = __builtin_amdgcn_cvt_scalef32_pk_fp4_f32(p, v[k][0] * inv, v[k][1] * inv, 1.0f, 0);
            p = __builtin_amdgcn_cvt_scalef32_pk_fp4_f32(p, v[k][2] * inv, v[k][3] * inv, 1.0f, 1);
            *(u16*)(dst + (isv ? (size_t)k * 128 : (size_t)k * SLICE_T) + 2 * lane) = (u16)p;
            if ((lane & 7) == 0) {
                const int c = lane >> 3;
                if (isv) sdst[8 * k + c] = (unsigned char)(kx + 127); else sdst[(size_t)k * SLICE_S + 2 * (c & 3) + (c >> 2)] = (unsigned char)(kx + 127);
            }
        }
    }
}

__device__ __forceinline__ void axpy32_fp4(const uint4 w, const float s, float (&acc)[32]) {
    const unsigned ww[4] = {w.x, w.y, w.z, w.w};
#pragma unroll
    for (int k = 0; k < 4; ++k) {
        const f32x2_t a0 = __builtin_amdgcn_cvt_scalef32_pk_f32_fp4(ww[k], 1.0f, 0), a1 = __builtin_amdgcn_cvt_scalef32_pk_f32_fp4(ww[k], 1.0f, 1);
        const f32x2_t a2 = __builtin_amdgcn_cvt_scalef32_pk_f32_fp4(ww[k], 1.0f, 2), a3 = __builtin_amdgcn_cvt_scalef32_pk_f32_fp4(ww[k], 1.0f, 3);
        acc[8 * k + 0] += s * a0.x; acc[8 * k + 1] += s * a0.y; acc[8 * k + 2] += s * a1.x; acc[8 * k + 3] += s * a1.y;
        acc[8 * k + 4] += s * a2.x; acc[8 * k + 5] += s * a2.y; acc[8 * k + 6] += s * a3.x; acc[8 * k + 7] += s * a3.y;
    }
}
#define DPP_F(v_, ctrl_) __builtin_bit_cast(float, __builtin_amdgcn_update_dpp(0, __builtin_bit_cast(int, v_), ctrl_, 0xf, 0xf, true))
__device__ __forceinline__ void phase_eu(const Args& a, unsigned char* lds) {
    const int* IDX = (const int*)(a.ws + WS_IDX);
    u16* AP = (u16*)(a.ws + WS_AP);
    const int lane = threadIdx.x & 63, wave = threadIdx.x >> 6;
    const int x = blockIdx.x & 7, gw = (blockIdx.x >> 3) * NWAVES + wave, NGW = (((int)gridDim.x - x + 7) >> 3) * NWAVES;
    const unsigned char* TUx = a.ws + WS_TU + (size_t)x * SLICE_T;
    const int m = lane & 15, g = lane >> 4;
    typedef unsigned eu_u32x4 __attribute__((ext_vector_type(4)));
    eu_u32x4 rA[8], rB[8]; u16 sA[4], sB[4];
    { const uint4* ssrc = (const uint4*)(a.ws + WS_SU + (size_t)x * SLICE_S);
      for (int i = threadIdx.x; i < (int)(SLICE_S / 16); i += NTHREADS) ((uint4*)lds)[i] = ssrc[i];
      __syncthreads(); }
    i32x8 hB0, hB1, nB0, nB1; int sbt = 127, nkx = 0, ckx = 0;
    int iv0 = 0, iv1 = 0, niv0 = 0, niv1 = 0;
    const int j8 = lane >> 3, c8 = lane & 7;
    LAS unsigned char* ldsl = (LAS unsigned char*)lds;
    LAS unsigned char* stg = ldsl + LDS_MAIN + 16 + wave * 2048;
#define EU_LOAD(r_, s_, ivh_) do { _Pragma("unroll") for (int q = 0; q < 8; ++q) { \
            const int e_ = __shfl(ivh_, 8 * q + j8); \
            r_[q] = *(const eu_u32x4*)(TUx + ((unsigned)e_ * 128u + 16u * (unsigned)(c8 ^ j8))); } \
        _Pragma("unroll") for (int q = 0; q < 4; ++q) { const int e_ = __shfl(ivh_, 16 * q + m); s_[q] = *(const LAS u16*)(ldsl + e_ * 8 + 2 * g); } } while (0)
    const unsigned char* IMG = a.ws + WS_IMG; const int* KXS = (const int*)(a.ws + WS_KXS);
#define EU_BLOAD(t_, B0_, B1_, kx_) do { const eu_u32x4* ip_ = (const eu_u32x4*)(IMG + (((size_t)(t_) * 8 + x) * 8 + 2 * g + (lane & 1)) * 64); \
            const eu_u32x4 q0_ = ip_[0], q1_ = ip_[1], q2_ = ip_[2], q3_ = ip_[3]; \
            B0_ = (i32x8){(int)q0_[0], (int)q0_[1], (int)q0_[2], (int)q0_[3], (int)q1_[0], (int)q1_[1], (int)q1_[2], (int)q1_[3]}; \
            B1_ = (i32x8){(int)q2_[0], (int)q2_[1], (int)q2_[2], (int)q2_[3], (int)q3_[0], (int)q3_[1], (int)q3_[2], (int)q3_[3]}; \
            kx_ = KXS[(size_t)(t_) * 8 + x]; } while (0)
#define EU_COMPUTE(r_, s_, kb_, t_) do { _Pragma("unroll") for (int q = 0; q < 4; ++q) { \
            *(LAS eu_u32x4*)(stg + lane * 16) = r_[2 * q]; *(LAS eu_u32x4*)(stg + 1024 + lane * 16) = r_[2 * q + 1]; \
            const eu_u32x4 f0_ = *(const LAS eu_u32x4*)(stg + m * 128 + 16 * (g ^ (m & 7))), f1_ = *(const LAS eu_u32x4*)(stg + m * 128 + 16 * ((4 + g) ^ (m & 7))); \
            const i32x8 A0_ = {(int)f0_[0], (int)f0_[1], (int)f0_[2], (int)f0_[3], 0, 0, 0, 0}; \
            const i32x8 A1_ = {(int)f1_[0], (int)f1_[1], (int)f1_[2], (int)f1_[3], 0, 0, 0, 0}; \
            f32x4 c_ = {0.f, 0.f, 0.f, 0.f}; \
            c_ = __builtin_amdgcn_mfma_scale_f32_16x16x128_f8f6f4(A0_, hB0, c_, 4, 0, 0, (int)s_[q], 0, sbt); \
            c_ = __builtin_amdgcn_mfma_scale_f32_16x16x128_f8f6f4(A1_, hB1, c_, 4, 0, 1, (int)s_[q], 0, sbt); \
            f32x4 o_; _Pragma("unroll") for (int j = 0; j < 4; ++j) o_[j] = c_[j] + DPP_F(c_[j], 0xB1); \
            if (m == 0) *(uint2*)(AP + ((size_t)(t_) * 8 + x) * 128 + (kb_) + 16 * q + 4 * g) = make_uint2(pack2(o_[0], o_[1]), pack2(o_[2], o_[3])); } } while (0)
#define EU_IDX(t_, i0_, i1_) do { i0_ = IDX[(size_t)(t_) * 128 + lane]; i1_ = IDX[(size_t)(t_) * 128 + 64 + lane]; } while (0)
    if (gw < T) { EU_IDX(gw, iv0, iv1); EU_BLOAD(gw, hB0, hB1, ckx); const int t1 = (gw + NGW < T) ? gw + NGW : gw; EU_IDX(t1, niv0, niv1); EU_LOAD(rA, sA, iv0); sbt = 127 + ckx - ((lane & 1) ? 4 : 0); }
    for (int t = gw; t < T; t += NGW) {
        const int tn = (t + NGW < T) ? t + NGW : t, tnn = (t + 2 * NGW < T) ? t + 2 * NGW : t;
        EU_LOAD(rB, sB, iv1);
        EU_BLOAD(tn, nB0, nB1, nkx);
        int nn0, nn1; EU_IDX(tnn, nn0, nn1);
        EU_COMPUTE(rA, sA, 0, t);
        EU_LOAD(rA, sA, niv0);
        EU_COMPUTE(rB, sB, 64, t);
        hB0 = nB0; hB1 = nB1; sbt = 127 + nkx - ((lane & 1) ? 4 : 0);
        iv0 = niv0; iv1 = niv1; niv0 = nn0; niv1 = nn1;
    }
#undef EU_LOAD
#undef EU_BLOAD
#undef EU_COMPUTE
#undef EU_IDX
}

__device__ __forceinline__ void phase_ev(const Args& a, unsigned char* lds) {
    const u16* X1 = (const u16*)(a.ws + WS_X1);
    const int* IDX = (const int*)(a.ws + WS_IDX);
    const float* GATE = (const float*)(a.ws + WS_GATE);
    const u16* AP = (const u16*)(a.ws + WS_AP);
    const float* mod = (const float*)(a.ws + WS_MOD);
    const unsigned char* V = a.ws + WS_TV;
    const int lane = threadIdx.x & 63, wave = threadIdx.x >> 6;
    const int gw = blockIdx.x * NWAVES + wave, NGW = gridDim.x * NWAVES;
    LAS f32x4* lga = (LAS f32x4*)lds; LAS f32x4* lgf = (LAS f32x4*)(lds + 4 * 8192);
    for (int i = threadIdx.x; i < 5 * 512; i += NTHREADS) {
        const int v = i >> 9, j = i & 511, k = j >> 6, ln = j & 63;
        const float* srcp = (v < 4) ? (mod + v * 12288 + 5 * 2048) : a.g_fin;
        lga[i] = *(const f32x4*)(srcp + ln * 32 + 4 * k);
    }
    __syncthreads();
    int iv0 = 0, iv1 = 0; float gv0 = 0.f, gv1 = 0.f;
    int niv0 = 0, niv1 = 0; float ngv0 = 0.f, ngv1 = 0.f;
    uint4 rA[4], rB[4]; u16 sA[4], sB[4];
#define ROW_LOAD(TB_, r_, s_, r0_) do { _Pragma("unroll") for (int q = 0; q < 4; ++q) { \
            const int rr_ = (r0_) + q; const int e_ = __builtin_amdgcn_readlane(rr_ < 64 ? iv0 : iv1, rr_ & 63); \
            const unsigned char* rp_ = TB_ + (size_t)e_ * TROW; \
            const unsigned char* sp_ = a.ws + WS_SV + (size_t)e_ * 64; \
            r_[q] = *(const uint4*)(rp_ + lane * 16); s_[q] = (u16)*(sp_ + lane); } } while (0)
#define TOK_FETCH(t_, i0_, i1_, g0_, g1_, ap_) do { \
            i0_ = IDX[(size_t)(t_) * 128 + lane]; i1_ = IDX[(size_t)(t_) * 128 + 64 + lane]; \
            g0_ = GATE[(size_t)(t_) * 128 + lane]; g1_ = GATE[(size_t)(t_) * 128 + 64 + lane]; \
            _Pragma("unroll") for (int xx = 0; xx < 8; ++xx) { ap_[xx] = AP[((size_t)(t_) * 8 + xx) * 128 + lane]; ap_[8 + xx] = AP[((size_t)(t_) * 8 + xx) * 128 + 64 + lane]; } } while (0)
    u16 ap[16], nap[16];
    if (gw < T) { TOK_FETCH(gw, iv0, iv1, gv0, gv1, ap); ROW_LOAD(V, rA, sA, 0); }
    for (int t = gw; t < T; t += NGW) {
        const int b = t / S;
        const bool has_next = (t + NGW) < T;
        float a0 = 0.f, a1 = 0.f;
#pragma unroll
        for (int xx = 0; xx < 8; ++xx) { a0 += bf2f(ap[xx]); a1 += bf2f(ap[8 + xx]); }
        const float w0 = gv0 * gelu_f(a0), w1 = gv1 * gelu_f(a1);
        float acc[32];
#pragma unroll
        for (int i = 0; i < 32; ++i) acc[i] = 0.f;
#define V_COMPUTE(r_, s_, r0_) do { _Pragma("unroll") for (int q = 0; q < 4; ++q) { const int rr_ = (r0_) + q; \
                const float g_ = __builtin_bit_cast(float, __builtin_amdgcn_readlane(__builtin_bit_cast(int, rr_ < 64 ? w0 : w1), rr_ & 63)); \
                axpy32_fp4(r_[q], g_ * __uint_as_float((unsigned)s_[q] << 23), acc); } } while (0)
        { const int tn = has_next ? t + NGW : t; TOK_FETCH(tn, niv0, niv1, ngv0, ngv1, nap); }
#pragma unroll 1
        for (int r0 = 0; r0 < 128; r0 += 8) {
            ROW_LOAD(V, rB, sB, r0 + 4);
            V_COMPUTE(rA, sA, r0);
            if (r0 + 8 < 128) ROW_LOAD(V, rA, sA, r0 + 8);
            else { iv0 = niv0; iv1 = niv1; gv0 = ngv0; gv1 = ngv1;
                _Pragma("unroll") for (int i = 0; i < 16; ++i) ap[i] = nap[i];
                if (has_next) ROW_LOAD(V, rA, sA, 0); }
            V_COMPUTE(rB, sB, r0 + 4);
        }
#undef V_COMPUTE
        int lt = lane; asm volatile("" : "+v"(lt));
        float ss = 0.f;
#pragma unroll
        for (int k = 0; k < 8; ++k) {
            const int c0 = lt * 32 + 4 * k;
            const hw_f32x2 xn = __builtin_nontemporal_load((const hw_f32x2*)(X1 + (size_t)t * D + c0));
            const uint2 xp = make_uint2(__float_as_uint(xn[0]), __float_as_uint(xn[1]));
            const float4 xa = make_float4(lo2f(xp.x), hi2f(xp.x), lo2f(xp.y), hi2f(xp.y));
            const f32x4 gav = lga[b * 512 + k * 64 + lt]; const float4 ga = make_float4(gav[0], gav[1], gav[2], gav[3]);
            acc[4 * k + 0] = xa.x + ga.x * acc[4 * k + 0]; acc[4 * k + 1] = xa.y + ga.y * acc[4 * k + 1];
            acc[4 * k + 2] = xa.z + ga.z * acc[4 * k + 2]; acc[4 * k + 3] = xa.w + ga.w * acc[4 * k + 3];
#pragma unroll
            for (int i = 0; i < 4; ++i) ss += acc[4 * k + i] * acc[4 * k + i];
        }
        ss = wave_sum(ss);
        const float rstd = rsqrtf(ss * (1.f / D) + NORM_EPS);
#pragma unroll
        for (int k = 0; k < 8; ++k) {
            const int c0 = lt * 32 + 4 * k;
            const f32x4 gfv = lgf[k * 64 + lt]; const float4 gf = make_float4(gfv[0], gfv[1], gfv[2], gfv[3]);
            *(float4*)(a.out + (size_t)t * D + c0) = make_float4(acc[4 * k + 0] * rstd * gf.x, acc[4 * k + 1] * rstd * gf.y, acc[4 * k + 2] * rstd * gf.z, acc[4 * k + 3] * rstd * gf.w);
        }
    }
#undef ROW_LOAD
#undef TOK_FETCH
}

#undef DPP_F

#define XB_TMO      128
#define XB_XCNT(j)  (256  + 64 * (j))
#define XB_XSUB(j)  (1280 + 64 * (j))
#define XB_XGEN(j)  (2304 + 64 * (j))
#define XB_TOP      3328
#define XB_TOPGEN   3392
#define XCD_BAR_WORDS 3456
#define XB_SPIN_CAP (1u << 18)

__device__ __forceinline__ unsigned xb_ld(unsigned* p)              { return __hip_atomic_load(p, __ATOMIC_RELAXED, __HIP_MEMORY_SCOPE_AGENT); }
__device__ __forceinline__ unsigned xb_add(unsigned* p, unsigned v) { return __hip_atomic_fetch_add(p, v, __ATOMIC_RELAXED, __HIP_MEMORY_SCOPE_AGENT); }
__device__ __forceinline__ unsigned xb_xcc_id() { return (unsigned)__builtin_amdgcn_s_getreg((3 << 11) | 20) & 0xFu; }
#define XB_SPIN(cond, bar) do { unsigned _sp = 0; while (cond) { __builtin_amdgcn_s_sleep(1); \
    if ((++_sp & 255u) == 0u) { if (xb_ld(&(bar)[XB_TMO])) break; if (_sp > XB_SPIN_CAP) { atomicAdd(&(bar)[XB_TMO], 1u); break; } } } } while (0)

struct XcdBarrier {
    unsigned* bar; unsigned x;
    volatile LAS unsigned* st;
};

__device__ __forceinline__ XcdBarrier xcd_barrier_post(unsigned* bar, volatile LAS unsigned* st) {
    XcdBarrier b; b.bar = bar; b.x = xb_xcc_id(); b.st = st;
    if (threadIdx.x == 0) (void)xb_add(&bar[XB_XCNT(b.x)], 1u);
    return b;
}
__device__ __forceinline__ void xcd_barrier_complete(unsigned* bar, unsigned x, unsigned& nloc, unsigned& nx) {
    const unsigned G = gridDim.x * gridDim.y * gridDim.z;
    unsigned sum, cnt, mine, sp = 0u;
    for (;;) {
        sum = 0u; cnt = 0u; mine = 0u;
#pragma unroll
        for (unsigned j = 0; j < 16; ++j) { const unsigned c = xb_ld(&bar[XB_XCNT(j)]); sum += c; cnt += (c > 0u) ? 1u : 0u; mine = (j == x) ? c : mine; }
        if (sum == G) break;
        __builtin_amdgcn_s_sleep(1);
        if ((++sp & 255u) == 0u) { if (xb_ld(&bar[XB_TMO])) break; if (sp > XB_SPIN_CAP) { atomicAdd(&bar[XB_TMO], 1u); break; } }
    }
    nloc = mine > 0u ? mine : 1u; nx = cnt > 0u ? cnt : 1u;
}

__device__ __forceinline__ void xcd_barrier(const XcdBarrier& b) {
    asm volatile("s_waitcnt vmcnt(0)" ::: "memory");
    __syncthreads();
    if (threadIdx.x == 0) {
        unsigned* bar = b.bar;
        __builtin_amdgcn_s_waitcnt(0);
        unsigned nloc = b.st[0], nx = b.st[1];
        if (nloc == 0u) { xcd_barrier_complete(bar, b.x, nloc, nx); b.st[0] = nloc; b.st[1] = nx; }
        const unsigned old = xb_add(&bar[XB_XSUB(b.x)], 1u);
        const unsigned gen = old / nloc;
        if (old + 1u == (gen + 1u) * nloc) {
            __builtin_amdgcn_fence(__ATOMIC_RELEASE, "agent");
            asm volatile("s_waitcnt vmcnt(0)" ::: "memory");
            const unsigned og = xb_add(&bar[XB_TOP], 1u);
            const unsigned tg = og / nx;
            if (og + 1u == (tg + 1u) * nx) xb_add(&bar[XB_TOPGEN], 1u);
            else XB_SPIN(xb_ld(&bar[XB_TOPGEN]) == tg, bar);
            __builtin_amdgcn_fence(__ATOMIC_ACQUIRE, "agent");
            xb_add(&bar[XB_XGEN(b.x)], 1u);
            asm volatile("s_waitcnt vmcnt(0)" ::: "memory");
        } else {
            XB_SPIN(xb_ld(&bar[XB_XGEN(b.x)]) == gen, bar);
            __builtin_amdgcn_fence(__ATOMIC_ACQUIRE, "agent");
            asm volatile("s_waitcnt vmcnt(0)" ::: "memory");
        }
    }
    __syncthreads();
}

constexpr int NPHASES = 12;
__global__ void __launch_bounds__(NTHREADS, 2) mk_fwd(Args a) {
    extern __shared__ __attribute__((aligned(16))) unsigned char lds[];
    cg::grid_group grid = cg::this_grid();
    const int lo = a.ph_lo, hi = a.ph_hi;
    volatile LAS unsigned* xbw = (volatile LAS unsigned*)(lds + LDS_MAIN);
    if (threadIdx.x < 4) xbw[threadIdx.x] = 0u;
    __syncthreads();
    XcdBarrier xbar = xcd_barrier_post((unsigned*)(a.ws + WS_CTL), xbw);
#define IN(k) (lo <= (k) && (k) < hi)
    if (lo < 0) grid.sync();
#define SEAM(k) do { if (IN(k) && IN((k) + 1)) xcd_barrier(xbar); } while (0)
    const float* mod = (const float*)(a.ws + WS_MOD);
    if (IN(0)) phase0(a, lds);
    SEAM(0);
    if (IN(1)) norm_mod_phase<false>(a.x, a.g_mix, mod, 0, 1, (u16*)(a.ws + WS_ACT));
    SEAM(1);
    if (IN(2)) { gemm8(lds, (const u16*)(a.ws + WS_ACT), (const u16*)(a.ws + WS_WIN), T, NP, D, EpiProj{(u16*)(a.ws + WS_P), (const float*)(a.ws + WS_CS)}); gz_phase(lds, (const u16*)(a.ws + WS_ACT), (const u16*)(a.ws + WS_WIN) + (size_t)NP * D, (float*)(a.ws + WS_GZ)); }
    SEAM(2);
    if (IN(3)) phase_rope_prep(a, lds);
    SEAM(3);
    if (IN(4)) phase_mixers(a, lds);
    SEAM(4);
    if (IN(5)) phase_gla_fin(a);
    SEAM(5);
    if (IN(6)) gemm8(lds, (const u16*)(a.ws + WS_ACT), (const u16*)(a.ws + WS_WOUT), T, D, D, EpiResid{a.x, mod, (u16*)(a.ws + WS_X1)});
    SEAM(6);
    if (IN(7)) { norm_mod_phase<true>(a.ws + WS_X1, a.g_ffn, mod, 3, 4, (u16*)(a.ws + WS_ACT), a.ws + WS_IMG, (int*)(a.ws + WS_KXS)); convert_tables(a); }
    SEAM(7);
    if (IN(8)) gemm8(lds, (const u16*)(a.ws + WS_ACT), (const u16*)(a.ws + WS_WPQ), T, D, D, EpiBf16{(u16*)(a.ws + WS_Q)});
    SEAM(8);
    if (IN(9)) phase_route(a, lds);
    SEAM(9);
    if (IN(10)) phase_eu(a, lds);
    SEAM(10);
    if (IN(11)) phase_ev(a, lds);
#undef IN
#undef SEAM
}

#ifndef MK_ONE_LAUNCH
#define MK_ONE_LAUNCH 1
#endif
extern "C" void kernel_launch(void* const* d_in, const int* in_sizes, int n_in, void* d_out, int out_size, void* d_ws, size_t ws_size, hipStream_t stream) {
    static int grid = 0;
    if (grid == 0) {
        if (n_in != 19 || out_size != T * D || ws_size < WS_END) {
            fprintf(stderr, "kernel_launch: unexpected shapes: n_in %d out %d ws %zu (need %zu)\n", n_in, out_size, ws_size, (size_t)WS_END);
            grid = -1; return;
        }
        int dev = 0, cus = 0, per_cu = 0;
        (void)hipGetDevice(&dev);
        (void)hipDeviceGetAttribute(&cus, hipDeviceAttributeMultiprocessorCount, dev);
        (void)hipFuncSetAttribute((const void*)mk_fwd, hipFuncAttributeMaxDynamicSharedMemorySize, LDS_BYTES);
        (void)hipOccupancyMaxActiveBlocksPerMultiprocessor(&per_cu, (const void*)mk_fwd, NTHREADS, LDS_BYTES);
        if (per_cu < 1) { fprintf(stderr, "kernel_launch: occupancy query says %d blocks/CU\n", per_cu); grid = -1; return; }
        grid = cus;
        (void)hipGetLastError();
    }
    if (grid < 0) return;
    Args a{};
    a.x = (const float*)d_in[0]; a.c = (const float*)d_in[1]; a.pos = (const int*)d_in[2]; a.w_ada = (const float*)d_in[3];
    a.b_ada = (const float*)d_in[4]; a.g_mix = (const float*)d_in[5]; a.w_in = (const float*)d_in[6]; a.wgf = (const float*)d_in[7];
    a.bgf = (const float*)d_in[8]; a.wgb = (const float*)d_in[9]; a.bgb = (const float*)d_in[10]; a.g_gla = (const float*)d_in[11];
    a.w_out = (const float*)d_in[12]; a.g_ffn = (const float*)d_in[13]; a.w_pq = (const float*)d_in[14]; a.subk = (const float*)d_in[15];
    a.pu = (const float*)d_in[16]; a.pv = (const float*)d_in[17]; a.g_fin = (const float*)d_in[18];
    a.out = (float*)d_out; a.ws = (unsigned char*)d_ws;
#if MK_ONE_LAUNCH
    (void)hipMemsetAsync((unsigned char*)d_ws + WS_CTL, 0, XCD_BAR_WORDS * 4, stream);
    a.ph_lo = 0; a.ph_hi = NPHASES;
    void* args[] = {&a};
    hipError_t e = hipLaunchCooperativeKernel((const void*)mk_fwd, dim3(grid), dim3(NTHREADS), args, LDS_BYTES, stream);
    if (e != hipSuccess) fprintf(stderr, "cooperative launch failed: %s (grid %d)\n", hipGetErrorString(e), grid);
#else
    for (int p = 0; p < NPHASES; ++p) {
        a.ph_lo = p; a.ph_hi = p + 1;
        hipLaunchKernelGGL(mk_fwd, dim3(grid), dim3(NTHREADS), LDS_BYTES, stream, a);
    }
#endif
}
```

```cpp
#include <hip/hip_runtime.h>
#include <hip/hip_cooperative_groups.h>
#include <cstdio>
#include <cstdint>

namespace cg = cooperative_groups;

typedef unsigned short u16;
typedef __attribute__((ext_vector_type(8))) short bf16x8;
typedef __attribute__((ext_vector_type(4))) float f32x4;
typedef short s16x4 __attribute__((ext_vector_type(4)));
#define TID ((int)threadIdx.x)
#define BID ((int)blockIdx.x)
#define GDIM ((int)gridDim.x)
#define LAS __attribute__((address_space(3)))

constexpr int D = 2048, NB = 4, S = 4096, T = NB * S;
constexpr int INW = 6176;
constexpr int NP = 6144;
constexpr int NPAD = 6208;
constexpr int C_GQ = 0, C_GK = 512, C_GV = 1024, C_GR = 2048, C_DQ = 3072, C_DK = 4096, C_DV = 5120;
constexpr int NTHREADS = 512, NWAVES = 8;
constexpr int LDS_MAIN = 128 * 1024;
constexpr int LDS_STAGE = 16 * 1024;
constexpr int LDS_BYTES = LDS_MAIN + 16 + LDS_STAGE;
constexpr float NORM_EPS = 1e-6f;

constexpr size_t WS_CTL = 0;
constexpr size_t WS_MOD = 65536;
constexpr size_t WS_CS = 524288;
constexpr size_t WS_WIN = WS_CS + (size_t)T * 64 * 8;
constexpr size_t WS_WOUT = WS_WIN + (size_t)NPAD * D * 2;
constexpr size_t WS_WPQ = WS_WOUT + (size_t)D * D * 2;
constexpr size_t WS_ACT = WS_WPQ + (size_t)D * D * 2;
constexpr size_t WS_P = WS_ACT + (size_t)T * D * 2;
constexpr size_t WS_X1 = WS_P;
constexpr size_t WS_Q = WS_P + (size_t)T * D * 4;
constexpr size_t WS_GZ = WS_P + (size_t)T * NP * 2;
constexpr int GLA_NPREP = NB * 4 * 2 * (S / 64);
constexpr size_t WS_QD = WS_GZ + (size_t)T * 32 * 4;
constexpr size_t WS_KE = WS_QD + (size_t)GLA_NPREP * 16384;
constexpr size_t WS_AT = WS_KE + (size_t)GLA_NPREP * 16384;
constexpr size_t WS_DEC = WS_AT + (size_t)GLA_NPREP * 8192;
constexpr size_t WS_OFB = WS_DEC + (size_t)GLA_NPREP * 512;
constexpr size_t WS_IDX = WS_OFB + (size_t)2 * T * 1024 * 2;
constexpr size_t WS_GATE = WS_IDX + (size_t)T * 128 * 4;
constexpr size_t WS_SS = WS_GATE + (size_t)T * 128 * 4;
constexpr size_t WS_KXS = WS_SS + (size_t)T * 8 * 4;
constexpr size_t WS_END = WS_KXS + (size_t)T * 8 * 4;
constexpr size_t WS_IMG = WS_OFB;
constexpr size_t WS_AP = WS_P + (size_t)T * D * 2;
constexpr size_t SLICE_T = (size_t)16384 * 128, SLICE_S = (size_t)16384 * 8;
constexpr size_t WS_TU = WS_QD;
constexpr size_t WS_TV = WS_TU + (size_t)16384 * 1024;
constexpr size_t WS_SU = WS_TV + (size_t)16384 * 1024;
constexpr size_t WS_SV = WS_SU + (size_t)16384 * 128;
static_assert(WS_SV + (size_t)16384 * 128 <= WS_IDX, "table region");

struct Args {
    const float* x; const float* c; const int* pos; const float* w_ada; const float* b_ada; const float* g_mix;
    const float* w_in; const float* wgf; const float* bgf; const float* wgb; const float* bgb; const float* g_gla;
    const float* w_out; const float* g_ffn; const float* w_pq; const float* subk; const float* pu; const float* pv; const float* g_fin;
    float* out; unsigned char* ws; int ph_lo, ph_hi;
};

__device__ __forceinline__ float bf2f(u16 h) { return __uint_as_float(((unsigned)h) << 16); }
typedef __bf16 hw_bf16x2 __attribute__((ext_vector_type(2)));
typedef float hw_f32x2 __attribute__((ext_vector_type(2)));
typedef unsigned u32x2_t __attribute__((ext_vector_type(2)));
__device__ __forceinline__ unsigned pack2(float a, float b) { const hw_f32x2 f = {a, b}; return __builtin_bit_cast(unsigned, __builtin_convertvector(f, hw_bf16x2)); }
__device__ __forceinline__ u16 f2bf(float f) { return (u16)(pack2(f, 0.f) & 0xffffu); }
__device__ __forceinline__ float lo2f(unsigned p) { return __uint_as_float(p << 16); }
__device__ __forceinline__ float hi2f(unsigned p) { return __uint_as_float(p & 0xffff0000u); }
__device__ __forceinline__ float wave_sum(float v) {
#pragma unroll
    for (int o = 32; o > 0; o >>= 1) v += __shfl_xor(v, o);
    return v;
}
__device__ __forceinline__ float wave_max(float v) {
#pragma unroll
    for (int o = 32; o > 0; o >>= 1) v = fmaxf(v, __shfl_xor(v, o));
    return v;
}
__device__ __forceinline__ float silu_f(float v) { return v / (1.f + __expf(-v)); }
__device__ __forceinline__ float gelu_f(float a) { return 0.5f * a * (1.f + erff(a * 0.70710678118654752f)); }
__device__ __forceinline__ float logsigmoid_f(float z) { return z < 0.f ? z - log1pf(expf(z)) : -log1pf(expf(-z)); }

constexpr int MOD_BLOCKS = 96;
__device__ __forceinline__ void p0_mod(const Args& a, unsigned char* lds, int bi) {
    float* sc = (float*)lds;
    float* red = sc + 4 * 2048;
    const int tid = threadIdx.x, lane = tid & 63, wave = tid >> 6;
    for (int i = tid; i < 4 * 2048; i += NTHREADS) sc[i] = silu_f(a.c[i]);
    __syncthreads();
    const int j0 = bi * 128 + lane * 2;
    float acc[4][2];
#pragma unroll
    for (int b = 0; b < 4; ++b) { acc[b][0] = 0.f; acc[b][1] = 0.f; }
    const int k0 = wave * 256;
#pragma unroll 8
    for (int kk = 0; kk < 256; ++kk) {
        const int k = k0 + kk;
        const hw_f32x2 wv_ = __builtin_nontemporal_load((const hw_f32x2*)(a.w_ada + (size_t)k * 12288 + j0)); const float2 w = make_float2(wv_[0], wv_[1]);
#pragma unroll
        for (int b = 0; b < 4; ++b) { const float s = sc[b * 2048 + k]; acc[b][0] += s * w.x; acc[b][1] += s * w.y; }
    }
#pragma unroll
    for (int b = 0; b < 4; ++b) { red[(wave * 4 + b) * 128 + lane * 2] = acc[b][0]; red[(wave * 4 + b) * 128 + lane * 2 + 1] = acc[b][1]; }
    __syncthreads();
    float* mod = (float*)(a.ws + WS_MOD);
    {
        const int b = tid >> 7, jc = tid & 127;
        float s = 0.f;
#pragma unroll
        for (int w = 0; w < 8; ++w) s += red[(w * 4 + b) * 128 + jc];
        mod[b * 12288 + bi * 128 + jc] = s + a.b_ada[bi * 128 + jc];
    }
    __syncthreads();
}

__device__ __forceinline__ void p0_transpose_item(const float* __restrict__ W, int ldw, int k0, int src_col0, int n_valid,
                                                  u16* __restrict__ WT, int ldt, int n_out0, unsigned char* wlds, bool rope_perm = false) {
    u16* tl = (u16*)wlds;
    const int lane = threadIdx.x & 63;
    const int rsub = lane >> 4, nc = (lane & 15) * 4;
    int scol = src_col0 + nc;
    if (rope_perm) { const int p = (n_out0 & 64) + nc, g = p >> 3; scol = (src_col0 - (n_out0 & 64)) + ((p & 4) ? 64 + 4 * g : 4 * g); }
    float4 v[16];
#pragma unroll
    for (int j = 0; j < 16; ++j) {
        const int k = 4 * j + rsub;
        if (nc < n_valid) { const f32x4 q_ = __builtin_nontemporal_load((const f32x4*)(W + (size_t)(k0 + k) * ldw + scol)); v[j] = make_float4(q_[0], q_[1], q_[2], q_[3]); }
        else v[j] = make_float4(0.f, 0.f, 0.f, 0.f);
    }
#pragma unroll
    for (int j = 0; j < 16; ++j) {
        const int k = 4 * j + rsub;
        tl[(nc + 0) * 72 + k] = f2bf(v[j].x); tl[(nc + 1) * 72 + k] = f2bf(v[j].y); tl[(nc + 2) * 72 + k] = f2bf(v[j].z); tl[(nc + 3) * 72 + k] = f2bf(v[j].w);
    }
#pragma unroll
    for (int j = 0; j < 8; ++j) {
        const int c = lane + 64 * j, n = c >> 3, kc = (c & 7) * 8;
        const uint4 o = *(const uint4*)(tl + n * 72 + kc);
        *(uint4*)(WT + (size_t)(n_out0 + n) * ldt + k0 + kc) = o;
    }
}

__device__ __forceinline__ void phase0(const Args& a, unsigned char* lds) {
    const int bi = blockIdx.x, G = gridDim.x, tid = threadIdx.x, wave = tid >> 6;
    const bool modblk = (G > MOD_BLOCKS) && (bi < MOD_BLOCKS);
    if (G > MOD_BLOCKS) { if (modblk) p0_mod(a, lds, bi); }
    else { for (int mb = bi; mb < MOD_BLOCKS; mb += G) p0_mod(a, lds, mb); }
    const int nb = (G > MOD_BLOCKS) ? G - MOD_BLOCKS : G, b0 = (G > MOD_BLOCKS) ? bi - MOD_BLOCKS : bi;
    if (!modblk) {
        constexpr int I_IN = 32 * (NPAD / 64), I_SQ = 32 * 32;
        u16* WinT = (u16*)(a.ws + WS_WIN); u16* WoutT = (u16*)(a.ws + WS_WOUT); u16* WpqT = (u16*)(a.ws + WS_WPQ);
        unsigned char* wlds = lds + wave * 9216;
        for (int it = b0 * NWAVES + wave; it < I_IN + 2 * I_SQ; it += nb * NWAVES) {
            if (it < I_IN) {
                const int kt = it & 31, nt = it >> 5;
                const int n0 = nt * 64;
                int src, nv;
                if (n0 < 3072) { src = n0; nv = 64; }
                else if (n0 < 6144) { src = n0 + 32; nv = 64; }
                else if (n0 == 6144) { src = 3072; nv = 32; }
                else { src = 0; nv = 0; }
                p0_transpose_item(a.w_in, INW, kt * 64, src, nv, WinT, D, n0, wlds, n0 >= C_DQ && n0 < C_DV);
            } else if (it < I_IN + I_SQ) {
                const int r = it - I_IN; const int kt = r & 31, nt = r >> 5;
                p0_transpose_item(a.w_out, D, kt * 64, nt * 64, 64, WoutT, D, nt * 64, wlds);
            } else {
                const int r = it - I_IN - I_SQ; const int kt = r & 31, nt = r >> 5;
                p0_transpose_item(a.w_pq, D, kt * 64, nt * 64, 64, WpqT, D, nt * 64, wlds);
            }
        }
        float2* cs = (float2*)(a.ws + WS_CS);
        for (int i = b0 * NTHREADS + tid; i < T * 64; i += nb * NTHREADS) {
            const int t = i >> 6, f = i & 63;
            const float inv_freq = powf(10000.0f, -(float)f * 2.0f / 128.0f);
            const float ang = (float)a.pos[t] * inv_freq;
            const double rev = (double)ang * 0.15915494309189533577;
            const float fr = (float)(rev - floor(rev));
            cs[i] = make_float2(__builtin_amdgcn_cosf(fr), __builtin_amdgcn_sinf(fr));
        }
    }
    __syncthreads();
}

template <bool BF16IN> __device__ __forceinline__ void norm_mod_phase(const void* __restrict__ xin_, const float* __restrict__ g, const float* __restrict__ mod,
                                               int sh_chunk, int sc_chunk, u16* __restrict__ outp, unsigned char* lds, unsigned char* __restrict__ img = nullptr, int* __restrict__ kxs = nullptr) {
    const int lane = threadIdx.x & 63, wave = threadIdx.x >> 6;
    LAS f32x4* lmul = (LAS f32x4*)lds; LAS f32x4* lsh = (LAS f32x4*)(lds + 32768);
    for (int i = threadIdx.x; i < 4 * 512; i += NTHREADS) {
        const int bb = i >> 9, j = i & 511;
        const f32x4 gg = ((const f32x4*)g)[j], sc = ((const f32x4*)(mod + bb * 12288 + sc_chunk * 2048))[j], sh = ((const f32x4*)(mod + bb * 12288 + sh_chunk * 2048))[j];
        lmul[i] = gg * (1.f + sc); lsh[i] = sh;
    }
    __syncthreads();
    const int gw = blockIdx.x * NWAVES + wave, NGW = gridDim.x * NWAVES;
    float4 v[8], vn[8];
#define NM_LOAD(dst_, t_) do { if (BF16IN) { const hw_f32x2* xr_ = (const hw_f32x2*)((const u16*)xin_ + (size_t)(t_) * D); \
            _Pragma("unroll") for (int m = 0; m < 8; ++m) { const hw_f32x2 q_ = __builtin_nontemporal_load(xr_ + lane + 64 * m); const unsigned px_ = __float_as_uint(q_[0]), py_ = __float_as_uint(q_[1]); \
                dst_[m] = make_float4(lo2f(px_), hi2f(px_), lo2f(py_), hi2f(py_)); } } \
        else { const f32x4* xr_ = (const f32x4*)((const float*)xin_ + (size_t)(t_) * D); \
            _Pragma("unroll") for (int m = 0; m < 8; ++m) { const f32x4 q_ = __builtin_nontemporal_load(xr_ + lane + 64 * m); dst_[m] = make_float4(q_[0], q_[1], q_[2], q_[3]); } } } while (0)
    if (gw < T) NM_LOAD(v, gw);
    for (int t = gw; t < T; t += NGW) {
        const int b = t / S;
        if (t + NGW < T) NM_LOAD(vn, t + NGW);
        float ss = 0.f;
#pragma unroll
        for (int m = 0; m < 8; ++m) ss += v[m].x * v[m].x + v[m].y * v[m].y + v[m].z * v[m].z + v[m].w * v[m].w;
        ss = wave_sum(ss);
        const float rstd = rsqrtf(ss * (1.f / D) + NORM_EPS);

        uint2* op = (uint2*)(outp + (size_t)t * D);
#pragma unroll
        for (int m = 0; m < 8; ++m) {
            const int i = lane + 64 * m;
            const f32x4 mu = lmul[b * 512 + i], sh = lsh[b * 512 + i];
            const float h0 = v[m].x * rstd * mu[0] + sh[0];
            const float h1 = v[m].y * rstd * mu[1] + sh[1];
            const float h2 = v[m].z * rstd * mu[2] + sh[2];
            const float h3 = v[m].w * rstd * mu[3] + sh[3];
            const uint2 pk = make_uint2(pack2(h0, h1), pack2(h2, h3));
            op[i] = pk;
            if (BF16IN) {
                const float e0 = lo2f(pk.x), e1 = hi2f(pk.x), e2 = lo2f(pk.y), e3 = hi2f(pk.y);
                float amx = fmaxf(fmaxf(fabsf(e0), fabsf(e1)), fmaxf(fabsf(e2), fabsf(e3)));
#pragma unroll
                for (int o = 32; o > 0; o >>= 1) amx = fmaxf(amx, __shfl_xor(amx, o));
                const unsigned bits = __float_as_uint(amx);
                int kx = (int)(bits >> 23) - 127 - 8 + (((bits & 0x7fffffu) > 0x600000u) ? 1 : 0); kx = kx < -100 ? -100 : kx;
                const float hinv = __uint_as_float((unsigned)(127 - kx) << 23);
                const float x0 = e0 * hinv, x1 = e1 * hinv, x2 = e2 * hinv, x3 = e3 * hinv;
                int w = __builtin_amdgcn_cvt_pk_fp8_f32(x0, x1, 0, false); w = __builtin_amdgcn_cvt_pk_fp8_f32(x2, x3, w, true);
                const hw_f32x2 d0 = __builtin_amdgcn_cvt_pk_f32_fp8(w, false), d1 = __builtin_amdgcn_cvt_pk_f32_fp8(w, true);
                int l = __builtin_amdgcn_cvt_pk_fp8_f32((x0 - d0[0]) * 16.f, (x1 - d0[1]) * 16.f, 0, false);
                l = __builtin_amdgcn_cvt_pk_fp8_f32((x2 - d1[0]) * 16.f, (x3 - d1[1]) * 16.f, l, true);
                const int ei = 4 * lane, s = ei >> 7, k = ei & 127, g = (k & 63) >> 4, bb = (k & 15) + 16 * (k >> 6);
                unsigned char* ip = img + (((size_t)t * 8 + m) * 8 + 2 * g) * 64 + s * 32 + bb;
                *(int*)ip = w; *(int*)(ip + 64) = l;
                if (lane == 0) kxs[(size_t)t * 8 + m] = kx;
            }
        }
#pragma unroll
        for (int m = 0; m < 8; ++m) v[m] = vn[m];
    }
#undef NM_LOAD
}

namespace pg8 {
#define PG8_LAS __attribute__((address_space(3)))
typedef unsigned short bf16_t;
typedef short bf16x8 __attribute__((ext_vector_type(8)));
typedef float f32x4 __attribute__((ext_vector_type(4)));
typedef unsigned u32x4 __attribute__((ext_vector_type(4)));
constexpr int BM = 256, BK = 64, HALF = 128, HTB = HALF * BK * 2  , STAGE_BYTES = 8 * HTB, NXCD = 8, WGM = 8;

__host__ __device__ __forceinline__ int lds_byte(int r, int c) { const int st = (r >> 4) * 2 + (c >> 5), rr = r & 15, cc = c & 31, ob = rr * 64 + cc * 2; return st * 1024 + (ob ^ (((ob >> 9) & 1) << 5)); }
__host__ __device__ __forceinline__ void stage_rc(int b, int& R, int& C) { const int st = b / 1024, sb = b % 1024, swz = sb ^ (((sb >> 9) & 1) << 5); R = (st >> 1) * 16 + swz / 64; C = (st & 1) * 32 + (swz % 64) / 2; }
__host__ __device__ __forceinline__ int perm32(int rho) { const int n = rho >> 4, i = rho & 15; return 8 * (i >> 2) + 4 * n + (i & 3); }

struct Unit { int pm, pn; };
struct Gemm { const bf16_t* A; const bf16_t* Bt; int M, N, K; };

struct StaticOrder {
    int nM, nN, nwg, G, c;
    __host__ __device__ void init(int M, int N, int G_, int c_) { nM = M / BM; nN = N / BM; nwg = nM * nN; G = G_; c = c_; }
    __host__ __device__ bool next(int i, Unit& u) const {
        const long L = (long)i * G + c; if (L >= nwg) return false;
        int wgid = (int)L; { const int q = nwg / NXCD, r = nwg % NXCD, xcd = wgid % NXCD, off = wgid / NXCD; wgid = (xcd < r ? xcd * (q + 1) : r * (q + 1) + (xcd - r) * q) + off; }
        const int nig = WGM * nN, gid = wgid / nig, fm = gid * WGM, gsz = (nM - fm) < WGM ? (nM - fm) : WGM;
        u.pm = fm + ((wgid % nig) % gsz); u.pn = (wgid % nig) / gsz; return true;
    }
    __device__ __forceinline__ void a_ready(const Unit&) const {}
    __device__ __forceinline__ void done(const Unit&) const {}
};
__device__ __forceinline__ unsigned cvt_pk_bf16(float lo, float hi) { unsigned r; asm volatile("v_cvt_pk_bf16_f32 %0, %1, %2" : "=v"(r) : "v"(lo), "v"(hi)); return r; }
typedef float f32x2 __attribute__((ext_vector_type(2)));
template <class Epi, class Sched, bool STAMP = false>
__device__ __forceinline__ void gemm_phase(PG8_LAS unsigned char* lds, const Gemm g, const Sched& S, const Epi& E, unsigned long long* stamps) {
    const int tid = threadIdx.x, wid = __builtin_amdgcn_readfirstlane(tid >> 6), lane = tid & 63, wr = wid >> 2, wc = wid & 3, fr = lane & 15, fq = lane >> 4;
    const int K = g.K, nt = K / BK;
    int ts_lo = 0, ts_hi = 0, nts = 0; const unsigned long long rt_entry = STAMP ? (unsigned long long)wall_clock64() : 0ull;
#define PG8_STAMP() do { if (STAMP && wid == 0 && nts < 64) { const unsigned long long _c = (unsigned long long)clock64(); \
        ts_lo = (lane == nts) ? (int)(unsigned)_c : ts_lo; ts_hi = (lane == nts) ? (int)(unsigned)(_c >> 32) : ts_hi; ++nts; } } while (0)
    PG8_STAMP();
    unsigned voffA[2], voffB[2];
#pragma unroll
    for (int i = 0; i < 2; ++i) { int R, C; stage_rc(tid * 16 + i * 8192, R, C); const int Rb = Epi::PERM ? ((R & ~31) + perm32(R & 31)) : R;
        voffA[i] = (unsigned)(R * K + C) * 2u; voffB[i] = (unsigned)(Rb * K + C) * 2u; }
    const size_t kstep = (size_t)(BK * 2);
    const size_t hstep = (size_t)HALF * K * 2;
    const size_t tstep = 2 * hstep;
    const unsigned ldsw = (unsigned)wid * 1024u;
    const int aoff = lds_byte(wr * 64 + fr, fq * 8), boff = lds_byte(wc * 32 + fr, fq * 8);
#define PG8_SA(b, h) (((b) * 2 + (h)) * HTB)
#define PG8_SB(b, h) ((4 + (b) * 2 + (h)) * HTB)
#define PG8_STAGE(bufoff, gbase, voff) do { _Pragma("unroll") for (int _i = 0; _i < 2; ++_i) \
        __builtin_amdgcn_global_load_lds((const unsigned*)((const char*)(gbase) + (voff)[_i]), (PG8_LAS unsigned*)(lds + (bufoff) + ldsw + _i * 8192), 16, 0, 0); } while (0)
#define PG8_LDA(dst, b, h) do { _Pragma("unroll") for (int m = 0; m < 4; ++m) _Pragma("unroll") for (int k = 0; k < 2; ++k) dst[m][k] = *(const PG8_LAS bf16x8*)(lds + PG8_SA(b, h) + aoff + m * 2048 + k * 1024); } while (0)
#define PG8_LDB(dst, b, h) do { _Pragma("unroll") for (int n = 0; n < 2; ++n) _Pragma("unroll") for (int k = 0; k < 2; ++k) dst[n][k] = *(const PG8_LAS bf16x8*)(lds + PG8_SB(b, h) + boff + n * 2048 + k * 1024); } while (0)
#define PG8_MMA(ai, bj, At, Bt) do { __builtin_amdgcn_s_setprio(1); _Pragma("unroll") for (int m = 0; m < 4; ++m) _Pragma("unroll") for (int n = 0; n < 2; ++n) _Pragma("unroll") for (int k = 0; k < 2; ++k) \
        acc[ai][bj][m][n] = __builtin_amdgcn_mfma_f32_16x16x32_bf16(Bt[n][k], At[m][k], acc[ai][bj][m][n], 0, 0, 0); __builtin_amdgcn_s_setprio(0); } while (0)
#define PG8_WAIT_V(n) asm volatile("s_waitcnt vmcnt(" #n ")" ::: "memory")
#define PG8_WAIT_L(n) asm volatile("s_waitcnt lgkmcnt(" #n ")" ::: "memory")
#define PG8_BAR __builtin_amdgcn_s_barrier()
#define PG8_SCHED __builtin_amdgcn_sched_barrier(0)
    Unit cur, nxt; int ui = 0;
    if (!S.next(0, cur)) return;
    f32x4 acc[2][2][4][2];
#pragma unroll
    for (int a = 0; a < 2; ++a)
#pragma unroll
        for (int b = 0; b < 2; ++b)
#pragma unroll
            for (int m = 0; m < 4; ++m)
#pragma unroll
                for (int n = 0; n < 2; ++n) acc[a][b][m][n] = (f32x4){0.f, 0.f, 0.f, 0.f};
    bf16x8 At[4][2], B0[2][2], B1[2][2];
    const char* cA = (const char*)g.A + (size_t)cur.pm * tstep; const char* cB = (const char*)g.Bt + (size_t)cur.pn * tstep;
    S.a_ready(cur);
    PG8_STAGE(PG8_SB(0, 0), cB, voffB); PG8_STAGE(PG8_SA(0, 0), cA, voffA); PG8_STAGE(PG8_SB(0, 1), cB + hstep, voffB); PG8_STAGE(PG8_SA(0, 1), cA + hstep, voffA);
    if (wr == 1) PG8_BAR;
    PG8_WAIT_V(4); PG8_BAR;
    PG8_STAGE(PG8_SB(1, 0), cB + kstep, voffB); PG8_STAGE(PG8_SA(1, 0), cA + kstep, voffA); PG8_STAGE(PG8_SB(1, 1), cB + hstep + kstep, voffB);
    PG8_WAIT_V(6); PG8_BAR;
    PG8_STAMP();
    for (;;) {
        const bool has_next = S.next(ui + 1, nxt);
        const char* nA = has_next ? (const char*)g.A + (size_t)nxt.pm * tstep : cA; const char* nB = has_next ? (const char*)g.Bt + (size_t)nxt.pn * tstep : cB;
        for (int t = 0; t < nt; t += 2) {
            const bool last = (t == nt - 2);
            const char* a1 = cA + (size_t)(t + 1) * kstep;
            const char* a2 = last ? nA : cA + (size_t)(t + 2) * kstep; const char* b2 = last ? nB : cB + (size_t)(t + 2) * kstep;
            const char* a3 = a2 + kstep; const char* b3 = b2 + kstep;
            if (last && has_next) S.a_ready(nxt);
            PG8_LDB(B0, 0, 0); PG8_SCHED; PG8_LDA(At, 0, 0); PG8_STAGE(PG8_SA(1, 1), a1 + hstep, voffA);
            PG8_WAIT_L(8); PG8_BAR; PG8_WAIT_L(0); PG8_MMA(0, 0, At, B0); PG8_BAR; PG8_SCHED;
            PG8_LDB(B1, 0, 1); PG8_STAGE(PG8_SB(0, 0), b2, voffB);
            PG8_BAR; PG8_WAIT_L(0); PG8_MMA(0, 1, At, B1); PG8_BAR;
            PG8_LDA(At, 0, 1); PG8_STAGE(PG8_SA(0, 0), a2, voffA);
            PG8_BAR; PG8_WAIT_L(0); PG8_MMA(1, 0, At, B0); PG8_BAR; PG8_SCHED;
            PG8_STAGE(PG8_SB(0, 1), b2 + hstep, voffB);
            PG8_WAIT_V(6); PG8_BAR; PG8_MMA(1, 1, At, B1); PG8_BAR;
            PG8_LDB(B0, 1, 0); PG8_SCHED; PG8_LDA(At, 1, 0); PG8_STAGE(PG8_SA(0, 1), a2 + hstep, voffA);
            PG8_WAIT_L(8); PG8_BAR; PG8_WAIT_L(0); PG8_MMA(0, 0, At, B0); PG8_BAR; PG8_SCHED;
            PG8_LDB(B1, 1, 1); PG8_STAGE(PG8_SB(1, 0), b3, voffB);
            PG8_BAR; PG8_WAIT_L(0); PG8_MMA(0, 1, At, B1); PG8_BAR;
            PG8_LDA(At, 1, 1); PG8_STAGE(PG8_SA(1, 0), a3, voffA);
            PG8_BAR; PG8_WAIT_L(0); PG8_MMA(1, 0, At, B0); PG8_BAR; PG8_SCHED;
            PG8_STAGE(PG8_SB(1, 1), b3 + hstep, voffB);
            PG8_WAIT_V(6); PG8_BAR; PG8_MMA(1, 1, At, B1); PG8_BAR;
        }
        PG8_STAMP();
        if constexpr (!Epi::AFTER_DRAIN) { E(acc, cur, wr, wc, fr, fq); S.done(cur); }
        PG8_STAMP();
        if (!has_next) break;
#pragma unroll
        for (int a = 0; a < 2; ++a)
#pragma unroll
            for (int b = 0; b < 2; ++b)
#pragma unroll
                for (int m = 0; m < 4; ++m)
#pragma unroll
                    for (int n = 0; n < 2; ++n) acc[a][b][m][n] = (f32x4){0.f, 0.f, 0.f, 0.f};
        cur = nxt; cA = nA; cB = nB; ++ui;
    }
    PG8_WAIT_V(0);
    if (wr == 0) PG8_BAR;
    PG8_BAR;
    if constexpr (Epi::AFTER_DRAIN) { E.fused(acc, cur, wr, wc, fr, fq, lds, wid, lane); S.done(cur); }
    PG8_STAMP();
    if (STAMP && wid == 0) { stamps[lane] = lane < nts ? (((unsigned long long)(unsigned)ts_hi << 32) | (unsigned)ts_lo) : 0ull;
        if (lane == 62) stamps[62] = rt_entry; if (lane == 63) stamps[63] = (unsigned long long)wall_clock64(); }
#undef PG8_STAMP
#undef PG8_SA
#undef PG8_SB
#undef PG8_STAGE
#undef PG8_LDA
#undef PG8_LDB
#undef PG8_MMA
#undef PG8_WAIT_V
#undef PG8_WAIT_L
#undef PG8_BAR
#undef PG8_SCHED
}
}

struct EpiProj {
    static constexpr bool PERM = true, AFTER_DRAIN = false;
    u16* P; const float* cs;
    __device__ __forceinline__ void operator()(const pg8::f32x4 (&acc)[2][2][4][2], const pg8::Unit& u, int wr, int wc, int fr, int fq) const {
        const int row0 = u.pm * 256 + wr * 64 + fr;
        const int col0 = u.pn * 256 + wc * 32 + 8 * fq;
        const bool rope = (u.pn >= C_DQ / 256) && (u.pn < C_DV / 256);
#pragma unroll
        for (int ai = 0; ai < 2; ++ai)
#pragma unroll
            for (int m = 0; m < 4; ++m) { const int row = row0 + ai * 128 + m * 16; u16* rowp = P + (size_t)row * NP + col0;
                pg8::f32x4 c01 = (pg8::f32x4){1.f, 0.f, 1.f, 0.f}, c23 = c01;
                if (rope) { const pg8::f32x4* cp = (const pg8::f32x4*)(cs + ((size_t)row * 64 + 4 * (4 * wc + fq)) * 2); c01 = cp[0]; c23 = cp[1]; }
#pragma unroll
                for (int bj = 0; bj < 2; ++bj) { pg8::f32x4 v0 = acc[ai][bj][m][0], v1 = acc[ai][bj][m][1];
                    if (rope) {
                        const pg8::f32x4 cc = {c01[0], c01[2], c23[0], c23[2]}, sn = {c01[1], c01[3], c23[1], c23[3]};
                        const pg8::f32x4 y1 = v0 * cc - v1 * sn, y2 = v0 * sn + v1 * cc; v0 = y1; v1 = y2; }
                    pg8::u32x4 w; w.x = pg8::cvt_pk_bf16(v0[0], v0[1]); w.y = pg8::cvt_pk_bf16(v0[2], v0[3]); w.z = pg8::cvt_pk_bf16(v1[0], v1[1]); w.w = pg8::cvt_pk_bf16(v1[2], v1[3]);
                    *(pg8::u32x4*)(rowp + bj * 128) = w; } }
    }
};
__device__ __forceinline__ void gz_phase(unsigned char* lds, const u16* __restrict__ H1, const u16* __restrict__ Wg, float* __restrict__ gz) {
    const int tid = threadIdx.x, lane = tid & 63, wave = tid >> 6, fr = lane & 15, fq = lane >> 4;
    float* red = (float*)lds;
    for (int rb = blockIdx.x; rb < T / 64; rb += gridDim.x) {
        const int r0 = rb * 64, k0 = wave * 256;
        f32x4 acc[4][2];
#pragma unroll
        for (int m = 0; m < 4; ++m) { acc[m][0] = (f32x4){0.f, 0.f, 0.f, 0.f}; acc[m][1] = (f32x4){0.f, 0.f, 0.f, 0.f}; }
#pragma unroll
        for (int ks = 0; ks < 8; ++ks) {
            bf16x8 af[4], bfr[2];
#pragma unroll
            for (int m = 0; m < 4; ++m) af[m] = *(const bf16x8*)(H1 + (size_t)(r0 + 16 * m + fr) * D + k0 + 32 * ks + 8 * fq);
#pragma unroll
            for (int n = 0; n < 2; ++n) bfr[n] = *(const bf16x8*)(Wg + (size_t)(16 * n + fr) * D + k0 + 32 * ks + 8 * fq);
#pragma unroll
            for (int m = 0; m < 4; ++m)
#pragma unroll
                for (int n = 0; n < 2; ++n) acc[m][n] = __builtin_amdgcn_mfma_f32_16x16x32_bf16(af[m], bfr[n], acc[m][n], 0, 0, 0);
        }
        __syncthreads();
#pragma unroll
        for (int m = 0; m < 4; ++m)
#pragma unroll
            for (int n = 0; n < 2; ++n)
#pragma unroll
                for (int j = 0; j < 4; ++j) red[(wave * 64 + 16 * m + 4 * fq + j) * 32 + 16 * n + fr] = acc[m][n][j];
        __syncthreads();
#pragma unroll
        for (int k = 0; k < 4; ++k) {
            const int e = tid + 512 * k;
            float s = 0.f;
#pragma unroll
            for (int w = 0; w < 8; ++w) s += red[w * 2048 + e];
            gz[(size_t)r0 * 32 + e] = s;
        }
    }
    __syncthreads();
}
struct EpiResid {
    static constexpr bool PERM = true, AFTER_DRAIN = false;
    const float* x; const float* mod; u16* x1;
    __device__ __forceinline__ void operator()(const pg8::f32x4 (&acc)[2][2][4][2], const pg8::Unit& u, int wr, int wc, int fr, int fq) const {
        const int row0 = u.pm * 256 + wr * 64 + fr, col0 = u.pn * 256 + wc * 32 + 8 * fq;
        const int b = (u.pm * 256) / S;
        pg8::f32x4 ga[2][2];
#pragma unroll
        for (int bj = 0; bj < 2; ++bj)
#pragma unroll
            for (int n = 0; n < 2; ++n) ga[bj][n] = *(const pg8::f32x4*)(mod + b * 12288 + 2 * 2048 + col0 + bj * 128 + 4 * n);
#pragma unroll
        for (int ai = 0; ai < 2; ++ai)
#pragma unroll
            for (int m = 0; m < 4; ++m) { const size_t off = (size_t)(row0 + ai * 128 + m * 16) * D + col0;
#pragma unroll
                for (int bj = 0; bj < 2; ++bj) {
                    const pg8::f32x4 x0 = __builtin_nontemporal_load((const pg8::f32x4*)(x + off + bj * 128)), x1v = __builtin_nontemporal_load((const pg8::f32x4*)(x + off + bj * 128 + 4));
                    const pg8::f32x4 v0 = x0 + ga[bj][0] * acc[ai][bj][m][0], v1 = x1v + ga[bj][1] * acc[ai][bj][m][1];
                    pg8::u32x4 w; w.x = pg8::cvt_pk_bf16(v0[0], v0[1]); w.y = pg8::cvt_pk_bf16(v0[2], v0[3]); w.z = pg8::cvt_pk_bf16(v1[0], v1[1]); w.w = pg8::cvt_pk_bf16(v1[2], v1[3]);
                    *(pg8::u32x4*)(x1 + off + bj * 128) = w; } }
    }
};
struct EpiBf16 {
    static constexpr bool PERM = true, AFTER_DRAIN = false;
    u16* Q;
    __device__ __forceinline__ void operator()(const pg8::f32x4 (&acc)[2][2][4][2], const pg8::Unit& u, int wr, int wc, int fr, int fq) const {
        const int row0 = u.pm * 256 + wr * 64 + fr, col0 = u.pn * 256 + wc * 32 + 8 * fq;
#pragma unroll
        for (int ai = 0; ai < 2; ++ai)
#pragma unroll
            for (int m = 0; m < 4; ++m) { u16* rowp = Q + (size_t)(row0 + ai * 128 + m * 16) * D + col0;
#pragma unroll
                for (int bj = 0; bj < 2; ++bj) { const pg8::f32x4 v0 = acc[ai][bj][m][0], v1 = acc[ai][bj][m][1];
                    pg8::u32x4 w; w.x = pg8::cvt_pk_bf16(v0[0], v0[1]); w.y = pg8::cvt_pk_bf16(v0[2], v0[3]); w.z = pg8::cvt_pk_bf16(v1[0], v1[1]); w.w = pg8::cvt_pk_bf16(v1[2], v1[3]);
                    *(pg8::u32x4*)(rowp + bj * 128) = w; } }
    }
};
template <class Epi>
__device__ __forceinline__ void gemm8(unsigned char* lds, const u16* A, const u16* Bt, int M, int N, int K, const Epi& E) {
    pg8::Gemm g{A, Bt, M, N, K}; pg8::StaticOrder So; So.init(M, N, (int)gridDim.x, (int)blockIdx.x);
    pg8::gemm_phase<Epi, pg8::StaticOrder, false>((PG8_LAS unsigned char*)lds, g, So, E, nullptr);
    __syncthreads();
}

#define GLA_QD_BYTES 16384
#define GLA_AT_BYTES 8192
__device__ __forceinline__ float gla_logsigmoid(float z) { return fminf(z, 0.f) - __logf(1.f + __expf(-fabsf(z))); }

__device__ __forceinline__ void gla_prep_item(const u16* __restrict__ P, int ldp, int cq, int ck, const float* __restrict__ gz,
                                              const float* __restrict__ wg_f, const float* __restrict__ bg_f, const float* __restrict__ wg_b, const float* __restrict__ bg_b,
                                              int Sq, unsigned char* __restrict__ QDg, unsigned char* __restrict__ KEg, unsigned char* __restrict__ ATg, float* __restrict__ DECg,
                                              unsigned char* lds, int item) {
    const int nch = Sq / 64;
    const int c = item % nch, dir = (item / nch) & 1, hh = (item / (nch * 2)) & 3, b = item / (nch * 8);
    const int tid = TID, lane = tid & 63, wave = tid >> 6, li = lane & 15, fq = lane >> 4;
    float* gzs = (float*)lds;
    float* segs = gzs + 64 * 16;
    unsigned char* QDs = lds + 8192;
    unsigned char* KIs = QDs + 16384;
    unsigned char* KEs = KIs + 16384;
    float* bmat = (float*)(KEs + 16384);
    const size_t tok0 = (size_t)b * Sq;
    __syncthreads();
    uint4 rq0, rq1, rk0, rk1;
    {
        const int i0 = tid >> 4, i1 = (tid + 512) >> 4, cc = tid & 15;
        const int s0 = dir ? (Sq - 1 - (64 * c + i0)) : (64 * c + i0), s1 = dir ? (Sq - 1 - (64 * c + i1)) : (64 * c + i1);
        rq0 = *(const uint4*)(P + (tok0 + s0) * ldp + cq + hh * 128 + cc * 8); rk0 = *(const uint4*)(P + (tok0 + s0) * ldp + ck + hh * 128 + cc * 8);
        rq1 = *(const uint4*)(P + (tok0 + s1) * ldp + cq + hh * 128 + cc * 8); rk1 = *(const uint4*)(P + (tok0 + s1) * ldp + ck + hh * 128 + cc * 8);
    }
    for (int e = tid; e < 64 * 16; e += 512) {
        const int i = e >> 4, r = e & 15;
        const int s = dir ? (Sq - 1 - (64 * c + i)) : (64 * c + i);
        gzs[e] = gz[(tok0 + s) * 32 + dir * 16 + r];
    }
    const int d = tid & 127, seg = tid >> 7;
    const float* wg = dir ? wg_b : wg_f;
    float wcol[16];
#pragma unroll
    for (int r = 0; r < 16; ++r) wcol[r] = wg[r * 512 + hh * 128 + d];
    const float bias = (dir ? bg_b : bg_f)[hh * 128 + d];
    __syncthreads();
    float run = 0.f;
#pragma unroll
    for (int k = 0; k < 16; ++k) {
        const int i = 16 * seg + k;
        float z = bias;
#pragma unroll
        for (int r = 0; r < 16; ++r) z += gzs[i * 16 + r] * wcol[r];
        run += gla_logsigmoid(z) * (1.f / 16.f);
        bmat[i * 128 + d] = run;
    }
    segs[seg * 128 + d] = run;
    __syncthreads();
    if (seg == 0) {
        const float t0 = segs[d], t1 = segs[128 + d], t2 = segs[256 + d], t3 = segs[384 + d];
        segs[d] = 0.f; segs[128 + d] = t0; segs[256 + d] = t0 + t1; segs[384 + d] = t0 + t1 + t2; segs[512 + d] = t0 + t1 + t2 + t3;
        DECg[(size_t)item * 128 + d] = __expf(t0 + t1 + t2 + t3);
    }
    __syncthreads();
    const float qscale = 0.08838834764831845f;
#pragma unroll
    for (int k = 0; k < 2; ++k) {
        const int id = tid + 512 * k, i = id >> 4, cc = id & 15, d0 = cc * 8, sg = i >> 4;
        const uint4 qv = k ? rq1 : rq0, kv = k ? rk1 : rk0;
        const float qx[8] = {lo2f(qv.x), hi2f(qv.x), lo2f(qv.y), hi2f(qv.y), lo2f(qv.z), hi2f(qv.z), lo2f(qv.w), hi2f(qv.w)};
        const float kx[8] = {lo2f(kv.x), hi2f(kv.x), lo2f(kv.y), hi2f(kv.y), lo2f(kv.z), hi2f(kv.z), lo2f(kv.w), hi2f(kv.w)};
        float qd[8], ki[8], ke[8];
        const float4 bA = *(const float4*)(bmat + i * 128 + d0), bB = *(const float4*)(bmat + i * 128 + d0 + 4);
        const float4 oA = *(const float4*)(segs + sg * 128 + d0), oB = *(const float4*)(segs + sg * 128 + d0 + 4);
        const float4 tA = *(const float4*)(segs + 512 + d0), tB = *(const float4*)(segs + 512 + d0 + 4);
        const float bv[8] = {bA.x + oA.x, bA.y + oA.y, bA.z + oA.z, bA.w + oA.w, bB.x + oB.x, bB.y + oB.y, bB.z + oB.z, bB.w + oB.w};
        const float tv[8] = {tA.x, tA.y, tA.z, tA.w, tB.x, tB.y, tB.z, tB.w};
#pragma unroll
        for (int e = 0; e < 8; ++e) {
            const float bb = bv[e], tot = tv[e];
            qd[e] = qx[e] * qscale * __expf(bb); ki[e] = kx[e] * __expf(-bb); ke[e] = kx[e] * __expf(tot - bb);
        }
        const int o = i * 256 + ((cc ^ (i & 15)) << 4);
        *(uint4*)(QDs + o) = make_uint4(pack2(qd[0], qd[1]), pack2(qd[2], qd[3]), pack2(qd[4], qd[5]), pack2(qd[6], qd[7]));
        *(uint4*)(KIs + o) = make_uint4(pack2(ki[0], ki[1]), pack2(ki[2], ki[3]), pack2(ki[4], ki[5]), pack2(ki[6], ki[7]));
        *(uint4*)(KEs + o) = make_uint4(pack2(ke[0], ke[1]), pack2(ke[2], ke[3]), pack2(ke[4], ke[5]), pack2(ke[6], ke[7]));
    }
    __syncthreads();
    {
        uint4* qo = (uint4*)(QDg + (size_t)item * GLA_QD_BYTES); uint4* ko = (uint4*)(KEg + (size_t)item * GLA_QD_BYTES);
#pragma unroll
        for (int k = 0; k < 2; ++k) { const int e = tid + 512 * k; qo[e] = ((const uint4*)QDs)[e]; ko[e] = ((const uint4*)KEs)[e]; }
    }
#pragma unroll
    for (int tt = 0; tt < 2; ++tt) {
        const int tile = wave + 8 * tt, jt = tile >> 2, it = tile & 3;
        f32x4 acc = (f32x4){0.f, 0.f, 0.f, 0.f};
        if (jt <= it) {
            const int jr = 16 * jt + li, ir = 16 * it + li;
#pragma unroll
            for (int ks = 0; ks < 4; ++ks) {
                const bf16x8 kf = *(const bf16x8*)(KIs + jr * 256 + (((4 * ks + fq) ^ (jr & 15)) << 4));
                const bf16x8 qf = *(const bf16x8*)(QDs + ir * 256 + (((4 * ks + fq) ^ (ir & 15)) << 4));
                acc = __builtin_amdgcn_mfma_f32_16x16x32_bf16(kf, qf, acc, 0, 0, 0);
            }
        }
        const int i = 16 * it + li, j0 = 16 * jt + 4 * fq;
        float v[4];
#pragma unroll
        for (int jj = 0; jj < 4; ++jj) v[jj] = (j0 + jj <= i) ? acc[jj] : 0.f;
        const int chunk = 2 * jt + (fq >> 1), sub = (fq & 1) * 8;
        *(uint2*)(ATg + (size_t)item * GLA_AT_BYTES + i * 128 + ((chunk ^ (i & 7)) << 4) + sub) = make_uint2(pack2(v[0], v[1]), pack2(v[2], v[3]));
    }
}

__device__ __forceinline__ void gla_seq_item(const u16* __restrict__ P, int ldp, int cv, int Sq,
                                             const unsigned char* __restrict__ QDg, const unsigned char* __restrict__ KEg, const unsigned char* __restrict__ ATg, const float* __restrict__ DECg,
                                             u16* __restrict__ Oout  , int Ttot, unsigned char* lds, int item) {
    const int slice = item & 1, dir = (item >> 1) & 1, hh = (item >> 2) & 3, b = item >> 4;
    const int nch = Sq / 64;
    const int tid = TID, lane = tid & 63, wave = tid >> 6, li = lane & 15, fq = lane >> 4;
    const size_t tok0 = (size_t)b * Sq;
    const int pitem0 = ((b * 4 + hh) * 2 + dir) * nch;
    constexpr int BUF = 16384 * 3 + 8192 + 512;
    typedef unsigned gla_u32x4 __attribute__((ext_vector_type(4)));
    gla_u32x4 rq0, rq1, rk0, rk1, rv0, rv1, ra; float rd = 0.f;
#define GLA_VROW(c_, k_) ((tok0 + (size_t)(dir ? (Sq - 1 - (64 * (c_) + ((tid + 512 * (k_)) >> 4))) : (64 * (c_) + ((tid + 512 * (k_)) >> 4)))) * ldp + cv + hh * 256 + slice * 128 + ((tid + 512 * (k_)) & 15) * 8)
#define GLA_ISSUE(c_) do { \
        const gla_u32x4* qsrc_ = (const gla_u32x4*)(QDg + (size_t)(pitem0 + (c_)) * GLA_QD_BYTES); const gla_u32x4* ksrc_ = (const gla_u32x4*)(KEg + (size_t)(pitem0 + (c_)) * GLA_QD_BYTES); \
        rq0 = qsrc_[tid]; rq1 = qsrc_[tid + 512]; rk0 = ksrc_[tid]; rk1 = ksrc_[tid + 512]; \
        ra = ((const gla_u32x4*)(ATg + (size_t)(pitem0 + (c_)) * GLA_AT_BYTES))[tid]; \
        rv0 = *(const gla_u32x4*)(P + GLA_VROW(c_, 0)); rv1 = *(const gla_u32x4*)(P + GLA_VROW(c_, 1)); \
        if (tid < 128) rd = DECg[(size_t)(pitem0 + (c_)) * 128 + tid]; } while (0)
#define GLA_COMMIT(buf_) do { \
        unsigned char* base_ = lds + (buf_) * BUF; \
        ((gla_u32x4*)base_)[tid] = rq0; ((gla_u32x4*)base_)[tid + 512] = rq1; ((gla_u32x4*)(base_ + 16384))[tid] = rk0; ((gla_u32x4*)(base_ + 16384))[tid + 512] = rk1; \
        { const int row_ = tid >> 4, ch_ = tid & 15; *(gla_u32x4*)(base_ + 32768 + row_ * 256 + ((ch_ ^ (row_ & 15)) << 4)) = rv0; } \
        { const int row_ = (tid + 512) >> 4, ch_ = tid & 15; *(gla_u32x4*)(base_ + 32768 + row_ * 256 + ((ch_ ^ (row_ & 15)) << 4)) = rv1; } \
        ((gla_u32x4*)(base_ + 49152))[tid] = ra; \
        if (tid < 128) ((float*)(base_ + 57344))[tid] = rd; } while (0)
    f32x4 st[8];
#pragma unroll
    for (int dt = 0; dt < 8; ++dt) st[dt] = (f32x4){0.f, 0.f, 0.f, 0.f};
    __syncthreads();
    GLA_ISSUE(0); GLA_COMMIT(0);
    __syncthreads();
#pragma unroll 1
    for (int c = 0; c < nch; ++c) {
        const int buf = c & 1;
        if (c + 1 < nch) GLA_ISSUE(c + 1);
        const unsigned char* QDs = lds + buf * BUF; const unsigned char* KEs = QDs + 16384; const unsigned char* Vs = QDs + 32768;
        const unsigned char* ATs = QDs + 49152; const float* DECs = (const float*)(QDs + 57344);
        bf16x8 vf[2];
#pragma unroll
        for (int jp = 0; jp < 2; ++jp) {
            const int rowA = 32 * jp + 8 * fq + (li >> 2), rowB = rowA + 4;
            const int chunk = 2 * wave + ((li & 3) >> 1), sub = ((li & 3) & 1) * 8;
            const s16x4 va = __builtin_amdgcn_ds_read_tr16_b64_v4i16((LAS s16x4*)(Vs + rowA * 256 + ((chunk ^ (rowA & 15)) << 4) + sub));
            const s16x4 vb = __builtin_amdgcn_ds_read_tr16_b64_v4i16((LAS s16x4*)(Vs + rowB * 256 + ((chunk ^ (rowB & 15)) << 4) + sub));
            vf[jp] = __builtin_shufflevector(va, vb, 0, 1, 2, 3, 4, 5, 6, 7);
        }
        bf16x8 sf[4];
#pragma unroll
        for (int dp = 0; dp < 4; ++dp) {
            const gla_u32x4 t_ = {pack2(st[2 * dp][0], st[2 * dp][1]), pack2(st[2 * dp][2], st[2 * dp][3]), pack2(st[2 * dp + 1][0], st[2 * dp + 1][1]), pack2(st[2 * dp + 1][2], st[2 * dp + 1][3])};
            sf[dp] = __builtin_bit_cast(bf16x8, t_);
        }
        f32x4 ot[4];
#pragma unroll
        for (int it = 0; it < 4; ++it) {
            f32x4 acc = (f32x4){0.f, 0.f, 0.f, 0.f};
            const int ir = 16 * it + li;
#pragma unroll
            for (int dp = 0; dp < 4; ++dp) {
                const int c0 = 4 * dp + (fq >> 1), c1 = c0 + 2, sub = (fq & 1) * 8;
                const uint2 lo = *(const uint2*)(QDs + ir * 256 + ((c0 ^ (ir & 15)) << 4) + sub);
                const uint2 hi = *(const uint2*)(QDs + ir * 256 + ((c1 ^ (ir & 15)) << 4) + sub);
                const gla_u32x4 q_ = {lo.x, lo.y, hi.x, hi.y};
                const bf16x8 qf = __builtin_bit_cast(bf16x8, q_);
                acc = __builtin_amdgcn_mfma_f32_16x16x32_bf16(sf[dp], qf, acc, 0, 0, 0);
            }
#pragma unroll
            for (int jp = 0; jp < 2; ++jp) {
                if (32 * jp <= 16 * it + 15) {
                    const bf16x8 af = *(const bf16x8*)(ATs + ir * 128 + (((4 * jp + fq) ^ (ir & 7)) << 4));
                    acc = __builtin_amdgcn_mfma_f32_16x16x32_bf16(vf[jp], af, acc, 0, 0, 0);
                }
            }
            ot[it] = acc;
        }
#pragma unroll
        for (int dt = 0; dt < 8; ++dt) {
            const f32x4 dec = *(const f32x4*)(DECs + 16 * dt + 4 * fq);
            f32x4 acc = st[dt] * dec;
#pragma unroll
            for (int jp = 0; jp < 2; ++jp) {
                const int rowA = 32 * jp + 8 * fq + (li >> 2), rowB = rowA + 4;
                const int chunk = 2 * dt + ((li & 3) >> 1), sub = ((li & 3) & 1) * 8;
                const s16x4 ka = __builtin_amdgcn_ds_read_tr16_b64_v4i16((LAS s16x4*)(KEs + rowA * 256 + ((chunk ^ (rowA & 15)) << 4) + sub));
                const s16x4 kb = __builtin_amdgcn_ds_read_tr16_b64_v4i16((LAS s16x4*)(KEs + rowB * 256 + ((chunk ^ (rowB & 15)) << 4) + sub));
                const bf16x8 kf = __builtin_shufflevector(ka, kb, 0, 1, 2, 3, 4, 5, 6, 7);
                acc = __builtin_amdgcn_mfma_f32_16x16x32_bf16(kf, vf[jp], acc, 0, 0, 0);
            }
            st[dt] = acc;
        }
#pragma unroll
        for (int it = 0; it < 4; ++it) {
            const int i = 16 * it + li;
            const int s = dir ? (Sq - 1 - (64 * c + i)) : (64 * c + i);
            *(uint2*)(Oout + ((size_t)dir * Ttot + tok0 + s) * 1024 + hh * 256 + slice * 128 + 16 * wave + 4 * fq) =
                make_uint2(pack2(ot[it][0], ot[it][1]), pack2(ot[it][2], ot[it][3]));
        }
        if (c + 1 < nch) GLA_COMMIT(buf ^ 1);
        __syncthreads();
    }
}
__device__ __forceinline__ void phase_rope_prep(const Args& a, unsigned char* lds) {
    u16* P = (u16*)(a.ws + WS_P);
    const float2* cs = (const float2*)(a.ws + WS_CS);
    const int gt = blockIdx.x * NTHREADS + threadIdx.x, NT = gridDim.x * NTHREADS;
    for (int item = blockIdx.x; item < GLA_NPREP; item += gridDim.x)
        gla_prep_item(P, NP, C_GQ, C_GK, (const float*)(a.ws + WS_GZ), a.wgf, a.bgf, a.wgb, a.bgb, S,
                      a.ws + WS_QD, a.ws + WS_KE, a.ws + WS_AT, (float*)(a.ws + WS_DEC), lds, item);
}

#define ATTN_DECODE(item_) \
    const int nb_per = Sq / 128; \
    const int within = (item_) % nb_per, hh = ((item_) / nb_per) & 7, b = ((item_) / (nb_per * 8)) & 3, pat = (item_) / (nb_per * 32); \
    const int dil = pat == 0 ? 1 : (pat == 1 ? 4 : 16); \
    const int M = Sq / dil; \
    const int r = within % dil, blk = within / dil; \
    const int p0 = blk * 128, kbase = p0 - 64; \
    const size_t tok0 = (size_t)b * Sq;
typedef unsigned attn_u32x4 __attribute__((ext_vector_type(4)));
__device__ __forceinline__ void attn_phase(const u16* __restrict__ P, int ldp, int cq, int ck, int cv, int Sq,
                                           u16* __restrict__ part_o, float* __restrict__ part_lse, int Ttot,
                                           unsigned char* lds, int first, int stride, int nitems) {
    const int tid = TID, lane = tid & 63, wave = tid >> 6, li = lane & 15, fq = lane >> 4;
    unsigned char* Ks = lds;
    unsigned char* Vs = lds + 65536;
    attn_u32x4 kr0, kr1, kr2, kr3, kr4, kr5, kr6, kr7, vr0, vr1, vr2, vr3, vr4, vr5, vr6, vr7;
    bf16x8 qn0, qn1, qn2, qn3;
#define ATTN_LD1(i_, kreg_, vreg_) { const int id_ = tid + 512 * (i_), row_ = id_ >> 4, c_ = id_ & 15; \
        int kp_ = kbase + row_; kp_ = kp_ < 0 ? 0 : (kp_ > M - 1 ? M - 1 : kp_); \
        const size_t t_ = tok0 + r + (size_t)dil * kp_; \
        kreg_ = *(const attn_u32x4*)(P + t_ * ldp + ck + hh * 128 + c_ * 8); vreg_ = *(const attn_u32x4*)(P + t_ * ldp + cv + hh * 128 + c_ * 8); }
#define ATTN_LOAD(item_) do { ATTN_DECODE(item_) \
        { const size_t tq_ = tok0 + r + (size_t)dil * (p0 + 16 * wave + li); const u16* qp_ = P + tq_ * ldp + cq + hh * 128 + 8 * fq; \
          qn0 = *(const bf16x8*)(qp_); qn1 = *(const bf16x8*)(qp_ + 32); qn2 = *(const bf16x8*)(qp_ + 64); qn3 = *(const bf16x8*)(qp_ + 96); } \
        ATTN_LD1(0, kr0, vr0) ATTN_LD1(1, kr1, vr1) ATTN_LD1(2, kr2, vr2) ATTN_LD1(3, kr3, vr3) ATTN_LD1(4, kr4, vr4) ATTN_LD1(5, kr5, vr5) ATTN_LD1(6, kr6, vr6) ATTN_LD1(7, kr7, vr7) } while (0)
#define ATTN_ST1(i_, kreg_, vreg_) { const int id_ = tid + 512 * (i_), row_ = id_ >> 4, c_ = id_ & 15; const int off_ = row_ * 256 + ((c_ ^ (row_ & 15)) << 4); \
        *(attn_u32x4*)(Ks + off_) = kreg_; *(attn_u32x4*)(Vs + off_) = vreg_; }
#define ATTN_COMMIT() do { ATTN_ST1(0, kr0, vr0) ATTN_ST1(1, kr1, vr1) ATTN_ST1(2, kr2, vr2) ATTN_ST1(3, kr3, vr3) ATTN_ST1(4, kr4, vr4) ATTN_ST1(5, kr5, vr5) ATTN_ST1(6, kr6, vr6) ATTN_ST1(7, kr7, vr7) } while (0)
    int item = first;
    if (item < nitems) ATTN_LOAD(item);
    for (; item < nitems; item += stride) {
        ATTN_DECODE(item)
        __syncthreads();
        ATTN_COMMIT();
        const int qp = p0 + 16 * wave + li;
        const size_t tq = tok0 + r + (size_t)dil * qp;
        const bf16x8 qf[4] = {qn0, qn1, qn2, qn3};
        __syncthreads();
        if (item + stride < nitems) ATTN_LOAD(item + stride);
        const float scale = 0.08838834764831845f;
        float m = -1e30f, l = 0.f;
        f32x4 o[8];
#pragma unroll
        for (int dt = 0; dt < 8; ++dt) o[dt] = (f32x4){0.f, 0.f, 0.f, 0.f};
        const bool edge = (blk == 0) || (p0 + 128 >= M);
#define ATTN_SOFTMAX_PV(MASKED_) do { \
            float mx = -1e30f; \
            _Pragma("unroll") for (int j = 0; j < 8; ++j) mx = ((MASKED_) && !ok[j]) ? mx : fmaxf(mx, s[j]); \
            mx = fmaxf(mx, __shfl_xor(mx, 16)); \
            mx = fmaxf(mx, __shfl_xor(mx, 32)); \
            const float mn = fmaxf(m, mx); \
            const float al = __expf(m - mn); \
            float ps = 0.f; float p[8]; \
            _Pragma("unroll") for (int j = 0; j < 8; ++j) { p[j] = ((MASKED_) && !ok[j]) ? 0.f : __expf(s[j] - mn); ps += p[j]; } \
            l = l * al + ps; m = mn; \
            const attn_u32x4 p_ = {pack2(p[0], p[1]), pack2(p[2], p[3]), pack2(p[4], p[5]), pack2(p[6], p[7])}; \
            const bf16x8 pf = __builtin_bit_cast(bf16x8, p_); \
            _Pragma("unroll") for (int dt = 0; dt < 8; ++dt) o[dt] *= al; \
            int rowA = 16 * wave + 32 * tp + 4 * fq + (li >> 2); rowA = rowA > 255 ? 255 : rowA; \
            int rowB = 16 * wave + 32 * tp + 16 + 4 * fq + (li >> 2); rowB = rowB > 255 ? 255 : rowB; \
            _Pragma("unroll") for (int dt = 0; dt < 8; ++dt) { \
                const int chunk = 2 * dt + ((li & 3) >> 1), sub = ((li & 3) & 1) * 8; \
                const s16x4 va = __builtin_amdgcn_ds_read_tr16_b64_v4i16((LAS s16x4*)(Vs + rowA * 256 + ((chunk ^ (rowA & 15)) << 4) + sub)); \
                s16x4 vb = va; \
                if (!lastt) vb = __builtin_amdgcn_ds_read_tr16_b64_v4i16((LAS s16x4*)(Vs + rowB * 256 + ((chunk ^ (rowB & 15)) << 4) + sub)); \
                const bf16x8 vf = __builtin_shufflevector(va, vb, 0, 1, 2, 3, 4, 5, 6, 7); \
                o[dt] = __builtin_amdgcn_mfma_f32_16x16x32_bf16(vf, pf, o[dt], 0, 0, 0); } } while (0)
#define ATTN_QK(tp_, sdst_) do { _Pragma("unroll") for (int h2 = 0; h2 < 2; ++h2) { \
                const int kk0 = 16 * wave + 16 * (2 * (tp_) + h2); \
                int krow = kk0 + li; krow = krow > 255 ? 255 : krow; \
                f32x4 acc = (f32x4){0.f, 0.f, 0.f, 0.f}; \
                if (!((tp_) == 4 && h2 == 1)) {            \
                    _Pragma("unroll") for (int ks = 0; ks < 4; ++ks) { \
                        const bf16x8 kf = *(const bf16x8*)(Ks + krow * 256 + (((4 * ks + fq) ^ (krow & 15)) << 4)); \
                        acc = __builtin_amdgcn_mfma_f32_16x16x32_bf16(kf, qf[ks], acc, 0, 0, 0); } } \
                _Pragma("unroll") for (int j = 0; j < 4; ++j) sdst_[4 * h2 + j] = acc[j] * scale; } } while (0)
        float sn[8];
        ATTN_QK(0, sn);
#pragma unroll 1
        for (int tp = 0; tp < 5; ++tp) {
            const bool lastt = (tp == 4);
            float s[8]; bool ok[8];
#pragma unroll
            for (int j = 0; j < 8; ++j) s[j] = sn[j];
            if (!lastt) ATTN_QK(tp + 1, sn);
            if (edge || tp == 0 || lastt) {
#pragma unroll
                for (int h2 = 0; h2 < 2; ++h2)
#pragma unroll
                    for (int j = 0; j < 4; ++j) {
                        const int kp = kbase + 16 * wave + 16 * (2 * tp + h2) + 4 * fq + j;
                        const int rel = kp - qp;
                        ok[4 * h2 + j] = (kp >= 0) && (kp < M) && (rel <= 64) && (rel >= -64);
                    }
                ATTN_SOFTMAX_PV(1);
            } else {
#pragma unroll
                for (int j = 0; j < 8; ++j) ok[j] = true;
                ATTN_SOFTMAX_PV(0);
            }
        }
#undef ATTN_QK
#undef ATTN_SOFTMAX_PV
        l += __shfl_xor(l, 16);
        l += __shfl_xor(l, 32);
        const float inv = 1.f / l;
        u16* orow = part_o + ((size_t)pat * Ttot + tq) * 1024 + hh * 128 + 4 * fq;
#pragma unroll
        for (int dt = 0; dt < 8; ++dt)
            *(uint2*)(orow + 16 * dt) = make_uint2(pack2(o[dt][0] * inv, o[dt][1] * inv), pack2(o[dt][2] * inv, o[dt][3] * inv));
        if (fq == 0) part_lse[((size_t)pat * Ttot + tq) * 8 + hh] = m + logf(l);
    }
#undef ATTN_LD1
#undef ATTN_LOAD
#undef ATTN_ST1
#undef ATTN_COMMIT
}

__device__ __forceinline__ void attn_merge_token(const u16* __restrict__ part_o, const float* __restrict__ part_lse, int Ttot, size_t t,
                                                 u16* __restrict__ dst  , int lane) {
    const int hh = lane >> 3;
    const float l0 = part_lse[((size_t)0 * Ttot + t) * 8 + hh], l1 = part_lse[((size_t)1 * Ttot + t) * 8 + hh], l2 = part_lse[((size_t)2 * Ttot + t) * 8 + hh];
    const float mx = fmaxf(l0, fmaxf(l1, l2));
    const float e0 = __expf(l0 - mx), e1 = __expf(l1 - mx), e2 = __expf(l2 - mx);
    const float inv = 1.f / (e0 + e1 + e2);
    const float w[3] = {e0 * inv, e1 * inv, e2 * inv};
    float acc[16];
#pragma unroll
    for (int i = 0; i < 16; ++i) acc[i] = 0.f;
#pragma unroll
    for (int p = 0; p < 3; ++p) {
        const uint4* src = (const uint4*)(part_o + ((size_t)p * Ttot + t) * 1024 + lane * 16);
        const uint4 a = src[0], bb = src[1];
        acc[0] += w[p] * lo2f(a.x); acc[1] += w[p] * hi2f(a.x); acc[2] += w[p] * lo2f(a.y); acc[3] += w[p] * hi2f(a.y);
        acc[4] += w[p] * lo2f(a.z); acc[5] += w[p] * hi2f(a.z); acc[6] += w[p] * lo2f(a.w); acc[7] += w[p] * hi2f(a.w);
        acc[8] += w[p] * lo2f(bb.x); acc[9] += w[p] * hi2f(bb.x); acc[10] += w[p] * lo2f(bb.y); acc[11] += w[p] * hi2f(bb.y);
        acc[12] += w[p] * lo2f(bb.z); acc[13] += w[p] * hi2f(bb.z); acc[14] += w[p] * lo2f(bb.w); acc[15] += w[p] * hi2f(bb.w);
    }
    uint4* d = (uint4*)(dst + lane * 16);
    d[0] = make_uint4(pack2(acc[0], acc[1]), pack2(acc[2], acc[3]), pack2(acc[4], acc[5]), pack2(acc[6], acc[7]));
    d[1] = make_uint4(pack2(acc[8], acc[9]), pack2(acc[10], acc[11]), pack2(acc[12], acc[13]), pack2(acc[14], acc[15]));
}

__device__ __forceinline__ void phase_mixers(const Args& a, unsigned char* lds) {
    const int bi = blockIdx.x, G = gridDim.x;
    if (bi < 64) {
        gla_seq_item((const u16*)(a.ws + WS_P), NP, C_GV, S, a.ws + WS_QD, a.ws + WS_KE, a.ws + WS_AT, (const float*)(a.ws + WS_DEC),
                     (u16*)(a.ws + WS_OFB), T, lds, bi);
    } else {
        u16* part_o = (u16*)a.out; float* part_lse = (float*)((unsigned char*)a.out + (size_t)3 * T * 1024 * 2);
        attn_phase((const u16*)(a.ws + WS_P), NP, C_DQ, C_DK, C_DV, S, part_o, part_lse, T, lds, bi - 64, G - 64, 3 * 4 * 8 * (S / 128));
    }
}

__device__ __forceinline__ void phase_gla_fin(const Args& a) {
    const u16* Of = (const u16*)(a.ws + WS_OFB);
    const u16* Ob = Of + (size_t)T * 1024;
    const u16* P = (const u16*)(a.ws + WS_P);
    u16* A2 = (u16*)(a.ws + WS_ACT);
    const u16* part_o = (const u16*)a.out; const float* part_lse = (const float*)((const unsigned char*)a.out + (size_t)3 * T * 1024 * 2);
    const int lane = threadIdx.x & 63, wave = threadIdx.x >> 6;
    const int gw = blockIdx.x * NWAVES + wave, NGW = gridDim.x * NWAVES;
    const int hh = lane >> 4;
    float gg[16];
#pragma unroll
    for (int k = 0; k < 4; ++k) { const float4 g4 = *(const float4*)(a.g_gla + lane * 16 + 4 * k); gg[4 * k] = g4.x; gg[4 * k + 1] = g4.y; gg[4 * k + 2] = g4.z; gg[4 * k + 3] = g4.w; }
    for (int t = gw; t < T; t += NGW) {
        const uint4* fp = (const uint4*)(Of + (size_t)t * 1024 + lane * 16); const uint4* bp = (const uint4*)(Ob + (size_t)t * 1024 + lane * 16);
        const uint4* rp = (const uint4*)(P + (size_t)t * NP + C_GR + lane * 16);
#define NT16(p_) ({ const f32x4 q_ = __builtin_nontemporal_load((const f32x4*)(p_)); make_uint4(__float_as_uint(q_[0]), __float_as_uint(q_[1]), __float_as_uint(q_[2]), __float_as_uint(q_[3])); })
        const uint4 f0 = NT16(fp), f1 = NT16(fp + 1), b0 = NT16(bp), b1 = NT16(bp + 1), r0 = NT16(rp), r1 = NT16(rp + 1);
#undef NT16
        attn_merge_token(part_o, part_lse, T, (size_t)t, A2 + (size_t)t * D + 1024, lane);
        const unsigned fw[8] = {f0.x, f0.y, f0.z, f0.w, f1.x, f1.y, f1.z, f1.w}, bw[8] = {b0.x, b0.y, b0.z, b0.w, b1.x, b1.y, b1.z, b1.w};
        const unsigned rw[8] = {r0.x, r0.y, r0.z, r0.w, r1.x, r1.y, r1.z, r1.w};
        float o[16]; float ss = 0.f;
#pragma unroll
        for (int k = 0; k < 8; ++k) { o[2 * k] = lo2f(fw[k]) + lo2f(bw[k]); o[2 * k + 1] = hi2f(fw[k]) + hi2f(bw[k]); ss += o[2 * k] * o[2 * k] + o[2 * k + 1] * o[2 * k + 1]; }
        ss += __shfl_xor(ss, 1); ss += __shfl_xor(ss, 2); ss += __shfl_xor(ss, 4); ss += __shfl_xor(ss, 8);
        const float rstd = rsqrtf(ss * (1.f / 256.f) + NORM_EPS);
        unsigned y[8];
#pragma unroll
        for (int k = 0; k < 8; ++k) y[k] = pack2(o[2 * k] * rstd * gg[2 * k] * silu_f(lo2f(rw[k])), o[2 * k + 1] * rstd * gg[2 * k + 1] * silu_f(hi2f(rw[k])));
        uint4* dp = (uint4*)(A2 + (size_t)t * D + lane * 16);
        dp[0] = make_uint4(y[0], y[1], y[2], y[3]); dp[1] = make_uint4(y[4], y[5], y[6], y[7]);
    }
    (void)hh;
}

typedef float f32x16 __attribute__((ext_vector_type(16)));
#define RT_CE(a_, b_) do { const float hi_ = fmaxf(a_, b_), lo_ = fminf(a_, b_); a_ = hi_; b_ = lo_; } while (0)
template <int N> __device__ __forceinline__ void rt_sort_desc(float (&v)[N], int base) {
#pragma unroll
    for (int k = 2; k <= 16; k <<= 1)
#pragma unroll
        for (int j = k >> 1; j > 0; j >>= 1)
#pragma unroll
            for (int i = 0; i < 16; ++i) {
                const int l = i ^ j;
                if (l > i) { if ((i & k) == 0) RT_CE(v[base + i], v[base + l]); else RT_CE(v[base + l], v[base + i]); }
            }
}
template <int N> __device__ __forceinline__ void rt_merge_desc(float (&v)[N], int a, int b) {
#pragma unroll
    for (int i = 0; i < 16; ++i) v[a + i] = fmaxf(v[a + i], v[b + 15 - i]);
#pragma unroll
    for (int j = 8; j > 0; j >>= 1)
#pragma unroll
        for (int i = 0; i < 16; ++i) { const int l = i ^ j; if (l > i) RT_CE(v[a + i], v[a + l]); }
}

__device__ __forceinline__ void route_stage_keys(const float* __restrict__ subk, int hh, unsigned char* lds) {
    const int tid = TID;
    __syncthreads();
    for (int e = tid; e < 2 * 128 * 16; e += 512) {
        const int c = e & 15, row = e >> 4;
        const float* src = subk + ((size_t)(hh * 2) * 128 + row) * 128 + c * 8;
        const float4 v0 = *(const float4*)src, v1 = *(const float4*)(src + 4);
        *(uint4*)(lds + row * 256 + ((c ^ (row & 15)) << 4)) = make_uint4(pack2(v0.x, v0.y), pack2(v0.z, v0.w), pack2(v1.x, v1.y), pack2(v1.z, v1.w));
    }
    __syncthreads();
}

__device__ __forceinline__ void route_tile(const u16* __restrict__ Q, int ldq, int hh, int tok_base, const unsigned char* lds,
                                           int* __restrict__ IDX, float* __restrict__ GATE) {
    const int lane = TID & 63, r = lane & 31, h = lane >> 5;
    float sc[128];
    {
        f32x16 X[4], Y[4];
#pragma unroll
        for (int kt = 0; kt < 4; ++kt) {
#pragma unroll
            for (int i = 0; i < 16; ++i) { X[kt][i] = 0.f; Y[kt][i] = 0.f; }
        }
        const u16* qrow = Q + (size_t)(tok_base + r) * ldq + hh * 256;
#pragma unroll
        for (int half = 0; half < 2; ++half) {
            bf16x8 qf[8];
#pragma unroll
            for (int ks = 0; ks < 8; ++ks) qf[ks] = *(const bf16x8*)(qrow + half * 128 + 16 * ks + 8 * h);
#pragma unroll
            for (int kt = 0; kt < 4; ++kt) {
                const int krow = half * 128 + 32 * kt + r;
#pragma unroll
                for (int ks = 0; ks < 8; ++ks) {
                    const bf16x8 kf = *(const bf16x8*)(lds + krow * 256 + (((2 * ks + h) ^ (krow & 15)) << 4));
                    if (half == 0) X[kt] = __builtin_amdgcn_mfma_f32_32x32x16_bf16(kf, qf[ks], X[kt], 0, 0, 0);
                    else Y[kt] = __builtin_amdgcn_mfma_f32_32x32x16_bf16(kf, qf[ks], Y[kt], 0, 0, 0);
                }
            }
        }
#pragma unroll
        for (int kt = 0; kt < 4; ++kt)
#pragma unroll
            for (int i = 0; i < 16; ++i) {
                const auto sw = __builtin_amdgcn_permlane32_swap(__float_as_uint(X[kt][i]), __float_as_uint(Y[kt][i]), false, false);
                const int key0 = 32 * kt + (i & 3) + 8 * (i >> 2);
                sc[kt * 32 + i] = __uint_as_float((sw[0] & 0xffffff80u) | (unsigned)key0);
                sc[kt * 32 + 16 + i] = __uint_as_float((sw[1] & 0xffffff80u) | (unsigned)(key0 + 4));
            }
    }
#pragma unroll
    for (int g = 0; g < 8; ++g) rt_sort_desc(sc, 16 * g);
    rt_merge_desc(sc, 0, 16); rt_merge_desc(sc, 32, 48); rt_merge_desc(sc, 64, 80); rt_merge_desc(sc, 96, 112);
    rt_merge_desc(sc, 0, 32); rt_merge_desc(sc, 64, 96);
    rt_merge_desc(sc, 0, 64);
    float l0[16], l1[16];
#pragma unroll
    for (int i = 0; i < 16; ++i) {
        const auto sw = __builtin_amdgcn_permlane32_swap(__float_as_uint(sc[i]), __float_as_uint(sc[i]), false, false);
        l0[i] = __uint_as_float(sw[0]); l1[i] = __uint_as_float(sw[1]);
    }
    float s0[16], s1[16]; int k0[16], k1[16];
#pragma unroll
    for (int i = 0; i < 16; ++i) {
        const unsigned a = __float_as_uint(l0[i]), b = __float_as_uint(l1[i]);
        s0[i] = __uint_as_float(a & 0xffffff80u); k0[i] = (int)(a & 0x7fu);
        s1[i] = __uint_as_float(b & 0xffffff80u); k1[i] = (int)(b & 0x7fu);
    }
    float cs[64];
    {
        int n = 0;
#pragma unroll
        for (int i = 0; i < 16; ++i)
#pragma unroll
            for (int j = 0; j < 16; ++j)
                if ((i + 1) * (j + 1) <= 16) { cs[n] = s0[i] + s1[j]; ++n; }
#pragma unroll
        for (int q = 50; q < 64; ++q) cs[q] = -3.0e38f;
    }
    float ct[64];
#pragma unroll
    for (int q = 0; q < 64; ++q) ct[q] = cs[q];
#pragma unroll
    for (int g = 0; g < 4; ++g) rt_sort_desc(ct, 16 * g);
    rt_merge_desc(ct, 0, 16); rt_merge_desc(ct, 32, 48); rt_merge_desc(ct, 0, 32);
    const float theta = ct[15], smax = ct[0];
    float den = 0.f;
    {
        int cnt = 0;
#pragma unroll
        for (int q = 0; q < 50; ++q) { const bool sel = (cs[q] >= theta) && (cnt < 16); den += sel ? __expf(cs[q] - smax) : 0.f; cnt += sel ? 1 : 0; }
    }
    const float inv = 1.f / den;
    const size_t obase = (size_t)(tok_base + r) * 128 + hh * 16;
    int pos = 0;
    {
        int n = 0;
#pragma unroll
        for (int i = 0; i < 16; ++i)
#pragma unroll
            for (int j = 0; j < 16; ++j)
                if ((i + 1) * (j + 1) <= 16) {
                    const bool sel = (cs[n] >= theta) && (pos < 16);
                    if (sel) {
                        if (h == 0) IDX[obase + pos] = k0[i] * 128 + k1[j];
                        else GATE[obase + pos] = __expf(cs[n] - smax) * inv;
                        ++pos;
                    }
                    ++n;
                }
    }
}
__device__ __forceinline__ void phase_route(const Args& a, unsigned char* lds) {
    const int hh = BID & 7, grp = BID >> 3, ngrp = GDIM >> 3, wave = TID >> 6;
    route_stage_keys(a.subk, hh, lds);
    int j = 0;
    for (int tile = grp; tile < T / 32; tile += ngrp, ++j)
        if ((j & 7) == wave) route_tile((const u16*)(a.ws + WS_Q), D, hh, tile * 32, lds, (int*)(a.ws + WS_IDX), (float*)(a.ws + WS_GATE));
    __syncthreads();
}

typedef __bf16 bf16x2_t __attribute__((ext_vector_type(2)));
__device__ __forceinline__ float dot2bf(unsigned w, unsigned x, float acc) {
    return __builtin_amdgcn_fdot2_f32_bf16(__builtin_bit_cast(bf16x2_t, w), __builtin_bit_cast(bf16x2_t, x), acc, false);
}
constexpr int TROW = 1024;
typedef float f32x2_t __attribute__((ext_vector_type(2)));
typedef int i32x8 __attribute__((ext_vector_type(8)));
__device__ __forceinline__ void convert_tables(const Args& a) {
    const int lane = threadIdx.x & 63, wave = threadIdx.x >> 6;
    const int gw = blockIdx.x * NWAVES + wave, NGW = gridDim.x * NWAVES;
    for (int row = gw; row < 2 * 16384; row += NGW) {
        const bool isv = row >= 16384; const int e = isv ? row - 16384 : row;
        const f32x4* sp = (const f32x4*)((isv ? a.pv : a.pu) + (size_t)e * D);
        unsigned char* dst = a.ws + (isv ? WS_TV + (size_t)e * 1024 : WS_TU + (size_t)e * 128);
        unsigned char* sdst = a.ws + (isv ? WS_SV + (size_t)e * 64 : WS_SU + (size_t)e * 8);
        f32x4 v[8];
#pragma unroll
        for (int k = 0; k < 8; ++k) v[k] = __builtin_nontemporal_load(sp + lane + 64 * k);
#pragma unroll
        for (int k = 0; k < 8; ++k) {
            float mx = fmaxf(fmaxf(fabsf(v[k][0]), fabsf(v[k][1])), fmaxf(fabsf(v[k][2]), fabsf(v[k][3])));
            mx = fmaxf(mx, __shfl_xor(mx, 1)); mx = fmaxf(mx, __shfl_xor(mx, 2)); mx = fmaxf(mx, __shfl_xor(mx, 4));
            const unsigned bits = __float_as_uint(mx);
            int kx = (int)(bits >> 23) - 127 - 2 + (((bits & 0x7fffffu) > 0x400000u) ? 1 : 0);
            kx = kx < -126 ? -126 : kx;
            const float inv = __uint_as_float((unsigned)(127 - kx) << 23);
            unsigned p = 0u;
            p = __builtin_amdgcn_cvt_scalef32_pk_fp4_f32(p, v[k][0] * inv, v[k][1] * inv, 1.0f, 0);
            p = __builtin_amdgcn_cvt_scalef32_pk_fp4_f32(p, v[k][2] * inv, v[k][3] * inv, 1.0f, 1);
            *(u16*)(dst + (isv ? (size_t)k * 128 : (size_t)k * SLICE_T) + 2 * lane) = (u16)p;
            if ((lane & 7) == 0) {
                const int c = lane >> 3;
                if (isv) sdst[8 * k + c] = (unsigned char)(kx + 127); else sdst[(size_t)k * SLICE_S + 2 * (c & 3) + (c >> 2)] = (unsigned char)(kx + 127);
            }
        }
    }
}

__device__ __forceinline__ void axpy32_fp4(const uint4 w, const float s, float (&acc)[32]) {
    const unsigned ww[4] = {w.x, w.y, w.z, w.w};
#pragma unroll
    for (int k = 0; k < 4; ++k) {
        const f32x2_t a0 = __builtin_amdgcn_cvt_scalef32_pk_f32_fp4(ww[k], 1.0f, 0), a1 = __builtin_amdgcn_cvt_scalef32_pk_f32_fp4(ww[k], 1.0f, 1);
        const f32x2_t a2 = __builtin_amdgcn_cvt_scalef32_pk_f32_fp4(ww[k], 1.0f, 2), a3 = __builtin_amdgcn_cvt_scalef32_pk_f32_fp4(ww[k], 1.0f, 3);
        acc[8 * k + 0] += s * a0.x; acc[8 * k + 1] += s * a0.y; acc[8 * k + 2] += s * a1.x; acc[8 * k + 3] += s * a1.y;
        acc[8 * k + 4] += s * a2.x; acc[8 * k + 5] += s * a2.y; acc[8 * k + 6] += s * a3.x; acc[8 * k + 7] += s * a3.y;
    }
}
#define DPP_F(v_, ctrl_) __builtin_bit_cast(float, __builtin_amdgcn_update_dpp(0, __builtin_bit_cast(int, v_), ctrl_, 0xf, 0xf, true))
__device__ __forceinline__ void phase_eu(const Args& a, unsigned char* lds) {
    const int* IDX = (const int*)(a.ws + WS_IDX);
    u16* AP = (u16*)(a.ws + WS_AP);
    const int lane = threadIdx.x & 63, wave = threadIdx.x >> 6;
    const int x = blockIdx.x & 7, gw = (blockIdx.x >> 3) * NWAVES + wave, NGW = (((int)gridDim.x - x + 7) >> 3) * NWAVES;
    const unsigned char* TUx = a.ws + WS_TU + (size_t)x * SLICE_T;
    const int m = lane & 15, g = lane >> 4;
    typedef unsigned eu_u32x4 __attribute__((ext_vector_type(4)));
    eu_u32x4 rA[8], rB[8]; u16 sA[4], sB[4];
    { const uint4* ssrc = (const uint4*)(a.ws + WS_SU + (size_t)x * SLICE_S);
      for (int i = threadIdx.x; i < (int)(SLICE_S / 16); i += NTHREADS) ((uint4*)lds)[i] = ssrc[i];
      __syncthreads(); }
    i32x8 hB0, hB1, nB0, nB1; int sbt = 127, nkx = 0, ckx = 0;
    int iv0 = 0, iv1 = 0, niv0 = 0, niv1 = 0;
    const int j8 = lane >> 3, c8 = lane & 7;
    LAS unsigned char* ldsl = (LAS unsigned char*)lds;
    LAS unsigned char* stg = ldsl + LDS_MAIN + 16 + wave * 2048;
#define EU_LOAD(r_, s_, ivh_) do { _Pragma("unroll") for (int q = 0; q < 8; ++q) { \
            const int e_ = __shfl(ivh_, 8 * q + j8); \
            r_[q] = *(const eu_u32x4*)(TUx + ((unsigned)e_ * 128u + 16u * (unsigned)(c8 ^ j8))); } \
        _Pragma("unroll") for (int q = 0; q < 4; ++q) { const int e_ = __shfl(ivh_, 16 * q + m); s_[q] = *(const LAS u16*)(ldsl + e_ * 8 + 2 * g); } } while (0)
    const unsigned char* IMG = a.ws + WS_IMG; const int* KXS = (const int*)(a.ws + WS_KXS);
#define EU_BLOAD(t_, B0_, B1_, kx_) do { const eu_u32x4* ip_ = (const eu_u32x4*)(IMG + (((size_t)(t_) * 8 + x) * 8 + 2 * g + (lane & 1)) * 64); \
            const eu_u32x4 q0_ = ip_[0], q1_ = ip_[1], q2_ = ip_[2], q3_ = ip_[3]; \
            B0_ = (i32x8){(int)q0_[0], (int)q0_[1], (int)q0_[2], (int)q0_[3], (int)q1_[0], (int)q1_[1], (int)q1_[2], (int)q1_[3]}; \
            B1_ = (i32x8){(int)q2_[0], (int)q2_[1], (int)q2_[2], (int)q2_[3], (int)q3_[0], (int)q3_[1], (int)q3_[2], (int)q3_[3]}; \
            kx_ = KXS[(size_t)(t_) * 8 + x]; } while (0)
#define EU_COMPUTE(r_, s_, kb_, t_) do { _Pragma("unroll") for (int q = 0; q < 4; ++q) { \
            *(LAS eu_u32x4*)(stg + lane * 16) = r_[2 * q]; *(LAS eu_u32x4*)(stg + 1024 + lane * 16) = r_[2 * q + 1]; \
            const eu_u32x4 f0_ = *(const LAS eu_u32x4*)(stg + m * 128 + 16 * (g ^ (m & 7))), f1_ = *(const LAS eu_u32x4*)(stg + m * 128 + 16 * ((4 + g) ^ (m & 7))); \
            const i32x8 A0_ = {(int)f0_[0], (int)f0_[1], (int)f0_[2], (int)f0_[3], 0, 0, 0, 0}; \
            const i32x8 A1_ = {(int)f1_[0], (int)f1_[1], (int)f1_[2], (int)f1_[3], 0, 0, 0, 0}; \
            f32x4 c_ = {0.f, 0.f, 0.f, 0.f}; \
            c_ = __builtin_amdgcn_mfma_scale_f32_16x16x128_f8f6f4(A0_, hB0, c_, 4, 0, 0, (int)s_[q], 0, sbt); \
            c_ = __builtin_amdgcn_mfma_scale_f32_16x16x128_f8f6f4(A1_, hB1, c_, 4, 0, 1, (int)s_[q], 0, sbt); \
            f32x4 o_; _Pragma("unroll") for (int j = 0; j < 4; ++j) o_[j] = c_[j] + DPP_F(c_[j], 0xB1); \
            if (m == 0) *(uint2*)(AP + ((size_t)(t_) * 8 + x) * 128 + (kb_) + 16 * q + 4 * g) = make_uint2(pack2(o_[0], o_[1]), pack2(o_[2], o_[3])); } } while (0)
#define EU_IDX(t_, i0_, i1_) do { i0_ = IDX[(size_t)(t_) * 128 + lane]; i1_ = IDX[(size_t)(t_) * 128 + 64 + lane]; } while (0)
    if (gw < T) { EU_IDX(gw, iv0, iv1); EU_BLOAD(gw, hB0, hB1, ckx); const int t1 = (gw + NGW < T) ? gw + NGW : gw; EU_IDX(t1, niv0, niv1); EU_LOAD(rA, sA, iv0); sbt = 127 + ckx - ((lane & 1) ? 4 : 0); }
    for (int t = gw; t < T; t += NGW) {
        const int tn = (t + NGW < T) ? t + NGW : t, tnn = (t + 2 * NGW < T) ? t + 2 * NGW : t;
        EU_LOAD(rB, sB, iv1);
        EU_BLOAD(tn, nB0, nB1, nkx);
        int nn0, nn1; EU_IDX(tnn, nn0, nn1);
        EU_COMPUTE(rA, sA, 0, t);
        EU_LOAD(rA, sA, niv0);
        EU_COMPUTE(rB, sB, 64, t);
        hB0 = nB0; hB1 = nB1; sbt = 127 + nkx - ((lane & 1) ? 4 : 0);
        iv0 = niv0; iv1 = niv1; niv0 = nn0; niv1 = nn1;
    }
#undef EU_LOAD
#undef EU_BLOAD
#undef EU_COMPUTE
#undef EU_IDX
}

__device__ __forceinline__ void phase_ev(const Args& a, unsigned char* lds) {
    const u16* X1 = (const u16*)(a.ws + WS_X1);
    const int* IDX = (const int*)(a.ws + WS_IDX);
    const float* GATE = (const float*)(a.ws + WS_GATE);
    const u16* AP = (const u16*)(a.ws + WS_AP);
    const float* mod = (const float*)(a.ws + WS_MOD);
    const unsigned char* V = a.ws + WS_TV;
    const int lane = threadIdx.x & 63, wave = threadIdx.x >> 6;
    const int gw = blockIdx.x * NWAVES + wave, NGW = gridDim.x * NWAVES;
    LAS f32x4* lga = (LAS f32x4*)lds; LAS f32x4* lgf = (LAS f32x4*)(lds + 4 * 8192);
    for (int i = threadIdx.x; i < 5 * 512; i += NTHREADS) {
        const int v = i >> 9, j = i & 511, k = j >> 6, ln = j & 63;
        const float* srcp = (v < 4) ? (mod + v * 12288 + 5 * 2048) : a.g_fin;
        lga[i] = *(const f32x4*)(srcp + ln * 32 + 4 * k);
    }
    __syncthreads();
    int iv0 = 0, iv1 = 0; float gv0 = 0.f, gv1 = 0.f;
    int niv0 = 0, niv1 = 0; float ngv0 = 0.f, ngv1 = 0.f;
    uint4 rA[4], rB[4]; u16 sA[4], sB[4];
#define ROW_LOAD(TB_, r_, s_, r0_) do { _Pragma("unroll") for (int q = 0; q < 4; ++q) { \
            const int rr_ = (r0_) + q; const int e_ = __builtin_amdgcn_readlane(rr_ < 64 ? iv0 : iv1, rr_ & 63); \
            const unsigned char* rp_ = TB_ + (size_t)e_ * TROW; \
            const unsigned char* sp_ = a.ws + WS_SV + (size_t)e_ * 64; \
            r_[q] = *(const uint4*)(rp_ + lane * 16); s_[q] = (u16)*(sp_ + lane); } } while (0)
#define TOK_FETCH(t_, i0_, i1_, g0_, g1_, ap_) do { \
            i0_ = IDX[(size_t)(t_) * 128 + lane]; i1_ = IDX[(size_t)(t_) * 128 + 64 + lane]; \
            g0_ = GATE[(size_t)(t_) * 128 + lane]; g1_ = GATE[(size_t)(t_) * 128 + 64 + lane]; \
            _Pragma("unroll") for (int xx = 0; xx < 8; ++xx) { ap_[xx] = AP[((size_t)(t_) * 8 + xx) * 128 + lane]; ap_[8 + xx] = AP[((size_t)(t_) * 8 + xx) * 128 + 64 + lane]; } } while (0)
    u16 ap[16], nap[16];
    if (gw < T) { TOK_FETCH(gw, iv0, iv1, gv0, gv1, ap); ROW_LOAD(V, rA, sA, 0); }
    for (int t = gw; t < T; t += NGW) {
        const int b = t / S;
        const bool has_next = (t + NGW) < T;
        float a0 = 0.f, a1 = 0.f;
#pragma unroll
        for (int xx = 0; xx < 8; ++xx) { a0 += bf2f(ap[xx]); a1 += bf2f(ap[8 + xx]); }
        const float w0 = gv0 * gelu_f(a0), w1 = gv1 * gelu_f(a1);
        float acc[32];
#pragma unroll
        for (int i = 0; i < 32; ++i) acc[i] = 0.f;
#define V_COMPUTE(r_, s_, r0_) do { _Pragma("unroll") for (int q = 0; q < 4; ++q) { const int rr_ = (r0_) + q; \
                const float g_ = __builtin_bit_cast(float, __builtin_amdgcn_readlane(__builtin_bit_cast(int, rr_ < 64 ? w0 : w1), rr_ & 63)); \
                axpy32_fp4(r_[q], g_ * __uint_as_float((unsigned)s_[q] << 23), acc); } } while (0)
        { const int tn = has_next ? t + NGW : t; TOK_FETCH(tn, niv0, niv1, ngv0, ngv1, nap); }
#pragma unroll 1
        for (int r0 = 0; r0 < 128; r0 += 8) {
            ROW_LOAD(V, rB, sB, r0 + 4);
            V_COMPUTE(rA, sA, r0);
            if (r0 + 8 < 128) ROW_LOAD(V, rA, sA, r0 + 8);
            else { iv0 = niv0; iv1 = niv1; gv0 = ngv0; gv1 = ngv1;
                _Pragma("unroll") for (int i = 0; i < 16; ++i) ap[i] = nap[i];
                if (has_next) ROW_LOAD(V, rA, sA, 0); }
            V_COMPUTE(rB, sB, r0 + 4);
        }
#undef V_COMPUTE
        int lt = lane; asm volatile("" : "+v"(lt));
        float ss = 0.f;
#pragma unroll
        for (int k = 0; k < 8; ++k) {
            const int c0 = lt * 32 + 4 * k;
            const hw_f32x2 xn = __builtin_nontemporal_load((const hw_f32x2*)(X1 + (size_t)t * D + c0));
            const uint2 xp = make_uint2(__float_as_uint(xn[0]), __float_as_uint(xn[1]));
            const float4 xa = make_float4(lo2f(xp.x), hi2f(xp.x), lo2f(xp.y), hi2f(xp.y));
            const f32x4 gav = lga[b * 512 + k * 64 + lt]; const float4 ga = make_float4(gav[0], gav[1], gav[2], gav[3]);
            acc[4 * k + 0] = xa.x + ga.x * acc[4 * k + 0]; acc[4 * k + 1] = xa.y + ga.y * acc[4 * k + 1];
            acc[4 * k + 2] = xa.z + ga.z * acc[4 * k + 2]; acc[4 * k + 3] = xa.w + ga.w * acc[4 * k + 3];
#pragma unroll
            for (int i = 0; i < 4; ++i) ss += acc[4 * k + i] * acc[4 * k + i];
        }
        ss = wave_sum(ss);
        const float rstd = rsqrtf(ss * (1.f / D) + NORM_EPS);
#pragma unroll
        for (int k = 0; k < 8; ++k) {
            const int c0 = lt * 32 + 4 * k;
            const f32x4 gfv = lgf[k * 64 + lt]; const float4 gf = make_float4(gfv[0], gfv[1], gfv[2], gfv[3]);
            *(float4*)(a.out + (size_t)t * D + c0) = make_float4(acc[4 * k + 0] * rstd * gf.x, acc[4 * k + 1] * rstd * gf.y, acc[4 * k + 2] * rstd * gf.z, acc[4 * k + 3] * rstd * gf.w);
        }
    }
#undef ROW_LOAD
#undef TOK_FETCH
}

#undef DPP_F

#define XB_TMO      128
#define XB_XCNT(j)  (256  + 64 * (j))
#define XB_XSUB(j)  (1280 + 64 * (j))
#define XB_XGEN(j)  (2304 + 64 * (j))
#define XB_TOP      3328
#define XB_TOPGEN   3392
#define XCD_BAR_WORDS 3456
#define XB_SPIN_CAP (1u << 18)

__device__ __forceinline__ unsigned xb_ld(unsigned* p)              { return __hip_atomic_load(p, __ATOMIC_RELAXED, __HIP_MEMORY_SCOPE_AGENT); }
__device__ __forceinline__ unsigned xb_add(unsigned* p, unsigned v) { return __hip_atomic_fetch_add(p, v, __ATOMIC_RELAXED, __HIP_MEMORY_SCOPE_AGENT); }
__device__ __forceinline__ unsigned xb_xcc_id() { return (unsigned)__builtin_amdgcn_s_getreg((3 << 11) | 20) & 0xFu; }
#define XB_SPIN(cond, bar) do { unsigned _sp = 0; while (cond) { __builtin_amdgcn_s_sleep(1); \
    if ((++_sp & 255u) == 0u) { if (xb_ld(&(bar)[XB_TMO])) break; if (_sp > XB_SPIN_CAP) { atomicAdd(&(bar)[XB_TMO], 1u); break; } } } } while (0)

struct XcdBarrier {
    unsigned* bar; unsigned x;
    volatile LAS unsigned* st;
};

__device__ __forceinline__ XcdBarrier xcd_barrier_post(unsigned* bar, volatile LAS unsigned* st) {
    XcdBarrier b; b.bar = bar; b.x = xb_xcc_id(); b.st = st;
    if (threadIdx.x == 0) (void)xb_add(&bar[XB_XCNT(b.x)], 1u);
    return b;
}
__device__ __forceinline__ void xcd_barrier_complete(unsigned* bar, unsigned x, unsigned& nloc, unsigned& nx) {
    const unsigned G = gridDim.x * gridDim.y * gridDim.z;
    unsigned sum, cnt, mine, sp = 0u;
    for (;;) {
        sum = 0u; cnt = 0u; mine = 0u;
#pragma unroll
        for (unsigned j = 0; j < 16; ++j) { const unsigned c = xb_ld(&bar[XB_XCNT(j)]); sum += c; cnt += (c > 0u) ? 1u : 0u; mine = (j == x) ? c : mine; }
        if (sum == G) break;
        __builtin_amdgcn_s_sleep(1);
        if ((++sp & 255u) == 0u) { if (xb_ld(&bar[XB_TMO])) break; if (sp > XB_SPIN_CAP) { atomicAdd(&bar[XB_TMO], 1u); break; } }
    }
    nloc = mine > 0u ? mine : 1u; nx = cnt > 0u ? cnt : 1u;
}

__device__ __forceinline__ void xcd_barrier(const XcdBarrier& b) {
    asm volatile("s_waitcnt vmcnt(0)" ::: "memory");
    __syncthreads();
    if (threadIdx.x == 0) {
        unsigned* bar = b.bar;
        __builtin_amdgcn_s_waitcnt(0);
        unsigned nloc = b.st[0], nx = b.st[1];
        if (nloc == 0u) { xcd_barrier_complete(bar, b.x, nloc, nx); b.st[0] = nloc; b.st[1] = nx; }
        const unsigned old = xb_add(&bar[XB_XSUB(b.x)], 1u);
        const unsigned gen = old / nloc;
        if (old + 1u == (gen + 1u) * nloc) {
            __builtin_amdgcn_fence(__ATOMIC_RELEASE, "agent");
            asm volatile("s_waitcnt vmcnt(0)" ::: "memory");
            const unsigned og = xb_add(&bar[XB_TOP], 1u);
            const unsigned tg = og / nx;
            if (og + 1u == (tg + 1u) * nx) xb_add(&bar[XB_TOPGEN], 1u);
            else XB_SPIN(xb_ld(&bar[XB_TOPGEN]) == tg, bar);
            __builtin_amdgcn_fence(__ATOMIC_ACQUIRE, "agent");
            xb_add(&bar[XB_XGEN(b.x)], 1u);
            asm volatile("s_waitcnt vmcnt(0)" ::: "memory");
        } else {
            XB_SPIN(xb_ld(&bar[XB_XGEN(b.x)]) == gen, bar);
            __builtin_amdgcn_fence(__ATOMIC_ACQUIRE, "agent");
            asm volatile("s_waitcnt vmcnt(0)" ::: "memory");
        }
    }
    __syncthreads();
}

constexpr int NPHASES = 12;
__global__ void __launch_bounds__(NTHREADS, 2) mk_fwd(Args a) {
    extern __shared__ __attribute__((aligned(16))) unsigned char lds[];
    cg::grid_group grid = cg::this_grid();
    const int lo = a.ph_lo, hi = a.ph_hi;
    volatile LAS unsigned* xbw = (volatile LAS unsigned*)(lds + LDS_MAIN);
    if (threadIdx.x < 4) xbw[threadIdx.x] = 0u;
    __syncthreads();
    XcdBarrier xbar = xcd_barrier_post((unsigned*)(a.ws + WS_CTL), xbw);
#define IN(k) (lo <= (k) && (k) < hi)
    if (lo < 0) grid.sync();
#define SEAM(k) do { if (IN(k) && IN((k) + 1)) xcd_barrier(xbar); } while (0)
    const float* mod = (const float*)(a.ws + WS_MOD);
    if (IN(0)) phase0(a, lds);
    SEAM(0);
    if (IN(1)) norm_mod_phase<false>(a.x, a.g_mix, mod, 0, 1, (u16*)(a.ws + WS_ACT), lds);
    SEAM(1);
    if (IN(2)) { gemm8(lds, (const u16*)(a.ws + WS_ACT), (const u16*)(a.ws + WS_WIN), T, NP, D, EpiProj{(u16*)(a.ws + WS_P), (const float*)(a.ws + WS_CS)}); gz_phase(lds, (const u16*)(a.ws + WS_ACT), (const u16*)(a.ws + WS_WIN) + (size_t)NP * D, (float*)(a.ws + WS_GZ)); }
    SEAM(2);
    if (IN(3)) phase_rope_prep(a, lds);
    SEAM(3);
    if (IN(4)) phase_mixers(a, lds);
    SEAM(4);
    if (IN(5)) phase_gla_fin(a);
    SEAM(5);
    if (IN(6)) gemm8(lds, (const u16*)(a.ws + WS_ACT), (const u16*)(a.ws + WS_WOUT), T, D, D, EpiResid{a.x, mod, (u16*)(a.ws + WS_X1)});
    SEAM(6);
    if (IN(7)) { norm_mod_phase<true>(a.ws + WS_X1, a.g_ffn, mod, 3, 4, (u16*)(a.ws + WS_ACT), lds, a.ws + WS_IMG, (int*)(a.ws + WS_KXS)); convert_tables(a); }
    SEAM(7);
    if (IN(8)) gemm8(lds, (const u16*)(a.ws + WS_ACT), (const u16*)(a.ws + WS_WPQ), T, D, D, EpiBf16{(u16*)(a.ws + WS_Q)});
    SEAM(8);
    if (IN(9)) phase_route(a, lds);
    SEAM(9);
    if (IN(10)) phase_eu(a, lds);
    SEAM(10);
    if (IN(11)) phase_ev(a, lds);
#undef IN
#undef SEAM
}

#ifndef MK_ONE_LAUNCH
#define MK_ONE_LAUNCH 1
#endif
extern "C" void kernel_launch(void* const* d_in, const int* in_sizes, int n_in, void* d_out, int out_size, void* d_ws, size_t ws_size, hipStream_t stream) {
    static int grid = 0;
    if (grid == 0) {
        if (n_in != 19 || out_size != T * D || ws_size < WS_END) {
            fprintf(stderr, "kernel_launch: unexpected shapes: n_in %d out %d ws %zu (need %zu)\n", n_in, out_size, ws_size, (size_t)WS_END);
            grid = -1; return;
        }
        int dev = 0, cus = 0, per_cu = 0;
        (void)hipGetDevice(&dev);
        (void)hipDeviceGetAttribute(&cus, hipDeviceAttributeMultiprocessorCount, dev);
        (void)hipFuncSetAttribute((const void*)mk_fwd, hipFuncAttributeMaxDynamicSharedMemorySize, LDS_BYTES);
        (void)hipOccupancyMaxActiveBlocksPerMultiprocessor(&per_cu, (const void*)mk_fwd, NTHREADS, LDS_BYTES);
        if (per_cu < 1) { fprintf(stderr, "kernel_launch: occupancy query says %d blocks/CU\n", per_cu); grid = -1; return; }
        grid = cus;
        (void)hipGetLastError();
    }
    if (grid < 0) return;
    Args a{};
    a.x = (const float*)d_in[0]; a.c = (const float*)d_in[1]; a.pos = (const int*)d_in[2]; a.w_ada = (const float*)d_in[3];
    a.b_ada = (const float*)d_in[4]; a.g_mix = (const float*)d_in[5]; a.w_in = (const float*)d_in[6]; a.wgf = (const float*)d_in[7];
    a.bgf = (const float*)d_in[8]; a.wgb = (const float*)d_in[9]; a.bgb = (const float*)d_in[10]; a.g_gla = (const float*)d_in[11];
    a.w_out = (const float*)d_in[12]; a.g_ffn = (const float*)d_in[13]; a.w_pq = (const float*)d_in[14]; a.subk = (const float*)d_in[15];
    a.pu = (const float*)d_in[16]; a.pv = (const float*)d_in[17]; a.g_fin = (const float*)d_in[18];
    a.out = (float*)d_out; a.ws = (unsigned char*)d_ws;
#if MK_ONE_LAUNCH
    (void)hipMemsetAsync((unsigned char*)d_ws + WS_CTL, 0, XCD_BAR_WORDS * 4, stream);
    a.ph_lo = 0; a.ph_hi = NPHASES;
    void* args[] = {&a};
    hipError_t e = hipLaunchCooperativeKernel((const void*)mk_fwd, dim3(grid), dim3(NTHREADS), args, LDS_BYTES, stream);
    if (e != hipSuccess) fprintf(stderr, "cooperative launch failed: %s (grid %d)\n", hipGetErrorString(e), grid);
#else
    for (int p = 0; p < NPHASES; ++p) {
        a.ph_lo = p; a.ph_hi = p + 1;
        hipLaunchKernelGGL(mk_fwd, dim3(grid), dim3(NTHREADS), LDS_BYTES, stream, a);
    }
#endif
}
```

```cpp
#include <hip/hip_runtime.h>
#include <hip/hip_cooperative_groups.h>
#include <cstdio>
#include <cstdint>

namespace cg = cooperative_groups;

typedef unsigned short u16;
typedef __attribute__((ext_vector_type(8))) short bf16x8;
typedef __attribute__((ext_vector_type(4))) float f32x4;
typedef short s16x4 __attribute__((ext_vector_type(4)));
#define TID ((int)threadIdx.x)
#define BID ((int)blockIdx.x)
#define GDIM ((int)gridDim.x)
#define LAS __attribute__((address_space(3)))

constexpr int D = 2048, NB = 4, S = 4096, T = NB * S;
constexpr int INW = 6176;
constexpr int NP = 6144;
constexpr int NPAD = 6208;
constexpr int C_GQ = 0, C_GK = 512, C_GV = 1024, C_GR = 2048, C_DQ = 3072, C_DK = 4096, C_DV = 5120;
constexpr int NTHREADS = 512, NWAVES = 8;
constexpr int LDS_MAIN = 128 * 1024;
constexpr int LDS_STAGE = 16 * 1024;
constexpr int LDS_BYTES = LDS_MAIN + 16 + LDS_STAGE;
constexpr float NORM_EPS = 1e-6f;

constexpr size_t WS_CTL = 0;
constexpr size_t WS_MOD = 65536;
constexpr size_t WS_CS = 524288;
constexpr size_t WS_WIN = WS_CS + (size_t)T * 64 * 8;
constexpr size_t WS_WOUT = WS_WIN + (size_t)NPAD * D * 2;
constexpr size_t WS_WPQ = WS_WOUT + (size_t)D * D * 2;
constexpr size_t WS_ACT = WS_WPQ + (size_t)D * D * 2;
constexpr size_t WS_P = WS_ACT + (size_t)T * D * 2;
constexpr size_t WS_X1 = WS_P;
constexpr size_t WS_Q = WS_P + (size_t)T * D * 4;
constexpr size_t WS_GZ = WS_P + (size_t)T * NP * 2;
constexpr int GLA_NPREP = NB * 4 * 2 * (S / 64);
constexpr size_t WS_QD = WS_GZ + (size_t)T * 32 * 4;
constexpr size_t WS_KE = WS_QD + (size_t)GLA_NPREP * 16384;
constexpr size_t WS_AT = WS_KE + (size_t)GLA_NPREP * 16384;
constexpr size_t WS_DEC = WS_AT + (size_t)GLA_NPREP * 8192;
constexpr size_t WS_OFB = WS_DEC + (size_t)GLA_NPREP * 512;
constexpr size_t WS_IDX = WS_OFB + (size_t)2 * T * 1024 * 2;
constexpr size_t WS_GATE = WS_IDX + (size_t)T * 128 * 4;
constexpr size_t WS_SS = WS_GATE + (size_t)T * 128 * 4;
constexpr size_t WS_KXS = WS_SS + (size_t)T * 8 * 4;
constexpr size_t WS_END = WS_KXS + (size_t)T * 8 * 4;
constexpr size_t WS_IMG = WS_OFB;
constexpr size_t WS_AP = WS_P + (size_t)T * D * 2;
constexpr size_t SLICE_T = (size_t)16384 * 128, SLICE_S = (size_t)16384 * 8;
constexpr size_t WS_TU = WS_QD;
constexpr size_t WS_TV = WS_TU + (size_t)16384 * 1024;
constexpr size_t WS_SU = WS_TV + (size_t)16384 * 1024;
constexpr size_t WS_SV = WS_SU + (size_t)16384 * 128;
static_assert(WS_SV + (size_t)16384 * 128 <= WS_IDX, "table region");

struct Args {
    const float* x; const float* c; const int* pos; const float* w_ada; const float* b_ada; const float* g_mix;
    const float* w_in; const float* wgf; const float* bgf; const float* wgb; const float* bgb; const float* g_gla;
    const float* w_out; const float* g_ffn; const float* w_pq; const float* subk; const float* pu; const float* pv; const float* g_fin;
    float* out; unsigned char* ws; int ph_lo, ph_hi;
};

__device__ __forceinline__ float bf2f(u16 h) { return __uint_as_float(((unsigned)h) << 16); }
typedef __bf16 hw_bf16x2 __attribute__((ext_vector_type(2)));
typedef float hw_f32x2 __attribute__((ext_vector_type(2)));
typedef unsigned u32x2_t __attribute__((ext_vector_type(2)));
__device__ __forceinline__ unsigned pack2(float a, float b) { const hw_f32x2 f = {a, b}; return __builtin_bit_cast(unsigned, __builtin_convertvector(f, hw_bf16x2)); }
__device__ __forceinline__ u16 f2bf(float f) { return (u16)(pack2(f, 0.f) & 0xffffu); }
__device__ __forceinline__ float lo2f(unsigned p) { return __uint_as_float(p << 16); }
__device__ __forceinline__ float hi2f(unsigned p) { return __uint_as_float(p & 0xffff0000u); }
__device__ __forceinline__ float wave_sum(float v) {
#pragma unroll
    for (int o = 32; o > 0; o >>= 1) v += __shfl_xor(v, o);
    return v;
}
__device__ __forceinline__ float wave_max(float v) {
#pragma unroll
    for (int o = 32; o > 0; o >>= 1) v = fmaxf(v, __shfl_xor(v, o));
    return v;
}
__device__ __forceinline__ float silu_f(float v) { return v / (1.f + __expf(-v)); }
__device__ __forceinline__ float gelu_f(float a) {
    const float x = fabsf(a) * 0.70710678118654752f;
    const float t = __builtin_amdgcn_rcpf(1.f + 0.3275911f * x);
    const float poly = t * (0.254829592f + t * (-0.284496736f + t * (1.421413741f + t * (-1.453152027f + t * 1.061405429f))));
    const float erfabs = 1.f - poly * __expf(-x * x);
    const float erfv = a < 0.f ? -erfabs : erfabs;
    return 0.5f * a * (1.f + erfv);
}
__device__ __forceinline__ float logsigmoid_f(float z) { return z < 0.f ? z - log1pf(expf(z)) : -log1pf(expf(-z)); }

constexpr int MOD_BLOCKS = 96;
__device__ __forceinline__ void p0_mod(const Args& a, unsigned char* lds, int bi) {
    float* sc = (float*)lds;
    float* red = sc + 4 * 2048;
    const int tid = threadIdx.x, lane = tid & 63, wave = tid >> 6;
    for (int i = tid; i < 4 * 2048; i += NTHREADS) sc[i] = silu_f(a.c[i]);
    __syncthreads();
    const int half = lane >> 5, cl = lane & 31;
    const int j0 = bi * 128 + cl * 4;
    float acc[4][4];
#pragma unroll
    for (int b = 0; b < 4; ++b) { acc[b][0] = 0.f; acc[b][1] = 0.f; acc[b][2] = 0.f; acc[b][3] = 0.f; }
    const int k0 = wave * 256 + half;
#pragma unroll 8
    for (int kk = 0; kk < 128; ++kk) {
        const int k = k0 + 2 * kk;
        const f32x4 w = __builtin_nontemporal_load((const f32x4*)(a.w_ada + (size_t)k * 12288 + j0));
#pragma unroll
        for (int b = 0; b < 4; ++b) { const float s = sc[b * 2048 + k]; acc[b][0] += s * w[0]; acc[b][1] += s * w[1]; acc[b][2] += s * w[2]; acc[b][3] += s * w[3]; }
    }
#pragma unroll
    for (int b = 0; b < 4; ++b)
#pragma unroll
        for (int i = 0; i < 4; ++i) acc[b][i] += __shfl_xor(acc[b][i], 32);
    if (half == 0) {
#pragma unroll
        for (int b = 0; b < 4; ++b) *(float4*)(red + (wave * 4 + b) * 128 + cl * 4) = make_float4(acc[b][0], acc[b][1], acc[b][2], acc[b][3]);
    }
    __syncthreads();
    float* mod = (float*)(a.ws + WS_MOD);
    {
        const int b = tid >> 7, jc = tid & 127;
        float s = 0.f;
#pragma unroll
        for (int w = 0; w < 8; ++w) s += red[(w * 4 + b) * 128 + jc];
        mod[b * 12288 + bi * 128 + jc] = s + a.b_ada[bi * 128 + jc];
    }
    __syncthreads();
}

__device__ __forceinline__ void p0_transpose_item(const float* __restrict__ W, int ldw, int k0, int src_col0, int n_valid,
                                                  u16* __restrict__ WT, int ldt, int n_out0, unsigned char* wlds, bool rope_perm = false) {
    u16* tl = (u16*)wlds;
    const int lane = threadIdx.x & 63;
    const int rsub = lane >> 4, nc = (lane & 15) * 4;
    int scol = src_col0 + nc;
    if (rope_perm) { const int p = (n_out0 & 64) + nc, g = p >> 3; scol = (src_col0 - (n_out0 & 64)) + ((p & 4) ? 64 + 4 * g : 4 * g); }
    float4 v[16];
#pragma unroll
    for (int j = 0; j < 16; ++j) {
        const int k = 4 * j + rsub;
        if (nc < n_valid) { const f32x4 q_ = __builtin_nontemporal_load((const f32x4*)(W + (size_t)(k0 + k) * ldw + scol)); v[j] = make_float4(q_[0], q_[1], q_[2], q_[3]); }
        else v[j] = make_float4(0.f, 0.f, 0.f, 0.f);
    }
#pragma unroll
    for (int j = 0; j < 16; ++j) {
        const int k = 4 * j + rsub;
        tl[(nc + 0) * 72 + k] = f2bf(v[j].x); tl[(nc + 1) * 72 + k] = f2bf(v[j].y); tl[(nc + 2) * 72 + k] = f2bf(v[j].z); tl[(nc + 3) * 72 + k] = f2bf(v[j].w);
    }
#pragma unroll
    for (int j = 0; j < 8; ++j) {
        const int c = lane + 64 * j, n = c >> 3, kc = (c & 7) * 8;
        const uint4 o = *(const uint4*)(tl + n * 72 + kc);
        *(uint4*)(WT + (size_t)(n_out0 + n) * ldt + k0 + kc) = o;
    }
}

__device__ __forceinline__ void phase0(const Args& a, unsigned char* lds) {
    const int bi = blockIdx.x, G = gridDim.x, tid = threadIdx.x, wave = tid >> 6;
    const bool modblk = (G > MOD_BLOCKS) && (bi < MOD_BLOCKS);
    if (G > MOD_BLOCKS) { if (modblk) p0_mod(a, lds, bi); }
    else { for (int mb = bi; mb < MOD_BLOCKS; mb += G) p0_mod(a, lds, mb); }
    const int nb = (G > MOD_BLOCKS) ? G - MOD_BLOCKS : G, b0 = (G > MOD_BLOCKS) ? bi - MOD_BLOCKS : bi;
    if (!modblk) {
        constexpr int I_IN = 32 * (NPAD / 64), I_SQ = 32 * 32;
        u16* WinT = (u16*)(a.ws + WS_WIN); u16* WoutT = (u16*)(a.ws + WS_WOUT); u16* WpqT = (u16*)(a.ws + WS_WPQ);
        unsigned char* wlds = lds + wave * 9216;
        for (int it = b0 * NWAVES + wave; it < I_IN + 2 * I_SQ; it += nb * NWAVES) {
            if (it < I_IN) {
                const int kt = it & 31, nt = it >> 5;
                const int n0 = nt * 64;
                int src, nv;
                if (n0 < 3072) { src = n0; nv = 64; }
                else if (n0 < 6144) { src = n0 + 32; nv = 64; }
                else if (n0 == 6144) { src = 3072; nv = 32; }
                else { src = 0; nv = 0; }
                p0_transpose_item(a.w_in, INW, kt * 64, src, nv, WinT, D, n0, wlds, n0 >= C_DQ && n0 < C_DV);
            } else if (it < I_IN + I_SQ) {
                const int r = it - I_IN; const int kt = r & 31, nt = r >> 5;
                p0_transpose_item(a.w_out, D, kt * 64, nt * 64, 64, WoutT, D, nt * 64, wlds);
            } else {
                const int r = it - I_IN - I_SQ; const int kt = r & 31, nt = r >> 5;
                p0_transpose_item(a.w_pq, D, kt * 64, nt * 64, 64, WpqT, D, nt * 64, wlds);
            }
        }
        unsigned* cs = (unsigned*)(a.ws + WS_CS);
        for (int i = b0 * NTHREADS + tid; i < T * 64; i += nb * NTHREADS) {
            const int t = i >> 6, f = i & 63;
            const float inv_freq = powf(10000.0f, -(float)f * 2.0f / 128.0f);
            const float ang = (float)a.pos[t] * inv_freq;
            const double rev = (double)ang * 0.15915494309189533577;
            const float fr = (float)(rev - floor(rev));
            cs[i] = pack2(__builtin_amdgcn_cosf(fr), __builtin_amdgcn_sinf(fr));
        }
    }
    __syncthreads();
}

template <bool BF16IN> __device__ __forceinline__ void norm_mod_phase(const void* __restrict__ xin_, const float* __restrict__ g, const float* __restrict__ mod,
                                               int sh_chunk, int sc_chunk, u16* __restrict__ outp, unsigned char* lds, unsigned char* __restrict__ img = nullptr, int* __restrict__ kxs = nullptr) {
    const int lane = threadIdx.x & 63, wave = threadIdx.x >> 6;
    LAS f32x4* lmul = (LAS f32x4*)lds; LAS f32x4* lsh = (LAS f32x4*)(lds + 32768);
    for (int i = threadIdx.x; i < 4 * 512; i += NTHREADS) {
        const int bb = i >> 9, j = i & 511;
        const f32x4 gg = ((const f32x4*)g)[j], sc = ((const f32x4*)(mod + bb * 12288 + sc_chunk * 2048))[j], sh = ((const f32x4*)(mod + bb * 12288 + sh_chunk * 2048))[j];
        lmul[i] = gg * (1.f + sc); lsh[i] = sh;
    }
    __syncthreads();
    const int gw = blockIdx.x * NWAVES + wave, NGW = gridDim.x * NWAVES;
    float4 v[8], vn[8];
#define NM_LOAD(dst_, t_) do { if (BF16IN) { const hw_f32x2* xr_ = (const hw_f32x2*)((const u16*)xin_ + (size_t)(t_) * D); \
            _Pragma("unroll") for (int m = 0; m < 8; ++m) { const hw_f32x2 q_ = __builtin_nontemporal_load(xr_ + lane + 64 * m); const unsigned px_ = __float_as_uint(q_[0]), py_ = __float_as_uint(q_[1]); \
                dst_[m] = make_float4(lo2f(px_), hi2f(px_), lo2f(py_), hi2f(py_)); } } \
        else { const f32x4* xr_ = (const f32x4*)((const float*)xin_ + (size_t)(t_) * D); \
            _Pragma("unroll") for (int m = 0; m < 8; ++m) { const f32x4 q_ = __builtin_nontemporal_load(xr_ + lane + 64 * m); dst_[m] = make_float4(q_[0], q_[1], q_[2], q_[3]); } } } while (0)
    if (gw < T) NM_LOAD(v, gw);
    for (int t = gw; t < T; t += NGW) {
        const int b = t / S;
        if (t + NGW < T) NM_LOAD(vn, t + NGW);
        float ss = 0.f;
#pragma unroll
        for (int m = 0; m < 8; ++m) ss += v[m].x * v[m].x + v[m].y * v[m].y + v[m].z * v[m].z + v[m].w * v[m].w;
        ss = wave_sum(ss);
        const float rstd = rsqrtf(ss * (1.f / D) + NORM_EPS);

        uint2* op = (uint2*)(outp + (size_t)t * D);
#pragma unroll
        for (int m = 0; m < 8; ++m) {
            const int i = lane + 64 * m;
            const f32x4 mu = lmul[b * 512 + i], sh = lsh[b * 512 + i];
            const float h0 = v[m].x * rstd * mu[0] + sh[0];
            const float h1 = v[m].y * rstd * mu[1] + sh[1];
            const float h2 = v[m].z * rstd * mu[2] + sh[2];
            const float h3 = v[m].w * rstd * mu[3] + sh[3];
            const uint2 pk = make_uint2(pack2(h0, h1), pack2(h2, h3));
            op[i] = pk;
            if (BF16IN) {
                const float e0 = lo2f(pk.x), e1 = hi2f(pk.x), e2 = lo2f(pk.y), e3 = hi2f(pk.y);
                float amx = fmaxf(fmaxf(fabsf(e0), fabsf(e1)), fmaxf(fabsf(e2), fabsf(e3)));
#pragma unroll
                for (int o = 32; o > 0; o >>= 1) amx = fmaxf(amx, __shfl_xor(amx, o));
                const unsigned bits = __float_as_uint(amx);
                int kx = (int)(bits >> 23) - 127 - 8 + (((bits & 0x7fffffu) > 0x600000u) ? 1 : 0); kx = kx < -100 ? -100 : kx;
                const float hinv = __uint_as_float((unsigned)(127 - kx) << 23);
                const float x0 = e0 * hinv, x1 = e1 * hinv, x2 = e2 * hinv, x3 = e3 * hinv;
                int w = __builtin_amdgcn_cvt_pk_fp8_f32(x0, x1, 0, false); w = __builtin_amdgcn_cvt_pk_fp8_f32(x2, x3, w, true);
                const hw_f32x2 d0 = __builtin_amdgcn_cvt_pk_f32_fp8(w, false), d1 = __builtin_amdgcn_cvt_pk_f32_fp8(w, true);
                int l = __builtin_amdgcn_cvt_pk_fp8_f32((x0 - d0[0]) * 16.f, (x1 - d0[1]) * 16.f, 0, false);
                l = __builtin_amdgcn_cvt_pk_fp8_f32((x2 - d1[0]) * 16.f, (x3 - d1[1]) * 16.f, l, true);
                const int ei = 4 * lane, s = ei >> 7, k = ei & 127, g = (k & 63) >> 4, bb = (k & 15) + 16 * (k >> 6);
                unsigned char* ip = img + (((size_t)t * 8 + m) * 8 + 2 * g) * 64 + s * 32 + bb;
                *(int*)ip = w; *(int*)(ip + 64) = l;
                if (lane == 0) kxs[(size_t)t * 8 + m] = kx;
            }
        }
#pragma unroll
        for (int m = 0; m < 8; ++m) v[m] = vn[m];
    }
#undef NM_LOAD
}

__device__ __forceinline__ void norm_img_phase(const u16* __restrict__ xin, const float* __restrict__ g, const float* __restrict__ mod,
                                               int sh_chunk, int sc_chunk, u16* __restrict__ outp, unsigned char* lds, unsigned char* __restrict__ img, int* __restrict__ kxs) {
    typedef unsigned ni_u32x4 __attribute__((ext_vector_type(4)));
    typedef unsigned ni_u32x2 __attribute__((ext_vector_type(2)));
    const int lane = threadIdx.x & 63, wave = threadIdx.x >> 6;
    LAS f32x4* lmul = (LAS f32x4*)lds; LAS f32x4* lsh = (LAS f32x4*)(lds + 32768);
    for (int i = threadIdx.x; i < 4 * 512; i += NTHREADS) {
        const int bb = i >> 9, r = i & 511, j = 128 * (r >> 7) + 2 * (r & 63) + ((r >> 6) & 1);
        const f32x4 gg = ((const f32x4*)g)[j], sc = ((const f32x4*)(mod + bb * 12288 + sc_chunk * 2048))[j], sh = ((const f32x4*)(mod + bb * 12288 + sh_chunk * 2048))[j];
        lmul[i] = gg * (1.f + sc); lsh[i] = sh;
    }
    __syncthreads();
    const int gw = blockIdx.x * NWAVES + wave, NGW = gridDim.x * NWAVES;
    const int l5 = lane & 31;
    const int ioff = (2 * (l5 >> 4) + ((l5 >> 3) & 1)) * 128 + ((l5 & 7) >> 1) * 32 + 8 * (l5 & 1);
    ni_u32x4 v[4], vn[4];
#define NI_LOAD(dst_, t_) do { const ni_u32x4* xr_ = (const ni_u32x4*)(xin + (size_t)(t_) * D); \
        _Pragma("unroll") for (int m = 0; m < 4; ++m) dst_[m] = __builtin_nontemporal_load(xr_ + lane + 64 * m); } while (0)
    if (gw < T) NI_LOAD(v, gw);
    for (int t = gw; t < T; t += NGW) {
        const int b = t / S;
        if (t + NGW < T) NI_LOAD(vn, t + NGW);
        float ss = 0.f;
#pragma unroll
        for (int m = 0; m < 4; ++m) {
#pragma unroll
            for (int d = 0; d < 4; ++d) { const float xa = lo2f(v[m][d]), xb = hi2f(v[m][d]); ss += xa * xa + xb * xb; }
        }
        ss = wave_sum(ss);
        const float rstd = rsqrtf(ss * (1.f / D) + NORM_EPS);

        ni_u32x4* op = (ni_u32x4*)(outp + (size_t)t * D);
#pragma unroll
        for (int m = 0; m < 4; ++m) {
            const f32x4 mu0 = lmul[b * 512 + (2 * m) * 64 + lane], mu1 = lmul[b * 512 + (2 * m + 1) * 64 + lane];
            const f32x4 sh0 = lsh[b * 512 + (2 * m) * 64 + lane], sh1 = lsh[b * 512 + (2 * m + 1) * 64 + lane];
            const float h0 = lo2f(v[m][0]) * rstd * mu0[0] + sh0[0], h1 = hi2f(v[m][0]) * rstd * mu0[1] + sh0[1];
            const float h2 = lo2f(v[m][1]) * rstd * mu0[2] + sh0[2], h3 = hi2f(v[m][1]) * rstd * mu0[3] + sh0[3];
            const float h4 = lo2f(v[m][2]) * rstd * mu1[0] + sh1[0], h5 = hi2f(v[m][2]) * rstd * mu1[1] + sh1[1];
            const float h6 = lo2f(v[m][3]) * rstd * mu1[2] + sh1[2], h7 = hi2f(v[m][3]) * rstd * mu1[3] + sh1[3];
            ni_u32x4 pk; pk[0] = pack2(h0, h1); pk[1] = pack2(h2, h3); pk[2] = pack2(h4, h5); pk[3] = pack2(h6, h7);
            op[lane + 64 * m] = pk;
            const float e0 = lo2f(pk[0]), e1 = hi2f(pk[0]), e2 = lo2f(pk[1]), e3 = hi2f(pk[1]), e4 = lo2f(pk[2]), e5 = hi2f(pk[2]), e6 = lo2f(pk[3]), e7 = hi2f(pk[3]);
            float amx = fmaxf(fmaxf(fmaxf(fabsf(e0), fabsf(e1)), fmaxf(fabsf(e2), fabsf(e3))), fmaxf(fmaxf(fabsf(e4), fabsf(e5)), fmaxf(fabsf(e6), fabsf(e7))));
#pragma unroll
            for (int o = 16; o > 0; o >>= 1) amx = fmaxf(amx, __shfl_xor(amx, o));
            const unsigned bits = __float_as_uint(amx);
            int kx = (int)(bits >> 23) - 127 - 8 + (((bits & 0x7fffffu) > 0x600000u) ? 1 : 0); kx = kx < -100 ? -100 : kx;
            const float hinv = __uint_as_float((unsigned)(127 - kx) << 23);
            const float x0 = e0 * hinv, x1 = e1 * hinv, x2 = e2 * hinv, x3 = e3 * hinv, x4 = e4 * hinv, x5 = e5 * hinv, x6 = e6 * hinv, x7 = e7 * hinv;
            int w0 = __builtin_amdgcn_cvt_pk_fp8_f32(x0, x1, 0, false); w0 = __builtin_amdgcn_cvt_pk_fp8_f32(x2, x3, w0, true);
            int w1 = __builtin_amdgcn_cvt_pk_fp8_f32(x4, x5, 0, false); w1 = __builtin_amdgcn_cvt_pk_fp8_f32(x6, x7, w1, true);
            const hw_f32x2 d0 = __builtin_amdgcn_cvt_pk_f32_fp8(w0, false), d1 = __builtin_amdgcn_cvt_pk_f32_fp8(w0, true);
            const hw_f32x2 d2 = __builtin_amdgcn_cvt_pk_f32_fp8(w1, false), d3 = __builtin_amdgcn_cvt_pk_f32_fp8(w1, true);
            int l0 = __builtin_amdgcn_cvt_pk_fp8_f32((x0 - d0[0]) * 16.f, (x1 - d0[1]) * 16.f, 0, false);
            l0 = __builtin_amdgcn_cvt_pk_fp8_f32((x2 - d1[0]) * 16.f, (x3 - d1[1]) * 16.f, l0, true);
            int l1 = __builtin_amdgcn_cvt_pk_fp8_f32((x4 - d2[0]) * 16.f, (x5 - d2[1]) * 16.f, 0, false);
            l1 = __builtin_amdgcn_cvt_pk_fp8_f32((x6 - d3[0]) * 16.f, (x7 - d3[1]) * 16.f, l1, true);
            const int sl = 2 * m + (lane >> 5);
            unsigned char* ip = img + ((size_t)t * 8 + sl) * 512 + ioff;
            ni_u32x2 wv, lv; wv[0] = (unsigned)w0; wv[1] = (unsigned)w1; lv[0] = (unsigned)l0; lv[1] = (unsigned)l1;
            *(ni_u32x2*)ip = wv; *(ni_u32x2*)(ip + 16) = lv;
            if (l5 == 0) kxs[(size_t)t * 8 + sl] = kx;
        }
#pragma unroll
        for (int m = 0; m < 4; ++m) v[m] = vn[m];
    }
#undef NI_LOAD
}

namespace pg8 {
#define PG8_LAS __attribute__((address_space(3)))
typedef unsigned short bf16_t;
typedef short bf16x8 __attribute__((ext_vector_type(8)));
typedef float f32x4 __attribute__((ext_vector_type(4)));
typedef unsigned u32x4 __attribute__((ext_vector_type(4)));
constexpr int BM = 256, BK = 64, HALF = 128, HTB = HALF * BK * 2  , STAGE_BYTES = 8 * HTB, NXCD = 8, WGM = 8;

__host__ __device__ __forceinline__ int lds_byte(int r, int c) { const int st = (r >> 4) * 2 + (c >> 5), rr = r & 15, cc = c & 31, ob = rr * 64 + cc * 2; return st * 1024 + (ob ^ (((ob >> 9) & 1) << 5)); }
__host__ __device__ __forceinline__ void stage_rc(int b, int& R, int& C) { const int st = b / 1024, sb = b % 1024, swz = sb ^ (((sb >> 9) & 1) << 5); R = (st >> 1) * 16 + swz / 64; C = (st & 1) * 32 + (swz % 64) / 2; }
__host__ __device__ __forceinline__ int perm32(int rho) { const int n = rho >> 4, i = rho & 15; return 8 * (i >> 2) + 4 * n + (i & 3); }

struct Unit { int pm, pn; };
struct Gemm { const bf16_t* A; const bf16_t* Bt; int M, N, K; };

struct StaticOrder {
    int nM, nN, nwg, G, c;
    __host__ __device__ void init(int M, int N, int G_, int c_) { nM = M / BM; nN = N / BM; nwg = nM * nN; G = G_; c = c_; }
    __host__ __device__ bool next(int i, Unit& u) const {
        const long L = (long)i * G + c; if (L >= nwg) return false;
        int wgid = (int)L; { const int q = nwg / NXCD, r = nwg % NXCD, xcd = wgid % NXCD, off = wgid / NXCD; wgid = (xcd < r ? xcd * (q + 1) : r * (q + 1) + (xcd - r) * q) + off; }
        const int nig = WGM * nN, gid = wgid / nig, fm = gid * WGM, gsz = (nM - fm) < WGM ? (nM - fm) : WGM;
        u.pm = fm + ((wgid % nig) % gsz); u.pn = (wgid % nig) / gsz; return true;
    }
    __device__ __forceinline__ void a_ready(const Unit&) const {}
    __device__ __forceinline__ void done(const Unit&) const {}
};
__device__ __forceinline__ unsigned cvt_pk_bf16(float lo, float hi) { unsigned r; asm volatile("v_cvt_pk_bf16_f32 %0, %1, %2" : "=v"(r) : "v"(lo), "v"(hi)); return r; }
typedef float f32x2 __attribute__((ext_vector_type(2)));
template <class Epi, class Sched, bool STAMP = false>
__device__ __forceinline__ void gemm_phase(PG8_LAS unsigned char* lds, const Gemm g, const Sched& S, const Epi& E, unsigned long long* stamps) {
    const int tid = threadIdx.x, wid = __builtin_amdgcn_readfirstlane(tid >> 6), lane = tid & 63, wr = wid >> 2, wc = wid & 3, fr = lane & 15, fq = lane >> 4;
    const int K = g.K, nt = K / BK;
    int ts_lo = 0, ts_hi = 0, nts = 0; const unsigned long long rt_entry = STAMP ? (unsigned long long)wall_clock64() : 0ull;
#define PG8_STAMP() do { if (STAMP && wid == 0 && nts < 64) { const unsigned long long _c = (unsigned long long)clock64(); \
        ts_lo = (lane == nts) ? (int)(unsigned)_c : ts_lo; ts_hi = (lane == nts) ? (int)(unsigned)(_c >> 32) : ts_hi; ++nts; } } while (0)
    PG8_STAMP();
    unsigned voffA[2], voffB[2];
#pragma unroll
    for (int i = 0; i < 2; ++i) { int R, C; stage_rc(tid * 16 + i * 8192, R, C); const int Rb = Epi::PERM ? ((R >> 5) * 64 + perm32(R & 31)) : R;
        voffA[i] = (unsigned)(R * K + C) * 2u; voffB[i] = (unsigned)(Rb * K + C) * 2u; }
    const size_t kstep = (size_t)(BK * 2);
    const size_t hstep = (size_t)HALF * K * 2;
    const size_t hstepB = Epi::PERM ? (size_t)32 * K * 2 : hstep;
    const size_t tstep = 2 * hstep;
    const unsigned ldsw = (unsigned)wid * 1024u;
    const int aoff = lds_byte(wr * 64 + fr, fq * 8), boff = lds_byte(wc * 32 + fr, fq * 8);
#define PG8_SA(b, h) (((b) * 2 + (h)) * HTB)
#define PG8_SB(b, h) ((4 + (b) * 2 + (h)) * HTB)
#define PG8_STAGE(bufoff, gbase, voff) do { _Pragma("unroll") for (int _i = 0; _i < 2; ++_i) \
        __builtin_amdgcn_global_load_lds((const unsigned*)((const char*)(gbase) + (voff)[_i]), (PG8_LAS unsigned*)(lds + (bufoff) + ldsw + _i * 8192), 16, 0, 0); } while (0)
#define PG8_LDA(dst, b, h) do { _Pragma("unroll") for (int m = 0; m < 4; ++m) _Pragma("unroll") for (int k = 0; k < 2; ++k) dst[m][k] = *(const PG8_LAS bf16x8*)(lds + PG8_SA(b, h) + aoff + m * 2048 + k * 1024); } while (0)
#define PG8_LDB(dst, b, h) do { _Pragma("unroll") for (int n = 0; n < 2; ++n) _Pragma("unroll") for (int k = 0; k < 2; ++k) dst[n][k] = *(const PG8_LAS bf16x8*)(lds + PG8_SB(b, h) + boff + n * 2048 + k * 1024); } while (0)
#define PG8_MMA(ai, bj, At, Bt) do { __builtin_amdgcn_s_setprio(1); _Pragma("unroll") for (int m = 0; m < 4; ++m) _Pragma("unroll") for (int n = 0; n < 2; ++n) _Pragma("unroll") for (int k = 0; k < 2; ++k) \
        acc[ai][bj][m][n] = __builtin_amdgcn_mfma_f32_16x16x32_bf16(Bt[n][k], At[m][k], acc[ai][bj][m][n], 0, 0, 0); __builtin_amdgcn_s_setprio(0); } while (0)
#define PG8_WAIT_V(n) asm volatile("s_waitcnt vmcnt(" #n ")" ::: "memory")
#define PG8_WAIT_L(n) asm volatile("s_waitcnt lgkmcnt(" #n ")" ::: "memory")
#define PG8_BAR __builtin_amdgcn_s_barrier()
#define PG8_SCHED __builtin_amdgcn_sched_barrier(0)
    Unit cur, nxt; int ui = 0;
    if (!S.next(0, cur)) return;
    f32x4 acc[2][2][4][2];
#pragma unroll
    for (int a = 0; a < 2; ++a)
#pragma unroll
        for (int b = 0; b < 2; ++b)
#pragma unroll
            for (int m = 0; m < 4; ++m)
#pragma unroll
                for (int n = 0; n < 2; ++n) acc[a][b][m][n] = (f32x4){0.f, 0.f, 0.f, 0.f};
    bf16x8 At[4][2], B0[2][2], B1[2][2];
    const char* cA = (const char*)g.A + (size_t)cur.pm * tstep; const char* cB = (const char*)g.Bt + (size_t)cur.pn * tstep;
    S.a_ready(cur);
    PG8_STAGE(PG8_SB(0, 0), cB, voffB); PG8_STAGE(PG8_SA(0, 0), cA, voffA); PG8_STAGE(PG8_SB(0, 1), cB + hstepB, voffB); PG8_STAGE(PG8_SA(0, 1), cA + hstep, voffA);
    if (wr == 1) PG8_BAR;
    PG8_WAIT_V(4); PG8_BAR;
    PG8_STAGE(PG8_SB(1, 0), cB + kstep, voffB); PG8_STAGE(PG8_SA(1, 0), cA + kstep, voffA); PG8_STAGE(PG8_SB(1, 1), cB + hstepB + kstep, voffB);
    PG8_WAIT_V(6); PG8_BAR;
    PG8_STAMP();
    for (;;) {
        const bool has_next = S.next(ui + 1, nxt);
        const char* nA = has_next ? (const char*)g.A + (size_t)nxt.pm * tstep : cA; const char* nB = has_next ? (const char*)g.Bt + (size_t)nxt.pn * tstep : cB;
        for (int t = 0; t < nt; t += 2) {
            const bool last = (t == nt - 2);
            const char* a1 = cA + (size_t)(t + 1) * kstep;
            const char* a2 = last ? nA : cA + (size_t)(t + 2) * kstep; const char* b2 = last ? nB : cB + (size_t)(t + 2) * kstep;
            const char* a3 = a2 + kstep; const char* b3 = b2 + kstep;
            if (last && has_next) S.a_ready(nxt);
            PG8_LDB(B0, 0, 0); PG8_SCHED; PG8_LDA(At, 0, 0); PG8_STAGE(PG8_SA(1, 1), a1 + hstep, voffA);
            PG8_WAIT_L(8); PG8_BAR; PG8_WAIT_L(0); PG8_MMA(0, 0, At, B0); PG8_BAR; PG8_SCHED;
            PG8_LDB(B1, 0, 1); PG8_STAGE(PG8_SB(0, 0), b2, voffB);
            PG8_BAR; PG8_WAIT_L(0); PG8_MMA(0, 1, At, B1); PG8_BAR;
            PG8_LDA(At, 0, 1); PG8_STAGE(PG8_SA(0, 0), a2, voffA);
            PG8_BAR; PG8_WAIT_L(0); PG8_MMA(1, 0, At, B0); PG8_BAR; PG8_SCHED;
            PG8_STAGE(PG8_SB(0, 1), b2 + hstepB, voffB);
            PG8_WAIT_V(6); PG8_BAR; PG8_MMA(1, 1, At, B1); PG8_BAR;
            PG8_LDB(B0, 1, 0); PG8_SCHED; PG8_LDA(At, 1, 0); PG8_STAGE(PG8_SA(0, 1), a2 + hstep, voffA);
            PG8_WAIT_L(8); PG8_BAR; PG8_WAIT_L(0); PG8_MMA(0, 0, At, B0); PG8_BAR; PG8_SCHED;
            PG8_LDB(B1, 1, 1); PG8_STAGE(PG8_SB(1, 0), b3, voffB);
            PG8_BAR; PG8_WAIT_L(0); PG8_MMA(0, 1, At, B1); PG8_BAR;
            PG8_LDA(At, 1, 1); PG8_STAGE(PG8_SA(1, 0), a3, voffA);
            PG8_BAR; PG8_WAIT_L(0); PG8_MMA(1, 0, At, B0); PG8_BAR; PG8_SCHED;
            PG8_STAGE(PG8_SB(1, 1), b3 + hstepB, voffB);
            PG8_WAIT_V(6); PG8_BAR; PG8_MMA(1, 1, At, B1); PG8_BAR;
        }
        PG8_STAMP();
        if constexpr (!Epi::AFTER_DRAIN) { E(acc, cur, wr, wc, fr, fq); S.done(cur); }
        PG8_STAMP();
        if (!has_next) break;
#pragma unroll
        for (int a = 0; a < 2; ++a)
#pragma unroll
            for (int b = 0; b < 2; ++b)
#pragma unroll
                for (int m = 0; m < 4; ++m)
#pragma unroll
                    for (int n = 0; n < 2; ++n) acc[a][b][m][n] = (f32x4){0.f, 0.f, 0.f, 0.f};
        cur = nxt; cA = nA; cB = nB; ++ui;
    }
    PG8_WAIT_V(0);
    if (wr == 0) PG8_BAR;
    PG8_BAR;
    if constexpr (Epi::AFTER_DRAIN) { E.fused(acc, cur, wr, wc, fr, fq, lds, wid, lane); S.done(cur); }
    PG8_STAMP();
    if (STAMP && wid == 0) { stamps[lane] = lane < nts ? (((unsigned long long)(unsigned)ts_hi << 32) | (unsigned)ts_lo) : 0ull;
        if (lane == 62) stamps[62] = rt_entry; if (lane == 63) stamps[63] = (unsigned long long)wall_clock64(); }
#undef PG8_STAMP
#undef PG8_SA
#undef PG8_SB
#undef PG8_STAGE
#undef PG8_LDA
#undef PG8_LDB
#undef PG8_MMA
#undef PG8_WAIT_V
#undef PG8_WAIT_L
#undef PG8_BAR
#undef PG8_SCHED
}
}

struct EpiProj {
    static constexpr bool PERM = true, AFTER_DRAIN = false;
    u16* P; const float* cs;
    __device__ __forceinline__ void operator()(const pg8::f32x4 (&acc)[2][2][4][2], const pg8::Unit& u, int wr, int wc, int fr, int fq) const {
        const int row0 = u.pm * 256 + wr * 64 + fr;
        const int col0 = u.pn * 256 + wc * 64 + 8 * fq;
        const bool rope = (u.pn >= C_DQ / 256) && (u.pn < C_DV / 256);
#pragma unroll
        for (int ai = 0; ai < 2; ++ai)
#pragma unroll
            for (int m = 0; m < 4; ++m) { const int row = row0 + ai * 128 + m * 16; u16* rowp = P + (size_t)row * NP + col0;
#pragma unroll
                for (int bj = 0; bj < 2; ++bj) { pg8::f32x4 v0 = acc[ai][bj][m][0], v1 = acc[ai][bj][m][1];
                    if (rope) {
                        const pg8::u32x4 q = *(const pg8::u32x4*)((const unsigned*)cs + (size_t)row * 64 + 4 * (8 * (wc & 1) + 4 * bj + fq));
                        const pg8::f32x4 cc = (pg8::f32x4){lo2f(q[0]), lo2f(q[1]), lo2f(q[2]), lo2f(q[3])}, sn = (pg8::f32x4){hi2f(q[0]), hi2f(q[1]), hi2f(q[2]), hi2f(q[3])};
                        const pg8::f32x4 y1 = v0 * cc - v1 * sn, y2 = v0 * sn + v1 * cc; v0 = y1; v1 = y2; }
                    pg8::u32x4 w; w.x = pg8::cvt_pk_bf16(v0[0], v0[1]); w.y = pg8::cvt_pk_bf16(v0[2], v0[3]); w.z = pg8::cvt_pk_bf16(v1[0], v1[1]); w.w = pg8::cvt_pk_bf16(v1[2], v1[3]);
                    *(pg8::u32x4*)(rowp + bj * 32) = w; } }
    }
};
__device__ __forceinline__ void gz_phase(unsigned char* lds, const u16* __restrict__ H1, const u16* __restrict__ Wg, float* __restrict__ gz) {
    const int tid = threadIdx.x, lane = tid & 63, wave = tid >> 6, fr = lane & 15, fq = lane >> 4;
    float* red = (float*)lds;
    for (int rb = blockIdx.x; rb < T / 64; rb += gridDim.x) {
        const int r0 = rb * 64, k0 = wave * 256;
        f32x4 acc[4][2];
#pragma unroll
        for (int m = 0; m < 4; ++m) { acc[m][0] = (f32x4){0.f, 0.f, 0.f, 0.f}; acc[m][1] = (f32x4){0.f, 0.f, 0.f, 0.f}; }
#pragma unroll
        for (int ks = 0; ks < 8; ++ks) {
            bf16x8 af[4], bfr[2];
#pragma unroll
            for (int m = 0; m < 4; ++m) af[m] = *(const bf16x8*)(H1 + (size_t)(r0 + 16 * m + fr) * D + k0 + 32 * ks + 8 * fq);
#pragma unroll
            for (int n = 0; n < 2; ++n) bfr[n] = *(const bf16x8*)(Wg + (size_t)(16 * n + fr) * D + k0 + 32 * ks + 8 * fq);
#pragma unroll
            for (int m = 0; m < 4; ++m)
#pragma unroll
                for (int n = 0; n < 2; ++n) acc[m][n] = __builtin_amdgcn_mfma_f32_16x16x32_bf16(af[m], bfr[n], acc[m][n], 0, 0, 0);
        }
        __syncthreads();
#pragma unroll
        for (int m = 0; m < 4; ++m)
#pragma unroll
            for (int n = 0; n < 2; ++n)
#pragma unroll
                for (int j = 0; j < 4; ++j) red[(wave * 64 + 16 * m + 4 * fq + j) * 32 + 16 * n + fr] = acc[m][n][j];
        __syncthreads();
#pragma unroll
        for (int k = 0; k < 4; ++k) {
            const int e = tid + 512 * k;
            float s = 0.f;
#pragma unroll
            for (int w = 0; w < 8; ++w) s += red[w * 2048 + e];
            gz[(size_t)r0 * 32 + e] = s;
        }
    }
    __syncthreads();
}
struct EpiResid {
    static constexpr bool PERM = true, AFTER_DRAIN = false;
    const float* x; const float* mod; u16* x1;
    __device__ __forceinline__ void operator()(const pg8::f32x4 (&acc)[2][2][4][2], const pg8::Unit& u, int wr, int wc, int fr, int fq) const {
        const int row0 = u.pm * 256 + wr * 64 + fr, col0 = u.pn * 256 + wc * 64 + 8 * fq;
        const int b = (u.pm * 256) / S;
        pg8::f32x4 ga[2][2];
#pragma unroll
        for (int bj = 0; bj < 2; ++bj)
#pragma unroll
            for (int n = 0; n < 2; ++n) ga[bj][n] = *(const pg8::f32x4*)(mod + b * 12288 + 2 * 2048 + col0 + bj * 32 + 4 * n);
#pragma unroll
        for (int ai = 0; ai < 2; ++ai)
#pragma unroll
            for (int m = 0; m < 4; ++m) { const size_t off = (size_t)(row0 + ai * 128 + m * 16) * D + col0;
#pragma unroll
                for (int bj = 0; bj < 2; ++bj) {
                    const pg8::f32x4 x0 = __builtin_nontemporal_load((const pg8::f32x4*)(x + off + bj * 32)), x1v = __builtin_nontemporal_load((const pg8::f32x4*)(x + off + bj * 32 + 4));
                    const pg8::f32x4 v0 = x0 + ga[bj][0] * acc[ai][bj][m][0], v1 = x1v + ga[bj][1] * acc[ai][bj][m][1];
                    pg8::u32x4 w; w.x = pg8::cvt_pk_bf16(v0[0], v0[1]); w.y = pg8::cvt_pk_bf16(v0[2], v0[3]); w.z = pg8::cvt_pk_bf16(v1[0], v1[1]); w.w = pg8::cvt_pk_bf16(v1[2], v1[3]);
                    *(pg8::u32x4*)(x1 + off + bj * 32) = w; } }
    }
};
struct EpiBf16 {
    static constexpr bool PERM = true, AFTER_DRAIN = false;
    u16* Q;
    __device__ __forceinline__ void operator()(const pg8::f32x4 (&acc)[2][2][4][2], const pg8::Unit& u, int wr, int wc, int fr, int fq) const {
        const int row0 = u.pm * 256 + wr * 64 + fr, col0 = u.pn * 256 + wc * 64 + 8 * fq;
#pragma unroll
        for (int ai = 0; ai < 2; ++ai)
#pragma unroll
            for (int m = 0; m < 4; ++m) { u16* rowp = Q + (size_t)(row0 + ai * 128 + m * 16) * D + col0;
#pragma unroll
                for (int bj = 0; bj < 2; ++bj) { const pg8::f32x4 v0 = acc[ai][bj][m][0], v1 = acc[ai][bj][m][1];
                    pg8::u32x4 w; w.x = pg8::cvt_pk_bf16(v0[0], v0[1]); w.y = pg8::cvt_pk_bf16(v0[2], v0[3]); w.z = pg8::cvt_pk_bf16(v1[0], v1[1]); w.w = pg8::cvt_pk_bf16(v1[2], v1[3]);
                    *(pg8::u32x4*)(rowp + bj * 32) = w; } }
    }
};
template <class Epi>
__device__ __forceinline__ void gemm8(unsigned char* lds, const u16* A, const u16* Bt, int M, int N, int K, const Epi& E) {
    pg8::Gemm g{A, Bt, M, N, K}; pg8::StaticOrder So; So.init(M, N, (int)gridDim.x, (int)blockIdx.x);
    pg8::gemm_phase<Epi, pg8::StaticOrder, false>((PG8_LAS unsigned char*)lds, g, So, E, nullptr);
    __syncthreads();
}

#define GLA_QD_BYTES 16384
#define GLA_AT_BYTES 8192
__device__ __forceinline__ float gla_logsigmoid(float z) { return fminf(z, 0.f) - __logf(1.f + __expf(-fabsf(z))); }

__device__ __forceinline__ void gla_prep_item(const u16* __restrict__ P, int ldp, int cq, int ck, const float* __restrict__ gz,
                                              const float* __restrict__ wg_f, const float* __restrict__ bg_f, const float* __restrict__ wg_b, const float* __restrict__ bg_b,
                                              int Sq, unsigned char* __restrict__ QDg, unsigned char* __restrict__ KEg, unsigned char* __restrict__ ATg, float* __restrict__ DECg,
                                              unsigned char* lds, int item, const uint4 rq0, const uint4 rq1, const uint4 rk0, const uint4 rk1, const float gza, const float gzb) {
    const int nch = Sq / 64;
    const int c = item % nch, dir = (item / nch) & 1, hh = (item / (nch * 2)) & 3, b = item / (nch * 8);
    const int tid = TID, lane = tid & 63, wave = tid >> 6, li = lane & 15, fq = lane >> 4;
    float* gzs = (float*)lds;
    float* segs = gzs + 64 * 16;
    unsigned char* QDs = lds + 8192;
    unsigned char* KIs = QDs + 16384;
    unsigned char* KEs = KIs + 16384;
    float* bmat = (float*)(KEs + 16384);
    const size_t tok0 = (size_t)b * Sq;
    __syncthreads();
    gzs[tid] = gza; gzs[tid + 512] = gzb;
    (void)gz; (void)P; (void)cq; (void)ck; (void)tok0;
    const int d = tid & 127, seg = tid >> 7;
    const float* wg = dir ? wg_b : wg_f;
    float wcol[16];
#pragma unroll
    for (int r = 0; r < 16; ++r) wcol[r] = wg[r * 512 + hh * 128 + d];
    const float bias = (dir ? bg_b : bg_f)[hh * 128 + d];
    __syncthreads();
    float run = 0.f;
#pragma unroll
    for (int k = 0; k < 16; ++k) {
        const int i = 16 * seg + k;
        float z = bias;
#pragma unroll
        for (int r = 0; r < 16; ++r) z += gzs[i * 16 + r] * wcol[r];
        run += gla_logsigmoid(z) * (1.f / 16.f);
        bmat[i * 128 + d] = run;
    }
    segs[seg * 128 + d] = run;
    __syncthreads();
    if (seg == 0) {
        const float t0 = segs[d], t1 = segs[128 + d], t2 = segs[256 + d], t3 = segs[384 + d];
        segs[d] = 0.f; segs[128 + d] = t0; segs[256 + d] = t0 + t1; segs[384 + d] = t0 + t1 + t2; segs[512 + d] = t0 + t1 + t2 + t3;
        DECg[(size_t)item * 128 + d] = __expf(t0 + t1 + t2 + t3);
    }
    __syncthreads();
    const float qscale = 0.08838834764831845f;
#pragma unroll
    for (int k = 0; k < 2; ++k) {
        const int id = tid + 512 * k, i = id >> 4, cc = id & 15, d0 = cc * 8, sg = i >> 4;
        const uint4 qv = k ? rq1 : rq0, kv = k ? rk1 : rk0;
        const float qx[8] = {lo2f(qv.x), hi2f(qv.x), lo2f(qv.y), hi2f(qv.y), lo2f(qv.z), hi2f(qv.z), lo2f(qv.w), hi2f(qv.w)};
        const float kx[8] = {lo2f(kv.x), hi2f(kv.x), lo2f(kv.y), hi2f(kv.y), lo2f(kv.z), hi2f(kv.z), lo2f(kv.w), hi2f(kv.w)};
        float qd[8], ki[8], ke[8];
        const float4 bA = *(const float4*)(bmat + i * 128 + d0), bB = *(const float4*)(bmat + i * 128 + d0 + 4);
        const float4 oA = *(const float4*)(segs + sg * 128 + d0), oB = *(const float4*)(segs + sg * 128 + d0 + 4);
        const float4 tA = *(const float4*)(segs + 512 + d0), tB = *(const float4*)(segs + 512 + d0 + 4);
        const float bv[8] = {bA.x + oA.x, bA.y + oA.y, bA.z + oA.z, bA.w + oA.w, bB.x + oB.x, bB.y + oB.y, bB.z + oB.z, bB.w + oB.w};
        const float tv[8] = {tA.x, tA.y, tA.z, tA.w, tB.x, tB.y, tB.z, tB.w};
#pragma unroll
        for (int e = 0; e < 8; ++e) {
            const float bb = bv[e], tot = tv[e];
            qd[e] = qx[e] * qscale * __expf(bb); ki[e] = kx[e] * __expf(-bb); ke[e] = kx[e] * __expf(tot - bb);
        }
        const int o = i * 256 + ((cc ^ (i & 15)) << 4);
        *(uint4*)(QDs + o) = make_uint4(pack2(qd[0], qd[1]), pack2(qd[2], qd[3]), pack2(qd[4], qd[5]), pack2(qd[6], qd[7]));
        *(uint4*)(KIs + o) = make_uint4(pack2(ki[0], ki[1]), pack2(ki[2], ki[3]), pack2(ki[4], ki[5]), pack2(ki[6], ki[7]));
        *(uint4*)(KEs + o) = make_uint4(pack2(ke[0], ke[1]), pack2(ke[2], ke[3]), pack2(ke[4], ke[5]), pack2(ke[6], ke[7]));
    }
    __syncthreads();
    {
        uint4* qo = (uint4*)(QDg + (size_t)item * GLA_QD_BYTES); uint4* ko = (uint4*)(KEg + (size_t)item * GLA_QD_BYTES);
#pragma unroll
        for (int k = 0; k < 2; ++k) { const int e = tid + 512 * k; ko[e] = ((const uint4*)KEs)[e];
            const int i = e >> 4, n = (e & 15) ^ (i & 15), dp = n >> 2, fq2 = n & 3, c0 = 4 * dp + (fq2 >> 1), sb = (fq2 & 1) * 8;
            const uint2 lo = *(const uint2*)(QDs + i * 256 + ((c0 ^ (i & 15)) << 4) + sb), hi = *(const uint2*)(QDs + i * 256 + (((c0 + 2) ^ (i & 15)) << 4) + sb);
            qo[e] = make_uint4(lo.x, lo.y, hi.x, hi.y); }
    }
#pragma unroll
    for (int tt = 0; tt < 2; ++tt) {
        const int tile = wave + 8 * tt, jt = tile >> 2, it = tile & 3;
        f32x4 acc = (f32x4){0.f, 0.f, 0.f, 0.f};
        if (jt <= it) {
            const int jr = 16 * jt + li, ir = 16 * it + li;
#pragma unroll
            for (int ks = 0; ks < 4; ++ks) {
                const bf16x8 kf = *(const bf16x8*)(KIs + jr * 256 + (((4 * ks + fq) ^ (jr & 15)) << 4));
                const bf16x8 qf = *(const bf16x8*)(QDs + ir * 256 + (((4 * ks + fq) ^ (ir & 15)) << 4));
                acc = __builtin_amdgcn_mfma_f32_16x16x32_bf16(kf, qf, acc, 0, 0, 0);
            }
        }
        const int i = 16 * it + li, j0 = 16 * jt + 4 * fq;
        float v[4];
#pragma unroll
        for (int jj = 0; jj < 4; ++jj) v[jj] = (j0 + jj <= i) ? acc[jj] : 0.f;
        const int chunk = 2 * jt + (fq >> 1), sub = (fq & 1) * 8;
        *(uint2*)(ATg + (size_t)item * GLA_AT_BYTES + i * 128 + ((chunk ^ (i & 7)) << 4) + sub) = make_uint2(pack2(v[0], v[1]), pack2(v[2], v[3]));
    }
}

__device__ __forceinline__ void gla_seq_item(const u16* __restrict__ P, int ldp, int cv, int Sq,
                                             const unsigned char* __restrict__ QDg, const unsigned char* __restrict__ KEg, const unsigned char* __restrict__ ATg, const float* __restrict__ DECg,
                                             u16* __restrict__ Oout  , int Ttot, unsigned char* lds, int item) {
    const int slice = item & 1, dir = (item >> 1) & 1, hh = (item >> 2) & 3, b = item >> 4;
    const int nch = Sq / 64;
    const int tid = TID, lane = tid & 63, wave = tid >> 6, li = lane & 15, fq = lane >> 4;
    const size_t tok0 = (size_t)b * Sq;
    const int pitem0 = ((b * 4 + hh) * 2 + dir) * nch;
    constexpr int BUF = 16384 * 3 + 8192 + 512;
    typedef unsigned gla_u32x4 __attribute__((ext_vector_type(4)));
    gla_u32x4 rq0, rq1, rk0, rk1, rv0, rv1, ra; float rd = 0.f;
#define GLA_VROW(c_, k_) ((tok0 + (size_t)(dir ? (Sq - 1 - (64 * (c_) + ((tid + 512 * (k_)) >> 4))) : (64 * (c_) + ((tid + 512 * (k_)) >> 4)))) * ldp + cv + hh * 256 + slice * 128 + ((tid + 512 * (k_)) & 15) * 8)
#define GLA_ISSUE(c_) do { \
        const gla_u32x4* qsrc_ = (const gla_u32x4*)(QDg + (size_t)(pitem0 + (c_)) * GLA_QD_BYTES); const gla_u32x4* ksrc_ = (const gla_u32x4*)(KEg + (size_t)(pitem0 + (c_)) * GLA_QD_BYTES); \
        rq0 = qsrc_[tid]; rq1 = qsrc_[tid + 512]; rk0 = ksrc_[tid]; rk1 = ksrc_[tid + 512]; \
        ra = ((const gla_u32x4*)(ATg + (size_t)(pitem0 + (c_)) * GLA_AT_BYTES))[tid]; \
        rv0 = *(const gla_u32x4*)(P + GLA_VROW(c_, 0)); rv1 = *(const gla_u32x4*)(P + GLA_VROW(c_, 1)); \
        if (tid < 128) rd = DECg[(size_t)(pitem0 + (c_)) * 128 + tid]; } while (0)
#define GLA_COMMIT(buf_) do { \
        unsigned char* base_ = lds + (buf_) * BUF; \
        ((gla_u32x4*)base_)[tid] = rq0; ((gla_u32x4*)base_)[tid + 512] = rq1; ((gla_u32x4*)(base_ + 16384))[tid] = rk0; ((gla_u32x4*)(base_ + 16384))[tid + 512] = rk1; \
        { const int row_ = tid >> 4, ch_ = tid & 15; *(gla_u32x4*)(base_ + 32768 + row_ * 256 + ((ch_ ^ (row_ & 15)) << 4)) = rv0; } \
        { const int row_ = (tid + 512) >> 4, ch_ = tid & 15; *(gla_u32x4*)(base_ + 32768 + row_ * 256 + ((ch_ ^ (row_ & 15)) << 4)) = rv1; } \
        ((gla_u32x4*)(base_ + 49152))[tid] = ra; \
        if (tid < 128) ((float*)(base_ + 57344))[tid] = rd; } while (0)
    f32x4 st[8];
#pragma unroll
    for (int dt = 0; dt < 8; ++dt) st[dt] = (f32x4){0.f, 0.f, 0.f, 0.f};
    __syncthreads();
    GLA_ISSUE(0); GLA_COMMIT(0);
    __syncthreads();
#pragma unroll 1
    for (int c = 0; c < nch; ++c) {
        const int buf = c & 1;
        if (c + 1 < nch) GLA_ISSUE(c + 1);
        const unsigned char* QDs = lds + buf * BUF; const unsigned char* KEs = QDs + 16384; const unsigned char* Vs = QDs + 32768;
        const unsigned char* ATs = QDs + 49152; const float* DECs = (const float*)(QDs + 57344);
        bf16x8 vf[2];
#pragma unroll
        for (int jp = 0; jp < 2; ++jp) {
            const int rowA = 32 * jp + 8 * fq + (li >> 2), rowB = rowA + 4;
            const int chunk = 2 * wave + ((li & 3) >> 1), sub = ((li & 3) & 1) * 8;
            const s16x4 va = __builtin_amdgcn_ds_read_tr16_b64_v4i16((LAS s16x4*)(Vs + rowA * 256 + ((chunk ^ (rowA & 15)) << 4) + sub));
            const s16x4 vb = __builtin_amdgcn_ds_read_tr16_b64_v4i16((LAS s16x4*)(Vs + rowB * 256 + ((chunk ^ (rowB & 15)) << 4) + sub));
            vf[jp] = __builtin_shufflevector(va, vb, 0, 1, 2, 3, 4, 5, 6, 7);
        }
        bf16x8 sf[4];
#pragma unroll
        for (int dp = 0; dp < 4; ++dp) {
            const gla_u32x4 t_ = {pack2(st[2 * dp][0], st[2 * dp][1]), pack2(st[2 * dp][2], st[2 * dp][3]), pack2(st[2 * dp + 1][0], st[2 * dp + 1][1]), pack2(st[2 * dp + 1][2], st[2 * dp + 1][3])};
            sf[dp] = __builtin_bit_cast(bf16x8, t_);
        }
        f32x4 ot[4];
#pragma unroll
        for (int it = 0; it < 4; ++it) {
            f32x4 acc = (f32x4){0.f, 0.f, 0.f, 0.f};
            const int ir = 16 * it + li;
#pragma unroll
            for (int dp = 0; dp < 4; ++dp) {
                const bf16x8 qf = *(const bf16x8*)(QDs + ir * 256 + (((4 * dp + fq) ^ (ir & 15)) << 4));
                acc = __builtin_amdgcn_mfma_f32_16x16x32_bf16(sf[dp], qf, acc, 0, 0, 0);
            }
#pragma unroll
            for (int jp = 0; jp < 2; ++jp) {
                if (32 * jp <= 16 * it + 15) {
                    const bf16x8 af = *(const bf16x8*)(ATs + ir * 128 + (((4 * jp + fq) ^ (ir & 7)) << 4));
                    acc = __builtin_amdgcn_mfma_f32_16x16x32_bf16(vf[jp], af, acc, 0, 0, 0);
                }
            }
            ot[it] = acc;
        }
#pragma unroll
        for (int dt = 0; dt < 8; ++dt) {
            const f32x4 dec = *(const f32x4*)(DECs + 16 * dt + 4 * fq);
            f32x4 acc = st[dt] * dec;
#pragma unroll
            for (int jp = 0; jp < 2; ++jp) {
                const int rowA = 32 * jp + 8 * fq + (li >> 2), rowB = rowA + 4;
                const int chunk = 2 * dt + ((li & 3) >> 1), sub = ((li & 3) & 1) * 8;
                const s16x4 ka = __builtin_amdgcn_ds_read_tr16_b64_v4i16((LAS s16x4*)(KEs + rowA * 256 + ((chunk ^ (rowA & 15)) << 4) + sub));
                const s16x4 kb = __builtin_amdgcn_ds_read_tr16_b64_v4i16((LAS s16x4*)(KEs + rowB * 256 + ((chunk ^ (rowB & 15)) << 4) + sub));
                const bf16x8 kf = __builtin_shufflevector(ka, kb, 0, 1, 2, 3, 4, 5, 6, 7);
                acc = __builtin_amdgcn_mfma_f32_16x16x32_bf16(kf, vf[jp], acc, 0, 0, 0);
            }
            st[dt] = acc;
        }
#pragma unroll
        for (int it = 0; it < 4; ++it) {
            const int i = 16 * it + li;
            const int s = dir ? (Sq - 1 - (64 * c + i)) : (64 * c + i);
            *(uint2*)(Oout + ((size_t)dir * Ttot + tok0 + s) * 1024 + hh * 256 + slice * 128 + 16 * wave + 4 * fq) =
                make_uint2(pack2(ot[it][0], ot[it][1]), pack2(ot[it][2], ot[it][3]));
        }
        if (c + 1 < nch) GLA_COMMIT(buf ^ 1);
        __syncthreads();
    }
}
__device__ __forceinline__ void phase_rope_prep(const Args& a, unsigned char* lds) {
    u16* P = (u16*)(a.ws + WS_P);
    const float2* cs = (const float2*)(a.ws + WS_CS);
    const int gt = blockIdx.x * NTHREADS + threadIdx.x, NT = gridDim.x * NTHREADS;
    const float* gz = (const float*)(a.ws + WS_GZ);
    const int tid = threadIdx.x, nch = S / 64;
    uint4 nq0 = make_uint4(0, 0, 0, 0), nq1 = nq0, nk0 = nq0, nk1 = nq0; float ngza = 0.f, ngzb = 0.f;
#define GP_FETCH(item_) do { const int c_ = (item_) % nch, dir_ = ((item_) / nch) & 1, hh_ = ((item_) / (nch * 2)) & 3, b_ = (item_) / (nch * 8); const size_t tok0_ = (size_t)b_ * S; \
        const int i0_ = tid >> 4, i1_ = (tid + 512) >> 4, cc_ = tid & 15; \
        const int s0_ = dir_ ? (S - 1 - (64 * c_ + i0_)) : (64 * c_ + i0_), s1_ = dir_ ? (S - 1 - (64 * c_ + i1_)) : (64 * c_ + i1_); \
        nq0 = *(const uint4*)(P + (tok0_ + s0_) * NP + C_GQ + hh_ * 128 + cc_ * 8); nk0 = *(const uint4*)(P + (tok0_ + s0_) * NP + C_GK + hh_ * 128 + cc_ * 8); \
        nq1 = *(const uint4*)(P + (tok0_ + s1_) * NP + C_GQ + hh_ * 128 + cc_ * 8); nk1 = *(const uint4*)(P + (tok0_ + s1_) * NP + C_GK + hh_ * 128 + cc_ * 8); \
        { const int ia_ = tid >> 4, ib_ = (tid + 512) >> 4, r_ = tid & 15; \
          const int sa_ = dir_ ? (S - 1 - (64 * c_ + ia_)) : (64 * c_ + ia_), sb_ = dir_ ? (S - 1 - (64 * c_ + ib_)) : (64 * c_ + ib_); \
          ngza = gz[(tok0_ + sa_) * 32 + dir_ * 16 + r_]; ngzb = gz[(tok0_ + sb_) * 32 + dir_ * 16 + r_]; } } while (0)
    if ((int)blockIdx.x < GLA_NPREP) GP_FETCH((int)blockIdx.x);
    for (int item = blockIdx.x; item < GLA_NPREP; item += gridDim.x) {
        const uint4 cq0 = nq0, cq1 = nq1, ck0 = nk0, ck1 = nk1; const float cga = ngza, cgb = ngzb;
        if (item + (int)gridDim.x < GLA_NPREP) GP_FETCH(item + (int)gridDim.x);
        gla_prep_item(P, NP, C_GQ, C_GK, gz, a.wgf, a.bgf, a.wgb, a.bgb, S,
                      a.ws + WS_QD, a.ws + WS_KE, a.ws + WS_AT, (float*)(a.ws + WS_DEC), lds, item, cq0, cq1, ck0, ck1, cga, cgb);
    }
#undef GP_FETCH
}

#define ATTN_DECODE(item_) \
    const int nb_per = Sq / 128; \
    const int within = (item_) % nb_per, hh = ((item_) / nb_per) & 7, b = ((item_) / (nb_per * 8)) & 3, pat = (item_) / (nb_per * 32); \
    const int dil = pat == 0 ? 1 : (pat == 1 ? 4 : 16); \
    const int M = Sq / dil; \
    const int r = within % dil, blk = within / dil; \
    const int p0 = blk * 128, kbase = p0 - 64; \
    const size_t tok0 = (size_t)b * Sq;
typedef unsigned attn_u32x4 __attribute__((ext_vector_type(4)));
__device__ __forceinline__ void attn_phase(const u16* __restrict__ P, int ldp, int cq, int ck, int cv, int Sq,
                                           u16* __restrict__ part_o, float* __restrict__ part_lse, int Ttot,
                                           unsigned char* lds, int first, int stride, int nitems) {
    const int tid = TID, lane = tid & 63, wave = tid >> 6, li = lane & 15, fq = lane >> 4;
    unsigned char* Ks = lds;
    unsigned char* Vs = lds + 65536;
    attn_u32x4 kr0, kr1, kr2, kr3, kr4, kr5, kr6, kr7, vr0, vr1, vr2, vr3, vr4, vr5, vr6, vr7;
    bf16x8 qn0, qn1, qn2, qn3;
#define ATTN_LD1(i_, kreg_, vreg_) { const int id_ = tid + 512 * (i_), row_ = id_ >> 4, c_ = id_ & 15; \
        int kp_ = kbase + row_; kp_ = kp_ < 0 ? 0 : (kp_ > M - 1 ? M - 1 : kp_); \
        const size_t t_ = tok0 + r + (size_t)dil * kp_; \
        kreg_ = *(const attn_u32x4*)(P + t_ * ldp + ck + hh * 128 + c_ * 8); vreg_ = *(const attn_u32x4*)(P + t_ * ldp + cv + hh * 128 + c_ * 8); }
#define ATTN_LOAD(item_) do { ATTN_DECODE(item_) \
        { const size_t tq_ = tok0 + r + (size_t)dil * (p0 + 16 * wave + li); const u16* qp_ = P + tq_ * ldp + cq + hh * 128 + 8 * fq; \
          qn0 = *(const bf16x8*)(qp_); qn1 = *(const bf16x8*)(qp_ + 32); qn2 = *(const bf16x8*)(qp_ + 64); qn3 = *(const bf16x8*)(qp_ + 96); } \
        ATTN_LD1(0, kr0, vr0) ATTN_LD1(1, kr1, vr1) ATTN_LD1(2, kr2, vr2) ATTN_LD1(3, kr3, vr3) ATTN_LD1(4, kr4, vr4) ATTN_LD1(5, kr5, vr5) ATTN_LD1(6, kr6, vr6) ATTN_LD1(7, kr7, vr7) } while (0)
#define ATTN_ST1(i_, kreg_, vreg_) { const int id_ = tid + 512 * (i_), row_ = id_ >> 4, c_ = id_ & 15; const int off_ = row_ * 256 + ((c_ ^ (row_ & 15)) << 4); \
        *(attn_u32x4*)(Ks + off_) = kreg_; *(attn_u32x4*)(Vs + off_) = vreg_; }
#define ATTN_COMMIT() do { ATTN_ST1(0, kr0, vr0) ATTN_ST1(1, kr1, vr1) ATTN_ST1(2, kr2, vr2) ATTN_ST1(3, kr3, vr3) ATTN_ST1(4, kr4, vr4) ATTN_ST1(5, kr5, vr5) ATTN_ST1(6, kr6, vr6) ATTN_ST1(7, kr7, vr7) } while (0)
    int item = first;
    if (item < nitems) ATTN_LOAD(item);
    for (; item < nitems; item += stride) {
        ATTN_DECODE(item)
        __syncthreads();
        ATTN_COMMIT();
        const int qp = p0 + 16 * wave + li;
        const size_t tq = tok0 + r + (size_t)dil * qp;
        const bf16x8 qf[4] = {qn0, qn1, qn2, qn3};
        __syncthreads();
        if (item + stride < nitems) ATTN_LOAD(item + stride);
        const float scale = 0.08838834764831845f;
        float m = -1e30f, l = 0.f;
        f32x4 o[8];
#pragma unroll
        for (int dt = 0; dt < 8; ++dt) o[dt] = (f32x4){0.f, 0.f, 0.f, 0.f};
        const bool edge = (blk == 0) || (p0 + 128 >= M);
#define ATTN_SOFTMAX_PV(MASKED_) do { \
            float mx = -1e30f; \
            _Pragma("unroll") for (int j = 0; j < 8; ++j) mx = ((MASKED_) && !ok[j]) ? mx : fmaxf(mx, s[j]); \
            mx = fmaxf(mx, __shfl_xor(mx, 16)); \
            mx = fmaxf(mx, __shfl_xor(mx, 32)); \
            const float mn = fmaxf(m, mx); \
            const float al = __expf(m - mn); \
            float ps = 0.f; float p[8]; \
            _Pragma("unroll") for (int j = 0; j < 8; ++j) { p[j] = ((MASKED_) && !ok[j]) ? 0.f : __expf(s[j] - mn); ps += p[j]; } \
            l = l * al + ps; m = mn; \
            const attn_u32x4 p_ = {pack2(p[0], p[1]), pack2(p[2], p[3]), pack2(p[4], p[5]), pack2(p[6], p[7])}; \
            const bf16x8 pf = __builtin_bit_cast(bf16x8, p_); \
            _Pragma("unroll") for (int dt = 0; dt < 8; ++dt) o[dt] *= al; \
            int rowA = 16 * wave + 32 * tp + 4 * fq + (li >> 2); rowA = rowA > 255 ? 255 : rowA; \
            int rowB = 16 * wave + 32 * tp + 16 + 4 * fq + (li >> 2); rowB = rowB > 255 ? 255 : rowB; \
            _Pragma("unroll") for (int dt = 0; dt < 8; ++dt) { \
                const int chunk = 2 * dt + ((li & 3) >> 1), sub = ((li & 3) & 1) * 8; \
                const s16x4 va = __builtin_amdgcn_ds_read_tr16_b64_v4i16((LAS s16x4*)(Vs + rowA * 256 + ((chunk ^ (rowA & 15)) << 4) + sub)); \
                s16x4 vb = va; \
                if (!lastt) vb = __builtin_amdgcn_ds_read_tr16_b64_v4i16((LAS s16x4*)(Vs + rowB * 256 + ((chunk ^ (rowB & 15)) << 4) + sub)); \
                const bf16x8 vf = __builtin_shufflevector(va, vb, 0, 1, 2, 3, 4, 5, 6, 7); \
                o[dt] = __builtin_amdgcn_mfma_f32_16x16x32_bf16(vf, pf, o[dt], 0, 0, 0); } } while (0)
#define ATTN_QK(tp_, sdst_) do { _Pragma("unroll") for (int h2 = 0; h2 < 2; ++h2) { \
                const int kk0 = 16 * wave + 16 * (2 * (tp_) + h2); \
                int krow = kk0 + li; krow = krow > 255 ? 255 : krow; \
                f32x4 acc = (f32x4){0.f, 0.f, 0.f, 0.f}; \
                if (!((tp_) == 4 && h2 == 1)) {            \
                    _Pragma("unroll") for (int ks = 0; ks < 4; ++ks) { \
                        const bf16x8 kf = *(const bf16x8*)(Ks + krow * 256 + (((4 * ks + fq) ^ (krow & 15)) << 4)); \
                        acc = __builtin_amdgcn_mfma_f32_16x16x32_bf16(kf, qf[ks], acc, 0, 0, 0); } } \
                _Pragma("unroll") for (int j = 0; j < 4; ++j) sdst_[4 * h2 + j] = acc[j] * scale; } } while (0)
        float sn[8];
        ATTN_QK(0, sn);
#pragma unroll 1
        for (int tp = 0; tp < 5; ++tp) {
            const bool lastt = (tp == 4);
            float s[8]; bool ok[8];
#pragma unroll
            for (int j = 0; j < 8; ++j) s[j] = sn[j];
            if (!lastt) ATTN_QK(tp + 1, sn);
            if (edge || tp == 0 || lastt) {
#pragma unroll
                for (int h2 = 0; h2 < 2; ++h2)
#pragma unroll
                    for (int j = 0; j < 4; ++j) {
                        const int kp = kbase + 16 * wave + 16 * (2 * tp + h2) + 4 * fq + j;
                        const int rel = kp - qp;
                        ok[4 * h2 + j] = (kp >= 0) && (kp < M) && (rel <= 64) && (rel >= -64);
                    }
                ATTN_SOFTMAX_PV(1);
            } else {
#pragma unroll
                for (int j = 0; j < 8; ++j) ok[j] = true;
                ATTN_SOFTMAX_PV(0);
            }
        }
#undef ATTN_QK
#undef ATTN_SOFTMAX_PV
        l += __shfl_xor(l, 16);
        l += __shfl_xor(l, 32);
        const float inv = 1.f / l;
        u16* orow = part_o + ((size_t)pat * Ttot + tq) * 1024 + hh * 128 + 4 * fq;
#pragma unroll
        for (int dt = 0; dt < 8; ++dt)
            *(uint2*)(orow + 16 * dt) = make_uint2(pack2(o[dt][0] * inv, o[dt][1] * inv), pack2(o[dt][2] * inv, o[dt][3] * inv));
        if (fq == 0) part_lse[((size_t)pat * Ttot + tq) * 8 + hh] = m + logf(l);
    }
#undef ATTN_LD1
#undef ATTN_LOAD
#undef ATTN_ST1
#undef ATTN_COMMIT
}

__device__ __forceinline__ void attn_merge_token(const u16* __restrict__ part_o, const float* __restrict__ part_lse, int Ttot, size_t t,
                                                 u16* __restrict__ dst  , int lane) {
    const int hh = lane >> 3;
    const float l0 = part_lse[((size_t)0 * Ttot + t) * 8 + hh], l1 = part_lse[((size_t)1 * Ttot + t) * 8 + hh], l2 = part_lse[((size_t)2 * Ttot + t) * 8 + hh];
    const float mx = fmaxf(l0, fmaxf(l1, l2));
    const float e0 = __expf(l0 - mx), e1 = __expf(l1 - mx), e2 = __expf(l2 - mx);
    const float inv = 1.f / (e0 + e1 + e2);
    const float w[3] = {e0 * inv, e1 * inv, e2 * inv};
    float acc[16];
#pragma unroll
    for (int i = 0; i < 16; ++i) acc[i] = 0.f;
#pragma unroll
    for (int p = 0; p < 3; ++p) {
        const uint4* src = (const uint4*)(part_o + ((size_t)p * Ttot + t) * 1024 + lane * 16);
        const f32x4 na_ = __builtin_nontemporal_load((const f32x4*)src), nb_ = __builtin_nontemporal_load((const f32x4*)(src + 1));
        const uint4 a = make_uint4(__float_as_uint(na_[0]), __float_as_uint(na_[1]), __float_as_uint(na_[2]), __float_as_uint(na_[3]));
        const uint4 bb = make_uint4(__float_as_uint(nb_[0]), __float_as_uint(nb_[1]), __float_as_uint(nb_[2]), __float_as_uint(nb_[3]));
        acc[0] += w[p] * lo2f(a.x); acc[1] += w[p] * hi2f(a.x); acc[2] += w[p] * lo2f(a.y); acc[3] += w[p] * hi2f(a.y);
        acc[4] += w[p] * lo2f(a.z); acc[5] += w[p] * hi2f(a.z); acc[6] += w[p] * lo2f(a.w); acc[7] += w[p] * hi2f(a.w);
        acc[8] += w[p] * lo2f(bb.x); acc[9] += w[p] * hi2f(bb.x); acc[10] += w[p] * lo2f(bb.y); acc[11] += w[p] * hi2f(bb.y);
        acc[12] += w[p] * lo2f(bb.z); acc[13] += w[p] * hi2f(bb.z); acc[14] += w[p] * lo2f(bb.w); acc[15] += w[p] * hi2f(bb.w);
    }
    uint4* d = (uint4*)(dst + lane * 16);
    d[0] = make_uint4(pack2(acc[0], acc[1]), pack2(acc[2], acc[3]), pack2(acc[4], acc[5]), pack2(acc[6], acc[7]));
    d[1] = make_uint4(pack2(acc[8], acc[9]), pack2(acc[10], acc[11]), pack2(acc[12], acc[13]), pack2(acc[14], acc[15]));
}

__device__ __forceinline__ void phase_mixers(const Args& a, unsigned char* lds) {
    const int bi = blockIdx.x, G = gridDim.x;
    if (bi < 64) {
        gla_seq_item((const u16*)(a.ws + WS_P), NP, C_GV, S, a.ws + WS_QD, a.ws + WS_KE, a.ws + WS_AT, (const float*)(a.ws + WS_DEC),
                     (u16*)(a.ws + WS_OFB), T, lds, bi);
    } else {
        u16* part_o = (u16*)a.out; float* part_lse = (float*)((unsigned char*)a.out + (size_t)3 * T * 1024 * 2);
        attn_phase((const u16*)(a.ws + WS_P), NP, C_DQ, C_DK, C_DV, S, part_o, part_lse, T, lds, bi - 64, G - 64, 3 * 4 * 8 * (S / 128));
    }
}

__device__ __forceinline__ void phase_gla_fin(const Args& a) {
    const u16* Of = (const u16*)(a.ws + WS_OFB);
    const u16* Ob = Of + (size_t)T * 1024;
    const u16* P = (const u16*)(a.ws + WS_P);
    u16* A2 = (u16*)(a.ws + WS_ACT);
    const u16* part_o = (const u16*)a.out; const float* part_lse = (const float*)((const unsigned char*)a.out + (size_t)3 * T * 1024 * 2);
    const int lane = threadIdx.x & 63, wave = threadIdx.x >> 6;
    const int gw = blockIdx.x * NWAVES + wave, NGW = gridDim.x * NWAVES;
    float gg[2][8];
#pragma unroll
    for (int ps = 0; ps < 2; ++ps) { const float4 g0 = *(const float4*)(a.g_gla + 512 * ps + 8 * lane), g1 = *(const float4*)(a.g_gla + 512 * ps + 8 * lane + 4);
      gg[ps][0] = g0.x; gg[ps][1] = g0.y; gg[ps][2] = g0.z; gg[ps][3] = g0.w; gg[ps][4] = g1.x; gg[ps][5] = g1.y; gg[ps][6] = g1.z; gg[ps][7] = g1.w; }
#define GF_NT16(p_) ({ const f32x4 q_ = __builtin_nontemporal_load((const f32x4*)(p_)); make_uint4(__float_as_uint(q_[0]), __float_as_uint(q_[1]), __float_as_uint(q_[2]), __float_as_uint(q_[3])); })
#define GF_DPP(x_, c_) __builtin_bit_cast(float, __builtin_amdgcn_update_dpp(0, __builtin_bit_cast(int, x_), c_, 0xf, 0xf, true))
    for (int t = gw; t < T; t += NGW) {
#pragma unroll
        for (int ps = 0; ps < 2; ++ps) {
            const int c = 512 * ps + 8 * lane, hh = 4 * ps + (lane >> 4);
            const uint4 f0 = GF_NT16(Of + (size_t)t * 1024 + c), b0 = GF_NT16(Ob + (size_t)t * 1024 + c), r0 = GF_NT16(P + (size_t)t * NP + C_GR + c);
            const uint4 o0 = GF_NT16(part_o + ((size_t)0 * T + t) * 1024 + c), o1 = GF_NT16(part_o + ((size_t)1 * T + t) * 1024 + c), o2 = GF_NT16(part_o + ((size_t)2 * T + t) * 1024 + c);
            const float l0 = part_lse[((size_t)0 * T + t) * 8 + hh], l1 = part_lse[((size_t)1 * T + t) * 8 + hh], l2 = part_lse[((size_t)2 * T + t) * 8 + hh];
            {
                const float mx = fmaxf(l0, fmaxf(l1, l2));
                const float e0 = __expf(l0 - mx), e1 = __expf(l1 - mx), e2 = __expf(l2 - mx);
                const float inv = 1.f / (e0 + e1 + e2);
                const float w0 = e0 * inv, w1 = e1 * inv, w2 = e2 * inv;
                const unsigned x0[4] = {o0.x, o0.y, o0.z, o0.w}, x1[4] = {o1.x, o1.y, o1.z, o1.w}, x2[4] = {o2.x, o2.y, o2.z, o2.w};
                unsigned y[4];
#pragma unroll
                for (int k = 0; k < 4; ++k) y[k] = pack2(w0 * lo2f(x0[k]) + w1 * lo2f(x1[k]) + w2 * lo2f(x2[k]), w0 * hi2f(x0[k]) + w1 * hi2f(x1[k]) + w2 * hi2f(x2[k]));
                *(uint4*)(A2 + (size_t)t * D + 1024 + c) = make_uint4(y[0], y[1], y[2], y[3]);
            }
            {
                const unsigned fw[4] = {f0.x, f0.y, f0.z, f0.w}, bw[4] = {b0.x, b0.y, b0.z, b0.w}, rw[4] = {r0.x, r0.y, r0.z, r0.w};
                float o[8]; float ss = 0.f;
#pragma unroll
                for (int k = 0; k < 4; ++k) { o[2 * k] = lo2f(fw[k]) + lo2f(bw[k]); o[2 * k + 1] = hi2f(fw[k]) + hi2f(bw[k]); ss += o[2 * k] * o[2 * k] + o[2 * k + 1] * o[2 * k + 1]; }
                ss += GF_DPP(ss, 0xB1); ss += GF_DPP(ss, 0x4E); ss += GF_DPP(ss, 0x141); ss += GF_DPP(ss, 0x140);
                { const auto sw_ = __builtin_amdgcn_permlane16_swap(__float_as_uint(ss), __float_as_uint(ss), false, false); ss = __uint_as_float(sw_[0]) + __uint_as_float(sw_[1]); }
                const float rstd = rsqrtf(ss * (1.f / 256.f) + NORM_EPS);
                unsigned y[4];
#pragma unroll
                for (int k = 0; k < 4; ++k) y[k] = pack2(o[2 * k] * rstd * gg[ps][2 * k] * silu_f(lo2f(rw[k])), o[2 * k + 1] * rstd * gg[ps][2 * k + 1] * silu_f(hi2f(rw[k])));
                *(uint4*)(A2 + (size_t)t * D + c) = make_uint4(y[0], y[1], y[2], y[3]);
            }
        }
    }
#undef GF_NT16
#undef GF_DPP
}

typedef float f32x16 __attribute__((ext_vector_type(16)));
#define RT_CE(a_, b_) do { const float hi_ = fmaxf(a_, b_), lo_ = fminf(a_, b_); a_ = hi_; b_ = lo_; } while (0)
template <int N> __device__ __forceinline__ void rt_sort_desc(float (&v)[N], int base) {
#pragma unroll
    for (int k = 2; k <= 16; k <<= 1)
#pragma unroll
        for (int j = k >> 1; j > 0; j >>= 1)
#pragma unroll
            for (int i = 0; i < 16; ++i) {
                const int l = i ^ j;
                if (l > i) { if ((i & k) == 0) RT_CE(v[base + i], v[base + l]); else RT_CE(v[base + l], v[base + i]); }
            }
}
template <int N> __device__ __forceinline__ void rt_merge_desc(float (&v)[N], int a, int b) {
#pragma unroll
    for (int i = 0; i < 16; ++i) v[a + i] = fmaxf(v[a + i], v[b + 15 - i]);
#pragma unroll
    for (int j = 8; j > 0; j >>= 1)
#pragma unroll
        for (int i = 0; i < 16; ++i) { const int l = i ^ j; if (l > i) RT_CE(v[a + i], v[a + l]); }
}

__device__ __forceinline__ void route_stage_keys(const float* __restrict__ subk, int hh, unsigned char* lds) {
    const int tid = TID;
    __syncthreads();
    for (int e = tid; e < 2 * 128 * 16; e += 512) {
        const int c = e & 15, row = e >> 4;
        const float* src = subk + ((size_t)(hh * 2) * 128 + row) * 128 + c * 8;
        const float4 v0 = *(const float4*)src, v1 = *(const float4*)(src + 4);
        *(uint4*)(lds + row * 256 + ((c ^ (row & 15)) << 4)) = make_uint4(pack2(v0.x, v0.y), pack2(v0.z, v0.w), pack2(v1.x, v1.y), pack2(v1.z, v1.w));
    }
    __syncthreads();
}

__device__ __forceinline__ void route_tile(const u16* __restrict__ Q, int ldq, int hh, int tok_base, const unsigned char* lds,
                                           int* __restrict__ IDX, float* __restrict__ GATE) {
    const int lane = TID & 63, r = lane & 31, h = lane >> 5;
    float sc[128];
    {
        f32x16 X[4], Y[4];
#pragma unroll
        for (int kt = 0; kt < 4; ++kt) {
#pragma unroll
            for (int i = 0; i < 16; ++i) { X[kt][i] = 0.f; Y[kt][i] = 0.f; }
        }
        const u16* qrow = Q + (size_t)(tok_base + r) * ldq + hh * 256;
#pragma unroll
        for (int half = 0; half < 2; ++half) {
            bf16x8 qf[8];
#pragma unroll
            for (int ks = 0; ks < 8; ++ks) qf[ks] = *(const bf16x8*)(qrow + half * 128 + 16 * ks + 8 * h);
#pragma unroll
            for (int kt = 0; kt < 4; ++kt) {
                const int krow = half * 128 + 32 * kt + r;
#pragma unroll
                for (int ks = 0; ks < 8; ++ks) {
                    const bf16x8 kf = *(const bf16x8*)(lds + krow * 256 + (((2 * ks + h) ^ (krow & 15)) << 4));
                    if (half == 0) X[kt] = __builtin_amdgcn_mfma_f32_32x32x16_bf16(kf, qf[ks], X[kt], 0, 0, 0);
                    else Y[kt] = __builtin_amdgcn_mfma_f32_32x32x16_bf16(kf, qf[ks], Y[kt], 0, 0, 0);
                }
            }
        }
#pragma unroll
        for (int kt = 0; kt < 4; ++kt)
#pragma unroll
            for (int i = 0; i < 16; ++i) {
                const auto sw = __builtin_amdgcn_permlane32_swap(__float_as_uint(X[kt][i]), __float_as_uint(Y[kt][i]), false, false);
                const int key0 = 32 * kt + (i & 3) + 8 * (i >> 2);
                sc[kt * 32 + i] = __uint_as_float((sw[0] & 0xffffff80u) | (unsigned)key0);
                sc[kt * 32 + 16 + i] = __uint_as_float((sw[1] & 0xffffff80u) | (unsigned)(key0 + 4));
            }
    }
#pragma unroll
    for (int g = 0; g < 8; ++g) rt_sort_desc(sc, 16 * g);
    rt_merge_desc(sc, 0, 16); rt_merge_desc(sc, 32, 48); rt_merge_desc(sc, 64, 80); rt_merge_desc(sc, 96, 112);
    rt_merge_desc(sc, 0, 32); rt_merge_desc(sc, 64, 96);
    rt_merge_desc(sc, 0, 64);
    float l0[16], l1[16];
#pragma unroll
    for (int i = 0; i < 16; ++i) {
        const auto sw = __builtin_amdgcn_permlane32_swap(__float_as_uint(sc[i]), __float_as_uint(sc[i]), false, false);
        l0[i] = __uint_as_float(sw[0]); l1[i] = __uint_as_float(sw[1]);
    }
    float s0[16], s1[16]; int k0[16], k1[16];
#pragma unroll
    for (int i = 0; i < 16; ++i) {
        const unsigned a = __float_as_uint(l0[i]), b = __float_as_uint(l1[i]);
        s0[i] = __uint_as_float(a & 0xffffff80u); k0[i] = (int)(a & 0x7fu);
        s1[i] = __uint_as_float(b & 0xffffff80u); k1[i] = (int)(b & 0x7fu);
    }
    float cs[64];
    {
        int n = 0;
#pragma unroll
        for (int i = 0; i < 16; ++i)
#pragma unroll
            for (int j = 0; j < 16; ++j)
                if ((i + 1) * (j + 1) <= 16) { cs[n] = s0[i] + s1[j]; ++n; }
#pragma unroll
        for (int q = 50; q < 64; ++q) cs[q] = -3.0e38f;
    }
    float ct[64];
#pragma unroll
    for (int q = 0; q < 64; ++q) ct[q] = cs[q];
#pragma unroll
    for (int g = 0; g < 4; ++g) rt_sort_desc(ct, 16 * g);
    rt_merge_desc(ct, 0, 16); rt_merge_desc(ct, 32, 48); rt_merge_desc(ct, 0, 32);
    const float theta = ct[15], smax = ct[0];
    float den = 0.f;
    {
        int cnt = 0;
#pragma unroll
        for (int q = 0; q < 50; ++q) { const bool sel = (cs[q] >= theta) && (cnt < 16); den += sel ? __expf(cs[q] - smax) : 0.f; cnt += sel ? 1 : 0; }
    }
    const float inv = 1.f / den;
    LAS unsigned* stw = (LAS unsigned*)((LAS unsigned char*)lds + 65536 + (TID >> 6) * 4096);
    int pos = 0;
    {
        const int swz = 4 * ((lane >> 2) & 3);
        int n = 0;
#pragma unroll
        for (int i = 0; i < 16; ++i)
#pragma unroll
            for (int j = 0; j < 16; ++j)
                if ((i + 1) * (j + 1) <= 16) {
                    const bool sel = (cs[n] >= theta) && (pos < 16);
                    if (sel) {
                        const unsigned val = (h == 0) ? (unsigned)(k0[i] * 128 + k1[j]) : __float_as_uint(__expf(cs[n] - smax) * inv);
                        stw[lane * 16 + (pos ^ swz)] = val;
                        ++pos;
                    }
                    ++n;
                }
    }
    {
        typedef unsigned rt_u32x4 __attribute__((ext_vector_type(4)));
#pragma unroll
        for (int i2 = 0; i2 < 4; ++i2) {
            const int rho = 16 * i2 + (lane >> 2), ch = lane & 3;
            const rt_u32x4 v = *(const LAS rt_u32x4*)(stw + rho * 16 + 4 * (ch ^ ((rho >> 2) & 3)));
            const size_t ob = (size_t)(tok_base + (rho & 31)) * 128 + hh * 16 + 4 * ch;
            if (i2 < 2) *(rt_u32x4*)(IDX + ob) = v; else *(rt_u32x4*)(GATE + ob) = v;
        }
    }
}
__device__ __forceinline__ void phase_route(const Args& a, unsigned char* lds) {
    const int hh = BID & 7, grp = BID >> 3, ngrp = GDIM >> 3, wave = TID >> 6;
    route_stage_keys(a.subk, hh, lds);
    int j = 0;
    for (int tile = grp; tile < T / 32; tile += ngrp, ++j)
        if ((j & 7) == wave) route_tile((const u16*)(a.ws + WS_Q), D, hh, tile * 32, lds, (int*)(a.ws + WS_IDX), (float*)(a.ws + WS_GATE));
    __syncthreads();
}

typedef __bf16 bf16x2_t __attribute__((ext_vector_type(2)));
__device__ __forceinline__ float dot2bf(unsigned w, unsigned x, float acc) {
    return __builtin_amdgcn_fdot2_f32_bf16(__builtin_bit_cast(bf16x2_t, w), __builtin_bit_cast(bf16x2_t, x), acc, false);
}
constexpr int TROW = 1024;
typedef float f32x2_t __attribute__((ext_vector_type(2)));
typedef int i32x8 __attribute__((ext_vector_type(8)));
__device__ __forceinline__ void convert_tables(const Args& a) {
    const int lane = threadIdx.x & 63, wave = threadIdx.x >> 6;
    const int gw = blockIdx.x * NWAVES + wave, NGW = gridDim.x * NWAVES;
    for (int row = gw; row < 2 * 16384; row += NGW) {
        const bool isv = row >= 16384; const int e = isv ? row - 16384 : row;
        const f32x4* sp = (const f32x4*)((isv ? a.pv : a.pu) + (size_t)e * D);
        unsigned char* dst = a.ws + (isv ? WS_TV + (size_t)e * 1024 : WS_TU + (size_t)e * 128);
        unsigned char* sdst = a.ws + (isv ? WS_SV + (size_t)e * 64 : WS_SU + (size_t)e * 8);
        f32x4 v[8];
#pragma unroll
        for (int k = 0; k < 8; ++k) v[k] = __builtin_nontemporal_load(sp + lane + 64 * k);
#pragma unroll
        for (int k = 0; k < 8; ++k) {
            float mx = fmaxf(fmaxf(fabsf(v[k][0]), fabsf(v[k][1])), fmaxf(fabsf(v[k][2]), fabsf(v[k][3])));
            mx = fmaxf(mx, __shfl_xor(mx, 1)); mx = fmaxf(mx, __shfl_xor(mx, 2)); mx = fmaxf(mx, __shfl_xor(mx, 4));
            const unsigned bits = __float_as_uint(mx);
            int kx = (int)(bits >> 23) - 127 - 2 + (((bits & 0x7fffffu) > 0x400000u) ? 1 : 0);
            kx = kx < -126 ? -126 : kx;
            const float inv = __uint_as_float((unsigned)(127 - kx) << 23);
            unsigned p = 0u;
            p = __builtin_amdgcn_cvt_scalef32_pk_fp4_f32(p, v[k][0] * inv, v[k][1] * inv, 1.0f, 0);
            p = __builtin_amdgcn_cvt_scalef32_pk_fp4_f32(p, v[k][2] * inv, v[k][3] * inv, 1.0f, 1);
            *(u16*)(dst + (isv ? (size_t)k * 128 : (size_t)k * SLICE_T) + 2 * lane) = (u16)p;
            if ((lane & 7) == 0) {
                const int c = lane >> 3;
                if (isv) sdst[8 * k + c] = (unsigned char)(kx + 127); else sdst[(size_t)k * SLICE_S + 2 * (c & 3) + (c >> 2)] = (unsigned char)(kx + 127);
            }
        }
    }
}

__device__ __forceinline__ void axpy32_fp4(const uint4 w, const float s, float (&acc)[32]) {
    const unsigned ww[4] = {w.x, w.y, w.z, w.w};
#pragma unroll
    for (int k = 0; k < 4; ++k) {
        const f32x2_t a0 = __builtin_amdgcn_cvt_scalef32_pk_f32_fp4(ww[k], 1.0f, 0), a1 = __builtin_amdgcn_cvt_scalef32_pk_f32_fp4(ww[k], 1.0f, 1);
        const f32x2_t a2 = __builtin_amdgcn_cvt_scalef32_pk_f32_fp4(ww[k], 1.0f, 2), a3 = __builtin_amdgcn_cvt_scalef32_pk_f32_fp4(ww[k], 1.0f, 3);
        acc[8 * k + 0] += s * a0.x; acc[8 * k + 1] += s * a0.y; acc[8 * k + 2] += s * a1.x; acc[8 * k + 3] += s * a1.y;
        acc[8 * k + 4] += s * a2.x; acc[8 * k + 5] += s * a2.y; acc[8 * k + 6] += s * a3.x; acc[8 * k + 7] += s * a3.y;
    }
}
#define DPP_F(v_, ctrl_) __builtin_bit_cast(float, __builtin_amdgcn_update_dpp(0, __builtin_bit_cast(int, v_), ctrl_, 0xf, 0xf, true))
__device__ __forceinline__ void phase_eu(const Args& a, unsigned char* lds) {
    const int* IDX = (const int*)(a.ws + WS_IDX);
    u16* AP = (u16*)(a.ws + WS_AP);
    const int lane = threadIdx.x & 63, wave = threadIdx.x >> 6;
    const int x = blockIdx.x & 7, gw = (blockIdx.x >> 3) * NWAVES + wave, NGW = (((int)gridDim.x - x + 7) >> 3) * NWAVES;
    const unsigned char* TUx = a.ws + WS_TU + (size_t)x * SLICE_T;
    const int m = lane & 15, g = lane >> 4;
    typedef unsigned eu_u32x4 __attribute__((ext_vector_type(4)));
    eu_u32x4 rA[8], rB[8], rC[8], rD[8]; u16 sA[4], sB[4], sC[4], sD[4];
    { const uint4* ssrc = (const uint4*)(a.ws + WS_SU + (size_t)x * SLICE_S);
      for (int i = threadIdx.x; i < (int)(SLICE_S / 16); i += NTHREADS) ((uint4*)lds)[i] = ssrc[i];
      __syncthreads(); }
    i32x8 hB0, hB1, nB0, nB1; int ckx = 0, nkx = 0;
    int i2a = 0, i2b = 0, i3a = 0, i3b = 0;
    const int j8 = lane >> 3, c8 = lane & 7;
    LAS unsigned char* ldsl = (LAS unsigned char*)lds;
    LAS unsigned char* stg = ldsl + LDS_MAIN + 16 + wave * 2048;
#define EU_LOAD(r_, s_, ivh_) do { _Pragma("unroll") for (int q = 0; q < 8; ++q) { \
            const int e_ = __shfl(ivh_, 8 * q + j8); \
            r_[q] = *(const eu_u32x4*)(TUx + ((unsigned)e_ * 128u + 16u * (unsigned)(c8 ^ j8))); } \
        _Pragma("unroll") for (int q = 0; q < 4; ++q) { const int e_ = __shfl(ivh_, 16 * q + m); s_[q] = *(const LAS u16*)(ldsl + e_ * 8 + 2 * g); } } while (0)
    const unsigned char* IMG = a.ws + WS_IMG; const int* KXS = (const int*)(a.ws + WS_KXS);
#define EU_BLOAD(t_, B0_, B1_, kx_) do { const eu_u32x4* ip_ = (const eu_u32x4*)(IMG + ((size_t)(t_) * 8 + x) * 512 + (2 * g + (lane & 1)) * 16); \
            const eu_u32x4 q0_ = __builtin_nontemporal_load(ip_), q1_ = __builtin_nontemporal_load(ip_ + 8), q2_ = __builtin_nontemporal_load(ip_ + 16), q3_ = __builtin_nontemporal_load(ip_ + 24); \
            B0_ = (i32x8){(int)q0_[0], (int)q0_[1], (int)q0_[2], (int)q0_[3], (int)q1_[0], (int)q1_[1], (int)q1_[2], (int)q1_[3]}; \
            B1_ = (i32x8){(int)q2_[0], (int)q2_[1], (int)q2_[2], (int)q2_[3], (int)q3_[0], (int)q3_[1], (int)q3_[2], (int)q3_[3]}; \
            kx_ = KXS[(size_t)(t_) * 8 + x]; } while (0)
#define EU_COMPUTE(r_, s_, kb_, t_, B0_, B1_, sb_, ok_) do { unsigned pa_[4], pb_[4]; _Pragma("unroll") for (int q = 0; q < 4; ++q) { \
            *(LAS eu_u32x4*)(stg + lane * 16) = r_[2 * q]; *(LAS eu_u32x4*)(stg + 1024 + lane * 16) = r_[2 * q + 1]; \
            const eu_u32x4 f0_ = *(const LAS eu_u32x4*)(stg + m * 128 + 16 * (g ^ (m & 7))), f1_ = *(const LAS eu_u32x4*)(stg + m * 128 + 16 * ((4 + g) ^ (m & 7))); \
            const i32x8 A0_ = {(int)f0_[0], (int)f0_[1], (int)f0_[2], (int)f0_[3], 0, 0, 0, 0}; \
            const i32x8 A1_ = {(int)f1_[0], (int)f1_[1], (int)f1_[2], (int)f1_[3], 0, 0, 0, 0}; \
            f32x4 c_ = {0.f, 0.f, 0.f, 0.f}; \
            c_ = __builtin_amdgcn_mfma_scale_f32_16x16x128_f8f6f4(A0_, B0_, c_, 4, 0, 0, (int)s_[q], 0, sb_); \
            c_ = __builtin_amdgcn_mfma_scale_f32_16x16x128_f8f6f4(A1_, B1_, c_, 4, 0, 1, (int)s_[q], 0, sb_); \
            f32x4 o_; _Pragma("unroll") for (int j = 0; j < 4; ++j) o_[j] = c_[j] + DPP_F(c_[j], 0xB1); \
            pa_[q] = pack2(o_[0], o_[1]); pb_[q] = pack2(o_[2], o_[3]); } \
          \
        unsigned ra_ = pa_[0], rb_ = pb_[0]; \
        { const unsigned ta_ = (unsigned)__builtin_amdgcn_update_dpp(0, (int)pa_[1], 0x111, 0xf, 0xf, true), tb_ = (unsigned)__builtin_amdgcn_update_dpp(0, (int)pb_[1], 0x111, 0xf, 0xf, true); ra_ = (m == 1) ? ta_ : ra_; rb_ = (m == 1) ? tb_ : rb_; } \
        { const unsigned ta_ = (unsigned)__builtin_amdgcn_update_dpp(0, (int)pa_[2], 0x112, 0xf, 0xf, true), tb_ = (unsigned)__builtin_amdgcn_update_dpp(0, (int)pb_[2], 0x112, 0xf, 0xf, true); ra_ = (m == 2) ? ta_ : ra_; rb_ = (m == 2) ? tb_ : rb_; } \
        { const unsigned ta_ = (unsigned)__builtin_amdgcn_update_dpp(0, (int)pa_[3], 0x113, 0xf, 0xf, true), tb_ = (unsigned)__builtin_amdgcn_update_dpp(0, (int)pb_[3], 0x113, 0xf, 0xf, true); ra_ = (m == 3) ? ta_ : ra_; rb_ = (m == 3) ? tb_ : rb_; } \
        if (m < 4 && (ok_)) *(uint2*)(AP + ((size_t)(t_) * 8 + x) * 128 + (kb_) + 16 * m + 4 * g) = make_uint2(ra_, rb_); } while (0)
#define EU_IDX(t_, i0_, i1_) do { i0_ = IDX[(size_t)(t_) * 128 + lane]; i1_ = IDX[(size_t)(t_) * 128 + 64 + lane]; } while (0)
#define EU_CLAMP(t_) (((t_) < T) ? (t_) : gw)
    const int hl4 = (lane & 1) ? 4 : 0;
    if (gw < T) {
        int i0a, i0b, i1a, i1b;
        EU_IDX(gw, i0a, i0b); EU_IDX(EU_CLAMP(gw + NGW), i1a, i1b); EU_IDX(EU_CLAMP(gw + 2 * NGW), i2a, i2b); EU_IDX(EU_CLAMP(gw + 3 * NGW), i3a, i3b);
        EU_BLOAD(gw, hB0, hB1, ckx); EU_BLOAD(EU_CLAMP(gw + NGW), nB0, nB1, nkx);
        EU_LOAD(rA, sA, i0a); EU_LOAD(rB, sB, i0b); EU_LOAD(rC, sC, i1a); EU_LOAD(rD, sD, i1b);
    }
    for (int t = gw; t < T; t += 2 * NGW) {
        const int tb = t + NGW; const bool okb = tb < T;
        int j0a, j0b, j1a, j1b; EU_IDX(EU_CLAMP(t + 4 * NGW), j0a, j0b); EU_IDX(EU_CLAMP(t + 5 * NGW), j1a, j1b);
        const int sba = 127 + ckx - hl4, sbb = 127 + nkx - hl4;
        EU_COMPUTE(rA, sA, 0, t, hB0, hB1, sba, true);
        EU_LOAD(rA, sA, i2a);
        EU_COMPUTE(rB, sB, 64, t, hB0, hB1, sba, true);
        EU_LOAD(rB, sB, i2b);
        EU_BLOAD(EU_CLAMP(t + 2 * NGW), hB0, hB1, ckx);
        EU_COMPUTE(rC, sC, 0, EU_CLAMP(tb), nB0, nB1, sbb, okb);
        EU_LOAD(rC, sC, i3a);
        EU_COMPUTE(rD, sD, 64, EU_CLAMP(tb), nB0, nB1, sbb, okb);
        EU_LOAD(rD, sD, i3b);
        EU_BLOAD(EU_CLAMP(t + 3 * NGW), nB0, nB1, nkx);
        i2a = j0a; i2b = j0b; i3a = j1a; i3b = j1b;
    }
#undef EU_CLAMP
#undef EU_LOAD
#undef EU_BLOAD
#undef EU_COMPUTE
#undef EU_IDX
}

__device__ __forceinline__ void phase_ev(const Args& a, unsigned char* lds) {
    const u16* X1 = (const u16*)(a.ws + WS_X1);
    const int* IDX = (const int*)(a.ws + WS_IDX);
    const float* GATE = (const float*)(a.ws + WS_GATE);
    const u16* AP = (const u16*)(a.ws + WS_AP);
    const float* mod = (const float*)(a.ws + WS_MOD);
    const unsigned char* V = a.ws + WS_TV;
    const int lane = threadIdx.x & 63, wave = threadIdx.x >> 6;
    const int gw = blockIdx.x * NWAVES + wave, NGW = gridDim.x * NWAVES;
    LAS f32x4* lga = (LAS f32x4*)lds; LAS f32x4* lgf = (LAS f32x4*)(lds + 4 * 8192);
    for (int i = threadIdx.x; i < 5 * 512; i += NTHREADS) {
        const int v = i >> 9, j = i & 511;
        const float* srcp = (v < 4) ? (mod + v * 12288 + 5 * 2048) : a.g_fin;
        lga[i] = *(const f32x4*)(srcp + 4 * j);
    }
    __syncthreads();
    int iv0 = 0, iv1 = 0; float gv0 = 0.f, gv1 = 0.f;
    int niv0 = 0, niv1 = 0; float ngv0 = 0.f, ngv1 = 0.f;
    uint4 rA[4], rB[4];
    LAS unsigned char* wsc = (LAS unsigned char*)lds + 40960 + wave * 1024; int scs = 0; uint2 scn = make_uint2(0u, 0u);
#define SC_LOAD(i0_, i1_, rb_) do { const int es_ = __shfl(((rb_) < 64) ? (i0_) : (i1_), ((rb_) & 63) + (lane >> 3)); \
            scn = *(const uint2*)(a.ws + WS_SV + (size_t)es_ * 64 + (lane & 7) * 8); } while (0)
#define SC_COMMIT() do { scs ^= 512; typedef unsigned sc_u32x2 __attribute__((ext_vector_type(2))); *(LAS sc_u32x2*)(wsc + scs + lane * 8) = (sc_u32x2){scn.x, scn.y}; } while (0)
#define SC_GET(q8_) ((unsigned)*(const LAS unsigned char*)(wsc + scs + (q8_) * 64 + lane))
#define ROW_LOAD(TB_, r_, s_, r0_) do { _Pragma("unroll") for (int q = 0; q < 4; ++q) { \
            const int rr_ = (r0_) + q; const int e_ = __builtin_amdgcn_readlane(rr_ < 64 ? iv0 : iv1, rr_ & 63); \
            const unsigned char* rp_ = TB_ + (size_t)e_ * TROW; \
            r_[q] = *(const uint4*)(rp_ + lane * 16); } } while (0)
#define TOK_FETCH(t_, i0_, i1_, g0_, g1_, ap_) do { \
            i0_ = IDX[(size_t)(t_) * 128 + lane]; i1_ = IDX[(size_t)(t_) * 128 + 64 + lane]; \
            g0_ = GATE[(size_t)(t_) * 128 + lane]; g1_ = GATE[(size_t)(t_) * 128 + 64 + lane]; \
            _Pragma("unroll") for (int xx = 0; xx < 8; ++xx) { ap_[xx] = AP[((size_t)(t_) * 8 + xx) * 128 + lane]; ap_[8 + xx] = AP[((size_t)(t_) * 8 + xx) * 128 + 64 + lane]; } } while (0)
    u16 ap[16], nap[16];
    if (gw < T) { TOK_FETCH(gw, iv0, iv1, gv0, gv1, ap); ROW_LOAD(V, rA, sA, 0); SC_LOAD(iv0, iv1, 0); SC_COMMIT(); }
    for (int t = gw; t < T; t += NGW) {
        const int b = t / S;
        const bool has_next = (t + NGW) < T;
        float a0 = 0.f, a1 = 0.f;
#pragma unroll
        for (int xx = 0; xx < 8; ++xx) { a0 += bf2f(ap[xx]); a1 += bf2f(ap[8 + xx]); }
        const float w0 = gv0 * gelu_f(a0), w1 = gv1 * gelu_f(a1);
        float acc[32];
#pragma unroll
        for (int i = 0; i < 32; ++i) acc[i] = 0.f;
#define V_COMPUTE(r_, s_, r0_) do { _Pragma("unroll") for (int q = 0; q < 4; ++q) { const int rr_ = (r0_) + q; \
                const float g_ = __builtin_bit_cast(float, __builtin_amdgcn_readlane(__builtin_bit_cast(int, rr_ < 64 ? w0 : w1), rr_ & 63)); \
                axpy32_fp4(r_[q], g_ * __uint_as_float(SC_GET((s_) + q) << 23), acc); } } while (0)
        { const int tn = has_next ? t + NGW : t; TOK_FETCH(tn, niv0, niv1, ngv0, ngv1, nap); }
#pragma unroll 1
        for (int r0 = 0; r0 < 128; r0 += 8) {
            ROW_LOAD(V, rB, sB, r0 + 4);
            if (r0 + 8 < 128) SC_LOAD(iv0, iv1, r0 + 8); else SC_LOAD(niv0, niv1, 0);
            V_COMPUTE(rA, 0, r0);
            if (r0 + 8 < 128) ROW_LOAD(V, rA, sA, r0 + 8);
            else { iv0 = niv0; iv1 = niv1; gv0 = ngv0; gv1 = ngv1;
                _Pragma("unroll") for (int i = 0; i < 16; ++i) ap[i] = nap[i];
                if (has_next) ROW_LOAD(V, rA, sA, 0); }
            V_COMPUTE(rB, 4, r0 + 4);
            SC_COMMIT();
        }
#undef V_COMPUTE
        int lt = lane; asm volatile("" : "+v"(lt));
        LAS unsigned char* tr = (LAS unsigned char*)lds + 49152 + wave * 8192;
#pragma unroll
        for (int k = 0; k < 8; ++k) { f32x4 w4; w4[0] = acc[4 * k]; w4[1] = acc[4 * k + 1]; w4[2] = acc[4 * k + 2]; w4[3] = acc[4 * k + 3];
            *(LAS f32x4*)(tr + lt * 128 + ((k ^ (lt & 7)) << 4)) = w4; }
        f32x4 y[8];
#pragma unroll
        for (int j = 0; j < 8; ++j) y[j] = *(const LAS f32x4*)(tr + (8 * j + (lt >> 3)) * 128 + (((lt & 7) ^ ((lt >> 3) & 7)) << 4));
        float ss = 0.f;
#pragma unroll
        for (int j = 0; j < 8; ++j) {
            const hw_f32x2 xq = __builtin_nontemporal_load((const hw_f32x2*)(X1 + (size_t)t * D + 256 * j + 4 * lt));
            const unsigned px = __float_as_uint(xq[0]), py = __float_as_uint(xq[1]);
            const f32x4 gav = lga[b * 512 + 64 * j + lt];
            y[j][0] = lo2f(px) + gav[0] * y[j][0]; y[j][1] = hi2f(px) + gav[1] * y[j][1]; y[j][2] = lo2f(py) + gav[2] * y[j][2]; y[j][3] = hi2f(py) + gav[3] * y[j][3];
            ss += y[j][0] * y[j][0] + y[j][1] * y[j][1] + y[j][2] * y[j][2] + y[j][3] * y[j][3];
        }
        ss = wave_sum(ss);
        const float rstd = rsqrtf(ss * (1.f / D) + NORM_EPS);
#pragma unroll
        for (int j = 0; j < 8; ++j) {
            const f32x4 gfv = lgf[64 * j + lt];
            *(float4*)(a.out + (size_t)t * D + 256 * j + 4 * lt) = make_float4(y[j][0] * rstd * gfv[0], y[j][1] * rstd * gfv[1], y[j][2] * rstd * gfv[2], y[j][3] * rstd * gfv[3]);
        }
    }
#undef ROW_LOAD
#undef TOK_FETCH
#undef SC_LOAD
#undef SC_COMMIT
#undef SC_GET
}

#undef DPP_F

#define XB_TMO      128
#define XB_XCNT(j)  (256  + 64 * (j))
#define XB_XSUB(j)  (1280 + 64 * (j))
#define XB_XGEN(j)  (2304 + 64 * (j))
#define XB_TOP      3328
#define XB_TOPGEN   3392
#define XCD_BAR_WORDS 3456
#define XB_SPIN_CAP (1u << 18)

__device__ __forceinline__ unsigned xb_ld(unsigned* p)              { return __hip_atomic_load(p, __ATOMIC_RELAXED, __HIP_MEMORY_SCOPE_AGENT); }
__device__ __forceinline__ unsigned xb_add(unsigned* p, unsigned v) { return __hip_atomic_fetch_add(p, v, __ATOMIC_RELAXED, __HIP_MEMORY_SCOPE_AGENT); }
__device__ __forceinline__ unsigned xb_xcc_id() { return (unsigned)__builtin_amdgcn_s_getreg((3 << 11) | 20) & 0xFu; }
#define XB_SPIN(cond, bar) do { unsigned _sp = 0; while (cond) { __builtin_amdgcn_s_sleep(1); \
    if ((++_sp & 255u) == 0u) { if (xb_ld(&(bar)[XB_TMO])) break; if (_sp > XB_SPIN_CAP) { atomicAdd(&(bar)[XB_TMO], 1u); break; } } } } while (0)

struct XcdBarrier {
    unsigned* bar; unsigned x;
    volatile LAS unsigned* st;
};

__device__ __forceinline__ XcdBarrier xcd_barrier_post(unsigned* bar, volatile LAS unsigned* st) {
    XcdBarrier b; b.bar = bar; b.x = xb_xcc_id(); b.st = st;
    if (threadIdx.x == 0) (void)xb_add(&bar[XB_XCNT(b.x)], 1u);
    return b;
}
__device__ __forceinline__ void xcd_barrier_complete(unsigned* bar, unsigned x, unsigned& nloc, unsigned& nx) {
    const unsigned G = gridDim.x * gridDim.y * gridDim.z;
    unsigned sum, cnt, mine, sp = 0u;
    for (;;) {
        sum = 0u; cnt = 0u; mine = 0u;
#pragma unroll
        for (unsigned j = 0; j < 16; ++j) { const unsigned c = xb_ld(&bar[XB_XCNT(j)]); sum += c; cnt += (c > 0u) ? 1u : 0u; mine = (j == x) ? c : mine; }
        if (sum == G) break;
        __builtin_amdgcn_s_sleep(1);
        if ((++sp & 255u) == 0u) { if (xb_ld(&bar[XB_TMO])) break; if (sp > XB_SPIN_CAP) { atomicAdd(&bar[XB_TMO], 1u); break; } }
    }
    nloc = mine > 0u ? mine : 1u; nx = cnt > 0u ? cnt : 1u;
}

__device__ __forceinline__ void xcd_barrier(const XcdBarrier& b) {
    asm volatile("s_waitcnt vmcnt(0)" ::: "memory");
    __syncthreads();
    if (threadIdx.x == 0) {
        unsigned* bar = b.bar;
        __builtin_amdgcn_s_waitcnt(0);
        unsigned nloc = b.st[0], nx = b.st[1];
        if (nloc == 0u) { xcd_barrier_complete(bar, b.x, nloc, nx); b.st[0] = nloc; b.st[1] = nx; }
        const unsigned old = xb_add(&bar[XB_XSUB(b.x)], 1u);
        const unsigned gen = old / nloc;
        if (old + 1u == (gen + 1u) * nloc) {
            __builtin_amdgcn_fence(__ATOMIC_RELEASE, "agent");
            asm volatile("s_waitcnt vmcnt(0)" ::: "memory");
            const unsigned og = xb_add(&bar[XB_TOP], 1u);
            const unsigned tg = og / nx;
            if (og + 1u == (tg + 1u) * nx) xb_add(&bar[XB_TOPGEN], 1u);
            else XB_SPIN(xb_ld(&bar[XB_TOPGEN]) == tg, bar);
            __builtin_amdgcn_fence(__ATOMIC_ACQUIRE, "agent");
            xb_add(&bar[XB_XGEN(b.x)], 1u);
            asm volatile("s_waitcnt vmcnt(0)" ::: "memory");
        } else {
            XB_SPIN(xb_ld(&bar[XB_XGEN(b.x)]) == gen, bar);
            __builtin_amdgcn_fence(__ATOMIC_ACQUIRE, "agent");
            asm volatile("s_waitcnt vmcnt(0)" ::: "memory");
        }
    }
    __syncthreads();
}

constexpr int NPHASES = 12;
__global__ void __launch_bounds__(NTHREADS, 2) mk_fwd(Args a) {
    extern __shared__ __attribute__((aligned(16))) unsigned char lds[];
    cg::grid_group grid = cg::this_grid();
    const int lo = a.ph_lo, hi = a.ph_hi;
    volatile LAS unsigned* xbw = (volatile LAS unsigned*)(lds + LDS_MAIN);
    if (threadIdx.x < 4) xbw[threadIdx.x] = 0u;
    __syncthreads();
    XcdBarrier xbar = xcd_barrier_post((unsigned*)(a.ws + WS_CTL), xbw);
#define IN(k) (lo <= (k) && (k) < hi)
    if (lo < 0) grid.sync();
#define SEAM(k) do { if (IN(k) && IN((k) + 1)) xcd_barrier(xbar); } while (0)
    const float* mod = (const float*)(a.ws + WS_MOD);
    if (IN(0)) phase0(a, lds);
    SEAM(0);
    if (IN(1)) norm_mod_phase<false>(a.x, a.g_mix, mod, 0, 1, (u16*)(a.ws + WS_ACT), lds);
    SEAM(1);
    if (IN(2)) { gemm8(lds, (const u16*)(a.ws + WS_ACT), (const u16*)(a.ws + WS_WIN), T, NP, D, EpiProj{(u16*)(a.ws + WS_P), (const float*)(a.ws + WS_CS)}); gz_phase(lds, (const u16*)(a.ws + WS_ACT), (const u16*)(a.ws + WS_WIN) + (size_t)NP * D, (float*)(a.ws + WS_GZ)); }
    SEAM(2);
    if (IN(3)) phase_rope_prep(a, lds);
    SEAM(3);
    if (IN(4)) phase_mixers(a, lds);
    SEAM(4);
    if (IN(5)) phase_gla_fin(a);
    SEAM(5);
    if (IN(6)) gemm8(lds, (const u16*)(a.ws + WS_ACT), (const u16*)(a.ws + WS_WOUT), T, D, D, EpiResid{a.x, mod, (u16*)(a.ws + WS_X1)});
    SEAM(6);
    if (IN(7)) { norm_img_phase((const u16*)(a.ws + WS_X1), a.g_ffn, mod, 3, 4, (u16*)(a.ws + WS_ACT), lds, a.ws + WS_IMG, (int*)(a.ws + WS_KXS)); convert_tables(a); }
    SEAM(7);
    if (IN(8)) gemm8(lds, (const u16*)(a.ws + WS_ACT), (const u16*)(a.ws + WS_WPQ), T, D, D, EpiBf16{(u16*)(a.ws + WS_Q)});
    SEAM(8);
    if (IN(9)) phase_route(a, lds);
    SEAM(9);
    if (IN(10)) phase_eu(a, lds);
    SEAM(10);
    if (IN(11)) phase_ev(a, lds);
#undef IN
#undef SEAM
}

#ifndef MK_ONE_LAUNCH
#define MK_ONE_LAUNCH 1
#endif
extern "C" void kernel_launch(void* const* d_in, const int* in_sizes, int n_in, void* d_out, int out_size, void* d_ws, size_t ws_size, hipStream_t stream) {
    static int grid = 0;
    if (grid == 0) {
        if (n_in != 19 || out_size != T * D || ws_size < WS_END) {
            fprintf(stderr, "kernel_launch: unexpected shapes: n_in %d out %d ws %zu (need %zu)\n", n_in, out_size, ws_size, (size_t)WS_END);
            grid = -1; return;
        }
        int dev = 0, cus = 0, per_cu = 0;
        (void)hipGetDevice(&dev);
        (void)hipDeviceGetAttribute(&cus, hipDeviceAttributeMultiprocessorCount, dev);
        (void)hipFuncSetAttribute((const void*)mk_fwd, hipFuncAttributeMaxDynamicSharedMemorySize, LDS_BYTES);
        (void)hipOccupancyMaxActiveBlocksPerMultiprocessor(&per_cu, (const void*)mk_fwd, NTHREADS, LDS_BYTES);
        if (per_cu < 1) { fprintf(stderr, "kernel_launch: occupancy query says %d blocks/CU\n", per_cu); grid = -1; return; }
        grid = cus;
        (void)hipGetLastError();
    }
    if (grid < 0) return;
    Args a{};
    a.x = (const float*)d_in[0]; a.c = (const float*)d_in[1]; a.pos = (const int*)d_in[2]; a.w_ada = (const float*)d_in[3];
    a.b_ada = (const float*)d_in[4]; a.g_mix = (const float*)d_in[5]; a.w_in = (const float*)d_in[6]; a.wgf = (const float*)d_in[7];
    a.bgf = (const float*)d_in[8]; a.wgb = (const float*)d_in[9]; a.bgb = (const float*)d_in[10]; a.g_gla = (const float*)d_in[11];
    a.w_out = (const float*)d_in[12]; a.g_ffn = (const float*)d_in[13]; a.w_pq = (const float*)d_in[14]; a.subk = (const float*)d_in[15];
    a.pu = (const float*)d_in[16]; a.pv = (const float*)d_in[17]; a.g_fin = (const float*)d_in[18];
    a.out = (float*)d_out; a.ws = (unsigned char*)d_ws;
#if MK_ONE_LAUNCH
    (void)hipMemsetAsync((unsigned char*)d_ws + WS_CTL, 0, XCD_BAR_WORDS * 4, stream);
    a.ph_lo = 0; a.ph_hi = NPHASES;
    void* args[] = {&a};
    hipError_t e = hipLaunchCooperativeKernel((const void*)mk_fwd, dim3(grid), dim3(NTHREADS), args, LDS_BYTES, stream);
    if (e != hipSuccess) fprintf(stderr, "cooperative launch failed: %s (grid %d)\n", hipGetErrorString(e), grid);
#else
    for (int p = 0; p < NPHASES; ++p) {
        a.ph_lo = p; a.ph_hi = p + 1;
        hipLaunchKernelGGL(mk_fwd, dim3(grid), dim3(NTHREADS), LDS_BYTES, stream, a);
    }
#endif
}
```
